# Optimizing an MI355X kernel written in HIP

```python
import math
import jax
import jax.numpy as jnp
from jax import lax
import numpy as np

D_MODEL = 1024
BATCH = 2
SEQ = 8192
DEPTH = 2

HEAD_DIM = 64
D_MIX = D_MODEL
MLSTM_WIDTH = D_MIX // 4
MLSTM_HEADS = MLSTM_WIDTH // HEAD_DIM
RWKV_WIDTH = 3 * D_MIX // 8
RWKV_HEADS = RWKV_WIDTH // HEAD_DIM
SSD_WIDTH = D_MIX - MLSTM_WIDTH - RWKV_WIDTH
SSD_HEADS = SSD_WIDTH // HEAD_DIM
SSD_GROUPS = 2
SSD_STATE = 128
RWKV_RANK_W = 64
RWKV_RANK_A = 64
RWKV_RANK_G = 128
CONV_WIDTH = 5
CHUNK = 64
FFN_HIDDEN = ((8 * D_MODEL + 3 * 256 - 1) // (3 * 256)) * 256
RMS_EPS = 1e-6
MLSTM_LN_EPS = 1e-6
RWKV_LN_EPS = 64e-5

MLSTM_COLS = 4 * MLSTM_WIDTH
RWKV_COLS = 3 * RWKV_WIDTH + 2 * RWKV_RANK_W + RWKV_RANK_A + RWKV_RANK_G
SSD_XBC = SSD_WIDTH + 2 * SSD_GROUPS * SSD_STATE
SSD_COLS = SSD_WIDTH + SSD_XBC + 2 * SSD_HEADS
N_IN = MLSTM_COLS + RWKV_COLS + SSD_COLS

kernel_name = "hybrid_mlstm_rwkv7_ssd_encoder"


def split_last(t, sizes):
    idx = [int(i) for i in np.cumsum(sizes)[:-1]]
    return jnp.split(t, idx, axis=-1)


def to_heads(t, n_heads):
    return t.reshape(t.shape[:-1] + (n_heads, t.shape[-1] // n_heads))


def flip_seq(t):
    return jnp.flip(t, axis=1)


def rmsnorm(x, g):
    xf = x.astype(jnp.float32)
    y = xf * lax.rsqrt(jnp.mean(xf * xf, -1, keepdims=True) + RMS_EPS)
    return (y * g).astype(x.dtype)


def head_layernorm(h, gain, bias, n_heads, eps):
    shp = h.shape
    hh = to_heads(h, n_heads)
    c = hh - jnp.mean(hh, -1, keepdims=True)
    y = (c * lax.rsqrt(jnp.mean(c * c, -1, keepdims=True) + eps)).reshape(shp) * gain
    return y if bias is None else y + bias


def centred_dwconv(x, w, b):
    pad = (CONV_WIDTH - 1) // 2
    y = lax.conv_general_dilated(x, w[:, None, :].astype(x.dtype), window_strides=(1,),
                                 padding=[(pad, pad)], dimension_numbers=('NWC', 'WIO', 'NWC'),
                                 feature_group_count=x.shape[-1])
    return y + b


def token_shift_mix(p, mu_prev, mu_next):
    prev = jnp.pad(p, ((0, 0), (1, 0), (0, 0)))[:, :-1]
    nxt = jnp.pad(p, ((0, 0), (0, 1), (0, 0)))[:, 1:]
    return p + mu_prev * (prev - p) + mu_next * (nxt - p)


def mlstm_chunkwise(q, k, v, log_i, log_f):
    bsz, s, h, d = q.shape
    nc = s // CHUNK
    q, k, v = (t.reshape(bsz, nc, CHUNK, h, d) for t in (q, k, v))
    li = log_i.reshape(bsz, nc, CHUNK, h)
    b = jnp.cumsum(log_f.reshape(bsz, nc, CHUNK, h), axis=2)
    b_last = b[:, :, -1]
    mask = jnp.tril(jnp.ones((CHUNK, CHUNK), dtype=bool))[None, None, :, :, None]
    dmat = jnp.where(mask, b[:, :, :, None] - b[:, :, None, :] + li[:, :, None, :], -jnp.inf)
    g = b_last[:, :, None] - b + li
    m_loc = jnp.max(g, axis=2)
    kw = k * jnp.exp(g - m_loc[:, :, None])[..., None]
    c_loc = jnp.einsum('bclhd,bclhe->bchde', kw, v)
    n_loc = jnp.sum(kw, axis=2)

    def step(carry, inp):
        c_st, n_st, m_st = carry
        cl, nl, ml, bl = inp
        m_new = jnp.maximum(bl + m_st, ml)
        s_old = jnp.exp(bl + m_st - m_new)
        s_new = jnp.exp(ml - m_new)
        c_next = s_old[..., None, None] * c_st + s_new[..., None, None] * cl
        n_next = s_old[..., None] * n_st + s_new[..., None] * nl
        return (c_next, n_next, m_new), (c_st, n_st, m_st)

    init = (jnp.zeros((bsz, h, d, d), jnp.float32), jnp.zeros((bsz, h, d), jnp.float32),
            jnp.zeros((bsz, h), jnp.float32))
    xs = tuple(jnp.moveaxis(t, 1, 0) for t in (c_loc, n_loc, m_loc, b_last))
    _, (c_prev, n_prev, m_prev) = lax.scan(step, init, xs)
    c_prev = jnp.moveaxis(c_prev, 0, 1)
    n_prev = jnp.moveaxis(n_prev, 0, 1)
    m_prev = jnp.moveaxis(m_prev, 0, 1)

    inter_log = b + m_prev[:, :, None]
    m_q = jnp.maximum(inter_log, jnp.max(dmat, axis=3))
    inter_w = jnp.exp(inter_log - m_q)
    scores = jnp.einsum('bclhd,bcshd->bclsh', q, k) * jnp.exp(dmat - m_q[:, :, :, None])
    num = (jnp.einsum('bclsh,bcshe->bclhe', scores, v)
           + inter_w[..., None] * jnp.einsum('bclhd,bchde->bclhe', q, c_prev))
    den = jnp.sum(scores, axis=3) + inter_w * jnp.einsum('bclhd,bchd->bclh', q, n_prev)
    out = num / jnp.maximum(jnp.abs(den), jnp.exp(-m_q))[..., None]
    return out.reshape(bsz, s, h, d)


def mlstm_mixer(cols, conv_w, conv_b, gate_w, gate_b, norm_g):
    qk_in, v, o = split_last(cols, [2 * MLSTM_WIDTH, MLSTM_WIDTH, MLSTM_WIDTH])
    qk = jax.nn.silu(centred_dwconv(qk_in, conv_w, conv_b))
    q, k = split_last(qk, [MLSTM_WIDTH, MLSTM_WIDTH])
    gates = jnp.concatenate([q, k, v], -1) @ gate_w + gate_b
    li_f, li_b, fp_f, fp_b = split_last(gates, [MLSTM_HEADS] * 4)
    qh = to_heads(q, MLSTM_HEADS)
    kh = to_heads(k, MLSTM_HEADS) * (HEAD_DIM ** -0.5)
    vh = to_heads(v, MLSTM_HEADS)
    h_f = mlstm_chunkwise(qh, kh, vh, li_f, jax.nn.log_sigmoid(fp_f))
    h_b = flip_seq(mlstm_chunkwise(flip_seq(qh), flip_seq(kh), flip_seq(vh), flip_seq(li_b),
                                   flip_seq(jax.nn.log_sigmoid(fp_b))))
    hsum = (h_f + h_b).reshape(cols.shape[:-1] + (MLSTM_WIDTH,))
    return jax.nn.sigmoid(o) * head_layernorm(hsum, norm_g, None, MLSTM_HEADS, MLSTM_LN_EPS)


def rwkv7_scan(r, w, k, v, kk, a):
    bsz, _, h, d = r.shape

    def step(state, inp):
        r_t, w_t, k_t, v_t, kk_t, a_t = inp
        sa = jnp.einsum('bhvk,bhk->bhv', state, kk_t)
        state = (state * w_t[:, :, None, :] - sa[..., None] * (kk_t * a_t)[:, :, None, :]
                 + v_t[..., None] * k_t[:, :, None, :])
        return state, jnp.einsum('bhvk,bhk->bhv', state, r_t)

    xs = tuple(jnp.moveaxis(t, 1, 0) for t in (r, w, k, v, kk, a))
    _, y = lax.scan(step, jnp.zeros((bsz, h, d, d), jnp.float32), xs)
    return jnp.moveaxis(y, 0, 1)


def rwkv7_mixer(cols, mu_prev, mu_next, w0, w_up, a0, a_up, g_up, k_k, k_a, r_k, norm_g, norm_b):
    cols = token_shift_mix(cols, mu_prev, mu_next)
    r, k, v, wd_f, wd_b, ad, gd = split_last(
        cols, [RWKV_WIDTH] * 3 + [RWKV_RANK_W, RWKV_RANK_W, RWKV_RANK_A, RWKV_RANK_G])
    a = jax.nn.sigmoid(a0 + ad @ a_up)
    gate = jax.nn.sigmoid(gd) @ g_up
    kk = to_heads(k * k_k, RWKV_HEADS)
    kk = kk / jnp.maximum(jnp.sqrt(jnp.sum(kk * kk, -1, keepdims=True)), 1e-12)
    k = k * (1.0 + (a - 1.0) * k_a)

    def decay(wd, d):
        w_log = -jax.nn.softplus(-(w0[d] + jnp.tanh(wd) @ w_up[d])) - 0.5
        return to_heads(jnp.exp(-jnp.exp(w_log)), RWKV_HEADS)

    rh, kh, vh, ah = (to_heads(t, RWKV_HEADS) for t in (r, k, v, a))
    y_f = rwkv7_scan(rh, decay(wd_f, 0), kh, vh, kk, ah)
    y_b = flip_seq(rwkv7_scan(flip_seq(rh), flip_seq(decay(wd_b, 1)), flip_seq(kh), flip_seq(vh),
                              flip_seq(kk), flip_seq(ah)))
    shp = cols.shape[:-1] + (RWKV_WIDTH,)
    y = head_layernorm((y_f + y_b).reshape(shp), norm_g, norm_b, RWKV_HEADS, RWKV_LN_EPS)
    bonus = jnp.sum(rh * kh * r_k, -1, keepdims=True) * vh
    return (y + bonus.reshape(shp)) * gate


def ssd_chunked(x, dt, a, bm, cm):
    bsz, s, g, hg, p = x.shape
    n = bm.shape[-1]
    nc = s // CHUNK
    x = x.reshape(bsz, nc, CHUNK, g, hg, p)
    dt = dt.reshape(bsz, nc, CHUNK, g, hg)
    bm = bm.reshape(bsz, nc, CHUNK, g, n)
    cm = cm.reshape(bsz, nc, CHUNK, g, n)
    a_cs = jnp.cumsum(dt * a, axis=2)
    xdt = x * dt[..., None]
    mask = jnp.tril(jnp.ones((CHUNK, CHUNK), dtype=bool))[None, None, :, :, None, None]
    seg = jnp.where(mask, a_cs[:, :, :, None] - a_cs[:, :, None, :], -jnp.inf)
    scores = jnp.einsum('bclgn,bcsgn->bclsg', cm, bm)[..., None] * jnp.exp(seg)
    y_diag = jnp.einsum('bclsgh,bcsghp->bclghp', scores, xdt)
    decay_to_end = jnp.exp(a_cs[:, :, -1:] - a_cs)
    states = jnp.einsum('bclgn,bclghp->bcghpn', bm, xdt * decay_to_end[..., None])
    chunk_decay = jnp.exp(a_cs[:, :, -1])

    def step(hstate, inp):
        dec, st = inp
        return dec[..., None, None] * hstate + st, hstate

    _, prev = lax.scan(step, jnp.zeros((bsz, g, hg, p, n), jnp.float32),
                       (jnp.moveaxis(chunk_decay, 1, 0), jnp.moveaxis(states, 1, 0)))
    prev = jnp.moveaxis(prev, 0, 1)
    y_off = jnp.einsum('bclgn,bcghpn->bclghp', cm, prev) * jnp.exp(a_cs)[..., None]
    return (y_diag + y_off).reshape(bsz, s, g, hg, p)


def ssd_mixer(cols, conv_w, conv_b, dt_bias, a_log, d_skip, norm_g):
    z, xbc, dt_raw = split_last(cols, [SSD_WIDTH, SSD_XBC, 2 * SSD_HEADS])
    xbc = jax.nn.silu(centred_dwconv(xbc, conv_w, conv_b))
    xs, bm, cm = split_last(xbc, [SSD_WIDTH, SSD_GROUPS * SSD_STATE, SSD_GROUPS * SSD_STATE])
    bsz, s = cols.shape[0], cols.shape[1]
    hg = SSD_HEADS // SSD_GROUPS
    xh = xs.reshape(bsz, s, SSD_GROUPS, hg, HEAD_DIM)
    bm = bm.reshape(bsz, s, SSD_GROUPS, SSD_STATE)
    cm = cm.reshape(bsz, s, SSD_GROUPS, SSD_STATE)
    dt = jax.nn.softplus(dt_raw.reshape(bsz, s, 2, SSD_HEADS) + dt_bias).reshape(bsz, s, 2, SSD_GROUPS, hg)
    a = -jnp.exp(a_log).reshape(2, SSD_GROUPS, hg)
    y_f = ssd_chunked(xh, dt[:, :, 0], a[0], bm, cm)
    y_b = flip_seq(ssd_chunked(flip_seq(xh), flip_seq(dt[:, :, 1]), a[1], flip_seq(bm), flip_seq(cm)))
    y = y_f + y_b + d_skip.reshape(SSD_GROUPS, hg)[..., None] * xh
    y = y.reshape(bsz, s, SSD_WIDTH) * jax.nn.silu(z)
    yg = y.reshape(bsz, s, SSD_GROUPS, SSD_WIDTH // SSD_GROUPS)
    yg = yg * lax.rsqrt(jnp.mean(yg * yg, -1, keepdims=True) + RMS_EPS)
    return yg.reshape(bsz, s, SSD_WIDTH) * norm_g


def setup_inputs(seed: int = 0) -> dict:
    key = jax.random.key(seed)
    keys = iter(jax.random.split(key, 48))

    def nrm(shape, scale):
        return scale * jax.random.normal(next(keys), shape, jnp.float32)

    def uni(shape, lo, hi):
        return jax.random.uniform(next(keys), shape, jnp.float32, lo, hi)

    L = DEPTH
    x = nrm((BATCH, SEQ, D_MODEL), 1.0)
    norm_mix_g = 1.0 + nrm((L, D_MODEL), 0.02)
    w_in = nrm((L, D_MODEL, N_IN), D_MODEL ** -0.5)
    mlstm_conv_w = nrm((L, CONV_WIDTH, 2 * MLSTM_WIDTH), CONV_WIDTH ** -0.5)
    mlstm_conv_b = nrm((L, 2 * MLSTM_WIDTH), 0.02)
    mlstm_gate_w = nrm((L, 3 * MLSTM_WIDTH, 4 * MLSTM_HEADS), 0.5 * (3 * MLSTM_WIDTH) ** -0.5)
    fbias = jnp.tile(jnp.linspace(3.0, 6.0, MLSTM_HEADS), (L, 2))
    mlstm_gate_b = jnp.concatenate([nrm((L, 2 * MLSTM_HEADS), 0.1),
                                    fbias + nrm((L, 2 * MLSTM_HEADS), 0.1)], -1)
    mlstm_norm_g = 1.0 + nrm((L, MLSTM_WIDTH), 0.02)
    rwkv_mu_prev = uni((L, RWKV_COLS), 0.0, 0.5)
    rwkv_mu_next = uni((L, RWKV_COLS), 0.0, 0.5)
    rwkv_w0 = jnp.linspace(-6.5, -1.5, RWKV_WIDTH) + nrm((L, 2, RWKV_WIDTH), 0.1)
    rwkv_w_up = nrm((L, 2, RWKV_RANK_W, RWKV_WIDTH), 0.5 * RWKV_RANK_W ** -0.5)
    rwkv_a0 = nrm((L, RWKV_WIDTH), 0.1)
    rwkv_a_up = nrm((L, RWKV_RANK_A, RWKV_WIDTH), RWKV_RANK_A ** -0.5)
    rwkv_g_up = nrm((L, RWKV_RANK_G, RWKV_WIDTH), RWKV_RANK_G ** -0.5)
    rwkv_k_k = 0.85 + nrm((L, RWKV_WIDTH), 0.02)
    rwkv_k_a = 1.0 + nrm((L, RWKV_WIDTH), 0.02)
    rwkv_r_k = nrm((L, RWKV_HEADS, HEAD_DIM), 0.1)
    rwkv_norm_g = 1.0 + nrm((L, RWKV_WIDTH), 0.02)
    rwkv_norm_b = nrm((L, RWKV_WIDTH), 0.02)
    ssd_conv_w = nrm((L, CONV_WIDTH, SSD_XBC), CONV_WIDTH ** -0.5)
    ssd_conv_b = nrm((L, SSD_XBC), 0.02)
    dt0 = jnp.exp(uni((L, 2, SSD_HEADS), math.log(1e-3), math.log(1e-1)))
    ssd_dt_bias = dt0 + jnp.log(-jnp.expm1(-dt0))
    ssd_a_log = jnp.log(uni((L, 2, SSD_HEADS), 1.0, 16.0))
    ssd_d = 1.0 + nrm((L, SSD_HEADS), 0.1)
    ssd_norm_g = 1.0 + nrm((L, SSD_WIDTH), 0.02)
    w_out = nrm((L, D_MIX, D_MODEL), D_MIX ** -0.5)
    norm_ffn_g = 1.0 + nrm((L, D_MODEL), 0.02)
    w_gate = nrm((L, D_MODEL, FFN_HIDDEN), D_MODEL ** -0.5)
    w_up = nrm((L, D_MODEL, FFN_HIDDEN), D_MODEL ** -0.5)
    w_down = nrm((L, FFN_HIDDEN, D_MODEL), FFN_HIDDEN ** -0.5)
    norm_final_g = 1.0 + nrm((D_MODEL,), 0.02)
    return {"x": x, "norm_mix_g": norm_mix_g, "w_in": w_in,
            "mlstm_conv_w": mlstm_conv_w, "mlstm_conv_b": mlstm_conv_b,
            "mlstm_gate_w": mlstm_gate_w, "mlstm_gate_b": mlstm_gate_b, "mlstm_norm_g": mlstm_norm_g,
            "rwkv_mu_prev": rwkv_mu_prev, "rwkv_mu_next": rwkv_mu_next, "rwkv_w0": rwkv_w0,
            "rwkv_w_up": rwkv_w_up, "rwkv_a0": rwkv_a0, "rwkv_a_up": rwkv_a_up, "rwkv_g_up": rwkv_g_up,
            "rwkv_k_k": rwkv_k_k, "rwkv_k_a": rwkv_k_a, "rwkv_r_k": rwkv_r_k,
            "rwkv_norm_g": rwkv_norm_g, "rwkv_norm_b": rwkv_norm_b,
            "ssd_conv_w": ssd_conv_w, "ssd_conv_b": ssd_conv_b, "ssd_dt_bias": ssd_dt_bias,
            "ssd_a_log": ssd_a_log, "ssd_d": ssd_d, "ssd_norm_g": ssd_norm_g,
            "w_out": w_out, "norm_ffn_g": norm_ffn_g, "w_gate": w_gate, "w_up": w_up,
            "w_down": w_down, "norm_final_g": norm_final_g}


def reference(x, norm_mix_g, w_in, mlstm_conv_w, mlstm_conv_b, mlstm_gate_w, mlstm_gate_b,
              mlstm_norm_g, rwkv_mu_prev, rwkv_mu_next, rwkv_w0, rwkv_w_up, rwkv_a0, rwkv_a_up,
              rwkv_g_up, rwkv_k_k, rwkv_k_a, rwkv_r_k, rwkv_norm_g, rwkv_norm_b, ssd_conv_w,
              ssd_conv_b, ssd_dt_bias, ssd_a_log, ssd_d, ssd_norm_g, w_out, norm_ffn_g, w_gate,
              w_up, w_down, norm_final_g):
    h = x
    for l in range(DEPTH):
        u = rmsnorm(h, norm_mix_g[l])
        cols = (u @ w_in[l]).astype(jnp.float32)
        c_a, c_r, c_s = split_last(cols, [MLSTM_COLS, RWKV_COLS, SSD_COLS])
        y_a = mlstm_mixer(c_a, mlstm_conv_w[l], mlstm_conv_b[l], mlstm_gate_w[l],
                          mlstm_gate_b[l], mlstm_norm_g[l])
        y_r = rwkv7_mixer(c_r, rwkv_mu_prev[l], rwkv_mu_next[l], rwkv_w0[l], rwkv_w_up[l],
                          rwkv_a0[l], rwkv_a_up[l], rwkv_g_up[l], rwkv_k_k[l], rwkv_k_a[l],
                          rwkv_r_k[l], rwkv_norm_g[l], rwkv_norm_b[l])
        y_s = ssd_mixer(c_s, ssd_conv_w[l], ssd_conv_b[l], ssd_dt_bias[l], ssd_a_log[l],
                        ssd_d[l], ssd_norm_g[l])
        mixed = jnp.concatenate([y_a, y_r, y_s], -1).astype(h.dtype)
        h = h + mixed @ w_out[l]
        u = rmsnorm(h, norm_ffn_g[l])
        h = h + (jax.nn.silu(u @ w_gate[l]) * (u @ w_up[l])) @ w_down[l]
    return rmsnorm(h, norm_final_g)
```

```cpp
#include <hip/hip_runtime.h>
#include <hip/hip_cooperative_groups.h>
#include <cstdio>
#include <cstdint>
namespace pg8 {
#define PG8_LAS __attribute__((address_space(3)))
typedef unsigned short bf16_t;
typedef short bf16x8 __attribute__((ext_vector_type(8)));
typedef float f32x4 __attribute__((ext_vector_type(4)));
typedef unsigned u32x4 __attribute__((ext_vector_type(4)));
constexpr int BM = 256, BK = 64, HALF = 128, HTB = HALF * BK * 2  , STAGE_BYTES = 8 * HTB, NXCD = 8, WGM = 8;

__host__ __device__ __forceinline__ int lds_byte(int r, int c) { const int st = (r >> 4) * 2 + (c >> 5), rr = r & 15, cc = c & 31, ob = rr * 64 + cc * 2; return st * 1024 + (ob ^ (((ob >> 9) & 1) << 5)); }
__host__ __device__ __forceinline__ void stage_rc(int b, int& R, int& C) { const int st = b / 1024, sb = b % 1024, swz = sb ^ (((sb >> 9) & 1) << 5); R = (st >> 1) * 16 + swz / 64; C = (st & 1) * 32 + (swz % 64) / 2; }
__host__ __device__ __forceinline__ int perm32(int rho) { const int n = rho >> 4, i = rho & 15; return 8 * (i >> 2) + 4 * n + (i & 3); }

struct Unit { int pm, pn; };
struct Gemm { const bf16_t* A; const bf16_t* Bt; int M, N, K; };

struct StaticOrder {
    int nM, nN, nwg, G, c;
    __host__ __device__ void init(int M, int N, int G_, int c_) { nM = M / BM; nN = N / BM; nwg = nM * nN; G = G_; c = c_; }
    __host__ __device__ bool next(int i, Unit& u) const {
        const long L = (long)i * G + c; if (L >= nwg) return false;
        int wgid = (int)L; { const int q = nwg / NXCD, r = nwg % NXCD, xcd = wgid % NXCD, off = wgid / NXCD; wgid = (xcd < r ? xcd * (q + 1) : r * (q + 1) + (xcd - r) * q) + off; }
        const int nig = WGM * nN, gid = wgid / nig, fm = gid * WGM, gsz = (nM - fm) < WGM ? (nM - fm) : WGM;
        u.pm = fm + ((wgid % nig) % gsz); u.pn = (wgid % nig) / gsz; return true;
    }
    __device__ __forceinline__ void a_ready(const Unit&) const {}
    __device__ __forceinline__ void done(const Unit&) const {}
};

__device__ __forceinline__ unsigned cvt_pk_bf16(float lo, float hi) { unsigned r; asm volatile("v_cvt_pk_bf16_f32 %0, %1, %2" : "=v"(r) : "v"(lo), "v"(hi)); return r; }
typedef float f32x2 __attribute__((ext_vector_type(2)));
__device__ __forceinline__ f32x2 gelu_pk(f32x2 v) {
    const f32x2 av = __builtin_elementwise_abs(v), d = av * 0.2316418882f + 1.0f;
    f32x2 t; t.x = __builtin_amdgcn_rcpf(d.x); t.y = __builtin_amdgcn_rcpf(d.y);
    f32x2 q = t * 0.5307027145f + (-0.7265760135f); q = q * t + 0.7107068705f; q = q * t + (-0.142248368f); q = q * t + 0.127414796f; q = q * t;
    const f32x2 s = (v * v) * (-0.72134752044f);
    f32x2 e; e.x = __builtin_amdgcn_exp2f(s.x); e.y = __builtin_amdgcn_exp2f(s.y);
    const f32x2 m = v * (q * e), r = v - m;
    f32x2 o; o.x = v.x < 0.f ? m.x : r.x; o.y = v.y < 0.f ? m.y : r.y; return o;
}

template <int ACT  > struct EpiBf16 {
    static constexpr bool PERM = true, AFTER_DRAIN = false; static_assert(ACT == 0 || ACT == 1, "EpiBf16: ACT is 0 (none) or 1 (gelu_pk)");
    bf16_t* O; int ldc; const float* bias; int split_cols; size_t split_stride; float scale0;
    __device__ __forceinline__ void operator()(const f32x4 (&acc)[2][2][4][2], const Unit& u, int wr, int wc, int fr, int fq) const {
        const int row0 = u.pm * BM + wr * 64 + fr; int colt = u.pn * BM; bf16_t* base = O;
        float sc = 1.f; if (split_cols) { const int t = colt / split_cols; base += (size_t)t * split_stride; colt -= t * split_cols; if (t == 0) sc = scale0; }
        const int col0 = colt + wc * 32 + 8 * fq, bcol0 = u.pn * BM + wc * 32 + 8 * fq;
        f32x4 bv[2][2];
#pragma unroll
        for (int bj = 0; bj < 2; ++bj)
#pragma unroll
            for (int n = 0; n < 2; ++n) bv[bj][n] = bias ? *(const f32x4*)(bias + bcol0 + bj * HALF + 4 * n) : (f32x4){0.f, 0.f, 0.f, 0.f};
#pragma unroll
        for (int ai = 0; ai < 2; ++ai)
#pragma unroll
            for (int m = 0; m < 4; ++m) { bf16_t* rowp = base + (size_t)(row0 + ai * HALF + m * 16) * ldc + col0;
#pragma unroll
                for (int bj = 0; bj < 2; ++bj) { f32x4 v0 = acc[ai][bj][m][0] + bv[bj][0], v1 = acc[ai][bj][m][1] + bv[bj][1];
                    if (ACT == 1) { f32x2 a = gelu_pk((f32x2){v0[0], v0[1]}), b = gelu_pk((f32x2){v0[2], v0[3]}), c = gelu_pk((f32x2){v1[0], v1[1]}), d = gelu_pk((f32x2){v1[2], v1[3]});
                        v0 = (f32x4){a.x, a.y, b.x, b.y}; v1 = (f32x4){c.x, c.y, d.x, d.y}; }
                    v0 = v0 * sc; v1 = v1 * sc; u32x4 w; w.x = cvt_pk_bf16(v0[0], v0[1]); w.y = cvt_pk_bf16(v0[2], v0[3]); w.z = cvt_pk_bf16(v1[0], v1[1]); w.w = cvt_pk_bf16(v1[2], v1[3]);
                    *(u32x4*)(rowp + bj * HALF) = w; } }
    }
};
struct EpiResidual {
    static constexpr bool PERM = false, AFTER_DRAIN = false;
    const float* base; float* out; int ldc;
    __device__ __forceinline__ void operator()(const f32x4 (&acc)[2][2][4][2], const Unit& u, int wr, int wc, int fr, int fq) const {
        const int col0 = u.pn * BM + wc * 32 + 4 * fq;
#pragma unroll
        for (int ai = 0; ai < 2; ++ai)
#pragma unroll
            for (int m = 0; m < 4; ++m) { const size_t off = (size_t)(u.pm * BM + ai * HALF + wr * 64 + m * 16 + fr) * ldc + col0;
#pragma unroll
                for (int bj = 0; bj < 2; ++bj)
#pragma unroll
                    for (int n = 0; n < 2; ++n) { const f32x4 bs = *(const f32x4*)(base + off + bj * HALF + n * 16); *(f32x4*)(out + off + bj * HALF + n * 16) = bs + acc[ai][bj][m][n]; }
                asm volatile("" ::: "memory"); }
    }
};
struct EpiSwiGLU {
    static constexpr bool PERM = true, AFTER_DRAIN = false;
    bf16_t* O; int ldc;
    __device__ __forceinline__ void operator()(const f32x4 (&acc)[2][2][4][2], const Unit& u, int wr, int wc, int fr, int fq) const {
        const int col0 = u.pn * HALF + wc * 32 + 8 * fq;
#pragma unroll
        for (int ai = 0; ai < 2; ++ai)
#pragma unroll
            for (int m = 0; m < 4; ++m) { bf16_t* rowp = O + (size_t)(u.pm * BM + ai * HALF + wr * 64 + m * 16 + fr) * ldc + col0;
                float r[8];
#pragma unroll
                for (int n = 0; n < 2; ++n)
#pragma unroll
                    for (int j = 0; j < 4; ++j) { const float g = acc[ai][0][m][n][j], up = acc[ai][1][m][n][j]; r[n * 4 + j] = g * __builtin_amdgcn_rcpf(1.f + __expf(-g)) * up; }
                u32x4 w; w.x = cvt_pk_bf16(r[0], r[1]); w.y = cvt_pk_bf16(r[2], r[3]); w.z = cvt_pk_bf16(r[4], r[5]); w.w = cvt_pk_bf16(r[6], r[7]);
                *(u32x4*)rowp = w; }
    }
};
template <class Epi, class Sched, bool ALIGN_EPI = false, bool SP2 = false>
__device__ __forceinline__ void gemm_phase(PG8_LAS unsigned char* lds, const Gemm g, const Sched& S, const Epi& E) {
    const int tid = threadIdx.x, wid = __builtin_amdgcn_readfirstlane(tid >> 6), lane = tid & 63, wr = wid >> 2, wc = wid & 3, fr = lane & 15, fq = lane >> 4;
    const int K = g.K, nt = K / BK;
    unsigned voffA[2], voffB[2];
#pragma unroll
    for (int i = 0; i < 2; ++i) { int R, C; stage_rc(tid * 16 + i * 8192, R, C); const int Rb = Epi::PERM ? ((R & ~31) + perm32(R & 31)) : R;
        voffA[i] = (unsigned)(R * K + C) * 2u; voffB[i] = (unsigned)(Rb * K + C) * 2u; }
    const size_t kstep = (size_t)(BK * 2);
    const size_t hstep = (size_t)HALF * K * 2;
    const size_t tstep = 2 * hstep;
    const unsigned ldsw = (unsigned)wid * 1024u;
    const int aoff = lds_byte(wr * 64 + fr, fq * 8), boff = lds_byte(wc * 32 + fr, fq * 8);
#define PG8_SA(b, h) (((b) * 2 + (h)) * HTB)
#define PG8_SB(b, h) ((4 + (b) * 2 + (h)) * HTB)
#define PG8_STAGE(bufoff, gbase, voff) do { _Pragma("unroll") for (int _i = 0; _i < 2; ++_i) \
        __builtin_amdgcn_global_load_lds((const unsigned*)((const char*)(gbase) + (voff)[_i]), (PG8_LAS unsigned*)(lds + (bufoff) + ldsw + _i * 8192), 16, 0, 0); } while (0)
#define PG8_LDA(dst, b, h) do { _Pragma("unroll") for (int m = 0; m < 4; ++m) _Pragma("unroll") for (int k = 0; k < 2; ++k) dst[m][k] = *(const PG8_LAS bf16x8*)(lds + PG8_SA(b, h) + aoff + m * 2048 + k * 1024); } while (0)
#define PG8_LDB(dst, b, h) do { _Pragma("unroll") for (int n = 0; n < 2; ++n) _Pragma("unroll") for (int k = 0; k < 2; ++k) dst[n][k] = *(const PG8_LAS bf16x8*)(lds + PG8_SB(b, h) + boff + n * 2048 + k * 1024); } while (0)
#define PG8_MMA(ai, bj, At, Bt) do { __builtin_amdgcn_s_setprio(1); _Pragma("unroll") for (int m = 0; m < 4; ++m) _Pragma("unroll") for (int n = 0; n < 2; ++n) _Pragma("unroll") for (int k = 0; k < 2; ++k) \
        acc[ai][bj][m][n] = __builtin_amdgcn_mfma_f32_16x16x32_bf16(Bt[n][k], At[m][k], acc[ai][bj][m][n], 0, 0, 0); __builtin_amdgcn_s_setprio(0); } while (0)
#define PG8_WAIT_V(n) asm volatile("s_waitcnt vmcnt(" #n ")" ::: "memory")
#define PG8_WAIT_L(n) asm volatile("s_waitcnt lgkmcnt(" #n ")" ::: "memory")
#define PG8_BAR __builtin_amdgcn_s_barrier()
#define PG8_SCHED __builtin_amdgcn_sched_barrier(0)
    Unit cur, nxt; int ui = 0;
    if (!S.next(0, cur)) return;
    f32x4 acc[2][2][4][2];
#pragma unroll
    for (int a = 0; a < 2; ++a)
#pragma unroll
        for (int b = 0; b < 2; ++b)
#pragma unroll
            for (int m = 0; m < 4; ++m)
#pragma unroll
                for (int n = 0; n < 2; ++n) acc[a][b][m][n] = (f32x4){0.f, 0.f, 0.f, 0.f};
    bf16x8 At[4][2], B0[2][2], B1[2][2];
    const char* cA = (const char*)g.A + (size_t)cur.pm * tstep; const char* cB = (const char*)g.Bt + (size_t)cur.pn * tstep;
    S.a_ready(cur);
    if constexpr (SP2) {
        PG8_STAGE(PG8_SB(0, 0), cB, voffB); PG8_STAGE(PG8_SB(0, 1), cB + hstep, voffB); PG8_STAGE(PG8_SA(0, 0), cA, voffA); PG8_STAGE(PG8_SA(0, 1), cA + hstep, voffA);
        if (wr == 1) PG8_BAR;
        PG8_WAIT_V(2); PG8_BAR;
        PG8_STAGE(PG8_SB(1, 0), cB + kstep, voffB); PG8_STAGE(PG8_SA(1, 0), cA + kstep, voffA); PG8_STAGE(PG8_SB(1, 1), cB + hstep + kstep, voffB);
        PG8_WAIT_V(6); PG8_BAR;
    } else {
        PG8_STAGE(PG8_SB(0, 0), cB, voffB); PG8_STAGE(PG8_SA(0, 0), cA, voffA); PG8_STAGE(PG8_SB(0, 1), cB + hstep, voffB); PG8_STAGE(PG8_SA(0, 1), cA + hstep, voffA);
        if (wr == 1) PG8_BAR;
        PG8_WAIT_V(4); PG8_BAR;
        PG8_STAGE(PG8_SB(1, 0), cB + kstep, voffB); PG8_STAGE(PG8_SA(1, 0), cA + kstep, voffA); PG8_STAGE(PG8_SB(1, 1), cB + hstep + kstep, voffB);
        PG8_WAIT_V(6); PG8_BAR;
    }
    for (;;) {
        const bool has_next = S.next(ui + 1, nxt);
        const char* nA = has_next ? (const char*)g.A + (size_t)nxt.pm * tstep : cA; const char* nB = has_next ? (const char*)g.Bt + (size_t)nxt.pn * tstep : cB;
        for (int t = 0; t < nt; t += 2) {
            const bool last = (t == nt - 2);
            const char* a1 = cA + (size_t)(t + 1) * kstep;
            const char* a2 = last ? nA : cA + (size_t)(t + 2) * kstep; const char* b2 = last ? nB : cB + (size_t)(t + 2) * kstep;
            const char* a3 = a2 + kstep; const char* b3 = b2 + kstep;
            if (last && has_next) S.a_ready(nxt);
            if constexpr (SP2) {
            PG8_LDB(B0, 0, 0); PG8_LDB(B1, 0, 1); PG8_SCHED; PG8_LDA(At, 0, 0); PG8_STAGE(PG8_SA(1, 1), a1 + hstep, voffA);
            PG8_WAIT_V(8); PG8_WAIT_L(0); PG8_BAR; PG8_MMA(0, 0, At, B0); PG8_MMA(0, 1, At, B1); PG8_BAR; PG8_SCHED;
            PG8_LDA(At, 0, 1); PG8_STAGE(PG8_SB(0, 0), b2, voffB); PG8_STAGE(PG8_SB(0, 1), b2 + hstep, voffB); PG8_STAGE(PG8_SA(0, 0), a2, voffA);
            PG8_WAIT_V(8); PG8_WAIT_L(0); PG8_BAR; PG8_MMA(1, 0, At, B0); PG8_MMA(1, 1, At, B1); PG8_BAR; PG8_SCHED;
            PG8_LDB(B0, 1, 0); PG8_LDB(B1, 1, 1); PG8_SCHED; PG8_LDA(At, 1, 0); PG8_STAGE(PG8_SA(0, 1), a2 + hstep, voffA);
            PG8_WAIT_V(8); PG8_WAIT_L(0); PG8_BAR; PG8_MMA(0, 0, At, B0); PG8_MMA(0, 1, At, B1); PG8_BAR; PG8_SCHED;
            PG8_LDA(At, 1, 1); PG8_STAGE(PG8_SB(1, 0), b3, voffB); PG8_STAGE(PG8_SB(1, 1), b3 + hstep, voffB); PG8_STAGE(PG8_SA(1, 0), a3, voffA);
            PG8_WAIT_V(8); PG8_WAIT_L(0); PG8_BAR; PG8_MMA(1, 0, At, B0); PG8_MMA(1, 1, At, B1); PG8_BAR; PG8_SCHED;
            } else {
            PG8_LDB(B0, 0, 0); PG8_SCHED; PG8_LDA(At, 0, 0); PG8_STAGE(PG8_SA(1, 1), a1 + hstep, voffA);
            PG8_WAIT_L(8); PG8_BAR; PG8_WAIT_L(0); PG8_MMA(0, 0, At, B0); PG8_BAR; PG8_SCHED;
            PG8_LDB(B1, 0, 1); PG8_STAGE(PG8_SB(0, 0), b2, voffB);
            PG8_BAR; PG8_WAIT_L(0); PG8_MMA(0, 1, At, B1); PG8_BAR;
            PG8_LDA(At, 0, 1); PG8_STAGE(PG8_SA(0, 0), a2, voffA);
            PG8_BAR; PG8_WAIT_L(0); PG8_MMA(1, 0, At, B0); PG8_BAR; PG8_SCHED;
            PG8_STAGE(PG8_SB(0, 1), b2 + hstep, voffB);
            PG8_WAIT_V(6); PG8_BAR; PG8_MMA(1, 1, At, B1); PG8_BAR;
            PG8_LDB(B0, 1, 0); PG8_SCHED; PG8_LDA(At, 1, 0); PG8_STAGE(PG8_SA(0, 1), a2 + hstep, voffA);
            PG8_WAIT_L(8); PG8_BAR; PG8_WAIT_L(0); PG8_MMA(0, 0, At, B0); PG8_BAR; PG8_SCHED;
            PG8_LDB(B1, 1, 1); PG8_STAGE(PG8_SB(1, 0), b3, voffB);
            PG8_BAR; PG8_WAIT_L(0); PG8_MMA(0, 1, At, B1); PG8_BAR;
            PG8_LDA(At, 1, 1); PG8_STAGE(PG8_SA(1, 0), a3, voffA);
            PG8_BAR; PG8_WAIT_L(0); PG8_MMA(1, 0, At, B0); PG8_BAR; PG8_SCHED;
            PG8_STAGE(PG8_SB(1, 1), b3 + hstep, voffB);
            PG8_WAIT_V(6); PG8_BAR; PG8_MMA(1, 1, At, B1); PG8_BAR;
            }
        }
        if constexpr (ALIGN_EPI) { if (wr == 0) PG8_BAR; }
        if constexpr (!Epi::AFTER_DRAIN) { E(acc, cur, wr, wc, fr, fq); S.done(cur); }
        if (!has_next) break;
#pragma unroll
        for (int a = 0; a < 2; ++a)
#pragma unroll
            for (int b = 0; b < 2; ++b)
#pragma unroll
                for (int m = 0; m < 4; ++m)
#pragma unroll
                    for (int n = 0; n < 2; ++n) acc[a][b][m][n] = (f32x4){0.f, 0.f, 0.f, 0.f};
        cur = nxt; cA = nA; cB = nB; ++ui;
        if constexpr (ALIGN_EPI) { if (wr == 1) PG8_BAR; }
    }
    PG8_WAIT_V(0);
    if constexpr (!ALIGN_EPI) { if (wr == 0) PG8_BAR; }
    PG8_BAR;
    if constexpr (Epi::AFTER_DRAIN) { E.fused(acc, cur, wr, wc, fr, fq, lds, wid, lane); S.done(cur); }
#undef PG8_SA
#undef PG8_SB
#undef PG8_STAGE
#undef PG8_LDA
#undef PG8_LDB
#undef PG8_MMA
#undef PG8_WAIT_V
#undef PG8_WAIT_L
#undef PG8_BAR
#undef PG8_SCHED
}
}

#ifndef PG8_SP2
#define PG8_SP2 true
#endif
#define PG8_ALIGN true
constexpr int NWAVES = 8;
constexpr int BATCH = 2, SEQ = 8192, DM = 1024, M = BATCH * SEQ, NIN = 3788, NINP = 3840, FFN = 2816, DEPTH = 2;
constexpr int A_Q = 0, A_K = 256, A_V = 512, A_O = 768;
constexpr int R_R = 1024, R_K = 1408, R_V = 1792, R_WDF = 2176, R_AD = 2304, R_GD = 2368;
constexpr int S_Z = 2496, S_X = 2880, S_B = 3264, S_C = 3520, S_DT = 3776;
constexpr size_t MiB = 1u << 20;
constexpr size_t WS_CTL = 0, CTL_ZERO_BYTES = 64 * 1024;
constexpr size_t WS_GATES = 1 * MiB, WS_CT = 2 * MiB;
constexpr size_t WS_WIN = 4 * MiB, WS_WOUT = 12 * MiB, WS_WGU = 14 * MiB, WS_WDN = 25 * MiB;
constexpr size_t WS_XN = 32 * MiB, WS_COLS = 64 * MiB, WS_Y = 184 * MiB, WS_END = 248 * MiB;
constexpr size_t Y_AF = WS_Y, Y_AB = WS_Y + 8 * MiB, Y_RF = WS_Y + 16 * MiB, Y_RB = WS_Y + 28 * MiB, Y_SF = WS_Y + 40 * MiB, Y_SB = WS_Y + 52 * MiB;
constexpr int CW_BAR = 1024;
constexpr int RING_BYTES = 131072;
constexpr int LDS_BYTES = 147456, MISC_OFF = LDS_BYTES - 256;

#define GAS __attribute__((address_space(1)))
#define LAS __attribute__((address_space(3)))
typedef unsigned short bf16;
typedef unsigned v4u __attribute__((ext_vector_type(4)));
typedef unsigned v2u __attribute__((ext_vector_type(2)));
typedef float f32x4 __attribute__((ext_vector_type(4)));
typedef short bf16x8 __attribute__((ext_vector_type(8)));
typedef GAS unsigned gu32;
#define RLX_AGENT __ATOMIC_RELAXED, __HIP_MEMORY_SCOPE_AGENT
#define LDS_WAIT() asm volatile("s_waitcnt lgkmcnt(0)" ::: "memory")
#define VM_WAIT() asm volatile("s_waitcnt vmcnt(0)" ::: "memory")
__device__ __forceinline__ unsigned f2bf(float f) { unsigned u = __builtin_bit_cast(unsigned, f); return (u + 0x7fffu + ((u >> 16) & 1u)) >> 16; }
__device__ __forceinline__ unsigned pk2(float lo, float hi) { return f2bf(lo) | (f2bf(hi) << 16); }
__device__ __forceinline__ float bf2f(unsigned u) { return __builtin_bit_cast(float, u << 16); }
__device__ __forceinline__ float sigmoidf_(float x) { return __builtin_amdgcn_rcpf(1.f + __expf(-x)); }
__device__ __forceinline__ float siluf_(float x) { return x * sigmoidf_(x); }
__device__ __forceinline__ float wave_sum(float v) {
#pragma unroll
    for (int o = 1; o < 64; o <<= 1) v += __shfl_xor(v, o);
    return v;
}
__device__ __forceinline__ float wave_max(float v) {
#pragma unroll
    for (int o = 1; o < 64; o <<= 1) v = fmaxf(v, __shfl_xor(v, o));
    return v;
}
template <int CTRL> __device__ __forceinline__ float dppf(float v) { return __builtin_bit_cast(float, __builtin_amdgcn_update_dpp(0, __builtin_bit_cast(int, v), CTRL, 0xf, 0xf, true)); }
__device__ __forceinline__ float row16_sum(float v) { v += dppf<0xB1>(v); v += dppf<0x4E>(v); v += dppf<0x141>(v); v += dppf<0x140>(v); return v; }
template <int K> __device__ __forceinline__ f32x4 mma16(const LAS bf16* A, int lda, const LAS bf16* Bt, int ldb, f32x4 acc, int lane) {
    const int r = lane & 15, q = lane >> 4;
    const LAS bf16* ap = A + r * lda + q * 8; const LAS bf16* bp = Bt + r * ldb + q * 8;
#pragma unroll
    for (int k0 = 0; k0 < K; k0 += 32) {
        const bf16x8 a = *(const LAS bf16x8*)(ap + k0); const bf16x8 b = *(const LAS bf16x8*)(bp + k0);
        acc = __builtin_amdgcn_mfma_f32_16x16x32_bf16(a, b, acc, 0, 0, 0);
    }
    return acc;
}
#define XB_TMO      128
#define XB_XCNT(j)  (256  + 64 * (j))
#define XB_XSUB(j)  (1280 + 64 * (j))
#define XB_XGEN(j)  (2304 + 64 * (j))
#define XB_TOP      3328
#define XB_TOPGEN   3392
#define XCD_BAR_WORDS 3456
#define XB_SPIN_CAP (1u << 18)

__device__ __forceinline__ unsigned xb_ld(unsigned* p)              { return __hip_atomic_load(p, __ATOMIC_RELAXED, __HIP_MEMORY_SCOPE_AGENT); }
__device__ __forceinline__ unsigned xb_add(unsigned* p, unsigned v) { return __hip_atomic_fetch_add(p, v, __ATOMIC_RELAXED, __HIP_MEMORY_SCOPE_AGENT); }
__device__ __forceinline__ unsigned xb_xcc_id() { return (unsigned)__builtin_amdgcn_s_getreg((3 << 11) | 20) & 0xFu; }
#define XB_SPIN(cond, bar) do { unsigned _sp = 0; while (cond) { __builtin_amdgcn_s_sleep(1); \
    if ((++_sp & 255u) == 0u) { if (xb_ld(&(bar)[XB_TMO])) break; if (_sp > XB_SPIN_CAP) { atomicAdd(&(bar)[XB_TMO], 1u); break; } } } } while (0)

struct XcdBarrier {
    unsigned* bar; unsigned x;
    volatile LAS unsigned* st;
};

__device__ __forceinline__ XcdBarrier xcd_barrier_post(unsigned* bar, volatile LAS unsigned* st) {
    XcdBarrier b; b.bar = bar; b.x = xb_xcc_id(); b.st = st;
    if (threadIdx.x == 0) (void)xb_add(&bar[XB_XCNT(b.x)], 1u);
    return b;
}
__device__ __forceinline__ void xcd_barrier_complete(unsigned* bar, unsigned x, unsigned& nloc, unsigned& nx) {
    const unsigned G = gridDim.x * gridDim.y * gridDim.z;
    unsigned sum, cnt, mine, sp = 0u;
    for (;;) {
        sum = 0u; cnt = 0u; mine = 0u;
#pragma unroll
        for (unsigned j = 0; j < 16; ++j) { const unsigned c = xb_ld(&bar[XB_XCNT(j)]); sum += c; cnt += (c > 0u) ? 1u : 0u; mine = (j == x) ? c : mine; }
        if (sum == G) break;
        __builtin_amdgcn_s_sleep(1);
        if ((++sp & 255u) == 0u) { if (xb_ld(&bar[XB_TMO])) break; if (sp > XB_SPIN_CAP) { atomicAdd(&bar[XB_TMO], 1u); break; } }
    }
    nloc = mine > 0u ? mine : 1u; nx = cnt > 0u ? cnt : 1u;
}

__device__ __forceinline__ void xcd_barrier(const XcdBarrier& b) {
    asm volatile("s_waitcnt vmcnt(0)" ::: "memory");
    __syncthreads();
    if (threadIdx.x == 0) {
        unsigned* bar = b.bar;
        __builtin_amdgcn_s_waitcnt(0);
        unsigned nloc = b.st[0], nx = b.st[1];
        if (nloc == 0u) { xcd_barrier_complete(bar, b.x, nloc, nx); b.st[0] = nloc; b.st[1] = nx; }
        const unsigned old = xb_add(&bar[XB_XSUB(b.x)], 1u);
        const unsigned gen = old / nloc;
        if (old + 1u == (gen + 1u) * nloc) {
            __builtin_amdgcn_fence(__ATOMIC_RELEASE, "agent");
            asm volatile("s_waitcnt vmcnt(0)" ::: "memory");
            const unsigned og = xb_add(&bar[XB_TOP], 1u);
            const unsigned tg = og / nx;
            if (og + 1u == (tg + 1u) * nx) xb_add(&bar[XB_TOPGEN], 1u);
            else XB_SPIN(xb_ld(&bar[XB_TOPGEN]) == tg, bar);
            __builtin_amdgcn_fence(__ATOMIC_ACQUIRE, "agent");
            xb_add(&bar[XB_XGEN(b.x)], 1u);
            asm volatile("s_waitcnt vmcnt(0)" ::: "memory");
        } else {
            XB_SPIN(xb_ld(&bar[XB_XGEN(b.x)]) == gen, bar);
            __builtin_amdgcn_fence(__ATOMIC_ACQUIRE, "agent");
            asm volatile("s_waitcnt vmcnt(0)" ::: "memory");
        }
    }
    __syncthreads();
}
struct Frame {
    LAS unsigned char* lds;
    int tid, lane, wave, vcu, G;
};
struct Args { const float* in[32]; float* out; unsigned char* ws; int ph_lo, ph_hi; };
constexpr int PTAB_OFF = LDS_BYTES - 768;
__device__ __forceinline__ unsigned long long ptab_ld(const Frame& F, int i) {
    const unsigned long long v = *(volatile LAS unsigned long long*)(F.lds + PTAB_OFF + 8 * i);
    const unsigned lo = __builtin_amdgcn_readfirstlane((unsigned)v), hi = __builtin_amdgcn_readfirstlane((unsigned)(v >> 32));
    return ((unsigned long long)hi << 32) | lo;
}
__device__ __forceinline__ const float* INP(const Frame& F, int i) { return (const float*)ptab_ld(F, i); }
__device__ __forceinline__ unsigned char* WSP(const Frame& F) { return (unsigned char*)ptab_ld(F, 33); }
__device__ __forceinline__ float* OUTP(const Frame& F) { return (float*)ptab_ld(F, 32); }

__device__ __forceinline__ void transpose_item(const float* W, int K, int N, int nblk, bf16* WT, int mode, int row_off, LAS float* scr, int item, int lane) {
    const int kb = item / nblk, nb = item % nblk, k0 = 64 * kb, n0 = 32 * nb;
    const int ncol = n0 + (lane & 31); const bool ok = ncol < N;
#pragma unroll 8
    for (int i = 0; i < 32; ++i) { const int kk = 2 * i + (lane >> 5); scr[kk * 33 + (lane & 31)] = ok ? W[(size_t)(k0 + kk) * N + ncol] : 0.f; }
    LDS_WAIT(); asm volatile("" ::: "memory");
    const int c = lane & 7;
    const int drow0 = mode ? (256 * (n0 >> 7) + (n0 & 127) + row_off) : (row_off + n0);
#pragma unroll
    for (int j = 0; j < 4; ++j) { const int n = (lane >> 3) + 8 * j; const LAS float* s = scr + (8 * c) * 33 + n;
        v4u o; o.x = pk2(s[0 * 33], s[1 * 33]); o.y = pk2(s[2 * 33], s[3 * 33]); o.z = pk2(s[4 * 33], s[5 * 33]); o.w = pk2(s[6 * 33], s[7 * 33]);
        *(v4u*)(WT + (size_t)(drow0 + n) * K + k0 + 8 * c) = o; }
    LDS_WAIT(); asm volatile("" ::: "memory");
}
__device__ __forceinline__ void phase_convert(const Frame& F, int l) {
    LAS float* scr = (LAS float*)(F.lds + F.wave * 16384);
    const int gw = F.vcu * NWAVES + F.wave, NGW = F.G * NWAVES;
    bf16* Win = (bf16*)(WSP(F) + WS_WIN); bf16* Wout = (bf16*)(WSP(F) + WS_WOUT); bf16* Wgu = (bf16*)(WSP(F) + WS_WGU); bf16* Wdn = (bf16*)(WSP(F) + WS_WDN);
    constexpr int I_IN = 16 * 120, I_OUT = 16 * 32, I_G = 16 * 88, I_D = 44 * 32;
    constexpr int NITEMS = I_IN + I_OUT + 2 * I_G + I_D;
    for (int it = gw; it < NITEMS; it += NGW) {
        int r = it;
        if (r < I_IN) { transpose_item(INP(F, 2) + (size_t)l * DM * NIN, DM, NIN, 120, Win, 0, 0, scr, r, F.lane); continue; } r -= I_IN;
        if (r < I_OUT) { transpose_item(INP(F, 26) + (size_t)l * DM * DM, DM, DM, 32, Wout, 0, 0, scr, r, F.lane); continue; } r -= I_OUT;
        if (r < I_G) { transpose_item(INP(F, 28) + (size_t)l * DM * FFN, DM, FFN, 88, Wgu, 1, 0, scr, r, F.lane); continue; } r -= I_G;
        if (r < I_G) { transpose_item(INP(F, 29) + (size_t)l * DM * FFN, DM, FFN, 88, Wgu, 1, 128, scr, r, F.lane); continue; } r -= I_G;
        transpose_item(INP(F, 30) + (size_t)l * FFN * DM, FFN, DM, 32, Wdn, 0, 0, scr, r, F.lane);
    }
}
__device__ __forceinline__ void phase_norm(const Frame& F, const float* hin, const float* g, bf16* XN) {
    const int gw = F.vcu * NWAVES + F.wave, NGW = F.G * NWAVES;
    f32x4 gv[4];
#pragma unroll
    for (int j = 0; j < 4; ++j) gv[j] = ((const f32x4*)g)[64 * j + F.lane];
    for (int m = gw; m < M; m += NGW) {
        const f32x4* xr = (const f32x4*)(hin + (size_t)m * DM) + F.lane;
        f32x4 v[4]; float s = 0.f;
#pragma unroll
        for (int j = 0; j < 4; ++j) { v[j] = xr[64 * j]; s += (v[j].x * v[j].x + v[j].y * v[j].y) + (v[j].z * v[j].z + v[j].w * v[j].w); }
        const float r = 1.f / sqrtf(wave_sum(s) * (1.f / DM) + 1e-6f);
        v2u* o8 = (v2u*)(XN + (size_t)m * DM) + F.lane;
#pragma unroll
        for (int j = 0; j < 4; ++j) { v2u w; w.x = pk2(v[j].x * r * gv[j].x, v[j].y * r * gv[j].y); w.y = pk2(v[j].z * r * gv[j].z, v[j].w * r * gv[j].w); o8[64 * j] = w; }
    }
}
__device__ __forceinline__ void phase_final_norm(const Frame& F, float* h, const float* g) {
    const int gw = F.vcu * NWAVES + F.wave, NGW = F.G * NWAVES;
    f32x4 gv[4];
#pragma unroll
    for (int j = 0; j < 4; ++j) gv[j] = ((const f32x4*)g)[64 * j + F.lane];
    for (int m = gw; m < M; m += NGW) {
        f32x4* xr = (f32x4*)(h + (size_t)m * DM) + F.lane;
        f32x4 v[4]; float s = 0.f;
#pragma unroll
        for (int j = 0; j < 4; ++j) { v[j] = xr[64 * j]; s += (v[j].x * v[j].x + v[j].y * v[j].y) + (v[j].z * v[j].z + v[j].w * v[j].w); }
        const float r = 1.f / sqrtf(wave_sum(s) * (1.f / DM) + 1e-6f);
#pragma unroll
        for (int j = 0; j < 4; ++j) xr[64 * j] = v[j] * r * gv[j];
    }
}
__device__ __forceinline__ void phase_gates(const Frame& F, int l) {
    const bf16* cols = (const bf16*)(WSP(F) + WS_COLS); float* GT = (float*)(WSP(F) + WS_GATES);
    LAS bf16* raw = (LAS bf16*)(F.lds);
    LAS float* feat = (LAS float*)(F.lds + 32768);
    LAS float* gw = (LAS float*)(F.lds + 81920);
    const float* gwg = INP(F, 5) + (size_t)l * 768 * 16; const float* gb = INP(F, 6) + l * 16;
    const float* cw = INP(F, 3) + (size_t)l * 5 * 512; const float* cb = INP(F, 4) + l * 512;
    for (int i = F.tid; i < 768 * 16; i += 512) gw[i] = gwg[i];
    for (int tile = F.vcu; tile < M / 16; tile += F.G) {
        const int m0 = tile * 16, t0 = m0 % SEQ;
        __syncthreads();
        for (int ch = F.tid; ch < 20 * 96; ch += 512) { const int rr = ch / 96, cc = ch % 96; const int t = t0 - 2 + rr;
            v4u v = {0u, 0u, 0u, 0u}; if (t >= 0 && t < SEQ) v = *(const v4u*)(cols + (size_t)(m0 - 2 + rr) * NINP + cc * 8);
            *(LAS v4u*)(raw + rr * 768 + cc * 8) = v; }
        __syncthreads();
        for (int idx = F.tid; idx < 16 * 768; idx += 512) { const int t = idx / 768, c = idx % 768; float val;
            if (c < 512) { float s = cb[c];
#pragma unroll
                for (int j = 0; j < 5; ++j) s += cw[j * 512 + c] * bf2f(raw[(t + j) * 768 + c]);
                val = siluf_(s); } else val = bf2f(raw[(t + 2) * 768 + c]);
            feat[idx] = val; }
        __syncthreads();
        { const int t = F.tid >> 5, o = (F.tid >> 1) & 15, hf = F.tid & 1; float s = 0.f;
          const LAS float* fp = feat + t * 768 + hf * 384; const LAS float* wp = gw + (hf * 384) * 16 + o;
#pragma unroll 8
          for (int i = 0; i < 384; ++i) s += fp[i] * wp[i * 16];
          s += __shfl_xor(s, 1);
          if (hf == 0) { s += gb[o]; if (o >= 8) s = fminf(s, 0.f) - log1pf(__expf(-fabsf(s))); GT[(size_t)(m0 + t) * 16 + o] = s; } }
    }
    __syncthreads();
}
__device__ __forceinline__ void rwkv_scan(const Frame& F, int l, int task) {
    const int b = task / 24, rem = task % 24, h = rem >> 2, dir = (rem >> 1) & 1, half = rem & 1;
    const bf16* cols = (const bf16*)(WSP(F) + WS_COLS);
    bf16* Y = (bf16*)(WSP(F) + (dir ? Y_RB : Y_RF));
    float* CT = (float*)(WSP(F) + WS_CT);
    LAS bf16* WA = (LAS bf16*)(F.lds); LAS bf16* WW = (LAS bf16*)(F.lds + 9216);
    LAS bf16* XA = (LAS bf16*)(F.lds + 18432); LAS bf16* XW = (LAS bf16*)(F.lds + 23040);
    LAS bf16* RAWB = (LAS bf16*)(F.lds + 27648);
    LAS float* OPS = (LAS float*)(F.lds + 49408); LAS float* VV = (LAS float*)(F.lds + 90368);
    LAS float* MU = (LAS float*)(F.lds + 94464); LAS float* YB = (LAS float*)(F.lds + 97024);
    const int tid = F.tid, lane = F.lane, wave = F.wave;
    __syncthreads();
    { const float* aup = INP(F, 13) + (size_t)l * 64 * 384; const float* wup = INP(F, 11) + (size_t)(l * 2 + dir) * 64 * 384;
      for (int idx = tid; idx < 4096; idx += 512) { const int i = idx >> 6, c = idx & 63;
          WA[c * 72 + i] = (bf16)f2bf(aup[i * 384 + h * 64 + c]); WW[c * 72 + i] = (bf16)f2bf(wup[i * 384 + h * 64 + c]); }
      if (tid < 320) { const int which = tid >> 6, c = tid & 63;
          const int rc = which == 0 ? h * 64 + c : which == 1 ? 384 + h * 64 + c : which == 2 ? 768 + h * 64 + c : which == 3 ? 1152 + dir * 64 + c : 1280 + c;
          MU[tid] = INP(F, 8)[l * 1472 + rc]; MU[320 + tid] = INP(F, 9)[l * 1472 + rc]; } }
    const int hc = h * 64 + lane;
    const float kk_c = INP(F, 15)[l * 384 + hc], ka_c = INP(F, 16)[l * 384 + hc], rk_c = INP(F, 17)[l * 384 + hc];
    const int mat = wave >> 2, ct = wave & 3;
    const float bias3 = mat ? INP(F, 10)[(l * 2 + dir) * 384 + h * 64 + 16 * ct + (lane & 15)] : INP(F, 12)[l * 384 + h * 64 + 16 * ct + (lane & 15)];
    const int row = wave * 4 + (lane >> 4), j = lane & 15;
    f32x4 S = {0.f, 0.f, 0.f, 0.f};
    v4u pre[3];
    const size_t mb = (size_t)b * SEQ;
#define RW_ISSUE(blk) do { const int T0_ = dir ? SEQ - 32 * ((blk) + 1) : 32 * (blk); _Pragma("unroll") for (int i_ = 0; i_ < 3; ++i_) { const int idx_ = tid + 512 * i_; pre[i_] = (v4u){0u, 0u, 0u, 0u}; \
        if (idx_ < 1360) { const int rr_ = idx_ / 40, q_ = idx_ % 40, wh_ = q_ >> 3, c8_ = q_ & 7; const int t_ = T0_ - 1 + rr_; \
            const int gc_ = (wh_ == 0 ? R_R + h * 64 : wh_ == 1 ? R_K + h * 64 : wh_ == 2 ? R_V + h * 64 : wh_ == 3 ? R_WDF + dir * 64 : R_AD) + c8_ * 8; \
            if (t_ >= 0 && t_ < SEQ) pre[i_] = *(const v4u*)(cols + (mb + t_) * NINP + gc_); } } } while (0)
    RW_ISSUE(0);
    for (int blk = 0; blk < SEQ / 32; ++blk) {
        const int T0 = dir ? SEQ - 32 * (blk + 1) : 32 * blk;
#pragma unroll
        for (int i = 0; i < 3; ++i) { const int idx = tid + 512 * i; if (idx < 1360) { const int rr = idx / 40, q = idx % 40; *(LAS v4u*)(RAWB + rr * 320 + q * 8) = pre[i]; } }
        __syncthreads();
        if (blk + 1 < SEQ / 32) RW_ISSUE(blk + 1);
        for (int idx = tid; idx < 32 * 320; idx += 512) { const int t = idx / 320, cc = idx % 320, which = cc >> 6, c = cc & 63;
            const float p0 = bf2f(RAWB[t * 320 + cc]), p1 = bf2f(RAWB[(t + 1) * 320 + cc]), p2 = bf2f(RAWB[(t + 2) * 320 + cc]);
            const float v = p1 + MU[cc] * (p0 - p1) + MU[320 + cc] * (p2 - p1);
            if (which == 0) OPS[t * 320 + 256 + c] = v;
            else if (which == 1) OPS[t * 320 + 192 + c] = v;
            else if (which == 2) { if ((c >> 5) == half) VV[t * 32 + (c & 31)] = v; }
            else if (which == 3) XW[t * 72 + c] = (bf16)f2bf(tanhf(v));
            else XA[t * 72 + c] = (bf16)f2bf(v); }
        __syncthreads();
#pragma unroll
        for (int tt = 0; tt < 2; ++tt) { f32x4 acc = {0.f, 0.f, 0.f, 0.f};
            acc = mma16<64>((mat ? XW : XA) + tt * 16 * 72, 72, (mat ? WW : WA) + ct * 16 * 72, 72, acc, lane);
#pragma unroll
            for (int jj = 0; jj < 4; ++jj) { const int t = tt * 16 + (lane >> 4) * 4 + jj, c = ct * 16 + (lane & 15); const float x = bias3 + acc[jj];
                if (mat) { const float nx = -x; const float sp = nx > 20.f ? nx : log1pf(__expf(nx)); OPS[t * 320 + c] = __expf(-__expf(-sp - 0.5f)); }
                else OPS[t * 320 + 128 + c] = sigmoidf_(x); } }
        __syncthreads();
#pragma unroll
        for (int i = 0; i < 4; ++i) { const int t = wave * 4 + i; LAS float* op = OPS + t * 320 + lane;
            const float av = op[128], kp = op[192], rp = op[256];
            const float kr = kp * kk_c; const float ss = wave_sum(kr * kr); const float kkv = kr / fmaxf(sqrtf(ss), 1e-12f);
            const float km = kp * (1.f + (av - 1.f) * ka_c);
            const float cs = wave_sum(rp * km * rk_c);
            op[64] = kkv; op[128] = kkv * av; op[192] = km;
            if (dir == 0 && half == 0 && lane == 0) CT[(mb + T0 + t) * 8 + h] = cs; }
        __syncthreads();
#pragma unroll 4
        for (int i = 0; i < 32; ++i) { const int tl = dir ? 31 - i : i; const LAS float* op = OPS + tl * 320 + 4 * j;
            const f32x4 w4 = *(const LAS f32x4*)(op), kk4 = *(const LAS f32x4*)(op + 64), ka4 = *(const LAS f32x4*)(op + 128), km4 = *(const LAS f32x4*)(op + 192), r4 = *(const LAS f32x4*)(op + 256);
            const float vv = VV[tl * 32 + row];
            float sa = (S.x * kk4.x + S.y * kk4.y) + (S.z * kk4.z + S.w * kk4.w);
            const f32x4 pre_s = S * w4 + km4 * vv;
            sa = row16_sum(sa);
            S = pre_s - ka4 * sa;
            float y = (S.x * r4.x + S.y * r4.y) + (S.z * r4.z + S.w * r4.w);
            y = row16_sum(y);
            if (j == 0) YB[tl * 32 + row] = y; }
        __syncthreads();
        { const int idx = tid * 2, tl = idx >> 5, rw = idx & 31;
          *(unsigned*)(Y + (mb + T0 + tl) * 384 + h * 64 + 32 * half + rw) = pk2(YB[idx], YB[idx + 1]); }
    }
#undef RW_ISSUE
    __syncthreads();
}
__device__ __forceinline__ void mlstm_seq(const Frame& F, int l, int task) {
    const int b = task >> 3, h = (task >> 1) & 3, dir = task & 1;
    const bf16* cols = (const bf16*)(WSP(F) + WS_COLS); const float* GT = (const float*)(WSP(F) + WS_GATES);
    bf16* Y = (bf16*)(WSP(F) + (dir ? Y_AB : Y_AF));
    LAS bf16* RAWQ = (LAS bf16*)(F.lds);
    LAS bf16* Qs = (LAS bf16*)(F.lds + 17408); LAS bf16* Ks = (LAS bf16*)(F.lds + 26624);
    LAS bf16* Vt = (LAS bf16*)(F.lds + 35840); LAS bf16* KWt = (LAS bf16*)(F.lds + 45056);
    LAS bf16* Ps = (LAS bf16*)(F.lds + 54272); LAS bf16* Ct = (LAS bf16*)(F.lds + 63488);
    LAS float* fa = (LAS float*)(F.lds + 72704);
    LAS float* li = fa, *lf = fa + 64, *bcs = fa + 128, *gg = fa + 192, *mq = fa + 256, *iw = fa + 320, *den = fa + 384, *nst = fa + 448, *scal = fa + 512;
    const int tid = F.tid, lane = F.lane, wave = F.wave;
    const size_t mb = (size_t)b * SEQ;
    __syncthreads();
    for (int i = tid; i < 64 * 72; i += 512) Ct[i] = 0;
    if (tid < 64) nst[tid] = 0.f;
    const int cc = tid & 127, isK = cc >> 6, d0 = cc & 63, chn = isK * 256 + h * 64 + d0;
    float cw[5]; const float* cwp = INP(F, 3) + (size_t)l * 5 * 512;
#pragma unroll
    for (int jj = 0; jj < 5; ++jj) cw[jj] = cwp[jj * 512 + chn];
    const float cbv = INP(F, 4)[l * 512 + chn];
    f32x4 st[2] = {{0.f, 0.f, 0.f, 0.f}, {0.f, 0.f, 0.f, 0.f}};
    float m_st = 0.f, nloc = 0.f;
    for (int c = 0; c < SEQ / 64; ++c) {
        const int tlo = dir ? SEQ - 64 * (c + 1) : 64 * c;
        for (int ch = tid; ch < 68 * 16; ch += 512) { const int rr = ch >> 4, q = ch & 15; const int t = tlo - 2 + rr;
            v4u v = {0u, 0u, 0u, 0u}; if (t >= 0 && t < SEQ) v = *(const v4u*)(cols + (mb + t) * NINP + (q >> 3) * 256 + h * 64 + (q & 7) * 8);
            *(LAS v4u*)(RAWQ + rr * 128 + q * 8) = v; }
        { const int tl = tid >> 3, e8 = tid & 7; const int lpos = dir ? 63 - tl : tl;
          const v4u v = *(const v4u*)(cols + (mb + tlo + tl) * NINP + A_V + h * 64 + e8 * 8);
          const unsigned w[4] = {v.x, v.y, v.z, v.w};
#pragma unroll
          for (int k = 0; k < 4; ++k) { Vt[(e8 * 8 + 2 * k) * 72 + lpos] = (bf16)(w[k] & 0xffffu); Vt[(e8 * 8 + 2 * k + 1) * 72 + lpos] = (bf16)(w[k] >> 16); } }
        if (tid < 64) { const int t = dir ? tlo + 63 - tid : tlo + tid; li[tid] = GT[(mb + t) * 16 + dir * 4 + h]; lf[tid] = GT[(mb + t) * 16 + 8 + dir * 4 + h]; }
        __syncthreads();
#pragma unroll 4
        for (int i = 0; i < 16; ++i) { const int tl = (tid >> 7) + 4 * i; float s = cbv;
#pragma unroll
            for (int jj = 0; jj < 5; ++jj) s += cw[jj] * bf2f(RAWQ[(tl + jj) * 128 + cc]);
            s = siluf_(s); const int lpos = dir ? 63 - tl : tl;
            if (isK) Ks[lpos * 72 + d0] = (bf16)f2bf(s * 0.125f); else Qs[lpos * 72 + d0] = (bf16)f2bf(s); }
        if (tid < 64) { float run = 0.f, rm = -INFINITY, bl = 0.f;
            for (int s = 0; s < 64; ++s) { run += lf[s]; if (s <= tid) { rm = fmaxf(rm, li[s] - run); if (s == tid) bl = run; } }
            const float g = run - bl + li[tid]; const float mloc = wave_max(g);
            const float mqv = bl + fmaxf(m_st, rm);
            bcs[tid] = bl; gg[tid] = g; mq[tid] = mqv; iw[tid] = __expf(bl + m_st - mqv);
            if (tid == 0) { scal[0] = mloc; scal[1] = run; } }
        __syncthreads();
        const float mloc = scal[0], blast = scal[1];
        for (int idx = tid; idx < 4096; idx += 512) { const int lp = idx >> 6, d = idx & 63; KWt[d * 72 + lp] = (bf16)f2bf(bf2f(Ks[lp * 72 + d]) * __expf(gg[lp] - mloc)); }
#pragma unroll
        for (int k = 0; k < 2; ++k) { const int ti = 2 * wave + k, tl_ = ti >> 2, ts = ti & 3; f32x4 acc = {0.f, 0.f, 0.f, 0.f};
            if (ts <= tl_) acc = mma16<64>(Qs + tl_ * 16 * 72, 72, Ks + ts * 16 * 72, 72, acc, lane);
#pragma unroll
            for (int jj = 0; jj < 4; ++jj) { const int lr = tl_ * 16 + (lane >> 4) * 4 + jj, s = ts * 16 + (lane & 15);
                const float v = (s <= lr) ? acc[jj] * __expf(bcs[lr] - bcs[s] + li[s] - mq[lr]) : 0.f; Ps[lr * 72 + s] = (bf16)f2bf(v); } }
        __syncthreads();
        f32x4 a1[2], a2[2], lc[2];
#pragma unroll
        for (int k = 0; k < 2; ++k) { const int ti = 2 * wave + k, t0_ = ti >> 2, t1_ = ti & 3; const f32x4 z = {0.f, 0.f, 0.f, 0.f};
            a1[k] = mma16<64>(Ps + t0_ * 16 * 72, 72, Vt + t1_ * 16 * 72, 72, z, lane);
            a2[k] = mma16<64>(Qs + t0_ * 16 * 72, 72, Ct + t1_ * 16 * 72, 72, z, lane);
            lc[k] = mma16<64>(Vt + t0_ * 16 * 72, 72, KWt + t1_ * 16 * 72, 72, z, lane); }
        if (tid < 64) { float sp = 0.f, qn = 0.f, nl = 0.f;
            for (int s = 0; s < 64; ++s) { sp += bf2f(Ps[tid * 72 + s]); qn += bf2f(Qs[tid * 72 + s]) * nst[s]; nl += bf2f(KWt[tid * 72 + s]); }
            const float dn = sp + iw[tid] * qn; den[tid] = 1.f / fmaxf(fabsf(dn), __expf(-mq[tid])); nloc = nl; }
        __syncthreads();
        const float m_new = fmaxf(blast + m_st, mloc), s_old = __expf(blast + m_st - m_new), s_new = __expf(mloc - m_new);
#pragma unroll
        for (int k = 0; k < 2; ++k) { const int ti = 2 * wave + k, t0_ = ti >> 2, t1_ = ti & 3;
#pragma unroll
            for (int jj = 0; jj < 4; ++jj) { const int r_ = t0_ * 16 + (lane >> 4) * 4 + jj, c_ = t1_ * 16 + (lane & 15);
                const float val = (a1[k][jj] + iw[r_] * a2[k][jj]) * den[r_];
                const int t = dir ? tlo + 63 - r_ : tlo + r_;
                Y[(mb + t) * 256 + h * 64 + c_] = (bf16)f2bf(val);
                st[k][jj] = s_old * st[k][jj] + s_new * lc[k][jj];
                Ct[r_ * 72 + c_] = (bf16)f2bf(st[k][jj]); } }
        if (tid < 64) nst[tid] = s_old * nst[tid] + s_new * nloc;
        m_st = m_new;
        __syncthreads();
    }
}
__device__ __forceinline__ void ssd_seq(const Frame& F, int l, int task) {
    const int b = task / 12, rem = task % 12, head = rem >> 1, dir = rem & 1, g = head / 3;
    const bf16* cols = (const bf16*)(WSP(F) + WS_COLS);
    bf16* Y = (bf16*)(WSP(F) + (dir ? Y_SB : Y_SF));
    LAS bf16* RAW = (LAS bf16*)(F.lds);
    LAS bf16* Cm = (LAS bf16*)(F.lds + 43520); LAS bf16* Bm = (LAS bf16*)(F.lds + 60928);
    LAS bf16* Btn = (LAS bf16*)(F.lds + 78336); LAS bf16* Ps = (LAS bf16*)(F.lds + 96768);
    LAS bf16* XDt = (LAS bf16*)(F.lds + 105984); LAS bf16* XWt = (LAS bf16*)(F.lds + 115200);
    LAS bf16* Hs = (LAS bf16*)(F.lds + 124416);
    LAS float* dtv = (LAS float*)(F.lds + 141824); LAS float* acs = dtv + 64; LAS float* scal = dtv + 128;
    const int tid = F.tid, lane = F.lane, wave = F.wave;
    const size_t mb = (size_t)b * SEQ;
    __syncthreads();
    for (int i = tid; i < 64 * 136; i += 512) Hs[i] = 0;
    const float dtb = INP(F, 22)[(l * 2 + dir) * 6 + head];
    const float aneg = -__expf(INP(F, 23)[(l * 2 + dir) * 6 + head]);
    const int cc = tid < 320 ? tid : 0;
    const int chn = cc < 64 ? head * 64 + cc : (cc < 192 ? 384 + g * 128 + (cc - 64) : 640 + g * 128 + (cc - 192));
    float cw[5]; const float* cwp = INP(F, 20) + (size_t)l * 5 * 896;
#pragma unroll
    for (int jj = 0; jj < 5; ++jj) cw[jj] = cwp[jj * 896 + chn];
    const float cbv = INP(F, 21)[l * 896 + chn];
    f32x4 st[4];
#pragma unroll
    for (int k = 0; k < 4; ++k) st[k] = (f32x4){0.f, 0.f, 0.f, 0.f};
    for (int c = 0; c < SEQ / 64; ++c) {
        const int tlo = dir ? SEQ - 64 * (c + 1) : 64 * c;
        for (int ch = tid; ch < 68 * 40; ch += 512) { const int rr = ch / 40, q = ch % 40; const int t = tlo - 2 + rr;
            const int gc = q < 8 ? S_X + head * 64 + q * 8 : (q < 24 ? S_B + g * 128 + (q - 8) * 8 : S_C + g * 128 + (q - 24) * 8);
            v4u v = {0u, 0u, 0u, 0u}; if (t >= 0 && t < SEQ) v = *(const v4u*)(cols + (mb + t) * NINP + gc);
            *(LAS v4u*)(RAW + rr * 320 + q * 8) = v; }
        if (tid < 64) { const int t = dir ? tlo + 63 - tid : tlo + tid;
            const float x = bf2f(cols[(mb + t) * NINP + S_DT + dir * 6 + head]) + dtb;
            const float dt = x > 20.f ? x : log1pf(__expf(x));
            float cs = dt * aneg;
#pragma unroll
            for (int o = 1; o < 64; o <<= 1) { const float u = __shfl_up(cs, o); if (lane >= o) cs += u; }
            const float tot = __shfl(cs, 63);
            dtv[tid] = dt; acs[tid] = cs; if (tid == 0) scal[0] = tot; }
        __syncthreads();
        const float tot = scal[0];
        if (tid < 320) {
            float win[5];
#pragma unroll
            for (int jj = 0; jj < 4; ++jj) win[jj] = bf2f(RAW[jj * 320 + cc]);
            for (int tl = 0; tl < 64; ++tl) { win[4] = bf2f(RAW[(tl + 4) * 320 + cc]);
                float s = cbv;
#pragma unroll
                for (int jj = 0; jj < 5; ++jj) s += cw[jj] * win[jj];
#pragma unroll
                for (int jj = 0; jj < 4; ++jj) win[jj] = win[jj + 1];
                s = siluf_(s); const int lp = dir ? 63 - tl : tl;
                if (cc < 64) { const float xd = s * dtv[lp]; XDt[cc * 72 + lp] = (bf16)f2bf(xd); XWt[cc * 72 + lp] = (bf16)f2bf(xd * __expf(tot - acs[lp])); }
                else if (cc < 192) { const bf16 bv = (bf16)f2bf(s); Bm[lp * 136 + (cc - 64)] = bv; Btn[(cc - 64) * 72 + lp] = bv; }
                else Cm[lp * 136 + (cc - 192)] = (bf16)f2bf(s); } }
        __syncthreads();
        f32x4 yo[2], lc[4];
#pragma unroll
        for (int k = 0; k < 2; ++k) { const int ti = 2 * wave + k, tl_ = ti >> 2, ts = ti & 3; f32x4 acc = {0.f, 0.f, 0.f, 0.f};
            if (ts <= tl_) acc = mma16<128>(Cm + tl_ * 16 * 136, 136, Bm + ts * 16 * 136, 136, acc, lane);
#pragma unroll
            for (int jj = 0; jj < 4; ++jj) { const int lr = tl_ * 16 + (lane >> 4) * 4 + jj, s = ts * 16 + (lane & 15);
                const float v = (s <= lr) ? acc[jj] * __expf(acs[lr] - acs[s]) : 0.f; Ps[lr * 72 + s] = (bf16)f2bf(v); }
            const f32x4 z = {0.f, 0.f, 0.f, 0.f};
            yo[k] = mma16<128>(Cm + tl_ * 16 * 136, 136, Hs + ts * 16 * 136, 136, z, lane); }
#pragma unroll
        for (int k = 0; k < 4; ++k) { const int ti = 4 * wave + k, tp = ti >> 3, tn = ti & 7; const f32x4 z = {0.f, 0.f, 0.f, 0.f};
            lc[k] = mma16<64>(XWt + tp * 16 * 72, 72, Btn + tn * 16 * 72, 72, z, lane); }
        __syncthreads();
        const float cdec = __expf(tot);
#pragma unroll
        for (int k = 0; k < 2; ++k) { const int ti = 2 * wave + k, tl_ = ti >> 2, tp = ti & 3; const f32x4 z = {0.f, 0.f, 0.f, 0.f};
            const f32x4 yd = mma16<64>(Ps + tl_ * 16 * 72, 72, XDt + tp * 16 * 72, 72, z, lane);
#pragma unroll
            for (int jj = 0; jj < 4; ++jj) { const int lr = tl_ * 16 + (lane >> 4) * 4 + jj, p = tp * 16 + (lane & 15);
                const float val = yd[jj] + yo[k][jj] * __expf(acs[lr]);
                const int t = dir ? tlo + 63 - lr : tlo + lr;
                Y[(mb + t) * 384 + head * 64 + p] = (bf16)f2bf(val); } }
#pragma unroll
        for (int k = 0; k < 4; ++k) { const int ti = 4 * wave + k, tp = ti >> 3, tn = ti & 7;
#pragma unroll
            for (int jj = 0; jj < 4; ++jj) { const int p = tp * 16 + (lane >> 4) * 4 + jj, n = tn * 16 + (lane & 15);
                st[k][jj] = cdec * st[k][jj] + lc[k][jj]; Hs[p * 136 + n] = (bf16)f2bf(st[k][jj]); } }
        __syncthreads();
    }
}
__device__ __forceinline__ void phase_post(const Frame& F, int l) {
    const bf16* cols = (const bf16*)(WSP(F) + WS_COLS); bf16* MIX = (bf16*)(WSP(F) + WS_XN);
    const bf16* YAf = (const bf16*)(WSP(F) + Y_AF); const bf16* YAb = (const bf16*)(WSP(F) + Y_AB);
    const bf16* YRf = (const bf16*)(WSP(F) + Y_RF); const bf16* YRb = (const bf16*)(WSP(F) + Y_RB);
    const bf16* YSf = (const bf16*)(WSP(F) + Y_SF); const bf16* YSb = (const bf16*)(WSP(F) + Y_SB);
    const float* CT = (const float*)(WSP(F) + WS_CT);
    LAS float* sg = (LAS float*)(F.lds);
    LAS float* gate = (LAS float*)(F.lds + 8192);
    const int tid = F.tid, lane = F.lane, wave = F.wave;
    const float* mup = INP(F, 8) + l * 1472; const float* mun = INP(F, 9) + l * 1472;
    const float* gup = INP(F, 14) + (size_t)l * 128 * 384;
    const float* mng = INP(F, 7) + l * 256; const float* rng = INP(F, 18) + l * 384; const float* rnb = INP(F, 19) + l * 384;
    const float* scb = INP(F, 21) + l * 896; const float* scw = INP(F, 20) + (size_t)l * 5 * 896; const float* sdk = INP(F, 24) + l * 6; const float* sng = INP(F, 25) + l * 384;
    for (int tile = F.vcu; tile < M / 16; tile += F.G) {
        const int m0 = tile * 16;
        __syncthreads();
        for (int idx = tid; idx < 16 * 128; idx += 512) { const int tt = idx >> 7, i = idx & 127; const int m = m0 + tt, t = m % SEQ;
            const float p1 = bf2f(cols[(size_t)m * NINP + R_GD + i]);
            const float p0 = t > 0 ? bf2f(cols[(size_t)(m - 1) * NINP + R_GD + i]) : 0.f;
            const float p2 = t < SEQ - 1 ? bf2f(cols[(size_t)(m + 1) * NINP + R_GD + i]) : 0.f;
            sg[idx] = sigmoidf_(p1 + mup[1344 + i] * (p0 - p1) + mun[1344 + i] * (p2 - p1)); }
        __syncthreads();
        if (tid < 384) { float acc[16];
#pragma unroll
            for (int tt = 0; tt < 16; ++tt) acc[tt] = 0.f;
            for (int i = 0; i < 128; ++i) { const float w = gup[i * 384 + tid];
#pragma unroll
                for (int tt = 0; tt < 16; ++tt) acc[tt] += sg[tt * 128 + i] * w; }
#pragma unroll
            for (int tt = 0; tt < 16; ++tt) gate[tt * 384 + tid] = acc[tt]; }
        __syncthreads();
#pragma unroll 1
        for (int k = 0; k < 2; ++k) { const int tt = wave * 2 + k; const int m = m0 + tt, t = m % SEQ; const size_t cr = (size_t)m * NINP;
#pragma unroll
            for (int i = 0; i < 4; ++i) { const int col = i * 64 + lane;
                const float hs = bf2f(YAf[(size_t)m * 256 + col]) + bf2f(YAb[(size_t)m * 256 + col]);
                const float mean = wave_sum(hs) * (1.f / 64.f); const float d = hs - mean; const float var = wave_sum(d * d) * (1.f / 64.f);
                const float y = d * (1.f / sqrtf(var + 1e-6f)) * mng[col];
                MIX[(size_t)m * DM + col] = (bf16)f2bf(y * sigmoidf_(bf2f(cols[cr + A_O + col]))); }
#pragma unroll
            for (int i = 0; i < 6; ++i) { const int col = i * 64 + lane;
                const float ys = bf2f(YRf[(size_t)m * 384 + col]) + bf2f(YRb[(size_t)m * 384 + col]);
                const float mean = wave_sum(ys) * (1.f / 64.f); const float d = ys - mean; const float var = wave_sum(d * d) * (1.f / 64.f);
                const float y = d * (1.f / sqrtf(var + 64e-5f)) * rng[col] + rnb[col];
                const float p1 = bf2f(cols[cr + R_V + col]);
                const float p0 = t > 0 ? bf2f(cols[cr - NINP + R_V + col]) : 0.f;
                const float p2 = t < SEQ - 1 ? bf2f(cols[cr + NINP + R_V + col]) : 0.f;
                const float vv = p1 + mup[768 + col] * (p0 - p1) + mun[768 + col] * (p2 - p1);
                const float bonus = CT[(size_t)m * 8 + i] * vv;
                MIX[(size_t)m * DM + 256 + col] = (bf16)f2bf((y + bonus) * gate[tt * 384 + col]); }
            float yv[6]; float ssq[2] = {0.f, 0.f};
#pragma unroll
            for (int i = 0; i < 6; ++i) { const int col = i * 64 + lane;
                float s = scb[col];
#pragma unroll
                for (int jj = 0; jj < 5; ++jj) { const int tq = t + jj - 2; if (tq >= 0 && tq < SEQ) s += scw[jj * 896 + col] * bf2f(cols[cr + (jj - 2) * NINP + S_X + col]); }
                const float xc = siluf_(s);
                float y = bf2f(YSf[(size_t)m * 384 + col]) + bf2f(YSb[(size_t)m * 384 + col]) + sdk[i] * xc;
                y *= siluf_(bf2f(cols[cr + S_Z + col]));
                yv[i] = y; ssq[i / 3] += y * y; }
            const float r0 = 1.f / sqrtf(wave_sum(ssq[0]) * (1.f / 192.f) + 1e-6f), r1 = 1.f / sqrtf(wave_sum(ssq[1]) * (1.f / 192.f) + 1e-6f);
#pragma unroll
            for (int i = 0; i < 6; ++i) { const int col = i * 64 + lane;
                MIX[(size_t)m * DM + 640 + col] = (bf16)f2bf(yv[i] * (i < 3 ? r0 : r1) * sng[col]); }
        }
    }
    __syncthreads();
}
namespace cg = cooperative_groups;
constexpr int N_PHASES = 9 * DEPTH + 1;
__global__ void __launch_bounds__(NWAVES * 64, 2) mk_fwd(Args args) {
    extern __shared__ __attribute__((aligned(16))) unsigned char lds_raw[];
    Frame F;
    F.lds = (LAS unsigned char*)lds_raw;
    F.tid = threadIdx.x; F.lane = F.tid & 63; F.wave = __builtin_amdgcn_readfirstlane(F.tid >> 6);
    F.G = gridDim.x; { const int bx = blockIdx.x; F.vcu = (F.G % 8 == 0) ? (bx % 8) * (F.G / 8) + bx / 8 : bx; }
    volatile LAS unsigned* MISC = (volatile LAS unsigned*)(F.lds + MISC_OFF);
    if (F.tid < 64) MISC[F.tid] = 0u;
    if (F.tid < 34) *(LAS unsigned long long*)(F.lds + PTAB_OFF + 8 * F.tid) = ((const unsigned long long*)__builtin_amdgcn_kernarg_segment_ptr())[F.tid];
    __syncthreads();
    unsigned* ctl = (unsigned*)(WSP(F) + WS_CTL);
    XcdBarrier bar = xcd_barrier_post(ctl + CW_BAR, MISC + 8);
    const int lo = args.ph_lo, hi = args.ph_hi;
#define IN_(k) (lo <= (k) && (k) < hi)
#define SEAM(k) do { if (IN_(k) && IN_((k) + 1)) { if ((k) == 0) cg::this_grid().sync(); else xcd_barrier(bar); } } while (0)
#define LAYER(l, B) \
    if (IN_(B + 0)) { phase_convert(F, l); phase_norm(F, l == 0 ? INP(F, 0) : OUTP(F), INP(F, 1) + l * DM, (bf16*)(WSP(F) + WS_XN)); } SEAM(B + 0); \
    if (IN_(B + 1)) { unsigned char* ws = WSP(F); pg8::Gemm g{(const bf16*)(ws + WS_XN), (const bf16*)(ws + WS_WIN), M, NINP, DM}; pg8::StaticOrder S; S.init(M, NINP, F.G, (int)blockIdx.x); \
            pg8::EpiBf16<0> E{(bf16*)(ws + WS_COLS), NINP, nullptr, 0, 0, 1.f}; \
            pg8::gemm_phase<pg8::EpiBf16<0>, pg8::StaticOrder, PG8_ALIGN, PG8_SP2>(F.lds, g, S, E); } SEAM(B + 1); \
    if (IN_(B + 2)) phase_gates(F, l); SEAM(B + 2); \
    if (IN_(B + 3)) { const int bx = blockIdx.x; \
            if (bx < 48) rwkv_scan(F, l, bx); else if (bx < 64) mlstm_seq(F, l, bx - 48); else if (bx < 88) ssd_seq(F, l, bx - 64); } SEAM(B + 3); \
    if (IN_(B + 4)) phase_post(F, l); SEAM(B + 4); \
    if (IN_(B + 5)) { unsigned char* ws = WSP(F); pg8::Gemm g{(const bf16*)(ws + WS_XN), (const bf16*)(ws + WS_WOUT), M, DM, DM}; pg8::StaticOrder S; S.init(M, DM, F.G, (int)blockIdx.x); \
            pg8::EpiResidual E{l == 0 ? INP(F, 0) : OUTP(F), OUTP(F), DM}; \
            pg8::gemm_phase<pg8::EpiResidual, pg8::StaticOrder, PG8_ALIGN, PG8_SP2>(F.lds, g, S, E); } SEAM(B + 5); \
    if (IN_(B + 6)) phase_norm(F, OUTP(F), INP(F, 27) + l * DM, (bf16*)(WSP(F) + WS_XN)); SEAM(B + 6); \
    if (IN_(B + 7)) { unsigned char* ws = WSP(F); pg8::Gemm g{(const bf16*)(ws + WS_XN), (const bf16*)(ws + WS_WGU), M, 2 * FFN, DM}; pg8::StaticOrder S; S.init(M, 2 * FFN, F.G, (int)blockIdx.x); \
            pg8::EpiSwiGLU E{(bf16*)(ws + WS_COLS), FFN}; \
            pg8::gemm_phase<pg8::EpiSwiGLU, pg8::StaticOrder, PG8_ALIGN, PG8_SP2>(F.lds, g, S, E); } SEAM(B + 7); \
    if (IN_(B + 8)) { unsigned char* ws = WSP(F); pg8::Gemm g{(const bf16*)(ws + WS_COLS), (const bf16*)(ws + WS_WDN), M, DM, FFN}; pg8::StaticOrder S; S.init(M, DM, F.G, (int)blockIdx.x); \
            pg8::EpiResidual E{OUTP(F), OUTP(F), DM}; \
            pg8::gemm_phase<pg8::EpiResidual, pg8::StaticOrder, PG8_ALIGN, PG8_SP2>(F.lds, g, S, E); } SEAM(B + 8);
    LAYER(0, 0)
    LAYER(1, 9)
    if (IN_(18)) phase_final_norm(F, OUTP(F), INP(F, 31));
#undef IN_
#undef SEAM
#undef LAYER
}

#ifndef MK_PER_PHASE
#define MK_PER_PHASE 1
#endif
extern "C" void kernel_launch(void* const* d_in, const int* in_sizes, int n_in, void* d_out, int out_size, void* d_ws, size_t ws_size, hipStream_t stream) {
    static int grid = 0;
    if (grid == 0) {
        int dev = 0, cus = 0;
        if (n_in != 32 || out_size != M * DM || ws_size < WS_END) { fprintf(stderr, "kernel_launch: unexpected shapes (n_in %d out %d ws %zu)\n", n_in, out_size, ws_size); grid = -1; return; }
        if (hipGetDevice(&dev) != hipSuccess || hipDeviceGetAttribute(&cus, hipDeviceAttributeMultiprocessorCount, dev) != hipSuccess) { grid = -1; return; }
        if (hipFuncSetAttribute((const void*)mk_fwd, hipFuncAttributeMaxDynamicSharedMemorySize, LDS_BYTES) != hipSuccess) { fprintf(stderr, "kernel_launch: hipFuncSetAttribute failed\n"); grid = -1; return; }
        int per_cu = 0;
        if (hipOccupancyMaxActiveBlocksPerMultiprocessor(&per_cu, (const void*)mk_fwd, NWAVES * 64, LDS_BYTES) != hipSuccess || per_cu < 1) { fprintf(stderr, "kernel_launch: occupancy query says %d\n", per_cu); }
        (void)hipGetLastError();
        grid = cus;
    }
    if (grid < 0) return;
    (void)hipMemsetAsync((char*)d_ws + WS_CTL, 0, CTL_ZERO_BYTES, stream);
    Args a{};
    for (int i = 0; i < 32; ++i) a.in[i] = (const float*)d_in[i];
    a.out = (float*)d_out; a.ws = (unsigned char*)d_ws;
#if MK_PER_PHASE
    for (int p = 0; p < N_PHASES; ++p) { a.ph_lo = p; a.ph_hi = p + 1; hipLaunchKernelGGL(mk_fwd, dim3(grid), dim3(NWAVES * 64), LDS_BYTES, stream, a); }
#else
    a.ph_lo = 0; a.ph_hi = N_PHASES;
    void* kargs[] = {&a};
    hipError_t e = hipLaunchCooperativeKernel((const void*)mk_fwd, dim3(grid), dim3(NWAVES * 64), kargs, LDS_BYTES, stream);
    if (e != hipSuccess) fprintf(stderr, "cooperative launch failed: %s (grid %d)\n", hipGetErrorString(e), grid);
#endif
}
```

```cpp
#include <hip/hip_runtime.h>
#include <hip/hip_cooperative_groups.h>
#include <cstdio>
#include <cstdint>
namespace pg8 {
#define PG8_LAS __attribute__((address_space(3)))
typedef unsigned short bf16_t;
typedef short bf16x8 __attribute__((ext_vector_type(8)));
typedef float f32x4 __attribute__((ext_vector_type(4)));
typedef unsigned u32x4 __attribute__((ext_vector_type(4)));
constexpr int BM = 256, BK = 64, HALF = 128, HTB = HALF * BK * 2  , STAGE_BYTES = 8 * HTB, NXCD = 8, WGM = 8;

__host__ __device__ __forceinline__ int lds_byte(int r, int c) { const int st = (r >> 4) * 2 + (c >> 5), rr = r & 15, cc = c & 31, ob = rr * 64 + cc * 2; return st * 1024 + (ob ^ (((ob >> 9) & 1) << 5)); }
__host__ __device__ __forceinline__ void stage_rc(int b, int& R, int& C) { const int st = b / 1024, sb = b % 1024, swz = sb ^ (((sb >> 9) & 1) << 5); R = (st >> 1) * 16 + swz / 64; C = (st & 1) * 32 + (swz % 64) / 2; }
__host__ __device__ __forceinline__ int perm32(int rho) { const int n = rho >> 4, i = rho & 15; return 8 * (i >> 2) + 4 * n + (i & 3); }

struct Unit { int pm, pn; };
struct Gemm { const bf16_t* A; const bf16_t* Bt; int M, N, K; };

struct StaticOrder {
    int nM, nN, nwg, G, c;
    __host__ __device__ void init(int M, int N, int G_, int c_) { nM = M / BM; nN = N / BM; nwg = nM * nN; G = G_; c = c_; }
    __host__ __device__ bool next(int i, Unit& u) const {
        const long L = (long)i * G + c; if (L >= nwg) return false;
        int wgid = (int)L; { const int q = nwg / NXCD, r = nwg % NXCD, xcd = wgid % NXCD, off = wgid / NXCD; wgid = (xcd < r ? xcd * (q + 1) : r * (q + 1) + (xcd - r) * q) + off; }
        const int nig = WGM * nN, gid = wgid / nig, fm = gid * WGM, gsz = (nM - fm) < WGM ? (nM - fm) : WGM;
        u.pm = fm + ((wgid % nig) % gsz); u.pn = (wgid % nig) / gsz; return true;
    }
    __device__ __forceinline__ void a_ready(const Unit&) const {}
    __device__ __forceinline__ void done(const Unit&) const {}
};

__device__ __forceinline__ unsigned cvt_pk_bf16(float lo, float hi) { unsigned r; asm volatile("v_cvt_pk_bf16_f32 %0, %1, %2" : "=v"(r) : "v"(lo), "v"(hi)); return r; }
typedef float f32x2 __attribute__((ext_vector_type(2)));
__device__ __forceinline__ f32x2 gelu_pk(f32x2 v) {
    const f32x2 av = __builtin_elementwise_abs(v), d = av * 0.2316418882f + 1.0f;
    f32x2 t; t.x = __builtin_amdgcn_rcpf(d.x); t.y = __builtin_amdgcn_rcpf(d.y);
    f32x2 q = t * 0.5307027145f + (-0.7265760135f); q = q * t + 0.7107068705f; q = q * t + (-0.142248368f); q = q * t + 0.127414796f; q = q * t;
    const f32x2 s = (v * v) * (-0.72134752044f);
    f32x2 e; e.x = __builtin_amdgcn_exp2f(s.x); e.y = __builtin_amdgcn_exp2f(s.y);
    const f32x2 m = v * (q * e), r = v - m;
    f32x2 o; o.x = v.x < 0.f ? m.x : r.x; o.y = v.y < 0.f ? m.y : r.y; return o;
}

template <int ACT  > struct EpiBf16 {
    static constexpr bool PERM = true, AFTER_DRAIN = false; static_assert(ACT == 0 || ACT == 1, "EpiBf16: ACT is 0 (none) or 1 (gelu_pk)");
    bf16_t* O; int ldc; const float* bias; int split_cols; size_t split_stride; float scale0;
    __device__ __forceinline__ void operator()(const f32x4 (&acc)[2][2][4][2], const Unit& u, int wr, int wc, int fr, int fq) const {
        const int row0 = u.pm * BM + wr * 64 + fr; int colt = u.pn * BM; bf16_t* base = O;
        float sc = 1.f; if (split_cols) { const int t = colt / split_cols; base += (size_t)t * split_stride; colt -= t * split_cols; if (t == 0) sc = scale0; }
        const int col0 = colt + wc * 32 + 8 * fq, bcol0 = u.pn * BM + wc * 32 + 8 * fq;
        f32x4 bv[2][2];
#pragma unroll
        for (int bj = 0; bj < 2; ++bj)
#pragma unroll
            for (int n = 0; n < 2; ++n) bv[bj][n] = bias ? *(const f32x4*)(bias + bcol0 + bj * HALF + 4 * n) : (f32x4){0.f, 0.f, 0.f, 0.f};
#pragma unroll
        for (int ai = 0; ai < 2; ++ai)
#pragma unroll
            for (int m = 0; m < 4; ++m) { bf16_t* rowp = base + (size_t)(row0 + ai * HALF + m * 16) * ldc + col0;
#pragma unroll
                for (int bj = 0; bj < 2; ++bj) { f32x4 v0 = acc[ai][bj][m][0] + bv[bj][0], v1 = acc[ai][bj][m][1] + bv[bj][1];
                    if (ACT == 1) { f32x2 a = gelu_pk((f32x2){v0[0], v0[1]}), b = gelu_pk((f32x2){v0[2], v0[3]}), c = gelu_pk((f32x2){v1[0], v1[1]}), d = gelu_pk((f32x2){v1[2], v1[3]});
                        v0 = (f32x4){a.x, a.y, b.x, b.y}; v1 = (f32x4){c.x, c.y, d.x, d.y}; }
                    v0 = v0 * sc; v1 = v1 * sc; u32x4 w; w.x = cvt_pk_bf16(v0[0], v0[1]); w.y = cvt_pk_bf16(v0[2], v0[3]); w.z = cvt_pk_bf16(v1[0], v1[1]); w.w = cvt_pk_bf16(v1[2], v1[3]);
                    *(u32x4*)(rowp + bj * HALF) = w; } }
    }
};
struct EpiResidual {
    static constexpr bool PERM = false, AFTER_DRAIN = false;
    const float* base; float* out; int ldc;
    __device__ __forceinline__ void operator()(const f32x4 (&acc)[2][2][4][2], const Unit& u, int wr, int wc, int fr, int fq) const {
        const int col0 = u.pn * BM + wc * 32 + 4 * fq;
#pragma unroll
        for (int ai = 0; ai < 2; ++ai)
#pragma unroll
            for (int m = 0; m < 4; ++m) { const size_t off = (size_t)(u.pm * BM + ai * HALF + wr * 64 + m * 16 + fr) * ldc + col0;
#pragma unroll
                for (int bj = 0; bj < 2; ++bj)
#pragma unroll
                    for (int n = 0; n < 2; ++n) { const f32x4 bs = *(const f32x4*)(base + off + bj * HALF + n * 16); *(f32x4*)(out + off + bj * HALF + n * 16) = bs + acc[ai][bj][m][n]; }
                asm volatile("" ::: "memory"); }
    }
};
struct EpiSwiGLU {
    static constexpr bool PERM = true, AFTER_DRAIN = false;
    bf16_t* O; int ldc;
    __device__ __forceinline__ void operator()(const f32x4 (&acc)[2][2][4][2], const Unit& u, int wr, int wc, int fr, int fq) const {
        const int col0 = u.pn * HALF + wc * 32 + 8 * fq;
#pragma unroll
        for (int ai = 0; ai < 2; ++ai)
#pragma unroll
            for (int m = 0; m < 4; ++m) { bf16_t* rowp = O + (size_t)(u.pm * BM + ai * HALF + wr * 64 + m * 16 + fr) * ldc + col0;
                float r[8];
#pragma unroll
                for (int n = 0; n < 2; ++n)
#pragma unroll
                    for (int j = 0; j < 4; ++j) { const float g = acc[ai][0][m][n][j], up = acc[ai][1][m][n][j]; r[n * 4 + j] = g * __builtin_amdgcn_rcpf(1.f + __expf(-g)) * up; }
                u32x4 w; w.x = cvt_pk_bf16(r[0], r[1]); w.y = cvt_pk_bf16(r[2], r[3]); w.z = cvt_pk_bf16(r[4], r[5]); w.w = cvt_pk_bf16(r[6], r[7]);
                *(u32x4*)rowp = w; }
    }
};
template <class Epi, class Sched, bool ALIGN_EPI = false, bool SP2 = false>
__device__ __forceinline__ void gemm_phase(PG8_LAS unsigned char* lds, const Gemm g, const Sched& S, const Epi& E) {
    const int tid = threadIdx.x, wid = __builtin_amdgcn_readfirstlane(tid >> 6), lane = tid & 63, wr = wid >> 2, wc = wid & 3, fr = lane & 15, fq = lane >> 4;
    const int K = g.K, nt = K / BK;
    unsigned voffA[2], voffB[2];
#pragma unroll
    for (int i = 0; i < 2; ++i) { int R, C; stage_rc(tid * 16 + i * 8192, R, C); const int Rb = Epi::PERM ? ((R & ~31) + perm32(R & 31)) : R;
        voffA[i] = (unsigned)(R * K + C) * 2u; voffB[i] = (unsigned)(Rb * K + C) * 2u; }
    const size_t kstep = (size_t)(BK * 2);
    const size_t hstep = (size_t)HALF * K * 2;
    const size_t tstep = 2 * hstep;
    const unsigned ldsw = (unsigned)wid * 1024u;
    const int aoff = lds_byte(wr * 64 + fr, fq * 8), boff = lds_byte(wc * 32 + fr, fq * 8);
#define PG8_SA(b, h) (((b) * 2 + (h)) * HTB)
#define PG8_SB(b, h) ((4 + (b) * 2 + (h)) * HTB)
#define PG8_STAGE(bufoff, gbase, voff) do { _Pragma("unroll") for (int _i = 0; _i < 2; ++_i) \
        __builtin_amdgcn_global_load_lds((const unsigned*)((const char*)(gbase) + (voff)[_i]), (PG8_LAS unsigned*)(lds + (bufoff) + ldsw + _i * 8192), 16, 0, 0); } while (0)
#define PG8_LDA(dst, b, h) do { _Pragma("unroll") for (int m = 0; m < 4; ++m) _Pragma("unroll") for (int k = 0; k < 2; ++k) dst[m][k] = *(const PG8_LAS bf16x8*)(lds + PG8_SA(b, h) + aoff + m * 2048 + k * 1024); } while (0)
#define PG8_LDB(dst, b, h) do { _Pragma("unroll") for (int n = 0; n < 2; ++n) _Pragma("unroll") for (int k = 0; k < 2; ++k) dst[n][k] = *(const PG8_LAS bf16x8*)(lds + PG8_SB(b, h) + boff + n * 2048 + k * 1024); } while (0)
#define PG8_MMA(ai, bj, At, Bt) do { __builtin_amdgcn_s_setprio(1); _Pragma("unroll") for (int m = 0; m < 4; ++m) _Pragma("unroll") for (int n = 0; n < 2; ++n) _Pragma("unroll") for (int k = 0; k < 2; ++k) \
        acc[ai][bj][m][n] = __builtin_amdgcn_mfma_f32_16x16x32_bf16(Bt[n][k], At[m][k], acc[ai][bj][m][n], 0, 0, 0); __builtin_amdgcn_s_setprio(0); } while (0)
#define PG8_WAIT_V(n) asm volatile("s_waitcnt vmcnt(" #n ")" ::: "memory")
#define PG8_WAIT_L(n) asm volatile("s_waitcnt lgkmcnt(" #n ")" ::: "memory")
#define PG8_BAR __builtin_amdgcn_s_barrier()
#define PG8_SCHED __builtin_amdgcn_sched_barrier(0)
    Unit cur, nxt; int ui = 0;
    if (!S.next(0, cur)) return;
    f32x4 acc[2][2][4][2];
#pragma unroll
    for (int a = 0; a < 2; ++a)
#pragma unroll
        for (int b = 0; b < 2; ++b)
#pragma unroll
            for (int m = 0; m < 4; ++m)
#pragma unroll
                for (int n = 0; n < 2; ++n) acc[a][b][m][n] = (f32x4){0.f, 0.f, 0.f, 0.f};
    bf16x8 At[4][2], B0[2][2], B1[2][2];
    const char* cA = (const char*)g.A + (size_t)cur.pm * tstep; const char* cB = (const char*)g.Bt + (size_t)cur.pn * tstep;
    S.a_ready(cur);
    if constexpr (SP2) {
        PG8_STAGE(PG8_SB(0, 0), cB, voffB); PG8_STAGE(PG8_SB(0, 1), cB + hstep, voffB); PG8_STAGE(PG8_SA(0, 0), cA, voffA); PG8_STAGE(PG8_SA(0, 1), cA + hstep, voffA);
        if (wr == 1) PG8_BAR;
        PG8_WAIT_V(2); PG8_BAR;
        PG8_STAGE(PG8_SB(1, 0), cB + kstep, voffB); PG8_STAGE(PG8_SA(1, 0), cA + kstep, voffA); PG8_STAGE(PG8_SB(1, 1), cB + hstep + kstep, voffB);
        PG8_WAIT_V(6); PG8_BAR;
    } else {
        PG8_STAGE(PG8_SB(0, 0), cB, voffB); PG8_STAGE(PG8_SA(0, 0), cA, voffA); PG8_STAGE(PG8_SB(0, 1), cB + hstep, voffB); PG8_STAGE(PG8_SA(0, 1), cA + hstep, voffA);
        if (wr == 1) PG8_BAR;
        PG8_WAIT_V(4); PG8_BAR;
        PG8_STAGE(PG8_SB(1, 0), cB + kstep, voffB); PG8_STAGE(PG8_SA(1, 0), cA + kstep, voffA); PG8_STAGE(PG8_SB(1, 1), cB + hstep + kstep, voffB);
        PG8_WAIT_V(6); PG8_BAR;
    }
    for (;;) {
        const bool has_next = S.next(ui + 1, nxt);
        const char* nA = has_next ? (const char*)g.A + (size_t)nxt.pm * tstep : cA; const char* nB = has_next ? (const char*)g.Bt + (size_t)nxt.pn * tstep : cB;
        for (int t = 0; t < nt; t += 2) {
            const bool last = (t == nt - 2);
            const char* a1 = cA + (size_t)(t + 1) * kstep;
            const char* a2 = last ? nA : cA + (size_t)(t + 2) * kstep; const char* b2 = last ? nB : cB + (size_t)(t + 2) * kstep;
            const char* a3 = a2 + kstep; const char* b3 = b2 + kstep;
            if (last && has_next) S.a_ready(nxt);
            if constexpr (SP2) {
            PG8_LDB(B0, 0, 0); PG8_LDB(B1, 0, 1); PG8_SCHED; PG8_LDA(At, 0, 0); PG8_STAGE(PG8_SA(1, 1), a1 + hstep, voffA);
            PG8_WAIT_V(8); PG8_WAIT_L(0); PG8_BAR; PG8_MMA(0, 0, At, B0); PG8_MMA(0, 1, At, B1); PG8_BAR; PG8_SCHED;
            PG8_LDA(At, 0, 1); PG8_STAGE(PG8_SB(0, 0), b2, voffB); PG8_STAGE(PG8_SB(0, 1), b2 + hstep, voffB); PG8_STAGE(PG8_SA(0, 0), a2, voffA);
            PG8_WAIT_V(8); PG8_WAIT_L(0); PG8_BAR; PG8_MMA(1, 0, At, B0); PG8_MMA(1, 1, At, B1); PG8_BAR; PG8_SCHED;
            PG8_LDB(B0, 1, 0); PG8_LDB(B1, 1, 1); PG8_SCHED; PG8_LDA(At, 1, 0); PG8_STAGE(PG8_SA(0, 1), a2 + hstep, voffA);
            PG8_WAIT_V(8); PG8_WAIT_L(0); PG8_BAR; PG8_MMA(0, 0, At, B0); PG8_MMA(0, 1, At, B1); PG8_BAR; PG8_SCHED;
            PG8_LDA(At, 1, 1); PG8_STAGE(PG8_SB(1, 0), b3, voffB); PG8_STAGE(PG8_SB(1, 1), b3 + hstep, voffB); PG8_STAGE(PG8_SA(1, 0), a3, voffA);
            PG8_WAIT_V(8); PG8_WAIT_L(0); PG8_BAR; PG8_MMA(1, 0, At, B0); PG8_MMA(1, 1, At, B1); PG8_BAR; PG8_SCHED;
            } else {
            PG8_LDB(B0, 0, 0); PG8_SCHED; PG8_LDA(At, 0, 0); PG8_STAGE(PG8_SA(1, 1), a1 + hstep, voffA);
            PG8_WAIT_L(8); PG8_BAR; PG8_WAIT_L(0); PG8_MMA(0, 0, At, B0); PG8_BAR; PG8_SCHED;
            PG8_LDB(B1, 0, 1); PG8_STAGE(PG8_SB(0, 0), b2, voffB);
            PG8_BAR; PG8_WAIT_L(0); PG8_MMA(0, 1, At, B1); PG8_BAR;
            PG8_LDA(At, 0, 1); PG8_STAGE(PG8_SA(0, 0), a2, voffA);
            PG8_BAR; PG8_WAIT_L(0); PG8_MMA(1, 0, At, B0); PG8_BAR; PG8_SCHED;
            PG8_STAGE(PG8_SB(0, 1), b2 + hstep, voffB);
            PG8_WAIT_V(6); PG8_BAR; PG8_MMA(1, 1, At, B1); PG8_BAR;
            PG8_LDB(B0, 1, 0); PG8_SCHED; PG8_LDA(At, 1, 0); PG8_STAGE(PG8_SA(0, 1), a2 + hstep, voffA);
            PG8_WAIT_L(8); PG8_BAR; PG8_WAIT_L(0); PG8_MMA(0, 0, At, B0); PG8_BAR; PG8_SCHED;
            PG8_LDB(B1, 1, 1); PG8_STAGE(PG8_SB(1, 0), b3, voffB);
            PG8_BAR; PG8_WAIT_L(0); PG8_MMA(0, 1, At, B1); PG8_BAR;
            PG8_LDA(At, 1, 1); PG8_STAGE(PG8_SA(1, 0), a3, voffA);
            PG8_BAR; PG8_WAIT_L(0); PG8_MMA(1, 0, At, B0); PG8_BAR; PG8_SCHED;
            PG8_STAGE(PG8_SB(1, 1), b3 + hstep, voffB);
            PG8_WAIT_V(6); PG8_BAR; PG8_MMA(1, 1, At, B1); PG8_BAR;
            }
        }
        if constexpr (ALIGN_EPI) { if (wr == 0) PG8_BAR; }
        if constexpr (!Epi::AFTER_DRAIN) { E(acc, cur, wr, wc, fr, fq); S.done(cur); }
        if (!has_next) break;
#pragma unroll
        for (int a = 0; a < 2; ++a)
#pragma unroll
            for (int b = 0; b < 2; ++b)
#pragma unroll
                for (int m = 0; m < 4; ++m)
#pragma unroll
                    for (int n = 0; n < 2; ++n) acc[a][b][m][n] = (f32x4){0.f, 0.f, 0.f, 0.f};
        cur = nxt; cA = nA; cB = nB; ++ui;
        if constexpr (ALIGN_EPI) { if (wr == 1) PG8_BAR; }
    }
    PG8_WAIT_V(0);
    if constexpr (!ALIGN_EPI) { if (wr == 0) PG8_BAR; }
    PG8_BAR;
    if constexpr (Epi::AFTER_DRAIN) { E.fused(acc, cur, wr, wc, fr, fq, lds, wid, lane); S.done(cur); }
#undef PG8_SA
#undef PG8_SB
#undef PG8_STAGE
#undef PG8_LDA
#undef PG8_LDB
#undef PG8_MMA
#undef PG8_WAIT_V
#undef PG8_WAIT_L
#undef PG8_BAR
#undef PG8_SCHED
}
}

#ifndef PG8_SP2
#define PG8_SP2 true
#endif
#define PG8_ALIGN true
constexpr int NWAVES = 8;
constexpr int BATCH = 2, SEQ = 8192, DM = 1024, M = BATCH * SEQ, NIN = 3788, NINP = 3840, FFN = 2816, DEPTH = 2;
constexpr int A_Q = 0, A_K = 256, A_V = 512, A_O = 768;
constexpr int R_R = 1024, R_K = 1408, R_V = 1792, R_WDF = 2176, R_AD = 2304, R_GD = 2368;
constexpr int S_Z = 2496, S_X = 2880, S_B = 3264, S_C = 3520, S_DT = 3776;
constexpr size_t MiB = 1u << 20;
constexpr size_t WS_CTL = 0, CTL_ZERO_BYTES = 64 * 1024;
constexpr size_t WS_GATES = 1 * MiB, WS_CT = 2 * MiB;
constexpr size_t WS_WIN = 4 * MiB, WS_WOUT = 12 * MiB, WS_WGU = 14 * MiB, WS_WDN = 25 * MiB;
constexpr size_t WS_XN = 32 * MiB, WS_COLS = 64 * MiB, WS_Y = 184 * MiB, WS_END = 248 * MiB;
constexpr size_t Y_AF = WS_Y, Y_AB = WS_Y + 8 * MiB, Y_RF = WS_Y + 16 * MiB, Y_RB = WS_Y + 28 * MiB, Y_SF = WS_Y + 40 * MiB, Y_SB = WS_Y + 52 * MiB;
constexpr int CW_BAR = 1024;
constexpr int RING_BYTES = 131072;
constexpr int LDS_BYTES = 147456, MISC_OFF = LDS_BYTES - 256;

#define GAS __attribute__((address_space(1)))
#define LAS __attribute__((address_space(3)))
typedef unsigned short bf16;
typedef unsigned v4u __attribute__((ext_vector_type(4)));
typedef unsigned v2u __attribute__((ext_vector_type(2)));
typedef float f32x4 __attribute__((ext_vector_type(4)));
typedef short bf16x8 __attribute__((ext_vector_type(8)));
typedef GAS unsigned gu32;
#define RLX_AGENT __ATOMIC_RELAXED, __HIP_MEMORY_SCOPE_AGENT
#define LDS_WAIT() asm volatile("s_waitcnt lgkmcnt(0)" ::: "memory")
#define VM_WAIT() asm volatile("s_waitcnt vmcnt(0)" ::: "memory")
__device__ __forceinline__ unsigned f2bf(float f) { unsigned u = __builtin_bit_cast(unsigned, f); return (u + 0x7fffu + ((u >> 16) & 1u)) >> 16; }
__device__ __forceinline__ unsigned pk2(float lo, float hi) { return f2bf(lo) | (f2bf(hi) << 16); }
__device__ __forceinline__ float bf2f(unsigned u) { return __builtin_bit_cast(float, u << 16); }
__device__ __forceinline__ float sigmoidf_(float x) { return __builtin_amdgcn_rcpf(1.f + __expf(-x)); }
__device__ __forceinline__ float siluf_(float x) { return x * sigmoidf_(x); }
__device__ __forceinline__ float wave_sum(float v) {
#pragma unroll
    for (int o = 1; o < 64; o <<= 1) v += __shfl_xor(v, o);
    return v;
}
__device__ __forceinline__ float wave_max(float v) {
#pragma unroll
    for (int o = 1; o < 64; o <<= 1) v = fmaxf(v, __shfl_xor(v, o));
    return v;
}
template <int CTRL> __device__ __forceinline__ float dppf(float v) { return __builtin_bit_cast(float, __builtin_amdgcn_update_dpp(0, __builtin_bit_cast(int, v), CTRL, 0xf, 0xf, true)); }
__device__ __forceinline__ float row16_sum(float v) { v += dppf<0xB1>(v); v += dppf<0x4E>(v); v += dppf<0x141>(v); v += dppf<0x140>(v); return v; }
template <int K> __device__ __forceinline__ f32x4 mma16(const LAS bf16* A, int lda, const LAS bf16* Bt, int ldb, f32x4 acc, int lane) {
    const int r = lane & 15, q = lane >> 4;
    const LAS bf16* ap = A + r * lda + q * 8; const LAS bf16* bp = Bt + r * ldb + q * 8;
#pragma unroll
    for (int k0 = 0; k0 < K; k0 += 32) {
        const bf16x8 a = *(const LAS bf16x8*)(ap + k0); const bf16x8 b = *(const LAS bf16x8*)(bp + k0);
        acc = __builtin_amdgcn_mfma_f32_16x16x32_bf16(a, b, acc, 0, 0, 0);
    }
    return acc;
}
#define XB_TMO      128
#define XB_XCNT(j)  (256  + 64 * (j))
#define XB_XSUB(j)  (1280 + 64 * (j))
#define XB_XGEN(j)  (2304 + 64 * (j))
#define XB_TOP      3328
#define XB_TOPGEN   3392
#define XCD_BAR_WORDS 3456
#define XB_SPIN_CAP (1u << 18)

__device__ __forceinline__ unsigned xb_ld(unsigned* p)              { return __hip_atomic_load(p, __ATOMIC_RELAXED, __HIP_MEMORY_SCOPE_AGENT); }
__device__ __forceinline__ unsigned xb_add(unsigned* p, unsigned v) { return __hip_atomic_fetch_add(p, v, __ATOMIC_RELAXED, __HIP_MEMORY_SCOPE_AGENT); }
__device__ __forceinline__ unsigned xb_xcc_id() { return (unsigned)__builtin_amdgcn_s_getreg((3 << 11) | 20) & 0xFu; }
#define XB_SPIN(cond, bar) do { unsigned _sp = 0; while (cond) { __builtin_amdgcn_s_sleep(1); \
    if ((++_sp & 255u) == 0u) { if (xb_ld(&(bar)[XB_TMO])) break; if (_sp > XB_SPIN_CAP) { atomicAdd(&(bar)[XB_TMO], 1u); break; } } } } while (0)

struct XcdBarrier {
    unsigned* bar; unsigned x;
    volatile LAS unsigned* st;
};

__device__ __forceinline__ XcdBarrier xcd_barrier_post(unsigned* bar, volatile LAS unsigned* st) {
    XcdBarrier b; b.bar = bar; b.x = xb_xcc_id(); b.st = st;
    if (threadIdx.x == 0) (void)xb_add(&bar[XB_XCNT(b.x)], 1u);
    return b;
}
__device__ __forceinline__ void xcd_barrier_complete(unsigned* bar, unsigned x, unsigned& nloc, unsigned& nx) {
    const unsigned G = gridDim.x * gridDim.y * gridDim.z;
    unsigned sum, cnt, mine, sp = 0u;
    for (;;) {
        sum = 0u; cnt = 0u; mine = 0u;
#pragma unroll
        for (unsigned j = 0; j < 16; ++j) { const unsigned c = xb_ld(&bar[XB_XCNT(j)]); sum += c; cnt += (c > 0u) ? 1u : 0u; mine = (j == x) ? c : mine; }
        if (sum == G) break;
        __builtin_amdgcn_s_sleep(1);
        if ((++sp & 255u) == 0u) { if (xb_ld(&bar[XB_TMO])) break; if (sp > XB_SPIN_CAP) { atomicAdd(&bar[XB_TMO], 1u); break; } }
    }
    nloc = mine > 0u ? mine : 1u; nx = cnt > 0u ? cnt : 1u;
}

__device__ __forceinline__ void xcd_barrier(const XcdBarrier& b) {
    asm volatile("s_waitcnt vmcnt(0)" ::: "memory");
    __syncthreads();
    if (threadIdx.x == 0) {
        unsigned* bar = b.bar;
        __builtin_amdgcn_s_waitcnt(0);
        unsigned nloc = b.st[0], nx = b.st[1];
        if (nloc == 0u) { xcd_barrier_complete(bar, b.x, nloc, nx); b.st[0] = nloc; b.st[1] = nx; }
        const unsigned old = xb_add(&bar[XB_XSUB(b.x)], 1u);
        const unsigned gen = old / nloc;
        if (old + 1u == (gen + 1u) * nloc) {
            __builtin_amdgcn_fence(__ATOMIC_RELEASE, "agent");
            asm volatile("s_waitcnt vmcnt(0)" ::: "memory");
            const unsigned og = xb_add(&bar[XB_TOP], 1u);
            const unsigned tg = og / nx;
            if (og + 1u == (tg + 1u) * nx) xb_add(&bar[XB_TOPGEN], 1u);
            else XB_SPIN(xb_ld(&bar[XB_TOPGEN]) == tg, bar);
            __builtin_amdgcn_fence(__ATOMIC_ACQUIRE, "agent");
            xb_add(&bar[XB_XGEN(b.x)], 1u);
            asm volatile("s_waitcnt vmcnt(0)" ::: "memory");
        } else {
            XB_SPIN(xb_ld(&bar[XB_XGEN(b.x)]) == gen, bar);
            __builtin_amdgcn_fence(__ATOMIC_ACQUIRE, "agent");
            asm volatile("s_waitcnt vmcnt(0)" ::: "memory");
        }
    }
    __syncthreads();
}
struct Frame {
    LAS unsigned char* lds;
    int tid, lane, wave, vcu, G;
};
struct Args { const float* in[32]; float* out; unsigned char* ws; int ph_lo, ph_hi; };
constexpr int PTAB_OFF = LDS_BYTES - 768;
__device__ __forceinline__ unsigned long long ptab_ld(const Frame& F, int i) {
    const unsigned long long v = *(volatile LAS unsigned long long*)(F.lds + PTAB_OFF + 8 * i);
    const unsigned lo = __builtin_amdgcn_readfirstlane((unsigned)v), hi = __builtin_amdgcn_readfirstlane((unsigned)(v >> 32));
    return ((unsigned long long)hi << 32) | lo;
}
__device__ __forceinline__ const float* INP(const Frame& F, int i) { return (const float*)ptab_ld(F, i); }
__device__ __forceinline__ unsigned char* WSP(const Frame& F) { return (unsigned char*)ptab_ld(F, 33); }
__device__ __forceinline__ float* OUTP(const Frame& F) { return (float*)ptab_ld(F, 32); }

__device__ __forceinline__ void transpose_item(const float* W, int K, int N, int nblk, bf16* WT, int mode, int row_off, LAS float* scr, int item, int lane) {
    const int kb = item / nblk, nb = item % nblk, k0 = 64 * kb, n0 = 32 * nb;
    const int ncol = n0 + (lane & 31); const bool ok = ncol < N;
#pragma unroll 8
    for (int i = 0; i < 32; ++i) { const int kk = 2 * i + (lane >> 5); scr[kk * 33 + (lane & 31)] = ok ? W[(size_t)(k0 + kk) * N + ncol] : 0.f; }
    LDS_WAIT(); asm volatile("" ::: "memory");
    const int c = lane & 7;
    const int drow0 = mode ? (256 * (n0 >> 7) + (n0 & 127) + row_off) : (row_off + n0);
#pragma unroll
    for (int j = 0; j < 4; ++j) { const int n = (lane >> 3) + 8 * j; const LAS float* s = scr + (8 * c) * 33 + n;
        v4u o; o.x = pk2(s[0 * 33], s[1 * 33]); o.y = pk2(s[2 * 33], s[3 * 33]); o.z = pk2(s[4 * 33], s[5 * 33]); o.w = pk2(s[6 * 33], s[7 * 33]);
        *(v4u*)(WT + (size_t)(drow0 + n) * K + k0 + 8 * c) = o; }
    LDS_WAIT(); asm volatile("" ::: "memory");
}
__device__ __forceinline__ void phase_convert(const Frame& F, int l) {
    LAS float* scr = (LAS float*)(F.lds + F.wave * 16384);
    const int gw = F.vcu * NWAVES + F.wave, NGW = F.G * NWAVES;
    bf16* Win = (bf16*)(WSP(F) + WS_WIN); bf16* Wout = (bf16*)(WSP(F) + WS_WOUT); bf16* Wgu = (bf16*)(WSP(F) + WS_WGU); bf16* Wdn = (bf16*)(WSP(F) + WS_WDN);
    constexpr int I_IN = 16 * 120, I_OUT = 16 * 32, I_G = 16 * 88, I_D = 44 * 32;
    constexpr int NITEMS = I_IN + I_OUT + 2 * I_G + I_D;
    for (int it = gw; it < NITEMS; it += NGW) {
        int r = it;
        if (r < I_IN) { transpose_item(INP(F, 2) + (size_t)l * DM * NIN, DM, NIN, 120, Win, 0, 0, scr, r, F.lane); continue; } r -= I_IN;
        if (r < I_OUT) { transpose_item(INP(F, 26) + (size_t)l * DM * DM, DM, DM, 32, Wout, 0, 0, scr, r, F.lane); continue; } r -= I_OUT;
        if (r < I_G) { transpose_item(INP(F, 28) + (size_t)l * DM * FFN, DM, FFN, 88, Wgu, 1, 0, scr, r, F.lane); continue; } r -= I_G;
        if (r < I_G) { transpose_item(INP(F, 29) + (size_t)l * DM * FFN, DM, FFN, 88, Wgu, 1, 128, scr, r, F.lane); continue; } r -= I_G;
        transpose_item(INP(F, 30) + (size_t)l * FFN * DM, FFN, DM, 32, Wdn, 0, 0, scr, r, F.lane);
    }
}
__device__ __forceinline__ void phase_norm(const Frame& F, const float* hin, const float* g, bf16* XN) {
    const int gw = F.vcu * NWAVES + F.wave, NGW = F.G * NWAVES;
    f32x4 gv[4];
#pragma unroll
    for (int j = 0; j < 4; ++j) gv[j] = ((const f32x4*)g)[64 * j + F.lane];
    for (int m = gw; m < M; m += NGW) {
        const f32x4* xr = (const f32x4*)(hin + (size_t)m * DM) + F.lane;
        f32x4 v[4]; float s = 0.f;
#pragma unroll
        for (int j = 0; j < 4; ++j) { v[j] = xr[64 * j]; s += (v[j].x * v[j].x + v[j].y * v[j].y) + (v[j].z * v[j].z + v[j].w * v[j].w); }
        const float r = 1.f / sqrtf(wave_sum(s) * (1.f / DM) + 1e-6f);
        v2u* o8 = (v2u*)(XN + (size_t)m * DM) + F.lane;
#pragma unroll
        for (int j = 0; j < 4; ++j) { v2u w; w.x = pk2(v[j].x * r * gv[j].x, v[j].y * r * gv[j].y); w.y = pk2(v[j].z * r * gv[j].z, v[j].w * r * gv[j].w); o8[64 * j] = w; }
    }
}
__device__ __forceinline__ void phase_final_norm(const Frame& F, float* h, const float* g) {
    const int gw = F.vcu * NWAVES + F.wave, NGW = F.G * NWAVES;
    f32x4 gv[4];
#pragma unroll
    for (int j = 0; j < 4; ++j) gv[j] = ((const f32x4*)g)[64 * j + F.lane];
    for (int m = gw; m < M; m += NGW) {
        f32x4* xr = (f32x4*)(h + (size_t)m * DM) + F.lane;
        f32x4 v[4]; float s = 0.f;
#pragma unroll
        for (int j = 0; j < 4; ++j) { v[j] = xr[64 * j]; s += (v[j].x * v[j].x + v[j].y * v[j].y) + (v[j].z * v[j].z + v[j].w * v[j].w); }
        const float r = 1.f / sqrtf(wave_sum(s) * (1.f / DM) + 1e-6f);
#pragma unroll
        for (int j = 0; j < 4; ++j) xr[64 * j] = v[j] * r * gv[j];
    }
}
__device__ __forceinline__ void phase_gates(const Frame& F, int l) {
    const bf16* cols = (const bf16*)(WSP(F) + WS_COLS); float* GT = (float*)(WSP(F) + WS_GATES);
    LAS bf16* raw = (LAS bf16*)(F.lds);
    LAS float* feat = (LAS float*)(F.lds + 32768);
    LAS float* gw = (LAS float*)(F.lds + 81920);
    const float* gwg = INP(F, 5) + (size_t)l * 768 * 16; const float* gb = INP(F, 6) + l * 16;
    const float* cw = INP(F, 3) + (size_t)l * 5 * 512; const float* cb = INP(F, 4) + l * 512;
    for (int i = F.tid; i < 768 * 16; i += 512) gw[i] = gwg[i];
    for (int tile = F.vcu; tile < M / 16; tile += F.G) {
        const int m0 = tile * 16, t0 = m0 % SEQ;
        __syncthreads();
        for (int ch = F.tid; ch < 20 * 96; ch += 512) { const int rr = ch / 96, cc = ch % 96; const int t = t0 - 2 + rr;
            v4u v = {0u, 0u, 0u, 0u}; if (t >= 0 && t < SEQ) v = *(const v4u*)(cols + (size_t)(m0 - 2 + rr) * NINP + cc * 8);
            *(LAS v4u*)(raw + rr * 768 + cc * 8) = v; }
        __syncthreads();
        for (int idx = F.tid; idx < 16 * 768; idx += 512) { const int t = idx / 768, c = idx % 768; float val;
            if (c < 512) { float s = cb[c];
#pragma unroll
                for (int j = 0; j < 5; ++j) s += cw[j * 512 + c] * bf2f(raw[(t + j) * 768 + c]);
                val = siluf_(s); } else val = bf2f(raw[(t + 2) * 768 + c]);
            feat[idx] = val; }
        __syncthreads();
        { const int t = F.tid >> 5, o = (F.tid >> 1) & 15, hf = F.tid & 1; float s = 0.f;
          const LAS float* fp = feat + t * 768 + hf * 384; const LAS float* wp = gw + (hf * 384) * 16 + o;
#pragma unroll 8
          for (int i = 0; i < 384; ++i) s += fp[i] * wp[i * 16];
          s += __shfl_xor(s, 1);
          if (hf == 0) { s += gb[o]; if (o >= 8) s = fminf(s, 0.f) - log1pf(__expf(-fabsf(s))); GT[(size_t)(m0 + t) * 16 + o] = s; } }
    }
    __syncthreads();
}
__device__ __forceinline__ void rwkv_scan(const Frame& F, int l, int task) {
    const int b = task / 24, rem = task % 24, h = rem >> 2, dir = (rem >> 1) & 1, half = rem & 1;
    const bf16* cols = (const bf16*)(WSP(F) + WS_COLS);
    bf16* Y = (bf16*)(WSP(F) + (dir ? Y_RB : Y_RF));
    float* CT = (float*)(WSP(F) + WS_CT);
    LAS bf16* WA = (LAS bf16*)(F.lds); LAS bf16* WW = (LAS bf16*)(F.lds + 9216);
    LAS bf16* XA = (LAS bf16*)(F.lds + 18432); LAS bf16* XW = (LAS bf16*)(F.lds + 23040);
    LAS bf16* RAWB = (LAS bf16*)(F.lds + 27648);
    LAS float* OPS = (LAS float*)(F.lds + 49408); LAS float* VV = (LAS float*)(F.lds + 90368);
    LAS float* MU = (LAS float*)(F.lds + 94464); LAS float* YB = (LAS float*)(F.lds + 97024);
    const int tid = F.tid, lane = F.lane, wave = F.wave;
    __syncthreads();
    { const float* aup = INP(F, 13) + (size_t)l * 64 * 384; const float* wup = INP(F, 11) + (size_t)(l * 2 + dir) * 64 * 384;
      for (int idx = tid; idx < 4096; idx += 512) { const int i = idx >> 6, c = idx & 63;
          WA[c * 72 + i] = (bf16)f2bf(aup[i * 384 + h * 64 + c]); WW[c * 72 + i] = (bf16)f2bf(wup[i * 384 + h * 64 + c]); }
      if (tid < 320) { const int which = tid >> 6, c = tid & 63;
          const int rc = which == 0 ? h * 64 + c : which == 1 ? 384 + h * 64 + c : which == 2 ? 768 + h * 64 + c : which == 3 ? 1152 + dir * 64 + c : 1280 + c;
          MU[tid] = INP(F, 8)[l * 1472 + rc]; MU[320 + tid] = INP(F, 9)[l * 1472 + rc]; } }
    const int hc = h * 64 + lane;
    const float kk_c = INP(F, 15)[l * 384 + hc], ka_c = INP(F, 16)[l * 384 + hc], rk_c = INP(F, 17)[l * 384 + hc];
    const int mat = wave >> 2, ct = wave & 3;
    const float bias3 = mat ? INP(F, 10)[(l * 2 + dir) * 384 + h * 64 + 16 * ct + (lane & 15)] : INP(F, 12)[l * 384 + h * 64 + 16 * ct + (lane & 15)];
    const int row = wave * 4 + (lane >> 4), j = lane & 15;
    f32x4 S = {0.f, 0.f, 0.f, 0.f};
    v4u pre[3];
    const size_t mb = (size_t)b * SEQ;
#define RW_ISSUE(blk) do { const int T0_ = dir ? SEQ - 32 * ((blk) + 1) : 32 * (blk); _Pragma("unroll") for (int i_ = 0; i_ < 3; ++i_) { const int idx_ = tid + 512 * i_; pre[i_] = (v4u){0u, 0u, 0u, 0u}; \
        if (idx_ < 1360) { const int rr_ = idx_ / 40, q_ = idx_ % 40, wh_ = q_ >> 3, c8_ = q_ & 7; const int t_ = T0_ - 1 + rr_; \
            const int gc_ = (wh_ == 0 ? R_R + h * 64 : wh_ == 1 ? R_K + h * 64 : wh_ == 2 ? R_V + h * 64 : wh_ == 3 ? R_WDF + dir * 64 : R_AD) + c8_ * 8; \
            if (t_ >= 0 && t_ < SEQ) pre[i_] = *(const v4u*)(cols + (mb + t_) * NINP + gc_); } } } while (0)
    RW_ISSUE(0);
    for (int blk = 0; blk < SEQ / 32; ++blk) {
        const int T0 = dir ? SEQ - 32 * (blk + 1) : 32 * blk;
#pragma unroll
        for (int i = 0; i < 3; ++i) { const int idx = tid + 512 * i; if (idx < 1360) { const int rr = idx / 40, q = idx % 40; *(LAS v4u*)(RAWB + rr * 320 + q * 8) = pre[i]; } }
        __syncthreads();
        if (blk + 1 < SEQ / 32) RW_ISSUE(blk + 1);
        for (int idx = tid; idx < 32 * 320; idx += 512) { const int t = idx / 320, cc = idx % 320, which = cc >> 6, c = cc & 63;
            const float p0 = bf2f(RAWB[t * 320 + cc]), p1 = bf2f(RAWB[(t + 1) * 320 + cc]), p2 = bf2f(RAWB[(t + 2) * 320 + cc]);
            const float v = p1 + MU[cc] * (p0 - p1) + MU[320 + cc] * (p2 - p1);
            if (which == 0) OPS[t * 320 + 256 + c] = v;
            else if (which == 1) OPS[t * 320 + 192 + c] = v;
            else if (which == 2) { if ((c >> 5) == half) VV[t * 32 + (c & 31)] = v; }
            else if (which == 3) XW[t * 72 + c] = (bf16)f2bf(tanhf(v));
            else XA[t * 72 + c] = (bf16)f2bf(v); }
        __syncthreads();
#pragma unroll
        for (int tt = 0; tt < 2; ++tt) { f32x4 acc = {0.f, 0.f, 0.f, 0.f};
            acc = mma16<64>((mat ? XW : XA) + tt * 16 * 72, 72, (mat ? WW : WA) + ct * 16 * 72, 72, acc, lane);
#pragma unroll
            for (int jj = 0; jj < 4; ++jj) { const int t = tt * 16 + (lane >> 4) * 4 + jj, c = ct * 16 + (lane & 15); const float x = bias3 + acc[jj];
                if (mat) { const float nx = -x; const float sp = nx > 20.f ? nx : log1pf(__expf(nx)); OPS[t * 320 + c] = __expf(-__expf(-sp - 0.5f)); }
                else OPS[t * 320 + 128 + c] = sigmoidf_(x); } }
        __syncthreads();
#pragma unroll
        for (int i = 0; i < 4; ++i) { const int t = wave * 4 + i; LAS float* op = OPS + t * 320 + lane;
            const float av = op[128], kp = op[192], rp = op[256];
            const float kr = kp * kk_c; const float ss = wave_sum(kr * kr); const float kkv = kr / fmaxf(sqrtf(ss), 1e-12f);
            const float km = kp * (1.f + (av - 1.f) * ka_c);
            const float cs = wave_sum(rp * km * rk_c);
            op[64] = kkv; op[128] = kkv * av; op[192] = km;
            if (dir == 0 && half == 0 && lane == 0) CT[(mb + T0 + t) * 8 + h] = cs; }
        __syncthreads();
#pragma unroll 4
        for (int i = 0; i < 32; ++i) { const int tl = dir ? 31 - i : i; const LAS float* op = OPS + tl * 320 + 4 * j;
            const f32x4 w4 = *(const LAS f32x4*)(op), kk4 = *(const LAS f32x4*)(op + 64), ka4 = *(const LAS f32x4*)(op + 128), km4 = *(const LAS f32x4*)(op + 192), r4 = *(const LAS f32x4*)(op + 256);
            const float vv = VV[tl * 32 + row];
            float sa = (S.x * kk4.x + S.y * kk4.y) + (S.z * kk4.z + S.w * kk4.w);
            const f32x4 pre_s = S * w4 + km4 * vv;
            sa = row16_sum(sa);
            S = pre_s - ka4 * sa;
            float y = (S.x * r4.x + S.y * r4.y) + (S.z * r4.z + S.w * r4.w);
            y = row16_sum(y);
            if (j == 0) YB[tl * 32 + row] = y; }
        __syncthreads();
        { const int idx = tid * 2, tl = idx >> 5, rw = idx & 31;
          *(unsigned*)(Y + (mb + T0 + tl) * 384 + h * 64 + 32 * half + rw) = pk2(YB[idx], YB[idx + 1]); }
    }
#undef RW_ISSUE
    __syncthreads();
}
__device__ __forceinline__ void mlstm_seq(const Frame& F, int l, int task) {
    const int b = task >> 3, h = (task >> 1) & 3, dir = task & 1;
    const bf16* cols = (const bf16*)(WSP(F) + WS_COLS); const float* GT = (const float*)(WSP(F) + WS_GATES);
    bf16* Y = (bf16*)(WSP(F) + (dir ? Y_AB : Y_AF));
    LAS bf16* RAWQ = (LAS bf16*)(F.lds);
    LAS bf16* Qs = (LAS bf16*)(F.lds + 17408); LAS bf16* Ks = (LAS bf16*)(F.lds + 26624);
    LAS bf16* Vt = (LAS bf16*)(F.lds + 35840); LAS bf16* KWt = (LAS bf16*)(F.lds + 45056);
    LAS bf16* Ps = (LAS bf16*)(F.lds + 54272); LAS bf16* Ct = (LAS bf16*)(F.lds + 63488);
    LAS float* fa = (LAS float*)(F.lds + 72704);
    LAS float* li = fa, *lf = fa + 64, *bcs = fa + 128, *gg = fa + 192, *mq = fa + 256, *iw = fa + 320, *den = fa + 384, *nst = fa + 448, *scal = fa + 512;
    const int tid = F.tid, lane = F.lane, wave = F.wave;
    const size_t mb = (size_t)b * SEQ;
    __syncthreads();
    for (int i = tid; i < 64 * 72; i += 512) Ct[i] = 0;
    if (tid < 64) nst[tid] = 0.f;
    const int cc = tid & 127, isK = cc >> 6, d0 = cc & 63, chn = isK * 256 + h * 64 + d0;
    float cw[5]; const float* cwp = INP(F, 3) + (size_t)l * 5 * 512;
#pragma unroll
    for (int jj = 0; jj < 5; ++jj) cw[jj] = cwp[jj * 512 + chn];
    const float cbv = INP(F, 4)[l * 512 + chn];
    f32x4 st[2] = {{0.f, 0.f, 0.f, 0.f}, {0.f, 0.f, 0.f, 0.f}};
    float m_st = 0.f, nloc = 0.f;
    for (int c = 0; c < SEQ / 64; ++c) {
        const int tlo = dir ? SEQ - 64 * (c + 1) : 64 * c;
        for (int ch = tid; ch < 68 * 16; ch += 512) { const int rr = ch >> 4, q = ch & 15; const int t = tlo - 2 + rr;
            v4u v = {0u, 0u, 0u, 0u}; if (t >= 0 && t < SEQ) v = *(const v4u*)(cols + (mb + t) * NINP + (q >> 3) * 256 + h * 64 + (q & 7) * 8);
            *(LAS v4u*)(RAWQ + rr * 128 + q * 8) = v; }
        { const int tl = tid >> 3, e8 = tid & 7; const int lpos = dir ? 63 - tl : tl;
          const v4u v = *(const v4u*)(cols + (mb + tlo + tl) * NINP + A_V + h * 64 + e8 * 8);
          const unsigned w[4] = {v.x, v.y, v.z, v.w};
#pragma unroll
          for (int k = 0; k < 4; ++k) { Vt[(e8 * 8 + 2 * k) * 72 + lpos] = (bf16)(w[k] & 0xffffu); Vt[(e8 * 8 + 2 * k + 1) * 72 + lpos] = (bf16)(w[k] >> 16); } }
        if (tid < 64) { const int t = dir ? tlo + 63 - tid : tlo + tid; li[tid] = GT[(mb + t) * 16 + dir * 4 + h]; lf[tid] = GT[(mb + t) * 16 + 8 + dir * 4 + h]; }
        __syncthreads();
#pragma unroll 4
        for (int i = 0; i < 16; ++i) { const int tl = (tid >> 7) + 4 * i; float s = cbv;
#pragma unroll
            for (int jj = 0; jj < 5; ++jj) s += cw[jj] * bf2f(RAWQ[(tl + jj) * 128 + cc]);
            s = siluf_(s); const int lpos = dir ? 63 - tl : tl;
            if (isK) Ks[lpos * 72 + d0] = (bf16)f2bf(s * 0.125f); else Qs[lpos * 72 + d0] = (bf16)f2bf(s); }
        if (tid < 64) { float run = 0.f, rm = -INFINITY, bl = 0.f;
            for (int s = 0; s < 64; ++s) { run += lf[s]; if (s <= tid) { rm = fmaxf(rm, li[s] - run); if (s == tid) bl = run; } }
            const float g = run - bl + li[tid]; const float mloc = wave_max(g);
            const float mqv = bl + fmaxf(m_st, rm);
            bcs[tid] = bl; gg[tid] = g; mq[tid] = mqv; iw[tid] = __expf(bl + m_st - mqv);
            if (tid == 0) { scal[0] = mloc; scal[1] = run; } }
        __syncthreads();
        const float mloc = scal[0], blast = scal[1];
        for (int idx = tid; idx < 4096; idx += 512) { const int lp = idx >> 6, d = idx & 63; KWt[d * 72 + lp] = (bf16)f2bf(bf2f(Ks[lp * 72 + d]) * __expf(gg[lp] - mloc)); }
#pragma unroll
        for (int k = 0; k < 2; ++k) { const int ti = 2 * wave + k, tl_ = ti >> 2, ts = ti & 3; f32x4 acc = {0.f, 0.f, 0.f, 0.f};
            if (ts <= tl_) acc = mma16<64>(Qs + tl_ * 16 * 72, 72, Ks + ts * 16 * 72, 72, acc, lane);
#pragma unroll
            for (int jj = 0; jj < 4; ++jj) { const int lr = tl_ * 16 + (lane >> 4) * 4 + jj, s = ts * 16 + (lane & 15);
                const float v = (s <= lr) ? acc[jj] * __expf(bcs[lr] - bcs[s] + li[s] - mq[lr]) : 0.f; Ps[lr * 72 + s] = (bf16)f2bf(v); } }
        __syncthreads();
        f32x4 a1[2], a2[2], lc[2];
#pragma unroll
        for (int k = 0; k < 2; ++k) { const int ti = 2 * wave + k, t0_ = ti >> 2, t1_ = ti & 3; const f32x4 z = {0.f, 0.f, 0.f, 0.f};
            a1[k] = mma16<64>(Ps + t0_ * 16 * 72, 72, Vt + t1_ * 16 * 72, 72, z, lane);
            a2[k] = mma16<64>(Qs + t0_ * 16 * 72, 72, Ct + t1_ * 16 * 72, 72, z, lane);
            lc[k] = mma16<64>(Vt + t0_ * 16 * 72, 72, KWt + t1_ * 16 * 72, 72, z, lane); }
        if (tid < 64) { float sp = 0.f, qn = 0.f, nl = 0.f;
            for (int s = 0; s < 64; ++s) { sp += bf2f(Ps[tid * 72 + s]); qn += bf2f(Qs[tid * 72 + s]) * nst[s]; nl += bf2f(KWt[tid * 72 + s]); }
            const float dn = sp + iw[tid] * qn; den[tid] = 1.f / fmaxf(fabsf(dn), __expf(-mq[tid])); nloc = nl; }
        __syncthreads();
        const float m_new = fmaxf(blast + m_st, mloc), s_old = __expf(blast + m_st - m_new), s_new = __expf(mloc - m_new);
#pragma unroll
        for (int k = 0; k < 2; ++k) { const int ti = 2 * wave + k, t0_ = ti >> 2, t1_ = ti & 3;
#pragma unroll
            for (int jj = 0; jj < 4; ++jj) { const int r_ = t0_ * 16 + (lane >> 4) * 4 + jj, c_ = t1_ * 16 + (lane & 15);
                const float val = (a1[k][jj] + iw[r_] * a2[k][jj]) * den[r_];
                const int t = dir ? tlo + 63 - r_ : tlo + r_;
                Y[(mb + t) * 256 + h * 64 + c_] = (bf16)f2bf(val);
                st[k][jj] = s_old * st[k][jj] + s_new * lc[k][jj];
                Ct[r_ * 72 + c_] = (bf16)f2bf(st[k][jj]); } }
        if (tid < 64) nst[tid] = s_old * nst[tid] + s_new * nloc;
        m_st = m_new;
        __syncthreads();
    }
}
__device__ __forceinline__ void ssd_seq(const Frame& F, int l, int task) {
    const int b = task / 12, rem = task % 12, head = rem >> 1, dir = rem & 1, g = head / 3;
    const bf16* cols = (const bf16*)(WSP(F) + WS_COLS);
    bf16* Y = (bf16*)(WSP(F) + (dir ? Y_SB : Y_SF));
    LAS bf16* RAW = (LAS bf16*)(F.lds);
    LAS bf16* Cm = (LAS bf16*)(F.lds + 43520); LAS bf16* Bm = (LAS bf16*)(F.lds + 60928);
    LAS bf16* Btn = (LAS bf16*)(F.lds + 78336); LAS bf16* Ps = (LAS bf16*)(F.lds + 96768);
    LAS bf16* XDt = (LAS bf16*)(F.lds + 105984); LAS bf16* XWt = (LAS bf16*)(F.lds + 115200);
    LAS bf16* Hs = (LAS bf16*)(F.lds + 124416);
    LAS float* dtv = (LAS float*)(F.lds + 141824); LAS float* acs = dtv + 64; LAS float* scal = dtv + 128;
    const int tid = F.tid, lane = F.lane, wave = F.wave;
    const size_t mb = (size_t)b * SEQ;
    __syncthreads();
    for (int i = tid; i < 64 * 136; i += 512) Hs[i] = 0;
    const float dtb = INP(F, 22)[(l * 2 + dir) * 6 + head];
    const float aneg = -__expf(INP(F, 23)[(l * 2 + dir) * 6 + head]);
    const int cc = tid < 320 ? tid : 0;
    const int chn = cc < 64 ? head * 64 + cc : (cc < 192 ? 384 + g * 128 + (cc - 64) : 640 + g * 128 + (cc - 192));
    float cw[5]; const float* cwp = INP(F, 20) + (size_t)l * 5 * 896;
#pragma unroll
    for (int jj = 0; jj < 5; ++jj) cw[jj] = cwp[jj * 896 + chn];
    const float cbv = INP(F, 21)[l * 896 + chn];
    f32x4 st[4];
#pragma unroll
    for (int k = 0; k < 4; ++k) st[k] = (f32x4){0.f, 0.f, 0.f, 0.f};
    for (int c = 0; c < SEQ / 64; ++c) {
        const int tlo = dir ? SEQ - 64 * (c + 1) : 64 * c;
        for (int ch = tid; ch < 68 * 40; ch += 512) { const int rr = ch / 40, q = ch % 40; const int t = tlo - 2 + rr;
            const int gc = q < 8 ? S_X + head * 64 + q * 8 : (q < 24 ? S_B + g * 128 + (q - 8) * 8 : S_C + g * 128 + (q - 24) * 8);
            v4u v = {0u, 0u, 0u, 0u}; if (t >= 0 && t < SEQ) v = *(const v4u*)(cols + (mb + t) * NINP + gc);
            *(LAS v4u*)(RAW + rr * 320 + q * 8) = v; }
        if (tid < 64) { const int t = dir ? tlo + 63 - tid : tlo + tid;
            const float x = bf2f(cols[(mb + t) * NINP + S_DT + dir * 6 + head]) + dtb;
            const float dt = x > 20.f ? x : log1pf(__expf(x));
            float cs = dt * aneg;
#pragma unroll
            for (int o = 1; o < 64; o <<= 1) { const float u = __shfl_up(cs, o); if (lane >= o) cs += u; }
            const float tot = __shfl(cs, 63);
            dtv[tid] = dt; acs[tid] = cs; if (tid == 0) scal[0] = tot; }
        __syncthreads();
        const float tot = scal[0];
        if (tid < 320) {
            float win[5];
#pragma unroll
            for (int jj = 0; jj < 4; ++jj) win[jj] = bf2f(RAW[jj * 320 + cc]);
            for (int tl = 0; tl < 64; ++tl) { win[4] = bf2f(RAW[(tl + 4) * 320 + cc]);
                float s = cbv;
#pragma unroll
                for (int jj = 0; jj < 5; ++jj) s += cw[jj] * win[jj];
#pragma unroll
                for (int jj = 0; jj < 4; ++jj) win[jj] = win[jj + 1];
                s = siluf_(s); const int lp = dir ? 63 - tl : tl;
                if (cc < 64) { const float xd = s * dtv[lp]; XDt[cc * 72 + lp] = (bf16)f2bf(xd); XWt[cc * 72 + lp] = (bf16)f2bf(xd * __expf(tot - acs[lp])); }
                else if (cc < 192) { const bf16 bv = (bf16)f2bf(s); Bm[lp * 136 + (cc - 64)] = bv; Btn[(cc - 64) * 72 + lp] = bv; }
                else Cm[lp * 136 + (cc - 192)] = (bf16)f2bf(s); } }
        __syncthreads();
        f32x4 yo[2], lc[4];
#pragma unroll
        for (int k = 0; k < 2; ++k) { const int ti = 2 * wave + k, tl_ = ti >> 2, ts = ti & 3; f32x4 acc = {0.f, 0.f, 0.f, 0.f};
            if (ts <= tl_) acc = mma16<128>(Cm + tl_ * 16 * 136, 136, Bm + ts * 16 * 136, 136, acc, lane);
#pragma unroll
            for (int jj = 0; jj < 4; ++jj) { const int lr = tl_ * 16 + (lane >> 4) * 4 + jj, s = ts * 16 + (lane & 15);
                const float v = (s <= lr) ? acc[jj] * __expf(acs[lr] - acs[s]) : 0.f; Ps[lr * 72 + s] = (bf16)f2bf(v); }
            const f32x4 z = {0.f, 0.f, 0.f, 0.f};
            yo[k] = mma16<128>(Cm + tl_ * 16 * 136, 136, Hs + ts * 16 * 136, 136, z, lane); }
#pragma unroll
        for (int k = 0; k < 4; ++k) { const int ti = 4 * wave + k, tp = ti >> 3, tn = ti & 7; const f32x4 z = {0.f, 0.f, 0.f, 0.f};
            lc[k] = mma16<64>(XWt + tp * 16 * 72, 72, Btn + tn * 16 * 72, 72, z, lane); }
        __syncthreads();
        const float cdec = __expf(tot);
#pragma unroll
        for (int k = 0; k < 2; ++k) { const int ti = 2 * wave + k, tl_ = ti >> 2, tp = ti & 3; const f32x4 z = {0.f, 0.f, 0.f, 0.f};
            const f32x4 yd = mma16<64>(Ps + tl_ * 16 * 72, 72, XDt + tp * 16 * 72, 72, z, lane);
#pragma unroll
            for (int jj = 0; jj < 4; ++jj) { const int lr = tl_ * 16 + (lane >> 4) * 4 + jj, p = tp * 16 + (lane & 15);
                const float val = yd[jj] + yo[k][jj] * __expf(acs[lr]);
                const int t = dir ? tlo + 63 - lr : tlo + lr;
                Y[(mb + t) * 384 + head * 64 + p] = (bf16)f2bf(val); } }
#pragma unroll
        for (int k = 0; k < 4; ++k) { const int ti = 4 * wave + k, tp = ti >> 3, tn = ti & 7;
#pragma unroll
            for (int jj = 0; jj < 4; ++jj) { const int p = tp * 16 + (lane >> 4) * 4 + jj, n = tn * 16 + (lane & 15);
                st[k][jj] = cdec * st[k][jj] + lc[k][jj]; Hs[p * 136 + n] = (bf16)f2bf(st[k][jj]); } }
        __syncthreads();
    }
}
__device__ __forceinline__ void phase_post(const Frame& F, int l) {
    const bf16* cols = (const bf16*)(WSP(F) + WS_COLS); bf16* MIX = (bf16*)(WSP(F) + WS_XN);
    const bf16* YAf = (const bf16*)(WSP(F) + Y_AF); const bf16* YAb = (const bf16*)(WSP(F) + Y_AB);
    const bf16* YRf = (const bf16*)(WSP(F) + Y_RF); const bf16* YRb = (const bf16*)(WSP(F) + Y_RB);
    const bf16* YSf = (const bf16*)(WSP(F) + Y_SF); const bf16* YSb = (const bf16*)(WSP(F) + Y_SB);
    const float* CT = (const float*)(WSP(F) + WS_CT);
    LAS float* sg = (LAS float*)(F.lds);
    LAS float* gate = (LAS float*)(F.lds + 8192);
    const int tid = F.tid, lane = F.lane, wave = F.wave;
    const float* mup = INP(F, 8) + l * 1472; const float* mun = INP(F, 9) + l * 1472;
    const float* gup = INP(F, 14) + (size_t)l * 128 * 384;
    const float* mng = INP(F, 7) + l * 256; const float* rng = INP(F, 18) + l * 384; const float* rnb = INP(F, 19) + l * 384;
    const float* scb = INP(F, 21) + l * 896; const float* scw = INP(F, 20) + (size_t)l * 5 * 896; const float* sdk = INP(F, 24) + l * 6; const float* sng = INP(F, 25) + l * 384;
    for (int tile = F.vcu; tile < M / 16; tile += F.G) {
        const int m0 = tile * 16;
        __syncthreads();
        for (int idx = tid; idx < 16 * 128; idx += 512) { const int tt = idx >> 7, i = idx & 127; const int m = m0 + tt, t = m % SEQ;
            const float p1 = bf2f(cols[(size_t)m * NINP + R_GD + i]);
            const float p0 = t > 0 ? bf2f(cols[(size_t)(m - 1) * NINP + R_GD + i]) : 0.f;
            const float p2 = t < SEQ - 1 ? bf2f(cols[(size_t)(m + 1) * NINP + R_GD + i]) : 0.f;
            sg[idx] = sigmoidf_(p1 + mup[1344 + i] * (p0 - p1) + mun[1344 + i] * (p2 - p1)); }
        __syncthreads();
        if (tid < 384) { float acc[16];
#pragma unroll
            for (int tt = 0; tt < 16; ++tt) acc[tt] = 0.f;
            for (int i = 0; i < 128; ++i) { const float w = gup[i * 384 + tid];
#pragma unroll
                for (int tt = 0; tt < 16; ++tt) acc[tt] += sg[tt * 128 + i] * w; }
#pragma unroll
            for (int tt = 0; tt < 16; ++tt) gate[tt * 384 + tid] = acc[tt]; }
        __syncthreads();
#pragma unroll 1
        for (int k = 0; k < 2; ++k) { const int tt = wave * 2 + k; const int m = m0 + tt, t = m % SEQ; const size_t cr = (size_t)m * NINP;
#pragma unroll
            for (int i = 0; i < 4; ++i) { const int col = i * 64 + lane;
                const float hs = bf2f(YAf[(size_t)m * 256 + col]) + bf2f(YAb[(size_t)m * 256 + col]);
                const float mean = wave_sum(hs) * (1.f / 64.f); const float d = hs - mean; const float var = wave_sum(d * d) * (1.f / 64.f);
                const float y = d * (1.f / sqrtf(var + 1e-6f)) * mng[col];
                MIX[(size_t)m * DM + col] = (bf16)f2bf(y * sigmoidf_(bf2f(cols[cr + A_O + col]))); }
#pragma unroll
            for (int i = 0; i < 6; ++i) { const int col = i * 64 + lane;
                const float ys = bf2f(YRf[(size_t)m * 384 + col]) + bf2f(YRb[(size_t)m * 384 + col]);
                const float mean = wave_sum(ys) * (1.f / 64.f); const float d = ys - mean; const float var = wave_sum(d * d) * (1.f / 64.f);
                const float y = d * (1.f / sqrtf(var + 64e-5f)) * rng[col] + rnb[col];
                const float p1 = bf2f(cols[cr + R_V + col]);
                const float p0 = t > 0 ? bf2f(cols[cr - NINP + R_V + col]) : 0.f;
                const float p2 = t < SEQ - 1 ? bf2f(cols[cr + NINP + R_V + col]) : 0.f;
                const float vv = p1 + mup[768 + col] * (p0 - p1) + mun[768 + col] * (p2 - p1);
                const float bonus = CT[(size_t)m * 8 + i] * vv;
                MIX[(size_t)m * DM + 256 + col] = (bf16)f2bf((y + bonus) * gate[tt * 384 + col]); }
            float yv[6]; float ssq[2] = {0.f, 0.f};
#pragma unroll
            for (int i = 0; i < 6; ++i) { const int col = i * 64 + lane;
                float s = scb[col];
#pragma unroll
                for (int jj = 0; jj < 5; ++jj) { const int tq = t + jj - 2; if (tq >= 0 && tq < SEQ) s += scw[jj * 896 + col] * bf2f(cols[cr + (jj - 2) * NINP + S_X + col]); }
                const float xc = siluf_(s);
                float y = bf2f(YSf[(size_t)m * 384 + col]) + bf2f(YSb[(size_t)m * 384 + col]) + sdk[i] * xc;
                y *= siluf_(bf2f(cols[cr + S_Z + col]));
                yv[i] = y; ssq[i / 3] += y * y; }
            const float r0 = 1.f / sqrtf(wave_sum(ssq[0]) * (1.f / 192.f) + 1e-6f), r1 = 1.f / sqrtf(wave_sum(ssq[1]) * (1.f / 192.f) + 1e-6f);
#pragma unroll
            for (int i = 0; i < 6; ++i) { const int col = i * 64 + lane;
                MIX[(size_t)m * DM + 640 + col] = (bf16)f2bf(yv[i] * (i < 3 ? r0 : r1) * sng[col]); }
        }
    }
    __syncthreads();
}
namespace cg = cooperative_groups;
constexpr int N_PHASES = 9 * DEPTH + 1;
__global__ void __launch_bounds__(NWAVES * 64, 2) mk_fwd(Args args) {
    extern __shared__ __attribute__((aligned(16))) unsigned char lds_raw[];
    Frame F;
    F.lds = (LAS unsigned char*)lds_raw;
    F.tid = threadIdx.x; F.lane = F.tid & 63; F.wave = __builtin_amdgcn_readfirstlane(F.tid >> 6);
    F.G = gridDim.x; { const int bx = blockIdx.x; F.vcu = (F.G % 8 == 0) ? (bx % 8) * (F.G / 8) + bx / 8 : bx; }
    volatile LAS unsigned* MISC = (volatile LAS unsigned*)(F.lds + MISC_OFF);
    if (F.tid < 64) MISC[F.tid] = 0u;
    if (F.tid < 34) *(LAS unsigned long long*)(F.lds + PTAB_OFF + 8 * F.tid) = ((const unsigned long long*)__builtin_amdgcn_kernarg_segment_ptr())[F.tid];
    __syncthreads();
    unsigned* ctl = (unsigned*)(WSP(F) + WS_CTL);
    XcdBarrier bar = xcd_barrier_post(ctl + CW_BAR, MISC + 8);
    const int lo = args.ph_lo, hi = args.ph_hi;
#define IN_(k) (lo <= (k) && (k) < hi)
#define SEAM(k) do { if (IN_(k) && IN_((k) + 1)) { if ((k) == 0) cg::this_grid().sync(); else xcd_barrier(bar); } } while (0)
#define LAYER(l, B) \
    if (IN_(B + 0)) { phase_convert(F, l); phase_norm(F, l == 0 ? INP(F, 0) : OUTP(F), INP(F, 1) + l * DM, (bf16*)(WSP(F) + WS_XN)); } SEAM(B + 0); \
    if (IN_(B + 1)) { unsigned char* ws = WSP(F); pg8::Gemm g{(const bf16*)(ws + WS_XN), (const bf16*)(ws + WS_WIN), M, NINP, DM}; pg8::StaticOrder S; S.init(M, NINP, F.G, (int)blockIdx.x); \
            pg8::EpiBf16<0> E{(bf16*)(ws + WS_COLS), NINP, nullptr, 0, 0, 1.f}; \
            pg8::gemm_phase<pg8::EpiBf16<0>, pg8::StaticOrder, PG8_ALIGN, PG8_SP2>(F.lds, g, S, E); } SEAM(B + 1); \
    if (IN_(B + 2)) phase_gates(F, l); SEAM(B + 2); \
    if (IN_(B + 3)) { const int bx = blockIdx.x; \
            if (bx < 48) rwkv_scan(F, l, bx); else if (bx < 64) mlstm_seq(F, l, bx - 48); else if (bx < 88) ssd_seq(F, l, bx - 64); } SEAM(B + 3); \
    if (IN_(B + 4)) phase_post(F, l); SEAM(B + 4); \
    if (IN_(B + 5)) { unsigned char* ws = WSP(F); pg8::Gemm g{(const bf16*)(ws + WS_XN), (const bf16*)(ws + WS_WOUT), M, DM, DM}; pg8::StaticOrder S; S.init(M, DM, F.G, (int)blockIdx.x); \
            pg8::EpiResidual E{l == 0 ? INP(F, 0) : OUTP(F), OUTP(F), DM}; \
            pg8::gemm_phase<pg8::EpiResidual, pg8::StaticOrder, PG8_ALIGN, PG8_SP2>(F.lds, g, S, E); } SEAM(B + 5); \
    if (IN_(B + 6)) phase_norm(F, OUTP(F), INP(F, 27) + l * DM, (bf16*)(WSP(F) + WS_XN)); SEAM(B + 6); \
    if (IN_(B + 7)) { unsigned char* ws = WSP(F); pg8::Gemm g{(const bf16*)(ws + WS_XN), (const bf16*)(ws + WS_WGU), M, 2 * FFN, DM}; pg8::StaticOrder S; S.init(M, 2 * FFN, F.G, (int)blockIdx.x); \
            pg8::EpiSwiGLU E{(bf16*)(ws + WS_COLS), FFN}; \
            pg8::gemm_phase<pg8::EpiSwiGLU, pg8::StaticOrder, PG8_ALIGN, PG8_SP2>(F.lds, g, S, E); } SEAM(B + 7); \
    if (IN_(B + 8)) { unsigned char* ws = WSP(F); pg8::Gemm g{(const bf16*)(ws + WS_COLS), (const bf16*)(ws + WS_WDN), M, DM, FFN}; pg8::StaticOrder S; S.init(M, DM, F.G, (int)blockIdx.x); \
            pg8::EpiResidual E{OUTP(F), OUTP(F), DM}; \
            pg8::gemm_phase<pg8::EpiResidual, pg8::StaticOrder, PG8_ALIGN, PG8_SP2>(F.lds, g, S, E); } SEAM(B + 8);
    LAYER(0, 0)
    LAYER(1, 9)
    if (IN_(18)) phase_final_norm(F, OUTP(F), INP(F, 31));
#undef IN_
#undef SEAM
#undef LAYER
}

#ifndef MK_PER_PHASE
#define MK_PER_PHASE 0
#endif
extern "C" void kernel_launch(void* const* d_in, const int* in_sizes, int n_in, void* d_out, int out_size, void* d_ws, size_t ws_size, hipStream_t stream) {
    static int grid = 0;
    if (grid == 0) {
        int dev = 0, cus = 0;
        if (n_in != 32 || out_size != M * DM || ws_size < WS_END) { fprintf(stderr, "kernel_launch: unexpected shapes (n_in %d out %d ws %zu)\n", n_in, out_size, ws_size); grid = -1; return; }
        if (hipGetDevice(&dev) != hipSuccess || hipDeviceGetAttribute(&cus, hipDeviceAttributeMultiprocessorCount, dev) != hipSuccess) { grid = -1; return; }
        if (hipFuncSetAttribute((const void*)mk_fwd, hipFuncAttributeMaxDynamicSharedMemorySize, LDS_BYTES) != hipSuccess) { fprintf(stderr, "kernel_launch: hipFuncSetAttribute failed\n"); grid = -1; return; }
        int per_cu = 0;
        if (hipOccupancyMaxActiveBlocksPerMultiprocessor(&per_cu, (const void*)mk_fwd, NWAVES * 64, LDS_BYTES) != hipSuccess || per_cu < 1) { fprintf(stderr, "kernel_launch: occupancy query says %d\n", per_cu); }
        (void)hipGetLastError();
        grid = cus;
    }
    if (grid < 0) return;
    (void)hipMemsetAsync((char*)d_ws + WS_CTL, 0, CTL_ZERO_BYTES, stream);
    Args a{};
    for (int i = 0; i < 32; ++i) a.in[i] = (const float*)d_in[i];
    a.out = (float*)d_out; a.ws = (unsigned char*)d_ws;
#if MK_PER_PHASE
    for (int p = 0; p < N_PHASES; ++p) { a.ph_lo = p; a.ph_hi = p + 1; hipLaunchKernelGGL(mk_fwd, dim3(grid), dim3(NWAVES * 64), LDS_BYTES, stream, a); }
#else
    a.ph_lo = 0; a.ph_hi = N_PHASES;
    void* kargs[] = {&a};
    hipError_t e = hipLaunchCooperativeKernel((const void*)mk_fwd, dim3(grid), dim3(NWAVES * 64), kargs, LDS_BYTES, stream);
    if (e != hipSuccess) fprintf(stderr, "cooperative launch failed: %s (grid %d)\n", hipGetErrorString(e), grid);
#endif
}
```

```cpp
#include <hip/hip_runtime.h>
#include <hip/hip_cooperative_groups.h>
#include <cstdio>
#include <cstdint>
namespace pg8 {
#define PG8_LAS __attribute__((address_space(3)))
typedef unsigned short bf16_t;
typedef short bf16x8 __attribute__((ext_vector_type(8)));
typedef float f32x4 __attribute__((ext_vector_type(4)));
typedef unsigned u32x4 __attribute__((ext_vector_type(4)));
constexpr int BM = 256, BK = 64, HALF = 128, HTB = HALF * BK * 2  , STAGE_BYTES = 8 * HTB, NXCD = 8, WGM = 8;

__host__ __device__ __forceinline__ int lds_byte(int r, int c) { const int st = (r >> 4) * 2 + (c >> 5), rr = r & 15, cc = c & 31, ob = rr * 64 + cc * 2; return st * 1024 + (ob ^ (((ob >> 9) & 1) << 5)); }
__host__ __device__ __forceinline__ void stage_rc(int b, int& R, int& C) { const int st = b / 1024, sb = b % 1024, swz = sb ^ (((sb >> 9) & 1) << 5); R = (st >> 1) * 16 + swz / 64; C = (st & 1) * 32 + (swz % 64) / 2; }
__host__ __device__ __forceinline__ int perm32(int rho) { const int n = rho >> 4, i = rho & 15; return 8 * (i >> 2) + 4 * n + (i & 3); }

struct Unit { int pm, pn; };
struct Gemm { const bf16_t* A; const bf16_t* Bt; int M, N, K; };

struct StaticOrder {
    int nM, nN, nwg, G, c;
    __host__ __device__ void init(int M, int N, int G_, int c_) { nM = M / BM; nN = N / BM; nwg = nM * nN; G = G_; c = c_; }
    __host__ __device__ bool next(int i, Unit& u) const {
        const long L = (long)i * G + c; if (L >= nwg) return false;
        int wgid = (int)L; { const int q = nwg / NXCD, r = nwg % NXCD, xcd = wgid % NXCD, off = wgid / NXCD; wgid = (xcd < r ? xcd * (q + 1) : r * (q + 1) + (xcd - r) * q) + off; }
        const int nig = WGM * nN, gid = wgid / nig, fm = gid * WGM, gsz = (nM - fm) < WGM ? (nM - fm) : WGM;
        u.pm = fm + ((wgid % nig) % gsz); u.pn = (wgid % nig) / gsz; return true;
    }
    __device__ __forceinline__ void a_ready(const Unit&) const {}
    __device__ __forceinline__ void done(const Unit&) const {}
};

__device__ __forceinline__ unsigned cvt_pk_bf16(float lo, float hi) { unsigned r; asm volatile("v_cvt_pk_bf16_f32 %0, %1, %2" : "=v"(r) : "v"(lo), "v"(hi)); return r; }
typedef float f32x2 __attribute__((ext_vector_type(2)));
__device__ __forceinline__ f32x2 gelu_pk(f32x2 v) {
    const f32x2 av = __builtin_elementwise_abs(v), d = av * 0.2316418882f + 1.0f;
    f32x2 t; t.x = __builtin_amdgcn_rcpf(d.x); t.y = __builtin_amdgcn_rcpf(d.y);
    f32x2 q = t * 0.5307027145f + (-0.7265760135f); q = q * t + 0.7107068705f; q = q * t + (-0.142248368f); q = q * t + 0.127414796f; q = q * t;
    const f32x2 s = (v * v) * (-0.72134752044f);
    f32x2 e; e.x = __builtin_amdgcn_exp2f(s.x); e.y = __builtin_amdgcn_exp2f(s.y);
    const f32x2 m = v * (q * e), r = v - m;
    f32x2 o; o.x = v.x < 0.f ? m.x : r.x; o.y = v.y < 0.f ? m.y : r.y; return o;
}

template <int ACT  > struct EpiBf16 {
    static constexpr bool PERM = true, AFTER_DRAIN = false; static_assert(ACT == 0 || ACT == 1, "EpiBf16: ACT is 0 (none) or 1 (gelu_pk)");
    bf16_t* O; int ldc; const float* bias; int split_cols; size_t split_stride; float scale0;
    __device__ __forceinline__ void operator()(const f32x4 (&acc)[2][2][4][2], const Unit& u, int wr, int wc, int fr, int fq) const {
        const int row0 = u.pm * BM + wr * 64 + fr; int colt = u.pn * BM; bf16_t* base = O;
        float sc = 1.f; if (split_cols) { const int t = colt / split_cols; base += (size_t)t * split_stride; colt -= t * split_cols; if (t == 0) sc = scale0; }
        const int col0 = colt + wc * 32 + 8 * fq, bcol0 = u.pn * BM + wc * 32 + 8 * fq;
        f32x4 bv[2][2];
#pragma unroll
        for (int bj = 0; bj < 2; ++bj)
#pragma unroll
            for (int n = 0; n < 2; ++n) bv[bj][n] = bias ? *(const f32x4*)(bias + bcol0 + bj * HALF + 4 * n) : (f32x4){0.f, 0.f, 0.f, 0.f};
#pragma unroll
        for (int ai = 0; ai < 2; ++ai)
#pragma unroll
            for (int m = 0; m < 4; ++m) { bf16_t* rowp = base + (size_t)(row0 + ai * HALF + m * 16) * ldc + col0;
#pragma unroll
                for (int bj = 0; bj < 2; ++bj) { f32x4 v0 = acc[ai][bj][m][0] + bv[bj][0], v1 = acc[ai][bj][m][1] + bv[bj][1];
                    if (ACT == 1) { f32x2 a = gelu_pk((f32x2){v0[0], v0[1]}), b = gelu_pk((f32x2){v0[2], v0[3]}), c = gelu_pk((f32x2){v1[0], v1[1]}), d = gelu_pk((f32x2){v1[2], v1[3]});
                        v0 = (f32x4){a.x, a.y, b.x, b.y}; v1 = (f32x4){c.x, c.y, d.x, d.y}; }
                    v0 = v0 * sc; v1 = v1 * sc; u32x4 w; w.x = cvt_pk_bf16(v0[0], v0[1]); w.y = cvt_pk_bf16(v0[2], v0[3]); w.z = cvt_pk_bf16(v1[0], v1[1]); w.w = cvt_pk_bf16(v1[2], v1[3]);
                    *(u32x4*)(rowp + bj * HALF) = w; } }
    }
};
struct EpiResidual {
    static constexpr bool PERM = false, AFTER_DRAIN = false;
    const float* base; float* out; int ldc;
    __device__ __forceinline__ void operator()(const f32x4 (&acc)[2][2][4][2], const Unit& u, int wr, int wc, int fr, int fq) const {
        const int col0 = u.pn * BM + wc * 32 + 4 * fq;
#pragma unroll
        for (int ai = 0; ai < 2; ++ai)
#pragma unroll
            for (int m = 0; m < 4; ++m) { const size_t off = (size_t)(u.pm * BM + ai * HALF + wr * 64 + m * 16 + fr) * ldc + col0;
#pragma unroll
                for (int bj = 0; bj < 2; ++bj)
#pragma unroll
                    for (int n = 0; n < 2; ++n) { const f32x4 bs = *(const f32x4*)(base + off + bj * HALF + n * 16); *(f32x4*)(out + off + bj * HALF + n * 16) = bs + acc[ai][bj][m][n]; }
                asm volatile("" ::: "memory"); }
    }
};
struct EpiSwiGLU {
    static constexpr bool PERM = true, AFTER_DRAIN = false;
    bf16_t* O; int ldc;
    __device__ __forceinline__ void operator()(const f32x4 (&acc)[2][2][4][2], const Unit& u, int wr, int wc, int fr, int fq) const {
        const int col0 = u.pn * HALF + wc * 32 + 8 * fq;
#pragma unroll
        for (int ai = 0; ai < 2; ++ai)
#pragma unroll
            for (int m = 0; m < 4; ++m) { bf16_t* rowp = O + (size_t)(u.pm * BM + ai * HALF + wr * 64 + m * 16 + fr) * ldc + col0;
                float r[8];
#pragma unroll
                for (int n = 0; n < 2; ++n)
#pragma unroll
                    for (int j = 0; j < 4; ++j) { const float g = acc[ai][0][m][n][j], up = acc[ai][1][m][n][j]; r[n * 4 + j] = g * __builtin_amdgcn_rcpf(1.f + __expf(-g)) * up; }
                u32x4 w; w.x = cvt_pk_bf16(r[0], r[1]); w.y = cvt_pk_bf16(r[2], r[3]); w.z = cvt_pk_bf16(r[4], r[5]); w.w = cvt_pk_bf16(r[6], r[7]);
                *(u32x4*)rowp = w; }
    }
};
template <class Epi, class Sched, bool ALIGN_EPI = false, bool SP2 = false>
__device__ __forceinline__ void gemm_phase(PG8_LAS unsigned char* lds, const Gemm g, const Sched& S, const Epi& E) {
    const int tid = threadIdx.x, wid = __builtin_amdgcn_readfirstlane(tid >> 6), lane = tid & 63, wr = wid >> 2, wc = wid & 3, fr = lane & 15, fq = lane >> 4;
    const int K = g.K, nt = K / BK;
    unsigned voffA[2], voffB[2];
#pragma unroll
    for (int i = 0; i < 2; ++i) { int R, C; stage_rc(tid * 16 + i * 8192, R, C); const int Rb = Epi::PERM ? ((R & ~31) + perm32(R & 31)) : R;
        voffA[i] = (unsigned)(R * K + C) * 2u; voffB[i] = (unsigned)(Rb * K + C) * 2u; }
    const size_t kstep = (size_t)(BK * 2);
    const size_t hstep = (size_t)HALF * K * 2;
    const size_t tstep = 2 * hstep;
    const unsigned ldsw = (unsigned)wid * 1024u;
    const int aoff = lds_byte(wr * 64 + fr, fq * 8), boff = lds_byte(wc * 32 + fr, fq * 8);
#define PG8_SA(b, h) (((b) * 2 + (h)) * HTB)
#define PG8_SB(b, h) ((4 + (b) * 2 + (h)) * HTB)
#define PG8_STAGE(bufoff, gbase, voff) do { _Pragma("unroll") for (int _i = 0; _i < 2; ++_i) \
        __builtin_amdgcn_global_load_lds((const unsigned*)((const char*)(gbase) + (voff)[_i]), (PG8_LAS unsigned*)(lds + (bufoff) + ldsw + _i * 8192), 16, 0, 0); } while (0)
#define PG8_LDA(dst, b, h) do { _Pragma("unroll") for (int m = 0; m < 4; ++m) _Pragma("unroll") for (int k = 0; k < 2; ++k) dst[m][k] = *(const PG8_LAS bf16x8*)(lds + PG8_SA(b, h) + aoff + m * 2048 + k * 1024); } while (0)
#define PG8_LDB(dst, b, h) do { _Pragma("unroll") for (int n = 0; n < 2; ++n) _Pragma("unroll") for (int k = 0; k < 2; ++k) dst[n][k] = *(const PG8_LAS bf16x8*)(lds + PG8_SB(b, h) + boff + n * 2048 + k * 1024); } while (0)
#define PG8_MMA(ai, bj, At, Bt) do { __builtin_amdgcn_s_setprio(1); _Pragma("unroll") for (int m = 0; m < 4; ++m) _Pragma("unroll") for (int n = 0; n < 2; ++n) _Pragma("unroll") for (int k = 0; k < 2; ++k) \
        acc[ai][bj][m][n] = __builtin_amdgcn_mfma_f32_16x16x32_bf16(Bt[n][k], At[m][k], acc[ai][bj][m][n], 0, 0, 0); __builtin_amdgcn_s_setprio(0); } while (0)
#define PG8_WAIT_V(n) asm volatile("s_waitcnt vmcnt(" #n ")" ::: "memory")
#define PG8_WAIT_L(n) asm volatile("s_waitcnt lgkmcnt(" #n ")" ::: "memory")
#define PG8_BAR __builtin_amdgcn_s_barrier()
#define PG8_SCHED __builtin_amdgcn_sched_barrier(0)
    Unit cur, nxt; int ui = 0;
    if (!S.next(0, cur)) return;
    f32x4 acc[2][2][4][2];
#pragma unroll
    for (int a = 0; a < 2; ++a)
#pragma unroll
        for (int b = 0; b < 2; ++b)
#pragma unroll
            for (int m = 0; m < 4; ++m)
#pragma unroll
                for (int n = 0; n < 2; ++n) acc[a][b][m][n] = (f32x4){0.f, 0.f, 0.f, 0.f};
    bf16x8 At[4][2], B0[2][2], B1[2][2];
    const char* cA = (const char*)g.A + (size_t)cur.pm * tstep; const char* cB = (const char*)g.Bt + (size_t)cur.pn * tstep;
    S.a_ready(cur);
    if constexpr (SP2) {
        PG8_STAGE(PG8_SB(0, 0), cB, voffB); PG8_STAGE(PG8_SB(0, 1), cB + hstep, voffB); PG8_STAGE(PG8_SA(0, 0), cA, voffA); PG8_STAGE(PG8_SA(0, 1), cA + hstep, voffA);
        if (wr == 1) PG8_BAR;
        PG8_WAIT_V(2); PG8_BAR;
        PG8_STAGE(PG8_SB(1, 0), cB + kstep, voffB); PG8_STAGE(PG8_SA(1, 0), cA + kstep, voffA); PG8_STAGE(PG8_SB(1, 1), cB + hstep + kstep, voffB);
        PG8_WAIT_V(6); PG8_BAR;
    } else {
        PG8_STAGE(PG8_SB(0, 0), cB, voffB); PG8_STAGE(PG8_SA(0, 0), cA, voffA); PG8_STAGE(PG8_SB(0, 1), cB + hstep, voffB); PG8_STAGE(PG8_SA(0, 1), cA + hstep, voffA);
        if (wr == 1) PG8_BAR;
        PG8_WAIT_V(4); PG8_BAR;
        PG8_STAGE(PG8_SB(1, 0), cB + kstep, voffB); PG8_STAGE(PG8_SA(1, 0), cA + kstep, voffA); PG8_STAGE(PG8_SB(1, 1), cB + hstep + kstep, voffB);
        PG8_WAIT_V(6); PG8_BAR;
    }
    for (;;) {
        const bool has_next = S.next(ui + 1, nxt);
        const char* nA = has_next ? (const char*)g.A + (size_t)nxt.pm * tstep : cA; const char* nB = has_next ? (const char*)g.Bt + (size_t)nxt.pn * tstep : cB;
        for (int t = 0; t < nt; t += 2) {
            const bool last = (t == nt - 2);
            const char* a1 = cA + (size_t)(t + 1) * kstep;
            const char* a2 = last ? nA : cA + (size_t)(t + 2) * kstep; const char* b2 = last ? nB : cB + (size_t)(t + 2) * kstep;
            const char* a3 = a2 + kstep; const char* b3 = b2 + kstep;
            if (last && has_next) S.a_ready(nxt);
            if constexpr (SP2) {
            PG8_LDB(B0, 0, 0); PG8_LDB(B1, 0, 1); PG8_SCHED; PG8_LDA(At, 0, 0); PG8_STAGE(PG8_SA(1, 1), a1 + hstep, voffA);
            PG8_WAIT_V(8); PG8_WAIT_L(0); PG8_BAR; PG8_MMA(0, 0, At, B0); PG8_MMA(0, 1, At, B1); PG8_BAR; PG8_SCHED;
            PG8_LDA(At, 0, 1); PG8_STAGE(PG8_SB(0, 0), b2, voffB); PG8_STAGE(PG8_SB(0, 1), b2 + hstep, voffB); PG8_STAGE(PG8_SA(0, 0), a2, voffA);
            PG8_WAIT_V(8); PG8_WAIT_L(0); PG8_BAR; PG8_MMA(1, 0, At, B0); PG8_MMA(1, 1, At, B1); PG8_BAR; PG8_SCHED;
            PG8_LDB(B0, 1, 0); PG8_LDB(B1, 1, 1); PG8_SCHED; PG8_LDA(At, 1, 0); PG8_STAGE(PG8_SA(0, 1), a2 + hstep, voffA);
            PG8_WAIT_V(8); PG8_WAIT_L(0); PG8_BAR; PG8_MMA(0, 0, At, B0); PG8_MMA(0, 1, At, B1); PG8_BAR; PG8_SCHED;
            PG8_LDA(At, 1, 1); PG8_STAGE(PG8_SB(1, 0), b3, voffB); PG8_STAGE(PG8_SB(1, 1), b3 + hstep, voffB); PG8_STAGE(PG8_SA(1, 0), a3, voffA);
            PG8_WAIT_V(8); PG8_WAIT_L(0); PG8_BAR; PG8_MMA(1, 0, At, B0); PG8_MMA(1, 1, At, B1); PG8_BAR; PG8_SCHED;
            } else {
            PG8_LDB(B0, 0, 0); PG8_SCHED; PG8_LDA(At, 0, 0); PG8_STAGE(PG8_SA(1, 1), a1 + hstep, voffA);
            PG8_WAIT_L(8); PG8_BAR; PG8_WAIT_L(0); PG8_MMA(0, 0, At, B0); PG8_BAR; PG8_SCHED;
            PG8_LDB(B1, 0, 1); PG8_STAGE(PG8_SB(0, 0), b2, voffB);
            PG8_BAR; PG8_WAIT_L(0); PG8_MMA(0, 1, At, B1); PG8_BAR;
            PG8_LDA(At, 0, 1); PG8_STAGE(PG8_SA(0, 0), a2, voffA);
            PG8_BAR; PG8_WAIT_L(0); PG8_MMA(1, 0, At, B0); PG8_BAR; PG8_SCHED;
            PG8_STAGE(PG8_SB(0, 1), b2 + hstep, voffB);
            PG8_WAIT_V(6); PG8_BAR; PG8_MMA(1, 1, At, B1); PG8_BAR;
            PG8_LDB(B0, 1, 0); PG8_SCHED; PG8_LDA(At, 1, 0); PG8_STAGE(PG8_SA(0, 1), a2 + hstep, voffA);
            PG8_WAIT_L(8); PG8_BAR; PG8_WAIT_L(0); PG8_MMA(0, 0, At, B0); PG8_BAR; PG8_SCHED;
            PG8_LDB(B1, 1, 1); PG8_STAGE(PG8_SB(1, 0), b3, voffB);
            PG8_BAR; PG8_WAIT_L(0); PG8_MMA(0, 1, At, B1); PG8_BAR;
            PG8_LDA(At, 1, 1); PG8_STAGE(PG8_SA(1, 0), a3, voffA);
            PG8_BAR; PG8_WAIT_L(0); PG8_MMA(1, 0, At, B0); PG8_BAR; PG8_SCHED;
            PG8_STAGE(PG8_SB(1, 1), b3 + hstep, voffB);
            PG8_WAIT_V(6); PG8_BAR; PG8_MMA(1, 1, At, B1); PG8_BAR;
            }
        }
        if constexpr (ALIGN_EPI) { if (wr == 0) PG8_BAR; }
        if constexpr (!Epi::AFTER_DRAIN) { E(acc, cur, wr, wc, fr, fq); S.done(cur); }
        if (!has_next) break;
#pragma unroll
        for (int a = 0; a < 2; ++a)
#pragma unroll
            for (int b = 0; b < 2; ++b)
#pragma unroll
                for (int m = 0; m < 4; ++m)
#pragma unroll
                    for (int n = 0; n < 2; ++n) acc[a][b][m][n] = (f32x4){0.f, 0.f, 0.f, 0.f};
        cur = nxt; cA = nA; cB = nB; ++ui;
        if constexpr (ALIGN_EPI) { if (wr == 1) PG8_BAR; }
    }
    PG8_WAIT_V(0);
    if constexpr (!ALIGN_EPI) { if (wr == 0) PG8_BAR; }
    PG8_BAR;
    if constexpr (Epi::AFTER_DRAIN) { E.fused(acc, cur, wr, wc, fr, fq, lds, wid, lane); S.done(cur); }
#undef PG8_SA
#undef PG8_SB
#undef PG8_STAGE
#undef PG8_LDA
#undef PG8_LDB
#undef PG8_MMA
#undef PG8_WAIT_V
#undef PG8_WAIT_L
#undef PG8_BAR
#undef PG8_SCHED
}
}

#ifndef PG8_SP2
#define PG8_SP2 true
#endif
#define PG8_ALIGN true
constexpr int NWAVES = 8;
constexpr int BATCH = 2, SEQ = 8192, DM = 1024, M = BATCH * SEQ, NIN = 3788, NINP = 3840, FFN = 2816, DEPTH = 2;
constexpr int A_Q = 0, A_K = 256, A_V = 512, A_O = 768;
constexpr int R_R = 1024, R_K = 1408, R_V = 1792, R_WDF = 2176, R_AD = 2304, R_GD = 2368;
constexpr int S_Z = 2496, S_X = 2880, S_B = 3264, S_C = 3520, S_DT = 3776;
constexpr size_t MiB = 1u << 20;
constexpr size_t WS_CTL = 0, CTL_ZERO_BYTES = 64 * 1024;
constexpr size_t WS_GATES = 1 * MiB, WS_CT = 2 * MiB;
constexpr size_t WS_WIN = 4 * MiB, WS_WOUT = 12 * MiB, WS_WGU = 14 * MiB, WS_WDN = 25 * MiB;
constexpr size_t WS_XN = 32 * MiB, WS_COLS = 64 * MiB, WS_Y = 184 * MiB, WS_END = 248 * MiB;
constexpr size_t Y_AF = WS_Y, Y_AB = WS_Y + 8 * MiB, Y_RF = WS_Y + 16 * MiB, Y_RB = WS_Y + 28 * MiB, Y_SF = WS_Y + 40 * MiB, Y_SB = WS_Y + 52 * MiB;
constexpr int CW_BAR = 1024;
constexpr int RING_BYTES = 131072;
constexpr int LDS_BYTES = 147456, MISC_OFF = LDS_BYTES - 256;

#define GAS __attribute__((address_space(1)))
#define LAS __attribute__((address_space(3)))
typedef unsigned short bf16;
typedef unsigned v4u __attribute__((ext_vector_type(4)));
typedef unsigned v2u __attribute__((ext_vector_type(2)));
typedef float f32x4 __attribute__((ext_vector_type(4)));
typedef short bf16x8 __attribute__((ext_vector_type(8)));
typedef GAS unsigned gu32;
#define RLX_AGENT __ATOMIC_RELAXED, __HIP_MEMORY_SCOPE_AGENT
#define LDS_WAIT() asm volatile("s_waitcnt lgkmcnt(0)" ::: "memory")
#define VM_WAIT() asm volatile("s_waitcnt vmcnt(0)" ::: "memory")
__device__ __forceinline__ unsigned f2bf(float f) { unsigned u = __builtin_bit_cast(unsigned, f); return (u + 0x7fffu + ((u >> 16) & 1u)) >> 16; }
__device__ __forceinline__ unsigned pk2(float lo, float hi) { return f2bf(lo) | (f2bf(hi) << 16); }
__device__ __forceinline__ float bf2f(unsigned u) { return __builtin_bit_cast(float, u << 16); }
__device__ __forceinline__ float sigmoidf_(float x) { return __builtin_amdgcn_rcpf(1.f + __expf(-x)); }
__device__ __forceinline__ float siluf_(float x) { return x * sigmoidf_(x); }
__device__ __forceinline__ float wave_sum(float v) {
#pragma unroll
    for (int o = 1; o < 64; o <<= 1) v += __shfl_xor(v, o);
    return v;
}
__device__ __forceinline__ float wave_max(float v) {
#pragma unroll
    for (int o = 1; o < 64; o <<= 1) v = fmaxf(v, __shfl_xor(v, o));
    return v;
}
template <int CTRL> __device__ __forceinline__ float dppf(float v) { return __builtin_bit_cast(float, __builtin_amdgcn_update_dpp(0, __builtin_bit_cast(int, v), CTRL, 0xf, 0xf, true)); }
__device__ __forceinline__ float row16_sum(float v) { v += dppf<0xB1>(v); v += dppf<0x4E>(v); v += dppf<0x141>(v); v += dppf<0x140>(v); return v; }
template <int K> __device__ __forceinline__ f32x4 mma16(const LAS bf16* A, int lda, const LAS bf16* Bt, int ldb, f32x4 acc, int lane) {
    const int r = lane & 15, q = lane >> 4;
    const LAS bf16* ap = A + r * lda + q * 8; const LAS bf16* bp = Bt + r * ldb + q * 8;
#pragma unroll
    for (int k0 = 0; k0 < K; k0 += 32) {
        const bf16x8 a = *(const LAS bf16x8*)(ap + k0); const bf16x8 b = *(const LAS bf16x8*)(bp + k0);
        acc = __builtin_amdgcn_mfma_f32_16x16x32_bf16(a, b, acc, 0, 0, 0);
    }
    return acc;
}
#define XB_TMO      128
#define XB_XCNT(j)  (256  + 64 * (j))
#define XB_XSUB(j)  (1280 + 64 * (j))
#define XB_XGEN(j)  (2304 + 64 * (j))
#define XB_TOP      3328
#define XB_TOPGEN   3392
#define XCD_BAR_WORDS 3456
#define XB_SPIN_CAP (1u << 18)

__device__ __forceinline__ unsigned xb_ld(unsigned* p)              { return __hip_atomic_load(p, __ATOMIC_RELAXED, __HIP_MEMORY_SCOPE_AGENT); }
__device__ __forceinline__ unsigned xb_add(unsigned* p, unsigned v) { return __hip_atomic_fetch_add(p, v, __ATOMIC_RELAXED, __HIP_MEMORY_SCOPE_AGENT); }
__device__ __forceinline__ unsigned xb_xcc_id() { return (unsigned)__builtin_amdgcn_s_getreg((3 << 11) | 20) & 0xFu; }
#define XB_SPIN(cond, bar) do { unsigned _sp = 0; while (cond) { __builtin_amdgcn_s_sleep(1); \
    if ((++_sp & 255u) == 0u) { if (xb_ld(&(bar)[XB_TMO])) break; if (_sp > XB_SPIN_CAP) { atomicAdd(&(bar)[XB_TMO], 1u); break; } } } } while (0)

struct XcdBarrier {
    unsigned* bar; unsigned x;
    volatile LAS unsigned* st;
};

__device__ __forceinline__ XcdBarrier xcd_barrier_post(unsigned* bar, volatile LAS unsigned* st) {
    XcdBarrier b; b.bar = bar; b.x = xb_xcc_id(); b.st = st;
    if (threadIdx.x == 0) (void)xb_add(&bar[XB_XCNT(b.x)], 1u);
    return b;
}
__device__ __forceinline__ void xcd_barrier_complete(unsigned* bar, unsigned x, unsigned& nloc, unsigned& nx) {
    const unsigned G = gridDim.x * gridDim.y * gridDim.z;
    unsigned sum, cnt, mine, sp = 0u;
    for (;;) {
        sum = 0u; cnt = 0u; mine = 0u;
#pragma unroll
        for (unsigned j = 0; j < 16; ++j) { const unsigned c = xb_ld(&bar[XB_XCNT(j)]); sum += c; cnt += (c > 0u) ? 1u : 0u; mine = (j == x) ? c : mine; }
        if (sum == G) break;
        __builtin_amdgcn_s_sleep(1);
        if ((++sp & 255u) == 0u) { if (xb_ld(&bar[XB_TMO])) break; if (sp > XB_SPIN_CAP) { atomicAdd(&bar[XB_TMO], 1u); break; } }
    }
    nloc = mine > 0u ? mine : 1u; nx = cnt > 0u ? cnt : 1u;
}

__device__ __forceinline__ void xcd_barrier(const XcdBarrier& b) {
    asm volatile("s_waitcnt vmcnt(0)" ::: "memory");
    __syncthreads();
    if (threadIdx.x == 0) {
        unsigned* bar = b.bar;
        __builtin_amdgcn_s_waitcnt(0);
        unsigned nloc = b.st[0], nx = b.st[1];
        if (nloc == 0u) { xcd_barrier_complete(bar, b.x, nloc, nx); b.st[0] = nloc; b.st[1] = nx; }
        const unsigned old = xb_add(&bar[XB_XSUB(b.x)], 1u);
        const unsigned gen = old / nloc;
        if (old + 1u == (gen + 1u) * nloc) {
            __builtin_amdgcn_fence(__ATOMIC_RELEASE, "agent");
            asm volatile("s_waitcnt vmcnt(0)" ::: "memory");
            const unsigned og = xb_add(&bar[XB_TOP], 1u);
            const unsigned tg = og / nx;
            if (og + 1u == (tg + 1u) * nx) xb_add(&bar[XB_TOPGEN], 1u);
            else XB_SPIN(xb_ld(&bar[XB_TOPGEN]) == tg, bar);
            __builtin_amdgcn_fence(__ATOMIC_ACQUIRE, "agent");
            xb_add(&bar[XB_XGEN(b.x)], 1u);
            asm volatile("s_waitcnt vmcnt(0)" ::: "memory");
        } else {
            XB_SPIN(xb_ld(&bar[XB_XGEN(b.x)]) == gen, bar);
            __builtin_amdgcn_fence(__ATOMIC_ACQUIRE, "agent");
            asm volatile("s_waitcnt vmcnt(0)" ::: "memory");
        }
    }
    __syncthreads();
}
struct Frame {
    LAS unsigned char* lds;
    int tid, lane, wave, vcu, G;
};
struct Args { const float* in[32]; float* out; unsigned char* ws; int ph_lo, ph_hi; };
constexpr int PTAB_OFF = LDS_BYTES - 768;
__device__ __forceinline__ unsigned long long ptab_ld(const Frame& F, int i) {
    const unsigned long long v = *(volatile LAS unsigned long long*)(F.lds + PTAB_OFF + 8 * i);
    const unsigned lo = __builtin_amdgcn_readfirstlane((unsigned)v), hi = __builtin_amdgcn_readfirstlane((unsigned)(v >> 32));
    return ((unsigned long long)hi << 32) | lo;
}
__device__ __forceinline__ const float* INP(const Frame& F, int i) { return (const float*)ptab_ld(F, i); }
__device__ __forceinline__ unsigned char* WSP(const Frame& F) { return (unsigned char*)ptab_ld(F, 33); }
__device__ __forceinline__ float* OUTP(const Frame& F) { return (float*)ptab_ld(F, 32); }

__device__ __forceinline__ void transpose_item(const float* W, int K, int N, int nblk, bf16* WT, int mode, int row_off, LAS float* scr, int item, int lane) {
    const int kb = item / nblk, nb = item % nblk, k0 = 64 * kb, n0 = 32 * nb;
    const int ncol = n0 + (lane & 31); const bool ok = ncol < N;
#pragma unroll 8
    for (int i = 0; i < 32; ++i) { const int kk = 2 * i + (lane >> 5); scr[kk * 33 + (lane & 31)] = ok ? W[(size_t)(k0 + kk) * N + ncol] : 0.f; }
    LDS_WAIT(); asm volatile("" ::: "memory");
    const int c = lane & 7;
    const int drow0 = mode ? (256 * (n0 >> 7) + (n0 & 127) + row_off) : (row_off + n0);
#pragma unroll
    for (int j = 0; j < 4; ++j) { const int n = (lane >> 3) + 8 * j; const LAS float* s = scr + (8 * c) * 33 + n;
        v4u o; o.x = pk2(s[0 * 33], s[1 * 33]); o.y = pk2(s[2 * 33], s[3 * 33]); o.z = pk2(s[4 * 33], s[5 * 33]); o.w = pk2(s[6 * 33], s[7 * 33]);
        *(v4u*)(WT + (size_t)(drow0 + n) * K + k0 + 8 * c) = o; }
    LDS_WAIT(); asm volatile("" ::: "memory");
}
__device__ __forceinline__ void phase_convert(const Frame& F, int l) {
    LAS float* scr = (LAS float*)(F.lds + F.wave * 16384);
    const int gw = F.vcu * NWAVES + F.wave, NGW = F.G * NWAVES;
    bf16* Win = (bf16*)(WSP(F) + WS_WIN); bf16* Wout = (bf16*)(WSP(F) + WS_WOUT); bf16* Wgu = (bf16*)(WSP(F) + WS_WGU); bf16* Wdn = (bf16*)(WSP(F) + WS_WDN);
    constexpr int I_IN = 16 * 120, I_OUT = 16 * 32, I_G = 16 * 88, I_D = 44 * 32;
    constexpr int NITEMS = I_IN + I_OUT + 2 * I_G + I_D;
    for (int it = gw; it < NITEMS; it += NGW) {
        int r = it;
        if (r < I_IN) { transpose_item(INP(F, 2) + (size_t)l * DM * NIN, DM, NIN, 120, Win, 0, 0, scr, r, F.lane); continue; } r -= I_IN;
        if (r < I_OUT) { transpose_item(INP(F, 26) + (size_t)l * DM * DM, DM, DM, 32, Wout, 0, 0, scr, r, F.lane); continue; } r -= I_OUT;
        if (r < I_G) { transpose_item(INP(F, 28) + (size_t)l * DM * FFN, DM, FFN, 88, Wgu, 1, 0, scr, r, F.lane); continue; } r -= I_G;
        if (r < I_G) { transpose_item(INP(F, 29) + (size_t)l * DM * FFN, DM, FFN, 88, Wgu, 1, 128, scr, r, F.lane); continue; } r -= I_G;
        transpose_item(INP(F, 30) + (size_t)l * FFN * DM, FFN, DM, 32, Wdn, 0, 0, scr, r, F.lane);
    }
}
__device__ __forceinline__ void phase_norm(const Frame& F, const float* hin, const float* g, bf16* XN) {
    const int gw = F.vcu * NWAVES + F.wave, NGW = F.G * NWAVES;
    f32x4 gv[4];
#pragma unroll
    for (int j = 0; j < 4; ++j) gv[j] = ((const f32x4*)g)[64 * j + F.lane];
    for (int m = gw; m < M; m += NGW) {
        const f32x4* xr = (const f32x4*)(hin + (size_t)m * DM) + F.lane;
        f32x4 v[4]; float s = 0.f;
#pragma unroll
        for (int j = 0; j < 4; ++j) { v[j] = xr[64 * j]; s += (v[j].x * v[j].x + v[j].y * v[j].y) + (v[j].z * v[j].z + v[j].w * v[j].w); }
        const float r = 1.f / sqrtf(wave_sum(s) * (1.f / DM) + 1e-6f);
        v2u* o8 = (v2u*)(XN + (size_t)m * DM) + F.lane;
#pragma unroll
        for (int j = 0; j < 4; ++j) { v2u w; w.x = pk2(v[j].x * r * gv[j].x, v[j].y * r * gv[j].y); w.y = pk2(v[j].z * r * gv[j].z, v[j].w * r * gv[j].w); o8[64 * j] = w; }
    }
}
__device__ __forceinline__ void phase_final_norm(const Frame& F, float* h, const float* g) {
    const int gw = F.vcu * NWAVES + F.wave, NGW = F.G * NWAVES;
    f32x4 gv[4];
#pragma unroll
    for (int j = 0; j < 4; ++j) gv[j] = ((const f32x4*)g)[64 * j + F.lane];
    for (int m = gw; m < M; m += NGW) {
        f32x4* xr = (f32x4*)(h + (size_t)m * DM) + F.lane;
        f32x4 v[4]; float s = 0.f;
#pragma unroll
        for (int j = 0; j < 4; ++j) { v[j] = xr[64 * j]; s += (v[j].x * v[j].x + v[j].y * v[j].y) + (v[j].z * v[j].z + v[j].w * v[j].w); }
        const float r = 1.f / sqrtf(wave_sum(s) * (1.f / DM) + 1e-6f);
#pragma unroll
        for (int j = 0; j < 4; ++j) xr[64 * j] = v[j] * r * gv[j];
    }
}
__device__ __forceinline__ void phase_gates(const Frame& F, int l) {
    const bf16* cols = (const bf16*)(WSP(F) + WS_COLS); float* GT = (float*)(WSP(F) + WS_GATES);
    LAS bf16* raw = (LAS bf16*)(F.lds);
    LAS float* feat = (LAS float*)(F.lds + 32768);
    LAS float* gw = (LAS float*)(F.lds + 81920);
    const float* gwg = INP(F, 5) + (size_t)l * 768 * 16; const float* gb = INP(F, 6) + l * 16;
    const float* cw = INP(F, 3) + (size_t)l * 5 * 512; const float* cb = INP(F, 4) + l * 512;
    for (int i = F.tid; i < 768 * 16; i += 512) gw[i] = gwg[i];
    for (int tile = F.vcu; tile < M / 16; tile += F.G) {
        const int m0 = tile * 16, t0 = m0 % SEQ;
        __syncthreads();
        for (int ch = F.tid; ch < 20 * 96; ch += 512) { const int rr = ch / 96, cc = ch % 96; const int t = t0 - 2 + rr;
            v4u v = {0u, 0u, 0u, 0u}; if (t >= 0 && t < SEQ) v = *(const v4u*)(cols + (size_t)(m0 - 2 + rr) * NINP + cc * 8);
            *(LAS v4u*)(raw + rr * 768 + cc * 8) = v; }
        __syncthreads();
        for (int idx = F.tid; idx < 16 * 768; idx += 512) { const int t = idx / 768, c = idx % 768; float val;
            if (c < 512) { float s = cb[c];
#pragma unroll
                for (int j = 0; j < 5; ++j) s += cw[j * 512 + c] * bf2f(raw[(t + j) * 768 + c]);
                val = siluf_(s); } else val = bf2f(raw[(t + 2) * 768 + c]);
            feat[idx] = val; }
        __syncthreads();
        { const int t = F.tid >> 5, o = (F.tid >> 1) & 15, hf = F.tid & 1; float s = 0.f;
          const LAS float* fp = feat + t * 768 + hf * 384; const LAS float* wp = gw + (hf * 384) * 16 + o;
#pragma unroll 8
          for (int i = 0; i < 384; ++i) s += fp[i] * wp[i * 16];
          s += __shfl_xor(s, 1);
          if (hf == 0) { s += gb[o]; if (o >= 8) s = fminf(s, 0.f) - log1pf(__expf(-fabsf(s))); GT[(size_t)(m0 + t) * 16 + o] = s; } }
    }
    __syncthreads();
}
__device__ __forceinline__ void rwkv_scan(const Frame& F, int l, int task) {
    const int b = task / 24, rem = task % 24, h = rem >> 2, dir = (rem >> 1) & 1, half = rem & 1;
    const bf16* cols = (const bf16*)(WSP(F) + WS_COLS);
    bf16* Y = (bf16*)(WSP(F) + (dir ? Y_RB : Y_RF));
    float* CT = (float*)(WSP(F) + WS_CT);
    LAS bf16* WA = (LAS bf16*)(F.lds); LAS bf16* WW = (LAS bf16*)(F.lds + 9216);
    LAS bf16* XA = (LAS bf16*)(F.lds + 18432); LAS bf16* XW = (LAS bf16*)(F.lds + 23040);
    LAS bf16* RAWB = (LAS bf16*)(F.lds + 27648);
    LAS float* OPS = (LAS float*)(F.lds + 49408); LAS float* VV = (LAS float*)(F.lds + 90368);
    LAS float* MU = (LAS float*)(F.lds + 94464); LAS float* YB = (LAS float*)(F.lds + 97024);
    const int tid = F.tid, lane = F.lane, wave = F.wave;
    __syncthreads();
    { const float* aup = INP(F, 13) + (size_t)l * 64 * 384; const float* wup = INP(F, 11) + (size_t)(l * 2 + dir) * 64 * 384;
      for (int idx = tid; idx < 4096; idx += 512) { const int i = idx >> 6, c = idx & 63;
          WA[c * 72 + i] = (bf16)f2bf(aup[i * 384 + h * 64 + c]); WW[c * 72 + i] = (bf16)f2bf(wup[i * 384 + h * 64 + c]); }
      if (tid < 320) { const int which = tid >> 6, c = tid & 63;
          const int rc = which == 0 ? h * 64 + c : which == 1 ? 384 + h * 64 + c : which == 2 ? 768 + h * 64 + c : which == 3 ? 1152 + dir * 64 + c : 1280 + c;
          MU[tid] = INP(F, 8)[l * 1472 + rc]; MU[320 + tid] = INP(F, 9)[l * 1472 + rc]; } }
    const int hc4 = h * 64 + 4 * (lane & 15);
    const f32x4 kk_c4 = *(const f32x4*)(INP(F, 15) + l * 384 + hc4), ka_c4 = *(const f32x4*)(INP(F, 16) + l * 384 + hc4), rk_c4 = *(const f32x4*)(INP(F, 17) + l * 384 + hc4);
    const int mat = wave >> 2, ct = wave & 3;
    const float bias3 = mat ? INP(F, 10)[(l * 2 + dir) * 384 + h * 64 + 16 * ct + (lane & 15)] : INP(F, 12)[l * 384 + h * 64 + 16 * ct + (lane & 15)];
    const int row = wave * 4 + (lane >> 4), j = lane & 15;
    f32x4 S = {0.f, 0.f, 0.f, 0.f};
    v4u pre[3];
    const size_t mb = (size_t)b * SEQ;
#define RW_ISSUE(blk) do { const int T0_ = dir ? SEQ - 32 * ((blk) + 1) : 32 * (blk); _Pragma("unroll") for (int i_ = 0; i_ < 3; ++i_) { const int idx_ = tid + 512 * i_; pre[i_] = (v4u){0u, 0u, 0u, 0u}; \
        if (idx_ < 1360) { const int rr_ = idx_ / 40, q_ = idx_ % 40, wh_ = q_ >> 3, c8_ = q_ & 7; const int t_ = T0_ - 1 + rr_; \
            const int gc_ = (wh_ == 0 ? R_R + h * 64 : wh_ == 1 ? R_K + h * 64 : wh_ == 2 ? R_V + h * 64 : wh_ == 3 ? R_WDF + dir * 64 : R_AD) + c8_ * 8; \
            if (t_ >= 0 && t_ < SEQ) pre[i_] = *(const v4u*)(cols + (mb + t_) * NINP + gc_); } } } while (0)
    RW_ISSUE(0);
    for (int blk = 0; blk < SEQ / 32; ++blk) {
        const int T0 = dir ? SEQ - 32 * (blk + 1) : 32 * blk;
#pragma unroll
        for (int i = 0; i < 3; ++i) { const int idx = tid + 512 * i; if (idx < 1360) { const int rr = idx / 40, q = idx % 40; *(LAS v4u*)(RAWB + rr * 320 + q * 8) = pre[i]; } }
        __syncthreads();
        if (blk + 1 < SEQ / 32) RW_ISSUE(blk + 1);
#pragma unroll
        for (int it = 0; it < 20; ++it) { const int which = it >> 2, t = (tid >> 6) + 8 * (it & 3), c = tid & 63, cc = which * 64 + c;
            const float p0 = bf2f(RAWB[t * 320 + cc]), p1 = bf2f(RAWB[(t + 1) * 320 + cc]), p2 = bf2f(RAWB[(t + 2) * 320 + cc]);
            const float v = p1 + MU[cc] * (p0 - p1) + MU[320 + cc] * (p2 - p1);
            if (which == 0) OPS[t * 320 + 256 + c] = v;
            else if (which == 1) OPS[t * 320 + 192 + c] = v;
            else if (which == 2) { if ((c >> 5) == half) VV[t * 32 + (c & 31)] = v; }
            else if (which == 3) { const float e = __expf(2.f * v); XW[t * 72 + c] = (bf16)f2bf(1.f - 2.f * __builtin_amdgcn_rcpf(e + 1.f)); }
            else XA[t * 72 + c] = (bf16)f2bf(v); }
        __syncthreads();
#pragma unroll
        for (int tt = 0; tt < 2; ++tt) { f32x4 acc = {0.f, 0.f, 0.f, 0.f};
            acc = mma16<64>((mat ? XW : XA) + tt * 16 * 72, 72, (mat ? WW : WA) + ct * 16 * 72, 72, acc, lane);
#pragma unroll
            for (int jj = 0; jj < 4; ++jj) { const int t = tt * 16 + (lane >> 4) * 4 + jj, c = ct * 16 + (lane & 15); const float x = bias3 + acc[jj];
                if (mat) { const float nx = -x; const float sp = nx > 20.f ? nx : __logf(1.f + __expf(nx)); OPS[t * 320 + c] = __expf(-__expf(-sp - 0.5f)); }
                else OPS[t * 320 + 128 + c] = sigmoidf_(x); } }
        __syncthreads();
        { const int t = wave * 4 + (lane >> 4); LAS float* op = OPS + t * 320 + 4 * j;
            const f32x4 av = *(const LAS f32x4*)(op + 128), kp = *(const LAS f32x4*)(op + 192), rp = *(const LAS f32x4*)(op + 256);
            const f32x4 kr = kp * kk_c4; const float ss = row16_sum((kr.x * kr.x + kr.y * kr.y) + (kr.z * kr.z + kr.w * kr.w));
            const f32x4 kkv = kr * (1.f / fmaxf(sqrtf(ss), 1e-12f));
            const f32x4 km = kp * ((av - 1.f) * ka_c4 + 1.f);
            const f32x4 q = rp * km * rk_c4; const float cs = row16_sum((q.x + q.y) + (q.z + q.w));
            *(LAS f32x4*)(op + 64) = kkv; *(LAS f32x4*)(op + 128) = kkv * av; *(LAS f32x4*)(op + 192) = km;
            if (dir == 0 && half == 0 && j == 0) CT[(mb + T0 + t) * 8 + h] = cs; }
        __syncthreads();
        { float yk0 = 0.f, yk1 = 0.f;
          const LAS float* op0 = OPS + (dir ? 31 : 0) * 320 + 4 * j; const int ostep = dir ? -320 : 320;
          const LAS float* vp0 = VV + (dir ? 31 : 0) * 32 + row; const int vstep = dir ? -32 : 32;
          f32x4 w4 = *(const LAS f32x4*)(op0), kk4 = *(const LAS f32x4*)(op0 + 64), ka4 = *(const LAS f32x4*)(op0 + 128), km4 = *(const LAS f32x4*)(op0 + 192), r4 = *(const LAS f32x4*)(op0 + 256);
          float vv = *vp0;
#pragma unroll
          for (int i = 0; i < 32; ++i) {
              f32x4 nw4, nkk4, nka4, nkm4, nr4; float nvv;
              if (i < 31) { const LAS float* op = op0 + (i + 1) * ostep; nw4 = *(const LAS f32x4*)(op); nkk4 = *(const LAS f32x4*)(op + 64); nka4 = *(const LAS f32x4*)(op + 128); nkm4 = *(const LAS f32x4*)(op + 192); nr4 = *(const LAS f32x4*)(op + 256); nvv = vp0[(i + 1) * vstep]; }
              float sa = (S.x * kk4.x + S.y * kk4.y) + (S.z * kk4.z + S.w * kk4.w);
              const f32x4 pre_s = S * w4 + km4 * vv;
              sa = row16_sum(sa);
              S = pre_s - ka4 * sa;
              float y = (S.x * r4.x + S.y * r4.y) + (S.z * r4.z + S.w * r4.w);
              y = row16_sum(y);
              if ((i & 15) == j) { if (i < 16) yk0 = y; else yk1 = y; }
              if (i < 31) { w4 = nw4; kk4 = nkk4; ka4 = nka4; km4 = nkm4; r4 = nr4; vv = nvv; } }
          YB[(dir ? 31 - j : j) * 32 + row] = yk0; YB[(dir ? 15 - j : 16 + j) * 32 + row] = yk1; }
        __syncthreads();
        { const int idx = tid * 2, tl = idx >> 5, rw = idx & 31;
          *(unsigned*)(Y + (mb + T0 + tl) * 384 + h * 64 + 32 * half + rw) = pk2(YB[idx], YB[idx + 1]); }
    }
#undef RW_ISSUE
    __syncthreads();
}
__device__ __forceinline__ void mlstm_seq(const Frame& F, int l, int task) {
    const int b = task >> 3, h = (task >> 1) & 3, dir = task & 1;
    const bf16* cols = (const bf16*)(WSP(F) + WS_COLS); const float* GT = (const float*)(WSP(F) + WS_GATES);
    bf16* Y = (bf16*)(WSP(F) + (dir ? Y_AB : Y_AF));
    LAS bf16* RAWQ = (LAS bf16*)(F.lds);
    LAS bf16* Qs = (LAS bf16*)(F.lds + 17408); LAS bf16* Ks = (LAS bf16*)(F.lds + 26624);
    LAS bf16* Vt = (LAS bf16*)(F.lds + 35840); LAS bf16* KWt = (LAS bf16*)(F.lds + 45056);
    LAS bf16* Ps = (LAS bf16*)(F.lds + 54272); LAS bf16* Ct = (LAS bf16*)(F.lds + 63488);
    LAS float* fa = (LAS float*)(F.lds + 72704);
    LAS float* li = fa, *lf = fa + 64, *bcs = fa + 128, *gg = fa + 192, *mq = fa + 256, *iw = fa + 320, *den = fa + 384, *nst = fa + 448, *scal = fa + 512;
    const int tid = F.tid, lane = F.lane, wave = F.wave;
    const size_t mb = (size_t)b * SEQ;
    __syncthreads();
    for (int i = tid; i < 64 * 72; i += 512) Ct[i] = 0;
    if (tid < 64) nst[tid] = 0.f;
    const int cc = tid & 127, isK = cc >> 6, d0 = cc & 63, chn = isK * 256 + h * 64 + d0;
    float cw[5]; const float* cwp = INP(F, 3) + (size_t)l * 5 * 512;
#pragma unroll
    for (int jj = 0; jj < 5; ++jj) cw[jj] = cwp[jj * 512 + chn];
    const float cbv = INP(F, 4)[l * 512 + chn];
    f32x4 st[2] = {{0.f, 0.f, 0.f, 0.f}, {0.f, 0.f, 0.f, 0.f}};
    float m_st = 0.f, nloc = 0.f;
    for (int c = 0; c < SEQ / 64; ++c) {
        const int tlo = dir ? SEQ - 64 * (c + 1) : 64 * c;
        for (int ch = tid; ch < 68 * 16; ch += 512) { const int rr = ch >> 4, q = ch & 15; const int t = tlo - 2 + rr;
            v4u v = {0u, 0u, 0u, 0u}; if (t >= 0 && t < SEQ) v = *(const v4u*)(cols + (mb + t) * NINP + (q >> 3) * 256 + h * 64 + (q & 7) * 8);
            *(LAS v4u*)(RAWQ + rr * 128 + q * 8) = v; }
        { const int tl = tid >> 3, e8 = tid & 7; const int lpos = dir ? 63 - tl : tl;
          const v4u v = *(const v4u*)(cols + (mb + tlo + tl) * NINP + A_V + h * 64 + e8 * 8);
          const unsigned w[4] = {v.x, v.y, v.z, v.w};
#pragma unroll
          for (int k = 0; k < 4; ++k) { Vt[(e8 * 8 + 2 * k) * 72 + lpos] = (bf16)(w[k] & 0xffffu); Vt[(e8 * 8 + 2 * k + 1) * 72 + lpos] = (bf16)(w[k] >> 16); } }
        if (tid < 64) { const int t = dir ? tlo + 63 - tid : tlo + tid; li[tid] = GT[(mb + t) * 16 + dir * 4 + h]; lf[tid] = GT[(mb + t) * 16 + 8 + dir * 4 + h]; }
        __syncthreads();
#pragma unroll 4
        for (int i = 0; i < 16; ++i) { const int tl = (tid >> 7) + 4 * i; float s = cbv;
#pragma unroll
            for (int jj = 0; jj < 5; ++jj) s += cw[jj] * bf2f(RAWQ[(tl + jj) * 128 + cc]);
            s = siluf_(s); const int lpos = dir ? 63 - tl : tl;
            if (isK) Ks[lpos * 72 + d0] = (bf16)f2bf(s * 0.125f); else Qs[lpos * 72 + d0] = (bf16)f2bf(s); }
        if (tid < 64) { float run = 0.f, rm = -INFINITY, bl = 0.f;
            for (int s = 0; s < 64; ++s) { run += lf[s]; if (s <= tid) { rm = fmaxf(rm, li[s] - run); if (s == tid) bl = run; } }
            const float g = run - bl + li[tid]; const float mloc = wave_max(g);
            const float mqv = bl + fmaxf(m_st, rm);
            bcs[tid] = bl; gg[tid] = g; mq[tid] = mqv; iw[tid] = __expf(bl + m_st - mqv);
            if (tid == 0) { scal[0] = mloc; scal[1] = run; } }
        __syncthreads();
        const float mloc = scal[0], blast = scal[1];
        for (int idx = tid; idx < 4096; idx += 512) { const int lp = idx >> 6, d = idx & 63; KWt[d * 72 + lp] = (bf16)f2bf(bf2f(Ks[lp * 72 + d]) * __expf(gg[lp] - mloc)); }
#pragma unroll
        for (int k = 0; k < 2; ++k) { const int ti = 2 * wave + k, tl_ = ti >> 2, ts = ti & 3; f32x4 acc = {0.f, 0.f, 0.f, 0.f};
            if (ts <= tl_) acc = mma16<64>(Qs + tl_ * 16 * 72, 72, Ks + ts * 16 * 72, 72, acc, lane);
#pragma unroll
            for (int jj = 0; jj < 4; ++jj) { const int lr = tl_ * 16 + (lane >> 4) * 4 + jj, s = ts * 16 + (lane & 15);
                const float v = (s <= lr) ? acc[jj] * __expf(bcs[lr] - bcs[s] + li[s] - mq[lr]) : 0.f; Ps[lr * 72 + s] = (bf16)f2bf(v); } }
        __syncthreads();
        f32x4 a1[2], a2[2], lc[2];
#pragma unroll
        for (int k = 0; k < 2; ++k) { const int ti = 2 * wave + k, t0_ = ti >> 2, t1_ = ti & 3; const f32x4 z = {0.f, 0.f, 0.f, 0.f};
            a1[k] = mma16<64>(Ps + t0_ * 16 * 72, 72, Vt + t1_ * 16 * 72, 72, z, lane);
            a2[k] = mma16<64>(Qs + t0_ * 16 * 72, 72, Ct + t1_ * 16 * 72, 72, z, lane);
            lc[k] = mma16<64>(Vt + t0_ * 16 * 72, 72, KWt + t1_ * 16 * 72, 72, z, lane); }
        if (tid < 64) { float sp = 0.f, qn = 0.f, nl = 0.f;
            for (int s = 0; s < 64; ++s) { sp += bf2f(Ps[tid * 72 + s]); qn += bf2f(Qs[tid * 72 + s]) * nst[s]; nl += bf2f(KWt[tid * 72 + s]); }
            const float dn = sp + iw[tid] * qn; den[tid] = 1.f / fmaxf(fabsf(dn), __expf(-mq[tid])); nloc = nl; }
        __syncthreads();
        const float m_new = fmaxf(blast + m_st, mloc), s_old = __expf(blast + m_st - m_new), s_new = __expf(mloc - m_new);
#pragma unroll
        for (int k = 0; k < 2; ++k) { const int ti = 2 * wave + k, t0_ = ti >> 2, t1_ = ti & 3;
#pragma unroll
            for (int jj = 0; jj < 4; ++jj) { const int r_ = t0_ * 16 + (lane >> 4) * 4 + jj, c_ = t1_ * 16 + (lane & 15);
                const float val = (a1[k][jj] + iw[r_] * a2[k][jj]) * den[r_];
                const int t = dir ? tlo + 63 - r_ : tlo + r_;
                Y[(mb + t) * 256 + h * 64 + c_] = (bf16)f2bf(val);
                st[k][jj] = s_old * st[k][jj] + s_new * lc[k][jj];
                Ct[r_ * 72 + c_] = (bf16)f2bf(st[k][jj]); } }
        if (tid < 64) nst[tid] = s_old * nst[tid] + s_new * nloc;
        m_st = m_new;
        __syncthreads();
    }
}
__device__ __forceinline__ void ssd_seq(const Frame& F, int l, int task) {
    const int b = task / 12, rem = task % 12, head = rem >> 1, dir = rem & 1, g = head / 3;
    const bf16* cols = (const bf16*)(WSP(F) + WS_COLS);
    bf16* Y = (bf16*)(WSP(F) + (dir ? Y_SB : Y_SF));
    LAS bf16* RAW = (LAS bf16*)(F.lds);
    LAS bf16* Cm = (LAS bf16*)(F.lds + 43520); LAS bf16* Bm = (LAS bf16*)(F.lds + 60928);
    LAS bf16* Btn = (LAS bf16*)(F.lds + 78336); LAS bf16* Ps = (LAS bf16*)(F.lds + 96768);
    LAS bf16* XDt = (LAS bf16*)(F.lds + 105984); LAS bf16* XWt = (LAS bf16*)(F.lds + 115200);
    LAS bf16* Hs = (LAS bf16*)(F.lds + 124416);
    LAS float* dtv = (LAS float*)(F.lds + 141824); LAS float* acs = dtv + 64; LAS float* scal = dtv + 128;
    const int tid = F.tid, lane = F.lane, wave = F.wave;
    const size_t mb = (size_t)b * SEQ;
    __syncthreads();
    for (int i = tid; i < 64 * 136; i += 512) Hs[i] = 0;
    const float dtb = INP(F, 22)[(l * 2 + dir) * 6 + head];
    const float aneg = -__expf(INP(F, 23)[(l * 2 + dir) * 6 + head]);
    const int cc = tid < 320 ? tid : 0;
    const int chn = cc < 64 ? head * 64 + cc : (cc < 192 ? 384 + g * 128 + (cc - 64) : 640 + g * 128 + (cc - 192));
    float cw[5]; const float* cwp = INP(F, 20) + (size_t)l * 5 * 896;
#pragma unroll
    for (int jj = 0; jj < 5; ++jj) cw[jj] = cwp[jj * 896 + chn];
    const float cbv = INP(F, 21)[l * 896 + chn];
    f32x4 st[4];
#pragma unroll
    for (int k = 0; k < 4; ++k) st[k] = (f32x4){0.f, 0.f, 0.f, 0.f};
    for (int c = 0; c < SEQ / 64; ++c) {
        const int tlo = dir ? SEQ - 64 * (c + 1) : 64 * c;
        for (int ch = tid; ch < 68 * 40; ch += 512) { const int rr = ch / 40, q = ch % 40; const int t = tlo - 2 + rr;
            const int gc = q < 8 ? S_X + head * 64 + q * 8 : (q < 24 ? S_B + g * 128 + (q - 8) * 8 : S_C + g * 128 + (q - 24) * 8);
            v4u v = {0u, 0u, 0u, 0u}; if (t >= 0 && t < SEQ) v = *(const v4u*)(cols + (mb + t) * NINP + gc);
            *(LAS v4u*)(RAW + rr * 320 + q * 8) = v; }
        if (tid < 64) { const int t = dir ? tlo + 63 - tid : tlo + tid;
            const float x = bf2f(cols[(mb + t) * NINP + S_DT + dir * 6 + head]) + dtb;
            const float dt = x > 20.f ? x : log1pf(__expf(x));
            float cs = dt * aneg;
#pragma unroll
            for (int o = 1; o < 64; o <<= 1) { const float u = __shfl_up(cs, o); if (lane >= o) cs += u; }
            const float tot = __shfl(cs, 63);
            dtv[tid] = dt; acs[tid] = cs; if (tid == 0) scal[0] = tot; }
        __syncthreads();
        const float tot = scal[0];
        if (tid < 320) {
            float win[5];
#pragma unroll
            for (int jj = 0; jj < 4; ++jj) win[jj] = bf2f(RAW[jj * 320 + cc]);
            for (int tl = 0; tl < 64; ++tl) { win[4] = bf2f(RAW[(tl + 4) * 320 + cc]);
                float s = cbv;
#pragma unroll
                for (int jj = 0; jj < 5; ++jj) s += cw[jj] * win[jj];
#pragma unroll
                for (int jj = 0; jj < 4; ++jj) win[jj] = win[jj + 1];
                s = siluf_(s); const int lp = dir ? 63 - tl : tl;
                if (cc < 64) { const float xd = s * dtv[lp]; XDt[cc * 72 + lp] = (bf16)f2bf(xd); XWt[cc * 72 + lp] = (bf16)f2bf(xd * __expf(tot - acs[lp])); }
                else if (cc < 192) { const bf16 bv = (bf16)f2bf(s); Bm[lp * 136 + (cc - 64)] = bv; Btn[(cc - 64) * 72 + lp] = bv; }
                else Cm[lp * 136 + (cc - 192)] = (bf16)f2bf(s); } }
        __syncthreads();
        f32x4 yo[2], lc[4];
#pragma unroll
        for (int k = 0; k < 2; ++k) { const int ti = 2 * wave + k, tl_ = ti >> 2, ts = ti & 3; f32x4 acc = {0.f, 0.f, 0.f, 0.f};
            if (ts <= tl_) acc = mma16<128>(Cm + tl_ * 16 * 136, 136, Bm + ts * 16 * 136, 136, acc, lane);
#pragma unroll
            for (int jj = 0; jj < 4; ++jj) { const int lr = tl_ * 16 + (lane >> 4) * 4 + jj, s = ts * 16 + (lane & 15);
                const float v = (s <= lr) ? acc[jj] * __expf(acs[lr] - acs[s]) : 0.f; Ps[lr * 72 + s] = (bf16)f2bf(v); }
            const f32x4 z = {0.f, 0.f, 0.f, 0.f};
            yo[k] = mma16<128>(Cm + tl_ * 16 * 136, 136, Hs + ts * 16 * 136, 136, z, lane); }
#pragma unroll
        for (int k = 0; k < 4; ++k) { const int ti = 4 * wave + k, tp = ti >> 3, tn = ti & 7; const f32x4 z = {0.f, 0.f, 0.f, 0.f};
            lc[k] = mma16<64>(XWt + tp * 16 * 72, 72, Btn + tn * 16 * 72, 72, z, lane); }
        __syncthreads();
        const float cdec = __expf(tot);
#pragma unroll
        for (int k = 0; k < 2; ++k) { const int ti = 2 * wave + k, tl_ = ti >> 2, tp = ti & 3; const f32x4 z = {0.f, 0.f, 0.f, 0.f};
            const f32x4 yd = mma16<64>(Ps + tl_ * 16 * 72, 72, XDt + tp * 16 * 72, 72, z, lane);
#pragma unroll
            for (int jj = 0; jj < 4; ++jj) { const int lr = tl_ * 16 + (lane >> 4) * 4 + jj, p = tp * 16 + (lane & 15);
                const float val = yd[jj] + yo[k][jj] * __expf(acs[lr]);
                const int t = dir ? tlo + 63 - lr : tlo + lr;
                Y[(mb + t) * 384 + head * 64 + p] = (bf16)f2bf(val); } }
#pragma unroll
        for (int k = 0; k < 4; ++k) { const int ti = 4 * wave + k, tp = ti >> 3, tn = ti & 7;
#pragma unroll
            for (int jj = 0; jj < 4; ++jj) { const int p = tp * 16 + (lane >> 4) * 4 + jj, n = tn * 16 + (lane & 15);
                st[k][jj] = cdec * st[k][jj] + lc[k][jj]; Hs[p * 136 + n] = (bf16)f2bf(st[k][jj]); } }
        __syncthreads();
    }
}
__device__ __forceinline__ void phase_post(const Frame& F, int l) {
    const bf16* cols = (const bf16*)(WSP(F) + WS_COLS); bf16* MIX = (bf16*)(WSP(F) + WS_XN);
    const bf16* YAf = (const bf16*)(WSP(F) + Y_AF); const bf16* YAb = (const bf16*)(WSP(F) + Y_AB);
    const bf16* YRf = (const bf16*)(WSP(F) + Y_RF); const bf16* YRb = (const bf16*)(WSP(F) + Y_RB);
    const bf16* YSf = (const bf16*)(WSP(F) + Y_SF); const bf16* YSb = (const bf16*)(WSP(F) + Y_SB);
    const float* CT = (const float*)(WSP(F) + WS_CT);
    LAS float* sg = (LAS float*)(F.lds);
    LAS float* gate = (LAS float*)(F.lds + 8192);
    const int tid = F.tid, lane = F.lane, wave = F.wave;
    const float* mup = INP(F, 8) + l * 1472; const float* mun = INP(F, 9) + l * 1472;
    const float* gup = INP(F, 14) + (size_t)l * 128 * 384;
    const float* mng = INP(F, 7) + l * 256; const float* rng = INP(F, 18) + l * 384; const float* rnb = INP(F, 19) + l * 384;
    const float* scb = INP(F, 21) + l * 896; const float* scw = INP(F, 20) + (size_t)l * 5 * 896; const float* sdk = INP(F, 24) + l * 6; const float* sng = INP(F, 25) + l * 384;
    for (int tile = F.vcu; tile < M / 16; tile += F.G) {
        const int m0 = tile * 16;
        __syncthreads();
        for (int idx = tid; idx < 16 * 128; idx += 512) { const int tt = idx >> 7, i = idx & 127; const int m = m0 + tt, t = m % SEQ;
            const float p1 = bf2f(cols[(size_t)m * NINP + R_GD + i]);
            const float p0 = t > 0 ? bf2f(cols[(size_t)(m - 1) * NINP + R_GD + i]) : 0.f;
            const float p2 = t < SEQ - 1 ? bf2f(cols[(size_t)(m + 1) * NINP + R_GD + i]) : 0.f;
            sg[idx] = sigmoidf_(p1 + mup[1344 + i] * (p0 - p1) + mun[1344 + i] * (p2 - p1)); }
        __syncthreads();
        if (tid < 384) { float acc[16];
#pragma unroll
            for (int tt = 0; tt < 16; ++tt) acc[tt] = 0.f;
            for (int i = 0; i < 128; ++i) { const float w = gup[i * 384 + tid];
#pragma unroll
                for (int tt = 0; tt < 16; ++tt) acc[tt] += sg[tt * 128 + i] * w; }
#pragma unroll
            for (int tt = 0; tt < 16; ++tt) gate[tt * 384 + tid] = acc[tt]; }
        __syncthreads();
#pragma unroll 1
        for (int k = 0; k < 2; ++k) { const int tt = wave * 2 + k; const int m = m0 + tt, t = m % SEQ; const size_t cr = (size_t)m * NINP;
#pragma unroll
            for (int i = 0; i < 4; ++i) { const int col = i * 64 + lane;
                const float hs = bf2f(YAf[(size_t)m * 256 + col]) + bf2f(YAb[(size_t)m * 256 + col]);
                const float mean = wave_sum(hs) * (1.f / 64.f); const float d = hs - mean; const float var = wave_sum(d * d) * (1.f / 64.f);
                const float y = d * (1.f / sqrtf(var + 1e-6f)) * mng[col];
                MIX[(size_t)m * DM + col] = (bf16)f2bf(y * sigmoidf_(bf2f(cols[cr + A_O + col]))); }
#pragma unroll
            for (int i = 0; i < 6; ++i) { const int col = i * 64 + lane;
                const float ys = bf2f(YRf[(size_t)m * 384 + col]) + bf2f(YRb[(size_t)m * 384 + col]);
                const float mean = wave_sum(ys) * (1.f / 64.f); const float d = ys - mean; const float var = wave_sum(d * d) * (1.f / 64.f);
                const float y = d * (1.f / sqrtf(var + 64e-5f)) * rng[col] + rnb[col];
                const float p1 = bf2f(cols[cr + R_V + col]);
                const float p0 = t > 0 ? bf2f(cols[cr - NINP + R_V + col]) : 0.f;
                const float p2 = t < SEQ - 1 ? bf2f(cols[cr + NINP + R_V + col]) : 0.f;
                const float vv = p1 + mup[768 + col] * (p0 - p1) + mun[768 + col] * (p2 - p1);
                const float bonus = CT[(size_t)m * 8 + i] * vv;
                MIX[(size_t)m * DM + 256 + col] = (bf16)f2bf((y + bonus) * gate[tt * 384 + col]); }
            float yv[6]; float ssq[2] = {0.f, 0.f};
#pragma unroll
            for (int i = 0; i < 6; ++i) { const int col = i * 64 + lane;
                float s = scb[col];
#pragma unroll
                for (int jj = 0; jj < 5; ++jj) { const int tq = t + jj - 2; if (tq >= 0 && tq < SEQ) s += scw[jj * 896 + col] * bf2f(cols[cr + (jj - 2) * NINP + S_X + col]); }
                const float xc = siluf_(s);
                float y = bf2f(YSf[(size_t)m * 384 + col]) + bf2f(YSb[(size_t)m * 384 + col]) + sdk[i] * xc;
                y *= siluf_(bf2f(cols[cr + S_Z + col]));
                yv[i] = y; ssq[i / 3] += y * y; }
            const float r0 = 1.f / sqrtf(wave_sum(ssq[0]) * (1.f / 192.f) + 1e-6f), r1 = 1.f / sqrtf(wave_sum(ssq[1]) * (1.f / 192.f) + 1e-6f);
#pragma unroll
            for (int i = 0; i < 6; ++i) { const int col = i * 64 + lane;
                MIX[(size_t)m * DM + 640 + col] = (bf16)f2bf(yv[i] * (i < 3 ? r0 : r1) * sng[col]); }
        }
    }
    __syncthreads();
}
namespace cg = cooperative_groups;
constexpr int N_PHASES = 9 * DEPTH + 1;
__global__ void __launch_bounds__(NWAVES * 64, 2) mk_fwd(Args args) {
    extern __shared__ __attribute__((aligned(16))) unsigned char lds_raw[];
    Frame F;
    F.lds = (LAS unsigned char*)lds_raw;
    F.tid = threadIdx.x; F.lane = F.tid & 63; F.wave = __builtin_amdgcn_readfirstlane(F.tid >> 6);
    F.G = gridDim.x; { const int bx = blockIdx.x; F.vcu = (F.G % 8 == 0) ? (bx % 8) * (F.G / 8) + bx / 8 : bx; }
    volatile LAS unsigned* MISC = (volatile LAS unsigned*)(F.lds + MISC_OFF);
    if (F.tid < 64) MISC[F.tid] = 0u;
    if (F.tid < 34) *(LAS unsigned long long*)(F.lds + PTAB_OFF + 8 * F.tid) = ((const unsigned long long*)__builtin_amdgcn_kernarg_segment_ptr())[F.tid];
    __syncthreads();
    unsigned* ctl = (unsigned*)(WSP(F) + WS_CTL);
    XcdBarrier bar = xcd_barrier_post(ctl + CW_BAR, MISC + 8);
    const int lo = args.ph_lo, hi = args.ph_hi;
#define IN_(k) (lo <= (k) && (k) < hi)
#define SEAM(k) do { if (IN_(k) && IN_((k) + 1)) { if ((k) == 0) cg::this_grid().sync(); else xcd_barrier(bar); } } while (0)
#define LAYER(l, B) \
    if (IN_(B + 0)) { phase_convert(F, l); phase_norm(F, l == 0 ? INP(F, 0) : OUTP(F), INP(F, 1) + l * DM, (bf16*)(WSP(F) + WS_XN)); } SEAM(B + 0); \
    if (IN_(B + 1)) { unsigned char* ws = WSP(F); pg8::Gemm g{(const bf16*)(ws + WS_XN), (const bf16*)(ws + WS_WIN), M, NINP, DM}; pg8::StaticOrder S; S.init(M, NINP, F.G, (int)blockIdx.x); \
            pg8::EpiBf16<0> E{(bf16*)(ws + WS_COLS), NINP, nullptr, 0, 0, 1.f}; \
            pg8::gemm_phase<pg8::EpiBf16<0>, pg8::StaticOrder, PG8_ALIGN, PG8_SP2>(F.lds, g, S, E); } SEAM(B + 1); \
    if (IN_(B + 2)) phase_gates(F, l); SEAM(B + 2); \
    if (IN_(B + 3)) { const int bx = blockIdx.x; \
            if (bx < 48) rwkv_scan(F, l, bx); else if (bx < 64) mlstm_seq(F, l, bx - 48); else if (bx < 88) ssd_seq(F, l, bx - 64); } SEAM(B + 3); \
    if (IN_(B + 4)) phase_post(F, l); SEAM(B + 4); \
    if (IN_(B + 5)) { unsigned char* ws = WSP(F); pg8::Gemm g{(const bf16*)(ws + WS_XN), (const bf16*)(ws + WS_WOUT), M, DM, DM}; pg8::StaticOrder S; S.init(M, DM, F.G, (int)blockIdx.x); \
            pg8::EpiResidual E{l == 0 ? INP(F, 0) : OUTP(F), OUTP(F), DM}; \
            pg8::gemm_phase<pg8::EpiResidual, pg8::StaticOrder, PG8_ALIGN, PG8_SP2>(F.lds, g, S, E); } SEAM(B + 5); \
    if (IN_(B + 6)) phase_norm(F, OUTP(F), INP(F, 27) + l * DM, (bf16*)(WSP(F) + WS_XN)); SEAM(B + 6); \
    if (IN_(B + 7)) { unsigned char* ws = WSP(F); pg8::Gemm g{(const bf16*)(ws + WS_XN), (const bf16*)(ws + WS_WGU), M, 2 * FFN, DM}; pg8::StaticOrder S; S.init(M, 2 * FFN, F.G, (int)blockIdx.x); \
            pg8::EpiSwiGLU E{(bf16*)(ws + WS_COLS), FFN}; \
            pg8::gemm_phase<pg8::EpiSwiGLU, pg8::StaticOrder, PG8_ALIGN, PG8_SP2>(F.lds, g, S, E); } SEAM(B + 7); \
    if (IN_(B + 8)) { unsigned char* ws = WSP(F); pg8::Gemm g{(const bf16*)(ws + WS_COLS), (const bf16*)(ws + WS_WDN), M, DM, FFN}; pg8::StaticOrder S; S.init(M, DM, F.G, (int)blockIdx.x); \
            pg8::EpiResidual E{OUTP(F), OUTP(F), DM}; \
            pg8::gemm_phase<pg8::EpiResidual, pg8::StaticOrder, PG8_ALIGN, PG8_SP2>(F.lds, g, S, E); } SEAM(B + 8);
    LAYER(0, 0)
    LAYER(1, 9)
    if (IN_(18)) phase_final_norm(F, OUTP(F), INP(F, 31));
#undef IN_
#undef SEAM
#undef LAYER
}

#ifndef MK_PER_PHASE
#define MK_PER_PHASE 0
#endif
extern "C" void kernel_launch(void* const* d_in, const int* in_sizes, int n_in, void* d_out, int out_size, void* d_ws, size_t ws_size, hipStream_t stream) {
    static int grid = 0;
    if (grid == 0) {
        int dev = 0, cus = 0;
        if (n_in != 32 || out_size != M * DM || ws_size < WS_END) { fprintf(stderr, "kernel_launch: unexpected shapes (n_in %d out %d ws %zu)\n", n_in, out_size, ws_size); grid = -1; return; }
        if (hipGetDevice(&dev) != hipSuccess || hipDeviceGetAttribute(&cus, hipDeviceAttributeMultiprocessorCount, dev) != hipSuccess) { grid = -1; return; }
        if (hipFuncSetAttribute((const void*)mk_fwd, hipFuncAttributeMaxDynamicSharedMemorySize, LDS_BYTES) != hipSuccess) { fprintf(stderr, "kernel_launch: hipFuncSetAttribute failed\n"); grid = -1; return; }
        int per_cu = 0;
        if (hipOccupancyMaxActiveBlocksPerMultiprocessor(&per_cu, (const void*)mk_fwd, NWAVES * 64, LDS_BYTES) != hipSuccess || per_cu < 1) { fprintf(stderr, "kernel_launch: occupancy query says %d\n", per_cu); }
        (void)hipGetLastError();
        grid = cus;
    }
    if (grid < 0) return;
    (void)hipMemsetAsync((char*)d_ws + WS_CTL, 0, CTL_ZERO_BYTES, stream);
    Args a{};
    for (int i = 0; i < 32; ++i) a.in[i] = (const float*)d_in[i];
    a.out = (float*)d_out; a.ws = (unsigned char*)d_ws;
#if MK_PER_PHASE
    for (int p = 0; p < N_PHASES; ++p) { a.ph_lo = p; a.ph_hi = p + 1; hipLaunchKernelGGL(mk_fwd, dim3(grid), dim3(NWAVES * 64), LDS_BYTES, stream, a); }
#else
    a.ph_lo = 0; a.ph_hi = N_PHASES;
    void* kargs[] = {&a};
    hipError_t e = hipLaunchCooperativeKernel((const void*)mk_fwd, dim3(grid), dim3(NWAVES * 64), kargs, LDS_BYTES, stream);
    if (e != hipSuccess) fprintf(stderr, "cooperative launch failed: %s (grid %d)\n", hipGetErrorString(e), grid);
#endif
}
```

```cpp
#include <hip/hip_runtime.h>
#include <hip/hip_cooperative_groups.h>
#include <cstdio>
#include <cstdint>
namespace pg8 {
#define PG8_LAS __attribute__((address_space(3)))
typedef unsigned short bf16_t;
typedef short bf16x8 __attribute__((ext_vector_type(8)));
typedef float f32x4 __attribute__((ext_vector_type(4)));
typedef unsigned u32x4 __attribute__((ext_vector_type(4)));
constexpr int BM = 256, BK = 64, HALF = 128, HTB = HALF * BK * 2  , STAGE_BYTES = 8 * HTB, NXCD = 8, WGM = 8;

__host__ __device__ __forceinline__ int lds_byte(int r, int c) { const int st = (r >> 4) * 2 + (c >> 5), rr = r & 15, cc = c & 31, ob = rr * 64 + cc * 2; return st * 1024 + (ob ^ (((ob >> 9) & 1) << 5)); }
__host__ __device__ __forceinline__ void stage_rc(int b, int& R, int& C) { const int st = b / 1024, sb = b % 1024, swz = sb ^ (((sb >> 9) & 1) << 5); R = (st >> 1) * 16 + swz / 64; C = (st & 1) * 32 + (swz % 64) / 2; }
__host__ __device__ __forceinline__ int perm32(int rho) { const int n = rho >> 4, i = rho & 15; return 8 * (i >> 2) + 4 * n + (i & 3); }

struct Unit { int pm, pn; };
struct Gemm { const bf16_t* A; const bf16_t* Bt; int M, N, K; };

struct StaticOrder {
    int nM, nN, nwg, G, c;
    __host__ __device__ void init(int M, int N, int G_, int c_) { nM = M / BM; nN = N / BM; nwg = nM * nN; G = G_; c = c_; }
    __host__ __device__ bool next(int i, Unit& u) const {
        const long L = (long)i * G + c; if (L >= nwg) return false;
        int wgid = (int)L; { const int q = nwg / NXCD, r = nwg % NXCD, xcd = wgid % NXCD, off = wgid / NXCD; wgid = (xcd < r ? xcd * (q + 1) : r * (q + 1) + (xcd - r) * q) + off; }
        const int nig = WGM * nN, gid = wgid / nig, fm = gid * WGM, gsz = (nM - fm) < WGM ? (nM - fm) : WGM;
        u.pm = fm + ((wgid % nig) % gsz); u.pn = (wgid % nig) / gsz; return true;
    }
    __device__ __forceinline__ void a_ready(const Unit&) const {}
    __device__ __forceinline__ void done(const Unit&) const {}
};

__device__ __forceinline__ unsigned cvt_pk_bf16(float lo, float hi) { unsigned r; asm volatile("v_cvt_pk_bf16_f32 %0, %1, %2" : "=v"(r) : "v"(lo), "v"(hi)); return r; }
typedef float f32x2 __attribute__((ext_vector_type(2)));
__device__ __forceinline__ f32x2 gelu_pk(f32x2 v) {
    const f32x2 av = __builtin_elementwise_abs(v), d = av * 0.2316418882f + 1.0f;
    f32x2 t; t.x = __builtin_amdgcn_rcpf(d.x); t.y = __builtin_amdgcn_rcpf(d.y);
    f32x2 q = t * 0.5307027145f + (-0.7265760135f); q = q * t + 0.7107068705f; q = q * t + (-0.142248368f); q = q * t + 0.127414796f; q = q * t;
    const f32x2 s = (v * v) * (-0.72134752044f);
    f32x2 e; e.x = __builtin_amdgcn_exp2f(s.x); e.y = __builtin_amdgcn_exp2f(s.y);
    const f32x2 m = v * (q * e), r = v - m;
    f32x2 o; o.x = v.x < 0.f ? m.x : r.x; o.y = v.y < 0.f ? m.y : r.y; return o;
}

template <int ACT  > struct EpiBf16 {
    static constexpr bool PERM = true, AFTER_DRAIN = false; static_assert(ACT == 0 || ACT == 1, "EpiBf16: ACT is 0 (none) or 1 (gelu_pk)");
    bf16_t* O; int ldc; const float* bias; int split_cols; size_t split_stride; float scale0;
    __device__ __forceinline__ void operator()(const f32x4 (&acc)[2][2][4][2], const Unit& u, int wr, int wc, int fr, int fq) const {
        const int row0 = u.pm * BM + wr * 64 + fr; int colt = u.pn * BM; bf16_t* base = O;
        float sc = 1.f; if (split_cols) { const int t = colt / split_cols; base += (size_t)t * split_stride; colt -= t * split_cols; if (t == 0) sc = scale0; }
        const int col0 = colt + wc * 32 + 8 * fq, bcol0 = u.pn * BM + wc * 32 + 8 * fq;
        f32x4 bv[2][2];
#pragma unroll
        for (int bj = 0; bj < 2; ++bj)
#pragma unroll
            for (int n = 0; n < 2; ++n) bv[bj][n] = bias ? *(const f32x4*)(bias + bcol0 + bj * HALF + 4 * n) : (f32x4){0.f, 0.f, 0.f, 0.f};
#pragma unroll
        for (int ai = 0; ai < 2; ++ai)
#pragma unroll
            for (int m = 0; m < 4; ++m) { bf16_t* rowp = base + (size_t)(row0 + ai * HALF + m * 16) * ldc + col0;
#pragma unroll
                for (int bj = 0; bj < 2; ++bj) { f32x4 v0 = acc[ai][bj][m][0] + bv[bj][0], v1 = acc[ai][bj][m][1] + bv[bj][1];
                    if (ACT == 1) { f32x2 a = gelu_pk((f32x2){v0[0], v0[1]}), b = gelu_pk((f32x2){v0[2], v0[3]}), c = gelu_pk((f32x2){v1[0], v1[1]}), d = gelu_pk((f32x2){v1[2], v1[3]});
                        v0 = (f32x4){a.x, a.y, b.x, b.y}; v1 = (f32x4){c.x, c.y, d.x, d.y}; }
                    v0 = v0 * sc; v1 = v1 * sc; u32x4 w; w.x = cvt_pk_bf16(v0[0], v0[1]); w.y = cvt_pk_bf16(v0[2], v0[3]); w.z = cvt_pk_bf16(v1[0], v1[1]); w.w = cvt_pk_bf16(v1[2], v1[3]);
                    *(u32x4*)(rowp + bj * HALF) = w; } }
    }
};
struct EpiResidual {
    static constexpr bool PERM = false, AFTER_DRAIN = false;
    const float* base; float* out; int ldc;
    __device__ __forceinline__ void operator()(const f32x4 (&acc)[2][2][4][2], const Unit& u, int wr, int wc, int fr, int fq) const {
        const int col0 = u.pn * BM + wc * 32 + 4 * fq;
#pragma unroll
        for (int ai = 0; ai < 2; ++ai)
#pragma unroll
            for (int m = 0; m < 4; ++m) { const size_t off = (size_t)(u.pm * BM + ai * HALF + wr * 64 + m * 16 + fr) * ldc + col0;
#pragma unroll
                for (int bj = 0; bj < 2; ++bj)
#pragma unroll
                    for (int n = 0; n < 2; ++n) { const f32x4 bs = *(const f32x4*)(base + off + bj * HALF + n * 16); *(f32x4*)(out + off + bj * HALF + n * 16) = bs + acc[ai][bj][m][n]; }
                asm volatile("" ::: "memory"); }
    }
};
struct EpiSwiGLU {
    static constexpr bool PERM = true, AFTER_DRAIN = false;
    bf16_t* O; int ldc;
    __device__ __forceinline__ void operator()(const f32x4 (&acc)[2][2][4][2], const Unit& u, int wr, int wc, int fr, int fq) const {
        const int col0 = u.pn * HALF + wc * 32 + 8 * fq;
#pragma unroll
        for (int ai = 0; ai < 2; ++ai)
#pragma unroll
            for (int m = 0; m < 4; ++m) { bf16_t* rowp = O + (size_t)(u.pm * BM + ai * HALF + wr * 64 + m * 16 + fr) * ldc + col0;
                float r[8];
#pragma unroll
                for (int n = 0; n < 2; ++n)
#pragma unroll
                    for (int j = 0; j < 4; ++j) { const float g = acc[ai][0][m][n][j], up = acc[ai][1][m][n][j]; r[n * 4 + j] = g * __builtin_amdgcn_rcpf(1.f + __expf(-g)) * up; }
                u32x4 w; w.x = cvt_pk_bf16(r[0], r[1]); w.y = cvt_pk_bf16(r[2], r[3]); w.z = cvt_pk_bf16(r[4], r[5]); w.w = cvt_pk_bf16(r[6], r[7]);
                *(u32x4*)rowp = w; }
    }
};
template <class Epi, class Sched, bool ALIGN_EPI = false, bool SP2 = false>
__device__ __forceinline__ void gemm_phase(PG8_LAS unsigned char* lds, const Gemm g, const Sched& S, const Epi& E) {
    const int tid = threadIdx.x, wid = __builtin_amdgcn_readfirstlane(tid >> 6), lane = tid & 63, wr = wid >> 2, wc = wid & 3, fr = lane & 15, fq = lane >> 4;
    const int K = g.K, nt = K / BK;
    unsigned voffA[2], voffB[2];
#pragma unroll
    for (int i = 0; i < 2; ++i) { int R, C; stage_rc(tid * 16 + i * 8192, R, C); const int Rb = Epi::PERM ? ((R & ~31) + perm32(R & 31)) : R;
        voffA[i] = (unsigned)(R * K + C) * 2u; voffB[i] = (unsigned)(Rb * K + C) * 2u; }
    const size_t kstep = (size_t)(BK * 2);
    const size_t hstep = (size_t)HALF * K * 2;
    const size_t tstep = 2 * hstep;
    const unsigned ldsw = (unsigned)wid * 1024u;
    const int aoff = lds_byte(wr * 64 + fr, fq * 8), boff = lds_byte(wc * 32 + fr, fq * 8);
#define PG8_SA(b, h) (((b) * 2 + (h)) * HTB)
#define PG8_SB(b, h) ((4 + (b) * 2 + (h)) * HTB)
#define PG8_STAGE(bufoff, gbase, voff) do { _Pragma("unroll") for (int _i = 0; _i < 2; ++_i) \
        __builtin_amdgcn_global_load_lds((const unsigned*)((const char*)(gbase) + (voff)[_i]), (PG8_LAS unsigned*)(lds + (bufoff) + ldsw + _i * 8192), 16, 0, 0); } while (0)
#define PG8_LDA(dst, b, h) do { _Pragma("unroll") for (int m = 0; m < 4; ++m) _Pragma("unroll") for (int k = 0; k < 2; ++k) dst[m][k] = *(const PG8_LAS bf16x8*)(lds + PG8_SA(b, h) + aoff + m * 2048 + k * 1024); } while (0)
#define PG8_LDB(dst, b, h) do { _Pragma("unroll") for (int n = 0; n < 2; ++n) _Pragma("unroll") for (int k = 0; k < 2; ++k) dst[n][k] = *(const PG8_LAS bf16x8*)(lds + PG8_SB(b, h) + boff + n * 2048 + k * 1024); } while (0)
#define PG8_MMA(ai, bj, At, Bt) do { __builtin_amdgcn_s_setprio(1); _Pragma("unroll") for (int m = 0; m < 4; ++m) _Pragma("unroll") for (int n = 0; n < 2; ++n) _Pragma("unroll") for (int k = 0; k < 2; ++k) \
        acc[ai][bj][m][n] = __builtin_amdgcn_mfma_f32_16x16x32_bf16(Bt[n][k], At[m][k], acc[ai][bj][m][n], 0, 0, 0); __builtin_amdgcn_s_setprio(0); } while (0)
#define PG8_WAIT_V(n) asm volatile("s_waitcnt vmcnt(" #n ")" ::: "memory")
#define PG8_WAIT_L(n) asm volatile("s_waitcnt lgkmcnt(" #n ")" ::: "memory")
#define PG8_BAR __builtin_amdgcn_s_barrier()
#define PG8_SCHED __builtin_amdgcn_sched_barrier(0)
    Unit cur, nxt; int ui = 0;
    if (!S.next(0, cur)) return;
    f32x4 acc[2][2][4][2];
#pragma unroll
    for (int a = 0; a < 2; ++a)
#pragma unroll
        for (int b = 0; b < 2; ++b)
#pragma unroll
            for (int m = 0; m < 4; ++m)
#pragma unroll
                for (int n = 0; n < 2; ++n) acc[a][b][m][n] = (f32x4){0.f, 0.f, 0.f, 0.f};
    bf16x8 At[4][2], B0[2][2], B1[2][2];
    const char* cA = (const char*)g.A + (size_t)cur.pm * tstep; const char* cB = (const char*)g.Bt + (size_t)cur.pn * tstep;
    S.a_ready(cur);
    if constexpr (SP2) {
        PG8_STAGE(PG8_SB(0, 0), cB, voffB); PG8_STAGE(PG8_SB(0, 1), cB + hstep, voffB); PG8_STAGE(PG8_SA(0, 0), cA, voffA); PG8_STAGE(PG8_SA(0, 1), cA + hstep, voffA);
        if (wr == 1) PG8_BAR;
        PG8_WAIT_V(2); PG8_BAR;
        PG8_STAGE(PG8_SB(1, 0), cB + kstep, voffB); PG8_STAGE(PG8_SA(1, 0), cA + kstep, voffA); PG8_STAGE(PG8_SB(1, 1), cB + hstep + kstep, voffB);
        PG8_WAIT_V(6); PG8_BAR;
    } else {
        PG8_STAGE(PG8_SB(0, 0), cB, voffB); PG8_STAGE(PG8_SA(0, 0), cA, voffA); PG8_STAGE(PG8_SB(0, 1), cB + hstep, voffB); PG8_STAGE(PG8_SA(0, 1), cA + hstep, voffA);
        if (wr == 1) PG8_BAR;
        PG8_WAIT_V(4); PG8_BAR;
        PG8_STAGE(PG8_SB(1, 0), cB + kstep, voffB); PG8_STAGE(PG8_SA(1, 0), cA + kstep, voffA); PG8_STAGE(PG8_SB(1, 1), cB + hstep + kstep, voffB);
        PG8_WAIT_V(6); PG8_BAR;
    }
    for (;;) {
        const bool has_next = S.next(ui + 1, nxt);
        const char* nA = has_next ? (const char*)g.A + (size_t)nxt.pm * tstep : cA; const char* nB = has_next ? (const char*)g.Bt + (size_t)nxt.pn * tstep : cB;
        for (int t = 0; t < nt; t += 2) {
            const bool last = (t == nt - 2);
            const char* a1 = cA + (size_t)(t + 1) * kstep;
            const char* a2 = last ? nA : cA + (size_t)(t + 2) * kstep; const char* b2 = last ? nB : cB + (size_t)(t + 2) * kstep;
            const char* a3 = a2 + kstep; const char* b3 = b2 + kstep;
            if (last && has_next) S.a_ready(nxt);
            if constexpr (SP2) {
            PG8_LDB(B0, 0, 0); PG8_LDB(B1, 0, 1); PG8_SCHED; PG8_LDA(At, 0, 0); PG8_STAGE(PG8_SA(1, 1), a1 + hstep, voffA);
            PG8_WAIT_V(8); PG8_WAIT_L(0); PG8_BAR; PG8_MMA(0, 0, At, B0); PG8_MMA(0, 1, At, B1); PG8_BAR; PG8_SCHED;
            PG8_LDA(At, 0, 1); PG8_STAGE(PG8_SB(0, 0), b2, voffB); PG8_STAGE(PG8_SB(0, 1), b2 + hstep, voffB); PG8_STAGE(PG8_SA(0, 0), a2, voffA);
            PG8_WAIT_V(8); PG8_WAIT_L(0); PG8_BAR; PG8_MMA(1, 0, At, B0); PG8_MMA(1, 1, At, B1); PG8_BAR; PG8_SCHED;
            PG8_LDB(B0, 1, 0); PG8_LDB(B1, 1, 1); PG8_SCHED; PG8_LDA(At, 1, 0); PG8_STAGE(PG8_SA(0, 1), a2 + hstep, voffA);
            PG8_WAIT_V(8); PG8_WAIT_L(0); PG8_BAR; PG8_MMA(0, 0, At, B0); PG8_MMA(0, 1, At, B1); PG8_BAR; PG8_SCHED;
            PG8_LDA(At, 1, 1); PG8_STAGE(PG8_SB(1, 0), b3, voffB); PG8_STAGE(PG8_SB(1, 1), b3 + hstep, voffB); PG8_STAGE(PG8_SA(1, 0), a3, voffA);
            PG8_WAIT_V(8); PG8_WAIT_L(0); PG8_BAR; PG8_MMA(1, 0, At, B0); PG8_MMA(1, 1, At, B1); PG8_BAR; PG8_SCHED;
            } else {
            PG8_LDB(B0, 0, 0); PG8_SCHED; PG8_LDA(At, 0, 0); PG8_STAGE(PG8_SA(1, 1), a1 + hstep, voffA);
            PG8_WAIT_L(8); PG8_BAR; PG8_WAIT_L(0); PG8_MMA(0, 0, At, B0); PG8_BAR; PG8_SCHED;
            PG8_LDB(B1, 0, 1); PG8_STAGE(PG8_SB(0, 0), b2, voffB);
            PG8_BAR; PG8_WAIT_L(0); PG8_MMA(0, 1, At, B1); PG8_BAR;
            PG8_LDA(At, 0, 1); PG8_STAGE(PG8_SA(0, 0), a2, voffA);
            PG8_BAR; PG8_WAIT_L(0); PG8_MMA(1, 0, At, B0); PG8_BAR; PG8_SCHED;
            PG8_STAGE(PG8_SB(0, 1), b2 + hstep, voffB);
            PG8_WAIT_V(6); PG8_BAR; PG8_MMA(1, 1, At, B1); PG8_BAR;
            PG8_LDB(B0, 1, 0); PG8_SCHED; PG8_LDA(At, 1, 0); PG8_STAGE(PG8_SA(0, 1), a2 + hstep, voffA);
            PG8_WAIT_L(8); PG8_BAR; PG8_WAIT_L(0); PG8_MMA(0, 0, At, B0); PG8_BAR; PG8_SCHED;
            PG8_LDB(B1, 1, 1); PG8_STAGE(PG8_SB(1, 0), b3, voffB);
            PG8_BAR; PG8_WAIT_L(0); PG8_MMA(0, 1, At, B1); PG8_BAR;
            PG8_LDA(At, 1, 1); PG8_STAGE(PG8_SA(1, 0), a3, voffA);
            PG8_BAR; PG8_WAIT_L(0); PG8_MMA(1, 0, At, B0); PG8_BAR; PG8_SCHED;
            PG8_STAGE(PG8_SB(1, 1), b3 + hstep, voffB);
            PG8_WAIT_V(6); PG8_BAR; PG8_MMA(1, 1, At, B1); PG8_BAR;
            }
        }
        if constexpr (ALIGN_EPI) { if (wr == 0) PG8_BAR; }
        if constexpr (!Epi::AFTER_DRAIN) { E(acc, cur, wr, wc, fr, fq); S.done(cur); }
        if (!has_next) break;
#pragma unroll
        for (int a = 0; a < 2; ++a)
#pragma unroll
            for (int b = 0; b < 2; ++b)
#pragma unroll
                for (int m = 0; m < 4; ++m)
#pragma unroll
                    for (int n = 0; n < 2; ++n) acc[a][b][m][n] = (f32x4){0.f, 0.f, 0.f, 0.f};
        cur = nxt; cA = nA; cB = nB; ++ui;
        if constexpr (ALIGN_EPI) { if (wr == 1) PG8_BAR; }
    }
    PG8_WAIT_V(0);
    if constexpr (!ALIGN_EPI) { if (wr == 0) PG8_BAR; }
    PG8_BAR;
    if constexpr (Epi::AFTER_DRAIN) { E.fused(acc, cur, wr, wc, fr, fq, lds, wid, lane); S.done(cur); }
#undef PG8_SA
#undef PG8_SB
#undef PG8_STAGE
#undef PG8_LDA
#undef PG8_LDB
#undef PG8_MMA
#undef PG8_WAIT_V
#undef PG8_WAIT_L
#undef PG8_BAR
#undef PG8_SCHED
}
}

#ifndef PG8_SP2
#define PG8_SP2 true
#endif
#define PG8_ALIGN true
constexpr int NWAVES = 8;
constexpr int BATCH = 2, SEQ = 8192, DM = 1024, M = BATCH * SEQ, NIN = 3788, NINP = 3840, FFN = 2816, DEPTH = 2;
constexpr int A_Q = 0, A_K = 256, A_V = 512, A_O = 768;
constexpr int R_R = 1024, R_K = 1408, R_V = 1792, R_WDF = 2176, R_AD = 2304, R_GD = 2368;
constexpr int S_Z = 2496, S_X = 2880, S_B = 3264, S_C = 3520, S_DT = 3776;
constexpr size_t MiB = 1u << 20;
constexpr size_t WS_CTL = 0, CTL_ZERO_BYTES = 64 * 1024;
constexpr size_t WS_GATES = 1 * MiB, WS_CT = 2 * MiB;
constexpr size_t WS_WIN = 4 * MiB, WS_WOUT = 12 * MiB, WS_WGU = 14 * MiB, WS_WDN = 25 * MiB;
constexpr size_t WS_XN = 32 * MiB, WS_COLS = 64 * MiB, WS_Y = 184 * MiB, WS_END = 248 * MiB;
constexpr size_t Y_AF = WS_Y, Y_AB = WS_Y + 8 * MiB, Y_RF = WS_Y + 16 * MiB, Y_RB = WS_Y + 28 * MiB, Y_SF = WS_Y + 40 * MiB, Y_SB = WS_Y + 52 * MiB;
constexpr int CW_BAR = 1024;
constexpr int RING_BYTES = 131072;
constexpr int LDS_BYTES = 147456, MISC_OFF = LDS_BYTES - 256;

#define GAS __attribute__((address_space(1)))
#define LAS __attribute__((address_space(3)))
typedef unsigned short bf16;
typedef unsigned v4u __attribute__((ext_vector_type(4)));
typedef unsigned v2u __attribute__((ext_vector_type(2)));
typedef float f32x4 __attribute__((ext_vector_type(4)));
typedef short bf16x8 __attribute__((ext_vector_type(8)));
typedef GAS unsigned gu32;
#define RLX_AGENT __ATOMIC_RELAXED, __HIP_MEMORY_SCOPE_AGENT
#define LDS_WAIT() asm volatile("s_waitcnt lgkmcnt(0)" ::: "memory")
#define VM_WAIT() asm volatile("s_waitcnt vmcnt(0)" ::: "memory")
__device__ __forceinline__ unsigned f2bf(float f) { unsigned u = __builtin_bit_cast(unsigned, f); return (u + 0x7fffu + ((u >> 16) & 1u)) >> 16; }
__device__ __forceinline__ unsigned pk2(float lo, float hi) { return f2bf(lo) | (f2bf(hi) << 16); }
__device__ __forceinline__ float bf2f(unsigned u) { return __builtin_bit_cast(float, u << 16); }
__device__ __forceinline__ float sigmoidf_(float x) { return __builtin_amdgcn_rcpf(1.f + __expf(-x)); }
__device__ __forceinline__ float siluf_(float x) { return x * sigmoidf_(x); }
__device__ __forceinline__ float wave_sum(float v) {
#pragma unroll
    for (int o = 1; o < 64; o <<= 1) v += __shfl_xor(v, o);
    return v;
}
__device__ __forceinline__ float wave_max(float v) {
#pragma unroll
    for (int o = 1; o < 64; o <<= 1) v = fmaxf(v, __shfl_xor(v, o));
    return v;
}
template <int CTRL> __device__ __forceinline__ float dppf(float v) { return __builtin_bit_cast(float, __builtin_amdgcn_update_dpp(0, __builtin_bit_cast(int, v), CTRL, 0xf, 0xf, true)); }
__device__ __forceinline__ float row16_sum(float v) { v += dppf<0xB1>(v); v += dppf<0x4E>(v); v += dppf<0x141>(v); v += dppf<0x140>(v); return v; }
template <int K> __device__ __forceinline__ f32x4 mma16(const LAS bf16* A, int lda, const LAS bf16* Bt, int ldb, f32x4 acc, int lane) {
    const int r = lane & 15, q = lane >> 4;
    const LAS bf16* ap = A + r * lda + q * 8; const LAS bf16* bp = Bt + r * ldb + q * 8;
#pragma unroll
    for (int k0 = 0; k0 < K; k0 += 32) {
        const bf16x8 a = *(const LAS bf16x8*)(ap + k0); const bf16x8 b = *(const LAS bf16x8*)(bp + k0);
        acc = __builtin_amdgcn_mfma_f32_16x16x32_bf16(a, b, acc, 0, 0, 0);
    }
    return acc;
}
#define XB_TMO      128
#define XB_XCNT(j)  (256  + 64 * (j))
#define XB_XSUB(j)  (1280 + 64 * (j))
#define XB_XGEN(j)  (2304 + 64 * (j))
#define XB_TOP      3328
#define XB_TOPGEN   3392
#define XCD_BAR_WORDS 3456
#define XB_SPIN_CAP (1u << 18)

__device__ __forceinline__ unsigned xb_ld(unsigned* p)              { return __hip_atomic_load(p, __ATOMIC_RELAXED, __HIP_MEMORY_SCOPE_AGENT); }
__device__ __forceinline__ unsigned xb_add(unsigned* p, unsigned v) { return __hip_atomic_fetch_add(p, v, __ATOMIC_RELAXED, __HIP_MEMORY_SCOPE_AGENT); }
__device__ __forceinline__ unsigned xb_xcc_id() { return (unsigned)__builtin_amdgcn_s_getreg((3 << 11) | 20) & 0xFu; }
#define XB_SPIN(cond, bar) do { unsigned _sp = 0; while (cond) { __builtin_amdgcn_s_sleep(1); \
    if ((++_sp & 255u) == 0u) { if (xb_ld(&(bar)[XB_TMO])) break; if (_sp > XB_SPIN_CAP) { atomicAdd(&(bar)[XB_TMO], 1u); break; } } } } while (0)

struct XcdBarrier {
    unsigned* bar; unsigned x;
    volatile LAS unsigned* st;
};

__device__ __forceinline__ XcdBarrier xcd_barrier_post(unsigned* bar, volatile LAS unsigned* st) {
    XcdBarrier b; b.bar = bar; b.x = xb_xcc_id(); b.st = st;
    if (threadIdx.x == 0) (void)xb_add(&bar[XB_XCNT(b.x)], 1u);
    return b;
}
__device__ __forceinline__ void xcd_barrier_complete(unsigned* bar, unsigned x, unsigned& nloc, unsigned& nx) {
    const unsigned G = gridDim.x * gridDim.y * gridDim.z;
    unsigned sum, cnt, mine, sp = 0u;
    for (;;) {
        sum = 0u; cnt = 0u; mine = 0u;
#pragma unroll
        for (unsigned j = 0; j < 16; ++j) { const unsigned c = xb_ld(&bar[XB_XCNT(j)]); sum += c; cnt += (c > 0u) ? 1u : 0u; mine = (j == x) ? c : mine; }
        if (sum == G) break;
        __builtin_amdgcn_s_sleep(1);
        if ((++sp & 255u) == 0u) { if (xb_ld(&bar[XB_TMO])) break; if (sp > XB_SPIN_CAP) { atomicAdd(&bar[XB_TMO], 1u); break; } }
    }
    nloc = mine > 0u ? mine : 1u; nx = cnt > 0u ? cnt : 1u;
}

__device__ __forceinline__ void xcd_barrier(const XcdBarrier& b) {
    asm volatile("s_waitcnt vmcnt(0)" ::: "memory");
    __syncthreads();
    if (threadIdx.x == 0) {
        unsigned* bar = b.bar;
        __builtin_amdgcn_s_waitcnt(0);
        unsigned nloc = b.st[0], nx = b.st[1];
        if (nloc == 0u) { xcd_barrier_complete(bar, b.x, nloc, nx); b.st[0] = nloc; b.st[1] = nx; }
        const unsigned old = xb_add(&bar[XB_XSUB(b.x)], 1u);
        const unsigned gen = old / nloc;
        if (old + 1u == (gen + 1u) * nloc) {
            __builtin_amdgcn_fence(__ATOMIC_RELEASE, "agent");
            asm volatile("s_waitcnt vmcnt(0)" ::: "memory");
            const unsigned og = xb_add(&bar[XB_TOP], 1u);
            const unsigned tg = og / nx;
            if (og + 1u == (tg + 1u) * nx) xb_add(&bar[XB_TOPGEN], 1u);
            else XB_SPIN(xb_ld(&bar[XB_TOPGEN]) == tg, bar);
            __builtin_amdgcn_fence(__ATOMIC_ACQUIRE, "agent");
            xb_add(&bar[XB_XGEN(b.x)], 1u);
            asm volatile("s_waitcnt vmcnt(0)" ::: "memory");
        } else {
            XB_SPIN(xb_ld(&bar[XB_XGEN(b.x)]) == gen, bar);
            __builtin_amdgcn_fence(__ATOMIC_ACQUIRE, "agent");
            asm volatile("s_waitcnt vmcnt(0)" ::: "memory");
        }
    }
    __syncthreads();
}
struct Frame {
    LAS unsigned char* lds;
    int tid, lane, wave, vcu, G;
};
struct Args { const float* in[32]; float* out; unsigned char* ws; int ph_lo, ph_hi; };
constexpr int PTAB_OFF = LDS_BYTES - 768;
__device__ __forceinline__ unsigned long long ptab_ld(const Frame& F, int i) {
    const unsigned long long v = *(volatile LAS unsigned long long*)(F.lds + PTAB_OFF + 8 * i);
    const unsigned lo = __builtin_amdgcn_readfirstlane((unsigned)v), hi = __builtin_amdgcn_readfirstlane((unsigned)(v >> 32));
    return ((unsigned long long)hi << 32) | lo;
}
__device__ __forceinline__ const float* INP(const Frame& F, int i) { return (const float*)ptab_ld(F, i); }
__device__ __forceinline__ unsigned char* WSP(const Frame& F) { return (unsigned char*)ptab_ld(F, 33); }
__device__ __forceinline__ float* OUTP(const Frame& F) { return (float*)ptab_ld(F, 32); }

__device__ __forceinline__ void transpose_item(const float* W, int K, int N, int nblk, bf16* WT, int mode, int row_off, LAS float* scr, int item, int lane) {
    const int kb = item / nblk, nb = item % nblk, k0 = 64 * kb, n0 = 32 * nb;
    const int ncol = n0 + (lane & 31); const bool ok = ncol < N;
#pragma unroll 8
    for (int i = 0; i < 32; ++i) { const int kk = 2 * i + (lane >> 5); scr[kk * 33 + (lane & 31)] = ok ? W[(size_t)(k0 + kk) * N + ncol] : 0.f; }
    LDS_WAIT(); asm volatile("" ::: "memory");
    const int c = lane & 7;
    const int drow0 = mode ? (256 * (n0 >> 7) + (n0 & 127) + row_off) : (row_off + n0);
#pragma unroll
    for (int j = 0; j < 4; ++j) { const int n = (lane >> 3) + 8 * j; const LAS float* s = scr + (8 * c) * 33 + n;
        v4u o; o.x = pk2(s[0 * 33], s[1 * 33]); o.y = pk2(s[2 * 33], s[3 * 33]); o.z = pk2(s[4 * 33], s[5 * 33]); o.w = pk2(s[6 * 33], s[7 * 33]);
        *(v4u*)(WT + (size_t)(drow0 + n) * K + k0 + 8 * c) = o; }
    LDS_WAIT(); asm volatile("" ::: "memory");
}
__device__ __forceinline__ void phase_convert(const Frame& F, int l) {
    LAS float* scr = (LAS float*)(F.lds + F.wave * 16384);
    const int gw = F.vcu * NWAVES + F.wave, NGW = F.G * NWAVES;
    bf16* Win = (bf16*)(WSP(F) + WS_WIN); bf16* Wout = (bf16*)(WSP(F) + WS_WOUT); bf16* Wgu = (bf16*)(WSP(F) + WS_WGU); bf16* Wdn = (bf16*)(WSP(F) + WS_WDN);
    constexpr int I_IN = 16 * 120, I_OUT = 16 * 32, I_G = 16 * 88, I_D = 44 * 32;
    constexpr int NITEMS = I_IN + I_OUT + 2 * I_G + I_D;
    for (int it = gw; it < NITEMS; it += NGW) {
        int r = it;
        if (r < I_IN) { transpose_item(INP(F, 2) + (size_t)l * DM * NIN, DM, NIN, 120, Win, 0, 0, scr, r, F.lane); continue; } r -= I_IN;
        if (r < I_OUT) { transpose_item(INP(F, 26) + (size_t)l * DM * DM, DM, DM, 32, Wout, 0, 0, scr, r, F.lane); continue; } r -= I_OUT;
        if (r < I_G) { transpose_item(INP(F, 28) + (size_t)l * DM * FFN, DM, FFN, 88, Wgu, 1, 0, scr, r, F.lane); continue; } r -= I_G;
        if (r < I_G) { transpose_item(INP(F, 29) + (size_t)l * DM * FFN, DM, FFN, 88, Wgu, 1, 128, scr, r, F.lane); continue; } r -= I_G;
        transpose_item(INP(F, 30) + (size_t)l * FFN * DM, FFN, DM, 32, Wdn, 0, 0, scr, r, F.lane);
    }
}
__device__ __forceinline__ void phase_norm(const Frame& F, const float* hin, const float* g, bf16* XN) {
    const int gw = F.vcu * NWAVES + F.wave, NGW = F.G * NWAVES;
    f32x4 gv[4];
#pragma unroll
    for (int j = 0; j < 4; ++j) gv[j] = ((const f32x4*)g)[64 * j + F.lane];
    for (int m = gw; m < M; m += NGW) {
        const f32x4* xr = (const f32x4*)(hin + (size_t)m * DM) + F.lane;
        f32x4 v[4]; float s = 0.f;
#pragma unroll
        for (int j = 0; j < 4; ++j) { v[j] = xr[64 * j]; s += (v[j].x * v[j].x + v[j].y * v[j].y) + (v[j].z * v[j].z + v[j].w * v[j].w); }
        const float r = 1.f / sqrtf(wave_sum(s) * (1.f / DM) + 1e-6f);
        v2u* o8 = (v2u*)(XN + (size_t)m * DM) + F.lane;
#pragma unroll
        for (int j = 0; j < 4; ++j) { v2u w; w.x = pk2(v[j].x * r * gv[j].x, v[j].y * r * gv[j].y); w.y = pk2(v[j].z * r * gv[j].z, v[j].w * r * gv[j].w); o8[64 * j] = w; }
    }
}
__device__ __forceinline__ void phase_final_norm(const Frame& F, float* h, const float* g) {
    const int gw = F.vcu * NWAVES + F.wave, NGW = F.G * NWAVES;
    f32x4 gv[4];
#pragma unroll
    for (int j = 0; j < 4; ++j) gv[j] = ((const f32x4*)g)[64 * j + F.lane];
    for (int m = gw; m < M; m += NGW) {
        f32x4* xr = (f32x4*)(h + (size_t)m * DM) + F.lane;
        f32x4 v[4]; float s = 0.f;
#pragma unroll
        for (int j = 0; j < 4; ++j) { v[j] = xr[64 * j]; s += (v[j].x * v[j].x + v[j].y * v[j].y) + (v[j].z * v[j].z + v[j].w * v[j].w); }
        const float r = 1.f / sqrtf(wave_sum(s) * (1.f / DM) + 1e-6f);
#pragma unroll
        for (int j = 0; j < 4; ++j) xr[64 * j] = v[j] * r * gv[j];
    }
}
__device__ __forceinline__ void phase_gates(const Frame& F, int l) {
    const bf16* cols = (const bf16*)(WSP(F) + WS_COLS); float* GT = (float*)(WSP(F) + WS_GATES);
    LAS bf16* raw = (LAS bf16*)(F.lds);
    LAS float* feat = (LAS float*)(F.lds + 32768);
    LAS float* gw = (LAS float*)(F.lds + 81920);
    const float* gwg = INP(F, 5) + (size_t)l * 768 * 16; const float* gb = INP(F, 6) + l * 16;
    const float* cw = INP(F, 3) + (size_t)l * 5 * 512; const float* cb = INP(F, 4) + l * 512;
    for (int i = F.tid; i < 768 * 16; i += 512) gw[i] = gwg[i];
    for (int tile = F.vcu; tile < M / 16; tile += F.G) {
        const int m0 = tile * 16, t0 = m0 % SEQ;
        __syncthreads();
        for (int ch = F.tid; ch < 20 * 96; ch += 512) { const int rr = ch / 96, cc = ch % 96; const int t = t0 - 2 + rr;
            v4u v = {0u, 0u, 0u, 0u}; if (t >= 0 && t < SEQ) v = *(const v4u*)(cols + (size_t)(m0 - 2 + rr) * NINP + cc * 8);
            *(LAS v4u*)(raw + rr * 768 + cc * 8) = v; }
        __syncthreads();
        for (int idx = F.tid; idx < 16 * 768; idx += 512) { const int t = idx / 768, c = idx % 768; float val;
            if (c < 512) { float s = cb[c];
#pragma unroll
                for (int j = 0; j < 5; ++j) s += cw[j * 512 + c] * bf2f(raw[(t + j) * 768 + c]);
                val = siluf_(s); } else val = bf2f(raw[(t + 2) * 768 + c]);
            feat[idx] = val; }
        __syncthreads();
        { const int t = F.tid >> 5, o = (F.tid >> 1) & 15, hf = F.tid & 1; float s = 0.f;
          const LAS float* fp = feat + t * 768 + hf * 384; const LAS float* wp = gw + (hf * 384) * 16 + o;
#pragma unroll 8
          for (int i = 0; i < 384; ++i) s += fp[i] * wp[i * 16];
          s += __shfl_xor(s, 1);
          if (hf == 0) { s += gb[o]; if (o >= 8) s = fminf(s, 0.f) - log1pf(__expf(-fabsf(s))); GT[(size_t)(m0 + t) * 16 + o] = s; } }
    }
    __syncthreads();
}
__device__ __forceinline__ f32x4 mma16_a8(const LAS bf16* A8, const LAS bf16* Bt, f32x4 acc, int lane) {
    const int q = lane >> 4;
    const LAS bf16* ap = A8 + (lane & 7) * 72 + q * 8; const LAS bf16* bp = Bt + (lane & 15) * 72 + q * 8;
#pragma unroll
    for (int k0 = 0; k0 < 64; k0 += 32) { const bf16x8 a = *(const LAS bf16x8*)(ap + k0); const bf16x8 b = *(const LAS bf16x8*)(bp + k0); acc = __builtin_amdgcn_mfma_f32_16x16x32_bf16(a, b, acc, 0, 0, 0); }
    return acc;
}
__device__ __forceinline__ void rwkv_scan(const Frame& F, int l, int task) {
    const int b = task / 48, rem = task % 48, h = rem >> 3, dir = (rem >> 2) & 1, qtr = rem & 3;
    const bf16* cols = (const bf16*)(WSP(F) + WS_COLS);
    bf16* Y = (bf16*)(WSP(F) + (dir ? Y_RB : Y_RF));
    float* CT = (float*)(WSP(F) + WS_CT);
    LAS bf16* WA = (LAS bf16*)(F.lds); LAS bf16* WW = (LAS bf16*)(F.lds + 9216);
    const int tid = F.tid, lane = F.lane, wave = F.wave;
    LAS bf16* XA = (LAS bf16*)(F.lds + 18432) + (wave & 3) * 576; LAS bf16* XW = (LAS bf16*)(F.lds + 23040) + (wave & 3) * 576;
    LAS bf16* RAWB = (LAS bf16*)(F.lds + 27648) + (wave & 3) * 3200;
    LAS float* MU = (LAS float*)(F.lds + 53248);
    LAS float* OPSb = (LAS float*)(F.lds + 55808);
    LAS float* VVb = (LAS float*)(F.lds + 137728);
    LAS float* YBb = (LAS float*)(F.lds + 141824);
    constexpr int NB = SEQ / 32;
    __syncthreads();
    { const float* aup = INP(F, 13) + (size_t)l * 64 * 384; const float* wup = INP(F, 11) + (size_t)(l * 2 + dir) * 64 * 384;
      for (int idx = tid; idx < 4096; idx += 512) { const int i = idx >> 6, c = idx & 63;
          WA[c * 72 + i] = (bf16)f2bf(aup[i * 384 + h * 64 + c]); WW[c * 72 + i] = (bf16)f2bf(wup[i * 384 + h * 64 + c]); }
      if (tid < 320) { const int which = tid >> 6, c = tid & 63;
          const int rc = which == 0 ? h * 64 + c : which == 1 ? 384 + h * 64 + c : which == 2 ? 768 + h * 64 + c : which == 3 ? 1152 + dir * 64 + c : 1280 + c;
          MU[tid] = INP(F, 8)[l * 1472 + rc]; MU[320 + tid] = INP(F, 9)[l * 1472 + rc]; } }
    __syncthreads();
    const size_t mb = (size_t)b * SEQ;
    const int j = lane & 15;
    if (wave < 4) {
        const int pw = wave;
        const int hc4 = h * 64 + 4 * j;
        const f32x4 kk_c4 = *(const f32x4*)(INP(F, 15) + l * 384 + hc4), ka_c4 = *(const f32x4*)(INP(F, 16) + l * 384 + hc4), rk_c4 = *(const f32x4*)(INP(F, 17) + l * 384 + hc4);
        float ba[4], bw[4];
#pragma unroll
        for (int ct = 0; ct < 4; ++ct) { ba[ct] = INP(F, 12)[l * 384 + h * 64 + 16 * ct + j]; bw[ct] = INP(F, 10)[(l * 2 + dir) * 384 + h * 64 + 16 * ct + j]; }
        v4u pre[7];
#define RW_ISSUE(blk) do { const int T0_ = dir ? SEQ - 32 * ((blk) + 1) : 32 * (blk); _Pragma("unroll") for (int i_ = 0; i_ < 7; ++i_) { const int idx_ = lane + 64 * i_; pre[i_] = (v4u){0u, 0u, 0u, 0u}; \
        if (idx_ < 400) { const int rr_ = idx_ / 40, q_ = idx_ % 40, wh_ = q_ >> 3, c8_ = q_ & 7; const int t_ = T0_ + 8 * pw - 1 + rr_; \
            const int gc_ = (wh_ == 0 ? R_R + h * 64 : wh_ == 1 ? R_K + h * 64 : wh_ == 2 ? R_V + h * 64 : wh_ == 3 ? R_WDF + dir * 64 : R_AD) + c8_ * 8; \
            if (t_ >= 0 && t_ < SEQ) pre[i_] = *(const v4u*)(cols + (mb + t_) * NINP + gc_); } } } while (0)
        RW_ISSUE(0);
#pragma unroll 1
        for (int it = 0; it <= NB; ++it) {
            if (it < NB) {
                const int T0 = dir ? SEQ - 32 * (it + 1) : 32 * it;
                LAS float* OPS = OPSb + (it & 1) * 10240; LAS float* VV = VVb + (it & 1) * 512;
#pragma unroll
                for (int i = 0; i < 7; ++i) { const int idx = lane + 64 * i; if (idx < 400) *(LAS v4u*)(RAWB + idx * 8) = pre[i]; }
                LDS_WAIT(); asm volatile("" ::: "memory");
                if (it + 1 < NB) RW_ISSUE(it + 1);
#pragma unroll
                for (int k2 = 0; k2 < 40; ++k2) { const int which = k2 >> 3, tt = k2 & 7, cc = which * 64 + lane, t = 8 * pw + tt;
                    const float p0 = bf2f(RAWB[tt * 320 + cc]), p1 = bf2f(RAWB[(tt + 1) * 320 + cc]), p2 = bf2f(RAWB[(tt + 2) * 320 + cc]);
                    const float v = p1 + MU[cc] * (p0 - p1) + MU[320 + cc] * (p2 - p1);
                    if (which == 0) OPS[t * 320 + 256 + lane] = v;
                    else if (which == 1) OPS[t * 320 + 192 + lane] = v;
                    else if (which == 2) { if ((lane >> 4) == qtr) VV[t * 16 + (lane & 15)] = v; }
                    else if (which == 3) { const float e = __expf(2.f * v); XW[tt * 72 + lane] = (bf16)f2bf(1.f - 2.f * __builtin_amdgcn_rcpf(e + 1.f)); }
                    else XA[tt * 72 + lane] = (bf16)f2bf(v); }
                LDS_WAIT(); asm volatile("" ::: "memory");
#pragma unroll
                for (int ct = 0; ct < 4; ++ct) { const f32x4 z = {0.f, 0.f, 0.f, 0.f};
                    const f32x4 ca = mma16_a8(XA, WA + ct * 16 * 72, z, lane), cw = mma16_a8(XW, WW + ct * 16 * 72, z, lane);
                    if (lane < 32) {
#pragma unroll
                        for (int jj = 0; jj < 4; ++jj) { const int t = 8 * pw + (lane >> 4) * 4 + jj, c = ct * 16 + j;
                            OPS[t * 320 + 128 + c] = sigmoidf_(ba[ct] + ca[jj]);
                            OPS[t * 320 + c] = __expf(-0.6065306597f * sigmoidf_(bw[ct] + cw[jj])); } } }
                LDS_WAIT(); asm volatile("" ::: "memory");
#pragma unroll
                for (int ps = 0; ps < 2; ++ps) { const int t = 8 * pw + 4 * ps + (lane >> 4); LAS float* op = OPS + t * 320 + 4 * j;
                    const f32x4 av = *(const LAS f32x4*)(op + 128), kp = *(const LAS f32x4*)(op + 192), rp = *(const LAS f32x4*)(op + 256);
                    const f32x4 kr = kp * kk_c4; const float ss = row16_sum((kr.x * kr.x + kr.y * kr.y) + (kr.z * kr.z + kr.w * kr.w));
                    const f32x4 kkv = kr * (1.f / fmaxf(sqrtf(ss), 1e-12f));
                    const f32x4 km = kp * ((av - 1.f) * ka_c4 + 1.f);
                    const f32x4 q = rp * km * rk_c4; const float cs = row16_sum((q.x + q.y) + (q.z + q.w));
                    *(LAS f32x4*)(op + 64) = kkv; *(LAS f32x4*)(op + 128) = kkv * av; *(LAS f32x4*)(op + 192) = km;
                    if (dir == 0 && qtr == 0 && j == 0) CT[(mb + T0 + t) * 8 + h] = cs; }
            }
            if (it >= 2) { const int bk = it - 2; const int T0 = dir ? SEQ - 32 * (bk + 1) : 32 * bk; const LAS float* YB = YBb + (bk & 1) * 512;
                const int idx = (pw * 64 + lane) * 2, tl = idx >> 4, rw = idx & 15;
                *(unsigned*)(Y + (mb + T0 + tl) * 384 + h * 64 + 16 * qtr + rw) = pk2(YB[idx], YB[idx + 1]); }
            __syncthreads();
        }
        { const int bk = NB - 1; const int T0 = dir ? SEQ - 32 * (bk + 1) : 32 * bk; const LAS float* YB = YBb + (bk & 1) * 512;
          const int idx = (pw * 64 + lane) * 2, tl = idx >> 4, rw = idx & 15;
          *(unsigned*)(Y + (mb + T0 + tl) * 384 + h * 64 + 16 * qtr + rw) = pk2(YB[idx], YB[idx + 1]); }
#undef RW_ISSUE
    } else {
        const int row = (wave - 4) * 4 + (lane >> 4);
        f32x4 S = {0.f, 0.f, 0.f, 0.f};
#pragma unroll 1
        for (int it = 0; it <= NB; ++it) {
            if (it >= 1) { const int bk = it - 1;
                const LAS float* OPS = OPSb + (bk & 1) * 10240; const LAS float* VV = VVb + (bk & 1) * 512; LAS float* YB = YBb + (bk & 1) * 512;
                __builtin_amdgcn_s_setprio(3);
                float yk0 = 0.f, yk1 = 0.f;
                const LAS float* op0 = OPS + (dir ? 31 : 0) * 320 + 4 * j; const int ostep = dir ? -320 : 320;
                const LAS float* vp0 = VV + (dir ? 31 : 0) * 16 + row; const int vstep = dir ? -16 : 16;
                f32x4 w4 = *(const LAS f32x4*)(op0), kk4 = *(const LAS f32x4*)(op0 + 64), ka4 = *(const LAS f32x4*)(op0 + 128), km4 = *(const LAS f32x4*)(op0 + 192), r4 = *(const LAS f32x4*)(op0 + 256);
                float vv = *vp0;
#pragma unroll
                for (int i = 0; i < 32; ++i) {
                    f32x4 nw4, nkk4, nka4, nkm4, nr4; float nvv;
                    if (i < 31) { const LAS float* op = op0 + (i + 1) * ostep; nw4 = *(const LAS f32x4*)(op); nkk4 = *(const LAS f32x4*)(op + 64); nka4 = *(const LAS f32x4*)(op + 128); nkm4 = *(const LAS f32x4*)(op + 192); nr4 = *(const LAS f32x4*)(op + 256); nvv = vp0[(i + 1) * vstep]; }
                    float sa = (S.x * kk4.x + S.y * kk4.y) + (S.z * kk4.z + S.w * kk4.w);
                    const f32x4 pre_s = S * w4 + km4 * vv;
                    sa = row16_sum(sa);
                    S = pre_s - ka4 * sa;
                    float y = (S.x * r4.x + S.y * r4.y) + (S.z * r4.z + S.w * r4.w);
                    y = row16_sum(y);
                    if ((i & 15) == j) { if (i < 16) yk0 = y; else yk1 = y; }
                    if (i < 31) { w4 = nw4; kk4 = nkk4; ka4 = nka4; km4 = nkm4; r4 = nr4; vv = nvv; } }
                YB[(dir ? 31 - j : j) * 16 + row] = yk0; YB[(dir ? 15 - j : 16 + j) * 16 + row] = yk1;
                __builtin_amdgcn_s_setprio(0);
            }
            __syncthreads();
        }
    }
    __syncthreads();
}
__device__ __forceinline__ void mlstm_seq(const Frame& F, int l, int task) {
    const int b = task >> 3, h = (task >> 1) & 3, dir = task & 1;
    const bf16* cols = (const bf16*)(WSP(F) + WS_COLS); const float* GT = (const float*)(WSP(F) + WS_GATES);
    bf16* Y = (bf16*)(WSP(F) + (dir ? Y_AB : Y_AF));
    LAS bf16* RAWQ = (LAS bf16*)(F.lds);
    LAS bf16* Qs = (LAS bf16*)(F.lds + 17408); LAS bf16* Ks = (LAS bf16*)(F.lds + 26624);
    LAS bf16* Vt = (LAS bf16*)(F.lds + 35840); LAS bf16* KWt = (LAS bf16*)(F.lds + 45056);
    LAS bf16* Ps = (LAS bf16*)(F.lds + 54272); LAS bf16* Ct = (LAS bf16*)(F.lds + 63488);
    LAS float* fa = (LAS float*)(F.lds + 72704);
    LAS float* li = fa, *lf = fa + 64, *bcs = fa + 128, *gg = fa + 192, *mq = fa + 256, *iw = fa + 320, *den = fa + 384, *nst = fa + 448, *scal = fa + 512;
    const int tid = F.tid, lane = F.lane, wave = F.wave;
    const size_t mb = (size_t)b * SEQ;
    __syncthreads();
    for (int i = tid; i < 64 * 72; i += 512) Ct[i] = 0;
    if (tid < 64) nst[tid] = 0.f;
    const int cc = tid & 127, isK = cc >> 6, d0 = cc & 63, chn = isK * 256 + h * 64 + d0;
    float cw[5]; const float* cwp = INP(F, 3) + (size_t)l * 5 * 512;
#pragma unroll
    for (int jj = 0; jj < 5; ++jj) cw[jj] = cwp[jj * 512 + chn];
    const float cbv = INP(F, 4)[l * 512 + chn];
    f32x4 st[2] = {{0.f, 0.f, 0.f, 0.f}, {0.f, 0.f, 0.f, 0.f}};
    float m_st = 0.f, nloc = 0.f;
    for (int c = 0; c < SEQ / 64; ++c) {
        const int tlo = dir ? SEQ - 64 * (c + 1) : 64 * c;
        for (int ch = tid; ch < 68 * 16; ch += 512) { const int rr = ch >> 4, q = ch & 15; const int t = tlo - 2 + rr;
            v4u v = {0u, 0u, 0u, 0u}; if (t >= 0 && t < SEQ) v = *(const v4u*)(cols + (mb + t) * NINP + (q >> 3) * 256 + h * 64 + (q & 7) * 8);
            *(LAS v4u*)(RAWQ + rr * 128 + q * 8) = v; }
        { const int tl = tid >> 3, e8 = tid & 7; const int lpos = dir ? 63 - tl : tl;
          const v4u v = *(const v4u*)(cols + (mb + tlo + tl) * NINP + A_V + h * 64 + e8 * 8);
          const unsigned w[4] = {v.x, v.y, v.z, v.w};
#pragma unroll
          for (int k = 0; k < 4; ++k) { Vt[(e8 * 8 + 2 * k) * 72 + lpos] = (bf16)(w[k] & 0xffffu); Vt[(e8 * 8 + 2 * k + 1) * 72 + lpos] = (bf16)(w[k] >> 16); } }
        if (tid < 64) { const int t = dir ? tlo + 63 - tid : tlo + tid; li[tid] = GT[(mb + t) * 16 + dir * 4 + h]; lf[tid] = GT[(mb + t) * 16 + 8 + dir * 4 + h]; }
        __syncthreads();
#pragma unroll 4
        for (int i = 0; i < 16; ++i) { const int tl = (tid >> 7) + 4 * i; float s = cbv;
#pragma unroll
            for (int jj = 0; jj < 5; ++jj) s += cw[jj] * bf2f(RAWQ[(tl + jj) * 128 + cc]);
            s = siluf_(s); const int lpos = dir ? 63 - tl : tl;
            if (isK) Ks[lpos * 72 + d0] = (bf16)f2bf(s * 0.125f); else Qs[lpos * 72 + d0] = (bf16)f2bf(s); }
        if (tid < 64) { float run = 0.f, rm = -INFINITY, bl = 0.f;
            for (int s = 0; s < 64; ++s) { run += lf[s]; if (s <= tid) { rm = fmaxf(rm, li[s] - run); if (s == tid) bl = run; } }
            const float g = run - bl + li[tid]; const float mloc = wave_max(g);
            const float mqv = bl + fmaxf(m_st, rm);
            bcs[tid] = bl; gg[tid] = g; mq[tid] = mqv; iw[tid] = __expf(bl + m_st - mqv);
            if (tid == 0) { scal[0] = mloc; scal[1] = run; } }
        __syncthreads();
        const float mloc = scal[0], blast = scal[1];
        for (int idx = tid; idx < 4096; idx += 512) { const int lp = idx >> 6, d = idx & 63; KWt[d * 72 + lp] = (bf16)f2bf(bf2f(Ks[lp * 72 + d]) * __expf(gg[lp] - mloc)); }
#pragma unroll
        for (int k = 0; k < 2; ++k) { const int ti = 2 * wave + k, tl_ = ti >> 2, ts = ti & 3; f32x4 acc = {0.f, 0.f, 0.f, 0.f};
            if (ts <= tl_) acc = mma16<64>(Qs + tl_ * 16 * 72, 72, Ks + ts * 16 * 72, 72, acc, lane);
#pragma unroll
            for (int jj = 0; jj < 4; ++jj) { const int lr = tl_ * 16 + (lane >> 4) * 4 + jj, s = ts * 16 + (lane & 15);
                const float v = (s <= lr) ? acc[jj] * __expf(bcs[lr] - bcs[s] + li[s] - mq[lr]) : 0.f; Ps[lr * 72 + s] = (bf16)f2bf(v); } }
        __syncthreads();
        f32x4 a1[2], a2[2], lc[2];
#pragma unroll
        for (int k = 0; k < 2; ++k) { const int ti = 2 * wave + k, t0_ = ti >> 2, t1_ = ti & 3; const f32x4 z = {0.f, 0.f, 0.f, 0.f};
            a1[k] = mma16<64>(Ps + t0_ * 16 * 72, 72, Vt + t1_ * 16 * 72, 72, z, lane);
            a2[k] = mma16<64>(Qs + t0_ * 16 * 72, 72, Ct + t1_ * 16 * 72, 72, z, lane);
            lc[k] = mma16<64>(Vt + t0_ * 16 * 72, 72, KWt + t1_ * 16 * 72, 72, z, lane); }
        if (tid < 64) { float sp = 0.f, qn = 0.f, nl = 0.f;
            for (int s = 0; s < 64; ++s) { sp += bf2f(Ps[tid * 72 + s]); qn += bf2f(Qs[tid * 72 + s]) * nst[s]; nl += bf2f(KWt[tid * 72 + s]); }
            const float dn = sp + iw[tid] * qn; den[tid] = 1.f / fmaxf(fabsf(dn), __expf(-mq[tid])); nloc = nl; }
        __syncthreads();
        const float m_new = fmaxf(blast + m_st, mloc), s_old = __expf(blast + m_st - m_new), s_new = __expf(mloc - m_new);
#pragma unroll
        for (int k = 0; k < 2; ++k) { const int ti = 2 * wave + k, t0_ = ti >> 2, t1_ = ti & 3;
#pragma unroll
            for (int jj = 0; jj < 4; ++jj) { const int r_ = t0_ * 16 + (lane >> 4) * 4 + jj, c_ = t1_ * 16 + (lane & 15);
                const float val = (a1[k][jj] + iw[r_] * a2[k][jj]) * den[r_];
                const int t = dir ? tlo + 63 - r_ : tlo + r_;
                Y[(mb + t) * 256 + h * 64 + c_] = (bf16)f2bf(val);
                st[k][jj] = s_old * st[k][jj] + s_new * lc[k][jj];
                Ct[r_ * 72 + c_] = (bf16)f2bf(st[k][jj]); } }
        if (tid < 64) nst[tid] = s_old * nst[tid] + s_new * nloc;
        m_st = m_new;
        __syncthreads();
    }
}
__device__ __forceinline__ void phase_ssd_conv(const Frame& F, int l) {
    const bf16* cols = (const bf16*)(WSP(F) + WS_COLS); bf16* XBC = (bf16*)(WSP(F) + WS_XN);
    LAS bf16* raw = (LAS bf16*)(F.lds);
    const float* cwp = INP(F, 20) + (size_t)l * 5 * 896; const float* cbp = INP(F, 21) + l * 896;
    const int tid = F.tid;
    float cw0[5], cw1[5]; const int c1 = tid + 512 < 896 ? tid + 512 : tid;
#pragma unroll
    for (int jj = 0; jj < 5; ++jj) { cw0[jj] = cwp[jj * 896 + tid]; cw1[jj] = cwp[jj * 896 + c1]; }
    const float cb0 = cbp[tid], cb1 = cbp[c1];
    for (int tile = F.vcu; tile < M / 32; tile += F.G) {
        const int m0 = tile * 32, t0 = m0 % SEQ;
        __syncthreads();
        for (int ch = tid; ch < 36 * 112; ch += 512) { const int rr = ch / 112, cc = ch % 112; const int t = t0 - 2 + rr;
            v4u v = {0u, 0u, 0u, 0u}; if (t >= 0 && t < SEQ) v = *(const v4u*)(cols + (size_t)(m0 - 2 + rr) * NINP + S_X + cc * 8);
            *(LAS v4u*)(raw + rr * 896 + cc * 8) = v; }
        __syncthreads();
#pragma unroll
        for (int half = 0; half < 2; ++half) { const int c = half ? c1 : tid; if (half && tid + 512 >= 896) break;
            float win[5];
#pragma unroll
            for (int jj = 0; jj < 4; ++jj) win[jj] = bf2f(raw[jj * 896 + c]);
            for (int tl = 0; tl < 32; ++tl) { win[4] = bf2f(raw[(tl + 4) * 896 + c]);
                float s = half ? cb1 : cb0;
#pragma unroll
                for (int jj = 0; jj < 5; ++jj) s += (half ? cw1[jj] : cw0[jj]) * win[jj];
#pragma unroll
                for (int jj = 0; jj < 4; ++jj) win[jj] = win[jj + 1];
                XBC[(size_t)(m0 + tl) * 896 + c] = (bf16)f2bf(siluf_(s)); } }
    }
    __syncthreads();
}
__device__ __forceinline__ void ssd_seq(const Frame& F, int l, int task) {
    const int b = task / 12, rem = task % 12, head = rem >> 1, dir = rem & 1, g = head / 3;
    const bf16* cols = (const bf16*)(WSP(F) + WS_COLS); const bf16* XBC = (const bf16*)(WSP(F) + WS_XN);
    bf16* Y = (bf16*)(WSP(F) + (dir ? Y_SB : Y_SF));
    LAS bf16* Cm = (LAS bf16*)(F.lds); LAS bf16* Bm = (LAS bf16*)(F.lds + 17408);
    LAS bf16* Btw = (LAS bf16*)(F.lds + 34816); LAS bf16* Xt = (LAS bf16*)(F.lds + 53248);
    LAS bf16* Ps = (LAS bf16*)(F.lds + 62464); LAS bf16* Hs = (LAS bf16*)(F.lds + 71680);
    LAS float* dtvb = (LAS float*)(F.lds + 89088);
    LAS float* acsb = dtvb + 128;
    LAS float* totb = dtvb + 256;
    const int tid = F.tid, lane = F.lane, wave = F.wave;
    const size_t mb = (size_t)b * SEQ;
    constexpr int NC = SEQ / 64;
    __syncthreads();
    for (int i = tid; i < 64 * 136; i += 512) Hs[i] = 0;
    const float dtb = INP(F, 22)[(l * 2 + dir) * 6 + head];
    const float aneg = -__expf(INP(F, 23)[(l * 2 + dir) * 6 + head]);
    f32x4 st[4];
#pragma unroll
    for (int k = 0; k < 4; ++k) st[k] = (f32x4){0.f, 0.f, 0.f, 0.f};
    v4u pre[5]; float dtraw = 0.f;
#define SSD_ISSUE(c_) do { const int tlo_ = dir ? SEQ - 64 * ((c_) + 1) : 64 * (c_); _Pragma("unroll") for (int i_ = 0; i_ < 5; ++i_) { const int idx_ = tid + 512 * i_; const int tl_ = idx_ / 40, q_ = idx_ % 40; \
        const int gc_ = q_ < 8 ? head * 64 + q_ * 8 : (q_ < 24 ? 384 + g * 128 + (q_ - 8) * 8 : 640 + g * 128 + (q_ - 24) * 8); \
        pre[i_] = *(const v4u*)(XBC + (mb + tlo_ + tl_) * 896 + gc_); } } while (0)
#define SSD_DTLOAD(c_) do { if (tid < 64) { const int tlo_ = dir ? SEQ - 64 * ((c_) + 1) : 64 * (c_); const int t_ = dir ? tlo_ + 63 - tid : tlo_ + tid; dtraw = bf2f(cols[(mb + t_) * NINP + S_DT + dir * 6 + head]); } } while (0)
#define SSD_DTCALC(c_) do { if (tid < 64) { const float x_ = dtraw + dtb; const float dt_ = x_ > 20.f ? x_ : log1pf(__expf(x_)); float cs_ = dt_ * aneg; \
        _Pragma("unroll") for (int o_ = 1; o_ < 64; o_ <<= 1) { const float u_ = __shfl_up(cs_, o_); if (lane >= o_) cs_ += u_; } \
        const float tt_ = __shfl(cs_, 63); dtvb[((c_) & 1) * 64 + tid] = dt_; acsb[((c_) & 1) * 64 + tid] = cs_; if (tid == 0) totb[(c_) & 1] = tt_; } } while (0)
    SSD_ISSUE(0); SSD_DTLOAD(0); SSD_DTCALC(0); SSD_DTLOAD(1);
    __syncthreads();
#pragma unroll 1
    for (int c = 0; c < NC; ++c) {
        const int tlo = dir ? SEQ - 64 * (c + 1) : 64 * c;
        const LAS float* dtv = dtvb + (c & 1) * 64; const LAS float* acs = acsb + (c & 1) * 64; const float tot = totb[c & 1];
#pragma unroll
        for (int i = 0; i < 5; ++i) { const int idx = tid + 512 * i; const int tl = idx / 40, q = idx % 40; const int lp = dir ? 63 - tl : tl;
            const unsigned w[4] = {pre[i].x, pre[i].y, pre[i].z, pre[i].w};
            if (q < 8) {
#pragma unroll
                for (int k = 0; k < 4; ++k) { Xt[(q * 8 + 2 * k) * 72 + lp] = (bf16)(w[k] & 0xffffu); Xt[(q * 8 + 2 * k + 1) * 72 + lp] = (bf16)(w[k] >> 16); } }
            else if (q < 24) { const int n0 = (q - 8) * 8; *(LAS v4u*)(Bm + lp * 136 + n0) = pre[i]; const float sc = dtv[lp] * __expf(tot - acs[lp]);
#pragma unroll
                for (int k = 0; k < 4; ++k) { Btw[(n0 + 2 * k) * 72 + lp] = (bf16)f2bf(bf2f(w[k] & 0xffffu) * sc); Btw[(n0 + 2 * k + 1) * 72 + lp] = (bf16)f2bf(bf2f(w[k] >> 16) * sc); } }
            else { const int n0 = (q - 24) * 8; *(LAS v4u*)(Cm + lp * 136 + n0) = pre[i]; } }
        if (c + 1 < NC) SSD_ISSUE(c + 1);
        __syncthreads();
        f32x4 yo[2], lc[4];
#pragma unroll
        for (int k = 0; k < 2; ++k) { const int ti = 2 * wave + k, tl_ = ti >> 2, ts = ti & 3; f32x4 acc = {0.f, 0.f, 0.f, 0.f};
            if (ts <= tl_) acc = mma16<128>(Cm + tl_ * 16 * 136, 136, Bm + ts * 16 * 136, 136, acc, lane);
#pragma unroll
            for (int jj = 0; jj < 4; ++jj) { const int lr = tl_ * 16 + (lane >> 4) * 4 + jj, s = ts * 16 + (lane & 15);
                const float v = (s <= lr) ? acc[jj] * __expf(acs[lr] - acs[s]) * dtv[s] : 0.f; Ps[lr * 72 + s] = (bf16)f2bf(v); }
            const f32x4 z = {0.f, 0.f, 0.f, 0.f};
            yo[k] = mma16<128>(Cm + tl_ * 16 * 136, 136, Hs + ts * 16 * 136, 136, z, lane); }
#pragma unroll
        for (int k = 0; k < 4; ++k) { const int ti = 4 * wave + k, tp = ti >> 3, tn = ti & 7; const f32x4 z = {0.f, 0.f, 0.f, 0.f};
            lc[k] = mma16<64>(Xt + tp * 16 * 72, 72, Btw + tn * 16 * 72, 72, z, lane); }
        __syncthreads();
        const float cdec = __expf(tot);
#pragma unroll
        for (int k = 0; k < 2; ++k) { const int ti = 2 * wave + k, tl_ = ti >> 2, tp = ti & 3; const f32x4 z = {0.f, 0.f, 0.f, 0.f};
            const f32x4 yd = mma16<64>(Ps + tl_ * 16 * 72, 72, Xt + tp * 16 * 72, 72, z, lane);
#pragma unroll
            for (int jj = 0; jj < 4; ++jj) { const int lr = tl_ * 16 + (lane >> 4) * 4 + jj, p = tp * 16 + (lane & 15);
                const float val = yd[jj] + yo[k][jj] * __expf(acs[lr]);
                const int t = dir ? tlo + 63 - lr : tlo + lr;
                Y[(mb + t) * 384 + head * 64 + p] = (bf16)f2bf(val); } }
#pragma unroll
        for (int k = 0; k < 4; ++k) { const int ti = 4 * wave + k, tp = ti >> 3, tn = ti & 7;
#pragma unroll
            for (int jj = 0; jj < 4; ++jj) { const int p = tp * 16 + (lane >> 4) * 4 + jj, n = tn * 16 + (lane & 15);
                st[k][jj] = cdec * st[k][jj] + lc[k][jj]; Hs[p * 136 + n] = (bf16)f2bf(st[k][jj]); } }
        if (c + 1 < NC) { SSD_DTCALC(c + 1); if (c + 2 < NC) SSD_DTLOAD(c + 2); }
        __syncthreads();
    }
#undef SSD_ISSUE
#undef SSD_DTLOAD
#undef SSD_DTCALC
}
__device__ __forceinline__ void phase_post(const Frame& F, int l) {
    const bf16* cols = (const bf16*)(WSP(F) + WS_COLS); bf16* MIX = (bf16*)(WSP(F) + WS_XN);
    const bf16* YAf = (const bf16*)(WSP(F) + Y_AF); const bf16* YAb = (const bf16*)(WSP(F) + Y_AB);
    const bf16* YRf = (const bf16*)(WSP(F) + Y_RF); const bf16* YRb = (const bf16*)(WSP(F) + Y_RB);
    const bf16* YSf = (const bf16*)(WSP(F) + Y_SF); const bf16* YSb = (const bf16*)(WSP(F) + Y_SB);
    const float* CT = (const float*)(WSP(F) + WS_CT);
    LAS float* sg = (LAS float*)(F.lds);
    LAS float* gate = (LAS float*)(F.lds + 8192);
    const int tid = F.tid, lane = F.lane, wave = F.wave;
    const float* mup = INP(F, 8) + l * 1472; const float* mun = INP(F, 9) + l * 1472;
    const float* gup = INP(F, 14) + (size_t)l * 128 * 384;
    const float* mng = INP(F, 7) + l * 256; const float* rng = INP(F, 18) + l * 384; const float* rnb = INP(F, 19) + l * 384;
    const float* scb = INP(F, 21) + l * 896; const float* scw = INP(F, 20) + (size_t)l * 5 * 896; const float* sdk = INP(F, 24) + l * 6; const float* sng = INP(F, 25) + l * 384;
    for (int tile = F.vcu; tile < M / 16; tile += F.G) {
        const int m0 = tile * 16;
        __syncthreads();
        for (int idx = tid; idx < 16 * 128; idx += 512) { const int tt = idx >> 7, i = idx & 127; const int m = m0 + tt, t = m % SEQ;
            const float p1 = bf2f(cols[(size_t)m * NINP + R_GD + i]);
            const float p0 = t > 0 ? bf2f(cols[(size_t)(m - 1) * NINP + R_GD + i]) : 0.f;
            const float p2 = t < SEQ - 1 ? bf2f(cols[(size_t)(m + 1) * NINP + R_GD + i]) : 0.f;
            sg[idx] = sigmoidf_(p1 + mup[1344 + i] * (p0 - p1) + mun[1344 + i] * (p2 - p1)); }
        __syncthreads();
        if (tid < 384) { float acc[16];
#pragma unroll
            for (int tt = 0; tt < 16; ++tt) acc[tt] = 0.f;
            for (int i = 0; i < 128; ++i) { const float w = gup[i * 384 + tid];
#pragma unroll
                for (int tt = 0; tt < 16; ++tt) acc[tt] += sg[tt * 128 + i] * w; }
#pragma unroll
            for (int tt = 0; tt < 16; ++tt) gate[tt * 384 + tid] = acc[tt]; }
        __syncthreads();
#pragma unroll 1
        for (int k = 0; k < 2; ++k) { const int tt = wave * 2 + k; const int m = m0 + tt, t = m % SEQ; const size_t cr = (size_t)m * NINP;
#pragma unroll
            for (int i = 0; i < 4; ++i) { const int col = i * 64 + lane;
                const float hs = bf2f(YAf[(size_t)m * 256 + col]) + bf2f(YAb[(size_t)m * 256 + col]);
                const float mean = wave_sum(hs) * (1.f / 64.f); const float d = hs - mean; const float var = wave_sum(d * d) * (1.f / 64.f);
                const float y = d * (1.f / sqrtf(var + 1e-6f)) * mng[col];
                MIX[(size_t)m * DM + col] = (bf16)f2bf(y * sigmoidf_(bf2f(cols[cr + A_O + col]))); }
#pragma unroll
            for (int i = 0; i < 6; ++i) { const int col = i * 64 + lane;
                const float ys = bf2f(YRf[(size_t)m * 384 + col]) + bf2f(YRb[(size_t)m * 384 + col]);
                const float mean = wave_sum(ys) * (1.f / 64.f); const float d = ys - mean; const float var = wave_sum(d * d) * (1.f / 64.f);
                const float y = d * (1.f / sqrtf(var + 64e-5f)) * rng[col] + rnb[col];
                const float p1 = bf2f(cols[cr + R_V + col]);
                const float p0 = t > 0 ? bf2f(cols[cr - NINP + R_V + col]) : 0.f;
                const float p2 = t < SEQ - 1 ? bf2f(cols[cr + NINP + R_V + col]) : 0.f;
                const float vv = p1 + mup[768 + col] * (p0 - p1) + mun[768 + col] * (p2 - p1);
                const float bonus = CT[(size_t)m * 8 + i] * vv;
                MIX[(size_t)m * DM + 256 + col] = (bf16)f2bf((y + bonus) * gate[tt * 384 + col]); }
            float yv[6]; float ssq[2] = {0.f, 0.f};
#pragma unroll
            for (int i = 0; i < 6; ++i) { const int col = i * 64 + lane;
                float s = scb[col];
#pragma unroll
                for (int jj = 0; jj < 5; ++jj) { const int tq = t + jj - 2; if (tq >= 0 && tq < SEQ) s += scw[jj * 896 + col] * bf2f(cols[cr + (jj - 2) * NINP + S_X + col]); }
                const float xc = siluf_(s);
                float y = bf2f(YSf[(size_t)m * 384 + col]) + bf2f(YSb[(size_t)m * 384 + col]) + sdk[i] * xc;
                y *= siluf_(bf2f(cols[cr + S_Z + col]));
                yv[i] = y; ssq[i / 3] += y * y; }
            const float r0 = 1.f / sqrtf(wave_sum(ssq[0]) * (1.f / 192.f) + 1e-6f), r1 = 1.f / sqrtf(wave_sum(ssq[1]) * (1.f / 192.f) + 1e-6f);
#pragma unroll
            for (int i = 0; i < 6; ++i) { const int col = i * 64 + lane;
                MIX[(size_t)m * DM + 640 + col] = (bf16)f2bf(yv[i] * (i < 3 ? r0 : r1) * sng[col]); }
        }
    }
    __syncthreads();
}
namespace cg = cooperative_groups;
constexpr int N_PHASES = 9 * DEPTH + 1;
__global__ void __launch_bounds__(NWAVES * 64, 2) mk_fwd(Args args) {
    extern __shared__ __attribute__((aligned(16))) unsigned char lds_raw[];
    Frame F;
    F.lds = (LAS unsigned char*)lds_raw;
    F.tid = threadIdx.x; F.lane = F.tid & 63; F.wave = __builtin_amdgcn_readfirstlane(F.tid >> 6);
    F.G = gridDim.x; { const int bx = blockIdx.x; F.vcu = (F.G % 8 == 0) ? (bx % 8) * (F.G / 8) + bx / 8 : bx; }
    volatile LAS unsigned* MISC = (volatile LAS unsigned*)(F.lds + MISC_OFF);
    if (F.tid < 64) MISC[F.tid] = 0u;
    if (F.tid < 34) *(LAS unsigned long long*)(F.lds + PTAB_OFF + 8 * F.tid) = ((const unsigned long long*)__builtin_amdgcn_kernarg_segment_ptr())[F.tid];
    __syncthreads();
    unsigned* ctl = (unsigned*)(WSP(F) + WS_CTL);
    XcdBarrier bar = xcd_barrier_post(ctl + CW_BAR, MISC + 8);
    const int lo = args.ph_lo, hi = args.ph_hi;
#define IN_(k) (lo <= (k) && (k) < hi)
#define SEAM(k) do { if (IN_(k) && IN_((k) + 1)) { if ((k) == 0) cg::this_grid().sync(); else xcd_barrier(bar); } } while (0)
#define LAYER(l, B) \
    if (IN_(B + 0)) { phase_convert(F, l); phase_norm(F, l == 0 ? INP(F, 0) : OUTP(F), INP(F, 1) + l * DM, (bf16*)(WSP(F) + WS_XN)); } SEAM(B + 0); \
    if (IN_(B + 1)) { unsigned char* ws = WSP(F); pg8::Gemm g{(const bf16*)(ws + WS_XN), (const bf16*)(ws + WS_WIN), M, NINP, DM}; pg8::StaticOrder S; S.init(M, NINP, F.G, (int)blockIdx.x); \
            pg8::EpiBf16<0> E{(bf16*)(ws + WS_COLS), NINP, nullptr, 0, 0, 1.f}; \
            pg8::gemm_phase<pg8::EpiBf16<0>, pg8::StaticOrder, PG8_ALIGN, PG8_SP2>(F.lds, g, S, E); } SEAM(B + 1); \
    if (IN_(B + 2)) { phase_gates(F, l); phase_ssd_conv(F, l); } SEAM(B + 2); \
    if (IN_(B + 3)) { const int bx = blockIdx.x; \
            if (bx < 96) rwkv_scan(F, l, bx); else if (bx < 112) mlstm_seq(F, l, bx - 96); else if (bx < 136) ssd_seq(F, l, bx - 112); } SEAM(B + 3); \
    if (IN_(B + 4)) phase_post(F, l); SEAM(B + 4); \
    if (IN_(B + 5)) { unsigned char* ws = WSP(F); pg8::Gemm g{(const bf16*)(ws + WS_XN), (const bf16*)(ws + WS_WOUT), M, DM, DM}; pg8::StaticOrder S; S.init(M, DM, F.G, (int)blockIdx.x); \
            pg8::EpiResidual E{l == 0 ? INP(F, 0) : OUTP(F), OUTP(F), DM}; \
            pg8::gemm_phase<pg8::EpiResidual, pg8::StaticOrder, PG8_ALIGN, PG8_SP2>(F.lds, g, S, E); } SEAM(B + 5); \
    if (IN_(B + 6)) phase_norm(F, OUTP(F), INP(F, 27) + l * DM, (bf16*)(WSP(F) + WS_XN)); SEAM(B + 6); \
    if (IN_(B + 7)) { unsigned char* ws = WSP(F); pg8::Gemm g{(const bf16*)(ws + WS_XN), (const bf16*)(ws + WS_WGU), M, 2 * FFN, DM}; pg8::StaticOrder S; S.init(M, 2 * FFN, F.G, (int)blockIdx.x); \
            pg8::EpiSwiGLU E{(bf16*)(ws + WS_COLS), FFN}; \
            pg8::gemm_phase<pg8::EpiSwiGLU, pg8::StaticOrder, PG8_ALIGN, PG8_SP2>(F.lds, g, S, E); } SEAM(B + 7); \
    if (IN_(B + 8)) { unsigned char* ws = WSP(F); pg8::Gemm g{(const bf16*)(ws + WS_COLS), (const bf16*)(ws + WS_WDN), M, DM, FFN}; pg8::StaticOrder S; S.init(M, DM, F.G, (int)blockIdx.x); \
            pg8::EpiResidual E{OUTP(F), OUTP(F), DM}; \
            pg8::gemm_phase<pg8::EpiResidual, pg8::StaticOrder, PG8_ALIGN, PG8_SP2>(F.lds, g, S, E); } SEAM(B + 8);
    LAYER(0, 0)
    LAYER(1, 9)
    if (IN_(18)) phase_final_norm(F, OUTP(F), INP(F, 31));
#undef IN_
#undef SEAM
#undef LAYER
}

#ifndef MK_PER_PHASE
#define MK_PER_PHASE 0
#endif
extern "C" void kernel_launch(void* const* d_in, const int* in_sizes, int n_in, void* d_out, int out_size, void* d_ws, size_t ws_size, hipStream_t stream) {
    static int grid = 0;
    if (grid == 0) {
        int dev = 0, cus = 0;
        if (n_in != 32 || out_size != M * DM || ws_size < WS_END) { fprintf(stderr, "kernel_launch: unexpected shapes (n_in %d out %d ws %zu)\n", n_in, out_size, ws_size); grid = -1; return; }
        if (hipGetDevice(&dev) != hipSuccess || hipDeviceGetAttribute(&cus, hipDeviceAttributeMultiprocessorCount, dev) != hipSuccess) { grid = -1; return; }
        if (hipFuncSetAttribute((const void*)mk_fwd, hipFuncAttributeMaxDynamicSharedMemorySize, LDS_BYTES) != hipSuccess) { fprintf(stderr, "kernel_launch: hipFuncSetAttribute failed\n"); grid = -1; return; }
        int per_cu = 0;
        if (hipOccupancyMaxActiveBlocksPerMultiprocessor(&per_cu, (const void*)mk_fwd, NWAVES * 64, LDS_BYTES) != hipSuccess || per_cu < 1) { fprintf(stderr, "kernel_launch: occupancy query says %d\n", per_cu); }
        (void)hipGetLastError();
        grid = cus;
    }
    if (grid < 0) return;
    (void)hipMemsetAsync((char*)d_ws + WS_CTL, 0, CTL_ZERO_BYTES, stream);
    Args a{};
    for (int i = 0; i < 32; ++i) a.in[i] = (const float*)d_in[i];
    a.out = (float*)d_out; a.ws = (unsigned char*)d_ws;
#if MK_PER_PHASE
    for (int p = 0; p < N_PHASES; ++p) { a.ph_lo = p; a.ph_hi = p + 1; hipLaunchKernelGGL(mk_fwd, dim3(grid), dim3(NWAVES * 64), LDS_BYTES, stream, a); }
#else
    a.ph_lo = 0; a.ph_hi = N_PHASES;
    void* kargs[] = {&a};
    hipError_t e = hipLaunchCooperativeKernel((const void*)mk_fwd, dim3(grid), dim3(NWAVES * 64), kargs, LDS_BYTES, stream);
    if (e != hipSuccess) fprintf(stderr, "cooperative launch failed: %s (grid %d)\n", hipGetErrorString(e), grid);
#endif
}
```

```cpp
#include <hip/hip_runtime.h>
#include <hip/hip_cooperative_groups.h>
#include <cstdio>
#include <cstdint>
namespace pg8 {
#define PG8_LAS __attribute__((address_space(3)))
typedef unsigned short bf16_t;
typedef short bf16x8 __attribute__((ext_vector_type(8)));
typedef float f32x4 __attribute__((ext_vector_type(4)));
typedef unsigned u32x4 __attribute__((ext_vector_type(4)));
constexpr int BM = 256, BK = 64, HALF = 128, HTB = HALF * BK * 2  , STAGE_BYTES = 8 * HTB, NXCD = 8, WGM = 8;

__host__ __device__ __forceinline__ int lds_byte(int r, int c) { const int st = (r >> 4) * 2 + (c >> 5), rr = r & 15, cc = c & 31, ob = rr * 64 + cc * 2; return st * 1024 + (ob ^ (((ob >> 9) & 1) << 5)); }
__host__ __device__ __forceinline__ void stage_rc(int b, int& R, int& C) { const int st = b / 1024, sb = b % 1024, swz = sb ^ (((sb >> 9) & 1) << 5); R = (st >> 1) * 16 + swz / 64; C = (st & 1) * 32 + (swz % 64) / 2; }
__host__ __device__ __forceinline__ int perm32(int rho) { const int n = rho >> 4, i = rho & 15; return 8 * (i >> 2) + 4 * n + (i & 3); }

struct Unit { int pm, pn; };
struct Gemm { const bf16_t* A; const bf16_t* Bt; int M, N, K; };

struct StaticOrder {
    int nM, nN, nwg, G, c;
    __host__ __device__ void init(int M, int N, int G_, int c_) { nM = M / BM; nN = N / BM; nwg = nM * nN; G = G_; c = c_; }
    __host__ __device__ bool next(int i, Unit& u) const {
        const long L = (long)i * G + c; if (L >= nwg) return false;
        int wgid = (int)L; { const int q = nwg / NXCD, r = nwg % NXCD, xcd = wgid % NXCD, off = wgid / NXCD; wgid = (xcd < r ? xcd * (q + 1) : r * (q + 1) + (xcd - r) * q) + off; }
        const int nig = WGM * nN, gid = wgid / nig, fm = gid * WGM, gsz = (nM - fm) < WGM ? (nM - fm) : WGM;
        u.pm = fm + ((wgid % nig) % gsz); u.pn = (wgid % nig) / gsz; return true;
    }
    __device__ __forceinline__ void a_ready(const Unit&) const {}
    __device__ __forceinline__ void done(const Unit&) const {}
};

__device__ __forceinline__ unsigned cvt_pk_bf16(float lo, float hi) { unsigned r; asm volatile("v_cvt_pk_bf16_f32 %0, %1, %2" : "=v"(r) : "v"(lo), "v"(hi)); return r; }
typedef float f32x2 __attribute__((ext_vector_type(2)));
__device__ __forceinline__ f32x2 gelu_pk(f32x2 v) {
    const f32x2 av = __builtin_elementwise_abs(v), d = av * 0.2316418882f + 1.0f;
    f32x2 t; t.x = __builtin_amdgcn_rcpf(d.x); t.y = __builtin_amdgcn_rcpf(d.y);
    f32x2 q = t * 0.5307027145f + (-0.7265760135f); q = q * t + 0.7107068705f; q = q * t + (-0.142248368f); q = q * t + 0.127414796f; q = q * t;
    const f32x2 s = (v * v) * (-0.72134752044f);
    f32x2 e; e.x = __builtin_amdgcn_exp2f(s.x); e.y = __builtin_amdgcn_exp2f(s.y);
    const f32x2 m = v * (q * e), r = v - m;
    f32x2 o; o.x = v.x < 0.f ? m.x : r.x; o.y = v.y < 0.f ? m.y : r.y; return o;
}

template <int ACT  > struct EpiBf16 {
    static constexpr bool PERM = true, AFTER_DRAIN = false; static_assert(ACT == 0 || ACT == 1, "EpiBf16: ACT is 0 (none) or 1 (gelu_pk)");
    bf16_t* O; int ldc; const float* bias; int split_cols; size_t split_stride; float scale0;
    __device__ __forceinline__ void operator()(const f32x4 (&acc)[2][2][4][2], const Unit& u, int wr, int wc, int fr, int fq) const {
        const int row0 = u.pm * BM + wr * 64 + fr; int colt = u.pn * BM; bf16_t* base = O;
        float sc = 1.f; if (split_cols) { const int t = colt / split_cols; base += (size_t)t * split_stride; colt -= t * split_cols; if (t == 0) sc = scale0; }
        const int col0 = colt + wc * 32 + 8 * fq, bcol0 = u.pn * BM + wc * 32 + 8 * fq;
        f32x4 bv[2][2];
#pragma unroll
        for (int bj = 0; bj < 2; ++bj)
#pragma unroll
            for (int n = 0; n < 2; ++n) bv[bj][n] = bias ? *(const f32x4*)(bias + bcol0 + bj * HALF + 4 * n) : (f32x4){0.f, 0.f, 0.f, 0.f};
#pragma unroll
        for (int ai = 0; ai < 2; ++ai)
#pragma unroll
            for (int m = 0; m < 4; ++m) { bf16_t* rowp = base + (size_t)(row0 + ai * HALF + m * 16) * ldc + col0;
#pragma unroll
                for (int bj = 0; bj < 2; ++bj) { f32x4 v0 = acc[ai][bj][m][0] + bv[bj][0], v1 = acc[ai][bj][m][1] + bv[bj][1];
                    if (ACT == 1) { f32x2 a = gelu_pk((f32x2){v0[0], v0[1]}), b = gelu_pk((f32x2){v0[2], v0[3]}), c = gelu_pk((f32x2){v1[0], v1[1]}), d = gelu_pk((f32x2){v1[2], v1[3]});
                        v0 = (f32x4){a.x, a.y, b.x, b.y}; v1 = (f32x4){c.x, c.y, d.x, d.y}; }
                    v0 = v0 * sc; v1 = v1 * sc; u32x4 w; w.x = cvt_pk_bf16(v0[0], v0[1]); w.y = cvt_pk_bf16(v0[2], v0[3]); w.z = cvt_pk_bf16(v1[0], v1[1]); w.w = cvt_pk_bf16(v1[2], v1[3]);
                    *(u32x4*)(rowp + bj * HALF) = w; } }
    }
};
struct EpiResidual {
    static constexpr bool PERM = false, AFTER_DRAIN = false;
    const float* base; float* out; int ldc;
    __device__ __forceinline__ void operator()(const f32x4 (&acc)[2][2][4][2], const Unit& u, int wr, int wc, int fr, int fq) const {
        const int col0 = u.pn * BM + wc * 32 + 4 * fq;
#pragma unroll
        for (int ai = 0; ai < 2; ++ai)
#pragma unroll
            for (int m = 0; m < 4; ++m) { const size_t off = (size_t)(u.pm * BM + ai * HALF + wr * 64 + m * 16 + fr) * ldc + col0;
#pragma unroll
                for (int bj = 0; bj < 2; ++bj)
#pragma unroll
                    for (int n = 0; n < 2; ++n) { const f32x4 bs = *(const f32x4*)(base + off + bj * HALF + n * 16); *(f32x4*)(out + off + bj * HALF + n * 16) = bs + acc[ai][bj][m][n]; }
                asm volatile("" ::: "memory"); }
    }
};
struct EpiSwiGLU {
    static constexpr bool PERM = true, AFTER_DRAIN = false;
    bf16_t* O; int ldc;
    __device__ __forceinline__ void operator()(const f32x4 (&acc)[2][2][4][2], const Unit& u, int wr, int wc, int fr, int fq) const {
        const int col0 = u.pn * HALF + wc * 32 + 8 * fq;
#pragma unroll
        for (int ai = 0; ai < 2; ++ai)
#pragma unroll
            for (int m = 0; m < 4; ++m) { bf16_t* rowp = O + (size_t)(u.pm * BM + ai * HALF + wr * 64 + m * 16 + fr) * ldc + col0;
                float r[8];
#pragma unroll
                for (int n = 0; n < 2; ++n)
#pragma unroll
                    for (int j = 0; j < 4; ++j) { const float g = acc[ai][0][m][n][j], up = acc[ai][1][m][n][j]; r[n * 4 + j] = g * __builtin_amdgcn_rcpf(1.f + __expf(-g)) * up; }
                u32x4 w; w.x = cvt_pk_bf16(r[0], r[1]); w.y = cvt_pk_bf16(r[2], r[3]); w.z = cvt_pk_bf16(r[4], r[5]); w.w = cvt_pk_bf16(r[6], r[7]);
                *(u32x4*)rowp = w; }
    }
};
template <class Epi, class Sched, bool ALIGN_EPI = false, bool SP2 = false>
__device__ __forceinline__ void gemm_phase(PG8_LAS unsigned char* lds, const Gemm g, const Sched& S, const Epi& E) {
    const int tid = threadIdx.x, wid = __builtin_amdgcn_readfirstlane(tid >> 6), lane = tid & 63, wr = wid >> 2, wc = wid & 3, fr = lane & 15, fq = lane >> 4;
    const int K = g.K, nt = K / BK;
    unsigned voffA[2], voffB[2];
#pragma unroll
    for (int i = 0; i < 2; ++i) { int R, C; stage_rc(tid * 16 + i * 8192, R, C); const int Rb = Epi::PERM ? ((R & ~31) + perm32(R & 31)) : R;
        voffA[i] = (unsigned)(R * K + C) * 2u; voffB[i] = (unsigned)(Rb * K + C) * 2u; }
    const size_t kstep = (size_t)(BK * 2);
    const size_t hstep = (size_t)HALF * K * 2;
    const size_t tstep = 2 * hstep;
    const unsigned ldsw = (unsigned)wid * 1024u;
    const int aoff = lds_byte(wr * 64 + fr, fq * 8), boff = lds_byte(wc * 32 + fr, fq * 8);
#define PG8_SA(b, h) (((b) * 2 + (h)) * HTB)
#define PG8_SB(b, h) ((4 + (b) * 2 + (h)) * HTB)
#define PG8_STAGE(bufoff, gbase, voff) do { _Pragma("unroll") for (int _i = 0; _i < 2; ++_i) \
        __builtin_amdgcn_global_load_lds((const unsigned*)((const char*)(gbase) + (voff)[_i]), (PG8_LAS unsigned*)(lds + (bufoff) + ldsw + _i * 8192), 16, 0, 0); } while (0)
#define PG8_LDA(dst, b, h) do { _Pragma("unroll") for (int m = 0; m < 4; ++m) _Pragma("unroll") for (int k = 0; k < 2; ++k) dst[m][k] = *(const PG8_LAS bf16x8*)(lds + PG8_SA(b, h) + aoff + m * 2048 + k * 1024); } while (0)
#define PG8_LDB(dst, b, h) do { _Pragma("unroll") for (int n = 0; n < 2; ++n) _Pragma("unroll") for (int k = 0; k < 2; ++k) dst[n][k] = *(const PG8_LAS bf16x8*)(lds + PG8_SB(b, h) + boff + n * 2048 + k * 1024); } while (0)
#define PG8_MMA(ai, bj, At, Bt) do { __builtin_amdgcn_s_setprio(1); _Pragma("unroll") for (int m = 0; m < 4; ++m) _Pragma("unroll") for (int n = 0; n < 2; ++n) _Pragma("unroll") for (int k = 0; k < 2; ++k) \
        acc[ai][bj][m][n] = __builtin_amdgcn_mfma_f32_16x16x32_bf16(Bt[n][k], At[m][k], acc[ai][bj][m][n], 0, 0, 0); __builtin_amdgcn_s_setprio(0); } while (0)
#define PG8_WAIT_V(n) asm volatile("s_waitcnt vmcnt(" #n ")" ::: "memory")
#define PG8_WAIT_L(n) asm volatile("s_waitcnt lgkmcnt(" #n ")" ::: "memory")
#define PG8_BAR __builtin_amdgcn_s_barrier()
#define PG8_SCHED __builtin_amdgcn_sched_barrier(0)
    Unit cur, nxt; int ui = 0;
    if (!S.next(0, cur)) return;
    f32x4 acc[2][2][4][2];
#pragma unroll
    for (int a = 0; a < 2; ++a)
#pragma unroll
        for (int b = 0; b < 2; ++b)
#pragma unroll
            for (int m = 0; m < 4; ++m)
#pragma unroll
                for (int n = 0; n < 2; ++n) acc[a][b][m][n] = (f32x4){0.f, 0.f, 0.f, 0.f};
    bf16x8 At[4][2], B0[2][2], B1[2][2];
    const char* cA = (const char*)g.A + (size_t)cur.pm * tstep; const char* cB = (const char*)g.Bt + (size_t)cur.pn * tstep;
    S.a_ready(cur);
    if constexpr (SP2) {
        PG8_STAGE(PG8_SB(0, 0), cB, voffB); PG8_STAGE(PG8_SB(0, 1), cB + hstep, voffB); PG8_STAGE(PG8_SA(0, 0), cA, voffA); PG8_STAGE(PG8_SA(0, 1), cA + hstep, voffA);
        if (wr == 1) PG8_BAR;
        PG8_WAIT_V(2); PG8_BAR;
        PG8_STAGE(PG8_SB(1, 0), cB + kstep, voffB); PG8_STAGE(PG8_SA(1, 0), cA + kstep, voffA); PG8_STAGE(PG8_SB(1, 1), cB + hstep + kstep, voffB);
        PG8_WAIT_V(6); PG8_BAR;
    } else {
        PG8_STAGE(PG8_SB(0, 0), cB, voffB); PG8_STAGE(PG8_SA(0, 0), cA, voffA); PG8_STAGE(PG8_SB(0, 1), cB + hstep, voffB); PG8_STAGE(PG8_SA(0, 1), cA + hstep, voffA);
        if (wr == 1) PG8_BAR;
        PG8_WAIT_V(4); PG8_BAR;
        PG8_STAGE(PG8_SB(1, 0), cB + kstep, voffB); PG8_STAGE(PG8_SA(1, 0), cA + kstep, voffA); PG8_STAGE(PG8_SB(1, 1), cB + hstep + kstep, voffB);
        PG8_WAIT_V(6); PG8_BAR;
    }
    for (;;) {
        const bool has_next = S.next(ui + 1, nxt);
        const char* nA = has_next ? (const char*)g.A + (size_t)nxt.pm * tstep : cA; const char* nB = has_next ? (const char*)g.Bt + (size_t)nxt.pn * tstep : cB;
        for (int t = 0; t < nt; t += 2) {
            const bool last = (t == nt - 2);
            const char* a1 = cA + (size_t)(t + 1) * kstep;
            const char* a2 = last ? nA : cA + (size_t)(t + 2) * kstep; const char* b2 = last ? nB : cB + (size_t)(t + 2) * kstep;
            const char* a3 = a2 + kstep; const char* b3 = b2 + kstep;
            if (last && has_next) S.a_ready(nxt);
            if constexpr (SP2) {
            PG8_LDB(B0, 0, 0); PG8_LDB(B1, 0, 1); PG8_SCHED; PG8_LDA(At, 0, 0); PG8_STAGE(PG8_SA(1, 1), a1 + hstep, voffA);
            PG8_WAIT_V(8); PG8_WAIT_L(0); PG8_BAR; PG8_MMA(0, 0, At, B0); PG8_MMA(0, 1, At, B1); PG8_BAR; PG8_SCHED;
            PG8_LDA(At, 0, 1); PG8_STAGE(PG8_SB(0, 0), b2, voffB); PG8_STAGE(PG8_SB(0, 1), b2 + hstep, voffB); PG8_STAGE(PG8_SA(0, 0), a2, voffA);
            PG8_WAIT_V(8); PG8_WAIT_L(0); PG8_BAR; PG8_MMA(1, 0, At, B0); PG8_MMA(1, 1, At, B1); PG8_BAR; PG8_SCHED;
            PG8_LDB(B0, 1, 0); PG8_LDB(B1, 1, 1); PG8_SCHED; PG8_LDA(At, 1, 0); PG8_STAGE(PG8_SA(0, 1), a2 + hstep, voffA);
            PG8_WAIT_V(8); PG8_WAIT_L(0); PG8_BAR; PG8_MMA(0, 0, At, B0); PG8_MMA(0, 1, At, B1); PG8_BAR; PG8_SCHED;
            PG8_LDA(At, 1, 1); PG8_STAGE(PG8_SB(1, 0), b3, voffB); PG8_STAGE(PG8_SB(1, 1), b3 + hstep, voffB); PG8_STAGE(PG8_SA(1, 0), a3, voffA);
            PG8_WAIT_V(8); PG8_WAIT_L(0); PG8_BAR; PG8_MMA(1, 0, At, B0); PG8_MMA(1, 1, At, B1); PG8_BAR; PG8_SCHED;
            } else {
            PG8_LDB(B0, 0, 0); PG8_SCHED; PG8_LDA(At, 0, 0); PG8_STAGE(PG8_SA(1, 1), a1 + hstep, voffA);
            PG8_WAIT_L(8); PG8_BAR; PG8_WAIT_L(0); PG8_MMA(0, 0, At, B0); PG8_BAR; PG8_SCHED;
            PG8_LDB(B1, 0, 1); PG8_STAGE(PG8_SB(0, 0), b2, voffB);
            PG8_BAR; PG8_WAIT_L(0); PG8_MMA(0, 1, At, B1); PG8_BAR;
            PG8_LDA(At, 0, 1); PG8_STAGE(PG8_SA(0, 0), a2, voffA);
            PG8_BAR; PG8_WAIT_L(0); PG8_MMA(1, 0, At, B0); PG8_BAR; PG8_SCHED;
            PG8_STAGE(PG8_SB(0, 1), b2 + hstep, voffB);
            PG8_WAIT_V(6); PG8_BAR; PG8_MMA(1, 1, At, B1); PG8_BAR;
            PG8_LDB(B0, 1, 0); PG8_SCHED; PG8_LDA(At, 1, 0); PG8_STAGE(PG8_SA(0, 1), a2 + hstep, voffA);
            PG8_WAIT_L(8); PG8_BAR; PG8_WAIT_L(0); PG8_MMA(0, 0, At, B0); PG8_BAR; PG8_SCHED;
            PG8_LDB(B1, 1, 1); PG8_STAGE(PG8_SB(1, 0), b3, voffB);
            PG8_BAR; PG8_WAIT_L(0); PG8_MMA(0, 1, At, B1); PG8_BAR;
            PG8_LDA(At, 1, 1); PG8_STAGE(PG8_SA(1, 0), a3, voffA);
            PG8_BAR; PG8_WAIT_L(0); PG8_MMA(1, 0, At, B0); PG8_BAR; PG8_SCHED;
            PG8_STAGE(PG8_SB(1, 1), b3 + hstep, voffB);
            PG8_WAIT_V(6); PG8_BAR; PG8_MMA(1, 1, At, B1); PG8_BAR;
            }
        }
        if constexpr (ALIGN_EPI) { if (wr == 0) PG8_BAR; }
        if constexpr (!Epi::AFTER_DRAIN) { E(acc, cur, wr, wc, fr, fq); S.done(cur); }
        if (!has_next) break;
#pragma unroll
        for (int a = 0; a < 2; ++a)
#pragma unroll
            for (int b = 0; b < 2; ++b)
#pragma unroll
                for (int m = 0; m < 4; ++m)
#pragma unroll
                    for (int n = 0; n < 2; ++n) acc[a][b][m][n] = (f32x4){0.f, 0.f, 0.f, 0.f};
        cur = nxt; cA = nA; cB = nB; ++ui;
        if constexpr (ALIGN_EPI) { if (wr == 1) PG8_BAR; }
    }
    PG8_WAIT_V(0);
    if constexpr (!ALIGN_EPI) { if (wr == 0) PG8_BAR; }
    PG8_BAR;
    if constexpr (Epi::AFTER_DRAIN) { E.fused(acc, cur, wr, wc, fr, fq, lds, wid, lane); S.done(cur); }
#undef PG8_SA
#undef PG8_SB
#undef PG8_STAGE
#undef PG8_LDA
#undef PG8_LDB
#undef PG8_MMA
#undef PG8_WAIT_V
#undef PG8_WAIT_L
#undef PG8_BAR
#undef PG8_SCHED
}
}

#ifndef PG8_SP2
#define PG8_SP2 true
#endif
#define PG8_ALIGN true
constexpr int NWAVES = 8;
constexpr int BATCH = 2, SEQ = 8192, DM = 1024, M = BATCH * SEQ, NIN = 3788, NINP = 3840, FFN = 2816, DEPTH = 2;
constexpr int A_Q = 0, A_K = 256, A_V = 512, A_O = 768;
constexpr int R_R = 1024, R_K = 1408, R_V = 1792, R_WDF = 2176, R_AD = 2304, R_GD = 2368;
constexpr int S_Z = 2496, S_X = 2880, S_B = 3264, S_C = 3520, S_DT = 3776;
constexpr size_t MiB = 1u << 20;
constexpr size_t WS_CTL = 0, CTL_ZERO_BYTES = 64 * 1024;
constexpr size_t WS_GATES = 1 * MiB, WS_CT = 2 * MiB;
constexpr size_t WS_WIN = 4 * MiB, WS_WOUT = 12 * MiB, WS_WGU = 14 * MiB, WS_WDN = 25 * MiB;
constexpr size_t WS_XN = 32 * MiB, WS_COLS = 64 * MiB, WS_Y = 184 * MiB, WS_END = 248 * MiB;
constexpr size_t Y_AF = WS_Y, Y_AB = WS_Y + 8 * MiB, Y_RF = WS_Y + 16 * MiB, Y_RB = WS_Y + 28 * MiB, Y_SF = WS_Y + 40 * MiB, Y_SB = WS_Y + 52 * MiB;
constexpr int CW_BAR = 1024;
constexpr int RING_BYTES = 131072;
constexpr int LDS_BYTES = 147456, MISC_OFF = LDS_BYTES - 256;

#define GAS __attribute__((address_space(1)))
#define LAS __attribute__((address_space(3)))
typedef unsigned short bf16;
typedef unsigned v4u __attribute__((ext_vector_type(4)));
typedef unsigned v2u __attribute__((ext_vector_type(2)));
typedef float f32x4 __attribute__((ext_vector_type(4)));
typedef short bf16x8 __attribute__((ext_vector_type(8)));
typedef GAS unsigned gu32;
#define RLX_AGENT __ATOMIC_RELAXED, __HIP_MEMORY_SCOPE_AGENT
#define LDS_WAIT() asm volatile("s_waitcnt lgkmcnt(0)" ::: "memory")
#define VM_WAIT() asm volatile("s_waitcnt vmcnt(0)" ::: "memory")
__device__ __forceinline__ unsigned f2bf(float f) { unsigned u = __builtin_bit_cast(unsigned, f); return (u + 0x7fffu + ((u >> 16) & 1u)) >> 16; }
__device__ __forceinline__ unsigned pk2(float lo, float hi) { return f2bf(lo) | (f2bf(hi) << 16); }
__device__ __forceinline__ float bf2f(unsigned u) { return __builtin_bit_cast(float, u << 16); }
__device__ __forceinline__ float sigmoidf_(float x) { return __builtin_amdgcn_rcpf(1.f + __expf(-x)); }
__device__ __forceinline__ float siluf_(float x) { return x * sigmoidf_(x); }
__device__ __forceinline__ float wave_sum(float v) {
#pragma unroll
    for (int o = 1; o < 64; o <<= 1) v += __shfl_xor(v, o);
    return v;
}
__device__ __forceinline__ float wave_max(float v) {
#pragma unroll
    for (int o = 1; o < 64; o <<= 1) v = fmaxf(v, __shfl_xor(v, o));
    return v;
}
template <int CTRL> __device__ __forceinline__ float dppf(float v) { return __builtin_bit_cast(float, __builtin_amdgcn_update_dpp(0, __builtin_bit_cast(int, v), CTRL, 0xf, 0xf, true)); }
__device__ __forceinline__ float row16_sum(float v) { v += dppf<0xB1>(v); v += dppf<0x4E>(v); v += dppf<0x141>(v); v += dppf<0x140>(v); return v; }
template <int K> __device__ __forceinline__ f32x4 mma16(const LAS bf16* A, int lda, const LAS bf16* Bt, int ldb, f32x4 acc, int lane) {
    const int r = lane & 15, q = lane >> 4;
    const LAS bf16* ap = A + r * lda + q * 8; const LAS bf16* bp = Bt + r * ldb + q * 8;
#pragma unroll
    for (int k0 = 0; k0 < K; k0 += 32) {
        const bf16x8 a = *(const LAS bf16x8*)(ap + k0); const bf16x8 b = *(const LAS bf16x8*)(bp + k0);
        acc = __builtin_amdgcn_mfma_f32_16x16x32_bf16(a, b, acc, 0, 0, 0);
    }
    return acc;
}
#define XB_TMO      128
#define XB_XCNT(j)  (256  + 64 * (j))
#define XB_XSUB(j)  (1280 + 64 * (j))
#define XB_XGEN(j)  (2304 + 64 * (j))
#define XB_TOP      3328
#define XB_TOPGEN   3392
#define XCD_BAR_WORDS 3456
#define XB_SPIN_CAP (1u << 18)

__device__ __forceinline__ unsigned xb_ld(unsigned* p)              { return __hip_atomic_load(p, __ATOMIC_RELAXED, __HIP_MEMORY_SCOPE_AGENT); }
__device__ __forceinline__ unsigned xb_add(unsigned* p, unsigned v) { return __hip_atomic_fetch_add(p, v, __ATOMIC_RELAXED, __HIP_MEMORY_SCOPE_AGENT); }
__device__ __forceinline__ unsigned xb_xcc_id() { return (unsigned)__builtin_amdgcn_s_getreg((3 << 11) | 20) & 0xFu; }
#define XB_SPIN(cond, bar) do { unsigned _sp = 0; while (cond) { __builtin_amdgcn_s_sleep(1); \
    if ((++_sp & 255u) == 0u) { if (xb_ld(&(bar)[XB_TMO])) break; if (_sp > XB_SPIN_CAP) { atomicAdd(&(bar)[XB_TMO], 1u); break; } } } } while (0)

struct XcdBarrier {
    unsigned* bar; unsigned x;
    volatile LAS unsigned* st;
};

__device__ __forceinline__ XcdBarrier xcd_barrier_post(unsigned* bar, volatile LAS unsigned* st) {
    XcdBarrier b; b.bar = bar; b.x = xb_xcc_id(); b.st = st;
    if (threadIdx.x == 0) (void)xb_add(&bar[XB_XCNT(b.x)], 1u);
    return b;
}
__device__ __forceinline__ void xcd_barrier_complete(unsigned* bar, unsigned x, unsigned& nloc, unsigned& nx) {
    const unsigned G = gridDim.x * gridDim.y * gridDim.z;
    unsigned sum, cnt, mine, sp = 0u;
    for (;;) {
        sum = 0u; cnt = 0u; mine = 0u;
#pragma unroll
        for (unsigned j = 0; j < 16; ++j) { const unsigned c = xb_ld(&bar[XB_XCNT(j)]); sum += c; cnt += (c > 0u) ? 1u : 0u; mine = (j == x) ? c : mine; }
        if (sum == G) break;
        __builtin_amdgcn_s_sleep(1);
        if ((++sp & 255u) == 0u) { if (xb_ld(&bar[XB_TMO])) break; if (sp > XB_SPIN_CAP) { atomicAdd(&bar[XB_TMO], 1u); break; } }
    }
    nloc = mine > 0u ? mine : 1u; nx = cnt > 0u ? cnt : 1u;
}

__device__ __forceinline__ void xcd_barrier(const XcdBarrier& b) {
    asm volatile("s_waitcnt vmcnt(0)" ::: "memory");
    __syncthreads();
    if (threadIdx.x == 0) {
        unsigned* bar = b.bar;
        __builtin_amdgcn_s_waitcnt(0);
        unsigned nloc = b.st[0], nx = b.st[1];
        if (nloc == 0u) { xcd_barrier_complete(bar, b.x, nloc, nx); b.st[0] = nloc; b.st[1] = nx; }
        const unsigned old = xb_add(&bar[XB_XSUB(b.x)], 1u);
        const unsigned gen = old / nloc;
        if (old + 1u == (gen + 1u) * nloc) {
            __builtin_amdgcn_fence(__ATOMIC_RELEASE, "agent");
            asm volatile("s_waitcnt vmcnt(0)" ::: "memory");
            const unsigned og = xb_add(&bar[XB_TOP], 1u);
            const unsigned tg = og / nx;
            if (og + 1u == (tg + 1u) * nx) xb_add(&bar[XB_TOPGEN], 1u);
            else XB_SPIN(xb_ld(&bar[XB_TOPGEN]) == tg, bar);
            __builtin_amdgcn_fence(__ATOMIC_ACQUIRE, "agent");
            xb_add(&bar[XB_XGEN(b.x)], 1u);
            asm volatile("s_waitcnt vmcnt(0)" ::: "memory");
        } else {
            XB_SPIN(xb_ld(&bar[XB_XGEN(b.x)]) == gen, bar);
            __builtin_amdgcn_fence(__ATOMIC_ACQUIRE, "agent");
            asm volatile("s_waitcnt vmcnt(0)" ::: "memory");
        }
    }
    __syncthreads();
}
struct Frame {
    LAS unsigned char* lds;
    int tid, lane, wave, vcu, G;
};
struct Args { const float* in[32]; float* out; unsigned char* ws; int ph_lo, ph_hi; };
constexpr int PTAB_OFF = LDS_BYTES - 768;
__device__ __forceinline__ unsigned long long ptab_ld(const Frame& F, int i) {
    const unsigned long long v = *(volatile LAS unsigned long long*)(F.lds + PTAB_OFF + 8 * i);
    const unsigned lo = __builtin_amdgcn_readfirstlane((unsigned)v), hi = __builtin_amdgcn_readfirstlane((unsigned)(v >> 32));
    return ((unsigned long long)hi << 32) | lo;
}
__device__ __forceinline__ const float* INP(const Frame& F, int i) { return (const float*)ptab_ld(F, i); }
__device__ __forceinline__ unsigned char* WSP(const Frame& F) { return (unsigned char*)ptab_ld(F, 33); }
__device__ __forceinline__ float* OUTP(const Frame& F) { return (float*)ptab_ld(F, 32); }

__device__ __forceinline__ void transpose_item(const float* W, int K, int N, int nblk, bf16* WT, int mode, int row_off, LAS float* scr, int item, int lane) {
    const int kb = item / nblk, nb = item % nblk, k0 = 64 * kb, n0 = 32 * nb;
    const int ncol = n0 + (lane & 31); const bool ok = ncol < N;
#pragma unroll 8
    for (int i = 0; i < 32; ++i) { const int kk = 2 * i + (lane >> 5); scr[kk * 33 + (lane & 31)] = ok ? W[(size_t)(k0 + kk) * N + ncol] : 0.f; }
    LDS_WAIT(); asm volatile("" ::: "memory");
    const int c = lane & 7;
    const int drow0 = mode ? (256 * (n0 >> 7) + (n0 & 127) + row_off) : (row_off + n0);
#pragma unroll
    for (int j = 0; j < 4; ++j) { const int n = (lane >> 3) + 8 * j; const LAS float* s = scr + (8 * c) * 33 + n;
        v4u o; o.x = pk2(s[0 * 33], s[1 * 33]); o.y = pk2(s[2 * 33], s[3 * 33]); o.z = pk2(s[4 * 33], s[5 * 33]); o.w = pk2(s[6 * 33], s[7 * 33]);
        *(v4u*)(WT + (size_t)(drow0 + n) * K + k0 + 8 * c) = o; }
    LDS_WAIT(); asm volatile("" ::: "memory");
}
__device__ __forceinline__ void phase_convert(const Frame& F, int l) {
    LAS float* scr = (LAS float*)(F.lds + F.wave * 16384);
    const int gw = F.vcu * NWAVES + F.wave, NGW = F.G * NWAVES;
    bf16* Win = (bf16*)(WSP(F) + WS_WIN); bf16* Wout = (bf16*)(WSP(F) + WS_WOUT); bf16* Wgu = (bf16*)(WSP(F) + WS_WGU); bf16* Wdn = (bf16*)(WSP(F) + WS_WDN);
    constexpr int I_IN = 16 * 120, I_OUT = 16 * 32, I_G = 16 * 88, I_D = 44 * 32;
    constexpr int NITEMS = I_IN + I_OUT + 2 * I_G + I_D;
    for (int it = gw; it < NITEMS; it += NGW) {
        int r = it;
        if (r < I_IN) { transpose_item(INP(F, 2) + (size_t)l * DM * NIN, DM, NIN, 120, Win, 0, 0, scr, r, F.lane); continue; } r -= I_IN;
        if (r < I_OUT) { transpose_item(INP(F, 26) + (size_t)l * DM * DM, DM, DM, 32, Wout, 0, 0, scr, r, F.lane); continue; } r -= I_OUT;
        if (r < I_G) { transpose_item(INP(F, 28) + (size_t)l * DM * FFN, DM, FFN, 88, Wgu, 1, 0, scr, r, F.lane); continue; } r -= I_G;
        if (r < I_G) { transpose_item(INP(F, 29) + (size_t)l * DM * FFN, DM, FFN, 88, Wgu, 1, 128, scr, r, F.lane); continue; } r -= I_G;
        transpose_item(INP(F, 30) + (size_t)l * FFN * DM, FFN, DM, 32, Wdn, 0, 0, scr, r, F.lane);
    }
}
__device__ __forceinline__ void phase_norm(const Frame& F, const float* hin, const float* g, bf16* XN) {
    const int gw = F.vcu * NWAVES + F.wave, NGW = F.G * NWAVES;
    f32x4 gv[4];
#pragma unroll
    for (int j = 0; j < 4; ++j) gv[j] = ((const f32x4*)g)[64 * j + F.lane];
    for (int m = gw; m < M; m += NGW) {
        const f32x4* xr = (const f32x4*)(hin + (size_t)m * DM) + F.lane;
        f32x4 v[4]; float s = 0.f;
#pragma unroll
        for (int j = 0; j < 4; ++j) { v[j] = xr[64 * j]; s += (v[j].x * v[j].x + v[j].y * v[j].y) + (v[j].z * v[j].z + v[j].w * v[j].w); }
        const float r = 1.f / sqrtf(wave_sum(s) * (1.f / DM) + 1e-6f);
        v2u* o8 = (v2u*)(XN + (size_t)m * DM) + F.lane;
#pragma unroll
        for (int j = 0; j < 4; ++j) { v2u w; w.x = pk2(v[j].x * r * gv[j].x, v[j].y * r * gv[j].y); w.y = pk2(v[j].z * r * gv[j].z, v[j].w * r * gv[j].w); o8[64 * j] = w; }
    }
}
__device__ __forceinline__ void phase_final_norm(const Frame& F, float* h, const float* g) {
    const int gw = F.vcu * NWAVES + F.wave, NGW = F.G * NWAVES;
    f32x4 gv[4];
#pragma unroll
    for (int j = 0; j < 4; ++j) gv[j] = ((const f32x4*)g)[64 * j + F.lane];
    for (int m = gw; m < M; m += NGW) {
        f32x4* xr = (f32x4*)(h + (size_t)m * DM) + F.lane;
        f32x4 v[4]; float s = 0.f;
#pragma unroll
        for (int j = 0; j < 4; ++j) { v[j] = xr[64 * j]; s += (v[j].x * v[j].x + v[j].y * v[j].y) + (v[j].z * v[j].z + v[j].w * v[j].w); }
        const float r = 1.f / sqrtf(wave_sum(s) * (1.f / DM) + 1e-6f);
#pragma unroll
        for (int j = 0; j < 4; ++j) xr[64 * j] = v[j] * r * gv[j];
    }
}
__device__ __forceinline__ void phase_gates(const Frame& F, int l) {
    const bf16* cols = (const bf16*)(WSP(F) + WS_COLS); float* GT = (float*)(WSP(F) + WS_GATES);
    LAS bf16* raw = (LAS bf16*)(F.lds);
    LAS float* feat = (LAS float*)(F.lds + 32768);
    LAS float* gw = (LAS float*)(F.lds + 81920);
    const float* gwg = INP(F, 5) + (size_t)l * 768 * 16; const float* gb = INP(F, 6) + l * 16;
    const float* cw = INP(F, 3) + (size_t)l * 5 * 512; const float* cb = INP(F, 4) + l * 512;
    for (int i = F.tid; i < 768 * 16; i += 512) gw[i] = gwg[i];
    for (int tile = F.vcu; tile < M / 16; tile += F.G) {
        const int m0 = tile * 16, t0 = m0 % SEQ;
        __syncthreads();
        for (int ch = F.tid; ch < 20 * 96; ch += 512) { const int rr = ch / 96, cc = ch % 96; const int t = t0 - 2 + rr;
            v4u v = {0u, 0u, 0u, 0u}; if (t >= 0 && t < SEQ) v = *(const v4u*)(cols + (size_t)(m0 - 2 + rr) * NINP + cc * 8);
            *(LAS v4u*)(raw + rr * 768 + cc * 8) = v; }
        __syncthreads();
        for (int idx = F.tid; idx < 16 * 768; idx += 512) { const int t = idx / 768, c = idx % 768; float val;
            if (c < 512) { float s = cb[c];
#pragma unroll
                for (int j = 0; j < 5; ++j) s += cw[j * 512 + c] * bf2f(raw[(t + j) * 768 + c]);
                val = siluf_(s); } else val = bf2f(raw[(t + 2) * 768 + c]);
            feat[idx] = val; }
        __syncthreads();
        { const int t = F.tid >> 5, o = (F.tid >> 1) & 15, hf = F.tid & 1; float s = 0.f;
          const LAS float* fp = feat + t * 768 + hf * 384; const LAS float* wp = gw + (hf * 384) * 16 + o;
#pragma unroll 8
          for (int i = 0; i < 384; ++i) s += fp[i] * wp[i * 16];
          s += __shfl_xor(s, 1);
          if (hf == 0) { s += gb[o]; if (o >= 8) s = fminf(s, 0.f) - log1pf(__expf(-fabsf(s))); GT[(size_t)(m0 + t) * 16 + o] = s; } }
    }
    __syncthreads();
}
__device__ __forceinline__ f32x4 mma16_a8(const LAS bf16* A8, const LAS bf16* Bt, f32x4 acc, int lane) {
    const int q = lane >> 4;
    const LAS bf16* ap = A8 + (lane & 7) * 72 + q * 8; const LAS bf16* bp = Bt + (lane & 15) * 72 + q * 8;
#pragma unroll
    for (int k0 = 0; k0 < 64; k0 += 32) { const bf16x8 a = *(const LAS bf16x8*)(ap + k0); const bf16x8 b = *(const LAS bf16x8*)(bp + k0); acc = __builtin_amdgcn_mfma_f32_16x16x32_bf16(a, b, acc, 0, 0, 0); }
    return acc;
}
__device__ __forceinline__ void rwkv_scan(const Frame& F, int l, int task) {
    const int b = task / 48, rem = task % 48, h = rem >> 3, dir = (rem >> 2) & 1, qtr = rem & 3;
    const bf16* cols = (const bf16*)(WSP(F) + WS_COLS);
    bf16* Y = (bf16*)(WSP(F) + (dir ? Y_RB : Y_RF));
    float* CT = (float*)(WSP(F) + WS_CT);
    LAS bf16* WA = (LAS bf16*)(F.lds); LAS bf16* WW = (LAS bf16*)(F.lds + 9216);
    const int tid = F.tid, lane = F.lane, wave = F.wave;
    LAS bf16* XA = (LAS bf16*)(F.lds + 18432) + (wave & 3) * 576; LAS bf16* XW = (LAS bf16*)(F.lds + 23040) + (wave & 3) * 576;
    LAS bf16* RAWB = (LAS bf16*)(F.lds + 27648) + (wave & 3) * 3200;
    LAS float* MU = (LAS float*)(F.lds + 53248);
    LAS float* OPSb = (LAS float*)(F.lds + 55808);
    LAS float* VVb = (LAS float*)(F.lds + 137728);
    LAS float* YBb = (LAS float*)(F.lds + 141824);
    constexpr int NB = SEQ / 32;
    __syncthreads();
    { const float* aup = INP(F, 13) + (size_t)l * 64 * 384; const float* wup = INP(F, 11) + (size_t)(l * 2 + dir) * 64 * 384;
      for (int idx = tid; idx < 4096; idx += 512) { const int i = idx >> 6, c = idx & 63;
          WA[c * 72 + i] = (bf16)f2bf(aup[i * 384 + h * 64 + c]); WW[c * 72 + i] = (bf16)f2bf(wup[i * 384 + h * 64 + c]); }
      if (tid < 320) { const int which = tid >> 6, c = tid & 63;
          const int rc = which == 0 ? h * 64 + c : which == 1 ? 384 + h * 64 + c : which == 2 ? 768 + h * 64 + c : which == 3 ? 1152 + dir * 64 + c : 1280 + c;
          MU[tid] = INP(F, 8)[l * 1472 + rc]; MU[320 + tid] = INP(F, 9)[l * 1472 + rc]; } }
    __syncthreads();
    const size_t mb = (size_t)b * SEQ;
    const int j = lane & 15;
    if (wave < 4) {
        const int pw = wave;
        const int hc4 = h * 64 + 4 * j;
        const f32x4 kk_c4 = *(const f32x4*)(INP(F, 15) + l * 384 + hc4), ka_c4 = *(const f32x4*)(INP(F, 16) + l * 384 + hc4), rk_c4 = *(const f32x4*)(INP(F, 17) + l * 384 + hc4);
        float ba[4], bw[4];
#pragma unroll
        for (int ct = 0; ct < 4; ++ct) { ba[ct] = INP(F, 12)[l * 384 + h * 64 + 16 * ct + j]; bw[ct] = INP(F, 10)[(l * 2 + dir) * 384 + h * 64 + 16 * ct + j]; }
        v4u pre[7];
#define RW_ISSUE(blk) do { const int T0_ = dir ? SEQ - 32 * ((blk) + 1) : 32 * (blk); _Pragma("unroll") for (int i_ = 0; i_ < 7; ++i_) { const int idx_ = lane + 64 * i_; pre[i_] = (v4u){0u, 0u, 0u, 0u}; \
        if (idx_ < 400) { const int rr_ = idx_ / 40, q_ = idx_ % 40, wh_ = q_ >> 3, c8_ = q_ & 7; const int t_ = T0_ + 8 * pw - 1 + rr_; \
            const int gc_ = (wh_ == 0 ? R_R + h * 64 : wh_ == 1 ? R_K + h * 64 : wh_ == 2 ? R_V + h * 64 : wh_ == 3 ? R_WDF + dir * 64 : R_AD) + c8_ * 8; \
            if (t_ >= 0 && t_ < SEQ) pre[i_] = *(const v4u*)(cols + (mb + t_) * NINP + gc_); } } } while (0)
        RW_ISSUE(0);
#pragma unroll 1
        for (int it = 0; it <= NB; ++it) {
            if (it < NB) {
                const int T0 = dir ? SEQ - 32 * (it + 1) : 32 * it;
                LAS float* OPS = OPSb + (it & 1) * 10240; LAS float* VV = VVb + (it & 1) * 512;
#pragma unroll
                for (int i = 0; i < 7; ++i) { const int idx = lane + 64 * i; if (idx < 400) *(LAS v4u*)(RAWB + idx * 8) = pre[i]; }
                LDS_WAIT(); asm volatile("" ::: "memory");
                if (it + 1 < NB) RW_ISSUE(it + 1);
#pragma unroll
                for (int k2 = 0; k2 < 40; ++k2) { const int which = k2 >> 3, tt = k2 & 7, cc = which * 64 + lane, t = 8 * pw + tt;
                    const float p0 = bf2f(RAWB[tt * 320 + cc]), p1 = bf2f(RAWB[(tt + 1) * 320 + cc]), p2 = bf2f(RAWB[(tt + 2) * 320 + cc]);
                    const float v = p1 + MU[cc] * (p0 - p1) + MU[320 + cc] * (p2 - p1);
                    if (which == 0) OPS[t * 320 + 256 + lane] = v;
                    else if (which == 1) OPS[t * 320 + 192 + lane] = v;
                    else if (which == 2) { if ((lane >> 4) == qtr) VV[t * 16 + (lane & 15)] = v; }
                    else if (which == 3) { const float e = __expf(2.f * v); XW[tt * 72 + lane] = (bf16)f2bf(1.f - 2.f * __builtin_amdgcn_rcpf(e + 1.f)); }
                    else XA[tt * 72 + lane] = (bf16)f2bf(v); }
                LDS_WAIT(); asm volatile("" ::: "memory");
#pragma unroll
                for (int ct = 0; ct < 4; ++ct) { const f32x4 z = {0.f, 0.f, 0.f, 0.f};
                    const f32x4 ca = mma16_a8(XA, WA + ct * 16 * 72, z, lane), cw = mma16_a8(XW, WW + ct * 16 * 72, z, lane);
                    if (lane < 32) {
#pragma unroll
                        for (int jj = 0; jj < 4; ++jj) { const int t = 8 * pw + (lane >> 4) * 4 + jj, c = ct * 16 + j;
                            OPS[t * 320 + 128 + c] = sigmoidf_(ba[ct] + ca[jj]);
                            OPS[t * 320 + c] = __expf(-0.6065306597f * sigmoidf_(bw[ct] + cw[jj])); } } }
                LDS_WAIT(); asm volatile("" ::: "memory");
#pragma unroll
                for (int ps = 0; ps < 2; ++ps) { const int t = 8 * pw + 4 * ps + (lane >> 4); LAS float* op = OPS + t * 320 + 4 * j;
                    const f32x4 av = *(const LAS f32x4*)(op + 128), kp = *(const LAS f32x4*)(op + 192), rp = *(const LAS f32x4*)(op + 256);
                    const f32x4 kr = kp * kk_c4; const float ss = row16_sum((kr.x * kr.x + kr.y * kr.y) + (kr.z * kr.z + kr.w * kr.w));
                    const f32x4 kkv = kr * (1.f / fmaxf(sqrtf(ss), 1e-12f));
                    const f32x4 km = kp * ((av - 1.f) * ka_c4 + 1.f);
                    const f32x4 q = rp * km * rk_c4; const float cs = row16_sum((q.x + q.y) + (q.z + q.w));
                    *(LAS f32x4*)(op + 64) = kkv; *(LAS f32x4*)(op + 128) = kkv * av; *(LAS f32x4*)(op + 192) = km;
                    if (dir == 0 && qtr == 0 && j == 0) CT[(mb + T0 + t) * 8 + h] = cs; }
            }
            if (it >= 2) { const int bk = it - 2; const int T0 = dir ? SEQ - 32 * (bk + 1) : 32 * bk; const LAS float* YB = YBb + (bk & 1) * 512;
                const int idx = (pw * 64 + lane) * 2, tl = idx >> 4, rw = idx & 15;
                *(unsigned*)(Y + (mb + T0 + tl) * 384 + h * 64 + 16 * qtr + rw) = pk2(YB[idx], YB[idx + 1]); }
            __syncthreads();
        }
        { const int bk = NB - 1; const int T0 = dir ? SEQ - 32 * (bk + 1) : 32 * bk; const LAS float* YB = YBb + (bk & 1) * 512;
          const int idx = (pw * 64 + lane) * 2, tl = idx >> 4, rw = idx & 15;
          *(unsigned*)(Y + (mb + T0 + tl) * 384 + h * 64 + 16 * qtr + rw) = pk2(YB[idx], YB[idx + 1]); }
#undef RW_ISSUE
    } else {
        const int row = (wave - 4) * 4 + (lane >> 4);
        f32x4 S = {0.f, 0.f, 0.f, 0.f};
#pragma unroll 1
        for (int it = 0; it <= NB; ++it) {
            if (it >= 1) { const int bk = it - 1;
                const LAS float* OPS = OPSb + (bk & 1) * 10240; const LAS float* VV = VVb + (bk & 1) * 512; LAS float* YB = YBb + (bk & 1) * 512;
                __builtin_amdgcn_s_setprio(3);
                float yk0 = 0.f, yk1 = 0.f;
                const LAS float* op0 = OPS + (dir ? 31 : 0) * 320 + 4 * j; const int ostep = dir ? -320 : 320;
                const LAS float* vp0 = VV + (dir ? 31 : 0) * 16 + row; const int vstep = dir ? -16 : 16;
                f32x4 w4 = *(const LAS f32x4*)(op0), kk4 = *(const LAS f32x4*)(op0 + 64), ka4 = *(const LAS f32x4*)(op0 + 128), km4 = *(const LAS f32x4*)(op0 + 192), r4 = *(const LAS f32x4*)(op0 + 256);
                float vv = *vp0;
#pragma unroll
                for (int i = 0; i < 32; ++i) {
                    f32x4 nw4, nkk4, nka4, nkm4, nr4; float nvv;
                    if (i < 31) { const LAS float* op = op0 + (i + 1) * ostep; nw4 = *(const LAS f32x4*)(op); nkk4 = *(const LAS f32x4*)(op + 64); nka4 = *(const LAS f32x4*)(op + 128); nkm4 = *(const LAS f32x4*)(op + 192); nr4 = *(const LAS f32x4*)(op + 256); nvv = vp0[(i + 1) * vstep]; }
                    float sa = (S.x * kk4.x + S.y * kk4.y) + (S.z * kk4.z + S.w * kk4.w);
                    const f32x4 pre_s = S * w4 + km4 * vv;
                    sa = row16_sum(sa);
                    S = pre_s - ka4 * sa;
                    float y = (S.x * r4.x + S.y * r4.y) + (S.z * r4.z + S.w * r4.w);
                    y = row16_sum(y);
                    if ((i & 15) == j) { if (i < 16) yk0 = y; else yk1 = y; }
                    if (i < 31) { w4 = nw4; kk4 = nkk4; ka4 = nka4; km4 = nkm4; r4 = nr4; vv = nvv; } }
                YB[(dir ? 31 - j : j) * 16 + row] = yk0; YB[(dir ? 15 - j : 16 + j) * 16 + row] = yk1;
                __builtin_amdgcn_s_setprio(0);
            }
            __syncthreads();
        }
    }
    __syncthreads();
}
__device__ __forceinline__ float row8_sum(float v) { v += dppf<0xB1>(v); v += dppf<0x4E>(v); v += dppf<0x141>(v); return v; }
__device__ __forceinline__ void mlstm_seq(const Frame& F, int l, int task) {
    const int b = task >> 3, h = (task >> 1) & 3, dir = task & 1;
    const bf16* cols = (const bf16*)(WSP(F) + WS_COLS); const float* GT = (const float*)(WSP(F) + WS_GATES);
    bf16* Y = (bf16*)(WSP(F) + (dir ? Y_AB : Y_AF));
    LAS bf16* RAWQ = (LAS bf16*)(F.lds);
    LAS bf16* Qs = (LAS bf16*)(F.lds + 17408); LAS bf16* Ks = (LAS bf16*)(F.lds + 26624);
    LAS bf16* Vtb = (LAS bf16*)(F.lds + 35840);
    LAS bf16* KWt = (LAS bf16*)(F.lds + 54272); LAS bf16* Ps = (LAS bf16*)(F.lds + 63488);
    LAS bf16* Ctb = (LAS bf16*)(F.lds + 72704);
    LAS float* ub = (LAS float*)(F.lds + 91136);
    LAS float* blb = ub + 128; LAS float* rmb = ub + 256;
    LAS float* den = ub + 384; LAS float* qn = ub + 448; LAS float* nst = ub + 512; LAS float* scb = ub + 576;
    const int tid = F.tid, lane = F.lane, wave = F.wave;
    const size_t mb = (size_t)b * SEQ;
    constexpr int NC = SEQ / 64;
    __syncthreads();
    for (int i = tid; i < 2 * 64 * 72; i += 512) Ctb[i] = 0;
    if (tid < 64) nst[tid] = 0.f;
    const int cc = tid & 127, isK = cc >> 6, d0 = cc & 63, chn = isK * 256 + h * 64 + d0;
    float cw[5]; const float* cwp = INP(F, 3) + (size_t)l * 5 * 512;
#pragma unroll
    for (int jj = 0; jj < 5; ++jj) cw[jj] = cwp[jj * 512 + chn];
    const float cbv = INP(F, 4)[l * 512 + chn];
    f32x4 st[2] = {{0.f, 0.f, 0.f, 0.f}, {0.f, 0.f, 0.f, 0.f}};
    float m_st = 0.f;
    v4u pre[3], prev; float gli = 0.f, glf = 0.f;
#define ML_ISSUE(c_) do { const int tlo_ = dir ? SEQ - 64 * ((c_) + 1) : 64 * (c_); _Pragma("unroll") for (int i_ = 0; i_ < 3; ++i_) { const int ch_ = tid + 512 * i_; pre[i_] = (v4u){0u, 0u, 0u, 0u}; \
        if (ch_ < 68 * 16) { const int rr_ = ch_ >> 4, q_ = ch_ & 15; const int t_ = tlo_ - 2 + rr_; if (t_ >= 0 && t_ < SEQ) pre[i_] = *(const v4u*)(cols + (mb + t_) * NINP + (q_ >> 3) * 256 + h * 64 + (q_ & 7) * 8); } } \
        prev = *(const v4u*)(cols + (mb + tlo_ + (tid >> 3)) * NINP + A_V + h * 64 + (tid & 7) * 8); \
        if (tid < 64) { const int t_ = dir ? tlo_ + 63 - tid : tlo_ + tid; gli = GT[(mb + t_) * 16 + dir * 4 + h]; glf = GT[(mb + t_) * 16 + 8 + dir * 4 + h]; } } while (0)
#define ML_FILL(c_) do { _Pragma("unroll") for (int i_ = 0; i_ < 3; ++i_) { const int ch_ = tid + 512 * i_; if (ch_ < 68 * 16) *(LAS v4u*)(RAWQ + (ch_ >> 4) * 128 + (ch_ & 15) * 8) = pre[i_]; } \
        { LAS bf16* Vt_ = Vtb + ((c_) & 1) * 4608; const int tl_ = tid >> 3, e8_ = tid & 7; const int lp_ = dir ? 63 - tl_ : tl_; const unsigned w_[4] = {prev.x, prev.y, prev.z, prev.w}; \
          _Pragma("unroll") for (int k_ = 0; k_ < 4; ++k_) { Vt_[(e8_ * 8 + 2 * k_) * 72 + lp_] = (bf16)(w_[k_] & 0xffffu); Vt_[(e8_ * 8 + 2 * k_ + 1) * 72 + lp_] = (bf16)(w_[k_] >> 16); } } \
        if (tid < 64) { float bl_ = glf; _Pragma("unroll") for (int o_ = 1; o_ < 64; o_ <<= 1) { const float x_ = __shfl_up(bl_, o_); if (lane >= o_) bl_ += x_; } \
            const float u_ = gli - bl_; float rm_ = u_; _Pragma("unroll") for (int o_ = 1; o_ < 64; o_ <<= 1) { const float x_ = __shfl_up(rm_, o_); if (lane >= o_) rm_ = fmaxf(rm_, x_); } \
            ub[((c_) & 1) * 64 + tid] = u_; blb[((c_) & 1) * 64 + tid] = bl_; rmb[((c_) & 1) * 64 + tid] = rm_; if (tid == 63) { scb[((c_) & 1) * 2] = rm_; scb[((c_) & 1) * 2 + 1] = bl_; } } } while (0)
    ML_ISSUE(0); ML_FILL(0); ML_ISSUE(1);
    __syncthreads();
#pragma unroll 1
    for (int c = 0; c < NC; ++c) {
        const int tlo = dir ? SEQ - 64 * (c + 1) : 64 * c;
        const LAS float* u = ub + (c & 1) * 64; const LAS float* bl = blb + (c & 1) * 64; const LAS float* rm = rmb + (c & 1) * 64;
        const LAS bf16* Vt = Vtb + (c & 1) * 4608; const LAS bf16* Ct = Ctb + (c & 1) * 4608; LAS bf16* Ctn = Ctb + ((c + 1) & 1) * 4608;
#pragma unroll 4
        for (int i = 0; i < 16; ++i) { const int tl = (tid >> 7) + 4 * i; float s = cbv;
#pragma unroll
            for (int jj = 0; jj < 5; ++jj) s += cw[jj] * bf2f(RAWQ[(tl + jj) * 128 + cc]);
            s = siluf_(s); const int lpos = dir ? 63 - tl : tl;
            if (isK) Ks[lpos * 72 + d0] = (bf16)f2bf(s * 0.125f); else Qs[lpos * 72 + d0] = (bf16)f2bf(s); }
        if (tid < 64) den[tid] = 0.f;
        __syncthreads();
        const float umax = scb[(c & 1) * 2], tot = scb[(c & 1) * 2 + 1];
        for (int idx = tid; idx < 4096; idx += 512) { const int lp = idx >> 6, d = idx & 63; KWt[d * 72 + lp] = (bf16)f2bf(bf2f(Ks[lp * 72 + d]) * __expf(u[lp] - umax)); }
#pragma unroll
        for (int k = 0; k < 2; ++k) { const int ti = 2 * wave + k, tl_ = ti >> 2, ts = ti & 3; f32x4 acc = {0.f, 0.f, 0.f, 0.f};
            if (ts <= tl_) acc = mma16<64>(Qs + tl_ * 16 * 72, 72, Ks + ts * 16 * 72, 72, acc, lane);
#pragma unroll
            for (int jj = 0; jj < 4; ++jj) { const int lr = tl_ * 16 + (lane >> 4) * 4 + jj, s = ts * 16 + (lane & 15);
                const float v = (s <= lr) ? acc[jj] * __expf(u[s] - fmaxf(m_st, rm[lr])) : 0.f; const unsigned vb = f2bf(v); Ps[lr * 72 + s] = (bf16)vb;
                if (ts <= tl_) { const float rs = row16_sum(bf2f(vb)); if ((lane & 15) == 0) __hip_atomic_fetch_add(den + lr, rs, __ATOMIC_RELAXED, __HIP_MEMORY_SCOPE_WORKGROUP); } } }
        { const int lq = tid >> 3, part = tid & 7; float s = 0.f;
#pragma unroll
          for (int k = 0; k < 8; ++k) s += bf2f(Qs[lq * 72 + part * 8 + k]) * nst[part * 8 + k];
          s = row8_sum(s); if (part == 0) qn[lq] = s; }
        __syncthreads();
        const float mmax = fmaxf(m_st, umax), s_old = __expf(m_st - mmax), s_new = __expf(umax - mmax);
#pragma unroll
        for (int k = 0; k < 2; ++k) { const int ti = 2 * wave + k, t0_ = ti >> 2, t1_ = ti & 3; const f32x4 z = {0.f, 0.f, 0.f, 0.f};
            const f32x4 a1 = mma16<64>(Ps + t0_ * 16 * 72, 72, Vt + t1_ * 16 * 72, 72, z, lane);
            const f32x4 a2 = mma16<64>(Qs + t0_ * 16 * 72, 72, Ct + t1_ * 16 * 72, 72, z, lane);
            const f32x4 lc = mma16<64>(Vt + t0_ * 16 * 72, 72, KWt + t1_ * 16 * 72, 72, z, lane);
#pragma unroll
            for (int jj = 0; jj < 4; ++jj) { const int r_ = t0_ * 16 + (lane >> 4) * 4 + jj, c_ = t1_ * 16 + (lane & 15);
                const float mx = fmaxf(m_st, rm[r_]), iwv = __expf(m_st - mx);
                const float dn = den[r_] + iwv * qn[r_];
                const float val = (a1[jj] + iwv * a2[jj]) / fmaxf(fabsf(dn), __expf(-(bl[r_] + mx)));
                const int t = dir ? tlo + 63 - r_ : tlo + r_;
                Y[(mb + t) * 256 + h * 64 + c_] = (bf16)f2bf(val);
                st[k][jj] = s_old * st[k][jj] + s_new * lc[jj];
                Ctn[r_ * 72 + c_] = (bf16)f2bf(st[k][jj]); } }
        { const int dq = tid >> 3, part = tid & 7; float s = 0.f;
#pragma unroll
          for (int k = 0; k < 8; ++k) s += bf2f(KWt[dq * 72 + part * 8 + k]);
          s = row8_sum(s); if (part == 0) nst[dq] = s_old * nst[dq] + s_new * s; }
        m_st = tot + mmax;
        if (c + 1 < NC) { ML_FILL(c + 1); if (c + 2 < NC) ML_ISSUE(c + 2); }
        __syncthreads();
    }
#undef ML_ISSUE
#undef ML_FILL
}
__device__ __forceinline__ void phase_ssd_conv(const Frame& F, int l) {
    const bf16* cols = (const bf16*)(WSP(F) + WS_COLS); bf16* XBC = (bf16*)(WSP(F) + WS_XN);
    LAS bf16* raw = (LAS bf16*)(F.lds);
    const float* cwp = INP(F, 20) + (size_t)l * 5 * 896; const float* cbp = INP(F, 21) + l * 896;
    const int tid = F.tid;
    float cw0[5], cw1[5]; const int c1 = tid + 512 < 896 ? tid + 512 : tid;
#pragma unroll
    for (int jj = 0; jj < 5; ++jj) { cw0[jj] = cwp[jj * 896 + tid]; cw1[jj] = cwp[jj * 896 + c1]; }
    const float cb0 = cbp[tid], cb1 = cbp[c1];
    for (int tile = F.vcu; tile < M / 32; tile += F.G) {
        const int m0 = tile * 32, t0 = m0 % SEQ;
        __syncthreads();
        for (int ch = tid; ch < 36 * 112; ch += 512) { const int rr = ch / 112, cc = ch % 112; const int t = t0 - 2 + rr;
            v4u v = {0u, 0u, 0u, 0u}; if (t >= 0 && t < SEQ) v = *(const v4u*)(cols + (size_t)(m0 - 2 + rr) * NINP + S_X + cc * 8);
            *(LAS v4u*)(raw + rr * 896 + cc * 8) = v; }
        __syncthreads();
#pragma unroll
        for (int half = 0; half < 2; ++half) { const int c = half ? c1 : tid; if (half && tid + 512 >= 896) break;
            float win[5];
#pragma unroll
            for (int jj = 0; jj < 4; ++jj) win[jj] = bf2f(raw[jj * 896 + c]);
            for (int tl = 0; tl < 32; ++tl) { win[4] = bf2f(raw[(tl + 4) * 896 + c]);
                float s = half ? cb1 : cb0;
#pragma unroll
                for (int jj = 0; jj < 5; ++jj) s += (half ? cw1[jj] : cw0[jj]) * win[jj];
#pragma unroll
                for (int jj = 0; jj < 4; ++jj) win[jj] = win[jj + 1];
                XBC[(size_t)(m0 + tl) * 896 + c] = (bf16)f2bf(siluf_(s)); } }
    }
    __syncthreads();
}
__device__ __forceinline__ void ssd_seq(const Frame& F, int l, int task) {
    const int b = task / 12, rem = task % 12, head = rem >> 1, dir = rem & 1, g = head / 3;
    const bf16* cols = (const bf16*)(WSP(F) + WS_COLS); const bf16* XBC = (const bf16*)(WSP(F) + WS_XN);
    bf16* Y = (bf16*)(WSP(F) + (dir ? Y_SB : Y_SF));
    LAS bf16* Cm = (LAS bf16*)(F.lds); LAS bf16* Bm = (LAS bf16*)(F.lds + 17408);
    LAS bf16* Btw = (LAS bf16*)(F.lds + 34816); LAS bf16* Xt = (LAS bf16*)(F.lds + 53248);
    LAS bf16* Ps = (LAS bf16*)(F.lds + 62464); LAS bf16* Hs = (LAS bf16*)(F.lds + 71680);
    LAS float* dtvb = (LAS float*)(F.lds + 89088);
    LAS float* acsb = dtvb + 128;
    LAS float* totb = dtvb + 256;
    const int tid = F.tid, lane = F.lane, wave = F.wave;
    const size_t mb = (size_t)b * SEQ;
    constexpr int NC = SEQ / 64;
    __syncthreads();
    for (int i = tid; i < 64 * 136; i += 512) Hs[i] = 0;
    const float dtb = INP(F, 22)[(l * 2 + dir) * 6 + head];
    const float aneg = -__expf(INP(F, 23)[(l * 2 + dir) * 6 + head]);
    f32x4 st[4];
#pragma unroll
    for (int k = 0; k < 4; ++k) st[k] = (f32x4){0.f, 0.f, 0.f, 0.f};
    v4u pre[5]; float dtraw = 0.f;
#define SSD_ISSUE(c_) do { const int tlo_ = dir ? SEQ - 64 * ((c_) + 1) : 64 * (c_); _Pragma("unroll") for (int i_ = 0; i_ < 5; ++i_) { const int idx_ = tid + 512 * i_; const int tl_ = idx_ / 40, q_ = idx_ % 40; \
        const int gc_ = q_ < 8 ? head * 64 + q_ * 8 : (q_ < 24 ? 384 + g * 128 + (q_ - 8) * 8 : 640 + g * 128 + (q_ - 24) * 8); \
        pre[i_] = *(const v4u*)(XBC + (mb + tlo_ + tl_) * 896 + gc_); } } while (0)
#define SSD_DTLOAD(c_) do { if (tid < 64) { const int tlo_ = dir ? SEQ - 64 * ((c_) + 1) : 64 * (c_); const int t_ = dir ? tlo_ + 63 - tid : tlo_ + tid; dtraw = bf2f(cols[(mb + t_) * NINP + S_DT + dir * 6 + head]); } } while (0)
#define SSD_DTCALC(c_) do { if (tid < 64) { const float x_ = dtraw + dtb; const float dt_ = x_ > 20.f ? x_ : log1pf(__expf(x_)); float cs_ = dt_ * aneg; \
        _Pragma("unroll") for (int o_ = 1; o_ < 64; o_ <<= 1) { const float u_ = __shfl_up(cs_, o_); if (lane >= o_) cs_ += u_; } \
        const float tt_ = __shfl(cs_, 63); dtvb[((c_) & 1) * 64 + tid] = dt_; acsb[((c_) & 1) * 64 + tid] = cs_; if (tid == 0) totb[(c_) & 1] = tt_; } } while (0)
    SSD_ISSUE(0); SSD_DTLOAD(0); SSD_DTCALC(0); SSD_DTLOAD(1);
    __syncthreads();
#pragma unroll 1
    for (int c = 0; c < NC; ++c) {
        const int tlo = dir ? SEQ - 64 * (c + 1) : 64 * c;
        const LAS float* dtv = dtvb + (c & 1) * 64; const LAS float* acs = acsb + (c & 1) * 64; const float tot = totb[c & 1];
#pragma unroll
        for (int i = 0; i < 5; ++i) { const int idx = tid + 512 * i; const int tl = idx / 40, q = idx % 40; const int lp = dir ? 63 - tl : tl;
            const unsigned w[4] = {pre[i].x, pre[i].y, pre[i].z, pre[i].w};
            if (q < 8) {
#pragma unroll
                for (int k = 0; k < 4; ++k) { Xt[(q * 8 + 2 * k) * 72 + lp] = (bf16)(w[k] & 0xffffu); Xt[(q * 8 + 2 * k + 1) * 72 + lp] = (bf16)(w[k] >> 16); } }
            else if (q < 24) { const int n0 = (q - 8) * 8; *(LAS v4u*)(Bm + lp * 136 + n0) = pre[i]; const float sc = dtv[lp] * __expf(tot - acs[lp]);
#pragma unroll
                for (int k = 0; k < 4; ++k) { Btw[(n0 + 2 * k) * 72 + lp] = (bf16)f2bf(bf2f(w[k] & 0xffffu) * sc); Btw[(n0 + 2 * k + 1) * 72 + lp] = (bf16)f2bf(bf2f(w[k] >> 16) * sc); } }
            else { const int n0 = (q - 24) * 8; *(LAS v4u*)(Cm + lp * 136 + n0) = pre[i]; } }
        if (c + 1 < NC) SSD_ISSUE(c + 1);
        __syncthreads();
        f32x4 yo[2], lc[4];
#pragma unroll
        for (int k = 0; k < 2; ++k) { const int ti = 2 * wave + k, tl_ = ti >> 2, ts = ti & 3; f32x4 acc = {0.f, 0.f, 0.f, 0.f};
            if (ts <= tl_) acc = mma16<128>(Cm + tl_ * 16 * 136, 136, Bm + ts * 16 * 136, 136, acc, lane);
#pragma unroll
            for (int jj = 0; jj < 4; ++jj) { const int lr = tl_ * 16 + (lane >> 4) * 4 + jj, s = ts * 16 + (lane & 15);
                const float v = (s <= lr) ? acc[jj] * __expf(acs[lr] - acs[s]) * dtv[s] : 0.f; Ps[lr * 72 + s] = (bf16)f2bf(v); }
            const f32x4 z = {0.f, 0.f, 0.f, 0.f};
            yo[k] = mma16<128>(Cm + tl_ * 16 * 136, 136, Hs + ts * 16 * 136, 136, z, lane); }
#pragma unroll
        for (int k = 0; k < 4; ++k) { const int ti = 4 * wave + k, tp = ti >> 3, tn = ti & 7; const f32x4 z = {0.f, 0.f, 0.f, 0.f};
            lc[k] = mma16<64>(Xt + tp * 16 * 72, 72, Btw + tn * 16 * 72, 72, z, lane); }
        __syncthreads();
        const float cdec = __expf(tot);
#pragma unroll
        for (int k = 0; k < 2; ++k) { const int ti = 2 * wave + k, tl_ = ti >> 2, tp = ti & 3; const f32x4 z = {0.f, 0.f, 0.f, 0.f};
            const f32x4 yd = mma16<64>(Ps + tl_ * 16 * 72, 72, Xt + tp * 16 * 72, 72, z, lane);
#pragma unroll
            for (int jj = 0; jj < 4; ++jj) { const int lr = tl_ * 16 + (lane >> 4) * 4 + jj, p = tp * 16 + (lane & 15);
                const float val = yd[jj] + yo[k][jj] * __expf(acs[lr]);
                const int t = dir ? tlo + 63 - lr : tlo + lr;
                Y[(mb + t) * 384 + head * 64 + p] = (bf16)f2bf(val); } }
#pragma unroll
        for (int k = 0; k < 4; ++k) { const int ti = 4 * wave + k, tp = ti >> 3, tn = ti & 7;
#pragma unroll
            for (int jj = 0; jj < 4; ++jj) { const int p = tp * 16 + (lane >> 4) * 4 + jj, n = tn * 16 + (lane & 15);
                st[k][jj] = cdec * st[k][jj] + lc[k][jj]; Hs[p * 136 + n] = (bf16)f2bf(st[k][jj]); } }
        if (c + 1 < NC) { SSD_DTCALC(c + 1); if (c + 2 < NC) SSD_DTLOAD(c + 2); }
        __syncthreads();
    }
#undef SSD_ISSUE
#undef SSD_DTLOAD
#undef SSD_DTCALC
}
__device__ __forceinline__ void phase_post(const Frame& F, int l) {
    const bf16* cols = (const bf16*)(WSP(F) + WS_COLS); bf16* MIX = (bf16*)(WSP(F) + WS_XN);
    const bf16* YAf = (const bf16*)(WSP(F) + Y_AF); const bf16* YAb = (const bf16*)(WSP(F) + Y_AB);
    const bf16* YRf = (const bf16*)(WSP(F) + Y_RF); const bf16* YRb = (const bf16*)(WSP(F) + Y_RB);
    const bf16* YSf = (const bf16*)(WSP(F) + Y_SF); const bf16* YSb = (const bf16*)(WSP(F) + Y_SB);
    const float* CT = (const float*)(WSP(F) + WS_CT);
    LAS float* sg = (LAS float*)(F.lds);
    LAS float* gate = (LAS float*)(F.lds + 8192);
    const int tid = F.tid, lane = F.lane, wave = F.wave;
    const float* mup = INP(F, 8) + l * 1472; const float* mun = INP(F, 9) + l * 1472;
    const float* gup = INP(F, 14) + (size_t)l * 128 * 384;
    const float* mng = INP(F, 7) + l * 256; const float* rng = INP(F, 18) + l * 384; const float* rnb = INP(F, 19) + l * 384;
    const float* scb = INP(F, 21) + l * 896; const float* scw = INP(F, 20) + (size_t)l * 5 * 896; const float* sdk = INP(F, 24) + l * 6; const float* sng = INP(F, 25) + l * 384;
    for (int tile = F.vcu; tile < M / 16; tile += F.G) {
        const int m0 = tile * 16;
        __syncthreads();
        for (int idx = tid; idx < 16 * 128; idx += 512) { const int tt = idx >> 7, i = idx & 127; const int m = m0 + tt, t = m % SEQ;
            const float p1 = bf2f(cols[(size_t)m * NINP + R_GD + i]);
            const float p0 = t > 0 ? bf2f(cols[(size_t)(m - 1) * NINP + R_GD + i]) : 0.f;
            const float p2 = t < SEQ - 1 ? bf2f(cols[(size_t)(m + 1) * NINP + R_GD + i]) : 0.f;
            sg[idx] = sigmoidf_(p1 + mup[1344 + i] * (p0 - p1) + mun[1344 + i] * (p2 - p1)); }
        __syncthreads();
        if (tid < 384) { float acc[16];
#pragma unroll
            for (int tt = 0; tt < 16; ++tt) acc[tt] = 0.f;
            for (int i = 0; i < 128; ++i) { const float w = gup[i * 384 + tid];
#pragma unroll
                for (int tt = 0; tt < 16; ++tt) acc[tt] += sg[tt * 128 + i] * w; }
#pragma unroll
            for (int tt = 0; tt < 16; ++tt) gate[tt * 384 + tid] = acc[tt]; }
        __syncthreads();
#pragma unroll 1
        for (int k = 0; k < 2; ++k) { const int tt = wave * 2 + k; const int m = m0 + tt, t = m % SEQ; const size_t cr = (size_t)m * NINP;
#pragma unroll
            for (int i = 0; i < 4; ++i) { const int col = i * 64 + lane;
                const float hs = bf2f(YAf[(size_t)m * 256 + col]) + bf2f(YAb[(size_t)m * 256 + col]);
                const float mean = wave_sum(hs) * (1.f / 64.f); const float d = hs - mean; const float var = wave_sum(d * d) * (1.f / 64.f);
                const float y = d * (1.f / sqrtf(var + 1e-6f)) * mng[col];
                MIX[(size_t)m * DM + col] = (bf16)f2bf(y * sigmoidf_(bf2f(cols[cr + A_O + col]))); }
#pragma unroll
            for (int i = 0; i < 6; ++i) { const int col = i * 64 + lane;
                const float ys = bf2f(YRf[(size_t)m * 384 + col]) + bf2f(YRb[(size_t)m * 384 + col]);
                const float mean = wave_sum(ys) * (1.f / 64.f); const float d = ys - mean; const float var = wave_sum(d * d) * (1.f / 64.f);
                const float y = d * (1.f / sqrtf(var + 64e-5f)) * rng[col] + rnb[col];
                const float p1 = bf2f(cols[cr + R_V + col]);
                const float p0 = t > 0 ? bf2f(cols[cr - NINP + R_V + col]) : 0.f;
                const float p2 = t < SEQ - 1 ? bf2f(cols[cr + NINP + R_V + col]) : 0.f;
                const float vv = p1 + mup[768 + col] * (p0 - p1) + mun[768 + col] * (p2 - p1);
                const float bonus = CT[(size_t)m * 8 + i] * vv;
                MIX[(size_t)m * DM + 256 + col] = (bf16)f2bf((y + bonus) * gate[tt * 384 + col]); }
            float yv[6]; float ssq[2] = {0.f, 0.f};
#pragma unroll
            for (int i = 0; i < 6; ++i) { const int col = i * 64 + lane;
                float s = scb[col];
#pragma unroll
                for (int jj = 0; jj < 5; ++jj) { const int tq = t + jj - 2; if (tq >= 0 && tq < SEQ) s += scw[jj * 896 + col] * bf2f(cols[cr + (jj - 2) * NINP + S_X + col]); }
                const float xc = siluf_(s);
                float y = bf2f(YSf[(size_t)m * 384 + col]) + bf2f(YSb[(size_t)m * 384 + col]) + sdk[i] * xc;
                y *= siluf_(bf2f(cols[cr + S_Z + col]));
                yv[i] = y; ssq[i / 3] += y * y; }
            const float r0 = 1.f / sqrtf(wave_sum(ssq[0]) * (1.f / 192.f) + 1e-6f), r1 = 1.f / sqrtf(wave_sum(ssq[1]) * (1.f / 192.f) + 1e-6f);
#pragma unroll
            for (int i = 0; i < 6; ++i) { const int col = i * 64 + lane;
                MIX[(size_t)m * DM + 640 + col] = (bf16)f2bf(yv[i] * (i < 3 ? r0 : r1) * sng[col]); }
        }
    }
    __syncthreads();
}
namespace cg = cooperative_groups;
constexpr int N_PHASES = 9 * DEPTH + 1;
__global__ void __launch_bounds__(NWAVES * 64, 2) mk_fwd(Args args) {
    extern __shared__ __attribute__((aligned(16))) unsigned char lds_raw[];
    Frame F;
    F.lds = (LAS unsigned char*)lds_raw;
    F.tid = threadIdx.x; F.lane = F.tid & 63; F.wave = __builtin_amdgcn_readfirstlane(F.tid >> 6);
    F.G = gridDim.x; { const int bx = blockIdx.x; F.vcu = (F.G % 8 == 0) ? (bx % 8) * (F.G / 8) + bx / 8 : bx; }
    volatile LAS unsigned* MISC = (volatile LAS unsigned*)(F.lds + MISC_OFF);
    if (F.tid < 64) MISC[F.tid] = 0u;
    if (F.tid < 34) *(LAS unsigned long long*)(F.lds + PTAB_OFF + 8 * F.tid) = ((const unsigned long long*)__builtin_amdgcn_kernarg_segment_ptr())[F.tid];
    __syncthreads();
    unsigned* ctl = (unsigned*)(WSP(F) + WS_CTL);
    XcdBarrier bar = xcd_barrier_post(ctl + CW_BAR, MISC + 8);
    const int lo = args.ph_lo, hi = args.ph_hi;
#define IN_(k) (lo <= (k) && (k) < hi)
#define SEAM(k) do { if (IN_(k) && IN_((k) + 1)) { if ((k) == 0) cg::this_grid().sync(); else xcd_barrier(bar); } } while (0)
#define LAYER(l, B) \
    if (IN_(B + 0)) { phase_convert(F, l); phase_norm(F, l == 0 ? INP(F, 0) : OUTP(F), INP(F, 1) + l * DM, (bf16*)(WSP(F) + WS_XN)); } SEAM(B + 0); \
    if (IN_(B + 1)) { unsigned char* ws = WSP(F); pg8::Gemm g{(const bf16*)(ws + WS_XN), (const bf16*)(ws + WS_WIN), M, NINP, DM}; pg8::StaticOrder S; S.init(M, NINP, F.G, (int)blockIdx.x); \
            pg8::EpiBf16<0> E{(bf16*)(ws + WS_COLS), NINP, nullptr, 0, 0, 1.f}; \
            pg8::gemm_phase<pg8::EpiBf16<0>, pg8::StaticOrder, PG8_ALIGN, PG8_SP2>(F.lds, g, S, E); } SEAM(B + 1); \
    if (IN_(B + 2)) { phase_gates(F, l); phase_ssd_conv(F, l); } SEAM(B + 2); \
    if (IN_(B + 3)) { const int bx = blockIdx.x; \
            if (bx < 96) rwkv_scan(F, l, bx); else if (bx < 112) mlstm_seq(F, l, bx - 96); else if (bx < 136) ssd_seq(F, l, bx - 112); } SEAM(B + 3); \
    if (IN_(B + 4)) phase_post(F, l); SEAM(B + 4); \
    if (IN_(B + 5)) { unsigned char* ws = WSP(F); pg8::Gemm g{(const bf16*)(ws + WS_XN), (const bf16*)(ws + WS_WOUT), M, DM, DM}; pg8::StaticOrder S; S.init(M, DM, F.G, (int)blockIdx.x); \
            pg8::EpiResidual E{l == 0 ? INP(F, 0) : OUTP(F), OUTP(F), DM}; \
            pg8::gemm_phase<pg8::EpiResidual, pg8::StaticOrder, PG8_ALIGN, PG8_SP2>(F.lds, g, S, E); } SEAM(B + 5); \
    if (IN_(B + 6)) phase_norm(F, OUTP(F), INP(F, 27) + l * DM, (bf16*)(WSP(F) + WS_XN)); SEAM(B + 6); \
    if (IN_(B + 7)) { unsigned char* ws = WSP(F); pg8::Gemm g{(const bf16*)(ws + WS_XN), (const bf16*)(ws + WS_WGU), M, 2 * FFN, DM}; pg8::StaticOrder S; S.init(M, 2 * FFN, F.G, (int)blockIdx.x); \
            pg8::EpiSwiGLU E{(bf16*)(ws + WS_COLS), FFN}; \
            pg8::gemm_phase<pg8::EpiSwiGLU, pg8::StaticOrder, PG8_ALIGN, PG8_SP2>(F.lds, g, S, E); } SEAM(B + 7); \
    if (IN_(B + 8)) { unsigned char* ws = WSP(F); pg8::Gemm g{(const bf16*)(ws + WS_COLS), (const bf16*)(ws + WS_WDN), M, DM, FFN}; pg8::StaticOrder S; S.init(M, DM, F.G, (int)blockIdx.x); \
            pg8::EpiResidual E{OUTP(F), OUTP(F), DM}; \
            pg8::gemm_phase<pg8::EpiResidual, pg8::StaticOrder, PG8_ALIGN, PG8_SP2>(F.lds, g, S, E); } SEAM(B + 8);
    LAYER(0, 0)
    LAYER(1, 9)
    if (IN_(18)) phase_final_norm(F, OUTP(F), INP(F, 31));
#undef IN_
#undef SEAM
#undef LAYER
}

#ifndef MK_PER_PHASE
#define MK_PER_PHASE 0
#endif
extern "C" void kernel_launch(void* const* d_in, const int* in_sizes, int n_in, void* d_out, int out_size, void* d_ws, size_t ws_size, hipStream_t stream) {
    static int grid = 0;
    if (grid == 0) {
        int dev = 0, cus = 0;
        if (n_in != 32 || out_size != M * DM || ws_size < WS_END) { fprintf(stderr, "kernel_launch: unexpected shapes (n_in %d out %d ws %zu)\n", n_in, out_size, ws_size); grid = -1; return; }
        if (hipGetDevice(&dev) != hipSuccess || hipDeviceGetAttribute(&cus, hipDeviceAttributeMultiprocessorCount, dev) != hipSuccess) { grid = -1; return; }
        if (hipFuncSetAttribute((const void*)mk_fwd, hipFuncAttributeMaxDynamicSharedMemorySize, LDS_BYTES) != hipSuccess) { fprintf(stderr, "kernel_launch: hipFuncSetAttribute failed\n"); grid = -1; return; }
        int per_cu = 0;
        if (hipOccupancyMaxActiveBlocksPerMultiprocessor(&per_cu, (const void*)mk_fwd, NWAVES * 64, LDS_BYTES) != hipSuccess || per_cu < 1) { fprintf(stderr, "kernel_launch: occupancy query says %d\n", per_cu); }
        (void)hipGetLastError();
        grid = cus;
    }
    if (grid < 0) return;
    (void)hipMemsetAsync((char*)d_ws + WS_CTL, 0, CTL_ZERO_BYTES, stream);
    Args a{};
    for (int i = 0; i < 32; ++i) a.in[i] = (const float*)d_in[i];
    a.out = (float*)d_out; a.ws = (unsigned char*)d_ws;
#if MK_PER_PHASE
    for (int p = 0; p < N_PHASES; ++p) { a.ph_lo = p; a.ph_hi = p + 1; hipLaunchKernelGGL(mk_fwd, dim3(grid), dim3(NWAVES * 64), LDS_BYTES, stream, a); }
#else
    a.ph_lo = 0; a.ph_hi = N_PHASES;
    void* kargs[] = {&a};
    hipError_t e = hipLaunchCooperativeKernel((const void*)mk_fwd, dim3(grid), dim3(NWAVES * 64), kargs, LDS_BYTES, stream);
    if (e != hipSuccess) fprintf(stderr, "cooperative launch failed: %s (grid %d)\n", hipGetErrorString(e), grid);
#endif
}
```

```cpp
#include <hip/hip_runtime.h>
#include <hip/hip_cooperative_groups.h>
#include <cstdio>
#include <cstdint>
namespace pg8 {
#define PG8_LAS __attribute__((address_space(3)))
typedef unsigned short bf16_t;
typedef short bf16x8 __attribute__((ext_vector_type(8)));
typedef float f32x4 __attribute__((ext_vector_type(4)));
typedef unsigned u32x4 __attribute__((ext_vector_type(4)));
constexpr int BM = 256, BK = 64, HALF = 128, HTB = HALF * BK * 2  , STAGE_BYTES = 8 * HTB, NXCD = 8, WGM = 8;

__host__ __device__ __forceinline__ int lds_byte(int r, int c) { const int st = (r >> 4) * 2 + (c >> 5), rr = r & 15, cc = c & 31, ob = rr * 64 + cc * 2; return st * 1024 + (ob ^ (((ob >> 9) & 1) << 5)); }
__host__ __device__ __forceinline__ void stage_rc(int b, int& R, int& C) { const int st = b / 1024, sb = b % 1024, swz = sb ^ (((sb >> 9) & 1) << 5); R = (st >> 1) * 16 + swz / 64; C = (st & 1) * 32 + (swz % 64) / 2; }
__host__ __device__ __forceinline__ int perm32(int rho) { const int n = rho >> 4, i = rho & 15; return 8 * (i >> 2) + 4 * n + (i & 3); }

struct Unit { int pm, pn; };
struct Gemm { const bf16_t* A; const bf16_t* Bt; int M, N, K; };

struct StaticOrder {
    int nM, nN, nwg, G, c;
    __host__ __device__ void init(int M, int N, int G_, int c_) { nM = M / BM; nN = N / BM; nwg = nM * nN; G = G_; c = c_; }
    __host__ __device__ bool next(int i, Unit& u) const {
        const long L = (long)i * G + c; if (L >= nwg) return false;
        int wgid = (int)L; { const int q = nwg / NXCD, r = nwg % NXCD, xcd = wgid % NXCD, off = wgid / NXCD; wgid = (xcd < r ? xcd * (q + 1) : r * (q + 1) + (xcd - r) * q) + off; }
        const int nig = WGM * nN, gid = wgid / nig, fm = gid * WGM, gsz = (nM - fm) < WGM ? (nM - fm) : WGM;
        u.pm = fm + ((wgid % nig) % gsz); u.pn = (wgid % nig) / gsz; return true;
    }
    __device__ __forceinline__ void a_ready(const Unit&) const {}
    __device__ __forceinline__ void done(const Unit&) const {}
};

__device__ __forceinline__ unsigned cvt_pk_bf16(float lo, float hi) { unsigned r; asm volatile("v_cvt_pk_bf16_f32 %0, %1, %2" : "=v"(r) : "v"(lo), "v"(hi)); return r; }
typedef float f32x2 __attribute__((ext_vector_type(2)));
__device__ __forceinline__ f32x2 gelu_pk(f32x2 v) {
    const f32x2 av = __builtin_elementwise_abs(v), d = av * 0.2316418882f + 1.0f;
    f32x2 t; t.x = __builtin_amdgcn_rcpf(d.x); t.y = __builtin_amdgcn_rcpf(d.y);
    f32x2 q = t * 0.5307027145f + (-0.7265760135f); q = q * t + 0.7107068705f; q = q * t + (-0.142248368f); q = q * t + 0.127414796f; q = q * t;
    const f32x2 s = (v * v) * (-0.72134752044f);
    f32x2 e; e.x = __builtin_amdgcn_exp2f(s.x); e.y = __builtin_amdgcn_exp2f(s.y);
    const f32x2 m = v * (q * e), r = v - m;
    f32x2 o; o.x = v.x < 0.f ? m.x : r.x; o.y = v.y < 0.f ? m.y : r.y; return o;
}

template <int ACT  > struct EpiBf16 {
    static constexpr bool PERM = true, AFTER_DRAIN = false; static_assert(ACT == 0 || ACT == 1, "EpiBf16: ACT is 0 (none) or 1 (gelu_pk)");
    bf16_t* O; int ldc; const float* bias; int split_cols; size_t split_stride; float scale0;
    __device__ __forceinline__ void operator()(const f32x4 (&acc)[2][2][4][2], const Unit& u, int wr, int wc, int fr, int fq) const {
        const int row0 = u.pm * BM + wr * 64 + fr; int colt = u.pn * BM; bf16_t* base = O;
        float sc = 1.f; if (split_cols) { const int t = colt / split_cols; base += (size_t)t * split_stride; colt -= t * split_cols; if (t == 0) sc = scale0; }
        const int col0 = colt + wc * 32 + 8 * fq, bcol0 = u.pn * BM + wc * 32 + 8 * fq;
        f32x4 bv[2][2];
#pragma unroll
        for (int bj = 0; bj < 2; ++bj)
#pragma unroll
            for (int n = 0; n < 2; ++n) bv[bj][n] = bias ? *(const f32x4*)(bias + bcol0 + bj * HALF + 4 * n) : (f32x4){0.f, 0.f, 0.f, 0.f};
#pragma unroll
        for (int ai = 0; ai < 2; ++ai)
#pragma unroll
            for (int m = 0; m < 4; ++m) { bf16_t* rowp = base + (size_t)(row0 + ai * HALF + m * 16) * ldc + col0;
#pragma unroll
                for (int bj = 0; bj < 2; ++bj) { f32x4 v0 = acc[ai][bj][m][0] + bv[bj][0], v1 = acc[ai][bj][m][1] + bv[bj][1];
                    if (ACT == 1) { f32x2 a = gelu_pk((f32x2){v0[0], v0[1]}), b = gelu_pk((f32x2){v0[2], v0[3]}), c = gelu_pk((f32x2){v1[0], v1[1]}), d = gelu_pk((f32x2){v1[2], v1[3]});
                        v0 = (f32x4){a.x, a.y, b.x, b.y}; v1 = (f32x4){c.x, c.y, d.x, d.y}; }
                    v0 = v0 * sc; v1 = v1 * sc; u32x4 w; w.x = cvt_pk_bf16(v0[0], v0[1]); w.y = cvt_pk_bf16(v0[2], v0[3]); w.z = cvt_pk_bf16(v1[0], v1[1]); w.w = cvt_pk_bf16(v1[2], v1[3]);
                    *(u32x4*)(rowp + bj * HALF) = w; } }
    }
};
struct EpiResidual {
    static constexpr bool PERM = false, AFTER_DRAIN = false;
    const float* base; float* out; int ldc;
    __device__ __forceinline__ void operator()(const f32x4 (&acc)[2][2][4][2], const Unit& u, int wr, int wc, int fr, int fq) const {
        const int col0 = u.pn * BM + wc * 32 + 4 * fq;
#pragma unroll
        for (int ai = 0; ai < 2; ++ai)
#pragma unroll
            for (int m = 0; m < 4; ++m) { const size_t off = (size_t)(u.pm * BM + ai * HALF + wr * 64 + m * 16 + fr) * ldc + col0;
#pragma unroll
                for (int bj = 0; bj < 2; ++bj)
#pragma unroll
                    for (int n = 0; n < 2; ++n) { const f32x4 bs = *(const f32x4*)(base + off + bj * HALF + n * 16); *(f32x4*)(out + off + bj * HALF + n * 16) = bs + acc[ai][bj][m][n]; }
                asm volatile("" ::: "memory"); }
    }
};
struct EpiSwiGLU {
    static constexpr bool PERM = true, AFTER_DRAIN = false;
    bf16_t* O; int ldc;
    __device__ __forceinline__ void operator()(const f32x4 (&acc)[2][2][4][2], const Unit& u, int wr, int wc, int fr, int fq) const {
        const int col0 = u.pn * HALF + wc * 32 + 8 * fq;
#pragma unroll
        for (int ai = 0; ai < 2; ++ai)
#pragma unroll
            for (int m = 0; m < 4; ++m) { bf16_t* rowp = O + (size_t)(u.pm * BM + ai * HALF + wr * 64 + m * 16 + fr) * ldc + col0;
                float r[8];
#pragma unroll
                for (int n = 0; n < 2; ++n)
#pragma unroll
                    for (int j = 0; j < 4; ++j) { const float g = acc[ai][0][m][n][j], up = acc[ai][1][m][n][j]; r[n * 4 + j] = g * __builtin_amdgcn_rcpf(1.f + __expf(-g)) * up; }
                u32x4 w; w.x = cvt_pk_bf16(r[0], r[1]); w.y = cvt_pk_bf16(r[2], r[3]); w.z = cvt_pk_bf16(r[4], r[5]); w.w = cvt_pk_bf16(r[6], r[7]);
                *(u32x4*)rowp = w; }
    }
};
template <class Epi, class Sched, bool ALIGN_EPI = false, bool SP2 = false>
__device__ __forceinline__ void gemm_phase(PG8_LAS unsigned char* lds, const Gemm g, const Sched& S, const Epi& E) {
    const int tid = threadIdx.x, wid = __builtin_amdgcn_readfirstlane(tid >> 6), lane = tid & 63, wr = wid >> 2, wc = wid & 3, fr = lane & 15, fq = lane >> 4;
    const int K = g.K, nt = K / BK;
    unsigned voffA[2], voffB[2];
#pragma unroll
    for (int i = 0; i < 2; ++i) { int R, C; stage_rc(tid * 16 + i * 8192, R, C); const int Rb = Epi::PERM ? ((R & ~31) + perm32(R & 31)) : R;
        voffA[i] = (unsigned)(R * K + C) * 2u; voffB[i] = (unsigned)(Rb * K + C) * 2u; }
    const size_t kstep = (size_t)(BK * 2);
    const size_t hstep = (size_t)HALF * K * 2;
    const size_t tstep = 2 * hstep;
    const unsigned ldsw = (unsigned)wid * 1024u;
    const int aoff = lds_byte(wr * 64 + fr, fq * 8), boff = lds_byte(wc * 32 + fr, fq * 8);
#define PG8_SA(b, h) (((b) * 2 + (h)) * HTB)
#define PG8_SB(b, h) ((4 + (b) * 2 + (h)) * HTB)
#define PG8_STAGE(bufoff, gbase, voff) do { _Pragma("unroll") for (int _i = 0; _i < 2; ++_i) \
        __builtin_amdgcn_global_load_lds((const unsigned*)((const char*)(gbase) + (voff)[_i]), (PG8_LAS unsigned*)(lds + (bufoff) + ldsw + _i * 8192), 16, 0, 0); } while (0)
#define PG8_LDA(dst, b, h) do { _Pragma("unroll") for (int m = 0; m < 4; ++m) _Pragma("unroll") for (int k = 0; k < 2; ++k) dst[m][k] = *(const PG8_LAS bf16x8*)(lds + PG8_SA(b, h) + aoff + m * 2048 + k * 1024); } while (0)
#define PG8_LDB(dst, b, h) do { _Pragma("unroll") for (int n = 0; n < 2; ++n) _Pragma("unroll") for (int k = 0; k < 2; ++k) dst[n][k] = *(const PG8_LAS bf16x8*)(lds + PG8_SB(b, h) + boff + n * 2048 + k * 1024); } while (0)
#define PG8_MMA(ai, bj, At, Bt) do { __builtin_amdgcn_s_setprio(1); _Pragma("unroll") for (int m = 0; m < 4; ++m) _Pragma("unroll") for (int n = 0; n < 2; ++n) _Pragma("unroll") for (int k = 0; k < 2; ++k) \
        acc[ai][bj][m][n] = __builtin_amdgcn_mfma_f32_16x16x32_bf16(Bt[n][k], At[m][k], acc[ai][bj][m][n], 0, 0, 0); __builtin_amdgcn_s_setprio(0); } while (0)
#define PG8_WAIT_V(n) asm volatile("s_waitcnt vmcnt(" #n ")" ::: "memory")
#define PG8_WAIT_L(n) asm volatile("s_waitcnt lgkmcnt(" #n ")" ::: "memory")
#define PG8_BAR __builtin_amdgcn_s_barrier()
#define PG8_SCHED __builtin_amdgcn_sched_barrier(0)
    Unit cur, nxt; int ui = 0;
    if (!S.next(0, cur)) return;
    f32x4 acc[2][2][4][2];
#pragma unroll
    for (int a = 0; a < 2; ++a)
#pragma unroll
        for (int b = 0; b < 2; ++b)
#pragma unroll
            for (int m = 0; m < 4; ++m)
#pragma unroll
                for (int n = 0; n < 2; ++n) acc[a][b][m][n] = (f32x4){0.f, 0.f, 0.f, 0.f};
    bf16x8 At[4][2], B0[2][2], B1[2][2];
    const char* cA = (const char*)g.A + (size_t)cur.pm * tstep; const char* cB = (const char*)g.Bt + (size_t)cur.pn * tstep;
    S.a_ready(cur);
    if constexpr (SP2) {
        PG8_STAGE(PG8_SB(0, 0), cB, voffB); PG8_STAGE(PG8_SB(0, 1), cB + hstep, voffB); PG8_STAGE(PG8_SA(0, 0), cA, voffA); PG8_STAGE(PG8_SA(0, 1), cA + hstep, voffA);
        if (wr == 1) PG8_BAR;
        PG8_WAIT_V(2); PG8_BAR;
        PG8_STAGE(PG8_SB(1, 0), cB + kstep, voffB); PG8_STAGE(PG8_SA(1, 0), cA + kstep, voffA); PG8_STAGE(PG8_SB(1, 1), cB + hstep + kstep, voffB);
        PG8_WAIT_V(6); PG8_BAR;
    } else {
        PG8_STAGE(PG8_SB(0, 0), cB, voffB); PG8_STAGE(PG8_SA(0, 0), cA, voffA); PG8_STAGE(PG8_SB(0, 1), cB + hstep, voffB); PG8_STAGE(PG8_SA(0, 1), cA + hstep, voffA);
        if (wr == 1) PG8_BAR;
        PG8_WAIT_V(4); PG8_BAR;
        PG8_STAGE(PG8_SB(1, 0), cB + kstep, voffB); PG8_STAGE(PG8_SA(1, 0), cA + kstep, voffA); PG8_STAGE(PG8_SB(1, 1), cB + hstep + kstep, voffB);
        PG8_WAIT_V(6); PG8_BAR;
    }
    for (;;) {
        const bool has_next = S.next(ui + 1, nxt);
        const char* nA = has_next ? (const char*)g.A + (size_t)nxt.pm * tstep : cA; const char* nB = has_next ? (const char*)g.Bt + (size_t)nxt.pn * tstep : cB;
        for (int t = 0; t < nt; t += 2) {
            const bool last = (t == nt - 2);
            const char* a1 = cA + (size_t)(t + 1) * kstep;
            const char* a2 = last ? nA : cA + (size_t)(t + 2) * kstep; const char* b2 = last ? nB : cB + (size_t)(t + 2) * kstep;
            const char* a3 = a2 + kstep; const char* b3 = b2 + kstep;
            if (last && has_next) S.a_ready(nxt);
            if constexpr (SP2) {
            PG8_LDB(B0, 0, 0); PG8_LDB(B1, 0, 1); PG8_SCHED; PG8_LDA(At, 0, 0); PG8_STAGE(PG8_SA(1, 1), a1 + hstep, voffA);
            PG8_WAIT_V(8); PG8_WAIT_L(0); PG8_BAR; PG8_MMA(0, 0, At, B0); PG8_MMA(0, 1, At, B1); PG8_BAR; PG8_SCHED;
            PG8_LDA(At, 0, 1); PG8_STAGE(PG8_SB(0, 0), b2, voffB); PG8_STAGE(PG8_SB(0, 1), b2 + hstep, voffB); PG8_STAGE(PG8_SA(0, 0), a2, voffA);
            PG8_WAIT_V(8); PG8_WAIT_L(0); PG8_BAR; PG8_MMA(1, 0, At, B0); PG8_MMA(1, 1, At, B1); PG8_BAR; PG8_SCHED;
            PG8_LDB(B0, 1, 0); PG8_LDB(B1, 1, 1); PG8_SCHED; PG8_LDA(At, 1, 0); PG8_STAGE(PG8_SA(0, 1), a2 + hstep, voffA);
            PG8_WAIT_V(8); PG8_WAIT_L(0); PG8_BAR; PG8_MMA(0, 0, At, B0); PG8_MMA(0, 1, At, B1); PG8_BAR; PG8_SCHED;
            PG8_LDA(At, 1, 1); PG8_STAGE(PG8_SB(1, 0), b3, voffB); PG8_STAGE(PG8_SB(1, 1), b3 + hstep, voffB); PG8_STAGE(PG8_SA(1, 0), a3, voffA);
            PG8_WAIT_V(8); PG8_WAIT_L(0); PG8_BAR; PG8_MMA(1, 0, At, B0); PG8_MMA(1, 1, At, B1); PG8_BAR; PG8_SCHED;
            } else {
            PG8_LDB(B0, 0, 0); PG8_SCHED; PG8_LDA(At, 0, 0); PG8_STAGE(PG8_SA(1, 1), a1 + hstep, voffA);
            PG8_WAIT_L(8); PG8_BAR; PG8_WAIT_L(0); PG8_MMA(0, 0, At, B0); PG8_BAR; PG8_SCHED;
            PG8_LDB(B1, 0, 1); PG8_STAGE(PG8_SB(0, 0), b2, voffB);
            PG8_BAR; PG8_WAIT_L(0); PG8_MMA(0, 1, At, B1); PG8_BAR;
            PG8_LDA(At, 0, 1); PG8_STAGE(PG8_SA(0, 0), a2, voffA);
            PG8_BAR; PG8_WAIT_L(0); PG8_MMA(1, 0, At, B0); PG8_BAR; PG8_SCHED;
            PG8_STAGE(PG8_SB(0, 1), b2 + hstep, voffB);
            PG8_WAIT_V(6); PG8_BAR; PG8_MMA(1, 1, At, B1); PG8_BAR;
            PG8_LDB(B0, 1, 0); PG8_SCHED; PG8_LDA(At, 1, 0); PG8_STAGE(PG8_SA(0, 1), a2 + hstep, voffA);
            PG8_WAIT_L(8); PG8_BAR; PG8_WAIT_L(0); PG8_MMA(0, 0, At, B0); PG8_BAR; PG8_SCHED;
            PG8_LDB(B1, 1, 1); PG8_STAGE(PG8_SB(1, 0), b3, voffB);
            PG8_BAR; PG8_WAIT_L(0); PG8_MMA(0, 1, At, B1); PG8_BAR;
            PG8_LDA(At, 1, 1); PG8_STAGE(PG8_SA(1, 0), a3, voffA);
            PG8_BAR; PG8_WAIT_L(0); PG8_MMA(1, 0, At, B0); PG8_BAR; PG8_SCHED;
            PG8_STAGE(PG8_SB(1, 1), b3 + hstep, voffB);
            PG8_WAIT_V(6); PG8_BAR; PG8_MMA(1, 1, At, B1); PG8_BAR;
            }
        }
        if constexpr (ALIGN_EPI) { if (wr == 0) PG8_BAR; }
        if constexpr (!Epi::AFTER_DRAIN) { E(acc, cur, wr, wc, fr, fq); S.done(cur); }
        if (!has_next) break;
#pragma unroll
        for (int a = 0; a < 2; ++a)
#pragma unroll
            for (int b = 0; b < 2; ++b)
#pragma unroll
                for (int m = 0; m < 4; ++m)
#pragma unroll
                    for (int n = 0; n < 2; ++n) acc[a][b][m][n] = (f32x4){0.f, 0.f, 0.f, 0.f};
        cur = nxt; cA = nA; cB = nB; ++ui;
        if constexpr (ALIGN_EPI) { if (wr == 1) PG8_BAR; }
    }
    PG8_WAIT_V(0);
    if constexpr (!ALIGN_EPI) { if (wr == 0) PG8_BAR; }
    PG8_BAR;
    if constexpr (Epi::AFTER_DRAIN) { E.fused(acc, cur, wr, wc, fr, fq, lds, wid, lane); S.done(cur); }
#undef PG8_SA
#undef PG8_SB
#undef PG8_STAGE
#undef PG8_LDA
#undef PG8_LDB
#undef PG8_MMA
#undef PG8_WAIT_V
#undef PG8_WAIT_L
#undef PG8_BAR
#undef PG8_SCHED
}
}

#ifndef PG8_SP2
#define PG8_SP2 true
#endif
#define PG8_ALIGN true
constexpr int NWAVES = 8;
constexpr int BATCH = 2, SEQ = 8192, DM = 1024, M = BATCH * SEQ, NIN = 3788, NINP = 3840, FFN = 2816, DEPTH = 2;
constexpr int A_Q = 0, A_K = 256, A_V = 512, A_O = 768;
constexpr int R_R = 1024, R_K = 1408, R_V = 1792, R_WDF = 2176, R_AD = 2304, R_GD = 2368;
constexpr int S_Z = 2496, S_X = 2880, S_B = 3264, S_C = 3520, S_DT = 3776;
constexpr size_t MiB = 1u << 20;
constexpr size_t WS_CTL = 0, CTL_ZERO_BYTES = 64 * 1024;
constexpr size_t WS_GATES = 1 * MiB, WS_CT = 2 * MiB;
constexpr size_t WS_WIN = 4 * MiB, WS_WOUT = 12 * MiB, WS_WGU = 14 * MiB, WS_WDN = 25 * MiB;
constexpr size_t WS_XN = 32 * MiB, WS_COLS = 64 * MiB, WS_Y = 184 * MiB, WS_END = 248 * MiB;
constexpr size_t Y_AF = WS_Y, Y_AB = WS_Y + 8 * MiB, Y_RF = WS_Y + 16 * MiB, Y_RB = WS_Y + 28 * MiB, Y_SF = WS_Y + 40 * MiB, Y_SB = WS_Y + 52 * MiB;
constexpr int CW_BAR = 1024;
constexpr int RING_BYTES = 131072;
constexpr int LDS_BYTES = 147456, MISC_OFF = LDS_BYTES - 256;

#define GAS __attribute__((address_space(1)))
#define LAS __attribute__((address_space(3)))
typedef unsigned short bf16;
typedef unsigned v4u __attribute__((ext_vector_type(4)));
typedef unsigned v2u __attribute__((ext_vector_type(2)));
typedef float f32x4 __attribute__((ext_vector_type(4)));
typedef short bf16x8 __attribute__((ext_vector_type(8)));
typedef GAS unsigned gu32;
#define RLX_AGENT __ATOMIC_RELAXED, __HIP_MEMORY_SCOPE_AGENT
#define LDS_WAIT() asm volatile("s_waitcnt lgkmcnt(0)" ::: "memory")
#define VM_WAIT() asm volatile("s_waitcnt vmcnt(0)" ::: "memory")
__device__ __forceinline__ unsigned f2bf(float f) { unsigned u = __builtin_bit_cast(unsigned, f); return (u + 0x7fffu + ((u >> 16) & 1u)) >> 16; }
__device__ __forceinline__ unsigned pk2(float lo, float hi) { return f2bf(lo) | (f2bf(hi) << 16); }
__device__ __forceinline__ float bf2f(unsigned u) { return __builtin_bit_cast(float, u << 16); }
__device__ __forceinline__ float sigmoidf_(float x) { return __builtin_amdgcn_rcpf(1.f + __expf(-x)); }
__device__ __forceinline__ float siluf_(float x) { return x * sigmoidf_(x); }
__device__ __forceinline__ float wave_sum(float v) {
#pragma unroll
    for (int o = 1; o < 64; o <<= 1) v += __shfl_xor(v, o);
    return v;
}
__device__ __forceinline__ float wave_max(float v) {
#pragma unroll
    for (int o = 1; o < 64; o <<= 1) v = fmaxf(v, __shfl_xor(v, o));
    return v;
}
template <int CTRL> __device__ __forceinline__ float dppf(float v) { return __builtin_bit_cast(float, __builtin_amdgcn_update_dpp(0, __builtin_bit_cast(int, v), CTRL, 0xf, 0xf, true)); }
__device__ __forceinline__ float row16_sum(float v) { v += dppf<0xB1>(v); v += dppf<0x4E>(v); v += dppf<0x141>(v); v += dppf<0x140>(v); return v; }
template <int K> __device__ __forceinline__ f32x4 mma16(const LAS bf16* A, int lda, const LAS bf16* Bt, int ldb, f32x4 acc, int lane) {
    const int r = lane & 15, q = lane >> 4;
    const LAS bf16* ap = A + r * lda + q * 8; const LAS bf16* bp = Bt + r * ldb + q * 8;
#pragma unroll
    for (int k0 = 0; k0 < K; k0 += 32) {
        const bf16x8 a = *(const LAS bf16x8*)(ap + k0); const bf16x8 b = *(const LAS bf16x8*)(bp + k0);
        acc = __builtin_amdgcn_mfma_f32_16x16x32_bf16(a, b, acc, 0, 0, 0);
    }
    return acc;
}
#define XB_TMO      128
#define XB_XCNT(j)  (256  + 64 * (j))
#define XB_XSUB(j)  (1280 + 64 * (j))
#define XB_XGEN(j)  (2304 + 64 * (j))
#define XB_TOP      3328
#define XB_TOPGEN   3392
#define XCD_BAR_WORDS 3456
#define XB_SPIN_CAP (1u << 18)

__device__ __forceinline__ unsigned xb_ld(unsigned* p)              { return __hip_atomic_load(p, __ATOMIC_RELAXED, __HIP_MEMORY_SCOPE_AGENT); }
__device__ __forceinline__ unsigned xb_add(unsigned* p, unsigned v) { return __hip_atomic_fetch_add(p, v, __ATOMIC_RELAXED, __HIP_MEMORY_SCOPE_AGENT); }
__device__ __forceinline__ unsigned xb_xcc_id() { return (unsigned)__builtin_amdgcn_s_getreg((3 << 11) | 20) & 0xFu; }
#define XB_SPIN(cond, bar) do { unsigned _sp = 0; while (cond) { __builtin_amdgcn_s_sleep(1); \
    if ((++_sp & 255u) == 0u) { if (xb_ld(&(bar)[XB_TMO])) break; if (_sp > XB_SPIN_CAP) { atomicAdd(&(bar)[XB_TMO], 1u); break; } } } } while (0)

struct XcdBarrier {
    unsigned* bar; unsigned x;
    volatile LAS unsigned* st;
};

__device__ __forceinline__ XcdBarrier xcd_barrier_post(unsigned* bar, volatile LAS unsigned* st) {
    XcdBarrier b; b.bar = bar; b.x = xb_xcc_id(); b.st = st;
    if (threadIdx.x == 0) (void)xb_add(&bar[XB_XCNT(b.x)], 1u);
    return b;
}
__device__ __forceinline__ void xcd_barrier_complete(unsigned* bar, unsigned x, unsigned& nloc, unsigned& nx) {
    const unsigned G = gridDim.x * gridDim.y * gridDim.z;
    unsigned sum, cnt, mine, sp = 0u;
    for (;;) {
        sum = 0u; cnt = 0u; mine = 0u;
#pragma unroll
        for (unsigned j = 0; j < 16; ++j) { const unsigned c = xb_ld(&bar[XB_XCNT(j)]); sum += c; cnt += (c > 0u) ? 1u : 0u; mine = (j == x) ? c : mine; }
        if (sum == G) break;
        __builtin_amdgcn_s_sleep(1);
        if ((++sp & 255u) == 0u) { if (xb_ld(&bar[XB_TMO])) break; if (sp > XB_SPIN_CAP) { atomicAdd(&bar[XB_TMO], 1u); break; } }
    }
    nloc = mine > 0u ? mine : 1u; nx = cnt > 0u ? cnt : 1u;
}

__device__ __forceinline__ void xcd_barrier(const XcdBarrier& b) {
    asm volatile("s_waitcnt vmcnt(0)" ::: "memory");
    __syncthreads();
    if (threadIdx.x == 0) {
        unsigned* bar = b.bar;
        __builtin_amdgcn_s_waitcnt(0);
        unsigned nloc = b.st[0], nx = b.st[1];
        if (nloc == 0u) { xcd_barrier_complete(bar, b.x, nloc, nx); b.st[0] = nloc; b.st[1] = nx; }
        const unsigned old = xb_add(&bar[XB_XSUB(b.x)], 1u);
        const unsigned gen = old / nloc;
        if (old + 1u == (gen + 1u) * nloc) {
            __builtin_amdgcn_fence(__ATOMIC_RELEASE, "agent");
            asm volatile("s_waitcnt vmcnt(0)" ::: "memory");
            const unsigned og = xb_add(&bar[XB_TOP], 1u);
            const unsigned tg = og / nx;
            if (og + 1u == (tg + 1u) * nx) xb_add(&bar[XB_TOPGEN], 1u);
            else XB_SPIN(xb_ld(&bar[XB_TOPGEN]) == tg, bar);
            __builtin_amdgcn_fence(__ATOMIC_ACQUIRE, "agent");
            xb_add(&bar[XB_XGEN(b.x)], 1u);
            asm volatile("s_waitcnt vmcnt(0)" ::: "memory");
        } else {
            XB_SPIN(xb_ld(&bar[XB_XGEN(b.x)]) == gen, bar);
            __builtin_amdgcn_fence(__ATOMIC_ACQUIRE, "agent");
            asm volatile("s_waitcnt vmcnt(0)" ::: "memory");
        }
    }
    __syncthreads();
}
struct Frame {
    LAS unsigned char* lds;
    int tid, lane, wave, vcu, G;
};
struct Args { const float* in[32]; float* out; unsigned char* ws; int ph_lo, ph_hi; };
constexpr int PTAB_OFF = LDS_BYTES - 768;
__device__ __forceinline__ unsigned long long ptab_ld(const Frame& F, int i) {
    const unsigned long long v = *(volatile LAS unsigned long long*)(F.lds + PTAB_OFF + 8 * i);
    const unsigned lo = __builtin_amdgcn_readfirstlane((unsigned)v), hi = __builtin_amdgcn_readfirstlane((unsigned)(v >> 32));
    return ((unsigned long long)hi << 32) | lo;
}
__device__ __forceinline__ const float* INP(const Frame& F, int i) { return (const float*)ptab_ld(F, i); }
__device__ __forceinline__ unsigned char* WSP(const Frame& F) { return (unsigned char*)ptab_ld(F, 33); }
__device__ __forceinline__ float* OUTP(const Frame& F) { return (float*)ptab_ld(F, 32); }

__device__ __forceinline__ void transpose_item(const float* W, int K, int N, int nblk, bf16* WT, int mode, int row_off, LAS float* scr, int item, int lane) {
    const int kb = item / nblk, nb = item % nblk, k0 = 64 * kb, n0 = 32 * nb;
    const int ncol = n0 + (lane & 31); const bool ok = ncol < N;
#pragma unroll 8
    for (int i = 0; i < 32; ++i) { const int kk = 2 * i + (lane >> 5); scr[kk * 33 + (lane & 31)] = ok ? W[(size_t)(k0 + kk) * N + ncol] : 0.f; }
    LDS_WAIT(); asm volatile("" ::: "memory");
    const int c = lane & 7;
    const int drow0 = mode ? (256 * (n0 >> 7) + (n0 & 127) + row_off) : (row_off + n0);
#pragma unroll
    for (int j = 0; j < 4; ++j) { const int n = (lane >> 3) + 8 * j; const LAS float* s = scr + (8 * c) * 33 + n;
        v4u o; o.x = pk2(s[0 * 33], s[1 * 33]); o.y = pk2(s[2 * 33], s[3 * 33]); o.z = pk2(s[4 * 33], s[5 * 33]); o.w = pk2(s[6 * 33], s[7 * 33]);
        *(v4u*)(WT + (size_t)(drow0 + n) * K + k0 + 8 * c) = o; }
    LDS_WAIT(); asm volatile("" ::: "memory");
}
__device__ __forceinline__ void phase_convert(const Frame& F, int l) {
    LAS float* scr = (LAS float*)(F.lds + F.wave * 16384);
    const int gw = F.vcu * NWAVES + F.wave, NGW = F.G * NWAVES;
    bf16* Win = (bf16*)(WSP(F) + WS_WIN); bf16* Wout = (bf16*)(WSP(F) + WS_WOUT); bf16* Wgu = (bf16*)(WSP(F) + WS_WGU); bf16* Wdn = (bf16*)(WSP(F) + WS_WDN);
    constexpr int I_IN = 16 * 120, I_OUT = 16 * 32, I_G = 16 * 88, I_D = 44 * 32;
    constexpr int NITEMS = I_IN + I_OUT + 2 * I_G + I_D;
    for (int it = gw; it < NITEMS; it += NGW) {
        int r = it;
        if (r < I_IN) { transpose_item(INP(F, 2) + (size_t)l * DM * NIN, DM, NIN, 120, Win, 0, 0, scr, r, F.lane); continue; } r -= I_IN;
        if (r < I_OUT) { transpose_item(INP(F, 26) + (size_t)l * DM * DM, DM, DM, 32, Wout, 0, 0, scr, r, F.lane); continue; } r -= I_OUT;
        if (r < I_G) { transpose_item(INP(F, 28) + (size_t)l * DM * FFN, DM, FFN, 88, Wgu, 1, 0, scr, r, F.lane); continue; } r -= I_G;
        if (r < I_G) { transpose_item(INP(F, 29) + (size_t)l * DM * FFN, DM, FFN, 88, Wgu, 1, 128, scr, r, F.lane); continue; } r -= I_G;
        transpose_item(INP(F, 30) + (size_t)l * FFN * DM, FFN, DM, 32, Wdn, 0, 0, scr, r, F.lane);
    }
}
__device__ __forceinline__ void phase_norm(const Frame& F, const float* hin, const float* g, bf16* XN) {
    const int gw = F.vcu * NWAVES + F.wave, NGW = F.G * NWAVES;
    f32x4 gv[4];
#pragma unroll
    for (int j = 0; j < 4; ++j) gv[j] = ((const f32x4*)g)[64 * j + F.lane];
    for (int m = gw; m < M; m += NGW) {
        const f32x4* xr = (const f32x4*)(hin + (size_t)m * DM) + F.lane;
        f32x4 v[4]; float s = 0.f;
#pragma unroll
        for (int j = 0; j < 4; ++j) { v[j] = xr[64 * j]; s += (v[j].x * v[j].x + v[j].y * v[j].y) + (v[j].z * v[j].z + v[j].w * v[j].w); }
        const float r = 1.f / sqrtf(wave_sum(s) * (1.f / DM) + 1e-6f);
        v2u* o8 = (v2u*)(XN + (size_t)m * DM) + F.lane;
#pragma unroll
        for (int j = 0; j < 4; ++j) { v2u w; w.x = pk2(v[j].x * r * gv[j].x, v[j].y * r * gv[j].y); w.y = pk2(v[j].z * r * gv[j].z, v[j].w * r * gv[j].w); o8[64 * j] = w; }
    }
}
__device__ __forceinline__ void phase_final_norm(const Frame& F, float* h, const float* g) {
    const int gw = F.vcu * NWAVES + F.wave, NGW = F.G * NWAVES;
    f32x4 gv[4];
#pragma unroll
    for (int j = 0; j < 4; ++j) gv[j] = ((const f32x4*)g)[64 * j + F.lane];
    for (int m = gw; m < M; m += NGW) {
        f32x4* xr = (f32x4*)(h + (size_t)m * DM) + F.lane;
        f32x4 v[4]; float s = 0.f;
#pragma unroll
        for (int j = 0; j < 4; ++j) { v[j] = xr[64 * j]; s += (v[j].x * v[j].x + v[j].y * v[j].y) + (v[j].z * v[j].z + v[j].w * v[j].w); }
        const float r = 1.f / sqrtf(wave_sum(s) * (1.f / DM) + 1e-6f);
#pragma unroll
        for (int j = 0; j < 4; ++j) xr[64 * j] = v[j] * r * gv[j];
    }
}
__device__ __forceinline__ void phase_gates(const Frame& F, int l) {
    const bf16* cols = (const bf16*)(WSP(F) + WS_COLS); float* GT = (float*)(WSP(F) + WS_GATES);
    LAS bf16* raw = (LAS bf16*)(F.lds);
    LAS float* feat = (LAS float*)(F.lds + 32768);
    LAS float* gw = (LAS float*)(F.lds + 81920);
    const float* gwg = INP(F, 5) + (size_t)l * 768 * 16; const float* gb = INP(F, 6) + l * 16;
    const float* cw = INP(F, 3) + (size_t)l * 5 * 512; const float* cb = INP(F, 4) + l * 512;
    for (int i = F.tid; i < 768 * 16; i += 512) gw[i] = gwg[i];
    for (int tile = F.vcu; tile < M / 16; tile += F.G) {
        const int m0 = tile * 16, t0 = m0 % SEQ;
        __syncthreads();
        for (int ch = F.tid; ch < 20 * 96; ch += 512) { const int rr = ch / 96, cc = ch % 96; const int t = t0 - 2 + rr;
            v4u v = {0u, 0u, 0u, 0u}; if (t >= 0 && t < SEQ) v = *(const v4u*)(cols + (size_t)(m0 - 2 + rr) * NINP + cc * 8);
            *(LAS v4u*)(raw + rr * 768 + cc * 8) = v; }
        __syncthreads();
        for (int idx = F.tid; idx < 16 * 768; idx += 512) { const int t = idx / 768, c = idx % 768; float val;
            if (c < 512) { float s = cb[c];
#pragma unroll
                for (int j = 0; j < 5; ++j) s += cw[j * 512 + c] * bf2f(raw[(t + j) * 768 + c]);
                val = siluf_(s); } else val = bf2f(raw[(t + 2) * 768 + c]);
            feat[idx] = val; }
        __syncthreads();
        { const int t = F.tid >> 5, o = (F.tid >> 1) & 15, hf = F.tid & 1; float s = 0.f;
          const LAS float* fp = feat + t * 768 + hf * 384; const LAS float* wp = gw + (hf * 384) * 16 + o;
#pragma unroll 8
          for (int i = 0; i < 384; ++i) s += fp[i] * wp[i * 16];
          s += __shfl_xor(s, 1);
          if (hf == 0) { s += gb[o]; if (o >= 8) s = fminf(s, 0.f) - log1pf(__expf(-fabsf(s))); GT[(size_t)(m0 + t) * 16 + o] = s; } }
    }
    __syncthreads();
}
__device__ __forceinline__ f32x4 mma16_a8(const LAS bf16* A8, const LAS bf16* Bt, f32x4 acc, int lane) {
    const int q = lane >> 4;
    const LAS bf16* ap = A8 + (lane & 7) * 72 + q * 8; const LAS bf16* bp = Bt + (lane & 15) * 72 + q * 8;
#pragma unroll
    for (int k0 = 0; k0 < 64; k0 += 32) { const bf16x8 a = *(const LAS bf16x8*)(ap + k0); const bf16x8 b = *(const LAS bf16x8*)(bp + k0); acc = __builtin_amdgcn_mfma_f32_16x16x32_bf16(a, b, acc, 0, 0, 0); }
    return acc;
}
typedef float f32x2 __attribute__((ext_vector_type(2)));
template <bool DIR> __device__ __forceinline__ void rwkv_steps(const LAS float* OPS, const LAS float* VV, LAS float* YB, f32x4& S, int j, int row) {
    float yk0 = 0.f, yk1 = 0.f;
    const LAS float* opb = OPS + 4 * j; const LAS float* vpb = VV + row;
    constexpr int T00 = DIR ? 31 : 0;
    f32x4 w4 = *(const LAS f32x4*)(opb + T00 * 320), kk4 = *(const LAS f32x4*)(opb + T00 * 320 + 64), ka4 = *(const LAS f32x4*)(opb + T00 * 320 + 128), km4 = *(const LAS f32x4*)(opb + T00 * 320 + 192), r4 = *(const LAS f32x4*)(opb + T00 * 320 + 256);
    float vv = vpb[T00 * 16];
#pragma unroll
    for (int i = 0; i < 32; ++i) {
        f32x4 nw4, nkk4, nka4, nkm4, nr4; float nvv;
        if (i < 31) { const int tn = DIR ? 30 - i : i + 1; const LAS float* op = opb + tn * 320;
            nw4 = *(const LAS f32x4*)(op); nkk4 = *(const LAS f32x4*)(op + 64); nka4 = *(const LAS f32x4*)(op + 128); nkm4 = *(const LAS f32x4*)(op + 192); nr4 = *(const LAS f32x4*)(op + 256); nvv = vpb[tn * 16]; }
        f32x2 t2 = S.xy * kk4.xy; t2 = S.zw * kk4.zw + t2;
        float sa = t2.x + t2.y;
        const f32x4 pre_s = S * w4 + km4 * vv;
        sa = row16_sum(sa);
        S = pre_s + ka4 * sa;
        f32x2 y2 = S.xy * r4.xy; y2 = S.zw * r4.zw + y2;
        float y = y2.x + y2.y;
        y = row16_sum(y);
        if ((i & 15) == j) { if (i < 16) yk0 = y; else yk1 = y; }
        if (i < 31) { w4 = nw4; kk4 = nkk4; ka4 = nka4; km4 = nkm4; r4 = nr4; vv = nvv; } }
    YB[(DIR ? 31 - j : j) * 16 + row] = yk0; YB[(DIR ? 15 - j : 16 + j) * 16 + row] = yk1;
}
__device__ __forceinline__ void rwkv_scan(const Frame& F, int l, int task) {
    const int b = task / 48, rem = task % 48, h = rem >> 3, dir = (rem >> 2) & 1, qtr = rem & 3;
    const bf16* cols = (const bf16*)(WSP(F) + WS_COLS);
    bf16* Y = (bf16*)(WSP(F) + (dir ? Y_RB : Y_RF));
    float* CT = (float*)(WSP(F) + WS_CT);
    LAS bf16* WA = (LAS bf16*)(F.lds); LAS bf16* WW = (LAS bf16*)(F.lds + 9216);
    const int tid = F.tid, lane = F.lane, wave = F.wave;
    LAS bf16* XA = (LAS bf16*)(F.lds + 18432) + (wave & 3) * 576; LAS bf16* XW = (LAS bf16*)(F.lds + 23040) + (wave & 3) * 576;
    LAS bf16* RAWB = (LAS bf16*)(F.lds + 27648) + (wave & 3) * 3200;
    LAS float* MU = (LAS float*)(F.lds + 53248);
    LAS float* OPSb = (LAS float*)(F.lds + 55808);
    LAS float* VVb = (LAS float*)(F.lds + 137728);
    LAS float* YBb = (LAS float*)(F.lds + 141824);
    constexpr int NB = SEQ / 32;
    __syncthreads();
    { const float* aup = INP(F, 13) + (size_t)l * 64 * 384; const float* wup = INP(F, 11) + (size_t)(l * 2 + dir) * 64 * 384;
      for (int idx = tid; idx < 4096; idx += 512) { const int i = idx >> 6, c = idx & 63;
          WA[c * 72 + i] = (bf16)f2bf(aup[i * 384 + h * 64 + c]); WW[c * 72 + i] = (bf16)f2bf(wup[i * 384 + h * 64 + c]); }
      if (tid < 320) { const int which = tid >> 6, c = tid & 63;
          const int rc = which == 0 ? h * 64 + c : which == 1 ? 384 + h * 64 + c : which == 2 ? 768 + h * 64 + c : which == 3 ? 1152 + dir * 64 + c : 1280 + c;
          MU[tid] = INP(F, 8)[l * 1472 + rc]; MU[320 + tid] = INP(F, 9)[l * 1472 + rc]; } }
    __syncthreads();
    const size_t mb = (size_t)b * SEQ;
    const int j = lane & 15;
    if (wave < 4) {
        const int pw = wave;
        const int hc4 = h * 64 + 4 * j;
        const f32x4 kk_c4 = *(const f32x4*)(INP(F, 15) + l * 384 + hc4), ka_c4 = *(const f32x4*)(INP(F, 16) + l * 384 + hc4), rk_c4 = *(const f32x4*)(INP(F, 17) + l * 384 + hc4);
        float ba[4], bw[4];
#pragma unroll
        for (int ct = 0; ct < 4; ++ct) { ba[ct] = INP(F, 12)[l * 384 + h * 64 + 16 * ct + j]; bw[ct] = INP(F, 10)[(l * 2 + dir) * 384 + h * 64 + 16 * ct + j]; }
        const int c2 = (lane & 31) * 2;
        float mup_[5][2], mun_[5][2];
#pragma unroll
        for (int wq = 0; wq < 5; ++wq) { mup_[wq][0] = MU[wq * 64 + c2]; mup_[wq][1] = MU[wq * 64 + c2 + 1]; mun_[wq][0] = MU[320 + wq * 64 + c2]; mun_[wq][1] = MU[320 + wq * 64 + c2 + 1]; }
        v4u pre[7];
#define RW_ISSUE(blk) do { const int T0_ = dir ? SEQ - 32 * ((blk) + 1) : 32 * (blk); _Pragma("unroll") for (int i_ = 0; i_ < 7; ++i_) { const int idx_ = lane + 64 * i_; pre[i_] = (v4u){0u, 0u, 0u, 0u}; \
        if (idx_ < 400) { const int rr_ = idx_ / 40, q_ = idx_ % 40, wh_ = q_ >> 3, c8_ = q_ & 7; const int t_ = T0_ + 8 * pw - 1 + rr_; \
            const int gc_ = (wh_ == 0 ? R_R + h * 64 : wh_ == 1 ? R_K + h * 64 : wh_ == 2 ? R_V + h * 64 : wh_ == 3 ? R_WDF + dir * 64 : R_AD) + c8_ * 8; \
            if (t_ >= 0 && t_ < SEQ) pre[i_] = *(const v4u*)(cols + (mb + t_) * NINP + gc_); } } } while (0)
        RW_ISSUE(0);
#pragma unroll 1
        for (int it = 0; it <= NB; ++it) {
            if (it < NB) {
                const int T0 = dir ? SEQ - 32 * (it + 1) : 32 * it;
                LAS float* OPS = OPSb + (it & 1) * 10240; LAS float* VV = VVb + (it & 1) * 512;
#pragma unroll
                for (int i = 0; i < 7; ++i) { const int idx = lane + 64 * i; if (idx < 400) *(LAS v4u*)(RAWB + idx * 8) = pre[i]; }
                LDS_WAIT(); asm volatile("" ::: "memory");
                if (it + 1 < NB) RW_ISSUE(it + 1);
#pragma unroll
                for (int k2 = 0; k2 < 20; ++k2) { const int which = k2 >> 2, tt = 2 * (k2 & 3) + (lane >> 5), cc = which * 64 + c2, t = 8 * pw + tt;
                    const unsigned r0 = *(const LAS unsigned*)(RAWB + tt * 320 + cc), r1 = *(const LAS unsigned*)(RAWB + (tt + 1) * 320 + cc), r2 = *(const LAS unsigned*)(RAWB + (tt + 2) * 320 + cc);
                    const float p1x = bf2f(r1 & 0xffffu), p1y = bf2f(r1 >> 16);
                    const float vx = p1x + mup_[which][0] * (bf2f(r0 & 0xffffu) - p1x) + mun_[which][0] * (bf2f(r2 & 0xffffu) - p1x);
                    const float vy = p1y + mup_[which][1] * (bf2f(r0 >> 16) - p1y) + mun_[which][1] * (bf2f(r2 >> 16) - p1y);
                    if (which == 0) *(LAS f32x2*)(OPS + t * 320 + 256 + c2) = (f32x2){vx, vy};
                    else if (which == 1) *(LAS f32x2*)(OPS + t * 320 + 192 + c2) = (f32x2){vx, vy};
                    else if (which == 2) { if ((c2 >> 4) == qtr) *(LAS f32x2*)(VV + t * 16 + (c2 & 15)) = (f32x2){vx, vy}; }
                    else if (which == 3) { const float ex = __expf(2.f * vx), ey = __expf(2.f * vy);
                        *(LAS unsigned*)(XW + tt * 72 + c2) = pk2(1.f - 2.f * __builtin_amdgcn_rcpf(ex + 1.f), 1.f - 2.f * __builtin_amdgcn_rcpf(ey + 1.f)); }
                    else *(LAS unsigned*)(XA + tt * 72 + c2) = pk2(vx, vy); }
                LDS_WAIT(); asm volatile("" ::: "memory");
#pragma unroll
                for (int ct = 0; ct < 4; ++ct) { const f32x4 z = {0.f, 0.f, 0.f, 0.f};
                    const f32x4 ca = mma16_a8(XA, WA + ct * 16 * 72, z, lane), cw = mma16_a8(XW, WW + ct * 16 * 72, z, lane);
                    const bool hi = lane >= 32; const int tb = 8 * pw + ((lane >> 4) & 1) * 4 + (hi ? 2 : 0), c = ct * 16 + j;
                    const float a0v = hi ? ca[2] : ca[0], a1v = hi ? ca[3] : ca[1], w0v = hi ? cw[2] : cw[0], w1v = hi ? cw[3] : cw[1];
                    OPS[tb * 320 + 128 + c] = sigmoidf_(ba[ct] + a0v); OPS[(tb + 1) * 320 + 128 + c] = sigmoidf_(ba[ct] + a1v);
                    OPS[tb * 320 + c] = __expf(-0.6065306597f * sigmoidf_(bw[ct] + w0v)); OPS[(tb + 1) * 320 + c] = __expf(-0.6065306597f * sigmoidf_(bw[ct] + w1v)); }
                LDS_WAIT(); asm volatile("" ::: "memory");
#pragma unroll
                for (int ps = 0; ps < 2; ++ps) { const int t = 8 * pw + 4 * ps + (lane >> 4); LAS float* op = OPS + t * 320 + 4 * j;
                    const f32x4 av = *(const LAS f32x4*)(op + 128), kp = *(const LAS f32x4*)(op + 192), rp = *(const LAS f32x4*)(op + 256);
                    const f32x4 kr = kp * kk_c4; const float ss = row16_sum((kr.x * kr.x + kr.y * kr.y) + (kr.z * kr.z + kr.w * kr.w));
                    const f32x4 kkv = kr * (1.f / fmaxf(sqrtf(ss), 1e-12f));
                    const f32x4 km = kp * ((av - 1.f) * ka_c4 + 1.f);
                    const f32x4 q = rp * km * rk_c4; const float cs = row16_sum((q.x + q.y) + (q.z + q.w));
                    *(LAS f32x4*)(op + 64) = kkv; *(LAS f32x4*)(op + 128) = kkv * (-av); *(LAS f32x4*)(op + 192) = km;
                    if (dir == 0 && qtr == 0 && j == 0) CT[(mb + T0 + t) * 8 + h] = cs; }
            }
            if (it >= 2) { const int bk = it - 2; const int T0 = dir ? SEQ - 32 * (bk + 1) : 32 * bk; const LAS float* YB = YBb + (bk & 1) * 512;
                const int idx = (pw * 64 + lane) * 2, tl = idx >> 4, rw = idx & 15;
                *(unsigned*)(Y + (mb + T0 + tl) * 384 + h * 64 + 16 * qtr + rw) = pk2(YB[idx], YB[idx + 1]); }
            __syncthreads();
        }
        { const int bk = NB - 1; const int T0 = dir ? SEQ - 32 * (bk + 1) : 32 * bk; const LAS float* YB = YBb + (bk & 1) * 512;
          const int idx = (pw * 64 + lane) * 2, tl = idx >> 4, rw = idx & 15;
          *(unsigned*)(Y + (mb + T0 + tl) * 384 + h * 64 + 16 * qtr + rw) = pk2(YB[idx], YB[idx + 1]); }
#undef RW_ISSUE
    } else {
        const int row = (wave - 4) * 4 + (lane >> 4);
        f32x4 S = {0.f, 0.f, 0.f, 0.f};
#pragma unroll 1
        for (int it = 0; it <= NB; ++it) {
            if (it >= 1) { const int bk = it - 1;
                const LAS float* OPS = OPSb + (bk & 1) * 10240; const LAS float* VV = VVb + (bk & 1) * 512; LAS float* YB = YBb + (bk & 1) * 512;
                __builtin_amdgcn_s_setprio(3);
                if (dir) rwkv_steps<true>(OPS, VV, YB, S, j, row); else rwkv_steps<false>(OPS, VV, YB, S, j, row);
                __builtin_amdgcn_s_setprio(0);
            }
            __syncthreads();
        }
    }
    __syncthreads();
}
__device__ __forceinline__ float row8_sum(float v) { v += dppf<0xB1>(v); v += dppf<0x4E>(v); v += dppf<0x141>(v); return v; }
__device__ __forceinline__ void mlstm_seq(const Frame& F, int l, int task) {
    const int b = task >> 3, h = (task >> 1) & 3, dir = task & 1;
    const bf16* cols = (const bf16*)(WSP(F) + WS_COLS); const float* GT = (const float*)(WSP(F) + WS_GATES);
    bf16* Y = (bf16*)(WSP(F) + (dir ? Y_AB : Y_AF));
    LAS bf16* RAWQ = (LAS bf16*)(F.lds);
    LAS bf16* Qs = (LAS bf16*)(F.lds + 17408); LAS bf16* Ks = (LAS bf16*)(F.lds + 26624);
    LAS bf16* Vtb = (LAS bf16*)(F.lds + 35840);
    LAS bf16* KWt = (LAS bf16*)(F.lds + 54272); LAS bf16* Ps = (LAS bf16*)(F.lds + 63488);
    LAS bf16* Ctb = (LAS bf16*)(F.lds + 72704);
    LAS float* ub = (LAS float*)(F.lds + 91136);
    LAS float* blb = ub + 128; LAS float* rmb = ub + 256;
    LAS float* den = ub + 384; LAS float* qn = ub + 448; LAS float* nst = ub + 512; LAS float* scb = ub + 576;
    const int tid = F.tid, lane = F.lane, wave = F.wave;
    const size_t mb = (size_t)b * SEQ;
    constexpr int NC = SEQ / 64;
    __syncthreads();
    for (int i = tid; i < 2 * 64 * 72; i += 512) Ctb[i] = 0;
    if (tid < 64) nst[tid] = 0.f;
    const int cc = tid & 127, isK = cc >> 6, d0 = cc & 63, chn = isK * 256 + h * 64 + d0;
    float cw[5]; const float* cwp = INP(F, 3) + (size_t)l * 5 * 512;
#pragma unroll
    for (int jj = 0; jj < 5; ++jj) cw[jj] = cwp[jj * 512 + chn];
    const float cbv = INP(F, 4)[l * 512 + chn];
    f32x4 st[2] = {{0.f, 0.f, 0.f, 0.f}, {0.f, 0.f, 0.f, 0.f}};
    float m_st = 0.f;
    v4u pre[3], prev; float gli = 0.f, glf = 0.f;
#define ML_ISSUE(c_) do { const int tlo_ = dir ? SEQ - 64 * ((c_) + 1) : 64 * (c_); _Pragma("unroll") for (int i_ = 0; i_ < 3; ++i_) { const int ch_ = tid + 512 * i_; pre[i_] = (v4u){0u, 0u, 0u, 0u}; \
        if (ch_ < 68 * 16) { const int rr_ = ch_ >> 4, q_ = ch_ & 15; const int t_ = tlo_ - 2 + rr_; if (t_ >= 0 && t_ < SEQ) pre[i_] = *(const v4u*)(cols + (mb + t_) * NINP + (q_ >> 3) * 256 + h * 64 + (q_ & 7) * 8); } } \
        prev = *(const v4u*)(cols + (mb + tlo_ + (tid >> 3)) * NINP + A_V + h * 64 + (tid & 7) * 8); \
        if (tid < 64) { const int t_ = dir ? tlo_ + 63 - tid : tlo_ + tid; gli = GT[(mb + t_) * 16 + dir * 4 + h]; glf = GT[(mb + t_) * 16 + 8 + dir * 4 + h]; } } while (0)
#define ML_FILL(c_) do { _Pragma("unroll") for (int i_ = 0; i_ < 3; ++i_) { const int ch_ = tid + 512 * i_; if (ch_ < 68 * 16) *(LAS v4u*)(RAWQ + (ch_ >> 4) * 128 + (ch_ & 15) * 8) = pre[i_]; } \
        { LAS bf16* Vt_ = Vtb + ((c_) & 1) * 4608; const int tl_ = tid >> 3, e8_ = tid & 7; const int lp_ = dir ? 63 - tl_ : tl_; const unsigned w_[4] = {prev.x, prev.y, prev.z, prev.w}; \
          _Pragma("unroll") for (int k_ = 0; k_ < 4; ++k_) { Vt_[(e8_ * 8 + 2 * k_) * 72 + lp_] = (bf16)(w_[k_] & 0xffffu); Vt_[(e8_ * 8 + 2 * k_ + 1) * 72 + lp_] = (bf16)(w_[k_] >> 16); } } \
        if (tid < 64) { float bl_ = glf; _Pragma("unroll") for (int o_ = 1; o_ < 64; o_ <<= 1) { const float x_ = __shfl_up(bl_, o_); if (lane >= o_) bl_ += x_; } \
            const float u_ = gli - bl_; float rm_ = u_; _Pragma("unroll") for (int o_ = 1; o_ < 64; o_ <<= 1) { const float x_ = __shfl_up(rm_, o_); if (lane >= o_) rm_ = fmaxf(rm_, x_); } \
            ub[((c_) & 1) * 64 + tid] = u_; blb[((c_) & 1) * 64 + tid] = bl_; rmb[((c_) & 1) * 64 + tid] = rm_; if (tid == 63) { scb[((c_) & 1) * 2] = rm_; scb[((c_) & 1) * 2 + 1] = bl_; } } } while (0)
    ML_ISSUE(0); ML_FILL(0); ML_ISSUE(1);
    __syncthreads();
#pragma unroll 1
    for (int c = 0; c < NC; ++c) {
        const int tlo = dir ? SEQ - 64 * (c + 1) : 64 * c;
        const LAS float* u = ub + (c & 1) * 64; const LAS float* bl = blb + (c & 1) * 64; const LAS float* rm = rmb + (c & 1) * 64;
        const LAS bf16* Vt = Vtb + (c & 1) * 4608; const LAS bf16* Ct = Ctb + (c & 1) * 4608; LAS bf16* Ctn = Ctb + ((c + 1) & 1) * 4608;
#pragma unroll 4
        for (int i = 0; i < 16; ++i) { const int tl = (tid >> 7) + 4 * i; float s = cbv;
#pragma unroll
            for (int jj = 0; jj < 5; ++jj) s += cw[jj] * bf2f(RAWQ[(tl + jj) * 128 + cc]);
            s = siluf_(s); const int lpos = dir ? 63 - tl : tl;
            if (isK) Ks[lpos * 72 + d0] = (bf16)f2bf(s * 0.125f); else Qs[lpos * 72 + d0] = (bf16)f2bf(s); }
        if (tid < 64) den[tid] = 0.f;
        __syncthreads();
        const float umax = scb[(c & 1) * 2], tot = scb[(c & 1) * 2 + 1];
        for (int idx = tid; idx < 4096; idx += 512) { const int lp = idx >> 6, d = idx & 63; KWt[d * 72 + lp] = (bf16)f2bf(bf2f(Ks[lp * 72 + d]) * __expf(u[lp] - umax)); }
#pragma unroll
        for (int k = 0; k < 2; ++k) { const int ti = 2 * wave + k, tl_ = ti >> 2, ts = ti & 3; f32x4 acc = {0.f, 0.f, 0.f, 0.f};
            if (ts <= tl_) acc = mma16<64>(Qs + tl_ * 16 * 72, 72, Ks + ts * 16 * 72, 72, acc, lane);
#pragma unroll
            for (int jj = 0; jj < 4; ++jj) { const int lr = tl_ * 16 + (lane >> 4) * 4 + jj, s = ts * 16 + (lane & 15);
                const float v = (s <= lr) ? acc[jj] * __expf(u[s] - fmaxf(m_st, rm[lr])) : 0.f; const unsigned vb = f2bf(v); Ps[lr * 72 + s] = (bf16)vb;
                if (ts <= tl_) { const float rs = row16_sum(bf2f(vb)); if ((lane & 15) == 0) __hip_atomic_fetch_add(den + lr, rs, __ATOMIC_RELAXED, __HIP_MEMORY_SCOPE_WORKGROUP); } } }
        { const int lq = tid >> 3, part = tid & 7; float s = 0.f;
#pragma unroll
          for (int k = 0; k < 8; ++k) s += bf2f(Qs[lq * 72 + part * 8 + k]) * nst[part * 8 + k];
          s = row8_sum(s); if (part == 0) qn[lq] = s; }
        __syncthreads();
        const float mmax = fmaxf(m_st, umax), s_old = __expf(m_st - mmax), s_new = __expf(umax - mmax);
#pragma unroll
        for (int k = 0; k < 2; ++k) { const int ti = 2 * wave + k, t0_ = ti >> 2, t1_ = ti & 3; const f32x4 z = {0.f, 0.f, 0.f, 0.f};
            const f32x4 a1 = mma16<64>(Ps + t0_ * 16 * 72, 72, Vt + t1_ * 16 * 72, 72, z, lane);
            const f32x4 a2 = mma16<64>(Qs + t0_ * 16 * 72, 72, Ct + t1_ * 16 * 72, 72, z, lane);
            const f32x4 lc = mma16<64>(Vt + t0_ * 16 * 72, 72, KWt + t1_ * 16 * 72, 72, z, lane);
#pragma unroll
            for (int jj = 0; jj < 4; ++jj) { const int r_ = t0_ * 16 + (lane >> 4) * 4 + jj, c_ = t1_ * 16 + (lane & 15);
                const float mx = fmaxf(m_st, rm[r_]), iwv = __expf(m_st - mx);
                const float dn = den[r_] + iwv * qn[r_];
                const float val = (a1[jj] + iwv * a2[jj]) / fmaxf(fabsf(dn), __expf(-(bl[r_] + mx)));
                const int t = dir ? tlo + 63 - r_ : tlo + r_;
                Y[(mb + t) * 256 + h * 64 + c_] = (bf16)f2bf(val);
                st[k][jj] = s_old * st[k][jj] + s_new * lc[jj];
                Ctn[r_ * 72 + c_] = (bf16)f2bf(st[k][jj]); } }
        { const int dq = tid >> 3, part = tid & 7; float s = 0.f;
#pragma unroll
          for (int k = 0; k < 8; ++k) s += bf2f(KWt[dq * 72 + part * 8 + k]);
          s = row8_sum(s); if (part == 0) nst[dq] = s_old * nst[dq] + s_new * s; }
        m_st = tot + mmax;
        if (c + 1 < NC) { ML_FILL(c + 1); if (c + 2 < NC) ML_ISSUE(c + 2); }
        __syncthreads();
    }
#undef ML_ISSUE
#undef ML_FILL
}
__device__ __forceinline__ void phase_ssd_conv(const Frame& F, int l) {
    const bf16* cols = (const bf16*)(WSP(F) + WS_COLS); bf16* XBC = (bf16*)(WSP(F) + WS_XN);
    LAS bf16* raw = (LAS bf16*)(F.lds);
    const float* cwp = INP(F, 20) + (size_t)l * 5 * 896; const float* cbp = INP(F, 21) + l * 896;
    const int tid = F.tid;
    float cw0[5], cw1[5]; const int c1 = tid + 512 < 896 ? tid + 512 : tid;
#pragma unroll
    for (int jj = 0; jj < 5; ++jj) { cw0[jj] = cwp[jj * 896 + tid]; cw1[jj] = cwp[jj * 896 + c1]; }
    const float cb0 = cbp[tid], cb1 = cbp[c1];
    for (int tile = F.vcu; tile < M / 32; tile += F.G) {
        const int m0 = tile * 32, t0 = m0 % SEQ;
        __syncthreads();
        for (int ch = tid; ch < 36 * 112; ch += 512) { const int rr = ch / 112, cc = ch % 112; const int t = t0 - 2 + rr;
            v4u v = {0u, 0u, 0u, 0u}; if (t >= 0 && t < SEQ) v = *(const v4u*)(cols + (size_t)(m0 - 2 + rr) * NINP + S_X + cc * 8);
            *(LAS v4u*)(raw + rr * 896 + cc * 8) = v; }
        __syncthreads();
#pragma unroll
        for (int half = 0; half < 2; ++half) { const int c = half ? c1 : tid; if (half && tid + 512 >= 896) break;
            float win[5];
#pragma unroll
            for (int jj = 0; jj < 4; ++jj) win[jj] = bf2f(raw[jj * 896 + c]);
            for (int tl = 0; tl < 32; ++tl) { win[4] = bf2f(raw[(tl + 4) * 896 + c]);
                float s = half ? cb1 : cb0;
#pragma unroll
                for (int jj = 0; jj < 5; ++jj) s += (half ? cw1[jj] : cw0[jj]) * win[jj];
#pragma unroll
                for (int jj = 0; jj < 4; ++jj) win[jj] = win[jj + 1];
                XBC[(size_t)(m0 + tl) * 896 + c] = (bf16)f2bf(siluf_(s)); } }
    }
    __syncthreads();
}
__device__ __forceinline__ void ssd_seq(const Frame& F, int l, int task) {
    const int b = task / 12, rem = task % 12, head = rem >> 1, dir = rem & 1, g = head / 3;
    const bf16* cols = (const bf16*)(WSP(F) + WS_COLS); const bf16* XBC = (const bf16*)(WSP(F) + WS_XN);
    bf16* Y = (bf16*)(WSP(F) + (dir ? Y_SB : Y_SF));
    LAS bf16* Cm = (LAS bf16*)(F.lds); LAS bf16* Bm = (LAS bf16*)(F.lds + 17408);
    LAS bf16* Btw = (LAS bf16*)(F.lds + 34816); LAS bf16* Xt = (LAS bf16*)(F.lds + 53248);
    LAS bf16* Ps = (LAS bf16*)(F.lds + 62464); LAS bf16* Hs = (LAS bf16*)(F.lds + 71680);
    LAS float* dtvb = (LAS float*)(F.lds + 89088);
    LAS float* acsb = dtvb + 128;
    LAS float* totb = dtvb + 256;
    const int tid = F.tid, lane = F.lane, wave = F.wave;
    const size_t mb = (size_t)b * SEQ;
    constexpr int NC = SEQ / 64;
    __syncthreads();
    for (int i = tid; i < 64 * 136; i += 512) Hs[i] = 0;
    const float dtb = INP(F, 22)[(l * 2 + dir) * 6 + head];
    const float aneg = -__expf(INP(F, 23)[(l * 2 + dir) * 6 + head]);
    f32x4 st[4];
#pragma unroll
    for (int k = 0; k < 4; ++k) st[k] = (f32x4){0.f, 0.f, 0.f, 0.f};
    v4u pre[5]; float dtraw = 0.f;
#define SSD_ISSUE(c_) do { const int tlo_ = dir ? SEQ - 64 * ((c_) + 1) : 64 * (c_); _Pragma("unroll") for (int i_ = 0; i_ < 5; ++i_) { const int idx_ = tid + 512 * i_; const int tl_ = idx_ / 40, q_ = idx_ % 40; \
        const int gc_ = q_ < 8 ? head * 64 + q_ * 8 : (q_ < 24 ? 384 + g * 128 + (q_ - 8) * 8 : 640 + g * 128 + (q_ - 24) * 8); \
        pre[i_] = *(const v4u*)(XBC + (mb + tlo_ + tl_) * 896 + gc_); } } while (0)
#define SSD_DTLOAD(c_) do { if (tid < 64) { const int tlo_ = dir ? SEQ - 64 * ((c_) + 1) : 64 * (c_); const int t_ = dir ? tlo_ + 63 - tid : tlo_ + tid; dtraw = bf2f(cols[(mb + t_) * NINP + S_DT + dir * 6 + head]); } } while (0)
#define SSD_DTCALC(c_) do { if (tid < 64) { const float x_ = dtraw + dtb; const float dt_ = x_ > 20.f ? x_ : log1pf(__expf(x_)); float cs_ = dt_ * aneg; \
        _Pragma("unroll") for (int o_ = 1; o_ < 64; o_ <<= 1) { const float u_ = __shfl_up(cs_, o_); if (lane >= o_) cs_ += u_; } \
        const float tt_ = __shfl(cs_, 63); dtvb[((c_) & 1) * 64 + tid] = dt_; acsb[((c_) & 1) * 64 + tid] = cs_; if (tid == 0) totb[(c_) & 1] = tt_; } } while (0)
    SSD_ISSUE(0); SSD_DTLOAD(0); SSD_DTCALC(0); SSD_DTLOAD(1);
    __syncthreads();
#pragma unroll 1
    for (int c = 0; c < NC; ++c) {
        const int tlo = dir ? SEQ - 64 * (c + 1) : 64 * c;
        const LAS float* dtv = dtvb + (c & 1) * 64; const LAS float* acs = acsb + (c & 1) * 64; const float tot = totb[c & 1];
#pragma unroll
        for (int i = 0; i < 5; ++i) { const int idx = tid + 512 * i; const int tl = idx / 40, q = idx % 40; const int lp = dir ? 63 - tl : tl;
            const unsigned w[4] = {pre[i].x, pre[i].y, pre[i].z, pre[i].w};
            if (q < 8) {
#pragma unroll
                for (int k = 0; k < 4; ++k) { Xt[(q * 8 + 2 * k) * 72 + lp] = (bf16)(w[k] & 0xffffu); Xt[(q * 8 + 2 * k + 1) * 72 + lp] = (bf16)(w[k] >> 16); } }
            else if (q < 24) { const int n0 = (q - 8) * 8; *(LAS v4u*)(Bm + lp * 136 + n0) = pre[i]; const float sc = dtv[lp] * __expf(tot - acs[lp]);
#pragma unroll
                for (int k = 0; k < 4; ++k) { Btw[(n0 + 2 * k) * 72 + lp] = (bf16)f2bf(bf2f(w[k] & 0xffffu) * sc); Btw[(n0 + 2 * k + 1) * 72 + lp] = (bf16)f2bf(bf2f(w[k] >> 16) * sc); } }
            else { const int n0 = (q - 24) * 8; *(LAS v4u*)(Cm + lp * 136 + n0) = pre[i]; } }
        if (c + 1 < NC) SSD_ISSUE(c + 1);
        __syncthreads();
        f32x4 yo[2], lc[4];
#pragma unroll
        for (int k = 0; k < 2; ++k) { const int ti = 2 * wave + k, tl_ = ti >> 2, ts = ti & 3; f32x4 acc = {0.f, 0.f, 0.f, 0.f};
            if (ts <= tl_) acc = mma16<128>(Cm + tl_ * 16 * 136, 136, Bm + ts * 16 * 136, 136, acc, lane);
#pragma unroll
            for (int jj = 0; jj < 4; ++jj) { const int lr = tl_ * 16 + (lane >> 4) * 4 + jj, s = ts * 16 + (lane & 15);
                const float v = (s <= lr) ? acc[jj] * __expf(acs[lr] - acs[s]) * dtv[s] : 0.f; Ps[lr * 72 + s] = (bf16)f2bf(v); }
            const f32x4 z = {0.f, 0.f, 0.f, 0.f};
            yo[k] = mma16<128>(Cm + tl_ * 16 * 136, 136, Hs + ts * 16 * 136, 136, z, lane); }
#pragma unroll
        for (int k = 0; k < 4; ++k) { const int ti = 4 * wave + k, tp = ti >> 3, tn = ti & 7; const f32x4 z = {0.f, 0.f, 0.f, 0.f};
            lc[k] = mma16<64>(Xt + tp * 16 * 72, 72, Btw + tn * 16 * 72, 72, z, lane); }
        __syncthreads();
        const float cdec = __expf(tot);
#pragma unroll
        for (int k = 0; k < 2; ++k) { const int ti = 2 * wave + k, tl_ = ti >> 2, tp = ti & 3; const f32x4 z = {0.f, 0.f, 0.f, 0.f};
            const f32x4 yd = mma16<64>(Ps + tl_ * 16 * 72, 72, Xt + tp * 16 * 72, 72, z, lane);
#pragma unroll
            for (int jj = 0; jj < 4; ++jj) { const int lr = tl_ * 16 + (lane >> 4) * 4 + jj, p = tp * 16 + (lane & 15);
                const float val = yd[jj] + yo[k][jj] * __expf(acs[lr]);
                const int t = dir ? tlo + 63 - lr : tlo + lr;
                Y[(mb + t) * 384 + head * 64 + p] = (bf16)f2bf(val); } }
#pragma unroll
        for (int k = 0; k < 4; ++k) { const int ti = 4 * wave + k, tp = ti >> 3, tn = ti & 7;
#pragma unroll
            for (int jj = 0; jj < 4; ++jj) { const int p = tp * 16 + (lane >> 4) * 4 + jj, n = tn * 16 + (lane & 15);
                st[k][jj] = cdec * st[k][jj] + lc[k][jj]; Hs[p * 136 + n] = (bf16)f2bf(st[k][jj]); } }
        if (c + 1 < NC) { SSD_DTCALC(c + 1); if (c + 2 < NC) SSD_DTLOAD(c + 2); }
        __syncthreads();
    }
#undef SSD_ISSUE
#undef SSD_DTLOAD
#undef SSD_DTCALC
}
__device__ __forceinline__ void phase_post(const Frame& F, int l) {
    const bf16* cols = (const bf16*)(WSP(F) + WS_COLS); bf16* MIX = (bf16*)(WSP(F) + WS_XN);
    const bf16* YAf = (const bf16*)(WSP(F) + Y_AF); const bf16* YAb = (const bf16*)(WSP(F) + Y_AB);
    const bf16* YRf = (const bf16*)(WSP(F) + Y_RF); const bf16* YRb = (const bf16*)(WSP(F) + Y_RB);
    const bf16* YSf = (const bf16*)(WSP(F) + Y_SF); const bf16* YSb = (const bf16*)(WSP(F) + Y_SB);
    const float* CT = (const float*)(WSP(F) + WS_CT);
    LAS float* sg = (LAS float*)(F.lds);
    LAS float* gate = (LAS float*)(F.lds + 8192);
    const int tid = F.tid, lane = F.lane, wave = F.wave;
    const float* mup = INP(F, 8) + l * 1472; const float* mun = INP(F, 9) + l * 1472;
    const float* gup = INP(F, 14) + (size_t)l * 128 * 384;
    const float* mng = INP(F, 7) + l * 256; const float* rng = INP(F, 18) + l * 384; const float* rnb = INP(F, 19) + l * 384;
    const float* scb = INP(F, 21) + l * 896; const float* scw = INP(F, 20) + (size_t)l * 5 * 896; const float* sdk = INP(F, 24) + l * 6; const float* sng = INP(F, 25) + l * 384;
    for (int tile = F.vcu; tile < M / 16; tile += F.G) {
        const int m0 = tile * 16;
        __syncthreads();
        for (int idx = tid; idx < 16 * 128; idx += 512) { const int tt = idx >> 7, i = idx & 127; const int m = m0 + tt, t = m % SEQ;
            const float p1 = bf2f(cols[(size_t)m * NINP + R_GD + i]);
            const float p0 = t > 0 ? bf2f(cols[(size_t)(m - 1) * NINP + R_GD + i]) : 0.f;
            const float p2 = t < SEQ - 1 ? bf2f(cols[(size_t)(m + 1) * NINP + R_GD + i]) : 0.f;
            sg[idx] = sigmoidf_(p1 + mup[1344 + i] * (p0 - p1) + mun[1344 + i] * (p2 - p1)); }
        __syncthreads();
        if (tid < 384) { float acc[16];
#pragma unroll
            for (int tt = 0; tt < 16; ++tt) acc[tt] = 0.f;
            for (int i = 0; i < 128; ++i) { const float w = gup[i * 384 + tid];
#pragma unroll
                for (int tt = 0; tt < 16; ++tt) acc[tt] += sg[tt * 128 + i] * w; }
#pragma unroll
            for (int tt = 0; tt < 16; ++tt) gate[tt * 384 + tid] = acc[tt]; }
        __syncthreads();
#pragma unroll 1
        for (int k = 0; k < 2; ++k) { const int tt = wave * 2 + k; const int m = m0 + tt, t = m % SEQ; const size_t cr = (size_t)m * NINP;
#pragma unroll
            for (int i = 0; i < 4; ++i) { const int col = i * 64 + lane;
                const float hs = bf2f(YAf[(size_t)m * 256 + col]) + bf2f(YAb[(size_t)m * 256 + col]);
                const float mean = wave_sum(hs) * (1.f / 64.f); const float d = hs - mean; const float var = wave_sum(d * d) * (1.f / 64.f);
                const float y = d * (1.f / sqrtf(var + 1e-6f)) * mng[col];
                MIX[(size_t)m * DM + col] = (bf16)f2bf(y * sigmoidf_(bf2f(cols[cr + A_O + col]))); }
#pragma unroll
            for (int i = 0; i < 6; ++i) { const int col = i * 64 + lane;
                const float ys = bf2f(YRf[(size_t)m * 384 + col]) + bf2f(YRb[(size_t)m * 384 + col]);
                const float mean = wave_sum(ys) * (1.f / 64.f); const float d = ys - mean; const float var = wave_sum(d * d) * (1.f / 64.f);
                const float y = d * (1.f / sqrtf(var + 64e-5f)) * rng[col] + rnb[col];
                const float p1 = bf2f(cols[cr + R_V + col]);
                const float p0 = t > 0 ? bf2f(cols[cr - NINP + R_V + col]) : 0.f;
                const float p2 = t < SEQ - 1 ? bf2f(cols[cr + NINP + R_V + col]) : 0.f;
                const float vv = p1 + mup[768 + col] * (p0 - p1) + mun[768 + col] * (p2 - p1);
                const float bonus = CT[(size_t)m * 8 + i] * vv;
                MIX[(size_t)m * DM + 256 + col] = (bf16)f2bf((y + bonus) * gate[tt * 384 + col]); }
            float yv[6]; float ssq[2] = {0.f, 0.f};
#pragma unroll
            for (int i = 0; i < 6; ++i) { const int col = i * 64 + lane;
                float s = scb[col];
#pragma unroll
                for (int jj = 0; jj < 5; ++jj) { const int tq = t + jj - 2; if (tq >= 0 && tq < SEQ) s += scw[jj * 896 + col] * bf2f(cols[cr + (jj - 2) * NINP + S_X + col]); }
                const float xc = siluf_(s);
                float y = bf2f(YSf[(size_t)m * 384 + col]) + bf2f(YSb[(size_t)m * 384 + col]) + sdk[i] * xc;
                y *= siluf_(bf2f(cols[cr + S_Z + col]));
                yv[i] = y; ssq[i / 3] += y * y; }
            const float r0 = 1.f / sqrtf(wave_sum(ssq[0]) * (1.f / 192.f) + 1e-6f), r1 = 1.f / sqrtf(wave_sum(ssq[1]) * (1.f / 192.f) + 1e-6f);
#pragma unroll
            for (int i = 0; i < 6; ++i) { const int col = i * 64 + lane;
                MIX[(size_t)m * DM + 640 + col] = (bf16)f2bf(yv[i] * (i < 3 ? r0 : r1) * sng[col]); }
        }
    }
    __syncthreads();
}
namespace cg = cooperative_groups;
constexpr int N_PHASES = 9 * DEPTH + 1;
__global__ void __launch_bounds__(NWAVES * 64, 2) mk_fwd(Args args) {
    extern __shared__ __attribute__((aligned(16))) unsigned char lds_raw[];
    Frame F;
    F.lds = (LAS unsigned char*)lds_raw;
    F.tid = threadIdx.x; F.lane = F.tid & 63; F.wave = __builtin_amdgcn_readfirstlane(F.tid >> 6);
    F.G = gridDim.x; { const int bx = blockIdx.x; F.vcu = (F.G % 8 == 0) ? (bx % 8) * (F.G / 8) + bx / 8 : bx; }
    volatile LAS unsigned* MISC = (volatile LAS unsigned*)(F.lds + MISC_OFF);
    if (F.tid < 64) MISC[F.tid] = 0u;
    if (F.tid < 34) *(LAS unsigned long long*)(F.lds + PTAB_OFF + 8 * F.tid) = ((const unsigned long long*)__builtin_amdgcn_kernarg_segment_ptr())[F.tid];
    __syncthreads();
    unsigned* ctl = (unsigned*)(WSP(F) + WS_CTL);
    XcdBarrier bar = xcd_barrier_post(ctl + CW_BAR, MISC + 8);
    const int lo = args.ph_lo, hi = args.ph_hi;
#define IN_(k) (lo <= (k) && (k) < hi)
#define SEAM(k) do { if (IN_(k) && IN_((k) + 1)) { if ((k) == 0) cg::this_grid().sync(); else xcd_barrier(bar); } } while (0)
#define LAYER(l, B) \
    if (IN_(B + 0)) { phase_convert(F, l); phase_norm(F, l == 0 ? INP(F, 0) : OUTP(F), INP(F, 1) + l * DM, (bf16*)(WSP(F) + WS_XN)); } SEAM(B + 0); \
    if (IN_(B + 1)) { unsigned char* ws = WSP(F); pg8::Gemm g{(const bf16*)(ws + WS_XN), (const bf16*)(ws + WS_WIN), M, NINP, DM}; pg8::StaticOrder S; S.init(M, NINP, F.G, (int)blockIdx.x); \
            pg8::EpiBf16<0> E{(bf16*)(ws + WS_COLS), NINP, nullptr, 0, 0, 1.f}; \
            pg8::gemm_phase<pg8::EpiBf16<0>, pg8::StaticOrder, PG8_ALIGN, PG8_SP2>(F.lds, g, S, E); } SEAM(B + 1); \
    if (IN_(B + 2)) { phase_gates(F, l); phase_ssd_conv(F, l); } SEAM(B + 2); \
    if (IN_(B + 3)) { const int bx = blockIdx.x; \
            if (bx < 96) rwkv_scan(F, l, bx); else if (bx < 112) mlstm_seq(F, l, bx - 96); else if (bx < 136) ssd_seq(F, l, bx - 112); } SEAM(B + 3); \
    if (IN_(B + 4)) phase_post(F, l); SEAM(B + 4); \
    if (IN_(B + 5)) { unsigned char* ws = WSP(F); pg8::Gemm g{(const bf16*)(ws + WS_XN), (const bf16*)(ws + WS_WOUT), M, DM, DM}; pg8::StaticOrder S; S.init(M, DM, F.G, (int)blockIdx.x); \
            pg8::EpiResidual E{l == 0 ? INP(F, 0) : OUTP(F), OUTP(F), DM}; \
            pg8::gemm_phase<pg8::EpiResidual, pg8::StaticOrder, PG8_ALIGN, PG8_SP2>(F.lds, g, S, E); } SEAM(B + 5); \
    if (IN_(B + 6)) phase_norm(F, OUTP(F), INP(F, 27) + l * DM, (bf16*)(WSP(F) + WS_XN)); SEAM(B + 6); \
    if (IN_(B + 7)) { unsigned char* ws = WSP(F); pg8::Gemm g{(const bf16*)(ws + WS_XN), (const bf16*)(ws + WS_WGU), M, 2 * FFN, DM}; pg8::StaticOrder S; S.init(M, 2 * FFN, F.G, (int)blockIdx.x); \
            pg8::EpiSwiGLU E{(bf16*)(ws + WS_COLS), FFN}; \
            pg8::gemm_phase<pg8::EpiSwiGLU, pg8::StaticOrder, PG8_ALIGN, PG8_SP2>(F.lds, g, S, E); } SEAM(B + 7); \
    if (IN_(B + 8)) { unsigned char* ws = WSP(F); pg8::Gemm g{(const bf16*)(ws + WS_COLS), (const bf16*)(ws + WS_WDN), M, DM, FFN}; pg8::StaticOrder S; S.init(M, DM, F.G, (int)blockIdx.x); \
            pg8::EpiResidual E{OUTP(F), OUTP(F), DM}; \
            pg8::gemm_phase<pg8::EpiResidual, pg8::StaticOrder, PG8_ALIGN, PG8_SP2>(F.lds, g, S, E); } SEAM(B + 8);
    LAYER(0, 0)
    LAYER(1, 9)
    if (IN_(18)) phase_final_norm(F, OUTP(F), INP(F, 31));
#undef IN_
#undef SEAM
#undef LAYER
}

#ifndef MK_PER_PHASE
#define MK_PER_PHASE 0
#endif
extern "C" void kernel_launch(void* const* d_in, const int* in_sizes, int n_in, void* d_out, int out_size, void* d_ws, size_t ws_size, hipStream_t stream) {
    static int grid = 0;
    if (grid == 0) {
        int dev = 0, cus = 0;
        if (n_in != 32 || out_size != M * DM || ws_size < WS_END) { fprintf(stderr, "kernel_launch: unexpected shapes (n_in %d out %d ws %zu)\n", n_in, out_size, ws_size); grid = -1; return; }
        if (hipGetDevice(&dev) != hipSuccess || hipDeviceGetAttribute(&cus, hipDeviceAttributeMultiprocessorCount, dev) != hipSuccess) { grid = -1; return; }
        if (hipFuncSetAttribute((const void*)mk_fwd, hipFuncAttributeMaxDynamicSharedMemorySize, LDS_BYTES) != hipSuccess) { fprintf(stderr, "kernel_launch: hipFuncSetAttribute failed\n"); grid = -1; return; }
        int per_cu = 0;
        if (hipOccupancyMaxActiveBlocksPerMultiprocessor(&per_cu, (const void*)mk_fwd, NWAVES * 64, LDS_BYTES) != hipSuccess || per_cu < 1) { fprintf(stderr, "kernel_launch: occupancy query says %d\n", per_cu); }
        (void)hipGetLastError();
        grid = cus;
    }
    if (grid < 0) return;
    (void)hipMemsetAsync((char*)d_ws + WS_CTL, 0, CTL_ZERO_BYTES, stream);
    Args a{};
    for (int i = 0; i < 32; ++i) a.in[i] = (const float*)d_in[i];
    a.out = (float*)d_out; a.ws = (unsigned char*)d_ws;
#if MK_PER_PHASE
    for (int p = 0; p < N_PHASES; ++p) { a.ph_lo = p; a.ph_hi = p + 1; hipLaunchKernelGGL(mk_fwd, dim3(grid), dim3(NWAVES * 64), LDS_BYTES, stream, a); }
#else
    a.ph_lo = 0; a.ph_hi = N_PHASES;
    void* kargs[] = {&a};
    hipError_t e = hipLaunchCooperativeKernel((const void*)mk_fwd, dim3(grid), dim3(NWAVES * 64), kargs, LDS_BYTES, stream);
    if (e != hipSuccess) fprintf(stderr, "cooperative launch failed: %s (grid %d)\n", hipGetErrorString(e), grid);
#endif
}
```

```cpp
#include <hip/hip_runtime.h>
#include <hip/hip_cooperative_groups.h>
#include <cstdio>
#include <cstdint>
namespace pg8 {
#define PG8_LAS __attribute__((address_space(3)))
typedef unsigned short bf16_t;
typedef short bf16x8 __attribute__((ext_vector_type(8)));
typedef float f32x4 __attribute__((ext_vector_type(4)));
typedef unsigned u32x4 __attribute__((ext_vector_type(4)));
constexpr int BM = 256, BK = 64, HALF = 128, HTB = HALF * BK * 2  , STAGE_BYTES = 8 * HTB, NXCD = 8, WGM = 8;

__host__ __device__ __forceinline__ int lds_byte(int r, int c) { const int st = (r >> 4) * 2 + (c >> 5), rr = r & 15, cc = c & 31, ob = rr * 64 + cc * 2; return st * 1024 + (ob ^ (((ob >> 9) & 1) << 5)); }
__host__ __device__ __forceinline__ void stage_rc(int b, int& R, int& C) { const int st = b / 1024, sb = b % 1024, swz = sb ^ (((sb >> 9) & 1) << 5); R = (st >> 1) * 16 + swz / 64; C = (st & 1) * 32 + (swz % 64) / 2; }
__host__ __device__ __forceinline__ int perm32(int rho) { const int n = rho >> 4, i = rho & 15; return 8 * (i >> 2) + 4 * n + (i & 3); }

struct Unit { int pm, pn; };
struct Gemm { const bf16_t* A; const bf16_t* Bt; int M, N, K; };

struct StaticOrder {
    int nM, nN, nwg, G, c;
    __host__ __device__ void init(int M, int N, int G_, int c_) { nM = M / BM; nN = N / BM; nwg = nM * nN; G = G_; c = c_; }
    __host__ __device__ bool next(int i, Unit& u) const {
        const long L = (long)i * G + c; if (L >= nwg) return false;
        int wgid = (int)L; { const int q = nwg / NXCD, r = nwg % NXCD, xcd = wgid % NXCD, off = wgid / NXCD; wgid = (xcd < r ? xcd * (q + 1) : r * (q + 1) + (xcd - r) * q) + off; }
        const int nig = WGM * nN, gid = wgid / nig, fm = gid * WGM, gsz = (nM - fm) < WGM ? (nM - fm) : WGM;
        u.pm = fm + ((wgid % nig) % gsz); u.pn = (wgid % nig) / gsz; return true;
    }
    __device__ __forceinline__ void a_ready(const Unit&) const {}
    __device__ __forceinline__ void done(const Unit&) const {}
};

__device__ __forceinline__ unsigned cvt_pk_bf16(float lo, float hi) { unsigned r; asm volatile("v_cvt_pk_bf16_f32 %0, %1, %2" : "=v"(r) : "v"(lo), "v"(hi)); return r; }
typedef float f32x2 __attribute__((ext_vector_type(2)));
__device__ __forceinline__ f32x2 gelu_pk(f32x2 v) {
    const f32x2 av = __builtin_elementwise_abs(v), d = av * 0.2316418882f + 1.0f;
    f32x2 t; t.x = __builtin_amdgcn_rcpf(d.x); t.y = __builtin_amdgcn_rcpf(d.y);
    f32x2 q = t * 0.5307027145f + (-0.7265760135f); q = q * t + 0.7107068705f; q = q * t + (-0.142248368f); q = q * t + 0.127414796f; q = q * t;
    const f32x2 s = (v * v) * (-0.72134752044f);
    f32x2 e; e.x = __builtin_amdgcn_exp2f(s.x); e.y = __builtin_amdgcn_exp2f(s.y);
    const f32x2 m = v * (q * e), r = v - m;
    f32x2 o; o.x = v.x < 0.f ? m.x : r.x; o.y = v.y < 0.f ? m.y : r.y; return o;
}

template <int ACT  > struct EpiBf16 {
    static constexpr bool PERM = true, AFTER_DRAIN = false; static_assert(ACT == 0 || ACT == 1, "EpiBf16: ACT is 0 (none) or 1 (gelu_pk)");
    bf16_t* O; int ldc; const float* bias; int split_cols; size_t split_stride; float scale0;
    __device__ __forceinline__ void operator()(const f32x4 (&acc)[2][2][4][2], const Unit& u, int wr, int wc, int fr, int fq) const {
        const int row0 = u.pm * BM + wr * 64 + fr; int colt = u.pn * BM; bf16_t* base = O;
        float sc = 1.f; if (split_cols) { const int t = colt / split_cols; base += (size_t)t * split_stride; colt -= t * split_cols; if (t == 0) sc = scale0; }
        const int col0 = colt + wc * 32 + 8 * fq, bcol0 = u.pn * BM + wc * 32 + 8 * fq;
        f32x4 bv[2][2];
#pragma unroll
        for (int bj = 0; bj < 2; ++bj)
#pragma unroll
            for (int n = 0; n < 2; ++n) bv[bj][n] = bias ? *(const f32x4*)(bias + bcol0 + bj * HALF + 4 * n) : (f32x4){0.f, 0.f, 0.f, 0.f};
#pragma unroll
        for (int ai = 0; ai < 2; ++ai)
#pragma unroll
            for (int m = 0; m < 4; ++m) { bf16_t* rowp = base + (size_t)(row0 + ai * HALF + m * 16) * ldc + col0;
#pragma unroll
                for (int bj = 0; bj < 2; ++bj) { f32x4 v0 = acc[ai][bj][m][0] + bv[bj][0], v1 = acc[ai][bj][m][1] + bv[bj][1];
                    if (ACT == 1) { f32x2 a = gelu_pk((f32x2){v0[0], v0[1]}), b = gelu_pk((f32x2){v0[2], v0[3]}), c = gelu_pk((f32x2){v1[0], v1[1]}), d = gelu_pk((f32x2){v1[2], v1[3]});
                        v0 = (f32x4){a.x, a.y, b.x, b.y}; v1 = (f32x4){c.x, c.y, d.x, d.y}; }
                    v0 = v0 * sc; v1 = v1 * sc; u32x4 w; w.x = cvt_pk_bf16(v0[0], v0[1]); w.y = cvt_pk_bf16(v0[2], v0[3]); w.z = cvt_pk_bf16(v1[0], v1[1]); w.w = cvt_pk_bf16(v1[2], v1[3]);
                    *(u32x4*)(rowp + bj * HALF) = w; } }
    }
};
struct EpiResidual {
    static constexpr bool PERM = false, AFTER_DRAIN = false;
    const float* base; float* out; int ldc;
    __device__ __forceinline__ void operator()(const f32x4 (&acc)[2][2][4][2], const Unit& u, int wr, int wc, int fr, int fq) const {
        const int col0 = u.pn * BM + wc * 32 + 4 * fq;
#pragma unroll
        for (int ai = 0; ai < 2; ++ai)
#pragma unroll
            for (int m = 0; m < 4; ++m) { const size_t off = (size_t)(u.pm * BM + ai * HALF + wr * 64 + m * 16 + fr) * ldc + col0;
#pragma unroll
                for (int bj = 0; bj < 2; ++bj)
#pragma unroll
                    for (int n = 0; n < 2; ++n) { const f32x4 bs = *(const f32x4*)(base + off + bj * HALF + n * 16); *(f32x4*)(out + off + bj * HALF + n * 16) = bs + acc[ai][bj][m][n]; }
                asm volatile("" ::: "memory"); }
    }
};
struct EpiSwiGLU {
    static constexpr bool PERM = true, AFTER_DRAIN = false;
    bf16_t* O; int ldc;
    __device__ __forceinline__ void operator()(const f32x4 (&acc)[2][2][4][2], const Unit& u, int wr, int wc, int fr, int fq) const {
        const int col0 = u.pn * HALF + wc * 32 + 8 * fq;
#pragma unroll
        for (int ai = 0; ai < 2; ++ai)
#pragma unroll
            for (int m = 0; m < 4; ++m) { bf16_t* rowp = O + (size_t)(u.pm * BM + ai * HALF + wr * 64 + m * 16 + fr) * ldc + col0;
                float r[8];
#pragma unroll
                for (int n = 0; n < 2; ++n)
#pragma unroll
                    for (int j = 0; j < 4; ++j) { const float g = acc[ai][0][m][n][j], up = acc[ai][1][m][n][j]; r[n * 4 + j] = g * __builtin_amdgcn_rcpf(1.f + __expf(-g)) * up; }
                u32x4 w; w.x = cvt_pk_bf16(r[0], r[1]); w.y = cvt_pk_bf16(r[2], r[3]); w.z = cvt_pk_bf16(r[4], r[5]); w.w = cvt_pk_bf16(r[6], r[7]);
                *(u32x4*)rowp = w; }
    }
};
template <class Epi, class Sched, bool ALIGN_EPI = false, bool SP2 = false>
__device__ __forceinline__ void gemm_phase(PG8_LAS unsigned char* lds, const Gemm g, const Sched& S, const Epi& E) {
    const int tid = threadIdx.x, wid = __builtin_amdgcn_readfirstlane(tid >> 6), lane = tid & 63, wr = wid >> 2, wc = wid & 3, fr = lane & 15, fq = lane >> 4;
    const int K = g.K, nt = K / BK;
    unsigned voffA[2], voffB[2];
#pragma unroll
    for (int i = 0; i < 2; ++i) { int R, C; stage_rc(tid * 16 + i * 8192, R, C); const int Rb = Epi::PERM ? ((R & ~31) + perm32(R & 31)) : R;
        voffA[i] = (unsigned)(R * K + C) * 2u; voffB[i] = (unsigned)(Rb * K + C) * 2u; }
    const size_t kstep = (size_t)(BK * 2);
    const size_t hstep = (size_t)HALF * K * 2;
    const size_t tstep = 2 * hstep;
    const unsigned ldsw = (unsigned)wid * 1024u;
    const int aoff = lds_byte(wr * 64 + fr, fq * 8), boff = lds_byte(wc * 32 + fr, fq * 8);
#define PG8_SA(b, h) (((b) * 2 + (h)) * HTB)
#define PG8_SB(b, h) ((4 + (b) * 2 + (h)) * HTB)
#define PG8_STAGE(bufoff, gbase, voff) do { _Pragma("unroll") for (int _i = 0; _i < 2; ++_i) \
        __builtin_amdgcn_global_load_lds((const unsigned*)((const char*)(gbase) + (voff)[_i]), (PG8_LAS unsigned*)(lds + (bufoff) + ldsw + _i * 8192), 16, 0, 0); } while (0)
#define PG8_LDA(dst, b, h) do { _Pragma("unroll") for (int m = 0; m < 4; ++m) _Pragma("unroll") for (int k = 0; k < 2; ++k) dst[m][k] = *(const PG8_LAS bf16x8*)(lds + PG8_SA(b, h) + aoff + m * 2048 + k * 1024); } while (0)
#define PG8_LDB(dst, b, h) do { _Pragma("unroll") for (int n = 0; n < 2; ++n) _Pragma("unroll") for (int k = 0; k < 2; ++k) dst[n][k] = *(const PG8_LAS bf16x8*)(lds + PG8_SB(b, h) + boff + n * 2048 + k * 1024); } while (0)
#define PG8_MMA(ai, bj, At, Bt) do { __builtin_amdgcn_s_setprio(1); _Pragma("unroll") for (int m = 0; m < 4; ++m) _Pragma("unroll") for (int n = 0; n < 2; ++n) _Pragma("unroll") for (int k = 0; k < 2; ++k) \
        acc[ai][bj][m][n] = __builtin_amdgcn_mfma_f32_16x16x32_bf16(Bt[n][k], At[m][k], acc[ai][bj][m][n], 0, 0, 0); __builtin_amdgcn_s_setprio(0); } while (0)
#define PG8_WAIT_V(n) asm volatile("s_waitcnt vmcnt(" #n ")" ::: "memory")
#define PG8_WAIT_L(n) asm volatile("s_waitcnt lgkmcnt(" #n ")" ::: "memory")
#define PG8_BAR __builtin_amdgcn_s_barrier()
#define PG8_SCHED __builtin_amdgcn_sched_barrier(0)
    Unit cur, nxt; int ui = 0;
    if (!S.next(0, cur)) return;
    f32x4 acc[2][2][4][2];
#pragma unroll
    for (int a = 0; a < 2; ++a)
#pragma unroll
        for (int b = 0; b < 2; ++b)
#pragma unroll
            for (int m = 0; m < 4; ++m)
#pragma unroll
                for (int n = 0; n < 2; ++n) acc[a][b][m][n] = (f32x4){0.f, 0.f, 0.f, 0.f};
    bf16x8 At[4][2], B0[2][2], B1[2][2];
    const char* cA = (const char*)g.A + (size_t)cur.pm * tstep; const char* cB = (const char*)g.Bt + (size_t)cur.pn * tstep;
    S.a_ready(cur);
    if constexpr (SP2) {
        PG8_STAGE(PG8_SB(0, 0), cB, voffB); PG8_STAGE(PG8_SB(0, 1), cB + hstep, voffB); PG8_STAGE(PG8_SA(0, 0), cA, voffA); PG8_STAGE(PG8_SA(0, 1), cA + hstep, voffA);
        if (wr == 1) PG8_BAR;
        PG8_WAIT_V(2); PG8_BAR;
        PG8_STAGE(PG8_SB(1, 0), cB + kstep, voffB); PG8_STAGE(PG8_SA(1, 0), cA + kstep, voffA); PG8_STAGE(PG8_SB(1, 1), cB + hstep + kstep, voffB);
        PG8_WAIT_V(6); PG8_BAR;
    } else {
        PG8_STAGE(PG8_SB(0, 0), cB, voffB); PG8_STAGE(PG8_SA(0, 0), cA, voffA); PG8_STAGE(PG8_SB(0, 1), cB + hstep, voffB); PG8_STAGE(PG8_SA(0, 1), cA + hstep, voffA);
        if (wr == 1) PG8_BAR;
        PG8_WAIT_V(4); PG8_BAR;
        PG8_STAGE(PG8_SB(1, 0), cB + kstep, voffB); PG8_STAGE(PG8_SA(1, 0), cA + kstep, voffA); PG8_STAGE(PG8_SB(1, 1), cB + hstep + kstep, voffB);
        PG8_WAIT_V(6); PG8_BAR;
    }
    for (;;) {
        const bool has_next = S.next(ui + 1, nxt);
        const char* nA = has_next ? (const char*)g.A + (size_t)nxt.pm * tstep : cA; const char* nB = has_next ? (const char*)g.Bt + (size_t)nxt.pn * tstep : cB;
        for (int t = 0; t < nt; t += 2) {
            const bool last = (t == nt - 2);
            const char* a1 = cA + (size_t)(t + 1) * kstep;
            const char* a2 = last ? nA : cA + (size_t)(t + 2) * kstep; const char* b2 = last ? nB : cB + (size_t)(t + 2) * kstep;
            const char* a3 = a2 + kstep; const char* b3 = b2 + kstep;
            if (last && has_next) S.a_ready(nxt);
            if constexpr (SP2) {
            PG8_LDB(B0, 0, 0); PG8_LDB(B1, 0, 1); PG8_SCHED; PG8_LDA(At, 0, 0); PG8_STAGE(PG8_SA(1, 1), a1 + hstep, voffA);
            PG8_WAIT_V(8); PG8_WAIT_L(0); PG8_BAR; PG8_MMA(0, 0, At, B0); PG8_MMA(0, 1, At, B1); PG8_BAR; PG8_SCHED;
            PG8_LDA(At, 0, 1); PG8_STAGE(PG8_SB(0, 0), b2, voffB); PG8_STAGE(PG8_SB(0, 1), b2 + hstep, voffB); PG8_STAGE(PG8_SA(0, 0), a2, voffA);
            PG8_WAIT_V(8); PG8_WAIT_L(0); PG8_BAR; PG8_MMA(1, 0, At, B0); PG8_MMA(1, 1, At, B1); PG8_BAR; PG8_SCHED;
            PG8_LDB(B0, 1, 0); PG8_LDB(B1, 1, 1); PG8_SCHED; PG8_LDA(At, 1, 0); PG8_STAGE(PG8_SA(0, 1), a2 + hstep, voffA);
            PG8_WAIT_V(8); PG8_WAIT_L(0); PG8_BAR; PG8_MMA(0, 0, At, B0); PG8_MMA(0, 1, At, B1); PG8_BAR; PG8_SCHED;
            PG8_LDA(At, 1, 1); PG8_STAGE(PG8_SB(1, 0), b3, voffB); PG8_STAGE(PG8_SB(1, 1), b3 + hstep, voffB); PG8_STAGE(PG8_SA(1, 0), a3, voffA);
            PG8_WAIT_V(8); PG8_WAIT_L(0); PG8_BAR; PG8_MMA(1, 0, At, B0); PG8_MMA(1, 1, At, B1); PG8_BAR; PG8_SCHED;
            } else {
            PG8_LDB(B0, 0, 0); PG8_SCHED; PG8_LDA(At, 0, 0); PG8_STAGE(PG8_SA(1, 1), a1 + hstep, voffA);
            PG8_WAIT_L(8); PG8_BAR; PG8_WAIT_L(0); PG8_MMA(0, 0, At, B0); PG8_BAR; PG8_SCHED;
            PG8_LDB(B1, 0, 1); PG8_STAGE(PG8_SB(0, 0), b2, voffB);
            PG8_BAR; PG8_WAIT_L(0); PG8_MMA(0, 1, At, B1); PG8_BAR;
            PG8_LDA(At, 0, 1); PG8_STAGE(PG8_SA(0, 0), a2, voffA);
            PG8_BAR; PG8_WAIT_L(0); PG8_MMA(1, 0, At, B0); PG8_BAR; PG8_SCHED;
            PG8_STAGE(PG8_SB(0, 1), b2 + hstep, voffB);
            PG8_WAIT_V(6); PG8_BAR; PG8_MMA(1, 1, At, B1); PG8_BAR;
            PG8_LDB(B0, 1, 0); PG8_SCHED; PG8_LDA(At, 1, 0); PG8_STAGE(PG8_SA(0, 1), a2 + hstep, voffA);
            PG8_WAIT_L(8); PG8_BAR; PG8_WAIT_L(0); PG8_MMA(0, 0, At, B0); PG8_BAR; PG8_SCHED;
            PG8_LDB(B1, 1, 1); PG8_STAGE(PG8_SB(1, 0), b3, voffB);
            PG8_BAR; PG8_WAIT_L(0); PG8_MMA(0, 1, At, B1); PG8_BAR;
            PG8_LDA(At, 1, 1); PG8_STAGE(PG8_SA(1, 0), a3, voffA);
            PG8_BAR; PG8_WAIT_L(0); PG8_MMA(1, 0, At, B0); PG8_BAR; PG8_SCHED;
            PG8_STAGE(PG8_SB(1, 1), b3 + hstep, voffB);
            PG8_WAIT_V(6); PG8_BAR; PG8_MMA(1, 1, At, B1); PG8_BAR;
            }
        }
        if constexpr (ALIGN_EPI) { if (wr == 0) PG8_BAR; }
        if constexpr (!Epi::AFTER_DRAIN) { E(acc, cur, wr, wc, fr, fq); S.done(cur); }
        if (!has_next) break;
#pragma unroll
        for (int a = 0; a < 2; ++a)
#pragma unroll
            for (int b = 0; b < 2; ++b)
#pragma unroll
                for (int m = 0; m < 4; ++m)
#pragma unroll
                    for (int n = 0; n < 2; ++n) acc[a][b][m][n] = (f32x4){0.f, 0.f, 0.f, 0.f};
        cur = nxt; cA = nA; cB = nB; ++ui;
        if constexpr (ALIGN_EPI) { if (wr == 1) PG8_BAR; }
    }
    PG8_WAIT_V(0);
    if constexpr (!ALIGN_EPI) { if (wr == 0) PG8_BAR; }
    PG8_BAR;
    if constexpr (Epi::AFTER_DRAIN) { E.fused(acc, cur, wr, wc, fr, fq, lds, wid, lane); S.done(cur); }
#undef PG8_SA
#undef PG8_SB
#undef PG8_STAGE
#undef PG8_LDA
#undef PG8_LDB
#undef PG8_MMA
#undef PG8_WAIT_V
#undef PG8_WAIT_L
#undef PG8_BAR
#undef PG8_SCHED
}
}

#ifndef PG8_SP2
#define PG8_SP2 true
#endif
#define PG8_ALIGN true
constexpr int NWAVES = 8;
constexpr int BATCH = 2, SEQ = 8192, DM = 1024, M = BATCH * SEQ, NIN = 3788, NINP = 3840, FFN = 2816, DEPTH = 2;
constexpr int A_Q = 0, A_K = 256, A_V = 512, A_O = 768;
constexpr int R_R = 1024, R_K = 1408, R_V = 1792, R_WDF = 2176, R_AD = 2304, R_GD = 2368;
constexpr int S_Z = 2496, S_X = 2880, S_B = 3264, S_C = 3520, S_DT = 3776;
constexpr size_t MiB = 1u << 20;
constexpr size_t WS_CTL = 0, CTL_ZERO_BYTES = 64 * 1024;
constexpr size_t WS_GATES = 1 * MiB, WS_CT = 2 * MiB;
constexpr size_t WS_WIN = 4 * MiB, WS_WOUT = 12 * MiB, WS_WGU = 14 * MiB, WS_WDN = 25 * MiB;
constexpr size_t WS_XN = 32 * MiB, WS_COLS = 64 * MiB, WS_Y = 184 * MiB, WS_END = 248 * MiB;
constexpr size_t Y_AF = WS_Y, Y_AB = WS_Y + 8 * MiB, Y_RF = WS_Y + 16 * MiB, Y_RB = WS_Y + 28 * MiB, Y_SF = WS_Y + 40 * MiB, Y_SB = WS_Y + 52 * MiB;
constexpr int CW_BAR = 1024;
constexpr int RING_BYTES = 131072;
constexpr int LDS_BYTES = 147456, MISC_OFF = LDS_BYTES - 256;

#define GAS __attribute__((address_space(1)))
#define LAS __attribute__((address_space(3)))
typedef unsigned short bf16;
typedef unsigned v4u __attribute__((ext_vector_type(4)));
typedef unsigned v2u __attribute__((ext_vector_type(2)));
typedef float f32x4 __attribute__((ext_vector_type(4)));
typedef short bf16x8 __attribute__((ext_vector_type(8)));
typedef GAS unsigned gu32;
#define RLX_AGENT __ATOMIC_RELAXED, __HIP_MEMORY_SCOPE_AGENT
#define LDS_WAIT() asm volatile("s_waitcnt lgkmcnt(0)" ::: "memory")
#define VM_WAIT() asm volatile("s_waitcnt vmcnt(0)" ::: "memory")
__device__ __forceinline__ unsigned f2bf(float f) { unsigned u = __builtin_bit_cast(unsigned, f); return (u + 0x7fffu + ((u >> 16) & 1u)) >> 16; }
__device__ __forceinline__ unsigned pk2(float lo, float hi) { return f2bf(lo) | (f2bf(hi) << 16); }
__device__ __forceinline__ float bf2f(unsigned u) { return __builtin_bit_cast(float, u << 16); }
__device__ __forceinline__ float sigmoidf_(float x) { return __builtin_amdgcn_rcpf(1.f + __expf(-x)); }
__device__ __forceinline__ float siluf_(float x) { return x * sigmoidf_(x); }
__device__ __forceinline__ float wave_sum(float v) {
#pragma unroll
    for (int o = 1; o < 64; o <<= 1) v += __shfl_xor(v, o);
    return v;
}
__device__ __forceinline__ float wave_max(float v) {
#pragma unroll
    for (int o = 1; o < 64; o <<= 1) v = fmaxf(v, __shfl_xor(v, o));
    return v;
}
template <int CTRL> __device__ __forceinline__ float dppf(float v) { return __builtin_bit_cast(float, __builtin_amdgcn_update_dpp(0, __builtin_bit_cast(int, v), CTRL, 0xf, 0xf, true)); }
__device__ __forceinline__ float row16_sum(float v) { v += dppf<0xB1>(v); v += dppf<0x4E>(v); v += dppf<0x141>(v); v += dppf<0x140>(v); return v; }
template <int K> __device__ __forceinline__ f32x4 mma16(const LAS bf16* A, int lda, const LAS bf16* Bt, int ldb, f32x4 acc, int lane) {
    const int r = lane & 15, q = lane >> 4;
    const LAS bf16* ap = A + r * lda + q * 8; const LAS bf16* bp = Bt + r * ldb + q * 8;
#pragma unroll
    for (int k0 = 0; k0 < K; k0 += 32) {
        const bf16x8 a = *(const LAS bf16x8*)(ap + k0); const bf16x8 b = *(const LAS bf16x8*)(bp + k0);
        acc = __builtin_amdgcn_mfma_f32_16x16x32_bf16(a, b, acc, 0, 0, 0);
    }
    return acc;
}
#define XB_TMO      128
#define XB_XCNT(j)  (256  + 64 * (j))
#define XB_XSUB(j)  (1280 + 64 * (j))
#define XB_XGEN(j)  (2304 + 64 * (j))
#define XB_TOP      3328
#define XB_TOPGEN   3392
#define XCD_BAR_WORDS 3456
#define XB_SPIN_CAP (1u << 18)

__device__ __forceinline__ unsigned xb_ld(unsigned* p)              { return __hip_atomic_load(p, __ATOMIC_RELAXED, __HIP_MEMORY_SCOPE_AGENT); }
__device__ __forceinline__ unsigned xb_add(unsigned* p, unsigned v) { return __hip_atomic_fetch_add(p, v, __ATOMIC_RELAXED, __HIP_MEMORY_SCOPE_AGENT); }
__device__ __forceinline__ unsigned xb_xcc_id() { return (unsigned)__builtin_amdgcn_s_getreg((3 << 11) | 20) & 0xFu; }
#define XB_SPIN(cond, bar) do { unsigned _sp = 0; while (cond) { __builtin_amdgcn_s_sleep(1); \
    if ((++_sp & 255u) == 0u) { if (xb_ld(&(bar)[XB_TMO])) break; if (_sp > XB_SPIN_CAP) { atomicAdd(&(bar)[XB_TMO], 1u); break; } } } } while (0)

struct XcdBarrier {
    unsigned* bar; unsigned x;
    volatile LAS unsigned* st;
};

__device__ __forceinline__ XcdBarrier xcd_barrier_post(unsigned* bar, volatile LAS unsigned* st) {
    XcdBarrier b; b.bar = bar; b.x = xb_xcc_id(); b.st = st;
    if (threadIdx.x == 0) (void)xb_add(&bar[XB_XCNT(b.x)], 1u);
    return b;
}
__device__ __forceinline__ void xcd_barrier_complete(unsigned* bar, unsigned x, unsigned& nloc, unsigned& nx) {
    const unsigned G = gridDim.x * gridDim.y * gridDim.z;
    unsigned sum, cnt, mine, sp = 0u;
    for (;;) {
        sum = 0u; cnt = 0u; mine = 0u;
#pragma unroll
        for (unsigned j = 0; j < 16; ++j) { const unsigned c = xb_ld(&bar[XB_XCNT(j)]); sum += c; cnt += (c > 0u) ? 1u : 0u; mine = (j == x) ? c : mine; }
        if (sum == G) break;
        __builtin_amdgcn_s_sleep(1);
        if ((++sp & 255u) == 0u) { if (xb_ld(&bar[XB_TMO])) break; if (sp > XB_SPIN_CAP) { atomicAdd(&bar[XB_TMO], 1u); break; } }
    }
    nloc = mine > 0u ? mine : 1u; nx = cnt > 0u ? cnt : 1u;
}

__device__ __forceinline__ void xcd_barrier(const XcdBarrier& b) {
    asm volatile("s_waitcnt vmcnt(0)" ::: "memory");
    __syncthreads();
    if (threadIdx.x == 0) {
        unsigned* bar = b.bar;
        __builtin_amdgcn_s_waitcnt(0);
        unsigned nloc = b.st[0], nx = b.st[1];
        if (nloc == 0u) { xcd_barrier_complete(bar, b.x, nloc, nx); b.st[0] = nloc; b.st[1] = nx; }
        const unsigned old = xb_add(&bar[XB_XSUB(b.x)], 1u);
        const unsigned gen = old / nloc;
        if (old + 1u == (gen + 1u) * nloc) {
            __builtin_amdgcn_fence(__ATOMIC_RELEASE, "agent");
            asm volatile("s_waitcnt vmcnt(0)" ::: "memory");
            const unsigned og = xb_add(&bar[XB_TOP], 1u);
            const unsigned tg = og / nx;
            if (og + 1u == (tg + 1u) * nx) xb_add(&bar[XB_TOPGEN], 1u);
            else XB_SPIN(xb_ld(&bar[XB_TOPGEN]) == tg, bar);
            __builtin_amdgcn_fence(__ATOMIC_ACQUIRE, "agent");
            xb_add(&bar[XB_XGEN(b.x)], 1u);
            asm volatile("s_waitcnt vmcnt(0)" ::: "memory");
        } else {
            XB_SPIN(xb_ld(&bar[XB_XGEN(b.x)]) == gen, bar);
            __builtin_amdgcn_fence(__ATOMIC_ACQUIRE, "agent");
            asm volatile("s_waitcnt vmcnt(0)" ::: "memory");
        }
    }
    __syncthreads();
}
struct Frame {
    LAS unsigned char* lds;
    int tid, lane, wave, vcu, G;
};
struct Args { const float* in[32]; float* out; unsigned char* ws; int ph_lo, ph_hi; };
constexpr int PTAB_OFF = LDS_BYTES - 768;
__device__ __forceinline__ unsigned long long ptab_ld(const Frame& F, int i) {
    const unsigned long long v = *(volatile LAS unsigned long long*)(F.lds + PTAB_OFF + 8 * i);
    const unsigned lo = __builtin_amdgcn_readfirstlane((unsigned)v), hi = __builtin_amdgcn_readfirstlane((unsigned)(v >> 32));
    return ((unsigned long long)hi << 32) | lo;
}
__device__ __forceinline__ const float* INP(const Frame& F, int i) { return (const float*)ptab_ld(F, i); }
__device__ __forceinline__ unsigned char* WSP(const Frame& F) { return (unsigned char*)ptab_ld(F, 33); }
__device__ __forceinline__ float* OUTP(const Frame& F) { return (float*)ptab_ld(F, 32); }

__device__ __forceinline__ void transpose_item(const float* W, int K, int N, int nblk, bf16* WT, int mode, int row_off, LAS float* scr, int item, int lane) {
    const int kb = item / nblk, nb = item % nblk, k0 = 64 * kb, n0 = 32 * nb;
    const int ncol = n0 + (lane & 31); const bool ok = ncol < N;
#pragma unroll 8
    for (int i = 0; i < 32; ++i) { const int kk = 2 * i + (lane >> 5); scr[kk * 33 + (lane & 31)] = ok ? W[(size_t)(k0 + kk) * N + ncol] : 0.f; }
    LDS_WAIT(); asm volatile("" ::: "memory");
    const int c = lane & 7;
    const int drow0 = mode ? (256 * (n0 >> 7) + (n0 & 127) + row_off) : (row_off + n0);
#pragma unroll
    for (int j = 0; j < 4; ++j) { const int n = (lane >> 3) + 8 * j; const LAS float* s = scr + (8 * c) * 33 + n;
        v4u o; o.x = pk2(s[0 * 33], s[1 * 33]); o.y = pk2(s[2 * 33], s[3 * 33]); o.z = pk2(s[4 * 33], s[5 * 33]); o.w = pk2(s[6 * 33], s[7 * 33]);
        *(v4u*)(WT + (size_t)(drow0 + n) * K + k0 + 8 * c) = o; }
    LDS_WAIT(); asm volatile("" ::: "memory");
}
__device__ __forceinline__ void phase_convert(const Frame& F, int l) {
    LAS float* scr = (LAS float*)(F.lds + F.wave * 16384);
    const int gw = F.vcu * NWAVES + F.wave, NGW = F.G * NWAVES;
    bf16* Win = (bf16*)(WSP(F) + WS_WIN); bf16* Wout = (bf16*)(WSP(F) + WS_WOUT); bf16* Wgu = (bf16*)(WSP(F) + WS_WGU); bf16* Wdn = (bf16*)(WSP(F) + WS_WDN);
    constexpr int I_IN = 16 * 120, I_OUT = 16 * 32, I_G = 16 * 88, I_D = 44 * 32;
    constexpr int NITEMS = I_IN + I_OUT + 2 * I_G + I_D;
    for (int it = gw; it < NITEMS; it += NGW) {
        int r = it;
        if (r < I_IN) { transpose_item(INP(F, 2) + (size_t)l * DM * NIN, DM, NIN, 120, Win, 0, 0, scr, r, F.lane); continue; } r -= I_IN;
        if (r < I_OUT) { transpose_item(INP(F, 26) + (size_t)l * DM * DM, DM, DM, 32, Wout, 0, 0, scr, r, F.lane); continue; } r -= I_OUT;
        if (r < I_G) { transpose_item(INP(F, 28) + (size_t)l * DM * FFN, DM, FFN, 88, Wgu, 1, 0, scr, r, F.lane); continue; } r -= I_G;
        if (r < I_G) { transpose_item(INP(F, 29) + (size_t)l * DM * FFN, DM, FFN, 88, Wgu, 1, 128, scr, r, F.lane); continue; } r -= I_G;
        transpose_item(INP(F, 30) + (size_t)l * FFN * DM, FFN, DM, 32, Wdn, 0, 0, scr, r, F.lane);
    }
}
__device__ __forceinline__ void phase_norm(const Frame& F, const float* hin, const float* g, bf16* XN) {
    const int gw = F.vcu * NWAVES + F.wave, NGW = F.G * NWAVES;
    f32x4 gv[4];
#pragma unroll
    for (int j = 0; j < 4; ++j) gv[j] = ((const f32x4*)g)[64 * j + F.lane];
    for (int m = gw; m < M; m += NGW) {
        const f32x4* xr = (const f32x4*)(hin + (size_t)m * DM) + F.lane;
        f32x4 v[4]; float s = 0.f;
#pragma unroll
        for (int j = 0; j < 4; ++j) { v[j] = xr[64 * j]; s += (v[j].x * v[j].x + v[j].y * v[j].y) + (v[j].z * v[j].z + v[j].w * v[j].w); }
        const float r = 1.f / sqrtf(wave_sum(s) * (1.f / DM) + 1e-6f);
        v2u* o8 = (v2u*)(XN + (size_t)m * DM) + F.lane;
#pragma unroll
        for (int j = 0; j < 4; ++j) { v2u w; w.x = pk2(v[j].x * r * gv[j].x, v[j].y * r * gv[j].y); w.y = pk2(v[j].z * r * gv[j].z, v[j].w * r * gv[j].w); o8[64 * j] = w; }
    }
}
__device__ __forceinline__ void phase_final_norm(const Frame& F, float* h, const float* g) {
    const int gw = F.vcu * NWAVES + F.wave, NGW = F.G * NWAVES;
    f32x4 gv[4];
#pragma unroll
    for (int j = 0; j < 4; ++j) gv[j] = ((const f32x4*)g)[64 * j + F.lane];
    for (int m = gw; m < M; m += NGW) {
        f32x4* xr = (f32x4*)(h + (size_t)m * DM) + F.lane;
        f32x4 v[4]; float s = 0.f;
#pragma unroll
        for (int j = 0; j < 4; ++j) { v[j] = xr[64 * j]; s += (v[j].x * v[j].x + v[j].y * v[j].y) + (v[j].z * v[j].z + v[j].w * v[j].w); }
        const float r = 1.f / sqrtf(wave_sum(s) * (1.f / DM) + 1e-6f);
#pragma unroll
        for (int j = 0; j < 4; ++j) xr[64 * j] = v[j] * r * gv[j];
    }
}
__device__ __forceinline__ void phase_gates(const Frame& F, int l) {
    const bf16* cols = (const bf16*)(WSP(F) + WS_COLS); float* GT = (float*)(WSP(F) + WS_GATES);
    LAS bf16* raw = (LAS bf16*)(F.lds);
    LAS float* feat = (LAS float*)(F.lds + 32768);
    LAS float* gw = (LAS float*)(F.lds + 81920);
    const float* gwg = INP(F, 5) + (size_t)l * 768 * 16; const float* gb = INP(F, 6) + l * 16;
    const float* cw = INP(F, 3) + (size_t)l * 5 * 512; const float* cb = INP(F, 4) + l * 512;
    for (int i = F.tid; i < 768 * 16; i += 512) gw[i] = gwg[i];
    for (int tile = F.vcu; tile < M / 16; tile += F.G) {
        const int m0 = tile * 16, t0 = m0 % SEQ;
        __syncthreads();
        for (int ch = F.tid; ch < 20 * 96; ch += 512) { const int rr = ch / 96, cc = ch % 96; const int t = t0 - 2 + rr;
            v4u v = {0u, 0u, 0u, 0u}; if (t >= 0 && t < SEQ) v = *(const v4u*)(cols + (size_t)(m0 - 2 + rr) * NINP + cc * 8);
            *(LAS v4u*)(raw + rr * 768 + cc * 8) = v; }
        __syncthreads();
        for (int idx = F.tid; idx < 16 * 768; idx += 512) { const int t = idx / 768, c = idx % 768; float val;
            if (c < 512) { float s = cb[c];
#pragma unroll
                for (int j = 0; j < 5; ++j) s += cw[j * 512 + c] * bf2f(raw[(t + j) * 768 + c]);
                val = siluf_(s); } else val = bf2f(raw[(t + 2) * 768 + c]);
            feat[idx] = val; }
        __syncthreads();
        { const int t = F.tid >> 5, o = (F.tid >> 1) & 15, hf = F.tid & 1; float s = 0.f;
          const LAS float* fp = feat + t * 768 + hf * 384; const LAS float* wp = gw + (hf * 384) * 16 + o;
#pragma unroll 8
          for (int i = 0; i < 384; ++i) s += fp[i] * wp[i * 16];
          s += __shfl_xor(s, 1);
          if (hf == 0) { s += gb[o]; if (o >= 8) s = fminf(s, 0.f) - log1pf(__expf(-fabsf(s))); GT[(size_t)(m0 + t) * 16 + o] = s; } }
    }
    __syncthreads();
}
__device__ __forceinline__ f32x4 mma16_a8(const LAS bf16* A8, const LAS bf16* Bt, f32x4 acc, int lane) {
    const int q = lane >> 4;
    const LAS bf16* ap = A8 + (lane & 7) * 72 + q * 8; const LAS bf16* bp = Bt + (lane & 15) * 72 + q * 8;
#pragma unroll
    for (int k0 = 0; k0 < 64; k0 += 32) { const bf16x8 a = *(const LAS bf16x8*)(ap + k0); const bf16x8 b = *(const LAS bf16x8*)(bp + k0); acc = __builtin_amdgcn_mfma_f32_16x16x32_bf16(a, b, acc, 0, 0, 0); }
    return acc;
}
typedef float f32x2 __attribute__((ext_vector_type(2)));
template <bool DIR> __device__ __forceinline__ void rwkv_steps(const LAS float* OPS, const LAS float* VV, LAS float* YB, f32x4& S, int j, int row) {
    float yk0 = 0.f, yk1 = 0.f;
    const LAS float* opb = OPS + 4 * j; const LAS float* vpb = VV + row;
#define RWLD(W_, KK_, KA_, KM_, R_, V_, tl_) do { const LAS float* op_ = opb + (tl_) * 320; W_ = *(const LAS f32x4*)(op_); KK_ = *(const LAS f32x4*)(op_ + 64); KA_ = *(const LAS f32x4*)(op_ + 128); KM_ = *(const LAS f32x4*)(op_ + 192); R_ = *(const LAS f32x4*)(op_ + 256); V_ = vpb[(tl_) * 16]; } while (0)
    f32x4 w4, kk4, ka4, km4, r4, w4b, kk4b, ka4b, km4b, r4b; float vv, vvb;
    RWLD(w4, kk4, ka4, km4, r4, vv, (DIR ? 31 : 0));
    RWLD(w4b, kk4b, ka4b, km4b, r4b, vvb, (DIR ? 30 : 1));
#pragma unroll
    for (int i = 0; i < 32; ++i) {
        f32x4 nw4, nkk4, nka4, nkm4, nr4; float nvv;
        if (i < 30) RWLD(nw4, nkk4, nka4, nkm4, nr4, nvv, (DIR ? 29 - i : i + 2));
        f32x2 t2 = S.xy * kk4.xy; t2 = S.zw * kk4.zw + t2;
        float sa = t2.x + t2.y;
        const f32x4 pre_s = S * w4 + km4 * vv;
        sa = row16_sum(sa);
        S = pre_s + ka4 * sa;
        f32x2 y2 = S.xy * r4.xy; y2 = S.zw * r4.zw + y2;
        float y = y2.x + y2.y;
        y = row16_sum(y);
        if ((i & 15) == j) { if (i < 16) yk0 = y; else yk1 = y; }
        w4 = w4b; kk4 = kk4b; ka4 = ka4b; km4 = km4b; r4 = r4b; vv = vvb;
        if (i < 30) { w4b = nw4; kk4b = nkk4; ka4b = nka4; km4b = nkm4; r4b = nr4; vvb = nvv; } }
#undef RWLD
    YB[(DIR ? 31 - j : j) * 16 + row] = yk0; YB[(DIR ? 15 - j : 16 + j) * 16 + row] = yk1;
}
__device__ __forceinline__ void rwkv_scan(const Frame& F, int l, int task) {
    const int b = task / 48, rem = task % 48, h = rem >> 3, dir = (rem >> 2) & 1, qtr = rem & 3;
    const bf16* cols = (const bf16*)(WSP(F) + WS_COLS);
    bf16* Y = (bf16*)(WSP(F) + (dir ? Y_RB : Y_RF));
    float* CT = (float*)(WSP(F) + WS_CT);
    LAS bf16* WA = (LAS bf16*)(F.lds); LAS bf16* WW = (LAS bf16*)(F.lds + 9216);
    const int tid = F.tid, lane = F.lane, wave = F.wave;
    LAS bf16* XA = (LAS bf16*)(F.lds + 18432) + (wave & 3) * 576; LAS bf16* XW = (LAS bf16*)(F.lds + 23040) + (wave & 3) * 576;
    LAS bf16* RAWB = (LAS bf16*)(F.lds + 27648) + (wave & 3) * 3200;
    LAS float* MU = (LAS float*)(F.lds + 53248);
    LAS float* OPSb = (LAS float*)(F.lds + 55808);
    LAS float* VVb = (LAS float*)(F.lds + 137728);
    LAS float* YBb = (LAS float*)(F.lds + 141824);
    constexpr int NB = SEQ / 32;
    __syncthreads();
    { const float* aup = INP(F, 13) + (size_t)l * 64 * 384; const float* wup = INP(F, 11) + (size_t)(l * 2 + dir) * 64 * 384;
      for (int idx = tid; idx < 4096; idx += 512) { const int i = idx >> 6, c = idx & 63;
          WA[c * 72 + i] = (bf16)f2bf(aup[i * 384 + h * 64 + c]); WW[c * 72 + i] = (bf16)f2bf(wup[i * 384 + h * 64 + c]); }
      if (tid < 320) { const int which = tid >> 6, c = tid & 63;
          const int rc = which == 0 ? h * 64 + c : which == 1 ? 384 + h * 64 + c : which == 2 ? 768 + h * 64 + c : which == 3 ? 1152 + dir * 64 + c : 1280 + c;
          MU[tid] = INP(F, 8)[l * 1472 + rc]; MU[320 + tid] = INP(F, 9)[l * 1472 + rc]; } }
    __syncthreads();
    const size_t mb = (size_t)b * SEQ;
    const int j = lane & 15;
    if (wave < 4) {
        const int pw = wave;
        const int hc4 = h * 64 + 4 * j;
        const f32x4 kk_c4 = *(const f32x4*)(INP(F, 15) + l * 384 + hc4), ka_c4 = *(const f32x4*)(INP(F, 16) + l * 384 + hc4), rk_c4 = *(const f32x4*)(INP(F, 17) + l * 384 + hc4);
        float ba[4], bw[4];
#pragma unroll
        for (int ct = 0; ct < 4; ++ct) { ba[ct] = INP(F, 12)[l * 384 + h * 64 + 16 * ct + j]; bw[ct] = INP(F, 10)[(l * 2 + dir) * 384 + h * 64 + 16 * ct + j]; }
        const int c2 = (lane & 31) * 2;
        float mup_[5][2], mun_[5][2];
#pragma unroll
        for (int wq = 0; wq < 5; ++wq) { mup_[wq][0] = MU[wq * 64 + c2]; mup_[wq][1] = MU[wq * 64 + c2 + 1]; mun_[wq][0] = MU[320 + wq * 64 + c2]; mun_[wq][1] = MU[320 + wq * 64 + c2 + 1]; }
        v4u pre[7];
        int poff[7], prr[7];
#pragma unroll
        for (int i_ = 0; i_ < 7; ++i_) { const int idx_ = lane + 64 * i_; const int rr_ = idx_ / 40, q_ = idx_ % 40, wh_ = q_ >> 3, c8_ = q_ & 7;
            const int gc_ = (wh_ == 0 ? R_R + h * 64 : wh_ == 1 ? R_K + h * 64 : wh_ == 2 ? R_V + h * 64 : wh_ == 3 ? R_WDF + dir * 64 : R_AD) + c8_ * 8;
            prr[i_] = idx_ < 400 ? 8 * pw - 1 + rr_ : -100000; poff[i_] = (8 * pw - 1 + rr_) * NINP + gc_; }
        const bf16* colsb = cols + mb * NINP;
#define RW_ISSUE(blk) do { const int T0_ = dir ? SEQ - 32 * ((blk) + 1) : 32 * (blk); _Pragma("unroll") for (int i_ = 0; i_ < 7; ++i_) { pre[i_] = (v4u){0u, 0u, 0u, 0u}; \
        const int t_ = T0_ + prr[i_]; if (t_ >= 0 && t_ < SEQ) pre[i_] = *(const v4u*)(colsb + (size_t)T0_ * NINP + poff[i_]); } } while (0)
        RW_ISSUE(0);
#pragma unroll 1
        for (int it = 0; it <= NB; ++it) {
            if (it < NB) {
                __builtin_amdgcn_s_setprio(2);
                const int T0 = dir ? SEQ - 32 * (it + 1) : 32 * it;
                LAS float* OPS = OPSb + (it & 1) * 10240; LAS float* VV = VVb + (it & 1) * 512;
#pragma unroll
                for (int i = 0; i < 7; ++i) { const int idx = lane + 64 * i; if (idx < 400) *(LAS v4u*)(RAWB + idx * 8) = pre[i]; }
                LDS_WAIT(); asm volatile("" ::: "memory");
                if (it + 1 < NB) RW_ISSUE(it + 1);
#pragma unroll
                for (int k2 = 0; k2 < 20; ++k2) { const int which = k2 >> 2, tt = 2 * (k2 & 3) + (lane >> 5), cc = which * 64 + c2, t = 8 * pw + tt;
                    const unsigned r0 = *(const LAS unsigned*)(RAWB + tt * 320 + cc), r1 = *(const LAS unsigned*)(RAWB + (tt + 1) * 320 + cc), r2 = *(const LAS unsigned*)(RAWB + (tt + 2) * 320 + cc);
                    const float p1x = bf2f(r1 & 0xffffu), p1y = bf2f(r1 >> 16);
                    const float vx = p1x + mup_[which][0] * (bf2f(r0 & 0xffffu) - p1x) + mun_[which][0] * (bf2f(r2 & 0xffffu) - p1x);
                    const float vy = p1y + mup_[which][1] * (bf2f(r0 >> 16) - p1y) + mun_[which][1] * (bf2f(r2 >> 16) - p1y);
                    if (which == 0) *(LAS f32x2*)(OPS + t * 320 + 256 + c2) = (f32x2){vx, vy};
                    else if (which == 1) *(LAS f32x2*)(OPS + t * 320 + 192 + c2) = (f32x2){vx, vy};
                    else if (which == 2) { if ((c2 >> 4) == qtr) *(LAS f32x2*)(VV + t * 16 + (c2 & 15)) = (f32x2){vx, vy}; }
                    else if (which == 3) { const float ex = __expf(2.f * vx), ey = __expf(2.f * vy);
                        *(LAS unsigned*)(XW + tt * 72 + c2) = pk2(1.f - 2.f * __builtin_amdgcn_rcpf(ex + 1.f), 1.f - 2.f * __builtin_amdgcn_rcpf(ey + 1.f)); }
                    else *(LAS unsigned*)(XA + tt * 72 + c2) = pk2(vx, vy); }
                LDS_WAIT(); asm volatile("" ::: "memory");
#pragma unroll
                for (int ct = 0; ct < 4; ++ct) { const f32x4 z = {0.f, 0.f, 0.f, 0.f};
                    const f32x4 ca = mma16_a8(XA, WA + ct * 16 * 72, z, lane), cw = mma16_a8(XW, WW + ct * 16 * 72, z, lane);
                    const bool hi = lane >= 32; const int tb = 8 * pw + ((lane >> 4) & 1) * 4 + (hi ? 2 : 0), c = ct * 16 + j;
                    const float a0v = hi ? ca[2] : ca[0], a1v = hi ? ca[3] : ca[1], w0v = hi ? cw[2] : cw[0], w1v = hi ? cw[3] : cw[1];
                    OPS[tb * 320 + 128 + c] = sigmoidf_(ba[ct] + a0v); OPS[(tb + 1) * 320 + 128 + c] = sigmoidf_(ba[ct] + a1v);
                    OPS[tb * 320 + c] = __expf(-0.6065306597f * sigmoidf_(bw[ct] + w0v)); OPS[(tb + 1) * 320 + c] = __expf(-0.6065306597f * sigmoidf_(bw[ct] + w1v)); }
                LDS_WAIT(); asm volatile("" ::: "memory");
#pragma unroll
                for (int ps = 0; ps < 2; ++ps) { const int t = 8 * pw + 4 * ps + (lane >> 4); LAS float* op = OPS + t * 320 + 4 * j;
                    const f32x4 av = *(const LAS f32x4*)(op + 128), kp = *(const LAS f32x4*)(op + 192), rp = *(const LAS f32x4*)(op + 256);
                    const f32x4 kr = kp * kk_c4; const float ss = row16_sum((kr.x * kr.x + kr.y * kr.y) + (kr.z * kr.z + kr.w * kr.w));
                    const f32x4 kkv = kr * (1.f / fmaxf(sqrtf(ss), 1e-12f));
                    const f32x4 km = kp * ((av - 1.f) * ka_c4 + 1.f);
                    const f32x4 q = rp * km * rk_c4; const float cs = row16_sum((q.x + q.y) + (q.z + q.w));
                    *(LAS f32x4*)(op + 64) = kkv; *(LAS f32x4*)(op + 128) = kkv * (-av); *(LAS f32x4*)(op + 192) = km;
                    if (dir == 0 && qtr == 0 && j == 0) CT[(mb + T0 + t) * 8 + h] = cs; }
            }
            if (it >= 2) { const int bk = it - 2; const int T0 = dir ? SEQ - 32 * (bk + 1) : 32 * bk; const LAS float* YB = YBb + (bk & 1) * 512;
                const int idx = (pw * 64 + lane) * 2, tl = idx >> 4, rw = idx & 15;
                *(unsigned*)(Y + (mb + T0 + tl) * 384 + h * 64 + 16 * qtr + rw) = pk2(YB[idx], YB[idx + 1]); }
            __syncthreads();
        }
        { const int bk = NB - 1; const int T0 = dir ? SEQ - 32 * (bk + 1) : 32 * bk; const LAS float* YB = YBb + (bk & 1) * 512;
          const int idx = (pw * 64 + lane) * 2, tl = idx >> 4, rw = idx & 15;
          *(unsigned*)(Y + (mb + T0 + tl) * 384 + h * 64 + 16 * qtr + rw) = pk2(YB[idx], YB[idx + 1]); }
#undef RW_ISSUE
    } else {
        const int row = (wave - 4) * 4 + (lane >> 4);
        f32x4 S = {0.f, 0.f, 0.f, 0.f};
#pragma unroll 1
        for (int it = 0; it <= NB; ++it) {
            if (it >= 1) { const int bk = it - 1;
                const LAS float* OPS = OPSb + (bk & 1) * 10240; const LAS float* VV = VVb + (bk & 1) * 512; LAS float* YB = YBb + (bk & 1) * 512;

                if (dir) rwkv_steps<true>(OPS, VV, YB, S, j, row); else rwkv_steps<false>(OPS, VV, YB, S, j, row);
            }
            __syncthreads();
        }
    }
    __syncthreads();
}
__device__ __forceinline__ float row8_sum(float v) { v += dppf<0xB1>(v); v += dppf<0x4E>(v); v += dppf<0x141>(v); return v; }
__device__ __forceinline__ void mlstm_seq(const Frame& F, int l, int task) {
    const int b = task >> 3, h = (task >> 1) & 3, dir = task & 1;
    const bf16* cols = (const bf16*)(WSP(F) + WS_COLS); const float* GT = (const float*)(WSP(F) + WS_GATES);
    bf16* Y = (bf16*)(WSP(F) + (dir ? Y_AB : Y_AF));
    LAS bf16* RAWQ = (LAS bf16*)(F.lds);
    LAS bf16* Qs = (LAS bf16*)(F.lds + 17408); LAS bf16* Ks = (LAS bf16*)(F.lds + 26624);
    LAS bf16* Vtb = (LAS bf16*)(F.lds + 35840);
    LAS bf16* KWt = (LAS bf16*)(F.lds + 54272); LAS bf16* Ps = (LAS bf16*)(F.lds + 63488);
    LAS bf16* Ctb = (LAS bf16*)(F.lds + 72704);
    LAS float* ub = (LAS float*)(F.lds + 91136);
    LAS float* blb = ub + 128; LAS float* rmb = ub + 256;
    LAS float* den = ub + 384; LAS float* qn = ub + 448; LAS float* nst = ub + 512; LAS float* scb = ub + 576;
    const int tid = F.tid, lane = F.lane, wave = F.wave;
    const size_t mb = (size_t)b * SEQ;
    constexpr int NC = SEQ / 64;
    __syncthreads();
    for (int i = tid; i < 2 * 64 * 72; i += 512) Ctb[i] = 0;
    if (tid < 64) nst[tid] = 0.f;
    const int cc = tid & 127, isK = cc >> 6, d0 = cc & 63, chn = isK * 256 + h * 64 + d0;
    float cw[5]; const float* cwp = INP(F, 3) + (size_t)l * 5 * 512;
#pragma unroll
    for (int jj = 0; jj < 5; ++jj) cw[jj] = cwp[jj * 512 + chn];
    const float cbv = INP(F, 4)[l * 512 + chn];
    f32x4 st[2] = {{0.f, 0.f, 0.f, 0.f}, {0.f, 0.f, 0.f, 0.f}};
    float m_st = 0.f;
    v4u pre[3], prev; float gli = 0.f, glf = 0.f;
#define ML_ISSUE(c_) do { const int tlo_ = dir ? SEQ - 64 * ((c_) + 1) : 64 * (c_); _Pragma("unroll") for (int i_ = 0; i_ < 3; ++i_) { const int ch_ = tid + 512 * i_; pre[i_] = (v4u){0u, 0u, 0u, 0u}; \
        if (ch_ < 68 * 16) { const int rr_ = ch_ >> 4, q_ = ch_ & 15; const int t_ = tlo_ - 2 + rr_; if (t_ >= 0 && t_ < SEQ) pre[i_] = *(const v4u*)(cols + (mb + t_) * NINP + (q_ >> 3) * 256 + h * 64 + (q_ & 7) * 8); } } \
        prev = *(const v4u*)(cols + (mb + tlo_ + (tid >> 3)) * NINP + A_V + h * 64 + (tid & 7) * 8); \
        if (tid < 64) { const int t_ = dir ? tlo_ + 63 - tid : tlo_ + tid; gli = GT[(mb + t_) * 16 + dir * 4 + h]; glf = GT[(mb + t_) * 16 + 8 + dir * 4 + h]; } } while (0)
#define ML_FILL(c_) do { _Pragma("unroll") for (int i_ = 0; i_ < 3; ++i_) { const int ch_ = tid + 512 * i_; if (ch_ < 68 * 16) *(LAS v4u*)(RAWQ + (ch_ >> 4) * 128 + (ch_ & 15) * 8) = pre[i_]; } \
        { LAS bf16* Vt_ = Vtb + ((c_) & 1) * 4608; const int tl_ = tid >> 3, e8_ = tid & 7; const int lp_ = dir ? 63 - tl_ : tl_; const unsigned w_[4] = {prev.x, prev.y, prev.z, prev.w}; \
          _Pragma("unroll") for (int k_ = 0; k_ < 4; ++k_) { Vt_[(e8_ * 8 + 2 * k_) * 72 + lp_] = (bf16)(w_[k_] & 0xffffu); Vt_[(e8_ * 8 + 2 * k_ + 1) * 72 + lp_] = (bf16)(w_[k_] >> 16); } } \
        if (tid < 64) { float bl_ = glf; _Pragma("unroll") for (int o_ = 1; o_ < 64; o_ <<= 1) { const float x_ = __shfl_up(bl_, o_); if (lane >= o_) bl_ += x_; } \
            const float u_ = gli - bl_; float rm_ = u_; _Pragma("unroll") for (int o_ = 1; o_ < 64; o_ <<= 1) { const float x_ = __shfl_up(rm_, o_); if (lane >= o_) rm_ = fmaxf(rm_, x_); } \
            ub[((c_) & 1) * 64 + tid] = u_; blb[((c_) & 1) * 64 + tid] = bl_; rmb[((c_) & 1) * 64 + tid] = rm_; if (tid == 63) { scb[((c_) & 1) * 2] = rm_; scb[((c_) & 1) * 2 + 1] = bl_; } } } while (0)
    ML_ISSUE(0); ML_FILL(0); ML_ISSUE(1);
    __syncthreads();
#pragma unroll 1
    for (int c = 0; c < NC; ++c) {
        const int tlo = dir ? SEQ - 64 * (c + 1) : 64 * c;
        const LAS float* u = ub + (c & 1) * 64; const LAS float* bl = blb + (c & 1) * 64; const LAS float* rm = rmb + (c & 1) * 64;
        const LAS bf16* Vt = Vtb + (c & 1) * 4608; const LAS bf16* Ct = Ctb + (c & 1) * 4608; LAS bf16* Ctn = Ctb + ((c + 1) & 1) * 4608;
#pragma unroll 4
        for (int i = 0; i < 16; ++i) { const int tl = (tid >> 7) + 4 * i; float s = cbv;
#pragma unroll
            for (int jj = 0; jj < 5; ++jj) s += cw[jj] * bf2f(RAWQ[(tl + jj) * 128 + cc]);
            s = siluf_(s); const int lpos = dir ? 63 - tl : tl;
            if (isK) Ks[lpos * 72 + d0] = (bf16)f2bf(s * 0.125f); else Qs[lpos * 72 + d0] = (bf16)f2bf(s); }
        if (tid < 64) den[tid] = 0.f;
        __syncthreads();
        const float umax = scb[(c & 1) * 2], tot = scb[(c & 1) * 2 + 1];
        for (int idx = tid; idx < 4096; idx += 512) { const int lp = idx >> 6, d = idx & 63; KWt[d * 72 + lp] = (bf16)f2bf(bf2f(Ks[lp * 72 + d]) * __expf(u[lp] - umax)); }
#pragma unroll
        for (int k = 0; k < 2; ++k) { const int ti = 2 * wave + k, tl_ = ti >> 2, ts = ti & 3; f32x4 acc = {0.f, 0.f, 0.f, 0.f};
            if (ts <= tl_) acc = mma16<64>(Qs + tl_ * 16 * 72, 72, Ks + ts * 16 * 72, 72, acc, lane);
#pragma unroll
            for (int jj = 0; jj < 4; ++jj) { const int lr = tl_ * 16 + (lane >> 4) * 4 + jj, s = ts * 16 + (lane & 15);
                const float v = (s <= lr) ? acc[jj] * __expf(u[s] - fmaxf(m_st, rm[lr])) : 0.f; const unsigned vb = f2bf(v); Ps[lr * 72 + s] = (bf16)vb;
                if (ts <= tl_) { const float rs = row16_sum(bf2f(vb)); if ((lane & 15) == 0) __hip_atomic_fetch_add(den + lr, rs, __ATOMIC_RELAXED, __HIP_MEMORY_SCOPE_WORKGROUP); } } }
        { const int lq = tid >> 3, part = tid & 7; float s = 0.f;
#pragma unroll
          for (int k = 0; k < 8; ++k) s += bf2f(Qs[lq * 72 + part * 8 + k]) * nst[part * 8 + k];
          s = row8_sum(s); if (part == 0) qn[lq] = s; }
        __syncthreads();
        const float mmax = fmaxf(m_st, umax), s_old = __expf(m_st - mmax), s_new = __expf(umax - mmax);
#pragma unroll
        for (int k = 0; k < 2; ++k) { const int ti = 2 * wave + k, t0_ = ti >> 2, t1_ = ti & 3; const f32x4 z = {0.f, 0.f, 0.f, 0.f};
            const f32x4 a1 = mma16<64>(Ps + t0_ * 16 * 72, 72, Vt + t1_ * 16 * 72, 72, z, lane);
            const f32x4 a2 = mma16<64>(Qs + t0_ * 16 * 72, 72, Ct + t1_ * 16 * 72, 72, z, lane);
            const f32x4 lc = mma16<64>(Vt + t0_ * 16 * 72, 72, KWt + t1_ * 16 * 72, 72, z, lane);
#pragma unroll
            for (int jj = 0; jj < 4; ++jj) { const int r_ = t0_ * 16 + (lane >> 4) * 4 + jj, c_ = t1_ * 16 + (lane & 15);
                const float mx = fmaxf(m_st, rm[r_]), iwv = __expf(m_st - mx);
                const float dn = den[r_] + iwv * qn[r_];
                const float val = (a1[jj] + iwv * a2[jj]) / fmaxf(fabsf(dn), __expf(-(bl[r_] + mx)));
                const int t = dir ? tlo + 63 - r_ : tlo + r_;
                Y[(mb + t) * 256 + h * 64 + c_] = (bf16)f2bf(val);
                st[k][jj] = s_old * st[k][jj] + s_new * lc[jj];
                Ctn[r_ * 72 + c_] = (bf16)f2bf(st[k][jj]); } }
        { const int dq = tid >> 3, part = tid & 7; float s = 0.f;
#pragma unroll
          for (int k = 0; k < 8; ++k) s += bf2f(KWt[dq * 72 + part * 8 + k]);
          s = row8_sum(s); if (part == 0) nst[dq] = s_old * nst[dq] + s_new * s; }
        m_st = tot + mmax;
        if (c + 1 < NC) { ML_FILL(c + 1); if (c + 2 < NC) ML_ISSUE(c + 2); }
        __syncthreads();
    }
#undef ML_ISSUE
#undef ML_FILL
}
__device__ __forceinline__ void phase_ssd_conv(const Frame& F, int l) {
    const bf16* cols = (const bf16*)(WSP(F) + WS_COLS); bf16* XBC = (bf16*)(WSP(F) + WS_XN);
    LAS bf16* raw = (LAS bf16*)(F.lds);
    const float* cwp = INP(F, 20) + (size_t)l * 5 * 896; const float* cbp = INP(F, 21) + l * 896;
    const int tid = F.tid;
    float cw0[5], cw1[5]; const int c1 = tid + 512 < 896 ? tid + 512 : tid;
#pragma unroll
    for (int jj = 0; jj < 5; ++jj) { cw0[jj] = cwp[jj * 896 + tid]; cw1[jj] = cwp[jj * 896 + c1]; }
    const float cb0 = cbp[tid], cb1 = cbp[c1];
    for (int tile = F.vcu; tile < M / 32; tile += F.G) {
        const int m0 = tile * 32, t0 = m0 % SEQ;
        __syncthreads();
        for (int ch = tid; ch < 36 * 112; ch += 512) { const int rr = ch / 112, cc = ch % 112; const int t = t0 - 2 + rr;
            v4u v = {0u, 0u, 0u, 0u}; if (t >= 0 && t < SEQ) v = *(const v4u*)(cols + (size_t)(m0 - 2 + rr) * NINP + S_X + cc * 8);
            *(LAS v4u*)(raw + rr * 896 + cc * 8) = v; }
        __syncthreads();
#pragma unroll
        for (int half = 0; half < 2; ++half) { const int c = half ? c1 : tid; if (half && tid + 512 >= 896) break;
            float win[5];
#pragma unroll
            for (int jj = 0; jj < 4; ++jj) win[jj] = bf2f(raw[jj * 896 + c]);
            for (int tl = 0; tl < 32; ++tl) { win[4] = bf2f(raw[(tl + 4) * 896 + c]);
                float s = half ? cb1 : cb0;
#pragma unroll
                for (int jj = 0; jj < 5; ++jj) s += (half ? cw1[jj] : cw0[jj]) * win[jj];
#pragma unroll
                for (int jj = 0; jj < 4; ++jj) win[jj] = win[jj + 1];
                XBC[(size_t)(m0 + tl) * 896 + c] = (bf16)f2bf(siluf_(s)); } }
    }
    __syncthreads();
}
__device__ __forceinline__ void ssd_seq(const Frame& F, int l, int task) {
    const int b = task / 12, rem = task % 12, head = rem >> 1, dir = rem & 1, g = head / 3;
    const bf16* cols = (const bf16*)(WSP(F) + WS_COLS); const bf16* XBC = (const bf16*)(WSP(F) + WS_XN);
    bf16* Y = (bf16*)(WSP(F) + (dir ? Y_SB : Y_SF));
    LAS bf16* Cm = (LAS bf16*)(F.lds); LAS bf16* Bm = (LAS bf16*)(F.lds + 17408);
    LAS bf16* Btw = (LAS bf16*)(F.lds + 34816); LAS bf16* Xt = (LAS bf16*)(F.lds + 53248);
    LAS bf16* Ps = (LAS bf16*)(F.lds + 62464); LAS bf16* Hs = (LAS bf16*)(F.lds + 71680);
    LAS float* dtvb = (LAS float*)(F.lds + 89088);
    LAS float* acsb = dtvb + 128;
    LAS float* totb = dtvb + 256;
    const int tid = F.tid, lane = F.lane, wave = F.wave;
    const size_t mb = (size_t)b * SEQ;
    constexpr int NC = SEQ / 64;
    __syncthreads();
    for (int i = tid; i < 64 * 136; i += 512) Hs[i] = 0;
    const float dtb = INP(F, 22)[(l * 2 + dir) * 6 + head];
    const float aneg = -__expf(INP(F, 23)[(l * 2 + dir) * 6 + head]);
    f32x4 st[4];
#pragma unroll
    for (int k = 0; k < 4; ++k) st[k] = (f32x4){0.f, 0.f, 0.f, 0.f};
    v4u pre[5]; float dtraw = 0.f;
#define SSD_ISSUE(c_) do { const int tlo_ = dir ? SEQ - 64 * ((c_) + 1) : 64 * (c_); _Pragma("unroll") for (int i_ = 0; i_ < 5; ++i_) { const int idx_ = tid + 512 * i_; const int tl_ = idx_ / 40, q_ = idx_ % 40; \
        const int gc_ = q_ < 8 ? head * 64 + q_ * 8 : (q_ < 24 ? 384 + g * 128 + (q_ - 8) * 8 : 640 + g * 128 + (q_ - 24) * 8); \
        pre[i_] = *(const v4u*)(XBC + (mb + tlo_ + tl_) * 896 + gc_); } } while (0)
#define SSD_DTLOAD(c_) do { if (tid < 64) { const int tlo_ = dir ? SEQ - 64 * ((c_) + 1) : 64 * (c_); const int t_ = dir ? tlo_ + 63 - tid : tlo_ + tid; dtraw = bf2f(cols[(mb + t_) * NINP + S_DT + dir * 6 + head]); } } while (0)
#define SSD_DTCALC(c_) do { if (tid < 64) { const float x_ = dtraw + dtb; const float dt_ = x_ > 20.f ? x_ : log1pf(__expf(x_)); float cs_ = dt_ * aneg; \
        _Pragma("unroll") for (int o_ = 1; o_ < 64; o_ <<= 1) { const float u_ = __shfl_up(cs_, o_); if (lane >= o_) cs_ += u_; } \
        const float tt_ = __shfl(cs_, 63); dtvb[((c_) & 1) * 64 + tid] = dt_; acsb[((c_) & 1) * 64 + tid] = cs_; if (tid == 0) totb[(c_) & 1] = tt_; } } while (0)
    SSD_ISSUE(0); SSD_DTLOAD(0); SSD_DTCALC(0); SSD_DTLOAD(1);
    __syncthreads();
#pragma unroll 1
    for (int c = 0; c < NC; ++c) {
        const int tlo = dir ? SEQ - 64 * (c + 1) : 64 * c;
        const LAS float* dtv = dtvb + (c & 1) * 64; const LAS float* acs = acsb + (c & 1) * 64; const float tot = totb[c & 1];
#pragma unroll
        for (int i = 0; i < 5; ++i) { const int idx = tid + 512 * i; const int tl = idx / 40, q = idx % 40; const int lp = dir ? 63 - tl : tl;
            const unsigned w[4] = {pre[i].x, pre[i].y, pre[i].z, pre[i].w};
            if (q < 8) {
#pragma unroll
                for (int k = 0; k < 4; ++k) { Xt[(q * 8 + 2 * k) * 72 + lp] = (bf16)(w[k] & 0xffffu); Xt[(q * 8 + 2 * k + 1) * 72 + lp] = (bf16)(w[k] >> 16); } }
            else if (q < 24) { const int n0 = (q - 8) * 8; *(LAS v4u*)(Bm + lp * 136 + n0) = pre[i]; const float sc = dtv[lp] * __expf(tot - acs[lp]);
#pragma unroll
                for (int k = 0; k < 4; ++k) { Btw[(n0 + 2 * k) * 72 + lp] = (bf16)f2bf(bf2f(w[k] & 0xffffu) * sc); Btw[(n0 + 2 * k + 1) * 72 + lp] = (bf16)f2bf(bf2f(w[k] >> 16) * sc); } }
            else { const int n0 = (q - 24) * 8; *(LAS v4u*)(Cm + lp * 136 + n0) = pre[i]; } }
        if (c + 1 < NC) SSD_ISSUE(c + 1);
        __syncthreads();
        f32x4 yo[2], lc[4];
#pragma unroll
        for (int k = 0; k < 2; ++k) { const int ti = 2 * wave + k, tl_ = ti >> 2, ts = ti & 3; f32x4 acc = {0.f, 0.f, 0.f, 0.f};
            if (ts <= tl_) acc = mma16<128>(Cm + tl_ * 16 * 136, 136, Bm + ts * 16 * 136, 136, acc, lane);
#pragma unroll
            for (int jj = 0; jj < 4; ++jj) { const int lr = tl_ * 16 + (lane >> 4) * 4 + jj, s = ts * 16 + (lane & 15);
                const float v = (s <= lr) ? acc[jj] * __expf(acs[lr] - acs[s]) * dtv[s] : 0.f; Ps[lr * 72 + s] = (bf16)f2bf(v); }
            const f32x4 z = {0.f, 0.f, 0.f, 0.f};
            yo[k] = mma16<128>(Cm + tl_ * 16 * 136, 136, Hs + ts * 16 * 136, 136, z, lane); }
#pragma unroll
        for (int k = 0; k < 4; ++k) { const int ti = 4 * wave + k, tp = ti >> 3, tn = ti & 7; const f32x4 z = {0.f, 0.f, 0.f, 0.f};
            lc[k] = mma16<64>(Xt + tp * 16 * 72, 72, Btw + tn * 16 * 72, 72, z, lane); }
        __syncthreads();
        const float cdec = __expf(tot);
#pragma unroll
        for (int k = 0; k < 2; ++k) { const int ti = 2 * wave + k, tl_ = ti >> 2, tp = ti & 3; const f32x4 z = {0.f, 0.f, 0.f, 0.f};
            const f32x4 yd = mma16<64>(Ps + tl_ * 16 * 72, 72, Xt + tp * 16 * 72, 72, z, lane);
#pragma unroll
            for (int jj = 0; jj < 4; ++jj) { const int lr = tl_ * 16 + (lane >> 4) * 4 + jj, p = tp * 16 + (lane & 15);
                const float val = yd[jj] + yo[k][jj] * __expf(acs[lr]);
                const int t = dir ? tlo + 63 - lr : tlo + lr;
                Y[(mb + t) * 384 + head * 64 + p] = (bf16)f2bf(val); } }
#pragma unroll
        for (int k = 0; k < 4; ++k) { const int ti = 4 * wave + k, tp = ti >> 3, tn = ti & 7;
#pragma unroll
            for (int jj = 0; jj < 4; ++jj) { const int p = tp * 16 + (lane >> 4) * 4 + jj, n = tn * 16 + (lane & 15);
                st[k][jj] = cdec * st[k][jj] + lc[k][jj]; Hs[p * 136 + n] = (bf16)f2bf(st[k][jj]); } }
        if (c + 1 < NC) { SSD_DTCALC(c + 1); if (c + 2 < NC) SSD_DTLOAD(c + 2); }
        __syncthreads();
    }
#undef SSD_ISSUE
#undef SSD_DTLOAD
#undef SSD_DTCALC
}
__device__ __forceinline__ void phase_post(const Frame& F, int l) {
    const bf16* cols = (const bf16*)(WSP(F) + WS_COLS); bf16* MIX = (bf16*)(WSP(F) + WS_XN);
    const bf16* YAf = (const bf16*)(WSP(F) + Y_AF); const bf16* YAb = (const bf16*)(WSP(F) + Y_AB);
    const bf16* YRf = (const bf16*)(WSP(F) + Y_RF); const bf16* YRb = (const bf16*)(WSP(F) + Y_RB);
    const bf16* YSf = (const bf16*)(WSP(F) + Y_SF); const bf16* YSb = (const bf16*)(WSP(F) + Y_SB);
    const float* CT = (const float*)(WSP(F) + WS_CT);
    LAS float* sg = (LAS float*)(F.lds);
    LAS float* gate = (LAS float*)(F.lds + 8192);
    const int tid = F.tid, lane = F.lane, wave = F.wave;
    const float* mup = INP(F, 8) + l * 1472; const float* mun = INP(F, 9) + l * 1472;
    const float* gup = INP(F, 14) + (size_t)l * 128 * 384;
    const float* mng = INP(F, 7) + l * 256; const float* rng = INP(F, 18) + l * 384; const float* rnb = INP(F, 19) + l * 384;
    const float* scb = INP(F, 21) + l * 896; const float* scw = INP(F, 20) + (size_t)l * 5 * 896; const float* sdk = INP(F, 24) + l * 6; const float* sng = INP(F, 25) + l * 384;
    for (int tile = F.vcu; tile < M / 16; tile += F.G) {
        const int m0 = tile * 16;
        __syncthreads();
        for (int idx = tid; idx < 16 * 128; idx += 512) { const int tt = idx >> 7, i = idx & 127; const int m = m0 + tt, t = m % SEQ;
            const float p1 = bf2f(cols[(size_t)m * NINP + R_GD + i]);
            const float p0 = t > 0 ? bf2f(cols[(size_t)(m - 1) * NINP + R_GD + i]) : 0.f;
            const float p2 = t < SEQ - 1 ? bf2f(cols[(size_t)(m + 1) * NINP + R_GD + i]) : 0.f;
            sg[idx] = sigmoidf_(p1 + mup[1344 + i] * (p0 - p1) + mun[1344 + i] * (p2 - p1)); }
        __syncthreads();
        if (tid < 384) { float acc[16];
#pragma unroll
            for (int tt = 0; tt < 16; ++tt) acc[tt] = 0.f;
            for (int i = 0; i < 128; ++i) { const float w = gup[i * 384 + tid];
#pragma unroll
                for (int tt = 0; tt < 16; ++tt) acc[tt] += sg[tt * 128 + i] * w; }
#pragma unroll
            for (int tt = 0; tt < 16; ++tt) gate[tt * 384 + tid] = acc[tt]; }
        __syncthreads();
#pragma unroll 1
        for (int k = 0; k < 2; ++k) { const int tt = wave * 2 + k; const int m = m0 + tt, t = m % SEQ; const size_t cr = (size_t)m * NINP;
#pragma unroll
            for (int i = 0; i < 4; ++i) { const int col = i * 64 + lane;
                const float hs = bf2f(YAf[(size_t)m * 256 + col]) + bf2f(YAb[(size_t)m * 256 + col]);
                const float mean = wave_sum(hs) * (1.f / 64.f); const float d = hs - mean; const float var = wave_sum(d * d) * (1.f / 64.f);
                const float y = d * (1.f / sqrtf(var + 1e-6f)) * mng[col];
                MIX[(size_t)m * DM + col] = (bf16)f2bf(y * sigmoidf_(bf2f(cols[cr + A_O + col]))); }
#pragma unroll
            for (int i = 0; i < 6; ++i) { const int col = i * 64 + lane;
                const float ys = bf2f(YRf[(size_t)m * 384 + col]) + bf2f(YRb[(size_t)m * 384 + col]);
                const float mean = wave_sum(ys) * (1.f / 64.f); const float d = ys - mean; const float var = wave_sum(d * d) * (1.f / 64.f);
                const float y = d * (1.f / sqrtf(var + 64e-5f)) * rng[col] + rnb[col];
                const float p1 = bf2f(cols[cr + R_V + col]);
                const float p0 = t > 0 ? bf2f(cols[cr - NINP + R_V + col]) : 0.f;
                const float p2 = t < SEQ - 1 ? bf2f(cols[cr + NINP + R_V + col]) : 0.f;
                const float vv = p1 + mup[768 + col] * (p0 - p1) + mun[768 + col] * (p2 - p1);
                const float bonus = CT[(size_t)m * 8 + i] * vv;
                MIX[(size_t)m * DM + 256 + col] = (bf16)f2bf((y + bonus) * gate[tt * 384 + col]); }
            float yv[6]; float ssq[2] = {0.f, 0.f};
#pragma unroll
            for (int i = 0; i < 6; ++i) { const int col = i * 64 + lane;
                float s = scb[col];
#pragma unroll
                for (int jj = 0; jj < 5; ++jj) { const int tq = t + jj - 2; if (tq >= 0 && tq < SEQ) s += scw[jj * 896 + col] * bf2f(cols[cr + (jj - 2) * NINP + S_X + col]); }
                const float xc = siluf_(s);
                float y = bf2f(YSf[(size_t)m * 384 + col]) + bf2f(YSb[(size_t)m * 384 + col]) + sdk[i] * xc;
                y *= siluf_(bf2f(cols[cr + S_Z + col]));
                yv[i] = y; ssq[i / 3] += y * y; }
            const float r0 = 1.f / sqrtf(wave_sum(ssq[0]) * (1.f / 192.f) + 1e-6f), r1 = 1.f / sqrtf(wave_sum(ssq[1]) * (1.f / 192.f) + 1e-6f);
#pragma unroll
            for (int i = 0; i < 6; ++i) { const int col = i * 64 + lane;
                MIX[(size_t)m * DM + 640 + col] = (bf16)f2bf(yv[i] * (i < 3 ? r0 : r1) * sng[col]); }
        }
    }
    __syncthreads();
}
namespace cg = cooperative_groups;
constexpr int N_PHASES = 9 * DEPTH + 1;
__global__ void __launch_bounds__(NWAVES * 64, 2) mk_fwd(Args args) {
    extern __shared__ __attribute__((aligned(16))) unsigned char lds_raw[];
    Frame F;
    F.lds = (LAS unsigned char*)lds_raw;
    F.tid = threadIdx.x; F.lane = F.tid & 63; F.wave = __builtin_amdgcn_readfirstlane(F.tid >> 6);
    F.G = gridDim.x; { const int bx = blockIdx.x; F.vcu = (F.G % 8 == 0) ? (bx % 8) * (F.G / 8) + bx / 8 : bx; }
    volatile LAS unsigned* MISC = (volatile LAS unsigned*)(F.lds + MISC_OFF);
    if (F.tid < 64) MISC[F.tid] = 0u;
    if (F.tid < 34) *(LAS unsigned long long*)(F.lds + PTAB_OFF + 8 * F.tid) = ((const unsigned long long*)__builtin_amdgcn_kernarg_segment_ptr())[F.tid];
    __syncthreads();
    unsigned* ctl = (unsigned*)(WSP(F) + WS_CTL);
    XcdBarrier bar = xcd_barrier_post(ctl + CW_BAR, MISC + 8);
    const int lo = args.ph_lo, hi = args.ph_hi;
#define IN_(k) (lo <= (k) && (k) < hi)
#define SEAM(k) do { if (IN_(k) && IN_((k) + 1)) { if ((k) == 0) cg::this_grid().sync(); else xcd_barrier(bar); } } while (0)
#define LAYER(l, B) \
    if (IN_(B + 0)) { phase_convert(F, l); phase_norm(F, l == 0 ? INP(F, 0) : OUTP(F), INP(F, 1) + l * DM, (bf16*)(WSP(F) + WS_XN)); } SEAM(B + 0); \
    if (IN_(B + 1)) { unsigned char* ws = WSP(F); pg8::Gemm g{(const bf16*)(ws + WS_XN), (const bf16*)(ws + WS_WIN), M, NINP, DM}; pg8::StaticOrder S; S.init(M, NINP, F.G, (int)blockIdx.x); \
            pg8::EpiBf16<0> E{(bf16*)(ws + WS_COLS), NINP, nullptr, 0, 0, 1.f}; \
            pg8::gemm_phase<pg8::EpiBf16<0>, pg8::StaticOrder, PG8_ALIGN, PG8_SP2>(F.lds, g, S, E); } SEAM(B + 1); \
    if (IN_(B + 2)) { phase_gates(F, l); phase_ssd_conv(F, l); } SEAM(B + 2); \
    if (IN_(B + 3)) { const int bx = blockIdx.x; \
            if (bx < 96) rwkv_scan(F, l, bx); else if (bx < 112) mlstm_seq(F, l, bx - 96); else if (bx < 136) ssd_seq(F, l, bx - 112); } SEAM(B + 3); \
    if (IN_(B + 4)) phase_post(F, l); SEAM(B + 4); \
    if (IN_(B + 5)) { unsigned char* ws = WSP(F); pg8::Gemm g{(const bf16*)(ws + WS_XN), (const bf16*)(ws + WS_WOUT), M, DM, DM}; pg8::StaticOrder S; S.init(M, DM, F.G, (int)blockIdx.x); \
            pg8::EpiResidual E{l == 0 ? INP(F, 0) : OUTP(F), OUTP(F), DM}; \
            pg8::gemm_phase<pg8::EpiResidual, pg8::StaticOrder, PG8_ALIGN, PG8_SP2>(F.lds, g, S, E); } SEAM(B + 5); \
    if (IN_(B + 6)) phase_norm(F, OUTP(F), INP(F, 27) + l * DM, (bf16*)(WSP(F) + WS_XN)); SEAM(B + 6); \
    if (IN_(B + 7)) { unsigned char* ws = WSP(F); pg8::Gemm g{(const bf16*)(ws + WS_XN), (const bf16*)(ws + WS_WGU), M, 2 * FFN, DM}; pg8::StaticOrder S; S.init(M, 2 * FFN, F.G, (int)blockIdx.x); \
            pg8::EpiSwiGLU E{(bf16*)(ws + WS_COLS), FFN}; \
            pg8::gemm_phase<pg8::EpiSwiGLU, pg8::StaticOrder, PG8_ALIGN, PG8_SP2>(F.lds, g, S, E); } SEAM(B + 7); \
    if (IN_(B + 8)) { unsigned char* ws = WSP(F); pg8::Gemm g{(const bf16*)(ws + WS_COLS), (const bf16*)(ws + WS_WDN), M, DM, FFN}; pg8::StaticOrder S; S.init(M, DM, F.G, (int)blockIdx.x); \
            pg8::EpiResidual E{OUTP(F), OUTP(F), DM}; \
            pg8::gemm_phase<pg8::EpiResidual, pg8::StaticOrder, PG8_ALIGN, PG8_SP2>(F.lds, g, S, E); } SEAM(B + 8);
    LAYER(0, 0)
    LAYER(1, 9)
    if (IN_(18)) phase_final_norm(F, OUTP(F), INP(F, 31));
#undef IN_
#undef SEAM
#undef LAYER
}

#ifndef MK_PER_PHASE
#define MK_PER_PHASE 0
#endif
extern "C" void kernel_launch(void* const* d_in, const int* in_sizes, int n_in, void* d_out, int out_size, void* d_ws, size_t ws_size, hipStream_t stream) {
    static int grid = 0;
    if (grid == 0) {
        int dev = 0, cus = 0;
        if (n_in != 32 || out_size != M * DM || ws_size < WS_END) { fprintf(stderr, "kernel_launch: unexpected shapes (n_in %d out %d ws %zu)\n", n_in, out_size, ws_size); grid = -1; return; }
        if (hipGetDevice(&dev) != hipSuccess || hipDeviceGetAttribute(&cus, hipDeviceAttributeMultiprocessorCount, dev) != hipSuccess) { grid = -1; return; }
        if (hipFuncSetAttribute((const void*)mk_fwd, hipFuncAttributeMaxDynamicSharedMemorySize, LDS_BYTES) != hipSuccess) { fprintf(stderr, "kernel_launch: hipFuncSetAttribute failed\n"); grid = -1; return; }
        int per_cu = 0;
        if (hipOccupancyMaxActiveBlocksPerMultiprocessor(&per_cu, (const void*)mk_fwd, NWAVES * 64, LDS_BYTES) != hipSuccess || per_cu < 1) { fprintf(stderr, "kernel_launch: occupancy query says %d\n", per_cu); }
        (void)hipGetLastError();
        grid = cus;
    }
    if (grid < 0) return;
    (void)hipMemsetAsync((char*)d_ws + WS_CTL, 0, CTL_ZERO_BYTES, stream);
    Args a{};
    for (int i = 0; i < 32; ++i) a.in[i] = (const float*)d_in[i];
    a.out = (float*)d_out; a.ws = (unsigned char*)d_ws;
#if MK_PER_PHASE
    for (int p = 0; p < N_PHASES; ++p) { a.ph_lo = p; a.ph_hi = p + 1; hipLaunchKernelGGL(mk_fwd, dim3(grid), dim3(NWAVES * 64), LDS_BYTES, stream, a); }
#else
    a.ph_lo = 0; a.ph_hi = N_PHASES;
    void* kargs[] = {&a};
    hipError_t e = hipLaunchCooperativeKernel((const void*)mk_fwd, dim3(grid), dim3(NWAVES * 64), kargs, LDS_BYTES, stream);
    if (e != hipSuccess) fprintf(stderr, "cooperative launch failed: %s (grid %d)\n", hipGetErrorString(e), grid);
#endif
}
```

```cpp
#include <hip/hip_runtime.h>
#include <hip/hip_cooperative_groups.h>
#include <cstdio>
#include <cstdint>
namespace pg8 {
#define PG8_LAS __attribute__((address_space(3)))
typedef unsigned short bf16_t;
typedef short bf16x8 __attribute__((ext_vector_type(8)));
typedef float f32x4 __attribute__((ext_vector_type(4)));
typedef unsigned u32x4 __attribute__((ext_vector_type(4)));
constexpr int BM = 256, BK = 64, HALF = 128, HTB = HALF * BK * 2  , STAGE_BYTES = 8 * HTB, NXCD = 8, WGM = 8;

__host__ __device__ __forceinline__ int lds_byte(int r, int c) { const int st = (r >> 4) * 2 + (c >> 5), rr = r & 15, cc = c & 31, ob = rr * 64 + cc * 2; return st * 1024 + (ob ^ (((ob >> 9) & 1) << 5)); }
__host__ __device__ __forceinline__ void stage_rc(int b, int& R, int& C) { const int st = b / 1024, sb = b % 1024, swz = sb ^ (((sb >> 9) & 1) << 5); R = (st >> 1) * 16 + swz / 64; C = (st & 1) * 32 + (swz % 64) / 2; }
__host__ __device__ __forceinline__ int perm32(int rho) { const int n = rho >> 4, i = rho & 15; return 8 * (i >> 2) + 4 * n + (i & 3); }

struct Unit { int pm, pn; };
struct Gemm { const bf16_t* A; const bf16_t* Bt; int M, N, K; };

struct StaticOrder {
    int nM, nN, nwg, G, c;
    __host__ __device__ void init(int M, int N, int G_, int c_) { nM = M / BM; nN = N / BM; nwg = nM * nN; G = G_; c = c_; }
    __host__ __device__ bool next(int i, Unit& u) const {
        const long L = (long)i * G + c; if (L >= nwg) return false;
        int wgid = (int)L; { const int q = nwg / NXCD, r = nwg % NXCD, xcd = wgid % NXCD, off = wgid / NXCD; wgid = (xcd < r ? xcd * (q + 1) : r * (q + 1) + (xcd - r) * q) + off; }
        const int nig = WGM * nN, gid = wgid / nig, fm = gid * WGM, gsz = (nM - fm) < WGM ? (nM - fm) : WGM;
        u.pm = fm + ((wgid % nig) % gsz); u.pn = (wgid % nig) / gsz; return true;
    }
    __device__ __forceinline__ void a_ready(const Unit&) const {}
    __device__ __forceinline__ void done(const Unit&) const {}
};

__device__ __forceinline__ unsigned cvt_pk_bf16(float lo, float hi) { unsigned r; asm volatile("v_cvt_pk_bf16_f32 %0, %1, %2" : "=v"(r) : "v"(lo), "v"(hi)); return r; }
typedef float f32x2 __attribute__((ext_vector_type(2)));
__device__ __forceinline__ f32x2 gelu_pk(f32x2 v) {
    const f32x2 av = __builtin_elementwise_abs(v), d = av * 0.2316418882f + 1.0f;
    f32x2 t; t.x = __builtin_amdgcn_rcpf(d.x); t.y = __builtin_amdgcn_rcpf(d.y);
    f32x2 q = t * 0.5307027145f + (-0.7265760135f); q = q * t + 0.7107068705f; q = q * t + (-0.142248368f); q = q * t + 0.127414796f; q = q * t;
    const f32x2 s = (v * v) * (-0.72134752044f);
    f32x2 e; e.x = __builtin_amdgcn_exp2f(s.x); e.y = __builtin_amdgcn_exp2f(s.y);
    const f32x2 m = v * (q * e), r = v - m;
    f32x2 o; o.x = v.x < 0.f ? m.x : r.x; o.y = v.y < 0.f ? m.y : r.y; return o;
}

template <int ACT  > struct EpiBf16 {
    static constexpr bool PERM = true, AFTER_DRAIN = false; static_assert(ACT == 0 || ACT == 1, "EpiBf16: ACT is 0 (none) or 1 (gelu_pk)");
    bf16_t* O; int ldc; const float* bias; int split_cols; size_t split_stride; float scale0;
    __device__ __forceinline__ void operator()(const f32x4 (&acc)[2][2][4][2], const Unit& u, int wr, int wc, int fr, int fq) const {
        const int row0 = u.pm * BM + wr * 64 + fr; int colt = u.pn * BM; bf16_t* base = O;
        float sc = 1.f; if (split_cols) { const int t = colt / split_cols; base += (size_t)t * split_stride; colt -= t * split_cols; if (t == 0) sc = scale0; }
        const int col0 = colt + wc * 32 + 8 * fq, bcol0 = u.pn * BM + wc * 32 + 8 * fq;
        f32x4 bv[2][2];
#pragma unroll
        for (int bj = 0; bj < 2; ++bj)
#pragma unroll
            for (int n = 0; n < 2; ++n) bv[bj][n] = bias ? *(const f32x4*)(bias + bcol0 + bj * HALF + 4 * n) : (f32x4){0.f, 0.f, 0.f, 0.f};
#pragma unroll
        for (int ai = 0; ai < 2; ++ai)
#pragma unroll
            for (int m = 0; m < 4; ++m) { bf16_t* rowp = base + (size_t)(row0 + ai * HALF + m * 16) * ldc + col0;
#pragma unroll
                for (int bj = 0; bj < 2; ++bj) { f32x4 v0 = acc[ai][bj][m][0] + bv[bj][0], v1 = acc[ai][bj][m][1] + bv[bj][1];
                    if (ACT == 1) { f32x2 a = gelu_pk((f32x2){v0[0], v0[1]}), b = gelu_pk((f32x2){v0[2], v0[3]}), c = gelu_pk((f32x2){v1[0], v1[1]}), d = gelu_pk((f32x2){v1[2], v1[3]});
                        v0 = (f32x4){a.x, a.y, b.x, b.y}; v1 = (f32x4){c.x, c.y, d.x, d.y}; }
                    v0 = v0 * sc; v1 = v1 * sc; u32x4 w; w.x = cvt_pk_bf16(v0[0], v0[1]); w.y = cvt_pk_bf16(v0[2], v0[3]); w.z = cvt_pk_bf16(v1[0], v1[1]); w.w = cvt_pk_bf16(v1[2], v1[3]);
                    *(u32x4*)(rowp + bj * HALF) = w; } }
    }
};
struct EpiResidual {
    static constexpr bool PERM = false, AFTER_DRAIN = false;
    const float* base; float* out; int ldc;
    __device__ __forceinline__ void operator()(const f32x4 (&acc)[2][2][4][2], const Unit& u, int wr, int wc, int fr, int fq) const {
        const int col0 = u.pn * BM + wc * 32 + 4 * fq;
#pragma unroll
        for (int ai = 0; ai < 2; ++ai)
#pragma unroll
            for (int m = 0; m < 4; ++m) { const size_t off = (size_t)(u.pm * BM + ai * HALF + wr * 64 + m * 16 + fr) * ldc + col0;
#pragma unroll
                for (int bj = 0; bj < 2; ++bj)
#pragma unroll
                    for (int n = 0; n < 2; ++n) { const f32x4 bs = *(const f32x4*)(base + off + bj * HALF + n * 16); *(f32x4*)(out + off + bj * HALF + n * 16) = bs + acc[ai][bj][m][n]; }
                asm volatile("" ::: "memory"); }
    }
};
struct EpiSwiGLU {
    static constexpr bool PERM = true, AFTER_DRAIN = false;
    bf16_t* O; int ldc;
    __device__ __forceinline__ void operator()(const f32x4 (&acc)[2][2][4][2], const Unit& u, int wr, int wc, int fr, int fq) const {
        const int col0 = u.pn * HALF + wc * 32 + 8 * fq;
#pragma unroll
        for (int ai = 0; ai < 2; ++ai)
#pragma unroll
            for (int m = 0; m < 4; ++m) { bf16_t* rowp = O + (size_t)(u.pm * BM + ai * HALF + wr * 64 + m * 16 + fr) * ldc + col0;
                float r[8];
#pragma unroll
                for (int n = 0; n < 2; ++n)
#pragma unroll
                    for (int j = 0; j < 4; ++j) { const float g = acc[ai][0][m][n][j], up = acc[ai][1][m][n][j]; r[n * 4 + j] = g * __builtin_amdgcn_rcpf(1.f + __expf(-g)) * up; }
                u32x4 w; w.x = cvt_pk_bf16(r[0], r[1]); w.y = cvt_pk_bf16(r[2], r[3]); w.z = cvt_pk_bf16(r[4], r[5]); w.w = cvt_pk_bf16(r[6], r[7]);
                *(u32x4*)rowp = w; }
    }
};
template <class Epi, class Sched, bool ALIGN_EPI = false, bool SP2 = false>
__device__ __forceinline__ void gemm_phase(PG8_LAS unsigned char* lds, const Gemm g, const Sched& S, const Epi& E) {
    const int tid = threadIdx.x, wid = __builtin_amdgcn_readfirstlane(tid >> 6), lane = tid & 63, wr = wid >> 2, wc = wid & 3, fr = lane & 15, fq = lane >> 4;
    const int K = g.K, nt = K / BK;
    unsigned voffA[2], voffB[2];
#pragma unroll
    for (int i = 0; i < 2; ++i) { int R, C; stage_rc(tid * 16 + i * 8192, R, C); const int Rb = Epi::PERM ? ((R & ~31) + perm32(R & 31)) : R;
        voffA[i] = (unsigned)(R * K + C) * 2u; voffB[i] = (unsigned)(Rb * K + C) * 2u; }
    const size_t kstep = (size_t)(BK * 2);
    const size_t hstep = (size_t)HALF * K * 2;
    const size_t tstep = 2 * hstep;
    const unsigned ldsw = (unsigned)wid * 1024u;
    const int aoff = lds_byte(wr * 64 + fr, fq * 8), boff = lds_byte(wc * 32 + fr, fq * 8);
#define PG8_SA(b, h) (((b) * 2 + (h)) * HTB)
#define PG8_SB(b, h) ((4 + (b) * 2 + (h)) * HTB)
#define PG8_STAGE(bufoff, gbase, voff) do { _Pragma("unroll") for (int _i = 0; _i < 2; ++_i) \
        __builtin_amdgcn_global_load_lds((const unsigned*)((const char*)(gbase) + (voff)[_i]), (PG8_LAS unsigned*)(lds + (bufoff) + ldsw + _i * 8192), 16, 0, 0); } while (0)
#define PG8_LDA(dst, b, h) do { _Pragma("unroll") for (int m = 0; m < 4; ++m) _Pragma("unroll") for (int k = 0; k < 2; ++k) dst[m][k] = *(const PG8_LAS bf16x8*)(lds + PG8_SA(b, h) + aoff + m * 2048 + k * 1024); } while (0)
#define PG8_LDB(dst, b, h) do { _Pragma("unroll") for (int n = 0; n < 2; ++n) _Pragma("unroll") for (int k = 0; k < 2; ++k) dst[n][k] = *(const PG8_LAS bf16x8*)(lds + PG8_SB(b, h) + boff + n * 2048 + k * 1024); } while (0)
#define PG8_MMA(ai, bj, At, Bt) do { __builtin_amdgcn_s_setprio(1); _Pragma("unroll") for (int m = 0; m < 4; ++m) _Pragma("unroll") for (int n = 0; n < 2; ++n) _Pragma("unroll") for (int k = 0; k < 2; ++k) \
        acc[ai][bj][m][n] = __builtin_amdgcn_mfma_f32_16x16x32_bf16(Bt[n][k], At[m][k], acc[ai][bj][m][n], 0, 0, 0); __builtin_amdgcn_s_setprio(0); } while (0)
#define PG8_WAIT_V(n) asm volatile("s_waitcnt vmcnt(" #n ")" ::: "memory")
#define PG8_WAIT_L(n) asm volatile("s_waitcnt lgkmcnt(" #n ")" ::: "memory")
#define PG8_BAR __builtin_amdgcn_s_barrier()
#define PG8_SCHED __builtin_amdgcn_sched_barrier(0)
    Unit cur, nxt; int ui = 0;
    if (!S.next(0, cur)) return;
    f32x4 acc[2][2][4][2];
#pragma unroll
    for (int a = 0; a < 2; ++a)
#pragma unroll
        for (int b = 0; b < 2; ++b)
#pragma unroll
            for (int m = 0; m < 4; ++m)
#pragma unroll
                for (int n = 0; n < 2; ++n) acc[a][b][m][n] = (f32x4){0.f, 0.f, 0.f, 0.f};
    bf16x8 At[4][2], B0[2][2], B1[2][2];
    const char* cA = (const char*)g.A + (size_t)cur.pm * tstep; const char* cB = (const char*)g.Bt + (size_t)cur.pn * tstep;
    S.a_ready(cur);
    if constexpr (SP2) {
        PG8_STAGE(PG8_SB(0, 0), cB, voffB); PG8_STAGE(PG8_SB(0, 1), cB + hstep, voffB); PG8_STAGE(PG8_SA(0, 0), cA, voffA); PG8_STAGE(PG8_SA(0, 1), cA + hstep, voffA);
        if (wr == 1) PG8_BAR;
        PG8_WAIT_V(2); PG8_BAR;
        PG8_STAGE(PG8_SB(1, 0), cB + kstep, voffB); PG8_STAGE(PG8_SA(1, 0), cA + kstep, voffA); PG8_STAGE(PG8_SB(1, 1), cB + hstep + kstep, voffB);
        PG8_WAIT_V(6); PG8_BAR;
    } else {
        PG8_STAGE(PG8_SB(0, 0), cB, voffB); PG8_STAGE(PG8_SA(0, 0), cA, voffA); PG8_STAGE(PG8_SB(0, 1), cB + hstep, voffB); PG8_STAGE(PG8_SA(0, 1), cA + hstep, voffA);
        if (wr == 1) PG8_BAR;
        PG8_WAIT_V(4); PG8_BAR;
        PG8_STAGE(PG8_SB(1, 0), cB + kstep, voffB); PG8_STAGE(PG8_SA(1, 0), cA + kstep, voffA); PG8_STAGE(PG8_SB(1, 1), cB + hstep + kstep, voffB);
        PG8_WAIT_V(6); PG8_BAR;
    }
    for (;;) {
        const bool has_next = S.next(ui + 1, nxt);
        const char* nA = has_next ? (const char*)g.A + (size_t)nxt.pm * tstep : cA; const char* nB = has_next ? (const char*)g.Bt + (size_t)nxt.pn * tstep : cB;
        for (int t = 0; t < nt; t += 2) {
            const bool last = (t == nt - 2);
            const char* a1 = cA + (size_t)(t + 1) * kstep;
            const char* a2 = last ? nA : cA + (size_t)(t + 2) * kstep; const char* b2 = last ? nB : cB + (size_t)(t + 2) * kstep;
            const char* a3 = a2 + kstep; const char* b3 = b2 + kstep;
            if (last && has_next) S.a_ready(nxt);
            if constexpr (SP2) {
            PG8_LDB(B0, 0, 0); PG8_LDB(B1, 0, 1); PG8_SCHED; PG8_LDA(At, 0, 0); PG8_STAGE(PG8_SA(1, 1), a1 + hstep, voffA);
            PG8_WAIT_V(8); PG8_WAIT_L(0); PG8_BAR; PG8_MMA(0, 0, At, B0); PG8_MMA(0, 1, At, B1); PG8_BAR; PG8_SCHED;
            PG8_LDA(At, 0, 1); PG8_STAGE(PG8_SB(0, 0), b2, voffB); PG8_STAGE(PG8_SB(0, 1), b2 + hstep, voffB); PG8_STAGE(PG8_SA(0, 0), a2, voffA);
            PG8_WAIT_V(8); PG8_WAIT_L(0); PG8_BAR; PG8_MMA(1, 0, At, B0); PG8_MMA(1, 1, At, B1); PG8_BAR; PG8_SCHED;
            PG8_LDB(B0, 1, 0); PG8_LDB(B1, 1, 1); PG8_SCHED; PG8_LDA(At, 1, 0); PG8_STAGE(PG8_SA(0, 1), a2 + hstep, voffA);
            PG8_WAIT_V(8); PG8_WAIT_L(0); PG8_BAR; PG8_MMA(0, 0, At, B0); PG8_MMA(0, 1, At, B1); PG8_BAR; PG8_SCHED;
            PG8_LDA(At, 1, 1); PG8_STAGE(PG8_SB(1, 0), b3, voffB); PG8_STAGE(PG8_SB(1, 1), b3 + hstep, voffB); PG8_STAGE(PG8_SA(1, 0), a3, voffA);
            PG8_WAIT_V(8); PG8_WAIT_L(0); PG8_BAR; PG8_MMA(1, 0, At, B0); PG8_MMA(1, 1, At, B1); PG8_BAR; PG8_SCHED;
            } else {
            PG8_LDB(B0, 0, 0); PG8_SCHED; PG8_LDA(At, 0, 0); PG8_STAGE(PG8_SA(1, 1), a1 + hstep, voffA);
            PG8_WAIT_L(8); PG8_BAR; PG8_WAIT_L(0); PG8_MMA(0, 0, At, B0); PG8_BAR; PG8_SCHED;
            PG8_LDB(B1, 0, 1); PG8_STAGE(PG8_SB(0, 0), b2, voffB);
            PG8_BAR; PG8_WAIT_L(0); PG8_MMA(0, 1, At, B1); PG8_BAR;
            PG8_LDA(At, 0, 1); PG8_STAGE(PG8_SA(0, 0), a2, voffA);
            PG8_BAR; PG8_WAIT_L(0); PG8_MMA(1, 0, At, B0); PG8_BAR; PG8_SCHED;
            PG8_STAGE(PG8_SB(0, 1), b2 + hstep, voffB);
            PG8_WAIT_V(6); PG8_BAR; PG8_MMA(1, 1, At, B1); PG8_BAR;
            PG8_LDB(B0, 1, 0); PG8_SCHED; PG8_LDA(At, 1, 0); PG8_STAGE(PG8_SA(0, 1), a2 + hstep, voffA);
            PG8_WAIT_L(8); PG8_BAR; PG8_WAIT_L(0); PG8_MMA(0, 0, At, B0); PG8_BAR; PG8_SCHED;
            PG8_LDB(B1, 1, 1); PG8_STAGE(PG8_SB(1, 0), b3, voffB);
            PG8_BAR; PG8_WAIT_L(0); PG8_MMA(0, 1, At, B1); PG8_BAR;
            PG8_LDA(At, 1, 1); PG8_STAGE(PG8_SA(1, 0), a3, voffA);
            PG8_BAR; PG8_WAIT_L(0); PG8_MMA(1, 0, At, B0); PG8_BAR; PG8_SCHED;
            PG8_STAGE(PG8_SB(1, 1), b3 + hstep, voffB);
            PG8_WAIT_V(6); PG8_BAR; PG8_MMA(1, 1, At, B1); PG8_BAR;
            }
        }
        if constexpr (ALIGN_EPI) { if (wr == 0) PG8_BAR; }
        if constexpr (!Epi::AFTER_DRAIN) { E(acc, cur, wr, wc, fr, fq); S.done(cur); }
        if (!has_next) break;
#pragma unroll
        for (int a = 0; a < 2; ++a)
#pragma unroll
            for (int b = 0; b < 2; ++b)
#pragma unroll
                for (int m = 0; m < 4; ++m)
#pragma unroll
                    for (int n = 0; n < 2; ++n) acc[a][b][m][n] = (f32x4){0.f, 0.f, 0.f, 0.f};
        cur = nxt; cA = nA; cB = nB; ++ui;
        if constexpr (ALIGN_EPI) { if (wr == 1) PG8_BAR; }
    }
    PG8_WAIT_V(0);
    if constexpr (!ALIGN_EPI) { if (wr == 0) PG8_BAR; }
    PG8_BAR;
    if constexpr (Epi::AFTER_DRAIN) { E.fused(acc, cur, wr, wc, fr, fq, lds, wid, lane); S.done(cur); }
#undef PG8_SA
#undef PG8_SB
#undef PG8_STAGE
#undef PG8_LDA
#undef PG8_LDB
#undef PG8_MMA
#undef PG8_WAIT_V
#undef PG8_WAIT_L
#undef PG8_BAR
#undef PG8_SCHED
}
}

#ifndef PG8_SP2
#define PG8_SP2 true
#endif
#define PG8_ALIGN true
constexpr int NWAVES = 8;
constexpr int BATCH = 2, SEQ = 8192, DM = 1024, M = BATCH * SEQ, NIN = 3788, NINP = 3840, FFN = 2816, DEPTH = 2;
constexpr int A_Q = 0, A_K = 256, A_V = 512, A_O = 768;
constexpr int R_R = 1024, R_K = 1408, R_V = 1792, R_WDF = 2176, R_AD = 2304, R_GD = 2368;
constexpr int S_Z = 2496, S_X = 2880, S_B = 3264, S_C = 3520, S_DT = 3776;
constexpr size_t MiB = 1u << 20;
constexpr size_t WS_CTL = 0, CTL_ZERO_BYTES = 64 * 1024;
constexpr size_t WS_GATES = 1 * MiB, WS_CT = 2 * MiB;
constexpr size_t WS_WIN = 4 * MiB, WS_WOUT = 12 * MiB, WS_WGU = 14 * MiB, WS_WDN = 25 * MiB;
constexpr size_t WS_XN = 32 * MiB, WS_COLS = 64 * MiB, WS_Y = 184 * MiB, WS_END = 248 * MiB;
constexpr size_t Y_AF = WS_Y, Y_AB = WS_Y + 8 * MiB, Y_RF = WS_Y + 16 * MiB, Y_RB = WS_Y + 28 * MiB, Y_SF = WS_Y + 40 * MiB, Y_SB = WS_Y + 52 * MiB;
constexpr int CW_BAR = 1024;
constexpr int RING_BYTES = 131072;
constexpr int LDS_BYTES = 147456, MISC_OFF = LDS_BYTES - 256;

#define GAS __attribute__((address_space(1)))
#define LAS __attribute__((address_space(3)))
typedef unsigned short bf16;
typedef unsigned v4u __attribute__((ext_vector_type(4)));
typedef unsigned v2u __attribute__((ext_vector_type(2)));
typedef float f32x4 __attribute__((ext_vector_type(4)));
typedef short bf16x8 __attribute__((ext_vector_type(8)));
typedef GAS unsigned gu32;
#define RLX_AGENT __ATOMIC_RELAXED, __HIP_MEMORY_SCOPE_AGENT
#define LDS_WAIT() asm volatile("s_waitcnt lgkmcnt(0)" ::: "memory")
#define VM_WAIT() asm volatile("s_waitcnt vmcnt(0)" ::: "memory")
__device__ __forceinline__ unsigned f2bf(float f) { unsigned u = __builtin_bit_cast(unsigned, f); return (u + 0x7fffu + ((u >> 16) & 1u)) >> 16; }
__device__ __forceinline__ unsigned pk2(float lo, float hi) { return f2bf(lo) | (f2bf(hi) << 16); }
__device__ __forceinline__ float bf2f(unsigned u) { return __builtin_bit_cast(float, u << 16); }
__device__ __forceinline__ float sigmoidf_(float x) { return __builtin_amdgcn_rcpf(1.f + __expf(-x)); }
__device__ __forceinline__ float siluf_(float x) { return x * sigmoidf_(x); }
__device__ __forceinline__ float wave_sum(float v) {
#pragma unroll
    for (int o = 1; o < 64; o <<= 1) v += __shfl_xor(v, o);
    return v;
}
__device__ __forceinline__ float wave_max(float v) {
#pragma unroll
    for (int o = 1; o < 64; o <<= 1) v = fmaxf(v, __shfl_xor(v, o));
    return v;
}
template <int CTRL> __device__ __forceinline__ float dppf(float v) { return __builtin_bit_cast(float, __builtin_amdgcn_update_dpp(0, __builtin_bit_cast(int, v), CTRL, 0xf, 0xf, true)); }
__device__ __forceinline__ float row16_sum(float v) { v += dppf<0xB1>(v); v += dppf<0x4E>(v); v += dppf<0x141>(v); v += dppf<0x140>(v); return v; }
template <int K> __device__ __forceinline__ f32x4 mma16(const LAS bf16* A, int lda, const LAS bf16* Bt, int ldb, f32x4 acc, int lane) {
    const int r = lane & 15, q = lane >> 4;
    const LAS bf16* ap = A + r * lda + q * 8; const LAS bf16* bp = Bt + r * ldb + q * 8;
#pragma unroll
    for (int k0 = 0; k0 < K; k0 += 32) {
        const bf16x8 a = *(const LAS bf16x8*)(ap + k0); const bf16x8 b = *(const LAS bf16x8*)(bp + k0);
        acc = __builtin_amdgcn_mfma_f32_16x16x32_bf16(a, b, acc, 0, 0, 0);
    }
    return acc;
}
#define XB_TMO      128
#define XB_XCNT(j)  (256  + 64 * (j))
#define XB_XSUB(j)  (1280 + 64 * (j))
#define XB_XGEN(j)  (2304 + 64 * (j))
#define XB_TOP      3328
#define XB_TOPGEN   3392
#define XCD_BAR_WORDS 3456
#define XB_SPIN_CAP (1u << 18)

__device__ __forceinline__ unsigned xb_ld(unsigned* p)              { return __hip_atomic_load(p, __ATOMIC_RELAXED, __HIP_MEMORY_SCOPE_AGENT); }
__device__ __forceinline__ unsigned xb_add(unsigned* p, unsigned v) { return __hip_atomic_fetch_add(p, v, __ATOMIC_RELAXED, __HIP_MEMORY_SCOPE_AGENT); }
__device__ __forceinline__ unsigned xb_xcc_id() { return (unsigned)__builtin_amdgcn_s_getreg((3 << 11) | 20) & 0xFu; }
#define XB_SPIN(cond, bar) do { unsigned _sp = 0; while (cond) { __builtin_amdgcn_s_sleep(1); \
    if ((++_sp & 255u) == 0u) { if (xb_ld(&(bar)[XB_TMO])) break; if (_sp > XB_SPIN_CAP) { atomicAdd(&(bar)[XB_TMO], 1u); break; } } } } while (0)

struct XcdBarrier {
    unsigned* bar; unsigned x;
    volatile LAS unsigned* st;
};

__device__ __forceinline__ XcdBarrier xcd_barrier_post(unsigned* bar, volatile LAS unsigned* st) {
    XcdBarrier b; b.bar = bar; b.x = xb_xcc_id(); b.st = st;
    if (threadIdx.x == 0) (void)xb_add(&bar[XB_XCNT(b.x)], 1u);
    return b;
}
__device__ __forceinline__ void xcd_barrier_complete(unsigned* bar, unsigned x, unsigned& nloc, unsigned& nx) {
    const unsigned G = gridDim.x * gridDim.y * gridDim.z;
    unsigned sum, cnt, mine, sp = 0u;
    for (;;) {
        sum = 0u; cnt = 0u; mine = 0u;
#pragma unroll
        for (unsigned j = 0; j < 16; ++j) { const unsigned c = xb_ld(&bar[XB_XCNT(j)]); sum += c; cnt += (c > 0u) ? 1u : 0u; mine = (j == x) ? c : mine; }
        if (sum == G) break;
        __builtin_amdgcn_s_sleep(1);
        if ((++sp & 255u) == 0u) { if (xb_ld(&bar[XB_TMO])) break; if (sp > XB_SPIN_CAP) { atomicAdd(&bar[XB_TMO], 1u); break; } }
    }
    nloc = mine > 0u ? mine : 1u; nx = cnt > 0u ? cnt : 1u;
}

__device__ __forceinline__ void xcd_barrier(const XcdBarrier& b) {
    asm volatile("s_waitcnt vmcnt(0)" ::: "memory");
    __syncthreads();
    if (threadIdx.x == 0) {
        unsigned* bar = b.bar;
        __builtin_amdgcn_s_waitcnt(0);
        unsigned nloc = b.st[0], nx = b.st[1];
        if (nloc == 0u) { xcd_barrier_complete(bar, b.x, nloc, nx); b.st[0] = nloc; b.st[1] = nx; }
        const unsigned old = xb_add(&bar[XB_XSUB(b.x)], 1u);
        const unsigned gen = old / nloc;
        if (old + 1u == (gen + 1u) * nloc) {
            __builtin_amdgcn_fence(__ATOMIC_RELEASE, "agent");
            asm volatile("s_waitcnt vmcnt(0)" ::: "memory");
            const unsigned og = xb_add(&bar[XB_TOP], 1u);
            const unsigned tg = og / nx;
            if (og + 1u == (tg + 1u) * nx) xb_add(&bar[XB_TOPGEN], 1u);
            else XB_SPIN(xb_ld(&bar[XB_TOPGEN]) == tg, bar);
            __builtin_amdgcn_fence(__ATOMIC_ACQUIRE, "agent");
            xb_add(&bar[XB_XGEN(b.x)], 1u);
            asm volatile("s_waitcnt vmcnt(0)" ::: "memory");
        } else {
            XB_SPIN(xb_ld(&bar[XB_XGEN(b.x)]) == gen, bar);
            __builtin_amdgcn_fence(__ATOMIC_ACQUIRE, "agent");
            asm volatile("s_waitcnt vmcnt(0)" ::: "memory");
        }
    }
    __syncthreads();
}
struct Frame {
    LAS unsigned char* lds;
    int tid, lane, wave, vcu, G;
};
struct Args { const float* in[32]; float* out; unsigned char* ws; int ph_lo, ph_hi; };
constexpr int PTAB_OFF = LDS_BYTES - 768;
__device__ __forceinline__ unsigned long long ptab_ld(const Frame& F, int i) {
    const unsigned long long v = *(volatile LAS unsigned long long*)(F.lds + PTAB_OFF + 8 * i);
    const unsigned lo = __builtin_amdgcn_readfirstlane((unsigned)v), hi = __builtin_amdgcn_readfirstlane((unsigned)(v >> 32));
    return ((unsigned long long)hi << 32) | lo;
}
__device__ __forceinline__ const float* INP(const Frame& F, int i) { return (const float*)ptab_ld(F, i); }
__device__ __forceinline__ unsigned char* WSP(const Frame& F) { return (unsigned char*)ptab_ld(F, 33); }
__device__ __forceinline__ float* OUTP(const Frame& F) { return (float*)ptab_ld(F, 32); }

__device__ __forceinline__ void transpose_item(const float* W, int K, int N, int nblk, bf16* WT, int mode, int row_off, LAS float* scr, int item, int lane) {
    const int kb = item / nblk, nb = item % nblk, k0 = 64 * kb, n0 = 32 * nb;
    const int ncol = n0 + (lane & 31); const bool ok = ncol < N;
#pragma unroll 8
    for (int i = 0; i < 32; ++i) { const int kk = 2 * i + (lane >> 5); scr[kk * 33 + (lane & 31)] = ok ? W[(size_t)(k0 + kk) * N + ncol] : 0.f; }
    LDS_WAIT(); asm volatile("" ::: "memory");
    const int c = lane & 7;
    const int drow0 = mode ? (256 * (n0 >> 7) + (n0 & 127) + row_off) : (row_off + n0);
#pragma unroll
    for (int j = 0; j < 4; ++j) { const int n = (lane >> 3) + 8 * j; const LAS float* s = scr + (8 * c) * 33 + n;
        v4u o; o.x = pk2(s[0 * 33], s[1 * 33]); o.y = pk2(s[2 * 33], s[3 * 33]); o.z = pk2(s[4 * 33], s[5 * 33]); o.w = pk2(s[6 * 33], s[7 * 33]);
        *(v4u*)(WT + (size_t)(drow0 + n) * K + k0 + 8 * c) = o; }
    LDS_WAIT(); asm volatile("" ::: "memory");
}
__device__ __forceinline__ void phase_convert(const Frame& F, int l) {
    LAS float* scr = (LAS float*)(F.lds + F.wave * 16384);
    const int gw = F.vcu * NWAVES + F.wave, NGW = F.G * NWAVES;
    bf16* Win = (bf16*)(WSP(F) + WS_WIN); bf16* Wout = (bf16*)(WSP(F) + WS_WOUT); bf16* Wgu = (bf16*)(WSP(F) + WS_WGU); bf16* Wdn = (bf16*)(WSP(F) + WS_WDN);
    constexpr int I_IN = 16 * 120, I_OUT = 16 * 32, I_G = 16 * 88, I_D = 44 * 32;
    constexpr int NITEMS = I_IN + I_OUT + 2 * I_G + I_D;
    for (int it = gw; it < NITEMS; it += NGW) {
        int r = it;
        if (r < I_IN) { transpose_item(INP(F, 2) + (size_t)l * DM * NIN, DM, NIN, 120, Win, 0, 0, scr, r, F.lane); continue; } r -= I_IN;
        if (r < I_OUT) { transpose_item(INP(F, 26) + (size_t)l * DM * DM, DM, DM, 32, Wout, 0, 0, scr, r, F.lane); continue; } r -= I_OUT;
        if (r < I_G) { transpose_item(INP(F, 28) + (size_t)l * DM * FFN, DM, FFN, 88, Wgu, 1, 0, scr, r, F.lane); continue; } r -= I_G;
        if (r < I_G) { transpose_item(INP(F, 29) + (size_t)l * DM * FFN, DM, FFN, 88, Wgu, 1, 128, scr, r, F.lane); continue; } r -= I_G;
        transpose_item(INP(F, 30) + (size_t)l * FFN * DM, FFN, DM, 32, Wdn, 0, 0, scr, r, F.lane);
    }
}
__device__ __forceinline__ void phase_norm(const Frame& F, const float* hin, const float* g, bf16* XN) {
    const int gw = F.vcu * NWAVES + F.wave, NGW = F.G * NWAVES;
    f32x4 gv[4];
#pragma unroll
    for (int j = 0; j < 4; ++j) gv[j] = ((const f32x4*)g)[64 * j + F.lane];
    for (int m = gw; m < M; m += NGW) {
        const f32x4* xr = (const f32x4*)(hin + (size_t)m * DM) + F.lane;
        f32x4 v[4]; float s = 0.f;
#pragma unroll
        for (int j = 0; j < 4; ++j) { v[j] = xr[64 * j]; s += (v[j].x * v[j].x + v[j].y * v[j].y) + (v[j].z * v[j].z + v[j].w * v[j].w); }
        const float r = 1.f / sqrtf(wave_sum(s) * (1.f / DM) + 1e-6f);
        v2u* o8 = (v2u*)(XN + (size_t)m * DM) + F.lane;
#pragma unroll
        for (int j = 0; j < 4; ++j) { v2u w; w.x = pk2(v[j].x * r * gv[j].x, v[j].y * r * gv[j].y); w.y = pk2(v[j].z * r * gv[j].z, v[j].w * r * gv[j].w); o8[64 * j] = w; }
    }
}
__device__ __forceinline__ void phase_final_norm(const Frame& F, float* h, const float* g) {
    const int gw = F.vcu * NWAVES + F.wave, NGW = F.G * NWAVES;
    f32x4 gv[4];
#pragma unroll
    for (int j = 0; j < 4; ++j) gv[j] = ((const f32x4*)g)[64 * j + F.lane];
    for (int m = gw; m < M; m += NGW) {
        f32x4* xr = (f32x4*)(h + (size_t)m * DM) + F.lane;
        f32x4 v[4]; float s = 0.f;
#pragma unroll
        for (int j = 0; j < 4; ++j) { v[j] = xr[64 * j]; s += (v[j].x * v[j].x + v[j].y * v[j].y) + (v[j].z * v[j].z + v[j].w * v[j].w); }
        const float r = 1.f / sqrtf(wave_sum(s) * (1.f / DM) + 1e-6f);
#pragma unroll
        for (int j = 0; j < 4; ++j) xr[64 * j] = v[j] * r * gv[j];
    }
}
__device__ __forceinline__ void phase_gates(const Frame& F, int l) {
    const bf16* cols = (const bf16*)(WSP(F) + WS_COLS); float* GT = (float*)(WSP(F) + WS_GATES);
    LAS bf16* raw = (LAS bf16*)(F.lds);
    LAS float* feat = (LAS float*)(F.lds + 32768);
    LAS float* gw = (LAS float*)(F.lds + 81920);
    const float* gwg = INP(F, 5) + (size_t)l * 768 * 16; const float* gb = INP(F, 6) + l * 16;
    const float* cw = INP(F, 3) + (size_t)l * 5 * 512; const float* cb = INP(F, 4) + l * 512;
    for (int i = F.tid; i < 768 * 16; i += 512) gw[i] = gwg[i];
    for (int tile = F.vcu; tile < M / 16; tile += F.G) {
        const int m0 = tile * 16, t0 = m0 % SEQ;
        __syncthreads();
        for (int ch = F.tid; ch < 20 * 96; ch += 512) { const int rr = ch / 96, cc = ch % 96; const int t = t0 - 2 + rr;
            v4u v = {0u, 0u, 0u, 0u}; if (t >= 0 && t < SEQ) v = *(const v4u*)(cols + (size_t)(m0 - 2 + rr) * NINP + cc * 8);
            *(LAS v4u*)(raw + rr * 768 + cc * 8) = v; }
        __syncthreads();
        for (int idx = F.tid; idx < 16 * 768; idx += 512) { const int t = idx / 768, c = idx % 768; float val;
            if (c < 512) { float s = cb[c];
#pragma unroll
                for (int j = 0; j < 5; ++j) s += cw[j * 512 + c] * bf2f(raw[(t + j) * 768 + c]);
                val = siluf_(s); } else val = bf2f(raw[(t + 2) * 768 + c]);
            feat[idx] = val; }
        __syncthreads();
        { const int t = F.tid >> 5, o = (F.tid >> 1) & 15, hf = F.tid & 1; float s = 0.f;
          const LAS float* fp = feat + t * 768 + hf * 384; const LAS float* wp = gw + (hf * 384) * 16 + o;
#pragma unroll 8
          for (int i = 0; i < 384; ++i) s += fp[i] * wp[i * 16];
          s += __shfl_xor(s, 1);
          if (hf == 0) { s += gb[o]; if (o >= 8) s = fminf(s, 0.f) - log1pf(__expf(-fabsf(s))); GT[(size_t)(m0 + t) * 16 + o] = s; } }
    }
    __syncthreads();
}
__device__ __forceinline__ f32x4 mma16_a8(const LAS bf16* A8, const LAS bf16* Bt, f32x4 acc, int lane) {
    const int q = lane >> 4;
    const LAS bf16* ap = A8 + (lane & 7) * 72 + q * 8; const LAS bf16* bp = Bt + (lane & 15) * 72 + q * 8;
#pragma unroll
    for (int k0 = 0; k0 < 64; k0 += 32) { const bf16x8 a = *(const LAS bf16x8*)(ap + k0); const bf16x8 b = *(const LAS bf16x8*)(bp + k0); acc = __builtin_amdgcn_mfma_f32_16x16x32_bf16(a, b, acc, 0, 0, 0); }
    return acc;
}
typedef float f32x2 __attribute__((ext_vector_type(2)));
template <bool DIR> __device__ __forceinline__ void rwkv_steps(const LAS float* OPS, const LAS float* VV, LAS float* YB, f32x4& S, int j, int row) {
    float yk0 = 0.f, yk1 = 0.f;
    constexpr int ST = DIR ? -320 : 320, SV = DIR ? -16 : 16;
    const LAS float* op = OPS + 4 * j + (DIR ? 31 * 320 : 0); const LAS float* vp = VV + row + (DIR ? 31 * 16 : 0);
#define RWLD(W_, KK_, KA_, KM_, R_, V_, o_, v_) do { W_ = *(const LAS f32x4*)(o_); KK_ = *(const LAS f32x4*)((o_) + 64); KA_ = *(const LAS f32x4*)((o_) + 128); KM_ = *(const LAS f32x4*)((o_) + 192); R_ = *(const LAS f32x4*)((o_) + 256); V_ = *(v_); } while (0)
#define RWSTEP(W_, KK_, KA_, KM_, R_, V_, i_) do { f32x2 t2_ = S.xy * KK_.xy; t2_ = S.zw * KK_.zw + t2_; float sa_ = t2_.x + t2_.y; const f32x4 ps_ = S * W_ + KM_ * V_; sa_ = row16_sum(sa_); S = ps_ + KA_ * sa_; \
        f32x2 y2_ = S.xy * R_.xy; y2_ = S.zw * R_.zw + y2_; float y_ = y2_.x + y2_.y; y_ = row16_sum(y_); if (((i_) & 15) == j) { if ((i_) < 16) yk0 = y_; else yk1 = y_; } } while (0)
    f32x4 w4a, kk4a, ka4a, km4a, r4a, w4b, kk4b, ka4b, km4b, r4b; float vva, vvb;
    RWLD(w4a, kk4a, ka4a, km4a, r4a, vva, op, vp);
    RWLD(w4b, kk4b, ka4b, km4b, r4b, vvb, op + ST, vp + SV);
#pragma unroll 1
    for (int i = 0; i < 30; i += 2) {
        f32x4 nw, nkk, nka, nkm, nr; float nv;
        RWLD(nw, nkk, nka, nkm, nr, nv, op + 2 * ST, vp + 2 * SV);
        RWSTEP(w4a, kk4a, ka4a, km4a, r4a, vva, i);
        w4a = nw; kk4a = nkk; ka4a = nka; km4a = nkm; r4a = nr; vva = nv;
        RWLD(nw, nkk, nka, nkm, nr, nv, op + 3 * ST, vp + 3 * SV);
        RWSTEP(w4b, kk4b, ka4b, km4b, r4b, vvb, i + 1);
        w4b = nw; kk4b = nkk; ka4b = nka; km4b = nkm; r4b = nr; vvb = nv;
        op += 2 * ST; vp += 2 * SV;
    }
    RWSTEP(w4a, kk4a, ka4a, km4a, r4a, vva, 30);
    RWSTEP(w4b, kk4b, ka4b, km4b, r4b, vvb, 31);
#undef RWLD
#undef RWSTEP
    YB[(DIR ? 31 - j : j) * 16 + row] = yk0; YB[(DIR ? 15 - j : 16 + j) * 16 + row] = yk1;
}
struct RwCtx { LAS bf16* WA; LAS bf16* WW; LAS bf16* XA; LAS bf16* XW; LAS bf16* RAWB; LAS float* MU; float* CT; const bf16* colsb;
    f32x4 kk_c4, ka_c4, rk_c4; float ba[4], bw[4]; float mup_[5][2], mun_[5][2]; int h, dir, qtr, tb0; size_t mb; };
template <int NTOK> __device__ __forceinline__ void rw_addr_init(int (&poff)[5], int (&prr)[5], int lane, int tb0, int h, int dir) {
    constexpr int NCHK = (NTOK + 2) * 40;
#pragma unroll
    for (int i = 0; i < 5; ++i) { const int idx = lane + 64 * i; const int rr = idx / 40, q = idx % 40, wh = q >> 3, c8 = q & 7;
        const int gc = (wh == 0 ? R_R + h * 64 : wh == 1 ? R_K + h * 64 : wh == 2 ? R_V + h * 64 : wh == 3 ? R_WDF + dir * 64 : R_AD) + c8 * 8;
        prr[i] = idx < NCHK ? tb0 - 1 + rr : -100000; poff[i] = (tb0 - 1 + rr) * NINP + gc; }
}
template <int NTOK> __device__ __forceinline__ void rw_issue(v4u (&pre)[5], const int (&poff)[5], const int (&prr)[5], const bf16* colsb, int T0) {
    constexpr int NCH = ((NTOK + 2) * 40 + 63) / 64;
#pragma unroll
    for (int i = 0; i < NCH; ++i) { pre[i] = (v4u){0u, 0u, 0u, 0u}; const int t = T0 + prr[i]; if (t >= 0 && t < SEQ) pre[i] = *(const v4u*)(colsb + (size_t)T0 * NINP + poff[i]); }
}
template <int NTOK, bool FULLV> __device__ __forceinline__ void rw_prep(const RwCtx& C, const v4u (&pre)[5], LAS float* OPS, LAS float* VV, int T0, int lane) {
    constexpr int NCHK = (NTOK + 2) * 40, NCH = (NCHK + 63) / 64;
    const int j = lane & 15, c2 = (lane & 31) * 2;
#pragma unroll
    for (int i = 0; i < NCH; ++i) { const int idx = lane + 64 * i; if (idx < NCHK) *(LAS v4u*)(C.RAWB + idx * 8) = pre[i]; }
    LDS_WAIT(); asm volatile("" ::: "memory");
#pragma unroll
    for (int which = 0; which < 5; ++which)
#pragma unroll
        for (int pr = 0; pr < NTOK / 2; ++pr) { const int tt = 2 * pr + (lane >> 5), cc = which * 64 + c2, t = C.tb0 + tt;
            const unsigned r0 = *(const LAS unsigned*)(C.RAWB + tt * 320 + cc), r1 = *(const LAS unsigned*)(C.RAWB + (tt + 1) * 320 + cc), r2 = *(const LAS unsigned*)(C.RAWB + (tt + 2) * 320 + cc);
            const float p1x = bf2f(r1 & 0xffffu), p1y = bf2f(r1 >> 16);
            const float vx = p1x + C.mup_[which][0] * (bf2f(r0 & 0xffffu) - p1x) + C.mun_[which][0] * (bf2f(r2 & 0xffffu) - p1x);
            const float vy = p1y + C.mup_[which][1] * (bf2f(r0 >> 16) - p1y) + C.mun_[which][1] * (bf2f(r2 >> 16) - p1y);
            if (which == 0) *(LAS f32x2*)(OPS + t * 320 + 256 + c2) = (f32x2){vx, vy};
            else if (which == 1) *(LAS f32x2*)(OPS + t * 320 + 192 + c2) = (f32x2){vx, vy};
            else if (which == 2) { if (FULLV) *(LAS f32x2*)(VV + t * 64 + c2) = (f32x2){vx, vy}; else if ((c2 >> 4) == C.qtr) *(LAS f32x2*)(VV + t * 16 + (c2 & 15)) = (f32x2){vx, vy}; }
            else if (which == 3) { const float ex = __expf(2.f * vx), ey = __expf(2.f * vy);
                *(LAS unsigned*)(C.XW + tt * 72 + c2) = pk2(1.f - 2.f * __builtin_amdgcn_rcpf(ex + 1.f), 1.f - 2.f * __builtin_amdgcn_rcpf(ey + 1.f)); }
            else *(LAS unsigned*)(C.XA + tt * 72 + c2) = pk2(vx, vy); }
    LDS_WAIT(); asm volatile("" ::: "memory");
    { const bool hi = lane >= 32; const int lr = ((lane >> 4) & 1) * 4 + (hi ? 2 : 0); const bool ok0 = lr < NTOK, ok1 = lr + 1 < NTOK; const int tb = C.tb0 + lr;
#pragma unroll
      for (int ct = 0; ct < 4; ++ct) { const f32x4 z = {0.f, 0.f, 0.f, 0.f};
        const f32x4 ca = mma16_a8(C.XA, C.WA + ct * 16 * 72, z, lane), cw = mma16_a8(C.XW, C.WW + ct * 16 * 72, z, lane);
        const int c = ct * 16 + j;
        const float a0v = hi ? ca[2] : ca[0], a1v = hi ? ca[3] : ca[1], w0v = hi ? cw[2] : cw[0], w1v = hi ? cw[3] : cw[1];
        if (ok0) { OPS[tb * 320 + 128 + c] = sigmoidf_(C.ba[ct] + a0v); OPS[tb * 320 + c] = __expf(-0.6065306597f * sigmoidf_(C.bw[ct] + w0v)); }
        if (ok1) { OPS[(tb + 1) * 320 + 128 + c] = sigmoidf_(C.ba[ct] + a1v); OPS[(tb + 1) * 320 + c] = __expf(-0.6065306597f * sigmoidf_(C.bw[ct] + w1v)); } } }
    LDS_WAIT(); asm volatile("" ::: "memory");
#pragma unroll
    for (int ps = 0; ps < (NTOK + 3) / 4; ++ps) { const int tl = 4 * ps + (lane >> 4); const bool ok = tl < NTOK; const int t = C.tb0 + (ok ? tl : 0); LAS float* op = OPS + t * 320 + 4 * j;
        const f32x4 av = *(const LAS f32x4*)(op + 128), kp = *(const LAS f32x4*)(op + 192), rp = *(const LAS f32x4*)(op + 256);
        const f32x4 kr = kp * C.kk_c4; const float ss = row16_sum((kr.x * kr.x + kr.y * kr.y) + (kr.z * kr.z + kr.w * kr.w));
        const f32x4 kkv = kr * (1.f / fmaxf(sqrtf(ss), 1e-12f));
        const f32x4 km = kp * ((av - 1.f) * C.ka_c4 + 1.f);
        const f32x4 q = rp * km * C.rk_c4; const float cs = row16_sum((q.x + q.y) + (q.z + q.w));
        if (ok) { *(LAS f32x4*)(op + 64) = kkv; *(LAS f32x4*)(op + 128) = kkv * (-av); *(LAS f32x4*)(op + 192) = km;
            if (C.dir == 0 && C.qtr == 0 && j == 0) C.CT[(C.mb + T0 + t) * 8 + C.h] = cs; } }
}

constexpr int RW_NSLOT = 6, RW_SLOT_WORDS = 32 * 320 + 32 * 64;
constexpr size_t WS_RING = 248 * MiB;
constexpr int CW_RW = 8192;
__device__ __forceinline__ unsigned rw_ld(unsigned* p) { return __hip_atomic_load(p, __ATOMIC_RELAXED, __HIP_MEMORY_SCOPE_AGENT); }
__device__ __forceinline__ void rw_st(unsigned* p, unsigned v) { __hip_atomic_store(p, v, __ATOMIC_RELAXED, __HIP_MEMORY_SCOPE_AGENT); }
__device__ __forceinline__ void rwkv_produce(const Frame& F, int l, int p) {
    const int b = p / 12, rem = p % 12, h = rem >> 1, dir = rem & 1;
    const bf16* cols = (const bf16*)(WSP(F) + WS_COLS);
    const int tid = F.tid, lane = F.lane, wave = F.wave;
    LAS bf16* WA = (LAS bf16*)(F.lds); LAS bf16* WW = (LAS bf16*)(F.lds + 9216);
    LAS float* MU = (LAS float*)(F.lds + 67584);
    LAS float* OPS = (LAS float*)(F.lds + 70144);
    LAS float* VV = (LAS float*)(F.lds + 111104);
    LAS unsigned* flg = (LAS unsigned*)(F.lds + 119296);
    unsigned* ctl = (unsigned*)(WSP(F) + WS_CTL) + CW_RW + 320 * p;
    unsigned long long* ring = (unsigned long long*)(WSP(F) + WS_RING) + (size_t)p * RW_NSLOT * (RW_SLOT_WORDS / 2);
    constexpr int NB = SEQ / 32;
    __syncthreads();
    { const float* aup = INP(F, 13) + (size_t)l * 64 * 384; const float* wup = INP(F, 11) + (size_t)(l * 2 + dir) * 64 * 384;
      for (int idx = tid; idx < 4096; idx += 512) { const int i = idx >> 6, c = idx & 63;
          WA[c * 72 + i] = (bf16)f2bf(aup[i * 384 + h * 64 + c]); WW[c * 72 + i] = (bf16)f2bf(wup[i * 384 + h * 64 + c]); }
      if (tid < 320) { const int which = tid >> 6, c = tid & 63;
          const int rc = which == 0 ? h * 64 + c : which == 1 ? 384 + h * 64 + c : which == 2 ? 768 + h * 64 + c : which == 3 ? 1152 + dir * 64 + c : 1280 + c;
          MU[tid] = INP(F, 8)[l * 1472 + rc]; MU[320 + tid] = INP(F, 9)[l * 1472 + rc]; } }
    __syncthreads();
    const size_t mb = (size_t)b * SEQ;
    const int j = lane & 15;
    RwCtx C;
    C.WA = WA; C.WW = WW; C.XA = (LAS bf16*)(F.lds + 18432) + wave * 576; C.XW = (LAS bf16*)(F.lds + 27648) + wave * 576;
    C.RAWB = (LAS bf16*)(F.lds + 36864) + wave * 1920;
    C.MU = MU; C.CT = (float*)(WSP(F) + WS_CT); C.colsb = cols + mb * NINP; C.h = h; C.dir = dir; C.qtr = 0; C.mb = mb; C.tb0 = 4 * wave;
    { const int hc4 = h * 64 + 4 * j;
      C.kk_c4 = *(const f32x4*)(INP(F, 15) + l * 384 + hc4); C.ka_c4 = *(const f32x4*)(INP(F, 16) + l * 384 + hc4); C.rk_c4 = *(const f32x4*)(INP(F, 17) + l * 384 + hc4);
#pragma unroll
      for (int ct = 0; ct < 4; ++ct) { C.ba[ct] = INP(F, 12)[l * 384 + h * 64 + 16 * ct + j]; C.bw[ct] = INP(F, 10)[(l * 2 + dir) * 384 + h * 64 + 16 * ct + j]; }
      const int c2 = (lane & 31) * 2;
#pragma unroll
      for (int wq = 0; wq < 5; ++wq) { C.mup_[wq][0] = MU[wq * 64 + c2]; C.mup_[wq][1] = MU[wq * 64 + c2 + 1]; C.mun_[wq][0] = MU[320 + wq * 64 + c2]; C.mun_[wq][1] = MU[320 + wq * 64 + c2 + 1]; } }
    v4u pre[5]; int poff[5], prr[5];
    rw_addr_init<4>(poff, prr, lane, C.tb0, h, dir);
    rw_issue<4>(pre, poff, prr, C.colsb, dir ? SEQ - 32 : 0);
    const unsigned G0 = (unsigned)l * NB;
    bool dead = false; unsigned mseen = G0;
#pragma unroll 1
    for (int it = 0; it < NB; ++it) {
        const int T0 = dir ? SEQ - 32 * (it + 1) : 32 * it;
        v4u cur[5];
#pragma unroll
        for (int i = 0; i < 5; ++i) cur[i] = pre[i];
        if (it + 1 < NB) rw_issue<4>(pre, poff, prr, C.colsb, dir ? SEQ - 32 * (it + 2) : 32 * (it + 1));
        rw_prep<4, true>(C, cur, OPS, VV, T0, lane);
        if (tid == 0) { const unsigned need = G0 + (unsigned)it + 1u; unsigned sp = 0u;
            if (need > (unsigned)RW_NSLOT && !dead) { const unsigned want = need - (unsigned)RW_NSLOT;
                while (mseen < want) { if (++sp > (1u << 17)) { dead = true; break; } __builtin_amdgcn_s_sleep(2);
                    const unsigned m01 = min(rw_ld(ctl + 64), rw_ld(ctl + 128)), m23 = min(rw_ld(ctl + 192), rw_ld(ctl + 256)); mseen = min(m01, m23); } }
            flg[0] = sp; }
        __syncthreads();
        { unsigned long long* slot = ring + (size_t)((G0 + (unsigned)it) % RW_NSLOT) * (RW_SLOT_WORDS / 2);
          const LAS v4u* src = (const LAS v4u*)OPS;
#pragma unroll
          for (int i = 0; i < 6; ++i) { const int idx = tid + 512 * i; const v4u d = src[idx]; v4u* dst = (v4u*)slot + idx;
              asm volatile("global_store_dwordx4 %0, %1, off sc1\n\ts_nop 1" :: "v"(dst), "v"(d) : "memory"); } }
        asm volatile("s_waitcnt vmcnt(6)" ::: "memory");
        __syncthreads();
        if (tid == 0 && it >= 1) rw_st(ctl, G0 + (unsigned)it);
    }
    asm volatile("s_waitcnt vmcnt(0)" ::: "memory");
    __syncthreads();
    if (tid == 0) rw_st(ctl, G0 + (unsigned)NB);
    __syncthreads();
}
__device__ __forceinline__ void rwkv_scan(const Frame& F, int l, int p, int qtr) {
    const int b = p / 12, rem = p % 12, h = rem >> 1, dir = rem & 1;
    bf16* Y = (bf16*)(WSP(F) + (dir ? Y_RB : Y_RF));
    const int lane = F.lane, wave = F.wave;
    LAS float* OPSb = (LAS float*)(F.lds);
    LAS float* VVb = (LAS float*)(F.lds + 81920);
    LAS float* YBb = (LAS float*)(F.lds + 86016);
    unsigned* ctl = (unsigned*)(WSP(F) + WS_CTL) + CW_RW + 320 * p;
    const unsigned long long* ring = (const unsigned long long*)(WSP(F) + WS_RING) + (size_t)p * RW_NSLOT * (RW_SLOT_WORDS / 2);
    constexpr int NB = SEQ / 32;
    const size_t mb = (size_t)b * SEQ;
    const int j = lane & 15;
    const unsigned G0 = (unsigned)l * NB;
    __syncthreads();
    if (wave < 4) {
        const int lt = wave * 64 + lane;
        bool dead = false; unsigned pseen = G0;
#pragma unroll 1
        for (int it = 0; it <= NB; ++it) {
            if (it >= 1 && lt == 0) rw_st(ctl + 64 * (qtr + 1), G0 + (unsigned)it);
            if (it < NB) {
                const unsigned need = G0 + (unsigned)it + 1u; unsigned sp = 0u;
                if (!dead) { while (pseen < need) { pseen = rw_ld(ctl); if (pseen >= need) break; if (++sp > (1u << 17)) { dead = true; break; } __builtin_amdgcn_s_sleep(2); } }
                const unsigned long long* slot = ring + (size_t)((G0 + (unsigned)it) % RW_NSLOT) * (RW_SLOT_WORDS / 2);
                LAS unsigned long long* dO = (LAS unsigned long long*)(OPSb + (it & 1) * 10240); LAS unsigned long long* dV = (LAS unsigned long long*)(VVb + (it & 1) * 512);
                unsigned long long v[21];
#pragma unroll
                for (int i = 0; i < 20; ++i) v[i] = __hip_atomic_load(slot + lt + 256 * i, __ATOMIC_RELAXED, __HIP_MEMORY_SCOPE_AGENT);
                v[20] = __hip_atomic_load(slot + 5120 + (lt >> 3) * 32 + qtr * 8 + (lt & 7), __ATOMIC_RELAXED, __HIP_MEMORY_SCOPE_AGENT);
#pragma unroll
                for (int i = 0; i < 20; ++i) dO[lt + 256 * i] = v[i];
                dV[lt] = v[20];
            }
            if (it >= 2) { const int bk = it - 2; const int T0 = dir ? SEQ - 32 * (bk + 1) : 32 * bk; const LAS float* YB = YBb + (bk & 1) * 512;
                const int idx = lt * 2, tl = idx >> 4, rw = idx & 15;
                *(unsigned*)(Y + (mb + T0 + tl) * 384 + h * 64 + 16 * qtr + rw) = pk2(YB[idx], YB[idx + 1]); }
            __syncthreads();
        }
        { const int bk = NB - 1; const int T0 = dir ? SEQ - 32 * (bk + 1) : 32 * bk; const LAS float* YB = YBb + (bk & 1) * 512;
          const int idx = lt * 2, tl = idx >> 4, rw = idx & 15;
          *(unsigned*)(Y + (mb + T0 + tl) * 384 + h * 64 + 16 * qtr + rw) = pk2(YB[idx], YB[idx + 1]); }
    } else {
        const int row = (wave - 4) * 4 + (lane >> 4);
        f32x4 S = {0.f, 0.f, 0.f, 0.f};
#pragma unroll 1
        for (int it = 0; it <= NB; ++it) {
            if (it >= 1) { const int bk = it - 1;
                const LAS float* OPS = OPSb + (bk & 1) * 10240; const LAS float* VV = VVb + (bk & 1) * 512; LAS float* YB = YBb + (bk & 1) * 512;
                if (dir) rwkv_steps<true>(OPS, VV, YB, S, j, row); else rwkv_steps<false>(OPS, VV, YB, S, j, row);
            }
            __syncthreads();
        }
    }
    __syncthreads();
}
__device__ __forceinline__ float row8_sum(float v) { v += dppf<0xB1>(v); v += dppf<0x4E>(v); v += dppf<0x141>(v); return v; }
__device__ __forceinline__ void mlstm_seq(const Frame& F, int l, int task, int cfull0, int cend) {
    const int b = task >> 3, h = (task >> 1) & 3, dir = task & 1;
    const bf16* cols = (const bf16*)(WSP(F) + WS_COLS); const float* GT = (const float*)(WSP(F) + WS_GATES);
    bf16* Y = (bf16*)(WSP(F) + (dir ? Y_AB : Y_AF));
    LAS bf16* RAWQ = (LAS bf16*)(F.lds);
    LAS bf16* Qs = (LAS bf16*)(F.lds + 17408); LAS bf16* Ks = (LAS bf16*)(F.lds + 26624);
    LAS bf16* Vtb = (LAS bf16*)(F.lds + 35840);
    LAS bf16* KWt = (LAS bf16*)(F.lds + 54272); LAS bf16* Ps = (LAS bf16*)(F.lds + 63488);
    LAS bf16* Ctb = (LAS bf16*)(F.lds + 72704);
    LAS float* ub = (LAS float*)(F.lds + 91136);
    LAS float* blb = ub + 128; LAS float* rmb = ub + 256;
    LAS float* den = ub + 384; LAS float* qn = ub + 448; LAS float* nst = ub + 512; LAS float* scb = ub + 576;
    const int tid = F.tid, lane = F.lane, wave = F.wave;
    const size_t mb = (size_t)b * SEQ;
    constexpr int NC = SEQ / 64;
    __syncthreads();
    for (int i = tid; i < 2 * 64 * 72; i += 512) Ctb[i] = 0;
    if (tid < 64) nst[tid] = 0.f;
    const int cc = tid & 127, isK = cc >> 6, d0 = cc & 63, chn = isK * 256 + h * 64 + d0;
    float cw[5]; const float* cwp = INP(F, 3) + (size_t)l * 5 * 512;
#pragma unroll
    for (int jj = 0; jj < 5; ++jj) cw[jj] = cwp[jj * 512 + chn];
    const float cbv = INP(F, 4)[l * 512 + chn];
    f32x4 st[2] = {{0.f, 0.f, 0.f, 0.f}, {0.f, 0.f, 0.f, 0.f}};
    float m_st = 0.f;
    v4u pre[3], prev; float gli = 0.f, glf = 0.f;
#define ML_ISSUE(c_) do { const int tlo_ = dir ? SEQ - 64 * ((c_) + 1) : 64 * (c_); _Pragma("unroll") for (int i_ = 0; i_ < 3; ++i_) { const int ch_ = tid + 512 * i_; pre[i_] = (v4u){0u, 0u, 0u, 0u}; \
        if (ch_ < 68 * 16) { const int rr_ = ch_ >> 4, q_ = ch_ & 15; const int t_ = tlo_ - 2 + rr_; if (t_ >= 0 && t_ < SEQ) pre[i_] = *(const v4u*)(cols + (mb + t_) * NINP + (q_ >> 3) * 256 + h * 64 + (q_ & 7) * 8); } } \
        prev = *(const v4u*)(cols + (mb + tlo_ + (tid >> 3)) * NINP + A_V + h * 64 + (tid & 7) * 8); \
        if (tid < 64) { const int t_ = dir ? tlo_ + 63 - tid : tlo_ + tid; gli = GT[(mb + t_) * 16 + dir * 4 + h]; glf = GT[(mb + t_) * 16 + 8 + dir * 4 + h]; } } while (0)
#define ML_FILL(c_) do { _Pragma("unroll") for (int i_ = 0; i_ < 3; ++i_) { const int ch_ = tid + 512 * i_; if (ch_ < 68 * 16) *(LAS v4u*)(RAWQ + (ch_ >> 4) * 128 + (ch_ & 15) * 8) = pre[i_]; } \
        { LAS bf16* Vt_ = Vtb + ((c_) & 1) * 4608; const int tl_ = tid >> 3, e8_ = tid & 7; const int lp_ = dir ? 63 - tl_ : tl_; const unsigned w_[4] = {prev.x, prev.y, prev.z, prev.w}; \
          _Pragma("unroll") for (int k_ = 0; k_ < 4; ++k_) { Vt_[(e8_ * 8 + 2 * k_) * 72 + lp_] = (bf16)(w_[k_] & 0xffffu); Vt_[(e8_ * 8 + 2 * k_ + 1) * 72 + lp_] = (bf16)(w_[k_] >> 16); } } \
        if (tid < 64) { float bl_ = glf; _Pragma("unroll") for (int o_ = 1; o_ < 64; o_ <<= 1) { const float x_ = __shfl_up(bl_, o_); if (lane >= o_) bl_ += x_; } \
            const float u_ = gli - bl_; float rm_ = u_; _Pragma("unroll") for (int o_ = 1; o_ < 64; o_ <<= 1) { const float x_ = __shfl_up(rm_, o_); if (lane >= o_) rm_ = fmaxf(rm_, x_); } \
            ub[((c_) & 1) * 64 + tid] = u_; blb[((c_) & 1) * 64 + tid] = bl_; rmb[((c_) & 1) * 64 + tid] = rm_; if (tid == 63) { scb[((c_) & 1) * 2] = rm_; scb[((c_) & 1) * 2 + 1] = bl_; } } } while (0)
    ML_ISSUE(0); ML_FILL(0); ML_ISSUE(1);
    __syncthreads();
#pragma unroll 1
    for (int c = 0; c < cend; ++c) {
        const bool full = c >= cfull0;
        const int tlo = dir ? SEQ - 64 * (c + 1) : 64 * c;
        const LAS float* u = ub + (c & 1) * 64; const LAS float* bl = blb + (c & 1) * 64; const LAS float* rm = rmb + (c & 1) * 64;
        const LAS bf16* Vt = Vtb + (c & 1) * 4608; const LAS bf16* Ct = Ctb + (c & 1) * 4608; LAS bf16* Ctn = Ctb + ((c + 1) & 1) * 4608;
#pragma unroll 4
        for (int i = 0; i < 16; ++i) { const int tl = (tid >> 7) + 4 * i; float s = cbv;
#pragma unroll
            for (int jj = 0; jj < 5; ++jj) s += cw[jj] * bf2f(RAWQ[(tl + jj) * 128 + cc]);
            s = siluf_(s); const int lpos = dir ? 63 - tl : tl;
            if (isK) Ks[lpos * 72 + d0] = (bf16)f2bf(s * 0.125f); else Qs[lpos * 72 + d0] = (bf16)f2bf(s); }
        if (tid < 64) den[tid] = 0.f;
        __syncthreads();
        const float umax = scb[(c & 1) * 2], tot = scb[(c & 1) * 2 + 1];
        for (int idx = tid; idx < 4096; idx += 512) { const int lp = idx >> 6, d = idx & 63; KWt[d * 72 + lp] = (bf16)f2bf(bf2f(Ks[lp * 72 + d]) * __expf(u[lp] - umax)); }
        if (full) {
#pragma unroll
        for (int k = 0; k < 2; ++k) { const int ti = 2 * wave + k, tl_ = ti >> 2, ts = ti & 3; f32x4 acc = {0.f, 0.f, 0.f, 0.f};
            if (ts <= tl_) acc = mma16<64>(Qs + tl_ * 16 * 72, 72, Ks + ts * 16 * 72, 72, acc, lane);
#pragma unroll
            for (int jj = 0; jj < 4; ++jj) { const int lr = tl_ * 16 + (lane >> 4) * 4 + jj, s = ts * 16 + (lane & 15);
                const float v = (s <= lr) ? acc[jj] * __expf(u[s] - fmaxf(m_st, rm[lr])) : 0.f; const unsigned vb = f2bf(v); Ps[lr * 72 + s] = (bf16)vb;
                if (ts <= tl_) { const float rs = row16_sum(bf2f(vb)); if ((lane & 15) == 0) __hip_atomic_fetch_add(den + lr, rs, __ATOMIC_RELAXED, __HIP_MEMORY_SCOPE_WORKGROUP); } } }
        { const int lq = tid >> 3, part = tid & 7; float s = 0.f;
#pragma unroll
          for (int k = 0; k < 8; ++k) s += bf2f(Qs[lq * 72 + part * 8 + k]) * nst[part * 8 + k];
          s = row8_sum(s); if (part == 0) qn[lq] = s; }
        }
        __syncthreads();
        const float mmax = fmaxf(m_st, umax), s_old = __expf(m_st - mmax), s_new = __expf(umax - mmax);
#pragma unroll
        for (int k = 0; k < 2; ++k) { const int ti = 2 * wave + k, t0_ = ti >> 2, t1_ = ti & 3; const f32x4 z = {0.f, 0.f, 0.f, 0.f};
            f32x4 a1 = z, a2 = z;
            if (full) { a1 = mma16<64>(Ps + t0_ * 16 * 72, 72, Vt + t1_ * 16 * 72, 72, z, lane); a2 = mma16<64>(Qs + t0_ * 16 * 72, 72, Ct + t1_ * 16 * 72, 72, z, lane); }
            const f32x4 lc = mma16<64>(Vt + t0_ * 16 * 72, 72, KWt + t1_ * 16 * 72, 72, z, lane);
#pragma unroll
            for (int jj = 0; jj < 4; ++jj) { const int r_ = t0_ * 16 + (lane >> 4) * 4 + jj, c_ = t1_ * 16 + (lane & 15);
                if (full) { const float mx = fmaxf(m_st, rm[r_]), iwv = __expf(m_st - mx);
                const float dn = den[r_] + iwv * qn[r_];
                const float val = (a1[jj] + iwv * a2[jj]) / fmaxf(fabsf(dn), __expf(-(bl[r_] + mx)));
                const int t = dir ? tlo + 63 - r_ : tlo + r_;
                Y[(mb + t) * 256 + h * 64 + c_] = (bf16)f2bf(val); }
                st[k][jj] = s_old * st[k][jj] + s_new * lc[jj];
                Ctn[r_ * 72 + c_] = (bf16)f2bf(st[k][jj]); } }
        { const int dq = tid >> 3, part = tid & 7; float s = 0.f;
#pragma unroll
          for (int k = 0; k < 8; ++k) s += bf2f(KWt[dq * 72 + part * 8 + k]);
          s = row8_sum(s); if (part == 0) nst[dq] = s_old * nst[dq] + s_new * s; }
        m_st = tot + mmax;
        if (c + 1 < cend) { ML_FILL(c + 1); if (c + 2 < cend) ML_ISSUE(c + 2); }
        __syncthreads();
    }
#undef ML_ISSUE
#undef ML_FILL
}
__device__ __forceinline__ void phase_ssd_conv(const Frame& F, int l) {
    const bf16* cols = (const bf16*)(WSP(F) + WS_COLS); bf16* XBC = (bf16*)(WSP(F) + WS_XN);
    LAS bf16* raw = (LAS bf16*)(F.lds);
    const float* cwp = INP(F, 20) + (size_t)l * 5 * 896; const float* cbp = INP(F, 21) + l * 896;
    const int tid = F.tid;
    float cw0[5], cw1[5]; const int c1 = tid + 512 < 896 ? tid + 512 : tid;
#pragma unroll
    for (int jj = 0; jj < 5; ++jj) { cw0[jj] = cwp[jj * 896 + tid]; cw1[jj] = cwp[jj * 896 + c1]; }
    const float cb0 = cbp[tid], cb1 = cbp[c1];
    for (int tile = F.vcu; tile < M / 32; tile += F.G) {
        const int m0 = tile * 32, t0 = m0 % SEQ;
        __syncthreads();
        for (int ch = tid; ch < 36 * 112; ch += 512) { const int rr = ch / 112, cc = ch % 112; const int t = t0 - 2 + rr;
            v4u v = {0u, 0u, 0u, 0u}; if (t >= 0 && t < SEQ) v = *(const v4u*)(cols + (size_t)(m0 - 2 + rr) * NINP + S_X + cc * 8);
            *(LAS v4u*)(raw + rr * 896 + cc * 8) = v; }
        __syncthreads();
#pragma unroll
        for (int half = 0; half < 2; ++half) { const int c = half ? c1 : tid; if (half && tid + 512 >= 896) break;
            float win[5];
#pragma unroll
            for (int jj = 0; jj < 4; ++jj) win[jj] = bf2f(raw[jj * 896 + c]);
            for (int tl = 0; tl < 32; ++tl) { win[4] = bf2f(raw[(tl + 4) * 896 + c]);
                float s = half ? cb1 : cb0;
#pragma unroll
                for (int jj = 0; jj < 5; ++jj) s += (half ? cw1[jj] : cw0[jj]) * win[jj];
#pragma unroll
                for (int jj = 0; jj < 4; ++jj) win[jj] = win[jj + 1];
                XBC[(size_t)(m0 + tl) * 896 + c] = (bf16)f2bf(siluf_(s)); } }
    }
    __syncthreads();
}
__device__ __forceinline__ void ssd_seq(const Frame& F, int l, int task, int cfull0, int cend) {
    const int b = task / 12, rem = task % 12, head = rem >> 1, dir = rem & 1, g = head / 3;
    const bf16* cols = (const bf16*)(WSP(F) + WS_COLS); const bf16* XBC = (const bf16*)(WSP(F) + WS_XN);
    bf16* Y = (bf16*)(WSP(F) + (dir ? Y_SB : Y_SF));
    LAS bf16* Cm = (LAS bf16*)(F.lds); LAS bf16* Bm = (LAS bf16*)(F.lds + 17408);
    LAS bf16* Btw = (LAS bf16*)(F.lds + 34816); LAS bf16* Xt = (LAS bf16*)(F.lds + 53248);
    LAS bf16* Ps = (LAS bf16*)(F.lds + 62464); LAS bf16* Hs = (LAS bf16*)(F.lds + 71680);
    LAS float* dtvb = (LAS float*)(F.lds + 89088);
    LAS float* acsb = dtvb + 128;
    LAS float* totb = dtvb + 256;
    const int tid = F.tid, lane = F.lane, wave = F.wave;
    const size_t mb = (size_t)b * SEQ;
    constexpr int NC = SEQ / 64;
    __syncthreads();
    for (int i = tid; i < 64 * 136; i += 512) Hs[i] = 0;
    const float dtb = INP(F, 22)[(l * 2 + dir) * 6 + head];
    const float aneg = -__expf(INP(F, 23)[(l * 2 + dir) * 6 + head]);
    f32x4 st[4];
#pragma unroll
    for (int k = 0; k < 4; ++k) st[k] = (f32x4){0.f, 0.f, 0.f, 0.f};
    v4u pre[5]; float dtraw = 0.f;
#define SSD_ISSUE(c_) do { const int tlo_ = dir ? SEQ - 64 * ((c_) + 1) : 64 * (c_); _Pragma("unroll") for (int i_ = 0; i_ < 5; ++i_) { const int idx_ = tid + 512 * i_; const int tl_ = idx_ / 40, q_ = idx_ % 40; \
        const int gc_ = q_ < 8 ? head * 64 + q_ * 8 : (q_ < 24 ? 384 + g * 128 + (q_ - 8) * 8 : 640 + g * 128 + (q_ - 24) * 8); \
        pre[i_] = *(const v4u*)(XBC + (mb + tlo_ + tl_) * 896 + gc_); } } while (0)
#define SSD_DTLOAD(c_) do { if (tid < 64) { const int tlo_ = dir ? SEQ - 64 * ((c_) + 1) : 64 * (c_); const int t_ = dir ? tlo_ + 63 - tid : tlo_ + tid; dtraw = bf2f(cols[(mb + t_) * NINP + S_DT + dir * 6 + head]); } } while (0)
#define SSD_DTCALC(c_) do { if (tid < 64) { const float x_ = dtraw + dtb; const float dt_ = x_ > 20.f ? x_ : log1pf(__expf(x_)); float cs_ = dt_ * aneg; \
        _Pragma("unroll") for (int o_ = 1; o_ < 64; o_ <<= 1) { const float u_ = __shfl_up(cs_, o_); if (lane >= o_) cs_ += u_; } \
        const float tt_ = __shfl(cs_, 63); dtvb[((c_) & 1) * 64 + tid] = dt_; acsb[((c_) & 1) * 64 + tid] = cs_; if (tid == 0) totb[(c_) & 1] = tt_; } } while (0)
    SSD_ISSUE(0); SSD_DTLOAD(0); SSD_DTCALC(0); SSD_DTLOAD(1);
    __syncthreads();
#pragma unroll 1
    for (int c = 0; c < cend; ++c) {
        const bool full = c >= cfull0;
        const int tlo = dir ? SEQ - 64 * (c + 1) : 64 * c;
        const LAS float* dtv = dtvb + (c & 1) * 64; const LAS float* acs = acsb + (c & 1) * 64; const float tot = totb[c & 1];
#pragma unroll
        for (int i = 0; i < 5; ++i) { const int idx = tid + 512 * i; const int tl = idx / 40, q = idx % 40; const int lp = dir ? 63 - tl : tl;
            const unsigned w[4] = {pre[i].x, pre[i].y, pre[i].z, pre[i].w};
            if (q < 8) {
#pragma unroll
                for (int k = 0; k < 4; ++k) { Xt[(q * 8 + 2 * k) * 72 + lp] = (bf16)(w[k] & 0xffffu); Xt[(q * 8 + 2 * k + 1) * 72 + lp] = (bf16)(w[k] >> 16); } }
            else if (q < 24) { const int n0 = (q - 8) * 8; if (full) *(LAS v4u*)(Bm + lp * 136 + n0) = pre[i]; const float sc = dtv[lp] * __expf(tot - acs[lp]);
#pragma unroll
                for (int k = 0; k < 4; ++k) { Btw[(n0 + 2 * k) * 72 + lp] = (bf16)f2bf(bf2f(w[k] & 0xffffu) * sc); Btw[(n0 + 2 * k + 1) * 72 + lp] = (bf16)f2bf(bf2f(w[k] >> 16) * sc); } }
            else if (full) { const int n0 = (q - 24) * 8; *(LAS v4u*)(Cm + lp * 136 + n0) = pre[i]; } }
        if (c + 1 < cend) SSD_ISSUE(c + 1);
        __syncthreads();
        f32x4 yo[2] = {{0.f, 0.f, 0.f, 0.f}, {0.f, 0.f, 0.f, 0.f}}, lc[4];
        if (full) {
#pragma unroll
        for (int k = 0; k < 2; ++k) { const int ti = 2 * wave + k, tl_ = ti >> 2, ts = ti & 3; f32x4 acc = {0.f, 0.f, 0.f, 0.f};
            if (ts <= tl_) acc = mma16<128>(Cm + tl_ * 16 * 136, 136, Bm + ts * 16 * 136, 136, acc, lane);
#pragma unroll
            for (int jj = 0; jj < 4; ++jj) { const int lr = tl_ * 16 + (lane >> 4) * 4 + jj, s = ts * 16 + (lane & 15);
                const float v = (s <= lr) ? acc[jj] * __expf(acs[lr] - acs[s]) * dtv[s] : 0.f; Ps[lr * 72 + s] = (bf16)f2bf(v); }
            const f32x4 z = {0.f, 0.f, 0.f, 0.f};
            yo[k] = mma16<128>(Cm + tl_ * 16 * 136, 136, Hs + ts * 16 * 136, 136, z, lane); }
        }
#pragma unroll
        for (int k = 0; k < 4; ++k) { const int ti = 4 * wave + k, tp = ti >> 3, tn = ti & 7; const f32x4 z = {0.f, 0.f, 0.f, 0.f};
            lc[k] = mma16<64>(Xt + tp * 16 * 72, 72, Btw + tn * 16 * 72, 72, z, lane); }
        __syncthreads();
        const float cdec = __expf(tot);
        if (full) {
#pragma unroll
        for (int k = 0; k < 2; ++k) { const int ti = 2 * wave + k, tl_ = ti >> 2, tp = ti & 3; const f32x4 z = {0.f, 0.f, 0.f, 0.f};
            const f32x4 yd = mma16<64>(Ps + tl_ * 16 * 72, 72, Xt + tp * 16 * 72, 72, z, lane);
#pragma unroll
            for (int jj = 0; jj < 4; ++jj) { const int lr = tl_ * 16 + (lane >> 4) * 4 + jj, p = tp * 16 + (lane & 15);
                const float val = yd[jj] + yo[k][jj] * __expf(acs[lr]);
                const int t = dir ? tlo + 63 - lr : tlo + lr;
                Y[(mb + t) * 384 + head * 64 + p] = (bf16)f2bf(val); } }
        }
#pragma unroll
        for (int k = 0; k < 4; ++k) { const int ti = 4 * wave + k, tp = ti >> 3, tn = ti & 7;
#pragma unroll
            for (int jj = 0; jj < 4; ++jj) { const int p = tp * 16 + (lane >> 4) * 4 + jj, n = tn * 16 + (lane & 15);
                st[k][jj] = cdec * st[k][jj] + lc[k][jj]; Hs[p * 136 + n] = (bf16)f2bf(st[k][jj]); } }
        if (c + 1 < cend) { SSD_DTCALC(c + 1); if (c + 2 < cend) SSD_DTLOAD(c + 2); }
        __syncthreads();
    }
#undef SSD_ISSUE
#undef SSD_DTLOAD
#undef SSD_DTCALC
}
__device__ __forceinline__ void phase_post(const Frame& F, int l) {
    const bf16* cols = (const bf16*)(WSP(F) + WS_COLS); bf16* MIX = (bf16*)(WSP(F) + WS_XN);
    const bf16* YAf = (const bf16*)(WSP(F) + Y_AF); const bf16* YAb = (const bf16*)(WSP(F) + Y_AB);
    const bf16* YRf = (const bf16*)(WSP(F) + Y_RF); const bf16* YRb = (const bf16*)(WSP(F) + Y_RB);
    const bf16* YSf = (const bf16*)(WSP(F) + Y_SF); const bf16* YSb = (const bf16*)(WSP(F) + Y_SB);
    const float* CT = (const float*)(WSP(F) + WS_CT);
    LAS float* sg = (LAS float*)(F.lds);
    LAS float* gate = (LAS float*)(F.lds + 8192);
    const int tid = F.tid, lane = F.lane, wave = F.wave;
    const float* mup = INP(F, 8) + l * 1472; const float* mun = INP(F, 9) + l * 1472;
    const float* gup = INP(F, 14) + (size_t)l * 128 * 384;
    const float* mng = INP(F, 7) + l * 256; const float* rng = INP(F, 18) + l * 384; const float* rnb = INP(F, 19) + l * 384;
    const float* scb = INP(F, 21) + l * 896; const float* scw = INP(F, 20) + (size_t)l * 5 * 896; const float* sdk = INP(F, 24) + l * 6; const float* sng = INP(F, 25) + l * 384;
    for (int tile = F.vcu; tile < M / 16; tile += F.G) {
        const int m0 = tile * 16;
        __syncthreads();
        for (int idx = tid; idx < 16 * 128; idx += 512) { const int tt = idx >> 7, i = idx & 127; const int m = m0 + tt, t = m % SEQ;
            const float p1 = bf2f(cols[(size_t)m * NINP + R_GD + i]);
            const float p0 = t > 0 ? bf2f(cols[(size_t)(m - 1) * NINP + R_GD + i]) : 0.f;
            const float p2 = t < SEQ - 1 ? bf2f(cols[(size_t)(m + 1) * NINP + R_GD + i]) : 0.f;
            sg[idx] = sigmoidf_(p1 + mup[1344 + i] * (p0 - p1) + mun[1344 + i] * (p2 - p1)); }
        __syncthreads();
        if (tid < 384) { float acc[16];
#pragma unroll
            for (int tt = 0; tt < 16; ++tt) acc[tt] = 0.f;
            for (int i = 0; i < 128; ++i) { const float w = gup[i * 384 + tid];
#pragma unroll
                for (int tt = 0; tt < 16; ++tt) acc[tt] += sg[tt * 128 + i] * w; }
#pragma unroll
            for (int tt = 0; tt < 16; ++tt) gate[tt * 384 + tid] = acc[tt]; }
        __syncthreads();
#pragma unroll 1
        for (int k = 0; k < 2; ++k) { const int tt = wave * 2 + k; const int m = m0 + tt, t = m % SEQ; const size_t cr = (size_t)m * NINP;
#pragma unroll
            for (int i = 0; i < 4; ++i) { const int col = i * 64 + lane;
                const float hs = bf2f(YAf[(size_t)m * 256 + col]) + bf2f(YAb[(size_t)m * 256 + col]);
                const float mean = wave_sum(hs) * (1.f / 64.f); const float d = hs - mean; const float var = wave_sum(d * d) * (1.f / 64.f);
                const float y = d * (1.f / sqrtf(var + 1e-6f)) * mng[col];
                MIX[(size_t)m * DM + col] = (bf16)f2bf(y * sigmoidf_(bf2f(cols[cr + A_O + col]))); }
#pragma unroll
            for (int i = 0; i < 6; ++i) { const int col = i * 64 + lane;
                const float ys = bf2f(YRf[(size_t)m * 384 + col]) + bf2f(YRb[(size_t)m * 384 + col]);
                const float mean = wave_sum(ys) * (1.f / 64.f); const float d = ys - mean; const float var = wave_sum(d * d) * (1.f / 64.f);
                const float y = d * (1.f / sqrtf(var + 64e-5f)) * rng[col] + rnb[col];
                const float p1 = bf2f(cols[cr + R_V + col]);
                const float p0 = t > 0 ? bf2f(cols[cr - NINP + R_V + col]) : 0.f;
                const float p2 = t < SEQ - 1 ? bf2f(cols[cr + NINP + R_V + col]) : 0.f;
                const float vv = p1 + mup[768 + col] * (p0 - p1) + mun[768 + col] * (p2 - p1);
                const float bonus = CT[(size_t)m * 8 + i] * vv;
                MIX[(size_t)m * DM + 256 + col] = (bf16)f2bf((y + bonus) * gate[tt * 384 + col]); }
            float yv[6]; float ssq[2] = {0.f, 0.f};
#pragma unroll
            for (int i = 0; i < 6; ++i) { const int col = i * 64 + lane;
                float s = scb[col];
#pragma unroll
                for (int jj = 0; jj < 5; ++jj) { const int tq = t + jj - 2; if (tq >= 0 && tq < SEQ) s += scw[jj * 896 + col] * bf2f(cols[cr + (jj - 2) * NINP + S_X + col]); }
                const float xc = siluf_(s);
                float y = bf2f(YSf[(size_t)m * 384 + col]) + bf2f(YSb[(size_t)m * 384 + col]) + sdk[i] * xc;
                y *= siluf_(bf2f(cols[cr + S_Z + col]));
                yv[i] = y; ssq[i / 3] += y * y; }
            const float r0 = 1.f / sqrtf(wave_sum(ssq[0]) * (1.f / 192.f) + 1e-6f), r1 = 1.f / sqrtf(wave_sum(ssq[1]) * (1.f / 192.f) + 1e-6f);
#pragma unroll
            for (int i = 0; i < 6; ++i) { const int col = i * 64 + lane;
                MIX[(size_t)m * DM + 640 + col] = (bf16)f2bf(yv[i] * (i < 3 ? r0 : r1) * sng[col]); }
        }
    }
    __syncthreads();
}
namespace cg = cooperative_groups;
constexpr int N_PHASES = 9 * DEPTH + 1;
__global__ void __launch_bounds__(NWAVES * 64, 2) mk_fwd(Args args) {
    extern __shared__ __attribute__((aligned(16))) unsigned char lds_raw[];
    Frame F;
    F.lds = (LAS unsigned char*)lds_raw;
    F.tid = threadIdx.x; F.lane = F.tid & 63; F.wave = __builtin_amdgcn_readfirstlane(F.tid >> 6);
    F.G = gridDim.x; { const int bx = blockIdx.x; F.vcu = (F.G % 8 == 0) ? (bx % 8) * (F.G / 8) + bx / 8 : bx; }
    volatile LAS unsigned* MISC = (volatile LAS unsigned*)(F.lds + MISC_OFF);
    if (F.tid < 64) MISC[F.tid] = 0u;
    if (F.tid < 34) *(LAS unsigned long long*)(F.lds + PTAB_OFF + 8 * F.tid) = ((const unsigned long long*)__builtin_amdgcn_kernarg_segment_ptr())[F.tid];
    __syncthreads();
    unsigned* ctl = (unsigned*)(WSP(F) + WS_CTL);
    XcdBarrier bar = xcd_barrier_post(ctl + CW_BAR, MISC + 8);
    const int lo = args.ph_lo, hi = args.ph_hi;
#define IN_(k) (lo <= (k) && (k) < hi)
#define SEAM(k) do { if (IN_(k) && IN_((k) + 1)) { if ((k) == 0) cg::this_grid().sync(); else xcd_barrier(bar); } } while (0)
#define LAYER(l, B) \
    if (IN_(B + 0)) { phase_convert(F, l); phase_norm(F, l == 0 ? INP(F, 0) : OUTP(F), INP(F, 1) + l * DM, (bf16*)(WSP(F) + WS_XN)); } SEAM(B + 0); \
    if (IN_(B + 1)) { unsigned char* ws = WSP(F); pg8::Gemm g{(const bf16*)(ws + WS_XN), (const bf16*)(ws + WS_WIN), M, NINP, DM}; pg8::StaticOrder S; S.init(M, NINP, F.G, (int)blockIdx.x); \
            pg8::EpiBf16<0> E{(bf16*)(ws + WS_COLS), NINP, nullptr, 0, 0, 1.f}; \
            pg8::gemm_phase<pg8::EpiBf16<0>, pg8::StaticOrder, PG8_ALIGN, PG8_SP2>(F.lds, g, S, E); } SEAM(B + 1); \
    if (IN_(B + 2)) { phase_gates(F, l); phase_ssd_conv(F, l); } SEAM(B + 2); \
    if (IN_(B + 3)) { const int bx = blockIdx.x; \
            if (bx < 96) { const int c8 = bx & 7, k8 = bx >> 3; rwkv_scan(F, l, c8 + 8 * (k8 >> 2), k8 & 3); } else if (bx < 120) rwkv_produce(F, l, bx - 96); else if (bx < 216) { const int u = bx - 120, sg = 3 - (u / 24); ssd_seq(F, l, u % 24, 32 * sg, 32 * sg + 32); } else if (bx < 248) { const int u = bx - 216, sg = 1 - (u / 16); mlstm_seq(F, l, u % 16, 64 * sg, 64 * sg + 64); } } SEAM(B + 3); \
    if (IN_(B + 4)) phase_post(F, l); SEAM(B + 4); \
    if (IN_(B + 5)) { unsigned char* ws = WSP(F); pg8::Gemm g{(const bf16*)(ws + WS_XN), (const bf16*)(ws + WS_WOUT), M, DM, DM}; pg8::StaticOrder S; S.init(M, DM, F.G, (int)blockIdx.x); \
            pg8::EpiResidual E{l == 0 ? INP(F, 0) : OUTP(F), OUTP(F), DM}; \
            pg8::gemm_phase<pg8::EpiResidual, pg8::StaticOrder, PG8_ALIGN, PG8_SP2>(F.lds, g, S, E); } SEAM(B + 5); \
    if (IN_(B + 6)) phase_norm(F, OUTP(F), INP(F, 27) + l * DM, (bf16*)(WSP(F) + WS_XN)); SEAM(B + 6); \
    if (IN_(B + 7)) { unsigned char* ws = WSP(F); pg8::Gemm g{(const bf16*)(ws + WS_XN), (const bf16*)(ws + WS_WGU), M, 2 * FFN, DM}; pg8::StaticOrder S; S.init(M, 2 * FFN, F.G, (int)blockIdx.x); \
            pg8::EpiSwiGLU E{(bf16*)(ws + WS_COLS), FFN}; \
            pg8::gemm_phase<pg8::EpiSwiGLU, pg8::StaticOrder, PG8_ALIGN, PG8_SP2>(F.lds, g, S, E); } SEAM(B + 7); \
    if (IN_(B + 8)) { unsigned char* ws = WSP(F); pg8::Gemm g{(const bf16*)(ws + WS_COLS), (const bf16*)(ws + WS_WDN), M, DM, FFN}; pg8::StaticOrder S; S.init(M, DM, F.G, (int)blockIdx.x); \
            pg8::EpiResidual E{OUTP(F), OUTP(F), DM}; \
            pg8::gemm_phase<pg8::EpiResidual, pg8::StaticOrder, PG8_ALIGN, PG8_SP2>(F.lds, g, S, E); } SEAM(B + 8);
    LAYER(0, 0)
    LAYER(1, 9)
    if (IN_(18)) phase_final_norm(F, OUTP(F), INP(F, 31));
#undef IN_
#undef SEAM
#undef LAYER
}

#ifndef MK_PER_PHASE
#define MK_PER_PHASE 0
#endif
extern "C" void kernel_launch(void* const* d_in, const int* in_sizes, int n_in, void* d_out, int out_size, void* d_ws, size_t ws_size, hipStream_t stream) {
    static int grid = 0;
    if (grid == 0) {
        int dev = 0, cus = 0;
        if (n_in != 32 || out_size != M * DM || ws_size < WS_END) { fprintf(stderr, "kernel_launch: unexpected shapes (n_in %d out %d ws %zu)\n", n_in, out_size, ws_size); grid = -1; return; }
        if (hipGetDevice(&dev) != hipSuccess || hipDeviceGetAttribute(&cus, hipDeviceAttributeMultiprocessorCount, dev) != hipSuccess) { grid = -1; return; }
        if (hipFuncSetAttribute((const void*)mk_fwd, hipFuncAttributeMaxDynamicSharedMemorySize, LDS_BYTES) != hipSuccess) { fprintf(stderr, "kernel_launch: hipFuncSetAttribute failed\n"); grid = -1; return; }
        int per_cu = 0;
        if (hipOccupancyMaxActiveBlocksPerMultiprocessor(&per_cu, (const void*)mk_fwd, NWAVES * 64, LDS_BYTES) != hipSuccess || per_cu < 1) { fprintf(stderr, "kernel_launch: occupancy query says %d\n", per_cu); }
        (void)hipGetLastError();
        grid = cus;
    }
    if (grid < 0) return;
    (void)hipMemsetAsync((char*)d_ws + WS_CTL, 0, CTL_ZERO_BYTES, stream);
    Args a{};
    for (int i = 0; i < 32; ++i) a.in[i] = (const float*)d_in[i];
    a.out = (float*)d_out; a.ws = (unsigned char*)d_ws;
#if MK_PER_PHASE
    for (int p = 0; p < N_PHASES; ++p) { a.ph_lo = p; a.ph_hi = p + 1; hipLaunchKernelGGL(mk_fwd, dim3(grid), dim3(NWAVES * 64), LDS_BYTES, stream, a); }
#else
    a.ph_lo = 0; a.ph_hi = N_PHASES;
    void* kargs[] = {&a};
    hipError_t e = hipLaunchCooperativeKernel((const void*)mk_fwd, dim3(grid), dim3(NWAVES * 64), kargs, LDS_BYTES, stream);
    if (e != hipSuccess) fprintf(stderr, "cooperative launch failed: %s (grid %d)\n", hipGetErrorString(e), grid);
#endif
}
```

```cpp
#include <hip/hip_runtime.h>
#include <hip/hip_cooperative_groups.h>
#include <cstdio>
#include <cstdint>
namespace pg8 {
#define PG8_LAS __attribute__((address_space(3)))
typedef unsigned short bf16_t;
typedef short bf16x8 __attribute__((ext_vector_type(8)));
typedef float f32x4 __attribute__((ext_vector_type(4)));
typedef unsigned u32x4 __attribute__((ext_vector_type(4)));
constexpr int BM = 256, BK = 64, HALF = 128, HTB = HALF * BK * 2  , STAGE_BYTES = 8 * HTB, NXCD = 8, WGM = 8;

__host__ __device__ __forceinline__ int lds_byte(int r, int c) { const int st = (r >> 4) * 2 + (c >> 5), rr = r & 15, cc = c & 31, ob = rr * 64 + cc * 2; return st * 1024 + (ob ^ (((ob >> 9) & 1) << 5)); }
__host__ __device__ __forceinline__ void stage_rc(int b, int& R, int& C) { const int st = b / 1024, sb = b % 1024, swz = sb ^ (((sb >> 9) & 1) << 5); R = (st >> 1) * 16 + swz / 64; C = (st & 1) * 32 + (swz % 64) / 2; }
__host__ __device__ __forceinline__ int perm32(int rho) { const int n = rho >> 4, i = rho & 15; return 8 * (i >> 2) + 4 * n + (i & 3); }

struct Unit { int pm, pn; };
struct Gemm { const bf16_t* A; const bf16_t* Bt; int M, N, K; };

struct StaticOrder {
    int nM, nN, nwg, G, c;
    __host__ __device__ void init(int M, int N, int G_, int c_) { nM = M / BM; nN = N / BM; nwg = nM * nN; G = G_; c = c_; }
    __host__ __device__ bool next(int i, Unit& u) const {
        const long L = (long)i * G + c; if (L >= nwg) return false;
        int wgid = (int)L; { const int q = nwg / NXCD, r = nwg % NXCD, xcd = wgid % NXCD, off = wgid / NXCD; wgid = (xcd < r ? xcd * (q + 1) : r * (q + 1) + (xcd - r) * q) + off; }
        const int nig = WGM * nN, gid = wgid / nig, fm = gid * WGM, gsz = (nM - fm) < WGM ? (nM - fm) : WGM;
        u.pm = fm + ((wgid % nig) % gsz); u.pn = (wgid % nig) / gsz; return true;
    }
    __device__ __forceinline__ void a_ready(const Unit&) const {}
    __device__ __forceinline__ void done(const Unit&) const {}
};

__device__ __forceinline__ unsigned cvt_pk_bf16(float lo, float hi) { unsigned r; asm volatile("v_cvt_pk_bf16_f32 %0, %1, %2" : "=v"(r) : "v"(lo), "v"(hi)); return r; }
typedef float f32x2 __attribute__((ext_vector_type(2)));
__device__ __forceinline__ f32x2 gelu_pk(f32x2 v) {
    const f32x2 av = __builtin_elementwise_abs(v), d = av * 0.2316418882f + 1.0f;
    f32x2 t; t.x = __builtin_amdgcn_rcpf(d.x); t.y = __builtin_amdgcn_rcpf(d.y);
    f32x2 q = t * 0.5307027145f + (-0.7265760135f); q = q * t + 0.7107068705f; q = q * t + (-0.142248368f); q = q * t + 0.127414796f; q = q * t;
    const f32x2 s = (v * v) * (-0.72134752044f);
    f32x2 e; e.x = __builtin_amdgcn_exp2f(s.x); e.y = __builtin_amdgcn_exp2f(s.y);
    const f32x2 m = v * (q * e), r = v - m;
    f32x2 o; o.x = v.x < 0.f ? m.x : r.x; o.y = v.y < 0.f ? m.y : r.y; return o;
}

template <int ACT  > struct EpiBf16 {
    static constexpr bool PERM = true, AFTER_DRAIN = false; static_assert(ACT == 0 || ACT == 1, "EpiBf16: ACT is 0 (none) or 1 (gelu_pk)");
    bf16_t* O; int ldc; const float* bias; int split_cols; size_t split_stride; float scale0;
    __device__ __forceinline__ void operator()(const f32x4 (&acc)[2][2][4][2], const Unit& u, int wr, int wc, int fr, int fq) const {
        const int row0 = u.pm * BM + wr * 64 + fr; int colt = u.pn * BM; bf16_t* base = O;
        float sc = 1.f; if (split_cols) { const int t = colt / split_cols; base += (size_t)t * split_stride; colt -= t * split_cols; if (t == 0) sc = scale0; }
        const int col0 = colt + wc * 32 + 8 * fq, bcol0 = u.pn * BM + wc * 32 + 8 * fq;
        f32x4 bv[2][2];
#pragma unroll
        for (int bj = 0; bj < 2; ++bj)
#pragma unroll
            for (int n = 0; n < 2; ++n) bv[bj][n] = bias ? *(const f32x4*)(bias + bcol0 + bj * HALF + 4 * n) : (f32x4){0.f, 0.f, 0.f, 0.f};
#pragma unroll
        for (int ai = 0; ai < 2; ++ai)
#pragma unroll
            for (int m = 0; m < 4; ++m) { bf16_t* rowp = base + (size_t)(row0 + ai * HALF + m * 16) * ldc + col0;
#pragma unroll
                for (int bj = 0; bj < 2; ++bj) { f32x4 v0 = acc[ai][bj][m][0] + bv[bj][0], v1 = acc[ai][bj][m][1] + bv[bj][1];
                    if (ACT == 1) { f32x2 a = gelu_pk((f32x2){v0[0], v0[1]}), b = gelu_pk((f32x2){v0[2], v0[3]}), c = gelu_pk((f32x2){v1[0], v1[1]}), d = gelu_pk((f32x2){v1[2], v1[3]});
                        v0 = (f32x4){a.x, a.y, b.x, b.y}; v1 = (f32x4){c.x, c.y, d.x, d.y}; }
                    v0 = v0 * sc; v1 = v1 * sc; u32x4 w; w.x = cvt_pk_bf16(v0[0], v0[1]); w.y = cvt_pk_bf16(v0[2], v0[3]); w.z = cvt_pk_bf16(v1[0], v1[1]); w.w = cvt_pk_bf16(v1[2], v1[3]);
                    *(u32x4*)(rowp + bj * HALF) = w; } }
    }
};
struct EpiResidual {
    static constexpr bool PERM = false, AFTER_DRAIN = false;
    const float* base; float* out; int ldc;
    __device__ __forceinline__ void operator()(const f32x4 (&acc)[2][2][4][2], const Unit& u, int wr, int wc, int fr, int fq) const {
        const int col0 = u.pn * BM + wc * 32 + 4 * fq;
#pragma unroll
        for (int ai = 0; ai < 2; ++ai)
#pragma unroll
            for (int m = 0; m < 4; ++m) { const size_t off = (size_t)(u.pm * BM + ai * HALF + wr * 64 + m * 16 + fr) * ldc + col0;
#pragma unroll
                for (int bj = 0; bj < 2; ++bj)
#pragma unroll
                    for (int n = 0; n < 2; ++n) { const f32x4 bs = *(const f32x4*)(base + off + bj * HALF + n * 16); *(f32x4*)(out + off + bj * HALF + n * 16) = bs + acc[ai][bj][m][n]; }
                asm volatile("" ::: "memory"); }
    }
};
struct EpiSwiGLU {
    static constexpr bool PERM = true, AFTER_DRAIN = false;
    bf16_t* O; int ldc;
    __device__ __forceinline__ void operator()(const f32x4 (&acc)[2][2][4][2], const Unit& u, int wr, int wc, int fr, int fq) const {
        const int col0 = u.pn * HALF + wc * 32 + 8 * fq;
#pragma unroll
        for (int ai = 0; ai < 2; ++ai)
#pragma unroll
            for (int m = 0; m < 4; ++m) { bf16_t* rowp = O + (size_t)(u.pm * BM + ai * HALF + wr * 64 + m * 16 + fr) * ldc + col0;
                float r[8];
#pragma unroll
                for (int n = 0; n < 2; ++n)
#pragma unroll
                    for (int j = 0; j < 4; ++j) { const float g = acc[ai][0][m][n][j], up = acc[ai][1][m][n][j]; r[n * 4 + j] = g * __builtin_amdgcn_rcpf(1.f + __expf(-g)) * up; }
                u32x4 w; w.x = cvt_pk_bf16(r[0], r[1]); w.y = cvt_pk_bf16(r[2], r[3]); w.z = cvt_pk_bf16(r[4], r[5]); w.w = cvt_pk_bf16(r[6], r[7]);
                *(u32x4*)rowp = w; }
    }
};
template <class Epi, class Sched, bool ALIGN_EPI = false, bool SP2 = false>
__device__ __forceinline__ void gemm_phase(PG8_LAS unsigned char* lds, const Gemm g, const Sched& S, const Epi& E) {
    const int tid = threadIdx.x, wid = __builtin_amdgcn_readfirstlane(tid >> 6), lane = tid & 63, wr = wid >> 2, wc = wid & 3, fr = lane & 15, fq = lane >> 4;
    const int K = g.K, nt = K / BK;
    unsigned voffA[2], voffB[2];
#pragma unroll
    for (int i = 0; i < 2; ++i) { int R, C; stage_rc(tid * 16 + i * 8192, R, C); const int Rb = Epi::PERM ? ((R & ~31) + perm32(R & 31)) : R;
        voffA[i] = (unsigned)(R * K + C) * 2u; voffB[i] = (unsigned)(Rb * K + C) * 2u; }
    const size_t kstep = (size_t)(BK * 2);
    const size_t hstep = (size_t)HALF * K * 2;
    const size_t tstep = 2 * hstep;
    const unsigned ldsw = (unsigned)wid * 1024u;
    const int aoff = lds_byte(wr * 64 + fr, fq * 8), boff = lds_byte(wc * 32 + fr, fq * 8);
#define PG8_SA(b, h) (((b) * 2 + (h)) * HTB)
#define PG8_SB(b, h) ((4 + (b) * 2 + (h)) * HTB)
#define PG8_STAGE(bufoff, gbase, voff) do { _Pragma("unroll") for (int _i = 0; _i < 2; ++_i) \
        __builtin_amdgcn_global_load_lds((const unsigned*)((const char*)(gbase) + (voff)[_i]), (PG8_LAS unsigned*)(lds + (bufoff) + ldsw + _i * 8192), 16, 0, 0); } while (0)
#define PG8_LDA(dst, b, h) do { _Pragma("unroll") for (int m = 0; m < 4; ++m) _Pragma("unroll") for (int k = 0; k < 2; ++k) dst[m][k] = *(const PG8_LAS bf16x8*)(lds + PG8_SA(b, h) + aoff + m * 2048 + k * 1024); } while (0)
#define PG8_LDB(dst, b, h) do { _Pragma("unroll") for (int n = 0; n < 2; ++n) _Pragma("unroll") for (int k = 0; k < 2; ++k) dst[n][k] = *(const PG8_LAS bf16x8*)(lds + PG8_SB(b, h) + boff + n * 2048 + k * 1024); } while (0)
#define PG8_MMA(ai, bj, At, Bt) do { __builtin_amdgcn_s_setprio(1); _Pragma("unroll") for (int m = 0; m < 4; ++m) _Pragma("unroll") for (int n = 0; n < 2; ++n) _Pragma("unroll") for (int k = 0; k < 2; ++k) \
        acc[ai][bj][m][n] = __builtin_amdgcn_mfma_f32_16x16x32_bf16(Bt[n][k], At[m][k], acc[ai][bj][m][n], 0, 0, 0); __builtin_amdgcn_s_setprio(0); } while (0)
#define PG8_WAIT_V(n) asm volatile("s_waitcnt vmcnt(" #n ")" ::: "memory")
#define PG8_WAIT_L(n) asm volatile("s_waitcnt lgkmcnt(" #n ")" ::: "memory")
#define PG8_BAR __builtin_amdgcn_s_barrier()
#define PG8_SCHED __builtin_amdgcn_sched_barrier(0)
    Unit cur, nxt; int ui = 0;
    if (!S.next(0, cur)) return;
    f32x4 acc[2][2][4][2];
#pragma unroll
    for (int a = 0; a < 2; ++a)
#pragma unroll
        for (int b = 0; b < 2; ++b)
#pragma unroll
            for (int m = 0; m < 4; ++m)
#pragma unroll
                for (int n = 0; n < 2; ++n) acc[a][b][m][n] = (f32x4){0.f, 0.f, 0.f, 0.f};
    bf16x8 At[4][2], B0[2][2], B1[2][2];
    const char* cA = (const char*)g.A + (size_t)cur.pm * tstep; const char* cB = (const char*)g.Bt + (size_t)cur.pn * tstep;
    S.a_ready(cur);
    if constexpr (SP2) {
        PG8_STAGE(PG8_SB(0, 0), cB, voffB); PG8_STAGE(PG8_SB(0, 1), cB + hstep, voffB); PG8_STAGE(PG8_SA(0, 0), cA, voffA); PG8_STAGE(PG8_SA(0, 1), cA + hstep, voffA);
        if (wr == 1) PG8_BAR;
        PG8_WAIT_V(2); PG8_BAR;
        PG8_STAGE(PG8_SB(1, 0), cB + kstep, voffB); PG8_STAGE(PG8_SA(1, 0), cA + kstep, voffA); PG8_STAGE(PG8_SB(1, 1), cB + hstep + kstep, voffB);
        PG8_WAIT_V(6); PG8_BAR;
    } else {
        PG8_STAGE(PG8_SB(0, 0), cB, voffB); PG8_STAGE(PG8_SA(0, 0), cA, voffA); PG8_STAGE(PG8_SB(0, 1), cB + hstep, voffB); PG8_STAGE(PG8_SA(0, 1), cA + hstep, voffA);
        if (wr == 1) PG8_BAR;
        PG8_WAIT_V(4); PG8_BAR;
        PG8_STAGE(PG8_SB(1, 0), cB + kstep, voffB); PG8_STAGE(PG8_SA(1, 0), cA + kstep, voffA); PG8_STAGE(PG8_SB(1, 1), cB + hstep + kstep, voffB);
        PG8_WAIT_V(6); PG8_BAR;
    }
    for (;;) {
        const bool has_next = S.next(ui + 1, nxt);
        const char* nA = has_next ? (const char*)g.A + (size_t)nxt.pm * tstep : cA; const char* nB = has_next ? (const char*)g.Bt + (size_t)nxt.pn * tstep : cB;
        for (int t = 0; t < nt; t += 2) {
            const bool last = (t == nt - 2);
            const char* a1 = cA + (size_t)(t + 1) * kstep;
            const char* a2 = last ? nA : cA + (size_t)(t + 2) * kstep; const char* b2 = last ? nB : cB + (size_t)(t + 2) * kstep;
            const char* a3 = a2 + kstep; const char* b3 = b2 + kstep;
            if (last && has_next) S.a_ready(nxt);
            if constexpr (SP2) {
            PG8_LDB(B0, 0, 0); PG8_LDB(B1, 0, 1); PG8_SCHED; PG8_LDA(At, 0, 0); PG8_STAGE(PG8_SA(1, 1), a1 + hstep, voffA);
            PG8_WAIT_V(8); PG8_WAIT_L(0); PG8_BAR; PG8_MMA(0, 0, At, B0); PG8_MMA(0, 1, At, B1); PG8_BAR; PG8_SCHED;
            PG8_LDA(At, 0, 1); PG8_STAGE(PG8_SB(0, 0), b2, voffB); PG8_STAGE(PG8_SB(0, 1), b2 + hstep, voffB); PG8_STAGE(PG8_SA(0, 0), a2, voffA);
            PG8_WAIT_V(8); PG8_WAIT_L(0); PG8_BAR; PG8_MMA(1, 0, At, B0); PG8_MMA(1, 1, At, B1); PG8_BAR; PG8_SCHED;
            PG8_LDB(B0, 1, 0); PG8_LDB(B1, 1, 1); PG8_SCHED; PG8_LDA(At, 1, 0); PG8_STAGE(PG8_SA(0, 1), a2 + hstep, voffA);
            PG8_WAIT_V(8); PG8_WAIT_L(0); PG8_BAR; PG8_MMA(0, 0, At, B0); PG8_MMA(0, 1, At, B1); PG8_BAR; PG8_SCHED;
            PG8_LDA(At, 1, 1); PG8_STAGE(PG8_SB(1, 0), b3, voffB); PG8_STAGE(PG8_SB(1, 1), b3 + hstep, voffB); PG8_STAGE(PG8_SA(1, 0), a3, voffA);
            PG8_WAIT_V(8); PG8_WAIT_L(0); PG8_BAR; PG8_MMA(1, 0, At, B0); PG8_MMA(1, 1, At, B1); PG8_BAR; PG8_SCHED;
            } else {
            PG8_LDB(B0, 0, 0); PG8_SCHED; PG8_LDA(At, 0, 0); PG8_STAGE(PG8_SA(1, 1), a1 + hstep, voffA);
            PG8_WAIT_L(8); PG8_BAR; PG8_WAIT_L(0); PG8_MMA(0, 0, At, B0); PG8_BAR; PG8_SCHED;
            PG8_LDB(B1, 0, 1); PG8_STAGE(PG8_SB(0, 0), b2, voffB);
            PG8_BAR; PG8_WAIT_L(0); PG8_MMA(0, 1, At, B1); PG8_BAR;
            PG8_LDA(At, 0, 1); PG8_STAGE(PG8_SA(0, 0), a2, voffA);
            PG8_BAR; PG8_WAIT_L(0); PG8_MMA(1, 0, At, B0); PG8_BAR; PG8_SCHED;
            PG8_STAGE(PG8_SB(0, 1), b2 + hstep, voffB);
            PG8_WAIT_V(6); PG8_BAR; PG8_MMA(1, 1, At, B1); PG8_BAR;
            PG8_LDB(B0, 1, 0); PG8_SCHED; PG8_LDA(At, 1, 0); PG8_STAGE(PG8_SA(0, 1), a2 + hstep, voffA);
            PG8_WAIT_L(8); PG8_BAR; PG8_WAIT_L(0); PG8_MMA(0, 0, At, B0); PG8_BAR; PG8_SCHED;
            PG8_LDB(B1, 1, 1); PG8_STAGE(PG8_SB(1, 0), b3, voffB);
            PG8_BAR; PG8_WAIT_L(0); PG8_MMA(0, 1, At, B1); PG8_BAR;
            PG8_LDA(At, 1, 1); PG8_STAGE(PG8_SA(1, 0), a3, voffA);
            PG8_BAR; PG8_WAIT_L(0); PG8_MMA(1, 0, At, B0); PG8_BAR; PG8_SCHED;
            PG8_STAGE(PG8_SB(1, 1), b3 + hstep, voffB);
            PG8_WAIT_V(6); PG8_BAR; PG8_MMA(1, 1, At, B1); PG8_BAR;
            }
        }
        if constexpr (ALIGN_EPI) { if (wr == 0) PG8_BAR; }
        if constexpr (!Epi::AFTER_DRAIN) { E(acc, cur, wr, wc, fr, fq); S.done(cur); }
        if (!has_next) break;
#pragma unroll
        for (int a = 0; a < 2; ++a)
#pragma unroll
            for (int b = 0; b < 2; ++b)
#pragma unroll
                for (int m = 0; m < 4; ++m)
#pragma unroll
                    for (int n = 0; n < 2; ++n) acc[a][b][m][n] = (f32x4){0.f, 0.f, 0.f, 0.f};
        cur = nxt; cA = nA; cB = nB; ++ui;
        if constexpr (ALIGN_EPI) { if (wr == 1) PG8_BAR; }
    }
    PG8_WAIT_V(0);
    if constexpr (!ALIGN_EPI) { if (wr == 0) PG8_BAR; }
    PG8_BAR;
    if constexpr (Epi::AFTER_DRAIN) { E.fused(acc, cur, wr, wc, fr, fq, lds, wid, lane); S.done(cur); }
#undef PG8_SA
#undef PG8_SB
#undef PG8_STAGE
#undef PG8_LDA
#undef PG8_LDB
#undef PG8_MMA
#undef PG8_WAIT_V
#undef PG8_WAIT_L
#undef PG8_BAR
#undef PG8_SCHED
}
}

#ifndef PG8_SP2
#define PG8_SP2 true
#endif
#define PG8_ALIGN true
constexpr int NWAVES = 8;
constexpr int BATCH = 2, SEQ = 8192, DM = 1024, M = BATCH * SEQ, NIN = 3788, NINP = 3840, FFN = 2816, DEPTH = 2;
constexpr int A_Q = 0, A_K = 256, A_V = 512, A_O = 768;
constexpr int R_R = 1024, R_K = 1408, R_V = 1792, R_WDF = 2176, R_AD = 2304, R_GD = 2368;
constexpr int S_Z = 2496, S_X = 2880, S_B = 3264, S_C = 3520, S_DT = 3776;
constexpr size_t MiB = 1u << 20;
constexpr size_t WS_CTL = 0, CTL_ZERO_BYTES = 64 * 1024;
constexpr size_t WS_GATES = 1 * MiB, WS_CT = 2 * MiB;
constexpr size_t WS_WIN = 4 * MiB, WS_WOUT = 12 * MiB, WS_WGU = 14 * MiB, WS_WDN = 25 * MiB;
constexpr size_t WS_XN = 32 * MiB, WS_COLS = 64 * MiB, WS_Y = 184 * MiB, WS_END = 248 * MiB;
constexpr size_t Y_AF = WS_Y, Y_AB = WS_Y + 8 * MiB, Y_RF = WS_Y + 16 * MiB, Y_RB = WS_Y + 28 * MiB, Y_SF = WS_Y + 40 * MiB, Y_SB = WS_Y + 52 * MiB;
constexpr int CW_BAR = 1024;
constexpr int RING_BYTES = 131072;
constexpr int LDS_BYTES = 147456, MISC_OFF = LDS_BYTES - 256;

#define GAS __attribute__((address_space(1)))
#define LAS __attribute__((address_space(3)))
typedef unsigned short bf16;
typedef unsigned v4u __attribute__((ext_vector_type(4)));
typedef unsigned v2u __attribute__((ext_vector_type(2)));
typedef float f32x4 __attribute__((ext_vector_type(4)));
typedef short bf16x8 __attribute__((ext_vector_type(8)));
typedef GAS unsigned gu32;
#define RLX_AGENT __ATOMIC_RELAXED, __HIP_MEMORY_SCOPE_AGENT
#define LDS_WAIT() asm volatile("s_waitcnt lgkmcnt(0)" ::: "memory")
#define VM_WAIT() asm volatile("s_waitcnt vmcnt(0)" ::: "memory")
__device__ __forceinline__ unsigned f2bf(float f) { unsigned u = __builtin_bit_cast(unsigned, f); return (u + 0x7fffu + ((u >> 16) & 1u)) >> 16; }
__device__ __forceinline__ unsigned pk2(float lo, float hi) { return f2bf(lo) | (f2bf(hi) << 16); }
__device__ __forceinline__ float bf2f(unsigned u) { return __builtin_bit_cast(float, u << 16); }
__device__ __forceinline__ float sigmoidf_(float x) { return __builtin_amdgcn_rcpf(1.f + __expf(-x)); }
__device__ __forceinline__ float siluf_(float x) { return x * sigmoidf_(x); }
__device__ __forceinline__ float wave_sum(float v) {
#pragma unroll
    for (int o = 1; o < 64; o <<= 1) v += __shfl_xor(v, o);
    return v;
}
__device__ __forceinline__ float wave_max(float v) {
#pragma unroll
    for (int o = 1; o < 64; o <<= 1) v = fmaxf(v, __shfl_xor(v, o));
    return v;
}
template <int CTRL> __device__ __forceinline__ float dppf(float v) { return __builtin_bit_cast(float, __builtin_amdgcn_update_dpp(0, __builtin_bit_cast(int, v), CTRL, 0xf, 0xf, true)); }
__device__ __forceinline__ float row16_sum(float v) { v += dppf<0xB1>(v); v += dppf<0x4E>(v); v += dppf<0x141>(v); v += dppf<0x140>(v); return v; }
template <int K> __device__ __forceinline__ f32x4 mma16(const LAS bf16* A, int lda, const LAS bf16* Bt, int ldb, f32x4 acc, int lane) {
    const int r = lane & 15, q = lane >> 4;
    const LAS bf16* ap = A + r * lda + q * 8; const LAS bf16* bp = Bt + r * ldb + q * 8;
#pragma unroll
    for (int k0 = 0; k0 < K; k0 += 32) {
        const bf16x8 a = *(const LAS bf16x8*)(ap + k0); const bf16x8 b = *(const LAS bf16x8*)(bp + k0);
        acc = __builtin_amdgcn_mfma_f32_16x16x32_bf16(a, b, acc, 0, 0, 0);
    }
    return acc;
}

__device__ __forceinline__ int swz64(int row, int col) { return col ^ (((row >> 3) & 7) << 3); }
template <bool SWA, bool SWB> __device__ __forceinline__ f32x4 mma16s(const LAS bf16* A, int lda, int rowA0, const LAS bf16* Bt, int ldb, int rowB0, f32x4 acc, int lane) {
    const int r = lane & 15, q = lane >> 4; const int ra = rowA0 + r, rb = rowB0 + r;
#pragma unroll
    for (int k0 = 0; k0 < 64; k0 += 32) { const int ca = k0 + 8 * q, cb = k0 + 8 * q;
        const bf16x8 a = *(const LAS bf16x8*)(A + ra * lda + (SWA ? swz64(ra, ca) : ca)); const bf16x8 b = *(const LAS bf16x8*)(Bt + rb * ldb + (SWB ? swz64(rb, cb) : cb));
        acc = __builtin_amdgcn_mfma_f32_16x16x32_bf16(a, b, acc, 0, 0, 0); }
    return acc;
}
#define XB_TMO      128
#define XB_XCNT(j)  (256  + 64 * (j))
#define XB_XSUB(j)  (1280 + 64 * (j))
#define XB_XGEN(j)  (2304 + 64 * (j))
#define XB_TOP      3328
#define XB_TOPGEN   3392
#define XCD_BAR_WORDS 3456
#define XB_SPIN_CAP (1u << 18)

__device__ __forceinline__ unsigned xb_ld(unsigned* p)              { return __hip_atomic_load(p, __ATOMIC_RELAXED, __HIP_MEMORY_SCOPE_AGENT); }
__device__ __forceinline__ unsigned xb_add(unsigned* p, unsigned v) { return __hip_atomic_fetch_add(p, v, __ATOMIC_RELAXED, __HIP_MEMORY_SCOPE_AGENT); }
__device__ __forceinline__ unsigned xb_xcc_id() { return (unsigned)__builtin_amdgcn_s_getreg((3 << 11) | 20) & 0xFu; }
#define XB_SPIN(cond, bar) do { unsigned _sp = 0; while (cond) { __builtin_amdgcn_s_sleep(1); \
    if ((++_sp & 255u) == 0u) { if (xb_ld(&(bar)[XB_TMO])) break; if (_sp > XB_SPIN_CAP) { atomicAdd(&(bar)[XB_TMO], 1u); break; } } } } while (0)

struct XcdBarrier {
    unsigned* bar; unsigned x;
    volatile LAS unsigned* st;
};

__device__ __forceinline__ XcdBarrier xcd_barrier_post(unsigned* bar, volatile LAS unsigned* st) {
    XcdBarrier b; b.bar = bar; b.x = xb_xcc_id(); b.st = st;
    if (threadIdx.x == 0) (void)xb_add(&bar[XB_XCNT(b.x)], 1u);
    return b;
}
__device__ __forceinline__ void xcd_barrier_complete(unsigned* bar, unsigned x, unsigned& nloc, unsigned& nx) {
    const unsigned G = gridDim.x * gridDim.y * gridDim.z;
    unsigned sum, cnt, mine, sp = 0u;
    for (;;) {
        sum = 0u; cnt = 0u; mine = 0u;
#pragma unroll
        for (unsigned j = 0; j < 16; ++j) { const unsigned c = xb_ld(&bar[XB_XCNT(j)]); sum += c; cnt += (c > 0u) ? 1u : 0u; mine = (j == x) ? c : mine; }
        if (sum == G) break;
        __builtin_amdgcn_s_sleep(1);
        if ((++sp & 255u) == 0u) { if (xb_ld(&bar[XB_TMO])) break; if (sp > XB_SPIN_CAP) { atomicAdd(&bar[XB_TMO], 1u); break; } }
    }
    nloc = mine > 0u ? mine : 1u; nx = cnt > 0u ? cnt : 1u;
}

__device__ __forceinline__ void xcd_barrier(const XcdBarrier& b) {
    asm volatile("s_waitcnt vmcnt(0)" ::: "memory");
    __syncthreads();
    if (threadIdx.x == 0) {
        unsigned* bar = b.bar;
        __builtin_amdgcn_s_waitcnt(0);
        unsigned nloc = b.st[0], nx = b.st[1];
        if (nloc == 0u) { xcd_barrier_complete(bar, b.x, nloc, nx); b.st[0] = nloc; b.st[1] = nx; }
        const unsigned old = xb_add(&bar[XB_XSUB(b.x)], 1u);
        const unsigned gen = old / nloc;
        if (old + 1u == (gen + 1u) * nloc) {
            __builtin_amdgcn_fence(__ATOMIC_RELEASE, "agent");
            asm volatile("s_waitcnt vmcnt(0)" ::: "memory");
            const unsigned og = xb_add(&bar[XB_TOP], 1u);
            const unsigned tg = og / nx;
            if (og + 1u == (tg + 1u) * nx) xb_add(&bar[XB_TOPGEN], 1u);
            else XB_SPIN(xb_ld(&bar[XB_TOPGEN]) == tg, bar);
            __builtin_amdgcn_fence(__ATOMIC_ACQUIRE, "agent");
            xb_add(&bar[XB_XGEN(b.x)], 1u);
            asm volatile("s_waitcnt vmcnt(0)" ::: "memory");
        } else {
            XB_SPIN(xb_ld(&bar[XB_XGEN(b.x)]) == gen, bar);
            __builtin_amdgcn_fence(__ATOMIC_ACQUIRE, "agent");
            asm volatile("s_waitcnt vmcnt(0)" ::: "memory");
        }
    }
    __syncthreads();
}
struct Frame {
    LAS unsigned char* lds;
    int tid, lane, wave, vcu, G;
};
struct Args { const float* in[32]; float* out; unsigned char* ws; int ph_lo, ph_hi; };
constexpr int PTAB_OFF = LDS_BYTES - 768;
__device__ __forceinline__ unsigned long long ptab_ld(const Frame& F, int i) {
    const unsigned long long v = *(volatile LAS unsigned long long*)(F.lds + PTAB_OFF + 8 * i);
    const unsigned lo = __builtin_amdgcn_readfirstlane((unsigned)v), hi = __builtin_amdgcn_readfirstlane((unsigned)(v >> 32));
    return ((unsigned long long)hi << 32) | lo;
}
__device__ __forceinline__ const float* INP(const Frame& F, int i) { return (const float*)ptab_ld(F, i); }
__device__ __forceinline__ unsigned char* WSP(const Frame& F) { return (unsigned char*)ptab_ld(F, 33); }
__device__ __forceinline__ float* OUTP(const Frame& F) { return (float*)ptab_ld(F, 32); }

__device__ __forceinline__ void transpose_item(const float* W, int K, int N, int nblk, bf16* WT, int mode, int row_off, LAS float* scr, int item, int lane) {
    const int kb = item / nblk, nb = item % nblk, k0 = 64 * kb, n0 = 32 * nb;
    const int ncol = n0 + (lane & 31); const bool ok = ncol < N;
#pragma unroll 8
    for (int i = 0; i < 32; ++i) { const int kk = 2 * i + (lane >> 5); scr[kk * 33 + (lane & 31)] = ok ? W[(size_t)(k0 + kk) * N + ncol] : 0.f; }
    LDS_WAIT(); asm volatile("" ::: "memory");
    const int c = lane & 7;
    const int drow0 = mode ? (256 * (n0 >> 7) + (n0 & 127) + row_off) : (row_off + n0);
#pragma unroll
    for (int j = 0; j < 4; ++j) { const int n = (lane >> 3) + 8 * j; const LAS float* s = scr + (8 * c) * 33 + n;
        v4u o; o.x = pk2(s[0 * 33], s[1 * 33]); o.y = pk2(s[2 * 33], s[3 * 33]); o.z = pk2(s[4 * 33], s[5 * 33]); o.w = pk2(s[6 * 33], s[7 * 33]);
        *(v4u*)(WT + (size_t)(drow0 + n) * K + k0 + 8 * c) = o; }
    LDS_WAIT(); asm volatile("" ::: "memory");
}
__device__ __forceinline__ void phase_convert(const Frame& F, int l) {
    LAS float* scr = (LAS float*)(F.lds + F.wave * 16384);
    const int gw = F.vcu * NWAVES + F.wave, NGW = F.G * NWAVES;
    bf16* Win = (bf16*)(WSP(F) + WS_WIN); bf16* Wout = (bf16*)(WSP(F) + WS_WOUT); bf16* Wgu = (bf16*)(WSP(F) + WS_WGU); bf16* Wdn = (bf16*)(WSP(F) + WS_WDN);
    constexpr int I_IN = 16 * 120, I_OUT = 16 * 32, I_G = 16 * 88, I_D = 44 * 32;
    constexpr int NITEMS = I_IN + I_OUT + 2 * I_G + I_D;
    for (int it = gw; it < NITEMS; it += NGW) {
        int r = it;
        if (r < I_IN) { transpose_item(INP(F, 2) + (size_t)l * DM * NIN, DM, NIN, 120, Win, 0, 0, scr, r, F.lane); continue; } r -= I_IN;
        if (r < I_OUT) { transpose_item(INP(F, 26) + (size_t)l * DM * DM, DM, DM, 32, Wout, 0, 0, scr, r, F.lane); continue; } r -= I_OUT;
        if (r < I_G) { transpose_item(INP(F, 28) + (size_t)l * DM * FFN, DM, FFN, 88, Wgu, 1, 0, scr, r, F.lane); continue; } r -= I_G;
        if (r < I_G) { transpose_item(INP(F, 29) + (size_t)l * DM * FFN, DM, FFN, 88, Wgu, 1, 128, scr, r, F.lane); continue; } r -= I_G;
        transpose_item(INP(F, 30) + (size_t)l * FFN * DM, FFN, DM, 32, Wdn, 0, 0, scr, r, F.lane);
    }
}
__device__ __forceinline__ void phase_norm(const Frame& F, const float* hin, const float* g, bf16* XN) {
    const int gw = F.vcu * NWAVES + F.wave, NGW = F.G * NWAVES;
    f32x4 gv[4];
#pragma unroll
    for (int j = 0; j < 4; ++j) gv[j] = ((const f32x4*)g)[64 * j + F.lane];
    for (int m = gw; m < M; m += NGW) {
        const f32x4* xr = (const f32x4*)(hin + (size_t)m * DM) + F.lane;
        f32x4 v[4]; float s = 0.f;
#pragma unroll
        for (int j = 0; j < 4; ++j) { v[j] = xr[64 * j]; s += (v[j].x * v[j].x + v[j].y * v[j].y) + (v[j].z * v[j].z + v[j].w * v[j].w); }
        const float r = 1.f / sqrtf(wave_sum(s) * (1.f / DM) + 1e-6f);
        v2u* o8 = (v2u*)(XN + (size_t)m * DM) + F.lane;
#pragma unroll
        for (int j = 0; j < 4; ++j) { v2u w; w.x = pk2(v[j].x * r * gv[j].x, v[j].y * r * gv[j].y); w.y = pk2(v[j].z * r * gv[j].z, v[j].w * r * gv[j].w); o8[64 * j] = w; }
    }
}
__device__ __forceinline__ void phase_final_norm(const Frame& F, float* h, const float* g) {
    const int gw = F.vcu * NWAVES + F.wave, NGW = F.G * NWAVES;
    f32x4 gv[4];
#pragma unroll
    for (int j = 0; j < 4; ++j) gv[j] = ((const f32x4*)g)[64 * j + F.lane];
    for (int m = gw; m < M; m += NGW) {
        f32x4* xr = (f32x4*)(h + (size_t)m * DM) + F.lane;
        f32x4 v[4]; float s = 0.f;
#pragma unroll
        for (int j = 0; j < 4; ++j) { v[j] = xr[64 * j]; s += (v[j].x * v[j].x + v[j].y * v[j].y) + (v[j].z * v[j].z + v[j].w * v[j].w); }
        const float r = 1.f / sqrtf(wave_sum(s) * (1.f / DM) + 1e-6f);
#pragma unroll
        for (int j = 0; j < 4; ++j) xr[64 * j] = v[j] * r * gv[j];
    }
}
__device__ __forceinline__ void phase_gates(const Frame& F, int l) {
    const bf16* cols = (const bf16*)(WSP(F) + WS_COLS); float* GT = (float*)(WSP(F) + WS_GATES);
    LAS bf16* raw = (LAS bf16*)(F.lds);
    LAS float* feat = (LAS float*)(F.lds + 32768);
    LAS float* gw = (LAS float*)(F.lds + 81920);
    const float* gwg = INP(F, 5) + (size_t)l * 768 * 16; const float* gb = INP(F, 6) + l * 16;
    const float* cw = INP(F, 3) + (size_t)l * 5 * 512; const float* cb = INP(F, 4) + l * 512;
    for (int i = F.tid; i < 768 * 16; i += 512) gw[i] = gwg[i];
    for (int tile = F.vcu; tile < M / 16; tile += F.G) {
        const int m0 = tile * 16, t0 = m0 % SEQ;
        __syncthreads();
        for (int ch = F.tid; ch < 20 * 96; ch += 512) { const int rr = ch / 96, cc = ch % 96; const int t = t0 - 2 + rr;
            v4u v = {0u, 0u, 0u, 0u}; if (t >= 0 && t < SEQ) v = *(const v4u*)(cols + (size_t)(m0 - 2 + rr) * NINP + cc * 8);
            *(LAS v4u*)(raw + rr * 768 + cc * 8) = v; }
        __syncthreads();
        for (int idx = F.tid; idx < 16 * 768; idx += 512) { const int t = idx / 768, c = idx % 768; float val;
            if (c < 512) { float s = cb[c];
#pragma unroll
                for (int j = 0; j < 5; ++j) s += cw[j * 512 + c] * bf2f(raw[(t + j) * 768 + c]);
                val = siluf_(s); } else val = bf2f(raw[(t + 2) * 768 + c]);
            feat[idx] = val; }
        __syncthreads();
        { const int t = F.tid >> 5, o = (F.tid >> 1) & 15, hf = F.tid & 1; float s = 0.f;
          const LAS float* fp = feat + t * 768 + hf * 384; const LAS float* wp = gw + (hf * 384) * 16 + o;
#pragma unroll 8
          for (int i = 0; i < 384; ++i) s += fp[i] * wp[i * 16];
          s += __shfl_xor(s, 1);
          if (hf == 0) { s += gb[o]; if (o >= 8) s = fminf(s, 0.f) - log1pf(__expf(-fabsf(s))); GT[(size_t)(m0 + t) * 16 + o] = s; } }
    }
    __syncthreads();
}
__device__ __forceinline__ f32x4 mma16_a8(const LAS bf16* A8, const LAS bf16* Bt, f32x4 acc, int lane) {
    const int q = lane >> 4;
    const LAS bf16* ap = A8 + (lane & 7) * 72 + q * 8; const LAS bf16* bp = Bt + (lane & 15) * 72 + q * 8;
#pragma unroll
    for (int k0 = 0; k0 < 64; k0 += 32) { const bf16x8 a = *(const LAS bf16x8*)(ap + k0); const bf16x8 b = *(const LAS bf16x8*)(bp + k0); acc = __builtin_amdgcn_mfma_f32_16x16x32_bf16(a, b, acc, 0, 0, 0); }
    return acc;
}
typedef float f32x2 __attribute__((ext_vector_type(2)));
template <bool DIR> __device__ __forceinline__ void rwkv_steps(const LAS float* OPS, const LAS float* VV, LAS float* YB, f32x4& S, int j, int row) {
    float yk0 = 0.f, yk1 = 0.f;
    constexpr int ST = DIR ? -320 : 320, SV = DIR ? -16 : 16;
    const LAS float* op = OPS + 4 * j + (DIR ? 31 * 320 : 0); const LAS float* vp = VV + row + (DIR ? 31 * 16 : 0);
#define RWLD(W_, KK_, KA_, KM_, R_, V_, o_, v_) do { W_ = *(const LAS f32x4*)(o_); KK_ = *(const LAS f32x4*)((o_) + 64); KA_ = *(const LAS f32x4*)((o_) + 128); KM_ = *(const LAS f32x4*)((o_) + 192); R_ = *(const LAS f32x4*)((o_) + 256); V_ = *(v_); } while (0)
#define RWSTEP(W_, KK_, KA_, KM_, R_, V_, i_) do { f32x2 t2_ = S.xy * KK_.xy; t2_ = S.zw * KK_.zw + t2_; float sa_ = t2_.x + t2_.y; const f32x4 ps_ = S * W_ + KM_ * V_; sa_ = row16_sum(sa_); S = ps_ + KA_ * sa_; \
        f32x2 y2_ = S.xy * R_.xy; y2_ = S.zw * R_.zw + y2_; float y_ = y2_.x + y2_.y; y_ = row16_sum(y_); if (((i_) & 15) == j) { if ((i_) < 16) yk0 = y_; else yk1 = y_; } } while (0)
    f32x4 w4a, kk4a, ka4a, km4a, r4a, w4b, kk4b, ka4b, km4b, r4b; float vva, vvb;
    RWLD(w4a, kk4a, ka4a, km4a, r4a, vva, op, vp);
    RWLD(w4b, kk4b, ka4b, km4b, r4b, vvb, op + ST, vp + SV);
#pragma unroll 1
    for (int i = 0; i < 30; i += 2) {
        f32x4 nw, nkk, nka, nkm, nr; float nv;
        RWLD(nw, nkk, nka, nkm, nr, nv, op + 2 * ST, vp + 2 * SV);
        RWSTEP(w4a, kk4a, ka4a, km4a, r4a, vva, i);
        w4a = nw; kk4a = nkk; ka4a = nka; km4a = nkm; r4a = nr; vva = nv;
        RWLD(nw, nkk, nka, nkm, nr, nv, op + 3 * ST, vp + 3 * SV);
        RWSTEP(w4b, kk4b, ka4b, km4b, r4b, vvb, i + 1);
        w4b = nw; kk4b = nkk; ka4b = nka; km4b = nkm; r4b = nr; vvb = nv;
        op += 2 * ST; vp += 2 * SV;
    }
    RWSTEP(w4a, kk4a, ka4a, km4a, r4a, vva, 30);
    RWSTEP(w4b, kk4b, ka4b, km4b, r4b, vvb, 31);
#undef RWLD
#undef RWSTEP
    YB[(DIR ? 31 - j : j) * 16 + row] = yk0; YB[(DIR ? 15 - j : 16 + j) * 16 + row] = yk1;
}
struct RwCtx { LAS bf16* WA; LAS bf16* WW; LAS bf16* XA; LAS bf16* XW; LAS bf16* RAWB; LAS float* MU; float* CT; const bf16* colsb;
    f32x4 kk_c4, ka_c4, rk_c4; float ba[4], bw[4]; float mup_[5][2], mun_[5][2]; int h, dir, qtr, tb0; size_t mb; };
template <int NTOK> __device__ __forceinline__ void rw_addr_init(int (&poff)[5], int (&prr)[5], int lane, int tb0, int h, int dir) {
    constexpr int NCHK = (NTOK + 2) * 40;
#pragma unroll
    for (int i = 0; i < 5; ++i) { const int idx = lane + 64 * i; const int rr = idx / 40, q = idx % 40, wh = q >> 3, c8 = q & 7;
        const int gc = (wh == 0 ? R_R + h * 64 : wh == 1 ? R_K + h * 64 : wh == 2 ? R_V + h * 64 : wh == 3 ? R_WDF + dir * 64 : R_AD) + c8 * 8;
        prr[i] = idx < NCHK ? tb0 - 1 + rr : -100000; poff[i] = (tb0 - 1 + rr) * NINP + gc; }
}
template <int NTOK> __device__ __forceinline__ void rw_issue(v4u (&pre)[5], const int (&poff)[5], const int (&prr)[5], const bf16* colsb, int T0) {
    constexpr int NCH = ((NTOK + 2) * 40 + 63) / 64;
#pragma unroll
    for (int i = 0; i < NCH; ++i) { pre[i] = (v4u){0u, 0u, 0u, 0u}; const int t = T0 + prr[i]; if (t >= 0 && t < SEQ) pre[i] = *(const v4u*)(colsb + (size_t)T0 * NINP + poff[i]); }
}
template <int NTOK, bool FULLV> __device__ __forceinline__ void rw_prep(const RwCtx& C, const v4u (&pre)[5], LAS float* OPS, LAS float* VV, int T0, int lane) {
    constexpr int NCHK = (NTOK + 2) * 40, NCH = (NCHK + 63) / 64;
    const int j = lane & 15, c2 = (lane & 31) * 2;
#pragma unroll
    for (int i = 0; i < NCH; ++i) { const int idx = lane + 64 * i; if (idx < NCHK) *(LAS v4u*)(C.RAWB + idx * 8) = pre[i]; }
    LDS_WAIT(); asm volatile("" ::: "memory");
#pragma unroll
    for (int which = 0; which < 5; ++which)
#pragma unroll
        for (int pr = 0; pr < NTOK / 2; ++pr) { const int tt = 2 * pr + (lane >> 5), cc = which * 64 + c2, t = C.tb0 + tt;
            const unsigned r0 = *(const LAS unsigned*)(C.RAWB + tt * 320 + cc), r1 = *(const LAS unsigned*)(C.RAWB + (tt + 1) * 320 + cc), r2 = *(const LAS unsigned*)(C.RAWB + (tt + 2) * 320 + cc);
            const float p1x = bf2f(r1 & 0xffffu), p1y = bf2f(r1 >> 16);
            const float vx = p1x + C.mup_[which][0] * (bf2f(r0 & 0xffffu) - p1x) + C.mun_[which][0] * (bf2f(r2 & 0xffffu) - p1x);
            const float vy = p1y + C.mup_[which][1] * (bf2f(r0 >> 16) - p1y) + C.mun_[which][1] * (bf2f(r2 >> 16) - p1y);
            if (which == 0) *(LAS f32x2*)(OPS + t * 320 + 256 + c2) = (f32x2){vx, vy};
            else if (which == 1) *(LAS f32x2*)(OPS + t * 320 + 192 + c2) = (f32x2){vx, vy};
            else if (which == 2) { if (FULLV) *(LAS f32x2*)(VV + t * 64 + c2) = (f32x2){vx, vy}; else if ((c2 >> 4) == C.qtr) *(LAS f32x2*)(VV + t * 16 + (c2 & 15)) = (f32x2){vx, vy}; }
            else if (which == 3) { const float ex = __expf(2.f * vx), ey = __expf(2.f * vy);
                *(LAS unsigned*)(C.XW + tt * 72 + c2) = pk2(1.f - 2.f * __builtin_amdgcn_rcpf(ex + 1.f), 1.f - 2.f * __builtin_amdgcn_rcpf(ey + 1.f)); }
            else *(LAS unsigned*)(C.XA + tt * 72 + c2) = pk2(vx, vy); }
    LDS_WAIT(); asm volatile("" ::: "memory");
    { const bool hi = lane >= 32; const int lr = ((lane >> 4) & 1) * 4 + (hi ? 2 : 0); const bool ok0 = lr < NTOK, ok1 = lr + 1 < NTOK; const int tb = C.tb0 + lr;
#pragma unroll
      for (int ct = 0; ct < 4; ++ct) { const f32x4 z = {0.f, 0.f, 0.f, 0.f};
        const f32x4 ca = mma16_a8(C.XA, C.WA + ct * 16 * 72, z, lane), cw = mma16_a8(C.XW, C.WW + ct * 16 * 72, z, lane);
        const int c = ct * 16 + j;
        const float a0v = hi ? ca[2] : ca[0], a1v = hi ? ca[3] : ca[1], w0v = hi ? cw[2] : cw[0], w1v = hi ? cw[3] : cw[1];
        if (ok0) { OPS[tb * 320 + 128 + c] = sigmoidf_(C.ba[ct] + a0v); OPS[tb * 320 + c] = __expf(-0.6065306597f * sigmoidf_(C.bw[ct] + w0v)); }
        if (ok1) { OPS[(tb + 1) * 320 + 128 + c] = sigmoidf_(C.ba[ct] + a1v); OPS[(tb + 1) * 320 + c] = __expf(-0.6065306597f * sigmoidf_(C.bw[ct] + w1v)); } } }
    LDS_WAIT(); asm volatile("" ::: "memory");
#pragma unroll
    for (int ps = 0; ps < (NTOK + 3) / 4; ++ps) { const int tl = 4 * ps + (lane >> 4); const bool ok = tl < NTOK; const int t = C.tb0 + (ok ? tl : 0); LAS float* op = OPS + t * 320 + 4 * j;
        const f32x4 av = *(const LAS f32x4*)(op + 128), kp = *(const LAS f32x4*)(op + 192), rp = *(const LAS f32x4*)(op + 256);
        const f32x4 kr = kp * C.kk_c4; const float ss = row16_sum((kr.x * kr.x + kr.y * kr.y) + (kr.z * kr.z + kr.w * kr.w));
        const f32x4 kkv = kr * (1.f / fmaxf(sqrtf(ss), 1e-12f));
        const f32x4 km = kp * ((av - 1.f) * C.ka_c4 + 1.f);
        const f32x4 q = rp * km * C.rk_c4; const float cs = row16_sum((q.x + q.y) + (q.z + q.w));
        if (ok) { *(LAS f32x4*)(op + 64) = kkv; *(LAS f32x4*)(op + 128) = kkv * (-av); *(LAS f32x4*)(op + 192) = km;
            if (C.dir == 0 && C.qtr == 0 && j == 0) C.CT[(C.mb + T0 + t) * 8 + C.h] = cs; } }
}

constexpr int RW_NSLOT = 6, RW_SLOT_WORDS = 32 * 320 + 32 * 64;
constexpr size_t WS_RING = 248 * MiB;
constexpr int CW_RW = 8192;
__device__ __forceinline__ unsigned rw_ld(unsigned* p) { return __hip_atomic_load(p, __ATOMIC_RELAXED, __HIP_MEMORY_SCOPE_AGENT); }
__device__ __forceinline__ void rw_st(unsigned* p, unsigned v) { __hip_atomic_store(p, v, __ATOMIC_RELAXED, __HIP_MEMORY_SCOPE_AGENT); }
__device__ __forceinline__ void rwkv_produce(const Frame& F, int l, int p) {
    const int b = p / 12, rem = p % 12, h = rem >> 1, dir = rem & 1;
    const bf16* cols = (const bf16*)(WSP(F) + WS_COLS);
    const int tid = F.tid, lane = F.lane, wave = F.wave;
    LAS bf16* WA = (LAS bf16*)(F.lds); LAS bf16* WW = (LAS bf16*)(F.lds + 9216);
    LAS float* MU = (LAS float*)(F.lds + 67584);
    LAS float* OPS = (LAS float*)(F.lds + 70144);
    LAS float* VV = (LAS float*)(F.lds + 111104);
    LAS unsigned* flg = (LAS unsigned*)(F.lds + 119296);
    unsigned* ctl = (unsigned*)(WSP(F) + WS_CTL) + CW_RW + 320 * p;
    unsigned long long* ring = (unsigned long long*)(WSP(F) + WS_RING) + (size_t)p * RW_NSLOT * (RW_SLOT_WORDS / 2);
    constexpr int NB = SEQ / 32;
    __syncthreads();
    { const float* aup = INP(F, 13) + (size_t)l * 64 * 384; const float* wup = INP(F, 11) + (size_t)(l * 2 + dir) * 64 * 384;
      for (int idx = tid; idx < 4096; idx += 512) { const int i = idx >> 6, c = idx & 63;
          WA[c * 72 + i] = (bf16)f2bf(aup[i * 384 + h * 64 + c]); WW[c * 72 + i] = (bf16)f2bf(wup[i * 384 + h * 64 + c]); }
      if (tid < 320) { const int which = tid >> 6, c = tid & 63;
          const int rc = which == 0 ? h * 64 + c : which == 1 ? 384 + h * 64 + c : which == 2 ? 768 + h * 64 + c : which == 3 ? 1152 + dir * 64 + c : 1280 + c;
          MU[tid] = INP(F, 8)[l * 1472 + rc]; MU[320 + tid] = INP(F, 9)[l * 1472 + rc]; } }
    __syncthreads();
    const size_t mb = (size_t)b * SEQ;
    const int j = lane & 15;
    RwCtx C;
    C.WA = WA; C.WW = WW; C.XA = (LAS bf16*)(F.lds + 18432) + wave * 576; C.XW = (LAS bf16*)(F.lds + 27648) + wave * 576;
    C.RAWB = (LAS bf16*)(F.lds + 36864) + wave * 1920;
    C.MU = MU; C.CT = (float*)(WSP(F) + WS_CT); C.colsb = cols + mb * NINP; C.h = h; C.dir = dir; C.qtr = 0; C.mb = mb; C.tb0 = 4 * wave;
    { const int hc4 = h * 64 + 4 * j;
      C.kk_c4 = *(const f32x4*)(INP(F, 15) + l * 384 + hc4); C.ka_c4 = *(const f32x4*)(INP(F, 16) + l * 384 + hc4); C.rk_c4 = *(const f32x4*)(INP(F, 17) + l * 384 + hc4);
#pragma unroll
      for (int ct = 0; ct < 4; ++ct) { C.ba[ct] = INP(F, 12)[l * 384 + h * 64 + 16 * ct + j]; C.bw[ct] = INP(F, 10)[(l * 2 + dir) * 384 + h * 64 + 16 * ct + j]; }
      const int c2 = (lane & 31) * 2;
#pragma unroll
      for (int wq = 0; wq < 5; ++wq) { C.mup_[wq][0] = MU[wq * 64 + c2]; C.mup_[wq][1] = MU[wq * 64 + c2 + 1]; C.mun_[wq][0] = MU[320 + wq * 64 + c2]; C.mun_[wq][1] = MU[320 + wq * 64 + c2 + 1]; } }
    v4u pre[5]; int poff[5], prr[5];
    rw_addr_init<4>(poff, prr, lane, C.tb0, h, dir);
    rw_issue<4>(pre, poff, prr, C.colsb, dir ? SEQ - 32 : 0);
    const unsigned G0 = (unsigned)l * NB;
    bool dead = false; unsigned mseen = G0;
#pragma unroll 1
    for (int it = 0; it < NB; ++it) {
        const int T0 = dir ? SEQ - 32 * (it + 1) : 32 * it;
        v4u cur[5];
#pragma unroll
        for (int i = 0; i < 5; ++i) cur[i] = pre[i];
        if (it + 1 < NB) rw_issue<4>(pre, poff, prr, C.colsb, dir ? SEQ - 32 * (it + 2) : 32 * (it + 1));
        rw_prep<4, true>(C, cur, OPS, VV, T0, lane);
        if (tid == 0) { const unsigned need = G0 + (unsigned)it + 1u; unsigned sp = 0u;
            if (need > (unsigned)RW_NSLOT && !dead) { const unsigned want = need - (unsigned)RW_NSLOT;
                while (mseen < want) { if (++sp > (1u << 17)) { dead = true; break; } __builtin_amdgcn_s_sleep(2);
                    const unsigned m01 = min(rw_ld(ctl + 64), rw_ld(ctl + 128)), m23 = min(rw_ld(ctl + 192), rw_ld(ctl + 256)); mseen = min(m01, m23); } }
            flg[0] = sp; }
        __syncthreads();
        { unsigned long long* slot = ring + (size_t)((G0 + (unsigned)it) % RW_NSLOT) * (RW_SLOT_WORDS / 2);
          const LAS v4u* src = (const LAS v4u*)OPS;
#pragma unroll
          for (int i = 0; i < 6; ++i) { const int idx = tid + 512 * i; const v4u d = src[idx]; v4u* dst = (v4u*)slot + idx;
              asm volatile("global_store_dwordx4 %0, %1, off sc1\n\ts_nop 1" :: "v"(dst), "v"(d) : "memory"); } }
        asm volatile("s_waitcnt vmcnt(6)" ::: "memory");
        __syncthreads();
        if (tid == 0 && it >= 1) rw_st(ctl, G0 + (unsigned)it);
    }
    asm volatile("s_waitcnt vmcnt(0)" ::: "memory");
    __syncthreads();
    if (tid == 0) rw_st(ctl, G0 + (unsigned)NB);
    __syncthreads();
}
__device__ __forceinline__ void rwkv_scan(const Frame& F, int l, int p, int qtr) {
    const int b = p / 12, rem = p % 12, h = rem >> 1, dir = rem & 1;
    bf16* Y = (bf16*)(WSP(F) + (dir ? Y_RB : Y_RF));
    const int lane = F.lane, wave = F.wave;
    LAS float* OPSb = (LAS float*)(F.lds);
    LAS float* VVb = (LAS float*)(F.lds + 81920);
    LAS float* YBb = (LAS float*)(F.lds + 86016);
    unsigned* ctl = (unsigned*)(WSP(F) + WS_CTL) + CW_RW + 320 * p;
    const unsigned long long* ring = (const unsigned long long*)(WSP(F) + WS_RING) + (size_t)p * RW_NSLOT * (RW_SLOT_WORDS / 2);
    constexpr int NB = SEQ / 32;
    const size_t mb = (size_t)b * SEQ;
    const int j = lane & 15;
    const unsigned G0 = (unsigned)l * NB;
    __syncthreads();
    if (wave < 4) {
        const int lt = wave * 64 + lane;
        bool dead = false; unsigned pseen = G0;
#pragma unroll 1
        for (int it = 0; it <= NB; ++it) {
            if (it >= 1 && lt == 0) rw_st(ctl + 64 * (qtr + 1), G0 + (unsigned)it);
            if (it < NB) {
                const unsigned need = G0 + (unsigned)it + 1u; unsigned sp = 0u;
                if (!dead) { while (pseen < need) { pseen = rw_ld(ctl); if (pseen >= need) break; if (++sp > (1u << 17)) { dead = true; break; } __builtin_amdgcn_s_sleep(2); } }
                const unsigned long long* slot = ring + (size_t)((G0 + (unsigned)it) % RW_NSLOT) * (RW_SLOT_WORDS / 2);
                LAS unsigned long long* dO = (LAS unsigned long long*)(OPSb + (it & 1) * 10240); LAS unsigned long long* dV = (LAS unsigned long long*)(VVb + (it & 1) * 512);
                unsigned long long v[21];
#pragma unroll
                for (int i = 0; i < 20; ++i) v[i] = __hip_atomic_load(slot + lt + 256 * i, __ATOMIC_RELAXED, __HIP_MEMORY_SCOPE_AGENT);
                v[20] = __hip_atomic_load(slot + 5120 + (lt >> 3) * 32 + qtr * 8 + (lt & 7), __ATOMIC_RELAXED, __HIP_MEMORY_SCOPE_AGENT);
#pragma unroll
                for (int i = 0; i < 20; ++i) dO[lt + 256 * i] = v[i];
                dV[lt] = v[20];
            }
            if (it >= 2) { const int bk = it - 2; const int T0 = dir ? SEQ - 32 * (bk + 1) : 32 * bk; const LAS float* YB = YBb + (bk & 1) * 512;
                const int idx = lt * 2, tl = idx >> 4, rw = idx & 15;
                *(unsigned*)(Y + (mb + T0 + tl) * 384 + h * 64 + 16 * qtr + rw) = pk2(YB[idx], YB[idx + 1]); }
            __syncthreads();
        }
        { const int bk = NB - 1; const int T0 = dir ? SEQ - 32 * (bk + 1) : 32 * bk; const LAS float* YB = YBb + (bk & 1) * 512;
          const int idx = lt * 2, tl = idx >> 4, rw = idx & 15;
          *(unsigned*)(Y + (mb + T0 + tl) * 384 + h * 64 + 16 * qtr + rw) = pk2(YB[idx], YB[idx + 1]); }
    } else {
        const int row = (wave - 4) * 4 + (lane >> 4);
        f32x4 S = {0.f, 0.f, 0.f, 0.f};
#pragma unroll 1
        for (int it = 0; it <= NB; ++it) {
            if (it >= 1) { const int bk = it - 1;
                const LAS float* OPS = OPSb + (bk & 1) * 10240; const LAS float* VV = VVb + (bk & 1) * 512; LAS float* YB = YBb + (bk & 1) * 512;
                if (dir) rwkv_steps<true>(OPS, VV, YB, S, j, row); else rwkv_steps<false>(OPS, VV, YB, S, j, row);
            }
            __syncthreads();
        }
    }
    __syncthreads();
}
__device__ __forceinline__ float row8_sum(float v) { v += dppf<0xB1>(v); v += dppf<0x4E>(v); v += dppf<0x141>(v); return v; }
__device__ __forceinline__ void mlstm_seq(const Frame& F, int l, int task, int cfull0, int cend) {
    const int b = task >> 3, h = (task >> 1) & 3, dir = task & 1;
    const bf16* cols = (const bf16*)(WSP(F) + WS_COLS); const float* GT = (const float*)(WSP(F) + WS_GATES);
    bf16* Y = (bf16*)(WSP(F) + (dir ? Y_AB : Y_AF));
    LAS bf16* RAWQ = (LAS bf16*)(F.lds);
    LAS bf16* Qs = (LAS bf16*)(F.lds + 17408); LAS bf16* Ks = (LAS bf16*)(F.lds + 26624);
    LAS bf16* Vtb = (LAS bf16*)(F.lds + 35840);
    LAS bf16* KWt = (LAS bf16*)(F.lds + 54272); LAS bf16* Ps = (LAS bf16*)(F.lds + 63488);
    LAS bf16* Ctb = (LAS bf16*)(F.lds + 72704);
    LAS float* ub = (LAS float*)(F.lds + 91136);
    LAS float* blb = ub + 128; LAS float* rmb = ub + 256;
    LAS float* den = ub + 384; LAS float* qn = ub + 448; LAS float* nst = ub + 512; LAS float* scb = ub + 576;
    const int tid = F.tid, lane = F.lane, wave = F.wave;
    const size_t mb = (size_t)b * SEQ;
    constexpr int NC = SEQ / 64;
    __syncthreads();
    for (int i = tid; i < 2 * 64 * 72; i += 512) Ctb[i] = 0;
    if (tid < 64) nst[tid] = 0.f;
    const int cc = tid & 127, isK = cc >> 6, d0 = cc & 63, chn = isK * 256 + h * 64 + d0;
    float cw[5]; const float* cwp = INP(F, 3) + (size_t)l * 5 * 512;
#pragma unroll
    for (int jj = 0; jj < 5; ++jj) cw[jj] = cwp[jj * 512 + chn];
    const float cbv = INP(F, 4)[l * 512 + chn];
    f32x4 st[2] = {{0.f, 0.f, 0.f, 0.f}, {0.f, 0.f, 0.f, 0.f}};
    float m_st = 0.f;
    v4u pre[3], prev; float gli = 0.f, glf = 0.f;
#define ML_ISSUE(c_) do { const int tlo_ = dir ? SEQ - 64 * ((c_) + 1) : 64 * (c_); _Pragma("unroll") for (int i_ = 0; i_ < 3; ++i_) { const int ch_ = tid + 512 * i_; pre[i_] = (v4u){0u, 0u, 0u, 0u}; \
        if (ch_ < 68 * 16) { const int rr_ = ch_ >> 4, q_ = ch_ & 15; const int t_ = tlo_ - 2 + rr_; if (t_ >= 0 && t_ < SEQ) pre[i_] = *(const v4u*)(cols + (mb + t_) * NINP + (q_ >> 3) * 256 + h * 64 + (q_ & 7) * 8); } } \
        prev = *(const v4u*)(cols + (mb + tlo_ + (tid >> 3)) * NINP + A_V + h * 64 + (tid & 7) * 8); \
        if (tid < 64) { const int t_ = dir ? tlo_ + 63 - tid : tlo_ + tid; gli = GT[(mb + t_) * 16 + dir * 4 + h]; glf = GT[(mb + t_) * 16 + 8 + dir * 4 + h]; } } while (0)
#define ML_FILL(c_) do { _Pragma("unroll") for (int i_ = 0; i_ < 3; ++i_) { const int ch_ = tid + 512 * i_; if (ch_ < 68 * 16) *(LAS v4u*)(RAWQ + (ch_ >> 4) * 128 + (ch_ & 15) * 8) = pre[i_]; } \
        { LAS bf16* Vt_ = Vtb + ((c_) & 1) * 4608; const int tl_ = tid >> 3, e8_ = tid & 7; const int lp_ = dir ? 63 - tl_ : tl_; const unsigned w_[4] = {prev.x, prev.y, prev.z, prev.w}; \
          _Pragma("unroll") for (int k_ = 0; k_ < 4; ++k_) { const int e_ = e8_ * 8 + 2 * k_; Vt_[e_ * 72 + swz64(e_, lp_)] = (bf16)(w_[k_] & 0xffffu); Vt_[(e_ + 1) * 72 + swz64(e_ + 1, lp_)] = (bf16)(w_[k_] >> 16); } } \
        if (tid < 64) { float bl_ = glf; _Pragma("unroll") for (int o_ = 1; o_ < 64; o_ <<= 1) { const float x_ = __shfl_up(bl_, o_); if (lane >= o_) bl_ += x_; } \
            const float u_ = gli - bl_; float rm_ = u_; _Pragma("unroll") for (int o_ = 1; o_ < 64; o_ <<= 1) { const float x_ = __shfl_up(rm_, o_); if (lane >= o_) rm_ = fmaxf(rm_, x_); } \
            ub[((c_) & 1) * 64 + tid] = u_; blb[((c_) & 1) * 64 + tid] = bl_; rmb[((c_) & 1) * 64 + tid] = rm_; if (tid == 63) { scb[((c_) & 1) * 2] = rm_; scb[((c_) & 1) * 2 + 1] = bl_; } } } while (0)
    ML_ISSUE(0); ML_FILL(0); ML_ISSUE(1);
    __syncthreads();
#pragma unroll 1
    for (int c = 0; c < cend; ++c) {
        const bool full = c >= cfull0;
        const int tlo = dir ? SEQ - 64 * (c + 1) : 64 * c;
        const LAS float* u = ub + (c & 1) * 64; const LAS float* bl = blb + (c & 1) * 64; const LAS float* rm = rmb + (c & 1) * 64;
        const LAS bf16* Vt = Vtb + (c & 1) * 4608; const LAS bf16* Ct = Ctb + (c & 1) * 4608; LAS bf16* Ctn = Ctb + ((c + 1) & 1) * 4608;
#pragma unroll 4
        for (int i = 0; i < 16; ++i) { const int tl = (tid >> 7) + 4 * i; float s = cbv;
#pragma unroll
            for (int jj = 0; jj < 5; ++jj) s += cw[jj] * bf2f(RAWQ[(tl + jj) * 128 + cc]);
            s = siluf_(s); const int lpos = dir ? 63 - tl : tl;
            if (isK) Ks[lpos * 72 + d0] = (bf16)f2bf(s * 0.125f); else Qs[lpos * 72 + d0] = (bf16)f2bf(s); }
        if (tid < 64) den[tid] = 0.f;
        __syncthreads();
        const float umax = scb[(c & 1) * 2], tot = scb[(c & 1) * 2 + 1];
        for (int idx = tid; idx < 4096; idx += 512) { const int lp = idx >> 6, d = idx & 63; KWt[d * 72 + swz64(d, lp)] = (bf16)f2bf(bf2f(Ks[lp * 72 + d]) * __expf(u[lp] - umax)); }
        if (full) {
#pragma unroll
        for (int k = 0; k < 2; ++k) { const int ti = 2 * wave + k, tl_ = ti >> 2, ts = ti & 3; f32x4 acc = {0.f, 0.f, 0.f, 0.f};
            if (ts <= tl_) acc = mma16<64>(Qs + tl_ * 16 * 72, 72, Ks + ts * 16 * 72, 72, acc, lane);
#pragma unroll
            for (int jj = 0; jj < 4; ++jj) { const int lr = tl_ * 16 + (lane >> 4) * 4 + jj, s = ts * 16 + (lane & 15);
                const float v = (s <= lr) ? acc[jj] * __expf(u[s] - fmaxf(m_st, rm[lr])) : 0.f; const unsigned vb = f2bf(v); Ps[lr * 72 + s] = (bf16)vb;
                if (ts <= tl_) { const float rs = row16_sum(bf2f(vb)); if ((lane & 15) == 0) __hip_atomic_fetch_add(den + lr, rs, __ATOMIC_RELAXED, __HIP_MEMORY_SCOPE_WORKGROUP); } } }
        { const int lq = tid >> 3, part = tid & 7; float s = 0.f;
#pragma unroll
          for (int k = 0; k < 8; ++k) s += bf2f(Qs[lq * 72 + part * 8 + k]) * nst[part * 8 + k];
          s = row8_sum(s); if (part == 0) qn[lq] = s; }
        }
        __syncthreads();
        const float mmax = fmaxf(m_st, umax), s_old = __expf(m_st - mmax), s_new = __expf(umax - mmax);
#pragma unroll
        for (int k = 0; k < 2; ++k) { const int ti = 2 * wave + k, t0_ = ti >> 2, t1_ = ti & 3; const f32x4 z = {0.f, 0.f, 0.f, 0.f};
            f32x4 a1 = z, a2 = z;
            if (full) { a1 = mma16s<false, true>(Ps, 72, t0_ * 16, Vt, 72, t1_ * 16, z, lane); a2 = mma16<64>(Qs + t0_ * 16 * 72, 72, Ct + t1_ * 16 * 72, 72, z, lane); }
            const f32x4 lc = mma16s<true, true>(Vt, 72, t0_ * 16, KWt, 72, t1_ * 16, z, lane);
#pragma unroll
            for (int jj = 0; jj < 4; ++jj) { const int r_ = t0_ * 16 + (lane >> 4) * 4 + jj, c_ = t1_ * 16 + (lane & 15);
                if (full) { const float mx = fmaxf(m_st, rm[r_]), iwv = __expf(m_st - mx);
                const float dn = den[r_] + iwv * qn[r_];
                const float val = (a1[jj] + iwv * a2[jj]) / fmaxf(fabsf(dn), __expf(-(bl[r_] + mx)));
                const int t = dir ? tlo + 63 - r_ : tlo + r_;
                Y[(mb + t) * 256 + h * 64 + c_] = (bf16)f2bf(val); }
                st[k][jj] = s_old * st[k][jj] + s_new * lc[jj];
                Ctn[r_ * 72 + c_] = (bf16)f2bf(st[k][jj]); } }
        { const int dq = tid >> 3, part = tid & 7; float s = 0.f;
#pragma unroll
          for (int k = 0; k < 8; ++k) s += bf2f(KWt[dq * 72 + swz64(dq, part * 8) + k]);
          s = row8_sum(s); if (part == 0) nst[dq] = s_old * nst[dq] + s_new * s; }
        m_st = tot + mmax;
        if (c + 1 < cend) { ML_FILL(c + 1); if (c + 2 < cend) ML_ISSUE(c + 2); }
        __syncthreads();
    }
#undef ML_ISSUE
#undef ML_FILL
}
__device__ __forceinline__ void phase_ssd_conv(const Frame& F, int l) {
    const bf16* cols = (const bf16*)(WSP(F) + WS_COLS); bf16* XBC = (bf16*)(WSP(F) + WS_XN);
    LAS bf16* raw = (LAS bf16*)(F.lds);
    const float* cwp = INP(F, 20) + (size_t)l * 5 * 896; const float* cbp = INP(F, 21) + l * 896;
    const int tid = F.tid;
    float cw0[5], cw1[5]; const int c1 = tid + 512 < 896 ? tid + 512 : tid;
#pragma unroll
    for (int jj = 0; jj < 5; ++jj) { cw0[jj] = cwp[jj * 896 + tid]; cw1[jj] = cwp[jj * 896 + c1]; }
    const float cb0 = cbp[tid], cb1 = cbp[c1];
    for (int tile = F.vcu; tile < M / 32; tile += F.G) {
        const int m0 = tile * 32, t0 = m0 % SEQ;
        __syncthreads();
        for (int ch = tid; ch < 36 * 112; ch += 512) { const int rr = ch / 112, cc = ch % 112; const int t = t0 - 2 + rr;
            v4u v = {0u, 0u, 0u, 0u}; if (t >= 0 && t < SEQ) v = *(const v4u*)(cols + (size_t)(m0 - 2 + rr) * NINP + S_X + cc * 8);
            *(LAS v4u*)(raw + rr * 896 + cc * 8) = v; }
        __syncthreads();
#pragma unroll
        for (int half = 0; half < 2; ++half) { const int c = half ? c1 : tid; if (half && tid + 512 >= 896) break;
            float win[5];
#pragma unroll
            for (int jj = 0; jj < 4; ++jj) win[jj] = bf2f(raw[jj * 896 + c]);
            for (int tl = 0; tl < 32; ++tl) { win[4] = bf2f(raw[(tl + 4) * 896 + c]);
                float s = half ? cb1 : cb0;
#pragma unroll
                for (int jj = 0; jj < 5; ++jj) s += (half ? cw1[jj] : cw0[jj]) * win[jj];
#pragma unroll
                for (int jj = 0; jj < 4; ++jj) win[jj] = win[jj + 1];
                XBC[(size_t)(m0 + tl) * 896 + c] = (bf16)f2bf(siluf_(s)); } }
    }
    __syncthreads();
}
__device__ __forceinline__ void ssd_seq(const Frame& F, int l, int task, int cfull0, int cend) {
    const int b = task / 12, rem = task % 12, head = rem >> 1, dir = rem & 1, g = head / 3;
    const bf16* cols = (const bf16*)(WSP(F) + WS_COLS); const bf16* XBC = (const bf16*)(WSP(F) + WS_XN);
    bf16* Y = (bf16*)(WSP(F) + (dir ? Y_SB : Y_SF));
    LAS bf16* Cm = (LAS bf16*)(F.lds); LAS bf16* Bm = (LAS bf16*)(F.lds + 17408);
    LAS bf16* Btw = (LAS bf16*)(F.lds + 34816); LAS bf16* Xt = (LAS bf16*)(F.lds + 53248);
    LAS bf16* Ps = (LAS bf16*)(F.lds + 62464); LAS bf16* Hs = (LAS bf16*)(F.lds + 71680);
    LAS float* dtvb = (LAS float*)(F.lds + 89088);
    LAS float* acsb = dtvb + 128;
    LAS float* totb = dtvb + 256;
    const int tid = F.tid, lane = F.lane, wave = F.wave;
    const size_t mb = (size_t)b * SEQ;
    constexpr int NC = SEQ / 64;
    __syncthreads();
    for (int i = tid; i < 64 * 136; i += 512) Hs[i] = 0;
    const float dtb = INP(F, 22)[(l * 2 + dir) * 6 + head];
    const float aneg = -__expf(INP(F, 23)[(l * 2 + dir) * 6 + head]);
    f32x4 st[4];
#pragma unroll
    for (int k = 0; k < 4; ++k) st[k] = (f32x4){0.f, 0.f, 0.f, 0.f};
    v4u pre[5]; float dtraw = 0.f;
#define SSD_ISSUE(c_) do { const int tlo_ = dir ? SEQ - 64 * ((c_) + 1) : 64 * (c_); _Pragma("unroll") for (int i_ = 0; i_ < 5; ++i_) { const int idx_ = tid + 512 * i_; const int tl_ = idx_ / 40, q_ = idx_ % 40; \
        const int gc_ = q_ < 8 ? head * 64 + q_ * 8 : (q_ < 24 ? 384 + g * 128 + (q_ - 8) * 8 : 640 + g * 128 + (q_ - 24) * 8); \
        pre[i_] = *(const v4u*)(XBC + (mb + tlo_ + tl_) * 896 + gc_); } } while (0)
#define SSD_DTLOAD(c_) do { if (tid < 64) { const int tlo_ = dir ? SEQ - 64 * ((c_) + 1) : 64 * (c_); const int t_ = dir ? tlo_ + 63 - tid : tlo_ + tid; dtraw = bf2f(cols[(mb + t_) * NINP + S_DT + dir * 6 + head]); } } while (0)
#define SSD_DTCALC(c_) do { if (tid < 64) { const float x_ = dtraw + dtb; const float dt_ = x_ > 20.f ? x_ : log1pf(__expf(x_)); float cs_ = dt_ * aneg; \
        _Pragma("unroll") for (int o_ = 1; o_ < 64; o_ <<= 1) { const float u_ = __shfl_up(cs_, o_); if (lane >= o_) cs_ += u_; } \
        const float tt_ = __shfl(cs_, 63); dtvb[((c_) & 1) * 64 + tid] = dt_; acsb[((c_) & 1) * 64 + tid] = cs_; if (tid == 0) totb[(c_) & 1] = tt_; } } while (0)
    SSD_ISSUE(0); SSD_DTLOAD(0); SSD_DTCALC(0); SSD_DTLOAD(1);
    __syncthreads();
#pragma unroll 1
    for (int c = 0; c < cend; ++c) {
        const bool full = c >= cfull0;
        const int tlo = dir ? SEQ - 64 * (c + 1) : 64 * c;
        const LAS float* dtv = dtvb + (c & 1) * 64; const LAS float* acs = acsb + (c & 1) * 64; const float tot = totb[c & 1];
#pragma unroll
        for (int i = 0; i < 5; ++i) { const int idx = tid + 512 * i; const int tl = idx / 40, q = idx % 40; const int lp = dir ? 63 - tl : tl;
            const unsigned w[4] = {pre[i].x, pre[i].y, pre[i].z, pre[i].w};
            if (q < 8) {
#pragma unroll
                for (int k = 0; k < 4; ++k) { const int p0 = q * 8 + 2 * k; Xt[p0 * 72 + swz64(p0, lp)] = (bf16)(w[k] & 0xffffu); Xt[(p0 + 1) * 72 + swz64(p0 + 1, lp)] = (bf16)(w[k] >> 16); } }
            else if (q < 24) { const int n0 = (q - 8) * 8; if (full) *(LAS v4u*)(Bm + lp * 136 + n0) = pre[i]; const float sc = dtv[lp] * __expf(tot - acs[lp]);
#pragma unroll
                for (int k = 0; k < 4; ++k) { const int nn = n0 + 2 * k; Btw[nn * 72 + swz64(nn, lp)] = (bf16)f2bf(bf2f(w[k] & 0xffffu) * sc); Btw[(nn + 1) * 72 + swz64(nn + 1, lp)] = (bf16)f2bf(bf2f(w[k] >> 16) * sc); } }
            else if (full) { const int n0 = (q - 24) * 8; *(LAS v4u*)(Cm + lp * 136 + n0) = pre[i]; } }
        if (c + 1 < cend) SSD_ISSUE(c + 1);
        __syncthreads();
        f32x4 yo[2] = {{0.f, 0.f, 0.f, 0.f}, {0.f, 0.f, 0.f, 0.f}}, lc[4];
        if (full) {
#pragma unroll
        for (int k = 0; k < 2; ++k) { const int ti = 2 * wave + k, tl_ = ti >> 2, ts = ti & 3; f32x4 acc = {0.f, 0.f, 0.f, 0.f};
            if (ts <= tl_) acc = mma16<128>(Cm + tl_ * 16 * 136, 136, Bm + ts * 16 * 136, 136, acc, lane);
#pragma unroll
            for (int jj = 0; jj < 4; ++jj) { const int lr = tl_ * 16 + (lane >> 4) * 4 + jj, s = ts * 16 + (lane & 15);
                const float v = (s <= lr) ? acc[jj] * __expf(acs[lr] - acs[s]) * dtv[s] : 0.f; Ps[lr * 72 + s] = (bf16)f2bf(v); }
            const f32x4 z = {0.f, 0.f, 0.f, 0.f};
            yo[k] = mma16<128>(Cm + tl_ * 16 * 136, 136, Hs + ts * 16 * 136, 136, z, lane); }
        }
#pragma unroll
        for (int k = 0; k < 4; ++k) { const int ti = 4 * wave + k, tp = ti >> 3, tn = ti & 7; const f32x4 z = {0.f, 0.f, 0.f, 0.f};
            lc[k] = mma16s<true, true>(Xt, 72, tp * 16, Btw, 72, tn * 16, z, lane); }
        __syncthreads();
        const float cdec = __expf(tot);
        if (full) {
#pragma unroll
        for (int k = 0; k < 2; ++k) { const int ti = 2 * wave + k, tl_ = ti >> 2, tp = ti & 3; const f32x4 z = {0.f, 0.f, 0.f, 0.f};
            const f32x4 yd = mma16s<false, true>(Ps, 72, tl_ * 16, Xt, 72, tp * 16, z, lane);
#pragma unroll
            for (int jj = 0; jj < 4; ++jj) { const int lr = tl_ * 16 + (lane >> 4) * 4 + jj, p = tp * 16 + (lane & 15);
                const float val = yd[jj] + yo[k][jj] * __expf(acs[lr]);
                const int t = dir ? tlo + 63 - lr : tlo + lr;
                Y[(mb + t) * 384 + head * 64 + p] = (bf16)f2bf(val); } }
        }
#pragma unroll
        for (int k = 0; k < 4; ++k) { const int ti = 4 * wave + k, tp = ti >> 3, tn = ti & 7;
#pragma unroll
            for (int jj = 0; jj < 4; ++jj) { const int p = tp * 16 + (lane >> 4) * 4 + jj, n = tn * 16 + (lane & 15);
                st[k][jj] = cdec * st[k][jj] + lc[k][jj]; Hs[p * 136 + n] = (bf16)f2bf(st[k][jj]); } }
        if (c + 1 < cend) { SSD_DTCALC(c + 1); if (c + 2 < cend) SSD_DTLOAD(c + 2); }
        __syncthreads();
    }
#undef SSD_ISSUE
#undef SSD_DTLOAD
#undef SSD_DTCALC
}
__device__ __forceinline__ float wave_sum2(float v) { v = row16_sum(v); v += __shfl_xor(v, 16); v += __shfl_xor(v, 32); return v; }
__device__ __forceinline__ f32x4 bf4(v2u w) { return (f32x4){bf2f(w.x & 0xffffu), bf2f(w.x >> 16), bf2f(w.y & 0xffffu), bf2f(w.y >> 16)}; }
__device__ __forceinline__ v2u pk4(f32x4 v) { v2u w; w.x = pk2(v.x, v.y); w.y = pk2(v.z, v.w); return w; }
__device__ __forceinline__ void phase_post(const Frame& F, int l) {
    const bf16* cols = (const bf16*)(WSP(F) + WS_COLS); bf16* MIX = (bf16*)(WSP(F) + WS_XN);
    const bf16* YAf = (const bf16*)(WSP(F) + Y_AF); const bf16* YAb = (const bf16*)(WSP(F) + Y_AB);
    const bf16* YRf = (const bf16*)(WSP(F) + Y_RF); const bf16* YRb = (const bf16*)(WSP(F) + Y_RB);
    const bf16* YSf = (const bf16*)(WSP(F) + Y_SF); const bf16* YSb = (const bf16*)(WSP(F) + Y_SB);
    const float* CT = (const float*)(WSP(F) + WS_CT);
    LAS bf16* GU = (LAS bf16*)(F.lds);
    LAS bf16* SG = (LAS bf16*)(F.lds + 104448);
    LAS float* gate = (LAS float*)(F.lds + 108800);
    LAS float* SCW = (LAS float*)(F.lds + 133632);
    const int tid = F.tid, lane = F.lane, wave = F.wave;
    const float* mup = INP(F, 8) + l * 1472; const float* mun = INP(F, 9) + l * 1472;
    const float* gup = INP(F, 14) + (size_t)l * 128 * 384;
    const float* sdk = INP(F, 24) + l * 6;
    __syncthreads();
    for (int idx = tid; idx < 128 * 384; idx += 512) { const int i = idx / 384, c = idx % 384; GU[c * 136 + i] = (bf16)f2bf(gup[idx]); }
    { const float* scw = INP(F, 20) + (size_t)l * 5 * 896; for (int idx = tid; idx < 5 * 384; idx += 512) SCW[idx] = scw[(idx / 384) * 896 + (idx % 384)]; }
    const int gch = tid & 15;
    float gmp[8], gmn[8];
#pragma unroll
    for (int k = 0; k < 8; ++k) { gmp[k] = mup[1344 + 8 * gch + k]; gmn[k] = mun[1344 + 8 * gch + k]; }
    const int qa = lane, qb = 64 + (lane & 31);
    const f32x4 mng4 = *(const f32x4*)(INP(F, 7) + l * 256 + 4 * qa);
    f32x4 rmp[2], rmn[2], rng[2], rnb[2], scb[2], sng[2];
#pragma unroll
    for (int ps = 0; ps < 2; ++ps) { const int c0 = 4 * (ps ? qb : qa);
        rmp[ps] = *(const f32x4*)(mup + 768 + c0); rmn[ps] = *(const f32x4*)(mun + 768 + c0);
        rng[ps] = *(const f32x4*)(INP(F, 18) + l * 384 + c0); rnb[ps] = *(const f32x4*)(INP(F, 19) + l * 384 + c0);
        scb[ps] = *(const f32x4*)(INP(F, 21) + l * 896 + c0); sng[ps] = *(const f32x4*)(INP(F, 25) + l * 384 + c0); }
    for (int tile = F.vcu; tile < M / 16; tile += F.G) {
        const int m0 = tile * 16;
        __syncthreads();
        if (tid < 256) { const int tt = tid >> 4; const int m = m0 + tt, t = m % SEQ; const bf16* cp = cols + (size_t)m * NINP + R_GD + 8 * gch;
            const v4u c1 = *(const v4u*)cp; v4u c0 = {0u, 0u, 0u, 0u}, c2 = {0u, 0u, 0u, 0u};
            if (t > 0) c0 = *(const v4u*)(cp - NINP); if (t < SEQ - 1) c2 = *(const v4u*)(cp + NINP);
            const unsigned w0[4] = {c0.x, c0.y, c0.z, c0.w}, w1[4] = {c1.x, c1.y, c1.z, c1.w}, w2[4] = {c2.x, c2.y, c2.z, c2.w}; unsigned o[4];
#pragma unroll
            for (int k = 0; k < 4; ++k) { const float a1 = bf2f(w1[k] & 0xffffu), b1 = bf2f(w1[k] >> 16);
                const float va = a1 + gmp[2 * k] * (bf2f(w0[k] & 0xffffu) - a1) + gmn[2 * k] * (bf2f(w2[k] & 0xffffu) - a1);
                const float vb = b1 + gmp[2 * k + 1] * (bf2f(w0[k] >> 16) - b1) + gmn[2 * k + 1] * (bf2f(w2[k] >> 16) - b1);
                o[k] = pk2(sigmoidf_(va), sigmoidf_(vb)); }
            *(LAS v4u*)(SG + tt * 136 + 8 * gch) = (v4u){o[0], o[1], o[2], o[3]}; }
        __syncthreads();
#pragma unroll
        for (int k = 0; k < 3; ++k) { const int ct = wave + 8 * k; const f32x4 z = {0.f, 0.f, 0.f, 0.f};
            const f32x4 acc = mma16<128>(SG, 136, GU + ct * 16 * 136, 136, z, lane);
#pragma unroll
            for (int jj = 0; jj < 4; ++jj) gate[((lane >> 4) * 4 + jj) * 388 + ct * 16 + (lane & 15)] = acc[jj]; }
        __syncthreads();
#pragma unroll 1
        for (int k = 0; k < 2; ++k) { const int tt = wave * 2 + k; const int m = m0 + tt, t = m % SEQ; const size_t cr = (size_t)m * NINP;
            { const int c0 = 4 * qa;
              const f32x4 hs = bf4(*(const v2u*)(YAf + (size_t)m * 256 + c0)) + bf4(*(const v2u*)(YAb + (size_t)m * 256 + c0));
              const float mean = row16_sum((hs.x + hs.y) + (hs.z + hs.w)) * (1.f / 64.f); const f32x4 d = hs - mean;
              const float var = row16_sum((d.x * d.x + d.y * d.y) + (d.z * d.z + d.w * d.w)) * (1.f / 64.f);
              const f32x4 o = bf4(*(const v2u*)(cols + cr + A_O + c0));
              f32x4 y = d * (1.f / sqrtf(var + 1e-6f)) * mng4;
              y.x *= sigmoidf_(o.x); y.y *= sigmoidf_(o.y); y.z *= sigmoidf_(o.z); y.w *= sigmoidf_(o.w);
              *(v2u*)(MIX + (size_t)m * DM + c0) = pk4(y); }
#pragma unroll
            for (int ps = 0; ps < 2; ++ps) { const int qd = ps ? qb : qa, c0 = 4 * qd; const bool act = ps == 0 || lane < 32;
              const f32x4 ys = bf4(*(const v2u*)(YRf + (size_t)m * 384 + c0)) + bf4(*(const v2u*)(YRb + (size_t)m * 384 + c0));
              const float mean = row16_sum((ys.x + ys.y) + (ys.z + ys.w)) * (1.f / 64.f); const f32x4 d = ys - mean;
              const float var = row16_sum((d.x * d.x + d.y * d.y) + (d.z * d.z + d.w * d.w)) * (1.f / 64.f);
              const f32x4 y = d * (1.f / sqrtf(var + 64e-5f)) * rng[ps] + rnb[ps];
              const f32x4 p1 = bf4(*(const v2u*)(cols + cr + R_V + c0));
              f32x4 p0 = {0.f, 0.f, 0.f, 0.f}, p2 = {0.f, 0.f, 0.f, 0.f};
              if (t > 0) p0 = bf4(*(const v2u*)(cols + cr - NINP + R_V + c0)); if (t < SEQ - 1) p2 = bf4(*(const v2u*)(cols + cr + NINP + R_V + c0));
              const f32x4 vv = p1 + rmp[ps] * (p0 - p1) + rmn[ps] * (p2 - p1);
              const float ctv = CT[(size_t)m * 8 + (qd >> 4)];
              const f32x4 g4 = *(const LAS f32x4*)(gate + tt * 388 + c0);
              if (act) *(v2u*)(MIX + (size_t)m * DM + 256 + c0) = pk4((y + vv * ctv) * g4); }
            f32x4 yv[2]; float ssq0 = 0.f, ssq1 = 0.f;
#pragma unroll
            for (int ps = 0; ps < 2; ++ps) { const int qd = ps ? qb : qa, c0 = 4 * qd; const bool act = ps == 0 || lane < 32;
              f32x4 s = scb[ps];
#pragma unroll
              for (int jj = 0; jj < 5; ++jj) { const int tq = t + jj - 2; if (tq >= 0 && tq < SEQ) s += *(const LAS f32x4*)(SCW + jj * 384 + c0) * bf4(*(const v2u*)(cols + cr + (jj - 2) * NINP + S_X + c0)); }
              const f32x4 z = bf4(*(const v2u*)(cols + cr + S_Z + c0));
              f32x4 y = bf4(*(const v2u*)(YSf + (size_t)m * 384 + c0)) + bf4(*(const v2u*)(YSb + (size_t)m * 384 + c0));
              const float dsk = sdk[qd >> 4];
              y.x = (y.x + dsk * siluf_(s.x)) * siluf_(z.x); y.y = (y.y + dsk * siluf_(s.y)) * siluf_(z.y); y.z = (y.z + dsk * siluf_(s.z)) * siluf_(z.z); y.w = (y.w + dsk * siluf_(s.w)) * siluf_(z.w);
              yv[ps] = y; const float sq = act ? (y.x * y.x + y.y * y.y) + (y.z * y.z + y.w * y.w) : 0.f;
              if (qd < 48) ssq0 += sq; else ssq1 += sq; }
            const float r0 = 1.f / sqrtf(wave_sum2(ssq0) * (1.f / 192.f) + 1e-6f), r1 = 1.f / sqrtf(wave_sum2(ssq1) * (1.f / 192.f) + 1e-6f);
#pragma unroll
            for (int ps = 0; ps < 2; ++ps) { const int qd = ps ? qb : qa, c0 = 4 * qd; const bool act = ps == 0 || lane < 32;
              if (act) *(v2u*)(MIX + (size_t)m * DM + 640 + c0) = pk4(yv[ps] * (qd < 48 ? r0 : r1) * sng[ps]); }
        }
    }
    __syncthreads();
}
namespace cg = cooperative_groups;
constexpr int N_PHASES = 9 * DEPTH + 1;
__global__ void __launch_bounds__(NWAVES * 64, 2) mk_fwd(Args args) {
    extern __shared__ __attribute__((aligned(16))) unsigned char lds_raw[];
    Frame F;
    F.lds = (LAS unsigned char*)lds_raw;
    F.tid = threadIdx.x; F.lane = F.tid & 63; F.wave = __builtin_amdgcn_readfirstlane(F.tid >> 6);
    F.G = gridDim.x; { const int bx = blockIdx.x; F.vcu = (F.G % 8 == 0) ? (bx % 8) * (F.G / 8) + bx / 8 : bx; }
    volatile LAS unsigned* MISC = (volatile LAS unsigned*)(F.lds + MISC_OFF);
    if (F.tid < 64) MISC[F.tid] = 0u;
    if (F.tid < 34) *(LAS unsigned long long*)(F.lds + PTAB_OFF + 8 * F.tid) = ((const unsigned long long*)__builtin_amdgcn_kernarg_segment_ptr())[F.tid];
    __syncthreads();
    unsigned* ctl = (unsigned*)(WSP(F) + WS_CTL);
    XcdBarrier bar = xcd_barrier_post(ctl + CW_BAR, MISC + 8);
    const int lo = args.ph_lo, hi = args.ph_hi;
#define IN_(k) (lo <= (k) && (k) < hi)
#define SEAM(k) do { if (IN_(k) && IN_((k) + 1)) { if ((k) == 0) cg::this_grid().sync(); else xcd_barrier(bar); } } while (0)
#define LAYER(l, B) \
    if (IN_(B + 0)) { phase_convert(F, l); phase_norm(F, l == 0 ? INP(F, 0) : OUTP(F), INP(F, 1) + l * DM, (bf16*)(WSP(F) + WS_XN)); } SEAM(B + 0); \
    if (IN_(B + 1)) { unsigned char* ws = WSP(F); pg8::Gemm g{(const bf16*)(ws + WS_XN), (const bf16*)(ws + WS_WIN), M, NINP, DM}; pg8::StaticOrder S; S.init(M, NINP, F.G, (int)blockIdx.x); \
            pg8::EpiBf16<0> E{(bf16*)(ws + WS_COLS), NINP, nullptr, 0, 0, 1.f}; \
            pg8::gemm_phase<pg8::EpiBf16<0>, pg8::StaticOrder, PG8_ALIGN, PG8_SP2>(F.lds, g, S, E); } SEAM(B + 1); \
    if (IN_(B + 2)) { phase_gates(F, l); phase_ssd_conv(F, l); } SEAM(B + 2); \
    if (IN_(B + 3)) { const int bx = blockIdx.x; \
            if (bx < 96) { const int c8 = bx & 7, k8 = bx >> 3; rwkv_scan(F, l, c8 + 8 * (k8 >> 2), k8 & 3); } else if (bx < 120) rwkv_produce(F, l, bx - 96); else if (bx < 216) { const int u = bx - 120, sg = 3 - (u / 24); ssd_seq(F, l, u % 24, 32 * sg, 32 * sg + 32); } else if (bx < 248) { const int u = bx - 216, sg = 1 - (u / 16); mlstm_seq(F, l, u % 16, 64 * sg, 64 * sg + 64); } } SEAM(B + 3); \
    if (IN_(B + 4)) phase_post(F, l); SEAM(B + 4); \
    if (IN_(B + 5)) { unsigned char* ws = WSP(F); pg8::Gemm g{(const bf16*)(ws + WS_XN), (const bf16*)(ws + WS_WOUT), M, DM, DM}; pg8::StaticOrder S; S.init(M, DM, F.G, (int)blockIdx.x); \
            pg8::EpiResidual E{l == 0 ? INP(F, 0) : OUTP(F), OUTP(F), DM}; \
            pg8::gemm_phase<pg8::EpiResidual, pg8::StaticOrder, PG8_ALIGN, PG8_SP2>(F.lds, g, S, E); } SEAM(B + 5); \
    if (IN_(B + 6)) phase_norm(F, OUTP(F), INP(F, 27) + l * DM, (bf16*)(WSP(F) + WS_XN)); SEAM(B + 6); \
    if (IN_(B + 7)) { unsigned char* ws = WSP(F); pg8::Gemm g{(const bf16*)(ws + WS_XN), (const bf16*)(ws + WS_WGU), M, 2 * FFN, DM}; pg8::StaticOrder S; S.init(M, 2 * FFN, F.G, (int)blockIdx.x); \
            pg8::EpiSwiGLU E{(bf16*)(ws + WS_COLS), FFN}; \
            pg8::gemm_phase<pg8::EpiSwiGLU, pg8::StaticOrder, PG8_ALIGN, PG8_SP2>(F.lds, g, S, E); } SEAM(B + 7); \
    if (IN_(B + 8)) { unsigned char* ws = WSP(F); pg8::Gemm g{(const bf16*)(ws + WS_COLS), (const bf16*)(ws + WS_WDN), M, DM, FFN}; pg8::StaticOrder S; S.init(M, DM, F.G, (int)blockIdx.x); \
            pg8::EpiResidual E{OUTP(F), OUTP(F), DM}; \
            pg8::gemm_phase<pg8::EpiResidual, pg8::StaticOrder, PG8_ALIGN, PG8_SP2>(F.lds, g, S, E); } SEAM(B + 8);
    LAYER(0, 0)
    LAYER(1, 9)
    if (IN_(18)) phase_final_norm(F, OUTP(F), INP(F, 31));
#undef IN_
#undef SEAM
#undef LAYER
}

#ifndef MK_PER_PHASE
#define MK_PER_PHASE 0
#endif
extern "C" void kernel_launch(void* const* d_in, const int* in_sizes, int n_in, void* d_out, int out_size, void* d_ws, size_t ws_size, hipStream_t stream) {
    static int grid = 0;
    if (grid == 0) {
        int dev = 0, cus = 0;
        if (n_in != 32 || out_size != M * DM || ws_size < WS_END) { fprintf(stderr, "kernel_launch: unexpected shapes (n_in %d out %d ws %zu)\n", n_in, out_size, ws_size); grid = -1; return; }
        if (hipGetDevice(&dev) != hipSuccess || hipDeviceGetAttribute(&cus, hipDeviceAttributeMultiprocessorCount, dev) != hipSuccess) { grid = -1; return; }
        if (hipFuncSetAttribute((const void*)mk_fwd, hipFuncAttributeMaxDynamicSharedMemorySize, LDS_BYTES) != hipSuccess) { fprintf(stderr, "kernel_launch: hipFuncSetAttribute failed\n"); grid = -1; return; }
        int per_cu = 0;
        if (hipOccupancyMaxActiveBlocksPerMultiprocessor(&per_cu, (const void*)mk_fwd, NWAVES * 64, LDS_BYTES) != hipSuccess || per_cu < 1) { fprintf(stderr, "kernel_launch: occupancy query says %d\n", per_cu); }
        (void)hipGetLastError();
        grid = cus;
    }
    if (grid < 0) return;
    (void)hipMemsetAsync((char*)d_ws + WS_CTL, 0, CTL_ZERO_BYTES, stream);
    Args a{};
    for (int i = 0; i < 32; ++i) a.in[i] = (const float*)d_in[i];
    a.out = (float*)d_out; a.ws = (unsigned char*)d_ws;
#if MK_PER_PHASE
    for (int p = 0; p < N_PHASES; ++p) { a.ph_lo = p; a.ph_hi = p + 1; hipLaunchKernelGGL(mk_fwd, dim3(grid), dim3(NWAVES * 64), LDS_BYTES, stream, a); }
#else
    a.ph_lo = 0; a.ph_hi = N_PHASES;
    void* kargs[] = {&a};
    hipError_t e = hipLaunchCooperativeKernel((const void*)mk_fwd, dim3(grid), dim3(NWAVES * 64), kargs, LDS_BYTES, stream);
    if (e != hipSuccess) fprintf(stderr, "cooperative launch failed: %s (grid %d)\n", hipGetErrorString(e), grid);
#endif
}
```

```cpp
#include <hip/hip_runtime.h>
#include <hip/hip_cooperative_groups.h>
#include <cstdio>
#include <cstdint>
namespace pg8 {
#define PG8_LAS __attribute__((address_space(3)))
typedef unsigned short bf16_t;
typedef short bf16x8 __attribute__((ext_vector_type(8)));
typedef float f32x4 __attribute__((ext_vector_type(4)));
typedef unsigned u32x4 __attribute__((ext_vector_type(4)));
constexpr int BM = 256, BK = 64, HALF = 128, HTB = HALF * BK * 2  , STAGE_BYTES = 8 * HTB, NXCD = 8, WGM = 8;

__host__ __device__ __forceinline__ int lds_byte(int r, int c) { const int st = (r >> 4) * 2 + (c >> 5), rr = r & 15, cc = c & 31, ob = rr * 64 + cc * 2; return st * 1024 + (ob ^ (((ob >> 9) & 1) << 5)); }
__host__ __device__ __forceinline__ void stage_rc(int b, int& R, int& C) { const int st = b / 1024, sb = b % 1024, swz = sb ^ (((sb >> 9) & 1) << 5); R = (st >> 1) * 16 + swz / 64; C = (st & 1) * 32 + (swz % 64) / 2; }
__host__ __device__ __forceinline__ int perm32(int rho) { const int n = rho >> 4, i = rho & 15; return 8 * (i >> 2) + 4 * n + (i & 3); }

struct Unit { int pm, pn; };
struct Gemm { const bf16_t* A; const bf16_t* Bt; int M, N, K; };

struct StaticOrder {
    int nM, nN, nwg, G, c;
    __host__ __device__ void init(int M, int N, int G_, int c_) { nM = M / BM; nN = N / BM; nwg = nM * nN; G = G_; c = c_; }
    __host__ __device__ bool next(int i, Unit& u) const {
        const long L = (long)i * G + c; if (L >= nwg) return false;
        int wgid = (int)L; { const int q = nwg / NXCD, r = nwg % NXCD, xcd = wgid % NXCD, off = wgid / NXCD; wgid = (xcd < r ? xcd * (q + 1) : r * (q + 1) + (xcd - r) * q) + off; }
        const int nig = WGM * nN, gid = wgid / nig, fm = gid * WGM, gsz = (nM - fm) < WGM ? (nM - fm) : WGM;
        u.pm = fm + ((wgid % nig) % gsz); u.pn = (wgid % nig) / gsz; return true;
    }
    __device__ __forceinline__ void a_ready(const Unit&) const {}
    __device__ __forceinline__ void done(const Unit&) const {}
};

__device__ __forceinline__ unsigned cvt_pk_bf16(float lo, float hi) { unsigned r; asm volatile("v_cvt_pk_bf16_f32 %0, %1, %2" : "=v"(r) : "v"(lo), "v"(hi)); return r; }
typedef float f32x2 __attribute__((ext_vector_type(2)));
__device__ __forceinline__ f32x2 gelu_pk(f32x2 v) {
    const f32x2 av = __builtin_elementwise_abs(v), d = av * 0.2316418882f + 1.0f;
    f32x2 t; t.x = __builtin_amdgcn_rcpf(d.x); t.y = __builtin_amdgcn_rcpf(d.y);
    f32x2 q = t * 0.5307027145f + (-0.7265760135f); q = q * t + 0.7107068705f; q = q * t + (-0.142248368f); q = q * t + 0.127414796f; q = q * t;
    const f32x2 s = (v * v) * (-0.72134752044f);
    f32x2 e; e.x = __builtin_amdgcn_exp2f(s.x); e.y = __builtin_amdgcn_exp2f(s.y);
    const f32x2 m = v * (q * e), r = v - m;
    f32x2 o; o.x = v.x < 0.f ? m.x : r.x; o.y = v.y < 0.f ? m.y : r.y; return o;
}

template <int ACT  > struct EpiBf16 {
    static constexpr bool PERM = true, AFTER_DRAIN = false; static_assert(ACT == 0 || ACT == 1, "EpiBf16: ACT is 0 (none) or 1 (gelu_pk)");
    bf16_t* O; int ldc; const float* bias; int split_cols; size_t split_stride; float scale0;
    __device__ __forceinline__ void operator()(const f32x4 (&acc)[2][2][4][2], const Unit& u, int wr, int wc, int fr, int fq) const {
        const int row0 = u.pm * BM + wr * 64 + fr; int colt = u.pn * BM; bf16_t* base = O;
        float sc = 1.f; if (split_cols) { const int t = colt / split_cols; base += (size_t)t * split_stride; colt -= t * split_cols; if (t == 0) sc = scale0; }
        const int col0 = colt + wc * 32 + 8 * fq, bcol0 = u.pn * BM + wc * 32 + 8 * fq;
        f32x4 bv[2][2];
#pragma unroll
        for (int bj = 0; bj < 2; ++bj)
#pragma unroll
            for (int n = 0; n < 2; ++n) bv[bj][n] = bias ? *(const f32x4*)(bias + bcol0 + bj * HALF + 4 * n) : (f32x4){0.f, 0.f, 0.f, 0.f};
#pragma unroll
        for (int ai = 0; ai < 2; ++ai)
#pragma unroll
            for (int m = 0; m < 4; ++m) { bf16_t* rowp = base + (size_t)(row0 + ai * HALF + m * 16) * ldc + col0;
#pragma unroll
                for (int bj = 0; bj < 2; ++bj) { f32x4 v0 = acc[ai][bj][m][0] + bv[bj][0], v1 = acc[ai][bj][m][1] + bv[bj][1];
                    if (ACT == 1) { f32x2 a = gelu_pk((f32x2){v0[0], v0[1]}), b = gelu_pk((f32x2){v0[2], v0[3]}), c = gelu_pk((f32x2){v1[0], v1[1]}), d = gelu_pk((f32x2){v1[2], v1[3]});
                        v0 = (f32x4){a.x, a.y, b.x, b.y}; v1 = (f32x4){c.x, c.y, d.x, d.y}; }
                    v0 = v0 * sc; v1 = v1 * sc; u32x4 w; w.x = cvt_pk_bf16(v0[0], v0[1]); w.y = cvt_pk_bf16(v0[2], v0[3]); w.z = cvt_pk_bf16(v1[0], v1[1]); w.w = cvt_pk_bf16(v1[2], v1[3]);
                    *(u32x4*)(rowp + bj * HALF) = w; } }
    }
};
struct EpiResidual {
    static constexpr bool PERM = false, AFTER_DRAIN = false;
    const float* base; float* out; int ldc;
    __device__ __forceinline__ void operator()(const f32x4 (&acc)[2][2][4][2], const Unit& u, int wr, int wc, int fr, int fq) const {
        const int col0 = u.pn * BM + wc * 32 + 4 * fq;
#pragma unroll
        for (int ai = 0; ai < 2; ++ai)
#pragma unroll
            for (int m = 0; m < 4; ++m) { const size_t off = (size_t)(u.pm * BM + ai * HALF + wr * 64 + m * 16 + fr) * ldc + col0;
#pragma unroll
                for (int bj = 0; bj < 2; ++bj)
#pragma unroll
                    for (int n = 0; n < 2; ++n) { const f32x4 bs = *(const f32x4*)(base + off + bj * HALF + n * 16); *(f32x4*)(out + off + bj * HALF + n * 16) = bs + acc[ai][bj][m][n]; }
                asm volatile("" ::: "memory"); }
    }
};
struct EpiSwiGLU {
    static constexpr bool PERM = true, AFTER_DRAIN = false;
    bf16_t* O; int ldc;
    __device__ __forceinline__ void operator()(const f32x4 (&acc)[2][2][4][2], const Unit& u, int wr, int wc, int fr, int fq) const {
        const int col0 = u.pn * HALF + wc * 32 + 8 * fq;
#pragma unroll
        for (int ai = 0; ai < 2; ++ai)
#pragma unroll
            for (int m = 0; m < 4; ++m) { bf16_t* rowp = O + (size_t)(u.pm * BM + ai * HALF + wr * 64 + m * 16 + fr) * ldc + col0;
                float r[8];
#pragma unroll
                for (int n = 0; n < 2; ++n)
#pragma unroll
                    for (int j = 0; j < 4; ++j) { const float g = acc[ai][0][m][n][j], up = acc[ai][1][m][n][j]; r[n * 4 + j] = g * __builtin_amdgcn_rcpf(1.f + __expf(-g)) * up; }
                u32x4 w; w.x = cvt_pk_bf16(r[0], r[1]); w.y = cvt_pk_bf16(r[2], r[3]); w.z = cvt_pk_bf16(r[4], r[5]); w.w = cvt_pk_bf16(r[6], r[7]);
                *(u32x4*)rowp = w; }
    }
};
template <class Epi, class Sched, bool ALIGN_EPI = false, bool SP2 = false>
__device__ __forceinline__ void gemm_phase(PG8_LAS unsigned char* lds, const Gemm g, const Sched& S, const Epi& E) {
    const int tid = threadIdx.x, wid = __builtin_amdgcn_readfirstlane(tid >> 6), lane = tid & 63, wr = wid >> 2, wc = wid & 3, fr = lane & 15, fq = lane >> 4;
    const int K = g.K, nt = K / BK;
    unsigned voffA[2], voffB[2];
#pragma unroll
    for (int i = 0; i < 2; ++i) { int R, C; stage_rc(tid * 16 + i * 8192, R, C); const int Rb = Epi::PERM ? ((R & ~31) + perm32(R & 31)) : R;
        voffA[i] = (unsigned)(R * K + C) * 2u; voffB[i] = (unsigned)(Rb * K + C) * 2u; }
    const size_t kstep = (size_t)(BK * 2);
    const size_t hstep = (size_t)HALF * K * 2;
    const size_t tstep = 2 * hstep;
    const unsigned ldsw = (unsigned)wid * 1024u;
    const int aoff = lds_byte(wr * 64 + fr, fq * 8), boff = lds_byte(wc * 32 + fr, fq * 8);
#define PG8_SA(b, h) (((b) * 2 + (h)) * HTB)
#define PG8_SB(b, h) ((4 + (b) * 2 + (h)) * HTB)
#define PG8_STAGE(bufoff, gbase, voff) do { _Pragma("unroll") for (int _i = 0; _i < 2; ++_i) \
        __builtin_amdgcn_global_load_lds((const unsigned*)((const char*)(gbase) + (voff)[_i]), (PG8_LAS unsigned*)(lds + (bufoff) + ldsw + _i * 8192), 16, 0, 0); } while (0)
#define PG8_LDA(dst, b, h) do { _Pragma("unroll") for (int m = 0; m < 4; ++m) _Pragma("unroll") for (int k = 0; k < 2; ++k) dst[m][k] = *(const PG8_LAS bf16x8*)(lds + PG8_SA(b, h) + aoff + m * 2048 + k * 1024); } while (0)
#define PG8_LDB(dst, b, h) do { _Pragma("unroll") for (int n = 0; n < 2; ++n) _Pragma("unroll") for (int k = 0; k < 2; ++k) dst[n][k] = *(const PG8_LAS bf16x8*)(lds + PG8_SB(b, h) + boff + n * 2048 + k * 1024); } while (0)
#define PG8_MMA(ai, bj, At, Bt) do { __builtin_amdgcn_s_setprio(1); _Pragma("unroll") for (int m = 0; m < 4; ++m) _Pragma("unroll") for (int n = 0; n < 2; ++n) _Pragma("unroll") for (int k = 0; k < 2; ++k) \
        acc[ai][bj][m][n] = __builtin_amdgcn_mfma_f32_16x16x32_bf16(Bt[n][k], At[m][k], acc[ai][bj][m][n], 0, 0, 0); __builtin_amdgcn_s_setprio(0); } while (0)
#define PG8_WAIT_V(n) asm volatile("s_waitcnt vmcnt(" #n ")" ::: "memory")
#define PG8_WAIT_L(n) asm volatile("s_waitcnt lgkmcnt(" #n ")" ::: "memory")
#define PG8_BAR __builtin_amdgcn_s_barrier()
#define PG8_SCHED __builtin_amdgcn_sched_barrier(0)
    Unit cur, nxt; int ui = 0;
    if (!S.next(0, cur)) return;
    f32x4 acc[2][2][4][2];
#pragma unroll
    for (int a = 0; a < 2; ++a)
#pragma unroll
        for (int b = 0; b < 2; ++b)
#pragma unroll
            for (int m = 0; m < 4; ++m)
#pragma unroll
                for (int n = 0; n < 2; ++n) acc[a][b][m][n] = (f32x4){0.f, 0.f, 0.f, 0.f};
    bf16x8 At[4][2], B0[2][2], B1[2][2];
    const char* cA = (const char*)g.A + (size_t)cur.pm * tstep; const char* cB = (const char*)g.Bt + (size_t)cur.pn * tstep;
    S.a_ready(cur);
    if constexpr (SP2) {
        PG8_STAGE(PG8_SB(0, 0), cB, voffB); PG8_STAGE(PG8_SB(0, 1), cB + hstep, voffB); PG8_STAGE(PG8_SA(0, 0), cA, voffA); PG8_STAGE(PG8_SA(0, 1), cA + hstep, voffA);
        if (wr == 1) PG8_BAR;
        PG8_WAIT_V(2); PG8_BAR;
        PG8_STAGE(PG8_SB(1, 0), cB + kstep, voffB); PG8_STAGE(PG8_SA(1, 0), cA + kstep, voffA); PG8_STAGE(PG8_SB(1, 1), cB + hstep + kstep, voffB);
        PG8_WAIT_V(6); PG8_BAR;
    } else {
        PG8_STAGE(PG8_SB(0, 0), cB, voffB); PG8_STAGE(PG8_SA(0, 0), cA, voffA); PG8_STAGE(PG8_SB(0, 1), cB + hstep, voffB); PG8_STAGE(PG8_SA(0, 1), cA + hstep, voffA);
        if (wr == 1) PG8_BAR;
        PG8_WAIT_V(4); PG8_BAR;
        PG8_STAGE(PG8_SB(1, 0), cB + kstep, voffB); PG8_STAGE(PG8_SA(1, 0), cA + kstep, voffA); PG8_STAGE(PG8_SB(1, 1), cB + hstep + kstep, voffB);
        PG8_WAIT_V(6); PG8_BAR;
    }
    for (;;) {
        const bool has_next = S.next(ui + 1, nxt);
        const char* nA = has_next ? (const char*)g.A + (size_t)nxt.pm * tstep : cA; const char* nB = has_next ? (const char*)g.Bt + (size_t)nxt.pn * tstep : cB;
        for (int t = 0; t < nt; t += 2) {
            const bool last = (t == nt - 2);
            const char* a1 = cA + (size_t)(t + 1) * kstep;
            const char* a2 = last ? nA : cA + (size_t)(t + 2) * kstep; const char* b2 = last ? nB : cB + (size_t)(t + 2) * kstep;
            const char* a3 = a2 + kstep; const char* b3 = b2 + kstep;
            if (last && has_next) S.a_ready(nxt);
            if constexpr (SP2) {
            PG8_LDB(B0, 0, 0); PG8_LDB(B1, 0, 1); PG8_SCHED; PG8_LDA(At, 0, 0); PG8_STAGE(PG8_SA(1, 1), a1 + hstep, voffA);
            PG8_WAIT_V(8); PG8_WAIT_L(0); PG8_BAR; PG8_MMA(0, 0, At, B0); PG8_MMA(0, 1, At, B1); PG8_BAR; PG8_SCHED;
            PG8_LDA(At, 0, 1); PG8_STAGE(PG8_SB(0, 0), b2, voffB); PG8_STAGE(PG8_SB(0, 1), b2 + hstep, voffB); PG8_STAGE(PG8_SA(0, 0), a2, voffA);
            PG8_WAIT_V(8); PG8_WAIT_L(0); PG8_BAR; PG8_MMA(1, 0, At, B0); PG8_MMA(1, 1, At, B1); PG8_BAR; PG8_SCHED;
            PG8_LDB(B0, 1, 0); PG8_LDB(B1, 1, 1); PG8_SCHED; PG8_LDA(At, 1, 0); PG8_STAGE(PG8_SA(0, 1), a2 + hstep, voffA);
            PG8_WAIT_V(8); PG8_WAIT_L(0); PG8_BAR; PG8_MMA(0, 0, At, B0); PG8_MMA(0, 1, At, B1); PG8_BAR; PG8_SCHED;
            PG8_LDA(At, 1, 1); PG8_STAGE(PG8_SB(1, 0), b3, voffB); PG8_STAGE(PG8_SB(1, 1), b3 + hstep, voffB); PG8_STAGE(PG8_SA(1, 0), a3, voffA);
            PG8_WAIT_V(8); PG8_WAIT_L(0); PG8_BAR; PG8_MMA(1, 0, At, B0); PG8_MMA(1, 1, At, B1); PG8_BAR; PG8_SCHED;
            } else {
            PG8_LDB(B0, 0, 0); PG8_SCHED; PG8_LDA(At, 0, 0); PG8_STAGE(PG8_SA(1, 1), a1 + hstep, voffA);
            PG8_WAIT_L(8); PG8_BAR; PG8_WAIT_L(0); PG8_MMA(0, 0, At, B0); PG8_BAR; PG8_SCHED;
            PG8_LDB(B1, 0, 1); PG8_STAGE(PG8_SB(0, 0), b2, voffB);
            PG8_BAR; PG8_WAIT_L(0); PG8_MMA(0, 1, At, B1); PG8_BAR;
            PG8_LDA(At, 0, 1); PG8_STAGE(PG8_SA(0, 0), a2, voffA);
            PG8_BAR; PG8_WAIT_L(0); PG8_MMA(1, 0, At, B0); PG8_BAR; PG8_SCHED;
            PG8_STAGE(PG8_SB(0, 1), b2 + hstep, voffB);
            PG8_WAIT_V(6); PG8_BAR; PG8_MMA(1, 1, At, B1); PG8_BAR;
            PG8_LDB(B0, 1, 0); PG8_SCHED; PG8_LDA(At, 1, 0); PG8_STAGE(PG8_SA(0, 1), a2 + hstep, voffA);
            PG8_WAIT_L(8); PG8_BAR; PG8_WAIT_L(0); PG8_MMA(0, 0, At, B0); PG8_BAR; PG8_SCHED;
            PG8_LDB(B1, 1, 1); PG8_STAGE(PG8_SB(1, 0), b3, voffB);
            PG8_BAR; PG8_WAIT_L(0); PG8_MMA(0, 1, At, B1); PG8_BAR;
            PG8_LDA(At, 1, 1); PG8_STAGE(PG8_SA(1, 0), a3, voffA);
            PG8_BAR; PG8_WAIT_L(0); PG8_MMA(1, 0, At, B0); PG8_BAR; PG8_SCHED;
            PG8_STAGE(PG8_SB(1, 1), b3 + hstep, voffB);
            PG8_WAIT_V(6); PG8_BAR; PG8_MMA(1, 1, At, B1); PG8_BAR;
            }
        }
        if constexpr (ALIGN_EPI) { if (wr == 0) PG8_BAR; }
        if constexpr (!Epi::AFTER_DRAIN) { E(acc, cur, wr, wc, fr, fq); S.done(cur); }
        if (!has_next) break;
#pragma unroll
        for (int a = 0; a < 2; ++a)
#pragma unroll
            for (int b = 0; b < 2; ++b)
#pragma unroll
                for (int m = 0; m < 4; ++m)
#pragma unroll
                    for (int n = 0; n < 2; ++n) acc[a][b][m][n] = (f32x4){0.f, 0.f, 0.f, 0.f};
        cur = nxt; cA = nA; cB = nB; ++ui;
        if constexpr (ALIGN_EPI) { if (wr == 1) PG8_BAR; }
    }
    PG8_WAIT_V(0);
    if constexpr (!ALIGN_EPI) { if (wr == 0) PG8_BAR; }
    PG8_BAR;
    if constexpr (Epi::AFTER_DRAIN) { E.fused(acc, cur, wr, wc, fr, fq, lds, wid, lane); S.done(cur); }
#undef PG8_SA
#undef PG8_SB
#undef PG8_STAGE
#undef PG8_LDA
#undef PG8_LDB
#undef PG8_MMA
#undef PG8_WAIT_V
#undef PG8_WAIT_L
#undef PG8_BAR
#undef PG8_SCHED
}
}

#ifndef PG8_SP2
#define PG8_SP2 true
#endif
#define PG8_ALIGN true
constexpr int NWAVES = 8;
constexpr int BATCH = 2, SEQ = 8192, DM = 1024, M = BATCH * SEQ, NIN = 3788, NINP = 3840, FFN = 2816, DEPTH = 2;
constexpr int A_Q = 0, A_K = 256, A_V = 512, A_O = 768;
constexpr int R_R = 1024, R_K = 1408, R_V = 1792, R_WDF = 2176, R_AD = 2304, R_GD = 2368;
constexpr int S_Z = 2496, S_X = 2880, S_B = 3264, S_C = 3520, S_DT = 3776;
constexpr size_t MiB = 1u << 20;
constexpr size_t WS_CTL = 0, CTL_ZERO_BYTES = 64 * 1024;
constexpr size_t WS_GATES = 1 * MiB, WS_CT = 2 * MiB;
constexpr size_t WS_WIN = 4 * MiB, WS_WOUT = 12 * MiB, WS_WGU = 14 * MiB, WS_WDN = 25 * MiB;
constexpr size_t WS_XN = 32 * MiB, WS_COLS = 64 * MiB, WS_Y = 184 * MiB, WS_END = 256 * MiB;
constexpr size_t Y_AF = WS_Y, Y_AB = WS_Y + 8 * MiB, Y_RF = WS_Y + 16 * MiB, Y_RB = WS_Y + 28 * MiB, Y_SF = WS_Y + 40 * MiB, Y_SB = WS_Y + 52 * MiB;
constexpr int CW_BAR = 1024;
constexpr int RING_BYTES = 131072;
constexpr int LDS_BYTES = 147456, MISC_OFF = LDS_BYTES - 256;

#define GAS __attribute__((address_space(1)))
#define LAS __attribute__((address_space(3)))
typedef unsigned short bf16;
typedef unsigned v4u __attribute__((ext_vector_type(4)));
typedef unsigned v2u __attribute__((ext_vector_type(2)));
typedef float f32x4 __attribute__((ext_vector_type(4)));
typedef short bf16x8 __attribute__((ext_vector_type(8)));
typedef GAS unsigned gu32;
#define RLX_AGENT __ATOMIC_RELAXED, __HIP_MEMORY_SCOPE_AGENT
#define LDS_WAIT() asm volatile("s_waitcnt lgkmcnt(0)" ::: "memory")
#define VM_WAIT() asm volatile("s_waitcnt vmcnt(0)" ::: "memory")
__device__ __forceinline__ unsigned f2bf(float f) { unsigned u = __builtin_bit_cast(unsigned, f); return (u + 0x7fffu + ((u >> 16) & 1u)) >> 16; }
__device__ __forceinline__ unsigned pk2(float lo, float hi) { return f2bf(lo) | (f2bf(hi) << 16); }
__device__ __forceinline__ float bf2f(unsigned u) { return __builtin_bit_cast(float, u << 16); }
__device__ __forceinline__ float sigmoidf_(float x) { return __builtin_amdgcn_rcpf(1.f + __expf(-x)); }
__device__ __forceinline__ float siluf_(float x) { return x * sigmoidf_(x); }
__device__ __forceinline__ float wave_sum(float v) {
#pragma unroll
    for (int o = 1; o < 64; o <<= 1) v += __shfl_xor(v, o);
    return v;
}
__device__ __forceinline__ float wave_max(float v) {
#pragma unroll
    for (int o = 1; o < 64; o <<= 1) v = fmaxf(v, __shfl_xor(v, o));
    return v;
}
template <int CTRL> __device__ __forceinline__ float dppf(float v) { return __builtin_bit_cast(float, __builtin_amdgcn_update_dpp(0, __builtin_bit_cast(int, v), CTRL, 0xf, 0xf, true)); }
__device__ __forceinline__ float row16_sum(float v) { v += dppf<0xB1>(v); v += dppf<0x4E>(v); v += dppf<0x141>(v); v += dppf<0x140>(v); return v; }
template <int K> __device__ __forceinline__ f32x4 mma16(const LAS bf16* A, int lda, const LAS bf16* Bt, int ldb, f32x4 acc, int lane) {
    const int r = lane & 15, q = lane >> 4;
    const LAS bf16* ap = A + r * lda + q * 8; const LAS bf16* bp = Bt + r * ldb + q * 8;
#pragma unroll
    for (int k0 = 0; k0 < K; k0 += 32) {
        const bf16x8 a = *(const LAS bf16x8*)(ap + k0); const bf16x8 b = *(const LAS bf16x8*)(bp + k0);
        acc = __builtin_amdgcn_mfma_f32_16x16x32_bf16(a, b, acc, 0, 0, 0);
    }
    return acc;
}

__device__ __forceinline__ int swz64(int row, int col) { return col ^ (((row >> 3) & 7) << 3); }
template <bool SWA, bool SWB> __device__ __forceinline__ f32x4 mma16s(const LAS bf16* A, int lda, int rowA0, const LAS bf16* Bt, int ldb, int rowB0, f32x4 acc, int lane) {
    const int r = lane & 15, q = lane >> 4; const int ra = rowA0 + r, rb = rowB0 + r;
#pragma unroll
    for (int k0 = 0; k0 < 64; k0 += 32) { const int ca = k0 + 8 * q, cb = k0 + 8 * q;
        const bf16x8 a = *(const LAS bf16x8*)(A + ra * lda + (SWA ? swz64(ra, ca) : ca)); const bf16x8 b = *(const LAS bf16x8*)(Bt + rb * ldb + (SWB ? swz64(rb, cb) : cb));
        acc = __builtin_amdgcn_mfma_f32_16x16x32_bf16(a, b, acc, 0, 0, 0); }
    return acc;
}

template <int CTRL, int RM, int BM> __device__ __forceinline__ float dppm(float oldv, float v) { return __builtin_bit_cast(float, __builtin_amdgcn_update_dpp(__builtin_bit_cast(int, oldv), __builtin_bit_cast(int, v), CTRL, RM, BM, false)); }
__device__ __forceinline__ float wave_scan_add(float x) {
    float y = x + dppm<0x111, 0xf, 0xf>(0.f, x); y += dppm<0x112, 0xf, 0xf>(0.f, x); y += dppm<0x113, 0xf, 0xf>(0.f, x);
    y += dppm<0x114, 0xf, 0xe>(0.f, y); y += dppm<0x118, 0xf, 0xc>(0.f, y);
    y += dppm<0x142, 0xa, 0xf>(0.f, y); y += dppm<0x143, 0xc, 0xf>(0.f, y);
    return y;
}
__device__ __forceinline__ float wave_scan_max(float x) {
    const float ninf = -INFINITY;
    float y = fmaxf(x, dppm<0x111, 0xf, 0xf>(ninf, x)); y = fmaxf(y, dppm<0x112, 0xf, 0xf>(ninf, x)); y = fmaxf(y, dppm<0x113, 0xf, 0xf>(ninf, x));
    y = fmaxf(y, dppm<0x114, 0xf, 0xe>(ninf, y)); y = fmaxf(y, dppm<0x118, 0xf, 0xc>(ninf, y));
    y = fmaxf(y, dppm<0x142, 0xa, 0xf>(ninf, y)); y = fmaxf(y, dppm<0x143, 0xc, 0xf>(ninf, y));
    return y;
}
#define XB_TMO      128
#define XB_XCNT(j)  (256  + 64 * (j))
#define XB_XSUB(j)  (1280 + 64 * (j))
#define XB_XGEN(j)  (2304 + 64 * (j))
#define XB_TOP      3328
#define XB_TOPGEN   3392
#define XCD_BAR_WORDS 3456
#define XB_SPIN_CAP (1u << 18)

__device__ __forceinline__ unsigned xb_ld(unsigned* p)              { return __hip_atomic_load(p, __ATOMIC_RELAXED, __HIP_MEMORY_SCOPE_AGENT); }
__device__ __forceinline__ unsigned xb_add(unsigned* p, unsigned v) { return __hip_atomic_fetch_add(p, v, __ATOMIC_RELAXED, __HIP_MEMORY_SCOPE_AGENT); }
__device__ __forceinline__ unsigned xb_xcc_id() { return (unsigned)__builtin_amdgcn_s_getreg((3 << 11) | 20) & 0xFu; }
#define XB_SPIN(cond, bar) do { unsigned _sp = 0; while (cond) { __builtin_amdgcn_s_sleep(1); \
    if ((++_sp & 255u) == 0u) { if (xb_ld(&(bar)[XB_TMO])) break; if (_sp > XB_SPIN_CAP) { atomicAdd(&(bar)[XB_TMO], 1u); break; } } } } while (0)

struct XcdBarrier {
    unsigned* bar; unsigned x;
    volatile LAS unsigned* st;
};

__device__ __forceinline__ XcdBarrier xcd_barrier_post(unsigned* bar, volatile LAS unsigned* st) {
    XcdBarrier b; b.bar = bar; b.x = xb_xcc_id(); b.st = st;
    if (threadIdx.x == 0) (void)xb_add(&bar[XB_XCNT(b.x)], 1u);
    return b;
}
__device__ __forceinline__ void xcd_barrier_complete(unsigned* bar, unsigned x, unsigned& nloc, unsigned& nx) {
    const unsigned G = gridDim.x * gridDim.y * gridDim.z;
    unsigned sum, cnt, mine, sp = 0u;
    for (;;) {
        sum = 0u; cnt = 0u; mine = 0u;
#pragma unroll
        for (unsigned j = 0; j < 16; ++j) { const unsigned c = xb_ld(&bar[XB_XCNT(j)]); sum += c; cnt += (c > 0u) ? 1u : 0u; mine = (j == x) ? c : mine; }
        if (sum == G) break;
        __builtin_amdgcn_s_sleep(1);
        if ((++sp & 255u) == 0u) { if (xb_ld(&bar[XB_TMO])) break; if (sp > XB_SPIN_CAP) { atomicAdd(&bar[XB_TMO], 1u); break; } }
    }
    nloc = mine > 0u ? mine : 1u; nx = cnt > 0u ? cnt : 1u;
}

__device__ __forceinline__ void xcd_barrier(const XcdBarrier& b) {
    asm volatile("s_waitcnt vmcnt(0)" ::: "memory");
    __syncthreads();
    if (threadIdx.x == 0) {
        unsigned* bar = b.bar;
        __builtin_amdgcn_s_waitcnt(0);
        unsigned nloc = b.st[0], nx = b.st[1];
        if (nloc == 0u) { xcd_barrier_complete(bar, b.x, nloc, nx); b.st[0] = nloc; b.st[1] = nx; }
        const unsigned old = xb_add(&bar[XB_XSUB(b.x)], 1u);
        const unsigned gen = old / nloc;
        if (old + 1u == (gen + 1u) * nloc) {
            __builtin_amdgcn_fence(__ATOMIC_RELEASE, "agent");
            asm volatile("s_waitcnt vmcnt(0)" ::: "memory");
            const unsigned og = xb_add(&bar[XB_TOP], 1u);
            const unsigned tg = og / nx;
            if (og + 1u == (tg + 1u) * nx) xb_add(&bar[XB_TOPGEN], 1u);
            else XB_SPIN(xb_ld(&bar[XB_TOPGEN]) == tg, bar);
            __builtin_amdgcn_fence(__ATOMIC_ACQUIRE, "agent");
            xb_add(&bar[XB_XGEN(b.x)], 1u);
            asm volatile("s_waitcnt vmcnt(0)" ::: "memory");
        } else {
            XB_SPIN(xb_ld(&bar[XB_XGEN(b.x)]) == gen, bar);
            __builtin_amdgcn_fence(__ATOMIC_ACQUIRE, "agent");
            asm volatile("s_waitcnt vmcnt(0)" ::: "memory");
        }
    }
    __syncthreads();
}
struct Frame {
    LAS unsigned char* lds;
    int tid, lane, wave, vcu, G;
};
struct Args { const float* in[32]; float* out; unsigned char* ws; int ph_lo, ph_hi; };
constexpr int PTAB_OFF = LDS_BYTES - 768;
__device__ __forceinline__ unsigned long long ptab_ld(const Frame& F, int i) {
    const unsigned long long v = *(volatile LAS unsigned long long*)(F.lds + PTAB_OFF + 8 * i);
    const unsigned lo = __builtin_amdgcn_readfirstlane((unsigned)v), hi = __builtin_amdgcn_readfirstlane((unsigned)(v >> 32));
    return ((unsigned long long)hi << 32) | lo;
}
__device__ __forceinline__ const float* INP(const Frame& F, int i) { return (const float*)ptab_ld(F, i); }
__device__ __forceinline__ unsigned char* WSP(const Frame& F) { return (unsigned char*)ptab_ld(F, 33); }
__device__ __forceinline__ float* OUTP(const Frame& F) { return (float*)ptab_ld(F, 32); }

__device__ __forceinline__ void transpose_item(const float* W, int K, int N, int nblk, bf16* WT, int mode, int row_off, LAS float* scr, int item, int lane) {
    const int kb = item / nblk, nb = item % nblk, k0 = 64 * kb, n0 = 32 * nb;
    const int ncol = n0 + (lane & 31); const bool ok = ncol < N;
#pragma unroll 8
    for (int i = 0; i < 32; ++i) { const int kk = 2 * i + (lane >> 5); scr[kk * 33 + (lane & 31)] = ok ? W[(size_t)(k0 + kk) * N + ncol] : 0.f; }
    LDS_WAIT(); asm volatile("" ::: "memory");
    const int c = lane & 7;
    const int drow0 = mode ? (256 * (n0 >> 7) + (n0 & 127) + row_off) : (row_off + n0);
#pragma unroll
    for (int j = 0; j < 4; ++j) { const int n = (lane >> 3) + 8 * j; const LAS float* s = scr + (8 * c) * 33 + n;
        v4u o; o.x = pk2(s[0 * 33], s[1 * 33]); o.y = pk2(s[2 * 33], s[3 * 33]); o.z = pk2(s[4 * 33], s[5 * 33]); o.w = pk2(s[6 * 33], s[7 * 33]);
        *(v4u*)(WT + (size_t)(drow0 + n) * K + k0 + 8 * c) = o; }
    LDS_WAIT(); asm volatile("" ::: "memory");
}
__device__ __forceinline__ void phase_convert(const Frame& F, int l) {
    LAS float* scr = (LAS float*)(F.lds + F.wave * 16384);
    const int gw = F.vcu * NWAVES + F.wave, NGW = F.G * NWAVES;
    bf16* Win = (bf16*)(WSP(F) + WS_WIN); bf16* Wout = (bf16*)(WSP(F) + WS_WOUT); bf16* Wgu = (bf16*)(WSP(F) + WS_WGU); bf16* Wdn = (bf16*)(WSP(F) + WS_WDN);
    constexpr int I_IN = 16 * 120, I_OUT = 16 * 32, I_G = 16 * 88, I_D = 44 * 32;
    constexpr int NITEMS = I_IN + I_OUT + 2 * I_G + I_D;
    for (int it = gw; it < NITEMS; it += NGW) {
        int r = it;
        if (r < I_IN) { transpose_item(INP(F, 2) + (size_t)l * DM * NIN, DM, NIN, 120, Win, 0, 0, scr, r, F.lane); continue; } r -= I_IN;
        if (r < I_OUT) { transpose_item(INP(F, 26) + (size_t)l * DM * DM, DM, DM, 32, Wout, 0, 0, scr, r, F.lane); continue; } r -= I_OUT;
        if (r < I_G) { transpose_item(INP(F, 28) + (size_t)l * DM * FFN, DM, FFN, 88, Wgu, 1, 0, scr, r, F.lane); continue; } r -= I_G;
        if (r < I_G) { transpose_item(INP(F, 29) + (size_t)l * DM * FFN, DM, FFN, 88, Wgu, 1, 128, scr, r, F.lane); continue; } r -= I_G;
        transpose_item(INP(F, 30) + (size_t)l * FFN * DM, FFN, DM, 32, Wdn, 0, 0, scr, r, F.lane);
    }
}
__device__ __forceinline__ void phase_norm(const Frame& F, const float* hin, const float* g, bf16* XN) {
    const int gw = F.vcu * NWAVES + F.wave, NGW = F.G * NWAVES;
    f32x4 gv[4];
#pragma unroll
    for (int j = 0; j < 4; ++j) gv[j] = ((const f32x4*)g)[64 * j + F.lane];
    for (int m = gw; m < M; m += NGW) {
        const f32x4* xr = (const f32x4*)(hin + (size_t)m * DM) + F.lane;
        f32x4 v[4]; float s = 0.f;
#pragma unroll
        for (int j = 0; j < 4; ++j) { v[j] = xr[64 * j]; s += (v[j].x * v[j].x + v[j].y * v[j].y) + (v[j].z * v[j].z + v[j].w * v[j].w); }
        const float r = 1.f / sqrtf(wave_sum(s) * (1.f / DM) + 1e-6f);
        v2u* o8 = (v2u*)(XN + (size_t)m * DM) + F.lane;
#pragma unroll
        for (int j = 0; j < 4; ++j) { v2u w; w.x = pk2(v[j].x * r * gv[j].x, v[j].y * r * gv[j].y); w.y = pk2(v[j].z * r * gv[j].z, v[j].w * r * gv[j].w); o8[64 * j] = w; }
    }
}
__device__ __forceinline__ void phase_final_norm(const Frame& F, float* h, const float* g) {
    const int gw = F.vcu * NWAVES + F.wave, NGW = F.G * NWAVES;
    f32x4 gv[4];
#pragma unroll
    for (int j = 0; j < 4; ++j) gv[j] = ((const f32x4*)g)[64 * j + F.lane];
    for (int m = gw; m < M; m += NGW) {
        f32x4* xr = (f32x4*)(h + (size_t)m * DM) + F.lane;
        f32x4 v[4]; float s = 0.f;
#pragma unroll
        for (int j = 0; j < 4; ++j) { v[j] = xr[64 * j]; s += (v[j].x * v[j].x + v[j].y * v[j].y) + (v[j].z * v[j].z + v[j].w * v[j].w); }
        const float r = 1.f / sqrtf(wave_sum(s) * (1.f / DM) + 1e-6f);
#pragma unroll
        for (int j = 0; j < 4; ++j) xr[64 * j] = v[j] * r * gv[j];
    }
}
__device__ __forceinline__ void phase_gates(const Frame& F, int l) {
    const bf16* cols = (const bf16*)(WSP(F) + WS_COLS); float* GT = (float*)(WSP(F) + WS_GATES);
    LAS bf16* raw = (LAS bf16*)(F.lds);
    LAS float* feat = (LAS float*)(F.lds + 32768);
    LAS float* gw = (LAS float*)(F.lds + 81920);
    const float* gwg = INP(F, 5) + (size_t)l * 768 * 16; const float* gb = INP(F, 6) + l * 16;
    const float* cw = INP(F, 3) + (size_t)l * 5 * 512; const float* cb = INP(F, 4) + l * 512;
    for (int i = F.tid; i < 768 * 16; i += 512) gw[i] = gwg[i];
    for (int tile = F.vcu; tile < M / 16; tile += F.G) {
        const int m0 = tile * 16, t0 = m0 % SEQ;
        __syncthreads();
        for (int ch = F.tid; ch < 20 * 96; ch += 512) { const int rr = ch / 96, cc = ch % 96; const int t = t0 - 2 + rr;
            v4u v = {0u, 0u, 0u, 0u}; if (t >= 0 && t < SEQ) v = *(const v4u*)(cols + (size_t)(m0 - 2 + rr) * NINP + cc * 8);
            *(LAS v4u*)(raw + rr * 768 + cc * 8) = v; }
        __syncthreads();
        for (int idx = F.tid; idx < 16 * 768; idx += 512) { const int t = idx / 768, c = idx % 768; float val;
            if (c < 512) { float s = cb[c];
#pragma unroll
                for (int j = 0; j < 5; ++j) s += cw[j * 512 + c] * bf2f(raw[(t + j) * 768 + c]);
                val = siluf_(s); } else val = bf2f(raw[(t + 2) * 768 + c]);
            feat[idx] = val; }
        __syncthreads();
        { const int t = F.tid >> 5, o = (F.tid >> 1) & 15, hf = F.tid & 1; float s = 0.f;
          const LAS float* fp = feat + t * 768 + hf * 384; const LAS float* wp = gw + (hf * 384) * 16 + o;
#pragma unroll 8
          for (int i = 0; i < 384; ++i) s += fp[i] * wp[i * 16];
          s += __shfl_xor(s, 1);
          if (hf == 0) { s += gb[o]; if (o >= 8) s = fminf(s, 0.f) - log1pf(__expf(-fabsf(s))); GT[(size_t)(m0 + t) * 16 + o] = s; } }
    }
    __syncthreads();
}
__device__ __forceinline__ f32x4 mma16_a8(const LAS bf16* A8, const LAS bf16* Bt, f32x4 acc, int lane) {
    const int q = lane >> 4;
    const LAS bf16* ap = A8 + (lane & 7) * 72 + q * 8; const LAS bf16* bp = Bt + (lane & 15) * 72 + q * 8;
#pragma unroll
    for (int k0 = 0; k0 < 64; k0 += 32) { const bf16x8 a = *(const LAS bf16x8*)(ap + k0); const bf16x8 b = *(const LAS bf16x8*)(bp + k0); acc = __builtin_amdgcn_mfma_f32_16x16x32_bf16(a, b, acc, 0, 0, 0); }
    return acc;
}
typedef float f32x2 __attribute__((ext_vector_type(2)));
template <bool DIR> __device__ __forceinline__ void rwkv_steps(const LAS float* OPS, const LAS float* VV, LAS float* YB, f32x4& S, int j, int row) {
    float yk0 = 0.f, yk1 = 0.f;
    constexpr int ST = DIR ? -320 : 320, SV = DIR ? -16 : 16;
    const LAS float* op = OPS + 4 * j + (DIR ? 31 * 320 : 0); const LAS float* vp = VV + row + (DIR ? 31 * 16 : 0);
#define RWLD(W_, KK_, KA_, KM_, R_, V_, o_, v_) do { W_ = *(const LAS f32x4*)(o_); KK_ = *(const LAS f32x4*)((o_) + 64); KA_ = *(const LAS f32x4*)((o_) + 128); KM_ = *(const LAS f32x4*)((o_) + 192); R_ = *(const LAS f32x4*)((o_) + 256); V_ = *(v_); } while (0)
#define RWSTEP(W_, KK_, KA_, KM_, R_, V_, i_) do { f32x2 t2_ = S.xy * KK_.xy; t2_ = S.zw * KK_.zw + t2_; float sa_ = t2_.x + t2_.y; const f32x4 ps_ = S * W_ + KM_ * V_; sa_ = row16_sum(sa_); S = ps_ + KA_ * sa_; \
        f32x2 y2_ = S.xy * R_.xy; y2_ = S.zw * R_.zw + y2_; float y_ = y2_.x + y2_.y; y_ = row16_sum(y_); if (((i_) & 15) == j) { if ((i_) < 16) yk0 = y_; else yk1 = y_; } } while (0)
    f32x4 w4a, kk4a, ka4a, km4a, r4a, w4b, kk4b, ka4b, km4b, r4b; float vva, vvb;
    RWLD(w4a, kk4a, ka4a, km4a, r4a, vva, op, vp);
    RWLD(w4b, kk4b, ka4b, km4b, r4b, vvb, op + ST, vp + SV);
#pragma unroll 1
    for (int i = 0; i < 30; i += 2) {
        f32x4 nw, nkk, nka, nkm, nr; float nv;
        RWLD(nw, nkk, nka, nkm, nr, nv, op + 2 * ST, vp + 2 * SV);
        RWSTEP(w4a, kk4a, ka4a, km4a, r4a, vva, i);
        w4a = nw; kk4a = nkk; ka4a = nka; km4a = nkm; r4a = nr; vva = nv;
        RWLD(nw, nkk, nka, nkm, nr, nv, op + 3 * ST, vp + 3 * SV);
        RWSTEP(w4b, kk4b, ka4b, km4b, r4b, vvb, i + 1);
        w4b = nw; kk4b = nkk; ka4b = nka; km4b = nkm; r4b = nr; vvb = nv;
        op += 2 * ST; vp += 2 * SV;
    }
    RWSTEP(w4a, kk4a, ka4a, km4a, r4a, vva, 30);
    RWSTEP(w4b, kk4b, ka4b, km4b, r4b, vvb, 31);
#undef RWLD
#undef RWSTEP
    YB[(DIR ? 31 - j : j) * 16 + row] = yk0; YB[(DIR ? 15 - j : 16 + j) * 16 + row] = yk1;
}
struct RwCtx { LAS bf16* WA; LAS bf16* WW; LAS bf16* XA; LAS bf16* XW; LAS bf16* RAWB; LAS float* MU; float* CT; const bf16* colsb;
    f32x4 kk_c4, ka_c4, rk_c4; float ba[4], bw[4]; float mup_[5][2], mun_[5][2]; int h, dir, qtr, tb0; size_t mb; };
template <int NTOK> __device__ __forceinline__ void rw_addr_init(int (&poff)[5], int (&prr)[5], int lane, int tb0, int h, int dir) {
    constexpr int NCHK = (NTOK + 2) * 40;
#pragma unroll
    for (int i = 0; i < 5; ++i) { const int idx = lane + 64 * i; const int rr = idx / 40, q = idx % 40, wh = q >> 3, c8 = q & 7;
        const int gc = (wh == 0 ? R_R + h * 64 : wh == 1 ? R_K + h * 64 : wh == 2 ? R_V + h * 64 : wh == 3 ? R_WDF + dir * 64 : R_AD) + c8 * 8;
        prr[i] = idx < NCHK ? tb0 - 1 + rr : -100000; poff[i] = (tb0 - 1 + rr) * NINP + gc; }
}
template <int NTOK> __device__ __forceinline__ void rw_issue(v4u (&pre)[5], const int (&poff)[5], const int (&prr)[5], const bf16* colsb, int T0) {
    constexpr int NCH = ((NTOK + 2) * 40 + 63) / 64;
#pragma unroll
    for (int i = 0; i < NCH; ++i) { pre[i] = (v4u){0u, 0u, 0u, 0u}; const int t = T0 + prr[i]; if (t >= 0 && t < SEQ) pre[i] = *(const v4u*)(colsb + (size_t)T0 * NINP + poff[i]); }
}
template <int NTOK, bool FULLV> __device__ __forceinline__ void rw_prep(const RwCtx& C, const v4u (&pre)[5], LAS float* OPS, LAS float* VV, int T0, int lane) {
    constexpr int NCHK = (NTOK + 2) * 40, NCH = (NCHK + 63) / 64;
    const int j = lane & 15, c2 = (lane & 31) * 2;
#pragma unroll
    for (int i = 0; i < NCH; ++i) { const int idx = lane + 64 * i; if (idx < NCHK) *(LAS v4u*)(C.RAWB + idx * 8) = pre[i]; }
    LDS_WAIT(); asm volatile("" ::: "memory");
#pragma unroll
    for (int which = 0; which < 5; ++which)
#pragma unroll
        for (int pr = 0; pr < NTOK / 2; ++pr) { const int tt = 2 * pr + (lane >> 5), cc = which * 64 + c2, t = C.tb0 + tt;
            const unsigned r0 = *(const LAS unsigned*)(C.RAWB + tt * 320 + cc), r1 = *(const LAS unsigned*)(C.RAWB + (tt + 1) * 320 + cc), r2 = *(const LAS unsigned*)(C.RAWB + (tt + 2) * 320 + cc);
            const float p1x = bf2f(r1 & 0xffffu), p1y = bf2f(r1 >> 16);
            const float vx = p1x + C.mup_[which][0] * (bf2f(r0 & 0xffffu) - p1x) + C.mun_[which][0] * (bf2f(r2 & 0xffffu) - p1x);
            const float vy = p1y + C.mup_[which][1] * (bf2f(r0 >> 16) - p1y) + C.mun_[which][1] * (bf2f(r2 >> 16) - p1y);
            if (which == 0) *(LAS f32x2*)(OPS + t * 320 + 256 + c2) = (f32x2){vx, vy};
            else if (which == 1) *(LAS f32x2*)(OPS + t * 320 + 192 + c2) = (f32x2){vx, vy};
            else if (which == 2) { if (FULLV) *(LAS f32x2*)(VV + t * 64 + c2) = (f32x2){vx, vy}; else if ((c2 >> 4) == C.qtr) *(LAS f32x2*)(VV + t * 16 + (c2 & 15)) = (f32x2){vx, vy}; }
            else if (which == 3) { const float ex = __expf(2.f * vx), ey = __expf(2.f * vy);
                *(LAS unsigned*)(C.XW + tt * 72 + c2) = pk2(1.f - 2.f * __builtin_amdgcn_rcpf(ex + 1.f), 1.f - 2.f * __builtin_amdgcn_rcpf(ey + 1.f)); }
            else *(LAS unsigned*)(C.XA + tt * 72 + c2) = pk2(vx, vy); }
    LDS_WAIT(); asm volatile("" ::: "memory");
    { const bool hi = lane >= 32; const int lr = ((lane >> 4) & 1) * 4 + (hi ? 2 : 0); const bool ok0 = lr < NTOK, ok1 = lr + 1 < NTOK; const int tb = C.tb0 + lr;
#pragma unroll
      for (int ct = 0; ct < 4; ++ct) { const f32x4 z = {0.f, 0.f, 0.f, 0.f};
        const f32x4 ca = mma16_a8(C.XA, C.WA + ct * 16 * 72, z, lane), cw = mma16_a8(C.XW, C.WW + ct * 16 * 72, z, lane);
        const int c = ct * 16 + j;
        const float a0v = hi ? ca[2] : ca[0], a1v = hi ? ca[3] : ca[1], w0v = hi ? cw[2] : cw[0], w1v = hi ? cw[3] : cw[1];
        if (ok0) { OPS[tb * 320 + 128 + c] = sigmoidf_(C.ba[ct] + a0v); OPS[tb * 320 + c] = __expf(-0.6065306597f * sigmoidf_(C.bw[ct] + w0v)); }
        if (ok1) { OPS[(tb + 1) * 320 + 128 + c] = sigmoidf_(C.ba[ct] + a1v); OPS[(tb + 1) * 320 + c] = __expf(-0.6065306597f * sigmoidf_(C.bw[ct] + w1v)); } } }
    LDS_WAIT(); asm volatile("" ::: "memory");
#pragma unroll
    for (int ps = 0; ps < (NTOK + 3) / 4; ++ps) { const int tl = 4 * ps + (lane >> 4); const bool ok = tl < NTOK; const int t = C.tb0 + (ok ? tl : 0); LAS float* op = OPS + t * 320 + 4 * j;
        const f32x4 av = *(const LAS f32x4*)(op + 128), kp = *(const LAS f32x4*)(op + 192), rp = *(const LAS f32x4*)(op + 256);
        const f32x4 kr = kp * C.kk_c4; const float ss = row16_sum((kr.x * kr.x + kr.y * kr.y) + (kr.z * kr.z + kr.w * kr.w));
        const f32x4 kkv = kr * (1.f / fmaxf(sqrtf(ss), 1e-12f));
        const f32x4 km = kp * ((av - 1.f) * C.ka_c4 + 1.f);
        const f32x4 q = rp * km * C.rk_c4; const float cs = row16_sum((q.x + q.y) + (q.z + q.w));
        if (ok) { *(LAS f32x4*)(op + 64) = kkv; *(LAS f32x4*)(op + 128) = kkv * (-av); *(LAS f32x4*)(op + 192) = km;
            if (C.dir == 0 && C.qtr == 0 && j == 0) C.CT[(C.mb + T0 + t) * 8 + C.h] = cs; } }
}

constexpr int RW_NSLOT = 6, RW_SLOT_WORDS = 32 * 320 + 32 * 64;
constexpr size_t WS_RING = 248 * MiB;
constexpr int CW_RW = 8192;
__device__ __forceinline__ unsigned rw_ld(unsigned* p) { return __hip_atomic_load(p, __ATOMIC_RELAXED, __HIP_MEMORY_SCOPE_AGENT); }
__device__ __forceinline__ void rw_st(unsigned* p, unsigned v) { __hip_atomic_store(p, v, __ATOMIC_RELAXED, __HIP_MEMORY_SCOPE_AGENT); }
__device__ __forceinline__ void rwkv_produce(const Frame& F, int l, int p) {
    const int b = p / 12, rem = p % 12, h = rem >> 1, dir = rem & 1;
    const bf16* cols = (const bf16*)(WSP(F) + WS_COLS);
    const int tid = F.tid, lane = F.lane, wave = F.wave;
    LAS bf16* WA = (LAS bf16*)(F.lds); LAS bf16* WW = (LAS bf16*)(F.lds + 9216);
    LAS float* MU = (LAS float*)(F.lds + 67584);
    LAS float* OPS = (LAS float*)(F.lds + 70144);
    LAS float* VV = (LAS float*)(F.lds + 111104);
    LAS unsigned* flg = (LAS unsigned*)(F.lds + 119296);
    unsigned* ctl = (unsigned*)(WSP(F) + WS_CTL) + CW_RW + 320 * p;
    unsigned long long* ring = (unsigned long long*)(WSP(F) + WS_RING) + (size_t)p * RW_NSLOT * (RW_SLOT_WORDS / 2);
    constexpr int NB = SEQ / 32;
    __syncthreads();
    { const float* aup = INP(F, 13) + (size_t)l * 64 * 384; const float* wup = INP(F, 11) + (size_t)(l * 2 + dir) * 64 * 384;
      for (int idx = tid; idx < 4096; idx += 512) { const int i = idx >> 6, c = idx & 63;
          WA[c * 72 + i] = (bf16)f2bf(aup[i * 384 + h * 64 + c]); WW[c * 72 + i] = (bf16)f2bf(wup[i * 384 + h * 64 + c]); }
      if (tid < 320) { const int which = tid >> 6, c = tid & 63;
          const int rc = which == 0 ? h * 64 + c : which == 1 ? 384 + h * 64 + c : which == 2 ? 768 + h * 64 + c : which == 3 ? 1152 + dir * 64 + c : 1280 + c;
          MU[tid] = INP(F, 8)[l * 1472 + rc]; MU[320 + tid] = INP(F, 9)[l * 1472 + rc]; } }
    __syncthreads();
    const size_t mb = (size_t)b * SEQ;
    const int j = lane & 15;
    RwCtx C;
    C.WA = WA; C.WW = WW; C.XA = (LAS bf16*)(F.lds + 18432) + wave * 576; C.XW = (LAS bf16*)(F.lds + 27648) + wave * 576;
    C.RAWB = (LAS bf16*)(F.lds + 36864) + wave * 1920;
    C.MU = MU; C.CT = (float*)(WSP(F) + WS_CT); C.colsb = cols + mb * NINP; C.h = h; C.dir = dir; C.qtr = 0; C.mb = mb; C.tb0 = 4 * wave;
    { const int hc4 = h * 64 + 4 * j;
      C.kk_c4 = *(const f32x4*)(INP(F, 15) + l * 384 + hc4); C.ka_c4 = *(const f32x4*)(INP(F, 16) + l * 384 + hc4); C.rk_c4 = *(const f32x4*)(INP(F, 17) + l * 384 + hc4);
#pragma unroll
      for (int ct = 0; ct < 4; ++ct) { C.ba[ct] = INP(F, 12)[l * 384 + h * 64 + 16 * ct + j]; C.bw[ct] = INP(F, 10)[(l * 2 + dir) * 384 + h * 64 + 16 * ct + j]; }
      const int c2 = (lane & 31) * 2;
#pragma unroll
      for (int wq = 0; wq < 5; ++wq) { C.mup_[wq][0] = MU[wq * 64 + c2]; C.mup_[wq][1] = MU[wq * 64 + c2 + 1]; C.mun_[wq][0] = MU[320 + wq * 64 + c2]; C.mun_[wq][1] = MU[320 + wq * 64 + c2 + 1]; } }
    v4u pre[5]; int poff[5], prr[5];
    rw_addr_init<4>(poff, prr, lane, C.tb0, h, dir);
    rw_issue<4>(pre, poff, prr, C.colsb, dir ? SEQ - 32 : 0);
    const unsigned G0 = (unsigned)l * NB;
    bool dead = false; unsigned mseen = G0;
#pragma unroll 1
    for (int it = 0; it < NB; ++it) {
        const int T0 = dir ? SEQ - 32 * (it + 1) : 32 * it;
        v4u cur[5];
#pragma unroll
        for (int i = 0; i < 5; ++i) cur[i] = pre[i];
        if (it + 1 < NB) rw_issue<4>(pre, poff, prr, C.colsb, dir ? SEQ - 32 * (it + 2) : 32 * (it + 1));
        rw_prep<4, true>(C, cur, OPS, VV, T0, lane);
        if (tid == 0) { const unsigned need = G0 + (unsigned)it + 1u; unsigned sp = 0u;
            if (need > (unsigned)RW_NSLOT && !dead) { const unsigned want = need - (unsigned)RW_NSLOT;
                while (mseen < want) { if (++sp > (1u << 17)) { dead = true; break; } __builtin_amdgcn_s_sleep(2);
                    const unsigned m01 = min(rw_ld(ctl + 64), rw_ld(ctl + 128)), m23 = min(rw_ld(ctl + 192), rw_ld(ctl + 256)); mseen = min(m01, m23); } }
            flg[0] = sp; }
        __syncthreads();
        { unsigned long long* slot = ring + (size_t)((G0 + (unsigned)it) % RW_NSLOT) * (RW_SLOT_WORDS / 2);
          const LAS v4u* src = (const LAS v4u*)OPS;
#pragma unroll
          for (int i = 0; i < 6; ++i) { const int idx = tid + 512 * i; const v4u d = src[idx]; v4u* dst = (v4u*)slot + idx;
              asm volatile("global_store_dwordx4 %0, %1, off sc1\n\ts_nop 1" :: "v"(dst), "v"(d) : "memory"); } }
        asm volatile("s_waitcnt vmcnt(6)" ::: "memory");
        __syncthreads();
        if (tid == 0 && it >= 1) rw_st(ctl, G0 + (unsigned)it);
    }
    asm volatile("s_waitcnt vmcnt(0)" ::: "memory");
    __syncthreads();
    if (tid == 0) rw_st(ctl, G0 + (unsigned)NB);
    __syncthreads();
}
__device__ __forceinline__ void rwkv_scan(const Frame& F, int l, int p, int qtr) {
    const int b = p / 12, rem = p % 12, h = rem >> 1, dir = rem & 1;
    bf16* Y = (bf16*)(WSP(F) + (dir ? Y_RB : Y_RF));
    const int lane = F.lane, wave = F.wave;
    LAS float* OPSb = (LAS float*)(F.lds);
    LAS float* VVb = (LAS float*)(F.lds + 81920);
    LAS float* YBb = (LAS float*)(F.lds + 86016);
    unsigned* ctl = (unsigned*)(WSP(F) + WS_CTL) + CW_RW + 320 * p;
    const unsigned long long* ring = (const unsigned long long*)(WSP(F) + WS_RING) + (size_t)p * RW_NSLOT * (RW_SLOT_WORDS / 2);
    constexpr int NB = SEQ / 32;
    const size_t mb = (size_t)b * SEQ;
    const int j = lane & 15;
    const unsigned G0 = (unsigned)l * NB;
    __syncthreads();
    if (wave < 4) {
        const int lt = wave * 64 + lane;
        bool dead = false; unsigned pseen = G0;
#pragma unroll 1
        for (int it = 0; it <= NB; ++it) {
            if (it >= 1 && lt == 0) rw_st(ctl + 64 * (qtr + 1), G0 + (unsigned)it);
            if (it < NB) {
                const unsigned need = G0 + (unsigned)it + 1u; unsigned sp = 0u;
                if (!dead) { while (pseen < need) { pseen = rw_ld(ctl); if (pseen >= need) break; if (++sp > (1u << 17)) { dead = true; break; } __builtin_amdgcn_s_sleep(2); } }
                const unsigned long long* slot = ring + (size_t)((G0 + (unsigned)it) % RW_NSLOT) * (RW_SLOT_WORDS / 2);
                LAS unsigned long long* dO = (LAS unsigned long long*)(OPSb + (it & 1) * 10240); LAS unsigned long long* dV = (LAS unsigned long long*)(VVb + (it & 1) * 512);
                unsigned long long v[21];
#pragma unroll
                for (int i = 0; i < 20; ++i) v[i] = __hip_atomic_load(slot + lt + 256 * i, __ATOMIC_RELAXED, __HIP_MEMORY_SCOPE_AGENT);
                v[20] = __hip_atomic_load(slot + 5120 + (lt >> 3) * 32 + qtr * 8 + (lt & 7), __ATOMIC_RELAXED, __HIP_MEMORY_SCOPE_AGENT);
#pragma unroll
                for (int i = 0; i < 20; ++i) dO[lt + 256 * i] = v[i];
                dV[lt] = v[20];
            }
            if (it >= 2) { const int bk = it - 2; const int T0 = dir ? SEQ - 32 * (bk + 1) : 32 * bk; const LAS float* YB = YBb + (bk & 1) * 512;
                const int idx = lt * 2, tl = idx >> 4, rw = idx & 15;
                *(unsigned*)(Y + (mb + T0 + tl) * 384 + h * 64 + 16 * qtr + rw) = pk2(YB[idx], YB[idx + 1]); }
            __syncthreads();
        }
        { const int bk = NB - 1; const int T0 = dir ? SEQ - 32 * (bk + 1) : 32 * bk; const LAS float* YB = YBb + (bk & 1) * 512;
          const int idx = lt * 2, tl = idx >> 4, rw = idx & 15;
          *(unsigned*)(Y + (mb + T0 + tl) * 384 + h * 64 + 16 * qtr + rw) = pk2(YB[idx], YB[idx + 1]); }
    } else {
        const int row = (wave - 4) * 4 + (lane >> 4);
        f32x4 S = {0.f, 0.f, 0.f, 0.f};
#pragma unroll 1
        for (int it = 0; it <= NB; ++it) {
            if (it >= 1) { const int bk = it - 1;
                const LAS float* OPS = OPSb + (bk & 1) * 10240; const LAS float* VV = VVb + (bk & 1) * 512; LAS float* YB = YBb + (bk & 1) * 512;
                if (dir) rwkv_steps<true>(OPS, VV, YB, S, j, row); else rwkv_steps<false>(OPS, VV, YB, S, j, row);
            }
            __syncthreads();
        }
    }
    __syncthreads();
}
__device__ __forceinline__ float row8_sum(float v) { v += dppf<0xB1>(v); v += dppf<0x4E>(v); v += dppf<0x141>(v); return v; }
__device__ __forceinline__ void mlstm_seq(const Frame& F, int l, int task, int cfull0, int cend) {
    const int b = task >> 3, h = (task >> 1) & 3, dir = task & 1;
    const bf16* cols = (const bf16*)(WSP(F) + WS_COLS); const float* GT = (const float*)(WSP(F) + WS_GATES);
    bf16* Y = (bf16*)(WSP(F) + (dir ? Y_AB : Y_AF));
    LAS bf16* RAWQ = (LAS bf16*)(F.lds);
    LAS bf16* Qs = (LAS bf16*)(F.lds + 17408); LAS bf16* Ks = (LAS bf16*)(F.lds + 26624);
    LAS bf16* Vtb = (LAS bf16*)(F.lds + 35840);
    LAS bf16* KWt = (LAS bf16*)(F.lds + 54272); LAS bf16* Ps = (LAS bf16*)(F.lds + 63488);
    LAS bf16* Ctb = (LAS bf16*)(F.lds + 72704);
    LAS float* ub = (LAS float*)(F.lds + 91136);
    LAS float* blb = ub + 128; LAS float* rmb = ub + 256;
    LAS float* den = ub + 384; LAS float* qn = ub + 448; LAS float* nst = ub + 512; LAS float* scb = ub + 576;
    const int tid = F.tid, lane = F.lane, wave = F.wave;
    const size_t mb = (size_t)b * SEQ;
    constexpr int NC = SEQ / 64;
    __syncthreads();
    for (int i = tid; i < 2 * 64 * 72; i += 512) Ctb[i] = 0;
    if (tid < 64) nst[tid] = 0.f;
    const int cc = tid & 127, isK = cc >> 6, d0 = cc & 63, chn = isK * 256 + h * 64 + d0;
    float cw[5]; const float* cwp = INP(F, 3) + (size_t)l * 5 * 512;
#pragma unroll
    for (int jj = 0; jj < 5; ++jj) cw[jj] = cwp[jj * 512 + chn];
    const float cbv = INP(F, 4)[l * 512 + chn];
    f32x4 st[2] = {{0.f, 0.f, 0.f, 0.f}, {0.f, 0.f, 0.f, 0.f}};
    float m_st = 0.f;
    v4u pre[3], prev; float gli = 0.f, glf = 0.f;
#define ML_ISSUE(c_) do { const int tlo_ = dir ? SEQ - 64 * ((c_) + 1) : 64 * (c_); _Pragma("unroll") for (int i_ = 0; i_ < 3; ++i_) { const int ch_ = tid + 512 * i_; pre[i_] = (v4u){0u, 0u, 0u, 0u}; \
        if (ch_ < 68 * 16) { const int rr_ = ch_ >> 4, q_ = ch_ & 15; const int t_ = tlo_ - 2 + rr_; if (t_ >= 0 && t_ < SEQ) pre[i_] = *(const v4u*)(cols + (mb + t_) * NINP + (q_ >> 3) * 256 + h * 64 + (q_ & 7) * 8); } } \
        prev = *(const v4u*)(cols + (mb + tlo_ + (tid >> 3)) * NINP + A_V + h * 64 + (tid & 7) * 8); \
        if (tid < 64) { const int t_ = dir ? tlo_ + 63 - tid : tlo_ + tid; gli = GT[(mb + t_) * 16 + dir * 4 + h]; glf = GT[(mb + t_) * 16 + 8 + dir * 4 + h]; } } while (0)
#define ML_FILL(c_) do { _Pragma("unroll") for (int i_ = 0; i_ < 3; ++i_) { const int ch_ = tid + 512 * i_; if (ch_ < 68 * 16) *(LAS v4u*)(RAWQ + (ch_ >> 4) * 128 + (ch_ & 15) * 8) = pre[i_]; } \
        { LAS bf16* Vt_ = Vtb + ((c_) & 1) * 4608; const int tl_ = tid >> 3, e8_ = tid & 7; const int lp_ = dir ? 63 - tl_ : tl_; const unsigned w_[4] = {prev.x, prev.y, prev.z, prev.w}; \
          _Pragma("unroll") for (int k_ = 0; k_ < 4; ++k_) { const int e_ = e8_ * 8 + 2 * k_; Vt_[e_ * 72 + swz64(e_, lp_)] = (bf16)(w_[k_] & 0xffffu); Vt_[(e_ + 1) * 72 + swz64(e_ + 1, lp_)] = (bf16)(w_[k_] >> 16); } } \
        if (tid < 64) { const float bl_ = wave_scan_add(glf); \
            const float u_ = gli - bl_; const float rm_ = wave_scan_max(u_); \
            ub[((c_) & 1) * 64 + tid] = u_; blb[((c_) & 1) * 64 + tid] = bl_; rmb[((c_) & 1) * 64 + tid] = rm_; if (tid == 63) { scb[((c_) & 1) * 2] = rm_; scb[((c_) & 1) * 2 + 1] = bl_; } } } while (0)
    ML_ISSUE(0); ML_FILL(0); ML_ISSUE(1);
    __syncthreads();
#pragma unroll 1
    for (int c = 0; c < cend; ++c) {
        const bool full = c >= cfull0;
        const int tlo = dir ? SEQ - 64 * (c + 1) : 64 * c;
        const LAS float* u = ub + (c & 1) * 64; const LAS float* bl = blb + (c & 1) * 64; const LAS float* rm = rmb + (c & 1) * 64;
        const LAS bf16* Vt = Vtb + (c & 1) * 4608; const LAS bf16* Ct = Ctb + (c & 1) * 4608; LAS bf16* Ctn = Ctb + ((c + 1) & 1) * 4608;
#pragma unroll 4
        for (int i = 0; i < 16; ++i) { const int tl = (tid >> 7) + 4 * i; float s = cbv;
#pragma unroll
            for (int jj = 0; jj < 5; ++jj) s += cw[jj] * bf2f(RAWQ[(tl + jj) * 128 + cc]);
            s = siluf_(s); const int lpos = dir ? 63 - tl : tl;
            if (isK) Ks[lpos * 72 + d0] = (bf16)f2bf(s * 0.125f); else Qs[lpos * 72 + d0] = (bf16)f2bf(s); }
        if (tid < 64) den[tid] = 0.f;
        __syncthreads();
        const float umax = scb[(c & 1) * 2], tot = scb[(c & 1) * 2 + 1];
        for (int idx = tid; idx < 4096; idx += 512) { const int lp = idx >> 6, d = idx & 63; KWt[d * 72 + swz64(d, lp)] = (bf16)f2bf(bf2f(Ks[lp * 72 + d]) * __expf(u[lp] - umax)); }
        if (full) {
#pragma unroll
        for (int k = 0; k < 2; ++k) { const int ti = 2 * wave + k, tl_ = ti >> 2, ts = ti & 3; f32x4 acc = {0.f, 0.f, 0.f, 0.f};
            if (ts <= tl_) acc = mma16<64>(Qs + tl_ * 16 * 72, 72, Ks + ts * 16 * 72, 72, acc, lane);
#pragma unroll
            for (int jj = 0; jj < 4; ++jj) { const int lr = tl_ * 16 + (lane >> 4) * 4 + jj, s = ts * 16 + (lane & 15);
                const float v = (s <= lr) ? acc[jj] * __expf(u[s] - fmaxf(m_st, rm[lr])) : 0.f; const unsigned vb = f2bf(v); Ps[lr * 72 + s] = (bf16)vb;
                if (ts <= tl_) { const float rs = row16_sum(bf2f(vb)); if ((lane & 15) == 0) __hip_atomic_fetch_add(den + lr, rs, __ATOMIC_RELAXED, __HIP_MEMORY_SCOPE_WORKGROUP); } } }
        { const int lq = tid >> 3, part = tid & 7; float s = 0.f;
#pragma unroll
          for (int k = 0; k < 8; ++k) s += bf2f(Qs[lq * 72 + part * 8 + k]) * nst[part * 8 + k];
          s = row8_sum(s); if (part == 0) qn[lq] = s; }
        }
        __syncthreads();
        const float mmax = fmaxf(m_st, umax), s_old = __expf(m_st - mmax), s_new = __expf(umax - mmax);
#pragma unroll
        for (int k = 0; k < 2; ++k) { const int ti = 2 * wave + k, t0_ = ti >> 2, t1_ = ti & 3; const f32x4 z = {0.f, 0.f, 0.f, 0.f};
            f32x4 a1 = z, a2 = z;
            if (full) { a1 = mma16s<false, true>(Ps, 72, t0_ * 16, Vt, 72, t1_ * 16, z, lane); a2 = mma16<64>(Qs + t0_ * 16 * 72, 72, Ct + t1_ * 16 * 72, 72, z, lane); }
            const f32x4 lc = mma16s<true, true>(Vt, 72, t0_ * 16, KWt, 72, t1_ * 16, z, lane);
#pragma unroll
            for (int jj = 0; jj < 4; ++jj) { const int r_ = t0_ * 16 + (lane >> 4) * 4 + jj, c_ = t1_ * 16 + (lane & 15);
                if (full) { const float mx = fmaxf(m_st, rm[r_]), iwv = __expf(m_st - mx);
                const float dn = den[r_] + iwv * qn[r_];
                const float val = (a1[jj] + iwv * a2[jj]) / fmaxf(fabsf(dn), __expf(-(bl[r_] + mx)));
                const int t = dir ? tlo + 63 - r_ : tlo + r_;
                Y[(mb + t) * 256 + h * 64 + c_] = (bf16)f2bf(val); }
                st[k][jj] = s_old * st[k][jj] + s_new * lc[jj];
                Ctn[r_ * 72 + c_] = (bf16)f2bf(st[k][jj]); } }
        { const int dq = tid >> 3, part = tid & 7; float s = 0.f;
#pragma unroll
          for (int k = 0; k < 8; ++k) s += bf2f(KWt[dq * 72 + swz64(dq, part * 8) + k]);
          s = row8_sum(s); if (part == 0) nst[dq] = s_old * nst[dq] + s_new * s; }
        m_st = tot + mmax;
        if (c + 1 < cend) { ML_FILL(c + 1); if (c + 2 < cend) ML_ISSUE(c + 2); }
        __syncthreads();
    }
#undef ML_ISSUE
#undef ML_FILL
}
__device__ __forceinline__ void phase_ssd_conv(const Frame& F, int l) {
    const bf16* cols = (const bf16*)(WSP(F) + WS_COLS); bf16* XBC = (bf16*)(WSP(F) + WS_XN);
    LAS bf16* raw = (LAS bf16*)(F.lds);
    const float* cwp = INP(F, 20) + (size_t)l * 5 * 896; const float* cbp = INP(F, 21) + l * 896;
    const int tid = F.tid;
    float cw0[5], cw1[5]; const int c1 = tid + 512 < 896 ? tid + 512 : tid;
#pragma unroll
    for (int jj = 0; jj < 5; ++jj) { cw0[jj] = cwp[jj * 896 + tid]; cw1[jj] = cwp[jj * 896 + c1]; }
    const float cb0 = cbp[tid], cb1 = cbp[c1];
    for (int tile = F.vcu; tile < M / 32; tile += F.G) {
        const int m0 = tile * 32, t0 = m0 % SEQ;
        __syncthreads();
        for (int ch = tid; ch < 36 * 112; ch += 512) { const int rr = ch / 112, cc = ch % 112; const int t = t0 - 2 + rr;
            v4u v = {0u, 0u, 0u, 0u}; if (t >= 0 && t < SEQ) v = *(const v4u*)(cols + (size_t)(m0 - 2 + rr) * NINP + S_X + cc * 8);
            *(LAS v4u*)(raw + rr * 896 + cc * 8) = v; }
        __syncthreads();
#pragma unroll
        for (int half = 0; half < 2; ++half) { const int c = half ? c1 : tid; if (half && tid + 512 >= 896) break;
            float win[5];
#pragma unroll
            for (int jj = 0; jj < 4; ++jj) win[jj] = bf2f(raw[jj * 896 + c]);
            for (int tl = 0; tl < 32; ++tl) { win[4] = bf2f(raw[(tl + 4) * 896 + c]);
                float s = half ? cb1 : cb0;
#pragma unroll
                for (int jj = 0; jj < 5; ++jj) s += (half ? cw1[jj] : cw0[jj]) * win[jj];
#pragma unroll
                for (int jj = 0; jj < 4; ++jj) win[jj] = win[jj + 1];
                XBC[(size_t)(m0 + tl) * 896 + c] = (bf16)f2bf(siluf_(s)); } }
    }
    __syncthreads();
}
__device__ __forceinline__ void ssd_seq(const Frame& F, int l, int task, int cfull0, int cend) {
    const int b = task / 12, rem = task % 12, head = rem >> 1, dir = rem & 1, g = head / 3;
    const bf16* cols = (const bf16*)(WSP(F) + WS_COLS); const bf16* XBC = (const bf16*)(WSP(F) + WS_XN);
    bf16* Y = (bf16*)(WSP(F) + (dir ? Y_SB : Y_SF));
    LAS bf16* Cm = (LAS bf16*)(F.lds); LAS bf16* Bm = (LAS bf16*)(F.lds + 17408);
    LAS bf16* Btw = (LAS bf16*)(F.lds + 34816); LAS bf16* Xt = (LAS bf16*)(F.lds + 53248);
    LAS bf16* Ps = (LAS bf16*)(F.lds + 62464); LAS bf16* Hs = (LAS bf16*)(F.lds + 71680);
    LAS float* dtvb = (LAS float*)(F.lds + 89088);
    LAS float* acsb = dtvb + 128;
    LAS float* totb = dtvb + 256;
    const int tid = F.tid, lane = F.lane, wave = F.wave;
    const size_t mb = (size_t)b * SEQ;
    constexpr int NC = SEQ / 64;
    __syncthreads();
    for (int i = tid; i < 64 * 136; i += 512) Hs[i] = 0;
    const float dtb = INP(F, 22)[(l * 2 + dir) * 6 + head];
    const float aneg = -__expf(INP(F, 23)[(l * 2 + dir) * 6 + head]);
    f32x4 st[4];
#pragma unroll
    for (int k = 0; k < 4; ++k) st[k] = (f32x4){0.f, 0.f, 0.f, 0.f};
    v4u pre[5]; float dtraw = 0.f;
#define SSD_ISSUE(c_) do { const int tlo_ = dir ? SEQ - 64 * ((c_) + 1) : 64 * (c_); _Pragma("unroll") for (int i_ = 0; i_ < 5; ++i_) { const int idx_ = tid + 512 * i_; const int tl_ = idx_ / 40, q_ = idx_ % 40; \
        const int gc_ = q_ < 8 ? head * 64 + q_ * 8 : (q_ < 24 ? 384 + g * 128 + (q_ - 8) * 8 : 640 + g * 128 + (q_ - 24) * 8); \
        pre[i_] = *(const v4u*)(XBC + (mb + tlo_ + tl_) * 896 + gc_); } } while (0)
#define SSD_DTLOAD(c_) do { if (tid < 64) { const int tlo_ = dir ? SEQ - 64 * ((c_) + 1) : 64 * (c_); const int t_ = dir ? tlo_ + 63 - tid : tlo_ + tid; dtraw = bf2f(cols[(mb + t_) * NINP + S_DT + dir * 6 + head]); } } while (0)
#define SSD_DTCALC(c_) do { if (tid < 64) { const float x_ = dtraw + dtb; const float dt_ = x_ > 20.f ? x_ : log1pf(__expf(x_)); float cs_ = dt_ * aneg; \
        cs_ = wave_scan_add(cs_); \
        const float tt_ = __builtin_bit_cast(float, __builtin_amdgcn_readlane(__builtin_bit_cast(int, cs_), 63)); dtvb[((c_) & 1) * 64 + tid] = dt_; acsb[((c_) & 1) * 64 + tid] = cs_; if (tid == 0) totb[(c_) & 1] = tt_; } } while (0)
    SSD_ISSUE(0); SSD_DTLOAD(0); SSD_DTCALC(0); SSD_DTLOAD(1);
    __syncthreads();
#pragma unroll 1
    for (int c = 0; c < cend; ++c) {
        const bool full = c >= cfull0;
        const int tlo = dir ? SEQ - 64 * (c + 1) : 64 * c;
        const LAS float* dtv = dtvb + (c & 1) * 64; const LAS float* acs = acsb + (c & 1) * 64; const float tot = totb[c & 1];
#pragma unroll
        for (int i = 0; i < 5; ++i) { const int idx = tid + 512 * i; const int tl = idx / 40, q = idx % 40; const int lp = dir ? 63 - tl : tl;
            const unsigned w[4] = {pre[i].x, pre[i].y, pre[i].z, pre[i].w};
            if (q < 8) {
#pragma unroll
                for (int k = 0; k < 4; ++k) { const int p0 = q * 8 + 2 * k; Xt[p0 * 72 + swz64(p0, lp)] = (bf16)(w[k] & 0xffffu); Xt[(p0 + 1) * 72 + swz64(p0 + 1, lp)] = (bf16)(w[k] >> 16); } }
            else if (q < 24) { const int n0 = (q - 8) * 8; if (full) *(LAS v4u*)(Bm + lp * 136 + n0) = pre[i]; const float sc = dtv[lp] * __expf(tot - acs[lp]);
#pragma unroll
                for (int k = 0; k < 4; ++k) { const int nn = n0 + 2 * k; Btw[nn * 72 + swz64(nn, lp)] = (bf16)f2bf(bf2f(w[k] & 0xffffu) * sc); Btw[(nn + 1) * 72 + swz64(nn + 1, lp)] = (bf16)f2bf(bf2f(w[k] >> 16) * sc); } }
            else if (full) { const int n0 = (q - 24) * 8; *(LAS v4u*)(Cm + lp * 136 + n0) = pre[i]; } }
        if (c + 1 < cend) SSD_ISSUE(c + 1);
        __syncthreads();
        f32x4 yo[2] = {{0.f, 0.f, 0.f, 0.f}, {0.f, 0.f, 0.f, 0.f}}, lc[4];
        if (full) {
#pragma unroll
        for (int k = 0; k < 2; ++k) { const int ti = 2 * wave + k, tl_ = ti >> 2, ts = ti & 3; f32x4 acc = {0.f, 0.f, 0.f, 0.f};
            if (ts <= tl_) acc = mma16<128>(Cm + tl_ * 16 * 136, 136, Bm + ts * 16 * 136, 136, acc, lane);
#pragma unroll
            for (int jj = 0; jj < 4; ++jj) { const int lr = tl_ * 16 + (lane >> 4) * 4 + jj, s = ts * 16 + (lane & 15);
                const float v = (s <= lr) ? acc[jj] * __expf(acs[lr] - acs[s]) * dtv[s] : 0.f; Ps[lr * 72 + s] = (bf16)f2bf(v); }
            const f32x4 z = {0.f, 0.f, 0.f, 0.f};
            yo[k] = mma16<128>(Cm + tl_ * 16 * 136, 136, Hs + ts * 16 * 136, 136, z, lane); }
        }
#pragma unroll
        for (int k = 0; k < 4; ++k) { const int ti = 4 * wave + k, tp = ti >> 3, tn = ti & 7; const f32x4 z = {0.f, 0.f, 0.f, 0.f};
            lc[k] = mma16s<true, true>(Xt, 72, tp * 16, Btw, 72, tn * 16, z, lane); }
        __syncthreads();
        const float cdec = __expf(tot);
        if (full) {
#pragma unroll
        for (int k = 0; k < 2; ++k) { const int ti = 2 * wave + k, tl_ = ti >> 2, tp = ti & 3; const f32x4 z = {0.f, 0.f, 0.f, 0.f};
            const f32x4 yd = mma16s<false, true>(Ps, 72, tl_ * 16, Xt, 72, tp * 16, z, lane);
#pragma unroll
            for (int jj = 0; jj < 4; ++jj) { const int lr = tl_ * 16 + (lane >> 4) * 4 + jj, p = tp * 16 + (lane & 15);
                const float val = yd[jj] + yo[k][jj] * __expf(acs[lr]);
                const int t = dir ? tlo + 63 - lr : tlo + lr;
                Y[(mb + t) * 384 + head * 64 + p] = (bf16)f2bf(val); } }
        }
#pragma unroll
        for (int k = 0; k < 4; ++k) { const int ti = 4 * wave + k, tp = ti >> 3, tn = ti & 7;
#pragma unroll
            for (int jj = 0; jj < 4; ++jj) { const int p = tp * 16 + (lane >> 4) * 4 + jj, n = tn * 16 + (lane & 15);
                st[k][jj] = cdec * st[k][jj] + lc[k][jj]; Hs[p * 136 + n] = (bf16)f2bf(st[k][jj]); } }
        if (c + 1 < cend) { SSD_DTCALC(c + 1); if (c + 2 < cend) SSD_DTLOAD(c + 2); }
        __syncthreads();
    }
#undef SSD_ISSUE
#undef SSD_DTLOAD
#undef SSD_DTCALC
}
__device__ __forceinline__ float wave_sum2(float v) { v = row16_sum(v); v += __shfl_xor(v, 16); v += __shfl_xor(v, 32); return v; }
__device__ __forceinline__ f32x4 bf4(v2u w) { return (f32x4){bf2f(w.x & 0xffffu), bf2f(w.x >> 16), bf2f(w.y & 0xffffu), bf2f(w.y >> 16)}; }
__device__ __forceinline__ v2u pk4(f32x4 v) { v2u w; w.x = pk2(v.x, v.y); w.y = pk2(v.z, v.w); return w; }
__device__ __forceinline__ void phase_post(const Frame& F, int l) {
    const bf16* cols = (const bf16*)(WSP(F) + WS_COLS); bf16* MIX = (bf16*)(WSP(F) + WS_XN);
    const bf16* YAf = (const bf16*)(WSP(F) + Y_AF); const bf16* YAb = (const bf16*)(WSP(F) + Y_AB);
    const bf16* YRf = (const bf16*)(WSP(F) + Y_RF); const bf16* YRb = (const bf16*)(WSP(F) + Y_RB);
    const bf16* YSf = (const bf16*)(WSP(F) + Y_SF); const bf16* YSb = (const bf16*)(WSP(F) + Y_SB);
    const float* CT = (const float*)(WSP(F) + WS_CT);
    LAS bf16* GU = (LAS bf16*)(F.lds);
    LAS bf16* SG = (LAS bf16*)(F.lds + 104448);
    LAS float* gate = (LAS float*)(F.lds + 108800);
    LAS float* SCW = (LAS float*)(F.lds + 133632);
    const int tid = F.tid, lane = F.lane, wave = F.wave;
    const float* mup = INP(F, 8) + l * 1472; const float* mun = INP(F, 9) + l * 1472;
    const float* gup = INP(F, 14) + (size_t)l * 128 * 384;
    const float* sdk = INP(F, 24) + l * 6;
    __syncthreads();
    for (int idx = tid; idx < 128 * 384; idx += 512) { const int i = idx / 384, c = idx % 384; GU[c * 136 + i] = (bf16)f2bf(gup[idx]); }
    { const float* scw = INP(F, 20) + (size_t)l * 5 * 896; for (int idx = tid; idx < 5 * 384; idx += 512) SCW[idx] = scw[(idx / 384) * 896 + (idx % 384)]; }
    const int gch = tid & 15;
    float gmp[8], gmn[8];
#pragma unroll
    for (int k = 0; k < 8; ++k) { gmp[k] = mup[1344 + 8 * gch + k]; gmn[k] = mun[1344 + 8 * gch + k]; }
    const int qa = lane, qb = 64 + (lane & 31);
    const f32x4 mng4 = *(const f32x4*)(INP(F, 7) + l * 256 + 4 * qa);
    f32x4 rmp[2], rmn[2], rng[2], rnb[2], scb[2], sng[2];
#pragma unroll
    for (int ps = 0; ps < 2; ++ps) { const int c0 = 4 * (ps ? qb : qa);
        rmp[ps] = *(const f32x4*)(mup + 768 + c0); rmn[ps] = *(const f32x4*)(mun + 768 + c0);
        rng[ps] = *(const f32x4*)(INP(F, 18) + l * 384 + c0); rnb[ps] = *(const f32x4*)(INP(F, 19) + l * 384 + c0);
        scb[ps] = *(const f32x4*)(INP(F, 21) + l * 896 + c0); sng[ps] = *(const f32x4*)(INP(F, 25) + l * 384 + c0); }
    for (int tile = F.vcu; tile < M / 16; tile += F.G) {
        const int m0 = tile * 16;
        __syncthreads();
        if (tid < 256) { const int tt = tid >> 4; const int m = m0 + tt, t = m % SEQ; const bf16* cp = cols + (size_t)m * NINP + R_GD + 8 * gch;
            const v4u c1 = *(const v4u*)cp; v4u c0 = {0u, 0u, 0u, 0u}, c2 = {0u, 0u, 0u, 0u};
            if (t > 0) c0 = *(const v4u*)(cp - NINP); if (t < SEQ - 1) c2 = *(const v4u*)(cp + NINP);
            const unsigned w0[4] = {c0.x, c0.y, c0.z, c0.w}, w1[4] = {c1.x, c1.y, c1.z, c1.w}, w2[4] = {c2.x, c2.y, c2.z, c2.w}; unsigned o[4];
#pragma unroll
            for (int k = 0; k < 4; ++k) { const float a1 = bf2f(w1[k] & 0xffffu), b1 = bf2f(w1[k] >> 16);
                const float va = a1 + gmp[2 * k] * (bf2f(w0[k] & 0xffffu) - a1) + gmn[2 * k] * (bf2f(w2[k] & 0xffffu) - a1);
                const float vb = b1 + gmp[2 * k + 1] * (bf2f(w0[k] >> 16) - b1) + gmn[2 * k + 1] * (bf2f(w2[k] >> 16) - b1);
                o[k] = pk2(sigmoidf_(va), sigmoidf_(vb)); }
            *(LAS v4u*)(SG + tt * 136 + 8 * gch) = (v4u){o[0], o[1], o[2], o[3]}; }
        __syncthreads();
#pragma unroll
        for (int k = 0; k < 3; ++k) { const int ct = wave + 8 * k; const f32x4 z = {0.f, 0.f, 0.f, 0.f};
            const f32x4 acc = mma16<128>(SG, 136, GU + ct * 16 * 136, 136, z, lane);
#pragma unroll
            for (int jj = 0; jj < 4; ++jj) gate[((lane >> 4) * 4 + jj) * 388 + ct * 16 + (lane & 15)] = acc[jj]; }
        __syncthreads();
#pragma unroll 1
        for (int k = 0; k < 2; ++k) { const int tt = wave * 2 + k; const int m = m0 + tt, t = m % SEQ; const size_t cr = (size_t)m * NINP;
            { const int c0 = 4 * qa;
              const f32x4 hs = bf4(*(const v2u*)(YAf + (size_t)m * 256 + c0)) + bf4(*(const v2u*)(YAb + (size_t)m * 256 + c0));
              const float mean = row16_sum((hs.x + hs.y) + (hs.z + hs.w)) * (1.f / 64.f); const f32x4 d = hs - mean;
              const float var = row16_sum((d.x * d.x + d.y * d.y) + (d.z * d.z + d.w * d.w)) * (1.f / 64.f);
              const f32x4 o = bf4(*(const v2u*)(cols + cr + A_O + c0));
              f32x4 y = d * (1.f / sqrtf(var + 1e-6f)) * mng4;
              y.x *= sigmoidf_(o.x); y.y *= sigmoidf_(o.y); y.z *= sigmoidf_(o.z); y.w *= sigmoidf_(o.w);
              *(v2u*)(MIX + (size_t)m * DM + c0) = pk4(y); }
#pragma unroll
            for (int ps = 0; ps < 2; ++ps) { const int qd = ps ? qb : qa, c0 = 4 * qd; const bool act = ps == 0 || lane < 32;
              const f32x4 ys = bf4(*(const v2u*)(YRf + (size_t)m * 384 + c0)) + bf4(*(const v2u*)(YRb + (size_t)m * 384 + c0));
              const float mean = row16_sum((ys.x + ys.y) + (ys.z + ys.w)) * (1.f / 64.f); const f32x4 d = ys - mean;
              const float var = row16_sum((d.x * d.x + d.y * d.y) + (d.z * d.z + d.w * d.w)) * (1.f / 64.f);
              const f32x4 y = d * (1.f / sqrtf(var + 64e-5f)) * rng[ps] + rnb[ps];
              const f32x4 p1 = bf4(*(const v2u*)(cols + cr + R_V + c0));
              f32x4 p0 = {0.f, 0.f, 0.f, 0.f}, p2 = {0.f, 0.f, 0.f, 0.f};
              if (t > 0) p0 = bf4(*(const v2u*)(cols + cr - NINP + R_V + c0)); if (t < SEQ - 1) p2 = bf4(*(const v2u*)(cols + cr + NINP + R_V + c0));
              const f32x4 vv = p1 + rmp[ps] * (p0 - p1) + rmn[ps] * (p2 - p1);
              const float ctv = CT[(size_t)m * 8 + (qd >> 4)];
              const f32x4 g4 = *(const LAS f32x4*)(gate + tt * 388 + c0);
              if (act) *(v2u*)(MIX + (size_t)m * DM + 256 + c0) = pk4((y + vv * ctv) * g4); }
            f32x4 yv[2]; float ssq0 = 0.f, ssq1 = 0.f;
#pragma unroll
            for (int ps = 0; ps < 2; ++ps) { const int qd = ps ? qb : qa, c0 = 4 * qd; const bool act = ps == 0 || lane < 32;
              f32x4 s = scb[ps];
#pragma unroll
              for (int jj = 0; jj < 5; ++jj) { const int tq = t + jj - 2; if (tq >= 0 && tq < SEQ) s += *(const LAS f32x4*)(SCW + jj * 384 + c0) * bf4(*(const v2u*)(cols + cr + (jj - 2) * NINP + S_X + c0)); }
              const f32x4 z = bf4(*(const v2u*)(cols + cr + S_Z + c0));
              f32x4 y = bf4(*(const v2u*)(YSf + (size_t)m * 384 + c0)) + bf4(*(const v2u*)(YSb + (size_t)m * 384 + c0));
              const float dsk = sdk[qd >> 4];
              y.x = (y.x + dsk * siluf_(s.x)) * siluf_(z.x); y.y = (y.y + dsk * siluf_(s.y)) * siluf_(z.y); y.z = (y.z + dsk * siluf_(s.z)) * siluf_(z.z); y.w = (y.w + dsk * siluf_(s.w)) * siluf_(z.w);
              yv[ps] = y; const float sq = act ? (y.x * y.x + y.y * y.y) + (y.z * y.z + y.w * y.w) : 0.f;
              if (qd < 48) ssq0 += sq; else ssq1 += sq; }
            const float r0 = 1.f / sqrtf(wave_sum2(ssq0) * (1.f / 192.f) + 1e-6f), r1 = 1.f / sqrtf(wave_sum2(ssq1) * (1.f / 192.f) + 1e-6f);
#pragma unroll
            for (int ps = 0; ps < 2; ++ps) { const int qd = ps ? qb : qa, c0 = 4 * qd; const bool act = ps == 0 || lane < 32;
              if (act) *(v2u*)(MIX + (size_t)m * DM + 640 + c0) = pk4(yv[ps] * (qd < 48 ? r0 : r1) * sng[ps]); }
        }
    }
    __syncthreads();
}
namespace cg = cooperative_groups;
constexpr int N_PHASES = 9 * DEPTH + 1;
__global__ void __launch_bounds__(NWAVES * 64, 2) mk_fwd(Args args) {
    extern __shared__ __attribute__((aligned(16))) unsigned char lds_raw[];
    Frame F;
    F.lds = (LAS unsigned char*)lds_raw;
    F.tid = threadIdx.x; F.lane = F.tid & 63; F.wave = __builtin_amdgcn_readfirstlane(F.tid >> 6);
    F.G = gridDim.x; { const int bx = blockIdx.x; F.vcu = (F.G % 8 == 0) ? (bx % 8) * (F.G / 8) + bx / 8 : bx; }
    volatile LAS unsigned* MISC = (volatile LAS unsigned*)(F.lds + MISC_OFF);
    if (F.tid < 64) MISC[F.tid] = 0u;
    if (F.tid < 34) *(LAS unsigned long long*)(F.lds + PTAB_OFF + 8 * F.tid) = ((const unsigned long long*)__builtin_amdgcn_kernarg_segment_ptr())[F.tid];
    __syncthreads();
    unsigned* ctl = (unsigned*)(WSP(F) + WS_CTL);
    XcdBarrier bar = xcd_barrier_post(ctl + CW_BAR, MISC + 8);
    const int lo = args.ph_lo, hi = args.ph_hi;
#define IN_(k) (lo <= (k) && (k) < hi)
#define SEAM(k) do { if (IN_(k) && IN_((k) + 1)) { if ((k) == 0) cg::this_grid().sync(); else xcd_barrier(bar); } } while (0)
#define LAYER(l, B) \
    if (IN_(B + 0)) { phase_convert(F, l); phase_norm(F, l == 0 ? INP(F, 0) : OUTP(F), INP(F, 1) + l * DM, (bf16*)(WSP(F) + WS_XN)); } SEAM(B + 0); \
    if (IN_(B + 1)) { unsigned char* ws = WSP(F); pg8::Gemm g{(const bf16*)(ws + WS_XN), (const bf16*)(ws + WS_WIN), M, NINP, DM}; pg8::StaticOrder S; S.init(M, NINP, F.G, (int)blockIdx.x); \
            pg8::EpiBf16<0> E{(bf16*)(ws + WS_COLS), NINP, nullptr, 0, 0, 1.f}; \
            pg8::gemm_phase<pg8::EpiBf16<0>, pg8::StaticOrder, PG8_ALIGN, PG8_SP2>(F.lds, g, S, E); } SEAM(B + 1); \
    if (IN_(B + 2)) { phase_gates(F, l); phase_ssd_conv(F, l); } SEAM(B + 2); \
    if (IN_(B + 3)) { const int bx = blockIdx.x; \
            if (bx < 96) { const int c8 = bx & 7, k8 = bx >> 3; rwkv_scan(F, l, c8 + 8 * (k8 >> 2), k8 & 3); } else if (bx < 120) rwkv_produce(F, l, bx - 96); else if (bx < 216) { const int u = bx - 120, sg = 3 - (u / 24); ssd_seq(F, l, u % 24, 32 * sg, 32 * sg + 32); } else if (bx < 248) { const int u = bx - 216, sg = 1 - (u / 16); mlstm_seq(F, l, u % 16, 64 * sg, 64 * sg + 64); } } SEAM(B + 3); \
    if (IN_(B + 4)) phase_post(F, l); SEAM(B + 4); \
    if (IN_(B + 5)) { unsigned char* ws = WSP(F); pg8::Gemm g{(const bf16*)(ws + WS_XN), (const bf16*)(ws + WS_WOUT), M, DM, DM}; pg8::StaticOrder S; S.init(M, DM, F.G, (int)blockIdx.x); \
            pg8::EpiResidual E{l == 0 ? INP(F, 0) : OUTP(F), OUTP(F), DM}; \
            pg8::gemm_phase<pg8::EpiResidual, pg8::StaticOrder, PG8_ALIGN, PG8_SP2>(F.lds, g, S, E); } SEAM(B + 5); \
    if (IN_(B + 6)) phase_norm(F, OUTP(F), INP(F, 27) + l * DM, (bf16*)(WSP(F) + WS_XN)); SEAM(B + 6); \
    if (IN_(B + 7)) { unsigned char* ws = WSP(F); pg8::Gemm g{(const bf16*)(ws + WS_XN), (const bf16*)(ws + WS_WGU), M, 2 * FFN, DM}; pg8::StaticOrder S; S.init(M, 2 * FFN, F.G, (int)blockIdx.x); \
            pg8::EpiSwiGLU E{(bf16*)(ws + WS_COLS), FFN}; \
            pg8::gemm_phase<pg8::EpiSwiGLU, pg8::StaticOrder, PG8_ALIGN, PG8_SP2>(F.lds, g, S, E); } SEAM(B + 7); \
    if (IN_(B + 8)) { unsigned char* ws = WSP(F); pg8::Gemm g{(const bf16*)(ws + WS_COLS), (const bf16*)(ws + WS_WDN), M, DM, FFN}; pg8::StaticOrder S; S.init(M, DM, F.G, (int)blockIdx.x); \
            pg8::EpiResidual E{OUTP(F), OUTP(F), DM}; \
            pg8::gemm_phase<pg8::EpiResidual, pg8::StaticOrder, PG8_ALIGN, PG8_SP2>(F.lds, g, S, E); } SEAM(B + 8);
    LAYER(0, 0)
    LAYER(1, 9)
    if (IN_(18)) phase_final_norm(F, OUTP(F), INP(F, 31));
#undef IN_
#undef SEAM
#undef LAYER
}

#ifndef MK_PER_PHASE
#define MK_PER_PHASE 0
#endif
extern "C" void kernel_launch(void* const* d_in, const int* in_sizes, int n_in, void* d_out, int out_size, void* d_ws, size_t ws_size, hipStream_t stream) {
    static int grid = 0;
    if (grid == 0) {
        int dev = 0, cus = 0;
        if (n_in != 32 || out_size != M * DM || ws_size < WS_END) { fprintf(stderr, "kernel_launch: unexpected shapes (n_in %d out %d ws %zu)\n", n_in, out_size, ws_size); grid = -1; return; }
        if (hipGetDevice(&dev) != hipSuccess || hipDeviceGetAttribute(&cus, hipDeviceAttributeMultiprocessorCount, dev) != hipSuccess) { grid = -1; return; }
        if (hipFuncSetAttribute((const void*)mk_fwd, hipFuncAttributeMaxDynamicSharedMemorySize, LDS_BYTES) != hipSuccess) { fprintf(stderr, "kernel_launch: hipFuncSetAttribute failed\n"); grid = -1; return; }
        int per_cu = 0;
        if (hipOccupancyMaxActiveBlocksPerMultiprocessor(&per_cu, (const void*)mk_fwd, NWAVES * 64, LDS_BYTES) != hipSuccess || per_cu < 1) { fprintf(stderr, "kernel_launch: occupancy query says %d\n", per_cu); }
        (void)hipGetLastError();
        grid = cus;
    }
    if (grid < 0) return;
    (void)hipMemsetAsync((char*)d_ws + WS_CTL, 0, CTL_ZERO_BYTES, stream);
    Args a{};
    for (int i = 0; i < 32; ++i) a.in[i] = (const float*)d_in[i];
    a.out = (float*)d_out; a.ws = (unsigned char*)d_ws;
#if MK_PER_PHASE
    for (int p = 0; p < N_PHASES; ++p) { a.ph_lo = p; a.ph_hi = p + 1; hipLaunchKernelGGL(mk_fwd, dim3(grid), dim3(NWAVES * 64), LDS_BYTES, stream, a); }
#else
    a.ph_lo = 0; a.ph_hi = N_PHASES;
    void* kargs[] = {&a};
    hipError_t e = hipLaunchCooperativeKernel((const void*)mk_fwd, dim3(grid), dim3(NWAVES * 64), kargs, LDS_BYTES, stream);
    if (e != hipSuccess) fprintf(stderr, "cooperative launch failed: %s (grid %d)\n", hipGetErrorString(e), grid);
#endif
}
```

```cpp
#include <hip/hip_runtime.h>
#include <hip/hip_cooperative_groups.h>
#include <cstdio>
#include <cstdint>
namespace pg8 {
#define PG8_LAS __attribute__((address_space(3)))
typedef unsigned short bf16_t;
typedef short bf16x8 __attribute__((ext_vector_type(8)));
typedef float f32x4 __attribute__((ext_vector_type(4)));
typedef unsigned u32x4 __attribute__((ext_vector_type(4)));
constexpr int BM = 256, BK = 64, HALF = 128, HTB = HALF * BK * 2  , STAGE_BYTES = 8 * HTB, NXCD = 8, WGM = 8;

__host__ __device__ __forceinline__ int lds_byte(int r, int c) { const int st = (r >> 4) * 2 + (c >> 5), rr = r & 15, cc = c & 31, ob = rr * 64 + cc * 2; return st * 1024 + (ob ^ (((ob >> 9) & 1) << 5)); }
__host__ __device__ __forceinline__ void stage_rc(int b, int& R, int& C) { const int st = b / 1024, sb = b % 1024, swz = sb ^ (((sb >> 9) & 1) << 5); R = (st >> 1) * 16 + swz / 64; C = (st & 1) * 32 + (swz % 64) / 2; }
__host__ __device__ __forceinline__ int perm32(int rho) { const int n = rho >> 4, i = rho & 15; return 8 * (i >> 2) + 4 * n + (i & 3); }

struct Unit { int pm, pn; };
struct Gemm { const bf16_t* A; const bf16_t* Bt; int M, N, K; };

struct StaticOrder {
    int nM, nN, nwg, G, c;
    __host__ __device__ void init(int M, int N, int G_, int c_) { nM = M / BM; nN = N / BM; nwg = nM * nN; G = G_; c = c_; }
    __host__ __device__ bool next(int i, Unit& u) const {
        const long L = (long)i * G + c; if (L >= nwg) return false;
        int wgid = (int)L; { const int q = nwg / NXCD, r = nwg % NXCD, xcd = wgid % NXCD, off = wgid / NXCD; wgid = (xcd < r ? xcd * (q + 1) : r * (q + 1) + (xcd - r) * q) + off; }
        const int nig = WGM * nN, gid = wgid / nig, fm = gid * WGM, gsz = (nM - fm) < WGM ? (nM - fm) : WGM;
        u.pm = fm + ((wgid % nig) % gsz); u.pn = (wgid % nig) / gsz; return true;
    }
    __device__ __forceinline__ void a_ready(const Unit&) const {}
    __device__ __forceinline__ void done(const Unit&) const {}
};

__device__ __forceinline__ unsigned cvt_pk_bf16(float lo, float hi) { unsigned r; asm volatile("v_cvt_pk_bf16_f32 %0, %1, %2" : "=v"(r) : "v"(lo), "v"(hi)); return r; }
typedef float f32x2 __attribute__((ext_vector_type(2)));
__device__ __forceinline__ f32x2 gelu_pk(f32x2 v) {
    const f32x2 av = __builtin_elementwise_abs(v), d = av * 0.2316418882f + 1.0f;
    f32x2 t; t.x = __builtin_amdgcn_rcpf(d.x); t.y = __builtin_amdgcn_rcpf(d.y);
    f32x2 q = t * 0.5307027145f + (-0.7265760135f); q = q * t + 0.7107068705f; q = q * t + (-0.142248368f); q = q * t + 0.127414796f; q = q * t;
    const f32x2 s = (v * v) * (-0.72134752044f);
    f32x2 e; e.x = __builtin_amdgcn_exp2f(s.x); e.y = __builtin_amdgcn_exp2f(s.y);
    const f32x2 m = v * (q * e), r = v - m;
    f32x2 o; o.x = v.x < 0.f ? m.x : r.x; o.y = v.y < 0.f ? m.y : r.y; return o;
}

template <int ACT  > struct EpiBf16 {
    static constexpr bool PERM = true, AFTER_DRAIN = false; static_assert(ACT == 0 || ACT == 1, "EpiBf16: ACT is 0 (none) or 1 (gelu_pk)");
    bf16_t* O; int ldc; const float* bias; int split_cols; size_t split_stride; float scale0;
    __device__ __forceinline__ void operator()(const f32x4 (&acc)[2][2][4][2], const Unit& u, int wr, int wc, int fr, int fq) const {
        const int row0 = u.pm * BM + wr * 64 + fr; int colt = u.pn * BM; bf16_t* base = O;
        float sc = 1.f; if (split_cols) { const int t = colt / split_cols; base += (size_t)t * split_stride; colt -= t * split_cols; if (t == 0) sc = scale0; }
        const int col0 = colt + wc * 32 + 8 * fq, bcol0 = u.pn * BM + wc * 32 + 8 * fq;
        f32x4 bv[2][2];
#pragma unroll
        for (int bj = 0; bj < 2; ++bj)
#pragma unroll
            for (int n = 0; n < 2; ++n) bv[bj][n] = bias ? *(const f32x4*)(bias + bcol0 + bj * HALF + 4 * n) : (f32x4){0.f, 0.f, 0.f, 0.f};
#pragma unroll
        for (int ai = 0; ai < 2; ++ai)
#pragma unroll
            for (int m = 0; m < 4; ++m) { bf16_t* rowp = base + (size_t)(row0 + ai * HALF + m * 16) * ldc + col0;
#pragma unroll
                for (int bj = 0; bj < 2; ++bj) { f32x4 v0 = acc[ai][bj][m][0] + bv[bj][0], v1 = acc[ai][bj][m][1] + bv[bj][1];
                    if (ACT == 1) { f32x2 a = gelu_pk((f32x2){v0[0], v0[1]}), b = gelu_pk((f32x2){v0[2], v0[3]}), c = gelu_pk((f32x2){v1[0], v1[1]}), d = gelu_pk((f32x2){v1[2], v1[3]});
                        v0 = (f32x4){a.x, a.y, b.x, b.y}; v1 = (f32x4){c.x, c.y, d.x, d.y}; }
                    v0 = v0 * sc; v1 = v1 * sc; u32x4 w; w.x = cvt_pk_bf16(v0[0], v0[1]); w.y = cvt_pk_bf16(v0[2], v0[3]); w.z = cvt_pk_bf16(v1[0], v1[1]); w.w = cvt_pk_bf16(v1[2], v1[3]);
                    *(u32x4*)(rowp + bj * HALF) = w; } }
    }
};
struct EpiResidual {
    static constexpr bool PERM = false, AFTER_DRAIN = false;
    const float* base; float* out; int ldc;
    __device__ __forceinline__ void operator()(const f32x4 (&acc)[2][2][4][2], const Unit& u, int wr, int wc, int fr, int fq) const {
        const int col0 = u.pn * BM + wc * 32 + 4 * fq;
#pragma unroll
        for (int ai = 0; ai < 2; ++ai)
#pragma unroll
            for (int m = 0; m < 4; ++m) { const size_t off = (size_t)(u.pm * BM + ai * HALF + wr * 64 + m * 16 + fr) * ldc + col0;
#pragma unroll
                for (int bj = 0; bj < 2; ++bj)
#pragma unroll
                    for (int n = 0; n < 2; ++n) { const f32x4 bs = *(const f32x4*)(base + off + bj * HALF + n * 16); *(f32x4*)(out + off + bj * HALF + n * 16) = bs + acc[ai][bj][m][n]; }
                asm volatile("" ::: "memory"); }
    }
};
struct EpiSwiGLU {
    static constexpr bool PERM = true, AFTER_DRAIN = false;
    bf16_t* O; int ldc;
    __device__ __forceinline__ void operator()(const f32x4 (&acc)[2][2][4][2], const Unit& u, int wr, int wc, int fr, int fq) const {
        const int col0 = u.pn * HALF + wc * 32 + 8 * fq;
#pragma unroll
        for (int ai = 0; ai < 2; ++ai)
#pragma unroll
            for (int m = 0; m < 4; ++m) { bf16_t* rowp = O + (size_t)(u.pm * BM + ai * HALF + wr * 64 + m * 16 + fr) * ldc + col0;
                float r[8];
#pragma unroll
                for (int n = 0; n < 2; ++n)
#pragma unroll
                    for (int j = 0; j < 4; ++j) { const float g = acc[ai][0][m][n][j], up = acc[ai][1][m][n][j]; r[n * 4 + j] = g * __builtin_amdgcn_rcpf(1.f + __expf(-g)) * up; }
                u32x4 w; w.x = cvt_pk_bf16(r[0], r[1]); w.y = cvt_pk_bf16(r[2], r[3]); w.z = cvt_pk_bf16(r[4], r[5]); w.w = cvt_pk_bf16(r[6], r[7]);
                *(u32x4*)rowp = w; }
    }
};
template <class Epi, class Sched, bool ALIGN_EPI = false, bool SP2 = false>
__device__ __forceinline__ void gemm_phase(PG8_LAS unsigned char* lds, const Gemm g, const Sched& S, const Epi& E) {
    const int tid = threadIdx.x, wid = __builtin_amdgcn_readfirstlane(tid >> 6), lane = tid & 63, wr = wid >> 2, wc = wid & 3, fr = lane & 15, fq = lane >> 4;
    const int K = g.K, nt = K / BK;
    unsigned voffA[2], voffB[2];
#pragma unroll
    for (int i = 0; i < 2; ++i) { int R, C; stage_rc(tid * 16 + i * 8192, R, C); const int Rb = Epi::PERM ? ((R & ~31) + perm32(R & 31)) : R;
        voffA[i] = (unsigned)(R * K + C) * 2u; voffB[i] = (unsigned)(Rb * K + C) * 2u; }
    const size_t kstep = (size_t)(BK * 2);
    const size_t hstep = (size_t)HALF * K * 2;
    const size_t tstep = 2 * hstep;
    const unsigned ldsw = (unsigned)wid * 1024u;
    const int aoff = lds_byte(wr * 64 + fr, fq * 8), boff = lds_byte(wc * 32 + fr, fq * 8);
#define PG8_SA(b, h) (((b) * 2 + (h)) * HTB)
#define PG8_SB(b, h) ((4 + (b) * 2 + (h)) * HTB)
#define PG8_STAGE(bufoff, gbase, voff) do { _Pragma("unroll") for (int _i = 0; _i < 2; ++_i) \
        __builtin_amdgcn_global_load_lds((const unsigned*)((const char*)(gbase) + (voff)[_i]), (PG8_LAS unsigned*)(lds + (bufoff) + ldsw + _i * 8192), 16, 0, 0); } while (0)
#define PG8_LDA(dst, b, h) do { _Pragma("unroll") for (int m = 0; m < 4; ++m) _Pragma("unroll") for (int k = 0; k < 2; ++k) dst[m][k] = *(const PG8_LAS bf16x8*)(lds + PG8_SA(b, h) + aoff + m * 2048 + k * 1024); } while (0)
#define PG8_LDB(dst, b, h) do { _Pragma("unroll") for (int n = 0; n < 2; ++n) _Pragma("unroll") for (int k = 0; k < 2; ++k) dst[n][k] = *(const PG8_LAS bf16x8*)(lds + PG8_SB(b, h) + boff + n * 2048 + k * 1024); } while (0)
#define PG8_MMA(ai, bj, At, Bt) do { __builtin_amdgcn_s_setprio(1); _Pragma("unroll") for (int m = 0; m < 4; ++m) _Pragma("unroll") for (int n = 0; n < 2; ++n) _Pragma("unroll") for (int k = 0; k < 2; ++k) \
        acc[ai][bj][m][n] = __builtin_amdgcn_mfma_f32_16x16x32_bf16(Bt[n][k], At[m][k], acc[ai][bj][m][n], 0, 0, 0); __builtin_amdgcn_s_setprio(0); } while (0)
#define PG8_WAIT_V(n) asm volatile("s_waitcnt vmcnt(" #n ")" ::: "memory")
#define PG8_WAIT_L(n) asm volatile("s_waitcnt lgkmcnt(" #n ")" ::: "memory")
#define PG8_BAR __builtin_amdgcn_s_barrier()
#define PG8_SCHED __builtin_amdgcn_sched_barrier(0)
    Unit cur, nxt; int ui = 0;
    if (!S.next(0, cur)) return;
    f32x4 acc[2][2][4][2];
#pragma unroll
    for (int a = 0; a < 2; ++a)
#pragma unroll
        for (int b = 0; b < 2; ++b)
#pragma unroll
            for (int m = 0; m < 4; ++m)
#pragma unroll
                for (int n = 0; n < 2; ++n) acc[a][b][m][n] = (f32x4){0.f, 0.f, 0.f, 0.f};
    bf16x8 At[4][2], B0[2][2], B1[2][2];
    const char* cA = (const char*)g.A + (size_t)cur.pm * tstep; const char* cB = (const char*)g.Bt + (size_t)cur.pn * tstep;
    S.a_ready(cur);
    if constexpr (SP2) {
        PG8_STAGE(PG8_SB(0, 0), cB, voffB); PG8_STAGE(PG8_SB(0, 1), cB + hstep, voffB); PG8_STAGE(PG8_SA(0, 0), cA, voffA); PG8_STAGE(PG8_SA(0, 1), cA + hstep, voffA);
        if (wr == 1) PG8_BAR;
        PG8_WAIT_V(2); PG8_BAR;
        PG8_STAGE(PG8_SB(1, 0), cB + kstep, voffB); PG8_STAGE(PG8_SA(1, 0), cA + kstep, voffA); PG8_STAGE(PG8_SB(1, 1), cB + hstep + kstep, voffB);
        PG8_WAIT_V(6); PG8_BAR;
    } else {
        PG8_STAGE(PG8_SB(0, 0), cB, voffB); PG8_STAGE(PG8_SA(0, 0), cA, voffA); PG8_STAGE(PG8_SB(0, 1), cB + hstep, voffB); PG8_STAGE(PG8_SA(0, 1), cA + hstep, voffA);
        if (wr == 1) PG8_BAR;
        PG8_WAIT_V(4); PG8_BAR;
        PG8_STAGE(PG8_SB(1, 0), cB + kstep, voffB); PG8_STAGE(PG8_SA(1, 0), cA + kstep, voffA); PG8_STAGE(PG8_SB(1, 1), cB + hstep + kstep, voffB);
        PG8_WAIT_V(6); PG8_BAR;
    }
    for (;;) {
        const bool has_next = S.next(ui + 1, nxt);
        const char* nA = has_next ? (const char*)g.A + (size_t)nxt.pm * tstep : cA; const char* nB = has_next ? (const char*)g.Bt + (size_t)nxt.pn * tstep : cB;
        for (int t = 0; t < nt; t += 2) {
            const bool last = (t == nt - 2);
            const char* a1 = cA + (size_t)(t + 1) * kstep;
            const char* a2 = last ? nA : cA + (size_t)(t + 2) * kstep; const char* b2 = last ? nB : cB + (size_t)(t + 2) * kstep;
            const char* a3 = a2 + kstep; const char* b3 = b2 + kstep;
            if (last && has_next) S.a_ready(nxt);
            if constexpr (SP2) {
            PG8_LDB(B0, 0, 0); PG8_LDB(B1, 0, 1); PG8_SCHED; PG8_LDA(At, 0, 0); PG8_STAGE(PG8_SA(1, 1), a1 + hstep, voffA);
            PG8_WAIT_V(8); PG8_WAIT_L(0); PG8_BAR; PG8_MMA(0, 0, At, B0); PG8_MMA(0, 1, At, B1); PG8_BAR; PG8_SCHED;
            PG8_LDA(At, 0, 1); PG8_STAGE(PG8_SB(0, 0), b2, voffB); PG8_STAGE(PG8_SB(0, 1), b2 + hstep, voffB); PG8_STAGE(PG8_SA(0, 0), a2, voffA);
            PG8_WAIT_V(8); PG8_WAIT_L(0); PG8_BAR; PG8_MMA(1, 0, At, B0); PG8_MMA(1, 1, At, B1); PG8_BAR; PG8_SCHED;
            PG8_LDB(B0, 1, 0); PG8_LDB(B1, 1, 1); PG8_SCHED; PG8_LDA(At, 1, 0); PG8_STAGE(PG8_SA(0, 1), a2 + hstep, voffA);
            PG8_WAIT_V(8); PG8_WAIT_L(0); PG8_BAR; PG8_MMA(0, 0, At, B0); PG8_MMA(0, 1, At, B1); PG8_BAR; PG8_SCHED;
            PG8_LDA(At, 1, 1); PG8_STAGE(PG8_SB(1, 0), b3, voffB); PG8_STAGE(PG8_SB(1, 1), b3 + hstep, voffB); PG8_STAGE(PG8_SA(1, 0), a3, voffA);
            PG8_WAIT_V(8); PG8_WAIT_L(0); PG8_BAR; PG8_MMA(1, 0, At, B0); PG8_MMA(1, 1, At, B1); PG8_BAR; PG8_SCHED;
            } else {
            PG8_LDB(B0, 0, 0); PG8_SCHED; PG8_LDA(At, 0, 0); PG8_STAGE(PG8_SA(1, 1), a1 + hstep, voffA);
            PG8_WAIT_L(8); PG8_BAR; PG8_WAIT_L(0); PG8_MMA(0, 0, At, B0); PG8_BAR; PG8_SCHED;
            PG8_LDB(B1, 0, 1); PG8_STAGE(PG8_SB(0, 0), b2, voffB);
            PG8_BAR; PG8_WAIT_L(0); PG8_MMA(0, 1, At, B1); PG8_BAR;
            PG8_LDA(At, 0, 1); PG8_STAGE(PG8_SA(0, 0), a2, voffA);
            PG8_BAR; PG8_WAIT_L(0); PG8_MMA(1, 0, At, B0); PG8_BAR; PG8_SCHED;
            PG8_STAGE(PG8_SB(0, 1), b2 + hstep, voffB);
            PG8_WAIT_V(6); PG8_BAR; PG8_MMA(1, 1, At, B1); PG8_BAR;
            PG8_LDB(B0, 1, 0); PG8_SCHED; PG8_LDA(At, 1, 0); PG8_STAGE(PG8_SA(0, 1), a2 + hstep, voffA);
            PG8_WAIT_L(8); PG8_BAR; PG8_WAIT_L(0); PG8_MMA(0, 0, At, B0); PG8_BAR; PG8_SCHED;
            PG8_LDB(B1, 1, 1); PG8_STAGE(PG8_SB(1, 0), b3, voffB);
            PG8_BAR; PG8_WAIT_L(0); PG8_MMA(0, 1, At, B1); PG8_BAR;
            PG8_LDA(At, 1, 1); PG8_STAGE(PG8_SA(1, 0), a3, voffA);
            PG8_BAR; PG8_WAIT_L(0); PG8_MMA(1, 0, At, B0); PG8_BAR; PG8_SCHED;
            PG8_STAGE(PG8_SB(1, 1), b3 + hstep, voffB);
            PG8_WAIT_V(6); PG8_BAR; PG8_MMA(1, 1, At, B1); PG8_BAR;
            }
        }
        if constexpr (ALIGN_EPI) { if (wr == 0) PG8_BAR; }
        if constexpr (!Epi::AFTER_DRAIN) { E(acc, cur, wr, wc, fr, fq); S.done(cur); }
        if (!has_next) break;
#pragma unroll
        for (int a = 0; a < 2; ++a)
#pragma unroll
            for (int b = 0; b < 2; ++b)
#pragma unroll
                for (int m = 0; m < 4; ++m)
#pragma unroll
                    for (int n = 0; n < 2; ++n) acc[a][b][m][n] = (f32x4){0.f, 0.f, 0.f, 0.f};
        cur = nxt; cA = nA; cB = nB; ++ui;
        if constexpr (ALIGN_EPI) { if (wr == 1) PG8_BAR; }
    }
    PG8_WAIT_V(0);
    if constexpr (!ALIGN_EPI) { if (wr == 0) PG8_BAR; }
    PG8_BAR;
    if constexpr (Epi::AFTER_DRAIN) { E.fused(acc, cur, wr, wc, fr, fq, lds, wid, lane); S.done(cur); }
#undef PG8_SA
#undef PG8_SB
#undef PG8_STAGE
#undef PG8_LDA
#undef PG8_LDB
#undef PG8_MMA
#undef PG8_WAIT_V
#undef PG8_WAIT_L
#undef PG8_BAR
#undef PG8_SCHED
}
}

#ifndef PG8_SP2
#define PG8_SP2 true
#endif
#define PG8_ALIGN true
constexpr int NWAVES = 8;
constexpr int BATCH = 2, SEQ = 8192, DM = 1024, M = BATCH * SEQ, NIN = 3788, NINP = 3840, FFN = 2816, DEPTH = 2;
constexpr int A_Q = 0, A_K = 256, A_V = 512, A_O = 768;
constexpr int R_R = 1024, R_K = 1408, R_V = 1792, R_WDF = 2176, R_AD = 2304, R_GD = 2368;
constexpr int S_Z = 2496, S_X = 2880, S_B = 3264, S_C = 3520, S_DT = 3776;
constexpr size_t MiB = 1u << 20;
constexpr size_t WS_CTL = 0, CTL_ZERO_BYTES = 64 * 1024;
constexpr size_t WS_GATES = 1 * MiB, WS_CT = 2 * MiB;
constexpr size_t WS_WIN = 4 * MiB, WS_WOUT = 12 * MiB, WS_WGU = 14 * MiB, WS_WDN = 25 * MiB;
constexpr size_t WS_XN = 32 * MiB, WS_COLS = 64 * MiB, WS_Y = 184 * MiB, WS_END = 256 * MiB;
constexpr size_t Y_AF = WS_Y, Y_AB = WS_Y + 8 * MiB, Y_RF = WS_Y + 16 * MiB, Y_RB = WS_Y + 28 * MiB, Y_SF = WS_Y + 40 * MiB, Y_SB = WS_Y + 52 * MiB;
constexpr int CW_BAR = 1024;
constexpr int RING_BYTES = 131072;
constexpr int LDS_BYTES = 147456, MISC_OFF = LDS_BYTES - 256;

#define GAS __attribute__((address_space(1)))
#define LAS __attribute__((address_space(3)))
typedef unsigned short bf16;
typedef unsigned v4u __attribute__((ext_vector_type(4)));
typedef unsigned v2u __attribute__((ext_vector_type(2)));
typedef float f32x4 __attribute__((ext_vector_type(4)));
typedef short bf16x8 __attribute__((ext_vector_type(8)));
typedef GAS unsigned gu32;
#define RLX_AGENT __ATOMIC_RELAXED, __HIP_MEMORY_SCOPE_AGENT
#define LDS_WAIT() asm volatile("s_waitcnt lgkmcnt(0)" ::: "memory")
#define VM_WAIT() asm volatile("s_waitcnt vmcnt(0)" ::: "memory")
__device__ __forceinline__ unsigned f2bf(float f) { unsigned u = __builtin_bit_cast(unsigned, f); return (u + 0x7fffu + ((u >> 16) & 1u)) >> 16; }
__device__ __forceinline__ unsigned pk2(float lo, float hi) { return f2bf(lo) | (f2bf(hi) << 16); }
__device__ __forceinline__ float bf2f(unsigned u) { return __builtin_bit_cast(float, u << 16); }
__device__ __forceinline__ float sigmoidf_(float x) { return __builtin_amdgcn_rcpf(1.f + __expf(-x)); }
__device__ __forceinline__ float siluf_(float x) { return x * sigmoidf_(x); }
__device__ __forceinline__ float wave_sum(float v) {
#pragma unroll
    for (int o = 1; o < 64; o <<= 1) v += __shfl_xor(v, o);
    return v;
}
__device__ __forceinline__ float wave_max(float v) {
#pragma unroll
    for (int o = 1; o < 64; o <<= 1) v = fmaxf(v, __shfl_xor(v, o));
    return v;
}
template <int CTRL> __device__ __forceinline__ float dppf(float v) { return __builtin_bit_cast(float, __builtin_amdgcn_update_dpp(0, __builtin_bit_cast(int, v), CTRL, 0xf, 0xf, true)); }
__device__ __forceinline__ float row16_sum(float v) { v += dppf<0xB1>(v); v += dppf<0x4E>(v); v += dppf<0x141>(v); v += dppf<0x140>(v); return v; }
template <int K> __device__ __forceinline__ f32x4 mma16(const LAS bf16* A, int lda, const LAS bf16* Bt, int ldb, f32x4 acc, int lane) {
    const int r = lane & 15, q = lane >> 4;
    const LAS bf16* ap = A + r * lda + q * 8; const LAS bf16* bp = Bt + r * ldb + q * 8;
#pragma unroll
    for (int k0 = 0; k0 < K; k0 += 32) {
        const bf16x8 a = *(const LAS bf16x8*)(ap + k0); const bf16x8 b = *(const LAS bf16x8*)(bp + k0);
        acc = __builtin_amdgcn_mfma_f32_16x16x32_bf16(a, b, acc, 0, 0, 0);
    }
    return acc;
}

__device__ __forceinline__ int swz64(int row, int col) { return col ^ (((row >> 3) & 7) << 3); }
template <bool SWA, bool SWB> __device__ __forceinline__ f32x4 mma16s(const LAS bf16* A, int lda, int rowA0, const LAS bf16* Bt, int ldb, int rowB0, f32x4 acc, int lane) {
    const int r = lane & 15, q = lane >> 4; const int ra = rowA0 + r, rb = rowB0 + r;
#pragma unroll
    for (int k0 = 0; k0 < 64; k0 += 32) { const int ca = k0 + 8 * q, cb = k0 + 8 * q;
        const bf16x8 a = *(const LAS bf16x8*)(A + ra * lda + (SWA ? swz64(ra, ca) : ca)); const bf16x8 b = *(const LAS bf16x8*)(Bt + rb * ldb + (SWB ? swz64(rb, cb) : cb));
        acc = __builtin_amdgcn_mfma_f32_16x16x32_bf16(a, b, acc, 0, 0, 0); }
    return acc;
}

template <int CTRL, int RM, int BM> __device__ __forceinline__ float dppm(float oldv, float v) { return __builtin_bit_cast(float, __builtin_amdgcn_update_dpp(__builtin_bit_cast(int, oldv), __builtin_bit_cast(int, v), CTRL, RM, BM, false)); }
__device__ __forceinline__ float wave_scan_add(float x) {
    float y = x + dppm<0x111, 0xf, 0xf>(0.f, x); y += dppm<0x112, 0xf, 0xf>(0.f, x); y += dppm<0x113, 0xf, 0xf>(0.f, x);
    y += dppm<0x114, 0xf, 0xe>(0.f, y); y += dppm<0x118, 0xf, 0xc>(0.f, y);
    y += dppm<0x142, 0xa, 0xf>(0.f, y); y += dppm<0x143, 0xc, 0xf>(0.f, y);
    return y;
}
__device__ __forceinline__ float wave_scan_max(float x) {
    const float ninf = -INFINITY;
    float y = fmaxf(x, dppm<0x111, 0xf, 0xf>(ninf, x)); y = fmaxf(y, dppm<0x112, 0xf, 0xf>(ninf, x)); y = fmaxf(y, dppm<0x113, 0xf, 0xf>(ninf, x));
    y = fmaxf(y, dppm<0x114, 0xf, 0xe>(ninf, y)); y = fmaxf(y, dppm<0x118, 0xf, 0xc>(ninf, y));
    y = fmaxf(y, dppm<0x142, 0xa, 0xf>(ninf, y)); y = fmaxf(y, dppm<0x143, 0xc, 0xf>(ninf, y));
    return y;
}
#define XB_TMO      128
#define XB_XCNT(j)  (256  + 64 * (j))
#define XB_XSUB(j)  (1280 + 64 * (j))
#define XB_XGEN(j)  (2304 + 64 * (j))
#define XB_TOP      3328
#define XB_TOPGEN   3392
#define XCD_BAR_WORDS 3456
#define XB_SPIN_CAP (1u << 18)

__device__ __forceinline__ unsigned xb_ld(unsigned* p)              { return __hip_atomic_load(p, __ATOMIC_RELAXED, __HIP_MEMORY_SCOPE_AGENT); }
__device__ __forceinline__ unsigned xb_add(unsigned* p, unsigned v) { return __hip_atomic_fetch_add(p, v, __ATOMIC_RELAXED, __HIP_MEMORY_SCOPE_AGENT); }
__device__ __forceinline__ unsigned xb_xcc_id() { return (unsigned)__builtin_amdgcn_s_getreg((3 << 11) | 20) & 0xFu; }
#define XB_SPIN(cond, bar) do { unsigned _sp = 0; while (cond) { __builtin_amdgcn_s_sleep(1); \
    if ((++_sp & 255u) == 0u) { if (xb_ld(&(bar)[XB_TMO])) break; if (_sp > XB_SPIN_CAP) { atomicAdd(&(bar)[XB_TMO], 1u); break; } } } } while (0)

struct XcdBarrier {
    unsigned* bar; unsigned x;
    volatile LAS unsigned* st;
};

__device__ __forceinline__ XcdBarrier xcd_barrier_post(unsigned* bar, volatile LAS unsigned* st) {
    XcdBarrier b; b.bar = bar; b.x = xb_xcc_id(); b.st = st;
    if (threadIdx.x == 0) (void)xb_add(&bar[XB_XCNT(b.x)], 1u);
    return b;
}
__device__ __forceinline__ void xcd_barrier_complete(unsigned* bar, unsigned x, unsigned& nloc, unsigned& nx) {
    const unsigned G = gridDim.x * gridDim.y * gridDim.z;
    unsigned sum, cnt, mine, sp = 0u;
    for (;;) {
        sum = 0u; cnt = 0u; mine = 0u;
#pragma unroll
        for (unsigned j = 0; j < 16; ++j) { const unsigned c = xb_ld(&bar[XB_XCNT(j)]); sum += c; cnt += (c > 0u) ? 1u : 0u; mine = (j == x) ? c : mine; }
        if (sum == G) break;
        __builtin_amdgcn_s_sleep(1);
        if ((++sp & 255u) == 0u) { if (xb_ld(&bar[XB_TMO])) break; if (sp > XB_SPIN_CAP) { atomicAdd(&bar[XB_TMO], 1u); break; } }
    }
    nloc = mine > 0u ? mine : 1u; nx = cnt > 0u ? cnt : 1u;
}

__device__ __forceinline__ void xcd_barrier(const XcdBarrier& b) {
    asm volatile("s_waitcnt vmcnt(0)" ::: "memory");
    __syncthreads();
    if (threadIdx.x == 0) {
        unsigned* bar = b.bar;
        __builtin_amdgcn_s_waitcnt(0);
        unsigned nloc = b.st[0], nx = b.st[1];
        if (nloc == 0u) { xcd_barrier_complete(bar, b.x, nloc, nx); b.st[0] = nloc; b.st[1] = nx; }
        const unsigned old = xb_add(&bar[XB_XSUB(b.x)], 1u);
        const unsigned gen = old / nloc;
        if (old + 1u == (gen + 1u) * nloc) {
            __builtin_amdgcn_fence(__ATOMIC_RELEASE, "agent");
            asm volatile("s_waitcnt vmcnt(0)" ::: "memory");
            const unsigned og = xb_add(&bar[XB_TOP], 1u);
            const unsigned tg = og / nx;
            if (og + 1u == (tg + 1u) * nx) xb_add(&bar[XB_TOPGEN], 1u);
            else XB_SPIN(xb_ld(&bar[XB_TOPGEN]) == tg, bar);
            __builtin_amdgcn_fence(__ATOMIC_ACQUIRE, "agent");
            xb_add(&bar[XB_XGEN(b.x)], 1u);
            asm volatile("s_waitcnt vmcnt(0)" ::: "memory");
        } else {
            XB_SPIN(xb_ld(&bar[XB_XGEN(b.x)]) == gen, bar);
            __builtin_amdgcn_fence(__ATOMIC_ACQUIRE, "agent");
            asm volatile("s_waitcnt vmcnt(0)" ::: "memory");
        }
    }
    __syncthreads();
}
struct Frame {
    LAS unsigned char* lds;
    int tid, lane, wave, vcu, G;
};
struct Args { const float* in[32]; float* out; unsigned char* ws; int ph_lo, ph_hi; };
constexpr int PTAB_OFF = LDS_BYTES - 768;
__device__ __forceinline__ unsigned long long ptab_ld(const Frame& F, int i) {
    const unsigned long long v = *(volatile LAS unsigned long long*)(F.lds + PTAB_OFF + 8 * i);
    const unsigned lo = __builtin_amdgcn_readfirstlane((unsigned)v), hi = __builtin_amdgcn_readfirstlane((unsigned)(v >> 32));
    return ((unsigned long long)hi << 32) | lo;
}
__device__ __forceinline__ const float* INP(const Frame& F, int i) { return (const float*)ptab_ld(F, i); }
__device__ __forceinline__ unsigned char* WSP(const Frame& F) { return (unsigned char*)ptab_ld(F, 33); }
__device__ __forceinline__ float* OUTP(const Frame& F) { return (float*)ptab_ld(F, 32); }

__device__ __forceinline__ void transpose_item(const float* W, int K, int N, int nblk, bf16* WT, int mode, int row_off, LAS float* scr, int item, int lane) {
    const int kb = item / nblk, nb = item % nblk, k0 = 64 * kb, n0 = 32 * nb;
    const int ncol = n0 + (lane & 31); const bool ok = ncol < N;
#pragma unroll 8
    for (int i = 0; i < 32; ++i) { const int kk = 2 * i + (lane >> 5); scr[kk * 33 + (lane & 31)] = ok ? W[(size_t)(k0 + kk) * N + ncol] : 0.f; }
    LDS_WAIT(); asm volatile("" ::: "memory");
    const int c = lane & 7;
    const int drow0 = mode ? (256 * (n0 >> 7) + (n0 & 127) + row_off) : (row_off + n0);
#pragma unroll
    for (int j = 0; j < 4; ++j) { const int n = (lane >> 3) + 8 * j; const LAS float* s = scr + (8 * c) * 33 + n;
        v4u o; o.x = pk2(s[0 * 33], s[1 * 33]); o.y = pk2(s[2 * 33], s[3 * 33]); o.z = pk2(s[4 * 33], s[5 * 33]); o.w = pk2(s[6 * 33], s[7 * 33]);
        *(v4u*)(WT + (size_t)(drow0 + n) * K + k0 + 8 * c) = o; }
    LDS_WAIT(); asm volatile("" ::: "memory");
}
__device__ __forceinline__ void phase_convert(const Frame& F, int l) {
    LAS float* scr = (LAS float*)(F.lds + F.wave * 16384);
    const int gw = F.vcu * NWAVES + F.wave, NGW = F.G * NWAVES;
    bf16* Win = (bf16*)(WSP(F) + WS_WIN); bf16* Wout = (bf16*)(WSP(F) + WS_WOUT); bf16* Wgu = (bf16*)(WSP(F) + WS_WGU); bf16* Wdn = (bf16*)(WSP(F) + WS_WDN);
    constexpr int I_IN = 16 * 120, I_OUT = 16 * 32, I_G = 16 * 88, I_D = 44 * 32;
    constexpr int NITEMS = I_IN + I_OUT + 2 * I_G + I_D;
    for (int it = gw; it < NITEMS; it += NGW) {
        int r = it;
        if (r < I_IN) { transpose_item(INP(F, 2) + (size_t)l * DM * NIN, DM, NIN, 120, Win, 0, 0, scr, r, F.lane); continue; } r -= I_IN;
        if (r < I_OUT) { transpose_item(INP(F, 26) + (size_t)l * DM * DM, DM, DM, 32, Wout, 0, 0, scr, r, F.lane); continue; } r -= I_OUT;
        if (r < I_G) { transpose_item(INP(F, 28) + (size_t)l * DM * FFN, DM, FFN, 88, Wgu, 1, 0, scr, r, F.lane); continue; } r -= I_G;
        if (r < I_G) { transpose_item(INP(F, 29) + (size_t)l * DM * FFN, DM, FFN, 88, Wgu, 1, 128, scr, r, F.lane); continue; } r -= I_G;
        transpose_item(INP(F, 30) + (size_t)l * FFN * DM, FFN, DM, 32, Wdn, 0, 0, scr, r, F.lane);
    }
}
__device__ __forceinline__ void phase_norm(const Frame& F, const float* hin, const float* g, bf16* XN) {
    const int gw = F.vcu * NWAVES + F.wave, NGW = F.G * NWAVES;
    f32x4 gv[4];
#pragma unroll
    for (int j = 0; j < 4; ++j) gv[j] = ((const f32x4*)g)[64 * j + F.lane];
    for (int m = gw; m < M; m += NGW) {
        const f32x4* xr = (const f32x4*)(hin + (size_t)m * DM) + F.lane;
        f32x4 v[4]; float s = 0.f;
#pragma unroll
        for (int j = 0; j < 4; ++j) { v[j] = xr[64 * j]; s += (v[j].x * v[j].x + v[j].y * v[j].y) + (v[j].z * v[j].z + v[j].w * v[j].w); }
        const float r = 1.f / sqrtf(wave_sum(s) * (1.f / DM) + 1e-6f);
        v2u* o8 = (v2u*)(XN + (size_t)m * DM) + F.lane;
#pragma unroll
        for (int j = 0; j < 4; ++j) { v2u w; w.x = pk2(v[j].x * r * gv[j].x, v[j].y * r * gv[j].y); w.y = pk2(v[j].z * r * gv[j].z, v[j].w * r * gv[j].w); o8[64 * j] = w; }
    }
}
__device__ __forceinline__ void phase_final_norm(const Frame& F, float* h, const float* g) {
    const int gw = F.vcu * NWAVES + F.wave, NGW = F.G * NWAVES;
    f32x4 gv[4];
#pragma unroll
    for (int j = 0; j < 4; ++j) gv[j] = ((const f32x4*)g)[64 * j + F.lane];
    for (int m = gw; m < M; m += NGW) {
        f32x4* xr = (f32x4*)(h + (size_t)m * DM) + F.lane;
        f32x4 v[4]; float s = 0.f;
#pragma unroll
        for (int j = 0; j < 4; ++j) { v[j] = xr[64 * j]; s += (v[j].x * v[j].x + v[j].y * v[j].y) + (v[j].z * v[j].z + v[j].w * v[j].w); }
        const float r = 1.f / sqrtf(wave_sum(s) * (1.f / DM) + 1e-6f);
#pragma unroll
        for (int j = 0; j < 4; ++j) xr[64 * j] = v[j] * r * gv[j];
    }
}
__device__ __forceinline__ void phase_gates(const Frame& F, int l) {
    const bf16* cols = (const bf16*)(WSP(F) + WS_COLS); float* GT = (float*)(WSP(F) + WS_GATES);
    LAS bf16* raw = (LAS bf16*)(F.lds);
    LAS bf16* featb = (LAS bf16*)(F.lds + 30720);
    LAS bf16* gwT = (LAS bf16*)(F.lds + 55552);
    LAS float* outp = (LAS float*)(F.lds + 80384);
    const float* gwg = INP(F, 5) + (size_t)l * 768 * 16; const float* gb = INP(F, 6) + l * 16;
    const int tid = F.tid, lane = F.lane, wave = F.wave;
    __syncthreads();
    for (int i = tid; i < 768 * 16; i += 512) gwT[(i & 15) * 776 + (i >> 4)] = (bf16)f2bf(gwg[i]);
    float cw[5]; { const float* cwp = INP(F, 3) + (size_t)l * 5 * 512;
#pragma unroll
        for (int j = 0; j < 5; ++j) cw[j] = cwp[j * 512 + tid]; }
    const float cbv = INP(F, 4)[l * 512 + tid];
    const float gbv = gb[tid & 15];
    for (int tile = F.vcu; tile < M / 16; tile += F.G) {
        const int m0 = tile * 16, t0 = m0 % SEQ;
        __syncthreads();
        for (int ch = tid; ch < 20 * 96; ch += 512) { const int rr = ch / 96, cc = ch % 96; const int t = t0 - 2 + rr;
            v4u v = {0u, 0u, 0u, 0u}; if (t >= 0 && t < SEQ) v = *(const v4u*)(cols + (size_t)(m0 - 2 + rr) * NINP + cc * 8);
            *(LAS v4u*)(raw + rr * 768 + cc * 8) = v; }
        if (tid < 256) outp[tid] = 0.f;
        __syncthreads();
        { float win[5];
#pragma unroll
          for (int j = 0; j < 4; ++j) win[j] = bf2f(raw[j * 768 + tid]);
#pragma unroll 4
          for (int t = 0; t < 16; ++t) { win[4] = bf2f(raw[(t + 4) * 768 + tid]); float s = cbv;
#pragma unroll
              for (int j = 0; j < 5; ++j) s += cw[j] * win[j];
#pragma unroll
              for (int j = 0; j < 4; ++j) win[j] = win[j + 1];
              featb[t * 776 + tid] = (bf16)f2bf(siluf_(s)); }
          const int t = tid >> 5, c8 = tid & 31; *(LAS v4u*)(featb + t * 776 + 512 + c8 * 8) = *(const LAS v4u*)(raw + (t + 2) * 768 + 512 + c8 * 8); }
        __syncthreads();
        { const f32x4 z = {0.f, 0.f, 0.f, 0.f}; const f32x4 acc = mma16<96>(featb + 96 * wave, 776, gwT + 96 * wave, 776, z, lane);
#pragma unroll
          for (int jj = 0; jj < 4; ++jj) __hip_atomic_fetch_add(outp + ((lane >> 4) * 4 + jj) * 16 + (lane & 15), acc[jj], __ATOMIC_RELAXED, __HIP_MEMORY_SCOPE_WORKGROUP); }
        __syncthreads();
        if (tid < 256) { float s = outp[tid] + gbv; if ((tid & 15) >= 8) s = fminf(s, 0.f) - log1pf(__expf(-fabsf(s))); GT[(size_t)(m0 + (tid >> 4)) * 16 + (tid & 15)] = s; }
    }
    __syncthreads();
}
__device__ __forceinline__ f32x4 mma16_a8(const LAS bf16* A8, const LAS bf16* Bt, f32x4 acc, int lane) {
    const int q = lane >> 4;
    const LAS bf16* ap = A8 + (lane & 7) * 72 + q * 8; const LAS bf16* bp = Bt + (lane & 15) * 72 + q * 8;
#pragma unroll
    for (int k0 = 0; k0 < 64; k0 += 32) { const bf16x8 a = *(const LAS bf16x8*)(ap + k0); const bf16x8 b = *(const LAS bf16x8*)(bp + k0); acc = __builtin_amdgcn_mfma_f32_16x16x32_bf16(a, b, acc, 0, 0, 0); }
    return acc;
}
typedef float f32x2 __attribute__((ext_vector_type(2)));
template <bool DIR> __device__ __forceinline__ void rwkv_steps(const LAS float* OPS, const LAS float* VV, LAS float* YB, f32x4& S, int j, int row) {
    float yk0 = 0.f, yk1 = 0.f;
    constexpr int ST = DIR ? -320 : 320, SV = DIR ? -16 : 16;
    const LAS float* op = OPS + 4 * j + (DIR ? 31 * 320 : 0); const LAS float* vp = VV + row + (DIR ? 31 * 16 : 0);
#define RWLD(W_, KK_, KA_, KM_, R_, V_, o_, v_) do { W_ = *(const LAS f32x4*)(o_); KK_ = *(const LAS f32x4*)((o_) + 64); KA_ = *(const LAS f32x4*)((o_) + 128); KM_ = *(const LAS f32x4*)((o_) + 192); R_ = *(const LAS f32x4*)((o_) + 256); V_ = *(v_); } while (0)
#define RWSTEP(W_, KK_, KA_, KM_, R_, V_, i_) do { f32x2 t2_ = S.xy * KK_.xy; t2_ = S.zw * KK_.zw + t2_; float sa_ = t2_.x + t2_.y; const f32x4 ps_ = S * W_ + KM_ * V_; sa_ = row16_sum(sa_); S = ps_ + KA_ * sa_; \
        f32x2 y2_ = S.xy * R_.xy; y2_ = S.zw * R_.zw + y2_; float y_ = y2_.x + y2_.y; y_ = row16_sum(y_); if (((i_) & 15) == j) { if ((i_) < 16) yk0 = y_; else yk1 = y_; } } while (0)
    f32x4 w4a, kk4a, ka4a, km4a, r4a, w4b, kk4b, ka4b, km4b, r4b; float vva, vvb;
    RWLD(w4a, kk4a, ka4a, km4a, r4a, vva, op, vp);
    RWLD(w4b, kk4b, ka4b, km4b, r4b, vvb, op + ST, vp + SV);
#pragma unroll 1
    for (int i = 0; i < 30; i += 2) {
        f32x4 nw, nkk, nka, nkm, nr; float nv;
        RWLD(nw, nkk, nka, nkm, nr, nv, op + 2 * ST, vp + 2 * SV);
        RWSTEP(w4a, kk4a, ka4a, km4a, r4a, vva, i);
        w4a = nw; kk4a = nkk; ka4a = nka; km4a = nkm; r4a = nr; vva = nv;
        RWLD(nw, nkk, nka, nkm, nr, nv, op + 3 * ST, vp + 3 * SV);
        RWSTEP(w4b, kk4b, ka4b, km4b, r4b, vvb, i + 1);
        w4b = nw; kk4b = nkk; ka4b = nka; km4b = nkm; r4b = nr; vvb = nv;
        op += 2 * ST; vp += 2 * SV;
    }
    RWSTEP(w4a, kk4a, ka4a, km4a, r4a, vva, 30);
    RWSTEP(w4b, kk4b, ka4b, km4b, r4b, vvb, 31);
#undef RWLD
#undef RWSTEP
    YB[(DIR ? 31 - j : j) * 16 + row] = yk0; YB[(DIR ? 15 - j : 16 + j) * 16 + row] = yk1;
}
struct RwCtx { LAS bf16* WA; LAS bf16* WW; LAS bf16* XA; LAS bf16* XW; LAS bf16* RAWB; LAS float* MU; float* CT; const bf16* colsb;
    f32x4 kk_c4, ka_c4, rk_c4; float ba[4], bw[4]; float mup_[5][2], mun_[5][2]; int h, dir, qtr, tb0; size_t mb; };
template <int NTOK> __device__ __forceinline__ void rw_addr_init(int (&poff)[5], int (&prr)[5], int lane, int tb0, int h, int dir) {
    constexpr int NCHK = (NTOK + 2) * 40;
#pragma unroll
    for (int i = 0; i < 5; ++i) { const int idx = lane + 64 * i; const int rr = idx / 40, q = idx % 40, wh = q >> 3, c8 = q & 7;
        const int gc = (wh == 0 ? R_R + h * 64 : wh == 1 ? R_K + h * 64 : wh == 2 ? R_V + h * 64 : wh == 3 ? R_WDF + dir * 64 : R_AD) + c8 * 8;
        prr[i] = idx < NCHK ? tb0 - 1 + rr : -100000; poff[i] = (tb0 - 1 + rr) * NINP + gc; }
}
template <int NTOK> __device__ __forceinline__ void rw_issue(v4u (&pre)[5], const int (&poff)[5], const int (&prr)[5], const bf16* colsb, int T0) {
    constexpr int NCH = ((NTOK + 2) * 40 + 63) / 64;
#pragma unroll
    for (int i = 0; i < NCH; ++i) { pre[i] = (v4u){0u, 0u, 0u, 0u}; const int t = T0 + prr[i]; if (t >= 0 && t < SEQ) pre[i] = *(const v4u*)(colsb + (size_t)T0 * NINP + poff[i]); }
}
template <int NTOK, bool FULLV> __device__ __forceinline__ void rw_prep(const RwCtx& C, const v4u (&pre)[5], LAS float* OPS, LAS float* VV, int T0, int lane) {
    constexpr int NCHK = (NTOK + 2) * 40, NCH = (NCHK + 63) / 64;
    const int j = lane & 15, c2 = (lane & 31) * 2;
#pragma unroll
    for (int i = 0; i < NCH; ++i) { const int idx = lane + 64 * i; if (idx < NCHK) *(LAS v4u*)(C.RAWB + idx * 8) = pre[i]; }
    LDS_WAIT(); asm volatile("" ::: "memory");
#pragma unroll
    for (int which = 0; which < 5; ++which)
#pragma unroll
        for (int pr = 0; pr < NTOK / 2; ++pr) { const int tt = 2 * pr + (lane >> 5), cc = which * 64 + c2, t = C.tb0 + tt;
            const unsigned r0 = *(const LAS unsigned*)(C.RAWB + tt * 320 + cc), r1 = *(const LAS unsigned*)(C.RAWB + (tt + 1) * 320 + cc), r2 = *(const LAS unsigned*)(C.RAWB + (tt + 2) * 320 + cc);
            const float p1x = bf2f(r1 & 0xffffu), p1y = bf2f(r1 >> 16);
            const float vx = p1x + C.mup_[which][0] * (bf2f(r0 & 0xffffu) - p1x) + C.mun_[which][0] * (bf2f(r2 & 0xffffu) - p1x);
            const float vy = p1y + C.mup_[which][1] * (bf2f(r0 >> 16) - p1y) + C.mun_[which][1] * (bf2f(r2 >> 16) - p1y);
            if (which == 0) *(LAS f32x2*)(OPS + t * 320 + 256 + c2) = (f32x2){vx, vy};
            else if (which == 1) *(LAS f32x2*)(OPS + t * 320 + 192 + c2) = (f32x2){vx, vy};
            else if (which == 2) { if (FULLV) *(LAS f32x2*)(VV + t * 64 + c2) = (f32x2){vx, vy}; else if ((c2 >> 4) == C.qtr) *(LAS f32x2*)(VV + t * 16 + (c2 & 15)) = (f32x2){vx, vy}; }
            else if (which == 3) { const float ex = __expf(2.f * vx), ey = __expf(2.f * vy);
                *(LAS unsigned*)(C.XW + tt * 72 + c2) = pk2(1.f - 2.f * __builtin_amdgcn_rcpf(ex + 1.f), 1.f - 2.f * __builtin_amdgcn_rcpf(ey + 1.f)); }
            else *(LAS unsigned*)(C.XA + tt * 72 + c2) = pk2(vx, vy); }
    LDS_WAIT(); asm volatile("" ::: "memory");
    { const bool hi = lane >= 32; const int lr = ((lane >> 4) & 1) * 4 + (hi ? 2 : 0); const bool ok0 = lr < NTOK, ok1 = lr + 1 < NTOK; const int tb = C.tb0 + lr;
#pragma unroll
      for (int ct = 0; ct < 4; ++ct) { const f32x4 z = {0.f, 0.f, 0.f, 0.f};
        const f32x4 ca = mma16_a8(C.XA, C.WA + ct * 16 * 72, z, lane), cw = mma16_a8(C.XW, C.WW + ct * 16 * 72, z, lane);
        const int c = ct * 16 + j;
        const float a0v = hi ? ca[2] : ca[0], a1v = hi ? ca[3] : ca[1], w0v = hi ? cw[2] : cw[0], w1v = hi ? cw[3] : cw[1];
        if (ok0) { OPS[tb * 320 + 128 + c] = sigmoidf_(C.ba[ct] + a0v); OPS[tb * 320 + c] = __expf(-0.6065306597f * sigmoidf_(C.bw[ct] + w0v)); }
        if (ok1) { OPS[(tb + 1) * 320 + 128 + c] = sigmoidf_(C.ba[ct] + a1v); OPS[(tb + 1) * 320 + c] = __expf(-0.6065306597f * sigmoidf_(C.bw[ct] + w1v)); } } }
    LDS_WAIT(); asm volatile("" ::: "memory");
#pragma unroll
    for (int ps = 0; ps < (NTOK + 3) / 4; ++ps) { const int tl = 4 * ps + (lane >> 4); const bool ok = tl < NTOK; const int t = C.tb0 + (ok ? tl : 0); LAS float* op = OPS + t * 320 + 4 * j;
        const f32x4 av = *(const LAS f32x4*)(op + 128), kp = *(const LAS f32x4*)(op + 192), rp = *(const LAS f32x4*)(op + 256);
        const f32x4 kr = kp * C.kk_c4; const float ss = row16_sum((kr.x * kr.x + kr.y * kr.y) + (kr.z * kr.z + kr.w * kr.w));
        const f32x4 kkv = kr * (1.f / fmaxf(sqrtf(ss), 1e-12f));
        const f32x4 km = kp * ((av - 1.f) * C.ka_c4 + 1.f);
        const f32x4 q = rp * km * C.rk_c4; const float cs = row16_sum((q.x + q.y) + (q.z + q.w));
        if (ok) { *(LAS f32x4*)(op + 64) = kkv; *(LAS f32x4*)(op + 128) = kkv * (-av); *(LAS f32x4*)(op + 192) = km;
            if (C.dir == 0 && C.qtr == 0 && j == 0) C.CT[(C.mb + T0 + t) * 8 + C.h] = cs; } }
}

constexpr int RW_NSLOT = 6, RW_SLOT_WORDS = 32 * 320 + 32 * 64;
constexpr size_t WS_RING = 248 * MiB;
constexpr int CW_RW = 8192;
__device__ __forceinline__ unsigned rw_ld(unsigned* p) { return __hip_atomic_load(p, __ATOMIC_RELAXED, __HIP_MEMORY_SCOPE_AGENT); }
__device__ __forceinline__ void rw_st(unsigned* p, unsigned v) { __hip_atomic_store(p, v, __ATOMIC_RELAXED, __HIP_MEMORY_SCOPE_AGENT); }
__device__ __forceinline__ void rwkv_produce(const Frame& F, int l, int p) {
    const int b = p / 12, rem = p % 12, h = rem >> 1, dir = rem & 1;
    const bf16* cols = (const bf16*)(WSP(F) + WS_COLS);
    const int tid = F.tid, lane = F.lane, wave = F.wave;
    LAS bf16* WA = (LAS bf16*)(F.lds); LAS bf16* WW = (LAS bf16*)(F.lds + 9216);
    LAS float* MU = (LAS float*)(F.lds + 67584);
    LAS float* OPS = (LAS float*)(F.lds + 70144);
    LAS float* VV = (LAS float*)(F.lds + 111104);
    LAS unsigned* flg = (LAS unsigned*)(F.lds + 119296);
    unsigned* ctl = (unsigned*)(WSP(F) + WS_CTL) + CW_RW + 320 * p;
    unsigned long long* ring = (unsigned long long*)(WSP(F) + WS_RING) + (size_t)p * RW_NSLOT * (RW_SLOT_WORDS / 2);
    constexpr int NB = SEQ / 32;
    __syncthreads();
    { const float* aup = INP(F, 13) + (size_t)l * 64 * 384; const float* wup = INP(F, 11) + (size_t)(l * 2 + dir) * 64 * 384;
      for (int idx = tid; idx < 4096; idx += 512) { const int i = idx >> 6, c = idx & 63;
          WA[c * 72 + i] = (bf16)f2bf(aup[i * 384 + h * 64 + c]); WW[c * 72 + i] = (bf16)f2bf(wup[i * 384 + h * 64 + c]); }
      if (tid < 320) { const int which = tid >> 6, c = tid & 63;
          const int rc = which == 0 ? h * 64 + c : which == 1 ? 384 + h * 64 + c : which == 2 ? 768 + h * 64 + c : which == 3 ? 1152 + dir * 64 + c : 1280 + c;
          MU[tid] = INP(F, 8)[l * 1472 + rc]; MU[320 + tid] = INP(F, 9)[l * 1472 + rc]; } }
    __syncthreads();
    const size_t mb = (size_t)b * SEQ;
    const int j = lane & 15;
    RwCtx C;
    C.WA = WA; C.WW = WW; C.XA = (LAS bf16*)(F.lds + 18432) + wave * 576; C.XW = (LAS bf16*)(F.lds + 27648) + wave * 576;
    C.RAWB = (LAS bf16*)(F.lds + 36864) + wave * 1920;
    C.MU = MU; C.CT = (float*)(WSP(F) + WS_CT); C.colsb = cols + mb * NINP; C.h = h; C.dir = dir; C.qtr = 0; C.mb = mb; C.tb0 = 4 * wave;
    { const int hc4 = h * 64 + 4 * j;
      C.kk_c4 = *(const f32x4*)(INP(F, 15) + l * 384 + hc4); C.ka_c4 = *(const f32x4*)(INP(F, 16) + l * 384 + hc4); C.rk_c4 = *(const f32x4*)(INP(F, 17) + l * 384 + hc4);
#pragma unroll
      for (int ct = 0; ct < 4; ++ct) { C.ba[ct] = INP(F, 12)[l * 384 + h * 64 + 16 * ct + j]; C.bw[ct] = INP(F, 10)[(l * 2 + dir) * 384 + h * 64 + 16 * ct + j]; }
      const int c2 = (lane & 31) * 2;
#pragma unroll
      for (int wq = 0; wq < 5; ++wq) { C.mup_[wq][0] = MU[wq * 64 + c2]; C.mup_[wq][1] = MU[wq * 64 + c2 + 1]; C.mun_[wq][0] = MU[320 + wq * 64 + c2]; C.mun_[wq][1] = MU[320 + wq * 64 + c2 + 1]; } }
    v4u pre[5]; int poff[5], prr[5];
    rw_addr_init<4>(poff, prr, lane, C.tb0, h, dir);
    rw_issue<4>(pre, poff, prr, C.colsb, dir ? SEQ - 32 : 0);
    const unsigned G0 = (unsigned)l * NB;
    bool dead = false; unsigned mseen = G0;
#pragma unroll 1
    for (int it = 0; it < NB; ++it) {
        const int T0 = dir ? SEQ - 32 * (it + 1) : 32 * it;
        v4u cur[5];
#pragma unroll
        for (int i = 0; i < 5; ++i) cur[i] = pre[i];
        if (it + 1 < NB) rw_issue<4>(pre, poff, prr, C.colsb, dir ? SEQ - 32 * (it + 2) : 32 * (it + 1));
        rw_prep<4, true>(C, cur, OPS, VV, T0, lane);
        if (tid == 0) { const unsigned need = G0 + (unsigned)it + 1u; unsigned sp = 0u;
            if (need > (unsigned)RW_NSLOT && !dead) { const unsigned want = need - (unsigned)RW_NSLOT;
                while (mseen < want) { if (++sp > (1u << 17)) { dead = true; break; } __builtin_amdgcn_s_sleep(2);
                    const unsigned m01 = min(rw_ld(ctl + 64), rw_ld(ctl + 128)), m23 = min(rw_ld(ctl + 192), rw_ld(ctl + 256)); mseen = min(m01, m23); } }
            flg[0] = sp; }
        __syncthreads();
        { unsigned long long* slot = ring + (size_t)((G0 + (unsigned)it) % RW_NSLOT) * (RW_SLOT_WORDS / 2);
          const LAS v4u* src = (const LAS v4u*)OPS;
#pragma unroll
          for (int i = 0; i < 6; ++i) { const int idx = tid + 512 * i; const v4u d = src[idx]; v4u* dst = (v4u*)slot + idx;
              asm volatile("global_store_dwordx4 %0, %1, off sc1\n\ts_nop 1" :: "v"(dst), "v"(d) : "memory"); } }
        asm volatile("s_waitcnt vmcnt(6)" ::: "memory");
        __syncthreads();
        if (tid == 0 && it >= 1) rw_st(ctl, G0 + (unsigned)it);
    }
    asm volatile("s_waitcnt vmcnt(0)" ::: "memory");
    __syncthreads();
    if (tid == 0) rw_st(ctl, G0 + (unsigned)NB);
    __syncthreads();
}
__device__ __forceinline__ void rwkv_scan(const Frame& F, int l, int p, int qtr) {
    const int b = p / 12, rem = p % 12, h = rem >> 1, dir = rem & 1;
    bf16* Y = (bf16*)(WSP(F) + (dir ? Y_RB : Y_RF));
    const int lane = F.lane, wave = F.wave;
    LAS float* OPSb = (LAS float*)(F.lds);
    LAS float* VVb = (LAS float*)(F.lds + 81920);
    LAS float* YBb = (LAS float*)(F.lds + 86016);
    unsigned* ctl = (unsigned*)(WSP(F) + WS_CTL) + CW_RW + 320 * p;
    const unsigned long long* ring = (const unsigned long long*)(WSP(F) + WS_RING) + (size_t)p * RW_NSLOT * (RW_SLOT_WORDS / 2);
    constexpr int NB = SEQ / 32;
    const size_t mb = (size_t)b * SEQ;
    const int j = lane & 15;
    const unsigned G0 = (unsigned)l * NB;
    __syncthreads();
    if (wave < 4) {
        const int lt = wave * 64 + lane;
        bool dead = false; unsigned pseen = G0;
#pragma unroll 1
        for (int it = 0; it <= NB; ++it) {
            if (it >= 1 && lt == 0) rw_st(ctl + 64 * (qtr + 1), G0 + (unsigned)it);
            if (it < NB) {
                const unsigned need = G0 + (unsigned)it + 1u; unsigned sp = 0u;
                if (!dead) { while (pseen < need) { pseen = rw_ld(ctl); if (pseen >= need) break; if (++sp > (1u << 17)) { dead = true; break; } __builtin_amdgcn_s_sleep(2); } }
                const unsigned long long* slot = ring + (size_t)((G0 + (unsigned)it) % RW_NSLOT) * (RW_SLOT_WORDS / 2);
                LAS unsigned long long* dO = (LAS unsigned long long*)(OPSb + (it & 1) * 10240); LAS unsigned long long* dV = (LAS unsigned long long*)(VVb + (it & 1) * 512);
                unsigned long long v[21];
#pragma unroll
                for (int i = 0; i < 20; ++i) v[i] = __hip_atomic_load(slot + lt + 256 * i, __ATOMIC_RELAXED, __HIP_MEMORY_SCOPE_AGENT);
                v[20] = __hip_atomic_load(slot + 5120 + (lt >> 3) * 32 + qtr * 8 + (lt & 7), __ATOMIC_RELAXED, __HIP_MEMORY_SCOPE_AGENT);
#pragma unroll
                for (int i = 0; i < 20; ++i) dO[lt + 256 * i] = v[i];
                dV[lt] = v[20];
            }
            if (it >= 2) { const int bk = it - 2; const int T0 = dir ? SEQ - 32 * (bk + 1) : 32 * bk; const LAS float* YB = YBb + (bk & 1) * 512;
                const int idx = lt * 2, tl = idx >> 4, rw = idx & 15;
                *(unsigned*)(Y + (mb + T0 + tl) * 384 + h * 64 + 16 * qtr + rw) = pk2(YB[idx], YB[idx + 1]); }
            __syncthreads();
        }
        { const int bk = NB - 1; const int T0 = dir ? SEQ - 32 * (bk + 1) : 32 * bk; const LAS float* YB = YBb + (bk & 1) * 512;
          const int idx = lt * 2, tl = idx >> 4, rw = idx & 15;
          *(unsigned*)(Y + (mb + T0 + tl) * 384 + h * 64 + 16 * qtr + rw) = pk2(YB[idx], YB[idx + 1]); }
    } else {
        const int row = (wave - 4) * 4 + (lane >> 4);
        f32x4 S = {0.f, 0.f, 0.f, 0.f};
#pragma unroll 1
        for (int it = 0; it <= NB; ++it) {
            if (it >= 1) { const int bk = it - 1;
                const LAS float* OPS = OPSb + (bk & 1) * 10240; const LAS float* VV = VVb + (bk & 1) * 512; LAS float* YB = YBb + (bk & 1) * 512;
                if (dir) rwkv_steps<true>(OPS, VV, YB, S, j, row); else rwkv_steps<false>(OPS, VV, YB, S, j, row);
            }
            __syncthreads();
        }
    }
    __syncthreads();
}
__device__ __forceinline__ float row8_sum(float v) { v += dppf<0xB1>(v); v += dppf<0x4E>(v); v += dppf<0x141>(v); return v; }
__device__ __forceinline__ void mlstm_seq(const Frame& F, int l, int task, int cfull0, int cend) {
    const int b = task >> 3, h = (task >> 1) & 3, dir = task & 1;
    const bf16* cols = (const bf16*)(WSP(F) + WS_COLS); const float* GT = (const float*)(WSP(F) + WS_GATES);
    bf16* Y = (bf16*)(WSP(F) + (dir ? Y_AB : Y_AF));
    LAS bf16* RAWQ = (LAS bf16*)(F.lds);
    LAS bf16* Qs = (LAS bf16*)(F.lds + 17408); LAS bf16* Ks = (LAS bf16*)(F.lds + 26624);
    LAS bf16* Vtb = (LAS bf16*)(F.lds + 35840);
    LAS bf16* KWt = (LAS bf16*)(F.lds + 54272); LAS bf16* Ps = (LAS bf16*)(F.lds + 63488);
    LAS bf16* Ctb = (LAS bf16*)(F.lds + 72704);
    LAS float* ub = (LAS float*)(F.lds + 91136);
    LAS float* blb = ub + 128; LAS float* rmb = ub + 256;
    LAS float* den = ub + 384; LAS float* qn = ub + 448; LAS float* nst = ub + 512; LAS float* scb = ub + 576;
    const int tid = F.tid, lane = F.lane, wave = F.wave;
    const size_t mb = (size_t)b * SEQ;
    constexpr int NC = SEQ / 64;
    __syncthreads();
    for (int i = tid; i < 2 * 64 * 72; i += 512) Ctb[i] = 0;
    if (tid < 64) nst[tid] = 0.f;
    const int cc = tid & 127, isK = cc >> 6, d0 = cc & 63, chn = isK * 256 + h * 64 + d0;
    float cw[5]; const float* cwp = INP(F, 3) + (size_t)l * 5 * 512;
#pragma unroll
    for (int jj = 0; jj < 5; ++jj) cw[jj] = cwp[jj * 512 + chn];
    const float cbv = INP(F, 4)[l * 512 + chn];
    f32x4 st[2] = {{0.f, 0.f, 0.f, 0.f}, {0.f, 0.f, 0.f, 0.f}};
    float m_st = 0.f;
    v4u pre[3], prev; float gli = 0.f, glf = 0.f;
#define ML_ISSUE(c_) do { const int tlo_ = dir ? SEQ - 64 * ((c_) + 1) : 64 * (c_); _Pragma("unroll") for (int i_ = 0; i_ < 3; ++i_) { const int ch_ = tid + 512 * i_; pre[i_] = (v4u){0u, 0u, 0u, 0u}; \
        if (ch_ < 68 * 16) { const int rr_ = ch_ >> 4, q_ = ch_ & 15; const int t_ = tlo_ - 2 + rr_; if (t_ >= 0 && t_ < SEQ) pre[i_] = *(const v4u*)(cols + (mb + t_) * NINP + (q_ >> 3) * 256 + h * 64 + (q_ & 7) * 8); } } \
        prev = *(const v4u*)(cols + (mb + tlo_ + (tid >> 3)) * NINP + A_V + h * 64 + (tid & 7) * 8); \
        if (tid < 64) { const int t_ = dir ? tlo_ + 63 - tid : tlo_ + tid; gli = GT[(mb + t_) * 16 + dir * 4 + h]; glf = GT[(mb + t_) * 16 + 8 + dir * 4 + h]; } } while (0)
#define ML_FILL(c_) do { _Pragma("unroll") for (int i_ = 0; i_ < 3; ++i_) { const int ch_ = tid + 512 * i_; if (ch_ < 68 * 16) *(LAS v4u*)(RAWQ + (ch_ >> 4) * 128 + (ch_ & 15) * 8) = pre[i_]; } \
        { LAS bf16* Vt_ = Vtb + ((c_) & 1) * 4608; const int tl_ = tid >> 3, e8_ = tid & 7; const int lp_ = dir ? 63 - tl_ : tl_; const unsigned w_[4] = {prev.x, prev.y, prev.z, prev.w}; \
          _Pragma("unroll") for (int k_ = 0; k_ < 4; ++k_) { const int e_ = e8_ * 8 + 2 * k_; Vt_[e_ * 72 + swz64(e_, lp_)] = (bf16)(w_[k_] & 0xffffu); Vt_[(e_ + 1) * 72 + swz64(e_ + 1, lp_)] = (bf16)(w_[k_] >> 16); } } \
        if (tid < 64) { const float bl_ = wave_scan_add(glf); \
            const float u_ = gli - bl_; const float rm_ = wave_scan_max(u_); \
            ub[((c_) & 1) * 64 + tid] = u_; blb[((c_) & 1) * 64 + tid] = bl_; rmb[((c_) & 1) * 64 + tid] = rm_; if (tid == 63) { scb[((c_) & 1) * 2] = rm_; scb[((c_) & 1) * 2 + 1] = bl_; } } } while (0)
    ML_ISSUE(0); ML_FILL(0); ML_ISSUE(1);
    __syncthreads();
#pragma unroll 1
    for (int c = 0; c < cend; ++c) {
        const bool full = c >= cfull0;
        const int tlo = dir ? SEQ - 64 * (c + 1) : 64 * c;
        const LAS float* u = ub + (c & 1) * 64; const LAS float* bl = blb + (c & 1) * 64; const LAS float* rm = rmb + (c & 1) * 64;
        const LAS bf16* Vt = Vtb + (c & 1) * 4608; const LAS bf16* Ct = Ctb + (c & 1) * 4608; LAS bf16* Ctn = Ctb + ((c + 1) & 1) * 4608;
#pragma unroll 4
        for (int i = 0; i < 16; ++i) { const int tl = (tid >> 7) + 4 * i; float s = cbv;
#pragma unroll
            for (int jj = 0; jj < 5; ++jj) s += cw[jj] * bf2f(RAWQ[(tl + jj) * 128 + cc]);
            s = siluf_(s); const int lpos = dir ? 63 - tl : tl;
            if (isK) Ks[lpos * 72 + d0] = (bf16)f2bf(s * 0.125f); else Qs[lpos * 72 + d0] = (bf16)f2bf(s); }
        if (tid < 64) den[tid] = 0.f;
        __syncthreads();
        const float umax = scb[(c & 1) * 2], tot = scb[(c & 1) * 2 + 1];
        for (int idx = tid; idx < 4096; idx += 512) { const int lp = idx >> 6, d = idx & 63; KWt[d * 72 + swz64(d, lp)] = (bf16)f2bf(bf2f(Ks[lp * 72 + d]) * __expf(u[lp] - umax)); }
        if (full) {
#pragma unroll
        for (int k = 0; k < 2; ++k) { const int ti = 2 * wave + k, tl_ = ti >> 2, ts = ti & 3; f32x4 acc = {0.f, 0.f, 0.f, 0.f};
            if (ts <= tl_) acc = mma16<64>(Qs + tl_ * 16 * 72, 72, Ks + ts * 16 * 72, 72, acc, lane);
#pragma unroll
            for (int jj = 0; jj < 4; ++jj) { const int lr = tl_ * 16 + (lane >> 4) * 4 + jj, s = ts * 16 + (lane & 15);
                const float v = (s <= lr) ? acc[jj] * __expf(u[s] - fmaxf(m_st, rm[lr])) : 0.f; const unsigned vb = f2bf(v); Ps[lr * 72 + s] = (bf16)vb;
                if (ts <= tl_) { const float rs = row16_sum(bf2f(vb)); if ((lane & 15) == 0) __hip_atomic_fetch_add(den + lr, rs, __ATOMIC_RELAXED, __HIP_MEMORY_SCOPE_WORKGROUP); } } }
        { const int lq = tid >> 3, part = tid & 7; float s = 0.f;
#pragma unroll
          for (int k = 0; k < 8; ++k) s += bf2f(Qs[lq * 72 + part * 8 + k]) * nst[part * 8 + k];
          s = row8_sum(s); if (part == 0) qn[lq] = s; }
        }
        __syncthreads();
        const float mmax = fmaxf(m_st, umax), s_old = __expf(m_st - mmax), s_new = __expf(umax - mmax);
#pragma unroll
        for (int k = 0; k < 2; ++k) { const int ti = 2 * wave + k, t0_ = ti >> 2, t1_ = ti & 3; const f32x4 z = {0.f, 0.f, 0.f, 0.f};
            f32x4 a1 = z, a2 = z;
            if (full) { a1 = mma16s<false, true>(Ps, 72, t0_ * 16, Vt, 72, t1_ * 16, z, lane); a2 = mma16<64>(Qs + t0_ * 16 * 72, 72, Ct + t1_ * 16 * 72, 72, z, lane); }
            const f32x4 lc = mma16s<true, true>(Vt, 72, t0_ * 16, KWt, 72, t1_ * 16, z, lane);
#pragma unroll
            for (int jj = 0; jj < 4; ++jj) { const int r_ = t0_ * 16 + (lane >> 4) * 4 + jj, c_ = t1_ * 16 + (lane & 15);
                if (full) { const float mx = fmaxf(m_st, rm[r_]), iwv = __expf(m_st - mx);
                const float dn = den[r_] + iwv * qn[r_];
                const float val = (a1[jj] + iwv * a2[jj]) / fmaxf(fabsf(dn), __expf(-(bl[r_] + mx)));
                const int t = dir ? tlo + 63 - r_ : tlo + r_;
                Y[(mb + t) * 256 + h * 64 + c_] = (bf16)f2bf(val); }
                st[k][jj] = s_old * st[k][jj] + s_new * lc[jj];
                Ctn[r_ * 72 + c_] = (bf16)f2bf(st[k][jj]); } }
        { const int dq = tid >> 3, part = tid & 7; float s = 0.f;
#pragma unroll
          for (int k = 0; k < 8; ++k) s += bf2f(KWt[dq * 72 + swz64(dq, part * 8) + k]);
          s = row8_sum(s); if (part == 0) nst[dq] = s_old * nst[dq] + s_new * s; }
        m_st = tot + mmax;
        if (c + 1 < cend) { ML_FILL(c + 1); if (c + 2 < cend) ML_ISSUE(c + 2); }
        __syncthreads();
    }
#undef ML_ISSUE
#undef ML_FILL
}
__device__ __forceinline__ void phase_ssd_conv(const Frame& F, int l) {
    const bf16* cols = (const bf16*)(WSP(F) + WS_COLS); bf16* XBC = (bf16*)(WSP(F) + WS_XN);
    LAS bf16* raw = (LAS bf16*)(F.lds);
    const float* cwp = INP(F, 20) + (size_t)l * 5 * 896; const float* cbp = INP(F, 21) + l * 896;
    const int tid = F.tid;
    float cw0[5], cw1[5]; const int c1 = tid + 512 < 896 ? tid + 512 : tid;
#pragma unroll
    for (int jj = 0; jj < 5; ++jj) { cw0[jj] = cwp[jj * 896 + tid]; cw1[jj] = cwp[jj * 896 + c1]; }
    const float cb0 = cbp[tid], cb1 = cbp[c1];
    for (int tile = F.vcu; tile < M / 32; tile += F.G) {
        const int m0 = tile * 32, t0 = m0 % SEQ;
        __syncthreads();
        for (int ch = tid; ch < 36 * 112; ch += 512) { const int rr = ch / 112, cc = ch % 112; const int t = t0 - 2 + rr;
            v4u v = {0u, 0u, 0u, 0u}; if (t >= 0 && t < SEQ) v = *(const v4u*)(cols + (size_t)(m0 - 2 + rr) * NINP + S_X + cc * 8);
            *(LAS v4u*)(raw + rr * 896 + cc * 8) = v; }
        __syncthreads();
#pragma unroll
        for (int half = 0; half < 2; ++half) { const int c = half ? c1 : tid; if (half && tid + 512 >= 896) break;
            float win[5];
#pragma unroll
            for (int jj = 0; jj < 4; ++jj) win[jj] = bf2f(raw[jj * 896 + c]);
            for (int tl = 0; tl < 32; ++tl) { win[4] = bf2f(raw[(tl + 4) * 896 + c]);
                float s = half ? cb1 : cb0;
#pragma unroll
                for (int jj = 0; jj < 5; ++jj) s += (half ? cw1[jj] : cw0[jj]) * win[jj];
#pragma unroll
                for (int jj = 0; jj < 4; ++jj) win[jj] = win[jj + 1];
                XBC[(size_t)(m0 + tl) * 896 + c] = (bf16)f2bf(siluf_(s)); } }
    }
    __syncthreads();
}
__device__ __forceinline__ void ssd_seq(const Frame& F, int l, int task, int cfull0, int cend) {
    const int b = task / 12, rem = task % 12, head = rem >> 1, dir = rem & 1, g = head / 3;
    const bf16* cols = (const bf16*)(WSP(F) + WS_COLS); const bf16* XBC = (const bf16*)(WSP(F) + WS_XN);
    bf16* Y = (bf16*)(WSP(F) + (dir ? Y_SB : Y_SF));
    LAS bf16* Cm = (LAS bf16*)(F.lds); LAS bf16* Bm = (LAS bf16*)(F.lds + 17408);
    LAS bf16* Btw = (LAS bf16*)(F.lds + 34816); LAS bf16* Xt = (LAS bf16*)(F.lds + 53248);
    LAS bf16* Ps = (LAS bf16*)(F.lds + 62464); LAS bf16* Hs = (LAS bf16*)(F.lds + 71680);
    LAS float* dtvb = (LAS float*)(F.lds + 89088);
    LAS float* acsb = dtvb + 128;
    LAS float* totb = dtvb + 256;
    const int tid = F.tid, lane = F.lane, wave = F.wave;
    const size_t mb = (size_t)b * SEQ;
    constexpr int NC = SEQ / 64;
    __syncthreads();
    for (int i = tid; i < 64 * 136; i += 512) Hs[i] = 0;
    const float dtb = INP(F, 22)[(l * 2 + dir) * 6 + head];
    const float aneg = -__expf(INP(F, 23)[(l * 2 + dir) * 6 + head]);
    f32x4 st[4];
#pragma unroll
    for (int k = 0; k < 4; ++k) st[k] = (f32x4){0.f, 0.f, 0.f, 0.f};
    v4u pre[5]; float dtraw = 0.f;
#define SSD_ISSUE(c_) do { const int tlo_ = dir ? SEQ - 64 * ((c_) + 1) : 64 * (c_); _Pragma("unroll") for (int i_ = 0; i_ < 5; ++i_) { const int idx_ = tid + 512 * i_; const int tl_ = idx_ / 40, q_ = idx_ % 40; \
        const int gc_ = q_ < 8 ? head * 64 + q_ * 8 : (q_ < 24 ? 384 + g * 128 + (q_ - 8) * 8 : 640 + g * 128 + (q_ - 24) * 8); \
        pre[i_] = *(const v4u*)(XBC + (mb + tlo_ + tl_) * 896 + gc_); } } while (0)
#define SSD_DTLOAD(c_) do { if (tid < 64) { const int tlo_ = dir ? SEQ - 64 * ((c_) + 1) : 64 * (c_); const int t_ = dir ? tlo_ + 63 - tid : tlo_ + tid; dtraw = bf2f(cols[(mb + t_) * NINP + S_DT + dir * 6 + head]); } } while (0)
#define SSD_DTCALC(c_) do { if (tid < 64) { const float x_ = dtraw + dtb; const float dt_ = x_ > 20.f ? x_ : log1pf(__expf(x_)); float cs_ = dt_ * aneg; \
        cs_ = wave_scan_add(cs_); \
        const float tt_ = __builtin_bit_cast(float, __builtin_amdgcn_readlane(__builtin_bit_cast(int, cs_), 63)); dtvb[((c_) & 1) * 64 + tid] = dt_; acsb[((c_) & 1) * 64 + tid] = cs_; if (tid == 0) totb[(c_) & 1] = tt_; } } while (0)
    SSD_ISSUE(0); SSD_DTLOAD(0); SSD_DTCALC(0); SSD_DTLOAD(1);
    __syncthreads();
#pragma unroll 1
    for (int c = 0; c < cend; ++c) {
        const bool full = c >= cfull0;
        const int tlo = dir ? SEQ - 64 * (c + 1) : 64 * c;
        const LAS float* dtv = dtvb + (c & 1) * 64; const LAS float* acs = acsb + (c & 1) * 64; const float tot = totb[c & 1];
#pragma unroll
        for (int i = 0; i < 5; ++i) { const int idx = tid + 512 * i; const int tl = idx / 40, q = idx % 40; const int lp = dir ? 63 - tl : tl;
            const unsigned w[4] = {pre[i].x, pre[i].y, pre[i].z, pre[i].w};
            if (q < 8) {
#pragma unroll
                for (int k = 0; k < 4; ++k) { const int p0 = q * 8 + 2 * k; Xt[p0 * 72 + swz64(p0, lp)] = (bf16)(w[k] & 0xffffu); Xt[(p0 + 1) * 72 + swz64(p0 + 1, lp)] = (bf16)(w[k] >> 16); } }
            else if (q < 24) { const int n0 = (q - 8) * 8; if (full) *(LAS v4u*)(Bm + lp * 136 + n0) = pre[i]; const float sc = dtv[lp] * __expf(tot - acs[lp]);
#pragma unroll
                for (int k = 0; k < 4; ++k) { const int nn = n0 + 2 * k; Btw[nn * 72 + swz64(nn, lp)] = (bf16)f2bf(bf2f(w[k] & 0xffffu) * sc); Btw[(nn + 1) * 72 + swz64(nn + 1, lp)] = (bf16)f2bf(bf2f(w[k] >> 16) * sc); } }
            else if (full) { const int n0 = (q - 24) * 8; *(LAS v4u*)(Cm + lp * 136 + n0) = pre[i]; } }
        if (c + 1 < cend) SSD_ISSUE(c + 1);
        __syncthreads();
        f32x4 yo[2] = {{0.f, 0.f, 0.f, 0.f}, {0.f, 0.f, 0.f, 0.f}}, lc[4];
        if (full) {
#pragma unroll
        for (int k = 0; k < 2; ++k) { const int ti = 2 * wave + k, tl_ = ti >> 2, ts = ti & 3; f32x4 acc = {0.f, 0.f, 0.f, 0.f};
            if (ts <= tl_) acc = mma16<128>(Cm + tl_ * 16 * 136, 136, Bm + ts * 16 * 136, 136, acc, lane);
#pragma unroll
            for (int jj = 0; jj < 4; ++jj) { const int lr = tl_ * 16 + (lane >> 4) * 4 + jj, s = ts * 16 + (lane & 15);
                const float v = (s <= lr) ? acc[jj] * __expf(acs[lr] - acs[s]) * dtv[s] : 0.f; Ps[lr * 72 + s] = (bf16)f2bf(v); }
            const f32x4 z = {0.f, 0.f, 0.f, 0.f};
            yo[k] = mma16<128>(Cm + tl_ * 16 * 136, 136, Hs + ts * 16 * 136, 136, z, lane); }
        }
#pragma unroll
        for (int k = 0; k < 4; ++k) { const int ti = 4 * wave + k, tp = ti >> 3, tn = ti & 7; const f32x4 z = {0.f, 0.f, 0.f, 0.f};
            lc[k] = mma16s<true, true>(Xt, 72, tp * 16, Btw, 72, tn * 16, z, lane); }
        __syncthreads();
        const float cdec = __expf(tot);
        if (full) {
#pragma unroll
        for (int k = 0; k < 2; ++k) { const int ti = 2 * wave + k, tl_ = ti >> 2, tp = ti & 3; const f32x4 z = {0.f, 0.f, 0.f, 0.f};
            const f32x4 yd = mma16s<false, true>(Ps, 72, tl_ * 16, Xt, 72, tp * 16, z, lane);
#pragma unroll
            for (int jj = 0; jj < 4; ++jj) { const int lr = tl_ * 16 + (lane >> 4) * 4 + jj, p = tp * 16 + (lane & 15);
                const float val = yd[jj] + yo[k][jj] * __expf(acs[lr]);
                const int t = dir ? tlo + 63 - lr : tlo + lr;
                Y[(mb + t) * 384 + head * 64 + p] = (bf16)f2bf(val); } }
        }
#pragma unroll
        for (int k = 0; k < 4; ++k) { const int ti = 4 * wave + k, tp = ti >> 3, tn = ti & 7;
#pragma unroll
            for (int jj = 0; jj < 4; ++jj) { const int p = tp * 16 + (lane >> 4) * 4 + jj, n = tn * 16 + (lane & 15);
                st[k][jj] = cdec * st[k][jj] + lc[k][jj]; Hs[p * 136 + n] = (bf16)f2bf(st[k][jj]); } }
        if (c + 1 < cend) { SSD_DTCALC(c + 1); if (c + 2 < cend) SSD_DTLOAD(c + 2); }
        __syncthreads();
    }
#undef SSD_ISSUE
#undef SSD_DTLOAD
#undef SSD_DTCALC
}
__device__ __forceinline__ float wave_sum2(float v) { v = row16_sum(v); v += __shfl_xor(v, 16); v += __shfl_xor(v, 32); return v; }
__device__ __forceinline__ f32x4 bf4(v2u w) { return (f32x4){bf2f(w.x & 0xffffu), bf2f(w.x >> 16), bf2f(w.y & 0xffffu), bf2f(w.y >> 16)}; }
__device__ __forceinline__ v2u pk4(f32x4 v) { v2u w; w.x = pk2(v.x, v.y); w.y = pk2(v.z, v.w); return w; }
__device__ __forceinline__ void phase_post(const Frame& F, int l) {
    const bf16* cols = (const bf16*)(WSP(F) + WS_COLS); bf16* MIX = (bf16*)(WSP(F) + WS_XN);
    const bf16* YAf = (const bf16*)(WSP(F) + Y_AF); const bf16* YAb = (const bf16*)(WSP(F) + Y_AB);
    const bf16* YRf = (const bf16*)(WSP(F) + Y_RF); const bf16* YRb = (const bf16*)(WSP(F) + Y_RB);
    const bf16* YSf = (const bf16*)(WSP(F) + Y_SF); const bf16* YSb = (const bf16*)(WSP(F) + Y_SB);
    const float* CT = (const float*)(WSP(F) + WS_CT);
    LAS bf16* GU = (LAS bf16*)(F.lds);
    LAS bf16* SG = (LAS bf16*)(F.lds + 104448);
    LAS float* gate = (LAS float*)(F.lds + 108800);
    LAS float* SCW = (LAS float*)(F.lds + 133632);
    const int tid = F.tid, lane = F.lane, wave = F.wave;
    const float* mup = INP(F, 8) + l * 1472; const float* mun = INP(F, 9) + l * 1472;
    const float* gup = INP(F, 14) + (size_t)l * 128 * 384;
    const float* sdk = INP(F, 24) + l * 6;
    __syncthreads();
    for (int idx = tid; idx < 128 * 384; idx += 512) { const int i = idx / 384, c = idx % 384; GU[c * 136 + i] = (bf16)f2bf(gup[idx]); }
    { const float* scw = INP(F, 20) + (size_t)l * 5 * 896; for (int idx = tid; idx < 5 * 384; idx += 512) SCW[idx] = scw[(idx / 384) * 896 + (idx % 384)]; }
    const int gch = tid & 15;
    float gmp[8], gmn[8];
#pragma unroll
    for (int k = 0; k < 8; ++k) { gmp[k] = mup[1344 + 8 * gch + k]; gmn[k] = mun[1344 + 8 * gch + k]; }
    const int qa = lane, qb = 64 + (lane & 31);
    const f32x4 mng4 = *(const f32x4*)(INP(F, 7) + l * 256 + 4 * qa);
    f32x4 rmp[2], rmn[2], rng[2], rnb[2], scb[2], sng[2];
#pragma unroll
    for (int ps = 0; ps < 2; ++ps) { const int c0 = 4 * (ps ? qb : qa);
        rmp[ps] = *(const f32x4*)(mup + 768 + c0); rmn[ps] = *(const f32x4*)(mun + 768 + c0);
        rng[ps] = *(const f32x4*)(INP(F, 18) + l * 384 + c0); rnb[ps] = *(const f32x4*)(INP(F, 19) + l * 384 + c0);
        scb[ps] = *(const f32x4*)(INP(F, 21) + l * 896 + c0); sng[ps] = *(const f32x4*)(INP(F, 25) + l * 384 + c0); }
    for (int tile = F.vcu; tile < M / 16; tile += F.G) {
        const int m0 = tile * 16;
        __syncthreads();
        if (tid < 256) { const int tt = tid >> 4; const int m = m0 + tt, t = m % SEQ; const bf16* cp = cols + (size_t)m * NINP + R_GD + 8 * gch;
            const v4u c1 = *(const v4u*)cp; v4u c0 = {0u, 0u, 0u, 0u}, c2 = {0u, 0u, 0u, 0u};
            if (t > 0) c0 = *(const v4u*)(cp - NINP); if (t < SEQ - 1) c2 = *(const v4u*)(cp + NINP);
            const unsigned w0[4] = {c0.x, c0.y, c0.z, c0.w}, w1[4] = {c1.x, c1.y, c1.z, c1.w}, w2[4] = {c2.x, c2.y, c2.z, c2.w}; unsigned o[4];
#pragma unroll
            for (int k = 0; k < 4; ++k) { const float a1 = bf2f(w1[k] & 0xffffu), b1 = bf2f(w1[k] >> 16);
                const float va = a1 + gmp[2 * k] * (bf2f(w0[k] & 0xffffu) - a1) + gmn[2 * k] * (bf2f(w2[k] & 0xffffu) - a1);
                const float vb = b1 + gmp[2 * k + 1] * (bf2f(w0[k] >> 16) - b1) + gmn[2 * k + 1] * (bf2f(w2[k] >> 16) - b1);
                o[k] = pk2(sigmoidf_(va), sigmoidf_(vb)); }
            *(LAS v4u*)(SG + tt * 136 + 8 * gch) = (v4u){o[0], o[1], o[2], o[3]}; }
        __syncthreads();
#pragma unroll
        for (int k = 0; k < 3; ++k) { const int ct = wave + 8 * k; const f32x4 z = {0.f, 0.f, 0.f, 0.f};
            const f32x4 acc = mma16<128>(SG, 136, GU + ct * 16 * 136, 136, z, lane);
#pragma unroll
            for (int jj = 0; jj < 4; ++jj) gate[((lane >> 4) * 4 + jj) * 388 + ct * 16 + (lane & 15)] = acc[jj]; }
        __syncthreads();
#pragma unroll 1
        for (int k = 0; k < 2; ++k) { const int tt = wave * 2 + k; const int m = m0 + tt, t = m % SEQ; const size_t cr = (size_t)m * NINP;
            { const int c0 = 4 * qa;
              const f32x4 hs = bf4(*(const v2u*)(YAf + (size_t)m * 256 + c0)) + bf4(*(const v2u*)(YAb + (size_t)m * 256 + c0));
              const float mean = row16_sum((hs.x + hs.y) + (hs.z + hs.w)) * (1.f / 64.f); const f32x4 d = hs - mean;
              const float var = row16_sum((d.x * d.x + d.y * d.y) + (d.z * d.z + d.w * d.w)) * (1.f / 64.f);
              const f32x4 o = bf4(*(const v2u*)(cols + cr + A_O + c0));
              f32x4 y = d * (1.f / sqrtf(var + 1e-6f)) * mng4;
              y.x *= sigmoidf_(o.x); y.y *= sigmoidf_(o.y); y.z *= sigmoidf_(o.z); y.w *= sigmoidf_(o.w);
              *(v2u*)(MIX + (size_t)m * DM + c0) = pk4(y); }
#pragma unroll
            for (int ps = 0; ps < 2; ++ps) { const int qd = ps ? qb : qa, c0 = 4 * qd; const bool act = ps == 0 || lane < 32;
              const f32x4 ys = bf4(*(const v2u*)(YRf + (size_t)m * 384 + c0)) + bf4(*(const v2u*)(YRb + (size_t)m * 384 + c0));
              const float mean = row16_sum((ys.x + ys.y) + (ys.z + ys.w)) * (1.f / 64.f); const f32x4 d = ys - mean;
              const float var = row16_sum((d.x * d.x + d.y * d.y) + (d.z * d.z + d.w * d.w)) * (1.f / 64.f);
              const f32x4 y = d * (1.f / sqrtf(var + 64e-5f)) * rng[ps] + rnb[ps];
              const f32x4 p1 = bf4(*(const v2u*)(cols + cr + R_V + c0));
              f32x4 p0 = {0.f, 0.f, 0.f, 0.f}, p2 = {0.f, 0.f, 0.f, 0.f};
              if (t > 0) p0 = bf4(*(const v2u*)(cols + cr - NINP + R_V + c0)); if (t < SEQ - 1) p2 = bf4(*(const v2u*)(cols + cr + NINP + R_V + c0));
              const f32x4 vv = p1 + rmp[ps] * (p0 - p1) + rmn[ps] * (p2 - p1);
              const float ctv = CT[(size_t)m * 8 + (qd >> 4)];
              const f32x4 g4 = *(const LAS f32x4*)(gate + tt * 388 + c0);
              if (act) *(v2u*)(MIX + (size_t)m * DM + 256 + c0) = pk4((y + vv * ctv) * g4); }
            f32x4 yv[2]; float ssq0 = 0.f, ssq1 = 0.f;
#pragma unroll
            for (int ps = 0; ps < 2; ++ps) { const int qd = ps ? qb : qa, c0 = 4 * qd; const bool act = ps == 0 || lane < 32;
              f32x4 s = scb[ps];
#pragma unroll
              for (int jj = 0; jj < 5; ++jj) { const int tq = t + jj - 2; if (tq >= 0 && tq < SEQ) s += *(const LAS f32x4*)(SCW + jj * 384 + c0) * bf4(*(const v2u*)(cols + cr + (jj - 2) * NINP + S_X + c0)); }
              const f32x4 z = bf4(*(const v2u*)(cols + cr + S_Z + c0));
              f32x4 y = bf4(*(const v2u*)(YSf + (size_t)m * 384 + c0)) + bf4(*(const v2u*)(YSb + (size_t)m * 384 + c0));
              const float dsk = sdk[qd >> 4];
              y.x = (y.x + dsk * siluf_(s.x)) * siluf_(z.x); y.y = (y.y + dsk * siluf_(s.y)) * siluf_(z.y); y.z = (y.z + dsk * siluf_(s.z)) * siluf_(z.z); y.w = (y.w + dsk * siluf_(s.w)) * siluf_(z.w);
              yv[ps] = y; const float sq = act ? (y.x * y.x + y.y * y.y) + (y.z * y.z + y.w * y.w) : 0.f;
              if (qd < 48) ssq0 += sq; else ssq1 += sq; }
            const float r0 = 1.f / sqrtf(wave_sum2(ssq0) * (1.f / 192.f) + 1e-6f), r1 = 1.f / sqrtf(wave_sum2(ssq1) * (1.f / 192.f) + 1e-6f);
#pragma unroll
            for (int ps = 0; ps < 2; ++ps) { const int qd = ps ? qb : qa, c0 = 4 * qd; const bool act = ps == 0 || lane < 32;
              if (act) *(v2u*)(MIX + (size_t)m * DM + 640 + c0) = pk4(yv[ps] * (qd < 48 ? r0 : r1) * sng[ps]); }
        }
    }
    __syncthreads();
}
namespace cg = cooperative_groups;
constexpr int N_PHASES = 9 * DEPTH + 1;
__global__ void __launch_bounds__(NWAVES * 64, 2) mk_fwd(Args args) {
    extern __shared__ __attribute__((aligned(16))) unsigned char lds_raw[];
    Frame F;
    F.lds = (LAS unsigned char*)lds_raw;
    F.tid = threadIdx.x; F.lane = F.tid & 63; F.wave = __builtin_amdgcn_readfirstlane(F.tid >> 6);
    F.G = gridDim.x; { const int bx = blockIdx.x; F.vcu = (F.G % 8 == 0) ? (bx % 8) * (F.G / 8) + bx / 8 : bx; }
    volatile LAS unsigned* MISC = (volatile LAS unsigned*)(F.lds + MISC_OFF);
    if (F.tid < 64) MISC[F.tid] = 0u;
    if (F.tid < 34) *(LAS unsigned long long*)(F.lds + PTAB_OFF + 8 * F.tid) = ((const unsigned long long*)__builtin_amdgcn_kernarg_segment_ptr())[F.tid];
    __syncthreads();
    unsigned* ctl = (unsigned*)(WSP(F) + WS_CTL);
    XcdBarrier bar = xcd_barrier_post(ctl + CW_BAR, MISC + 8);
    const int lo = args.ph_lo, hi = args.ph_hi;
#define IN_(k) (lo <= (k) && (k) < hi)
#define SEAM(k) do { if (IN_(k) && IN_((k) + 1)) { if ((k) == 0) cg::this_grid().sync(); else xcd_barrier(bar); } } while (0)
#define LAYER(l, B) \
    if (IN_(B + 0)) { phase_convert(F, l); phase_norm(F, l == 0 ? INP(F, 0) : OUTP(F), INP(F, 1) + l * DM, (bf16*)(WSP(F) + WS_XN)); } SEAM(B + 0); \
    if (IN_(B + 1)) { unsigned char* ws = WSP(F); pg8::Gemm g{(const bf16*)(ws + WS_XN), (const bf16*)(ws + WS_WIN), M, NINP, DM}; pg8::StaticOrder S; S.init(M, NINP, F.G, (int)blockIdx.x); \
            pg8::EpiBf16<0> E{(bf16*)(ws + WS_COLS), NINP, nullptr, 0, 0, 1.f}; \
            pg8::gemm_phase<pg8::EpiBf16<0>, pg8::StaticOrder, PG8_ALIGN, PG8_SP2>(F.lds, g, S, E); } SEAM(B + 1); \
    if (IN_(B + 2)) { phase_gates(F, l); phase_ssd_conv(F, l); } SEAM(B + 2); \
    if (IN_(B + 3)) { const int bx = blockIdx.x; \
            if (bx < 96) { const int c8 = bx & 7, k8 = bx >> 3; rwkv_scan(F, l, c8 + 8 * (k8 >> 2), k8 & 3); } else if (bx < 120) rwkv_produce(F, l, bx - 96); else if (bx < 216) { const int u = bx - 120, sg = 3 - (u / 24); ssd_seq(F, l, u % 24, 32 * sg, 32 * sg + 32); } else if (bx < 248) { const int u = bx - 216, sg = 1 - (u / 16); mlstm_seq(F, l, u % 16, 64 * sg, 64 * sg + 64); } } SEAM(B + 3); \
    if (IN_(B + 4)) phase_post(F, l); SEAM(B + 4); \
    if (IN_(B + 5)) { unsigned char* ws = WSP(F); pg8::Gemm g{(const bf16*)(ws + WS_XN), (const bf16*)(ws + WS_WOUT), M, DM, DM}; pg8::StaticOrder S; S.init(M, DM, F.G, (int)blockIdx.x); \
            pg8::EpiResidual E{l == 0 ? INP(F, 0) : OUTP(F), OUTP(F), DM}; \
            pg8::gemm_phase<pg8::EpiResidual, pg8::StaticOrder, PG8_ALIGN, PG8_SP2>(F.lds, g, S, E); } SEAM(B + 5); \
    if (IN_(B + 6)) phase_norm(F, OUTP(F), INP(F, 27) + l * DM, (bf16*)(WSP(F) + WS_XN)); SEAM(B + 6); \
    if (IN_(B + 7)) { unsigned char* ws = WSP(F); pg8::Gemm g{(const bf16*)(ws + WS_XN), (const bf16*)(ws + WS_WGU), M, 2 * FFN, DM}; pg8::StaticOrder S; S.init(M, 2 * FFN, F.G, (int)blockIdx.x); \
            pg8::EpiSwiGLU E{(bf16*)(ws + WS_COLS), FFN}; \
            pg8::gemm_phase<pg8::EpiSwiGLU, pg8::StaticOrder, PG8_ALIGN, PG8_SP2>(F.lds, g, S, E); } SEAM(B + 7); \
    if (IN_(B + 8)) { unsigned char* ws = WSP(F); pg8::Gemm g{(const bf16*)(ws + WS_COLS), (const bf16*)(ws + WS_WDN), M, DM, FFN}; pg8::StaticOrder S; S.init(M, DM, F.G, (int)blockIdx.x); \
            pg8::EpiResidual E{OUTP(F), OUTP(F), DM}; \
            pg8::gemm_phase<pg8::EpiResidual, pg8::StaticOrder, PG8_ALIGN, PG8_SP2>(F.lds, g, S, E); } SEAM(B + 8);
    LAYER(0, 0)
    LAYER(1, 9)
    if (IN_(18)) phase_final_norm(F, OUTP(F), INP(F, 31));
#undef IN_
#undef SEAM
#undef LAYER
}

#ifndef MK_PER_PHASE
#define MK_PER_PHASE 0
#endif
extern "C" void kernel_launch(void* const* d_in, const int* in_sizes, int n_in, void* d_out, int out_size, void* d_ws, size_t ws_size, hipStream_t stream) {
    static int grid = 0;
    if (grid == 0) {
        int dev = 0, cus = 0;
        if (n_in != 32 || out_size != M * DM || ws_size < WS_END) { fprintf(stderr, "kernel_launch: unexpected shapes (n_in %d out %d ws %zu)\n", n_in, out_size, ws_size); grid = -1; return; }
        if (hipGetDevice(&dev) != hipSuccess || hipDeviceGetAttribute(&cus, hipDeviceAttributeMultiprocessorCount, dev) != hipSuccess) { grid = -1; return; }
        if (hipFuncSetAttribute((const void*)mk_fwd, hipFuncAttributeMaxDynamicSharedMemorySize, LDS_BYTES) != hipSuccess) { fprintf(stderr, "kernel_launch: hipFuncSetAttribute failed\n"); grid = -1; return; }
        int per_cu = 0;
        if (hipOccupancyMaxActiveBlocksPerMultiprocessor(&per_cu, (const void*)mk_fwd, NWAVES * 64, LDS_BYTES) != hipSuccess || per_cu < 1) { fprintf(stderr, "kernel_launch: occupancy query says %d\n", per_cu); }
        (void)hipGetLastError();
        grid = cus;
    }
    if (grid < 0) return;
    (void)hipMemsetAsync((char*)d_ws + WS_CTL, 0, CTL_ZERO_BYTES, stream);
    Args a{};
    for (int i = 0; i < 32; ++i) a.in[i] = (const float*)d_in[i];
    a.out = (float*)d_out; a.ws = (unsigned char*)d_ws;
#if MK_PER_PHASE
    for (int p = 0; p < N_PHASES; ++p) { a.ph_lo = p; a.ph_hi = p + 1; hipLaunchKernelGGL(mk_fwd, dim3(grid), dim3(NWAVES * 64), LDS_BYTES, stream, a); }
#else
    a.ph_lo = 0; a.ph_hi = N_PHASES;
    void* kargs[] = {&a};
    hipError_t e = hipLaunchCooperativeKernel((const void*)mk_fwd, dim3(grid), dim3(NWAVES * 64), kargs, LDS_BYTES, stream);
    if (e != hipSuccess) fprintf(stderr, "cooperative launch failed: %s (grid %d)\n", hipGetErrorString(e), grid);
#endif
}
```

```cpp
#include <hip/hip_runtime.h>
#include <hip/hip_cooperative_groups.h>
#include <cstdio>
#include <cstdint>
namespace pg8 {
#define PG8_LAS __attribute__((address_space(3)))
typedef unsigned short bf16_t;
typedef short bf16x8 __attribute__((ext_vector_type(8)));
typedef float f32x4 __attribute__((ext_vector_type(4)));
typedef unsigned u32x4 __attribute__((ext_vector_type(4)));
constexpr int BM = 256, BK = 64, HALF = 128, HTB = HALF * BK * 2  , STAGE_BYTES = 8 * HTB, NXCD = 8, WGM = 8;

__host__ __device__ __forceinline__ int lds_byte(int r, int c) { const int st = (r >> 4) * 2 + (c >> 5), rr = r & 15, cc = c & 31, ob = rr * 64 + cc * 2; return st * 1024 + (ob ^ (((ob >> 9) & 1) << 5)); }
__host__ __device__ __forceinline__ void stage_rc(int b, int& R, int& C) { const int st = b / 1024, sb = b % 1024, swz = sb ^ (((sb >> 9) & 1) << 5); R = (st >> 1) * 16 + swz / 64; C = (st & 1) * 32 + (swz % 64) / 2; }
__host__ __device__ __forceinline__ int perm32(int rho) { const int n = rho >> 4, i = rho & 15; return 8 * (i >> 2) + 4 * n + (i & 3); }

struct Unit { int pm, pn; };
struct Gemm { const bf16_t* A; const bf16_t* Bt; int M, N, K; };

struct StaticOrder {
    int nM, nN, nwg, G, c;
    __host__ __device__ void init(int M, int N, int G_, int c_) { nM = M / BM; nN = N / BM; nwg = nM * nN; G = G_; c = c_; }
    __host__ __device__ bool next(int i, Unit& u) const {
        const long L = (long)i * G + c; if (L >= nwg) return false;
        int wgid = (int)L; { const int q = nwg / NXCD, r = nwg % NXCD, xcd = wgid % NXCD, off = wgid / NXCD; wgid = (xcd < r ? xcd * (q + 1) : r * (q + 1) + (xcd - r) * q) + off; }
        const int nig = WGM * nN, gid = wgid / nig, fm = gid * WGM, gsz = (nM - fm) < WGM ? (nM - fm) : WGM;
        u.pm = fm + ((wgid % nig) % gsz); u.pn = (wgid % nig) / gsz; return true;
    }
    __device__ __forceinline__ void a_ready(const Unit&) const {}
    __device__ __forceinline__ void done(const Unit&) const {}
};

__device__ __forceinline__ unsigned cvt_pk_bf16(float lo, float hi) { unsigned r; asm volatile("v_cvt_pk_bf16_f32 %0, %1, %2" : "=v"(r) : "v"(lo), "v"(hi)); return r; }
typedef float f32x2 __attribute__((ext_vector_type(2)));
__device__ __forceinline__ f32x2 gelu_pk(f32x2 v) {
    const f32x2 av = __builtin_elementwise_abs(v), d = av * 0.2316418882f + 1.0f;
    f32x2 t; t.x = __builtin_amdgcn_rcpf(d.x); t.y = __builtin_amdgcn_rcpf(d.y);
    f32x2 q = t * 0.5307027145f + (-0.7265760135f); q = q * t + 0.7107068705f; q = q * t + (-0.142248368f); q = q * t + 0.127414796f; q = q * t;
    const f32x2 s = (v * v) * (-0.72134752044f);
    f32x2 e; e.x = __builtin_amdgcn_exp2f(s.x); e.y = __builtin_amdgcn_exp2f(s.y);
    const f32x2 m = v * (q * e), r = v - m;
    f32x2 o; o.x = v.x < 0.f ? m.x : r.x; o.y = v.y < 0.f ? m.y : r.y; return o;
}

template <int ACT  > struct EpiBf16 {
    static constexpr bool PERM = true, AFTER_DRAIN = false; static_assert(ACT == 0 || ACT == 1, "EpiBf16: ACT is 0 (none) or 1 (gelu_pk)");
    bf16_t* O; int ldc; const float* bias; int split_cols; size_t split_stride; float scale0;
    __device__ __forceinline__ void operator()(const f32x4 (&acc)[2][2][4][2], const Unit& u, int wr, int wc, int fr, int fq) const {
        const int row0 = u.pm * BM + wr * 64 + fr; int colt = u.pn * BM; bf16_t* base = O;
        float sc = 1.f; if (split_cols) { const int t = colt / split_cols; base += (size_t)t * split_stride; colt -= t * split_cols; if (t == 0) sc = scale0; }
        const int col0 = colt + wc * 32 + 8 * fq, bcol0 = u.pn * BM + wc * 32 + 8 * fq;
        f32x4 bv[2][2];
#pragma unroll
        for (int bj = 0; bj < 2; ++bj)
#pragma unroll
            for (int n = 0; n < 2; ++n) bv[bj][n] = bias ? *(const f32x4*)(bias + bcol0 + bj * HALF + 4 * n) : (f32x4){0.f, 0.f, 0.f, 0.f};
#pragma unroll
        for (int ai = 0; ai < 2; ++ai)
#pragma unroll
            for (int m = 0; m < 4; ++m) { bf16_t* rowp = base + (size_t)(row0 + ai * HALF + m * 16) * ldc + col0;
#pragma unroll
                for (int bj = 0; bj < 2; ++bj) { f32x4 v0 = acc[ai][bj][m][0] + bv[bj][0], v1 = acc[ai][bj][m][1] + bv[bj][1];
                    if (ACT == 1) { f32x2 a = gelu_pk((f32x2){v0[0], v0[1]}), b = gelu_pk((f32x2){v0[2], v0[3]}), c = gelu_pk((f32x2){v1[0], v1[1]}), d = gelu_pk((f32x2){v1[2], v1[3]});
                        v0 = (f32x4){a.x, a.y, b.x, b.y}; v1 = (f32x4){c.x, c.y, d.x, d.y}; }
                    v0 = v0 * sc; v1 = v1 * sc; u32x4 w; w.x = cvt_pk_bf16(v0[0], v0[1]); w.y = cvt_pk_bf16(v0[2], v0[3]); w.z = cvt_pk_bf16(v1[0], v1[1]); w.w = cvt_pk_bf16(v1[2], v1[3]);
                    *(u32x4*)(rowp + bj * HALF) = w; } }
    }
};
struct EpiResidual {
    static constexpr bool PERM = false, AFTER_DRAIN = false;
    const float* base; float* out; int ldc;
    __device__ __forceinline__ void operator()(const f32x4 (&acc)[2][2][4][2], const Unit& u, int wr, int wc, int fr, int fq) const {
        const int col0 = u.pn * BM + wc * 32 + 4 * fq;
#pragma unroll
        for (int ai = 0; ai < 2; ++ai)
#pragma unroll
            for (int m = 0; m < 4; ++m) { const size_t off = (size_t)(u.pm * BM + ai * HALF + wr * 64 + m * 16 + fr) * ldc + col0;
#pragma unroll
                for (int bj = 0; bj < 2; ++bj)
#pragma unroll
                    for (int n = 0; n < 2; ++n) { const f32x4 bs = *(const f32x4*)(base + off + bj * HALF + n * 16); *(f32x4*)(out + off + bj * HALF + n * 16) = bs + acc[ai][bj][m][n]; }
                asm volatile("" ::: "memory"); }
    }
};
struct EpiSwiGLU {
    static constexpr bool PERM = true, AFTER_DRAIN = false;
    bf16_t* O; int ldc;
    __device__ __forceinline__ void operator()(const f32x4 (&acc)[2][2][4][2], const Unit& u, int wr, int wc, int fr, int fq) const {
        const int col0 = u.pn * HALF + wc * 32 + 8 * fq;
#pragma unroll
        for (int ai = 0; ai < 2; ++ai)
#pragma unroll
            for (int m = 0; m < 4; ++m) { bf16_t* rowp = O + (size_t)(u.pm * BM + ai * HALF + wr * 64 + m * 16 + fr) * ldc + col0;
                float r[8];
#pragma unroll
                for (int n = 0; n < 2; ++n)
#pragma unroll
                    for (int j = 0; j < 4; ++j) { const float g = acc[ai][0][m][n][j], up = acc[ai][1][m][n][j]; r[n * 4 + j] = g * __builtin_amdgcn_rcpf(1.f + __expf(-g)) * up; }
                u32x4 w; w.x = cvt_pk_bf16(r[0], r[1]); w.y = cvt_pk_bf16(r[2], r[3]); w.z = cvt_pk_bf16(r[4], r[5]); w.w = cvt_pk_bf16(r[6], r[7]);
                *(u32x4*)rowp = w; }
    }
};
template <class Epi, class Sched, bool ALIGN_EPI = false, bool SP2 = false>
__device__ __forceinline__ void gemm_phase(PG8_LAS unsigned char* lds, const Gemm g, const Sched& S, const Epi& E) {
    const int tid = threadIdx.x, wid = __builtin_amdgcn_readfirstlane(tid >> 6), lane = tid & 63, wr = wid >> 2, wc = wid & 3, fr = lane & 15, fq = lane >> 4;
    const int K = g.K, nt = K / BK;
    unsigned voffA[2], voffB[2];
#pragma unroll
    for (int i = 0; i < 2; ++i) { int R, C; stage_rc(tid * 16 + i * 8192, R, C); const int Rb = Epi::PERM ? ((R & ~31) + perm32(R & 31)) : R;
        voffA[i] = (unsigned)(R * K + C) * 2u; voffB[i] = (unsigned)(Rb * K + C) * 2u; }
    const size_t kstep = (size_t)(BK * 2);
    const size_t hstep = (size_t)HALF * K * 2;
    const size_t tstep = 2 * hstep;
    const unsigned ldsw = (unsigned)wid * 1024u;
    const int aoff = lds_byte(wr * 64 + fr, fq * 8), boff = lds_byte(wc * 32 + fr, fq * 8);
#define PG8_SA(b, h) (((b) * 2 + (h)) * HTB)
#define PG8_SB(b, h) ((4 + (b) * 2 + (h)) * HTB)
#define PG8_STAGE(bufoff, gbase, voff) do { _Pragma("unroll") for (int _i = 0; _i < 2; ++_i) \
        __builtin_amdgcn_global_load_lds((const unsigned*)((const char*)(gbase) + (voff)[_i]), (PG8_LAS unsigned*)(lds + (bufoff) + ldsw + _i * 8192), 16, 0, 0); } while (0)
#define PG8_LDA(dst, b, h) do { _Pragma("unroll") for (int m = 0; m < 4; ++m) _Pragma("unroll") for (int k = 0; k < 2; ++k) dst[m][k] = *(const PG8_LAS bf16x8*)(lds + PG8_SA(b, h) + aoff + m * 2048 + k * 1024); } while (0)
#define PG8_LDB(dst, b, h) do { _Pragma("unroll") for (int n = 0; n < 2; ++n) _Pragma("unroll") for (int k = 0; k < 2; ++k) dst[n][k] = *(const PG8_LAS bf16x8*)(lds + PG8_SB(b, h) + boff + n * 2048 + k * 1024); } while (0)
#define PG8_MMA(ai, bj, At, Bt) do { __builtin_amdgcn_s_setprio(1); _Pragma("unroll") for (int m = 0; m < 4; ++m) _Pragma("unroll") for (int n = 0; n < 2; ++n) _Pragma("unroll") for (int k = 0; k < 2; ++k) \
        acc[ai][bj][m][n] = __builtin_amdgcn_mfma_f32_16x16x32_bf16(Bt[n][k], At[m][k], acc[ai][bj][m][n], 0, 0, 0); __builtin_amdgcn_s_setprio(0); } while (0)
#define PG8_WAIT_V(n) asm volatile("s_waitcnt vmcnt(" #n ")" ::: "memory")
#define PG8_WAIT_L(n) asm volatile("s_waitcnt lgkmcnt(" #n ")" ::: "memory")
#define PG8_BAR __builtin_amdgcn_s_barrier()
#define PG8_SCHED __builtin_amdgcn_sched_barrier(0)
    Unit cur, nxt; int ui = 0;
    if (!S.next(0, cur)) return;
    f32x4 acc[2][2][4][2];
#pragma unroll
    for (int a = 0; a < 2; ++a)
#pragma unroll
        for (int b = 0; b < 2; ++b)
#pragma unroll
            for (int m = 0; m < 4; ++m)
#pragma unroll
                for (int n = 0; n < 2; ++n) acc[a][b][m][n] = (f32x4){0.f, 0.f, 0.f, 0.f};
    bf16x8 At[4][2], B0[2][2], B1[2][2];
    const char* cA = (const char*)g.A + (size_t)cur.pm * tstep; const char* cB = (const char*)g.Bt + (size_t)cur.pn * tstep;
    S.a_ready(cur);
    if constexpr (SP2) {
        PG8_STAGE(PG8_SB(0, 0), cB, voffB); PG8_STAGE(PG8_SB(0, 1), cB + hstep, voffB); PG8_STAGE(PG8_SA(0, 0), cA, voffA); PG8_STAGE(PG8_SA(0, 1), cA + hstep, voffA);
        if (wr == 1) PG8_BAR;
        PG8_WAIT_V(2); PG8_BAR;
        PG8_STAGE(PG8_SB(1, 0), cB + kstep, voffB); PG8_STAGE(PG8_SA(1, 0), cA + kstep, voffA); PG8_STAGE(PG8_SB(1, 1), cB + hstep + kstep, voffB);
        PG8_WAIT_V(6); PG8_BAR;
    } else {
        PG8_STAGE(PG8_SB(0, 0), cB, voffB); PG8_STAGE(PG8_SA(0, 0), cA, voffA); PG8_STAGE(PG8_SB(0, 1), cB + hstep, voffB); PG8_STAGE(PG8_SA(0, 1), cA + hstep, voffA);
        if (wr == 1) PG8_BAR;
        PG8_WAIT_V(4); PG8_BAR;
        PG8_STAGE(PG8_SB(1, 0), cB + kstep, voffB); PG8_STAGE(PG8_SA(1, 0), cA + kstep, voffA); PG8_STAGE(PG8_SB(1, 1), cB + hstep + kstep, voffB);
        PG8_WAIT_V(6); PG8_BAR;
    }
    for (;;) {
        const bool has_next = S.next(ui + 1, nxt);
        const char* nA = has_next ? (const char*)g.A + (size_t)nxt.pm * tstep : cA; const char* nB = has_next ? (const char*)g.Bt + (size_t)nxt.pn * tstep : cB;
        for (int t = 0; t < nt; t += 2) {
            const bool last = (t == nt - 2);
            const char* a1 = cA + (size_t)(t + 1) * kstep;
            const char* a2 = last ? nA : cA + (size_t)(t + 2) * kstep; const char* b2 = last ? nB : cB + (size_t)(t + 2) * kstep;
            const char* a3 = a2 + kstep; const char* b3 = b2 + kstep;
            if (last && has_next) S.a_ready(nxt);
            if constexpr (SP2) {
            PG8_LDB(B0, 0, 0); PG8_LDB(B1, 0, 1); PG8_SCHED; PG8_LDA(At, 0, 0); PG8_STAGE(PG8_SA(1, 1), a1 + hstep, voffA);
            PG8_WAIT_V(8); PG8_WAIT_L(0); PG8_BAR; PG8_MMA(0, 0, At, B0); PG8_MMA(0, 1, At, B1); PG8_BAR; PG8_SCHED;
            PG8_LDA(At, 0, 1); PG8_STAGE(PG8_SB(0, 0), b2, voffB); PG8_STAGE(PG8_SB(0, 1), b2 + hstep, voffB); PG8_STAGE(PG8_SA(0, 0), a2, voffA);
            PG8_WAIT_V(8); PG8_WAIT_L(0); PG8_BAR; PG8_MMA(1, 0, At, B0); PG8_MMA(1, 1, At, B1); PG8_BAR; PG8_SCHED;
            PG8_LDB(B0, 1, 0); PG8_LDB(B1, 1, 1); PG8_SCHED; PG8_LDA(At, 1, 0); PG8_STAGE(PG8_SA(0, 1), a2 + hstep, voffA);
            PG8_WAIT_V(8); PG8_WAIT_L(0); PG8_BAR; PG8_MMA(0, 0, At, B0); PG8_MMA(0, 1, At, B1); PG8_BAR; PG8_SCHED;
            PG8_LDA(At, 1, 1); PG8_STAGE(PG8_SB(1, 0), b3, voffB); PG8_STAGE(PG8_SB(1, 1), b3 + hstep, voffB); PG8_STAGE(PG8_SA(1, 0), a3, voffA);
            PG8_WAIT_V(8); PG8_WAIT_L(0); PG8_BAR; PG8_MMA(1, 0, At, B0); PG8_MMA(1, 1, At, B1); PG8_BAR; PG8_SCHED;
            } else {
            PG8_LDB(B0, 0, 0); PG8_SCHED; PG8_LDA(At, 0, 0); PG8_STAGE(PG8_SA(1, 1), a1 + hstep, voffA);
            PG8_WAIT_L(8); PG8_BAR; PG8_WAIT_L(0); PG8_MMA(0, 0, At, B0); PG8_BAR; PG8_SCHED;
            PG8_LDB(B1, 0, 1); PG8_STAGE(PG8_SB(0, 0), b2, voffB);
            PG8_BAR; PG8_WAIT_L(0); PG8_MMA(0, 1, At, B1); PG8_BAR;
            PG8_LDA(At, 0, 1); PG8_STAGE(PG8_SA(0, 0), a2, voffA);
            PG8_BAR; PG8_WAIT_L(0); PG8_MMA(1, 0, At, B0); PG8_BAR; PG8_SCHED;
            PG8_STAGE(PG8_SB(0, 1), b2 + hstep, voffB);
            PG8_WAIT_V(6); PG8_BAR; PG8_MMA(1, 1, At, B1); PG8_BAR;
            PG8_LDB(B0, 1, 0); PG8_SCHED; PG8_LDA(At, 1, 0); PG8_STAGE(PG8_SA(0, 1), a2 + hstep, voffA);
            PG8_WAIT_L(8); PG8_BAR; PG8_WAIT_L(0); PG8_MMA(0, 0, At, B0); PG8_BAR; PG8_SCHED;
            PG8_LDB(B1, 1, 1); PG8_STAGE(PG8_SB(1, 0), b3, voffB);
            PG8_BAR; PG8_WAIT_L(0); PG8_MMA(0, 1, At, B1); PG8_BAR;
            PG8_LDA(At, 1, 1); PG8_STAGE(PG8_SA(1, 0), a3, voffA);
            PG8_BAR; PG8_WAIT_L(0); PG8_MMA(1, 0, At, B0); PG8_BAR; PG8_SCHED;
            PG8_STAGE(PG8_SB(1, 1), b3 + hstep, voffB);
            PG8_WAIT_V(6); PG8_BAR; PG8_MMA(1, 1, At, B1); PG8_BAR;
            }
        }
        if constexpr (ALIGN_EPI) { if (wr == 0) PG8_BAR; }
        if constexpr (!Epi::AFTER_DRAIN) { E(acc, cur, wr, wc, fr, fq); S.done(cur); }
        if (!has_next) break;
#pragma unroll
        for (int a = 0; a < 2; ++a)
#pragma unroll
            for (int b = 0; b < 2; ++b)
#pragma unroll
                for (int m = 0; m < 4; ++m)
#pragma unroll
                    for (int n = 0; n < 2; ++n) acc[a][b][m][n] = (f32x4){0.f, 0.f, 0.f, 0.f};
        cur = nxt; cA = nA; cB = nB; ++ui;
        if constexpr (ALIGN_EPI) { if (wr == 1) PG8_BAR; }
    }
    PG8_WAIT_V(0);
    if constexpr (!ALIGN_EPI) { if (wr == 0) PG8_BAR; }
    PG8_BAR;
    if constexpr (Epi::AFTER_DRAIN) { E.fused(acc, cur, wr, wc, fr, fq, lds, wid, lane); S.done(cur); }
#undef PG8_SA
#undef PG8_SB
#undef PG8_STAGE
#undef PG8_LDA
#undef PG8_LDB
#undef PG8_MMA
#undef PG8_WAIT_V
#undef PG8_WAIT_L
#undef PG8_BAR
#undef PG8_SCHED
}
}

#ifndef PG8_SP2
#define PG8_SP2 true
#endif
#define PG8_ALIGN true
constexpr int NWAVES = 8;
constexpr int BATCH = 2, SEQ = 8192, DM = 1024, M = BATCH * SEQ, NIN = 3788, NINP = 3840, FFN = 2816, DEPTH = 2;
constexpr int A_Q = 0, A_K = 256, A_V = 512, A_O = 768;
constexpr int R_R = 1024, R_K = 1408, R_V = 1792, R_WDF = 2176, R_AD = 2304, R_GD = 2368;
constexpr int S_Z = 2496, S_X = 2880, S_B = 3264, S_C = 3520, S_DT = 3776;
constexpr size_t MiB = 1u << 20;
constexpr size_t WS_CTL = 0, CTL_ZERO_BYTES = 64 * 1024;
constexpr size_t WS_GATES = 1 * MiB, WS_CT = 2 * MiB;
constexpr size_t WS_WIN = 4 * MiB, WS_WOUT = 12 * MiB, WS_WGU = 14 * MiB, WS_WDN = 25 * MiB;
constexpr size_t WS_XN = 32 * MiB, WS_COLS = 64 * MiB, WS_Y = 184 * MiB, WS_END = 256 * MiB;
constexpr size_t Y_AF = WS_Y, Y_AB = WS_Y + 8 * MiB, Y_RF = WS_Y + 16 * MiB, Y_RB = WS_Y + 28 * MiB, Y_SF = WS_Y + 40 * MiB, Y_SB = WS_Y + 52 * MiB;
constexpr int CW_BAR = 1024;
constexpr int RING_BYTES = 131072;
constexpr int LDS_BYTES = 147456, MISC_OFF = LDS_BYTES - 256;

#define GAS __attribute__((address_space(1)))
#define LAS __attribute__((address_space(3)))
typedef unsigned short bf16;
typedef unsigned v4u __attribute__((ext_vector_type(4)));
typedef unsigned v2u __attribute__((ext_vector_type(2)));
typedef float f32x4 __attribute__((ext_vector_type(4)));
typedef short bf16x8 __attribute__((ext_vector_type(8)));
typedef GAS unsigned gu32;
#define RLX_AGENT __ATOMIC_RELAXED, __HIP_MEMORY_SCOPE_AGENT
#define LDS_WAIT() asm volatile("s_waitcnt lgkmcnt(0)" ::: "memory")
#define VM_WAIT() asm volatile("s_waitcnt vmcnt(0)" ::: "memory")
__device__ __forceinline__ unsigned f2bf(float f) { unsigned u = __builtin_bit_cast(unsigned, f); return (u + 0x7fffu + ((u >> 16) & 1u)) >> 16; }
__device__ __forceinline__ unsigned pk2(float lo, float hi) { return f2bf(lo) | (f2bf(hi) << 16); }
__device__ __forceinline__ float bf2f(unsigned u) { return __builtin_bit_cast(float, u << 16); }
__device__ __forceinline__ float sigmoidf_(float x) { return __builtin_amdgcn_rcpf(1.f + __expf(-x)); }
__device__ __forceinline__ float siluf_(float x) { return x * sigmoidf_(x); }
__device__ __forceinline__ float wave_sum(float v) {
#pragma unroll
    for (int o = 1; o < 64; o <<= 1) v += __shfl_xor(v, o);
    return v;
}
__device__ __forceinline__ float wave_max(float v) {
#pragma unroll
    for (int o = 1; o < 64; o <<= 1) v = fmaxf(v, __shfl_xor(v, o));
    return v;
}
template <int CTRL> __device__ __forceinline__ float dppf(float v) { return __builtin_bit_cast(float, __builtin_amdgcn_update_dpp(0, __builtin_bit_cast(int, v), CTRL, 0xf, 0xf, true)); }
__device__ __forceinline__ float row16_sum(float v) { v += dppf<0xB1>(v); v += dppf<0x4E>(v); v += dppf<0x141>(v); v += dppf<0x140>(v); return v; }
template <int K> __device__ __forceinline__ f32x4 mma16(const LAS bf16* A, int lda, const LAS bf16* Bt, int ldb, f32x4 acc, int lane) {
    const int r = lane & 15, q = lane >> 4;
    const LAS bf16* ap = A + r * lda + q * 8; const LAS bf16* bp = Bt + r * ldb + q * 8;
#pragma unroll
    for (int k0 = 0; k0 < K; k0 += 32) {
        const bf16x8 a = *(const LAS bf16x8*)(ap + k0); const bf16x8 b = *(const LAS bf16x8*)(bp + k0);
        acc = __builtin_amdgcn_mfma_f32_16x16x32_bf16(a, b, acc, 0, 0, 0);
    }
    return acc;
}

__device__ __forceinline__ int swz64(int row, int col) { return col ^ (((row >> 3) & 7) << 3); }
template <bool SWA, bool SWB> __device__ __forceinline__ f32x4 mma16s(const LAS bf16* A, int lda, int rowA0, const LAS bf16* Bt, int ldb, int rowB0, f32x4 acc, int lane) {
    const int r = lane & 15, q = lane >> 4; const int ra = rowA0 + r, rb = rowB0 + r;
#pragma unroll
    for (int k0 = 0; k0 < 64; k0 += 32) { const int ca = k0 + 8 * q, cb = k0 + 8 * q;
        const bf16x8 a = *(const LAS bf16x8*)(A + ra * lda + (SWA ? swz64(ra, ca) : ca)); const bf16x8 b = *(const LAS bf16x8*)(Bt + rb * ldb + (SWB ? swz64(rb, cb) : cb));
        acc = __builtin_amdgcn_mfma_f32_16x16x32_bf16(a, b, acc, 0, 0, 0); }
    return acc;
}

template <int CTRL, int RM, int BM> __device__ __forceinline__ float dppm(float oldv, float v) { return __builtin_bit_cast(float, __builtin_amdgcn_update_dpp(__builtin_bit_cast(int, oldv), __builtin_bit_cast(int, v), CTRL, RM, BM, false)); }
__device__ __forceinline__ float wave_scan_add(float x) {
    float y = x + dppm<0x111, 0xf, 0xf>(0.f, x); y += dppm<0x112, 0xf, 0xf>(0.f, x); y += dppm<0x113, 0xf, 0xf>(0.f, x);
    y += dppm<0x114, 0xf, 0xe>(0.f, y); y += dppm<0x118, 0xf, 0xc>(0.f, y);
    y += dppm<0x142, 0xa, 0xf>(0.f, y); y += dppm<0x143, 0xc, 0xf>(0.f, y);
    return y;
}
__device__ __forceinline__ float wave_scan_max(float x) {
    const float ninf = -INFINITY;
    float y = fmaxf(x, dppm<0x111, 0xf, 0xf>(ninf, x)); y = fmaxf(y, dppm<0x112, 0xf, 0xf>(ninf, x)); y = fmaxf(y, dppm<0x113, 0xf, 0xf>(ninf, x));
    y = fmaxf(y, dppm<0x114, 0xf, 0xe>(ninf, y)); y = fmaxf(y, dppm<0x118, 0xf, 0xc>(ninf, y));
    y = fmaxf(y, dppm<0x142, 0xa, 0xf>(ninf, y)); y = fmaxf(y, dppm<0x143, 0xc, 0xf>(ninf, y));
    return y;
}
#define XB_TMO      128
#define XB_XCNT(j)  (256  + 64 * (j))
#define XB_XSUB(j)  (1280 + 64 * (j))
#define XB_XGEN(j)  (2304 + 64 * (j))
#define XB_TOP      3328
#define XB_TOPGEN   3392
#define XCD_BAR_WORDS 3456
#define XB_SPIN_CAP (1u << 18)

__device__ __forceinline__ unsigned xb_ld(unsigned* p)              { return __hip_atomic_load(p, __ATOMIC_RELAXED, __HIP_MEMORY_SCOPE_AGENT); }
__device__ __forceinline__ unsigned xb_add(unsigned* p, unsigned v) { return __hip_atomic_fetch_add(p, v, __ATOMIC_RELAXED, __HIP_MEMORY_SCOPE_AGENT); }
__device__ __forceinline__ unsigned xb_xcc_id() { return (unsigned)__builtin_amdgcn_s_getreg((3 << 11) | 20) & 0xFu; }
#define XB_SPIN(cond, bar) do { unsigned _sp = 0; while (cond) { __builtin_amdgcn_s_sleep(1); \
    if ((++_sp & 255u) == 0u) { if (xb_ld(&(bar)[XB_TMO])) break; if (_sp > XB_SPIN_CAP) { atomicAdd(&(bar)[XB_TMO], 1u); break; } } } } while (0)

struct XcdBarrier {
    unsigned* bar; unsigned x;
    volatile LAS unsigned* st;
};

__device__ __forceinline__ XcdBarrier xcd_barrier_post(unsigned* bar, volatile LAS unsigned* st) {
    XcdBarrier b; b.bar = bar; b.x = xb_xcc_id(); b.st = st;
    if (threadIdx.x == 0) (void)xb_add(&bar[XB_XCNT(b.x)], 1u);
    return b;
}
__device__ __forceinline__ void xcd_barrier_complete(unsigned* bar, unsigned x, unsigned& nloc, unsigned& nx) {
    const unsigned G = gridDim.x * gridDim.y * gridDim.z;
    unsigned sum, cnt, mine, sp = 0u;
    for (;;) {
        sum = 0u; cnt = 0u; mine = 0u;
#pragma unroll
        for (unsigned j = 0; j < 16; ++j) { const unsigned c = xb_ld(&bar[XB_XCNT(j)]); sum += c; cnt += (c > 0u) ? 1u : 0u; mine = (j == x) ? c : mine; }
        if (sum == G) break;
        __builtin_amdgcn_s_sleep(1);
        if ((++sp & 255u) == 0u) { if (xb_ld(&bar[XB_TMO])) break; if (sp > XB_SPIN_CAP) { atomicAdd(&bar[XB_TMO], 1u); break; } }
    }
    nloc = mine > 0u ? mine : 1u; nx = cnt > 0u ? cnt : 1u;
}

__device__ __forceinline__ void xcd_barrier(const XcdBarrier& b) {
    asm volatile("s_waitcnt vmcnt(0)" ::: "memory");
    __syncthreads();
    if (threadIdx.x == 0) {
        unsigned* bar = b.bar;
        __builtin_amdgcn_s_waitcnt(0);
        unsigned nloc = b.st[0], nx = b.st[1];
        if (nloc == 0u) { xcd_barrier_complete(bar, b.x, nloc, nx); b.st[0] = nloc; b.st[1] = nx; }
        const unsigned old = xb_add(&bar[XB_XSUB(b.x)], 1u);
        const unsigned gen = old / nloc;
        if (old + 1u == (gen + 1u) * nloc) {
            __builtin_amdgcn_fence(__ATOMIC_RELEASE, "agent");
            asm volatile("s_waitcnt vmcnt(0)" ::: "memory");
            const unsigned og = xb_add(&bar[XB_TOP], 1u);
            const unsigned tg = og / nx;
            if (og + 1u == (tg + 1u) * nx) xb_add(&bar[XB_TOPGEN], 1u);
            else XB_SPIN(xb_ld(&bar[XB_TOPGEN]) == tg, bar);
            __builtin_amdgcn_fence(__ATOMIC_ACQUIRE, "agent");
            xb_add(&bar[XB_XGEN(b.x)], 1u);
            asm volatile("s_waitcnt vmcnt(0)" ::: "memory");
        } else {
            XB_SPIN(xb_ld(&bar[XB_XGEN(b.x)]) == gen, bar);
            __builtin_amdgcn_fence(__ATOMIC_ACQUIRE, "agent");
            asm volatile("s_waitcnt vmcnt(0)" ::: "memory");
        }
    }
    __syncthreads();
}
struct Frame {
    LAS unsigned char* lds;
    int tid, lane, wave, vcu, G;
};
struct Args { const float* in[32]; float* out; unsigned char* ws; int ph_lo, ph_hi; };
constexpr int PTAB_OFF = LDS_BYTES - 768;
__device__ __forceinline__ unsigned long long ptab_ld(const Frame& F, int i) {
    const unsigned long long v = *(volatile LAS unsigned long long*)(F.lds + PTAB_OFF + 8 * i);
    const unsigned lo = __builtin_amdgcn_readfirstlane((unsigned)v), hi = __builtin_amdgcn_readfirstlane((unsigned)(v >> 32));
    return ((unsigned long long)hi << 32) | lo;
}
__device__ __forceinline__ const float* INP(const Frame& F, int i) { return (const float*)ptab_ld(F, i); }
__device__ __forceinline__ unsigned char* WSP(const Frame& F) { return (unsigned char*)ptab_ld(F, 33); }
__device__ __forceinline__ float* OUTP(const Frame& F) { return (float*)ptab_ld(F, 32); }

__device__ __forceinline__ void transpose_item(const float* W, int K, int N, int nblk, bf16* WT, int mode, int row_off, LAS float* scr, int item, int lane) {
    const int kb = item / nblk, nb = item % nblk, k0 = 64 * kb, n0 = 32 * nb;
    const int ncol = n0 + (lane & 31); const bool ok = ncol < N;
#pragma unroll 8
    for (int i = 0; i < 32; ++i) { const int kk = 2 * i + (lane >> 5); scr[kk * 33 + (lane & 31)] = ok ? W[(size_t)(k0 + kk) * N + ncol] : 0.f; }
    LDS_WAIT(); asm volatile("" ::: "memory");
    const int c = lane & 7;
    const int drow0 = mode ? (256 * (n0 >> 7) + (n0 & 127) + row_off) : (row_off + n0);
#pragma unroll
    for (int j = 0; j < 4; ++j) { const int n = (lane >> 3) + 8 * j; const LAS float* s = scr + (8 * c) * 33 + n;
        v4u o; o.x = pk2(s[0 * 33], s[1 * 33]); o.y = pk2(s[2 * 33], s[3 * 33]); o.z = pk2(s[4 * 33], s[5 * 33]); o.w = pk2(s[6 * 33], s[7 * 33]);
        *(v4u*)(WT + (size_t)(drow0 + n) * K + k0 + 8 * c) = o; }
    LDS_WAIT(); asm volatile("" ::: "memory");
}
__device__ __forceinline__ void phase_convert(const Frame& F, int l) {
    LAS float* scr = (LAS float*)(F.lds + F.wave * 16384);
    const int gw = F.vcu * NWAVES + F.wave, NGW = F.G * NWAVES;
    bf16* Win = (bf16*)(WSP(F) + WS_WIN); bf16* Wout = (bf16*)(WSP(F) + WS_WOUT); bf16* Wgu = (bf16*)(WSP(F) + WS_WGU); bf16* Wdn = (bf16*)(WSP(F) + WS_WDN);
    constexpr int I_IN = 16 * 120, I_OUT = 16 * 32, I_G = 16 * 88, I_D = 44 * 32;
    constexpr int NITEMS = I_IN + I_OUT + 2 * I_G + I_D;
    for (int it = gw; it < NITEMS; it += NGW) {
        int r = it;
        if (r < I_IN) { transpose_item(INP(F, 2) + (size_t)l * DM * NIN, DM, NIN, 120, Win, 0, 0, scr, r, F.lane); continue; } r -= I_IN;
        if (r < I_OUT) { transpose_item(INP(F, 26) + (size_t)l * DM * DM, DM, DM, 32, Wout, 0, 0, scr, r, F.lane); continue; } r -= I_OUT;
        if (r < I_G) { transpose_item(INP(F, 28) + (size_t)l * DM * FFN, DM, FFN, 88, Wgu, 1, 0, scr, r, F.lane); continue; } r -= I_G;
        if (r < I_G) { transpose_item(INP(F, 29) + (size_t)l * DM * FFN, DM, FFN, 88, Wgu, 1, 128, scr, r, F.lane); continue; } r -= I_G;
        transpose_item(INP(F, 30) + (size_t)l * FFN * DM, FFN, DM, 32, Wdn, 0, 0, scr, r, F.lane);
    }
}
__device__ __forceinline__ void phase_norm(const Frame& F, const float* hin, const float* g, bf16* XN) {
    const int gw = F.vcu * NWAVES + F.wave, NGW = F.G * NWAVES;
    f32x4 gv[4];
#pragma unroll
    for (int j = 0; j < 4; ++j) gv[j] = ((const f32x4*)g)[64 * j + F.lane];
    for (int m = gw; m < M; m += NGW) {
        const f32x4* xr = (const f32x4*)(hin + (size_t)m * DM) + F.lane;
        f32x4 v[4]; float s = 0.f;
#pragma unroll
        for (int j = 0; j < 4; ++j) { v[j] = xr[64 * j]; s += (v[j].x * v[j].x + v[j].y * v[j].y) + (v[j].z * v[j].z + v[j].w * v[j].w); }
        const float r = 1.f / sqrtf(wave_sum(s) * (1.f / DM) + 1e-6f);
        v2u* o8 = (v2u*)(XN + (size_t)m * DM) + F.lane;
#pragma unroll
        for (int j = 0; j < 4; ++j) { v2u w; w.x = pk2(v[j].x * r * gv[j].x, v[j].y * r * gv[j].y); w.y = pk2(v[j].z * r * gv[j].z, v[j].w * r * gv[j].w); o8[64 * j] = w; }
    }
}
__device__ __forceinline__ void phase_final_norm(const Frame& F, float* h, const float* g) {
    const int gw = F.vcu * NWAVES + F.wave, NGW = F.G * NWAVES;
    f32x4 gv[4];
#pragma unroll
    for (int j = 0; j < 4; ++j) gv[j] = ((const f32x4*)g)[64 * j + F.lane];
    for (int m = gw; m < M; m += NGW) {
        f32x4* xr = (f32x4*)(h + (size_t)m * DM) + F.lane;
        f32x4 v[4]; float s = 0.f;
#pragma unroll
        for (int j = 0; j < 4; ++j) { v[j] = xr[64 * j]; s += (v[j].x * v[j].x + v[j].y * v[j].y) + (v[j].z * v[j].z + v[j].w * v[j].w); }
        const float r = 1.f / sqrtf(wave_sum(s) * (1.f / DM) + 1e-6f);
#pragma unroll
        for (int j = 0; j < 4; ++j) xr[64 * j] = v[j] * r * gv[j];
    }
}
__device__ __forceinline__ void phase_gates(const Frame& F, int l) {
    const bf16* cols = (const bf16*)(WSP(F) + WS_COLS); float* GT = (float*)(WSP(F) + WS_GATES);
    LAS bf16* raw = (LAS bf16*)(F.lds);
    LAS bf16* featb = (LAS bf16*)(F.lds + 30720);
    LAS bf16* gwT = (LAS bf16*)(F.lds + 55552);
    LAS float* outp = (LAS float*)(F.lds + 80384);
    const float* gwg = INP(F, 5) + (size_t)l * 768 * 16; const float* gb = INP(F, 6) + l * 16;
    const int tid = F.tid, lane = F.lane, wave = F.wave;
    __syncthreads();
    for (int i = tid; i < 768 * 16; i += 512) gwT[(i & 15) * 776 + (i >> 4)] = (bf16)f2bf(gwg[i]);
    float cw[5]; { const float* cwp = INP(F, 3) + (size_t)l * 5 * 512;
#pragma unroll
        for (int j = 0; j < 5; ++j) cw[j] = cwp[j * 512 + tid]; }
    const float cbv = INP(F, 4)[l * 512 + tid];
    const float gbv = gb[tid & 15];
    for (int tile = F.vcu; tile < M / 16; tile += F.G) {
        const int m0 = tile * 16, t0 = m0 % SEQ;
        __syncthreads();
        for (int ch = tid; ch < 20 * 96; ch += 512) { const int rr = ch / 96, cc = ch % 96; const int t = t0 - 2 + rr;
            v4u v = {0u, 0u, 0u, 0u}; if (t >= 0 && t < SEQ) v = *(const v4u*)(cols + (size_t)(m0 - 2 + rr) * NINP + cc * 8);
            *(LAS v4u*)(raw + rr * 768 + cc * 8) = v; }
        if (tid < 256) outp[tid] = 0.f;
        __syncthreads();
        { float win[5];
#pragma unroll
          for (int j = 0; j < 4; ++j) win[j] = bf2f(raw[j * 768 + tid]);
#pragma unroll 4
          for (int t = 0; t < 16; ++t) { win[4] = bf2f(raw[(t + 4) * 768 + tid]); float s = cbv;
#pragma unroll
              for (int j = 0; j < 5; ++j) s += cw[j] * win[j];
#pragma unroll
              for (int j = 0; j < 4; ++j) win[j] = win[j + 1];
              featb[t * 776 + tid] = (bf16)f2bf(siluf_(s)); }
          const int t = tid >> 5, c8 = tid & 31; *(LAS v4u*)(featb + t * 776 + 512 + c8 * 8) = *(const LAS v4u*)(raw + (t + 2) * 768 + 512 + c8 * 8); }
        __syncthreads();
        { const f32x4 z = {0.f, 0.f, 0.f, 0.f}; const f32x4 acc = mma16<96>(featb + 96 * wave, 776, gwT + 96 * wave, 776, z, lane);
#pragma unroll
          for (int jj = 0; jj < 4; ++jj) __hip_atomic_fetch_add(outp + ((lane >> 4) * 4 + jj) * 16 + (lane & 15), acc[jj], __ATOMIC_RELAXED, __HIP_MEMORY_SCOPE_WORKGROUP); }
        __syncthreads();
        if (tid < 256) { float s = outp[tid] + gbv; if ((tid & 15) >= 8) s = fminf(s, 0.f) - log1pf(__expf(-fabsf(s))); GT[(size_t)(m0 + (tid >> 4)) * 16 + (tid & 15)] = s; }
    }
    __syncthreads();
}
__device__ __forceinline__ f32x4 mma16_a8(const LAS bf16* A8, const LAS bf16* Bt, f32x4 acc, int lane) {
    const int q = lane >> 4;
    const LAS bf16* ap = A8 + (lane & 7) * 72 + q * 8; const LAS bf16* bp = Bt + (lane & 15) * 72 + q * 8;
#pragma unroll
    for (int k0 = 0; k0 < 64; k0 += 32) { const bf16x8 a = *(const LAS bf16x8*)(ap + k0); const bf16x8 b = *(const LAS bf16x8*)(bp + k0); acc = __builtin_amdgcn_mfma_f32_16x16x32_bf16(a, b, acc, 0, 0, 0); }
    return acc;
}
typedef float f32x2 __attribute__((ext_vector_type(2)));
template <bool DIR> __device__ __forceinline__ void rwkv_steps(const LAS float* OPS, const LAS float* VV, LAS float* YB, f32x4& S, int j, int row) {
    float yk0 = 0.f, yk1 = 0.f;
    const LAS float* opb = OPS + 4 * j; const LAS float* vpb = VV + row;
#define RWLD(W_, KK_, KA_, KM_, R_, V_, tl_) do { const LAS float* op_ = opb + (tl_) * 320; W_ = *(const LAS f32x4*)(op_); KK_ = *(const LAS f32x4*)(op_ + 64); KA_ = *(const LAS f32x4*)(op_ + 128); KM_ = *(const LAS f32x4*)(op_ + 192); R_ = *(const LAS f32x4*)(op_ + 256); V_ = vpb[(tl_) * 16]; } while (0)
    f32x4 w4, kk4, ka4, km4, r4, w4b, kk4b, ka4b, km4b, r4b; float vv, vvb;
    RWLD(w4, kk4, ka4, km4, r4, vv, (DIR ? 31 : 0));
    RWLD(w4b, kk4b, ka4b, km4b, r4b, vvb, (DIR ? 30 : 1));
#pragma unroll
    for (int i = 0; i < 32; ++i) {
        f32x4 nw4, nkk4, nka4, nkm4, nr4; float nvv;
        if (i < 30) RWLD(nw4, nkk4, nka4, nkm4, nr4, nvv, (DIR ? 29 - i : i + 2));
        f32x2 t2 = S.xy * kk4.xy; t2 = S.zw * kk4.zw + t2;
        float sa = t2.x + t2.y;
        const f32x4 pre_s = S * w4 + km4 * vv;
        sa = row16_sum(sa);
        S = pre_s + ka4 * sa;
        f32x2 y2 = S.xy * r4.xy; y2 = S.zw * r4.zw + y2;
        float y = y2.x + y2.y;
        y = row16_sum(y);
        if ((i & 15) == j) { if (i < 16) yk0 = y; else yk1 = y; }
        w4 = w4b; kk4 = kk4b; ka4 = ka4b; km4 = km4b; r4 = r4b; vv = vvb;
        if (i < 30) { w4b = nw4; kk4b = nkk4; ka4b = nka4; km4b = nkm4; r4b = nr4; vvb = nvv; } }
#undef RWLD
    YB[(DIR ? 31 - j : j) * 16 + row] = yk0; YB[(DIR ? 15 - j : 16 + j) * 16 + row] = yk1;
}
struct RwCtx { LAS bf16* WA; LAS bf16* WW; LAS bf16* XA; LAS bf16* XW; LAS bf16* RAWB; LAS float* MU; float* CT; const bf16* colsb;
    f32x4 kk_c4, ka_c4, rk_c4; float ba[4], bw[4]; float mup_[5][2], mun_[5][2]; int h, dir, qtr, tb0; size_t mb; };
template <int NTOK> __device__ __forceinline__ void rw_addr_init(int (&poff)[5], int (&prr)[5], int lane, int tb0, int h, int dir) {
    constexpr int NCHK = (NTOK + 2) * 40;
#pragma unroll
    for (int i = 0; i < 5; ++i) { const int idx = lane + 64 * i; const int rr = idx / 40, q = idx % 40, wh = q >> 3, c8 = q & 7;
        const int gc = (wh == 0 ? R_R + h * 64 : wh == 1 ? R_K + h * 64 : wh == 2 ? R_V + h * 64 : wh == 3 ? R_WDF + dir * 64 : R_AD) + c8 * 8;
        prr[i] = idx < NCHK ? tb0 - 1 + rr : -100000; poff[i] = (tb0 - 1 + rr) * NINP + gc; }
}
template <int NTOK> __device__ __forceinline__ void rw_issue(v4u (&pre)[5], const int (&poff)[5], const int (&prr)[5], const bf16* colsb, int T0) {
    constexpr int NCH = ((NTOK + 2) * 40 + 63) / 64;
#pragma unroll
    for (int i = 0; i < NCH; ++i) { pre[i] = (v4u){0u, 0u, 0u, 0u}; const int t = T0 + prr[i]; if (t >= 0 && t < SEQ) pre[i] = *(const v4u*)(colsb + (size_t)T0 * NINP + poff[i]); }
}
template <int NTOK, bool FULLV> __device__ __forceinline__ void rw_prep(const RwCtx& C, const v4u (&pre)[5], LAS float* OPS, LAS float* VV, int T0, int lane) {
    constexpr int NCHK = (NTOK + 2) * 40, NCH = (NCHK + 63) / 64;
    const int j = lane & 15, c2 = (lane & 31) * 2;
#pragma unroll
    for (int i = 0; i < NCH; ++i) { const int idx = lane + 64 * i; if (idx < NCHK) *(LAS v4u*)(C.RAWB + idx * 8) = pre[i]; }
    LDS_WAIT(); asm volatile("" ::: "memory");
#pragma unroll
    for (int which = 0; which < 5; ++which)
#pragma unroll
        for (int pr = 0; pr < NTOK / 2; ++pr) { const int tt = 2 * pr + (lane >> 5), cc = which * 64 + c2, t = C.tb0 + tt;
            const unsigned r0 = *(const LAS unsigned*)(C.RAWB + tt * 320 + cc), r1 = *(const LAS unsigned*)(C.RAWB + (tt + 1) * 320 + cc), r2 = *(const LAS unsigned*)(C.RAWB + (tt + 2) * 320 + cc);
            const float p1x = bf2f(r1 & 0xffffu), p1y = bf2f(r1 >> 16);
            const float vx = p1x + C.mup_[which][0] * (bf2f(r0 & 0xffffu) - p1x) + C.mun_[which][0] * (bf2f(r2 & 0xffffu) - p1x);
            const float vy = p1y + C.mup_[which][1] * (bf2f(r0 >> 16) - p1y) + C.mun_[which][1] * (bf2f(r2 >> 16) - p1y);
            if (which == 0) *(LAS f32x2*)(OPS + t * 320 + 256 + c2) = (f32x2){vx, vy};
            else if (which == 1) *(LAS f32x2*)(OPS + t * 320 + 192 + c2) = (f32x2){vx, vy};
            else if (which == 2) { if (FULLV) *(LAS f32x2*)(VV + t * 64 + c2) = (f32x2){vx, vy}; else if ((c2 >> 4) == C.qtr) *(LAS f32x2*)(VV + t * 16 + (c2 & 15)) = (f32x2){vx, vy}; }
            else if (which == 3) { const float ex = __expf(2.f * vx), ey = __expf(2.f * vy);
                *(LAS unsigned*)(C.XW + tt * 72 + c2) = pk2(1.f - 2.f * __builtin_amdgcn_rcpf(ex + 1.f), 1.f - 2.f * __builtin_amdgcn_rcpf(ey + 1.f)); }
            else *(LAS unsigned*)(C.XA + tt * 72 + c2) = pk2(vx, vy); }
    LDS_WAIT(); asm volatile("" ::: "memory");
    { const bool hi = lane >= 32; const int lr = ((lane >> 4) & 1) * 4 + (hi ? 2 : 0); const bool ok0 = lr < NTOK, ok1 = lr + 1 < NTOK; const int tb = C.tb0 + lr;
#pragma unroll
      for (int ct = 0; ct < 4; ++ct) { const f32x4 z = {0.f, 0.f, 0.f, 0.f};
        const f32x4 ca = mma16_a8(C.XA, C.WA + ct * 16 * 72, z, lane), cw = mma16_a8(C.XW, C.WW + ct * 16 * 72, z, lane);
        const int c = ct * 16 + j;
        const float a0v = hi ? ca[2] : ca[0], a1v = hi ? ca[3] : ca[1], w0v = hi ? cw[2] : cw[0], w1v = hi ? cw[3] : cw[1];
        if (ok0) { OPS[tb * 320 + 128 + c] = sigmoidf_(C.ba[ct] + a0v); OPS[tb * 320 + c] = __expf(-0.6065306597f * sigmoidf_(C.bw[ct] + w0v)); }
        if (ok1) { OPS[(tb + 1) * 320 + 128 + c] = sigmoidf_(C.ba[ct] + a1v); OPS[(tb + 1) * 320 + c] = __expf(-0.6065306597f * sigmoidf_(C.bw[ct] + w1v)); } } }
    LDS_WAIT(); asm volatile("" ::: "memory");
#pragma unroll
    for (int ps = 0; ps < (NTOK + 3) / 4; ++ps) { const int tl = 4 * ps + (lane >> 4); const bool ok = tl < NTOK; const int t = C.tb0 + (ok ? tl : 0); LAS float* op = OPS + t * 320 + 4 * j;
        const f32x4 av = *(const LAS f32x4*)(op + 128), kp = *(const LAS f32x4*)(op + 192), rp = *(const LAS f32x4*)(op + 256);
        const f32x4 kr = kp * C.kk_c4; const float ss = row16_sum((kr.x * kr.x + kr.y * kr.y) + (kr.z * kr.z + kr.w * kr.w));
        const f32x4 kkv = kr * (1.f / fmaxf(sqrtf(ss), 1e-12f));
        const f32x4 km = kp * ((av - 1.f) * C.ka_c4 + 1.f);
        const f32x4 q = rp * km * C.rk_c4; const float cs = row16_sum((q.x + q.y) + (q.z + q.w));
        if (ok) { *(LAS f32x4*)(op + 64) = kkv; *(LAS f32x4*)(op + 128) = kkv * (-av); *(LAS f32x4*)(op + 192) = km;
            if (C.dir == 0 && C.qtr == 0 && j == 0) C.CT[(C.mb + T0 + t) * 8 + C.h] = cs; } }
}

constexpr int RW_NSLOT = 6, RW_SLOT_WORDS = 32 * 320 + 32 * 64;
constexpr size_t WS_RING = 248 * MiB;
constexpr int CW_RW = 8192;
__device__ __forceinline__ unsigned rw_ld(unsigned* p) { return __hip_atomic_load(p, __ATOMIC_RELAXED, __HIP_MEMORY_SCOPE_AGENT); }
__device__ __forceinline__ void rw_st(unsigned* p, unsigned v) { __hip_atomic_store(p, v, __ATOMIC_RELAXED, __HIP_MEMORY_SCOPE_AGENT); }
__device__ __forceinline__ void rwkv_produce(const Frame& F, int l, int p, unsigned G0) {
    const int b = p / 12, rem = p % 12, h = rem >> 1, dir = rem & 1;
    const bf16* cols = (const bf16*)(WSP(F) + WS_COLS);
    const int tid = F.tid, lane = F.lane, wave = F.wave;
    LAS bf16* WA = (LAS bf16*)(F.lds); LAS bf16* WW = (LAS bf16*)(F.lds + 9216);
    LAS float* MU = (LAS float*)(F.lds + 67584);
    LAS float* OPS = (LAS float*)(F.lds + 70144);
    LAS float* VV = (LAS float*)(F.lds + 111104);
    LAS unsigned* flg = (LAS unsigned*)(F.lds + 119296);
    unsigned* ctl = (unsigned*)(WSP(F) + WS_CTL) + CW_RW + 320 * p;
    unsigned long long* ring = (unsigned long long*)(WSP(F) + WS_RING) + (size_t)p * RW_NSLOT * (RW_SLOT_WORDS / 2);
    constexpr int NB = SEQ / 32;
    __syncthreads();
    { const float* aup = INP(F, 13) + (size_t)l * 64 * 384; const float* wup = INP(F, 11) + (size_t)(l * 2 + dir) * 64 * 384;
      for (int idx = tid; idx < 4096; idx += 512) { const int i = idx >> 6, c = idx & 63;
          WA[c * 72 + i] = (bf16)f2bf(aup[i * 384 + h * 64 + c]); WW[c * 72 + i] = (bf16)f2bf(wup[i * 384 + h * 64 + c]); }
      if (tid < 320) { const int which = tid >> 6, c = tid & 63;
          const int rc = which == 0 ? h * 64 + c : which == 1 ? 384 + h * 64 + c : which == 2 ? 768 + h * 64 + c : which == 3 ? 1152 + dir * 64 + c : 1280 + c;
          MU[tid] = INP(F, 8)[l * 1472 + rc]; MU[320 + tid] = INP(F, 9)[l * 1472 + rc]; } }
    __syncthreads();
    const size_t mb = (size_t)b * SEQ;
    const int j = lane & 15;
    RwCtx C;
    C.WA = WA; C.WW = WW; C.XA = (LAS bf16*)(F.lds + 18432) + wave * 576; C.XW = (LAS bf16*)(F.lds + 27648) + wave * 576;
    C.RAWB = (LAS bf16*)(F.lds + 36864) + wave * 1920;
    C.MU = MU; C.CT = (float*)(WSP(F) + WS_CT); C.colsb = cols + mb * NINP; C.h = h; C.dir = dir; C.qtr = 0; C.mb = mb; C.tb0 = 4 * wave;
    { const int hc4 = h * 64 + 4 * j;
      C.kk_c4 = *(const f32x4*)(INP(F, 15) + l * 384 + hc4); C.ka_c4 = *(const f32x4*)(INP(F, 16) + l * 384 + hc4); C.rk_c4 = *(const f32x4*)(INP(F, 17) + l * 384 + hc4);
#pragma unroll
      for (int ct = 0; ct < 4; ++ct) { C.ba[ct] = INP(F, 12)[l * 384 + h * 64 + 16 * ct + j]; C.bw[ct] = INP(F, 10)[(l * 2 + dir) * 384 + h * 64 + 16 * ct + j]; }
      const int c2 = (lane & 31) * 2;
#pragma unroll
      for (int wq = 0; wq < 5; ++wq) { C.mup_[wq][0] = MU[wq * 64 + c2]; C.mup_[wq][1] = MU[wq * 64 + c2 + 1]; C.mun_[wq][0] = MU[320 + wq * 64 + c2]; C.mun_[wq][1] = MU[320 + wq * 64 + c2 + 1]; } }
    v4u pre[5]; int poff[5], prr[5];
    rw_addr_init<4>(poff, prr, lane, C.tb0, h, dir);
    rw_issue<4>(pre, poff, prr, C.colsb, dir ? SEQ - 32 : 0);
    bool dead = false; unsigned mseen = G0;
#pragma unroll 1
    for (int it = 0; it < NB; ++it) {
        const int T0 = dir ? SEQ - 32 * (it + 1) : 32 * it;
        v4u cur[5];
#pragma unroll
        for (int i = 0; i < 5; ++i) cur[i] = pre[i];
        if (it + 1 < NB) rw_issue<4>(pre, poff, prr, C.colsb, dir ? SEQ - 32 * (it + 2) : 32 * (it + 1));
        rw_prep<4, true>(C, cur, OPS, VV, T0, lane);
        if (tid == 0) { const unsigned need = G0 + (unsigned)it + 1u; unsigned sp = 0u;
            if (need > (unsigned)RW_NSLOT && !dead) { const unsigned want = need - (unsigned)RW_NSLOT;
                while (mseen < want) { if (++sp > (1u << 17)) { dead = true; break; } __builtin_amdgcn_s_sleep(2);
                    const unsigned m01 = min(rw_ld(ctl + 64), rw_ld(ctl + 128)), m23 = min(rw_ld(ctl + 192), rw_ld(ctl + 256)); mseen = min(m01, m23); } }
            flg[0] = sp; }
        __syncthreads();
        { unsigned long long* slot = ring + (size_t)((G0 + (unsigned)it) % RW_NSLOT) * (RW_SLOT_WORDS / 2);
          const LAS v4u* src = (const LAS v4u*)OPS;
#pragma unroll
          for (int i = 0; i < 6; ++i) { const int idx = tid + 512 * i; const v4u d = src[idx]; v4u* dst = (v4u*)slot + idx;
              asm volatile("global_store_dwordx4 %0, %1, off sc1\n\ts_nop 1" :: "v"(dst), "v"(d) : "memory"); } }
        asm volatile("s_waitcnt vmcnt(6)" ::: "memory");
        __syncthreads();
        if (tid == 0 && it >= 1) rw_st(ctl, G0 + (unsigned)it);
    }
    asm volatile("s_waitcnt vmcnt(0)" ::: "memory");
    __syncthreads();
    if (tid == 0) rw_st(ctl, G0 + (unsigned)NB);
    __syncthreads();
}
__device__ __forceinline__ void rwkv_scan(const Frame& F, int l, int p, int qtr, unsigned G0) {
    const int b = p / 12, rem = p % 12, h = rem >> 1, dir = rem & 1;
    bf16* Y = (bf16*)(WSP(F) + (dir ? Y_RB : Y_RF));
    const int lane = F.lane, wave = F.wave;
    LAS float* OPSb = (LAS float*)(F.lds);
    LAS float* VVb = (LAS float*)(F.lds + 81920);
    LAS float* YBb = (LAS float*)(F.lds + 86016);
    unsigned* ctl = (unsigned*)(WSP(F) + WS_CTL) + CW_RW + 320 * p;
    const unsigned long long* ring = (const unsigned long long*)(WSP(F) + WS_RING) + (size_t)p * RW_NSLOT * (RW_SLOT_WORDS / 2);
    constexpr int NB = SEQ / 32;
    const size_t mb = (size_t)b * SEQ;
    const int j = lane & 15;
    __syncthreads();
    if (wave < 4) {
        const int lt = wave * 64 + lane;
        bool dead = false; unsigned pseen = G0;
        unsigned long long v[21];
#define RW_FETCH(k_) do { const unsigned need_ = G0 + (unsigned)(k_) + 1u; unsigned sp_ = 0u; \
            if (!dead) { while (pseen < need_) { pseen = rw_ld(ctl); if (pseen >= need_) break; if (++sp_ > (1u << 17)) { dead = true; break; } __builtin_amdgcn_s_sleep(2); } } \
            const unsigned long long* slot_ = ring + (size_t)((G0 + (unsigned)(k_)) % RW_NSLOT) * (RW_SLOT_WORDS / 2); \
            _Pragma("unroll") for (int i_ = 0; i_ < 20; ++i_) v[i_] = __hip_atomic_load(slot_ + lt + 256 * i_, __ATOMIC_RELAXED, __HIP_MEMORY_SCOPE_AGENT); \
            v[20] = __hip_atomic_load(slot_ + 5120 + (lt >> 3) * 32 + qtr * 8 + (lt & 7), __ATOMIC_RELAXED, __HIP_MEMORY_SCOPE_AGENT); } while (0)
        RW_FETCH(0);
#pragma unroll 1
        for (int it = 0; it <= NB; ++it) {
            if (it >= 1 && lt == 0) rw_st(ctl + 64 * (qtr + 1), G0 + (unsigned)it);
            if (it < NB) {
                LAS unsigned long long* dO = (LAS unsigned long long*)(OPSb + (it & 1) * 10240); LAS unsigned long long* dV = (LAS unsigned long long*)(VVb + (it & 1) * 512);
#pragma unroll
                for (int i = 0; i < 20; ++i) dO[lt + 256 * i] = v[i];
                dV[lt] = v[20];
                if (it + 1 < NB) RW_FETCH(it + 1);
            }
            if (it >= 2) { const int bk = it - 2; const int T0 = dir ? SEQ - 32 * (bk + 1) : 32 * bk; const LAS float* YB = YBb + (bk & 1) * 512;
                const int idx = lt * 2, tl = idx >> 4, rw = idx & 15;
                *(unsigned*)(Y + (mb + T0 + tl) * 384 + h * 64 + 16 * qtr + rw) = pk2(YB[idx], YB[idx + 1]); }
            __syncthreads();
        }
#undef RW_FETCH
        { const int bk = NB - 1; const int T0 = dir ? SEQ - 32 * (bk + 1) : 32 * bk; const LAS float* YB = YBb + (bk & 1) * 512;
          const int idx = lt * 2, tl = idx >> 4, rw = idx & 15;
          *(unsigned*)(Y + (mb + T0 + tl) * 384 + h * 64 + 16 * qtr + rw) = pk2(YB[idx], YB[idx + 1]); }
    } else {
        const int row = (wave - 4) * 4 + (lane >> 4);
        f32x4 S = {0.f, 0.f, 0.f, 0.f};
#pragma unroll 1
        for (int it = 0; it <= NB; ++it) {
            if (it >= 1) { const int bk = it - 1;
                const LAS float* OPS = OPSb + (bk & 1) * 10240; const LAS float* VV = VVb + (bk & 1) * 512; LAS float* YB = YBb + (bk & 1) * 512;
                if (dir) rwkv_steps<true>(OPS, VV, YB, S, j, row); else rwkv_steps<false>(OPS, VV, YB, S, j, row);
            }
            __syncthreads();
        }
    }
    __syncthreads();
}
__device__ __forceinline__ float row8_sum(float v) { v += dppf<0xB1>(v); v += dppf<0x4E>(v); v += dppf<0x141>(v); return v; }
__device__ __forceinline__ void mlstm_seq(const Frame& F, int l, int task, int cfull0, int cend) {
    const int b = task >> 3, h = (task >> 1) & 3, dir = task & 1;
    const bf16* cols = (const bf16*)(WSP(F) + WS_COLS); const float* GT = (const float*)(WSP(F) + WS_GATES);
    bf16* Y = (bf16*)(WSP(F) + (dir ? Y_AB : Y_AF));
    LAS bf16* RAWQ = (LAS bf16*)(F.lds);
    LAS bf16* Qs = (LAS bf16*)(F.lds + 17408); LAS bf16* Ks = (LAS bf16*)(F.lds + 26624);
    LAS bf16* Vtb = (LAS bf16*)(F.lds + 35840);
    LAS bf16* KWt = (LAS bf16*)(F.lds + 54272); LAS bf16* Ps = (LAS bf16*)(F.lds + 63488);
    LAS bf16* Ctb = (LAS bf16*)(F.lds + 72704);
    LAS float* ub = (LAS float*)(F.lds + 91136);
    LAS float* blb = ub + 128; LAS float* rmb = ub + 256;
    LAS float* den = ub + 384; LAS float* qn = ub + 448; LAS float* nst = ub + 512; LAS float* scb = ub + 576;
    const int tid = F.tid, lane = F.lane, wave = F.wave;
    const size_t mb = (size_t)b * SEQ;
    constexpr int NC = SEQ / 64;
    __syncthreads();
    for (int i = tid; i < 2 * 64 * 72; i += 512) Ctb[i] = 0;
    if (tid < 64) nst[tid] = 0.f;
    const int cc = tid & 127, isK = cc >> 6, d0 = cc & 63, chn = isK * 256 + h * 64 + d0;
    float cw[5]; const float* cwp = INP(F, 3) + (size_t)l * 5 * 512;
#pragma unroll
    for (int jj = 0; jj < 5; ++jj) cw[jj] = cwp[jj * 512 + chn];
    const float cbv = INP(F, 4)[l * 512 + chn];
    f32x4 st[2] = {{0.f, 0.f, 0.f, 0.f}, {0.f, 0.f, 0.f, 0.f}};
    float m_st = 0.f;
    v4u pre[3], prev; float gli = 0.f, glf = 0.f;
#define ML_ISSUE(c_) do { const int tlo_ = dir ? SEQ - 64 * ((c_) + 1) : 64 * (c_); _Pragma("unroll") for (int i_ = 0; i_ < 3; ++i_) { const int ch_ = tid + 512 * i_; pre[i_] = (v4u){0u, 0u, 0u, 0u}; \
        if (ch_ < 68 * 16) { const int rr_ = ch_ >> 4, q_ = ch_ & 15; const int t_ = tlo_ - 2 + rr_; if (t_ >= 0 && t_ < SEQ) pre[i_] = *(const v4u*)(cols + (mb + t_) * NINP + (q_ >> 3) * 256 + h * 64 + (q_ & 7) * 8); } } \
        prev = *(const v4u*)(cols + (mb + tlo_ + (tid >> 3)) * NINP + A_V + h * 64 + (tid & 7) * 8); \
        if (tid < 64) { const int t_ = dir ? tlo_ + 63 - tid : tlo_ + tid; gli = GT[(mb + t_) * 16 + dir * 4 + h]; glf = GT[(mb + t_) * 16 + 8 + dir * 4 + h]; } } while (0)
#define ML_FILL(c_) do { _Pragma("unroll") for (int i_ = 0; i_ < 3; ++i_) { const int ch_ = tid + 512 * i_; if (ch_ < 68 * 16) *(LAS v4u*)(RAWQ + (ch_ >> 4) * 128 + (ch_ & 15) * 8) = pre[i_]; } \
        { LAS bf16* Vt_ = Vtb + ((c_) & 1) * 4608; const int tl_ = tid >> 3, e8_ = tid & 7; const int lp_ = dir ? 63 - tl_ : tl_; const unsigned w_[4] = {prev.x, prev.y, prev.z, prev.w}; \
          _Pragma("unroll") for (int k_ = 0; k_ < 4; ++k_) { const int e_ = e8_ * 8 + 2 * k_; Vt_[e_ * 72 + swz64(e_, lp_)] = (bf16)(w_[k_] & 0xffffu); Vt_[(e_ + 1) * 72 + swz64(e_ + 1, lp_)] = (bf16)(w_[k_] >> 16); } } \
        if (tid < 64) { const float bl_ = wave_scan_add(glf); \
            const float u_ = gli - bl_; const float rm_ = wave_scan_max(u_); \
            ub[((c_) & 1) * 64 + tid] = u_; blb[((c_) & 1) * 64 + tid] = bl_; rmb[((c_) & 1) * 64 + tid] = rm_; if (tid == 63) { scb[((c_) & 1) * 2] = rm_; scb[((c_) & 1) * 2 + 1] = bl_; } } } while (0)
    ML_ISSUE(0); ML_FILL(0); ML_ISSUE(1);
    __syncthreads();
#pragma unroll 1
    for (int c = 0; c < cend; ++c) {
        const bool full = c >= cfull0;
        const int tlo = dir ? SEQ - 64 * (c + 1) : 64 * c;
        const LAS float* u = ub + (c & 1) * 64; const LAS float* bl = blb + (c & 1) * 64; const LAS float* rm = rmb + (c & 1) * 64;
        const LAS bf16* Vt = Vtb + (c & 1) * 4608; const LAS bf16* Ct = Ctb + (c & 1) * 4608; LAS bf16* Ctn = Ctb + ((c + 1) & 1) * 4608;
#pragma unroll 4
        for (int i = 0; i < 16; ++i) { const int tl = (tid >> 7) + 4 * i; float s = cbv;
#pragma unroll
            for (int jj = 0; jj < 5; ++jj) s += cw[jj] * bf2f(RAWQ[(tl + jj) * 128 + cc]);
            s = siluf_(s); const int lpos = dir ? 63 - tl : tl;
            if (isK) Ks[lpos * 72 + d0] = (bf16)f2bf(s * 0.125f); else Qs[lpos * 72 + d0] = (bf16)f2bf(s); }
        if (tid < 64) den[tid] = 0.f;
        __syncthreads();
        const float umax = scb[(c & 1) * 2], tot = scb[(c & 1) * 2 + 1];
        for (int idx = tid; idx < 4096; idx += 512) { const int lp = idx >> 6, d = idx & 63; KWt[d * 72 + swz64(d, lp)] = (bf16)f2bf(bf2f(Ks[lp * 72 + d]) * __expf(u[lp] - umax)); }
        if (full) {
#pragma unroll
        for (int k = 0; k < 2; ++k) { const int ti = 2 * wave + k, tl_ = ti >> 2, ts = ti & 3; f32x4 acc = {0.f, 0.f, 0.f, 0.f};
            if (ts <= tl_) acc = mma16<64>(Qs + tl_ * 16 * 72, 72, Ks + ts * 16 * 72, 72, acc, lane);
#pragma unroll
            for (int jj = 0; jj < 4; ++jj) { const int lr = tl_ * 16 + (lane >> 4) * 4 + jj, s = ts * 16 + (lane & 15);
                const float v = (s <= lr) ? acc[jj] * __expf(u[s] - fmaxf(m_st, rm[lr])) : 0.f; const unsigned vb = f2bf(v); Ps[lr * 72 + s] = (bf16)vb;
                if (ts <= tl_) { const float rs = row16_sum(bf2f(vb)); if ((lane & 15) == 0) __hip_atomic_fetch_add(den + lr, rs, __ATOMIC_RELAXED, __HIP_MEMORY_SCOPE_WORKGROUP); } } }
        { const int lq = tid >> 3, part = tid & 7; float s = 0.f;
#pragma unroll
          for (int k = 0; k < 8; ++k) s += bf2f(Qs[lq * 72 + part * 8 + k]) * nst[part * 8 + k];
          s = row8_sum(s); if (part == 0) qn[lq] = s; }
        }
        __syncthreads();
        const float mmax = fmaxf(m_st, umax), s_old = __expf(m_st - mmax), s_new = __expf(umax - mmax);
#pragma unroll
        for (int k = 0; k < 2; ++k) { const int ti = 2 * wave + k, t0_ = ti >> 2, t1_ = ti & 3; const f32x4 z = {0.f, 0.f, 0.f, 0.f};
            f32x4 a1 = z, a2 = z;
            if (full) { a1 = mma16s<false, true>(Ps, 72, t0_ * 16, Vt, 72, t1_ * 16, z, lane); a2 = mma16<64>(Qs + t0_ * 16 * 72, 72, Ct + t1_ * 16 * 72, 72, z, lane); }
            const f32x4 lc = mma16s<true, true>(Vt, 72, t0_ * 16, KWt, 72, t1_ * 16, z, lane);
#pragma unroll
            for (int jj = 0; jj < 4; ++jj) { const int r_ = t0_ * 16 + (lane >> 4) * 4 + jj, c_ = t1_ * 16 + (lane & 15);
                if (full) { const float mx = fmaxf(m_st, rm[r_]), iwv = __expf(m_st - mx);
                const float dn = den[r_] + iwv * qn[r_];
                const float val = (a1[jj] + iwv * a2[jj]) / fmaxf(fabsf(dn), __expf(-(bl[r_] + mx)));
                const int t = dir ? tlo + 63 - r_ : tlo + r_;
                Y[(mb + t) * 256 + h * 64 + c_] = (bf16)f2bf(val); }
                st[k][jj] = s_old * st[k][jj] + s_new * lc[jj];
                Ctn[r_ * 72 + c_] = (bf16)f2bf(st[k][jj]); } }
        { const int dq = tid >> 3, part = tid & 7; float s = 0.f;
#pragma unroll
          for (int k = 0; k < 8; ++k) s += bf2f(KWt[dq * 72 + swz64(dq, part * 8) + k]);
          s = row8_sum(s); if (part == 0) nst[dq] = s_old * nst[dq] + s_new * s; }
        m_st = tot + mmax;
        if (c + 1 < cend) { ML_FILL(c + 1); if (c + 2 < cend) ML_ISSUE(c + 2); }
        __syncthreads();
    }
#undef ML_ISSUE
#undef ML_FILL
}
__device__ __forceinline__ void phase_ssd_conv(const Frame& F, int l) {
    const bf16* cols = (const bf16*)(WSP(F) + WS_COLS); bf16* XBC = (bf16*)(WSP(F) + WS_XN);
    LAS bf16* raw = (LAS bf16*)(F.lds);
    const float* cwp = INP(F, 20) + (size_t)l * 5 * 896; const float* cbp = INP(F, 21) + l * 896;
    const int tid = F.tid;
    float cw0[5], cw1[5]; const int c1 = tid + 512 < 896 ? tid + 512 : tid;
#pragma unroll
    for (int jj = 0; jj < 5; ++jj) { cw0[jj] = cwp[jj * 896 + tid]; cw1[jj] = cwp[jj * 896 + c1]; }
    const float cb0 = cbp[tid], cb1 = cbp[c1];
    for (int tile = F.vcu; tile < M / 32; tile += F.G) {
        const int m0 = tile * 32, t0 = m0 % SEQ;
        __syncthreads();
        for (int ch = tid; ch < 36 * 112; ch += 512) { const int rr = ch / 112, cc = ch % 112; const int t = t0 - 2 + rr;
            v4u v = {0u, 0u, 0u, 0u}; if (t >= 0 && t < SEQ) v = *(const v4u*)(cols + (size_t)(m0 - 2 + rr) * NINP + S_X + cc * 8);
            *(LAS v4u*)(raw + rr * 896 + cc * 8) = v; }
        __syncthreads();
#pragma unroll
        for (int half = 0; half < 2; ++half) { const int c = half ? c1 : tid; if (half && tid + 512 >= 896) break;
            float win[5];
#pragma unroll
            for (int jj = 0; jj < 4; ++jj) win[jj] = bf2f(raw[jj * 896 + c]);
            for (int tl = 0; tl < 32; ++tl) { win[4] = bf2f(raw[(tl + 4) * 896 + c]);
                float s = half ? cb1 : cb0;
#pragma unroll
                for (int jj = 0; jj < 5; ++jj) s += (half ? cw1[jj] : cw0[jj]) * win[jj];
#pragma unroll
                for (int jj = 0; jj < 4; ++jj) win[jj] = win[jj + 1];
                XBC[(size_t)(m0 + tl) * 896 + c] = (bf16)f2bf(siluf_(s)); } }
    }
    __syncthreads();
}
__device__ __forceinline__ void ssd_seq(const Frame& F, int l, int task, int cfull0, int cend) {
    const int b = task / 12, rem = task % 12, head = rem >> 1, dir = rem & 1, g = head / 3;
    const bf16* cols = (const bf16*)(WSP(F) + WS_COLS); const bf16* XBC = (const bf16*)(WSP(F) + WS_XN);
    bf16* Y = (bf16*)(WSP(F) + (dir ? Y_SB : Y_SF));
    LAS bf16* Cm = (LAS bf16*)(F.lds); LAS bf16* Bm = (LAS bf16*)(F.lds + 17408);
    LAS bf16* Btw = (LAS bf16*)(F.lds + 34816); LAS bf16* Xt = (LAS bf16*)(F.lds + 53248);
    LAS bf16* Ps = (LAS bf16*)(F.lds + 62464); LAS bf16* Hs = (LAS bf16*)(F.lds + 71680);
    LAS float* dtvb = (LAS float*)(F.lds + 89088);
    LAS float* acsb = dtvb + 128;
    LAS float* totb = dtvb + 256;
    const int tid = F.tid, lane = F.lane, wave = F.wave;
    const size_t mb = (size_t)b * SEQ;
    constexpr int NC = SEQ / 64;
    __syncthreads();
    for (int i = tid; i < 64 * 136; i += 512) Hs[i] = 0;
    const float dtb = INP(F, 22)[(l * 2 + dir) * 6 + head];
    const float aneg = -__expf(INP(F, 23)[(l * 2 + dir) * 6 + head]);
    f32x4 st[4];
#pragma unroll
    for (int k = 0; k < 4; ++k) st[k] = (f32x4){0.f, 0.f, 0.f, 0.f};
    v4u pre[5]; float dtraw = 0.f;
#define SSD_ISSUE(c_) do { const int tlo_ = dir ? SEQ - 64 * ((c_) + 1) : 64 * (c_); _Pragma("unroll") for (int i_ = 0; i_ < 5; ++i_) { const int idx_ = tid + 512 * i_; const int tl_ = idx_ / 40, q_ = idx_ % 40; \
        const int gc_ = q_ < 8 ? head * 64 + q_ * 8 : (q_ < 24 ? 384 + g * 128 + (q_ - 8) * 8 : 640 + g * 128 + (q_ - 24) * 8); \
        pre[i_] = *(const v4u*)(XBC + (mb + tlo_ + tl_) * 896 + gc_); } } while (0)
#define SSD_DTLOAD(c_) do { if (tid < 64) { const int tlo_ = dir ? SEQ - 64 * ((c_) + 1) : 64 * (c_); const int t_ = dir ? tlo_ + 63 - tid : tlo_ + tid; dtraw = bf2f(cols[(mb + t_) * NINP + S_DT + dir * 6 + head]); } } while (0)
#define SSD_DTCALC(c_) do { if (tid < 64) { const float x_ = dtraw + dtb; const float dt_ = x_ > 20.f ? x_ : log1pf(__expf(x_)); float cs_ = dt_ * aneg; \
        cs_ = wave_scan_add(cs_); \
        const float tt_ = __builtin_bit_cast(float, __builtin_amdgcn_readlane(__builtin_bit_cast(int, cs_), 63)); dtvb[((c_) & 1) * 64 + tid] = dt_; acsb[((c_) & 1) * 64 + tid] = cs_; if (tid == 0) totb[(c_) & 1] = tt_; } } while (0)
    SSD_ISSUE(0); SSD_DTLOAD(0); SSD_DTCALC(0); SSD_DTLOAD(1);
    __syncthreads();
    if (cfull0 > 0) {
#pragma unroll 1
        for (int c = 0; c < cfull0; ++c) {
            LAS bf16* Xl = (c & 1) ? (LAS bf16*)(F.lds + 92160) : Xt; LAS bf16* Bl = (c & 1) ? (LAS bf16*)(F.lds + 101376) : Btw;
            const LAS float* dtv = dtvb + (c & 1) * 64; const LAS float* acs = acsb + (c & 1) * 64; const float tot = totb[c & 1];
#pragma unroll
            for (int i = 0; i < 5; ++i) { const int idx = tid + 512 * i; const int tl = idx / 40, q = idx % 40; const int lp = dir ? 63 - tl : tl;
                const unsigned w[4] = {pre[i].x, pre[i].y, pre[i].z, pre[i].w};
                if (q < 8) {
#pragma unroll
                    for (int k = 0; k < 4; ++k) { const int p0 = q * 8 + 2 * k; Xl[p0 * 72 + swz64(p0, lp)] = (bf16)(w[k] & 0xffffu); Xl[(p0 + 1) * 72 + swz64(p0 + 1, lp)] = (bf16)(w[k] >> 16); } }
                else if (q < 24) { const int n0 = (q - 8) * 8; const float sc = dtv[lp] * __expf(tot - acs[lp]);
#pragma unroll
                    for (int k = 0; k < 4; ++k) { const int nn = n0 + 2 * k; Bl[nn * 72 + swz64(nn, lp)] = (bf16)f2bf(bf2f(w[k] & 0xffffu) * sc); Bl[(nn + 1) * 72 + swz64(nn + 1, lp)] = (bf16)f2bf(bf2f(w[k] >> 16) * sc); } } }
            SSD_ISSUE(c + 1);
            SSD_DTCALC(c + 1); if (c + 2 < cend) SSD_DTLOAD(c + 2);
            __syncthreads();
            const float cdec = __expf(tot);
#pragma unroll
            for (int k = 0; k < 4; ++k) { const int ti = 4 * wave + k, tp = ti >> 3, tn = ti & 7; const f32x4 z = {0.f, 0.f, 0.f, 0.f};
                const f32x4 lcv = mma16s<true, true>(Xl, 72, tp * 16, Bl, 72, tn * 16, z, lane);
                st[k] = st[k] * cdec + lcv; }
        }
#pragma unroll
        for (int k = 0; k < 4; ++k) { const int ti = 4 * wave + k, tp = ti >> 3, tn = ti & 7;
#pragma unroll
            for (int jj = 0; jj < 4; ++jj) { const int p = tp * 16 + (lane >> 4) * 4 + jj, n = tn * 16 + (lane & 15); Hs[p * 136 + n] = (bf16)f2bf(st[k][jj]); } }
        __syncthreads();
    }
#pragma unroll 1
    for (int c = cfull0; c < cend; ++c) {
        const bool full = c >= cfull0;
        const int tlo = dir ? SEQ - 64 * (c + 1) : 64 * c;
        const LAS float* dtv = dtvb + (c & 1) * 64; const LAS float* acs = acsb + (c & 1) * 64; const float tot = totb[c & 1];
#pragma unroll
        for (int i = 0; i < 5; ++i) { const int idx = tid + 512 * i; const int tl = idx / 40, q = idx % 40; const int lp = dir ? 63 - tl : tl;
            const unsigned w[4] = {pre[i].x, pre[i].y, pre[i].z, pre[i].w};
            if (q < 8) {
#pragma unroll
                for (int k = 0; k < 4; ++k) { const int p0 = q * 8 + 2 * k; Xt[p0 * 72 + swz64(p0, lp)] = (bf16)(w[k] & 0xffffu); Xt[(p0 + 1) * 72 + swz64(p0 + 1, lp)] = (bf16)(w[k] >> 16); } }
            else if (q < 24) { const int n0 = (q - 8) * 8; if (full) *(LAS v4u*)(Bm + lp * 136 + n0) = pre[i]; const float sc = dtv[lp] * __expf(tot - acs[lp]);
#pragma unroll
                for (int k = 0; k < 4; ++k) { const int nn = n0 + 2 * k; Btw[nn * 72 + swz64(nn, lp)] = (bf16)f2bf(bf2f(w[k] & 0xffffu) * sc); Btw[(nn + 1) * 72 + swz64(nn + 1, lp)] = (bf16)f2bf(bf2f(w[k] >> 16) * sc); } }
            else if (full) { const int n0 = (q - 24) * 8; *(LAS v4u*)(Cm + lp * 136 + n0) = pre[i]; } }
        if (c + 1 < cend) SSD_ISSUE(c + 1);
        __syncthreads();
        f32x4 yo[2] = {{0.f, 0.f, 0.f, 0.f}, {0.f, 0.f, 0.f, 0.f}}, lc[4];
        if (full) {
#pragma unroll
        for (int k = 0; k < 2; ++k) { const int ti = 2 * wave + k, tl_ = ti >> 2, ts = ti & 3; f32x4 acc = {0.f, 0.f, 0.f, 0.f};
            if (ts <= tl_) acc = mma16<128>(Cm + tl_ * 16 * 136, 136, Bm + ts * 16 * 136, 136, acc, lane);
#pragma unroll
            for (int jj = 0; jj < 4; ++jj) { const int lr = tl_ * 16 + (lane >> 4) * 4 + jj, s = ts * 16 + (lane & 15);
                const float v = (s <= lr) ? acc[jj] * __expf(acs[lr] - acs[s]) * dtv[s] : 0.f; Ps[lr * 72 + s] = (bf16)f2bf(v); }
            const f32x4 z = {0.f, 0.f, 0.f, 0.f};
            yo[k] = mma16<128>(Cm + tl_ * 16 * 136, 136, Hs + ts * 16 * 136, 136, z, lane); }
        }
#pragma unroll
        for (int k = 0; k < 4; ++k) { const int ti = 4 * wave + k, tp = ti >> 3, tn = ti & 7; const f32x4 z = {0.f, 0.f, 0.f, 0.f};
            lc[k] = mma16s<true, true>(Xt, 72, tp * 16, Btw, 72, tn * 16, z, lane); }
        __syncthreads();
        const float cdec = __expf(tot);
        if (full) {
#pragma unroll
        for (int k = 0; k < 2; ++k) { const int ti = 2 * wave + k, tl_ = ti >> 2, tp = ti & 3; const f32x4 z = {0.f, 0.f, 0.f, 0.f};
            const f32x4 yd = mma16s<false, true>(Ps, 72, tl_ * 16, Xt, 72, tp * 16, z, lane);
#pragma unroll
            for (int jj = 0; jj < 4; ++jj) { const int lr = tl_ * 16 + (lane >> 4) * 4 + jj, p = tp * 16 + (lane & 15);
                const float val = yd[jj] + yo[k][jj] * __expf(acs[lr]);
                const int t = dir ? tlo + 63 - lr : tlo + lr;
                Y[(mb + t) * 384 + head * 64 + p] = (bf16)f2bf(val); } }
        }
#pragma unroll
        for (int k = 0; k < 4; ++k) { const int ti = 4 * wave + k, tp = ti >> 3, tn = ti & 7;
#pragma unroll
            for (int jj = 0; jj < 4; ++jj) { const int p = tp * 16 + (lane >> 4) * 4 + jj, n = tn * 16 + (lane & 15);
                st[k][jj] = cdec * st[k][jj] + lc[k][jj]; Hs[p * 136 + n] = (bf16)f2bf(st[k][jj]); } }
        if (c + 1 < cend) { SSD_DTCALC(c + 1); if (c + 2 < cend) SSD_DTLOAD(c + 2); }
        __syncthreads();
    }
#undef SSD_ISSUE
#undef SSD_DTLOAD
#undef SSD_DTCALC
}
__device__ __forceinline__ float wave_sum2(float v) { v = row16_sum(v); v += __shfl_xor(v, 16); v += __shfl_xor(v, 32); return v; }
__device__ __forceinline__ f32x4 bf4(v2u w) { return (f32x4){bf2f(w.x & 0xffffu), bf2f(w.x >> 16), bf2f(w.y & 0xffffu), bf2f(w.y >> 16)}; }
__device__ __forceinline__ v2u pk4(f32x4 v) { v2u w; w.x = pk2(v.x, v.y); w.y = pk2(v.z, v.w); return w; }
__device__ __forceinline__ void phase_post(const Frame& F, int l) {
    const bf16* cols = (const bf16*)(WSP(F) + WS_COLS); bf16* MIX = (bf16*)(WSP(F) + WS_XN);
    const bf16* YAf = (const bf16*)(WSP(F) + Y_AF); const bf16* YAb = (const bf16*)(WSP(F) + Y_AB);
    const bf16* YRf = (const bf16*)(WSP(F) + Y_RF); const bf16* YRb = (const bf16*)(WSP(F) + Y_RB);
    const bf16* YSf = (const bf16*)(WSP(F) + Y_SF); const bf16* YSb = (const bf16*)(WSP(F) + Y_SB);
    const float* CT = (const float*)(WSP(F) + WS_CT);
    LAS bf16* GU = (LAS bf16*)(F.lds);
    LAS bf16* SG = (LAS bf16*)(F.lds + 104448);
    LAS float* gate = (LAS float*)(F.lds + 108800);
    LAS float* SCW = (LAS float*)(F.lds + 133632);
    const int tid = F.tid, lane = F.lane, wave = F.wave;
    const float* mup = INP(F, 8) + l * 1472; const float* mun = INP(F, 9) + l * 1472;
    const float* gup = INP(F, 14) + (size_t)l * 128 * 384;
    const float* sdk = INP(F, 24) + l * 6;
    __syncthreads();
    for (int idx = tid; idx < 128 * 384; idx += 512) { const int i = idx / 384, c = idx % 384; GU[c * 136 + i] = (bf16)f2bf(gup[idx]); }
    { const float* scw = INP(F, 20) + (size_t)l * 5 * 896; for (int idx = tid; idx < 5 * 384; idx += 512) SCW[idx] = scw[(idx / 384) * 896 + (idx % 384)]; }
    const int gch = tid & 15;
    float gmp[8], gmn[8];
#pragma unroll
    for (int k = 0; k < 8; ++k) { gmp[k] = mup[1344 + 8 * gch + k]; gmn[k] = mun[1344 + 8 * gch + k]; }
    const int qa = lane, qb = 64 + (lane & 31);
    const f32x4 mng4 = *(const f32x4*)(INP(F, 7) + l * 256 + 4 * qa);
    f32x4 rmp[2], rmn[2], rng[2], rnb[2], scb[2], sng[2];
#pragma unroll
    for (int ps = 0; ps < 2; ++ps) { const int c0 = 4 * (ps ? qb : qa);
        rmp[ps] = *(const f32x4*)(mup + 768 + c0); rmn[ps] = *(const f32x4*)(mun + 768 + c0);
        rng[ps] = *(const f32x4*)(INP(F, 18) + l * 384 + c0); rnb[ps] = *(const f32x4*)(INP(F, 19) + l * 384 + c0);
        scb[ps] = *(const f32x4*)(INP(F, 21) + l * 896 + c0); sng[ps] = *(const f32x4*)(INP(F, 25) + l * 384 + c0); }
    for (int tile = F.vcu; tile < M / 16; tile += F.G) {
        const int m0 = tile * 16;
        __syncthreads();
        if (tid < 256) { const int tt = tid >> 4; const int m = m0 + tt, t = m % SEQ; const bf16* cp = cols + (size_t)m * NINP + R_GD + 8 * gch;
            const v4u c1 = *(const v4u*)cp; v4u c0 = {0u, 0u, 0u, 0u}, c2 = {0u, 0u, 0u, 0u};
            if (t > 0) c0 = *(const v4u*)(cp - NINP); if (t < SEQ - 1) c2 = *(const v4u*)(cp + NINP);
            const unsigned w0[4] = {c0.x, c0.y, c0.z, c0.w}, w1[4] = {c1.x, c1.y, c1.z, c1.w}, w2[4] = {c2.x, c2.y, c2.z, c2.w}; unsigned o[4];
#pragma unroll
            for (int k = 0; k < 4; ++k) { const float a1 = bf2f(w1[k] & 0xffffu), b1 = bf2f(w1[k] >> 16);
                const float va = a1 + gmp[2 * k] * (bf2f(w0[k] & 0xffffu) - a1) + gmn[2 * k] * (bf2f(w2[k] & 0xffffu) - a1);
                const float vb = b1 + gmp[2 * k + 1] * (bf2f(w0[k] >> 16) - b1) + gmn[2 * k + 1] * (bf2f(w2[k] >> 16) - b1);
                o[k] = pk2(sigmoidf_(va), sigmoidf_(vb)); }
            *(LAS v4u*)(SG + tt * 136 + 8 * gch) = (v4u){o[0], o[1], o[2], o[3]}; }
        __syncthreads();
#pragma unroll
        for (int k = 0; k < 3; ++k) { const int ct = wave + 8 * k; const f32x4 z = {0.f, 0.f, 0.f, 0.f};
            const f32x4 acc = mma16<128>(SG, 136, GU + ct * 16 * 136, 136, z, lane);
#pragma unroll
            for (int jj = 0; jj < 4; ++jj) gate[((lane >> 4) * 4 + jj) * 388 + ct * 16 + (lane & 15)] = acc[jj]; }
        __syncthreads();
#pragma unroll 1
        for (int k = 0; k < 2; ++k) { const int tt = wave * 2 + k; const int m = m0 + tt, t = m % SEQ; const size_t cr = (size_t)m * NINP;
            { const int c0 = 4 * qa;
              const f32x4 hs = bf4(*(const v2u*)(YAf + (size_t)m * 256 + c0)) + bf4(*(const v2u*)(YAb + (size_t)m * 256 + c0));
              const float mean = row16_sum((hs.x + hs.y) + (hs.z + hs.w)) * (1.f / 64.f); const f32x4 d = hs - mean;
              const float var = row16_sum((d.x * d.x + d.y * d.y) + (d.z * d.z + d.w * d.w)) * (1.f / 64.f);
              const f32x4 o = bf4(*(const v2u*)(cols + cr + A_O + c0));
              f32x4 y = d * (1.f / sqrtf(var + 1e-6f)) * mng4;
              y.x *= sigmoidf_(o.x); y.y *= sigmoidf_(o.y); y.z *= sigmoidf_(o.z); y.w *= sigmoidf_(o.w);
              *(v2u*)(MIX + (size_t)m * DM + c0) = pk4(y); }
#pragma unroll
            for (int ps = 0; ps < 2; ++ps) { const int qd = ps ? qb : qa, c0 = 4 * qd; const bool act = ps == 0 || lane < 32;
              const f32x4 ys = bf4(*(const v2u*)(YRf + (size_t)m * 384 + c0)) + bf4(*(const v2u*)(YRb + (size_t)m * 384 + c0));
              const float mean = row16_sum((ys.x + ys.y) + (ys.z + ys.w)) * (1.f / 64.f); const f32x4 d = ys - mean;
              const float var = row16_sum((d.x * d.x + d.y * d.y) + (d.z * d.z + d.w * d.w)) * (1.f / 64.f);
              const f32x4 y = d * (1.f / sqrtf(var + 64e-5f)) * rng[ps] + rnb[ps];
              const f32x4 p1 = bf4(*(const v2u*)(cols + cr + R_V + c0));
              f32x4 p0 = {0.f, 0.f, 0.f, 0.f}, p2 = {0.f, 0.f, 0.f, 0.f};
              if (t > 0) p0 = bf4(*(const v2u*)(cols + cr - NINP + R_V + c0)); if (t < SEQ - 1) p2 = bf4(*(const v2u*)(cols + cr + NINP + R_V + c0));
              const f32x4 vv = p1 + rmp[ps] * (p0 - p1) + rmn[ps] * (p2 - p1);
              const float ctv = CT[(size_t)m * 8 + (qd >> 4)];
              const f32x4 g4 = *(const LAS f32x4*)(gate + tt * 388 + c0);
              if (act) *(v2u*)(MIX + (size_t)m * DM + 256 + c0) = pk4((y + vv * ctv) * g4); }
            f32x4 yv[2]; float ssq0 = 0.f, ssq1 = 0.f;
#pragma unroll
            for (int ps = 0; ps < 2; ++ps) { const int qd = ps ? qb : qa, c0 = 4 * qd; const bool act = ps == 0 || lane < 32;
              f32x4 s = scb[ps];
#pragma unroll
              for (int jj = 0; jj < 5; ++jj) { const int tq = t + jj - 2; if (tq >= 0 && tq < SEQ) s += *(const LAS f32x4*)(SCW + jj * 384 + c0) * bf4(*(const v2u*)(cols + cr + (jj - 2) * NINP + S_X + c0)); }
              const f32x4 z = bf4(*(const v2u*)(cols + cr + S_Z + c0));
              f32x4 y = bf4(*(const v2u*)(YSf + (size_t)m * 384 + c0)) + bf4(*(const v2u*)(YSb + (size_t)m * 384 + c0));
              const float dsk = sdk[qd >> 4];
              y.x = (y.x + dsk * siluf_(s.x)) * siluf_(z.x); y.y = (y.y + dsk * siluf_(s.y)) * siluf_(z.y); y.z = (y.z + dsk * siluf_(s.z)) * siluf_(z.z); y.w = (y.w + dsk * siluf_(s.w)) * siluf_(z.w);
              yv[ps] = y; const float sq = act ? (y.x * y.x + y.y * y.y) + (y.z * y.z + y.w * y.w) : 0.f;
              if (qd < 48) ssq0 += sq; else ssq1 += sq; }
            const float r0 = 1.f / sqrtf(wave_sum2(ssq0) * (1.f / 192.f) + 1e-6f), r1 = 1.f / sqrtf(wave_sum2(ssq1) * (1.f / 192.f) + 1e-6f);
#pragma unroll
            for (int ps = 0; ps < 2; ++ps) { const int qd = ps ? qb : qa, c0 = 4 * qd; const bool act = ps == 0 || lane < 32;
              if (act) *(v2u*)(MIX + (size_t)m * DM + 640 + c0) = pk4(yv[ps] * (qd < 48 ? r0 : r1) * sng[ps]); }
        }
    }
    __syncthreads();
}
namespace cg = cooperative_groups;
constexpr int N_PHASES = 9 * DEPTH + 1;
__global__ void __launch_bounds__(NWAVES * 64, 2) mk_fwd(Args args) {
    extern __shared__ __attribute__((aligned(16))) unsigned char lds_raw[];
    Frame F;
    F.lds = (LAS unsigned char*)lds_raw;
    F.tid = threadIdx.x; F.lane = F.tid & 63; F.wave = __builtin_amdgcn_readfirstlane(F.tid >> 6);
    F.G = gridDim.x; { const int bx = blockIdx.x; F.vcu = (F.G % 8 == 0) ? (bx % 8) * (F.G / 8) + bx / 8 : bx; }
    volatile LAS unsigned* MISC = (volatile LAS unsigned*)(F.lds + MISC_OFF);
    if (F.tid < 64) MISC[F.tid] = 0u;
    if (F.tid < 34) *(LAS unsigned long long*)(F.lds + PTAB_OFF + 8 * F.tid) = ((const unsigned long long*)__builtin_amdgcn_kernarg_segment_ptr())[F.tid];
    __syncthreads();
    unsigned* ctl = (unsigned*)(WSP(F) + WS_CTL);
    XcdBarrier bar = xcd_barrier_post(ctl + CW_BAR, MISC + 8);
    const int lo = args.ph_lo, hi = args.ph_hi;
#define IN_(k) (lo <= (k) && (k) < hi)
#define SEAM(k) do { if (IN_(k) && IN_((k) + 1)) { if ((k) == 0) cg::this_grid().sync(); else xcd_barrier(bar); } } while (0)
#define LAYER(l, B) \
    if (IN_(B + 0)) { phase_convert(F, l); phase_norm(F, l == 0 ? INP(F, 0) : OUTP(F), INP(F, 1) + l * DM, (bf16*)(WSP(F) + WS_XN)); } SEAM(B + 0); \
    if (IN_(B + 1)) { unsigned char* ws = WSP(F); pg8::Gemm g{(const bf16*)(ws + WS_XN), (const bf16*)(ws + WS_WIN), M, NINP, DM}; pg8::StaticOrder S; S.init(M, NINP, F.G, (int)blockIdx.x); \
            pg8::EpiBf16<0> E{(bf16*)(ws + WS_COLS), NINP, nullptr, 0, 0, 1.f}; \
            pg8::gemm_phase<pg8::EpiBf16<0>, pg8::StaticOrder, PG8_ALIGN, PG8_SP2>(F.lds, g, S, E); } SEAM(B + 1); \
    if (IN_(B + 2)) { phase_gates(F, l); phase_ssd_conv(F, l); } SEAM(B + 2); \
    if (IN_(B + 3)) { const int bx = blockIdx.x; \
            if (bx < 96) { const int c8 = bx & 7, k8 = bx >> 3; rwkv_scan(F, l, c8 + 8 * (k8 >> 2), k8 & 3, (unsigned)l * (SEQ / 32)); } else if (bx < 120) rwkv_produce(F, l, bx - 96, (unsigned)l * (SEQ / 32)); else if (bx < 192) { const int u = bx - 120, sg = 2 - (u / 24); ssd_seq(F, l, u % 24, sg == 0 ? 0 : (sg == 1 ? 43 : 86), sg == 0 ? 43 : (sg == 1 ? 86 : 128)); } else if (bx < 256) { const int u = bx - 192, sg = 3 - (u / 16); mlstm_seq(F, l, u % 16, 32 * sg, 32 * sg + 32); } } SEAM(B + 3); \
    if (IN_(B + 4)) phase_post(F, l); SEAM(B + 4); \
    if (IN_(B + 5)) { unsigned char* ws = WSP(F); pg8::Gemm g{(const bf16*)(ws + WS_XN), (const bf16*)(ws + WS_WOUT), M, DM, DM}; pg8::StaticOrder S; S.init(M, DM, F.G, (int)blockIdx.x); \
            pg8::EpiResidual E{l == 0 ? INP(F, 0) : OUTP(F), OUTP(F), DM}; \
            pg8::gemm_phase<pg8::EpiResidual, pg8::StaticOrder, PG8_ALIGN, PG8_SP2>(F.lds, g, S, E); } SEAM(B + 5); \
    if (IN_(B + 6)) phase_norm(F, OUTP(F), INP(F, 27) + l * DM, (bf16*)(WSP(F) + WS_XN)); SEAM(B + 6); \
    if (IN_(B + 7)) { unsigned char* ws = WSP(F); pg8::Gemm g{(const bf16*)(ws + WS_XN), (const bf16*)(ws + WS_WGU), M, 2 * FFN, DM}; pg8::StaticOrder S; S.init(M, 2 * FFN, F.G, (int)blockIdx.x); \
            pg8::EpiSwiGLU E{(bf16*)(ws + WS_COLS), FFN}; \
            pg8::gemm_phase<pg8::EpiSwiGLU, pg8::StaticOrder, PG8_ALIGN, PG8_SP2>(F.lds, g, S, E); } SEAM(B + 7); \
    if (IN_(B + 8)) { unsigned char* ws = WSP(F); pg8::Gemm g{(const bf16*)(ws + WS_COLS), (const bf16*)(ws + WS_WDN), M, DM, FFN}; pg8::StaticOrder S; S.init(M, DM, F.G, (int)blockIdx.x); \
            pg8::EpiResidual E{OUTP(F), OUTP(F), DM}; \
            pg8::gemm_phase<pg8::EpiResidual, pg8::StaticOrder, PG8_ALIGN, PG8_SP2>(F.lds, g, S, E); } SEAM(B + 8);
    LAYER(0, 0)
    LAYER(1, 9)
    if (IN_(18)) phase_final_norm(F, OUTP(F), INP(F, 31));
#undef IN_
#undef SEAM
#undef LAYER
}

#ifndef MK_PER_PHASE
#define MK_PER_PHASE 0
#endif
extern "C" void kernel_launch(void* const* d_in, const int* in_sizes, int n_in, void* d_out, int out_size, void* d_ws, size_t ws_size, hipStream_t stream) {
    static int grid = 0;
    if (grid == 0) {
        int dev = 0, cus = 0;
        if (n_in != 32 || out_size != M * DM || ws_size < WS_END) { fprintf(stderr, "kernel_launch: unexpected shapes (n_in %d out %d ws %zu)\n", n_in, out_size, ws_size); grid = -1; return; }
        if (hipGetDevice(&dev) != hipSuccess || hipDeviceGetAttribute(&cus, hipDeviceAttributeMultiprocessorCount, dev) != hipSuccess) { grid = -1; return; }
        if (hipFuncSetAttribute((const void*)mk_fwd, hipFuncAttributeMaxDynamicSharedMemorySize, LDS_BYTES) != hipSuccess) { fprintf(stderr, "kernel_launch: hipFuncSetAttribute failed\n"); grid = -1; return; }
        int per_cu = 0;
        if (hipOccupancyMaxActiveBlocksPerMultiprocessor(&per_cu, (const void*)mk_fwd, NWAVES * 64, LDS_BYTES) != hipSuccess || per_cu < 1) { fprintf(stderr, "kernel_launch: occupancy query says %d\n", per_cu); }
        (void)hipGetLastError();
        grid = cus;
    }
    if (grid < 0) return;
    (void)hipMemsetAsync((char*)d_ws + WS_CTL, 0, CTL_ZERO_BYTES, stream);
    Args a{};
    for (int i = 0; i < 32; ++i) a.in[i] = (const float*)d_in[i];
    a.out = (float*)d_out; a.ws = (unsigned char*)d_ws;
#if MK_PER_PHASE
    for (int p = 0; p < N_PHASES; ++p) { a.ph_lo = p; a.ph_hi = p + 1; hipLaunchKernelGGL(mk_fwd, dim3(grid), dim3(NWAVES * 64), LDS_BYTES, stream, a); }
#else
    a.ph_lo = 0; a.ph_hi = N_PHASES;
    void* kargs[] = {&a};
    hipError_t e = hipLaunchCooperativeKernel((const void*)mk_fwd, dim3(grid), dim3(NWAVES * 64), kargs, LDS_BYTES, stream);
    if (e != hipSuccess) fprintf(stderr, "cooperative launch failed: %s (grid %d)\n", hipGetErrorString(e), grid);
#endif
}
```

```cpp
#include <hip/hip_runtime.h>
#include <hip/hip_cooperative_groups.h>
#include <cstdio>
#include <cstdint>
namespace pg8 {
#define PG8_LAS __attribute__((address_space(3)))
typedef unsigned short bf16_t;
typedef short bf16x8 __attribute__((ext_vector_type(8)));
typedef float f32x4 __attribute__((ext_vector_type(4)));
typedef unsigned u32x4 __attribute__((ext_vector_type(4)));
constexpr int BM = 256, BK = 64, HALF = 128, HTB = HALF * BK * 2  , STAGE_BYTES = 8 * HTB, NXCD = 8, WGM = 8;

__host__ __device__ __forceinline__ int lds_byte(int r, int c) { const int st = (r >> 4) * 2 + (c >> 5), rr = r & 15, cc = c & 31, ob = rr * 64 + cc * 2; return st * 1024 + (ob ^ (((ob >> 9) & 1) << 5)); }
__host__ __device__ __forceinline__ void stage_rc(int b, int& R, int& C) { const int st = b / 1024, sb = b % 1024, swz = sb ^ (((sb >> 9) & 1) << 5); R = (st >> 1) * 16 + swz / 64; C = (st & 1) * 32 + (swz % 64) / 2; }
__host__ __device__ __forceinline__ int perm32(int rho) { const int n = rho >> 4, i = rho & 15; return 8 * (i >> 2) + 4 * n + (i & 3); }

struct Unit { int pm, pn; };
struct Gemm { const bf16_t* A; const bf16_t* Bt; int M, N, K; };

struct StaticOrder {
    int nM, nN, nwg, G, c;
    __host__ __device__ void init(int M, int N, int G_, int c_) { nM = M / BM; nN = N / BM; nwg = nM * nN; G = G_; c = c_; }
    __host__ __device__ bool next(int i, Unit& u) const {
        const long L = (long)i * G + c; if (L >= nwg) return false;
        int wgid = (int)L; { const int q = nwg / NXCD, r = nwg % NXCD, xcd = wgid % NXCD, off = wgid / NXCD; wgid = (xcd < r ? xcd * (q + 1) : r * (q + 1) + (xcd - r) * q) + off; }
        const int nig = WGM * nN, gid = wgid / nig, fm = gid * WGM, gsz = (nM - fm) < WGM ? (nM - fm) : WGM;
        u.pm = fm + ((wgid % nig) % gsz); u.pn = (wgid % nig) / gsz; return true;
    }
    __device__ __forceinline__ void a_ready(const Unit&) const {}
    __device__ __forceinline__ void done(const Unit&) const {}
};

__device__ __forceinline__ unsigned cvt_pk_bf16(float lo, float hi) { unsigned r; asm volatile("v_cvt_pk_bf16_f32 %0, %1, %2" : "=v"(r) : "v"(lo), "v"(hi)); return r; }
typedef float f32x2 __attribute__((ext_vector_type(2)));
__device__ __forceinline__ f32x2 gelu_pk(f32x2 v) {
    const f32x2 av = __builtin_elementwise_abs(v), d = av * 0.2316418882f + 1.0f;
    f32x2 t; t.x = __builtin_amdgcn_rcpf(d.x); t.y = __builtin_amdgcn_rcpf(d.y);
    f32x2 q = t * 0.5307027145f + (-0.7265760135f); q = q * t + 0.7107068705f; q = q * t + (-0.142248368f); q = q * t + 0.127414796f; q = q * t;
    const f32x2 s = (v * v) * (-0.72134752044f);
    f32x2 e; e.x = __builtin_amdgcn_exp2f(s.x); e.y = __builtin_amdgcn_exp2f(s.y);
    const f32x2 m = v * (q * e), r = v - m;
    f32x2 o; o.x = v.x < 0.f ? m.x : r.x; o.y = v.y < 0.f ? m.y : r.y; return o;
}

template <int ACT  > struct EpiBf16 {
    static constexpr bool PERM = true, AFTER_DRAIN = false; static_assert(ACT == 0 || ACT == 1, "EpiBf16: ACT is 0 (none) or 1 (gelu_pk)");
    bf16_t* O; int ldc; const float* bias; int split_cols; size_t split_stride; float scale0;
    __device__ __forceinline__ void operator()(const f32x4 (&acc)[2][2][4][2], const Unit& u, int wr, int wc, int fr, int fq) const {
        const int row0 = u.pm * BM + wr * 64 + fr; int colt = u.pn * BM; bf16_t* base = O;
        float sc = 1.f; if (split_cols) { const int t = colt / split_cols; base += (size_t)t * split_stride; colt -= t * split_cols; if (t == 0) sc = scale0; }
        const int col0 = colt + wc * 32 + 8 * fq, bcol0 = u.pn * BM + wc * 32 + 8 * fq;
        f32x4 bv[2][2];
#pragma unroll
        for (int bj = 0; bj < 2; ++bj)
#pragma unroll
            for (int n = 0; n < 2; ++n) bv[bj][n] = bias ? *(const f32x4*)(bias + bcol0 + bj * HALF + 4 * n) : (f32x4){0.f, 0.f, 0.f, 0.f};
#pragma unroll
        for (int ai = 0; ai < 2; ++ai)
#pragma unroll
            for (int m = 0; m < 4; ++m) { bf16_t* rowp = base + (size_t)(row0 + ai * HALF + m * 16) * ldc + col0;
#pragma unroll
                for (int bj = 0; bj < 2; ++bj) { f32x4 v0 = acc[ai][bj][m][0] + bv[bj][0], v1 = acc[ai][bj][m][1] + bv[bj][1];
                    if (ACT == 1) { f32x2 a = gelu_pk((f32x2){v0[0], v0[1]}), b = gelu_pk((f32x2){v0[2], v0[3]}), c = gelu_pk((f32x2){v1[0], v1[1]}), d = gelu_pk((f32x2){v1[2], v1[3]});
                        v0 = (f32x4){a.x, a.y, b.x, b.y}; v1 = (f32x4){c.x, c.y, d.x, d.y}; }
                    v0 = v0 * sc; v1 = v1 * sc; u32x4 w; w.x = cvt_pk_bf16(v0[0], v0[1]); w.y = cvt_pk_bf16(v0[2], v0[3]); w.z = cvt_pk_bf16(v1[0], v1[1]); w.w = cvt_pk_bf16(v1[2], v1[3]);
                    *(u32x4*)(rowp + bj * HALF) = w; } }
    }
};
struct EpiResidual {
    static constexpr bool PERM = false, AFTER_DRAIN = false;
    const float* base; float* out; int ldc;
    __device__ __forceinline__ void operator()(const f32x4 (&acc)[2][2][4][2], const Unit& u, int wr, int wc, int fr, int fq) const {
        const int col0 = u.pn * BM + wc * 32 + 4 * fq;
#pragma unroll
        for (int ai = 0; ai < 2; ++ai)
#pragma unroll
            for (int m = 0; m < 4; ++m) { const size_t off = (size_t)(u.pm * BM + ai * HALF + wr * 64 + m * 16 + fr) * ldc + col0;
#pragma unroll
                for (int bj = 0; bj < 2; ++bj)
#pragma unroll
                    for (int n = 0; n < 2; ++n) { const f32x4 bs = *(const f32x4*)(base + off + bj * HALF + n * 16); *(f32x4*)(out + off + bj * HALF + n * 16) = bs + acc[ai][bj][m][n]; }
                asm volatile("" ::: "memory"); }
    }
};
struct EpiSwiGLU {
    static constexpr bool PERM = true, AFTER_DRAIN = false;
    bf16_t* O; int ldc;
    __device__ __forceinline__ void operator()(const f32x4 (&acc)[2][2][4][2], const Unit& u, int wr, int wc, int fr, int fq) const {
        const int col0 = u.pn * HALF + wc * 32 + 8 * fq;
#pragma unroll
        for (int ai = 0; ai < 2; ++ai)
#pragma unroll
            for (int m = 0; m < 4; ++m) { bf16_t* rowp = O + (size_t)(u.pm * BM + ai * HALF + wr * 64 + m * 16 + fr) * ldc + col0;
                float r[8];
#pragma unroll
                for (int n = 0; n < 2; ++n)
#pragma unroll
                    for (int j = 0; j < 4; ++j) { const float g = acc[ai][0][m][n][j], up = acc[ai][1][m][n][j]; r[n * 4 + j] = g * __builtin_amdgcn_rcpf(1.f + __expf(-g)) * up; }
                u32x4 w; w.x = cvt_pk_bf16(r[0], r[1]); w.y = cvt_pk_bf16(r[2], r[3]); w.z = cvt_pk_bf16(r[4], r[5]); w.w = cvt_pk_bf16(r[6], r[7]);
                *(u32x4*)rowp = w; }
    }
};
template <class Epi, class Sched, bool ALIGN_EPI = false, bool SP2 = false>
__device__ __forceinline__ void gemm_phase(PG8_LAS unsigned char* lds, const Gemm g, const Sched& S, const Epi& E) {
    const int tid = threadIdx.x, wid = __builtin_amdgcn_readfirstlane(tid >> 6), lane = tid & 63, wr = wid >> 2, wc = wid & 3, fr = lane & 15, fq = lane >> 4;
    const int K = g.K, nt = K / BK;
    unsigned voffA[2], voffB[2];
#pragma unroll
    for (int i = 0; i < 2; ++i) { int R, C; stage_rc(tid * 16 + i * 8192, R, C); const int Rb = Epi::PERM ? ((R & ~31) + perm32(R & 31)) : R;
        voffA[i] = (unsigned)(R * K + C) * 2u; voffB[i] = (unsigned)(Rb * K + C) * 2u; }
    const size_t kstep = (size_t)(BK * 2);
    const size_t hstep = (size_t)HALF * K * 2;
    const size_t tstep = 2 * hstep;
    const unsigned ldsw = (unsigned)wid * 1024u;
    const int aoff = lds_byte(wr * 64 + fr, fq * 8), boff = lds_byte(wc * 32 + fr, fq * 8);
#define PG8_SA(b, h) (((b) * 2 + (h)) * HTB)
#define PG8_SB(b, h) ((4 + (b) * 2 + (h)) * HTB)
#define PG8_STAGE(bufoff, gbase, voff) do { _Pragma("unroll") for (int _i = 0; _i < 2; ++_i) \
        __builtin_amdgcn_global_load_lds((const unsigned*)((const char*)(gbase) + (voff)[_i]), (PG8_LAS unsigned*)(lds + (bufoff) + ldsw + _i * 8192), 16, 0, 0); } while (0)
#define PG8_LDA(dst, b, h) do { _Pragma("unroll") for (int m = 0; m < 4; ++m) _Pragma("unroll") for (int k = 0; k < 2; ++k) dst[m][k] = *(const PG8_LAS bf16x8*)(lds + PG8_SA(b, h) + aoff + m * 2048 + k * 1024); } while (0)
#define PG8_LDB(dst, b, h) do { _Pragma("unroll") for (int n = 0; n < 2; ++n) _Pragma("unroll") for (int k = 0; k < 2; ++k) dst[n][k] = *(const PG8_LAS bf16x8*)(lds + PG8_SB(b, h) + boff + n * 2048 + k * 1024); } while (0)
#define PG8_MMA(ai, bj, At, Bt) do { __builtin_amdgcn_s_setprio(1); _Pragma("unroll") for (int m = 0; m < 4; ++m) _Pragma("unroll") for (int n = 0; n < 2; ++n) _Pragma("unroll") for (int k = 0; k < 2; ++k) \
        acc[ai][bj][m][n] = __builtin_amdgcn_mfma_f32_16x16x32_bf16(Bt[n][k], At[m][k], acc[ai][bj][m][n], 0, 0, 0); __builtin_amdgcn_s_setprio(0); } while (0)
#define PG8_WAIT_V(n) asm volatile("s_waitcnt vmcnt(" #n ")" ::: "memory")
#define PG8_WAIT_L(n) asm volatile("s_waitcnt lgkmcnt(" #n ")" ::: "memory")
#define PG8_BAR __builtin_amdgcn_s_barrier()
#define PG8_SCHED __builtin_amdgcn_sched_barrier(0)
    Unit cur, nxt; int ui = 0;
    if (!S.next(0, cur)) return;
    f32x4 acc[2][2][4][2];
#pragma unroll
    for (int a = 0; a < 2; ++a)
#pragma unroll
        for (int b = 0; b < 2; ++b)
#pragma unroll
            for (int m = 0; m < 4; ++m)
#pragma unroll
                for (int n = 0; n < 2; ++n) acc[a][b][m][n] = (f32x4){0.f, 0.f, 0.f, 0.f};
    bf16x8 At[4][2], B0[2][2], B1[2][2];
    const char* cA = (const char*)g.A + (size_t)cur.pm * tstep; const char* cB = (const char*)g.Bt + (size_t)cur.pn * tstep;
    S.a_ready(cur);
    if constexpr (SP2) {
        PG8_STAGE(PG8_SB(0, 0), cB, voffB); PG8_STAGE(PG8_SB(0, 1), cB + hstep, voffB); PG8_STAGE(PG8_SA(0, 0), cA, voffA); PG8_STAGE(PG8_SA(0, 1), cA + hstep, voffA);
        if (wr == 1) PG8_BAR;
        PG8_WAIT_V(2); PG8_BAR;
        PG8_STAGE(PG8_SB(1, 0), cB + kstep, voffB); PG8_STAGE(PG8_SA(1, 0), cA + kstep, voffA); PG8_STAGE(PG8_SB(1, 1), cB + hstep + kstep, voffB);
        PG8_WAIT_V(6); PG8_BAR;
    } else {
        PG8_STAGE(PG8_SB(0, 0), cB, voffB); PG8_STAGE(PG8_SA(0, 0), cA, voffA); PG8_STAGE(PG8_SB(0, 1), cB + hstep, voffB); PG8_STAGE(PG8_SA(0, 1), cA + hstep, voffA);
        if (wr == 1) PG8_BAR;
        PG8_WAIT_V(4); PG8_BAR;
        PG8_STAGE(PG8_SB(1, 0), cB + kstep, voffB); PG8_STAGE(PG8_SA(1, 0), cA + kstep, voffA); PG8_STAGE(PG8_SB(1, 1), cB + hstep + kstep, voffB);
        PG8_WAIT_V(6); PG8_BAR;
    }
    for (;;) {
        const bool has_next = S.next(ui + 1, nxt);
        const char* nA = has_next ? (const char*)g.A + (size_t)nxt.pm * tstep : cA; const char* nB = has_next ? (const char*)g.Bt + (size_t)nxt.pn * tstep : cB;
        for (int t = 0; t < nt; t += 2) {
            const bool last = (t == nt - 2);
            const char* a1 = cA + (size_t)(t + 1) * kstep;
            const char* a2 = last ? nA : cA + (size_t)(t + 2) * kstep; const char* b2 = last ? nB : cB + (size_t)(t + 2) * kstep;
            const char* a3 = a2 + kstep; const char* b3 = b2 + kstep;
            if (last && has_next) S.a_ready(nxt);
            if constexpr (SP2) {
            PG8_LDB(B0, 0, 0); PG8_LDB(B1, 0, 1); PG8_SCHED; PG8_LDA(At, 0, 0); PG8_STAGE(PG8_SA(1, 1), a1 + hstep, voffA);
            PG8_WAIT_V(8); PG8_WAIT_L(0); PG8_BAR; PG8_MMA(0, 0, At, B0); PG8_MMA(0, 1, At, B1); PG8_BAR; PG8_SCHED;
            PG8_LDA(At, 0, 1); PG8_STAGE(PG8_SB(0, 0), b2, voffB); PG8_STAGE(PG8_SB(0, 1), b2 + hstep, voffB); PG8_STAGE(PG8_SA(0, 0), a2, voffA);
            PG8_WAIT_V(8); PG8_WAIT_L(0); PG8_BAR; PG8_MMA(1, 0, At, B0); PG8_MMA(1, 1, At, B1); PG8_BAR; PG8_SCHED;
            PG8_LDB(B0, 1, 0); PG8_LDB(B1, 1, 1); PG8_SCHED; PG8_LDA(At, 1, 0); PG8_STAGE(PG8_SA(0, 1), a2 + hstep, voffA);
            PG8_WAIT_V(8); PG8_WAIT_L(0); PG8_BAR; PG8_MMA(0, 0, At, B0); PG8_MMA(0, 1, At, B1); PG8_BAR; PG8_SCHED;
            PG8_LDA(At, 1, 1); PG8_STAGE(PG8_SB(1, 0), b3, voffB); PG8_STAGE(PG8_SB(1, 1), b3 + hstep, voffB); PG8_STAGE(PG8_SA(1, 0), a3, voffA);
            PG8_WAIT_V(8); PG8_WAIT_L(0); PG8_BAR; PG8_MMA(1, 0, At, B0); PG8_MMA(1, 1, At, B1); PG8_BAR; PG8_SCHED;
            } else {
            PG8_LDB(B0, 0, 0); PG8_SCHED; PG8_LDA(At, 0, 0); PG8_STAGE(PG8_SA(1, 1), a1 + hstep, voffA);
            PG8_WAIT_L(8); PG8_BAR; PG8_WAIT_L(0); PG8_MMA(0, 0, At, B0); PG8_BAR; PG8_SCHED;
            PG8_LDB(B1, 0, 1); PG8_STAGE(PG8_SB(0, 0), b2, voffB);
            PG8_BAR; PG8_WAIT_L(0); PG8_MMA(0, 1, At, B1); PG8_BAR;
            PG8_LDA(At, 0, 1); PG8_STAGE(PG8_SA(0, 0), a2, voffA);
            PG8_BAR; PG8_WAIT_L(0); PG8_MMA(1, 0, At, B0); PG8_BAR; PG8_SCHED;
            PG8_STAGE(PG8_SB(0, 1), b2 + hstep, voffB);
            PG8_WAIT_V(6); PG8_BAR; PG8_MMA(1, 1, At, B1); PG8_BAR;
            PG8_LDB(B0, 1, 0); PG8_SCHED; PG8_LDA(At, 1, 0); PG8_STAGE(PG8_SA(0, 1), a2 + hstep, voffA);
            PG8_WAIT_L(8); PG8_BAR; PG8_WAIT_L(0); PG8_MMA(0, 0, At, B0); PG8_BAR; PG8_SCHED;
            PG8_LDB(B1, 1, 1); PG8_STAGE(PG8_SB(1, 0), b3, voffB);
            PG8_BAR; PG8_WAIT_L(0); PG8_MMA(0, 1, At, B1); PG8_BAR;
            PG8_LDA(At, 1, 1); PG8_STAGE(PG8_SA(1, 0), a3, voffA);
            PG8_BAR; PG8_WAIT_L(0); PG8_MMA(1, 0, At, B0); PG8_BAR; PG8_SCHED;
            PG8_STAGE(PG8_SB(1, 1), b3 + hstep, voffB);
            PG8_WAIT_V(6); PG8_BAR; PG8_MMA(1, 1, At, B1); PG8_BAR;
            }
        }
        if constexpr (ALIGN_EPI) { if (wr == 0) PG8_BAR; }
        if constexpr (!Epi::AFTER_DRAIN) { E(acc, cur, wr, wc, fr, fq); S.done(cur); }
        if (!has_next) break;
#pragma unroll
        for (int a = 0; a < 2; ++a)
#pragma unroll
            for (int b = 0; b < 2; ++b)
#pragma unroll
                for (int m = 0; m < 4; ++m)
#pragma unroll
                    for (int n = 0; n < 2; ++n) acc[a][b][m][n] = (f32x4){0.f, 0.f, 0.f, 0.f};
        cur = nxt; cA = nA; cB = nB; ++ui;
        if constexpr (ALIGN_EPI) { if (wr == 1) PG8_BAR; }
    }
    PG8_WAIT_V(0);
    if constexpr (!ALIGN_EPI) { if (wr == 0) PG8_BAR; }
    PG8_BAR;
    if constexpr (Epi::AFTER_DRAIN) { E.fused(acc, cur, wr, wc, fr, fq, lds, wid, lane); S.done(cur); }
#undef PG8_SA
#undef PG8_SB
#undef PG8_STAGE
#undef PG8_LDA
#undef PG8_LDB
#undef PG8_MMA
#undef PG8_WAIT_V
#undef PG8_WAIT_L
#undef PG8_BAR
#undef PG8_SCHED
}
}

#ifndef PG8_SP2
#define PG8_SP2 true
#endif
#define PG8_ALIGN true
constexpr int NWAVES = 8;
constexpr int BATCH = 2, SEQ = 8192, DM = 1024, M = BATCH * SEQ, NIN = 3788, NINP = 3840, FFN = 2816, DEPTH = 2;
constexpr int A_Q = 0, A_K = 256, A_V = 512, A_O = 768;
constexpr int R_R = 1024, R_K = 1408, R_V = 1792, R_WDF = 2176, R_AD = 2304, R_GD = 2368;
constexpr int S_Z = 2496, S_X = 2880, S_B = 3264, S_C = 3520, S_DT = 3776;
constexpr size_t MiB = 1u << 20;
constexpr size_t WS_CTL = 0, CTL_ZERO_BYTES = 128 * 1024;
constexpr size_t WS_GATES = 1 * MiB, WS_CT = 2 * MiB, WS_DTV = 2 * MiB + 512 * 1024;
constexpr size_t WS_WIN = 4 * MiB, WS_WOUT = 12 * MiB, WS_WGU = 14 * MiB, WS_WDN = 25 * MiB;
constexpr size_t WS_XN = 32 * MiB, WS_COLS = 64 * MiB, WS_Y = 184 * MiB, WS_END = 256 * MiB;
constexpr size_t Y_AF = WS_Y, Y_AB = WS_Y + 8 * MiB, Y_RF = WS_Y + 16 * MiB, Y_RB = WS_Y + 28 * MiB, Y_SF = WS_Y + 40 * MiB, Y_SB = WS_Y + 52 * MiB;
constexpr int CW_BAR = 1024;
constexpr int RING_BYTES = 131072;
constexpr int LDS_BYTES = 147456, MISC_OFF = LDS_BYTES - 256;

#define GAS __attribute__((address_space(1)))
#define LAS __attribute__((address_space(3)))
typedef unsigned short bf16;
typedef unsigned v4u __attribute__((ext_vector_type(4)));
typedef unsigned v2u __attribute__((ext_vector_type(2)));
typedef float f32x4 __attribute__((ext_vector_type(4)));
typedef short bf16x8 __attribute__((ext_vector_type(8)));
typedef GAS unsigned gu32;
#define RLX_AGENT __ATOMIC_RELAXED, __HIP_MEMORY_SCOPE_AGENT
#define LDS_WAIT() asm volatile("s_waitcnt lgkmcnt(0)" ::: "memory")
#define VM_WAIT() asm volatile("s_waitcnt vmcnt(0)" ::: "memory")
__device__ __forceinline__ unsigned f2bf(float f) { unsigned u = __builtin_bit_cast(unsigned, f); return (u + 0x7fffu + ((u >> 16) & 1u)) >> 16; }
__device__ __forceinline__ unsigned pk2(float lo, float hi) { return f2bf(lo) | (f2bf(hi) << 16); }
__device__ __forceinline__ float bf2f(unsigned u) { return __builtin_bit_cast(float, u << 16); }
__device__ __forceinline__ float sigmoidf_(float x) { return __builtin_amdgcn_rcpf(1.f + __expf(-x)); }
__device__ __forceinline__ float siluf_(float x) { return x * sigmoidf_(x); }
__device__ __forceinline__ float wave_sum(float v) {
#pragma unroll
    for (int o = 1; o < 64; o <<= 1) v += __shfl_xor(v, o);
    return v;
}
__device__ __forceinline__ float wave_max(float v) {
#pragma unroll
    for (int o = 1; o < 64; o <<= 1) v = fmaxf(v, __shfl_xor(v, o));
    return v;
}
template <int CTRL> __device__ __forceinline__ float dppf(float v) { return __builtin_bit_cast(float, __builtin_amdgcn_update_dpp(0, __builtin_bit_cast(int, v), CTRL, 0xf, 0xf, true)); }
__device__ __forceinline__ float row16_sum(float v) { v += dppf<0xB1>(v); v += dppf<0x4E>(v); v += dppf<0x141>(v); v += dppf<0x140>(v); return v; }
template <int K> __device__ __forceinline__ f32x4 mma16(const LAS bf16* A, int lda, const LAS bf16* Bt, int ldb, f32x4 acc, int lane) {
    const int r = lane & 15, q = lane >> 4;
    const LAS bf16* ap = A + r * lda + q * 8; const LAS bf16* bp = Bt + r * ldb + q * 8;
#pragma unroll
    for (int k0 = 0; k0 < K; k0 += 32) {
        const bf16x8 a = *(const LAS bf16x8*)(ap + k0); const bf16x8 b = *(const LAS bf16x8*)(bp + k0);
        acc = __builtin_amdgcn_mfma_f32_16x16x32_bf16(a, b, acc, 0, 0, 0);
    }
    return acc;
}

__device__ __forceinline__ int swz64(int row, int col) { return col ^ (((row >> 3) & 7) << 3); }
template <bool SWA, bool SWB> __device__ __forceinline__ f32x4 mma16s(const LAS bf16* A, int lda, int rowA0, const LAS bf16* Bt, int ldb, int rowB0, f32x4 acc, int lane) {
    const int r = lane & 15, q = lane >> 4; const int ra = rowA0 + r, rb = rowB0 + r;
#pragma unroll
    for (int k0 = 0; k0 < 64; k0 += 32) { const int ca = k0 + 8 * q, cb = k0 + 8 * q;
        const bf16x8 a = *(const LAS bf16x8*)(A + ra * lda + (SWA ? swz64(ra, ca) : ca)); const bf16x8 b = *(const LAS bf16x8*)(Bt + rb * ldb + (SWB ? swz64(rb, cb) : cb));
        acc = __builtin_amdgcn_mfma_f32_16x16x32_bf16(a, b, acc, 0, 0, 0); }
    return acc;
}

template <int CTRL, int RM, int BM> __device__ __forceinline__ float dppm(float oldv, float v) { return __builtin_bit_cast(float, __builtin_amdgcn_update_dpp(__builtin_bit_cast(int, oldv), __builtin_bit_cast(int, v), CTRL, RM, BM, false)); }
__device__ __forceinline__ float wave_scan_add(float x) {
    float y = x + dppm<0x111, 0xf, 0xf>(0.f, x); y += dppm<0x112, 0xf, 0xf>(0.f, x); y += dppm<0x113, 0xf, 0xf>(0.f, x);
    y += dppm<0x114, 0xf, 0xe>(0.f, y); y += dppm<0x118, 0xf, 0xc>(0.f, y);
    y += dppm<0x142, 0xa, 0xf>(0.f, y); y += dppm<0x143, 0xc, 0xf>(0.f, y);
    return y;
}
__device__ __forceinline__ float wave_scan_max(float x) {
    const float ninf = -INFINITY;
    float y = fmaxf(x, dppm<0x111, 0xf, 0xf>(ninf, x)); y = fmaxf(y, dppm<0x112, 0xf, 0xf>(ninf, x)); y = fmaxf(y, dppm<0x113, 0xf, 0xf>(ninf, x));
    y = fmaxf(y, dppm<0x114, 0xf, 0xe>(ninf, y)); y = fmaxf(y, dppm<0x118, 0xf, 0xc>(ninf, y));
    y = fmaxf(y, dppm<0x142, 0xa, 0xf>(ninf, y)); y = fmaxf(y, dppm<0x143, 0xc, 0xf>(ninf, y));
    return y;
}
#define XB_TMO      128
#define XB_XCNT(j)  (256  + 64 * (j))
#define XB_XSUB(j)  (1280 + 64 * (j))
#define XB_XGEN(j)  (2304 + 64 * (j))
#define XB_TOP      3328
#define XB_TOPGEN   3392
#define XCD_BAR_WORDS 3456
#define XB_SPIN_CAP (1u << 18)

__device__ __forceinline__ unsigned xb_ld(unsigned* p)              { return __hip_atomic_load(p, __ATOMIC_RELAXED, __HIP_MEMORY_SCOPE_AGENT); }
__device__ __forceinline__ unsigned xb_add(unsigned* p, unsigned v) { return __hip_atomic_fetch_add(p, v, __ATOMIC_RELAXED, __HIP_MEMORY_SCOPE_AGENT); }
__device__ __forceinline__ unsigned xb_xcc_id() { return (unsigned)__builtin_amdgcn_s_getreg((3 << 11) | 20) & 0xFu; }
#define XB_SPIN(cond, bar) do { unsigned _sp = 0; while (cond) { __builtin_amdgcn_s_sleep(1); \
    if ((++_sp & 255u) == 0u) { if (xb_ld(&(bar)[XB_TMO])) break; if (_sp > XB_SPIN_CAP) { atomicAdd(&(bar)[XB_TMO], 1u); break; } } } } while (0)

struct XcdBarrier {
    unsigned* bar; unsigned x;
    volatile LAS unsigned* st;
};

__device__ __forceinline__ XcdBarrier xcd_barrier_post(unsigned* bar, volatile LAS unsigned* st) {
    XcdBarrier b; b.bar = bar; b.x = xb_xcc_id(); b.st = st;
    if (threadIdx.x == 0) (void)xb_add(&bar[XB_XCNT(b.x)], 1u);
    return b;
}
__device__ __forceinline__ void xcd_barrier_complete(unsigned* bar, unsigned x, unsigned& nloc, unsigned& nx) {
    const unsigned G = gridDim.x * gridDim.y * gridDim.z;
    unsigned sum, cnt, mine, sp = 0u;
    for (;;) {
        sum = 0u; cnt = 0u; mine = 0u;
#pragma unroll
        for (unsigned j = 0; j < 16; ++j) { const unsigned c = xb_ld(&bar[XB_XCNT(j)]); sum += c; cnt += (c > 0u) ? 1u : 0u; mine = (j == x) ? c : mine; }
        if (sum == G) break;
        __builtin_amdgcn_s_sleep(1);
        if ((++sp & 255u) == 0u) { if (xb_ld(&bar[XB_TMO])) break; if (sp > XB_SPIN_CAP) { atomicAdd(&bar[XB_TMO], 1u); break; } }
    }
    nloc = mine > 0u ? mine : 1u; nx = cnt > 0u ? cnt : 1u;
}

__device__ __forceinline__ void xcd_barrier(const XcdBarrier& b) {
    asm volatile("s_waitcnt vmcnt(0)" ::: "memory");
    __syncthreads();
    if (threadIdx.x == 0) {
        unsigned* bar = b.bar;
        __builtin_amdgcn_s_waitcnt(0);
        unsigned nloc = b.st[0], nx = b.st[1];
        if (nloc == 0u) { xcd_barrier_complete(bar, b.x, nloc, nx); b.st[0] = nloc; b.st[1] = nx; }
        const unsigned old = xb_add(&bar[XB_XSUB(b.x)], 1u);
        const unsigned gen = old / nloc;
        if (old + 1u == (gen + 1u) * nloc) {
            __builtin_amdgcn_fence(__ATOMIC_RELEASE, "agent");
            asm volatile("s_waitcnt vmcnt(0)" ::: "memory");
            const unsigned og = xb_add(&bar[XB_TOP], 1u);
            const unsigned tg = og / nx;
            if (og + 1u == (tg + 1u) * nx) xb_add(&bar[XB_TOPGEN], 1u);
            else XB_SPIN(xb_ld(&bar[XB_TOPGEN]) == tg, bar);
            __builtin_amdgcn_fence(__ATOMIC_ACQUIRE, "agent");
            xb_add(&bar[XB_XGEN(b.x)], 1u);
            asm volatile("s_waitcnt vmcnt(0)" ::: "memory");
        } else {
            XB_SPIN(xb_ld(&bar[XB_XGEN(b.x)]) == gen, bar);
            __builtin_amdgcn_fence(__ATOMIC_ACQUIRE, "agent");
            asm volatile("s_waitcnt vmcnt(0)" ::: "memory");
        }
    }
    __syncthreads();
}
struct Frame {
    LAS unsigned char* lds;
    int tid, lane, wave, vcu, G;
};
struct Args { const float* in[32]; float* out; unsigned char* ws; int ph_lo, ph_hi; };
constexpr int PTAB_OFF = LDS_BYTES - 768;
__device__ __forceinline__ unsigned long long ptab_ld(const Frame& F, int i) {
    const unsigned long long v = *(volatile LAS unsigned long long*)(F.lds + PTAB_OFF + 8 * i);
    const unsigned lo = __builtin_amdgcn_readfirstlane((unsigned)v), hi = __builtin_amdgcn_readfirstlane((unsigned)(v >> 32));
    return ((unsigned long long)hi << 32) | lo;
}
__device__ __forceinline__ const float* INP(const Frame& F, int i) { return (const float*)ptab_ld(F, i); }
__device__ __forceinline__ unsigned char* WSP(const Frame& F) { return (unsigned char*)ptab_ld(F, 33); }
__device__ __forceinline__ float* OUTP(const Frame& F) { return (float*)ptab_ld(F, 32); }

__device__ __forceinline__ void transpose_item(const float* W, int K, int N, int nblk, bf16* WT, int mode, int row_off, LAS float* scr, int item, int lane) {
    const int kb = item / nblk, nb = item % nblk, k0 = 64 * kb, n0 = 32 * nb;
    const int ncol = n0 + (lane & 31); const bool ok = ncol < N;
#pragma unroll 8
    for (int i = 0; i < 32; ++i) { const int kk = 2 * i + (lane >> 5); scr[kk * 33 + (lane & 31)] = ok ? W[(size_t)(k0 + kk) * N + ncol] : 0.f; }
    LDS_WAIT(); asm volatile("" ::: "memory");
    const int c = lane & 7;
    const int drow0 = mode ? (256 * (n0 >> 7) + (n0 & 127) + row_off) : (row_off + n0);
#pragma unroll
    for (int j = 0; j < 4; ++j) { const int n = (lane >> 3) + 8 * j; const LAS float* s = scr + (8 * c) * 33 + n;
        v4u o; o.x = pk2(s[0 * 33], s[1 * 33]); o.y = pk2(s[2 * 33], s[3 * 33]); o.z = pk2(s[4 * 33], s[5 * 33]); o.w = pk2(s[6 * 33], s[7 * 33]);
        *(v4u*)(WT + (size_t)(drow0 + n) * K + k0 + 8 * c) = o; }
    LDS_WAIT(); asm volatile("" ::: "memory");
}
__device__ __forceinline__ void phase_convert(const Frame& F, int l) {
    LAS float* scr = (LAS float*)(F.lds + F.wave * 16384);
    const int gw = F.vcu * NWAVES + F.wave, NGW = F.G * NWAVES;
    bf16* Win = (bf16*)(WSP(F) + WS_WIN); bf16* Wout = (bf16*)(WSP(F) + WS_WOUT); bf16* Wgu = (bf16*)(WSP(F) + WS_WGU); bf16* Wdn = (bf16*)(WSP(F) + WS_WDN);
    constexpr int I_IN = 16 * 120, I_OUT = 16 * 32, I_G = 16 * 88, I_D = 44 * 32;
    constexpr int NITEMS = I_IN + I_OUT + 2 * I_G + I_D;
    for (int it = gw; it < NITEMS; it += NGW) {
        int r = it;
        if (r < I_IN) { transpose_item(INP(F, 2) + (size_t)l * DM * NIN, DM, NIN, 120, Win, 0, 0, scr, r, F.lane); continue; } r -= I_IN;
        if (r < I_OUT) { transpose_item(INP(F, 26) + (size_t)l * DM * DM, DM, DM, 32, Wout, 0, 0, scr, r, F.lane); continue; } r -= I_OUT;
        if (r < I_G) { transpose_item(INP(F, 28) + (size_t)l * DM * FFN, DM, FFN, 88, Wgu, 1, 0, scr, r, F.lane); continue; } r -= I_G;
        if (r < I_G) { transpose_item(INP(F, 29) + (size_t)l * DM * FFN, DM, FFN, 88, Wgu, 1, 128, scr, r, F.lane); continue; } r -= I_G;
        transpose_item(INP(F, 30) + (size_t)l * FFN * DM, FFN, DM, 32, Wdn, 0, 0, scr, r, F.lane);
    }
}
__device__ __forceinline__ void phase_norm(const Frame& F, const float* hin, const float* g, bf16* XN) {
    const int gw = F.vcu * NWAVES + F.wave, NGW = F.G * NWAVES;
    f32x4 gv[4];
#pragma unroll
    for (int j = 0; j < 4; ++j) gv[j] = ((const f32x4*)g)[64 * j + F.lane];
    for (int m = gw; m < M; m += NGW) {
        const f32x4* xr = (const f32x4*)(hin + (size_t)m * DM) + F.lane;
        f32x4 v[4]; float s = 0.f;
#pragma unroll
        for (int j = 0; j < 4; ++j) { v[j] = xr[64 * j]; s += (v[j].x * v[j].x + v[j].y * v[j].y) + (v[j].z * v[j].z + v[j].w * v[j].w); }
        const float r = 1.f / sqrtf(wave_sum(s) * (1.f / DM) + 1e-6f);
        v2u* o8 = (v2u*)(XN + (size_t)m * DM) + F.lane;
#pragma unroll
        for (int j = 0; j < 4; ++j) { v2u w; w.x = pk2(v[j].x * r * gv[j].x, v[j].y * r * gv[j].y); w.y = pk2(v[j].z * r * gv[j].z, v[j].w * r * gv[j].w); o8[64 * j] = w; }
    }
}
__device__ __forceinline__ void phase_final_norm(const Frame& F, float* h, const float* g) {
    const int gw = F.vcu * NWAVES + F.wave, NGW = F.G * NWAVES;
    f32x4 gv[4];
#pragma unroll
    for (int j = 0; j < 4; ++j) gv[j] = ((const f32x4*)g)[64 * j + F.lane];
    for (int m = gw; m < M; m += NGW) {
        f32x4* xr = (f32x4*)(h + (size_t)m * DM) + F.lane;
        f32x4 v[4]; float s = 0.f;
#pragma unroll
        for (int j = 0; j < 4; ++j) { v[j] = xr[64 * j]; s += (v[j].x * v[j].x + v[j].y * v[j].y) + (v[j].z * v[j].z + v[j].w * v[j].w); }
        const float r = 1.f / sqrtf(wave_sum(s) * (1.f / DM) + 1e-6f);
#pragma unroll
        for (int j = 0; j < 4; ++j) xr[64 * j] = v[j] * r * gv[j];
    }
}
__device__ __forceinline__ void phase_gates(const Frame& F, int l) {
    const bf16* cols = (const bf16*)(WSP(F) + WS_COLS); float* GT = (float*)(WSP(F) + WS_GATES);
    LAS bf16* raw = (LAS bf16*)(F.lds);
    LAS bf16* featb = (LAS bf16*)(F.lds + 30720);
    LAS bf16* gwT = (LAS bf16*)(F.lds + 55552);
    LAS float* outp = (LAS float*)(F.lds + 80384);
    const float* gwg = INP(F, 5) + (size_t)l * 768 * 16; const float* gb = INP(F, 6) + l * 16;
    const int tid = F.tid, lane = F.lane, wave = F.wave;
    __syncthreads();
    for (int i = tid; i < 768 * 16; i += 512) gwT[(i & 15) * 776 + (i >> 4)] = (bf16)f2bf(gwg[i]);
    float cw[5]; { const float* cwp = INP(F, 3) + (size_t)l * 5 * 512;
#pragma unroll
        for (int j = 0; j < 5; ++j) cw[j] = cwp[j * 512 + tid]; }
    const float cbv = INP(F, 4)[l * 512 + tid];
    const float gbv = gb[tid & 15];
    for (int tile = F.vcu; tile < M / 16; tile += F.G) {
        const int m0 = tile * 16, t0 = m0 % SEQ;
        __syncthreads();
        for (int ch = tid; ch < 20 * 96; ch += 512) { const int rr = ch / 96, cc = ch % 96; const int t = t0 - 2 + rr;
            v4u v = {0u, 0u, 0u, 0u}; if (t >= 0 && t < SEQ) v = *(const v4u*)(cols + (size_t)(m0 - 2 + rr) * NINP + cc * 8);
            *(LAS v4u*)(raw + rr * 768 + cc * 8) = v; }
        if (tid < 256) outp[tid] = 0.f;
        __syncthreads();
        { float win[5];
#pragma unroll
          for (int j = 0; j < 4; ++j) win[j] = bf2f(raw[j * 768 + tid]);
#pragma unroll 4
          for (int t = 0; t < 16; ++t) { win[4] = bf2f(raw[(t + 4) * 768 + tid]); float s = cbv;
#pragma unroll
              for (int j = 0; j < 5; ++j) s += cw[j] * win[j];
#pragma unroll
              for (int j = 0; j < 4; ++j) win[j] = win[j + 1];
              featb[t * 776 + tid] = (bf16)f2bf(siluf_(s)); }
          const int t = tid >> 5, c8 = tid & 31; *(LAS v4u*)(featb + t * 776 + 512 + c8 * 8) = *(const LAS v4u*)(raw + (t + 2) * 768 + 512 + c8 * 8); }
        __syncthreads();
        { const f32x4 z = {0.f, 0.f, 0.f, 0.f}; const f32x4 acc = mma16<96>(featb + 96 * wave, 776, gwT + 96 * wave, 776, z, lane);
#pragma unroll
          for (int jj = 0; jj < 4; ++jj) __hip_atomic_fetch_add(outp + ((lane >> 4) * 4 + jj) * 16 + (lane & 15), acc[jj], __ATOMIC_RELAXED, __HIP_MEMORY_SCOPE_WORKGROUP); }
        __syncthreads();
        if (tid < 256) { float s = outp[tid] + gbv; if ((tid & 15) >= 8) s = fminf(s, 0.f) - log1pf(__expf(-fabsf(s))); GT[(size_t)(m0 + (tid >> 4)) * 16 + (tid & 15)] = s; }
    }
    __syncthreads();
}
__device__ __forceinline__ f32x4 mma16_a8(const LAS bf16* A8, const LAS bf16* Bt, f32x4 acc, int lane) {
    const int q = lane >> 4;
    const LAS bf16* ap = A8 + (lane & 7) * 72 + q * 8; const LAS bf16* bp = Bt + (lane & 15) * 72 + q * 8;
#pragma unroll
    for (int k0 = 0; k0 < 64; k0 += 32) { const bf16x8 a = *(const LAS bf16x8*)(ap + k0); const bf16x8 b = *(const LAS bf16x8*)(bp + k0); acc = __builtin_amdgcn_mfma_f32_16x16x32_bf16(a, b, acc, 0, 0, 0); }
    return acc;
}
typedef float f32x2 __attribute__((ext_vector_type(2)));
template <bool DIR> __device__ __forceinline__ void rwkv_steps(const LAS float* OPS, const LAS float* VV, LAS float* YB, f32x4& S, int j, int row) {
    float yk0 = 0.f, yk1 = 0.f;
    const LAS float* opb = OPS + 4 * j; const LAS float* vpb = VV + row;
#define RWLD(W_, KK_, KA_, KM_, R_, V_, tl_) do { const LAS float* op_ = opb + (tl_) * 320; W_ = *(const LAS f32x4*)(op_); KK_ = *(const LAS f32x4*)(op_ + 64); KA_ = *(const LAS f32x4*)(op_ + 128); KM_ = *(const LAS f32x4*)(op_ + 192); R_ = *(const LAS f32x4*)(op_ + 256); V_ = vpb[(tl_) * 16]; } while (0)
    f32x4 w4, kk4, ka4, km4, r4, w4b, kk4b, ka4b, km4b, r4b; float vv, vvb;
    RWLD(w4, kk4, ka4, km4, r4, vv, (DIR ? 31 : 0));
    RWLD(w4b, kk4b, ka4b, km4b, r4b, vvb, (DIR ? 30 : 1));
#pragma unroll
    for (int i = 0; i < 32; ++i) {
        f32x4 nw4, nkk4, nka4, nkm4, nr4; float nvv;
        if (i < 30) RWLD(nw4, nkk4, nka4, nkm4, nr4, nvv, (DIR ? 29 - i : i + 2));
        f32x2 t2 = S.xy * kk4.xy; t2 = S.zw * kk4.zw + t2;
        float sa = t2.x + t2.y;
        const f32x4 pre_s = S * w4 + km4 * vv;
        sa = row16_sum(sa);
        S = pre_s + ka4 * sa;
        f32x2 y2 = S.xy * r4.xy; y2 = S.zw * r4.zw + y2;
        float y = y2.x + y2.y;
        y = row16_sum(y);
        if ((i & 15) == j) { if (i < 16) yk0 = y; else yk1 = y; }
        w4 = w4b; kk4 = kk4b; ka4 = ka4b; km4 = km4b; r4 = r4b; vv = vvb;
        if (i < 30) { w4b = nw4; kk4b = nkk4; ka4b = nka4; km4b = nkm4; r4b = nr4; vvb = nvv; } }
#undef RWLD
    YB[(DIR ? 31 - j : j) * 16 + row] = yk0; YB[(DIR ? 15 - j : 16 + j) * 16 + row] = yk1;
}
struct RwCtx { LAS bf16* WA; LAS bf16* WW; LAS bf16* XA; LAS bf16* XW; LAS bf16* RAWB; LAS float* MU; float* CT; const bf16* colsb;
    f32x4 kk_c4, ka_c4, rk_c4; float ba[4], bw[4]; float mup_[5][2], mun_[5][2]; int h, dir, qtr, tb0; size_t mb; };
template <int NTOK> __device__ __forceinline__ void rw_addr_init(int (&poff)[5], int (&prr)[5], int lane, int tb0, int h, int dir) {
    constexpr int NCHK = (NTOK + 2) * 40;
#pragma unroll
    for (int i = 0; i < 5; ++i) { const int idx = lane + 64 * i; const int rr = idx / 40, q = idx % 40, wh = q >> 3, c8 = q & 7;
        const int gc = (wh == 0 ? R_R + h * 64 : wh == 1 ? R_K + h * 64 : wh == 2 ? R_V + h * 64 : wh == 3 ? R_WDF + dir * 64 : R_AD) + c8 * 8;
        prr[i] = idx < NCHK ? tb0 - 1 + rr : -100000; poff[i] = (tb0 - 1 + rr) * NINP + gc; }
}
template <int NTOK> __device__ __forceinline__ void rw_issue(v4u (&pre)[5], const int (&poff)[5], const int (&prr)[5], const bf16* colsb, int T0) {
    constexpr int NCH = ((NTOK + 2) * 40 + 63) / 64;
#pragma unroll
    for (int i = 0; i < NCH; ++i) { pre[i] = (v4u){0u, 0u, 0u, 0u}; const int t = T0 + prr[i]; if (t >= 0 && t < SEQ) pre[i] = *(const v4u*)(colsb + (size_t)T0 * NINP + poff[i]); }
}
template <int NTOK, bool FULLV> __device__ __forceinline__ void rw_prep(const RwCtx& C, const v4u (&pre)[5], LAS float* OPS, LAS float* VV, int T0, int lane) {
    constexpr int NCHK = (NTOK + 2) * 40, NCH = (NCHK + 63) / 64;
    const int j = lane & 15, c2 = (lane & 31) * 2;
#pragma unroll
    for (int i = 0; i < NCH; ++i) { const int idx = lane + 64 * i; if (idx < NCHK) *(LAS v4u*)(C.RAWB + idx * 8) = pre[i]; }
    LDS_WAIT(); asm volatile("" ::: "memory");
#pragma unroll
    for (int which = 0; which < 5; ++which)
#pragma unroll
        for (int pr = 0; pr < NTOK / 2; ++pr) { const int tt = 2 * pr + (lane >> 5), cc = which * 64 + c2, t = C.tb0 + tt;
            const unsigned r0 = *(const LAS unsigned*)(C.RAWB + tt * 320 + cc), r1 = *(const LAS unsigned*)(C.RAWB + (tt + 1) * 320 + cc), r2 = *(const LAS unsigned*)(C.RAWB + (tt + 2) * 320 + cc);
            const float p1x = bf2f(r1 & 0xffffu), p1y = bf2f(r1 >> 16);
            const float vx = p1x + C.mup_[which][0] * (bf2f(r0 & 0xffffu) - p1x) + C.mun_[which][0] * (bf2f(r2 & 0xffffu) - p1x);
            const float vy = p1y + C.mup_[which][1] * (bf2f(r0 >> 16) - p1y) + C.mun_[which][1] * (bf2f(r2 >> 16) - p1y);
            if (which == 0) *(LAS f32x2*)(OPS + t * 320 + 256 + c2) = (f32x2){vx, vy};
            else if (which == 1) *(LAS f32x2*)(OPS + t * 320 + 192 + c2) = (f32x2){vx, vy};
            else if (which == 2) { if (FULLV) *(LAS f32x2*)(VV + t * 64 + c2) = (f32x2){vx, vy}; else if ((c2 >> 4) == C.qtr) *(LAS f32x2*)(VV + t * 16 + (c2 & 15)) = (f32x2){vx, vy}; }
            else if (which == 3) { const float ex = __expf(2.f * vx), ey = __expf(2.f * vy);
                *(LAS unsigned*)(C.XW + tt * 72 + c2) = pk2(1.f - 2.f * __builtin_amdgcn_rcpf(ex + 1.f), 1.f - 2.f * __builtin_amdgcn_rcpf(ey + 1.f)); }
            else *(LAS unsigned*)(C.XA + tt * 72 + c2) = pk2(vx, vy); }
    LDS_WAIT(); asm volatile("" ::: "memory");
    { const bool hi = lane >= 32; const int lr = ((lane >> 4) & 1) * 4 + (hi ? 2 : 0); const bool ok0 = lr < NTOK, ok1 = lr + 1 < NTOK; const int tb = C.tb0 + lr;
#pragma unroll
      for (int ct = 0; ct < 4; ++ct) { const f32x4 z = {0.f, 0.f, 0.f, 0.f};
        const f32x4 ca = mma16_a8(C.XA, C.WA + ct * 16 * 72, z, lane), cw = mma16_a8(C.XW, C.WW + ct * 16 * 72, z, lane);
        const int c = ct * 16 + j;
        const float a0v = hi ? ca[2] : ca[0], a1v = hi ? ca[3] : ca[1], w0v = hi ? cw[2] : cw[0], w1v = hi ? cw[3] : cw[1];
        if (ok0) { OPS[tb * 320 + 128 + c] = sigmoidf_(C.ba[ct] + a0v); OPS[tb * 320 + c] = __expf(-0.6065306597f * sigmoidf_(C.bw[ct] + w0v)); }
        if (ok1) { OPS[(tb + 1) * 320 + 128 + c] = sigmoidf_(C.ba[ct] + a1v); OPS[(tb + 1) * 320 + c] = __expf(-0.6065306597f * sigmoidf_(C.bw[ct] + w1v)); } } }
    LDS_WAIT(); asm volatile("" ::: "memory");
#pragma unroll
    for (int ps = 0; ps < (NTOK + 3) / 4; ++ps) { const int tl = 4 * ps + (lane >> 4); const bool ok = tl < NTOK; const int t = C.tb0 + (ok ? tl : 0); LAS float* op = OPS + t * 320 + 4 * j;
        const f32x4 av = *(const LAS f32x4*)(op + 128), kp = *(const LAS f32x4*)(op + 192), rp = *(const LAS f32x4*)(op + 256);
        const f32x4 kr = kp * C.kk_c4; const float ss = row16_sum((kr.x * kr.x + kr.y * kr.y) + (kr.z * kr.z + kr.w * kr.w));
        const f32x4 kkv = kr * (1.f / fmaxf(sqrtf(ss), 1e-12f));
        const f32x4 km = kp * ((av - 1.f) * C.ka_c4 + 1.f);
        const f32x4 q = rp * km * C.rk_c4; const float cs = row16_sum((q.x + q.y) + (q.z + q.w));
        if (ok) { *(LAS f32x4*)(op + 64) = kkv; *(LAS f32x4*)(op + 128) = kkv * (-av); *(LAS f32x4*)(op + 192) = km;
            if (C.dir == 0 && C.qtr == 0 && j == 0) C.CT[(C.mb + T0 + t) * 8 + C.h] = cs; } }
}

constexpr int RW_NSLOT = 6, RW_SLOT_WORDS = 32 * 320 + 32 * 64;
constexpr size_t WS_RING = 248 * MiB;
constexpr int CW_RW = 8192;
__device__ __forceinline__ unsigned rw_ld(unsigned* p) { return __hip_atomic_load(p, __ATOMIC_RELAXED, __HIP_MEMORY_SCOPE_AGENT); }
__device__ __forceinline__ void rw_st(unsigned* p, unsigned v) { __hip_atomic_store(p, v, __ATOMIC_RELAXED, __HIP_MEMORY_SCOPE_AGENT); }
__device__ __forceinline__ void rwkv_produce(const Frame& F, int l, int p, int pp, unsigned G0) {
    const int b = p / 12, rem = p % 12, h = rem >> 1, dir = rem & 1;
    const bf16* cols = (const bf16*)(WSP(F) + WS_COLS);
    const int tid = F.tid, lane = F.lane, wave = F.wave;
    LAS bf16* WA = (LAS bf16*)(F.lds); LAS bf16* WW = (LAS bf16*)(F.lds + 9216);
    LAS float* MU = (LAS float*)(F.lds + 67584);
    LAS float* OPS = (LAS float*)(F.lds + 70144);
    LAS float* VV = (LAS float*)(F.lds + 111104);
    LAS unsigned* flg = (LAS unsigned*)(F.lds + 119296);
    unsigned* ctl = (unsigned*)(WSP(F) + WS_CTL) + CW_RW + 384 * p;
    unsigned long long* ring = (unsigned long long*)(WSP(F) + WS_RING) + (size_t)p * RW_NSLOT * (RW_SLOT_WORDS / 2);
    constexpr int NB = SEQ / 32;
    __syncthreads();
    { const float* aup = INP(F, 13) + (size_t)l * 64 * 384; const float* wup = INP(F, 11) + (size_t)(l * 2 + dir) * 64 * 384;
      for (int idx = tid; idx < 4096; idx += 512) { const int i = idx >> 6, c = idx & 63;
          WA[c * 72 + i] = (bf16)f2bf(aup[i * 384 + h * 64 + c]); WW[c * 72 + i] = (bf16)f2bf(wup[i * 384 + h * 64 + c]); }
      if (tid < 320) { const int which = tid >> 6, c = tid & 63;
          const int rc = which == 0 ? h * 64 + c : which == 1 ? 384 + h * 64 + c : which == 2 ? 768 + h * 64 + c : which == 3 ? 1152 + dir * 64 + c : 1280 + c;
          MU[tid] = INP(F, 8)[l * 1472 + rc]; MU[320 + tid] = INP(F, 9)[l * 1472 + rc]; } }
    __syncthreads();
    const size_t mb = (size_t)b * SEQ;
    const int j = lane & 15;
    RwCtx C;
    C.WA = WA; C.WW = WW; C.XA = (LAS bf16*)(F.lds + 18432) + wave * 576; C.XW = (LAS bf16*)(F.lds + 27648) + wave * 576;
    C.RAWB = (LAS bf16*)(F.lds + 36864) + wave * 1920;
    C.MU = MU; C.CT = (float*)(WSP(F) + WS_CT); C.colsb = cols + mb * NINP; C.h = h; C.dir = dir; C.qtr = 0; C.mb = mb; C.tb0 = 4 * wave;
    { const int hc4 = h * 64 + 4 * j;
      C.kk_c4 = *(const f32x4*)(INP(F, 15) + l * 384 + hc4); C.ka_c4 = *(const f32x4*)(INP(F, 16) + l * 384 + hc4); C.rk_c4 = *(const f32x4*)(INP(F, 17) + l * 384 + hc4);
#pragma unroll
      for (int ct = 0; ct < 4; ++ct) { C.ba[ct] = INP(F, 12)[l * 384 + h * 64 + 16 * ct + j]; C.bw[ct] = INP(F, 10)[(l * 2 + dir) * 384 + h * 64 + 16 * ct + j]; }
      const int c2 = (lane & 31) * 2;
#pragma unroll
      for (int wq = 0; wq < 5; ++wq) { C.mup_[wq][0] = MU[wq * 64 + c2]; C.mup_[wq][1] = MU[wq * 64 + c2 + 1]; C.mun_[wq][0] = MU[320 + wq * 64 + c2]; C.mun_[wq][1] = MU[320 + wq * 64 + c2 + 1]; } }
    v4u pre[5]; int poff[5], prr[5];
    rw_addr_init<4>(poff, prr, lane, C.tb0, h, dir);
    rw_issue<4>(pre, poff, prr, C.colsb, dir ? SEQ - 32 * (pp + 1) : 32 * pp);
    bool dead = false; unsigned mseen = G0;
    unsigned* myflag = ctl + 320 * pp; const unsigned PB = G0 / 2;
#pragma unroll 1
    for (int it = pp; it < NB; it += 2) {
        const int T0 = dir ? SEQ - 32 * (it + 1) : 32 * it;
        v4u cur[5];
#pragma unroll
        for (int i = 0; i < 5; ++i) cur[i] = pre[i];
        if (it + 2 < NB) rw_issue<4>(pre, poff, prr, C.colsb, dir ? SEQ - 32 * (it + 3) : 32 * (it + 2));
        rw_prep<4, true>(C, cur, OPS, VV, T0, lane);
        if (tid == 0) { const unsigned need = G0 + (unsigned)it + 1u; unsigned sp = 0u;
            if (need > (unsigned)RW_NSLOT && !dead) { const unsigned want = need - (unsigned)RW_NSLOT;
                while (mseen < want) { if (++sp > (1u << 17)) { dead = true; break; } __builtin_amdgcn_s_sleep(2);
                    const unsigned m01 = min(rw_ld(ctl + 64), rw_ld(ctl + 128)), m23 = min(rw_ld(ctl + 192), rw_ld(ctl + 256)); mseen = min(m01, m23); } }
            flg[0] = sp; }
        __syncthreads();
        { unsigned long long* slot = ring + (size_t)((G0 + (unsigned)it) % RW_NSLOT) * (RW_SLOT_WORDS / 2);
          const LAS v4u* src = (const LAS v4u*)OPS;
#pragma unroll
          for (int i = 0; i < 6; ++i) { const int idx = tid + 512 * i; const v4u d = src[idx]; v4u* dst = (v4u*)slot + idx;
              asm volatile("global_store_dwordx4 %0, %1, off sc1\n\ts_nop 1" :: "v"(dst), "v"(d) : "memory"); } }
        asm volatile("s_waitcnt vmcnt(6)" ::: "memory");
        __syncthreads();
        if (tid == 0 && it >= 2) rw_st(myflag, PB + (unsigned)(it >> 1));
    }
    asm volatile("s_waitcnt vmcnt(0)" ::: "memory");
    __syncthreads();
    if (tid == 0) rw_st(myflag, PB + (unsigned)(NB / 2));
    __syncthreads();
}
__device__ __forceinline__ void rwkv_scan(const Frame& F, int l, int p, int qtr, unsigned G0) {
    const int b = p / 12, rem = p % 12, h = rem >> 1, dir = rem & 1;
    bf16* Y = (bf16*)(WSP(F) + (dir ? Y_RB : Y_RF));
    const int lane = F.lane, wave = F.wave;
    LAS float* OPSb = (LAS float*)(F.lds);
    LAS float* VVb = (LAS float*)(F.lds + 81920);
    LAS float* YBb = (LAS float*)(F.lds + 86016);
    unsigned* ctl = (unsigned*)(WSP(F) + WS_CTL) + CW_RW + 384 * p;
    const unsigned long long* ring = (const unsigned long long*)(WSP(F) + WS_RING) + (size_t)p * RW_NSLOT * (RW_SLOT_WORDS / 2);
    constexpr int NB = SEQ / 32;
    const size_t mb = (size_t)b * SEQ;
    const int j = lane & 15;
    __syncthreads();
    if (wave < 4) {
        const int lt = wave * 64 + lane;
        bool dead = false; unsigned pseen0 = G0 / 2, pseen1 = G0 / 2;
        unsigned long long v[21];
#define RW_FETCH(k_) do { const unsigned need_ = G0 / 2 + (unsigned)((k_) >> 1) + 1u; unsigned sp_ = 0u; unsigned* fl_ = ctl + 320 * ((k_) & 1); \
            if (!dead) { unsigned ps_ = ((k_) & 1) ? pseen1 : pseen0; while (ps_ < need_) { ps_ = rw_ld(fl_); if (ps_ >= need_) break; if (++sp_ > (1u << 17)) { dead = true; break; } __builtin_amdgcn_s_sleep(2); } if ((k_) & 1) pseen1 = ps_; else pseen0 = ps_; } \
            const unsigned long long* slot_ = ring + (size_t)((G0 + (unsigned)(k_)) % RW_NSLOT) * (RW_SLOT_WORDS / 2); \
            _Pragma("unroll") for (int i_ = 0; i_ < 20; ++i_) v[i_] = __hip_atomic_load(slot_ + lt + 256 * i_, __ATOMIC_RELAXED, __HIP_MEMORY_SCOPE_AGENT); \
            v[20] = __hip_atomic_load(slot_ + 5120 + (lt >> 3) * 32 + qtr * 8 + (lt & 7), __ATOMIC_RELAXED, __HIP_MEMORY_SCOPE_AGENT); } while (0)
        RW_FETCH(0);
#pragma unroll 1
        for (int it = 0; it <= NB; ++it) {
            if (it >= 1 && lt == 0) rw_st(ctl + 64 * (qtr + 1), G0 + (unsigned)it);
            if (it < NB) {
                LAS unsigned long long* dO = (LAS unsigned long long*)(OPSb + (it & 1) * 10240); LAS unsigned long long* dV = (LAS unsigned long long*)(VVb + (it & 1) * 512);
#pragma unroll
                for (int i = 0; i < 20; ++i) dO[lt + 256 * i] = v[i];
                dV[lt] = v[20];
                if (it + 1 < NB) RW_FETCH(it + 1);
            }
            if (it >= 2) { const int bk = it - 2; const int T0 = dir ? SEQ - 32 * (bk + 1) : 32 * bk; const LAS float* YB = YBb + (bk & 1) * 512;
                const int idx = lt * 2, tl = idx >> 4, rw = idx & 15;
                *(unsigned*)(Y + (mb + T0 + tl) * 384 + h * 64 + 16 * qtr + rw) = pk2(YB[idx], YB[idx + 1]); }
            __syncthreads();
        }
#undef RW_FETCH
        { const int bk = NB - 1; const int T0 = dir ? SEQ - 32 * (bk + 1) : 32 * bk; const LAS float* YB = YBb + (bk & 1) * 512;
          const int idx = lt * 2, tl = idx >> 4, rw = idx & 15;
          *(unsigned*)(Y + (mb + T0 + tl) * 384 + h * 64 + 16 * qtr + rw) = pk2(YB[idx], YB[idx + 1]); }
    } else {
        const int row = (wave - 4) * 4 + (lane >> 4);
        f32x4 S = {0.f, 0.f, 0.f, 0.f};
#pragma unroll 1
        for (int it = 0; it <= NB; ++it) {
            if (it >= 1) { const int bk = it - 1;
                const LAS float* OPS = OPSb + (bk & 1) * 10240; const LAS float* VV = VVb + (bk & 1) * 512; LAS float* YB = YBb + (bk & 1) * 512;
                if (dir) rwkv_steps<true>(OPS, VV, YB, S, j, row); else rwkv_steps<false>(OPS, VV, YB, S, j, row);
            }
            __syncthreads();
        }
    }
    __syncthreads();
}
__device__ __forceinline__ float row8_sum(float v) { v += dppf<0xB1>(v); v += dppf<0x4E>(v); v += dppf<0x141>(v); return v; }
__device__ __forceinline__ void mlstm_seq(const Frame& F, int l, int task, int cfull0, int cend) {
    const int b = task >> 3, h = (task >> 1) & 3, dir = task & 1;
    const bf16* cols = (const bf16*)(WSP(F) + WS_COLS); const float* GT = (const float*)(WSP(F) + WS_GATES);
    bf16* Y = (bf16*)(WSP(F) + (dir ? Y_AB : Y_AF));
    LAS bf16* RAWQ = (LAS bf16*)(F.lds);
    LAS bf16* Qs = (LAS bf16*)(F.lds + 17408); LAS bf16* Ks = (LAS bf16*)(F.lds + 26624);
    LAS bf16* Vtb = (LAS bf16*)(F.lds + 35840);
    LAS bf16* KWt = (LAS bf16*)(F.lds + 54272); LAS bf16* Ps = (LAS bf16*)(F.lds + 63488);
    LAS bf16* Ctb = (LAS bf16*)(F.lds + 72704);
    LAS float* ub = (LAS float*)(F.lds + 91136);
    LAS float* blb = ub + 128; LAS float* rmb = ub + 256;
    LAS float* den = ub + 384; LAS float* qn = ub + 448; LAS float* nst = ub + 512; LAS float* scb = ub + 576;
    const int tid = F.tid, lane = F.lane, wave = F.wave;
    const size_t mb = (size_t)b * SEQ;
    constexpr int NC = SEQ / 64;
    __syncthreads();
    for (int i = tid; i < 2 * 64 * 72; i += 512) Ctb[i] = 0;
    if (tid < 64) nst[tid] = 0.f;
    const int cc = tid & 127, isK = cc >> 6, d0 = cc & 63, chn = isK * 256 + h * 64 + d0;
    float cw[5]; const float* cwp = INP(F, 3) + (size_t)l * 5 * 512;
#pragma unroll
    for (int jj = 0; jj < 5; ++jj) cw[jj] = cwp[jj * 512 + chn];
    const float cbv = INP(F, 4)[l * 512 + chn];
    f32x4 st[2] = {{0.f, 0.f, 0.f, 0.f}, {0.f, 0.f, 0.f, 0.f}};
    float m_st = 0.f;
    v4u pre[3], prev; float gli = 0.f, glf = 0.f;
#define ML_ISSUE(c_) do { const int tlo_ = dir ? SEQ - 64 * ((c_) + 1) : 64 * (c_); _Pragma("unroll") for (int i_ = 0; i_ < 3; ++i_) { const int ch_ = tid + 512 * i_; pre[i_] = (v4u){0u, 0u, 0u, 0u}; \
        if (ch_ < 68 * 16) { const int rr_ = ch_ >> 4, q_ = ch_ & 15; const int t_ = tlo_ - 2 + rr_; if (t_ >= 0 && t_ < SEQ) pre[i_] = *(const v4u*)(cols + (mb + t_) * NINP + (q_ >> 3) * 256 + h * 64 + (q_ & 7) * 8); } } \
        prev = *(const v4u*)(cols + (mb + tlo_ + (tid >> 3)) * NINP + A_V + h * 64 + (tid & 7) * 8); \
        if (tid < 64) { const int t_ = dir ? tlo_ + 63 - tid : tlo_ + tid; gli = GT[(mb + t_) * 16 + dir * 4 + h]; glf = GT[(mb + t_) * 16 + 8 + dir * 4 + h]; } } while (0)
#define ML_FILL(c_) do { _Pragma("unroll") for (int i_ = 0; i_ < 3; ++i_) { const int ch_ = tid + 512 * i_; if (ch_ < 68 * 16) *(LAS v4u*)(RAWQ + (ch_ >> 4) * 128 + (ch_ & 15) * 8) = pre[i_]; } \
        { LAS bf16* Vt_ = Vtb + ((c_) & 1) * 4608; const int tl_ = tid >> 3, e8_ = tid & 7; const int lp_ = dir ? 63 - tl_ : tl_; const unsigned w_[4] = {prev.x, prev.y, prev.z, prev.w}; \
          _Pragma("unroll") for (int k_ = 0; k_ < 4; ++k_) { const int e_ = e8_ * 8 + 2 * k_; Vt_[e_ * 72 + swz64(e_, lp_)] = (bf16)(w_[k_] & 0xffffu); Vt_[(e_ + 1) * 72 + swz64(e_ + 1, lp_)] = (bf16)(w_[k_] >> 16); } } \
        if (tid < 64) { const float bl_ = wave_scan_add(glf); \
            const float u_ = gli - bl_; const float rm_ = wave_scan_max(u_); \
            ub[((c_) & 1) * 64 + tid] = u_; blb[((c_) & 1) * 64 + tid] = bl_; rmb[((c_) & 1) * 64 + tid] = rm_; if (tid == 63) { scb[((c_) & 1) * 2] = rm_; scb[((c_) & 1) * 2 + 1] = bl_; } } } while (0)
    ML_ISSUE(0); ML_FILL(0); ML_ISSUE(1);
    __syncthreads();
#pragma unroll 1
    for (int c = 0; c < cend; ++c) {
        const bool full = c >= cfull0;
        const int tlo = dir ? SEQ - 64 * (c + 1) : 64 * c;
        const LAS float* u = ub + (c & 1) * 64; const LAS float* bl = blb + (c & 1) * 64; const LAS float* rm = rmb + (c & 1) * 64;
        const LAS bf16* Vt = Vtb + (c & 1) * 4608; const LAS bf16* Ct = Ctb + (c & 1) * 4608; LAS bf16* Ctn = Ctb + ((c + 1) & 1) * 4608;
#pragma unroll 4
        for (int i = 0; i < 16; ++i) { const int tl = (tid >> 7) + 4 * i; float s = cbv;
#pragma unroll
            for (int jj = 0; jj < 5; ++jj) s += cw[jj] * bf2f(RAWQ[(tl + jj) * 128 + cc]);
            s = siluf_(s); const int lpos = dir ? 63 - tl : tl;
            if (isK) Ks[lpos * 72 + d0] = (bf16)f2bf(s * 0.125f); else Qs[lpos * 72 + d0] = (bf16)f2bf(s); }
        if (tid < 64) den[tid] = 0.f;
        __syncthreads();
        const float umax = scb[(c & 1) * 2], tot = scb[(c & 1) * 2 + 1];
        for (int idx = tid; idx < 4096; idx += 512) { const int lp = idx >> 6, d = idx & 63; KWt[d * 72 + swz64(d, lp)] = (bf16)f2bf(bf2f(Ks[lp * 72 + d]) * __expf(u[lp] - umax)); }
        if (full) {
#pragma unroll
        for (int k = 0; k < 2; ++k) { const int ti = 2 * wave + k, tl_ = ti >> 2, ts = ti & 3; f32x4 acc = {0.f, 0.f, 0.f, 0.f};
            if (ts <= tl_) acc = mma16<64>(Qs + tl_ * 16 * 72, 72, Ks + ts * 16 * 72, 72, acc, lane);
#pragma unroll
            for (int jj = 0; jj < 4; ++jj) { const int lr = tl_ * 16 + (lane >> 4) * 4 + jj, s = ts * 16 + (lane & 15);
                const float v = (s <= lr) ? acc[jj] * __expf(u[s] - fmaxf(m_st, rm[lr])) : 0.f; const unsigned vb = f2bf(v); Ps[lr * 72 + s] = (bf16)vb;
                if (ts <= tl_) { const float rs = row16_sum(bf2f(vb)); if ((lane & 15) == 0) __hip_atomic_fetch_add(den + lr, rs, __ATOMIC_RELAXED, __HIP_MEMORY_SCOPE_WORKGROUP); } } }
        { const int lq = tid >> 3, part = tid & 7; float s = 0.f;
#pragma unroll
          for (int k = 0; k < 8; ++k) s += bf2f(Qs[lq * 72 + part * 8 + k]) * nst[part * 8 + k];
          s = row8_sum(s); if (part == 0) qn[lq] = s; }
        }
        __syncthreads();
        const float mmax = fmaxf(m_st, umax), s_old = __expf(m_st - mmax), s_new = __expf(umax - mmax);
#pragma unroll
        for (int k = 0; k < 2; ++k) { const int ti = 2 * wave + k, t0_ = ti >> 2, t1_ = ti & 3; const f32x4 z = {0.f, 0.f, 0.f, 0.f};
            f32x4 a1 = z, a2 = z;
            if (full) { a1 = mma16s<false, true>(Ps, 72, t0_ * 16, Vt, 72, t1_ * 16, z, lane); a2 = mma16<64>(Qs + t0_ * 16 * 72, 72, Ct + t1_ * 16 * 72, 72, z, lane); }
            const f32x4 lc = mma16s<true, true>(Vt, 72, t0_ * 16, KWt, 72, t1_ * 16, z, lane);
#pragma unroll
            for (int jj = 0; jj < 4; ++jj) { const int r_ = t0_ * 16 + (lane >> 4) * 4 + jj, c_ = t1_ * 16 + (lane & 15);
                if (full) { const float mx = fmaxf(m_st, rm[r_]), iwv = __expf(m_st - mx);
                const float dn = den[r_] + iwv * qn[r_];
                const float val = (a1[jj] + iwv * a2[jj]) / fmaxf(fabsf(dn), __expf(-(bl[r_] + mx)));
                const int t = dir ? tlo + 63 - r_ : tlo + r_;
                Y[(mb + t) * 256 + h * 64 + c_] = (bf16)f2bf(val); }
                st[k][jj] = s_old * st[k][jj] + s_new * lc[jj];
                Ctn[r_ * 72 + c_] = (bf16)f2bf(st[k][jj]); } }
        { const int dq = tid >> 3, part = tid & 7; float s = 0.f;
#pragma unroll
          for (int k = 0; k < 8; ++k) s += bf2f(KWt[dq * 72 + swz64(dq, part * 8) + k]);
          s = row8_sum(s); if (part == 0) nst[dq] = s_old * nst[dq] + s_new * s; }
        m_st = tot + mmax;
        if (c + 1 < cend) { ML_FILL(c + 1); if (c + 2 < cend) ML_ISSUE(c + 2); }
        __syncthreads();
    }
#undef ML_ISSUE
#undef ML_FILL
}
__device__ __forceinline__ void phase_ssd_conv(const Frame& F, int l) {
    const bf16* cols = (const bf16*)(WSP(F) + WS_COLS); bf16* XBC = (bf16*)(WSP(F) + WS_XN);
    LAS bf16* raw = (LAS bf16*)(F.lds);
    const float* cwp = INP(F, 20) + (size_t)l * 5 * 896; const float* cbp = INP(F, 21) + l * 896;
    const int tid = F.tid;
    float cw0[5], cw1[5]; const int c1 = tid + 512 < 896 ? tid + 512 : tid;
#pragma unroll
    for (int jj = 0; jj < 5; ++jj) { cw0[jj] = cwp[jj * 896 + tid]; cw1[jj] = cwp[jj * 896 + c1]; }
    const float cb0 = cbp[tid], cb1 = cbp[c1];
    float* DTV = (float*)(WSP(F) + WS_DTV); const float* dtbp = INP(F, 22) + l * 12;
    for (int tile = F.vcu; tile < M / 32; tile += F.G) {
        const int m0 = tile * 32, t0 = m0 % SEQ;
        __syncthreads();
        if (tid < 384) { const int tt = tid / 12, k = tid % 12; const float x = bf2f(cols[(size_t)(m0 + tt) * NINP + S_DT + k]) + dtbp[k]; DTV[(size_t)(m0 + tt) * 12 + k] = x > 20.f ? x : log1pf(__expf(x)); }
        for (int ch = tid; ch < 36 * 112; ch += 512) { const int rr = ch / 112, cc = ch % 112; const int t = t0 - 2 + rr;
            v4u v = {0u, 0u, 0u, 0u}; if (t >= 0 && t < SEQ) v = *(const v4u*)(cols + (size_t)(m0 - 2 + rr) * NINP + S_X + cc * 8);
            *(LAS v4u*)(raw + rr * 896 + cc * 8) = v; }
        __syncthreads();
#pragma unroll
        for (int half = 0; half < 2; ++half) { const int c = half ? c1 : tid; if (half && tid + 512 >= 896) break;
            float win[5];
#pragma unroll
            for (int jj = 0; jj < 4; ++jj) win[jj] = bf2f(raw[jj * 896 + c]);
            for (int tl = 0; tl < 32; ++tl) { win[4] = bf2f(raw[(tl + 4) * 896 + c]);
                float s = half ? cb1 : cb0;
#pragma unroll
                for (int jj = 0; jj < 5; ++jj) s += (half ? cw1[jj] : cw0[jj]) * win[jj];
#pragma unroll
                for (int jj = 0; jj < 4; ++jj) win[jj] = win[jj + 1];
                XBC[(size_t)(m0 + tl) * 896 + c] = (bf16)f2bf(siluf_(s)); } }
    }
    __syncthreads();
}
__device__ __forceinline__ void ssd_seq(const Frame& F, int l, int task, int cfull0, int cend) {
    const int b = task / 12, rem = task % 12, head = rem >> 1, dir = rem & 1, g = head / 3;
    const bf16* cols = (const bf16*)(WSP(F) + WS_COLS); const bf16* XBC = (const bf16*)(WSP(F) + WS_XN);
    bf16* Y = (bf16*)(WSP(F) + (dir ? Y_SB : Y_SF));
    LAS bf16* Cm = (LAS bf16*)(F.lds); LAS bf16* Bm = (LAS bf16*)(F.lds + 17408);
    LAS bf16* Btw = (LAS bf16*)(F.lds + 34816); LAS bf16* Xt = (LAS bf16*)(F.lds + 53248);
    LAS bf16* Ps = (LAS bf16*)(F.lds + 62464); LAS bf16* Hs = (LAS bf16*)(F.lds + 71680);
    LAS float* dtvb = (LAS float*)(F.lds + 89088);
    LAS float* acsb = dtvb + 128;
    LAS float* totb = dtvb + 256;
    const int tid = F.tid, lane = F.lane, wave = F.wave;
    const size_t mb = (size_t)b * SEQ;
    constexpr int NC = SEQ / 64;
    __syncthreads();
    for (int i = tid; i < 64 * 136; i += 512) Hs[i] = 0;
    const float* DTV = (const float*)(WSP(F) + WS_DTV);
    const float aneg = -__expf(INP(F, 23)[(l * 2 + dir) * 6 + head]);
    f32x4 st[4];
#pragma unroll
    for (int k = 0; k < 4; ++k) st[k] = (f32x4){0.f, 0.f, 0.f, 0.f};
    v4u pre[5]; float dtraw = 0.f;
#define SSD_ISSUE(c_) do { const int tlo_ = dir ? SEQ - 64 * ((c_) + 1) : 64 * (c_); _Pragma("unroll") for (int i_ = 0; i_ < 5; ++i_) { const int idx_ = tid + 512 * i_; const int tl_ = idx_ / 40, q_ = idx_ % 40; \
        const int gc_ = q_ < 8 ? head * 64 + q_ * 8 : (q_ < 24 ? 384 + g * 128 + (q_ - 8) * 8 : 640 + g * 128 + (q_ - 24) * 8); \
        pre[i_] = *(const v4u*)(XBC + (mb + tlo_ + tl_) * 896 + gc_); } } while (0)
#define SSD_DTLOAD(c_) do { if (tid < 64) { const int tlo_ = dir ? SEQ - 64 * ((c_) + 1) : 64 * (c_); const int t_ = dir ? tlo_ + 63 - tid : tlo_ + tid; dtraw = DTV[(mb + t_) * 12 + dir * 6 + head]; } } while (0)
#define SSD_DTCALC(c_) do { if (tid < 64) { const float dt_ = dtraw; float cs_ = dt_ * aneg; \
        cs_ = wave_scan_add(cs_); \
        const float tt_ = __builtin_bit_cast(float, __builtin_amdgcn_readlane(__builtin_bit_cast(int, cs_), 63)); dtvb[((c_) & 1) * 64 + tid] = dt_; acsb[((c_) & 1) * 64 + tid] = cs_; if (tid == 0) totb[(c_) & 1] = tt_; } } while (0)
    int lgo[3], llp[3], lq[3]; v4u prel[3];
#pragma unroll
    for (int i = 0; i < 3; ++i) { const int idx = tid + 512 * i; const int tl = idx / 24, q = idx % 24; lq[i] = q; llp[i] = dir ? 63 - tl : tl;
        lgo[i] = tl * 896 + (q < 8 ? head * 64 + q * 8 : 384 + g * 128 + (q - 8) * 8); }
#define SSD_ISSUE_L(dst_, c_) do { const int tlo_ = dir ? SEQ - 64 * ((c_) + 1) : 64 * (c_); const bf16* b_ = XBC + (mb + tlo_) * 896; _Pragma("unroll") for (int i_ = 0; i_ < 3; ++i_) dst_[i_] = *(const v4u*)(b_ + lgo[i_]); } while (0)
    v4u preN[3];
    if (cfull0 > 0) { SSD_ISSUE_L(prel, 0); if (cfull0 > 1) SSD_ISSUE_L(preN, 1); } else SSD_ISSUE(0);
    SSD_DTLOAD(0); SSD_DTCALC(0); SSD_DTLOAD(1);
    __syncthreads();
    if (cfull0 > 0) {
#pragma unroll 1
        for (int c = 0; c < cfull0; ++c) {
            LAS bf16* Xl = (c & 1) ? (LAS bf16*)(F.lds + 92160) : Xt; LAS bf16* Bl = (c & 1) ? (LAS bf16*)(F.lds + 101376) : Btw;
            const LAS float* dtv = dtvb + (c & 1) * 64; const LAS float* acs = acsb + (c & 1) * 64; const float tot = totb[c & 1];
#pragma unroll
            for (int i = 0; i < 3; ++i) { const int q = lq[i], lp = llp[i];
                const unsigned w[4] = {prel[i].x, prel[i].y, prel[i].z, prel[i].w};
                if (q < 8) {
#pragma unroll
                    for (int k = 0; k < 4; ++k) { const int p0 = q * 8 + 2 * k; Xl[p0 * 72 + swz64(p0, lp)] = (bf16)(w[k] & 0xffffu); Xl[(p0 + 1) * 72 + swz64(p0 + 1, lp)] = (bf16)(w[k] >> 16); } }
                else { const int n0 = (q - 8) * 8; const float sc = dtv[lp] * __expf(tot - acs[lp]);
#pragma unroll
                    for (int k = 0; k < 4; ++k) { const int nn = n0 + 2 * k; Bl[nn * 72 + swz64(nn, lp)] = (bf16)f2bf(bf2f(w[k] & 0xffffu) * sc); Bl[(nn + 1) * 72 + swz64(nn + 1, lp)] = (bf16)f2bf(bf2f(w[k] >> 16) * sc); } } }
            if (c + 1 < cfull0) {
#pragma unroll
                for (int i = 0; i < 3; ++i) prel[i] = preN[i];
                if (c + 2 < cfull0) SSD_ISSUE_L(preN, c + 2); }
            else SSD_ISSUE(c + 1);
            SSD_DTCALC(c + 1); if (c + 2 < cend) SSD_DTLOAD(c + 2);
            __syncthreads();
            const float cdec = __expf(tot);
#pragma unroll
            for (int k = 0; k < 4; ++k) { const int ti = 4 * wave + k, tp = ti >> 3, tn = ti & 7; const f32x4 z = {0.f, 0.f, 0.f, 0.f};
                const f32x4 lcv = mma16s<true, true>(Xl, 72, tp * 16, Bl, 72, tn * 16, z, lane);
                st[k] = st[k] * cdec + lcv; }
        }
#pragma unroll
        for (int k = 0; k < 4; ++k) { const int ti = 4 * wave + k, tp = ti >> 3, tn = ti & 7;
#pragma unroll
            for (int jj = 0; jj < 4; ++jj) { const int p = tp * 16 + (lane >> 4) * 4 + jj, n = tn * 16 + (lane & 15); Hs[p * 136 + n] = (bf16)f2bf(st[k][jj]); } }
        __syncthreads();
    }
#pragma unroll 1
    for (int c = cfull0; c < cend; ++c) {
        const bool full = c >= cfull0;
        const int tlo = dir ? SEQ - 64 * (c + 1) : 64 * c;
        const LAS float* dtv = dtvb + (c & 1) * 64; const LAS float* acs = acsb + (c & 1) * 64; const float tot = totb[c & 1];
#pragma unroll
        for (int i = 0; i < 5; ++i) { const int idx = tid + 512 * i; const int tl = idx / 40, q = idx % 40; const int lp = dir ? 63 - tl : tl;
            const unsigned w[4] = {pre[i].x, pre[i].y, pre[i].z, pre[i].w};
            if (q < 8) {
#pragma unroll
                for (int k = 0; k < 4; ++k) { const int p0 = q * 8 + 2 * k; Xt[p0 * 72 + swz64(p0, lp)] = (bf16)(w[k] & 0xffffu); Xt[(p0 + 1) * 72 + swz64(p0 + 1, lp)] = (bf16)(w[k] >> 16); } }
            else if (q < 24) { const int n0 = (q - 8) * 8; if (full) *(LAS v4u*)(Bm + lp * 136 + n0) = pre[i]; const float sc = dtv[lp] * __expf(tot - acs[lp]);
#pragma unroll
                for (int k = 0; k < 4; ++k) { const int nn = n0 + 2 * k; Btw[nn * 72 + swz64(nn, lp)] = (bf16)f2bf(bf2f(w[k] & 0xffffu) * sc); Btw[(nn + 1) * 72 + swz64(nn + 1, lp)] = (bf16)f2bf(bf2f(w[k] >> 16) * sc); } }
            else if (full) { const int n0 = (q - 24) * 8; *(LAS v4u*)(Cm + lp * 136 + n0) = pre[i]; } }
        if (c + 1 < cend) SSD_ISSUE(c + 1);
        __syncthreads();
        f32x4 yo[2] = {{0.f, 0.f, 0.f, 0.f}, {0.f, 0.f, 0.f, 0.f}}, lc[4];
        if (full) {
#pragma unroll
        for (int k = 0; k < 2; ++k) { const int ti = 2 * wave + k, tl_ = ti >> 2, ts = ti & 3; f32x4 acc = {0.f, 0.f, 0.f, 0.f};
            if (ts <= tl_) acc = mma16<128>(Cm + tl_ * 16 * 136, 136, Bm + ts * 16 * 136, 136, acc, lane);
#pragma unroll
            for (int jj = 0; jj < 4; ++jj) { const int lr = tl_ * 16 + (lane >> 4) * 4 + jj, s = ts * 16 + (lane & 15);
                const float v = (s <= lr) ? acc[jj] * __expf(acs[lr] - acs[s]) * dtv[s] : 0.f; Ps[lr * 72 + s] = (bf16)f2bf(v); }
            const f32x4 z = {0.f, 0.f, 0.f, 0.f};
            yo[k] = mma16<128>(Cm + tl_ * 16 * 136, 136, Hs + ts * 16 * 136, 136, z, lane); }
        }
#pragma unroll
        for (int k = 0; k < 4; ++k) { const int ti = 4 * wave + k, tp = ti >> 3, tn = ti & 7; const f32x4 z = {0.f, 0.f, 0.f, 0.f};
            lc[k] = mma16s<true, true>(Xt, 72, tp * 16, Btw, 72, tn * 16, z, lane); }
        __syncthreads();
        const float cdec = __expf(tot);
        if (full) {
#pragma unroll
        for (int k = 0; k < 2; ++k) { const int ti = 2 * wave + k, tl_ = ti >> 2, tp = ti & 3; const f32x4 z = {0.f, 0.f, 0.f, 0.f};
            const f32x4 yd = mma16s<false, true>(Ps, 72, tl_ * 16, Xt, 72, tp * 16, z, lane);
#pragma unroll
            for (int jj = 0; jj < 4; ++jj) { const int lr = tl_ * 16 + (lane >> 4) * 4 + jj, p = tp * 16 + (lane & 15);
                const float val = yd[jj] + yo[k][jj] * __expf(acs[lr]);
                const int t = dir ? tlo + 63 - lr : tlo + lr;
                Y[(mb + t) * 384 + head * 64 + p] = (bf16)f2bf(val); } }
        }
#pragma unroll
        for (int k = 0; k < 4; ++k) { const int ti = 4 * wave + k, tp = ti >> 3, tn = ti & 7;
#pragma unroll
            for (int jj = 0; jj < 4; ++jj) { const int p = tp * 16 + (lane >> 4) * 4 + jj, n = tn * 16 + (lane & 15);
                st[k][jj] = cdec * st[k][jj] + lc[k][jj]; Hs[p * 136 + n] = (bf16)f2bf(st[k][jj]); } }
        if (c + 1 < cend) { SSD_DTCALC(c + 1); if (c + 2 < cend) SSD_DTLOAD(c + 2); }
        __syncthreads();
    }
#undef SSD_ISSUE
#undef SSD_ISSUE_L
#undef SSD_DTLOAD
#undef SSD_DTCALC
}
__device__ __forceinline__ float wave_sum2(float v) { v = row16_sum(v); v += __shfl_xor(v, 16); v += __shfl_xor(v, 32); return v; }
__device__ __forceinline__ f32x4 bf4(v2u w) { return (f32x4){bf2f(w.x & 0xffffu), bf2f(w.x >> 16), bf2f(w.y & 0xffffu), bf2f(w.y >> 16)}; }
__device__ __forceinline__ v2u pk4(f32x4 v) { v2u w; w.x = pk2(v.x, v.y); w.y = pk2(v.z, v.w); return w; }
__device__ __forceinline__ void phase_post(const Frame& F, int l) {
    const bf16* cols = (const bf16*)(WSP(F) + WS_COLS); bf16* MIX = (bf16*)(WSP(F) + WS_XN);
    const bf16* YAf = (const bf16*)(WSP(F) + Y_AF); const bf16* YAb = (const bf16*)(WSP(F) + Y_AB);
    const bf16* YRf = (const bf16*)(WSP(F) + Y_RF); const bf16* YRb = (const bf16*)(WSP(F) + Y_RB);
    const bf16* YSf = (const bf16*)(WSP(F) + Y_SF); const bf16* YSb = (const bf16*)(WSP(F) + Y_SB);
    const float* CT = (const float*)(WSP(F) + WS_CT);
    LAS bf16* GU = (LAS bf16*)(F.lds);
    LAS bf16* SG = (LAS bf16*)(F.lds + 104448);
    LAS float* gate = (LAS float*)(F.lds + 108800);
    LAS float* SCW = (LAS float*)(F.lds + 133632);
    const int tid = F.tid, lane = F.lane, wave = F.wave;
    const float* mup = INP(F, 8) + l * 1472; const float* mun = INP(F, 9) + l * 1472;
    const float* gup = INP(F, 14) + (size_t)l * 128 * 384;
    const float* sdk = INP(F, 24) + l * 6;
    __syncthreads();
    for (int idx = tid; idx < 128 * 384; idx += 512) { const int i = idx / 384, c = idx % 384; GU[c * 136 + i] = (bf16)f2bf(gup[idx]); }
    { const float* scw = INP(F, 20) + (size_t)l * 5 * 896; for (int idx = tid; idx < 5 * 384; idx += 512) SCW[idx] = scw[(idx / 384) * 896 + (idx % 384)]; }
    const int gch = tid & 15;
    float gmp[8], gmn[8];
#pragma unroll
    for (int k = 0; k < 8; ++k) { gmp[k] = mup[1344 + 8 * gch + k]; gmn[k] = mun[1344 + 8 * gch + k]; }
    const int qa = lane, qb = 64 + (lane & 31);
    const f32x4 mng4 = *(const f32x4*)(INP(F, 7) + l * 256 + 4 * qa);
    f32x4 rmp[2], rmn[2], rng[2], rnb[2], scb[2], sng[2];
#pragma unroll
    for (int ps = 0; ps < 2; ++ps) { const int c0 = 4 * (ps ? qb : qa);
        rmp[ps] = *(const f32x4*)(mup + 768 + c0); rmn[ps] = *(const f32x4*)(mun + 768 + c0);
        rng[ps] = *(const f32x4*)(INP(F, 18) + l * 384 + c0); rnb[ps] = *(const f32x4*)(INP(F, 19) + l * 384 + c0);
        scb[ps] = *(const f32x4*)(INP(F, 21) + l * 896 + c0); sng[ps] = *(const f32x4*)(INP(F, 25) + l * 384 + c0); }
    for (int tile = F.vcu; tile < M / 16; tile += F.G) {
        const int m0 = tile * 16;
        __syncthreads();
        if (tid < 256) { const int tt = tid >> 4; const int m = m0 + tt, t = m % SEQ; const bf16* cp = cols + (size_t)m * NINP + R_GD + 8 * gch;
            const v4u c1 = *(const v4u*)cp; v4u c0 = {0u, 0u, 0u, 0u}, c2 = {0u, 0u, 0u, 0u};
            if (t > 0) c0 = *(const v4u*)(cp - NINP); if (t < SEQ - 1) c2 = *(const v4u*)(cp + NINP);
            const unsigned w0[4] = {c0.x, c0.y, c0.z, c0.w}, w1[4] = {c1.x, c1.y, c1.z, c1.w}, w2[4] = {c2.x, c2.y, c2.z, c2.w}; unsigned o[4];
#pragma unroll
            for (int k = 0; k < 4; ++k) { const float a1 = bf2f(w1[k] & 0xffffu), b1 = bf2f(w1[k] >> 16);
                const float va = a1 + gmp[2 * k] * (bf2f(w0[k] & 0xffffu) - a1) + gmn[2 * k] * (bf2f(w2[k] & 0xffffu) - a1);
                const float vb = b1 + gmp[2 * k + 1] * (bf2f(w0[k] >> 16) - b1) + gmn[2 * k + 1] * (bf2f(w2[k] >> 16) - b1);
                o[k] = pk2(sigmoidf_(va), sigmoidf_(vb)); }
            *(LAS v4u*)(SG + tt * 136 + 8 * gch) = (v4u){o[0], o[1], o[2], o[3]}; }
        __syncthreads();
#pragma unroll
        for (int k = 0; k < 3; ++k) { const int ct = wave + 8 * k; const f32x4 z = {0.f, 0.f, 0.f, 0.f};
            const f32x4 acc = mma16<128>(SG, 136, GU + ct * 16 * 136, 136, z, lane);
#pragma unroll
            for (int jj = 0; jj < 4; ++jj) gate[((lane >> 4) * 4 + jj) * 388 + ct * 16 + (lane & 15)] = acc[jj]; }
        __syncthreads();
#pragma unroll 1
        for (int k = 0; k < 2; ++k) { const int tt = wave * 2 + k; const int m = m0 + tt, t = m % SEQ; const size_t cr = (size_t)m * NINP;
            { const int c0 = 4 * qa;
              const f32x4 hs = bf4(*(const v2u*)(YAf + (size_t)m * 256 + c0)) + bf4(*(const v2u*)(YAb + (size_t)m * 256 + c0));
              const float mean = row16_sum((hs.x + hs.y) + (hs.z + hs.w)) * (1.f / 64.f); const f32x4 d = hs - mean;
              const float var = row16_sum((d.x * d.x + d.y * d.y) + (d.z * d.z + d.w * d.w)) * (1.f / 64.f);
              const f32x4 o = bf4(*(const v2u*)(cols + cr + A_O + c0));
              f32x4 y = d * (1.f / sqrtf(var + 1e-6f)) * mng4;
              y.x *= sigmoidf_(o.x); y.y *= sigmoidf_(o.y); y.z *= sigmoidf_(o.z); y.w *= sigmoidf_(o.w);
              *(v2u*)(MIX + (size_t)m * DM + c0) = pk4(y); }
#pragma unroll
            for (int ps = 0; ps < 2; ++ps) { const int qd = ps ? qb : qa, c0 = 4 * qd; const bool act = ps == 0 || lane < 32;
              const f32x4 ys = bf4(*(const v2u*)(YRf + (size_t)m * 384 + c0)) + bf4(*(const v2u*)(YRb + (size_t)m * 384 + c0));
              const float mean = row16_sum((ys.x + ys.y) + (ys.z + ys.w)) * (1.f / 64.f); const f32x4 d = ys - mean;
              const float var = row16_sum((d.x * d.x + d.y * d.y) + (d.z * d.z + d.w * d.w)) * (1.f / 64.f);
              const f32x4 y = d * (1.f / sqrtf(var + 64e-5f)) * rng[ps] + rnb[ps];
              const f32x4 p1 = bf4(*(const v2u*)(cols + cr + R_V + c0));
              f32x4 p0 = {0.f, 0.f, 0.f, 0.f}, p2 = {0.f, 0.f, 0.f, 0.f};
              if (t > 0) p0 = bf4(*(const v2u*)(cols + cr - NINP + R_V + c0)); if (t < SEQ - 1) p2 = bf4(*(const v2u*)(cols + cr + NINP + R_V + c0));
              const f32x4 vv = p1 + rmp[ps] * (p0 - p1) + rmn[ps] * (p2 - p1);
              const float ctv = CT[(size_t)m * 8 + (qd >> 4)];
              const f32x4 g4 = *(const LAS f32x4*)(gate + tt * 388 + c0);
              if (act) *(v2u*)(MIX + (size_t)m * DM + 256 + c0) = pk4((y + vv * ctv) * g4); }
            f32x4 yv[2]; float ssq0 = 0.f, ssq1 = 0.f;
#pragma unroll
            for (int ps = 0; ps < 2; ++ps) { const int qd = ps ? qb : qa, c0 = 4 * qd; const bool act = ps == 0 || lane < 32;
              f32x4 s = scb[ps];
#pragma unroll
              for (int jj = 0; jj < 5; ++jj) { const int tq = t + jj - 2; if (tq >= 0 && tq < SEQ) s += *(const LAS f32x4*)(SCW + jj * 384 + c0) * bf4(*(const v2u*)(cols + cr + (jj - 2) * NINP + S_X + c0)); }
              const f32x4 z = bf4(*(const v2u*)(cols + cr + S_Z + c0));
              f32x4 y = bf4(*(const v2u*)(YSf + (size_t)m * 384 + c0)) + bf4(*(const v2u*)(YSb + (size_t)m * 384 + c0));
              const float dsk = sdk[qd >> 4];
              y.x = (y.x + dsk * siluf_(s.x)) * siluf_(z.x); y.y = (y.y + dsk * siluf_(s.y)) * siluf_(z.y); y.z = (y.z + dsk * siluf_(s.z)) * siluf_(z.z); y.w = (y.w + dsk * siluf_(s.w)) * siluf_(z.w);
              yv[ps] = y; const float sq = act ? (y.x * y.x + y.y * y.y) + (y.z * y.z + y.w * y.w) : 0.f;
              if (qd < 48) ssq0 += sq; else ssq1 += sq; }
            const float r0 = 1.f / sqrtf(wave_sum2(ssq0) * (1.f / 192.f) + 1e-6f), r1 = 1.f / sqrtf(wave_sum2(ssq1) * (1.f / 192.f) + 1e-6f);
#pragma unroll
            for (int ps = 0; ps < 2; ++ps) { const int qd = ps ? qb : qa, c0 = 4 * qd; const bool act = ps == 0 || lane < 32;
              if (act) *(v2u*)(MIX + (size_t)m * DM + 640 + c0) = pk4(yv[ps] * (qd < 48 ? r0 : r1) * sng[ps]); }
        }
    }
    __syncthreads();
}
namespace cg = cooperative_groups;
constexpr int N_PHASES = 9 * DEPTH + 1;
__global__ void __launch_bounds__(NWAVES * 64, 2) mk_fwd(Args args) {
    extern __shared__ __attribute__((aligned(16))) unsigned char lds_raw[];
    Frame F;
    F.lds = (LAS unsigned char*)lds_raw;
    F.tid = threadIdx.x; F.lane = F.tid & 63; F.wave = __builtin_amdgcn_readfirstlane(F.tid >> 6);
    F.G = gridDim.x; { const int bx = blockIdx.x; F.vcu = (F.G % 8 == 0) ? (bx % 8) * (F.G / 8) + bx / 8 : bx; }
    volatile LAS unsigned* MISC = (volatile LAS unsigned*)(F.lds + MISC_OFF);
    if (F.tid < 64) MISC[F.tid] = 0u;
    if (F.tid < 34) *(LAS unsigned long long*)(F.lds + PTAB_OFF + 8 * F.tid) = ((const unsigned long long*)__builtin_amdgcn_kernarg_segment_ptr())[F.tid];
    __syncthreads();
    unsigned* ctl = (unsigned*)(WSP(F) + WS_CTL);
    XcdBarrier bar = xcd_barrier_post(ctl + CW_BAR, MISC + 8);
    const int lo = args.ph_lo, hi = args.ph_hi;
#define IN_(k) (lo <= (k) && (k) < hi)
#define SEAM(k) do { if (IN_(k) && IN_((k) + 1)) { if ((k) == 0) cg::this_grid().sync(); else xcd_barrier(bar); } } while (0)
#define LAYER(l, B) \
    if (IN_(B + 0)) { phase_convert(F, l); phase_norm(F, l == 0 ? INP(F, 0) : OUTP(F), INP(F, 1) + l * DM, (bf16*)(WSP(F) + WS_XN)); } SEAM(B + 0); \
    if (IN_(B + 1)) { unsigned char* ws = WSP(F); pg8::Gemm g{(const bf16*)(ws + WS_XN), (const bf16*)(ws + WS_WIN), M, NINP, DM}; pg8::StaticOrder S; S.init(M, NINP, F.G, (int)blockIdx.x); \
            pg8::EpiBf16<0> E{(bf16*)(ws + WS_COLS), NINP, nullptr, 0, 0, 1.f}; \
            pg8::gemm_phase<pg8::EpiBf16<0>, pg8::StaticOrder, PG8_ALIGN, PG8_SP2>(F.lds, g, S, E); } SEAM(B + 1); \
    if (IN_(B + 2)) { phase_gates(F, l); phase_ssd_conv(F, l); } SEAM(B + 2); \
    if (IN_(B + 3)) { const int bx = blockIdx.x; \
            if (bx < 96) { const int c8 = bx & 7, k8 = bx >> 3; rwkv_scan(F, l, c8 + 8 * (k8 >> 2), k8 & 3, (unsigned)l * (SEQ / 32)); } else if (bx < 144) rwkv_produce(F, l, (bx - 96) % 24, (bx - 96) / 24, (unsigned)l * (SEQ / 32)); else if (bx < 216) { const int u = bx - 144, sg = 2 - (u / 24); ssd_seq(F, l, u % 24, sg == 0 ? 0 : (sg == 1 ? 43 : 86), sg == 0 ? 43 : (sg == 1 ? 86 : 128)); } else if (bx < 248) { const int u = bx - 216, sg = 1 - (u / 16); mlstm_seq(F, l, u % 16, 64 * sg, 64 * sg + 64); } } SEAM(B + 3); \
    if (IN_(B + 4)) phase_post(F, l); SEAM(B + 4); \
    if (IN_(B + 5)) { unsigned char* ws = WSP(F); pg8::Gemm g{(const bf16*)(ws + WS_XN), (const bf16*)(ws + WS_WOUT), M, DM, DM}; pg8::StaticOrder S; S.init(M, DM, F.G, (int)blockIdx.x); \
            pg8::EpiResidual E{l == 0 ? INP(F, 0) : OUTP(F), OUTP(F), DM}; \
            pg8::gemm_phase<pg8::EpiResidual, pg8::StaticOrder, PG8_ALIGN, PG8_SP2>(F.lds, g, S, E); } SEAM(B + 5); \
    if (IN_(B + 6)) phase_norm(F, OUTP(F), INP(F, 27) + l * DM, (bf16*)(WSP(F) + WS_XN)); SEAM(B + 6); \
    if (IN_(B + 7)) { unsigned char* ws = WSP(F); pg8::Gemm g{(const bf16*)(ws + WS_XN), (const bf16*)(ws + WS_WGU), M, 2 * FFN, DM}; pg8::StaticOrder S; S.init(M, 2 * FFN, F.G, (int)blockIdx.x); \
            pg8::EpiSwiGLU E{(bf16*)(ws + WS_COLS), FFN}; \
            pg8::gemm_phase<pg8::EpiSwiGLU, pg8::StaticOrder, PG8_ALIGN, PG8_SP2>(F.lds, g, S, E); } SEAM(B + 7); \
    if (IN_(B + 8)) { unsigned char* ws = WSP(F); pg8::Gemm g{(const bf16*)(ws + WS_COLS), (const bf16*)(ws + WS_WDN), M, DM, FFN}; pg8::StaticOrder S; S.init(M, DM, F.G, (int)blockIdx.x); \
            pg8::EpiResidual E{OUTP(F), OUTP(F), DM}; \
            pg8::gemm_phase<pg8::EpiResidual, pg8::StaticOrder, PG8_ALIGN, PG8_SP2>(F.lds, g, S, E); } SEAM(B + 8);
    LAYER(0, 0)
    LAYER(1, 9)
    if (IN_(18)) phase_final_norm(F, OUTP(F), INP(F, 31));
#undef IN_
#undef SEAM
#undef LAYER
}

#ifndef MK_PER_PHASE
#define MK_PER_PHASE 0
#endif
extern "C" void kernel_launch(void* const* d_in, const int* in_sizes, int n_in, void* d_out, int out_size, void* d_ws, size_t ws_size, hipStream_t stream) {
    static int grid = 0;
    if (grid == 0) {
        int dev = 0, cus = 0;
        if (n_in != 32 || out_size != M * DM || ws_size < WS_END) { fprintf(stderr, "kernel_launch: unexpected shapes (n_in %d out %d ws %zu)\n", n_in, out_size, ws_size); grid = -1; return; }
        if (hipGetDevice(&dev) != hipSuccess || hipDeviceGetAttribute(&cus, hipDeviceAttributeMultiprocessorCount, dev) != hipSuccess) { grid = -1; return; }
        if (hipFuncSetAttribute((const void*)mk_fwd, hipFuncAttributeMaxDynamicSharedMemorySize, LDS_BYTES) != hipSuccess) { fprintf(stderr, "kernel_launch: hipFuncSetAttribute failed\n"); grid = -1; return; }
        int per_cu = 0;
        if (hipOccupancyMaxActiveBlocksPerMultiprocessor(&per_cu, (const void*)mk_fwd, NWAVES * 64, LDS_BYTES) != hipSuccess || per_cu < 1) { fprintf(stderr, "kernel_launch: occupancy query says %d\n", per_cu); }
        (void)hipGetLastError();
        grid = cus;
    }
    if (grid < 0) return;
    (void)hipMemsetAsync((char*)d_ws + WS_CTL, 0, CTL_ZERO_BYTES, stream);
    Args a{};
    for (int i = 0; i < 32; ++i) a.in[i] = (const float*)d_in[i];
    a.out = (float*)d_out; a.ws = (unsigned char*)d_ws;
#if MK_PER_PHASE
    for (int p = 0; p < N_PHASES; ++p) { a.ph_lo = p; a.ph_hi = p + 1; hipLaunchKernelGGL(mk_fwd, dim3(grid), dim3(NWAVES * 64), LDS_BYTES, stream, a); }
#else
    a.ph_lo = 0; a.ph_hi = N_PHASES;
    void* kargs[] = {&a};
    hipError_t e = hipLaunchCooperativeKernel((const void*)mk_fwd, dim3(grid), dim3(NWAVES * 64), kargs, LDS_BYTES, stream);
    if (e != hipSuccess) fprintf(stderr, "cooperative launch failed: %s (grid %d)\n", hipGetErrorString(e), grid);
#endif
}
```

```cpp
#include <hip/hip_runtime.h>
#include <hip/hip_cooperative_groups.h>
#include <cstdio>
#include <cstdint>
namespace pg8 {
#define PG8_LAS __attribute__((address_space(3)))
typedef unsigned short bf16_t;
typedef short bf16x8 __attribute__((ext_vector_type(8)));
typedef float f32x4 __attribute__((ext_vector_type(4)));
typedef unsigned u32x4 __attribute__((ext_vector_type(4)));
constexpr int BM = 256, BK = 64, HALF = 128, HTB = HALF * BK * 2  , STAGE_BYTES = 8 * HTB, NXCD = 8, WGM = 8;

__host__ __device__ __forceinline__ int lds_byte(int r, int c) { const int st = (r >> 4) * 2 + (c >> 5), rr = r & 15, cc = c & 31, ob = rr * 64 + cc * 2; return st * 1024 + (ob ^ (((ob >> 9) & 1) << 5)); }
__host__ __device__ __forceinline__ void stage_rc(int b, int& R, int& C) { const int st = b / 1024, sb = b % 1024, swz = sb ^ (((sb >> 9) & 1) << 5); R = (st >> 1) * 16 + swz / 64; C = (st & 1) * 32 + (swz % 64) / 2; }
__host__ __device__ __forceinline__ int perm32(int rho) { const int n = rho >> 4, i = rho & 15; return 8 * (i >> 2) + 4 * n + (i & 3); }

struct Unit { int pm, pn; };
struct Gemm { const bf16_t* A; const bf16_t* Bt; int M, N, K; };

struct StaticOrder {
    int nM, nN, nwg, G, c;
    __host__ __device__ void init(int M, int N, int G_, int c_) { nM = M / BM; nN = N / BM; nwg = nM * nN; G = G_; c = c_; }
    __host__ __device__ bool next(int i, Unit& u) const {
        const long L = (long)i * G + c; if (L >= nwg) return false;
        int wgid = (int)L; { const int q = nwg / NXCD, r = nwg % NXCD, xcd = wgid % NXCD, off = wgid / NXCD; wgid = (xcd < r ? xcd * (q + 1) : r * (q + 1) + (xcd - r) * q) + off; }
        const int nig = WGM * nN, gid = wgid / nig, fm = gid * WGM, gsz = (nM - fm) < WGM ? (nM - fm) : WGM;
        u.pm = fm + ((wgid % nig) % gsz); u.pn = (wgid % nig) / gsz; return true;
    }
    __device__ __forceinline__ void a_ready(const Unit&) const {}
    __device__ __forceinline__ void done(const Unit&) const {}
};

__device__ __forceinline__ unsigned cvt_pk_bf16(float lo, float hi) { unsigned r; asm volatile("v_cvt_pk_bf16_f32 %0, %1, %2" : "=v"(r) : "v"(lo), "v"(hi)); return r; }
typedef float f32x2 __attribute__((ext_vector_type(2)));
__device__ __forceinline__ f32x2 gelu_pk(f32x2 v) {
    const f32x2 av = __builtin_elementwise_abs(v), d = av * 0.2316418882f + 1.0f;
    f32x2 t; t.x = __builtin_amdgcn_rcpf(d.x); t.y = __builtin_amdgcn_rcpf(d.y);
    f32x2 q = t * 0.5307027145f + (-0.7265760135f); q = q * t + 0.7107068705f; q = q * t + (-0.142248368f); q = q * t + 0.127414796f; q = q * t;
    const f32x2 s = (v * v) * (-0.72134752044f);
    f32x2 e; e.x = __builtin_amdgcn_exp2f(s.x); e.y = __builtin_amdgcn_exp2f(s.y);
    const f32x2 m = v * (q * e), r = v - m;
    f32x2 o; o.x = v.x < 0.f ? m.x : r.x; o.y = v.y < 0.f ? m.y : r.y; return o;
}

template <int ACT  > struct EpiBf16 {
    static constexpr bool PERM = true, AFTER_DRAIN = false; static_assert(ACT == 0 || ACT == 1, "EpiBf16: ACT is 0 (none) or 1 (gelu_pk)");
    bf16_t* O; int ldc; const float* bias; int split_cols; size_t split_stride; float scale0;
    __device__ __forceinline__ void operator()(const f32x4 (&acc)[2][2][4][2], const Unit& u, int wr, int wc, int fr, int fq) const {
        const int row0 = u.pm * BM + wr * 64 + fr; int colt = u.pn * BM; bf16_t* base = O;
        float sc = 1.f; if (split_cols) { const int t = colt / split_cols; base += (size_t)t * split_stride; colt -= t * split_cols; if (t == 0) sc = scale0; }
        const int col0 = colt + wc * 32 + 8 * fq, bcol0 = u.pn * BM + wc * 32 + 8 * fq;
        f32x4 bv[2][2];
#pragma unroll
        for (int bj = 0; bj < 2; ++bj)
#pragma unroll
            for (int n = 0; n < 2; ++n) bv[bj][n] = bias ? *(const f32x4*)(bias + bcol0 + bj * HALF + 4 * n) : (f32x4){0.f, 0.f, 0.f, 0.f};
#pragma unroll
        for (int ai = 0; ai < 2; ++ai)
#pragma unroll
            for (int m = 0; m < 4; ++m) { bf16_t* rowp = base + (size_t)(row0 + ai * HALF + m * 16) * ldc + col0;
#pragma unroll
                for (int bj = 0; bj < 2; ++bj) { f32x4 v0 = acc[ai][bj][m][0] + bv[bj][0], v1 = acc[ai][bj][m][1] + bv[bj][1];
                    if (ACT == 1) { f32x2 a = gelu_pk((f32x2){v0[0], v0[1]}), b = gelu_pk((f32x2){v0[2], v0[3]}), c = gelu_pk((f32x2){v1[0], v1[1]}), d = gelu_pk((f32x2){v1[2], v1[3]});
                        v0 = (f32x4){a.x, a.y, b.x, b.y}; v1 = (f32x4){c.x, c.y, d.x, d.y}; }
                    v0 = v0 * sc; v1 = v1 * sc; u32x4 w; w.x = cvt_pk_bf16(v0[0], v0[1]); w.y = cvt_pk_bf16(v0[2], v0[3]); w.z = cvt_pk_bf16(v1[0], v1[1]); w.w = cvt_pk_bf16(v1[2], v1[3]);
                    *(u32x4*)(rowp + bj * HALF) = w; } }
    }
};
struct EpiResidual {
    static constexpr bool PERM = false, AFTER_DRAIN = false;
    const float* base; float* out; int ldc;
    __device__ __forceinline__ void operator()(const f32x4 (&acc)[2][2][4][2], const Unit& u, int wr, int wc, int fr, int fq) const {
        const int col0 = u.pn * BM + wc * 32 + 4 * fq;
#pragma unroll
        for (int ai = 0; ai < 2; ++ai)
#pragma unroll
            for (int m = 0; m < 4; ++m) { const size_t off = (size_t)(u.pm * BM + ai * HALF + wr * 64 + m * 16 + fr) * ldc + col0;
#pragma unroll
                for (int bj = 0; bj < 2; ++bj)
#pragma unroll
                    for (int n = 0; n < 2; ++n) { const f32x4 bs = *(const f32x4*)(base + off + bj * HALF + n * 16); *(f32x4*)(out + off + bj * HALF + n * 16) = bs + acc[ai][bj][m][n]; }
                asm volatile("" ::: "memory"); }
    }
};
struct EpiSwiGLU {
    static constexpr bool PERM = true, AFTER_DRAIN = false;
    bf16_t* O; int ldc;
    __device__ __forceinline__ void operator()(const f32x4 (&acc)[2][2][4][2], const Unit& u, int wr, int wc, int fr, int fq) const {
        const int col0 = u.pn * HALF + wc * 32 + 8 * fq;
#pragma unroll
        for (int ai = 0; ai < 2; ++ai)
#pragma unroll
            for (int m = 0; m < 4; ++m) { bf16_t* rowp = O + (size_t)(u.pm * BM + ai * HALF + wr * 64 + m * 16 + fr) * ldc + col0;
                float r[8];
#pragma unroll
                for (int n = 0; n < 2; ++n)
#pragma unroll
                    for (int j = 0; j < 4; ++j) { const float g = acc[ai][0][m][n][j], up = acc[ai][1][m][n][j]; r[n * 4 + j] = g * __builtin_amdgcn_rcpf(1.f + __expf(-g)) * up; }
                u32x4 w; w.x = cvt_pk_bf16(r[0], r[1]); w.y = cvt_pk_bf16(r[2], r[3]); w.z = cvt_pk_bf16(r[4], r[5]); w.w = cvt_pk_bf16(r[6], r[7]);
                *(u32x4*)rowp = w; }
    }
};
template <class Epi, class Sched, bool ALIGN_EPI = false, bool SP2 = false>
__device__ __forceinline__ void gemm_phase(PG8_LAS unsigned char* lds, const Gemm g, const Sched& S, const Epi& E) {
    const int tid = threadIdx.x, wid = __builtin_amdgcn_readfirstlane(tid >> 6), lane = tid & 63, wr = wid >> 2, wc = wid & 3, fr = lane & 15, fq = lane >> 4;
    const int K = g.K, nt = K / BK;
    unsigned voffA[2], voffB[2];
#pragma unroll
    for (int i = 0; i < 2; ++i) { int R, C; stage_rc(tid * 16 + i * 8192, R, C); const int Rb = Epi::PERM ? ((R & ~31) + perm32(R & 31)) : R;
        voffA[i] = (unsigned)(R * K + C) * 2u; voffB[i] = (unsigned)(Rb * K + C) * 2u; }
    const size_t kstep = (size_t)(BK * 2);
    const size_t hstep = (size_t)HALF * K * 2;
    const size_t tstep = 2 * hstep;
    const unsigned ldsw = (unsigned)wid * 1024u;
    const int aoff = lds_byte(wr * 64 + fr, fq * 8), boff = lds_byte(wc * 32 + fr, fq * 8);
#define PG8_SA(b, h) (((b) * 2 + (h)) * HTB)
#define PG8_SB(b, h) ((4 + (b) * 2 + (h)) * HTB)
#define PG8_STAGE(bufoff, gbase, voff) do { _Pragma("unroll") for (int _i = 0; _i < 2; ++_i) \
        __builtin_amdgcn_global_load_lds((const unsigned*)((const char*)(gbase) + (voff)[_i]), (PG8_LAS unsigned*)(lds + (bufoff) + ldsw + _i * 8192), 16, 0, 0); } while (0)
#define PG8_LDA(dst, b, h) do { _Pragma("unroll") for (int m = 0; m < 4; ++m) _Pragma("unroll") for (int k = 0; k < 2; ++k) dst[m][k] = *(const PG8_LAS bf16x8*)(lds + PG8_SA(b, h) + aoff + m * 2048 + k * 1024); } while (0)
#define PG8_LDB(dst, b, h) do { _Pragma("unroll") for (int n = 0; n < 2; ++n) _Pragma("unroll") for (int k = 0; k < 2; ++k) dst[n][k] = *(const PG8_LAS bf16x8*)(lds + PG8_SB(b, h) + boff + n * 2048 + k * 1024); } while (0)
#define PG8_MMA(ai, bj, At, Bt) do { __builtin_amdgcn_s_setprio(1); _Pragma("unroll") for (int m = 0; m < 4; ++m) _Pragma("unroll") for (int n = 0; n < 2; ++n) _Pragma("unroll") for (int k = 0; k < 2; ++k) \
        acc[ai][bj][m][n] = __builtin_amdgcn_mfma_f32_16x16x32_bf16(Bt[n][k], At[m][k], acc[ai][bj][m][n], 0, 0, 0); __builtin_amdgcn_s_setprio(0); } while (0)
#define PG8_WAIT_V(n) asm volatile("s_waitcnt vmcnt(" #n ")" ::: "memory")
#define PG8_WAIT_L(n) asm volatile("s_waitcnt lgkmcnt(" #n ")" ::: "memory")
#define PG8_BAR __builtin_amdgcn_s_barrier()
#define PG8_SCHED __builtin_amdgcn_sched_barrier(0)
    Unit cur, nxt; int ui = 0;
    if (!S.next(0, cur)) return;
    f32x4 acc[2][2][4][2];
#pragma unroll
    for (int a = 0; a < 2; ++a)
#pragma unroll
        for (int b = 0; b < 2; ++b)
#pragma unroll
            for (int m = 0; m < 4; ++m)
#pragma unroll
                for (int n = 0; n < 2; ++n) acc[a][b][m][n] = (f32x4){0.f, 0.f, 0.f, 0.f};
    bf16x8 At[4][2], B0[2][2], B1[2][2];
    const char* cA = (const char*)g.A + (size_t)cur.pm * tstep; const char* cB = (const char*)g.Bt + (size_t)cur.pn * tstep;
    S.a_ready(cur);
    if constexpr (SP2) {
        PG8_STAGE(PG8_SB(0, 0), cB, voffB); PG8_STAGE(PG8_SB(0, 1), cB + hstep, voffB); PG8_STAGE(PG8_SA(0, 0), cA, voffA); PG8_STAGE(PG8_SA(0, 1), cA + hstep, voffA);
        if (wr == 1) PG8_BAR;
        PG8_WAIT_V(2); PG8_BAR;
        PG8_STAGE(PG8_SB(1, 0), cB + kstep, voffB); PG8_STAGE(PG8_SA(1, 0), cA + kstep, voffA); PG8_STAGE(PG8_SB(1, 1), cB + hstep + kstep, voffB);
        PG8_WAIT_V(6); PG8_BAR;
    } else {
        PG8_STAGE(PG8_SB(0, 0), cB, voffB); PG8_STAGE(PG8_SA(0, 0), cA, voffA); PG8_STAGE(PG8_SB(0, 1), cB + hstep, voffB); PG8_STAGE(PG8_SA(0, 1), cA + hstep, voffA);
        if (wr == 1) PG8_BAR;
        PG8_WAIT_V(4); PG8_BAR;
        PG8_STAGE(PG8_SB(1, 0), cB + kstep, voffB); PG8_STAGE(PG8_SA(1, 0), cA + kstep, voffA); PG8_STAGE(PG8_SB(1, 1), cB + hstep + kstep, voffB);
        PG8_WAIT_V(6); PG8_BAR;
    }
    for (;;) {
        const bool has_next = S.next(ui + 1, nxt);
        const char* nA = has_next ? (const char*)g.A + (size_t)nxt.pm * tstep : cA; const char* nB = has_next ? (const char*)g.Bt + (size_t)nxt.pn * tstep : cB;
        for (int t = 0; t < nt; t += 2) {
            const bool last = (t == nt - 2);
            const char* a1 = cA + (size_t)(t + 1) * kstep;
            const char* a2 = last ? nA : cA + (size_t)(t + 2) * kstep; const char* b2 = last ? nB : cB + (size_t)(t + 2) * kstep;
            const char* a3 = a2 + kstep; const char* b3 = b2 + kstep;
            if (last && has_next) S.a_ready(nxt);
            if constexpr (SP2) {
            PG8_LDB(B0, 0, 0); PG8_LDB(B1, 0, 1); PG8_SCHED; PG8_LDA(At, 0, 0); PG8_STAGE(PG8_SA(1, 1), a1 + hstep, voffA);
            PG8_WAIT_V(8); PG8_WAIT_L(0); PG8_BAR; PG8_MMA(0, 0, At, B0); PG8_MMA(0, 1, At, B1); PG8_BAR; PG8_SCHED;
            PG8_LDA(At, 0, 1); PG8_STAGE(PG8_SB(0, 0), b2, voffB); PG8_STAGE(PG8_SB(0, 1), b2 + hstep, voffB); PG8_STAGE(PG8_SA(0, 0), a2, voffA);
            PG8_WAIT_V(8); PG8_WAIT_L(0); PG8_BAR; PG8_MMA(1, 0, At, B0); PG8_MMA(1, 1, At, B1); PG8_BAR; PG8_SCHED;
            PG8_LDB(B0, 1, 0); PG8_LDB(B1, 1, 1); PG8_SCHED; PG8_LDA(At, 1, 0); PG8_STAGE(PG8_SA(0, 1), a2 + hstep, voffA);
            PG8_WAIT_V(8); PG8_WAIT_L(0); PG8_BAR; PG8_MMA(0, 0, At, B0); PG8_MMA(0, 1, At, B1); PG8_BAR; PG8_SCHED;
            PG8_LDA(At, 1, 1); PG8_STAGE(PG8_SB(1, 0), b3, voffB); PG8_STAGE(PG8_SB(1, 1), b3 + hstep, voffB); PG8_STAGE(PG8_SA(1, 0), a3, voffA);
            PG8_WAIT_V(8); PG8_WAIT_L(0); PG8_BAR; PG8_MMA(1, 0, At, B0); PG8_MMA(1, 1, At, B1); PG8_BAR; PG8_SCHED;
            } else {
            PG8_LDB(B0, 0, 0); PG8_SCHED; PG8_LDA(At, 0, 0); PG8_STAGE(PG8_SA(1, 1), a1 + hstep, voffA);
            PG8_WAIT_L(8); PG8_BAR; PG8_WAIT_L(0); PG8_MMA(0, 0, At, B0); PG8_BAR; PG8_SCHED;
            PG8_LDB(B1, 0, 1); PG8_STAGE(PG8_SB(0, 0), b2, voffB);
            PG8_BAR; PG8_WAIT_L(0); PG8_MMA(0, 1, At, B1); PG8_BAR;
            PG8_LDA(At, 0, 1); PG8_STAGE(PG8_SA(0, 0), a2, voffA);
            PG8_BAR; PG8_WAIT_L(0); PG8_MMA(1, 0, At, B0); PG8_BAR; PG8_SCHED;
            PG8_STAGE(PG8_SB(0, 1), b2 + hstep, voffB);
            PG8_WAIT_V(6); PG8_BAR; PG8_MMA(1, 1, At, B1); PG8_BAR;
            PG8_LDB(B0, 1, 0); PG8_SCHED; PG8_LDA(At, 1, 0); PG8_STAGE(PG8_SA(0, 1), a2 + hstep, voffA);
            PG8_WAIT_L(8); PG8_BAR; PG8_WAIT_L(0); PG8_MMA(0, 0, At, B0); PG8_BAR; PG8_SCHED;
            PG8_LDB(B1, 1, 1); PG8_STAGE(PG8_SB(1, 0), b3, voffB);
            PG8_BAR; PG8_WAIT_L(0); PG8_MMA(0, 1, At, B1); PG8_BAR;
            PG8_LDA(At, 1, 1); PG8_STAGE(PG8_SA(1, 0), a3, voffA);
            PG8_BAR; PG8_WAIT_L(0); PG8_MMA(1, 0, At, B0); PG8_BAR; PG8_SCHED;
            PG8_STAGE(PG8_SB(1, 1), b3 + hstep, voffB);
            PG8_WAIT_V(6); PG8_BAR; PG8_MMA(1, 1, At, B1); PG8_BAR;
            }
        }
        if constexpr (ALIGN_EPI) { if (wr == 0) PG8_BAR; }
        if constexpr (!Epi::AFTER_DRAIN) { E(acc, cur, wr, wc, fr, fq); S.done(cur); }
        if (!has_next) break;
#pragma unroll
        for (int a = 0; a < 2; ++a)
#pragma unroll
            for (int b = 0; b < 2; ++b)
#pragma unroll
                for (int m = 0; m < 4; ++m)
#pragma unroll
                    for (int n = 0; n < 2; ++n) acc[a][b][m][n] = (f32x4){0.f, 0.f, 0.f, 0.f};
        cur = nxt; cA = nA; cB = nB; ++ui;
        if constexpr (ALIGN_EPI) { if (wr == 1) PG8_BAR; }
    }
    PG8_WAIT_V(0);
    if constexpr (!ALIGN_EPI) { if (wr == 0) PG8_BAR; }
    PG8_BAR;
    if constexpr (Epi::AFTER_DRAIN) { E.fused(acc, cur, wr, wc, fr, fq, lds, wid, lane); S.done(cur); }
#undef PG8_SA
#undef PG8_SB
#undef PG8_STAGE
#undef PG8_LDA
#undef PG8_LDB
#undef PG8_MMA
#undef PG8_WAIT_V
#undef PG8_WAIT_L
#undef PG8_BAR
#undef PG8_SCHED
}
}

#ifndef PG8_SP2
#define PG8_SP2 true
#endif
#define PG8_ALIGN true
constexpr int NWAVES = 8;
constexpr int BATCH = 2, SEQ = 8192, DM = 1024, M = BATCH * SEQ, NIN = 3788, NINP = 3840, FFN = 2816, DEPTH = 2;
constexpr int A_Q = 0, A_K = 256, A_V = 512, A_O = 768;
constexpr int R_R = 1024, R_K = 1408, R_V = 1792, R_WDF = 2176, R_AD = 2304, R_GD = 2368;
constexpr int S_Z = 2496, S_X = 2880, S_B = 3264, S_C = 3520, S_DT = 3776;
constexpr size_t MiB = 1u << 20;
constexpr size_t WS_CTL = 0, CTL_ZERO_BYTES = 128 * 1024;
constexpr size_t WS_GATES = 1 * MiB, WS_CT = 2 * MiB, WS_DTV = 2 * MiB + 512 * 1024;
constexpr size_t WS_WIN = 4 * MiB, WS_WOUT = 12 * MiB, WS_WGU = 14 * MiB, WS_WDN = 25 * MiB;
constexpr size_t WS_XN = 32 * MiB, WS_COLS = 64 * MiB, WS_Y = 184 * MiB, WS_END = 256 * MiB;
constexpr size_t Y_AF = WS_Y, Y_AB = WS_Y + 8 * MiB, Y_RF = WS_Y + 16 * MiB, Y_RB = WS_Y + 28 * MiB, Y_SF = WS_Y + 40 * MiB, Y_SB = WS_Y + 52 * MiB;
constexpr int CW_BAR = 1024;
constexpr int RING_BYTES = 131072;
constexpr int LDS_BYTES = 147456, MISC_OFF = LDS_BYTES - 256;

#define GAS __attribute__((address_space(1)))
#define LAS __attribute__((address_space(3)))
typedef unsigned short bf16;
typedef unsigned v4u __attribute__((ext_vector_type(4)));
typedef unsigned v2u __attribute__((ext_vector_type(2)));
typedef float f32x4 __attribute__((ext_vector_type(4)));
typedef short bf16x8 __attribute__((ext_vector_type(8)));
typedef GAS unsigned gu32;
#define RLX_AGENT __ATOMIC_RELAXED, __HIP_MEMORY_SCOPE_AGENT
#define LDS_WAIT() asm volatile("s_waitcnt lgkmcnt(0)" ::: "memory")
#define VM_WAIT() asm volatile("s_waitcnt vmcnt(0)" ::: "memory")
__device__ __forceinline__ unsigned f2bf(float f) { unsigned u = __builtin_bit_cast(unsigned, f); return (u + 0x7fffu + ((u >> 16) & 1u)) >> 16; }
__device__ __forceinline__ unsigned pk2(float lo, float hi) { return f2bf(lo) | (f2bf(hi) << 16); }
__device__ __forceinline__ float bf2f(unsigned u) { return __builtin_bit_cast(float, u << 16); }
__device__ __forceinline__ float sigmoidf_(float x) { return __builtin_amdgcn_rcpf(1.f + __expf(-x)); }
__device__ __forceinline__ float siluf_(float x) { return x * sigmoidf_(x); }
__device__ __forceinline__ float wave_sum(float v) {
#pragma unroll
    for (int o = 1; o < 64; o <<= 1) v += __shfl_xor(v, o);
    return v;
}
__device__ __forceinline__ float wave_max(float v) {
#pragma unroll
    for (int o = 1; o < 64; o <<= 1) v = fmaxf(v, __shfl_xor(v, o));
    return v;
}
template <int CTRL> __device__ __forceinline__ float dppf(float v) { return __builtin_bit_cast(float, __builtin_amdgcn_update_dpp(0, __builtin_bit_cast(int, v), CTRL, 0xf, 0xf, true)); }
__device__ __forceinline__ float row16_sum(float v) { v += dppf<0xB1>(v); v += dppf<0x4E>(v); v += dppf<0x141>(v); v += dppf<0x140>(v); return v; }
template <int K> __device__ __forceinline__ f32x4 mma16(const LAS bf16* A, int lda, const LAS bf16* Bt, int ldb, f32x4 acc, int lane) {
    const int r = lane & 15, q = lane >> 4;
    const LAS bf16* ap = A + r * lda + q * 8; const LAS bf16* bp = Bt + r * ldb + q * 8;
#pragma unroll
    for (int k0 = 0; k0 < K; k0 += 32) {
        const bf16x8 a = *(const LAS bf16x8*)(ap + k0); const bf16x8 b = *(const LAS bf16x8*)(bp + k0);
        acc = __builtin_amdgcn_mfma_f32_16x16x32_bf16(a, b, acc, 0, 0, 0);
    }
    return acc;
}

__device__ __forceinline__ int swz64(int row, int col) { return col ^ (((row >> 3) & 7) << 3); }
template <bool SWA, bool SWB> __device__ __forceinline__ f32x4 mma16s(const LAS bf16* A, int lda, int rowA0, const LAS bf16* Bt, int ldb, int rowB0, f32x4 acc, int lane) {
    const int r = lane & 15, q = lane >> 4; const int ra = rowA0 + r, rb = rowB0 + r;
#pragma unroll
    for (int k0 = 0; k0 < 64; k0 += 32) { const int ca = k0 + 8 * q, cb = k0 + 8 * q;
        const bf16x8 a = *(const LAS bf16x8*)(A + ra * lda + (SWA ? swz64(ra, ca) : ca)); const bf16x8 b = *(const LAS bf16x8*)(Bt + rb * ldb + (SWB ? swz64(rb, cb) : cb));
        acc = __builtin_amdgcn_mfma_f32_16x16x32_bf16(a, b, acc, 0, 0, 0); }
    return acc;
}

template <int CTRL, int RM, int BM> __device__ __forceinline__ float dppm(float oldv, float v) { return __builtin_bit_cast(float, __builtin_amdgcn_update_dpp(__builtin_bit_cast(int, oldv), __builtin_bit_cast(int, v), CTRL, RM, BM, false)); }
__device__ __forceinline__ float wave_scan_add(float x) {
    float y = x + dppm<0x111, 0xf, 0xf>(0.f, x); y += dppm<0x112, 0xf, 0xf>(0.f, x); y += dppm<0x113, 0xf, 0xf>(0.f, x);
    y += dppm<0x114, 0xf, 0xe>(0.f, y); y += dppm<0x118, 0xf, 0xc>(0.f, y);
    y += dppm<0x142, 0xa, 0xf>(0.f, y); y += dppm<0x143, 0xc, 0xf>(0.f, y);
    return y;
}
__device__ __forceinline__ float wave_scan_max(float x) {
    const float ninf = -INFINITY;
    float y = fmaxf(x, dppm<0x111, 0xf, 0xf>(ninf, x)); y = fmaxf(y, dppm<0x112, 0xf, 0xf>(ninf, x)); y = fmaxf(y, dppm<0x113, 0xf, 0xf>(ninf, x));
    y = fmaxf(y, dppm<0x114, 0xf, 0xe>(ninf, y)); y = fmaxf(y, dppm<0x118, 0xf, 0xc>(ninf, y));
    y = fmaxf(y, dppm<0x142, 0xa, 0xf>(ninf, y)); y = fmaxf(y, dppm<0x143, 0xc, 0xf>(ninf, y));
    return y;
}
#define XB_TMO      128
#define XB_XCNT(j)  (256  + 64 * (j))
#define XB_XSUB(j)  (1280 + 64 * (j))
#define XB_XGEN(j)  (2304 + 64 * (j))
#define XB_TOP      3328
#define XB_TOPGEN   3392
#define XCD_BAR_WORDS 3456
#define XB_SPIN_CAP (1u << 18)

__device__ __forceinline__ unsigned xb_ld(unsigned* p)              { return __hip_atomic_load(p, __ATOMIC_RELAXED, __HIP_MEMORY_SCOPE_AGENT); }
__device__ __forceinline__ unsigned xb_add(unsigned* p, unsigned v) { return __hip_atomic_fetch_add(p, v, __ATOMIC_RELAXED, __HIP_MEMORY_SCOPE_AGENT); }
__device__ __forceinline__ unsigned xb_xcc_id() { return (unsigned)__builtin_amdgcn_s_getreg((3 << 11) | 20) & 0xFu; }
#define XB_SPIN(cond, bar) do { unsigned _sp = 0; while (cond) { __builtin_amdgcn_s_sleep(1); \
    if ((++_sp & 255u) == 0u) { if (xb_ld(&(bar)[XB_TMO])) break; if (_sp > XB_SPIN_CAP) { atomicAdd(&(bar)[XB_TMO], 1u); break; } } } } while (0)

struct XcdBarrier {
    unsigned* bar; unsigned x;
    volatile LAS unsigned* st;
};

__device__ __forceinline__ XcdBarrier xcd_barrier_post(unsigned* bar, volatile LAS unsigned* st) {
    XcdBarrier b; b.bar = bar; b.x = xb_xcc_id(); b.st = st;
    if (threadIdx.x == 0) (void)xb_add(&bar[XB_XCNT(b.x)], 1u);
    return b;
}
__device__ __forceinline__ void xcd_barrier_complete(unsigned* bar, unsigned x, unsigned& nloc, unsigned& nx) {
    const unsigned G = gridDim.x * gridDim.y * gridDim.z;
    unsigned sum, cnt, mine, sp = 0u;
    for (;;) {
        sum = 0u; cnt = 0u; mine = 0u;
#pragma unroll
        for (unsigned j = 0; j < 16; ++j) { const unsigned c = xb_ld(&bar[XB_XCNT(j)]); sum += c; cnt += (c > 0u) ? 1u : 0u; mine = (j == x) ? c : mine; }
        if (sum == G) break;
        __builtin_amdgcn_s_sleep(1);
        if ((++sp & 255u) == 0u) { if (xb_ld(&bar[XB_TMO])) break; if (sp > XB_SPIN_CAP) { atomicAdd(&bar[XB_TMO], 1u); break; } }
    }
    nloc = mine > 0u ? mine : 1u; nx = cnt > 0u ? cnt : 1u;
}

__device__ __forceinline__ void xcd_barrier(const XcdBarrier& b) {
    asm volatile("s_waitcnt vmcnt(0)" ::: "memory");
    __syncthreads();
    if (threadIdx.x == 0) {
        unsigned* bar = b.bar;
        __builtin_amdgcn_s_waitcnt(0);
        unsigned nloc = b.st[0], nx = b.st[1];
        if (nloc == 0u) { xcd_barrier_complete(bar, b.x, nloc, nx); b.st[0] = nloc; b.st[1] = nx; }
        const unsigned old = xb_add(&bar[XB_XSUB(b.x)], 1u);
        const unsigned gen = old / nloc;
        if (old + 1u == (gen + 1u) * nloc) {
            __builtin_amdgcn_fence(__ATOMIC_RELEASE, "agent");
            asm volatile("s_waitcnt vmcnt(0)" ::: "memory");
            const unsigned og = xb_add(&bar[XB_TOP], 1u);
            const unsigned tg = og / nx;
            if (og + 1u == (tg + 1u) * nx) xb_add(&bar[XB_TOPGEN], 1u);
            else XB_SPIN(xb_ld(&bar[XB_TOPGEN]) == tg, bar);
            __builtin_amdgcn_fence(__ATOMIC_ACQUIRE, "agent");
            xb_add(&bar[XB_XGEN(b.x)], 1u);
            asm volatile("s_waitcnt vmcnt(0)" ::: "memory");
        } else {
            XB_SPIN(xb_ld(&bar[XB_XGEN(b.x)]) == gen, bar);
            __builtin_amdgcn_fence(__ATOMIC_ACQUIRE, "agent");
            asm volatile("s_waitcnt vmcnt(0)" ::: "memory");
        }
    }
    __syncthreads();
}
struct Frame {
    LAS unsigned char* lds;
    int tid, lane, wave, vcu, G;
};
struct Args { const float* in[32]; float* out; unsigned char* ws; int ph_lo, ph_hi; };
constexpr int PTAB_OFF = LDS_BYTES - 768;
__device__ __forceinline__ unsigned long long ptab_ld(const Frame& F, int i) {
    const unsigned long long v = *(volatile LAS unsigned long long*)(F.lds + PTAB_OFF + 8 * i);
    const unsigned lo = __builtin_amdgcn_readfirstlane((unsigned)v), hi = __builtin_amdgcn_readfirstlane((unsigned)(v >> 32));
    return ((unsigned long long)hi << 32) | lo;
}
__device__ __forceinline__ const float* INP(const Frame& F, int i) { return (const float*)ptab_ld(F, i); }
__device__ __forceinline__ unsigned char* WSP(const Frame& F) { return (unsigned char*)ptab_ld(F, 33); }
__device__ __forceinline__ float* OUTP(const Frame& F) { return (float*)ptab_ld(F, 32); }

__device__ __forceinline__ void transpose_item(const float* W, int K, int N, int nblk, bf16* WT, int mode, int row_off, LAS float* scr, int item, int lane) {
    const int kb = item / nblk, nb = item % nblk, k0 = 64 * kb, n0 = 32 * nb;
    const int ncol = n0 + (lane & 31); const bool ok = ncol < N;
#pragma unroll 8
    for (int i = 0; i < 32; ++i) { const int kk = 2 * i + (lane >> 5); scr[kk * 33 + (lane & 31)] = ok ? W[(size_t)(k0 + kk) * N + ncol] : 0.f; }
    LDS_WAIT(); asm volatile("" ::: "memory");
    const int c = lane & 7;
    const int drow0 = mode ? (256 * (n0 >> 7) + (n0 & 127) + row_off) : (row_off + n0);
#pragma unroll
    for (int j = 0; j < 4; ++j) { const int n = (lane >> 3) + 8 * j; const LAS float* s = scr + (8 * c) * 33 + n;
        v4u o; o.x = pk2(s[0 * 33], s[1 * 33]); o.y = pk2(s[2 * 33], s[3 * 33]); o.z = pk2(s[4 * 33], s[5 * 33]); o.w = pk2(s[6 * 33], s[7 * 33]);
        *(v4u*)(WT + (size_t)(drow0 + n) * K + k0 + 8 * c) = o; }
    LDS_WAIT(); asm volatile("" ::: "memory");
}
__device__ __forceinline__ void phase_convert(const Frame& F, int l) {
    LAS float* scr = (LAS float*)(F.lds + F.wave * 16384);
    const int gw = F.vcu * NWAVES + F.wave, NGW = F.G * NWAVES;
    bf16* Win = (bf16*)(WSP(F) + WS_WIN); bf16* Wout = (bf16*)(WSP(F) + WS_WOUT); bf16* Wgu = (bf16*)(WSP(F) + WS_WGU); bf16* Wdn = (bf16*)(WSP(F) + WS_WDN);
    constexpr int I_IN = 16 * 120, I_OUT = 16 * 32, I_G = 16 * 88, I_D = 44 * 32;
    constexpr int NITEMS = I_IN + I_OUT + 2 * I_G + I_D;
    for (int it = gw; it < NITEMS; it += NGW) {
        int r = it;
        if (r < I_IN) { transpose_item(INP(F, 2) + (size_t)l * DM * NIN, DM, NIN, 120, Win, 0, 0, scr, r, F.lane); continue; } r -= I_IN;
        if (r < I_OUT) { transpose_item(INP(F, 26) + (size_t)l * DM * DM, DM, DM, 32, Wout, 0, 0, scr, r, F.lane); continue; } r -= I_OUT;
        if (r < I_G) { transpose_item(INP(F, 28) + (size_t)l * DM * FFN, DM, FFN, 88, Wgu, 1, 0, scr, r, F.lane); continue; } r -= I_G;
        if (r < I_G) { transpose_item(INP(F, 29) + (size_t)l * DM * FFN, DM, FFN, 88, Wgu, 1, 128, scr, r, F.lane); continue; } r -= I_G;
        transpose_item(INP(F, 30) + (size_t)l * FFN * DM, FFN, DM, 32, Wdn, 0, 0, scr, r, F.lane);
    }
}
__device__ __forceinline__ void phase_norm(const Frame& F, const float* hin, const float* g, bf16* XN) {
    const int gw = F.vcu * NWAVES + F.wave, NGW = F.G * NWAVES;
    f32x4 gv[4];
#pragma unroll
    for (int j = 0; j < 4; ++j) gv[j] = ((const f32x4*)g)[64 * j + F.lane];
    for (int m = gw; m < M; m += NGW) {
        const f32x4* xr = (const f32x4*)(hin + (size_t)m * DM) + F.lane;
        f32x4 v[4]; float s = 0.f;
#pragma unroll
        for (int j = 0; j < 4; ++j) { v[j] = xr[64 * j]; s += (v[j].x * v[j].x + v[j].y * v[j].y) + (v[j].z * v[j].z + v[j].w * v[j].w); }
        const float r = 1.f / sqrtf(wave_sum(s) * (1.f / DM) + 1e-6f);
        v2u* o8 = (v2u*)(XN + (size_t)m * DM) + F.lane;
#pragma unroll
        for (int j = 0; j < 4; ++j) { v2u w; w.x = pk2(v[j].x * r * gv[j].x, v[j].y * r * gv[j].y); w.y = pk2(v[j].z * r * gv[j].z, v[j].w * r * gv[j].w); o8[64 * j] = w; }
    }
}
__device__ __forceinline__ void phase_final_norm(const Frame& F, float* h, const float* g) {
    const int gw = F.vcu * NWAVES + F.wave, NGW = F.G * NWAVES;
    f32x4 gv[4];
#pragma unroll
    for (int j = 0; j < 4; ++j) gv[j] = ((const f32x4*)g)[64 * j + F.lane];
    for (int m = gw; m < M; m += NGW) {
        f32x4* xr = (f32x4*)(h + (size_t)m * DM) + F.lane;
        f32x4 v[4]; float s = 0.f;
#pragma unroll
        for (int j = 0; j < 4; ++j) { v[j] = xr[64 * j]; s += (v[j].x * v[j].x + v[j].y * v[j].y) + (v[j].z * v[j].z + v[j].w * v[j].w); }
        const float r = 1.f / sqrtf(wave_sum(s) * (1.f / DM) + 1e-6f);
#pragma unroll
        for (int j = 0; j < 4; ++j) xr[64 * j] = v[j] * r * gv[j];
    }
}
__device__ __forceinline__ void phase_gates(const Frame& F, int l) {
    const bf16* cols = (const bf16*)(WSP(F) + WS_COLS); float* GT = (float*)(WSP(F) + WS_GATES);
    LAS bf16* raw = (LAS bf16*)(F.lds);
    LAS bf16* featb = (LAS bf16*)(F.lds + 30720);
    LAS bf16* gwT = (LAS bf16*)(F.lds + 55552);
    LAS float* outp = (LAS float*)(F.lds + 80384);
    const float* gwg = INP(F, 5) + (size_t)l * 768 * 16; const float* gb = INP(F, 6) + l * 16;
    const int tid = F.tid, lane = F.lane, wave = F.wave;
    __syncthreads();
    for (int i = tid; i < 768 * 16; i += 512) gwT[(i & 15) * 776 + (i >> 4)] = (bf16)f2bf(gwg[i]);
    float cw[5]; { const float* cwp = INP(F, 3) + (size_t)l * 5 * 512;
#pragma unroll
        for (int j = 0; j < 5; ++j) cw[j] = cwp[j * 512 + tid]; }
    const float cbv = INP(F, 4)[l * 512 + tid];
    const float gbv = gb[tid & 15];
    for (int tile = F.vcu; tile < M / 16; tile += F.G) {
        const int m0 = tile * 16, t0 = m0 % SEQ;
        __syncthreads();
        for (int ch = tid; ch < 20 * 96; ch += 512) { const int rr = ch / 96, cc = ch % 96; const int t = t0 - 2 + rr;
            v4u v = {0u, 0u, 0u, 0u}; if (t >= 0 && t < SEQ) v = *(const v4u*)(cols + (size_t)(m0 - 2 + rr) * NINP + cc * 8);
            *(LAS v4u*)(raw + rr * 768 + cc * 8) = v; }
        if (tid < 256) outp[tid] = 0.f;
        __syncthreads();
        { float win[5];
#pragma unroll
          for (int j = 0; j < 4; ++j) win[j] = bf2f(raw[j * 768 + tid]);
#pragma unroll 4
          for (int t = 0; t < 16; ++t) { win[4] = bf2f(raw[(t + 4) * 768 + tid]); float s = cbv;
#pragma unroll
              for (int j = 0; j < 5; ++j) s += cw[j] * win[j];
#pragma unroll
              for (int j = 0; j < 4; ++j) win[j] = win[j + 1];
              featb[t * 776 + tid] = (bf16)f2bf(siluf_(s)); }
          const int t = tid >> 5, c8 = tid & 31; *(LAS v4u*)(featb + t * 776 + 512 + c8 * 8) = *(const LAS v4u*)(raw + (t + 2) * 768 + 512 + c8 * 8); }
        __syncthreads();
        { const f32x4 z = {0.f, 0.f, 0.f, 0.f}; const f32x4 acc = mma16<96>(featb + 96 * wave, 776, gwT + 96 * wave, 776, z, lane);
#pragma unroll
          for (int jj = 0; jj < 4; ++jj) __hip_atomic_fetch_add(outp + ((lane >> 4) * 4 + jj) * 16 + (lane & 15), acc[jj], __ATOMIC_RELAXED, __HIP_MEMORY_SCOPE_WORKGROUP); }
        __syncthreads();
        if (tid < 256) { float s = outp[tid] + gbv; if ((tid & 15) >= 8) s = fminf(s, 0.f) - log1pf(__expf(-fabsf(s))); GT[(size_t)(m0 + (tid >> 4)) * 16 + (tid & 15)] = s; }
    }
    __syncthreads();
}
__device__ __forceinline__ f32x4 mma16_a8(const LAS bf16* A8, const LAS bf16* Bt, f32x4 acc, int lane) {
    const int q = lane >> 4;
    const LAS bf16* ap = A8 + (lane & 7) * 72 + q * 8; const LAS bf16* bp = Bt + (lane & 15) * 72 + q * 8;
#pragma unroll
    for (int k0 = 0; k0 < 64; k0 += 32) { const bf16x8 a = *(const LAS bf16x8*)(ap + k0); const bf16x8 b = *(const LAS bf16x8*)(bp + k0); acc = __builtin_amdgcn_mfma_f32_16x16x32_bf16(a, b, acc, 0, 0, 0); }
    return acc;
}
typedef float f32x2 __attribute__((ext_vector_type(2)));
template <bool DIR> __device__ __forceinline__ void rwkv_steps(const LAS float* OPS, const LAS float* VV, LAS float* YB, f32x4& S, int j, int row) {
    float yk0 = 0.f, yk1 = 0.f;
    const LAS float* opb = OPS + 4 * j; const LAS float* vpb = VV + row;
#define RWLD(W_, KK_, KA_, KM_, R_, V_, tl_) do { const LAS float* op_ = opb + (tl_) * 320; W_ = *(const LAS f32x4*)(op_); KK_ = *(const LAS f32x4*)(op_ + 64); KA_ = *(const LAS f32x4*)(op_ + 128); KM_ = *(const LAS f32x4*)(op_ + 192); R_ = *(const LAS f32x4*)(op_ + 256); V_ = vpb[(tl_) * 16]; } while (0)
    f32x4 w4, kk4, ka4, km4, r4, w4b, kk4b, ka4b, km4b, r4b; float vv, vvb;
    RWLD(w4, kk4, ka4, km4, r4, vv, (DIR ? 31 : 0));
    RWLD(w4b, kk4b, ka4b, km4b, r4b, vvb, (DIR ? 30 : 1));
#pragma unroll
    for (int i = 0; i < 32; ++i) {
        f32x4 nw4, nkk4, nka4, nkm4, nr4; float nvv;
        if (i < 30) RWLD(nw4, nkk4, nka4, nkm4, nr4, nvv, (DIR ? 29 - i : i + 2));
        f32x2 t2 = S.xy * kk4.xy; t2 = S.zw * kk4.zw + t2;
        float sa = t2.x + t2.y;
        const f32x4 pre_s = S * w4 + km4 * vv;
        sa = row16_sum(sa);
        S = pre_s + ka4 * sa;
        f32x2 y2 = S.xy * r4.xy; y2 = S.zw * r4.zw + y2;
        float y = y2.x + y2.y;
        y = row16_sum(y);
        if ((i & 15) == j) { if (i < 16) yk0 = y; else yk1 = y; }
        w4 = w4b; kk4 = kk4b; ka4 = ka4b; km4 = km4b; r4 = r4b; vv = vvb;
        if (i < 30) { w4b = nw4; kk4b = nkk4; ka4b = nka4; km4b = nkm4; r4b = nr4; vvb = nvv; } }
#undef RWLD
    YB[(DIR ? 31 - j : j) * 16 + row] = yk0; YB[(DIR ? 15 - j : 16 + j) * 16 + row] = yk1;
}
struct RwCtx { LAS bf16* WA; LAS bf16* WW; LAS bf16* XA; LAS bf16* XW; LAS bf16* RAWB; LAS float* MU; float* CT; const bf16* colsb;
    f32x4 kk_c4, ka_c4, rk_c4; float ba[4], bw[4]; float mup_[5][2], mun_[5][2]; int h, dir, qtr, tb0; size_t mb; };
template <int NTOK> __device__ __forceinline__ void rw_addr_init(int (&poff)[5], int (&prr)[5], int lane, int tb0, int h, int dir) {
    constexpr int NCHK = (NTOK + 2) * 40;
#pragma unroll
    for (int i = 0; i < 5; ++i) { const int idx = lane + 64 * i; const int rr = idx / 40, q = idx % 40, wh = q >> 3, c8 = q & 7;
        const int gc = (wh == 0 ? R_R + h * 64 : wh == 1 ? R_K + h * 64 : wh == 2 ? R_V + h * 64 : wh == 3 ? R_WDF + dir * 64 : R_AD) + c8 * 8;
        prr[i] = idx < NCHK ? tb0 - 1 + rr : -100000; poff[i] = (tb0 - 1 + rr) * NINP + gc; }
}
template <int NTOK> __device__ __forceinline__ void rw_issue(v4u (&pre)[5], const int (&poff)[5], const int (&prr)[5], const bf16* colsb, int T0) {
    constexpr int NCH = ((NTOK + 2) * 40 + 63) / 64;
#pragma unroll
    for (int i = 0; i < NCH; ++i) { pre[i] = (v4u){0u, 0u, 0u, 0u}; const int t = T0 + prr[i]; if (t >= 0 && t < SEQ) pre[i] = *(const v4u*)(colsb + (size_t)T0 * NINP + poff[i]); }
}
template <int NTOK, bool FULLV> __device__ __forceinline__ void rw_prep(const RwCtx& C, const v4u (&pre)[5], LAS float* OPS, LAS float* VV, int T0, int lane) {
    constexpr int NCHK = (NTOK + 2) * 40, NCH = (NCHK + 63) / 64;
    const int j = lane & 15, c2 = (lane & 31) * 2;
#pragma unroll
    for (int i = 0; i < NCH; ++i) { const int idx = lane + 64 * i; if (idx < NCHK) *(LAS v4u*)(C.RAWB + idx * 8) = pre[i]; }
    LDS_WAIT(); asm volatile("" ::: "memory");
#pragma unroll
    for (int which = 0; which < 5; ++which)
#pragma unroll
        for (int pr = 0; pr < NTOK / 2; ++pr) { const int tt = 2 * pr + (lane >> 5), cc = which * 64 + c2, t = C.tb0 + tt;
            const unsigned r0 = *(const LAS unsigned*)(C.RAWB + tt * 320 + cc), r1 = *(const LAS unsigned*)(C.RAWB + (tt + 1) * 320 + cc), r2 = *(const LAS unsigned*)(C.RAWB + (tt + 2) * 320 + cc);
            const float p1x = bf2f(r1 & 0xffffu), p1y = bf2f(r1 >> 16);
            const float vx = p1x + C.mup_[which][0] * (bf2f(r0 & 0xffffu) - p1x) + C.mun_[which][0] * (bf2f(r2 & 0xffffu) - p1x);
            const float vy = p1y + C.mup_[which][1] * (bf2f(r0 >> 16) - p1y) + C.mun_[which][1] * (bf2f(r2 >> 16) - p1y);
            if (which == 0) *(LAS f32x2*)(OPS + t * 320 + 256 + c2) = (f32x2){vx, vy};
            else if (which == 1) *(LAS f32x2*)(OPS + t * 320 + 192 + c2) = (f32x2){vx, vy};
            else if (which == 2) { if (FULLV) *(LAS f32x2*)(VV + t * 64 + c2) = (f32x2){vx, vy}; else if ((c2 >> 4) == C.qtr) *(LAS f32x2*)(VV + t * 16 + (c2 & 15)) = (f32x2){vx, vy}; }
            else if (which == 3) { const float ex = __expf(2.f * vx), ey = __expf(2.f * vy);
                *(LAS unsigned*)(C.XW + tt * 72 + c2) = pk2(1.f - 2.f * __builtin_amdgcn_rcpf(ex + 1.f), 1.f - 2.f * __builtin_amdgcn_rcpf(ey + 1.f)); }
            else *(LAS unsigned*)(C.XA + tt * 72 + c2) = pk2(vx, vy); }
    LDS_WAIT(); asm volatile("" ::: "memory");
    { const bool hi = lane >= 32; const int lr = ((lane >> 4) & 1) * 4 + (hi ? 2 : 0); const bool ok0 = lr < NTOK, ok1 = lr + 1 < NTOK; const int tb = C.tb0 + lr;
#pragma unroll
      for (int ct = 0; ct < 4; ++ct) { const f32x4 z = {0.f, 0.f, 0.f, 0.f};
        const f32x4 ca = mma16_a8(C.XA, C.WA + ct * 16 * 72, z, lane), cw = mma16_a8(C.XW, C.WW + ct * 16 * 72, z, lane);
        const int c = ct * 16 + j;
        const float a0v = hi ? ca[2] : ca[0], a1v = hi ? ca[3] : ca[1], w0v = hi ? cw[2] : cw[0], w1v = hi ? cw[3] : cw[1];
        if (ok0) { OPS[tb * 320 + 128 + c] = sigmoidf_(C.ba[ct] + a0v); OPS[tb * 320 + c] = __expf(-0.6065306597f * sigmoidf_(C.bw[ct] + w0v)); }
        if (ok1) { OPS[(tb + 1) * 320 + 128 + c] = sigmoidf_(C.ba[ct] + a1v); OPS[(tb + 1) * 320 + c] = __expf(-0.6065306597f * sigmoidf_(C.bw[ct] + w1v)); } } }
    LDS_WAIT(); asm volatile("" ::: "memory");
#pragma unroll
    for (int ps = 0; ps < (NTOK + 3) / 4; ++ps) { const int tl = 4 * ps + (lane >> 4); const bool ok = tl < NTOK; const int t = C.tb0 + (ok ? tl : 0); LAS float* op = OPS + t * 320 + 4 * j;
        const f32x4 av = *(const LAS f32x4*)(op + 128), kp = *(const LAS f32x4*)(op + 192), rp = *(const LAS f32x4*)(op + 256);
        const f32x4 kr = kp * C.kk_c4; const float ss = row16_sum((kr.x * kr.x + kr.y * kr.y) + (kr.z * kr.z + kr.w * kr.w));
        const f32x4 kkv = kr * (1.f / fmaxf(sqrtf(ss), 1e-12f));
        const f32x4 km = kp * ((av - 1.f) * C.ka_c4 + 1.f);
        const f32x4 q = rp * km * C.rk_c4; const float cs = row16_sum((q.x + q.y) + (q.z + q.w));
        if (ok) { *(LAS f32x4*)(op + 64) = kkv; *(LAS f32x4*)(op + 128) = kkv * (-av); *(LAS f32x4*)(op + 192) = km;
            if (C.dir == 0 && C.qtr == 0 && j == 0) C.CT[(C.mb + T0 + t) * 8 + C.h] = cs; } }
}

constexpr int RW_NSLOT = 6, RW_SLOT_WORDS = 32 * 320 + 32 * 64;
constexpr size_t WS_RING = 248 * MiB;
constexpr int CW_RW = 8192;
__device__ __forceinline__ unsigned rw_ld(unsigned* p) { return __hip_atomic_load(p, __ATOMIC_RELAXED, __HIP_MEMORY_SCOPE_AGENT); }
__device__ __forceinline__ void rw_st(unsigned* p, unsigned v) { __hip_atomic_store(p, v, __ATOMIC_RELAXED, __HIP_MEMORY_SCOPE_AGENT); }
__device__ __forceinline__ void rwkv_produce(const Frame& F, int l, int p, int pp, unsigned G0) {
    const int b = p / 12, rem = p % 12, h = rem >> 1, dir = rem & 1;
    const bf16* cols = (const bf16*)(WSP(F) + WS_COLS);
    const int tid = F.tid, lane = F.lane, wave = F.wave;
    LAS bf16* WA = (LAS bf16*)(F.lds); LAS bf16* WW = (LAS bf16*)(F.lds + 9216);
    LAS float* MU = (LAS float*)(F.lds + 67584);
    LAS float* OPS = (LAS float*)(F.lds + 70144);
    LAS float* VV = (LAS float*)(F.lds + 111104);
    LAS unsigned* flg = (LAS unsigned*)(F.lds + 119296);
    unsigned* ctl = (unsigned*)(WSP(F) + WS_CTL) + CW_RW + 384 * p;
    unsigned long long* ring = (unsigned long long*)(WSP(F) + WS_RING) + (size_t)p * RW_NSLOT * (RW_SLOT_WORDS / 2);
    constexpr int NB = SEQ / 32;
    __syncthreads();
    { const float* aup = INP(F, 13) + (size_t)l * 64 * 384; const float* wup = INP(F, 11) + (size_t)(l * 2 + dir) * 64 * 384;
      for (int idx = tid; idx < 4096; idx += 512) { const int i = idx >> 6, c = idx & 63;
          WA[c * 72 + i] = (bf16)f2bf(aup[i * 384 + h * 64 + c]); WW[c * 72 + i] = (bf16)f2bf(wup[i * 384 + h * 64 + c]); }
      if (tid < 320) { const int which = tid >> 6, c = tid & 63;
          const int rc = which == 0 ? h * 64 + c : which == 1 ? 384 + h * 64 + c : which == 2 ? 768 + h * 64 + c : which == 3 ? 1152 + dir * 64 + c : 1280 + c;
          MU[tid] = INP(F, 8)[l * 1472 + rc]; MU[320 + tid] = INP(F, 9)[l * 1472 + rc]; } }
    __syncthreads();
    const size_t mb = (size_t)b * SEQ;
    const int j = lane & 15;
    RwCtx C;
    C.WA = WA; C.WW = WW; C.XA = (LAS bf16*)(F.lds + 18432) + wave * 576; C.XW = (LAS bf16*)(F.lds + 27648) + wave * 576;
    C.RAWB = (LAS bf16*)(F.lds + 36864) + wave * 1920;
    C.MU = MU; C.CT = (float*)(WSP(F) + WS_CT); C.colsb = cols + mb * NINP; C.h = h; C.dir = dir; C.qtr = 0; C.mb = mb; C.tb0 = 4 * wave;
    { const int hc4 = h * 64 + 4 * j;
      C.kk_c4 = *(const f32x4*)(INP(F, 15) + l * 384 + hc4); C.ka_c4 = *(const f32x4*)(INP(F, 16) + l * 384 + hc4); C.rk_c4 = *(const f32x4*)(INP(F, 17) + l * 384 + hc4);
#pragma unroll
      for (int ct = 0; ct < 4; ++ct) { C.ba[ct] = INP(F, 12)[l * 384 + h * 64 + 16 * ct + j]; C.bw[ct] = INP(F, 10)[(l * 2 + dir) * 384 + h * 64 + 16 * ct + j]; }
      const int c2 = (lane & 31) * 2;
#pragma unroll
      for (int wq = 0; wq < 5; ++wq) { C.mup_[wq][0] = MU[wq * 64 + c2]; C.mup_[wq][1] = MU[wq * 64 + c2 + 1]; C.mun_[wq][0] = MU[320 + wq * 64 + c2]; C.mun_[wq][1] = MU[320 + wq * 64 + c2 + 1]; } }
    v4u pre[5]; int poff[5], prr[5];
    rw_addr_init<4>(poff, prr, lane, C.tb0, h, dir);
    rw_issue<4>(pre, poff, prr, C.colsb, dir ? SEQ - 32 * (pp + 1) : 32 * pp);
    bool dead = false; unsigned mseen = G0;
    unsigned* myflag = ctl + 320 * pp; const unsigned PB = G0 / 2;
#pragma unroll 1
    for (int it = pp; it < NB; it += 2) {
        const int T0 = dir ? SEQ - 32 * (it + 1) : 32 * it;
        v4u cur[5];
#pragma unroll
        for (int i = 0; i < 5; ++i) cur[i] = pre[i];
        if (it + 2 < NB) rw_issue<4>(pre, poff, prr, C.colsb, dir ? SEQ - 32 * (it + 3) : 32 * (it + 2));
        rw_prep<4, true>(C, cur, OPS, VV, T0, lane);
        if (tid == 0) { const unsigned need = G0 + (unsigned)it + 1u; unsigned sp = 0u;
            if (need > (unsigned)RW_NSLOT && !dead) { const unsigned want = need - (unsigned)RW_NSLOT;
                while (mseen < want) { if (++sp > (1u << 17)) { dead = true; break; } __builtin_amdgcn_s_sleep(2);
                    const unsigned m01 = min(rw_ld(ctl + 64), rw_ld(ctl + 128)), m23 = min(rw_ld(ctl + 192), rw_ld(ctl + 256)); mseen = min(m01, m23); } }
            flg[0] = sp; }
        __syncthreads();
        { unsigned long long* slot = ring + (size_t)((G0 + (unsigned)it) % RW_NSLOT) * (RW_SLOT_WORDS / 2);
          const LAS v4u* src = (const LAS v4u*)OPS;
#pragma unroll
          for (int i = 0; i < 6; ++i) { const int idx = tid + 512 * i; const v4u d = src[idx]; v4u* dst = (v4u*)slot + idx;
              asm volatile("global_store_dwordx4 %0, %1, off sc1\n\ts_nop 1" :: "v"(dst), "v"(d) : "memory"); } }
        asm volatile("s_waitcnt vmcnt(6)" ::: "memory");
        __syncthreads();
        if (tid == 0 && it >= 2) rw_st(myflag, PB + (unsigned)(it >> 1));
    }
    asm volatile("s_waitcnt vmcnt(0)" ::: "memory");
    __syncthreads();
    if (tid == 0) rw_st(myflag, PB + (unsigned)(NB / 2));
    __syncthreads();
}
__device__ __forceinline__ void rwkv_scan(const Frame& F, int l, int p, int qtr, unsigned G0) {
    const int b = p / 12, rem = p % 12, h = rem >> 1, dir = rem & 1;
    bf16* Y = (bf16*)(WSP(F) + (dir ? Y_RB : Y_RF));
    const int lane = F.lane, wave = F.wave;
    LAS float* OPSb = (LAS float*)(F.lds);
    LAS float* VVb = (LAS float*)(F.lds + 81920);
    LAS float* YBb = (LAS float*)(F.lds + 86016);
    unsigned* ctl = (unsigned*)(WSP(F) + WS_CTL) + CW_RW + 384 * p;
    const unsigned long long* ring = (const unsigned long long*)(WSP(F) + WS_RING) + (size_t)p * RW_NSLOT * (RW_SLOT_WORDS / 2);
    constexpr int NB = SEQ / 32;
    const size_t mb = (size_t)b * SEQ;
    const int j = lane & 15;
    __syncthreads();
    if (wave < 4) {
        const int lt = wave * 64 + lane;
        bool dead = false; unsigned pseen0 = G0 / 2, pseen1 = G0 / 2;
        unsigned long long v[21];
#define RW_FETCH(k_) do { const unsigned need_ = G0 / 2 + (unsigned)((k_) >> 1) + 1u; unsigned sp_ = 0u; unsigned* fl_ = ctl + 320 * ((k_) & 1); \
            if (!dead) { unsigned ps_ = ((k_) & 1) ? pseen1 : pseen0; while (ps_ < need_) { ps_ = rw_ld(fl_); if (ps_ >= need_) break; if (++sp_ > (1u << 17)) { dead = true; break; } __builtin_amdgcn_s_sleep(2); } if ((k_) & 1) pseen1 = ps_; else pseen0 = ps_; } \
            const unsigned long long* slot_ = ring + (size_t)((G0 + (unsigned)(k_)) % RW_NSLOT) * (RW_SLOT_WORDS / 2); \
            _Pragma("unroll") for (int i_ = 0; i_ < 20; ++i_) v[i_] = __hip_atomic_load(slot_ + lt + 256 * i_, __ATOMIC_RELAXED, __HIP_MEMORY_SCOPE_AGENT); \
            v[20] = __hip_atomic_load(slot_ + 5120 + (lt >> 3) * 32 + qtr * 8 + (lt & 7), __ATOMIC_RELAXED, __HIP_MEMORY_SCOPE_AGENT); } while (0)
        RW_FETCH(0);
#pragma unroll 1
        for (int it = 0; it <= NB; ++it) {
            if (it >= 1 && lt == 0) rw_st(ctl + 64 * (qtr + 1), G0 + (unsigned)it);
            if (it < NB) {
                LAS unsigned long long* dO = (LAS unsigned long long*)(OPSb + (it & 1) * 10240); LAS unsigned long long* dV = (LAS unsigned long long*)(VVb + (it & 1) * 512);
#pragma unroll
                for (int i = 0; i < 20; ++i) dO[lt + 256 * i] = v[i];
                dV[lt] = v[20];
                if (it + 1 < NB) RW_FETCH(it + 1);
            }
            if (it >= 2) { const int bk = it - 2; const int T0 = dir ? SEQ - 32 * (bk + 1) : 32 * bk; const LAS float* YB = YBb + (bk & 1) * 512;
                const int idx = lt * 2, tl = idx >> 4, rw = idx & 15;
                *(unsigned*)(Y + (mb + T0 + tl) * 384 + h * 64 + 16 * qtr + rw) = pk2(YB[idx], YB[idx + 1]); }
            __syncthreads();
        }
#undef RW_FETCH
        { const int bk = NB - 1; const int T0 = dir ? SEQ - 32 * (bk + 1) : 32 * bk; const LAS float* YB = YBb + (bk & 1) * 512;
          const int idx = lt * 2, tl = idx >> 4, rw = idx & 15;
          *(unsigned*)(Y + (mb + T0 + tl) * 384 + h * 64 + 16 * qtr + rw) = pk2(YB[idx], YB[idx + 1]); }
    } else {
        const int row = (wave - 4) * 4 + (lane >> 4);
        f32x4 S = {0.f, 0.f, 0.f, 0.f};
#pragma unroll 1
        for (int it = 0; it <= NB; ++it) {
            if (it >= 1) { const int bk = it - 1;
                const LAS float* OPS = OPSb + (bk & 1) * 10240; const LAS float* VV = VVb + (bk & 1) * 512; LAS float* YB = YBb + (bk & 1) * 512;
                if (dir) rwkv_steps<true>(OPS, VV, YB, S, j, row); else rwkv_steps<false>(OPS, VV, YB, S, j, row);
            }
            __syncthreads();
        }
    }
    __syncthreads();
}
__device__ __forceinline__ float row8_sum(float v) { v += dppf<0xB1>(v); v += dppf<0x4E>(v); v += dppf<0x141>(v); return v; }
__device__ __forceinline__ void mlstm_seq(const Frame& F, int l, int task, int cfull0, int cend) {
    const int b = task >> 3, h = (task >> 1) & 3, dir = task & 1;
    const bf16* cols = (const bf16*)(WSP(F) + WS_COLS); const float* GT = (const float*)(WSP(F) + WS_GATES);
    bf16* Y = (bf16*)(WSP(F) + (dir ? Y_AB : Y_AF));
    LAS bf16* RAWQ = (LAS bf16*)(F.lds);
    LAS bf16* Qs = (LAS bf16*)(F.lds + 17408); LAS bf16* Ks = (LAS bf16*)(F.lds + 26624);
    LAS bf16* Vtb = (LAS bf16*)(F.lds + 35840);
    LAS bf16* KWt = (LAS bf16*)(F.lds + 54272); LAS bf16* Ps = (LAS bf16*)(F.lds + 63488);
    LAS bf16* Ctb = (LAS bf16*)(F.lds + 72704);
    LAS float* ub = (LAS float*)(F.lds + 91136);
    LAS float* blb = ub + 128; LAS float* rmb = ub + 256;
    LAS float* den = ub + 384; LAS float* qn = ub + 448; LAS float* nst = ub + 512; LAS float* scb = ub + 576;
    const int tid = F.tid, lane = F.lane, wave = F.wave;
    const size_t mb = (size_t)b * SEQ;
    constexpr int NC = SEQ / 64;
    __syncthreads();
    for (int i = tid; i < 2 * 64 * 72; i += 512) Ctb[i] = 0;
    if (tid < 64) nst[tid] = 0.f;
    const int cc = tid & 127, isK = cc >> 6, d0 = cc & 63, chn = isK * 256 + h * 64 + d0;
    float cw[5]; const float* cwp = INP(F, 3) + (size_t)l * 5 * 512;
#pragma unroll
    for (int jj = 0; jj < 5; ++jj) cw[jj] = cwp[jj * 512 + chn];
    const float cbv = INP(F, 4)[l * 512 + chn];
    f32x4 st[2] = {{0.f, 0.f, 0.f, 0.f}, {0.f, 0.f, 0.f, 0.f}};
    float m_st = 0.f;
    v4u pre[3], prev; float gli = 0.f, glf = 0.f;
#define ML_ISSUE(c_) do { const int tlo_ = dir ? SEQ - 64 * ((c_) + 1) : 64 * (c_); _Pragma("unroll") for (int i_ = 0; i_ < 3; ++i_) { const int ch_ = tid + 512 * i_; pre[i_] = (v4u){0u, 0u, 0u, 0u}; \
        if (ch_ < 68 * 16) { const int rr_ = ch_ >> 4, q_ = ch_ & 15; const int t_ = tlo_ - 2 + rr_; if (t_ >= 0 && t_ < SEQ) pre[i_] = *(const v4u*)(cols + (mb + t_) * NINP + (q_ >> 3) * 256 + h * 64 + (q_ & 7) * 8); } } \
        prev = *(const v4u*)(cols + (mb + tlo_ + (tid >> 3)) * NINP + A_V + h * 64 + (tid & 7) * 8); \
        if (tid < 64) { const int t_ = dir ? tlo_ + 63 - tid : tlo_ + tid; gli = GT[(mb + t_) * 16 + dir * 4 + h]; glf = GT[(mb + t_) * 16 + 8 + dir * 4 + h]; } } while (0)
#define ML_FILL(c_) do { _Pragma("unroll") for (int i_ = 0; i_ < 3; ++i_) { const int ch_ = tid + 512 * i_; if (ch_ < 68 * 16) *(LAS v4u*)(RAWQ + (ch_ >> 4) * 128 + (ch_ & 15) * 8) = pre[i_]; } \
        { LAS bf16* Vt_ = Vtb + ((c_) & 1) * 4608; const int tl_ = tid >> 3, e8_ = tid & 7; const int lp_ = dir ? 63 - tl_ : tl_; const unsigned w_[4] = {prev.x, prev.y, prev.z, prev.w}; \
          _Pragma("unroll") for (int k_ = 0; k_ < 4; ++k_) { const int e_ = e8_ * 8 + 2 * k_; Vt_[e_ * 72 + swz64(e_, lp_)] = (bf16)(w_[k_] & 0xffffu); Vt_[(e_ + 1) * 72 + swz64(e_ + 1, lp_)] = (bf16)(w_[k_] >> 16); } } \
        if (tid < 64) { const float bl_ = wave_scan_add(glf); \
            const float u_ = gli - bl_; const float rm_ = wave_scan_max(u_); \
            ub[((c_) & 1) * 64 + tid] = u_; blb[((c_) & 1) * 64 + tid] = bl_; rmb[((c_) & 1) * 64 + tid] = rm_; if (tid == 63) { scb[((c_) & 1) * 2] = rm_; scb[((c_) & 1) * 2 + 1] = bl_; } } } while (0)
    ML_ISSUE(0); ML_FILL(0); ML_ISSUE(1);
    __syncthreads();
    if (cfull0 > 0) {
        const int dk = tid & 63; float cwk[5]; { const float* cwq = INP(F, 3) + (size_t)l * 5 * 512;
#pragma unroll
            for (int jj = 0; jj < 5; ++jj) cwk[jj] = cwq[jj * 512 + 256 + h * 64 + dk]; }
        const float cbk = INP(F, 4)[l * 512 + 256 + h * 64 + dk];
#pragma unroll 1
        for (int c = 0; c < cfull0; ++c) {
            const LAS float* u = ub + (c & 1) * 64;
            const LAS bf16* Vt = Vtb + (c & 1) * 4608; LAS bf16* Ctn = Ctb + ((c + 1) & 1) * 4608;
            const float umax = scb[(c & 1) * 2], tot = scb[(c & 1) * 2 + 1];
#pragma unroll 2
            for (int i = 0; i < 8; ++i) { const int tl = (tid >> 6) + 8 * i; float s = cbk;
#pragma unroll
                for (int jj = 0; jj < 5; ++jj) s += cwk[jj] * bf2f(RAWQ[(tl + jj) * 128 + 64 + dk]);
                const int lp = dir ? 63 - tl : tl;
                KWt[dk * 72 + swz64(dk, lp)] = (bf16)f2bf(siluf_(s) * 0.125f * __expf(u[lp] - umax)); }
            __syncthreads();
            const float mmax = fmaxf(m_st, umax), s_old = __expf(m_st - mmax), s_new = __expf(umax - mmax);
#pragma unroll
            for (int k = 0; k < 2; ++k) { const int ti = 2 * wave + k, t0_ = ti >> 2, t1_ = ti & 3; const f32x4 z = {0.f, 0.f, 0.f, 0.f};
                const f32x4 lc = mma16s<true, true>(Vt, 72, t0_ * 16, KWt, 72, t1_ * 16, z, lane);
#pragma unroll
                for (int jj = 0; jj < 4; ++jj) { const int r_ = t0_ * 16 + (lane >> 4) * 4 + jj, c_ = t1_ * 16 + (lane & 15);
                    st[k][jj] = s_old * st[k][jj] + s_new * lc[jj]; Ctn[r_ * 72 + c_] = (bf16)f2bf(st[k][jj]); } }
            { const int dq = tid >> 3, part = tid & 7; float s = 0.f;
#pragma unroll
              for (int k = 0; k < 8; ++k) s += bf2f(KWt[dq * 72 + swz64(dq, part * 8) + k]);
              s = row8_sum(s); if (part == 0) nst[dq] = s_old * nst[dq] + s_new * s; }
            m_st = tot + mmax;
            ML_FILL(c + 1); if (c + 2 < cend) ML_ISSUE(c + 2);
            __syncthreads();
        }
    }
#pragma unroll 1
    for (int c = cfull0; c < cend; ++c) {
        const bool full = c >= cfull0;
        const int tlo = dir ? SEQ - 64 * (c + 1) : 64 * c;
        const LAS float* u = ub + (c & 1) * 64; const LAS float* bl = blb + (c & 1) * 64; const LAS float* rm = rmb + (c & 1) * 64;
        const LAS bf16* Vt = Vtb + (c & 1) * 4608; const LAS bf16* Ct = Ctb + (c & 1) * 4608; LAS bf16* Ctn = Ctb + ((c + 1) & 1) * 4608;
#pragma unroll 4
        for (int i = 0; i < 16; ++i) { const int tl = (tid >> 7) + 4 * i; float s = cbv;
#pragma unroll
            for (int jj = 0; jj < 5; ++jj) s += cw[jj] * bf2f(RAWQ[(tl + jj) * 128 + cc]);
            s = siluf_(s); const int lpos = dir ? 63 - tl : tl;
            if (isK) Ks[lpos * 72 + d0] = (bf16)f2bf(s * 0.125f); else Qs[lpos * 72 + d0] = (bf16)f2bf(s); }
        if (tid < 64) den[tid] = 0.f;
        __syncthreads();
        const float umax = scb[(c & 1) * 2], tot = scb[(c & 1) * 2 + 1];
        for (int idx = tid; idx < 4096; idx += 512) { const int lp = idx >> 6, d = idx & 63; KWt[d * 72 + swz64(d, lp)] = (bf16)f2bf(bf2f(Ks[lp * 72 + d]) * __expf(u[lp] - umax)); }
        if (full) {
#pragma unroll
        for (int k = 0; k < 2; ++k) { const int ti = 2 * wave + k, tl_ = ti >> 2, ts = ti & 3; f32x4 acc = {0.f, 0.f, 0.f, 0.f};
            if (ts <= tl_) acc = mma16<64>(Qs + tl_ * 16 * 72, 72, Ks + ts * 16 * 72, 72, acc, lane);
#pragma unroll
            for (int jj = 0; jj < 4; ++jj) { const int lr = tl_ * 16 + (lane >> 4) * 4 + jj, s = ts * 16 + (lane & 15);
                const float v = (s <= lr) ? acc[jj] * __expf(u[s] - fmaxf(m_st, rm[lr])) : 0.f; const unsigned vb = f2bf(v); Ps[lr * 72 + s] = (bf16)vb;
                if (ts <= tl_) { const float rs = row16_sum(bf2f(vb)); if ((lane & 15) == 0) __hip_atomic_fetch_add(den + lr, rs, __ATOMIC_RELAXED, __HIP_MEMORY_SCOPE_WORKGROUP); } } }
        { const int lq = tid >> 3, part = tid & 7; float s = 0.f;
#pragma unroll
          for (int k = 0; k < 8; ++k) s += bf2f(Qs[lq * 72 + part * 8 + k]) * nst[part * 8 + k];
          s = row8_sum(s); if (part == 0) qn[lq] = s; }
        }
        __syncthreads();
        const float mmax = fmaxf(m_st, umax), s_old = __expf(m_st - mmax), s_new = __expf(umax - mmax);
#pragma unroll
        for (int k = 0; k < 2; ++k) { const int ti = 2 * wave + k, t0_ = ti >> 2, t1_ = ti & 3; const f32x4 z = {0.f, 0.f, 0.f, 0.f};
            f32x4 a1 = z, a2 = z;
            if (full) { a1 = mma16s<false, true>(Ps, 72, t0_ * 16, Vt, 72, t1_ * 16, z, lane); a2 = mma16<64>(Qs + t0_ * 16 * 72, 72, Ct + t1_ * 16 * 72, 72, z, lane); }
            const f32x4 lc = mma16s<true, true>(Vt, 72, t0_ * 16, KWt, 72, t1_ * 16, z, lane);
#pragma unroll
            for (int jj = 0; jj < 4; ++jj) { const int r_ = t0_ * 16 + (lane >> 4) * 4 + jj, c_ = t1_ * 16 + (lane & 15);
                if (full) { const float mx = fmaxf(m_st, rm[r_]), iwv = __expf(m_st - mx);
                const float dn = den[r_] + iwv * qn[r_];
                const float val = (a1[jj] + iwv * a2[jj]) / fmaxf(fabsf(dn), __expf(-(bl[r_] + mx)));
                const int t = dir ? tlo + 63 - r_ : tlo + r_;
                Y[(mb + t) * 256 + h * 64 + c_] = (bf16)f2bf(val); }
                st[k][jj] = s_old * st[k][jj] + s_new * lc[jj];
                Ctn[r_ * 72 + c_] = (bf16)f2bf(st[k][jj]); } }
        { const int dq = tid >> 3, part = tid & 7; float s = 0.f;
#pragma unroll
          for (int k = 0; k < 8; ++k) s += bf2f(KWt[dq * 72 + swz64(dq, part * 8) + k]);
          s = row8_sum(s); if (part == 0) nst[dq] = s_old * nst[dq] + s_new * s; }
        m_st = tot + mmax;
        if (c + 1 < cend) { ML_FILL(c + 1); if (c + 2 < cend) ML_ISSUE(c + 2); }
        __syncthreads();
    }
#undef ML_ISSUE
#undef ML_FILL
}
__device__ __forceinline__ void phase_ssd_conv(const Frame& F, int l) {
    const bf16* cols = (const bf16*)(WSP(F) + WS_COLS); bf16* XBC = (bf16*)(WSP(F) + WS_XN);
    LAS bf16* raw = (LAS bf16*)(F.lds);
    const float* cwp = INP(F, 20) + (size_t)l * 5 * 896; const float* cbp = INP(F, 21) + l * 896;
    const int tid = F.tid;
    float cw0[5], cw1[5]; const int c1 = tid + 512 < 896 ? tid + 512 : tid;
#pragma unroll
    for (int jj = 0; jj < 5; ++jj) { cw0[jj] = cwp[jj * 896 + tid]; cw1[jj] = cwp[jj * 896 + c1]; }
    const float cb0 = cbp[tid], cb1 = cbp[c1];
    float* DTV = (float*)(WSP(F) + WS_DTV); const float* dtbp = INP(F, 22) + l * 12;
    for (int tile = F.vcu; tile < M / 32; tile += F.G) {
        const int m0 = tile * 32, t0 = m0 % SEQ;
        __syncthreads();
        if (tid < 384) { const int tt = tid / 12, k = tid % 12; const float x = bf2f(cols[(size_t)(m0 + tt) * NINP + S_DT + k]) + dtbp[k]; DTV[(size_t)(m0 + tt) * 12 + k] = x > 20.f ? x : log1pf(__expf(x)); }
        for (int ch = tid; ch < 36 * 112; ch += 512) { const int rr = ch / 112, cc = ch % 112; const int t = t0 - 2 + rr;
            v4u v = {0u, 0u, 0u, 0u}; if (t >= 0 && t < SEQ) v = *(const v4u*)(cols + (size_t)(m0 - 2 + rr) * NINP + S_X + cc * 8);
            *(LAS v4u*)(raw + rr * 896 + cc * 8) = v; }
        __syncthreads();
#pragma unroll
        for (int half = 0; half < 2; ++half) { const int c = half ? c1 : tid; if (half && tid + 512 >= 896) break;
            float win[5];
#pragma unroll
            for (int jj = 0; jj < 4; ++jj) win[jj] = bf2f(raw[jj * 896 + c]);
            for (int tl = 0; tl < 32; ++tl) { win[4] = bf2f(raw[(tl + 4) * 896 + c]);
                float s = half ? cb1 : cb0;
#pragma unroll
                for (int jj = 0; jj < 5; ++jj) s += (half ? cw1[jj] : cw0[jj]) * win[jj];
#pragma unroll
                for (int jj = 0; jj < 4; ++jj) win[jj] = win[jj + 1];
                XBC[(size_t)(m0 + tl) * 896 + c] = (bf16)f2bf(siluf_(s)); } }
    }
    __syncthreads();
}
__device__ __forceinline__ void ssd_seq(const Frame& F, int l, int task, int cfull0, int cend) {
    const int b = task / 12, rem = task % 12, head = rem >> 1, dir = rem & 1, g = head / 3;
    const bf16* cols = (const bf16*)(WSP(F) + WS_COLS); const bf16* XBC = (const bf16*)(WSP(F) + WS_XN);
    bf16* Y = (bf16*)(WSP(F) + (dir ? Y_SB : Y_SF));
    LAS bf16* Cm = (LAS bf16*)(F.lds); LAS bf16* Bm = (LAS bf16*)(F.lds + 17408);
    LAS bf16* Btw = (LAS bf16*)(F.lds + 34816); LAS bf16* Xt = (LAS bf16*)(F.lds + 53248);
    LAS bf16* Ps = (LAS bf16*)(F.lds + 62464); LAS bf16* Hs = (LAS bf16*)(F.lds + 71680);
    LAS float* dtvb = (LAS float*)(F.lds + 89088);
    LAS float* acsb = dtvb + 128;
    LAS float* totb = dtvb + 256;
    const int tid = F.tid, lane = F.lane, wave = F.wave;
    const size_t mb = (size_t)b * SEQ;
    constexpr int NC = SEQ / 64;
    __syncthreads();
    for (int i = tid; i < 64 * 136; i += 512) Hs[i] = 0;
    const float* DTV = (const float*)(WSP(F) + WS_DTV);
    const float aneg = -__expf(INP(F, 23)[(l * 2 + dir) * 6 + head]);
    f32x4 st[4];
#pragma unroll
    for (int k = 0; k < 4; ++k) st[k] = (f32x4){0.f, 0.f, 0.f, 0.f};
    v4u pre[5]; float dtraw = 0.f;
#define SSD_ISSUE(c_) do { const int tlo_ = dir ? SEQ - 64 * ((c_) + 1) : 64 * (c_); _Pragma("unroll") for (int i_ = 0; i_ < 5; ++i_) { const int idx_ = tid + 512 * i_; const int tl_ = idx_ / 40, q_ = idx_ % 40; \
        const int gc_ = q_ < 8 ? head * 64 + q_ * 8 : (q_ < 24 ? 384 + g * 128 + (q_ - 8) * 8 : 640 + g * 128 + (q_ - 24) * 8); \
        pre[i_] = *(const v4u*)(XBC + (mb + tlo_ + tl_) * 896 + gc_); } } while (0)
#define SSD_DTLOAD(c_) do { if (tid < 64) { const int tlo_ = dir ? SEQ - 64 * ((c_) + 1) : 64 * (c_); const int t_ = dir ? tlo_ + 63 - tid : tlo_ + tid; dtraw = DTV[(mb + t_) * 12 + dir * 6 + head]; } } while (0)
#define SSD_DTCALC(c_) do { if (tid < 64) { const float dt_ = dtraw; float cs_ = dt_ * aneg; \
        cs_ = wave_scan_add(cs_); \
        const float tt_ = __builtin_bit_cast(float, __builtin_amdgcn_readlane(__builtin_bit_cast(int, cs_), 63)); dtvb[((c_) & 1) * 64 + tid] = dt_; acsb[((c_) & 1) * 64 + tid] = cs_; if (tid == 0) totb[(c_) & 1] = tt_; } } while (0)
    int lgo[3], llp[3], lq[3]; v4u prel[3];
#pragma unroll
    for (int i = 0; i < 3; ++i) { const int idx = tid + 512 * i; const int tl = idx / 24, q = idx % 24; lq[i] = q; llp[i] = dir ? 63 - tl : tl;
        lgo[i] = tl * 896 + (q < 8 ? head * 64 + q * 8 : 384 + g * 128 + (q - 8) * 8); }
#define SSD_ISSUE_L(dst_, c_) do { const int tlo_ = dir ? SEQ - 64 * ((c_) + 1) : 64 * (c_); const bf16* b_ = XBC + (mb + tlo_) * 896; _Pragma("unroll") for (int i_ = 0; i_ < 3; ++i_) dst_[i_] = *(const v4u*)(b_ + lgo[i_]); } while (0)
    v4u preN[3];
    if (cfull0 > 0) { SSD_ISSUE_L(prel, 0); if (cfull0 > 1) SSD_ISSUE_L(preN, 1); } else SSD_ISSUE(0);
    SSD_DTLOAD(0); SSD_DTCALC(0); SSD_DTLOAD(1);
    __syncthreads();
    if (cfull0 > 0) {
#pragma unroll 1
        for (int c = 0; c < cfull0; ++c) {
            LAS bf16* Xl = (c & 1) ? (LAS bf16*)(F.lds + 92160) : Xt; LAS bf16* Bl = (c & 1) ? (LAS bf16*)(F.lds + 101376) : Btw;
            const LAS float* dtv = dtvb + (c & 1) * 64; const LAS float* acs = acsb + (c & 1) * 64; const float tot = totb[c & 1];
#pragma unroll
            for (int i = 0; i < 3; ++i) { const int q = lq[i], lp = llp[i];
                const unsigned w[4] = {prel[i].x, prel[i].y, prel[i].z, prel[i].w};
                if (q < 8) {
#pragma unroll
                    for (int k = 0; k < 4; ++k) { const int p0 = q * 8 + 2 * k; Xl[p0 * 72 + swz64(p0, lp)] = (bf16)(w[k] & 0xffffu); Xl[(p0 + 1) * 72 + swz64(p0 + 1, lp)] = (bf16)(w[k] >> 16); } }
                else { const int n0 = (q - 8) * 8; const float sc = dtv[lp] * __expf(tot - acs[lp]);
#pragma unroll
                    for (int k = 0; k < 4; ++k) { const int nn = n0 + 2 * k; Bl[nn * 72 + swz64(nn, lp)] = (bf16)f2bf(bf2f(w[k] & 0xffffu) * sc); Bl[(nn + 1) * 72 + swz64(nn + 1, lp)] = (bf16)f2bf(bf2f(w[k] >> 16) * sc); } } }
            if (c + 1 < cfull0) {
#pragma unroll
                for (int i = 0; i < 3; ++i) prel[i] = preN[i];
                if (c + 2 < cfull0) SSD_ISSUE_L(preN, c + 2); }
            else SSD_ISSUE(c + 1);
            SSD_DTCALC(c + 1); if (c + 2 < cend) SSD_DTLOAD(c + 2);
            __syncthreads();
            const float cdec = __expf(tot);
#pragma unroll
            for (int k = 0; k < 4; ++k) { const int ti = 4 * wave + k, tp = ti >> 3, tn = ti & 7; const f32x4 z = {0.f, 0.f, 0.f, 0.f};
                const f32x4 lcv = mma16s<true, true>(Xl, 72, tp * 16, Bl, 72, tn * 16, z, lane);
                st[k] = st[k] * cdec + lcv; }
        }
#pragma unroll
        for (int k = 0; k < 4; ++k) { const int ti = 4 * wave + k, tp = ti >> 3, tn = ti & 7;
#pragma unroll
            for (int jj = 0; jj < 4; ++jj) { const int p = tp * 16 + (lane >> 4) * 4 + jj, n = tn * 16 + (lane & 15); Hs[p * 136 + n] = (bf16)f2bf(st[k][jj]); } }
        __syncthreads();
    }
#pragma unroll 1
    for (int c = cfull0; c < cend; ++c) {
        const bool full = c >= cfull0;
        const int tlo = dir ? SEQ - 64 * (c + 1) : 64 * c;
        const LAS float* dtv = dtvb + (c & 1) * 64; const LAS float* acs = acsb + (c & 1) * 64; const float tot = totb[c & 1];
#pragma unroll
        for (int i = 0; i < 5; ++i) { const int idx = tid + 512 * i; const int tl = idx / 40, q = idx % 40; const int lp = dir ? 63 - tl : tl;
            const unsigned w[4] = {pre[i].x, pre[i].y, pre[i].z, pre[i].w};
            if (q < 8) {
#pragma unroll
                for (int k = 0; k < 4; ++k) { const int p0 = q * 8 + 2 * k; Xt[p0 * 72 + swz64(p0, lp)] = (bf16)(w[k] & 0xffffu); Xt[(p0 + 1) * 72 + swz64(p0 + 1, lp)] = (bf16)(w[k] >> 16); } }
            else if (q < 24) { const int n0 = (q - 8) * 8; if (full) *(LAS v4u*)(Bm + lp * 136 + n0) = pre[i]; const float sc = dtv[lp] * __expf(tot - acs[lp]);
#pragma unroll
                for (int k = 0; k < 4; ++k) { const int nn = n0 + 2 * k; Btw[nn * 72 + swz64(nn, lp)] = (bf16)f2bf(bf2f(w[k] & 0xffffu) * sc); Btw[(nn + 1) * 72 + swz64(nn + 1, lp)] = (bf16)f2bf(bf2f(w[k] >> 16) * sc); } }
            else if (full) { const int n0 = (q - 24) * 8; *(LAS v4u*)(Cm + lp * 136 + n0) = pre[i]; } }
        if (c + 1 < cend) SSD_ISSUE(c + 1);
        __syncthreads();
        f32x4 yo[2] = {{0.f, 0.f, 0.f, 0.f}, {0.f, 0.f, 0.f, 0.f}}, lc[4];
        if (full) {
#pragma unroll
        for (int k = 0; k < 2; ++k) { const int ti = 2 * wave + k, tl_ = ti >> 2, ts = ti & 3; f32x4 acc = {0.f, 0.f, 0.f, 0.f};
            if (ts <= tl_) acc = mma16<128>(Cm + tl_ * 16 * 136, 136, Bm + ts * 16 * 136, 136, acc, lane);
#pragma unroll
            for (int jj = 0; jj < 4; ++jj) { const int lr = tl_ * 16 + (lane >> 4) * 4 + jj, s = ts * 16 + (lane & 15);
                const float v = (s <= lr) ? acc[jj] * __expf(acs[lr] - acs[s]) * dtv[s] : 0.f; Ps[lr * 72 + s] = (bf16)f2bf(v); }
            const f32x4 z = {0.f, 0.f, 0.f, 0.f};
            yo[k] = mma16<128>(Cm + tl_ * 16 * 136, 136, Hs + ts * 16 * 136, 136, z, lane); }
        }
#pragma unroll
        for (int k = 0; k < 4; ++k) { const int ti = 4 * wave + k, tp = ti >> 3, tn = ti & 7; const f32x4 z = {0.f, 0.f, 0.f, 0.f};
            lc[k] = mma16s<true, true>(Xt, 72, tp * 16, Btw, 72, tn * 16, z, lane); }
        __syncthreads();
        const float cdec = __expf(tot);
        if (full) {
#pragma unroll
        for (int k = 0; k < 2; ++k) { const int ti = 2 * wave + k, tl_ = ti >> 2, tp = ti & 3; const f32x4 z = {0.f, 0.f, 0.f, 0.f};
            const f32x4 yd = mma16s<false, true>(Ps, 72, tl_ * 16, Xt, 72, tp * 16, z, lane);
#pragma unroll
            for (int jj = 0; jj < 4; ++jj) { const int lr = tl_ * 16 + (lane >> 4) * 4 + jj, p = tp * 16 + (lane & 15);
                const float val = yd[jj] + yo[k][jj] * __expf(acs[lr]);
                const int t = dir ? tlo + 63 - lr : tlo + lr;
                Y[(mb + t) * 384 + head * 64 + p] = (bf16)f2bf(val); } }
        }
#pragma unroll
        for (int k = 0; k < 4; ++k) { const int ti = 4 * wave + k, tp = ti >> 3, tn = ti & 7;
#pragma unroll
            for (int jj = 0; jj < 4; ++jj) { const int p = tp * 16 + (lane >> 4) * 4 + jj, n = tn * 16 + (lane & 15);
                st[k][jj] = cdec * st[k][jj] + lc[k][jj]; Hs[p * 136 + n] = (bf16)f2bf(st[k][jj]); } }
        if (c + 1 < cend) { SSD_DTCALC(c + 1); if (c + 2 < cend) SSD_DTLOAD(c + 2); }
        __syncthreads();
    }
#undef SSD_ISSUE
#undef SSD_ISSUE_L
#undef SSD_DTLOAD
#undef SSD_DTCALC
}
__device__ __forceinline__ float wave_sum2(float v) { v = row16_sum(v); v += __shfl_xor(v, 16); v += __shfl_xor(v, 32); return v; }
__device__ __forceinline__ f32x4 bf4(v2u w) { return (f32x4){bf2f(w.x & 0xffffu), bf2f(w.x >> 16), bf2f(w.y & 0xffffu), bf2f(w.y >> 16)}; }
__device__ __forceinline__ v2u pk4(f32x4 v) { v2u w; w.x = pk2(v.x, v.y); w.y = pk2(v.z, v.w); return w; }
__device__ __forceinline__ void phase_post(const Frame& F, int l) {
    const bf16* cols = (const bf16*)(WSP(F) + WS_COLS); bf16* MIX = (bf16*)(WSP(F) + WS_XN);
    const bf16* YAf = (const bf16*)(WSP(F) + Y_AF); const bf16* YAb = (const bf16*)(WSP(F) + Y_AB);
    const bf16* YRf = (const bf16*)(WSP(F) + Y_RF); const bf16* YRb = (const bf16*)(WSP(F) + Y_RB);
    const bf16* YSf = (const bf16*)(WSP(F) + Y_SF); const bf16* YSb = (const bf16*)(WSP(F) + Y_SB);
    const float* CT = (const float*)(WSP(F) + WS_CT);
    LAS bf16* GU = (LAS bf16*)(F.lds);
    LAS bf16* SG = (LAS bf16*)(F.lds + 104448);
    LAS float* gate = (LAS float*)(F.lds + 108800);
    LAS float* SCW = (LAS float*)(F.lds + 133632);
    const int tid = F.tid, lane = F.lane, wave = F.wave;
    const float* mup = INP(F, 8) + l * 1472; const float* mun = INP(F, 9) + l * 1472;
    const float* gup = INP(F, 14) + (size_t)l * 128 * 384;
    const float* sdk = INP(F, 24) + l * 6;
    __syncthreads();
    for (int idx = tid; idx < 128 * 384; idx += 512) { const int i = idx / 384, c = idx % 384; GU[c * 136 + i] = (bf16)f2bf(gup[idx]); }
    { const float* scw = INP(F, 20) + (size_t)l * 5 * 896; for (int idx = tid; idx < 5 * 384; idx += 512) SCW[idx] = scw[(idx / 384) * 896 + (idx % 384)]; }
    const int gch = tid & 15;
    float gmp[8], gmn[8];
#pragma unroll
    for (int k = 0; k < 8; ++k) { gmp[k] = mup[1344 + 8 * gch + k]; gmn[k] = mun[1344 + 8 * gch + k]; }
    const int qa = lane, qb = 64 + (lane & 31);
    const f32x4 mng4 = *(const f32x4*)(INP(F, 7) + l * 256 + 4 * qa);
    f32x4 rmp[2], rmn[2], rng[2], rnb[2], scb[2], sng[2];
#pragma unroll
    for (int ps = 0; ps < 2; ++ps) { const int c0 = 4 * (ps ? qb : qa);
        rmp[ps] = *(const f32x4*)(mup + 768 + c0); rmn[ps] = *(const f32x4*)(mun + 768 + c0);
        rng[ps] = *(const f32x4*)(INP(F, 18) + l * 384 + c0); rnb[ps] = *(const f32x4*)(INP(F, 19) + l * 384 + c0);
        scb[ps] = *(const f32x4*)(INP(F, 21) + l * 896 + c0); sng[ps] = *(const f32x4*)(INP(F, 25) + l * 384 + c0); }
    for (int tile = F.vcu; tile < M / 16; tile += F.G) {
        const int m0 = tile * 16;
        __syncthreads();
        if (tid < 256) { const int tt = tid >> 4; const int m = m0 + tt, t = m % SEQ; const bf16* cp = cols + (size_t)m * NINP + R_GD + 8 * gch;
            const v4u c1 = *(const v4u*)cp; v4u c0 = {0u, 0u, 0u, 0u}, c2 = {0u, 0u, 0u, 0u};
            if (t > 0) c0 = *(const v4u*)(cp - NINP); if (t < SEQ - 1) c2 = *(const v4u*)(cp + NINP);
            const unsigned w0[4] = {c0.x, c0.y, c0.z, c0.w}, w1[4] = {c1.x, c1.y, c1.z, c1.w}, w2[4] = {c2.x, c2.y, c2.z, c2.w}; unsigned o[4];
#pragma unroll
            for (int k = 0; k < 4; ++k) { const float a1 = bf2f(w1[k] & 0xffffu), b1 = bf2f(w1[k] >> 16);
                const float va = a1 + gmp[2 * k] * (bf2f(w0[k] & 0xffffu) - a1) + gmn[2 * k] * (bf2f(w2[k] & 0xffffu) - a1);
                const float vb = b1 + gmp[2 * k + 1] * (bf2f(w0[k] >> 16) - b1) + gmn[2 * k + 1] * (bf2f(w2[k] >> 16) - b1);
                o[k] = pk2(sigmoidf_(va), sigmoidf_(vb)); }
            *(LAS v4u*)(SG + tt * 136 + 8 * gch) = (v4u){o[0], o[1], o[2], o[3]}; }
        __syncthreads();
#pragma unroll
        for (int k = 0; k < 3; ++k) { const int ct = wave + 8 * k; const f32x4 z = {0.f, 0.f, 0.f, 0.f};
            const f32x4 acc = mma16<128>(SG, 136, GU + ct * 16 * 136, 136, z, lane);
#pragma unroll
            for (int jj = 0; jj < 4; ++jj) gate[((lane >> 4) * 4 + jj) * 388 + ct * 16 + (lane & 15)] = acc[jj]; }
        __syncthreads();
#pragma unroll 1
        for (int k = 0; k < 2; ++k) { const int tt = wave * 2 + k; const int m = m0 + tt, t = m % SEQ; const size_t cr = (size_t)m * NINP;
            { const int c0 = 4 * qa;
              const f32x4 hs = bf4(*(const v2u*)(YAf + (size_t)m * 256 + c0)) + bf4(*(const v2u*)(YAb + (size_t)m * 256 + c0));
              const float mean = row16_sum((hs.x + hs.y) + (hs.z + hs.w)) * (1.f / 64.f); const f32x4 d = hs - mean;
              const float var = row16_sum((d.x * d.x + d.y * d.y) + (d.z * d.z + d.w * d.w)) * (1.f / 64.f);
              const f32x4 o = bf4(*(const v2u*)(cols + cr + A_O + c0));
              f32x4 y = d * (1.f / sqrtf(var + 1e-6f)) * mng4;
              y.x *= sigmoidf_(o.x); y.y *= sigmoidf_(o.y); y.z *= sigmoidf_(o.z); y.w *= sigmoidf_(o.w);
              *(v2u*)(MIX + (size_t)m * DM + c0) = pk4(y); }
#pragma unroll
            for (int ps = 0; ps < 2; ++ps) { const int qd = ps ? qb : qa, c0 = 4 * qd; const bool act = ps == 0 || lane < 32;
              const f32x4 ys = bf4(*(const v2u*)(YRf + (size_t)m * 384 + c0)) + bf4(*(const v2u*)(YRb + (size_t)m * 384 + c0));
              const float mean = row16_sum((ys.x + ys.y) + (ys.z + ys.w)) * (1.f / 64.f); const f32x4 d = ys - mean;
              const float var = row16_sum((d.x * d.x + d.y * d.y) + (d.z * d.z + d.w * d.w)) * (1.f / 64.f);
              const f32x4 y = d * (1.f / sqrtf(var + 64e-5f)) * rng[ps] + rnb[ps];
              const f32x4 p1 = bf4(*(const v2u*)(cols + cr + R_V + c0));
              f32x4 p0 = {0.f, 0.f, 0.f, 0.f}, p2 = {0.f, 0.f, 0.f, 0.f};
              if (t > 0) p0 = bf4(*(const v2u*)(cols + cr - NINP + R_V + c0)); if (t < SEQ - 1) p2 = bf4(*(const v2u*)(cols + cr + NINP + R_V + c0));
              const f32x4 vv = p1 + rmp[ps] * (p0 - p1) + rmn[ps] * (p2 - p1);
              const float ctv = CT[(size_t)m * 8 + (qd >> 4)];
              const f32x4 g4 = *(const LAS f32x4*)(gate + tt * 388 + c0);
              if (act) *(v2u*)(MIX + (size_t)m * DM + 256 + c0) = pk4((y + vv * ctv) * g4); }
            f32x4 yv[2]; float ssq0 = 0.f, ssq1 = 0.f;
#pragma unroll
            for (int ps = 0; ps < 2; ++ps) { const int qd = ps ? qb : qa, c0 = 4 * qd; const bool act = ps == 0 || lane < 32;
              f32x4 s = scb[ps];
#pragma unroll
              for (int jj = 0; jj < 5; ++jj) { const int tq = t + jj - 2; if (tq >= 0 && tq < SEQ) s += *(const LAS f32x4*)(SCW + jj * 384 + c0) * bf4(*(const v2u*)(cols + cr + (jj - 2) * NINP + S_X + c0)); }
              const f32x4 z = bf4(*(const v2u*)(cols + cr + S_Z + c0));
              f32x4 y = bf4(*(const v2u*)(YSf + (size_t)m * 384 + c0)) + bf4(*(const v2u*)(YSb + (size_t)m * 384 + c0));
              const float dsk = sdk[qd >> 4];
              y.x = (y.x + dsk * siluf_(s.x)) * siluf_(z.x); y.y = (y.y + dsk * siluf_(s.y)) * siluf_(z.y); y.z = (y.z + dsk * siluf_(s.z)) * siluf_(z.z); y.w = (y.w + dsk * siluf_(s.w)) * siluf_(z.w);
              yv[ps] = y; const float sq = act ? (y.x * y.x + y.y * y.y) + (y.z * y.z + y.w * y.w) : 0.f;
              if (qd < 48) ssq0 += sq; else ssq1 += sq; }
            const float r0 = 1.f / sqrtf(wave_sum2(ssq0) * (1.f / 192.f) + 1e-6f), r1 = 1.f / sqrtf(wave_sum2(ssq1) * (1.f / 192.f) + 1e-6f);
#pragma unroll
            for (int ps = 0; ps < 2; ++ps) { const int qd = ps ? qb : qa, c0 = 4 * qd; const bool act = ps == 0 || lane < 32;
              if (act) *(v2u*)(MIX + (size_t)m * DM + 640 + c0) = pk4(yv[ps] * (qd < 48 ? r0 : r1) * sng[ps]); }
        }
    }
    __syncthreads();
}
namespace cg = cooperative_groups;
constexpr int N_PHASES = 9 * DEPTH + 1;
__global__ void __launch_bounds__(NWAVES * 64, 2) mk_fwd(Args args) {
    extern __shared__ __attribute__((aligned(16))) unsigned char lds_raw[];
    Frame F;
    F.lds = (LAS unsigned char*)lds_raw;
    F.tid = threadIdx.x; F.lane = F.tid & 63; F.wave = __builtin_amdgcn_readfirstlane(F.tid >> 6);
    F.G = gridDim.x; { const int bx = blockIdx.x; F.vcu = (F.G % 8 == 0) ? (bx % 8) * (F.G / 8) + bx / 8 : bx; }
    volatile LAS unsigned* MISC = (volatile LAS unsigned*)(F.lds + MISC_OFF);
    if (F.tid < 64) MISC[F.tid] = 0u;
    if (F.tid < 34) *(LAS unsigned long long*)(F.lds + PTAB_OFF + 8 * F.tid) = ((const unsigned long long*)__builtin_amdgcn_kernarg_segment_ptr())[F.tid];
    __syncthreads();
    unsigned* ctl = (unsigned*)(WSP(F) + WS_CTL);
    XcdBarrier bar = xcd_barrier_post(ctl + CW_BAR, MISC + 8);
    const int lo = args.ph_lo, hi = args.ph_hi;
#define IN_(k) (lo <= (k) && (k) < hi)
#define SEAM(k) do { if (IN_(k) && IN_((k) + 1)) { if ((k) == 0) cg::this_grid().sync(); else xcd_barrier(bar); } } while (0)
#define LAYER(l, B) \
    if (IN_(B + 0)) { phase_convert(F, l); phase_norm(F, l == 0 ? INP(F, 0) : OUTP(F), INP(F, 1) + l * DM, (bf16*)(WSP(F) + WS_XN)); } SEAM(B + 0); \
    if (IN_(B + 1)) { unsigned char* ws = WSP(F); pg8::Gemm g{(const bf16*)(ws + WS_XN), (const bf16*)(ws + WS_WIN), M, NINP, DM}; pg8::StaticOrder S; S.init(M, NINP, F.G, (int)blockIdx.x); \
            pg8::EpiBf16<0> E{(bf16*)(ws + WS_COLS), NINP, nullptr, 0, 0, 1.f}; \
            pg8::gemm_phase<pg8::EpiBf16<0>, pg8::StaticOrder, PG8_ALIGN, PG8_SP2>(F.lds, g, S, E); } SEAM(B + 1); \
    if (IN_(B + 2)) { phase_gates(F, l); phase_ssd_conv(F, l); } SEAM(B + 2); \
    if (IN_(B + 3)) { const int bx = blockIdx.x; \
            if (bx < 96) { const int c8 = bx & 7, k8 = bx >> 3; rwkv_scan(F, l, c8 + 8 * (k8 >> 2), k8 & 3, (unsigned)l * (SEQ / 32)); } else if (bx < 144) rwkv_produce(F, l, (bx - 96) % 24, (bx - 96) / 24, (unsigned)l * (SEQ / 32)); else if (bx < 216) { const int u = bx - 144, sg = 2 - (u / 24); ssd_seq(F, l, u % 24, sg == 0 ? 0 : (sg == 1 ? 43 : 86), sg == 0 ? 43 : (sg == 1 ? 86 : 128)); } else if (bx < 248) { const int u = bx - 216, sg = 1 - (u / 16); mlstm_seq(F, l, u % 16, 64 * sg, 64 * sg + 64); } } SEAM(B + 3); \
    if (IN_(B + 4)) phase_post(F, l); SEAM(B + 4); \
    if (IN_(B + 5)) { unsigned char* ws = WSP(F); pg8::Gemm g{(const bf16*)(ws + WS_XN), (const bf16*)(ws + WS_WOUT), M, DM, DM}; pg8::StaticOrder S; S.init(M, DM, F.G, (int)blockIdx.x); \
            pg8::EpiResidual E{l == 0 ? INP(F, 0) : OUTP(F), OUTP(F), DM}; \
            pg8::gemm_phase<pg8::EpiResidual, pg8::StaticOrder, PG8_ALIGN, PG8_SP2>(F.lds, g, S, E); } SEAM(B + 5); \
    if (IN_(B + 6)) phase_norm(F, OUTP(F), INP(F, 27) + l * DM, (bf16*)(WSP(F) + WS_XN)); SEAM(B + 6); \
    if (IN_(B + 7)) { unsigned char* ws = WSP(F); pg8::Gemm g{(const bf16*)(ws + WS_XN), (const bf16*)(ws + WS_WGU), M, 2 * FFN, DM}; pg8::StaticOrder S; S.init(M, 2 * FFN, F.G, (int)blockIdx.x); \
            pg8::EpiSwiGLU E{(bf16*)(ws + WS_COLS), FFN}; \
            pg8::gemm_phase<pg8::EpiSwiGLU, pg8::StaticOrder, PG8_ALIGN, PG8_SP2>(F.lds, g, S, E); } SEAM(B + 7); \
    if (IN_(B + 8)) { unsigned char* ws = WSP(F); pg8::Gemm g{(const bf16*)(ws + WS_COLS), (const bf16*)(ws + WS_WDN), M, DM, FFN}; pg8::StaticOrder S; S.init(M, DM, F.G, (int)blockIdx.x); \
            pg8::EpiResidual E{OUTP(F), OUTP(F), DM}; \
            pg8::gemm_phase<pg8::EpiResidual, pg8::StaticOrder, PG8_ALIGN, PG8_SP2>(F.lds, g, S, E); } SEAM(B + 8);
    LAYER(0, 0)
    LAYER(1, 9)
    if (IN_(18)) phase_final_norm(F, OUTP(F), INP(F, 31));
#undef IN_
#undef SEAM
#undef LAYER
}

#ifndef MK_PER_PHASE
#define MK_PER_PHASE 0
#endif
extern "C" void kernel_launch(void* const* d_in, const int* in_sizes, int n_in, void* d_out, int out_size, void* d_ws, size_t ws_size, hipStream_t stream) {
    static int grid = 0;
    if (grid == 0) {
        int dev = 0, cus = 0;
        if (n_in != 32 || out_size != M * DM || ws_size < WS_END) { fprintf(stderr, "kernel_launch: unexpected shapes (n_in %d out %d ws %zu)\n", n_in, out_size, ws_size); grid = -1; return; }
        if (hipGetDevice(&dev) != hipSuccess || hipDeviceGetAttribute(&cus, hipDeviceAttributeMultiprocessorCount, dev) != hipSuccess) { grid = -1; return; }
        if (hipFuncSetAttribute((const void*)mk_fwd, hipFuncAttributeMaxDynamicSharedMemorySize, LDS_BYTES) != hipSuccess) { fprintf(stderr, "kernel_launch: hipFuncSetAttribute failed\n"); grid = -1; return; }
        int per_cu = 0;
        if (hipOccupancyMaxActiveBlocksPerMultiprocessor(&per_cu, (const void*)mk_fwd, NWAVES * 64, LDS_BYTES) != hipSuccess || per_cu < 1) { fprintf(stderr, "kernel_launch: occupancy query says %d\n", per_cu); }
        (void)hipGetLastError();
        grid = cus;
    }
    if (grid < 0) return;
    (void)hipMemsetAsync((char*)d_ws + WS_CTL, 0, CTL_ZERO_BYTES, stream);
    Args a{};
    for (int i = 0; i < 32; ++i) a.in[i] = (const float*)d_in[i];
    a.out = (float*)d_out; a.ws = (unsigned char*)d_ws;
#if MK_PER_PHASE
    for (int p = 0; p < N_PHASES; ++p) { a.ph_lo = p; a.ph_hi = p + 1; hipLaunchKernelGGL(mk_fwd, dim3(grid), dim3(NWAVES * 64), LDS_BYTES, stream, a); }
#else
    a.ph_lo = 0; a.ph_hi = N_PHASES;
    void* kargs[] = {&a};
    hipError_t e = hipLaunchCooperativeKernel((const void*)mk_fwd, dim3(grid), dim3(NWAVES * 64), kargs, LDS_BYTES, stream);
    if (e != hipSuccess) fprintf(stderr, "cooperative launch failed: %s (grid %d)\n", hipGetErrorString(e), grid);
#endif
}
```

```cpp
#include <hip/hip_runtime.h>
#include <hip/hip_cooperative_groups.h>
#include <cstdio>
#include <cstdint>
namespace pg8 {
#define PG8_LAS __attribute__((address_space(3)))
typedef unsigned short bf16_t;
typedef short bf16x8 __attribute__((ext_vector_type(8)));
typedef float f32x4 __attribute__((ext_vector_type(4)));
typedef unsigned u32x4 __attribute__((ext_vector_type(4)));
constexpr int BM = 256, BK = 64, HALF = 128, HTB = HALF * BK * 2  , STAGE_BYTES = 8 * HTB, NXCD = 8, WGM = 8;

__host__ __device__ __forceinline__ int lds_byte(int r, int c) { const int st = (r >> 4) * 2 + (c >> 5), rr = r & 15, cc = c & 31, ob = rr * 64 + cc * 2; return st * 1024 + (ob ^ (((ob >> 9) & 1) << 5)); }
__host__ __device__ __forceinline__ void stage_rc(int b, int& R, int& C) { const int st = b / 1024, sb = b % 1024, swz = sb ^ (((sb >> 9) & 1) << 5); R = (st >> 1) * 16 + swz / 64; C = (st & 1) * 32 + (swz % 64) / 2; }
__host__ __device__ __forceinline__ int perm32(int rho) { const int n = rho >> 4, i = rho & 15; return 8 * (i >> 2) + 4 * n + (i & 3); }

struct Unit { int pm, pn; };
struct Gemm { const bf16_t* A; const bf16_t* Bt; int M, N, K; };

struct StaticOrder {
    int nM, nN, nwg, G, c;
    __host__ __device__ void init(int M, int N, int G_, int c_) { nM = M / BM; nN = N / BM; nwg = nM * nN; G = G_; c = c_; }
    __host__ __device__ bool next(int i, Unit& u) const {
        const long L = (long)i * G + c; if (L >= nwg) return false;
        int wgid = (int)L; { const int q = nwg / NXCD, r = nwg % NXCD, xcd = wgid % NXCD, off = wgid / NXCD; wgid = (xcd < r ? xcd * (q + 1) : r * (q + 1) + (xcd - r) * q) + off; }
        const int nig = WGM * nN, gid = wgid / nig, fm = gid * WGM, gsz = (nM - fm) < WGM ? (nM - fm) : WGM;
        u.pm = fm + ((wgid % nig) % gsz); u.pn = (wgid % nig) / gsz; return true;
    }
    __device__ __forceinline__ void a_ready(const Unit&) const {}
    __device__ __forceinline__ void done(const Unit&) const {}
};

__device__ __forceinline__ unsigned cvt_pk_bf16(float lo, float hi) { unsigned r; asm volatile("v_cvt_pk_bf16_f32 %0, %1, %2" : "=v"(r) : "v"(lo), "v"(hi)); return r; }
typedef float f32x2 __attribute__((ext_vector_type(2)));
__device__ __forceinline__ f32x2 gelu_pk(f32x2 v) {
    const f32x2 av = __builtin_elementwise_abs(v), d = av * 0.2316418882f + 1.0f;
    f32x2 t; t.x = __builtin_amdgcn_rcpf(d.x); t.y = __builtin_amdgcn_rcpf(d.y);
    f32x2 q = t * 0.5307027145f + (-0.7265760135f); q = q * t + 0.7107068705f; q = q * t + (-0.142248368f); q = q * t + 0.127414796f; q = q * t;
    const f32x2 s = (v * v) * (-0.72134752044f);
    f32x2 e; e.x = __builtin_amdgcn_exp2f(s.x); e.y = __builtin_amdgcn_exp2f(s.y);
    const f32x2 m = v * (q * e), r = v - m;
    f32x2 o; o.x = v.x < 0.f ? m.x : r.x; o.y = v.y < 0.f ? m.y : r.y; return o;
}

template <int ACT  > struct EpiBf16 {
    static constexpr bool PERM = true, AFTER_DRAIN = false; static_assert(ACT == 0 || ACT == 1, "EpiBf16: ACT is 0 (none) or 1 (gelu_pk)");
    bf16_t* O; int ldc; const float* bias; int split_cols; size_t split_stride; float scale0;
    __device__ __forceinline__ void operator()(const f32x4 (&acc)[2][2][4][2], const Unit& u, int wr, int wc, int fr, int fq) const {
        const int row0 = u.pm * BM + wr * 64 + fr; int colt = u.pn * BM; bf16_t* base = O;
        float sc = 1.f; if (split_cols) { const int t = colt / split_cols; base += (size_t)t * split_stride; colt -= t * split_cols; if (t == 0) sc = scale0; }
        const int col0 = colt + wc * 32 + 8 * fq, bcol0 = u.pn * BM + wc * 32 + 8 * fq;
        f32x4 bv[2][2];
#pragma unroll
        for (int bj = 0; bj < 2; ++bj)
#pragma unroll
            for (int n = 0; n < 2; ++n) bv[bj][n] = bias ? *(const f32x4*)(bias + bcol0 + bj * HALF + 4 * n) : (f32x4){0.f, 0.f, 0.f, 0.f};
#pragma unroll
        for (int ai = 0; ai < 2; ++ai)
#pragma unroll
            for (int m = 0; m < 4; ++m) { bf16_t* rowp = base + (size_t)(row0 + ai * HALF + m * 16) * ldc + col0;
#pragma unroll
                for (int bj = 0; bj < 2; ++bj) { f32x4 v0 = acc[ai][bj][m][0] + bv[bj][0], v1 = acc[ai][bj][m][1] + bv[bj][1];
                    if (ACT == 1) { f32x2 a = gelu_pk((f32x2){v0[0], v0[1]}), b = gelu_pk((f32x2){v0[2], v0[3]}), c = gelu_pk((f32x2){v1[0], v1[1]}), d = gelu_pk((f32x2){v1[2], v1[3]});
                        v0 = (f32x4){a.x, a.y, b.x, b.y}; v1 = (f32x4){c.x, c.y, d.x, d.y}; }
                    v0 = v0 * sc; v1 = v1 * sc; u32x4 w; w.x = cvt_pk_bf16(v0[0], v0[1]); w.y = cvt_pk_bf16(v0[2], v0[3]); w.z = cvt_pk_bf16(v1[0], v1[1]); w.w = cvt_pk_bf16(v1[2], v1[3]);
                    *(u32x4*)(rowp + bj * HALF) = w; } }
    }
};
struct EpiResidual {
    static constexpr bool PERM = false, AFTER_DRAIN = false;
    const float* base; float* out; int ldc;
    __device__ __forceinline__ void operator()(const f32x4 (&acc)[2][2][4][2], const Unit& u, int wr, int wc, int fr, int fq) const {
        const int col0 = u.pn * BM + wc * 32 + 4 * fq;
#pragma unroll
        for (int ai = 0; ai < 2; ++ai)
#pragma unroll
            for (int m = 0; m < 4; ++m) { const size_t off = (size_t)(u.pm * BM + ai * HALF + wr * 64 + m * 16 + fr) * ldc + col0;
#pragma unroll
                for (int bj = 0; bj < 2; ++bj)
#pragma unroll
                    for (int n = 0; n < 2; ++n) { const f32x4 bs = *(const f32x4*)(base + off + bj * HALF + n * 16); *(f32x4*)(out + off + bj * HALF + n * 16) = bs + acc[ai][bj][m][n]; }
                asm volatile("" ::: "memory"); }
    }
};
struct EpiSwiGLU {
    static constexpr bool PERM = true, AFTER_DRAIN = false;
    bf16_t* O; int ldc;
    __device__ __forceinline__ void operator()(const f32x4 (&acc)[2][2][4][2], const Unit& u, int wr, int wc, int fr, int fq) const {
        const int col0 = u.pn * HALF + wc * 32 + 8 * fq;
#pragma unroll
        for (int ai = 0; ai < 2; ++ai)
#pragma unroll
            for (int m = 0; m < 4; ++m) { bf16_t* rowp = O + (size_t)(u.pm * BM + ai * HALF + wr * 64 + m * 16 + fr) * ldc + col0;
                float r[8];
#pragma unroll
                for (int n = 0; n < 2; ++n)
#pragma unroll
                    for (int j = 0; j < 4; ++j) { const float g = acc[ai][0][m][n][j], up = acc[ai][1][m][n][j]; r[n * 4 + j] = g * __builtin_amdgcn_rcpf(1.f + __expf(-g)) * up; }
                u32x4 w; w.x = cvt_pk_bf16(r[0], r[1]); w.y = cvt_pk_bf16(r[2], r[3]); w.z = cvt_pk_bf16(r[4], r[5]); w.w = cvt_pk_bf16(r[6], r[7]);
                *(u32x4*)rowp = w; }
    }
};
template <class Epi, class Sched, bool ALIGN_EPI = false, bool SP2 = false>
__device__ __forceinline__ void gemm_phase(PG8_LAS unsigned char* lds, const Gemm g, const Sched& S, const Epi& E) {
    const int tid = threadIdx.x, wid = __builtin_amdgcn_readfirstlane(tid >> 6), lane = tid & 63, wr = wid >> 2, wc = wid & 3, fr = lane & 15, fq = lane >> 4;
    const int K = g.K, nt = K / BK;
    unsigned voffA[2], voffB[2];
#pragma unroll
    for (int i = 0; i < 2; ++i) { int R, C; stage_rc(tid * 16 + i * 8192, R, C); const int Rb = Epi::PERM ? ((R & ~31) + perm32(R & 31)) : R;
        voffA[i] = (unsigned)(R * K + C) * 2u; voffB[i] = (unsigned)(Rb * K + C) * 2u; }
    const size_t kstep = (size_t)(BK * 2);
    const size_t hstep = (size_t)HALF * K * 2;
    const size_t tstep = 2 * hstep;
    const unsigned ldsw = (unsigned)wid * 1024u;
    const int aoff = lds_byte(wr * 64 + fr, fq * 8), boff = lds_byte(wc * 32 + fr, fq * 8);
#define PG8_SA(b, h) (((b) * 2 + (h)) * HTB)
#define PG8_SB(b, h) ((4 + (b) * 2 + (h)) * HTB)
#define PG8_STAGE(bufoff, gbase, voff) do { _Pragma("unroll") for (int _i = 0; _i < 2; ++_i) \
        __builtin_amdgcn_global_load_lds((const unsigned*)((const char*)(gbase) + (voff)[_i]), (PG8_LAS unsigned*)(lds + (bufoff) + ldsw + _i * 8192), 16, 0, 0); } while (0)
#define PG8_LDA(dst, b, h) do { _Pragma("unroll") for (int m = 0; m < 4; ++m) _Pragma("unroll") for (int k = 0; k < 2; ++k) dst[m][k] = *(const PG8_LAS bf16x8*)(lds + PG8_SA(b, h) + aoff + m * 2048 + k * 1024); } while (0)
#define PG8_LDB(dst, b, h) do { _Pragma("unroll") for (int n = 0; n < 2; ++n) _Pragma("unroll") for (int k = 0; k < 2; ++k) dst[n][k] = *(const PG8_LAS bf16x8*)(lds + PG8_SB(b, h) + boff + n * 2048 + k * 1024); } while (0)
#define PG8_MMA(ai, bj, At, Bt) do { __builtin_amdgcn_s_setprio(1); _Pragma("unroll") for (int m = 0; m < 4; ++m) _Pragma("unroll") for (int n = 0; n < 2; ++n) _Pragma("unroll") for (int k = 0; k < 2; ++k) \
        acc[ai][bj][m][n] = __builtin_amdgcn_mfma_f32_16x16x32_bf16(Bt[n][k], At[m][k], acc[ai][bj][m][n], 0, 0, 0); __builtin_amdgcn_s_setprio(0); } while (0)
#define PG8_WAIT_V(n) asm volatile("s_waitcnt vmcnt(" #n ")" ::: "memory")
#define PG8_WAIT_L(n) asm volatile("s_waitcnt lgkmcnt(" #n ")" ::: "memory")
#define PG8_BAR __builtin_amdgcn_s_barrier()
#define PG8_SCHED __builtin_amdgcn_sched_barrier(0)
    Unit cur, nxt; int ui = 0;
    if (!S.next(0, cur)) return;
    f32x4 acc[2][2][4][2];
#pragma unroll
    for (int a = 0; a < 2; ++a)
#pragma unroll
        for (int b = 0; b < 2; ++b)
#pragma unroll
            for (int m = 0; m < 4; ++m)
#pragma unroll
                for (int n = 0; n < 2; ++n) acc[a][b][m][n] = (f32x4){0.f, 0.f, 0.f, 0.f};
    bf16x8 At[4][2], B0[2][2], B1[2][2];
    const char* cA = (const char*)g.A + (size_t)cur.pm * tstep; const char* cB = (const char*)g.Bt + (size_t)cur.pn * tstep;
    S.a_ready(cur);
    if constexpr (SP2) {
        PG8_STAGE(PG8_SB(0, 0), cB, voffB); PG8_STAGE(PG8_SB(0, 1), cB + hstep, voffB); PG8_STAGE(PG8_SA(0, 0), cA, voffA); PG8_STAGE(PG8_SA(0, 1), cA + hstep, voffA);
        if (wr == 1) PG8_BAR;
        PG8_WAIT_V(2); PG8_BAR;
        PG8_STAGE(PG8_SB(1, 0), cB + kstep, voffB); PG8_STAGE(PG8_SA(1, 0), cA + kstep, voffA); PG8_STAGE(PG8_SB(1, 1), cB + hstep + kstep, voffB);
        PG8_WAIT_V(6); PG8_BAR;
    } else {
        PG8_STAGE(PG8_SB(0, 0), cB, voffB); PG8_STAGE(PG8_SA(0, 0), cA, voffA); PG8_STAGE(PG8_SB(0, 1), cB + hstep, voffB); PG8_STAGE(PG8_SA(0, 1), cA + hstep, voffA);
        if (wr == 1) PG8_BAR;
        PG8_WAIT_V(4); PG8_BAR;
        PG8_STAGE(PG8_SB(1, 0), cB + kstep, voffB); PG8_STAGE(PG8_SA(1, 0), cA + kstep, voffA); PG8_STAGE(PG8_SB(1, 1), cB + hstep + kstep, voffB);
        PG8_WAIT_V(6); PG8_BAR;
    }
    for (;;) {
        const bool has_next = S.next(ui + 1, nxt);
        const char* nA = has_next ? (const char*)g.A + (size_t)nxt.pm * tstep : cA; const char* nB = has_next ? (const char*)g.Bt + (size_t)nxt.pn * tstep : cB;
        for (int t = 0; t < nt; t += 2) {
            const bool last = (t == nt - 2);
            const char* a1 = cA + (size_t)(t + 1) * kstep;
            const char* a2 = last ? nA : cA + (size_t)(t + 2) * kstep; const char* b2 = last ? nB : cB + (size_t)(t + 2) * kstep;
            const char* a3 = a2 + kstep; const char* b3 = b2 + kstep;
            if (last && has_next) S.a_ready(nxt);
            if constexpr (SP2) {
            PG8_LDB(B0, 0, 0); PG8_LDB(B1, 0, 1); PG8_SCHED; PG8_LDA(At, 0, 0); PG8_STAGE(PG8_SA(1, 1), a1 + hstep, voffA);
            PG8_WAIT_V(8); PG8_WAIT_L(0); PG8_BAR; PG8_MMA(0, 0, At, B0); PG8_MMA(0, 1, At, B1); PG8_BAR; PG8_SCHED;
            PG8_LDA(At, 0, 1); PG8_STAGE(PG8_SB(0, 0), b2, voffB); PG8_STAGE(PG8_SB(0, 1), b2 + hstep, voffB); PG8_STAGE(PG8_SA(0, 0), a2, voffA);
            PG8_WAIT_V(8); PG8_WAIT_L(0); PG8_BAR; PG8_MMA(1, 0, At, B0); PG8_MMA(1, 1, At, B1); PG8_BAR; PG8_SCHED;
            PG8_LDB(B0, 1, 0); PG8_LDB(B1, 1, 1); PG8_SCHED; PG8_LDA(At, 1, 0); PG8_STAGE(PG8_SA(0, 1), a2 + hstep, voffA);
            PG8_WAIT_V(8); PG8_WAIT_L(0); PG8_BAR; PG8_MMA(0, 0, At, B0); PG8_MMA(0, 1, At, B1); PG8_BAR; PG8_SCHED;
            PG8_LDA(At, 1, 1); PG8_STAGE(PG8_SB(1, 0), b3, voffB); PG8_STAGE(PG8_SB(1, 1), b3 + hstep, voffB); PG8_STAGE(PG8_SA(1, 0), a3, voffA);
            PG8_WAIT_V(8); PG8_WAIT_L(0); PG8_BAR; PG8_MMA(1, 0, At, B0); PG8_MMA(1, 1, At, B1); PG8_BAR; PG8_SCHED;
            } else {
            PG8_LDB(B0, 0, 0); PG8_SCHED; PG8_LDA(At, 0, 0); PG8_STAGE(PG8_SA(1, 1), a1 + hstep, voffA);
            PG8_WAIT_L(8); PG8_BAR; PG8_WAIT_L(0); PG8_MMA(0, 0, At, B0); PG8_BAR; PG8_SCHED;
            PG8_LDB(B1, 0, 1); PG8_STAGE(PG8_SB(0, 0), b2, voffB);
            PG8_BAR; PG8_WAIT_L(0); PG8_MMA(0, 1, At, B1); PG8_BAR;
            PG8_LDA(At, 0, 1); PG8_STAGE(PG8_SA(0, 0), a2, voffA);
            PG8_BAR; PG8_WAIT_L(0); PG8_MMA(1, 0, At, B0); PG8_BAR; PG8_SCHED;
            PG8_STAGE(PG8_SB(0, 1), b2 + hstep, voffB);
            PG8_WAIT_V(6); PG8_BAR; PG8_MMA(1, 1, At, B1); PG8_BAR;
            PG8_LDB(B0, 1, 0); PG8_SCHED; PG8_LDA(At, 1, 0); PG8_STAGE(PG8_SA(0, 1), a2 + hstep, voffA);
            PG8_WAIT_L(8); PG8_BAR; PG8_WAIT_L(0); PG8_MMA(0, 0, At, B0); PG8_BAR; PG8_SCHED;
            PG8_LDB(B1, 1, 1); PG8_STAGE(PG8_SB(1, 0), b3, voffB);
            PG8_BAR; PG8_WAIT_L(0); PG8_MMA(0, 1, At, B1); PG8_BAR;
            PG8_LDA(At, 1, 1); PG8_STAGE(PG8_SA(1, 0), a3, voffA);
            PG8_BAR; PG8_WAIT_L(0); PG8_MMA(1, 0, At, B0); PG8_BAR; PG8_SCHED;
            PG8_STAGE(PG8_SB(1, 1), b3 + hstep, voffB);
            PG8_WAIT_V(6); PG8_BAR; PG8_MMA(1, 1, At, B1); PG8_BAR;
            }
        }
        if constexpr (ALIGN_EPI) { if (wr == 0) PG8_BAR; }
        if constexpr (!Epi::AFTER_DRAIN) { E(acc, cur, wr, wc, fr, fq); S.done(cur); }
        if (!has_next) break;
#pragma unroll
        for (int a = 0; a < 2; ++a)
#pragma unroll
            for (int b = 0; b < 2; ++b)
#pragma unroll
                for (int m = 0; m < 4; ++m)
#pragma unroll
                    for (int n = 0; n < 2; ++n) acc[a][b][m][n] = (f32x4){0.f, 0.f, 0.f, 0.f};
        cur = nxt; cA = nA; cB = nB; ++ui;
        if constexpr (ALIGN_EPI) { if (wr == 1) PG8_BAR; }
    }
    PG8_WAIT_V(0);
    if constexpr (!ALIGN_EPI) { if (wr == 0) PG8_BAR; }
    PG8_BAR;
    if constexpr (Epi::AFTER_DRAIN) { E.fused(acc, cur, wr, wc, fr, fq, lds, wid, lane); S.done(cur); }
#undef PG8_SA
#undef PG8_SB
#undef PG8_STAGE
#undef PG8_LDA
#undef PG8_LDB
#undef PG8_MMA
#undef PG8_WAIT_V
#undef PG8_WAIT_L
#undef PG8_BAR
#undef PG8_SCHED
}
}

#ifndef PG8_SP2
#define PG8_SP2 true
#endif
#define PG8_ALIGN true
constexpr int NWAVES = 8;
constexpr int BATCH = 2, SEQ = 8192, DM = 1024, M = BATCH * SEQ, NIN = 3788, NINP = 3840, FFN = 2816, DEPTH = 2;
constexpr int A_Q = 0, A_K = 256, A_V = 512, A_O = 768;
constexpr int R_R = 1024, R_K = 1408, R_V = 1792, R_WDF = 2176, R_AD = 2304, R_GD = 2368;
constexpr int S_Z = 2496, S_X = 2880, S_B = 3264, S_C = 3520, S_DT = 3776;
constexpr size_t MiB = 1u << 20;
constexpr size_t WS_CTL = 0, CTL_ZERO_BYTES = 128 * 1024;
constexpr size_t WS_GATES = 1 * MiB, WS_CT = 2 * MiB, WS_DTV = 2 * MiB + 512 * 1024;
constexpr size_t WS_WIN = 4 * MiB, WS_WOUT = 12 * MiB, WS_WGU = 14 * MiB, WS_WDN = 25 * MiB;
constexpr size_t WS_XN = 32 * MiB, WS_COLS = 64 * MiB, WS_Y = 184 * MiB, WS_END = 256 * MiB;
constexpr size_t Y_AF = WS_Y, Y_AB = WS_Y + 8 * MiB, Y_RF = WS_Y + 16 * MiB, Y_RB = WS_Y + 28 * MiB, Y_SF = WS_Y + 40 * MiB, Y_SB = WS_Y + 52 * MiB;
constexpr int CW_BAR = 1024;
constexpr int RING_BYTES = 131072;
constexpr int LDS_BYTES = 147456, MISC_OFF = LDS_BYTES - 256;

#define GAS __attribute__((address_space(1)))
#define LAS __attribute__((address_space(3)))
typedef unsigned short bf16;
typedef unsigned v4u __attribute__((ext_vector_type(4)));
typedef unsigned v2u __attribute__((ext_vector_type(2)));
typedef float f32x4 __attribute__((ext_vector_type(4)));
typedef short bf16x8 __attribute__((ext_vector_type(8)));
typedef GAS unsigned gu32;
#define RLX_AGENT __ATOMIC_RELAXED, __HIP_MEMORY_SCOPE_AGENT
#define LDS_WAIT() asm volatile("s_waitcnt lgkmcnt(0)" ::: "memory")
#define VM_WAIT() asm volatile("s_waitcnt vmcnt(0)" ::: "memory")
__device__ __forceinline__ unsigned f2bf(float f) { unsigned u = __builtin_bit_cast(unsigned, f); return (u + 0x7fffu + ((u >> 16) & 1u)) >> 16; }
__device__ __forceinline__ unsigned pk2(float lo, float hi) { return f2bf(lo) | (f2bf(hi) << 16); }
__device__ __forceinline__ float bf2f(unsigned u) { return __builtin_bit_cast(float, u << 16); }
__device__ __forceinline__ float sigmoidf_(float x) { return __builtin_amdgcn_rcpf(1.f + __expf(-x)); }
__device__ __forceinline__ float siluf_(float x) { return x * sigmoidf_(x); }
__device__ __forceinline__ float wave_sum(float v) {
#pragma unroll
    for (int o = 1; o < 64; o <<= 1) v += __shfl_xor(v, o);
    return v;
}
__device__ __forceinline__ float wave_max(float v) {
#pragma unroll
    for (int o = 1; o < 64; o <<= 1) v = fmaxf(v, __shfl_xor(v, o));
    return v;
}
template <int CTRL> __device__ __forceinline__ float dppf(float v) { return __builtin_bit_cast(float, __builtin_amdgcn_update_dpp(0, __builtin_bit_cast(int, v), CTRL, 0xf, 0xf, true)); }
__device__ __forceinline__ float row16_sum(float v) { v += dppf<0xB1>(v); v += dppf<0x4E>(v); v += dppf<0x141>(v); v += dppf<0x140>(v); return v; }
template <int K> __device__ __forceinline__ f32x4 mma16(const LAS bf16* A, int lda, const LAS bf16* Bt, int ldb, f32x4 acc, int lane) {
    const int r = lane & 15, q = lane >> 4;
    const LAS bf16* ap = A + r * lda + q * 8; const LAS bf16* bp = Bt + r * ldb + q * 8;
#pragma unroll
    for (int k0 = 0; k0 < K; k0 += 32) {
        const bf16x8 a = *(const LAS bf16x8*)(ap + k0); const bf16x8 b = *(const LAS bf16x8*)(bp + k0);
        acc = __builtin_amdgcn_mfma_f32_16x16x32_bf16(a, b, acc, 0, 0, 0);
    }
    return acc;
}

__device__ __forceinline__ int swz64(int row, int col) { return col ^ (((row >> 3) & 7) << 3); }
template <bool SWA, bool SWB> __device__ __forceinline__ f32x4 mma16s(const LAS bf16* A, int lda, int rowA0, const LAS bf16* Bt, int ldb, int rowB0, f32x4 acc, int lane) {
    const int r = lane & 15, q = lane >> 4; const int ra = rowA0 + r, rb = rowB0 + r;
#pragma unroll
    for (int k0 = 0; k0 < 64; k0 += 32) { const int ca = k0 + 8 * q, cb = k0 + 8 * q;
        const bf16x8 a = *(const LAS bf16x8*)(A + ra * lda + (SWA ? swz64(ra, ca) : ca)); const bf16x8 b = *(const LAS bf16x8*)(Bt + rb * ldb + (SWB ? swz64(rb, cb) : cb));
        acc = __builtin_amdgcn_mfma_f32_16x16x32_bf16(a, b, acc, 0, 0, 0); }
    return acc;
}

template <int CTRL, int RM, int BM> __device__ __forceinline__ float dppm(float oldv, float v) { return __builtin_bit_cast(float, __builtin_amdgcn_update_dpp(__builtin_bit_cast(int, oldv), __builtin_bit_cast(int, v), CTRL, RM, BM, false)); }
__device__ __forceinline__ float wave_scan_add(float x) {
    float y = x + dppm<0x111, 0xf, 0xf>(0.f, x); y += dppm<0x112, 0xf, 0xf>(0.f, x); y += dppm<0x113, 0xf, 0xf>(0.f, x);
    y += dppm<0x114, 0xf, 0xe>(0.f, y); y += dppm<0x118, 0xf, 0xc>(0.f, y);
    y += dppm<0x142, 0xa, 0xf>(0.f, y); y += dppm<0x143, 0xc, 0xf>(0.f, y);
    return y;
}
__device__ __forceinline__ float wave_scan_max(float x) {
    const float ninf = -INFINITY;
    float y = fmaxf(x, dppm<0x111, 0xf, 0xf>(ninf, x)); y = fmaxf(y, dppm<0x112, 0xf, 0xf>(ninf, x)); y = fmaxf(y, dppm<0x113, 0xf, 0xf>(ninf, x));
    y = fmaxf(y, dppm<0x114, 0xf, 0xe>(ninf, y)); y = fmaxf(y, dppm<0x118, 0xf, 0xc>(ninf, y));
    y = fmaxf(y, dppm<0x142, 0xa, 0xf>(ninf, y)); y = fmaxf(y, dppm<0x143, 0xc, 0xf>(ninf, y));
    return y;
}
#define XB_TMO      128
#define XB_XCNT(j)  (256  + 64 * (j))
#define XB_XSUB(j)  (1280 + 64 * (j))
#define XB_XGEN(j)  (2304 + 64 * (j))
#define XB_TOP      3328
#define XB_TOPGEN   3392
#define XCD_BAR_WORDS 3456
#define XB_SPIN_CAP (1u << 18)

__device__ __forceinline__ unsigned xb_ld(unsigned* p)              { return __hip_atomic_load(p, __ATOMIC_RELAXED, __HIP_MEMORY_SCOPE_AGENT); }
__device__ __forceinline__ unsigned xb_add(unsigned* p, unsigned v) { return __hip_atomic_fetch_add(p, v, __ATOMIC_RELAXED, __HIP_MEMORY_SCOPE_AGENT); }
__device__ __forceinline__ unsigned xb_xcc_id() { return (unsigned)__builtin_amdgcn_s_getreg((3 << 11) | 20) & 0xFu; }
#define XB_SPIN(cond, bar) do { unsigned _sp = 0; while (cond) { __builtin_amdgcn_s_sleep(1); \
    if ((++_sp & 255u) == 0u) { if (xb_ld(&(bar)[XB_TMO])) break; if (_sp > XB_SPIN_CAP) { atomicAdd(&(bar)[XB_TMO], 1u); break; } } } } while (0)

struct XcdBarrier {
    unsigned* bar; unsigned x;
    volatile LAS unsigned* st;
};

__device__ __forceinline__ XcdBarrier xcd_barrier_post(unsigned* bar, volatile LAS unsigned* st) {
    XcdBarrier b; b.bar = bar; b.x = xb_xcc_id(); b.st = st;
    if (threadIdx.x == 0) (void)xb_add(&bar[XB_XCNT(b.x)], 1u);
    return b;
}
__device__ __forceinline__ void xcd_barrier_complete(unsigned* bar, unsigned x, unsigned& nloc, unsigned& nx) {
    const unsigned G = gridDim.x * gridDim.y * gridDim.z;
    unsigned sum, cnt, mine, sp = 0u;
    for (;;) {
        sum = 0u; cnt = 0u; mine = 0u;
#pragma unroll
        for (unsigned j = 0; j < 16; ++j) { const unsigned c = xb_ld(&bar[XB_XCNT(j)]); sum += c; cnt += (c > 0u) ? 1u : 0u; mine = (j == x) ? c : mine; }
        if (sum == G) break;
        __builtin_amdgcn_s_sleep(1);
        if ((++sp & 255u) == 0u) { if (xb_ld(&bar[XB_TMO])) break; if (sp > XB_SPIN_CAP) { atomicAdd(&bar[XB_TMO], 1u); break; } }
    }
    nloc = mine > 0u ? mine : 1u; nx = cnt > 0u ? cnt : 1u;
}

__device__ __forceinline__ void xcd_barrier(const XcdBarrier& b) {
    asm volatile("s_waitcnt vmcnt(0)" ::: "memory");
    __syncthreads();
    if (threadIdx.x == 0) {
        unsigned* bar = b.bar;
        __builtin_amdgcn_s_waitcnt(0);
        unsigned nloc = b.st[0], nx = b.st[1];
        if (nloc == 0u) { xcd_barrier_complete(bar, b.x, nloc, nx); b.st[0] = nloc; b.st[1] = nx; }
        const unsigned old = xb_add(&bar[XB_XSUB(b.x)], 1u);
        const unsigned gen = old / nloc;
        if (old + 1u == (gen + 1u) * nloc) {
            __builtin_amdgcn_fence(__ATOMIC_RELEASE, "agent");
            asm volatile("s_waitcnt vmcnt(0)" ::: "memory");
            const unsigned og = xb_add(&bar[XB_TOP], 1u);
            const unsigned tg = og / nx;
            if (og + 1u == (tg + 1u) * nx) xb_add(&bar[XB_TOPGEN], 1u);
            else XB_SPIN(xb_ld(&bar[XB_TOPGEN]) == tg, bar);
            __builtin_amdgcn_fence(__ATOMIC_ACQUIRE, "agent");
            xb_add(&bar[XB_XGEN(b.x)], 1u);
            asm volatile("s_waitcnt vmcnt(0)" ::: "memory");
        } else {
            XB_SPIN(xb_ld(&bar[XB_XGEN(b.x)]) == gen, bar);
            __builtin_amdgcn_fence(__ATOMIC_ACQUIRE, "agent");
            asm volatile("s_waitcnt vmcnt(0)" ::: "memory");
        }
    }
    __syncthreads();
}
struct Frame {
    LAS unsigned char* lds;
    int tid, lane, wave, vcu, G;
};
struct Args { const float* in[32]; float* out; unsigned char* ws; int ph_lo, ph_hi; };
constexpr int PTAB_OFF = LDS_BYTES - 768;
__device__ __forceinline__ unsigned long long ptab_ld(const Frame& F, int i) {
    const unsigned long long v = *(volatile LAS unsigned long long*)(F.lds + PTAB_OFF + 8 * i);
    const unsigned lo = __builtin_amdgcn_readfirstlane((unsigned)v), hi = __builtin_amdgcn_readfirstlane((unsigned)(v >> 32));
    return ((unsigned long long)hi << 32) | lo;
}
__device__ __forceinline__ const float* INP(const Frame& F, int i) { return (const float*)ptab_ld(F, i); }
__device__ __forceinline__ unsigned char* WSP(const Frame& F) { return (unsigned char*)ptab_ld(F, 33); }
__device__ __forceinline__ float* OUTP(const Frame& F) { return (float*)ptab_ld(F, 32); }

__device__ __forceinline__ void transpose_item(const float* W, int K, int N, int nblk, bf16* WT, int mode, int row_off, LAS float* scr, int item, int lane) {
    const int kb = item / nblk, nb = item % nblk, k0 = 64 * kb, n0 = 32 * nb;
    const int ncol = n0 + (lane & 31); const bool ok = ncol < N;
#pragma unroll 8
    for (int i = 0; i < 32; ++i) { const int kk = 2 * i + (lane >> 5); scr[kk * 33 + (lane & 31)] = ok ? W[(size_t)(k0 + kk) * N + ncol] : 0.f; }
    LDS_WAIT(); asm volatile("" ::: "memory");
    const int c = lane & 7;
    const int drow0 = mode ? (256 * (n0 >> 7) + (n0 & 127) + row_off) : (row_off + n0);
#pragma unroll
    for (int j = 0; j < 4; ++j) { const int n = (lane >> 3) + 8 * j; const LAS float* s = scr + (8 * c) * 33 + n;
        v4u o; o.x = pk2(s[0 * 33], s[1 * 33]); o.y = pk2(s[2 * 33], s[3 * 33]); o.z = pk2(s[4 * 33], s[5 * 33]); o.w = pk2(s[6 * 33], s[7 * 33]);
        *(v4u*)(WT + (size_t)(drow0 + n) * K + k0 + 8 * c) = o; }
    LDS_WAIT(); asm volatile("" ::: "memory");
}
__device__ __forceinline__ void phase_convert(const Frame& F, int l) {
    LAS float* scr = (LAS float*)(F.lds + F.wave * 16384);
    const int gw = F.vcu * NWAVES + F.wave, NGW = F.G * NWAVES;
    bf16* Win = (bf16*)(WSP(F) + WS_WIN); bf16* Wout = (bf16*)(WSP(F) + WS_WOUT); bf16* Wgu = (bf16*)(WSP(F) + WS_WGU); bf16* Wdn = (bf16*)(WSP(F) + WS_WDN);
    constexpr int I_IN = 16 * 120, I_OUT = 16 * 32, I_G = 16 * 88, I_D = 44 * 32;
    constexpr int NITEMS = I_IN + I_OUT + 2 * I_G + I_D;
    for (int it = gw; it < NITEMS; it += NGW) {
        int r = it;
        if (r < I_IN) { transpose_item(INP(F, 2) + (size_t)l * DM * NIN, DM, NIN, 120, Win, 0, 0, scr, r, F.lane); continue; } r -= I_IN;
        if (r < I_OUT) { transpose_item(INP(F, 26) + (size_t)l * DM * DM, DM, DM, 32, Wout, 0, 0, scr, r, F.lane); continue; } r -= I_OUT;
        if (r < I_G) { transpose_item(INP(F, 28) + (size_t)l * DM * FFN, DM, FFN, 88, Wgu, 1, 0, scr, r, F.lane); continue; } r -= I_G;
        if (r < I_G) { transpose_item(INP(F, 29) + (size_t)l * DM * FFN, DM, FFN, 88, Wgu, 1, 128, scr, r, F.lane); continue; } r -= I_G;
        transpose_item(INP(F, 30) + (size_t)l * FFN * DM, FFN, DM, 32, Wdn, 0, 0, scr, r, F.lane);
    }
}
__device__ __forceinline__ void phase_norm(const Frame& F, const float* hin, const float* g, bf16* XN) {
    const int gw = F.vcu * NWAVES + F.wave, NGW = F.G * NWAVES;
    f32x4 gv[4];
#pragma unroll
    for (int j = 0; j < 4; ++j) gv[j] = ((const f32x4*)g)[64 * j + F.lane];
    for (int m = gw; m < M; m += NGW) {
        const f32x4* xr = (const f32x4*)(hin + (size_t)m * DM) + F.lane;
        f32x4 v[4]; float s = 0.f;
#pragma unroll
        for (int j = 0; j < 4; ++j) { v[j] = xr[64 * j]; s += (v[j].x * v[j].x + v[j].y * v[j].y) + (v[j].z * v[j].z + v[j].w * v[j].w); }
        const float r = 1.f / sqrtf(wave_sum(s) * (1.f / DM) + 1e-6f);
        v2u* o8 = (v2u*)(XN + (size_t)m * DM) + F.lane;
#pragma unroll
        for (int j = 0; j < 4; ++j) { v2u w; w.x = pk2(v[j].x * r * gv[j].x, v[j].y * r * gv[j].y); w.y = pk2(v[j].z * r * gv[j].z, v[j].w * r * gv[j].w); o8[64 * j] = w; }
    }
}
__device__ __forceinline__ void phase_final_norm(const Frame& F, float* h, const float* g) {
    const int gw = F.vcu * NWAVES + F.wave, NGW = F.G * NWAVES;
    f32x4 gv[4];
#pragma unroll
    for (int j = 0; j < 4; ++j) gv[j] = ((const f32x4*)g)[64 * j + F.lane];
    for (int m = gw; m < M; m += NGW) {
        f32x4* xr = (f32x4*)(h + (size_t)m * DM) + F.lane;
        f32x4 v[4]; float s = 0.f;
#pragma unroll
        for (int j = 0; j < 4; ++j) { v[j] = xr[64 * j]; s += (v[j].x * v[j].x + v[j].y * v[j].y) + (v[j].z * v[j].z + v[j].w * v[j].w); }
        const float r = 1.f / sqrtf(wave_sum(s) * (1.f / DM) + 1e-6f);
#pragma unroll
        for (int j = 0; j < 4; ++j) xr[64 * j] = v[j] * r * gv[j];
    }
}
__device__ __forceinline__ void phase_gates(const Frame& F, int l) {
    const bf16* cols = (const bf16*)(WSP(F) + WS_COLS); float* GT = (float*)(WSP(F) + WS_GATES);
    LAS bf16* raw = (LAS bf16*)(F.lds);
    LAS bf16* featb = (LAS bf16*)(F.lds + 30720);
    LAS bf16* gwT = (LAS bf16*)(F.lds + 55552);
    LAS float* outp = (LAS float*)(F.lds + 80384);
    const float* gwg = INP(F, 5) + (size_t)l * 768 * 16; const float* gb = INP(F, 6) + l * 16;
    const int tid = F.tid, lane = F.lane, wave = F.wave;
    __syncthreads();
    for (int i = tid; i < 768 * 16; i += 512) gwT[(i & 15) * 776 + (i >> 4)] = (bf16)f2bf(gwg[i]);
    float cw[5]; { const float* cwp = INP(F, 3) + (size_t)l * 5 * 512;
#pragma unroll
        for (int j = 0; j < 5; ++j) cw[j] = cwp[j * 512 + tid]; }
    const float cbv = INP(F, 4)[l * 512 + tid];
    const float gbv = gb[tid & 15];
    for (int tile = F.vcu; tile < M / 16; tile += F.G) {
        const int m0 = tile * 16, t0 = m0 % SEQ;
        __syncthreads();
        for (int ch = tid; ch < 20 * 96; ch += 512) { const int rr = ch / 96, cc = ch % 96; const int t = t0 - 2 + rr;
            v4u v = {0u, 0u, 0u, 0u}; if (t >= 0 && t < SEQ) v = *(const v4u*)(cols + (size_t)(m0 - 2 + rr) * NINP + cc * 8);
            *(LAS v4u*)(raw + rr * 768 + cc * 8) = v; }
        if (tid < 256) outp[tid] = 0.f;
        __syncthreads();
        { float win[5];
#pragma unroll
          for (int j = 0; j < 4; ++j) win[j] = bf2f(raw[j * 768 + tid]);
#pragma unroll 4
          for (int t = 0; t < 16; ++t) { win[4] = bf2f(raw[(t + 4) * 768 + tid]); float s = cbv;
#pragma unroll
              for (int j = 0; j < 5; ++j) s += cw[j] * win[j];
#pragma unroll
              for (int j = 0; j < 4; ++j) win[j] = win[j + 1];
              featb[t * 776 + tid] = (bf16)f2bf(siluf_(s)); }
          const int t = tid >> 5, c8 = tid & 31; *(LAS v4u*)(featb + t * 776 + 512 + c8 * 8) = *(const LAS v4u*)(raw + (t + 2) * 768 + 512 + c8 * 8); }
        __syncthreads();
        { const f32x4 z = {0.f, 0.f, 0.f, 0.f}; const f32x4 acc = mma16<96>(featb + 96 * wave, 776, gwT + 96 * wave, 776, z, lane);
#pragma unroll
          for (int jj = 0; jj < 4; ++jj) __hip_atomic_fetch_add(outp + ((lane >> 4) * 4 + jj) * 16 + (lane & 15), acc[jj], __ATOMIC_RELAXED, __HIP_MEMORY_SCOPE_WORKGROUP); }
        __syncthreads();
        if (tid < 256) { float s = outp[tid] + gbv; if ((tid & 15) >= 8) s = fminf(s, 0.f) - log1pf(__expf(-fabsf(s))); GT[(size_t)(m0 + (tid >> 4)) * 16 + (tid & 15)] = s; }
    }
    __syncthreads();
}
__device__ __forceinline__ f32x4 mma16_a8(const LAS bf16* A8, const LAS bf16* Bt, f32x4 acc, int lane) {
    const int q = lane >> 4;
    const LAS bf16* ap = A8 + (lane & 7) * 72 + q * 8; const LAS bf16* bp = Bt + (lane & 15) * 72 + q * 8;
#pragma unroll
    for (int k0 = 0; k0 < 64; k0 += 32) { const bf16x8 a = *(const LAS bf16x8*)(ap + k0); const bf16x8 b = *(const LAS bf16x8*)(bp + k0); acc = __builtin_amdgcn_mfma_f32_16x16x32_bf16(a, b, acc, 0, 0, 0); }
    return acc;
}
typedef float f32x2 __attribute__((ext_vector_type(2)));
template <bool DIR> __device__ __forceinline__ void rwkv_steps(const LAS float* OPS, const LAS float* VV, LAS float* YB, f32x4& S, int j, int row) {
    float yk0 = 0.f, yk1 = 0.f;
    const LAS float* opb = OPS + 4 * j; const LAS float* vpb = VV + row;
#define RWLD(W_, KK_, KA_, KM_, R_, V_, tl_) do { const LAS float* op_ = opb + (tl_) * 320; W_ = *(const LAS f32x4*)(op_); KK_ = *(const LAS f32x4*)(op_ + 64); KA_ = *(const LAS f32x4*)(op_ + 128); KM_ = *(const LAS f32x4*)(op_ + 192); R_ = *(const LAS f32x4*)(op_ + 256); V_ = vpb[(tl_) * 16]; } while (0)
    f32x4 w4, kk4, ka4, km4, r4, w4b, kk4b, ka4b, km4b, r4b; float vv, vvb;
    RWLD(w4, kk4, ka4, km4, r4, vv, (DIR ? 31 : 0));
    RWLD(w4b, kk4b, ka4b, km4b, r4b, vvb, (DIR ? 30 : 1));
#pragma unroll
    for (int i = 0; i < 32; ++i) {
        f32x4 nw4, nkk4, nka4, nkm4, nr4; float nvv;
        if (i < 30) RWLD(nw4, nkk4, nka4, nkm4, nr4, nvv, (DIR ? 29 - i : i + 2));
        f32x2 t2 = S.xy * kk4.xy; t2 = S.zw * kk4.zw + t2;
        float sa = t2.x + t2.y;
        const f32x4 pre_s = S * w4 + km4 * vv;
        sa = row16_sum(sa);
        S = pre_s + ka4 * sa;
        f32x2 y2 = S.xy * r4.xy; y2 = S.zw * r4.zw + y2;
        float y = y2.x + y2.y;
        y = row16_sum(y);
        if ((i & 15) == j) { if (i < 16) yk0 = y; else yk1 = y; }
        w4 = w4b; kk4 = kk4b; ka4 = ka4b; km4 = km4b; r4 = r4b; vv = vvb;
        if (i < 30) { w4b = nw4; kk4b = nkk4; ka4b = nka4; km4b = nkm4; r4b = nr4; vvb = nvv; } }
#undef RWLD
    YB[(DIR ? 31 - j : j) * 16 + row] = yk0; YB[(DIR ? 15 - j : 16 + j) * 16 + row] = yk1;
}
struct RwCtx { LAS bf16* WA; LAS bf16* WW; LAS bf16* XA; LAS bf16* XW; LAS bf16* RAWB; LAS float* MU; float* CT; const bf16* colsb;
    f32x4 kk_c4, ka_c4, rk_c4; float ba[4], bw[4]; float mup_[5][2], mun_[5][2]; int h, dir, qtr, tb0; size_t mb; };
template <int NTOK> __device__ __forceinline__ void rw_addr_init(int (&poff)[5], int (&prr)[5], int lane, int tb0, int h, int dir) {
    constexpr int NCHK = (NTOK + 2) * 40;
#pragma unroll
    for (int i = 0; i < 5; ++i) { const int idx = lane + 64 * i; const int rr = idx / 40, q = idx % 40, wh = q >> 3, c8 = q & 7;
        const int gc = (wh == 0 ? R_R + h * 64 : wh == 1 ? R_K + h * 64 : wh == 2 ? R_V + h * 64 : wh == 3 ? R_WDF + dir * 64 : R_AD) + c8 * 8;
        prr[i] = idx < NCHK ? tb0 - 1 + rr : -100000; poff[i] = (tb0 - 1 + rr) * NINP + gc; }
}
template <int NTOK> __device__ __forceinline__ void rw_issue(v4u (&pre)[5], const int (&poff)[5], const int (&prr)[5], const bf16* colsb, int T0) {
    constexpr int NCH = ((NTOK + 2) * 40 + 63) / 64;
#pragma unroll
    for (int i = 0; i < NCH; ++i) { pre[i] = (v4u){0u, 0u, 0u, 0u}; const int t = T0 + prr[i]; if (t >= 0 && t < SEQ) pre[i] = *(const v4u*)(colsb + (size_t)T0 * NINP + poff[i]); }
}
template <int NTOK, bool FULLV> __device__ __forceinline__ void rw_prep(const RwCtx& C, const v4u (&pre)[5], LAS float* OPS, LAS float* VV, int T0, int lane) {
    constexpr int NCHK = (NTOK + 2) * 40, NCH = (NCHK + 63) / 64;
    const int j = lane & 15, c2 = (lane & 31) * 2;
#pragma unroll
    for (int i = 0; i < NCH; ++i) { const int idx = lane + 64 * i; if (idx < NCHK) *(LAS v4u*)(C.RAWB + idx * 8) = pre[i]; }
    LDS_WAIT(); asm volatile("" ::: "memory");
#pragma unroll
    for (int which = 0; which < 5; ++which)
#pragma unroll
        for (int pr = 0; pr < NTOK / 2; ++pr) { const int tt = 2 * pr + (lane >> 5), cc = which * 64 + c2, t = C.tb0 + tt;
            const unsigned r0 = *(const LAS unsigned*)(C.RAWB + tt * 320 + cc), r1 = *(const LAS unsigned*)(C.RAWB + (tt + 1) * 320 + cc), r2 = *(const LAS unsigned*)(C.RAWB + (tt + 2) * 320 + cc);
            const float p1x = bf2f(r1 & 0xffffu), p1y = bf2f(r1 >> 16);
            const float vx = p1x + C.mup_[which][0] * (bf2f(r0 & 0xffffu) - p1x) + C.mun_[which][0] * (bf2f(r2 & 0xffffu) - p1x);
            const float vy = p1y + C.mup_[which][1] * (bf2f(r0 >> 16) - p1y) + C.mun_[which][1] * (bf2f(r2 >> 16) - p1y);
            if (which == 0) *(LAS f32x2*)(OPS + t * 320 + 256 + c2) = (f32x2){vx, vy};
            else if (which == 1) *(LAS f32x2*)(OPS + t * 320 + 192 + c2) = (f32x2){vx, vy};
            else if (which == 2) { if (FULLV) *(LAS f32x2*)(VV + t * 64 + c2) = (f32x2){vx, vy}; else if ((c2 >> 4) == C.qtr) *(LAS f32x2*)(VV + t * 16 + (c2 & 15)) = (f32x2){vx, vy}; }
            else if (which == 3) { const float ex = __expf(2.f * vx), ey = __expf(2.f * vy);
                *(LAS unsigned*)(C.XW + tt * 72 + c2) = pk2(1.f - 2.f * __builtin_amdgcn_rcpf(ex + 1.f), 1.f - 2.f * __builtin_amdgcn_rcpf(ey + 1.f)); }
            else *(LAS unsigned*)(C.XA + tt * 72 + c2) = pk2(vx, vy); }
    LDS_WAIT(); asm volatile("" ::: "memory");
    { const bool hi = lane >= 32; const int lr = ((lane >> 4) & 1) * 4 + (hi ? 2 : 0); const bool ok0 = lr < NTOK, ok1 = lr + 1 < NTOK; const int tb = C.tb0 + lr;
#pragma unroll
      for (int ct = 0; ct < 4; ++ct) { const f32x4 z = {0.f, 0.f, 0.f, 0.f};
        const f32x4 ca = mma16_a8(C.XA, C.WA + ct * 16 * 72, z, lane), cw = mma16_a8(C.XW, C.WW + ct * 16 * 72, z, lane);
        const int c = ct * 16 + j;
        const float a0v = hi ? ca[2] : ca[0], a1v = hi ? ca[3] : ca[1], w0v = hi ? cw[2] : cw[0], w1v = hi ? cw[3] : cw[1];
        if (ok0) { OPS[tb * 320 + 128 + c] = sigmoidf_(C.ba[ct] + a0v); OPS[tb * 320 + c] = __expf(-0.6065306597f * sigmoidf_(C.bw[ct] + w0v)); }
        if (ok1) { OPS[(tb + 1) * 320 + 128 + c] = sigmoidf_(C.ba[ct] + a1v); OPS[(tb + 1) * 320 + c] = __expf(-0.6065306597f * sigmoidf_(C.bw[ct] + w1v)); } } }
    LDS_WAIT(); asm volatile("" ::: "memory");
#pragma unroll
    for (int ps = 0; ps < (NTOK + 3) / 4; ++ps) { const int tl = 4 * ps + (lane >> 4); const bool ok = tl < NTOK; const int t = C.tb0 + (ok ? tl : 0); LAS float* op = OPS + t * 320 + 4 * j;
        const f32x4 av = *(const LAS f32x4*)(op + 128), kp = *(const LAS f32x4*)(op + 192), rp = *(const LAS f32x4*)(op + 256);
        const f32x4 kr = kp * C.kk_c4; const float ss = row16_sum((kr.x * kr.x + kr.y * kr.y) + (kr.z * kr.z + kr.w * kr.w));
        const f32x4 kkv = kr * (1.f / fmaxf(sqrtf(ss), 1e-12f));
        const f32x4 km = kp * ((av - 1.f) * C.ka_c4 + 1.f);
        const f32x4 q = rp * km * C.rk_c4; const float cs = row16_sum((q.x + q.y) + (q.z + q.w));
        if (ok) { *(LAS f32x4*)(op + 64) = kkv; *(LAS f32x4*)(op + 128) = kkv * (-av); *(LAS f32x4*)(op + 192) = km;
            if (C.dir == 0 && C.qtr == 0 && j == 0) C.CT[(C.mb + T0 + t) * 8 + C.h] = cs; } }
}

constexpr int RW_NSLOT = 6, RW_SLOT_WORDS = 32 * 320 + 32 * 64;
constexpr size_t WS_RING = 248 * MiB;
constexpr int CW_RW = 8192;
__device__ __forceinline__ unsigned rw_ld(unsigned* p) { return __hip_atomic_load(p, __ATOMIC_RELAXED, __HIP_MEMORY_SCOPE_AGENT); }
__device__ __forceinline__ void rw_st(unsigned* p, unsigned v) { __hip_atomic_store(p, v, __ATOMIC_RELAXED, __HIP_MEMORY_SCOPE_AGENT); }
__device__ __forceinline__ void rwkv_produce(const Frame& F, int l, int p, int pp, unsigned G0) {
    const int b = p / 12, rem = p % 12, h = rem >> 1, dir = rem & 1;
    const bf16* cols = (const bf16*)(WSP(F) + WS_COLS);
    const int tid = F.tid, lane = F.lane, wave = F.wave;
    LAS bf16* WA = (LAS bf16*)(F.lds); LAS bf16* WW = (LAS bf16*)(F.lds + 9216);
    LAS float* MU = (LAS float*)(F.lds + 67584);
    LAS float* OPS = (LAS float*)(F.lds + 70144);
    LAS float* VV = (LAS float*)(F.lds + 111104);
    LAS unsigned* flg = (LAS unsigned*)(F.lds + 119296);
    unsigned* ctl = (unsigned*)(WSP(F) + WS_CTL) + CW_RW + 384 * p;
    unsigned long long* ring = (unsigned long long*)(WSP(F) + WS_RING) + (size_t)p * RW_NSLOT * (RW_SLOT_WORDS / 2);
    constexpr int NB = SEQ / 32;
    __syncthreads();
    { const float* aup = INP(F, 13) + (size_t)l * 64 * 384; const float* wup = INP(F, 11) + (size_t)(l * 2 + dir) * 64 * 384;
      for (int idx = tid; idx < 4096; idx += 512) { const int i = idx >> 6, c = idx & 63;
          WA[c * 72 + i] = (bf16)f2bf(aup[i * 384 + h * 64 + c]); WW[c * 72 + i] = (bf16)f2bf(wup[i * 384 + h * 64 + c]); }
      if (tid < 320) { const int which = tid >> 6, c = tid & 63;
          const int rc = which == 0 ? h * 64 + c : which == 1 ? 384 + h * 64 + c : which == 2 ? 768 + h * 64 + c : which == 3 ? 1152 + dir * 64 + c : 1280 + c;
          MU[tid] = INP(F, 8)[l * 1472 + rc]; MU[320 + tid] = INP(F, 9)[l * 1472 + rc]; } }
    __syncthreads();
    const size_t mb = (size_t)b * SEQ;
    const int j = lane & 15;
    RwCtx C;
    C.WA = WA; C.WW = WW; C.XA = (LAS bf16*)(F.lds + 18432) + wave * 576; C.XW = (LAS bf16*)(F.lds + 27648) + wave * 576;
    C.RAWB = (LAS bf16*)(F.lds + 36864) + wave * 1920;
    C.MU = MU; C.CT = (float*)(WSP(F) + WS_CT); C.colsb = cols + mb * NINP; C.h = h; C.dir = dir; C.qtr = 0; C.mb = mb; C.tb0 = 4 * wave;
    { const int hc4 = h * 64 + 4 * j;
      C.kk_c4 = *(const f32x4*)(INP(F, 15) + l * 384 + hc4); C.ka_c4 = *(const f32x4*)(INP(F, 16) + l * 384 + hc4); C.rk_c4 = *(const f32x4*)(INP(F, 17) + l * 384 + hc4);
#pragma unroll
      for (int ct = 0; ct < 4; ++ct) { C.ba[ct] = INP(F, 12)[l * 384 + h * 64 + 16 * ct + j]; C.bw[ct] = INP(F, 10)[(l * 2 + dir) * 384 + h * 64 + 16 * ct + j]; }
      const int c2 = (lane & 31) * 2;
#pragma unroll
      for (int wq = 0; wq < 5; ++wq) { C.mup_[wq][0] = MU[wq * 64 + c2]; C.mup_[wq][1] = MU[wq * 64 + c2 + 1]; C.mun_[wq][0] = MU[320 + wq * 64 + c2]; C.mun_[wq][1] = MU[320 + wq * 64 + c2 + 1]; } }
    v4u pre[5]; int poff[5], prr[5];
    rw_addr_init<4>(poff, prr, lane, C.tb0, h, dir);
    rw_issue<4>(pre, poff, prr, C.colsb, dir ? SEQ - 32 * (pp + 1) : 32 * pp);
    bool dead = false; unsigned mseen = G0;
    unsigned* myflag = ctl + 320 * pp; const unsigned PB = G0 / 2;
#pragma unroll 1
    for (int it = pp; it < NB; it += 2) {
        const int T0 = dir ? SEQ - 32 * (it + 1) : 32 * it;
        v4u cur[5];
#pragma unroll
        for (int i = 0; i < 5; ++i) cur[i] = pre[i];
        if (it + 2 < NB) rw_issue<4>(pre, poff, prr, C.colsb, dir ? SEQ - 32 * (it + 3) : 32 * (it + 2));
        rw_prep<4, true>(C, cur, OPS, VV, T0, lane);
        if (tid == 0) { const unsigned need = G0 + (unsigned)it + 1u; unsigned sp = 0u;
            if (need > (unsigned)RW_NSLOT && !dead) { const unsigned want = need - (unsigned)RW_NSLOT;
                while (mseen < want) { if (++sp > (1u << 17)) { dead = true; break; } __builtin_amdgcn_s_sleep(2);
                    const unsigned m01 = min(rw_ld(ctl + 64), rw_ld(ctl + 128)), m23 = min(rw_ld(ctl + 192), rw_ld(ctl + 256)); mseen = min(m01, m23); } }
            flg[0] = sp; }
        __syncthreads();
        { unsigned long long* slot = ring + (size_t)((G0 + (unsigned)it) % RW_NSLOT) * (RW_SLOT_WORDS / 2);
          const LAS v4u* src = (const LAS v4u*)OPS;
#pragma unroll
          for (int i = 0; i < 6; ++i) { const int idx = tid + 512 * i; const v4u d = src[idx]; v4u* dst = (v4u*)slot + idx;
              asm volatile("global_store_dwordx4 %0, %1, off sc1\n\ts_nop 1" :: "v"(dst), "v"(d) : "memory"); } }
        asm volatile("s_waitcnt vmcnt(6)" ::: "memory");
        __syncthreads();
        if (tid == 0 && it >= 2) rw_st(myflag, PB + (unsigned)(it >> 1));
    }
    asm volatile("s_waitcnt vmcnt(0)" ::: "memory");
    __syncthreads();
    if (tid == 0) rw_st(myflag, PB + (unsigned)(NB / 2));
    __syncthreads();
}
__device__ __forceinline__ void rwkv_scan(const Frame& F, int l, int p, int qtr, unsigned G0) {
    const int b = p / 12, rem = p % 12, h = rem >> 1, dir = rem & 1;
    bf16* Y = (bf16*)(WSP(F) + (dir ? Y_RB : Y_RF));
    const int lane = F.lane, wave = F.wave;
    LAS float* OPSb = (LAS float*)(F.lds);
    LAS float* VVb = (LAS float*)(F.lds + 81920);
    LAS float* YBb = (LAS float*)(F.lds + 86016);
    unsigned* ctl = (unsigned*)(WSP(F) + WS_CTL) + CW_RW + 384 * p;
    const unsigned long long* ring = (const unsigned long long*)(WSP(F) + WS_RING) + (size_t)p * RW_NSLOT * (RW_SLOT_WORDS / 2);
    constexpr int NB = SEQ / 32;
    const size_t mb = (size_t)b * SEQ;
    const int j = lane & 15;
    __syncthreads();
    if (wave < 4) {
        const int lt = wave * 64 + lane;
        bool dead = false; unsigned pseen0 = G0 / 2, pseen1 = G0 / 2;
        unsigned long long va[21], vb[21];
#define RW_FETCH(v_, k_) do { const unsigned need_ = G0 / 2 + (unsigned)((k_) >> 1) + 1u; unsigned sp_ = 0u; unsigned* fl_ = ctl + 320 * ((k_) & 1); \
            if (!dead) { unsigned ps_ = ((k_) & 1) ? pseen1 : pseen0; while (ps_ < need_) { ps_ = rw_ld(fl_); if (ps_ >= need_) break; if (++sp_ > (1u << 17)) { dead = true; break; } __builtin_amdgcn_s_sleep(2); } if ((k_) & 1) pseen1 = ps_; else pseen0 = ps_; } \
            const unsigned long long* slot_ = ring + (size_t)((G0 + (unsigned)(k_)) % RW_NSLOT) * (RW_SLOT_WORDS / 2); \
            _Pragma("unroll") for (int i_ = 0; i_ < 20; ++i_) v_[i_] = __hip_atomic_load(slot_ + lt + 256 * i_, __ATOMIC_RELAXED, __HIP_MEMORY_SCOPE_AGENT); \
            v_[20] = __hip_atomic_load(slot_ + 5120 + (lt >> 3) * 32 + qtr * 8 + (lt & 7), __ATOMIC_RELAXED, __HIP_MEMORY_SCOPE_AGENT); } while (0)
#define RW_LITER(v_, k_) do { if ((k_) >= 1 && lt == 0) rw_st(ctl + 64 * (qtr + 1), G0 + (unsigned)(k_)); \
            if ((k_) < NB) { LAS unsigned long long* dO_ = (LAS unsigned long long*)(OPSb + ((k_) & 1) * 10240); LAS unsigned long long* dV_ = (LAS unsigned long long*)(VVb + ((k_) & 1) * 512); \
                _Pragma("unroll") for (int i_ = 0; i_ < 20; ++i_) dO_[lt + 256 * i_] = v_[i_]; dV_[lt] = v_[20]; \
                if ((k_) + 2 < NB) RW_FETCH(v_, (k_) + 2); } \
            if ((k_) >= 2) { const int bk_ = (k_) - 2; const int T0_ = dir ? SEQ - 32 * (bk_ + 1) : 32 * bk_; const LAS float* YB_ = YBb + (bk_ & 1) * 512; \
                const int idx_ = lt * 2, tl_ = idx_ >> 4, rw_ = idx_ & 15; \
                *(unsigned*)(Y + (mb + T0_ + tl_) * 384 + h * 64 + 16 * qtr + rw_) = pk2(YB_[idx_], YB_[idx_ + 1]); } \
            __syncthreads(); } while (0)
        RW_FETCH(va, 0); RW_FETCH(vb, 1);
#pragma unroll 1
        for (int it = 0; it < NB; it += 2) { RW_LITER(va, it); RW_LITER(vb, it + 1); }
        RW_LITER(va, NB);
#undef RW_FETCH
#undef RW_LITER
        { const int bk = NB - 1; const int T0 = dir ? SEQ - 32 * (bk + 1) : 32 * bk; const LAS float* YB = YBb + (bk & 1) * 512;
          const int idx = lt * 2, tl = idx >> 4, rw = idx & 15;
          *(unsigned*)(Y + (mb + T0 + tl) * 384 + h * 64 + 16 * qtr + rw) = pk2(YB[idx], YB[idx + 1]); }
    } else {
        const int row = (wave - 4) * 4 + (lane >> 4);
        f32x4 S = {0.f, 0.f, 0.f, 0.f};
#pragma unroll 1
        for (int it = 0; it <= NB; ++it) {
            if (it >= 1) { const int bk = it - 1;
                const LAS float* OPS = OPSb + (bk & 1) * 10240; const LAS float* VV = VVb + (bk & 1) * 512; LAS float* YB = YBb + (bk & 1) * 512;
                if (dir) rwkv_steps<true>(OPS, VV, YB, S, j, row); else rwkv_steps<false>(OPS, VV, YB, S, j, row);
            }
            __syncthreads();
        }
    }
    __syncthreads();
}
__device__ __forceinline__ float row8_sum(float v) { v += dppf<0xB1>(v); v += dppf<0x4E>(v); v += dppf<0x141>(v); return v; }
__device__ __forceinline__ void mlstm_seq(const Frame& F, int l, int task, int cfull0, int cend) {
    const int b = task >> 3, h = (task >> 1) & 3, dir = task & 1;
    const bf16* cols = (const bf16*)(WSP(F) + WS_COLS); const float* GT = (const float*)(WSP(F) + WS_GATES);
    bf16* Y = (bf16*)(WSP(F) + (dir ? Y_AB : Y_AF));
    LAS bf16* RAWQ = (LAS bf16*)(F.lds);
    LAS bf16* Qs = (LAS bf16*)(F.lds + 17408); LAS bf16* Ks = (LAS bf16*)(F.lds + 26624);
    LAS bf16* Vtb = (LAS bf16*)(F.lds + 35840);
    LAS bf16* KWt = (LAS bf16*)(F.lds + 54272); LAS bf16* Ps = (LAS bf16*)(F.lds + 63488);
    LAS bf16* Ctb = (LAS bf16*)(F.lds + 72704);
    LAS float* ub = (LAS float*)(F.lds + 91136);
    LAS float* blb = ub + 128; LAS float* rmb = ub + 256;
    LAS float* den = ub + 384; LAS float* qn = ub + 448; LAS float* nst = ub + 512; LAS float* scb = ub + 576;
    const int tid = F.tid, lane = F.lane, wave = F.wave;
    const size_t mb = (size_t)b * SEQ;
    constexpr int NC = SEQ / 64;
    __syncthreads();
    for (int i = tid; i < 2 * 64 * 72; i += 512) Ctb[i] = 0;
    if (tid < 64) nst[tid] = 0.f;
    const int cc = tid & 127, isK = cc >> 6, d0 = cc & 63, chn = isK * 256 + h * 64 + d0;
    float cw[5]; const float* cwp = INP(F, 3) + (size_t)l * 5 * 512;
#pragma unroll
    for (int jj = 0; jj < 5; ++jj) cw[jj] = cwp[jj * 512 + chn];
    const float cbv = INP(F, 4)[l * 512 + chn];
    f32x4 st[2] = {{0.f, 0.f, 0.f, 0.f}, {0.f, 0.f, 0.f, 0.f}};
    float m_st = 0.f;
    v4u pre[3], prev; float gli = 0.f, glf = 0.f;
#define ML_ISSUE(c_) do { const int tlo_ = dir ? SEQ - 64 * ((c_) + 1) : 64 * (c_); _Pragma("unroll") for (int i_ = 0; i_ < 3; ++i_) { const int ch_ = tid + 512 * i_; pre[i_] = (v4u){0u, 0u, 0u, 0u}; \
        if (ch_ < 68 * 16) { const int rr_ = ch_ >> 4, q_ = ch_ & 15; const int t_ = tlo_ - 2 + rr_; if (t_ >= 0 && t_ < SEQ) pre[i_] = *(const v4u*)(cols + (mb + t_) * NINP + (q_ >> 3) * 256 + h * 64 + (q_ & 7) * 8); } } \
        prev = *(const v4u*)(cols + (mb + tlo_ + (tid >> 3)) * NINP + A_V + h * 64 + (tid & 7) * 8); \
        if (tid < 64) { const int t_ = dir ? tlo_ + 63 - tid : tlo_ + tid; gli = GT[(mb + t_) * 16 + dir * 4 + h]; glf = GT[(mb + t_) * 16 + 8 + dir * 4 + h]; } } while (0)
#define ML_FILL(c_) do { _Pragma("unroll") for (int i_ = 0; i_ < 3; ++i_) { const int ch_ = tid + 512 * i_; if (ch_ < 68 * 16) *(LAS v4u*)(RAWQ + (ch_ >> 4) * 128 + (ch_ & 15) * 8) = pre[i_]; } \
        { LAS bf16* Vt_ = Vtb + ((c_) & 1) * 4608; const int tl_ = tid >> 3, e8_ = tid & 7; const int lp_ = dir ? 63 - tl_ : tl_; const unsigned w_[4] = {prev.x, prev.y, prev.z, prev.w}; \
          _Pragma("unroll") for (int k_ = 0; k_ < 4; ++k_) { const int e_ = e8_ * 8 + 2 * k_; Vt_[e_ * 72 + swz64(e_, lp_)] = (bf16)(w_[k_] & 0xffffu); Vt_[(e_ + 1) * 72 + swz64(e_ + 1, lp_)] = (bf16)(w_[k_] >> 16); } } \
        if (tid < 64) { const float bl_ = wave_scan_add(glf); \
            const float u_ = gli - bl_; const float rm_ = wave_scan_max(u_); \
            ub[((c_) & 1) * 64 + tid] = u_; blb[((c_) & 1) * 64 + tid] = bl_; rmb[((c_) & 1) * 64 + tid] = rm_; if (tid == 63) { scb[((c_) & 1) * 2] = rm_; scb[((c_) & 1) * 2 + 1] = bl_; } } } while (0)
    ML_ISSUE(0); ML_FILL(0); ML_ISSUE(1);
    __syncthreads();
    if (cfull0 > 0) {
        const int dk = tid & 63; float cwk[5]; { const float* cwq = INP(F, 3) + (size_t)l * 5 * 512;
#pragma unroll
            for (int jj = 0; jj < 5; ++jj) cwk[jj] = cwq[jj * 512 + 256 + h * 64 + dk]; }
        const float cbk = INP(F, 4)[l * 512 + 256 + h * 64 + dk];
#pragma unroll 1
        for (int c = 0; c < cfull0; ++c) {
            const LAS float* u = ub + (c & 1) * 64;
            const LAS bf16* Vt = Vtb + (c & 1) * 4608; LAS bf16* Ctn = Ctb + ((c + 1) & 1) * 4608;
            const float umax = scb[(c & 1) * 2], tot = scb[(c & 1) * 2 + 1];
#pragma unroll 2
            for (int i = 0; i < 8; ++i) { const int tl = (tid >> 6) + 8 * i; float s = cbk;
#pragma unroll
                for (int jj = 0; jj < 5; ++jj) s += cwk[jj] * bf2f(RAWQ[(tl + jj) * 128 + 64 + dk]);
                const int lp = dir ? 63 - tl : tl;
                KWt[dk * 72 + swz64(dk, lp)] = (bf16)f2bf(siluf_(s) * 0.125f * __expf(u[lp] - umax)); }
            __syncthreads();
            const float mmax = fmaxf(m_st, umax), s_old = __expf(m_st - mmax), s_new = __expf(umax - mmax);
#pragma unroll
            for (int k = 0; k < 2; ++k) { const int ti = 2 * wave + k, t0_ = ti >> 2, t1_ = ti & 3; const f32x4 z = {0.f, 0.f, 0.f, 0.f};
                const f32x4 lc = mma16s<true, true>(Vt, 72, t0_ * 16, KWt, 72, t1_ * 16, z, lane);
#pragma unroll
                for (int jj = 0; jj < 4; ++jj) { const int r_ = t0_ * 16 + (lane >> 4) * 4 + jj, c_ = t1_ * 16 + (lane & 15);
                    st[k][jj] = s_old * st[k][jj] + s_new * lc[jj]; Ctn[r_ * 72 + c_] = (bf16)f2bf(st[k][jj]); } }
            { const int dq = tid >> 3, part = tid & 7; float s = 0.f;
#pragma unroll
              for (int k = 0; k < 8; ++k) s += bf2f(KWt[dq * 72 + swz64(dq, part * 8) + k]);
              s = row8_sum(s); if (part == 0) nst[dq] = s_old * nst[dq] + s_new * s; }
            m_st = tot + mmax;
            ML_FILL(c + 1); if (c + 2 < cend) ML_ISSUE(c + 2);
            __syncthreads();
        }
    }
#pragma unroll 1
    for (int c = cfull0; c < cend; ++c) {
        const bool full = c >= cfull0;
        const int tlo = dir ? SEQ - 64 * (c + 1) : 64 * c;
        const LAS float* u = ub + (c & 1) * 64; const LAS float* bl = blb + (c & 1) * 64; const LAS float* rm = rmb + (c & 1) * 64;
        const LAS bf16* Vt = Vtb + (c & 1) * 4608; const LAS bf16* Ct = Ctb + (c & 1) * 4608; LAS bf16* Ctn = Ctb + ((c + 1) & 1) * 4608;
#pragma unroll 4
        for (int i = 0; i < 16; ++i) { const int tl = (tid >> 7) + 4 * i; float s = cbv;
#pragma unroll
            for (int jj = 0; jj < 5; ++jj) s += cw[jj] * bf2f(RAWQ[(tl + jj) * 128 + cc]);
            s = siluf_(s); const int lpos = dir ? 63 - tl : tl;
            if (isK) Ks[lpos * 72 + d0] = (bf16)f2bf(s * 0.125f); else Qs[lpos * 72 + d0] = (bf16)f2bf(s); }
        if (tid < 64) den[tid] = 0.f;
        __syncthreads();
        const float umax = scb[(c & 1) * 2], tot = scb[(c & 1) * 2 + 1];
        for (int idx = tid; idx < 4096; idx += 512) { const int lp = idx >> 6, d = idx & 63; KWt[d * 72 + swz64(d, lp)] = (bf16)f2bf(bf2f(Ks[lp * 72 + d]) * __expf(u[lp] - umax)); }
        if (full) {
#pragma unroll
        for (int k = 0; k < 2; ++k) { const int ti = 2 * wave + k, tl_ = ti >> 2, ts = ti & 3; f32x4 acc = {0.f, 0.f, 0.f, 0.f};
            if (ts <= tl_) acc = mma16<64>(Qs + tl_ * 16 * 72, 72, Ks + ts * 16 * 72, 72, acc, lane);
#pragma unroll
            for (int jj = 0; jj < 4; ++jj) { const int lr = tl_ * 16 + (lane >> 4) * 4 + jj, s = ts * 16 + (lane & 15);
                const float v = (s <= lr) ? acc[jj] * __expf(u[s] - fmaxf(m_st, rm[lr])) : 0.f; const unsigned vb = f2bf(v); Ps[lr * 72 + s] = (bf16)vb;
                if (ts <= tl_) { const float rs = row16_sum(bf2f(vb)); if ((lane & 15) == 0) __hip_atomic_fetch_add(den + lr, rs, __ATOMIC_RELAXED, __HIP_MEMORY_SCOPE_WORKGROUP); } } }
        { const int lq = tid >> 3, part = tid & 7; float s = 0.f;
#pragma unroll
          for (int k = 0; k < 8; ++k) s += bf2f(Qs[lq * 72 + part * 8 + k]) * nst[part * 8 + k];
          s = row8_sum(s); if (part == 0) qn[lq] = s; }
        }
        __syncthreads();
        const float mmax = fmaxf(m_st, umax), s_old = __expf(m_st - mmax), s_new = __expf(umax - mmax);
#pragma unroll
        for (int k = 0; k < 2; ++k) { const int ti = 2 * wave + k, t0_ = ti >> 2, t1_ = ti & 3; const f32x4 z = {0.f, 0.f, 0.f, 0.f};
            f32x4 a1 = z, a2 = z;
            if (full) { a1 = mma16s<false, true>(Ps, 72, t0_ * 16, Vt, 72, t1_ * 16, z, lane); a2 = mma16<64>(Qs + t0_ * 16 * 72, 72, Ct + t1_ * 16 * 72, 72, z, lane); }
            const f32x4 lc = mma16s<true, true>(Vt, 72, t0_ * 16, KWt, 72, t1_ * 16, z, lane);
#pragma unroll
            for (int jj = 0; jj < 4; ++jj) { const int r_ = t0_ * 16 + (lane >> 4) * 4 + jj, c_ = t1_ * 16 + (lane & 15);
                if (full) { const float mx = fmaxf(m_st, rm[r_]), iwv = __expf(m_st - mx);
                const float dn = den[r_] + iwv * qn[r_];
                const float val = (a1[jj] + iwv * a2[jj]) / fmaxf(fabsf(dn), __expf(-(bl[r_] + mx)));
                const int t = dir ? tlo + 63 - r_ : tlo + r_;
                Y[(mb + t) * 256 + h * 64 + c_] = (bf16)f2bf(val); }
                st[k][jj] = s_old * st[k][jj] + s_new * lc[jj];
                Ctn[r_ * 72 + c_] = (bf16)f2bf(st[k][jj]); } }
        { const int dq = tid >> 3, part = tid & 7; float s = 0.f;
#pragma unroll
          for (int k = 0; k < 8; ++k) s += bf2f(KWt[dq * 72 + swz64(dq, part * 8) + k]);
          s = row8_sum(s); if (part == 0) nst[dq] = s_old * nst[dq] + s_new * s; }
        m_st = tot + mmax;
        if (c + 1 < cend) { ML_FILL(c + 1); if (c + 2 < cend) ML_ISSUE(c + 2); }
        __syncthreads();
    }
#undef ML_ISSUE
#undef ML_FILL
}
__device__ __forceinline__ void phase_ssd_conv(const Frame& F, int l) {
    const bf16* cols = (const bf16*)(WSP(F) + WS_COLS); bf16* XBC = (bf16*)(WSP(F) + WS_XN);
    LAS bf16* raw = (LAS bf16*)(F.lds);
    const float* cwp = INP(F, 20) + (size_t)l * 5 * 896; const float* cbp = INP(F, 21) + l * 896;
    const int tid = F.tid;
    float cw0[5], cw1[5]; const int c1 = tid + 512 < 896 ? tid + 512 : tid;
#pragma unroll
    for (int jj = 0; jj < 5; ++jj) { cw0[jj] = cwp[jj * 896 + tid]; cw1[jj] = cwp[jj * 896 + c1]; }
    const float cb0 = cbp[tid], cb1 = cbp[c1];
    float* DTV = (float*)(WSP(F) + WS_DTV); const float* dtbp = INP(F, 22) + l * 12;
    for (int tile = F.vcu; tile < M / 32; tile += F.G) {
        const int m0 = tile * 32, t0 = m0 % SEQ;
        __syncthreads();
        if (tid < 384) { const int tt = tid / 12, k = tid % 12; const float x = bf2f(cols[(size_t)(m0 + tt) * NINP + S_DT + k]) + dtbp[k]; DTV[(size_t)(m0 + tt) * 12 + k] = x > 20.f ? x : log1pf(__expf(x)); }
        for (int ch = tid; ch < 36 * 112; ch += 512) { const int rr = ch / 112, cc = ch % 112; const int t = t0 - 2 + rr;
            v4u v = {0u, 0u, 0u, 0u}; if (t >= 0 && t < SEQ) v = *(const v4u*)(cols + (size_t)(m0 - 2 + rr) * NINP + S_X + cc * 8);
            *(LAS v4u*)(raw + rr * 896 + cc * 8) = v; }
        __syncthreads();
#pragma unroll
        for (int half = 0; half < 2; ++half) { const int c = half ? c1 : tid; if (half && tid + 512 >= 896) break;
            float win[5];
#pragma unroll
            for (int jj = 0; jj < 4; ++jj) win[jj] = bf2f(raw[jj * 896 + c]);
            for (int tl = 0; tl < 32; ++tl) { win[4] = bf2f(raw[(tl + 4) * 896 + c]);
                float s = half ? cb1 : cb0;
#pragma unroll
                for (int jj = 0; jj < 5; ++jj) s += (half ? cw1[jj] : cw0[jj]) * win[jj];
#pragma unroll
                for (int jj = 0; jj < 4; ++jj) win[jj] = win[jj + 1];
                XBC[(size_t)(m0 + tl) * 896 + c] = (bf16)f2bf(siluf_(s)); } }
    }
    __syncthreads();
}
__device__ __forceinline__ void ssd_seq(const Frame& F, int l, int task, int cfull0, int cend) {
    const int b = task / 12, rem = task % 12, head = rem >> 1, dir = rem & 1, g = head / 3;
    const bf16* cols = (const bf16*)(WSP(F) + WS_COLS); const bf16* XBC = (const bf16*)(WSP(F) + WS_XN);
    bf16* Y = (bf16*)(WSP(F) + (dir ? Y_SB : Y_SF));
    LAS bf16* Cm = (LAS bf16*)(F.lds); LAS bf16* Bm = (LAS bf16*)(F.lds + 17408);
    LAS bf16* Btw = (LAS bf16*)(F.lds + 34816); LAS bf16* Xt = (LAS bf16*)(F.lds + 53248);
    LAS bf16* Ps = (LAS bf16*)(F.lds + 62464); LAS bf16* Hs = (LAS bf16*)(F.lds + 71680);
    LAS float* dtvb = (LAS float*)(F.lds + 89088);
    LAS float* acsb = dtvb + 128;
    LAS float* totb = dtvb + 256;
    const int tid = F.tid, lane = F.lane, wave = F.wave;
    const size_t mb = (size_t)b * SEQ;
    constexpr int NC = SEQ / 64;
    __syncthreads();
    for (int i = tid; i < 64 * 136; i += 512) Hs[i] = 0;
    const float* DTV = (const float*)(WSP(F) + WS_DTV);
    const float aneg = -__expf(INP(F, 23)[(l * 2 + dir) * 6 + head]);
    f32x4 st[4];
#pragma unroll
    for (int k = 0; k < 4; ++k) st[k] = (f32x4){0.f, 0.f, 0.f, 0.f};
    v4u pre[5]; float dtraw = 0.f;
#define SSD_ISSUE(c_) do { const int tlo_ = dir ? SEQ - 64 * ((c_) + 1) : 64 * (c_); _Pragma("unroll") for (int i_ = 0; i_ < 5; ++i_) { const int idx_ = tid + 512 * i_; const int tl_ = idx_ / 40, q_ = idx_ % 40; \
        const int gc_ = q_ < 8 ? head * 64 + q_ * 8 : (q_ < 24 ? 384 + g * 128 + (q_ - 8) * 8 : 640 + g * 128 + (q_ - 24) * 8); \
        pre[i_] = *(const v4u*)(XBC + (mb + tlo_ + tl_) * 896 + gc_); } } while (0)
#define SSD_DTLOAD(c_) do { if (tid < 64) { const int tlo_ = dir ? SEQ - 64 * ((c_) + 1) : 64 * (c_); const int t_ = dir ? tlo_ + 63 - tid : tlo_ + tid; dtraw = DTV[(mb + t_) * 12 + dir * 6 + head]; } } while (0)
#define SSD_DTCALC(c_) do { if (tid < 64) { const float dt_ = dtraw; float cs_ = dt_ * aneg; \
        cs_ = wave_scan_add(cs_); \
        const float tt_ = __builtin_bit_cast(float, __builtin_amdgcn_readlane(__builtin_bit_cast(int, cs_), 63)); dtvb[((c_) & 1) * 64 + tid] = dt_; acsb[((c_) & 1) * 64 + tid] = cs_; if (tid == 0) totb[(c_) & 1] = tt_; } } while (0)
    int lgo[3], llp[3], lq[3]; v4u prel[3];
#pragma unroll
    for (int i = 0; i < 3; ++i) { const int idx = tid + 512 * i; const int tl = idx / 24, q = idx % 24; lq[i] = q; llp[i] = dir ? 63 - tl : tl;
        lgo[i] = tl * 896 + (q < 8 ? head * 64 + q * 8 : 384 + g * 128 + (q - 8) * 8); }
#define SSD_ISSUE_L(dst_, c_) do { const int tlo_ = dir ? SEQ - 64 * ((c_) + 1) : 64 * (c_); const bf16* b_ = XBC + (mb + tlo_) * 896; _Pragma("unroll") for (int i_ = 0; i_ < 3; ++i_) dst_[i_] = *(const v4u*)(b_ + lgo[i_]); } while (0)
    v4u preN[3];
    if (cfull0 > 0) { SSD_ISSUE_L(prel, 0); if (cfull0 > 1) SSD_ISSUE_L(preN, 1); } else SSD_ISSUE(0);
    SSD_DTLOAD(0); SSD_DTCALC(0); SSD_DTLOAD(1);
    __syncthreads();
    if (cfull0 > 0) {
#pragma unroll 1
        for (int c = 0; c < cfull0; ++c) {
            LAS bf16* Xl = (c & 1) ? (LAS bf16*)(F.lds + 92160) : Xt; LAS bf16* Bl = (c & 1) ? (LAS bf16*)(F.lds + 101376) : Btw;
            const LAS float* dtv = dtvb + (c & 1) * 64; const LAS float* acs = acsb + (c & 1) * 64; const float tot = totb[c & 1];
#pragma unroll
            for (int i = 0; i < 3; ++i) { const int q = lq[i], lp = llp[i];
                const unsigned w[4] = {prel[i].x, prel[i].y, prel[i].z, prel[i].w};
                if (q < 8) {
#pragma unroll
                    for (int k = 0; k < 4; ++k) { const int p0 = q * 8 + 2 * k; Xl[p0 * 72 + swz64(p0, lp)] = (bf16)(w[k] & 0xffffu); Xl[(p0 + 1) * 72 + swz64(p0 + 1, lp)] = (bf16)(w[k] >> 16); } }
                else { const int n0 = (q - 8) * 8; const float sc = dtv[lp] * __expf(tot - acs[lp]);
#pragma unroll
                    for (int k = 0; k < 4; ++k) { const int nn = n0 + 2 * k; Bl[nn * 72 + swz64(nn, lp)] = (bf16)f2bf(bf2f(w[k] & 0xffffu) * sc); Bl[(nn + 1) * 72 + swz64(nn + 1, lp)] = (bf16)f2bf(bf2f(w[k] >> 16) * sc); } } }
            if (c + 1 < cfull0) {
#pragma unroll
                for (int i = 0; i < 3; ++i) prel[i] = preN[i];
                if (c + 2 < cfull0) SSD_ISSUE_L(preN, c + 2); }
            else SSD_ISSUE(c + 1);
            SSD_DTCALC(c + 1); if (c + 2 < cend) SSD_DTLOAD(c + 2);
            __syncthreads();
            const float cdec = __expf(tot);
#pragma unroll
            for (int k = 0; k < 4; ++k) { const int ti = 4 * wave + k, tp = ti >> 3, tn = ti & 7; const f32x4 z = {0.f, 0.f, 0.f, 0.f};
                const f32x4 lcv = mma16s<true, true>(Xl, 72, tp * 16, Bl, 72, tn * 16, z, lane);
                st[k] = st[k] * cdec + lcv; }
        }
#pragma unroll
        for (int k = 0; k < 4; ++k) { const int ti = 4 * wave + k, tp = ti >> 3, tn = ti & 7;
#pragma unroll
            for (int jj = 0; jj < 4; ++jj) { const int p = tp * 16 + (lane >> 4) * 4 + jj, n = tn * 16 + (lane & 15); Hs[p * 136 + n] = (bf16)f2bf(st[k][jj]); } }
        __syncthreads();
    }
#pragma unroll 1
    for (int c = cfull0; c < cend; ++c) {
        const bool full = c >= cfull0;
        const int tlo = dir ? SEQ - 64 * (c + 1) : 64 * c;
        const LAS float* dtv = dtvb + (c & 1) * 64; const LAS float* acs = acsb + (c & 1) * 64; const float tot = totb[c & 1];
#pragma unroll
        for (int i = 0; i < 5; ++i) { const int idx = tid + 512 * i; const int tl = idx / 40, q = idx % 40; const int lp = dir ? 63 - tl : tl;
            const unsigned w[4] = {pre[i].x, pre[i].y, pre[i].z, pre[i].w};
            if (q < 8) {
#pragma unroll
                for (int k = 0; k < 4; ++k) { const int p0 = q * 8 + 2 * k; Xt[p0 * 72 + swz64(p0, lp)] = (bf16)(w[k] & 0xffffu); Xt[(p0 + 1) * 72 + swz64(p0 + 1, lp)] = (bf16)(w[k] >> 16); } }
            else if (q < 24) { const int n0 = (q - 8) * 8; if (full) *(LAS v4u*)(Bm + lp * 136 + n0) = pre[i]; const float sc = dtv[lp] * __expf(tot - acs[lp]);
#pragma unroll
                for (int k = 0; k < 4; ++k) { const int nn = n0 + 2 * k; Btw[nn * 72 + swz64(nn, lp)] = (bf16)f2bf(bf2f(w[k] & 0xffffu) * sc); Btw[(nn + 1) * 72 + swz64(nn + 1, lp)] = (bf16)f2bf(bf2f(w[k] >> 16) * sc); } }
            else if (full) { const int n0 = (q - 24) * 8; *(LAS v4u*)(Cm + lp * 136 + n0) = pre[i]; } }
        if (c + 1 < cend) SSD_ISSUE(c + 1);
        __syncthreads();
        f32x4 yo[2] = {{0.f, 0.f, 0.f, 0.f}, {0.f, 0.f, 0.f, 0.f}}, lc[4];
        if (full) {
#pragma unroll
        for (int k = 0; k < 2; ++k) { const int ti = 2 * wave + k, tl_ = ti >> 2, ts = ti & 3; f32x4 acc = {0.f, 0.f, 0.f, 0.f};
            if (ts <= tl_) acc = mma16<128>(Cm + tl_ * 16 * 136, 136, Bm + ts * 16 * 136, 136, acc, lane);
#pragma unroll
            for (int jj = 0; jj < 4; ++jj) { const int lr = tl_ * 16 + (lane >> 4) * 4 + jj, s = ts * 16 + (lane & 15);
                const float v = (s <= lr) ? acc[jj] * __expf(acs[lr] - acs[s]) * dtv[s] : 0.f; Ps[lr * 72 + s] = (bf16)f2bf(v); }
            const f32x4 z = {0.f, 0.f, 0.f, 0.f};
            yo[k] = mma16<128>(Cm + tl_ * 16 * 136, 136, Hs + ts * 16 * 136, 136, z, lane); }
        }
#pragma unroll
        for (int k = 0; k < 4; ++k) { const int ti = 4 * wave + k, tp = ti >> 3, tn = ti & 7; const f32x4 z = {0.f, 0.f, 0.f, 0.f};
            lc[k] = mma16s<true, true>(Xt, 72, tp * 16, Btw, 72, tn * 16, z, lane); }
        __syncthreads();
        const float cdec = __expf(tot);
        if (full) {
#pragma unroll
        for (int k = 0; k < 2; ++k) { const int ti = 2 * wave + k, tl_ = ti >> 2, tp = ti & 3; const f32x4 z = {0.f, 0.f, 0.f, 0.f};
            const f32x4 yd = mma16s<false, true>(Ps, 72, tl_ * 16, Xt, 72, tp * 16, z, lane);
#pragma unroll
            for (int jj = 0; jj < 4; ++jj) { const int lr = tl_ * 16 + (lane >> 4) * 4 + jj, p = tp * 16 + (lane & 15);
                const float val = yd[jj] + yo[k][jj] * __expf(acs[lr]);
                const int t = dir ? tlo + 63 - lr : tlo + lr;
                Y[(mb + t) * 384 + head * 64 + p] = (bf16)f2bf(val); } }
        }
#pragma unroll
        for (int k = 0; k < 4; ++k) { const int ti = 4 * wave + k, tp = ti >> 3, tn = ti & 7;
#pragma unroll
            for (int jj = 0; jj < 4; ++jj) { const int p = tp * 16 + (lane >> 4) * 4 + jj, n = tn * 16 + (lane & 15);
                st[k][jj] = cdec * st[k][jj] + lc[k][jj]; Hs[p * 136 + n] = (bf16)f2bf(st[k][jj]); } }
        if (c + 1 < cend) { SSD_DTCALC(c + 1); if (c + 2 < cend) SSD_DTLOAD(c + 2); }
        __syncthreads();
    }
#undef SSD_ISSUE
#undef SSD_ISSUE_L
#undef SSD_DTLOAD
#undef SSD_DTCALC
}
__device__ __forceinline__ float wave_sum2(float v) { v = row16_sum(v); v += __shfl_xor(v, 16); v += __shfl_xor(v, 32); return v; }
__device__ __forceinline__ f32x4 bf4(v2u w) { return (f32x4){bf2f(w.x & 0xffffu), bf2f(w.x >> 16), bf2f(w.y & 0xffffu), bf2f(w.y >> 16)}; }
__device__ __forceinline__ v2u pk4(f32x4 v) { v2u w; w.x = pk2(v.x, v.y); w.y = pk2(v.z, v.w); return w; }
__device__ __forceinline__ void phase_post(const Frame& F, int l) {
    const bf16* cols = (const bf16*)(WSP(F) + WS_COLS); bf16* MIX = (bf16*)(WSP(F) + WS_XN);
    const bf16* YAf = (const bf16*)(WSP(F) + Y_AF); const bf16* YAb = (const bf16*)(WSP(F) + Y_AB);
    const bf16* YRf = (const bf16*)(WSP(F) + Y_RF); const bf16* YRb = (const bf16*)(WSP(F) + Y_RB);
    const bf16* YSf = (const bf16*)(WSP(F) + Y_SF); const bf16* YSb = (const bf16*)(WSP(F) + Y_SB);
    const float* CT = (const float*)(WSP(F) + WS_CT);
    LAS bf16* GU = (LAS bf16*)(F.lds);
    LAS bf16* SG = (LAS bf16*)(F.lds + 104448);
    LAS float* gate = (LAS float*)(F.lds + 108800);
    LAS float* SCW = (LAS float*)(F.lds + 133632);
    const int tid = F.tid, lane = F.lane, wave = F.wave;
    const float* mup = INP(F, 8) + l * 1472; const float* mun = INP(F, 9) + l * 1472;
    const float* gup = INP(F, 14) + (size_t)l * 128 * 384;
    const float* sdk = INP(F, 24) + l * 6;
    __syncthreads();
    for (int idx = tid; idx < 128 * 384; idx += 512) { const int i = idx / 384, c = idx % 384; GU[c * 136 + i] = (bf16)f2bf(gup[idx]); }
    { const float* scw = INP(F, 20) + (size_t)l * 5 * 896; for (int idx = tid; idx < 5 * 384; idx += 512) SCW[idx] = scw[(idx / 384) * 896 + (idx % 384)]; }
    const int gch = tid & 15;
    float gmp[8], gmn[8];
#pragma unroll
    for (int k = 0; k < 8; ++k) { gmp[k] = mup[1344 + 8 * gch + k]; gmn[k] = mun[1344 + 8 * gch + k]; }
    const int qa = lane, qb = 64 + (lane & 31);
    const f32x4 mng4 = *(const f32x4*)(INP(F, 7) + l * 256 + 4 * qa);
    f32x4 rmp[2], rmn[2], rng[2], rnb[2], scb[2], sng[2];
#pragma unroll
    for (int ps = 0; ps < 2; ++ps) { const int c0 = 4 * (ps ? qb : qa);
        rmp[ps] = *(const f32x4*)(mup + 768 + c0); rmn[ps] = *(const f32x4*)(mun + 768 + c0);
        rng[ps] = *(const f32x4*)(INP(F, 18) + l * 384 + c0); rnb[ps] = *(const f32x4*)(INP(F, 19) + l * 384 + c0);
        scb[ps] = *(const f32x4*)(INP(F, 21) + l * 896 + c0); sng[ps] = *(const f32x4*)(INP(F, 25) + l * 384 + c0); }
    for (int tile = F.vcu; tile < M / 16; tile += F.G) {
        const int m0 = tile * 16;
        __syncthreads();
        if (tid < 256) { const int tt = tid >> 4; const int m = m0 + tt, t = m % SEQ; const bf16* cp = cols + (size_t)m * NINP + R_GD + 8 * gch;
            const v4u c1 = *(const v4u*)cp; v4u c0 = {0u, 0u, 0u, 0u}, c2 = {0u, 0u, 0u, 0u};
            if (t > 0) c0 = *(const v4u*)(cp - NINP); if (t < SEQ - 1) c2 = *(const v4u*)(cp + NINP);
            const unsigned w0[4] = {c0.x, c0.y, c0.z, c0.w}, w1[4] = {c1.x, c1.y, c1.z, c1.w}, w2[4] = {c2.x, c2.y, c2.z, c2.w}; unsigned o[4];
#pragma unroll
            for (int k = 0; k < 4; ++k) { const float a1 = bf2f(w1[k] & 0xffffu), b1 = bf2f(w1[k] >> 16);
                const float va = a1 + gmp[2 * k] * (bf2f(w0[k] & 0xffffu) - a1) + gmn[2 * k] * (bf2f(w2[k] & 0xffffu) - a1);
                const float vb = b1 + gmp[2 * k + 1] * (bf2f(w0[k] >> 16) - b1) + gmn[2 * k + 1] * (bf2f(w2[k] >> 16) - b1);
                o[k] = pk2(sigmoidf_(va), sigmoidf_(vb)); }
            *(LAS v4u*)(SG + tt * 136 + 8 * gch) = (v4u){o[0], o[1], o[2], o[3]}; }
        __syncthreads();
#pragma unroll
        for (int k = 0; k < 3; ++k) { const int ct = wave + 8 * k; const f32x4 z = {0.f, 0.f, 0.f, 0.f};
            const f32x4 acc = mma16<128>(SG, 136, GU + ct * 16 * 136, 136, z, lane);
#pragma unroll
            for (int jj = 0; jj < 4; ++jj) gate[((lane >> 4) * 4 + jj) * 388 + ct * 16 + (lane & 15)] = acc[jj]; }
        __syncthreads();
#pragma unroll 1
        for (int k = 0; k < 2; ++k) { const int tt = wave * 2 + k; const int m = m0 + tt, t = m % SEQ; const size_t cr = (size_t)m * NINP;
            { const int c0 = 4 * qa;
              const f32x4 hs = bf4(*(const v2u*)(YAf + (size_t)m * 256 + c0)) + bf4(*(const v2u*)(YAb + (size_t)m * 256 + c0));
              const float mean = row16_sum((hs.x + hs.y) + (hs.z + hs.w)) * (1.f / 64.f); const f32x4 d = hs - mean;
              const float var = row16_sum((d.x * d.x + d.y * d.y) + (d.z * d.z + d.w * d.w)) * (1.f / 64.f);
              const f32x4 o = bf4(*(const v2u*)(cols + cr + A_O + c0));
              f32x4 y = d * (1.f / sqrtf(var + 1e-6f)) * mng4;
              y.x *= sigmoidf_(o.x); y.y *= sigmoidf_(o.y); y.z *= sigmoidf_(o.z); y.w *= sigmoidf_(o.w);
              *(v2u*)(MIX + (size_t)m * DM + c0) = pk4(y); }
#pragma unroll
            for (int ps = 0; ps < 2; ++ps) { const int qd = ps ? qb : qa, c0 = 4 * qd; const bool act = ps == 0 || lane < 32;
              const f32x4 ys = bf4(*(const v2u*)(YRf + (size_t)m * 384 + c0)) + bf4(*(const v2u*)(YRb + (size_t)m * 384 + c0));
              const float mean = row16_sum((ys.x + ys.y) + (ys.z + ys.w)) * (1.f / 64.f); const f32x4 d = ys - mean;
              const float var = row16_sum((d.x * d.x + d.y * d.y) + (d.z * d.z + d.w * d.w)) * (1.f / 64.f);
              const f32x4 y = d * (1.f / sqrtf(var + 64e-5f)) * rng[ps] + rnb[ps];
              const f32x4 p1 = bf4(*(const v2u*)(cols + cr + R_V + c0));
              f32x4 p0 = {0.f, 0.f, 0.f, 0.f}, p2 = {0.f, 0.f, 0.f, 0.f};
              if (t > 0) p0 = bf4(*(const v2u*)(cols + cr - NINP + R_V + c0)); if (t < SEQ - 1) p2 = bf4(*(const v2u*)(cols + cr + NINP + R_V + c0));
              const f32x4 vv = p1 + rmp[ps] * (p0 - p1) + rmn[ps] * (p2 - p1);
              const float ctv = CT[(size_t)m * 8 + (qd >> 4)];
              const f32x4 g4 = *(const LAS f32x4*)(gate + tt * 388 + c0);
              if (act) *(v2u*)(MIX + (size_t)m * DM + 256 + c0) = pk4((y + vv * ctv) * g4); }
            f32x4 yv[2]; float ssq0 = 0.f, ssq1 = 0.f;
#pragma unroll
            for (int ps = 0; ps < 2; ++ps) { const int qd = ps ? qb : qa, c0 = 4 * qd; const bool act = ps == 0 || lane < 32;
              f32x4 s = scb[ps];
#pragma unroll
              for (int jj = 0; jj < 5; ++jj) { const int tq = t + jj - 2; if (tq >= 0 && tq < SEQ) s += *(const LAS f32x4*)(SCW + jj * 384 + c0) * bf4(*(const v2u*)(cols + cr + (jj - 2) * NINP + S_X + c0)); }
              const f32x4 z = bf4(*(const v2u*)(cols + cr + S_Z + c0));
              f32x4 y = bf4(*(const v2u*)(YSf + (size_t)m * 384 + c0)) + bf4(*(const v2u*)(YSb + (size_t)m * 384 + c0));
              const float dsk = sdk[qd >> 4];
              y.x = (y.x + dsk * siluf_(s.x)) * siluf_(z.x); y.y = (y.y + dsk * siluf_(s.y)) * siluf_(z.y); y.z = (y.z + dsk * siluf_(s.z)) * siluf_(z.z); y.w = (y.w + dsk * siluf_(s.w)) * siluf_(z.w);
              yv[ps] = y; const float sq = act ? (y.x * y.x + y.y * y.y) + (y.z * y.z + y.w * y.w) : 0.f;
              if (qd < 48) ssq0 += sq; else ssq1 += sq; }
            const float r0 = 1.f / sqrtf(wave_sum2(ssq0) * (1.f / 192.f) + 1e-6f), r1 = 1.f / sqrtf(wave_sum2(ssq1) * (1.f / 192.f) + 1e-6f);
#pragma unroll
            for (int ps = 0; ps < 2; ++ps) { const int qd = ps ? qb : qa, c0 = 4 * qd; const bool act = ps == 0 || lane < 32;
              if (act) *(v2u*)(MIX + (size_t)m * DM + 640 + c0) = pk4(yv[ps] * (qd < 48 ? r0 : r1) * sng[ps]); }
        }
    }
    __syncthreads();
}
namespace cg = cooperative_groups;
constexpr int N_PHASES = 9 * DEPTH + 1;
__global__ void __launch_bounds__(NWAVES * 64, 2) mk_fwd(Args args) {
    extern __shared__ __attribute__((aligned(16))) unsigned char lds_raw[];
    Frame F;
    F.lds = (LAS unsigned char*)lds_raw;
    F.tid = threadIdx.x; F.lane = F.tid & 63; F.wave = __builtin_amdgcn_readfirstlane(F.tid >> 6);
    F.G = gridDim.x; { const int bx = blockIdx.x; F.vcu = (F.G % 8 == 0) ? (bx % 8) * (F.G / 8) + bx / 8 : bx; }
    volatile LAS unsigned* MISC = (volatile LAS unsigned*)(F.lds + MISC_OFF);
    if (F.tid < 64) MISC[F.tid] = 0u;
    if (F.tid < 34) *(LAS unsigned long long*)(F.lds + PTAB_OFF + 8 * F.tid) = ((const unsigned long long*)__builtin_amdgcn_kernarg_segment_ptr())[F.tid];
    __syncthreads();
    unsigned* ctl = (unsigned*)(WSP(F) + WS_CTL);
    XcdBarrier bar = xcd_barrier_post(ctl + CW_BAR, MISC + 8);
    const int lo = args.ph_lo, hi = args.ph_hi;
#define IN_(k) (lo <= (k) && (k) < hi)
#define SEAM(k) do { if (IN_(k) && IN_((k) + 1)) { if ((k) == 0) cg::this_grid().sync(); else xcd_barrier(bar); } } while (0)
#define LAYER(l, B) \
    if (IN_(B + 0)) { phase_convert(F, l); phase_norm(F, l == 0 ? INP(F, 0) : OUTP(F), INP(F, 1) + l * DM, (bf16*)(WSP(F) + WS_XN)); } SEAM(B + 0); \
    if (IN_(B + 1)) { unsigned char* ws = WSP(F); pg8::Gemm g{(const bf16*)(ws + WS_XN), (const bf16*)(ws + WS_WIN), M, NINP, DM}; pg8::StaticOrder S; S.init(M, NINP, F.G, (int)blockIdx.x); \
            pg8::EpiBf16<0> E{(bf16*)(ws + WS_COLS), NINP, nullptr, 0, 0, 1.f}; \
            pg8::gemm_phase<pg8::EpiBf16<0>, pg8::StaticOrder, PG8_ALIGN, PG8_SP2>(F.lds, g, S, E); } SEAM(B + 1); \
    if (IN_(B + 2)) { phase_gates(F, l); phase_ssd_conv(F, l); } SEAM(B + 2); \
    if (IN_(B + 3)) { const int bx = blockIdx.x; \
            if (bx < 96) { const int c8 = bx & 7, k8 = bx >> 3; rwkv_scan(F, l, c8 + 8 * (k8 >> 2), k8 & 3, (unsigned)l * (SEQ / 32)); } else if (bx < 144) rwkv_produce(F, l, (bx - 96) % 24, (bx - 96) / 24, (unsigned)l * (SEQ / 32)); else if (bx < 216) { const int u = bx - 144, sg = 2 - (u / 24); ssd_seq(F, l, u % 24, sg == 0 ? 0 : (sg == 1 ? 43 : 86), sg == 0 ? 43 : (sg == 1 ? 86 : 128)); } else if (bx < 248) { const int u = bx - 216, sg = 1 - (u / 16); mlstm_seq(F, l, u % 16, 64 * sg, 64 * sg + 64); } } SEAM(B + 3); \
    if (IN_(B + 4)) phase_post(F, l); SEAM(B + 4); \
    if (IN_(B + 5)) { unsigned char* ws = WSP(F); pg8::Gemm g{(const bf16*)(ws + WS_XN), (const bf16*)(ws + WS_WOUT), M, DM, DM}; pg8::StaticOrder S; S.init(M, DM, F.G, (int)blockIdx.x); \
            pg8::EpiResidual E{l == 0 ? INP(F, 0) : OUTP(F), OUTP(F), DM}; \
            pg8::gemm_phase<pg8::EpiResidual, pg8::StaticOrder, PG8_ALIGN, PG8_SP2>(F.lds, g, S, E); } SEAM(B + 5); \
    if (IN_(B + 6)) phase_norm(F, OUTP(F), INP(F, 27) + l * DM, (bf16*)(WSP(F) + WS_XN)); SEAM(B + 6); \
    if (IN_(B + 7)) { unsigned char* ws = WSP(F); pg8::Gemm g{(const bf16*)(ws + WS_XN), (const bf16*)(ws + WS_WGU), M, 2 * FFN, DM}; pg8::StaticOrder S; S.init(M, 2 * FFN, F.G, (int)blockIdx.x); \
            pg8::EpiSwiGLU E{(bf16*)(ws + WS_COLS), FFN}; \
            pg8::gemm_phase<pg8::EpiSwiGLU, pg8::StaticOrder, PG8_ALIGN, PG8_SP2>(F.lds, g, S, E); } SEAM(B + 7); \
    if (IN_(B + 8)) { unsigned char* ws = WSP(F); pg8::Gemm g{(const bf16*)(ws + WS_COLS), (const bf16*)(ws + WS_WDN), M, DM, FFN}; pg8::StaticOrder S; S.init(M, DM, F.G, (int)blockIdx.x); \
            pg8::EpiResidual E{OUTP(F), OUTP(F), DM}; \
            pg8::gemm_phase<pg8::EpiResidual, pg8::StaticOrder, PG8_ALIGN, PG8_SP2>(F.lds, g, S, E); } SEAM(B + 8);
    LAYER(0, 0)
    LAYER(1, 9)
    if (IN_(18)) phase_final_norm(F, OUTP(F), INP(F, 31));
#undef IN_
#undef SEAM
#undef LAYER
}

#ifndef MK_PER_PHASE
#define MK_PER_PHASE 0
#endif
extern "C" void kernel_launch(void* const* d_in, const int* in_sizes, int n_in, void* d_out, int out_size, void* d_ws, size_t ws_size, hipStream_t stream) {
    static int grid = 0;
    if (grid == 0) {
        int dev = 0, cus = 0;
        if (n_in != 32 || out_size != M * DM || ws_size < WS_END) { fprintf(stderr, "kernel_launch: unexpected shapes (n_in %d out %d ws %zu)\n", n_in, out_size, ws_size); grid = -1; return; }
        if (hipGetDevice(&dev) != hipSuccess || hipDeviceGetAttribute(&cus, hipDeviceAttributeMultiprocessorCount, dev) != hipSuccess) { grid = -1; return; }
        if (hipFuncSetAttribute((const void*)mk_fwd, hipFuncAttributeMaxDynamicSharedMemorySize, LDS_BYTES) != hipSuccess) { fprintf(stderr, "kernel_launch: hipFuncSetAttribute failed\n"); grid = -1; return; }
        int per_cu = 0;
        if (hipOccupancyMaxActiveBlocksPerMultiprocessor(&per_cu, (const void*)mk_fwd, NWAVES * 64, LDS_BYTES) != hipSuccess || per_cu < 1) { fprintf(stderr, "kernel_launch: occupancy query says %d\n", per_cu); }
        (void)hipGetLastError();
        grid = cus;
    }
    if (grid < 0) return;
    (void)hipMemsetAsync((char*)d_ws + WS_CTL, 0, CTL_ZERO_BYTES, stream);
    Args a{};
    for (int i = 0; i < 32; ++i) a.in[i] = (const float*)d_in[i];
    a.out = (float*)d_out; a.ws = (unsigned char*)d_ws;
#if MK_PER_PHASE
    for (int p = 0; p < N_PHASES; ++p) { a.ph_lo = p; a.ph_hi = p + 1; hipLaunchKernelGGL(mk_fwd, dim3(grid), dim3(NWAVES * 64), LDS_BYTES, stream, a); }
#else
    a.ph_lo = 0; a.ph_hi = N_PHASES;
    void* kargs[] = {&a};
    hipError_t e = hipLaunchCooperativeKernel((const void*)mk_fwd, dim3(grid), dim3(NWAVES * 64), kargs, LDS_BYTES, stream);
    if (e != hipSuccess) fprintf(stderr, "cooperative launch failed: %s (grid %d)\n", hipGetErrorString(e), grid);
#endif
}
```

```cpp
#include <hip/hip_runtime.h>
#include <hip/hip_cooperative_groups.h>
#include <cstdio>
#include <cstdint>
namespace pg8 {
#define PG8_LAS __attribute__((address_space(3)))
typedef unsigned short bf16_t;
typedef short bf16x8 __attribute__((ext_vector_type(8)));
typedef float f32x4 __attribute__((ext_vector_type(4)));
typedef unsigned u32x4 __attribute__((ext_vector_type(4)));
constexpr int BM = 256, BK = 64, HALF = 128, HTB = HALF * BK * 2  , STAGE_BYTES = 8 * HTB, NXCD = 8, WGM = 8;

__host__ __device__ __forceinline__ int lds_byte(int r, int c) { const int st = (r >> 4) * 2 + (c >> 5), rr = r & 15, cc = c & 31, ob = rr * 64 + cc * 2; return st * 1024 + (ob ^ (((ob >> 9) & 1) << 5)); }
__host__ __device__ __forceinline__ void stage_rc(int b, int& R, int& C) { const int st = b / 1024, sb = b % 1024, swz = sb ^ (((sb >> 9) & 1) << 5); R = (st >> 1) * 16 + swz / 64; C = (st & 1) * 32 + (swz % 64) / 2; }
__host__ __device__ __forceinline__ int perm32(int rho) { const int n = rho >> 4, i = rho & 15; return 8 * (i >> 2) + 4 * n + (i & 3); }

struct Unit { int pm, pn; };
struct Gemm { const bf16_t* A; const bf16_t* Bt; int M, N, K; };

struct StaticOrder {
    int nM, nN, nwg, G, c;
    __host__ __device__ void init(int M, int N, int G_, int c_) { nM = M / BM; nN = N / BM; nwg = nM * nN; G = G_; c = c_; }
    __host__ __device__ bool next(int i, Unit& u) const {
        const long L = (long)i * G + c; if (L >= nwg) return false;
        int wgid = (int)L; { const int q = nwg / NXCD, r = nwg % NXCD, xcd = wgid % NXCD, off = wgid / NXCD; wgid = (xcd < r ? xcd * (q + 1) : r * (q + 1) + (xcd - r) * q) + off; }
        const int nig = WGM * nN, gid = wgid / nig, fm = gid * WGM, gsz = (nM - fm) < WGM ? (nM - fm) : WGM;
        u.pm = fm + ((wgid % nig) % gsz); u.pn = (wgid % nig) / gsz; return true;
    }
    __device__ __forceinline__ void a_ready(const Unit&) const {}
    __device__ __forceinline__ void done(const Unit&) const {}
};

__device__ __forceinline__ unsigned cvt_pk_bf16(float lo, float hi) { unsigned r; asm volatile("v_cvt_pk_bf16_f32 %0, %1, %2" : "=v"(r) : "v"(lo), "v"(hi)); return r; }
typedef float f32x2 __attribute__((ext_vector_type(2)));
__device__ __forceinline__ f32x2 gelu_pk(f32x2 v) {
    const f32x2 av = __builtin_elementwise_abs(v), d = av * 0.2316418882f + 1.0f;
    f32x2 t; t.x = __builtin_amdgcn_rcpf(d.x); t.y = __builtin_amdgcn_rcpf(d.y);
    f32x2 q = t * 0.5307027145f + (-0.7265760135f); q = q * t + 0.7107068705f; q = q * t + (-0.142248368f); q = q * t + 0.127414796f; q = q * t;
    const f32x2 s = (v * v) * (-0.72134752044f);
    f32x2 e; e.x = __builtin_amdgcn_exp2f(s.x); e.y = __builtin_amdgcn_exp2f(s.y);
    const f32x2 m = v * (q * e), r = v - m;
    f32x2 o; o.x = v.x < 0.f ? m.x : r.x; o.y = v.y < 0.f ? m.y : r.y; return o;
}

template <int ACT  > struct EpiBf16 {
    static constexpr bool PERM = true, AFTER_DRAIN = false; static_assert(ACT == 0 || ACT == 1, "EpiBf16: ACT is 0 (none) or 1 (gelu_pk)");
    bf16_t* O; int ldc; const float* bias; int split_cols; size_t split_stride; float scale0;
    __device__ __forceinline__ void operator()(const f32x4 (&acc)[2][2][4][2], const Unit& u, int wr, int wc, int fr, int fq) const {
        const int row0 = u.pm * BM + wr * 64 + fr; int colt = u.pn * BM; bf16_t* base = O;
        float sc = 1.f; if (split_cols) { const int t = colt / split_cols; base += (size_t)t * split_stride; colt -= t * split_cols; if (t == 0) sc = scale0; }
        const int col0 = colt + wc * 32 + 8 * fq, bcol0 = u.pn * BM + wc * 32 + 8 * fq;
        f32x4 bv[2][2];
#pragma unroll
        for (int bj = 0; bj < 2; ++bj)
#pragma unroll
            for (int n = 0; n < 2; ++n) bv[bj][n] = bias ? *(const f32x4*)(bias + bcol0 + bj * HALF + 4 * n) : (f32x4){0.f, 0.f, 0.f, 0.f};
#pragma unroll
        for (int ai = 0; ai < 2; ++ai)
#pragma unroll
            for (int m = 0; m < 4; ++m) { bf16_t* rowp = base + (size_t)(row0 + ai * HALF + m * 16) * ldc + col0;
#pragma unroll
                for (int bj = 0; bj < 2; ++bj) { f32x4 v0 = acc[ai][bj][m][0] + bv[bj][0], v1 = acc[ai][bj][m][1] + bv[bj][1];
                    if (ACT == 1) { f32x2 a = gelu_pk((f32x2){v0[0], v0[1]}), b = gelu_pk((f32x2){v0[2], v0[3]}), c = gelu_pk((f32x2){v1[0], v1[1]}), d = gelu_pk((f32x2){v1[2], v1[3]});
                        v0 = (f32x4){a.x, a.y, b.x, b.y}; v1 = (f32x4){c.x, c.y, d.x, d.y}; }
                    v0 = v0 * sc; v1 = v1 * sc; u32x4 w; w.x = cvt_pk_bf16(v0[0], v0[1]); w.y = cvt_pk_bf16(v0[2], v0[3]); w.z = cvt_pk_bf16(v1[0], v1[1]); w.w = cvt_pk_bf16(v1[2], v1[3]);
                    *(u32x4*)(rowp + bj * HALF) = w; } }
    }
};
struct EpiResidual {
    static constexpr bool PERM = false, AFTER_DRAIN = false;
    const float* base; float* out; int ldc;
    __device__ __forceinline__ void operator()(const f32x4 (&acc)[2][2][4][2], const Unit& u, int wr, int wc, int fr, int fq) const {
        const int col0 = u.pn * BM + wc * 32 + 4 * fq;
#pragma unroll
        for (int ai = 0; ai < 2; ++ai)
#pragma unroll
            for (int m = 0; m < 4; ++m) { const size_t off = (size_t)(u.pm * BM + ai * HALF + wr * 64 + m * 16 + fr) * ldc + col0;
#pragma unroll
                for (int bj = 0; bj < 2; ++bj)
#pragma unroll
                    for (int n = 0; n < 2; ++n) { const f32x4 bs = *(const f32x4*)(base + off + bj * HALF + n * 16); *(f32x4*)(out + off + bj * HALF + n * 16) = bs + acc[ai][bj][m][n]; }
                asm volatile("" ::: "memory"); }
    }
};
struct EpiSwiGLU {
    static constexpr bool PERM = true, AFTER_DRAIN = false;
    bf16_t* O; int ldc;
    __device__ __forceinline__ void operator()(const f32x4 (&acc)[2][2][4][2], const Unit& u, int wr, int wc, int fr, int fq) const {
        const int col0 = u.pn * HALF + wc * 32 + 8 * fq;
#pragma unroll
        for (int ai = 0; ai < 2; ++ai)
#pragma unroll
            for (int m = 0; m < 4; ++m) { bf16_t* rowp = O + (size_t)(u.pm * BM + ai * HALF + wr * 64 + m * 16 + fr) * ldc + col0;
                float r[8];
#pragma unroll
                for (int n = 0; n < 2; ++n)
#pragma unroll
                    for (int j = 0; j < 4; ++j) { const float g = acc[ai][0][m][n][j], up = acc[ai][1][m][n][j]; r[n * 4 + j] = g * __builtin_amdgcn_rcpf(1.f + __expf(-g)) * up; }
                u32x4 w; w.x = cvt_pk_bf16(r[0], r[1]); w.y = cvt_pk_bf16(r[2], r[3]); w.z = cvt_pk_bf16(r[4], r[5]); w.w = cvt_pk_bf16(r[6], r[7]);
                *(u32x4*)rowp = w; }
    }
};
template <class Epi, class Sched, bool ALIGN_EPI = false, bool SP2 = false>
__device__ __forceinline__ void gemm_phase(PG8_LAS unsigned char* lds, const Gemm g, const Sched& S, const Epi& E) {
    const int tid = threadIdx.x, wid = __builtin_amdgcn_readfirstlane(tid >> 6), lane = tid & 63, wr = wid >> 2, wc = wid & 3, fr = lane & 15, fq = lane >> 4;
    const int K = g.K, nt = K / BK;
    unsigned voffA[2], voffB[2];
#pragma unroll
    for (int i = 0; i < 2; ++i) { int R, C; stage_rc(tid * 16 + i * 8192, R, C); const int Rb = Epi::PERM ? ((R & ~31) + perm32(R & 31)) : R;
        voffA[i] = (unsigned)(R * K + C) * 2u; voffB[i] = (unsigned)(Rb * K + C) * 2u; }
    const size_t kstep = (size_t)(BK * 2);
    const size_t hstep = (size_t)HALF * K * 2;
    const size_t tstep = 2 * hstep;
    const unsigned ldsw = (unsigned)wid * 1024u;
    const int aoff = lds_byte(wr * 64 + fr, fq * 8), boff = lds_byte(wc * 32 + fr, fq * 8);
#define PG8_SA(b, h) (((b) * 2 + (h)) * HTB)
#define PG8_SB(b, h) ((4 + (b) * 2 + (h)) * HTB)
#define PG8_STAGE(bufoff, gbase, voff) do { _Pragma("unroll") for (int _i = 0; _i < 2; ++_i) \
        __builtin_amdgcn_global_load_lds((const unsigned*)((const char*)(gbase) + (voff)[_i]), (PG8_LAS unsigned*)(lds + (bufoff) + ldsw + _i * 8192), 16, 0, 0); } while (0)
#define PG8_LDA(dst, b, h) do { _Pragma("unroll") for (int m = 0; m < 4; ++m) _Pragma("unroll") for (int k = 0; k < 2; ++k) dst[m][k] = *(const PG8_LAS bf16x8*)(lds + PG8_SA(b, h) + aoff + m * 2048 + k * 1024); } while (0)
#define PG8_LDB(dst, b, h) do { _Pragma("unroll") for (int n = 0; n < 2; ++n) _Pragma("unroll") for (int k = 0; k < 2; ++k) dst[n][k] = *(const PG8_LAS bf16x8*)(lds + PG8_SB(b, h) + boff + n * 2048 + k * 1024); } while (0)
#define PG8_MMA(ai, bj, At, Bt) do { __builtin_amdgcn_s_setprio(1); _Pragma("unroll") for (int m = 0; m < 4; ++m) _Pragma("unroll") for (int n = 0; n < 2; ++n) _Pragma("unroll") for (int k = 0; k < 2; ++k) \
        acc[ai][bj][m][n] = __builtin_amdgcn_mfma_f32_16x16x32_bf16(Bt[n][k], At[m][k], acc[ai][bj][m][n], 0, 0, 0); __builtin_amdgcn_s_setprio(0); } while (0)
#define PG8_WAIT_V(n) asm volatile("s_waitcnt vmcnt(" #n ")" ::: "memory")
#define PG8_WAIT_L(n) asm volatile("s_waitcnt lgkmcnt(" #n ")" ::: "memory")
#define PG8_BAR __builtin_amdgcn_s_barrier()
#define PG8_SCHED __builtin_amdgcn_sched_barrier(0)
    Unit cur, nxt; int ui = 0;
    if (!S.next(0, cur)) return;
    f32x4 acc[2][2][4][2];
#pragma unroll
    for (int a = 0; a < 2; ++a)
#pragma unroll
        for (int b = 0; b < 2; ++b)
#pragma unroll
            for (int m = 0; m < 4; ++m)
#pragma unroll
                for (int n = 0; n < 2; ++n) acc[a][b][m][n] = (f32x4){0.f, 0.f, 0.f, 0.f};
    bf16x8 At[4][2], B0[2][2], B1[2][2];
    const char* cA = (const char*)g.A + (size_t)cur.pm * tstep; const char* cB = (const char*)g.Bt + (size_t)cur.pn * tstep;
    S.a_ready(cur);
    if constexpr (SP2) {
        PG8_STAGE(PG8_SB(0, 0), cB, voffB); PG8_STAGE(PG8_SB(0, 1), cB + hstep, voffB); PG8_STAGE(PG8_SA(0, 0), cA, voffA); PG8_STAGE(PG8_SA(0, 1), cA + hstep, voffA);
        if (wr == 1) PG8_BAR;
        PG8_WAIT_V(2); PG8_BAR;
        PG8_STAGE(PG8_SB(1, 0), cB + kstep, voffB); PG8_STAGE(PG8_SA(1, 0), cA + kstep, voffA); PG8_STAGE(PG8_SB(1, 1), cB + hstep + kstep, voffB);
        PG8_WAIT_V(6); PG8_BAR;
    } else {
        PG8_STAGE(PG8_SB(0, 0), cB, voffB); PG8_STAGE(PG8_SA(0, 0), cA, voffA); PG8_STAGE(PG8_SB(0, 1), cB + hstep, voffB); PG8_STAGE(PG8_SA(0, 1), cA + hstep, voffA);
        if (wr == 1) PG8_BAR;
        PG8_WAIT_V(4); PG8_BAR;
        PG8_STAGE(PG8_SB(1, 0), cB + kstep, voffB); PG8_STAGE(PG8_SA(1, 0), cA + kstep, voffA); PG8_STAGE(PG8_SB(1, 1), cB + hstep + kstep, voffB);
        PG8_WAIT_V(6); PG8_BAR;
    }
    for (;;) {
        const bool has_next = S.next(ui + 1, nxt);
        const char* nA = has_next ? (const char*)g.A + (size_t)nxt.pm * tstep : cA; const char* nB = has_next ? (const char*)g.Bt + (size_t)nxt.pn * tstep : cB;
        for (int t = 0; t < nt; t += 2) {
            const bool last = (t == nt - 2);
            const char* a1 = cA + (size_t)(t + 1) * kstep;
            const char* a2 = last ? nA : cA + (size_t)(t + 2) * kstep; const char* b2 = last ? nB : cB + (size_t)(t + 2) * kstep;
            const char* a3 = a2 + kstep; const char* b3 = b2 + kstep;
            if (last && has_next) S.a_ready(nxt);
            if constexpr (SP2) {
            PG8_LDB(B0, 0, 0); PG8_LDB(B1, 0, 1); PG8_SCHED; PG8_LDA(At, 0, 0); PG8_STAGE(PG8_SA(1, 1), a1 + hstep, voffA);
            PG8_WAIT_V(8); PG8_WAIT_L(0); PG8_BAR; PG8_MMA(0, 0, At, B0); PG8_MMA(0, 1, At, B1); PG8_BAR; PG8_SCHED;
            PG8_LDA(At, 0, 1); PG8_STAGE(PG8_SB(0, 0), b2, voffB); PG8_STAGE(PG8_SB(0, 1), b2 + hstep, voffB); PG8_STAGE(PG8_SA(0, 0), a2, voffA);
            PG8_WAIT_V(8); PG8_WAIT_L(0); PG8_BAR; PG8_MMA(1, 0, At, B0); PG8_MMA(1, 1, At, B1); PG8_BAR; PG8_SCHED;
            PG8_LDB(B0, 1, 0); PG8_LDB(B1, 1, 1); PG8_SCHED; PG8_LDA(At, 1, 0); PG8_STAGE(PG8_SA(0, 1), a2 + hstep, voffA);
            PG8_WAIT_V(8); PG8_WAIT_L(0); PG8_BAR; PG8_MMA(0, 0, At, B0); PG8_MMA(0, 1, At, B1); PG8_BAR; PG8_SCHED;
            PG8_LDA(At, 1, 1); PG8_STAGE(PG8_SB(1, 0), b3, voffB); PG8_STAGE(PG8_SB(1, 1), b3 + hstep, voffB); PG8_STAGE(PG8_SA(1, 0), a3, voffA);
            PG8_WAIT_V(8); PG8_WAIT_L(0); PG8_BAR; PG8_MMA(1, 0, At, B0); PG8_MMA(1, 1, At, B1); PG8_BAR; PG8_SCHED;
            } else {
            PG8_LDB(B0, 0, 0); PG8_SCHED; PG8_LDA(At, 0, 0); PG8_STAGE(PG8_SA(1, 1), a1 + hstep, voffA);
            PG8_WAIT_L(8); PG8_BAR; PG8_WAIT_L(0); PG8_MMA(0, 0, At, B0); PG8_BAR; PG8_SCHED;
            PG8_LDB(B1, 0, 1); PG8_STAGE(PG8_SB(0, 0), b2, voffB);
            PG8_BAR; PG8_WAIT_L(0); PG8_MMA(0, 1, At, B1); PG8_BAR;
            PG8_LDA(At, 0, 1); PG8_STAGE(PG8_SA(0, 0), a2, voffA);
            PG8_BAR; PG8_WAIT_L(0); PG8_MMA(1, 0, At, B0); PG8_BAR; PG8_SCHED;
            PG8_STAGE(PG8_SB(0, 1), b2 + hstep, voffB);
            PG8_WAIT_V(6); PG8_BAR; PG8_MMA(1, 1, At, B1); PG8_BAR;
            PG8_LDB(B0, 1, 0); PG8_SCHED; PG8_LDA(At, 1, 0); PG8_STAGE(PG8_SA(0, 1), a2 + hstep, voffA);
            PG8_WAIT_L(8); PG8_BAR; PG8_WAIT_L(0); PG8_MMA(0, 0, At, B0); PG8_BAR; PG8_SCHED;
            PG8_LDB(B1, 1, 1); PG8_STAGE(PG8_SB(1, 0), b3, voffB);
            PG8_BAR; PG8_WAIT_L(0); PG8_MMA(0, 1, At, B1); PG8_BAR;
            PG8_LDA(At, 1, 1); PG8_STAGE(PG8_SA(1, 0), a3, voffA);
            PG8_BAR; PG8_WAIT_L(0); PG8_MMA(1, 0, At, B0); PG8_BAR; PG8_SCHED;
            PG8_STAGE(PG8_SB(1, 1), b3 + hstep, voffB);
            PG8_WAIT_V(6); PG8_BAR; PG8_MMA(1, 1, At, B1); PG8_BAR;
            }
        }
        if constexpr (ALIGN_EPI) { if (wr == 0) PG8_BAR; }
        if constexpr (!Epi::AFTER_DRAIN) { E(acc, cur, wr, wc, fr, fq); S.done(cur); }
        if (!has_next) break;
#pragma unroll
        for (int a = 0; a < 2; ++a)
#pragma unroll
            for (int b = 0; b < 2; ++b)
#pragma unroll
                for (int m = 0; m < 4; ++m)
#pragma unroll
                    for (int n = 0; n < 2; ++n) acc[a][b][m][n] = (f32x4){0.f, 0.f, 0.f, 0.f};
        cur = nxt; cA = nA; cB = nB; ++ui;
        if constexpr (ALIGN_EPI) { if (wr == 1) PG8_BAR; }
    }
    PG8_WAIT_V(0);
    if constexpr (!ALIGN_EPI) { if (wr == 0) PG8_BAR; }
    PG8_BAR;
    if constexpr (Epi::AFTER_DRAIN) { E.fused(acc, cur, wr, wc, fr, fq, lds, wid, lane); S.done(cur); }
#undef PG8_SA
#undef PG8_SB
#undef PG8_STAGE
#undef PG8_LDA
#undef PG8_LDB
#undef PG8_MMA
#undef PG8_WAIT_V
#undef PG8_WAIT_L
#undef PG8_BAR
#undef PG8_SCHED
}
}

#ifndef PG8_SP2
#define PG8_SP2 true
#endif
#define PG8_ALIGN true
constexpr int NWAVES = 8;
constexpr int BATCH = 2, SEQ = 8192, DM = 1024, M = BATCH * SEQ, NIN = 3788, NINP = 3840, FFN = 2816, DEPTH = 2;
constexpr int A_Q = 0, A_K = 256, A_V = 512, A_O = 768;
constexpr int R_R = 1024, R_K = 1408, R_V = 1792, R_WDF = 2176, R_AD = 2304, R_GD = 2368;
constexpr int S_Z = 2496, S_X = 2880, S_B = 3264, S_C = 3520, S_DT = 3776;
constexpr size_t MiB = 1u << 20;
constexpr size_t WS_CTL = 0, CTL_ZERO_BYTES = 128 * 1024;
constexpr size_t WS_GATES = 1 * MiB, WS_CT = 2 * MiB, WS_DTV = 2 * MiB + 512 * 1024;
constexpr size_t WS_GUT = 31 * MiB;
constexpr size_t WS_WIN = 4 * MiB, WS_WOUT = 12 * MiB, WS_WGU = 14 * MiB, WS_WDN = 25 * MiB;
constexpr size_t WS_XN = 32 * MiB, WS_COLS = 64 * MiB, WS_Y = 184 * MiB, WS_END = 256 * MiB;
constexpr size_t Y_AF = WS_Y, Y_AB = WS_Y + 8 * MiB, Y_RF = WS_Y + 16 * MiB, Y_RB = WS_Y + 28 * MiB, Y_SF = WS_Y + 40 * MiB, Y_SB = WS_Y + 52 * MiB;
constexpr int CW_BAR = 1024;
constexpr int RING_BYTES = 131072;
constexpr int LDS_BYTES = 147456, MISC_OFF = LDS_BYTES - 256;

#define GAS __attribute__((address_space(1)))
#define LAS __attribute__((address_space(3)))
typedef unsigned short bf16;
typedef unsigned v4u __attribute__((ext_vector_type(4)));
typedef unsigned v2u __attribute__((ext_vector_type(2)));
typedef float f32x4 __attribute__((ext_vector_type(4)));
typedef short bf16x8 __attribute__((ext_vector_type(8)));
typedef GAS unsigned gu32;
#define RLX_AGENT __ATOMIC_RELAXED, __HIP_MEMORY_SCOPE_AGENT
#define LDS_WAIT() asm volatile("s_waitcnt lgkmcnt(0)" ::: "memory")
#define VM_WAIT() asm volatile("s_waitcnt vmcnt(0)" ::: "memory")
__device__ __forceinline__ unsigned f2bf(float f) { unsigned u = __builtin_bit_cast(unsigned, f); return (u + 0x7fffu + ((u >> 16) & 1u)) >> 16; }
__device__ __forceinline__ unsigned pk2(float lo, float hi) { return f2bf(lo) | (f2bf(hi) << 16); }
__device__ __forceinline__ float bf2f(unsigned u) { return __builtin_bit_cast(float, u << 16); }
__device__ __forceinline__ float sigmoidf_(float x) { return __builtin_amdgcn_rcpf(1.f + __expf(-x)); }
__device__ __forceinline__ float siluf_(float x) { return x * sigmoidf_(x); }
__device__ __forceinline__ float wave_sum(float v) {
#pragma unroll
    for (int o = 1; o < 64; o <<= 1) v += __shfl_xor(v, o);
    return v;
}
__device__ __forceinline__ float wave_max(float v) {
#pragma unroll
    for (int o = 1; o < 64; o <<= 1) v = fmaxf(v, __shfl_xor(v, o));
    return v;
}
template <int CTRL> __device__ __forceinline__ float dppf(float v) { return __builtin_bit_cast(float, __builtin_amdgcn_update_dpp(0, __builtin_bit_cast(int, v), CTRL, 0xf, 0xf, true)); }
__device__ __forceinline__ float row16_sum(float v) { v += dppf<0xB1>(v); v += dppf<0x4E>(v); v += dppf<0x141>(v); v += dppf<0x140>(v); return v; }
template <int K> __device__ __forceinline__ f32x4 mma16(const LAS bf16* A, int lda, const LAS bf16* Bt, int ldb, f32x4 acc, int lane) {
    const int r = lane & 15, q = lane >> 4;
    const LAS bf16* ap = A + r * lda + q * 8; const LAS bf16* bp = Bt + r * ldb + q * 8;
#pragma unroll
    for (int k0 = 0; k0 < K; k0 += 32) {
        const bf16x8 a = *(const LAS bf16x8*)(ap + k0); const bf16x8 b = *(const LAS bf16x8*)(bp + k0);
        acc = __builtin_amdgcn_mfma_f32_16x16x32_bf16(a, b, acc, 0, 0, 0);
    }
    return acc;
}

__device__ __forceinline__ int swz64(int row, int col) { return col ^ (((row >> 3) & 7) << 3); }
template <bool SWA, bool SWB> __device__ __forceinline__ f32x4 mma16s(const LAS bf16* A, int lda, int rowA0, const LAS bf16* Bt, int ldb, int rowB0, f32x4 acc, int lane) {
    const int r = lane & 15, q = lane >> 4; const int ra = rowA0 + r, rb = rowB0 + r;
#pragma unroll
    for (int k0 = 0; k0 < 64; k0 += 32) { const int ca = k0 + 8 * q, cb = k0 + 8 * q;
        const bf16x8 a = *(const LAS bf16x8*)(A + ra * lda + (SWA ? swz64(ra, ca) : ca)); const bf16x8 b = *(const LAS bf16x8*)(Bt + rb * ldb + (SWB ? swz64(rb, cb) : cb));
        acc = __builtin_amdgcn_mfma_f32_16x16x32_bf16(a, b, acc, 0, 0, 0); }
    return acc;
}

template <int CTRL, int RM, int BM> __device__ __forceinline__ float dppm(float oldv, float v) { return __builtin_bit_cast(float, __builtin_amdgcn_update_dpp(__builtin_bit_cast(int, oldv), __builtin_bit_cast(int, v), CTRL, RM, BM, false)); }
__device__ __forceinline__ float wave_scan_add(float x) {
    float y = x + dppm<0x111, 0xf, 0xf>(0.f, x); y += dppm<0x112, 0xf, 0xf>(0.f, x); y += dppm<0x113, 0xf, 0xf>(0.f, x);
    y += dppm<0x114, 0xf, 0xe>(0.f, y); y += dppm<0x118, 0xf, 0xc>(0.f, y);
    y += dppm<0x142, 0xa, 0xf>(0.f, y); y += dppm<0x143, 0xc, 0xf>(0.f, y);
    return y;
}
__device__ __forceinline__ float wave_scan_max(float x) {
    const float ninf = -INFINITY;
    float y = fmaxf(x, dppm<0x111, 0xf, 0xf>(ninf, x)); y = fmaxf(y, dppm<0x112, 0xf, 0xf>(ninf, x)); y = fmaxf(y, dppm<0x113, 0xf, 0xf>(ninf, x));
    y = fmaxf(y, dppm<0x114, 0xf, 0xe>(ninf, y)); y = fmaxf(y, dppm<0x118, 0xf, 0xc>(ninf, y));
    y = fmaxf(y, dppm<0x142, 0xa, 0xf>(ninf, y)); y = fmaxf(y, dppm<0x143, 0xc, 0xf>(ninf, y));
    return y;
}
#define XB_TMO      128
#define XB_XCNT(j)  (256  + 64 * (j))
#define XB_XSUB(j)  (1280 + 64 * (j))
#define XB_XGEN(j)  (2304 + 64 * (j))
#define XB_TOP      3328
#define XB_TOPGEN   3392
#define XCD_BAR_WORDS 3456
#define XB_SPIN_CAP (1u << 18)

__device__ __forceinline__ unsigned xb_ld(unsigned* p)              { return __hip_atomic_load(p, __ATOMIC_RELAXED, __HIP_MEMORY_SCOPE_AGENT); }
__device__ __forceinline__ unsigned xb_add(unsigned* p, unsigned v) { return __hip_atomic_fetch_add(p, v, __ATOMIC_RELAXED, __HIP_MEMORY_SCOPE_AGENT); }
__device__ __forceinline__ unsigned xb_xcc_id() { return (unsigned)__builtin_amdgcn_s_getreg((3 << 11) | 20) & 0xFu; }
#define XB_SPIN(cond, bar) do { unsigned _sp = 0; while (cond) { __builtin_amdgcn_s_sleep(1); \
    if ((++_sp & 255u) == 0u) { if (xb_ld(&(bar)[XB_TMO])) break; if (_sp > XB_SPIN_CAP) { atomicAdd(&(bar)[XB_TMO], 1u); break; } } } } while (0)

struct XcdBarrier {
    unsigned* bar; unsigned x;
    volatile LAS unsigned* st;
};

__device__ __forceinline__ XcdBarrier xcd_barrier_post(unsigned* bar, volatile LAS unsigned* st) {
    XcdBarrier b; b.bar = bar; b.x = xb_xcc_id(); b.st = st;
    if (threadIdx.x == 0) (void)xb_add(&bar[XB_XCNT(b.x)], 1u);
    return b;
}
__device__ __forceinline__ void xcd_barrier_complete(unsigned* bar, unsigned x, unsigned& nloc, unsigned& nx) {
    const unsigned G = gridDim.x * gridDim.y * gridDim.z;
    unsigned sum, cnt, mine, sp = 0u;
    for (;;) {
        sum = 0u; cnt = 0u; mine = 0u;
#pragma unroll
        for (unsigned j = 0; j < 16; ++j) { const unsigned c = xb_ld(&bar[XB_XCNT(j)]); sum += c; cnt += (c > 0u) ? 1u : 0u; mine = (j == x) ? c : mine; }
        if (sum == G) break;
        __builtin_amdgcn_s_sleep(1);
        if ((++sp & 255u) == 0u) { if (xb_ld(&bar[XB_TMO])) break; if (sp > XB_SPIN_CAP) { atomicAdd(&bar[XB_TMO], 1u); break; } }
    }
    nloc = mine > 0u ? mine : 1u; nx = cnt > 0u ? cnt : 1u;
}

__device__ __forceinline__ void xcd_barrier(const XcdBarrier& b) {
    asm volatile("s_waitcnt vmcnt(0)" ::: "memory");
    __syncthreads();
    if (threadIdx.x == 0) {
        unsigned* bar = b.bar;
        __builtin_amdgcn_s_waitcnt(0);
        unsigned nloc = b.st[0], nx = b.st[1];
        if (nloc == 0u) { xcd_barrier_complete(bar, b.x, nloc, nx); b.st[0] = nloc; b.st[1] = nx; }
        const unsigned old = xb_add(&bar[XB_XSUB(b.x)], 1u);
        const unsigned gen = old / nloc;
        if (old + 1u == (gen + 1u) * nloc) {
            __builtin_amdgcn_fence(__ATOMIC_RELEASE, "agent");
            asm volatile("s_waitcnt vmcnt(0)" ::: "memory");
            const unsigned og = xb_add(&bar[XB_TOP], 1u);
            const unsigned tg = og / nx;
            if (og + 1u == (tg + 1u) * nx) xb_add(&bar[XB_TOPGEN], 1u);
            else XB_SPIN(xb_ld(&bar[XB_TOPGEN]) == tg, bar);
            __builtin_amdgcn_fence(__ATOMIC_ACQUIRE, "agent");
            xb_add(&bar[XB_XGEN(b.x)], 1u);
            asm volatile("s_waitcnt vmcnt(0)" ::: "memory");
        } else {
            XB_SPIN(xb_ld(&bar[XB_XGEN(b.x)]) == gen, bar);
            __builtin_amdgcn_fence(__ATOMIC_ACQUIRE, "agent");
            asm volatile("s_waitcnt vmcnt(0)" ::: "memory");
        }
    }
    __syncthreads();
}
struct Frame {
    LAS unsigned char* lds;
    int tid, lane, wave, vcu, G;
};
struct Args { const float* in[32]; float* out; unsigned char* ws; int ph_lo, ph_hi; };
constexpr int PTAB_OFF = LDS_BYTES - 768;
__device__ __forceinline__ unsigned long long ptab_ld(const Frame& F, int i) {
    const unsigned long long v = *(volatile LAS unsigned long long*)(F.lds + PTAB_OFF + 8 * i);
    const unsigned lo = __builtin_amdgcn_readfirstlane((unsigned)v), hi = __builtin_amdgcn_readfirstlane((unsigned)(v >> 32));
    return ((unsigned long long)hi << 32) | lo;
}
__device__ __forceinline__ const float* INP(const Frame& F, int i) { return (const float*)ptab_ld(F, i); }
__device__ __forceinline__ unsigned char* WSP(const Frame& F) { return (unsigned char*)ptab_ld(F, 33); }
__device__ __forceinline__ float* OUTP(const Frame& F) { return (float*)ptab_ld(F, 32); }

__device__ __forceinline__ void transpose_item(const float* W, int K, int N, int nblk, bf16* WT, int mode, int row_off, LAS float* scr, int item, int lane) {
    const int kb = item / nblk, nb = item % nblk, k0 = 64 * kb, n0 = 32 * nb;
    const int ncol = n0 + (lane & 31); const bool ok = ncol < N;
#pragma unroll 8
    for (int i = 0; i < 32; ++i) { const int kk = 2 * i + (lane >> 5); scr[kk * 33 + (lane & 31)] = ok ? W[(size_t)(k0 + kk) * N + ncol] : 0.f; }
    LDS_WAIT(); asm volatile("" ::: "memory");
    const int c = lane & 7;
    const int drow0 = mode ? (256 * (n0 >> 7) + (n0 & 127) + row_off) : (row_off + n0);
#pragma unroll
    for (int j = 0; j < 4; ++j) { const int n = (lane >> 3) + 8 * j; const LAS float* s = scr + (8 * c) * 33 + n;
        v4u o; o.x = pk2(s[0 * 33], s[1 * 33]); o.y = pk2(s[2 * 33], s[3 * 33]); o.z = pk2(s[4 * 33], s[5 * 33]); o.w = pk2(s[6 * 33], s[7 * 33]);
        *(v4u*)(WT + (size_t)(drow0 + n) * K + k0 + 8 * c) = o; }
    LDS_WAIT(); asm volatile("" ::: "memory");
}
__device__ __forceinline__ void phase_convert(const Frame& F, int l) {
    LAS float* scr = (LAS float*)(F.lds + F.wave * 16384);
    const int gw = F.vcu * NWAVES + F.wave, NGW = F.G * NWAVES;
    bf16* Win = (bf16*)(WSP(F) + WS_WIN); bf16* Wout = (bf16*)(WSP(F) + WS_WOUT); bf16* Wgu = (bf16*)(WSP(F) + WS_WGU); bf16* Wdn = (bf16*)(WSP(F) + WS_WDN);
    constexpr int I_IN = 16 * 120, I_OUT = 16 * 32, I_G = 16 * 88, I_D = 44 * 32, I_GU = 2 * 12;
    constexpr int NITEMS = I_IN + I_OUT + 2 * I_G + I_D + I_GU;
    for (int it = gw; it < NITEMS; it += NGW) {
        int r = it;
        if (r < I_IN) { transpose_item(INP(F, 2) + (size_t)l * DM * NIN, DM, NIN, 120, Win, 0, 0, scr, r, F.lane); continue; } r -= I_IN;
        if (r < I_OUT) { transpose_item(INP(F, 26) + (size_t)l * DM * DM, DM, DM, 32, Wout, 0, 0, scr, r, F.lane); continue; } r -= I_OUT;
        if (r < I_G) { transpose_item(INP(F, 28) + (size_t)l * DM * FFN, DM, FFN, 88, Wgu, 1, 0, scr, r, F.lane); continue; } r -= I_G;
        if (r < I_G) { transpose_item(INP(F, 29) + (size_t)l * DM * FFN, DM, FFN, 88, Wgu, 1, 128, scr, r, F.lane); continue; } r -= I_G;
        if (r < I_D) { transpose_item(INP(F, 30) + (size_t)l * FFN * DM, FFN, DM, 32, Wdn, 0, 0, scr, r, F.lane); continue; } r -= I_D;
        transpose_item(INP(F, 14) + (size_t)l * 128 * 384, 128, 384, 12, (bf16*)(WSP(F) + WS_GUT), 0, 0, scr, r, F.lane);
    }
}
__device__ __forceinline__ void phase_norm(const Frame& F, const float* hin, const float* g, bf16* XN) {
    const int gw = F.vcu * NWAVES + F.wave, NGW = F.G * NWAVES;
    f32x4 gv[4];
#pragma unroll
    for (int j = 0; j < 4; ++j) gv[j] = ((const f32x4*)g)[64 * j + F.lane];
    for (int m = gw; m < M; m += NGW) {
        const f32x4* xr = (const f32x4*)(hin + (size_t)m * DM) + F.lane;
        f32x4 v[4]; float s = 0.f;
#pragma unroll
        for (int j = 0; j < 4; ++j) { v[j] = xr[64 * j]; s += (v[j].x * v[j].x + v[j].y * v[j].y) + (v[j].z * v[j].z + v[j].w * v[j].w); }
        const float r = 1.f / sqrtf(wave_sum(s) * (1.f / DM) + 1e-6f);
        v2u* o8 = (v2u*)(XN + (size_t)m * DM) + F.lane;
#pragma unroll
        for (int j = 0; j < 4; ++j) { v2u w; w.x = pk2(v[j].x * r * gv[j].x, v[j].y * r * gv[j].y); w.y = pk2(v[j].z * r * gv[j].z, v[j].w * r * gv[j].w); o8[64 * j] = w; }
    }
}
__device__ __forceinline__ void phase_final_norm(const Frame& F, float* h, const float* g) {
    const int gw = F.vcu * NWAVES + F.wave, NGW = F.G * NWAVES;
    f32x4 gv[4];
#pragma unroll
    for (int j = 0; j < 4; ++j) gv[j] = ((const f32x4*)g)[64 * j + F.lane];
    for (int m = gw; m < M; m += NGW) {
        f32x4* xr = (f32x4*)(h + (size_t)m * DM) + F.lane;
        f32x4 v[4]; float s = 0.f;
#pragma unroll
        for (int j = 0; j < 4; ++j) { v[j] = xr[64 * j]; s += (v[j].x * v[j].x + v[j].y * v[j].y) + (v[j].z * v[j].z + v[j].w * v[j].w); }
        const float r = 1.f / sqrtf(wave_sum(s) * (1.f / DM) + 1e-6f);
#pragma unroll
        for (int j = 0; j < 4; ++j) xr[64 * j] = v[j] * r * gv[j];
    }
}
__device__ __forceinline__ void phase_gates(const Frame& F, int l) {
    const bf16* cols = (const bf16*)(WSP(F) + WS_COLS); float* GT = (float*)(WSP(F) + WS_GATES);
    LAS bf16* raw = (LAS bf16*)(F.lds);
    LAS bf16* featb = (LAS bf16*)(F.lds + 30720);
    LAS bf16* gwT = (LAS bf16*)(F.lds + 55552);
    LAS float* outp = (LAS float*)(F.lds + 80384);
    const float* gwg = INP(F, 5) + (size_t)l * 768 * 16; const float* gb = INP(F, 6) + l * 16;
    const int tid = F.tid, lane = F.lane, wave = F.wave;
    __syncthreads();
    for (int i = tid; i < 768 * 16; i += 512) gwT[(i & 15) * 776 + (i >> 4)] = (bf16)f2bf(gwg[i]);
    float cw[5]; { const float* cwp = INP(F, 3) + (size_t)l * 5 * 512;
#pragma unroll
        for (int j = 0; j < 5; ++j) cw[j] = cwp[j * 512 + tid]; }
    const float cbv = INP(F, 4)[l * 512 + tid];
    const float gbv = gb[tid & 15];
    for (int tile = F.vcu; tile < M / 16; tile += F.G) {
        const int m0 = tile * 16, t0 = m0 % SEQ;
        __syncthreads();
        for (int ch = tid; ch < 20 * 96; ch += 512) { const int rr = ch / 96, cc = ch % 96; const int t = t0 - 2 + rr;
            v4u v = {0u, 0u, 0u, 0u}; if (t >= 0 && t < SEQ) v = *(const v4u*)(cols + (size_t)(m0 - 2 + rr) * NINP + cc * 8);
            *(LAS v4u*)(raw + rr * 768 + cc * 8) = v; }
        if (tid < 256) outp[tid] = 0.f;
        __syncthreads();
        { float win[5];
#pragma unroll
          for (int j = 0; j < 4; ++j) win[j] = bf2f(raw[j * 768 + tid]);
#pragma unroll 4
          for (int t = 0; t < 16; ++t) { win[4] = bf2f(raw[(t + 4) * 768 + tid]); float s = cbv;
#pragma unroll
              for (int j = 0; j < 5; ++j) s += cw[j] * win[j];
#pragma unroll
              for (int j = 0; j < 4; ++j) win[j] = win[j + 1];
              featb[t * 776 + tid] = (bf16)f2bf(siluf_(s)); }
          const int t = tid >> 5, c8 = tid & 31; *(LAS v4u*)(featb + t * 776 + 512 + c8 * 8) = *(const LAS v4u*)(raw + (t + 2) * 768 + 512 + c8 * 8); }
        __syncthreads();
        { const f32x4 z = {0.f, 0.f, 0.f, 0.f}; const f32x4 acc = mma16<96>(featb + 96 * wave, 776, gwT + 96 * wave, 776, z, lane);
#pragma unroll
          for (int jj = 0; jj < 4; ++jj) __hip_atomic_fetch_add(outp + ((lane >> 4) * 4 + jj) * 16 + (lane & 15), acc[jj], __ATOMIC_RELAXED, __HIP_MEMORY_SCOPE_WORKGROUP); }
        __syncthreads();
        if (tid < 256) { float s = outp[tid] + gbv; if ((tid & 15) >= 8) s = fminf(s, 0.f) - log1pf(__expf(-fabsf(s))); GT[(size_t)(m0 + (tid >> 4)) * 16 + (tid & 15)] = s; }
    }
    __syncthreads();
}
__device__ __forceinline__ f32x4 mma16_a8(const LAS bf16* A8, const LAS bf16* Bt, f32x4 acc, int lane) {
    const int q = lane >> 4;
    const LAS bf16* ap = A8 + (lane & 7) * 72 + q * 8; const LAS bf16* bp = Bt + (lane & 15) * 72 + q * 8;
#pragma unroll
    for (int k0 = 0; k0 < 64; k0 += 32) { const bf16x8 a = *(const LAS bf16x8*)(ap + k0); const bf16x8 b = *(const LAS bf16x8*)(bp + k0); acc = __builtin_amdgcn_mfma_f32_16x16x32_bf16(a, b, acc, 0, 0, 0); }
    return acc;
}
typedef float f32x2 __attribute__((ext_vector_type(2)));
template <bool DIR> __device__ __forceinline__ void rwkv_steps(const LAS float* OPS, const LAS float* VV, LAS float* YB, f32x4& S, int j, int row) {
    float yk0 = 0.f, yk1 = 0.f;
    const LAS float* opb = OPS + 4 * j; const LAS float* vpb = VV + row;
#define RWLD(W_, KK_, KA_, KM_, R_, V_, tl_) do { const LAS float* op_ = opb + (tl_) * 320; W_ = *(const LAS f32x4*)(op_); KK_ = *(const LAS f32x4*)(op_ + 64); KA_ = *(const LAS f32x4*)(op_ + 128); KM_ = *(const LAS f32x4*)(op_ + 192); R_ = *(const LAS f32x4*)(op_ + 256); V_ = vpb[(tl_) * 16]; } while (0)
    f32x4 w4, kk4, ka4, km4, r4, w4b, kk4b, ka4b, km4b, r4b; float vv, vvb;
    RWLD(w4, kk4, ka4, km4, r4, vv, (DIR ? 31 : 0));
    RWLD(w4b, kk4b, ka4b, km4b, r4b, vvb, (DIR ? 30 : 1));
#pragma unroll
    for (int i = 0; i < 32; ++i) {
        f32x4 nw4, nkk4, nka4, nkm4, nr4; float nvv;
        if (i < 30) RWLD(nw4, nkk4, nka4, nkm4, nr4, nvv, (DIR ? 29 - i : i + 2));
        f32x2 t2 = S.xy * kk4.xy; t2 = S.zw * kk4.zw + t2;
        float sa = t2.x + t2.y;
        const f32x4 pre_s = S * w4 + km4 * vv;
        sa = row16_sum(sa);
        S = pre_s + ka4 * sa;
        f32x2 y2 = S.xy * r4.xy; y2 = S.zw * r4.zw + y2;
        float y = y2.x + y2.y;
        y = row16_sum(y);
        if ((i & 15) == j) { if (i < 16) yk0 = y; else yk1 = y; }
        w4 = w4b; kk4 = kk4b; ka4 = ka4b; km4 = km4b; r4 = r4b; vv = vvb;
        if (i < 30) { w4b = nw4; kk4b = nkk4; ka4b = nka4; km4b = nkm4; r4b = nr4; vvb = nvv; } }
#undef RWLD
    YB[(DIR ? 31 - j : j) * 16 + row] = yk0; YB[(DIR ? 15 - j : 16 + j) * 16 + row] = yk1;
}
struct RwCtx { LAS bf16* WA; LAS bf16* WW; LAS bf16* XA; LAS bf16* XW; LAS bf16* RAWB; LAS float* MU; float* CT; const bf16* colsb;
    f32x4 kk_c4, ka_c4, rk_c4; float ba[4], bw[4]; float mup_[5][2], mun_[5][2]; int h, dir, qtr, tb0; size_t mb; };
template <int NTOK> __device__ __forceinline__ void rw_addr_init(int (&poff)[5], int (&prr)[5], int lane, int tb0, int h, int dir) {
    constexpr int NCHK = (NTOK + 2) * 40;
#pragma unroll
    for (int i = 0; i < 5; ++i) { const int idx = lane + 64 * i; const int rr = idx / 40, q = idx % 40, wh = q >> 3, c8 = q & 7;
        const int gc = (wh == 0 ? R_R + h * 64 : wh == 1 ? R_K + h * 64 : wh == 2 ? R_V + h * 64 : wh == 3 ? R_WDF + dir * 64 : R_AD) + c8 * 8;
        prr[i] = idx < NCHK ? tb0 - 1 + rr : -100000; poff[i] = (tb0 - 1 + rr) * NINP + gc; }
}
template <int NTOK> __device__ __forceinline__ void rw_issue(v4u (&pre)[5], const int (&poff)[5], const int (&prr)[5], const bf16* colsb, int T0) {
    constexpr int NCH = ((NTOK + 2) * 40 + 63) / 64;
#pragma unroll
    for (int i = 0; i < NCH; ++i) { const int t = T0 + prr[i]; const bool ok = t >= 0 && t < SEQ;
        const v4u vv = *(const v4u*)(colsb + (size_t)T0 * NINP + (ok ? poff[i] : 0)); pre[i] = ok ? vv : (v4u){0u, 0u, 0u, 0u}; }
}
template <int NTOK, bool FULLV> __device__ __forceinline__ void rw_prep(const RwCtx& C, const v4u (&pre)[5], LAS float* OPS, LAS float* VV, int T0, int lane) {
    constexpr int NCHK = (NTOK + 2) * 40, NCH = (NCHK + 63) / 64;
    const int j = lane & 15, c2 = (lane & 31) * 2;
#pragma unroll
    for (int i = 0; i < NCH; ++i) { const int idx = lane + 64 * i; if (idx < NCHK) *(LAS v4u*)(C.RAWB + idx * 8) = pre[i]; }
    LDS_WAIT(); asm volatile("" ::: "memory");
#pragma unroll
    for (int which = 0; which < 5; ++which)
#pragma unroll
        for (int pr = 0; pr < NTOK / 2; ++pr) { const int tt = 2 * pr + (lane >> 5), cc = which * 64 + c2, t = C.tb0 + tt;
            const unsigned r0 = *(const LAS unsigned*)(C.RAWB + tt * 320 + cc), r1 = *(const LAS unsigned*)(C.RAWB + (tt + 1) * 320 + cc), r2 = *(const LAS unsigned*)(C.RAWB + (tt + 2) * 320 + cc);
            const float p1x = bf2f(r1 & 0xffffu), p1y = bf2f(r1 >> 16);
            const float vx = p1x + C.mup_[which][0] * (bf2f(r0 & 0xffffu) - p1x) + C.mun_[which][0] * (bf2f(r2 & 0xffffu) - p1x);
            const float vy = p1y + C.mup_[which][1] * (bf2f(r0 >> 16) - p1y) + C.mun_[which][1] * (bf2f(r2 >> 16) - p1y);
            if (which == 0) *(LAS f32x2*)(OPS + t * 320 + 256 + c2) = (f32x2){vx, vy};
            else if (which == 1) *(LAS f32x2*)(OPS + t * 320 + 192 + c2) = (f32x2){vx, vy};
            else if (which == 2) { if (FULLV) *(LAS f32x2*)(VV + t * 64 + c2) = (f32x2){vx, vy}; else if ((c2 >> 4) == C.qtr) *(LAS f32x2*)(VV + t * 16 + (c2 & 15)) = (f32x2){vx, vy}; }
            else if (which == 3) { const float ex = __expf(2.f * vx), ey = __expf(2.f * vy);
                *(LAS unsigned*)(C.XW + tt * 72 + c2) = pk2(1.f - 2.f * __builtin_amdgcn_rcpf(ex + 1.f), 1.f - 2.f * __builtin_amdgcn_rcpf(ey + 1.f)); }
            else *(LAS unsigned*)(C.XA + tt * 72 + c2) = pk2(vx, vy); }
    LDS_WAIT(); asm volatile("" ::: "memory");
    { const bool hi = lane >= 32; const int lr = ((lane >> 4) & 1) * 4 + (hi ? 2 : 0); const bool ok0 = lr < NTOK, ok1 = lr + 1 < NTOK; const int tb = C.tb0 + lr;
#pragma unroll
      for (int ct = 0; ct < 4; ++ct) { const f32x4 z = {0.f, 0.f, 0.f, 0.f};
        const f32x4 ca = mma16_a8(C.XA, C.WA + ct * 16 * 72, z, lane), cw = mma16_a8(C.XW, C.WW + ct * 16 * 72, z, lane);
        const int c = ct * 16 + j;
        const float a0v = hi ? ca[2] : ca[0], a1v = hi ? ca[3] : ca[1], w0v = hi ? cw[2] : cw[0], w1v = hi ? cw[3] : cw[1];
        if (ok0) { OPS[tb * 320 + 128 + c] = sigmoidf_(C.ba[ct] + a0v); OPS[tb * 320 + c] = __expf(-0.6065306597f * sigmoidf_(C.bw[ct] + w0v)); }
        if (ok1) { OPS[(tb + 1) * 320 + 128 + c] = sigmoidf_(C.ba[ct] + a1v); OPS[(tb + 1) * 320 + c] = __expf(-0.6065306597f * sigmoidf_(C.bw[ct] + w1v)); } } }
    LDS_WAIT(); asm volatile("" ::: "memory");
#pragma unroll
    for (int ps = 0; ps < (NTOK + 3) / 4; ++ps) { const int tl = 4 * ps + (lane >> 4); const bool ok = tl < NTOK; const int t = C.tb0 + (ok ? tl : 0); LAS float* op = OPS + t * 320 + 4 * j;
        const f32x4 av = *(const LAS f32x4*)(op + 128), kp = *(const LAS f32x4*)(op + 192), rp = *(const LAS f32x4*)(op + 256);
        const f32x4 kr = kp * C.kk_c4; const float ss = row16_sum((kr.x * kr.x + kr.y * kr.y) + (kr.z * kr.z + kr.w * kr.w));
        const f32x4 kkv = kr * (1.f / fmaxf(sqrtf(ss), 1e-12f));
        const f32x4 km = kp * ((av - 1.f) * C.ka_c4 + 1.f);
        const f32x4 q = rp * km * C.rk_c4; const float cs = row16_sum((q.x + q.y) + (q.z + q.w));
        if (ok) { *(LAS f32x4*)(op + 64) = kkv; *(LAS f32x4*)(op + 128) = kkv * (-av); *(LAS f32x4*)(op + 192) = km;
            if (C.dir == 0 && C.qtr == 0 && j == 0) C.CT[(C.mb + T0 + t) * 8 + C.h] = cs; } }
}

constexpr int RW_NSLOT = 6, RW_SLOT_WORDS = 32 * 320 + 32 * 64;
constexpr size_t WS_RING = 248 * MiB;
constexpr int CW_RW = 8192;
__device__ __forceinline__ unsigned rw_ld(unsigned* p) { return __hip_atomic_load(p, __ATOMIC_RELAXED, __HIP_MEMORY_SCOPE_AGENT); }
__device__ __forceinline__ void rw_st(unsigned* p, unsigned v) { __hip_atomic_store(p, v, __ATOMIC_RELAXED, __HIP_MEMORY_SCOPE_AGENT); }
__device__ __forceinline__ void rwkv_produce(const Frame& F, int l, int p, int pp, unsigned G0) {
    const int b = p / 12, rem = p % 12, h = rem >> 1, dir = rem & 1;
    const bf16* cols = (const bf16*)(WSP(F) + WS_COLS);
    const int tid = F.tid, lane = F.lane, wave = F.wave;
    LAS bf16* WA = (LAS bf16*)(F.lds); LAS bf16* WW = (LAS bf16*)(F.lds + 9216);
    LAS float* MU = (LAS float*)(F.lds + 67584);
    LAS float* OPS = (LAS float*)(F.lds + 70144);
    LAS float* VV = (LAS float*)(F.lds + 111104);
    LAS unsigned* flg = (LAS unsigned*)(F.lds + 119296);
    unsigned* ctl = (unsigned*)(WSP(F) + WS_CTL) + CW_RW + 384 * p;
    unsigned long long* ring = (unsigned long long*)(WSP(F) + WS_RING) + (size_t)p * RW_NSLOT * (RW_SLOT_WORDS / 2);
    constexpr int NB = SEQ / 32;
    __syncthreads();
    { const float* aup = INP(F, 13) + (size_t)l * 64 * 384; const float* wup = INP(F, 11) + (size_t)(l * 2 + dir) * 64 * 384;
      for (int idx = tid; idx < 4096; idx += 512) { const int i = idx >> 6, c = idx & 63;
          WA[c * 72 + i] = (bf16)f2bf(aup[i * 384 + h * 64 + c]); WW[c * 72 + i] = (bf16)f2bf(wup[i * 384 + h * 64 + c]); }
      if (tid < 320) { const int which = tid >> 6, c = tid & 63;
          const int rc = which == 0 ? h * 64 + c : which == 1 ? 384 + h * 64 + c : which == 2 ? 768 + h * 64 + c : which == 3 ? 1152 + dir * 64 + c : 1280 + c;
          MU[tid] = INP(F, 8)[l * 1472 + rc]; MU[320 + tid] = INP(F, 9)[l * 1472 + rc]; } }
    __syncthreads();
    const size_t mb = (size_t)b * SEQ;
    const int j = lane & 15;
    RwCtx C;
    C.WA = WA; C.WW = WW; C.XA = (LAS bf16*)(F.lds + 18432) + wave * 576; C.XW = (LAS bf16*)(F.lds + 27648) + wave * 576;
    C.RAWB = (LAS bf16*)(F.lds + 36864) + wave * 1920;
    C.MU = MU; C.CT = (float*)(WSP(F) + WS_CT); C.colsb = cols + mb * NINP; C.h = h; C.dir = dir; C.qtr = 0; C.mb = mb; C.tb0 = 4 * wave;
    { const int hc4 = h * 64 + 4 * j;
      C.kk_c4 = *(const f32x4*)(INP(F, 15) + l * 384 + hc4); C.ka_c4 = *(const f32x4*)(INP(F, 16) + l * 384 + hc4); C.rk_c4 = *(const f32x4*)(INP(F, 17) + l * 384 + hc4);
#pragma unroll
      for (int ct = 0; ct < 4; ++ct) { C.ba[ct] = INP(F, 12)[l * 384 + h * 64 + 16 * ct + j]; C.bw[ct] = INP(F, 10)[(l * 2 + dir) * 384 + h * 64 + 16 * ct + j]; }
      const int c2 = (lane & 31) * 2;
#pragma unroll
      for (int wq = 0; wq < 5; ++wq) { C.mup_[wq][0] = MU[wq * 64 + c2]; C.mup_[wq][1] = MU[wq * 64 + c2 + 1]; C.mun_[wq][0] = MU[320 + wq * 64 + c2]; C.mun_[wq][1] = MU[320 + wq * 64 + c2 + 1]; } }
    v4u pre[5]; int poff[5], prr[5];
    rw_addr_init<4>(poff, prr, lane, C.tb0, h, dir);
    rw_issue<4>(pre, poff, prr, C.colsb, dir ? SEQ - 32 * (pp + 1) : 32 * pp);
    bool dead = false; unsigned mseen = G0;
    unsigned* myflag = ctl + 320 * pp; const unsigned PB = G0 / 2;
#pragma unroll 1
    for (int it = pp; it < NB; it += 2) {
        const int T0 = dir ? SEQ - 32 * (it + 1) : 32 * it;
        v4u cur[5];
#pragma unroll
        for (int i = 0; i < 5; ++i) cur[i] = pre[i];
        if (it + 2 < NB) rw_issue<4>(pre, poff, prr, C.colsb, dir ? SEQ - 32 * (it + 3) : 32 * (it + 2));
        rw_prep<4, true>(C, cur, OPS, VV, T0, lane);
        if (tid == 0) { const unsigned need = G0 + (unsigned)it + 1u; unsigned sp = 0u;
            if (need > (unsigned)RW_NSLOT && !dead) { const unsigned want = need - (unsigned)RW_NSLOT;
                while (mseen < want) { if (++sp > (1u << 17)) { dead = true; break; } __builtin_amdgcn_s_sleep(2);
                    const unsigned m01 = min(rw_ld(ctl + 64), rw_ld(ctl + 128)), m23 = min(rw_ld(ctl + 192), rw_ld(ctl + 256)); mseen = min(m01, m23); } }
            flg[0] = sp; }
        __syncthreads();
        { unsigned long long* slot = ring + (size_t)((G0 + (unsigned)it) % RW_NSLOT) * (RW_SLOT_WORDS / 2);
          const LAS v4u* src = (const LAS v4u*)OPS;
#pragma unroll
          for (int i = 0; i < 6; ++i) { const int idx = tid + 512 * i; const v4u d = src[idx]; v4u* dst = (v4u*)slot + idx;
              asm volatile("global_store_dwordx4 %0, %1, off sc1\n\ts_nop 1" :: "v"(dst), "v"(d) : "memory"); } }
        asm volatile("s_waitcnt vmcnt(10)" ::: "memory");
        __syncthreads();
        if (tid == 0 && it >= 2) rw_st(myflag, PB + (unsigned)(it >> 1));
    }
    asm volatile("s_waitcnt vmcnt(0)" ::: "memory");
    __syncthreads();
    if (tid == 0) rw_st(myflag, PB + (unsigned)(NB / 2));
    __syncthreads();
}
__device__ __forceinline__ void rwkv_scan(const Frame& F, int l, int p, int qtr, unsigned G0) {
    const int b = p / 12, rem = p % 12, h = rem >> 1, dir = rem & 1;
    bf16* Y = (bf16*)(WSP(F) + (dir ? Y_RB : Y_RF));
    const int lane = F.lane, wave = F.wave;
    LAS float* OPSb = (LAS float*)(F.lds);
    LAS float* VVb = (LAS float*)(F.lds + 81920);
    LAS float* YBb = (LAS float*)(F.lds + 86016);
    unsigned* ctl = (unsigned*)(WSP(F) + WS_CTL) + CW_RW + 384 * p;
    const unsigned long long* ring = (const unsigned long long*)(WSP(F) + WS_RING) + (size_t)p * RW_NSLOT * (RW_SLOT_WORDS / 2);
    constexpr int NB = SEQ / 32;
    const size_t mb = (size_t)b * SEQ;
    const int j = lane & 15;
    __syncthreads();
    if (wave < 4) {
        const int lt = wave * 64 + lane;
        bool dead = false; unsigned pseen0 = G0 / 2, pseen1 = G0 / 2;
        unsigned long long va[21], vb[21];
#define RW_FETCH(v_, k_) do { const unsigned need_ = G0 / 2 + (unsigned)((k_) >> 1) + 1u; unsigned sp_ = 0u; unsigned* fl_ = ctl + 320 * ((k_) & 1); \
            if (!dead) { unsigned ps_ = ((k_) & 1) ? pseen1 : pseen0; while (ps_ < need_) { ps_ = rw_ld(fl_); if (ps_ >= need_) break; if (++sp_ > (1u << 17)) { dead = true; break; } __builtin_amdgcn_s_sleep(2); } if ((k_) & 1) pseen1 = ps_; else pseen0 = ps_; } \
            const unsigned long long* slot_ = ring + (size_t)((G0 + (unsigned)(k_)) % RW_NSLOT) * (RW_SLOT_WORDS / 2); \
            _Pragma("unroll") for (int i_ = 0; i_ < 20; ++i_) v_[i_] = __hip_atomic_load(slot_ + lt + 256 * i_, __ATOMIC_RELAXED, __HIP_MEMORY_SCOPE_AGENT); \
            v_[20] = __hip_atomic_load(slot_ + 5120 + (lt >> 3) * 32 + qtr * 8 + (lt & 7), __ATOMIC_RELAXED, __HIP_MEMORY_SCOPE_AGENT); } while (0)
#define RW_LITER(v_, k_) do { if ((k_) >= 1 && lt == 0) rw_st(ctl + 64 * (qtr + 1), G0 + (unsigned)(k_)); \
            if ((k_) < NB) { LAS unsigned long long* dO_ = (LAS unsigned long long*)(OPSb + ((k_) & 1) * 10240); LAS unsigned long long* dV_ = (LAS unsigned long long*)(VVb + ((k_) & 1) * 512); \
                _Pragma("unroll") for (int i_ = 0; i_ < 20; ++i_) dO_[lt + 256 * i_] = v_[i_]; dV_[lt] = v_[20]; \
                if ((k_) + 2 < NB) RW_FETCH(v_, (k_) + 2); } \
            if ((k_) >= 2) { const int bk_ = (k_) - 2; const int T0_ = dir ? SEQ - 32 * (bk_ + 1) : 32 * bk_; const LAS float* YB_ = YBb + (bk_ & 1) * 512; \
                const int idx_ = lt * 2, tl_ = idx_ >> 4, rw_ = idx_ & 15; \
                *(unsigned*)(Y + (mb + T0_ + tl_) * 384 + h * 64 + 16 * qtr + rw_) = pk2(YB_[idx_], YB_[idx_ + 1]); } \
            __syncthreads(); } while (0)
        RW_FETCH(va, 0); RW_FETCH(vb, 1);
#pragma unroll 1
        for (int it = 0; it < NB; it += 2) { RW_LITER(va, it); RW_LITER(vb, it + 1); }
        RW_LITER(va, NB);
#undef RW_FETCH
#undef RW_LITER
        { const int bk = NB - 1; const int T0 = dir ? SEQ - 32 * (bk + 1) : 32 * bk; const LAS float* YB = YBb + (bk & 1) * 512;
          const int idx = lt * 2, tl = idx >> 4, rw = idx & 15;
          *(unsigned*)(Y + (mb + T0 + tl) * 384 + h * 64 + 16 * qtr + rw) = pk2(YB[idx], YB[idx + 1]); }
    } else {
        const int row = (wave - 4) * 4 + (lane >> 4);
        f32x4 S = {0.f, 0.f, 0.f, 0.f};
#pragma unroll 1
        for (int it = 0; it <= NB; ++it) {
            if (it >= 1) { const int bk = it - 1;
                const LAS float* OPS = OPSb + (bk & 1) * 10240; const LAS float* VV = VVb + (bk & 1) * 512; LAS float* YB = YBb + (bk & 1) * 512;
                if (dir) rwkv_steps<true>(OPS, VV, YB, S, j, row); else rwkv_steps<false>(OPS, VV, YB, S, j, row);
            }
            __syncthreads();
        }
    }
    __syncthreads();
}
__device__ __forceinline__ float row8_sum(float v) { v += dppf<0xB1>(v); v += dppf<0x4E>(v); v += dppf<0x141>(v); return v; }
__device__ __forceinline__ void mlstm_seq(const Frame& F, int l, int task, int cfull0, int cend) {
    const int b = task >> 3, h = (task >> 1) & 3, dir = task & 1;
    const bf16* cols = (const bf16*)(WSP(F) + WS_COLS); const float* GT = (const float*)(WSP(F) + WS_GATES);
    bf16* Y = (bf16*)(WSP(F) + (dir ? Y_AB : Y_AF));
    LAS bf16* RAWQ = (LAS bf16*)(F.lds);
    LAS bf16* Qs = (LAS bf16*)(F.lds + 17408); LAS bf16* Ks = (LAS bf16*)(F.lds + 26624);
    LAS bf16* Vtb = (LAS bf16*)(F.lds + 35840);
    LAS bf16* KWt = (LAS bf16*)(F.lds + 54272); LAS bf16* Ps = (LAS bf16*)(F.lds + 63488);
    LAS bf16* Ctb = (LAS bf16*)(F.lds + 72704);
    LAS float* ub = (LAS float*)(F.lds + 91136);
    LAS float* blb = ub + 128; LAS float* rmb = ub + 256;
    LAS float* den = ub + 384; LAS float* qn = ub + 448; LAS float* nst = ub + 512; LAS float* scb = ub + 576;
    const int tid = F.tid, lane = F.lane, wave = F.wave;
    const size_t mb = (size_t)b * SEQ;
    constexpr int NC = SEQ / 64;
    __syncthreads();
    for (int i = tid; i < 2 * 64 * 72; i += 512) Ctb[i] = 0;
    if (tid < 64) nst[tid] = 0.f;
    const int cc = tid & 127, isK = cc >> 6, d0 = cc & 63, chn = isK * 256 + h * 64 + d0;
    float cw[5]; const float* cwp = INP(F, 3) + (size_t)l * 5 * 512;
#pragma unroll
    for (int jj = 0; jj < 5; ++jj) cw[jj] = cwp[jj * 512 + chn];
    const float cbv = INP(F, 4)[l * 512 + chn];
    f32x4 st[2] = {{0.f, 0.f, 0.f, 0.f}, {0.f, 0.f, 0.f, 0.f}};
    float m_st = 0.f;
    v4u pre[3], prev; float gli = 0.f, glf = 0.f;
#define ML_ISSUE(c_) do { const int tlo_ = dir ? SEQ - 64 * ((c_) + 1) : 64 * (c_); _Pragma("unroll") for (int i_ = 0; i_ < 3; ++i_) { const int ch_ = tid + 512 * i_; pre[i_] = (v4u){0u, 0u, 0u, 0u}; \
        if (ch_ < 68 * 16) { const int rr_ = ch_ >> 4, q_ = ch_ & 15; const int t_ = tlo_ - 2 + rr_; if (t_ >= 0 && t_ < SEQ) pre[i_] = *(const v4u*)(cols + (mb + t_) * NINP + (q_ >> 3) * 256 + h * 64 + (q_ & 7) * 8); } } \
        prev = *(const v4u*)(cols + (mb + tlo_ + (tid >> 3)) * NINP + A_V + h * 64 + (tid & 7) * 8); \
        if (tid < 64) { const int t_ = dir ? tlo_ + 63 - tid : tlo_ + tid; gli = GT[(mb + t_) * 16 + dir * 4 + h]; glf = GT[(mb + t_) * 16 + 8 + dir * 4 + h]; } } while (0)
#define ML_FILL(c_) do { _Pragma("unroll") for (int i_ = 0; i_ < 3; ++i_) { const int ch_ = tid + 512 * i_; if (ch_ < 68 * 16) *(LAS v4u*)(RAWQ + (ch_ >> 4) * 128 + (ch_ & 15) * 8) = pre[i_]; } \
        { LAS bf16* Vt_ = Vtb + ((c_) & 1) * 4608; const int tl_ = tid >> 3, e8_ = tid & 7; const int lp_ = dir ? 63 - tl_ : tl_; const unsigned w_[4] = {prev.x, prev.y, prev.z, prev.w}; \
          _Pragma("unroll") for (int k_ = 0; k_ < 4; ++k_) { const int e_ = e8_ * 8 + 2 * k_; Vt_[e_ * 72 + swz64(e_, lp_)] = (bf16)(w_[k_] & 0xffffu); Vt_[(e_ + 1) * 72 + swz64(e_ + 1, lp_)] = (bf16)(w_[k_] >> 16); } } \
        if (tid < 64) { const float bl_ = wave_scan_add(glf); \
            const float u_ = gli - bl_; const float rm_ = wave_scan_max(u_); \
            ub[((c_) & 1) * 64 + tid] = u_; blb[((c_) & 1) * 64 + tid] = bl_; rmb[((c_) & 1) * 64 + tid] = rm_; if (tid == 63) { scb[((c_) & 1) * 2] = rm_; scb[((c_) & 1) * 2 + 1] = bl_; } } } while (0)
    ML_ISSUE(0); ML_FILL(0); ML_ISSUE(1);
    __syncthreads();
    if (cfull0 > 0) {
        const int dk = tid & 63; float cwk[5]; { const float* cwq = INP(F, 3) + (size_t)l * 5 * 512;
#pragma unroll
            for (int jj = 0; jj < 5; ++jj) cwk[jj] = cwq[jj * 512 + 256 + h * 64 + dk]; }
        const float cbk = INP(F, 4)[l * 512 + 256 + h * 64 + dk];
#pragma unroll 1
        for (int c = 0; c < cfull0; ++c) {
            const LAS float* u = ub + (c & 1) * 64;
            const LAS bf16* Vt = Vtb + (c & 1) * 4608; LAS bf16* Ctn = Ctb + ((c + 1) & 1) * 4608;
            const float umax = scb[(c & 1) * 2], tot = scb[(c & 1) * 2 + 1];
#pragma unroll 2
            for (int i = 0; i < 8; ++i) { const int tl = (tid >> 6) + 8 * i; float s = cbk;
#pragma unroll
                for (int jj = 0; jj < 5; ++jj) s += cwk[jj] * bf2f(RAWQ[(tl + jj) * 128 + 64 + dk]);
                const int lp = dir ? 63 - tl : tl;
                KWt[dk * 72 + swz64(dk, lp)] = (bf16)f2bf(siluf_(s) * 0.125f * __expf(u[lp] - umax)); }
            __syncthreads();
            const float mmax = fmaxf(m_st, umax), s_old = __expf(m_st - mmax), s_new = __expf(umax - mmax);
#pragma unroll
            for (int k = 0; k < 2; ++k) { const int ti = 2 * wave + k, t0_ = ti >> 2, t1_ = ti & 3; const f32x4 z = {0.f, 0.f, 0.f, 0.f};
                const f32x4 lc = mma16s<true, true>(Vt, 72, t0_ * 16, KWt, 72, t1_ * 16, z, lane);
#pragma unroll
                for (int jj = 0; jj < 4; ++jj) { const int r_ = t0_ * 16 + (lane >> 4) * 4 + jj, c_ = t1_ * 16 + (lane & 15);
                    st[k][jj] = s_old * st[k][jj] + s_new * lc[jj]; Ctn[r_ * 72 + c_] = (bf16)f2bf(st[k][jj]); } }
            { const int dq = tid >> 3, part = tid & 7; float s = 0.f;
#pragma unroll
              for (int k = 0; k < 8; ++k) s += bf2f(KWt[dq * 72 + swz64(dq, part * 8) + k]);
              s = row8_sum(s); if (part == 0) nst[dq] = s_old * nst[dq] + s_new * s; }
            m_st = tot + mmax;
            ML_FILL(c + 1); if (c + 2 < cend) ML_ISSUE(c + 2);
            __syncthreads();
        }
    }
#pragma unroll 1
    for (int c = cfull0; c < cend; ++c) {
        const bool full = c >= cfull0;
        const int tlo = dir ? SEQ - 64 * (c + 1) : 64 * c;
        const LAS float* u = ub + (c & 1) * 64; const LAS float* bl = blb + (c & 1) * 64; const LAS float* rm = rmb + (c & 1) * 64;
        const LAS bf16* Vt = Vtb + (c & 1) * 4608; const LAS bf16* Ct = Ctb + (c & 1) * 4608; LAS bf16* Ctn = Ctb + ((c + 1) & 1) * 4608;
#pragma unroll 4
        for (int i = 0; i < 16; ++i) { const int tl = (tid >> 7) + 4 * i; float s = cbv;
#pragma unroll
            for (int jj = 0; jj < 5; ++jj) s += cw[jj] * bf2f(RAWQ[(tl + jj) * 128 + cc]);
            s = siluf_(s); const int lpos = dir ? 63 - tl : tl;
            if (isK) Ks[lpos * 72 + d0] = (bf16)f2bf(s * 0.125f); else Qs[lpos * 72 + d0] = (bf16)f2bf(s); }
        if (tid < 64) den[tid] = 0.f;
        __syncthreads();
        const float umax = scb[(c & 1) * 2], tot = scb[(c & 1) * 2 + 1];
        for (int idx = tid; idx < 4096; idx += 512) { const int lp = idx >> 6, d = idx & 63; KWt[d * 72 + swz64(d, lp)] = (bf16)f2bf(bf2f(Ks[lp * 72 + d]) * __expf(u[lp] - umax)); }
        if (full) {
#pragma unroll
        for (int k = 0; k < 2; ++k) { const int ti = 2 * wave + k, tl_ = ti >> 2, ts = ti & 3; f32x4 acc = {0.f, 0.f, 0.f, 0.f};
            if (ts <= tl_) acc = mma16<64>(Qs + tl_ * 16 * 72, 72, Ks + ts * 16 * 72, 72, acc, lane);
#pragma unroll
            for (int jj = 0; jj < 4; ++jj) { const int lr = tl_ * 16 + (lane >> 4) * 4 + jj, s = ts * 16 + (lane & 15);
                const float v = (s <= lr) ? acc[jj] * __expf(u[s] - fmaxf(m_st, rm[lr])) : 0.f; const unsigned vb = f2bf(v); Ps[lr * 72 + s] = (bf16)vb;
                if (ts <= tl_) { const float rs = row16_sum(bf2f(vb)); if ((lane & 15) == 0) __hip_atomic_fetch_add(den + lr, rs, __ATOMIC_RELAXED, __HIP_MEMORY_SCOPE_WORKGROUP); } } }
        { const int lq = tid >> 3, part = tid & 7; float s = 0.f;
#pragma unroll
          for (int k = 0; k < 8; ++k) s += bf2f(Qs[lq * 72 + part * 8 + k]) * nst[part * 8 + k];
          s = row8_sum(s); if (part == 0) qn[lq] = s; }
        }
        __syncthreads();
        const float mmax = fmaxf(m_st, umax), s_old = __expf(m_st - mmax), s_new = __expf(umax - mmax);
#pragma unroll
        for (int k = 0; k < 2; ++k) { const int ti = 2 * wave + k, t0_ = ti >> 2, t1_ = ti & 3; const f32x4 z = {0.f, 0.f, 0.f, 0.f};
            f32x4 a1 = z, a2 = z;
            if (full) { a1 = mma16s<false, true>(Ps, 72, t0_ * 16, Vt, 72, t1_ * 16, z, lane); a2 = mma16<64>(Qs + t0_ * 16 * 72, 72, Ct + t1_ * 16 * 72, 72, z, lane); }
            const f32x4 lc = mma16s<true, true>(Vt, 72, t0_ * 16, KWt, 72, t1_ * 16, z, lane);
#pragma unroll
            for (int jj = 0; jj < 4; ++jj) { const int r_ = t0_ * 16 + (lane >> 4) * 4 + jj, c_ = t1_ * 16 + (lane & 15);
                if (full) { const float mx = fmaxf(m_st, rm[r_]), iwv = __expf(m_st - mx);
                const float dn = den[r_] + iwv * qn[r_];
                const float val = (a1[jj] + iwv * a2[jj]) / fmaxf(fabsf(dn), __expf(-(bl[r_] + mx)));
                const int t = dir ? tlo + 63 - r_ : tlo + r_;
                Y[(mb + t) * 256 + h * 64 + c_] = (bf16)f2bf(val); }
                st[k][jj] = s_old * st[k][jj] + s_new * lc[jj];
                Ctn[r_ * 72 + c_] = (bf16)f2bf(st[k][jj]); } }
        { const int dq = tid >> 3, part = tid & 7; float s = 0.f;
#pragma unroll
          for (int k = 0; k < 8; ++k) s += bf2f(KWt[dq * 72 + swz64(dq, part * 8) + k]);
          s = row8_sum(s); if (part == 0) nst[dq] = s_old * nst[dq] + s_new * s; }
        m_st = tot + mmax;
        if (c + 1 < cend) { ML_FILL(c + 1); if (c + 2 < cend) ML_ISSUE(c + 2); }
        __syncthreads();
    }
#undef ML_ISSUE
#undef ML_FILL
}
__device__ __forceinline__ void phase_ssd_conv(const Frame& F, int l) {
    const bf16* cols = (const bf16*)(WSP(F) + WS_COLS); bf16* XBC = (bf16*)(WSP(F) + WS_XN);
    LAS bf16* raw = (LAS bf16*)(F.lds);
    const float* cwp = INP(F, 20) + (size_t)l * 5 * 896; const float* cbp = INP(F, 21) + l * 896;
    const int tid = F.tid;
    float cw0[5], cw1[5]; const int c1 = tid + 512 < 896 ? tid + 512 : tid;
#pragma unroll
    for (int jj = 0; jj < 5; ++jj) { cw0[jj] = cwp[jj * 896 + tid]; cw1[jj] = cwp[jj * 896 + c1]; }
    const float cb0 = cbp[tid], cb1 = cbp[c1];
    float* DTV = (float*)(WSP(F) + WS_DTV); const float* dtbp = INP(F, 22) + l * 12;
    for (int tile = F.vcu; tile < M / 32; tile += F.G) {
        const int m0 = tile * 32, t0 = m0 % SEQ;
        __syncthreads();
        if (tid < 384) { const int tt = tid / 12, k = tid % 12; const float x = bf2f(cols[(size_t)(m0 + tt) * NINP + S_DT + k]) + dtbp[k]; DTV[(size_t)(m0 + tt) * 12 + k] = x > 20.f ? x : log1pf(__expf(x)); }
        for (int ch = tid; ch < 36 * 112; ch += 512) { const int rr = ch / 112, cc = ch % 112; const int t = t0 - 2 + rr;
            v4u v = {0u, 0u, 0u, 0u}; if (t >= 0 && t < SEQ) v = *(const v4u*)(cols + (size_t)(m0 - 2 + rr) * NINP + S_X + cc * 8);
            *(LAS v4u*)(raw + rr * 896 + cc * 8) = v; }
        __syncthreads();
#pragma unroll
        for (int half = 0; half < 2; ++half) { const int c = half ? c1 : tid; if (half && tid + 512 >= 896) break;
            float win[5];
#pragma unroll
            for (int jj = 0; jj < 4; ++jj) win[jj] = bf2f(raw[jj * 896 + c]);
            for (int tl = 0; tl < 32; ++tl) { win[4] = bf2f(raw[(tl + 4) * 896 + c]);
                float s = half ? cb1 : cb0;
#pragma unroll
                for (int jj = 0; jj < 5; ++jj) s += (half ? cw1[jj] : cw0[jj]) * win[jj];
#pragma unroll
                for (int jj = 0; jj < 4; ++jj) win[jj] = win[jj + 1];
                XBC[(size_t)(m0 + tl) * 896 + c] = (bf16)f2bf(siluf_(s)); } }
    }
    __syncthreads();
}
__device__ __forceinline__ void ssd_seq(const Frame& F, int l, int task, int cfull0, int cend) {
    const int b = task / 12, rem = task % 12, head = rem >> 1, dir = rem & 1, g = head / 3;
    const bf16* cols = (const bf16*)(WSP(F) + WS_COLS); const bf16* XBC = (const bf16*)(WSP(F) + WS_XN);
    bf16* Y = (bf16*)(WSP(F) + (dir ? Y_SB : Y_SF));
    LAS bf16* Cm = (LAS bf16*)(F.lds); LAS bf16* Bm = (LAS bf16*)(F.lds + 17408);
    LAS bf16* Btw = (LAS bf16*)(F.lds + 34816); LAS bf16* Xt = (LAS bf16*)(F.lds + 53248);
    LAS bf16* Ps = (LAS bf16*)(F.lds + 62464); LAS bf16* Hs = (LAS bf16*)(F.lds + 71680);
    LAS float* dtvb = (LAS float*)(F.lds + 89088);
    LAS float* acsb = dtvb + 128;
    LAS float* totb = dtvb + 256;
    const int tid = F.tid, lane = F.lane, wave = F.wave;
    const size_t mb = (size_t)b * SEQ;
    constexpr int NC = SEQ / 64;
    __syncthreads();
    for (int i = tid; i < 64 * 136; i += 512) Hs[i] = 0;
    const float* DTV = (const float*)(WSP(F) + WS_DTV);
    const float aneg = -__expf(INP(F, 23)[(l * 2 + dir) * 6 + head]);
    f32x4 st[4];
#pragma unroll
    for (int k = 0; k < 4; ++k) st[k] = (f32x4){0.f, 0.f, 0.f, 0.f};
    v4u pre[5]; float dtraw = 0.f;
#define SSD_ISSUE(c_) do { const int tlo_ = dir ? SEQ - 64 * ((c_) + 1) : 64 * (c_); _Pragma("unroll") for (int i_ = 0; i_ < 5; ++i_) { const int idx_ = tid + 512 * i_; const int tl_ = idx_ / 40, q_ = idx_ % 40; \
        const int gc_ = q_ < 8 ? head * 64 + q_ * 8 : (q_ < 24 ? 384 + g * 128 + (q_ - 8) * 8 : 640 + g * 128 + (q_ - 24) * 8); \
        pre[i_] = *(const v4u*)(XBC + (mb + tlo_ + tl_) * 896 + gc_); } } while (0)
#define SSD_DTLOAD(c_) do { if (tid < 64) { const int tlo_ = dir ? SEQ - 64 * ((c_) + 1) : 64 * (c_); const int t_ = dir ? tlo_ + 63 - tid : tlo_ + tid; dtraw = DTV[(mb + t_) * 12 + dir * 6 + head]; } } while (0)
#define SSD_DTCALC(c_) do { if (tid < 64) { const float dt_ = dtraw; float cs_ = dt_ * aneg; \
        cs_ = wave_scan_add(cs_); \
        const float tt_ = __builtin_bit_cast(float, __builtin_amdgcn_readlane(__builtin_bit_cast(int, cs_), 63)); dtvb[((c_) & 1) * 64 + tid] = dt_; acsb[((c_) & 1) * 64 + tid] = cs_; if (tid == 0) totb[(c_) & 1] = tt_; } } while (0)
    int lgo[3], llp[3], lq[3]; v4u prel[3];
#pragma unroll
    for (int i = 0; i < 3; ++i) { const int idx = tid + 512 * i; const int tl = idx / 24, q = idx % 24; lq[i] = q; llp[i] = dir ? 63 - tl : tl;
        lgo[i] = tl * 896 + (q < 8 ? head * 64 + q * 8 : 384 + g * 128 + (q - 8) * 8); }
#define SSD_ISSUE_L(dst_, c_) do { const int tlo_ = dir ? SEQ - 64 * ((c_) + 1) : 64 * (c_); const bf16* b_ = XBC + (mb + tlo_) * 896; _Pragma("unroll") for (int i_ = 0; i_ < 3; ++i_) dst_[i_] = *(const v4u*)(b_ + lgo[i_]); } while (0)
    v4u preN[3];
    if (cfull0 > 0) { SSD_ISSUE_L(prel, 0); if (cfull0 > 1) SSD_ISSUE_L(preN, 1); } else SSD_ISSUE(0);
    SSD_DTLOAD(0); SSD_DTCALC(0); SSD_DTLOAD(1);
    __syncthreads();
    if (cfull0 > 0) {
#pragma unroll 1
        for (int c = 0; c < cfull0; ++c) {
            LAS bf16* Xl = (c & 1) ? (LAS bf16*)(F.lds + 92160) : Xt; LAS bf16* Bl = (c & 1) ? (LAS bf16*)(F.lds + 101376) : Btw;
            const LAS float* dtv = dtvb + (c & 1) * 64; const LAS float* acs = acsb + (c & 1) * 64; const float tot = totb[c & 1];
#pragma unroll
            for (int i = 0; i < 3; ++i) { const int q = lq[i], lp = llp[i];
                const unsigned w[4] = {prel[i].x, prel[i].y, prel[i].z, prel[i].w};
                if (q < 8) {
#pragma unroll
                    for (int k = 0; k < 4; ++k) { const int p0 = q * 8 + 2 * k; Xl[p0 * 72 + swz64(p0, lp)] = (bf16)(w[k] & 0xffffu); Xl[(p0 + 1) * 72 + swz64(p0 + 1, lp)] = (bf16)(w[k] >> 16); } }
                else { const int n0 = (q - 8) * 8; const float sc = dtv[lp] * __expf(tot - acs[lp]);
#pragma unroll
                    for (int k = 0; k < 4; ++k) { const int nn = n0 + 2 * k; Bl[nn * 72 + swz64(nn, lp)] = (bf16)f2bf(bf2f(w[k] & 0xffffu) * sc); Bl[(nn + 1) * 72 + swz64(nn + 1, lp)] = (bf16)f2bf(bf2f(w[k] >> 16) * sc); } } }
            if (c + 1 < cfull0) {
#pragma unroll
                for (int i = 0; i < 3; ++i) prel[i] = preN[i];
                if (c + 2 < cfull0) SSD_ISSUE_L(preN, c + 2); }
            else SSD_ISSUE(c + 1);
            SSD_DTCALC(c + 1); if (c + 2 < cend) SSD_DTLOAD(c + 2);
            __syncthreads();
            const float cdec = __expf(tot);
#pragma unroll
            for (int k = 0; k < 4; ++k) { const int ti = 4 * wave + k, tp = ti >> 3, tn = ti & 7; const f32x4 z = {0.f, 0.f, 0.f, 0.f};
                const f32x4 lcv = mma16s<true, true>(Xl, 72, tp * 16, Bl, 72, tn * 16, z, lane);
                st[k] = st[k] * cdec + lcv; }
        }
#pragma unroll
        for (int k = 0; k < 4; ++k) { const int ti = 4 * wave + k, tp = ti >> 3, tn = ti & 7;
#pragma unroll
            for (int jj = 0; jj < 4; ++jj) { const int p = tp * 16 + (lane >> 4) * 4 + jj, n = tn * 16 + (lane & 15); Hs[p * 136 + n] = (bf16)f2bf(st[k][jj]); } }
        __syncthreads();
    }
#pragma unroll 1
    for (int c = cfull0; c < cend; ++c) {
        const bool full = c >= cfull0;
        const int tlo = dir ? SEQ - 64 * (c + 1) : 64 * c;
        const LAS float* dtv = dtvb + (c & 1) * 64; const LAS float* acs = acsb + (c & 1) * 64; const float tot = totb[c & 1];
#pragma unroll
        for (int i = 0; i < 5; ++i) { const int idx = tid + 512 * i; const int tl = idx / 40, q = idx % 40; const int lp = dir ? 63 - tl : tl;
            const unsigned w[4] = {pre[i].x, pre[i].y, pre[i].z, pre[i].w};
            if (q < 8) {
#pragma unroll
                for (int k = 0; k < 4; ++k) { const int p0 = q * 8 + 2 * k; Xt[p0 * 72 + swz64(p0, lp)] = (bf16)(w[k] & 0xffffu); Xt[(p0 + 1) * 72 + swz64(p0 + 1, lp)] = (bf16)(w[k] >> 16); } }
            else if (q < 24) { const int n0 = (q - 8) * 8; if (full) *(LAS v4u*)(Bm + lp * 136 + n0) = pre[i]; const float sc = dtv[lp] * __expf(tot - acs[lp]);
#pragma unroll
                for (int k = 0; k < 4; ++k) { const int nn = n0 + 2 * k; Btw[nn * 72 + swz64(nn, lp)] = (bf16)f2bf(bf2f(w[k] & 0xffffu) * sc); Btw[(nn + 1) * 72 + swz64(nn + 1, lp)] = (bf16)f2bf(bf2f(w[k] >> 16) * sc); } }
            else if (full) { const int n0 = (q - 24) * 8; *(LAS v4u*)(Cm + lp * 136 + n0) = pre[i]; } }
        if (c + 1 < cend) SSD_ISSUE(c + 1);
        __syncthreads();
        f32x4 yo[2] = {{0.f, 0.f, 0.f, 0.f}, {0.f, 0.f, 0.f, 0.f}}, lc[4];
        if (full) {
#pragma unroll
        for (int k = 0; k < 2; ++k) { const int ti = 2 * wave + k, tl_ = ti >> 2, ts = ti & 3; f32x4 acc = {0.f, 0.f, 0.f, 0.f};
            if (ts <= tl_) acc = mma16<128>(Cm + tl_ * 16 * 136, 136, Bm + ts * 16 * 136, 136, acc, lane);
#pragma unroll
            for (int jj = 0; jj < 4; ++jj) { const int lr = tl_ * 16 + (lane >> 4) * 4 + jj, s = ts * 16 + (lane & 15);
                const float v = (s <= lr) ? acc[jj] * __expf(acs[lr] - acs[s]) * dtv[s] : 0.f; Ps[lr * 72 + s] = (bf16)f2bf(v); }
            const f32x4 z = {0.f, 0.f, 0.f, 0.f};
            yo[k] = mma16<128>(Cm + tl_ * 16 * 136, 136, Hs + ts * 16 * 136, 136, z, lane); }
        }
#pragma unroll
        for (int k = 0; k < 4; ++k) { const int ti = 4 * wave + k, tp = ti >> 3, tn = ti & 7; const f32x4 z = {0.f, 0.f, 0.f, 0.f};
            lc[k] = mma16s<true, true>(Xt, 72, tp * 16, Btw, 72, tn * 16, z, lane); }
        __syncthreads();
        const float cdec = __expf(tot);
        if (full) {
#pragma unroll
        for (int k = 0; k < 2; ++k) { const int ti = 2 * wave + k, tl_ = ti >> 2, tp = ti & 3; const f32x4 z = {0.f, 0.f, 0.f, 0.f};
            const f32x4 yd = mma16s<false, true>(Ps, 72, tl_ * 16, Xt, 72, tp * 16, z, lane);
#pragma unroll
            for (int jj = 0; jj < 4; ++jj) { const int lr = tl_ * 16 + (lane >> 4) * 4 + jj, p = tp * 16 + (lane & 15);
                const float val = yd[jj] + yo[k][jj] * __expf(acs[lr]);
                const int t = dir ? tlo + 63 - lr : tlo + lr;
                Y[(mb + t) * 384 + head * 64 + p] = (bf16)f2bf(val); } }
        }
#pragma unroll
        for (int k = 0; k < 4; ++k) { const int ti = 4 * wave + k, tp = ti >> 3, tn = ti & 7;
#pragma unroll
            for (int jj = 0; jj < 4; ++jj) { const int p = tp * 16 + (lane >> 4) * 4 + jj, n = tn * 16 + (lane & 15);
                st[k][jj] = cdec * st[k][jj] + lc[k][jj]; Hs[p * 136 + n] = (bf16)f2bf(st[k][jj]); } }
        if (c + 1 < cend) { SSD_DTCALC(c + 1); if (c + 2 < cend) SSD_DTLOAD(c + 2); }
        __syncthreads();
    }
#undef SSD_ISSUE
#undef SSD_ISSUE_L
#undef SSD_DTLOAD
#undef SSD_DTCALC
}
__device__ __forceinline__ float wave_sum2(float v) { v = row16_sum(v); v += __shfl_xor(v, 16); v += __shfl_xor(v, 32); return v; }
__device__ __forceinline__ f32x4 bf4(v2u w) { return (f32x4){bf2f(w.x & 0xffffu), bf2f(w.x >> 16), bf2f(w.y & 0xffffu), bf2f(w.y >> 16)}; }
__device__ __forceinline__ v2u pk4(f32x4 v) { v2u w; w.x = pk2(v.x, v.y); w.y = pk2(v.z, v.w); return w; }
__device__ __forceinline__ void phase_post(const Frame& F, int l) {
    const bf16* cols = (const bf16*)(WSP(F) + WS_COLS); bf16* MIX = (bf16*)(WSP(F) + WS_XN);
    const bf16* YAf = (const bf16*)(WSP(F) + Y_AF); const bf16* YAb = (const bf16*)(WSP(F) + Y_AB);
    const bf16* YRf = (const bf16*)(WSP(F) + Y_RF); const bf16* YRb = (const bf16*)(WSP(F) + Y_RB);
    const bf16* YSf = (const bf16*)(WSP(F) + Y_SF); const bf16* YSb = (const bf16*)(WSP(F) + Y_SB);
    const float* CT = (const float*)(WSP(F) + WS_CT);
    LAS bf16* GU = (LAS bf16*)(F.lds);
    LAS bf16* SG = (LAS bf16*)(F.lds + 104448);
    LAS float* gate = (LAS float*)(F.lds + 108800);
    LAS float* SCW = (LAS float*)(F.lds + 133632);
    const int tid = F.tid, lane = F.lane, wave = F.wave;
    const float* mup = INP(F, 8) + l * 1472; const float* mun = INP(F, 9) + l * 1472;
    const float* sdk = INP(F, 24) + l * 6;
    __syncthreads();
    { const bf16* gut = (const bf16*)(WSP(F) + WS_GUT); for (int ch = tid; ch < 384 * 16; ch += 512) { const int c = ch >> 4, q = ch & 15; *(LAS v4u*)(GU + c * 136 + q * 8) = *(const v4u*)(gut + c * 128 + q * 8); } }
    { const float* scw = INP(F, 20) + (size_t)l * 5 * 896; for (int idx = tid; idx < 5 * 384; idx += 512) SCW[idx] = scw[(idx / 384) * 896 + (idx % 384)]; }
    const int gch = tid & 15;
    float gmp[8], gmn[8];
#pragma unroll
    for (int k = 0; k < 8; ++k) { gmp[k] = mup[1344 + 8 * gch + k]; gmn[k] = mun[1344 + 8 * gch + k]; }
    const int qa = lane, qb = 64 + (lane & 31);
    const f32x4 mng4 = *(const f32x4*)(INP(F, 7) + l * 256 + 4 * qa);
    f32x4 rmp[2], rmn[2], rng[2], rnb[2], scb[2], sng[2];
#pragma unroll
    for (int ps = 0; ps < 2; ++ps) { const int c0 = 4 * (ps ? qb : qa);
        rmp[ps] = *(const f32x4*)(mup + 768 + c0); rmn[ps] = *(const f32x4*)(mun + 768 + c0);
        rng[ps] = *(const f32x4*)(INP(F, 18) + l * 384 + c0); rnb[ps] = *(const f32x4*)(INP(F, 19) + l * 384 + c0);
        scb[ps] = *(const f32x4*)(INP(F, 21) + l * 896 + c0); sng[ps] = *(const f32x4*)(INP(F, 25) + l * 384 + c0); }
    for (int tile = F.vcu; tile < M / 16; tile += F.G) {
        const int m0 = tile * 16;
        __syncthreads();
        if (tid < 256) { const int tt = tid >> 4; const int m = m0 + tt, t = m % SEQ; const bf16* cp = cols + (size_t)m * NINP + R_GD + 8 * gch;
            const v4u c1 = *(const v4u*)cp; v4u c0 = {0u, 0u, 0u, 0u}, c2 = {0u, 0u, 0u, 0u};
            if (t > 0) c0 = *(const v4u*)(cp - NINP); if (t < SEQ - 1) c2 = *(const v4u*)(cp + NINP);
            const unsigned w0[4] = {c0.x, c0.y, c0.z, c0.w}, w1[4] = {c1.x, c1.y, c1.z, c1.w}, w2[4] = {c2.x, c2.y, c2.z, c2.w}; unsigned o[4];
#pragma unroll
            for (int k = 0; k < 4; ++k) { const float a1 = bf2f(w1[k] & 0xffffu), b1 = bf2f(w1[k] >> 16);
                const float va = a1 + gmp[2 * k] * (bf2f(w0[k] & 0xffffu) - a1) + gmn[2 * k] * (bf2f(w2[k] & 0xffffu) - a1);
                const float vb = b1 + gmp[2 * k + 1] * (bf2f(w0[k] >> 16) - b1) + gmn[2 * k + 1] * (bf2f(w2[k] >> 16) - b1);
                o[k] = pk2(sigmoidf_(va), sigmoidf_(vb)); }
            *(LAS v4u*)(SG + tt * 136 + 8 * gch) = (v4u){o[0], o[1], o[2], o[3]}; }
        __syncthreads();
#pragma unroll
        for (int k = 0; k < 3; ++k) { const int ct = wave + 8 * k; const f32x4 z = {0.f, 0.f, 0.f, 0.f};
            const f32x4 acc = mma16<128>(SG, 136, GU + ct * 16 * 136, 136, z, lane);
#pragma unroll
            for (int jj = 0; jj < 4; ++jj) gate[((lane >> 4) * 4 + jj) * 388 + ct * 16 + (lane & 15)] = acc[jj]; }
        __syncthreads();
#pragma unroll 1
        for (int k = 0; k < 2; ++k) { const int tt = wave * 2 + k; const int m = m0 + tt, t = m % SEQ; const size_t cr = (size_t)m * NINP;
            { const int c0 = 4 * qa;
              const f32x4 hs = bf4(*(const v2u*)(YAf + (size_t)m * 256 + c0)) + bf4(*(const v2u*)(YAb + (size_t)m * 256 + c0));
              const float mean = row16_sum((hs.x + hs.y) + (hs.z + hs.w)) * (1.f / 64.f); const f32x4 d = hs - mean;
              const float var = row16_sum((d.x * d.x + d.y * d.y) + (d.z * d.z + d.w * d.w)) * (1.f / 64.f);
              const f32x4 o = bf4(*(const v2u*)(cols + cr + A_O + c0));
              f32x4 y = d * (1.f / sqrtf(var + 1e-6f)) * mng4;
              y.x *= sigmoidf_(o.x); y.y *= sigmoidf_(o.y); y.z *= sigmoidf_(o.z); y.w *= sigmoidf_(o.w);
              *(v2u*)(MIX + (size_t)m * DM + c0) = pk4(y); }
#pragma unroll
            for (int ps = 0; ps < 2; ++ps) { const int qd = ps ? qb : qa, c0 = 4 * qd; const bool act = ps == 0 || lane < 32;
              const f32x4 ys = bf4(*(const v2u*)(YRf + (size_t)m * 384 + c0)) + bf4(*(const v2u*)(YRb + (size_t)m * 384 + c0));
              const float mean = row16_sum((ys.x + ys.y) + (ys.z + ys.w)) * (1.f / 64.f); const f32x4 d = ys - mean;
              const float var = row16_sum((d.x * d.x + d.y * d.y) + (d.z * d.z + d.w * d.w)) * (1.f / 64.f);
              const f32x4 y = d * (1.f / sqrtf(var + 64e-5f)) * rng[ps] + rnb[ps];
              const f32x4 p1 = bf4(*(const v2u*)(cols + cr + R_V + c0));
              f32x4 p0 = {0.f, 0.f, 0.f, 0.f}, p2 = {0.f, 0.f, 0.f, 0.f};
              if (t > 0) p0 = bf4(*(const v2u*)(cols + cr - NINP + R_V + c0)); if (t < SEQ - 1) p2 = bf4(*(const v2u*)(cols + cr + NINP + R_V + c0));
              const f32x4 vv = p1 + rmp[ps] * (p0 - p1) + rmn[ps] * (p2 - p1);
              const float ctv = CT[(size_t)m * 8 + (qd >> 4)];
              const f32x4 g4 = *(const LAS f32x4*)(gate + tt * 388 + c0);
              if (act) *(v2u*)(MIX + (size_t)m * DM + 256 + c0) = pk4((y + vv * ctv) * g4); }
            f32x4 yv[2]; float ssq0 = 0.f, ssq1 = 0.f;
#pragma unroll
            for (int ps = 0; ps < 2; ++ps) { const int qd = ps ? qb : qa, c0 = 4 * qd; const bool act = ps == 0 || lane < 32;
              f32x4 s = scb[ps];
#pragma unroll
              for (int jj = 0; jj < 5; ++jj) { const int tq = t + jj - 2; if (tq >= 0 && tq < SEQ) s += *(const LAS f32x4*)(SCW + jj * 384 + c0) * bf4(*(const v2u*)(cols + cr + (jj - 2) * NINP + S_X + c0)); }
              const f32x4 z = bf4(*(const v2u*)(cols + cr + S_Z + c0));
              f32x4 y = bf4(*(const v2u*)(YSf + (size_t)m * 384 + c0)) + bf4(*(const v2u*)(YSb + (size_t)m * 384 + c0));
              const float dsk = sdk[qd >> 4];
              y.x = (y.x + dsk * siluf_(s.x)) * siluf_(z.x); y.y = (y.y + dsk * siluf_(s.y)) * siluf_(z.y); y.z = (y.z + dsk * siluf_(s.z)) * siluf_(z.z); y.w = (y.w + dsk * siluf_(s.w)) * siluf_(z.w);
              yv[ps] = y; const float sq = act ? (y.x * y.x + y.y * y.y) + (y.z * y.z + y.w * y.w) : 0.f;
              if (qd < 48) ssq0 += sq; else ssq1 += sq; }
            const float r0 = 1.f / sqrtf(wave_sum2(ssq0) * (1.f / 192.f) + 1e-6f), r1 = 1.f / sqrtf(wave_sum2(ssq1) * (1.f / 192.f) + 1e-6f);
#pragma unroll
            for (int ps = 0; ps < 2; ++ps) { const int qd = ps ? qb : qa, c0 = 4 * qd; const bool act = ps == 0 || lane < 32;
              if (act) *(v2u*)(MIX + (size_t)m * DM + 640 + c0) = pk4(yv[ps] * (qd < 48 ? r0 : r1) * sng[ps]); }
        }
    }
    __syncthreads();
}
namespace cg = cooperative_groups;
constexpr int N_PHASES = 9 * DEPTH + 1;
__global__ void __launch_bounds__(NWAVES * 64, 2) mk_fwd(Args args) {
    extern __shared__ __attribute__((aligned(16))) unsigned char lds_raw[];
    Frame F;
    F.lds = (LAS unsigned char*)lds_raw;
    F.tid = threadIdx.x; F.lane = F.tid & 63; F.wave = __builtin_amdgcn_readfirstlane(F.tid >> 6);
    F.G = gridDim.x; { const int bx = blockIdx.x; F.vcu = (F.G % 8 == 0) ? (bx % 8) * (F.G / 8) + bx / 8 : bx; }
    volatile LAS unsigned* MISC = (volatile LAS unsigned*)(F.lds + MISC_OFF);
    if (F.tid < 64) MISC[F.tid] = 0u;
    if (F.tid < 34) *(LAS unsigned long long*)(F.lds + PTAB_OFF + 8 * F.tid) = ((const unsigned long long*)__builtin_amdgcn_kernarg_segment_ptr())[F.tid];
    __syncthreads();
    unsigned* ctl = (unsigned*)(WSP(F) + WS_CTL);
    XcdBarrier bar = xcd_barrier_post(ctl + CW_BAR, MISC + 8);
    const int lo = args.ph_lo, hi = args.ph_hi;
#define IN_(k) (lo <= (k) && (k) < hi)
#define SEAM(k) do { if (IN_(k) && IN_((k) + 1)) { if ((k) == 0) cg::this_grid().sync(); else xcd_barrier(bar); } } while (0)
#define LAYER(l, B) \
    if (IN_(B + 0)) { phase_convert(F, l); phase_norm(F, l == 0 ? INP(F, 0) : OUTP(F), INP(F, 1) + l * DM, (bf16*)(WSP(F) + WS_XN)); } SEAM(B + 0); \
    if (IN_(B + 1)) { unsigned char* ws = WSP(F); pg8::Gemm g{(const bf16*)(ws + WS_XN), (const bf16*)(ws + WS_WIN), M, NINP, DM}; pg8::StaticOrder S; S.init(M, NINP, F.G, (int)blockIdx.x); \
            pg8::EpiBf16<0> E{(bf16*)(ws + WS_COLS), NINP, nullptr, 0, 0, 1.f}; \
            pg8::gemm_phase<pg8::EpiBf16<0>, pg8::StaticOrder, PG8_ALIGN, PG8_SP2>(F.lds, g, S, E); } SEAM(B + 1); \
    if (IN_(B + 2)) { phase_gates(F, l); phase_ssd_conv(F, l); } SEAM(B + 2); \
    if (IN_(B + 3)) { const int bx = blockIdx.x; \
            if (bx < 96) { const int c8 = bx & 7, k8 = bx >> 3; rwkv_scan(F, l, c8 + 8 * (k8 >> 2), k8 & 3, (unsigned)l * (SEQ / 32)); } else if (bx < 144) rwkv_produce(F, l, (bx - 96) % 24, (bx - 96) / 24, (unsigned)l * (SEQ / 32)); else if (bx < 216) { const int u = bx - 144, sg = 2 - (u / 24); ssd_seq(F, l, u % 24, sg == 0 ? 0 : (sg == 1 ? 43 : 86), sg == 0 ? 43 : (sg == 1 ? 86 : 128)); } else if (bx < 248) { const int u = bx - 216, sg = 1 - (u / 16); mlstm_seq(F, l, u % 16, 64 * sg, 64 * sg + 64); } } SEAM(B + 3); \
    if (IN_(B + 4)) phase_post(F, l); SEAM(B + 4); \
    if (IN_(B + 5)) { unsigned char* ws = WSP(F); pg8::Gemm g{(const bf16*)(ws + WS_XN), (const bf16*)(ws + WS_WOUT), M, DM, DM}; pg8::StaticOrder S; S.init(M, DM, F.G, (int)blockIdx.x); \
            pg8::EpiResidual E{l == 0 ? INP(F, 0) : OUTP(F), OUTP(F), DM}; \
            pg8::gemm_phase<pg8::EpiResidual, pg8::StaticOrder, PG8_ALIGN, PG8_SP2>(F.lds, g, S, E); } SEAM(B + 5); \
    if (IN_(B + 6)) phase_norm(F, OUTP(F), INP(F, 27) + l * DM, (bf16*)(WSP(F) + WS_XN)); SEAM(B + 6); \
    if (IN_(B + 7)) { unsigned char* ws = WSP(F); pg8::Gemm g{(const bf16*)(ws + WS_XN), (const bf16*)(ws + WS_WGU), M, 2 * FFN, DM}; pg8::StaticOrder S; S.init(M, 2 * FFN, F.G, (int)blockIdx.x); \
            pg8::EpiSwiGLU E{(bf16*)(ws + WS_COLS), FFN}; \
            pg8::gemm_phase<pg8::EpiSwiGLU, pg8::StaticOrder, PG8_ALIGN, PG8_SP2>(F.lds, g, S, E); } SEAM(B + 7); \
    if (IN_(B + 8)) { unsigned char* ws = WSP(F); pg8::Gemm g{(const bf16*)(ws + WS_COLS), (const bf16*)(ws + WS_WDN), M, DM, FFN}; pg8::StaticOrder S; S.init(M, DM, F.G, (int)blockIdx.x); \
            pg8::EpiResidual E{OUTP(F), OUTP(F), DM}; \
            pg8::gemm_phase<pg8::EpiResidual, pg8::StaticOrder, PG8_ALIGN, PG8_SP2>(F.lds, g, S, E); } SEAM(B + 8);
    LAYER(0, 0)
    LAYER(1, 9)
    if (IN_(18)) phase_final_norm(F, OUTP(F), INP(F, 31));
#undef IN_
#undef SEAM
#undef LAYER
}

#ifndef MK_PER_PHASE
#define MK_PER_PHASE 0
#endif
extern "C" void kernel_launch(void* const* d_in, const int* in_sizes, int n_in, void* d_out, int out_size, void* d_ws, size_t ws_size, hipStream_t stream) {
    static int grid = 0;
    if (grid == 0) {
        int dev = 0, cus = 0;
        if (n_in != 32 || out_size != M * DM || ws_size < WS_END) { fprintf(stderr, "kernel_launch: unexpected shapes (n_in %d out %d ws %zu)\n", n_in, out_size, ws_size); grid = -1; return; }
        if (hipGetDevice(&dev) != hipSuccess || hipDeviceGetAttribute(&cus, hipDeviceAttributeMultiprocessorCount, dev) != hipSuccess) { grid = -1; return; }
        if (hipFuncSetAttribute((const void*)mk_fwd, hipFuncAttributeMaxDynamicSharedMemorySize, LDS_BYTES) != hipSuccess) { fprintf(stderr, "kernel_launch: hipFuncSetAttribute failed\n"); grid = -1; return; }
        int per_cu = 0;
        if (hipOccupancyMaxActiveBlocksPerMultiprocessor(&per_cu, (const void*)mk_fwd, NWAVES * 64, LDS_BYTES) != hipSuccess || per_cu < 1) { fprintf(stderr, "kernel_launch: occupancy query says %d\n", per_cu); }
        (void)hipGetLastError();
        grid = cus;
    }
    if (grid < 0) return;
    (void)hipMemsetAsync((char*)d_ws + WS_CTL, 0, CTL_ZERO_BYTES, stream);
    Args a{};
    for (int i = 0; i < 32; ++i) a.in[i] = (const float*)d_in[i];
    a.out = (float*)d_out; a.ws = (unsigned char*)d_ws;
#if MK_PER_PHASE
    for (int p = 0; p < N_PHASES; ++p) { a.ph_lo = p; a.ph_hi = p + 1; hipLaunchKernelGGL(mk_fwd, dim3(grid), dim3(NWAVES * 64), LDS_BYTES, stream, a); }
#else
    a.ph_lo = 0; a.ph_hi = N_PHASES;
    void* kargs[] = {&a};
    hipError_t e = hipLaunchCooperativeKernel((const void*)mk_fwd, dim3(grid), dim3(NWAVES * 64), kargs, LDS_BYTES, stream);
    if (e != hipSuccess) fprintf(stderr, "cooperative launch failed: %s (grid %d)\n", hipGetErrorString(e), grid);
#endif
}
```

```cpp
#include <hip/hip_runtime.h>
#include <hip/hip_cooperative_groups.h>
#include <cstdio>
#include <cstdint>
namespace pg8 {
#define PG8_LAS __attribute__((address_space(3)))
typedef unsigned short bf16_t;
typedef short bf16x8 __attribute__((ext_vector_type(8)));
typedef float f32x4 __attribute__((ext_vector_type(4)));
typedef unsigned u32x4 __attribute__((ext_vector_type(4)));
constexpr int BM = 256, BK = 64, HALF = 128, HTB = HALF * BK * 2  , STAGE_BYTES = 8 * HTB, NXCD = 8, WGM = 8;

__host__ __device__ __forceinline__ int lds_byte(int r, int c) { const int st = (r >> 4) * 2 + (c >> 5), rr = r & 15, cc = c & 31, ob = rr * 64 + cc * 2; return st * 1024 + (ob ^ (((ob >> 9) & 1) << 5)); }
__host__ __device__ __forceinline__ void stage_rc(int b, int& R, int& C) { const int st = b / 1024, sb = b % 1024, swz = sb ^ (((sb >> 9) & 1) << 5); R = (st >> 1) * 16 + swz / 64; C = (st & 1) * 32 + (swz % 64) / 2; }
__host__ __device__ __forceinline__ int perm32(int rho) { const int n = rho >> 4, i = rho & 15; return 8 * (i >> 2) + 4 * n + (i & 3); }

struct Unit { int pm, pn; };
struct Gemm { const bf16_t* A; const bf16_t* Bt; int M, N, K; };

struct StaticOrder {
    int nM, nN, nwg, G, c;
    __host__ __device__ void init(int M, int N, int G_, int c_) { nM = M / BM; nN = N / BM; nwg = nM * nN; G = G_; c = c_; }
    __host__ __device__ bool next(int i, Unit& u) const {
        const long L = (long)i * G + c; if (L >= nwg) return false;
        int wgid = (int)L; { const int q = nwg / NXCD, r = nwg % NXCD, xcd = wgid % NXCD, off = wgid / NXCD; wgid = (xcd < r ? xcd * (q + 1) : r * (q + 1) + (xcd - r) * q) + off; }
        const int nig = WGM * nN, gid = wgid / nig, fm = gid * WGM, gsz = (nM - fm) < WGM ? (nM - fm) : WGM;
        u.pm = fm + ((wgid % nig) % gsz); u.pn = (wgid % nig) / gsz; return true;
    }
    __device__ __forceinline__ void a_ready(const Unit&) const {}
    __device__ __forceinline__ void done(const Unit&) const {}
};

__device__ __forceinline__ unsigned cvt_pk_bf16(float lo, float hi) { unsigned r; asm volatile("v_cvt_pk_bf16_f32 %0, %1, %2" : "=v"(r) : "v"(lo), "v"(hi)); return r; }
typedef float f32x2 __attribute__((ext_vector_type(2)));
__device__ __forceinline__ f32x2 gelu_pk(f32x2 v) {
    const f32x2 av = __builtin_elementwise_abs(v), d = av * 0.2316418882f + 1.0f;
    f32x2 t; t.x = __builtin_amdgcn_rcpf(d.x); t.y = __builtin_amdgcn_rcpf(d.y);
    f32x2 q = t * 0.5307027145f + (-0.7265760135f); q = q * t + 0.7107068705f; q = q * t + (-0.142248368f); q = q * t + 0.127414796f; q = q * t;
    const f32x2 s = (v * v) * (-0.72134752044f);
    f32x2 e; e.x = __builtin_amdgcn_exp2f(s.x); e.y = __builtin_amdgcn_exp2f(s.y);
    const f32x2 m = v * (q * e), r = v - m;
    f32x2 o; o.x = v.x < 0.f ? m.x : r.x; o.y = v.y < 0.f ? m.y : r.y; return o;
}

template <int ACT  > struct EpiBf16 {
    static constexpr bool PERM = true, AFTER_DRAIN = false; static_assert(ACT == 0 || ACT == 1, "EpiBf16: ACT is 0 (none) or 1 (gelu_pk)");
    bf16_t* O; int ldc; const float* bias; int split_cols; size_t split_stride; float scale0;
    __device__ __forceinline__ void operator()(const f32x4 (&acc)[2][2][4][2], const Unit& u, int wr, int wc, int fr, int fq) const {
        const int row0 = u.pm * BM + wr * 64 + fr; int colt = u.pn * BM; bf16_t* base = O;
        float sc = 1.f; if (split_cols) { const int t = colt / split_cols; base += (size_t)t * split_stride; colt -= t * split_cols; if (t == 0) sc = scale0; }
        const int col0 = colt + wc * 32 + 8 * fq, bcol0 = u.pn * BM + wc * 32 + 8 * fq;
        f32x4 bv[2][2];
#pragma unroll
        for (int bj = 0; bj < 2; ++bj)
#pragma unroll
            for (int n = 0; n < 2; ++n) bv[bj][n] = bias ? *(const f32x4*)(bias + bcol0 + bj * HALF + 4 * n) : (f32x4){0.f, 0.f, 0.f, 0.f};
#pragma unroll
        for (int ai = 0; ai < 2; ++ai)
#pragma unroll
            for (int m = 0; m < 4; ++m) { bf16_t* rowp = base + (size_t)(row0 + ai * HALF + m * 16) * ldc + col0;
#pragma unroll
                for (int bj = 0; bj < 2; ++bj) { f32x4 v0 = acc[ai][bj][m][0] + bv[bj][0], v1 = acc[ai][bj][m][1] + bv[bj][1];
                    if (ACT == 1) { f32x2 a = gelu_pk((f32x2){v0[0], v0[1]}), b = gelu_pk((f32x2){v0[2], v0[3]}), c = gelu_pk((f32x2){v1[0], v1[1]}), d = gelu_pk((f32x2){v1[2], v1[3]});
                        v0 = (f32x4){a.x, a.y, b.x, b.y}; v1 = (f32x4){c.x, c.y, d.x, d.y}; }
                    v0 = v0 * sc; v1 = v1 * sc; u32x4 w; w.x = cvt_pk_bf16(v0[0], v0[1]); w.y = cvt_pk_bf16(v0[2], v0[3]); w.z = cvt_pk_bf16(v1[0], v1[1]); w.w = cvt_pk_bf16(v1[2], v1[3]);
                    *(u32x4*)(rowp + bj * HALF) = w; } }
    }
};
struct EpiResidual {
    static constexpr bool PERM = false, AFTER_DRAIN = false;
    const float* base; float* out; int ldc;
    __device__ __forceinline__ void operator()(const f32x4 (&acc)[2][2][4][2], const Unit& u, int wr, int wc, int fr, int fq) const {
        const int col0 = u.pn * BM + wc * 32 + 4 * fq;
#pragma unroll
        for (int ai = 0; ai < 2; ++ai)
#pragma unroll
            for (int m = 0; m < 4; ++m) { const size_t off = (size_t)(u.pm * BM + ai * HALF + wr * 64 + m * 16 + fr) * ldc + col0;
#pragma unroll
                for (int bj = 0; bj < 2; ++bj)
#pragma unroll
                    for (int n = 0; n < 2; ++n) { const f32x4 bs = *(const f32x4*)(base + off + bj * HALF + n * 16); *(f32x4*)(out + off + bj * HALF + n * 16) = bs + acc[ai][bj][m][n]; }
                asm volatile("" ::: "memory"); }
    }
};
struct EpiSwiGLU {
    static constexpr bool PERM = true, AFTER_DRAIN = false;
    bf16_t* O; int ldc;
    __device__ __forceinline__ void operator()(const f32x4 (&acc)[2][2][4][2], const Unit& u, int wr, int wc, int fr, int fq) const {
        const int col0 = u.pn * HALF + wc * 32 + 8 * fq;
#pragma unroll
        for (int ai = 0; ai < 2; ++ai)
#pragma unroll
            for (int m = 0; m < 4; ++m) { bf16_t* rowp = O + (size_t)(u.pm * BM + ai * HALF + wr * 64 + m * 16 + fr) * ldc + col0;
                float r[8];
#pragma unroll
                for (int n = 0; n < 2; ++n)
#pragma unroll
                    for (int j = 0; j < 4; ++j) { const float g = acc[ai][0][m][n][j], up = acc[ai][1][m][n][j]; r[n * 4 + j] = g * __builtin_amdgcn_rcpf(1.f + __expf(-g)) * up; }
                u32x4 w; w.x = cvt_pk_bf16(r[0], r[1]); w.y = cvt_pk_bf16(r[2], r[3]); w.z = cvt_pk_bf16(r[4], r[5]); w.w = cvt_pk_bf16(r[6], r[7]);
                *(u32x4*)rowp = w; }
    }
};
template <class Epi, class Sched, bool ALIGN_EPI = false, bool SP2 = false>
__device__ __forceinline__ void gemm_phase(PG8_LAS unsigned char* lds, const Gemm g, const Sched& S, const Epi& E) {
    const int tid = threadIdx.x, wid = __builtin_amdgcn_readfirstlane(tid >> 6), lane = tid & 63, wr = wid >> 2, wc = wid & 3, fr = lane & 15, fq = lane >> 4;
    const int K = g.K, nt = K / BK;
    unsigned voffA[2], voffB[2];
#pragma unroll
    for (int i = 0; i < 2; ++i) { int R, C; stage_rc(tid * 16 + i * 8192, R, C); const int Rb = Epi::PERM ? ((R & ~31) + perm32(R & 31)) : R;
        voffA[i] = (unsigned)(R * K + C) * 2u; voffB[i] = (unsigned)(Rb * K + C) * 2u; }
    const size_t kstep = (size_t)(BK * 2);
    const size_t hstep = (size_t)HALF * K * 2;
    const size_t tstep = 2 * hstep;
    const unsigned ldsw = (unsigned)wid * 1024u;
    const int aoff = lds_byte(wr * 64 + fr, fq * 8), boff = lds_byte(wc * 32 + fr, fq * 8);
#define PG8_SA(b, h) (((b) * 2 + (h)) * HTB)
#define PG8_SB(b, h) ((4 + (b) * 2 + (h)) * HTB)
#define PG8_STAGE(bufoff, gbase, voff) do { _Pragma("unroll") for (int _i = 0; _i < 2; ++_i) \
        __builtin_amdgcn_global_load_lds((const unsigned*)((const char*)(gbase) + (voff)[_i]), (PG8_LAS unsigned*)(lds + (bufoff) + ldsw + _i * 8192), 16, 0, 0); } while (0)
#define PG8_LDA(dst, b, h) do { _Pragma("unroll") for (int m = 0; m < 4; ++m) _Pragma("unroll") for (int k = 0; k < 2; ++k) dst[m][k] = *(const PG8_LAS bf16x8*)(lds + PG8_SA(b, h) + aoff + m * 2048 + k * 1024); } while (0)
#define PG8_LDB(dst, b, h) do { _Pragma("unroll") for (int n = 0; n < 2; ++n) _Pragma("unroll") for (int k = 0; k < 2; ++k) dst[n][k] = *(const PG8_LAS bf16x8*)(lds + PG8_SB(b, h) + boff + n * 2048 + k * 1024); } while (0)
#define PG8_MMA(ai, bj, At, Bt) do { __builtin_amdgcn_s_setprio(1); _Pragma("unroll") for (int m = 0; m < 4; ++m) _Pragma("unroll") for (int n = 0; n < 2; ++n) _Pragma("unroll") for (int k = 0; k < 2; ++k) \
        acc[ai][bj][m][n] = __builtin_amdgcn_mfma_f32_16x16x32_bf16(Bt[n][k], At[m][k], acc[ai][bj][m][n], 0, 0, 0); __builtin_amdgcn_s_setprio(0); } while (0)
#define PG8_WAIT_V(n) asm volatile("s_waitcnt vmcnt(" #n ")" ::: "memory")
#define PG8_WAIT_L(n) asm volatile("s_waitcnt lgkmcnt(" #n ")" ::: "memory")
#define PG8_BAR __builtin_amdgcn_s_barrier()
#define PG8_SCHED __builtin_amdgcn_sched_barrier(0)
    Unit cur, nxt; int ui = 0;
    if (!S.next(0, cur)) return;
    f32x4 acc[2][2][4][2];
#pragma unroll
    for (int a = 0; a < 2; ++a)
#pragma unroll
        for (int b = 0; b < 2; ++b)
#pragma unroll
            for (int m = 0; m < 4; ++m)
#pragma unroll
                for (int n = 0; n < 2; ++n) acc[a][b][m][n] = (f32x4){0.f, 0.f, 0.f, 0.f};
    bf16x8 At[4][2], B0[2][2], B1[2][2];
    const char* cA = (const char*)g.A + (size_t)cur.pm * tstep; const char* cB = (const char*)g.Bt + (size_t)cur.pn * tstep;
    S.a_ready(cur);
    if constexpr (SP2) {
        PG8_STAGE(PG8_SB(0, 0), cB, voffB); PG8_STAGE(PG8_SB(0, 1), cB + hstep, voffB); PG8_STAGE(PG8_SA(0, 0), cA, voffA); PG8_STAGE(PG8_SA(0, 1), cA + hstep, voffA);
        if (wr == 1) PG8_BAR;
        PG8_WAIT_V(2); PG8_BAR;
        PG8_STAGE(PG8_SB(1, 0), cB + kstep, voffB); PG8_STAGE(PG8_SA(1, 0), cA + kstep, voffA); PG8_STAGE(PG8_SB(1, 1), cB + hstep + kstep, voffB);
        PG8_WAIT_V(6); PG8_BAR;
    } else {
        PG8_STAGE(PG8_SB(0, 0), cB, voffB); PG8_STAGE(PG8_SA(0, 0), cA, voffA); PG8_STAGE(PG8_SB(0, 1), cB + hstep, voffB); PG8_STAGE(PG8_SA(0, 1), cA + hstep, voffA);
        if (wr == 1) PG8_BAR;
        PG8_WAIT_V(4); PG8_BAR;
        PG8_STAGE(PG8_SB(1, 0), cB + kstep, voffB); PG8_STAGE(PG8_SA(1, 0), cA + kstep, voffA); PG8_STAGE(PG8_SB(1, 1), cB + hstep + kstep, voffB);
        PG8_WAIT_V(6); PG8_BAR;
    }
    for (;;) {
        const bool has_next = S.next(ui + 1, nxt);
        const char* nA = has_next ? (const char*)g.A + (size_t)nxt.pm * tstep : cA; const char* nB = has_next ? (const char*)g.Bt + (size_t)nxt.pn * tstep : cB;
        for (int t = 0; t < nt; t += 2) {
            const bool last = (t == nt - 2);
            const char* a1 = cA + (size_t)(t + 1) * kstep;
            const char* a2 = last ? nA : cA + (size_t)(t + 2) * kstep; const char* b2 = last ? nB : cB + (size_t)(t + 2) * kstep;
            const char* a3 = a2 + kstep; const char* b3 = b2 + kstep;
            if (last && has_next) S.a_ready(nxt);
            if constexpr (SP2) {
            PG8_LDB(B0, 0, 0); PG8_LDB(B1, 0, 1); PG8_SCHED; PG8_LDA(At, 0, 0); PG8_STAGE(PG8_SA(1, 1), a1 + hstep, voffA);
            PG8_WAIT_V(8); PG8_WAIT_L(0); PG8_BAR; PG8_MMA(0, 0, At, B0); PG8_MMA(0, 1, At, B1); PG8_BAR; PG8_SCHED;
            PG8_LDA(At, 0, 1); PG8_STAGE(PG8_SB(0, 0), b2, voffB); PG8_STAGE(PG8_SB(0, 1), b2 + hstep, voffB); PG8_STAGE(PG8_SA(0, 0), a2, voffA);
            PG8_WAIT_V(8); PG8_WAIT_L(0); PG8_BAR; PG8_MMA(1, 0, At, B0); PG8_MMA(1, 1, At, B1); PG8_BAR; PG8_SCHED;
            PG8_LDB(B0, 1, 0); PG8_LDB(B1, 1, 1); PG8_SCHED; PG8_LDA(At, 1, 0); PG8_STAGE(PG8_SA(0, 1), a2 + hstep, voffA);
            PG8_WAIT_V(8); PG8_WAIT_L(0); PG8_BAR; PG8_MMA(0, 0, At, B0); PG8_MMA(0, 1, At, B1); PG8_BAR; PG8_SCHED;
            PG8_LDA(At, 1, 1); PG8_STAGE(PG8_SB(1, 0), b3, voffB); PG8_STAGE(PG8_SB(1, 1), b3 + hstep, voffB); PG8_STAGE(PG8_SA(1, 0), a3, voffA);
            PG8_WAIT_V(8); PG8_WAIT_L(0); PG8_BAR; PG8_MMA(1, 0, At, B0); PG8_MMA(1, 1, At, B1); PG8_BAR; PG8_SCHED;
            } else {
            PG8_LDB(B0, 0, 0); PG8_SCHED; PG8_LDA(At, 0, 0); PG8_STAGE(PG8_SA(1, 1), a1 + hstep, voffA);
            PG8_WAIT_L(8); PG8_BAR; PG8_WAIT_L(0); PG8_MMA(0, 0, At, B0); PG8_BAR; PG8_SCHED;
            PG8_LDB(B1, 0, 1); PG8_STAGE(PG8_SB(0, 0), b2, voffB);
            PG8_BAR; PG8_WAIT_L(0); PG8_MMA(0, 1, At, B1); PG8_BAR;
            PG8_LDA(At, 0, 1); PG8_STAGE(PG8_SA(0, 0), a2, voffA);
            PG8_BAR; PG8_WAIT_L(0); PG8_MMA(1, 0, At, B0); PG8_BAR; PG8_SCHED;
            PG8_STAGE(PG8_SB(0, 1), b2 + hstep, voffB);
            PG8_WAIT_V(6); PG8_BAR; PG8_MMA(1, 1, At, B1); PG8_BAR;
            PG8_LDB(B0, 1, 0); PG8_SCHED; PG8_LDA(At, 1, 0); PG8_STAGE(PG8_SA(0, 1), a2 + hstep, voffA);
            PG8_WAIT_L(8); PG8_BAR; PG8_WAIT_L(0); PG8_MMA(0, 0, At, B0); PG8_BAR; PG8_SCHED;
            PG8_LDB(B1, 1, 1); PG8_STAGE(PG8_SB(1, 0), b3, voffB);
            PG8_BAR; PG8_WAIT_L(0); PG8_MMA(0, 1, At, B1); PG8_BAR;
            PG8_LDA(At, 1, 1); PG8_STAGE(PG8_SA(1, 0), a3, voffA);
            PG8_BAR; PG8_WAIT_L(0); PG8_MMA(1, 0, At, B0); PG8_BAR; PG8_SCHED;
            PG8_STAGE(PG8_SB(1, 1), b3 + hstep, voffB);
            PG8_WAIT_V(6); PG8_BAR; PG8_MMA(1, 1, At, B1); PG8_BAR;
            }
        }
        if constexpr (ALIGN_EPI) { if (wr == 0) PG8_BAR; }
        if constexpr (!Epi::AFTER_DRAIN) { E(acc, cur, wr, wc, fr, fq); S.done(cur); }
        if (!has_next) break;
#pragma unroll
        for (int a = 0; a < 2; ++a)
#pragma unroll
            for (int b = 0; b < 2; ++b)
#pragma unroll
                for (int m = 0; m < 4; ++m)
#pragma unroll
                    for (int n = 0; n < 2; ++n) acc[a][b][m][n] = (f32x4){0.f, 0.f, 0.f, 0.f};
        cur = nxt; cA = nA; cB = nB; ++ui;
        if constexpr (ALIGN_EPI) { if (wr == 1) PG8_BAR; }
    }
    PG8_WAIT_V(0);
    if constexpr (!ALIGN_EPI) { if (wr == 0) PG8_BAR; }
    PG8_BAR;
    if constexpr (Epi::AFTER_DRAIN) { E.fused(acc, cur, wr, wc, fr, fq, lds, wid, lane); S.done(cur); }
#undef PG8_SA
#undef PG8_SB
#undef PG8_STAGE
#undef PG8_LDA
#undef PG8_LDB
#undef PG8_MMA
#undef PG8_WAIT_V
#undef PG8_WAIT_L
#undef PG8_BAR
#undef PG8_SCHED
}
}

#ifndef PG8_SP2
#define PG8_SP2 true
#endif
#define PG8_ALIGN true
constexpr int NWAVES = 8;
constexpr int BATCH = 2, SEQ = 8192, DM = 1024, M = BATCH * SEQ, NIN = 3788, NINP = 3840, FFN = 2816, DEPTH = 2;
constexpr int A_Q = 0, A_K = 256, A_V = 512, A_O = 768;
constexpr int R_R = 1024, R_K = 1408, R_V = 1792, R_WDF = 2176, R_AD = 2304, R_GD = 2368;
constexpr int S_Z = 2496, S_X = 2880, S_B = 3264, S_C = 3520, S_DT = 3776;
constexpr size_t MiB = 1u << 20;
constexpr size_t WS_CTL = 0, CTL_ZERO_BYTES = 128 * 1024;
constexpr size_t WS_GATES = 1 * MiB, WS_CT = 2 * MiB, WS_DTV = 2 * MiB + 512 * 1024;
constexpr size_t WS_GUT = 31 * MiB;
constexpr size_t WS_WIN = 4 * MiB, WS_WOUT = 12 * MiB, WS_WGU = 14 * MiB, WS_WDN = 25 * MiB;
constexpr size_t WS_XN = 32 * MiB, WS_COLS = 64 * MiB, WS_Y = 184 * MiB, WS_END = 256 * MiB;
constexpr size_t Y_AF = WS_Y, Y_AB = WS_Y + 8 * MiB, Y_RF = WS_Y + 16 * MiB, Y_RB = WS_Y + 28 * MiB, Y_SF = WS_Y + 40 * MiB, Y_SB = WS_Y + 52 * MiB;
constexpr int CW_BAR = 1024;
constexpr int RING_BYTES = 131072;
constexpr int LDS_BYTES = 147456, MISC_OFF = LDS_BYTES - 256;

#define GAS __attribute__((address_space(1)))
#define LAS __attribute__((address_space(3)))
typedef unsigned short bf16;
typedef unsigned v4u __attribute__((ext_vector_type(4)));
typedef unsigned v2u __attribute__((ext_vector_type(2)));
typedef float f32x4 __attribute__((ext_vector_type(4)));
typedef short bf16x8 __attribute__((ext_vector_type(8)));
typedef GAS unsigned gu32;
#define RLX_AGENT __ATOMIC_RELAXED, __HIP_MEMORY_SCOPE_AGENT
#define LDS_WAIT() asm volatile("s_waitcnt lgkmcnt(0)" ::: "memory")
#define VM_WAIT() asm volatile("s_waitcnt vmcnt(0)" ::: "memory")
__device__ __forceinline__ unsigned f2bf(float f) { unsigned u = __builtin_bit_cast(unsigned, f); return (u + 0x7fffu + ((u >> 16) & 1u)) >> 16; }
__device__ __forceinline__ unsigned pk2(float lo, float hi) { return f2bf(lo) | (f2bf(hi) << 16); }
__device__ __forceinline__ float bf2f(unsigned u) { return __builtin_bit_cast(float, u << 16); }
__device__ __forceinline__ float sigmoidf_(float x) { return __builtin_amdgcn_rcpf(1.f + __expf(-x)); }
__device__ __forceinline__ float siluf_(float x) { return x * sigmoidf_(x); }
__device__ __forceinline__ float wave_sum(float v) {
#pragma unroll
    for (int o = 1; o < 64; o <<= 1) v += __shfl_xor(v, o);
    return v;
}
__device__ __forceinline__ float wave_max(float v) {
#pragma unroll
    for (int o = 1; o < 64; o <<= 1) v = fmaxf(v, __shfl_xor(v, o));
    return v;
}
template <int CTRL> __device__ __forceinline__ float dppf(float v) { return __builtin_bit_cast(float, __builtin_amdgcn_update_dpp(0, __builtin_bit_cast(int, v), CTRL, 0xf, 0xf, true)); }
__device__ __forceinline__ float row16_sum(float v) { v += dppf<0xB1>(v); v += dppf<0x4E>(v); v += dppf<0x141>(v); v += dppf<0x140>(v); return v; }
template <int K> __device__ __forceinline__ f32x4 mma16(const LAS bf16* A, int lda, const LAS bf16* Bt, int ldb, f32x4 acc, int lane) {
    const int r = lane & 15, q = lane >> 4;
    const LAS bf16* ap = A + r * lda + q * 8; const LAS bf16* bp = Bt + r * ldb + q * 8;
#pragma unroll
    for (int k0 = 0; k0 < K; k0 += 32) {
        const bf16x8 a = *(const LAS bf16x8*)(ap + k0); const bf16x8 b = *(const LAS bf16x8*)(bp + k0);
        acc = __builtin_amdgcn_mfma_f32_16x16x32_bf16(a, b, acc, 0, 0, 0);
    }
    return acc;
}

__device__ __forceinline__ int swz64(int row, int col) { return col ^ (((row >> 3) & 7) << 3); }
template <bool SWA, bool SWB> __device__ __forceinline__ f32x4 mma16s(const LAS bf16* A, int lda, int rowA0, const LAS bf16* Bt, int ldb, int rowB0, f32x4 acc, int lane) {
    const int r = lane & 15, q = lane >> 4; const int ra = rowA0 + r, rb = rowB0 + r;
#pragma unroll
    for (int k0 = 0; k0 < 64; k0 += 32) { const int ca = k0 + 8 * q, cb = k0 + 8 * q;
        const bf16x8 a = *(const LAS bf16x8*)(A + ra * lda + (SWA ? swz64(ra, ca) : ca)); const bf16x8 b = *(const LAS bf16x8*)(Bt + rb * ldb + (SWB ? swz64(rb, cb) : cb));
        acc = __builtin_amdgcn_mfma_f32_16x16x32_bf16(a, b, acc, 0, 0, 0); }
    return acc;
}

template <int CTRL, int RM, int BM> __device__ __forceinline__ float dppm(float oldv, float v) { return __builtin_bit_cast(float, __builtin_amdgcn_update_dpp(__builtin_bit_cast(int, oldv), __builtin_bit_cast(int, v), CTRL, RM, BM, false)); }
__device__ __forceinline__ float wave_scan_add(float x) {
    float y = x + dppm<0x111, 0xf, 0xf>(0.f, x); y += dppm<0x112, 0xf, 0xf>(0.f, x); y += dppm<0x113, 0xf, 0xf>(0.f, x);
    y += dppm<0x114, 0xf, 0xe>(0.f, y); y += dppm<0x118, 0xf, 0xc>(0.f, y);
    y += dppm<0x142, 0xa, 0xf>(0.f, y); y += dppm<0x143, 0xc, 0xf>(0.f, y);
    return y;
}
__device__ __forceinline__ float wave_scan_max(float x) {
    const float ninf = -INFINITY;
    float y = fmaxf(x, dppm<0x111, 0xf, 0xf>(ninf, x)); y = fmaxf(y, dppm<0x112, 0xf, 0xf>(ninf, x)); y = fmaxf(y, dppm<0x113, 0xf, 0xf>(ninf, x));
    y = fmaxf(y, dppm<0x114, 0xf, 0xe>(ninf, y)); y = fmaxf(y, dppm<0x118, 0xf, 0xc>(ninf, y));
    y = fmaxf(y, dppm<0x142, 0xa, 0xf>(ninf, y)); y = fmaxf(y, dppm<0x143, 0xc, 0xf>(ninf, y));
    return y;
}
#define XB_TMO      128
#define XB_XCNT(j)  (256  + 64 * (j))
#define XB_XSUB(j)  (1280 + 64 * (j))
#define XB_XGEN(j)  (2304 + 64 * (j))
#define XB_TOP      3328
#define XB_TOPGEN   3392
#define XCD_BAR_WORDS 3456
#define XB_SPIN_CAP (1u << 18)

__device__ __forceinline__ unsigned xb_ld(unsigned* p)              { return __hip_atomic_load(p, __ATOMIC_RELAXED, __HIP_MEMORY_SCOPE_AGENT); }
__device__ __forceinline__ unsigned xb_add(unsigned* p, unsigned v) { return __hip_atomic_fetch_add(p, v, __ATOMIC_RELAXED, __HIP_MEMORY_SCOPE_AGENT); }
__device__ __forceinline__ unsigned xb_xcc_id() { return (unsigned)__builtin_amdgcn_s_getreg((3 << 11) | 20) & 0xFu; }
#define XB_SPIN(cond, bar) do { unsigned _sp = 0; while (cond) { __builtin_amdgcn_s_sleep(1); \
    if ((++_sp & 255u) == 0u) { if (xb_ld(&(bar)[XB_TMO])) break; if (_sp > XB_SPIN_CAP) { atomicAdd(&(bar)[XB_TMO], 1u); break; } } } } while (0)

struct XcdBarrier {
    unsigned* bar; unsigned x;
    volatile LAS unsigned* st;
};

__device__ __forceinline__ XcdBarrier xcd_barrier_post(unsigned* bar, volatile LAS unsigned* st) {
    XcdBarrier b; b.bar = bar; b.x = xb_xcc_id(); b.st = st;
    if (threadIdx.x == 0) (void)xb_add(&bar[XB_XCNT(b.x)], 1u);
    return b;
}
__device__ __forceinline__ void xcd_barrier_complete(unsigned* bar, unsigned x, unsigned& nloc, unsigned& nx) {
    const unsigned G = gridDim.x * gridDim.y * gridDim.z;
    unsigned sum, cnt, mine, sp = 0u;
    for (;;) {
        sum = 0u; cnt = 0u; mine = 0u;
#pragma unroll
        for (unsigned j = 0; j < 16; ++j) { const unsigned c = xb_ld(&bar[XB_XCNT(j)]); sum += c; cnt += (c > 0u) ? 1u : 0u; mine = (j == x) ? c : mine; }
        if (sum == G) break;
        __builtin_amdgcn_s_sleep(1);
        if ((++sp & 255u) == 0u) { if (xb_ld(&bar[XB_TMO])) break; if (sp > XB_SPIN_CAP) { atomicAdd(&bar[XB_TMO], 1u); break; } }
    }
    nloc = mine > 0u ? mine : 1u; nx = cnt > 0u ? cnt : 1u;
}

__device__ __forceinline__ void xcd_barrier(const XcdBarrier& b) {
    asm volatile("s_waitcnt vmcnt(0)" ::: "memory");
    __syncthreads();
    if (threadIdx.x == 0) {
        unsigned* bar = b.bar;
        __builtin_amdgcn_s_waitcnt(0);
        unsigned nloc = b.st[0], nx = b.st[1];
        if (nloc == 0u) { xcd_barrier_complete(bar, b.x, nloc, nx); b.st[0] = nloc; b.st[1] = nx; }
        const unsigned old = xb_add(&bar[XB_XSUB(b.x)], 1u);
        const unsigned gen = old / nloc;
        if (old + 1u == (gen + 1u) * nloc) {
            __builtin_amdgcn_fence(__ATOMIC_RELEASE, "agent");
            asm volatile("s_waitcnt vmcnt(0)" ::: "memory");
            const unsigned og = xb_add(&bar[XB_TOP], 1u);
            const unsigned tg = og / nx;
            if (og + 1u == (tg + 1u) * nx) xb_add(&bar[XB_TOPGEN], 1u);
            else XB_SPIN(xb_ld(&bar[XB_TOPGEN]) == tg, bar);
            __builtin_amdgcn_fence(__ATOMIC_ACQUIRE, "agent");
            xb_add(&bar[XB_XGEN(b.x)], 1u);
            asm volatile("s_waitcnt vmcnt(0)" ::: "memory");
        } else {
            XB_SPIN(xb_ld(&bar[XB_XGEN(b.x)]) == gen, bar);
            __builtin_amdgcn_fence(__ATOMIC_ACQUIRE, "agent");
            asm volatile("s_waitcnt vmcnt(0)" ::: "memory");
        }
    }
    __syncthreads();
}
struct Frame {
    LAS unsigned char* lds;
    int tid, lane, wave, vcu, G;
};
struct Args { const float* in[32]; float* out; unsigned char* ws; int ph_lo, ph_hi; };
constexpr int PTAB_OFF = LDS_BYTES - 768;
__device__ __forceinline__ unsigned long long ptab_ld(const Frame& F, int i) {
    const unsigned long long v = *(volatile LAS unsigned long long*)(F.lds + PTAB_OFF + 8 * i);
    const unsigned lo = __builtin_amdgcn_readfirstlane((unsigned)v), hi = __builtin_amdgcn_readfirstlane((unsigned)(v >> 32));
    return ((unsigned long long)hi << 32) | lo;
}
__device__ __forceinline__ const GAS float* INP(const Frame& F, int i) { return (const GAS float*)ptab_ld(F, i); }
__device__ __forceinline__ GAS unsigned char* WSP(const Frame& F) { return (GAS unsigned char*)ptab_ld(F, 33); }
__device__ __forceinline__ GAS float* OUTP(const Frame& F) { return (GAS float*)ptab_ld(F, 32); }
__device__ __forceinline__ void transpose_item(const GAS float* W, int K, int N, int nblk, GAS bf16* WT, int mode, int row_off, LAS float* scr, int item, int lane) {
    const int kb = item / nblk, nb = item % nblk, k0 = 64 * kb, n0 = 32 * nb;
    const int ncol = n0 + (lane & 31); const bool ok = ncol < N;
#pragma unroll 8
    for (int i = 0; i < 32; ++i) { const int kk = 2 * i + (lane >> 5); scr[kk * 33 + (lane & 31)] = ok ? W[(size_t)(k0 + kk) * N + ncol] : 0.f; }
    LDS_WAIT(); asm volatile("" ::: "memory");
    const int c = lane & 7;
    const int drow0 = mode ? (256 * (n0 >> 7) + (n0 & 127) + row_off) : (row_off + n0);
#pragma unroll
    for (int j = 0; j < 4; ++j) { const int n = (lane >> 3) + 8 * j; const LAS float* s = scr + (8 * c) * 33 + n;
        v4u o; o.x = pk2(s[0 * 33], s[1 * 33]); o.y = pk2(s[2 * 33], s[3 * 33]); o.z = pk2(s[4 * 33], s[5 * 33]); o.w = pk2(s[6 * 33], s[7 * 33]);
        *(GAS v4u*)(WT + (size_t)(drow0 + n) * K + k0 + 8 * c) = o; }
    LDS_WAIT(); asm volatile("" ::: "memory");
}
__device__ __forceinline__ void phase_convert(const Frame& F, int l) {
    LAS float* scr = (LAS float*)(F.lds + F.wave * 16384);
    const int gw = F.vcu * NWAVES + F.wave, NGW = F.G * NWAVES;
    GAS bf16* Win = (GAS bf16*)(WSP(F) + WS_WIN); GAS bf16* Wout = (GAS bf16*)(WSP(F) + WS_WOUT); GAS bf16* Wgu = (GAS bf16*)(WSP(F) + WS_WGU); GAS bf16* Wdn = (GAS bf16*)(WSP(F) + WS_WDN);
    constexpr int I_IN = 16 * 120, I_OUT = 16 * 32, I_G = 16 * 88, I_D = 44 * 32, I_GU = 2 * 12;
    constexpr int NITEMS = I_IN + I_OUT + 2 * I_G + I_D + I_GU;
    for (int it = gw; it < NITEMS; it += NGW) {
        int r = it;
        if (r < I_IN) { transpose_item(INP(F, 2) + (size_t)l * DM * NIN, DM, NIN, 120, Win, 0, 0, scr, r, F.lane); continue; } r -= I_IN;
        if (r < I_OUT) { transpose_item(INP(F, 26) + (size_t)l * DM * DM, DM, DM, 32, Wout, 0, 0, scr, r, F.lane); continue; } r -= I_OUT;
        if (r < I_G) { transpose_item(INP(F, 28) + (size_t)l * DM * FFN, DM, FFN, 88, Wgu, 1, 0, scr, r, F.lane); continue; } r -= I_G;
        if (r < I_G) { transpose_item(INP(F, 29) + (size_t)l * DM * FFN, DM, FFN, 88, Wgu, 1, 128, scr, r, F.lane); continue; } r -= I_G;
        if (r < I_D) { transpose_item(INP(F, 30) + (size_t)l * FFN * DM, FFN, DM, 32, Wdn, 0, 0, scr, r, F.lane); continue; } r -= I_D;
        transpose_item(INP(F, 14) + (size_t)l * 128 * 384, 128, 384, 12, (GAS bf16*)(WSP(F) + WS_GUT), 0, 0, scr, r, F.lane);
    }
}
__device__ __forceinline__ void phase_norm(const Frame& F, const GAS float* hin, const GAS float* g, GAS bf16* XN) {
    const int gw = F.vcu * NWAVES + F.wave, NGW = F.G * NWAVES;
    f32x4 gv[4];
#pragma unroll
    for (int j = 0; j < 4; ++j) gv[j] = ((const GAS f32x4*)g)[64 * j + F.lane];
    for (int m = gw; m < M; m += NGW) {
        const GAS f32x4* xr = (const GAS f32x4*)(hin + (size_t)m * DM) + F.lane;
        f32x4 v[4]; float s = 0.f;
#pragma unroll
        for (int j = 0; j < 4; ++j) { v[j] = xr[64 * j]; s += (v[j].x * v[j].x + v[j].y * v[j].y) + (v[j].z * v[j].z + v[j].w * v[j].w); }
        const float r = 1.f / sqrtf(wave_sum(s) * (1.f / DM) + 1e-6f);
        GAS v2u* o8 = (GAS v2u*)(XN + (size_t)m * DM) + F.lane;
#pragma unroll
        for (int j = 0; j < 4; ++j) { v2u w; w.x = pk2(v[j].x * r * gv[j].x, v[j].y * r * gv[j].y); w.y = pk2(v[j].z * r * gv[j].z, v[j].w * r * gv[j].w); o8[64 * j] = w; }
    }
}
__device__ __forceinline__ void phase_final_norm(const Frame& F, GAS float* h, const GAS float* g) {
    const int gw = F.vcu * NWAVES + F.wave, NGW = F.G * NWAVES;
    f32x4 gv[4];
#pragma unroll
    for (int j = 0; j < 4; ++j) gv[j] = ((const GAS f32x4*)g)[64 * j + F.lane];
    for (int m = gw; m < M; m += NGW) {
        GAS f32x4* xr = (GAS f32x4*)(h + (size_t)m * DM) + F.lane;
        f32x4 v[4]; float s = 0.f;
#pragma unroll
        for (int j = 0; j < 4; ++j) { v[j] = xr[64 * j]; s += (v[j].x * v[j].x + v[j].y * v[j].y) + (v[j].z * v[j].z + v[j].w * v[j].w); }
        const float r = 1.f / sqrtf(wave_sum(s) * (1.f / DM) + 1e-6f);
#pragma unroll
        for (int j = 0; j < 4; ++j) xr[64 * j] = v[j] * r * gv[j];
    }
}
__device__ __forceinline__ void phase_gates(const Frame& F, int l) {
    const GAS bf16* cols = (const GAS bf16*)(WSP(F) + WS_COLS); GAS float* GT = (GAS float*)(WSP(F) + WS_GATES);
    LAS bf16* raw = (LAS bf16*)(F.lds);
    LAS bf16* featb = (LAS bf16*)(F.lds + 30720);
    LAS bf16* gwT = (LAS bf16*)(F.lds + 55552);
    LAS float* outp = (LAS float*)(F.lds + 80384);
    const GAS float* gwg = INP(F, 5) + (size_t)l * 768 * 16; const GAS float* gb = INP(F, 6) + l * 16;
    const int tid = F.tid, lane = F.lane, wave = F.wave;
    __syncthreads();
    for (int i = tid; i < 768 * 16; i += 512) gwT[(i & 15) * 776 + (i >> 4)] = (bf16)f2bf(gwg[i]);
    float cw[5]; { const GAS float* cwp = INP(F, 3) + (size_t)l * 5 * 512;
#pragma unroll
        for (int j = 0; j < 5; ++j) cw[j] = cwp[j * 512 + tid]; }
    const float cbv = INP(F, 4)[l * 512 + tid];
    const float gbv = gb[tid & 15];
    for (int tile = F.vcu; tile < M / 16; tile += F.G) {
        const int m0 = tile * 16, t0 = m0 % SEQ;
        __syncthreads();
        for (int ch = tid; ch < 20 * 96; ch += 512) { const int rr = ch / 96, cc = ch % 96; const int t = t0 - 2 + rr;
            v4u v = {0u, 0u, 0u, 0u}; if (t >= 0 && t < SEQ) v = *(const GAS v4u*)(cols + (size_t)(m0 - 2 + rr) * NINP + cc * 8);
            *(LAS v4u*)(raw + rr * 768 + cc * 8) = v; }
        if (tid < 256) outp[tid] = 0.f;
        __syncthreads();
        { float win[5];
#pragma unroll
          for (int j = 0; j < 4; ++j) win[j] = bf2f(raw[j * 768 + tid]);
#pragma unroll 4
          for (int t = 0; t < 16; ++t) { win[4] = bf2f(raw[(t + 4) * 768 + tid]); float s = cbv;
#pragma unroll
              for (int j = 0; j < 5; ++j) s += cw[j] * win[j];
#pragma unroll
              for (int j = 0; j < 4; ++j) win[j] = win[j + 1];
              featb[t * 776 + tid] = (bf16)f2bf(siluf_(s)); }
          const int t = tid >> 5, c8 = tid & 31; *(LAS v4u*)(featb + t * 776 + 512 + c8 * 8) = *(const LAS v4u*)(raw + (t + 2) * 768 + 512 + c8 * 8); }
        __syncthreads();
        { const f32x4 z = {0.f, 0.f, 0.f, 0.f}; const f32x4 acc = mma16<96>(featb + 96 * wave, 776, gwT + 96 * wave, 776, z, lane);
#pragma unroll
          for (int jj = 0; jj < 4; ++jj) __hip_atomic_fetch_add(outp + ((lane >> 4) * 4 + jj) * 16 + (lane & 15), acc[jj], __ATOMIC_RELAXED, __HIP_MEMORY_SCOPE_WORKGROUP); }
        __syncthreads();
        if (tid < 256) { float s = outp[tid] + gbv; if ((tid & 15) >= 8) s = fminf(s, 0.f) - log1pf(__expf(-fabsf(s))); GT[(size_t)(m0 + (tid >> 4)) * 16 + (tid & 15)] = s; }
    }
    __syncthreads();
}
__device__ __forceinline__ f32x4 mma16_a8(const LAS bf16* A8, const LAS bf16* Bt, f32x4 acc, int lane) {
    const int q = lane >> 4;
    const LAS bf16* ap = A8 + (lane & 7) * 72 + q * 8; const LAS bf16* bp = Bt + (lane & 15) * 72 + q * 8;
#pragma unroll
    for (int k0 = 0; k0 < 64; k0 += 32) { const bf16x8 a = *(const LAS bf16x8*)(ap + k0); const bf16x8 b = *(const LAS bf16x8*)(bp + k0); acc = __builtin_amdgcn_mfma_f32_16x16x32_bf16(a, b, acc, 0, 0, 0); }
    return acc;
}
typedef float f32x2 __attribute__((ext_vector_type(2)));
template <bool DIR> __device__ __forceinline__ void rwkv_steps(const LAS float* OPS, const LAS float* VV, LAS float* YB, f32x4& S, int j, int row) {
    float yk0 = 0.f, yk1 = 0.f;
    const LAS float* opb = OPS + 4 * j; const LAS float* vpb = VV + row;
#define RWLD(W_, KK_, KA_, KM_, R_, V_, tl_) do { const LAS float* op_ = opb + (tl_) * 320; W_ = *(const LAS f32x4*)(op_); KK_ = *(const LAS f32x4*)(op_ + 64); KA_ = *(const LAS f32x4*)(op_ + 128); KM_ = *(const LAS f32x4*)(op_ + 192); R_ = *(const LAS f32x4*)(op_ + 256); V_ = vpb[(tl_) * 16]; } while (0)
    f32x4 w4, kk4, ka4, km4, r4, w4b, kk4b, ka4b, km4b, r4b; float vv, vvb;
    RWLD(w4, kk4, ka4, km4, r4, vv, (DIR ? 31 : 0));
    RWLD(w4b, kk4b, ka4b, km4b, r4b, vvb, (DIR ? 30 : 1));
#pragma unroll
    for (int i = 0; i < 32; ++i) {
        f32x4 nw4, nkk4, nka4, nkm4, nr4; float nvv;
        if (i < 30) RWLD(nw4, nkk4, nka4, nkm4, nr4, nvv, (DIR ? 29 - i : i + 2));
        f32x2 t2 = S.xy * kk4.xy; t2 = S.zw * kk4.zw + t2;
        float sa = t2.x + t2.y;
        const f32x4 pre_s = S * w4 + km4 * vv;
        sa = row16_sum(sa);
        S = pre_s + ka4 * sa;
        f32x2 y2 = S.xy * r4.xy; y2 = S.zw * r4.zw + y2;
        float y = y2.x + y2.y;
        y = row16_sum(y);
        if ((i & 15) == j) { if (i < 16) yk0 = y; else yk1 = y; }
        w4 = w4b; kk4 = kk4b; ka4 = ka4b; km4 = km4b; r4 = r4b; vv = vvb;
        if (i < 30) { w4b = nw4; kk4b = nkk4; ka4b = nka4; km4b = nkm4; r4b = nr4; vvb = nvv; } }
#undef RWLD
    YB[(DIR ? 31 - j : j) * 16 + row] = yk0; YB[(DIR ? 15 - j : 16 + j) * 16 + row] = yk1;
}
struct RwCtx { LAS bf16* WA; LAS bf16* WW; LAS bf16* XA; LAS bf16* XW; LAS bf16* RAWB; LAS float* MU; GAS float* CT; const GAS bf16* colsb;
    f32x4 kk_c4, ka_c4, rk_c4; float ba[4], bw[4]; float mup_[5][2], mun_[5][2]; int h, dir, qtr, tb0; size_t mb; };
template <int NTOK> __device__ __forceinline__ void rw_addr_init(int (&poff)[5], int (&prr)[5], int lane, int tb0, int h, int dir) {
    constexpr int NCHK = (NTOK + 2) * 40;
#pragma unroll
    for (int i = 0; i < 5; ++i) { const int idx = lane + 64 * i; const int rr = idx / 40, q = idx % 40, wh = q >> 3, c8 = q & 7;
        const int gc = (wh == 0 ? R_R + h * 64 : wh == 1 ? R_K + h * 64 : wh == 2 ? R_V + h * 64 : wh == 3 ? R_WDF + dir * 64 : R_AD) + c8 * 8;
        prr[i] = idx < NCHK ? tb0 - 1 + rr : -100000; poff[i] = (tb0 - 1 + rr) * NINP + gc; }
}
template <int NTOK> __device__ __forceinline__ void rw_issue(v4u (&pre)[5], const int (&poff)[5], const int (&prr)[5], const GAS bf16* colsb, int T0) {
    constexpr int NCH = ((NTOK + 2) * 40 + 63) / 64;
#pragma unroll
    for (int i = 0; i < NCH; ++i) { const int t = T0 + prr[i]; const bool ok = t >= 0 && t < SEQ;
        const v4u vv = *(const GAS v4u*)(colsb + (size_t)T0 * NINP + (ok ? poff[i] : 0)); pre[i] = ok ? vv : (v4u){0u, 0u, 0u, 0u}; }
}
template <int NTOK, bool FULLV> __device__ __forceinline__ void rw_prep(const RwCtx& C, const v4u (&pre)[5], LAS float* OPS, LAS float* VV, int T0, int lane) {
    constexpr int NCHK = (NTOK + 2) * 40, NCH = (NCHK + 63) / 64;
    const int j = lane & 15, c2 = (lane & 31) * 2;
#pragma unroll
    for (int i = 0; i < NCH; ++i) { const int idx = lane + 64 * i; if (idx < NCHK) *(LAS v4u*)(C.RAWB + idx * 8) = pre[i]; }
    LDS_WAIT(); asm volatile("" ::: "memory");
#pragma unroll
    for (int which = 0; which < 5; ++which)
#pragma unroll
        for (int pr = 0; pr < NTOK / 2; ++pr) { const int tt = 2 * pr + (lane >> 5), cc = which * 64 + c2, t = C.tb0 + tt;
            const unsigned r0 = *(const LAS unsigned*)(C.RAWB + tt * 320 + cc), r1 = *(const LAS unsigned*)(C.RAWB + (tt + 1) * 320 + cc), r2 = *(const LAS unsigned*)(C.RAWB + (tt + 2) * 320 + cc);
            const float p1x = bf2f(r1 & 0xffffu), p1y = bf2f(r1 >> 16);
            const float vx = p1x + C.mup_[which][0] * (bf2f(r0 & 0xffffu) - p1x) + C.mun_[which][0] * (bf2f(r2 & 0xffffu) - p1x);
            const float vy = p1y + C.mup_[which][1] * (bf2f(r0 >> 16) - p1y) + C.mun_[which][1] * (bf2f(r2 >> 16) - p1y);
            if (which == 0) *(LAS f32x2*)(OPS + t * 320 + 256 + c2) = (f32x2){vx, vy};
            else if (which == 1) *(LAS f32x2*)(OPS + t * 320 + 192 + c2) = (f32x2){vx, vy};
            else if (which == 2) { if (FULLV) *(LAS f32x2*)(VV + t * 64 + c2) = (f32x2){vx, vy}; else if ((c2 >> 4) == C.qtr) *(LAS f32x2*)(VV + t * 16 + (c2 & 15)) = (f32x2){vx, vy}; }
            else if (which == 3) { const float ex = __expf(2.f * vx), ey = __expf(2.f * vy);
                *(LAS unsigned*)(C.XW + tt * 72 + c2) = pk2(1.f - 2.f * __builtin_amdgcn_rcpf(ex + 1.f), 1.f - 2.f * __builtin_amdgcn_rcpf(ey + 1.f)); }
            else *(LAS unsigned*)(C.XA + tt * 72 + c2) = pk2(vx, vy); }
    LDS_WAIT(); asm volatile("" ::: "memory");
    { const bool hi = lane >= 32; const int lr = ((lane >> 4) & 1) * 4 + (hi ? 2 : 0); const bool ok0 = lr < NTOK, ok1 = lr + 1 < NTOK; const int tb = C.tb0 + lr;
#pragma unroll
      for (int ct = 0; ct < 4; ++ct) { const f32x4 z = {0.f, 0.f, 0.f, 0.f};
        const f32x4 ca = mma16_a8(C.XA, C.WA + ct * 16 * 72, z, lane), cw = mma16_a8(C.XW, C.WW + ct * 16 * 72, z, lane);
        const int c = ct * 16 + j;
        const float a0v = hi ? ca[2] : ca[0], a1v = hi ? ca[3] : ca[1], w0v = hi ? cw[2] : cw[0], w1v = hi ? cw[3] : cw[1];
        if (ok0) { OPS[tb * 320 + 128 + c] = sigmoidf_(C.ba[ct] + a0v); OPS[tb * 320 + c] = __expf(-0.6065306597f * sigmoidf_(C.bw[ct] + w0v)); }
        if (ok1) { OPS[(tb + 1) * 320 + 128 + c] = sigmoidf_(C.ba[ct] + a1v); OPS[(tb + 1) * 320 + c] = __expf(-0.6065306597f * sigmoidf_(C.bw[ct] + w1v)); } } }
    LDS_WAIT(); asm volatile("" ::: "memory");
#pragma unroll
    for (int ps = 0; ps < (NTOK + 3) / 4; ++ps) { const int tl = 4 * ps + (lane >> 4); const bool ok = tl < NTOK; const int t = C.tb0 + (ok ? tl : 0); LAS float* op = OPS + t * 320 + 4 * j;
        const f32x4 av = *(const LAS f32x4*)(op + 128), kp = *(const LAS f32x4*)(op + 192), rp = *(const LAS f32x4*)(op + 256);
        const f32x4 kr = kp * C.kk_c4; const float ss = row16_sum((kr.x * kr.x + kr.y * kr.y) + (kr.z * kr.z + kr.w * kr.w));
        const f32x4 kkv = kr * (1.f / fmaxf(sqrtf(ss), 1e-12f));
        const f32x4 km = kp * ((av - 1.f) * C.ka_c4 + 1.f);
        const f32x4 q = rp * km * C.rk_c4; const float cs = row16_sum((q.x + q.y) + (q.z + q.w));
        if (ok) { *(LAS f32x4*)(op + 64) = kkv; *(LAS f32x4*)(op + 128) = kkv * (-av); *(LAS f32x4*)(op + 192) = km;
            if (C.dir == 0 && C.qtr == 0 && j == 0) C.CT[(C.mb + T0 + t) * 8 + C.h] = cs; } }
}

constexpr int RW_NSLOT = 6, RW_SLOT_WORDS = 32 * 320 + 32 * 64;
constexpr size_t WS_RING = 248 * MiB;
constexpr int CW_RW = 8192;
__device__ __forceinline__ unsigned rw_ld(GAS unsigned* p) { return __hip_atomic_load(p, __ATOMIC_RELAXED, __HIP_MEMORY_SCOPE_AGENT); }
__device__ __forceinline__ void rw_st(GAS unsigned* p, unsigned v) { __hip_atomic_store(p, v, __ATOMIC_RELAXED, __HIP_MEMORY_SCOPE_AGENT); }
__device__ __forceinline__ void rwkv_produce(const Frame& F, int l, int p, int pp, unsigned G0) {
    const int b = p / 12, rem = p % 12, h = rem >> 1, dir = rem & 1;
    const GAS bf16* cols = (const GAS bf16*)(WSP(F) + WS_COLS);
    const int tid = F.tid, lane = F.lane, wave = F.wave;
    LAS bf16* WA = (LAS bf16*)(F.lds); LAS bf16* WW = (LAS bf16*)(F.lds + 9216);
    LAS float* MU = (LAS float*)(F.lds + 67584);
    LAS float* OPS = (LAS float*)(F.lds + 70144);
    LAS float* VV = (LAS float*)(F.lds + 111104);
    LAS unsigned* flg = (LAS unsigned*)(F.lds + 119296);
    GAS unsigned* ctl = (GAS unsigned*)(WSP(F) + WS_CTL) + CW_RW + 384 * p;
    GAS unsigned long long* ring = (GAS unsigned long long*)(WSP(F) + WS_RING) + (size_t)p * RW_NSLOT * (RW_SLOT_WORDS / 2);
    constexpr int NB = SEQ / 32;
    __syncthreads();
    { const GAS float* aup = INP(F, 13) + (size_t)l * 64 * 384; const GAS float* wup = INP(F, 11) + (size_t)(l * 2 + dir) * 64 * 384;
      for (int idx = tid; idx < 4096; idx += 512) { const int i = idx >> 6, c = idx & 63;
          WA[c * 72 + i] = (bf16)f2bf(aup[i * 384 + h * 64 + c]); WW[c * 72 + i] = (bf16)f2bf(wup[i * 384 + h * 64 + c]); }
      if (tid < 320) { const int which = tid >> 6, c = tid & 63;
          const int rc = which == 0 ? h * 64 + c : which == 1 ? 384 + h * 64 + c : which == 2 ? 768 + h * 64 + c : which == 3 ? 1152 + dir * 64 + c : 1280 + c;
          MU[tid] = INP(F, 8)[l * 1472 + rc]; MU[320 + tid] = INP(F, 9)[l * 1472 + rc]; } }
    __syncthreads();
    const size_t mb = (size_t)b * SEQ;
    const int j = lane & 15;
    RwCtx C;
    C.WA = WA; C.WW = WW; C.XA = (LAS bf16*)(F.lds + 18432) + wave * 576; C.XW = (LAS bf16*)(F.lds + 27648) + wave * 576;
    C.RAWB = (LAS bf16*)(F.lds + 36864) + wave * 1920;
    C.MU = MU; C.CT = (GAS float*)(WSP(F) + WS_CT); C.colsb = cols + mb * NINP; C.h = h; C.dir = dir; C.qtr = 0; C.mb = mb; C.tb0 = 4 * wave;
    { const int hc4 = h * 64 + 4 * j;
      C.kk_c4 = *(const GAS f32x4*)(INP(F, 15) + l * 384 + hc4); C.ka_c4 = *(const GAS f32x4*)(INP(F, 16) + l * 384 + hc4); C.rk_c4 = *(const GAS f32x4*)(INP(F, 17) + l * 384 + hc4);
#pragma unroll
      for (int ct = 0; ct < 4; ++ct) { C.ba[ct] = INP(F, 12)[l * 384 + h * 64 + 16 * ct + j]; C.bw[ct] = INP(F, 10)[(l * 2 + dir) * 384 + h * 64 + 16 * ct + j]; }
      const int c2 = (lane & 31) * 2;
#pragma unroll
      for (int wq = 0; wq < 5; ++wq) { C.mup_[wq][0] = MU[wq * 64 + c2]; C.mup_[wq][1] = MU[wq * 64 + c2 + 1]; C.mun_[wq][0] = MU[320 + wq * 64 + c2]; C.mun_[wq][1] = MU[320 + wq * 64 + c2 + 1]; } }
    v4u pre[5]; int poff[5], prr[5];
    rw_addr_init<4>(poff, prr, lane, C.tb0, h, dir);
    rw_issue<4>(pre, poff, prr, C.colsb, dir ? SEQ - 32 * (pp + 1) : 32 * pp);
    bool dead = false; unsigned mseen = G0;
    GAS unsigned* myflag = ctl + 320 * pp; const unsigned PB = G0 / 2;
#pragma unroll 1
    for (int it = pp; it < NB; it += 2) {
        const int T0 = dir ? SEQ - 32 * (it + 1) : 32 * it;
        v4u cur[5];
#pragma unroll
        for (int i = 0; i < 5; ++i) cur[i] = pre[i];
        if (it + 2 < NB) rw_issue<4>(pre, poff, prr, C.colsb, dir ? SEQ - 32 * (it + 3) : 32 * (it + 2));
        rw_prep<4, true>(C, cur, OPS, VV, T0, lane);
        if (tid == 0) { const unsigned need = G0 + (unsigned)it + 1u; unsigned sp = 0u;
            if (need > (unsigned)RW_NSLOT && !dead) { const unsigned want = need - (unsigned)RW_NSLOT;
                while (mseen < want) { if (++sp > (1u << 17)) { dead = true; break; } __builtin_amdgcn_s_sleep(2);
                    const unsigned m01 = min(rw_ld(ctl + 64), rw_ld(ctl + 128)), m23 = min(rw_ld(ctl + 192), rw_ld(ctl + 256)); mseen = min(m01, m23); } }
            flg[0] = sp; }
        __syncthreads();
        { GAS unsigned long long* slot = ring + (size_t)((G0 + (unsigned)it) % RW_NSLOT) * (RW_SLOT_WORDS / 2);
          const LAS v4u* src = (const LAS v4u*)OPS;
#pragma unroll
          for (int i = 0; i < 6; ++i) { const int idx = tid + 512 * i; const v4u d = src[idx]; GAS v4u* dst = (GAS v4u*)slot + idx;
              asm volatile("global_store_dwordx4 %0, %1, off sc1\n\ts_nop 1" :: "v"(dst), "v"(d) : "memory"); } }
        asm volatile("s_waitcnt vmcnt(10)" ::: "memory");
        __syncthreads();
        if (tid == 0 && it >= 2) rw_st(myflag, PB + (unsigned)(it >> 1));
    }
    asm volatile("s_waitcnt vmcnt(0)" ::: "memory");
    __syncthreads();
    if (tid == 0) rw_st(myflag, PB + (unsigned)(NB / 2));
    __syncthreads();
}
__device__ __forceinline__ void rwkv_scan(const Frame& F, int l, int p, int qtr, unsigned G0) {
    const int b = p / 12, rem = p % 12, h = rem >> 1, dir = rem & 1;
    GAS bf16* Y = (GAS bf16*)(WSP(F) + (dir ? Y_RB : Y_RF));
    const int lane = F.lane, wave = F.wave;
    LAS float* OPSb = (LAS float*)(F.lds);
    LAS float* VVb = (LAS float*)(F.lds + 81920);
    LAS float* YBb = (LAS float*)(F.lds + 86016);
    GAS unsigned* ctl = (GAS unsigned*)(WSP(F) + WS_CTL) + CW_RW + 384 * p;
    const GAS unsigned long long* ring = (const GAS unsigned long long*)(WSP(F) + WS_RING) + (size_t)p * RW_NSLOT * (RW_SLOT_WORDS / 2);
    constexpr int NB = SEQ / 32;
    const size_t mb = (size_t)b * SEQ;
    const int j = lane & 15;
    __syncthreads();
    if (wave < 4) {
        const int lt = wave * 64 + lane;
        bool dead = false; unsigned pseen0 = G0 / 2, pseen1 = G0 / 2;
        unsigned long long va[21], vb[21];
#define RW_FETCH(v_, k_) do { const unsigned need_ = G0 / 2 + (unsigned)((k_) >> 1) + 1u; unsigned sp_ = 0u; GAS unsigned* fl_ = ctl + 320 * ((k_) & 1); \
            if (!dead) { unsigned ps_ = ((k_) & 1) ? pseen1 : pseen0; while (ps_ < need_) { ps_ = rw_ld(fl_); if (ps_ >= need_) break; if (++sp_ > (1u << 17)) { dead = true; break; } __builtin_amdgcn_s_sleep(2); } if ((k_) & 1) pseen1 = ps_; else pseen0 = ps_; } \
            const GAS unsigned long long* slot_ = ring + (size_t)((G0 + (unsigned)(k_)) % RW_NSLOT) * (RW_SLOT_WORDS / 2); \
            _Pragma("unroll") for (int i_ = 0; i_ < 20; ++i_) v_[i_] = __hip_atomic_load(slot_ + lt + 256 * i_, __ATOMIC_RELAXED, __HIP_MEMORY_SCOPE_AGENT); \
            v_[20] = __hip_atomic_load(slot_ + 5120 + (lt >> 3) * 32 + qtr * 8 + (lt & 7), __ATOMIC_RELAXED, __HIP_MEMORY_SCOPE_AGENT); } while (0)
#define RW_LITER(v_, k_) do { if ((k_) >= 1 && lt == 0) rw_st(ctl + 64 * (qtr + 1), G0 + (unsigned)(k_)); \
            if ((k_) < NB) { LAS unsigned long long* dO_ = (LAS unsigned long long*)(OPSb + ((k_) & 1) * 10240); LAS unsigned long long* dV_ = (LAS unsigned long long*)(VVb + ((k_) & 1) * 512); \
                _Pragma("unroll") for (int i_ = 0; i_ < 20; ++i_) dO_[lt + 256 * i_] = v_[i_]; dV_[lt] = v_[20]; \
                if ((k_) + 2 < NB) RW_FETCH(v_, (k_) + 2); } \
            if ((k_) >= 2) { const int bk_ = (k_) - 2; const int T0_ = dir ? SEQ - 32 * (bk_ + 1) : 32 * bk_; const LAS float* YB_ = YBb + (bk_ & 1) * 512; \
                const int idx_ = lt * 2, tl_ = idx_ >> 4, rw_ = idx_ & 15; \
                *(GAS unsigned*)(Y + (mb + T0_ + tl_) * 384 + h * 64 + 16 * qtr + rw_) = pk2(YB_[idx_], YB_[idx_ + 1]); } \
            __syncthreads(); } while (0)
        RW_FETCH(va, 0); RW_FETCH(vb, 1);
#pragma unroll 1
        for (int it = 0; it < NB; it += 2) { RW_LITER(va, it); RW_LITER(vb, it + 1); }
        RW_LITER(va, NB);
#undef RW_FETCH
#undef RW_LITER
        { const int bk = NB - 1; const int T0 = dir ? SEQ - 32 * (bk + 1) : 32 * bk; const LAS float* YB = YBb + (bk & 1) * 512;
          const int idx = lt * 2, tl = idx >> 4, rw = idx & 15;
          *(GAS unsigned*)(Y + (mb + T0 + tl) * 384 + h * 64 + 16 * qtr + rw) = pk2(YB[idx], YB[idx + 1]); }
    } else {
        const int row = (wave - 4) * 4 + (lane >> 4);
        f32x4 S = {0.f, 0.f, 0.f, 0.f};
#pragma unroll 1
        for (int it = 0; it <= NB; ++it) {
            if (it >= 1) { const int bk = it - 1;
                const LAS float* OPS = OPSb + (bk & 1) * 10240; const LAS float* VV = VVb + (bk & 1) * 512; LAS float* YB = YBb + (bk & 1) * 512;
                if (dir) rwkv_steps<true>(OPS, VV, YB, S, j, row); else rwkv_steps<false>(OPS, VV, YB, S, j, row);
            }
            __syncthreads();
        }
    }
    __syncthreads();
}
__device__ __forceinline__ float row8_sum(float v) { v += dppf<0xB1>(v); v += dppf<0x4E>(v); v += dppf<0x141>(v); return v; }
__device__ __forceinline__ void mlstm_seq(const Frame& F, int l, int task, int cfull0, int cend) {
    const int b = task >> 3, h = (task >> 1) & 3, dir = task & 1;
    const GAS bf16* cols = (const GAS bf16*)(WSP(F) + WS_COLS); const GAS float* GT = (const GAS float*)(WSP(F) + WS_GATES);
    GAS bf16* Y = (GAS bf16*)(WSP(F) + (dir ? Y_AB : Y_AF));
    LAS bf16* RAWQ = (LAS bf16*)(F.lds);
    LAS bf16* Qs = (LAS bf16*)(F.lds + 17408); LAS bf16* Ks = (LAS bf16*)(F.lds + 26624);
    LAS bf16* Vtb = (LAS bf16*)(F.lds + 35840);
    LAS bf16* KWt = (LAS bf16*)(F.lds + 54272); LAS bf16* Ps = (LAS bf16*)(F.lds + 63488);
    LAS bf16* Ctb = (LAS bf16*)(F.lds + 72704);
    LAS float* ub = (LAS float*)(F.lds + 91136);
    LAS float* blb = ub + 128; LAS float* rmb = ub + 256;
    LAS float* den = ub + 384; LAS float* qn = ub + 448; LAS float* nst = ub + 512; LAS float* scb = ub + 576;
    const int tid = F.tid, lane = F.lane, wave = F.wave;
    const size_t mb = (size_t)b * SEQ;
    constexpr int NC = SEQ / 64;
    __syncthreads();
    for (int i = tid; i < 2 * 64 * 72; i += 512) Ctb[i] = 0;
    if (tid < 64) nst[tid] = 0.f;
    const int cc = tid & 127, isK = cc >> 6, d0 = cc & 63, chn = isK * 256 + h * 64 + d0;
    float cw[5]; const GAS float* cwp = INP(F, 3) + (size_t)l * 5 * 512;
#pragma unroll
    for (int jj = 0; jj < 5; ++jj) cw[jj] = cwp[jj * 512 + chn];
    const float cbv = INP(F, 4)[l * 512 + chn];
    f32x4 st[2] = {{0.f, 0.f, 0.f, 0.f}, {0.f, 0.f, 0.f, 0.f}};
    float m_st = 0.f;
    v4u pre[3], prev; float gli = 0.f, glf = 0.f;
#define ML_ISSUE(c_) do { const int tlo_ = dir ? SEQ - 64 * ((c_) + 1) : 64 * (c_); _Pragma("unroll") for (int i_ = 0; i_ < 3; ++i_) { const int ch_ = tid + 512 * i_; pre[i_] = (v4u){0u, 0u, 0u, 0u}; \
        if (ch_ < 68 * 16) { const int rr_ = ch_ >> 4, q_ = ch_ & 15; const int t_ = tlo_ - 2 + rr_; if (t_ >= 0 && t_ < SEQ) pre[i_] = *(const GAS v4u*)(cols + (mb + t_) * NINP + (q_ >> 3) * 256 + h * 64 + (q_ & 7) * 8); } } \
        prev = *(const GAS v4u*)(cols + (mb + tlo_ + (tid >> 3)) * NINP + A_V + h * 64 + (tid & 7) * 8); \
        if (tid < 64) { const int t_ = dir ? tlo_ + 63 - tid : tlo_ + tid; gli = GT[(mb + t_) * 16 + dir * 4 + h]; glf = GT[(mb + t_) * 16 + 8 + dir * 4 + h]; } } while (0)
#define ML_FILL(c_) do { _Pragma("unroll") for (int i_ = 0; i_ < 3; ++i_) { const int ch_ = tid + 512 * i_; if (ch_ < 68 * 16) *(LAS v4u*)(RAWQ + (ch_ >> 4) * 128 + (ch_ & 15) * 8) = pre[i_]; } \
        { LAS bf16* Vt_ = Vtb + ((c_) & 1) * 4608; const int tl_ = tid >> 3, e8_ = tid & 7; const int lp_ = dir ? 63 - tl_ : tl_; const unsigned w_[4] = {prev.x, prev.y, prev.z, prev.w}; \
          _Pragma("unroll") for (int k_ = 0; k_ < 4; ++k_) { const int e_ = e8_ * 8 + 2 * k_; Vt_[e_ * 72 + swz64(e_, lp_)] = (bf16)(w_[k_] & 0xffffu); Vt_[(e_ + 1) * 72 + swz64(e_ + 1, lp_)] = (bf16)(w_[k_] >> 16); } } \
        if (tid < 64) { const float bl_ = wave_scan_add(glf); \
            const float u_ = gli - bl_; const float rm_ = wave_scan_max(u_); \
            ub[((c_) & 1) * 64 + tid] = u_; blb[((c_) & 1) * 64 + tid] = bl_; rmb[((c_) & 1) * 64 + tid] = rm_; if (tid == 63) { scb[((c_) & 1) * 2] = rm_; scb[((c_) & 1) * 2 + 1] = bl_; } } } while (0)
    ML_ISSUE(0); ML_FILL(0); ML_ISSUE(1);
    __syncthreads();
    if (cfull0 > 0) {
        const int dk = tid & 63; float cwk[5]; { const GAS float* cwq = INP(F, 3) + (size_t)l * 5 * 512;
#pragma unroll
            for (int jj = 0; jj < 5; ++jj) cwk[jj] = cwq[jj * 512 + 256 + h * 64 + dk]; }
        const float cbk = INP(F, 4)[l * 512 + 256 + h * 64 + dk];
#pragma unroll 1
        for (int c = 0; c < cfull0; ++c) {
            const LAS float* u = ub + (c & 1) * 64;
            const LAS bf16* Vt = Vtb + (c & 1) * 4608; LAS bf16* Ctn = Ctb + ((c + 1) & 1) * 4608;
            const float umax = scb[(c & 1) * 2], tot = scb[(c & 1) * 2 + 1];
#pragma unroll 2
            for (int i = 0; i < 8; ++i) { const int tl = (tid >> 6) + 8 * i; float s = cbk;
#pragma unroll
                for (int jj = 0; jj < 5; ++jj) s += cwk[jj] * bf2f(RAWQ[(tl + jj) * 128 + 64 + dk]);
                const int lp = dir ? 63 - tl : tl;
                KWt[dk * 72 + swz64(dk, lp)] = (bf16)f2bf(siluf_(s) * 0.125f * __expf(u[lp] - umax)); }
            __syncthreads();
            const float mmax = fmaxf(m_st, umax), s_old = __expf(m_st - mmax), s_new = __expf(umax - mmax);
#pragma unroll
            for (int k = 0; k < 2; ++k) { const int ti = 2 * wave + k, t0_ = ti >> 2, t1_ = ti & 3; const f32x4 z = {0.f, 0.f, 0.f, 0.f};
                const f32x4 lc = mma16s<true, true>(Vt, 72, t0_ * 16, KWt, 72, t1_ * 16, z, lane);
#pragma unroll
                for (int jj = 0; jj < 4; ++jj) { const int r_ = t0_ * 16 + (lane >> 4) * 4 + jj, c_ = t1_ * 16 + (lane & 15);
                    st[k][jj] = s_old * st[k][jj] + s_new * lc[jj]; Ctn[r_ * 72 + c_] = (bf16)f2bf(st[k][jj]); } }
            { const int dq = tid >> 3, part = tid & 7; float s = 0.f;
#pragma unroll
              for (int k = 0; k < 8; ++k) s += bf2f(KWt[dq * 72 + swz64(dq, part * 8) + k]);
              s = row8_sum(s); if (part == 0) nst[dq] = s_old * nst[dq] + s_new * s; }
            m_st = tot + mmax;
            ML_FILL(c + 1); if (c + 2 < cend) ML_ISSUE(c + 2);
            __syncthreads();
        }
    }
#pragma unroll 1
    for (int c = cfull0; c < cend; ++c) {
        const bool full = c >= cfull0;
        const int tlo = dir ? SEQ - 64 * (c + 1) : 64 * c;
        const LAS float* u = ub + (c & 1) * 64; const LAS float* bl = blb + (c & 1) * 64; const LAS float* rm = rmb + (c & 1) * 64;
        const LAS bf16* Vt = Vtb + (c & 1) * 4608; const LAS bf16* Ct = Ctb + (c & 1) * 4608; LAS bf16* Ctn = Ctb + ((c + 1) & 1) * 4608;
#pragma unroll 4
        for (int i = 0; i < 16; ++i) { const int tl = (tid >> 7) + 4 * i; float s = cbv;
#pragma unroll
            for (int jj = 0; jj < 5; ++jj) s += cw[jj] * bf2f(RAWQ[(tl + jj) * 128 + cc]);
            s = siluf_(s); const int lpos = dir ? 63 - tl : tl;
            if (isK) Ks[lpos * 72 + d0] = (bf16)f2bf(s * 0.125f); else Qs[lpos * 72 + d0] = (bf16)f2bf(s); }
        if (tid < 64) den[tid] = 0.f;
        __syncthreads();
        const float umax = scb[(c & 1) * 2], tot = scb[(c & 1) * 2 + 1];
        for (int idx = tid; idx < 4096; idx += 512) { const int lp = idx >> 6, d = idx & 63; KWt[d * 72 + swz64(d, lp)] = (bf16)f2bf(bf2f(Ks[lp * 72 + d]) * __expf(u[lp] - umax)); }
        if (full) {
#pragma unroll
        for (int k = 0; k < 2; ++k) { const int ti = 2 * wave + k, tl_ = ti >> 2, ts = ti & 3; f32x4 acc = {0.f, 0.f, 0.f, 0.f};
            if (ts <= tl_) acc = mma16<64>(Qs + tl_ * 16 * 72, 72, Ks + ts * 16 * 72, 72, acc, lane);
#pragma unroll
            for (int jj = 0; jj < 4; ++jj) { const int lr = tl_ * 16 + (lane >> 4) * 4 + jj, s = ts * 16 + (lane & 15);
                const float v = (s <= lr) ? acc[jj] * __expf(u[s] - fmaxf(m_st, rm[lr])) : 0.f; const unsigned vb = f2bf(v); Ps[lr * 72 + s] = (bf16)vb;
                if (ts <= tl_) { const float rs = row16_sum(bf2f(vb)); if ((lane & 15) == 0) __hip_atomic_fetch_add(den + lr, rs, __ATOMIC_RELAXED, __HIP_MEMORY_SCOPE_WORKGROUP); } } }
        { const int lq = tid >> 3, part = tid & 7; float s = 0.f;
#pragma unroll
          for (int k = 0; k < 8; ++k) s += bf2f(Qs[lq * 72 + part * 8 + k]) * nst[part * 8 + k];
          s = row8_sum(s); if (part == 0) qn[lq] = s; }
        }
        __syncthreads();
        const float mmax = fmaxf(m_st, umax), s_old = __expf(m_st - mmax), s_new = __expf(umax - mmax);
#pragma unroll
        for (int k = 0; k < 2; ++k) { const int ti = 2 * wave + k, t0_ = ti >> 2, t1_ = ti & 3; const f32x4 z = {0.f, 0.f, 0.f, 0.f};
            f32x4 a1 = z, a2 = z;
            if (full) { a1 = mma16s<false, true>(Ps, 72, t0_ * 16, Vt, 72, t1_ * 16, z, lane); a2 = mma16<64>(Qs + t0_ * 16 * 72, 72, Ct + t1_ * 16 * 72, 72, z, lane); }
            const f32x4 lc = mma16s<true, true>(Vt, 72, t0_ * 16, KWt, 72, t1_ * 16, z, lane);
#pragma unroll
            for (int jj = 0; jj < 4; ++jj) { const int r_ = t0_ * 16 + (lane >> 4) * 4 + jj, c_ = t1_ * 16 + (lane & 15);
                if (full) { const float mx = fmaxf(m_st, rm[r_]), iwv = __expf(m_st - mx);
                const float dn = den[r_] + iwv * qn[r_];
                const float val = (a1[jj] + iwv * a2[jj]) / fmaxf(fabsf(dn), __expf(-(bl[r_] + mx)));
                const int t = dir ? tlo + 63 - r_ : tlo + r_;
                Y[(mb + t) * 256 + h * 64 + c_] = (bf16)f2bf(val); }
                st[k][jj] = s_old * st[k][jj] + s_new * lc[jj];
                Ctn[r_ * 72 + c_] = (bf16)f2bf(st[k][jj]); } }
        { const int dq = tid >> 3, part = tid & 7; float s = 0.f;
#pragma unroll
          for (int k = 0; k < 8; ++k) s += bf2f(KWt[dq * 72 + swz64(dq, part * 8) + k]);
          s = row8_sum(s); if (part == 0) nst[dq] = s_old * nst[dq] + s_new * s; }
        m_st = tot + mmax;
        if (c + 1 < cend) { ML_FILL(c + 1); if (c + 2 < cend) ML_ISSUE(c + 2); }
        __syncthreads();
    }
#undef ML_ISSUE
#undef ML_FILL
}
__device__ __forceinline__ void phase_ssd_conv(const Frame& F, int l) {
    const GAS bf16* cols = (const GAS bf16*)(WSP(F) + WS_COLS); GAS bf16* XBC = (GAS bf16*)(WSP(F) + WS_XN);
    LAS bf16* raw = (LAS bf16*)(F.lds);
    const GAS float* cwp = INP(F, 20) + (size_t)l * 5 * 896; const GAS float* cbp = INP(F, 21) + l * 896;
    const int tid = F.tid;
    float cw0[5], cw1[5]; const int c1 = tid + 512 < 896 ? tid + 512 : tid;
#pragma unroll
    for (int jj = 0; jj < 5; ++jj) { cw0[jj] = cwp[jj * 896 + tid]; cw1[jj] = cwp[jj * 896 + c1]; }
    const float cb0 = cbp[tid], cb1 = cbp[c1];
    GAS float* DTV = (GAS float*)(WSP(F) + WS_DTV); const GAS float* dtbp = INP(F, 22) + l * 12;
    for (int tile = F.vcu; tile < M / 32; tile += F.G) {
        const int m0 = tile * 32, t0 = m0 % SEQ;
        __syncthreads();
        if (tid < 384) { const int tt = tid / 12, k = tid % 12; const float x = bf2f(cols[(size_t)(m0 + tt) * NINP + S_DT + k]) + dtbp[k]; DTV[(size_t)(m0 + tt) * 12 + k] = x > 20.f ? x : log1pf(__expf(x)); }
        for (int ch = tid; ch < 36 * 112; ch += 512) { const int rr = ch / 112, cc = ch % 112; const int t = t0 - 2 + rr;
            v4u v = {0u, 0u, 0u, 0u}; if (t >= 0 && t < SEQ) v = *(const GAS v4u*)(cols + (size_t)(m0 - 2 + rr) * NINP + S_X + cc * 8);
            *(LAS v4u*)(raw + rr * 896 + cc * 8) = v; }
        __syncthreads();
#pragma unroll
        for (int half = 0; half < 2; ++half) { const int c = half ? c1 : tid; if (half && tid + 512 >= 896) break;
            float win[5];
#pragma unroll
            for (int jj = 0; jj < 4; ++jj) win[jj] = bf2f(raw[jj * 896 + c]);
            for (int tl = 0; tl < 32; ++tl) { win[4] = bf2f(raw[(tl + 4) * 896 + c]);
                float s = half ? cb1 : cb0;
#pragma unroll
                for (int jj = 0; jj < 5; ++jj) s += (half ? cw1[jj] : cw0[jj]) * win[jj];
#pragma unroll
                for (int jj = 0; jj < 4; ++jj) win[jj] = win[jj + 1];
                XBC[(size_t)(m0 + tl) * 896 + c] = (bf16)f2bf(siluf_(s)); } }
    }
    __syncthreads();
}
__device__ __forceinline__ void ssd_seq(const Frame& F, int l, int task, int cfull0, int cend) {
    const int b = task / 12, rem = task % 12, head = rem >> 1, dir = rem & 1, g = head / 3;
    const GAS bf16* cols = (const GAS bf16*)(WSP(F) + WS_COLS); const GAS bf16* XBC = (const GAS bf16*)(WSP(F) + WS_XN);
    GAS bf16* Y = (GAS bf16*)(WSP(F) + (dir ? Y_SB : Y_SF));
    LAS bf16* Cm = (LAS bf16*)(F.lds); LAS bf16* Bm = (LAS bf16*)(F.lds + 17408);
    LAS bf16* Btw = (LAS bf16*)(F.lds + 34816); LAS bf16* Xt = (LAS bf16*)(F.lds + 53248);
    LAS bf16* Ps = (LAS bf16*)(F.lds + 62464); LAS bf16* Hs = (LAS bf16*)(F.lds + 71680);
    LAS float* dtvb = (LAS float*)(F.lds + 89088);
    LAS float* acsb = dtvb + 128;
    LAS float* totb = dtvb + 256;
    const int tid = F.tid, lane = F.lane, wave = F.wave;
    const size_t mb = (size_t)b * SEQ;
    constexpr int NC = SEQ / 64;
    __syncthreads();
    for (int i = tid; i < 64 * 136; i += 512) Hs[i] = 0;
    const GAS float* DTV = (const GAS float*)(WSP(F) + WS_DTV);
    const float aneg = -__expf(INP(F, 23)[(l * 2 + dir) * 6 + head]);
    f32x4 st[4];
#pragma unroll
    for (int k = 0; k < 4; ++k) st[k] = (f32x4){0.f, 0.f, 0.f, 0.f};
    v4u pre[5]; float dtraw = 0.f;
#define SSD_ISSUE(c_) do { const int tlo_ = dir ? SEQ - 64 * ((c_) + 1) : 64 * (c_); _Pragma("unroll") for (int i_ = 0; i_ < 5; ++i_) { const int idx_ = tid + 512 * i_; const int tl_ = idx_ / 40, q_ = idx_ % 40; \
        const int gc_ = q_ < 8 ? head * 64 + q_ * 8 : (q_ < 24 ? 384 + g * 128 + (q_ - 8) * 8 : 640 + g * 128 + (q_ - 24) * 8); \
        pre[i_] = *(const GAS v4u*)(XBC + (mb + tlo_ + tl_) * 896 + gc_); } } while (0)
#define SSD_DTLOAD(c_) do { if (tid < 64) { const int tlo_ = dir ? SEQ - 64 * ((c_) + 1) : 64 * (c_); const int t_ = dir ? tlo_ + 63 - tid : tlo_ + tid; dtraw = DTV[(mb + t_) * 12 + dir * 6 + head]; } } while (0)
#define SSD_DTCALC(c_) do { if (tid < 64) { const float dt_ = dtraw; float cs_ = dt_ * aneg; \
        cs_ = wave_scan_add(cs_); \
        const float tt_ = __builtin_bit_cast(float, __builtin_amdgcn_readlane(__builtin_bit_cast(int, cs_), 63)); dtvb[((c_) & 1) * 64 + tid] = dt_; acsb[((c_) & 1) * 64 + tid] = cs_; if (tid == 0) totb[(c_) & 1] = tt_; } } while (0)
    int lgo[3], llp[3], lq[3]; v4u prel[3];
#pragma unroll
    for (int i = 0; i < 3; ++i) { const int idx = tid + 512 * i; const int tl = idx / 24, q = idx % 24; lq[i] = q; llp[i] = dir ? 63 - tl : tl;
        lgo[i] = tl * 896 + (q < 8 ? head * 64 + q * 8 : 384 + g * 128 + (q - 8) * 8); }
#define SSD_ISSUE_L(dst_, c_) do { const int tlo_ = dir ? SEQ - 64 * ((c_) + 1) : 64 * (c_); const GAS bf16* b_ = XBC + (mb + tlo_) * 896; _Pragma("unroll") for (int i_ = 0; i_ < 3; ++i_) dst_[i_] = *(const GAS v4u*)(b_ + lgo[i_]); } while (0)
    v4u preN[3];
    if (cfull0 > 0) { SSD_ISSUE_L(prel, 0); if (cfull0 > 1) SSD_ISSUE_L(preN, 1); } else SSD_ISSUE(0);
    SSD_DTLOAD(0); SSD_DTCALC(0); SSD_DTLOAD(1);
    __syncthreads();
    if (cfull0 > 0) {
#pragma unroll 1
        for (int c = 0; c < cfull0; ++c) {
            LAS bf16* Xl = (c & 1) ? (LAS bf16*)(F.lds + 92160) : Xt; LAS bf16* Bl = (c & 1) ? (LAS bf16*)(F.lds + 101376) : Btw;
            const LAS float* dtv = dtvb + (c & 1) * 64; const LAS float* acs = acsb + (c & 1) * 64; const float tot = totb[c & 1];
#pragma unroll
            for (int i = 0; i < 3; ++i) { const int q = lq[i], lp = llp[i];
                const unsigned w[4] = {prel[i].x, prel[i].y, prel[i].z, prel[i].w};
                if (q < 8) {
#pragma unroll
                    for (int k = 0; k < 4; ++k) { const int p0 = q * 8 + 2 * k; Xl[p0 * 72 + swz64(p0, lp)] = (bf16)(w[k] & 0xffffu); Xl[(p0 + 1) * 72 + swz64(p0 + 1, lp)] = (bf16)(w[k] >> 16); } }
                else { const int n0 = (q - 8) * 8; const float sc = dtv[lp] * __expf(tot - acs[lp]);
#pragma unroll
                    for (int k = 0; k < 4; ++k) { const int nn = n0 + 2 * k; Bl[nn * 72 + swz64(nn, lp)] = (bf16)f2bf(bf2f(w[k] & 0xffffu) * sc); Bl[(nn + 1) * 72 + swz64(nn + 1, lp)] = (bf16)f2bf(bf2f(w[k] >> 16) * sc); } } }
            if (c + 1 < cfull0) {
#pragma unroll
                for (int i = 0; i < 3; ++i) prel[i] = preN[i];
                if (c + 2 < cfull0) SSD_ISSUE_L(preN, c + 2); }
            else SSD_ISSUE(c + 1);
            SSD_DTCALC(c + 1); if (c + 2 < cend) SSD_DTLOAD(c + 2);
            __syncthreads();
            const float cdec = __expf(tot);
#pragma unroll
            for (int k = 0; k < 4; ++k) { const int ti = 4 * wave + k, tp = ti >> 3, tn = ti & 7; const f32x4 z = {0.f, 0.f, 0.f, 0.f};
                const f32x4 lcv = mma16s<true, true>(Xl, 72, tp * 16, Bl, 72, tn * 16, z, lane);
                st[k] = st[k] * cdec + lcv; }
        }
#pragma unroll
        for (int k = 0; k < 4; ++k) { const int ti = 4 * wave + k, tp = ti >> 3, tn = ti & 7;
#pragma unroll
            for (int jj = 0; jj < 4; ++jj) { const int p = tp * 16 + (lane >> 4) * 4 + jj, n = tn * 16 + (lane & 15); Hs[p * 136 + n] = (bf16)f2bf(st[k][jj]); } }
        __syncthreads();
    }
#pragma unroll 1
    for (int c = cfull0; c < cend; ++c) {
        const bool full = c >= cfull0;
        const int tlo = dir ? SEQ - 64 * (c + 1) : 64 * c;
        const LAS float* dtv = dtvb + (c & 1) * 64; const LAS float* acs = acsb + (c & 1) * 64; const float tot = totb[c & 1];
#pragma unroll
        for (int i = 0; i < 5; ++i) { const int idx = tid + 512 * i; const int tl = idx / 40, q = idx % 40; const int lp = dir ? 63 - tl : tl;
            const unsigned w[4] = {pre[i].x, pre[i].y, pre[i].z, pre[i].w};
            if (q < 8) {
#pragma unroll
                for (int k = 0; k < 4; ++k) { const int p0 = q * 8 + 2 * k; Xt[p0 * 72 + swz64(p0, lp)] = (bf16)(w[k] & 0xffffu); Xt[(p0 + 1) * 72 + swz64(p0 + 1, lp)] = (bf16)(w[k] >> 16); } }
            else if (q < 24) { const int n0 = (q - 8) * 8; if (full) *(LAS v4u*)(Bm + lp * 136 + n0) = pre[i]; const float sc = dtv[lp] * __expf(tot - acs[lp]);
#pragma unroll
                for (int k = 0; k < 4; ++k) { const int nn = n0 + 2 * k; Btw[nn * 72 + swz64(nn, lp)] = (bf16)f2bf(bf2f(w[k] & 0xffffu) * sc); Btw[(nn + 1) * 72 + swz64(nn + 1, lp)] = (bf16)f2bf(bf2f(w[k] >> 16) * sc); } }
            else if (full) { const int n0 = (q - 24) * 8; *(LAS v4u*)(Cm + lp * 136 + n0) = pre[i]; } }
        if (c + 1 < cend) SSD_ISSUE(c + 1);
        __syncthreads();
        f32x4 yo[2] = {{0.f, 0.f, 0.f, 0.f}, {0.f, 0.f, 0.f, 0.f}}, lc[4];
        if (full) {
#pragma unroll
        for (int k = 0; k < 2; ++k) { const int ti = 2 * wave + k, tl_ = ti >> 2, ts = ti & 3; f32x4 acc = {0.f, 0.f, 0.f, 0.f};
            if (ts <= tl_) acc = mma16<128>(Cm + tl_ * 16 * 136, 136, Bm + ts * 16 * 136, 136, acc, lane);
#pragma unroll
            for (int jj = 0; jj < 4; ++jj) { const int lr = tl_ * 16 + (lane >> 4) * 4 + jj, s = ts * 16 + (lane & 15);
                const float v = (s <= lr) ? acc[jj] * __expf(acs[lr] - acs[s]) * dtv[s] : 0.f; Ps[lr * 72 + s] = (bf16)f2bf(v); }
            const f32x4 z = {0.f, 0.f, 0.f, 0.f};
            yo[k] = mma16<128>(Cm + tl_ * 16 * 136, 136, Hs + ts * 16 * 136, 136, z, lane); }
        }
#pragma unroll
        for (int k = 0; k < 4; ++k) { const int ti = 4 * wave + k, tp = ti >> 3, tn = ti & 7; const f32x4 z = {0.f, 0.f, 0.f, 0.f};
            lc[k] = mma16s<true, true>(Xt, 72, tp * 16, Btw, 72, tn * 16, z, lane); }
        __syncthreads();
        const float cdec = __expf(tot);
        if (full) {
#pragma unroll
        for (int k = 0; k < 2; ++k) { const int ti = 2 * wave + k, tl_ = ti >> 2, tp = ti & 3; const f32x4 z = {0.f, 0.f, 0.f, 0.f};
            const f32x4 yd = mma16s<false, true>(Ps, 72, tl_ * 16, Xt, 72, tp * 16, z, lane);
#pragma unroll
            for (int jj = 0; jj < 4; ++jj) { const int lr = tl_ * 16 + (lane >> 4) * 4 + jj, p = tp * 16 + (lane & 15);
                const float val = yd[jj] + yo[k][jj] * __expf(acs[lr]);
                const int t = dir ? tlo + 63 - lr : tlo + lr;
                Y[(mb + t) * 384 + head * 64 + p] = (bf16)f2bf(val); } }
        }
#pragma unroll
        for (int k = 0; k < 4; ++k) { const int ti = 4 * wave + k, tp = ti >> 3, tn = ti & 7;
#pragma unroll
            for (int jj = 0; jj < 4; ++jj) { const int p = tp * 16 + (lane >> 4) * 4 + jj, n = tn * 16 + (lane & 15);
                st[k][jj] = cdec * st[k][jj] + lc[k][jj]; Hs[p * 136 + n] = (bf16)f2bf(st[k][jj]); } }
        if (c + 1 < cend) { SSD_DTCALC(c + 1); if (c + 2 < cend) SSD_DTLOAD(c + 2); }
        __syncthreads();
    }
#undef SSD_ISSUE
#undef SSD_ISSUE_L
#undef SSD_DTLOAD
#undef SSD_DTCALC
}
__device__ __forceinline__ float wave_sum2(float v) { v = row16_sum(v); v += __shfl_xor(v, 16); v += __shfl_xor(v, 32); return v; }
__device__ __forceinline__ f32x4 bf4(v2u w) { return (f32x4){bf2f(w.x & 0xffffu), bf2f(w.x >> 16), bf2f(w.y & 0xffffu), bf2f(w.y >> 16)}; }
__device__ __forceinline__ v2u pk4(f32x4 v) { v2u w; w.x = pk2(v.x, v.y); w.y = pk2(v.z, v.w); return w; }
__device__ __forceinline__ void phase_post(const Frame& F, int l) {
    const GAS bf16* cols = (const GAS bf16*)(WSP(F) + WS_COLS); GAS bf16* MIX = (GAS bf16*)(WSP(F) + WS_XN);
    const GAS bf16* YAf = (const GAS bf16*)(WSP(F) + Y_AF); const GAS bf16* YAb = (const GAS bf16*)(WSP(F) + Y_AB);
    const GAS bf16* YRf = (const GAS bf16*)(WSP(F) + Y_RF); const GAS bf16* YRb = (const GAS bf16*)(WSP(F) + Y_RB);
    const GAS bf16* YSf = (const GAS bf16*)(WSP(F) + Y_SF); const GAS bf16* YSb = (const GAS bf16*)(WSP(F) + Y_SB);
    const GAS float* CT = (const GAS float*)(WSP(F) + WS_CT);
    LAS bf16* GU = (LAS bf16*)(F.lds);
    LAS bf16* SG = (LAS bf16*)(F.lds + 104448);
    LAS float* gate = (LAS float*)(F.lds + 108800);
    LAS float* SCW = (LAS float*)(F.lds + 133632);
    const int tid = F.tid, lane = F.lane, wave = F.wave;
    const GAS float* mup = INP(F, 8) + l * 1472; const GAS float* mun = INP(F, 9) + l * 1472;
    const GAS float* sdk = INP(F, 24) + l * 6;
    __syncthreads();
    { const GAS bf16* gut = (const GAS bf16*)(WSP(F) + WS_GUT); for (int ch = tid; ch < 384 * 16; ch += 512) { const int c = ch >> 4, q = ch & 15; *(LAS v4u*)(GU + c * 136 + q * 8) = *(const GAS v4u*)(gut + c * 128 + q * 8); } }
    { const GAS float* scw = INP(F, 20) + (size_t)l * 5 * 896; for (int idx = tid; idx < 5 * 384; idx += 512) SCW[idx] = scw[(idx / 384) * 896 + (idx % 384)]; }
    const int gch = tid & 15;
    float gmp[8], gmn[8];
#pragma unroll
    for (int k = 0; k < 8; ++k) { gmp[k] = mup[1344 + 8 * gch + k]; gmn[k] = mun[1344 + 8 * gch + k]; }
    const int qa = lane, qb = 64 + (lane & 31);
    const f32x4 mng4 = *(const GAS f32x4*)(INP(F, 7) + l * 256 + 4 * qa);
    f32x4 rmp[2], rmn[2], rng[2], rnb[2], scb[2], sng[2];
#pragma unroll
    for (int ps = 0; ps < 2; ++ps) { const int c0 = 4 * (ps ? qb : qa);
        rmp[ps] = *(const GAS f32x4*)(mup + 768 + c0); rmn[ps] = *(const GAS f32x4*)(mun + 768 + c0);
        rng[ps] = *(const GAS f32x4*)(INP(F, 18) + l * 384 + c0); rnb[ps] = *(const GAS f32x4*)(INP(F, 19) + l * 384 + c0);
        scb[ps] = *(const GAS f32x4*)(INP(F, 21) + l * 896 + c0); sng[ps] = *(const GAS f32x4*)(INP(F, 25) + l * 384 + c0); }
    for (int tile = F.vcu; tile < M / 16; tile += F.G) {
        const int m0 = tile * 16;
        __syncthreads();
        if (tid < 256) { const int tt = tid >> 4; const int m = m0 + tt, t = m % SEQ; const GAS bf16* cp = cols + (size_t)m * NINP + R_GD + 8 * gch;
            const v4u c1 = *(const GAS v4u*)cp; v4u c0 = {0u, 0u, 0u, 0u}, c2 = {0u, 0u, 0u, 0u};
            if (t > 0) c0 = *(const GAS v4u*)(cp - NINP); if (t < SEQ - 1) c2 = *(const GAS v4u*)(cp + NINP);
            const unsigned w0[4] = {c0.x, c0.y, c0.z, c0.w}, w1[4] = {c1.x, c1.y, c1.z, c1.w}, w2[4] = {c2.x, c2.y, c2.z, c2.w}; unsigned o[4];
#pragma unroll
            for (int k = 0; k < 4; ++k) { const float a1 = bf2f(w1[k] & 0xffffu), b1 = bf2f(w1[k] >> 16);
                const float va = a1 + gmp[2 * k] * (bf2f(w0[k] & 0xffffu) - a1) + gmn[2 * k] * (bf2f(w2[k] & 0xffffu) - a1);
                const float vb = b1 + gmp[2 * k + 1] * (bf2f(w0[k] >> 16) - b1) + gmn[2 * k + 1] * (bf2f(w2[k] >> 16) - b1);
                o[k] = pk2(sigmoidf_(va), sigmoidf_(vb)); }
            *(LAS v4u*)(SG + tt * 136 + 8 * gch) = (v4u){o[0], o[1], o[2], o[3]}; }
        __syncthreads();
#pragma unroll
        for (int k = 0; k < 3; ++k) { const int ct = wave + 8 * k; const f32x4 z = {0.f, 0.f, 0.f, 0.f};
            const f32x4 acc = mma16<128>(SG, 136, GU + ct * 16 * 136, 136, z, lane);
#pragma unroll
            for (int jj = 0; jj < 4; ++jj) gate[((lane >> 4) * 4 + jj) * 388 + ct * 16 + (lane & 15)] = acc[jj]; }
        __syncthreads();
#pragma unroll 1
        for (int k = 0; k < 2; ++k) { const int tt = wave * 2 + k; const int m = m0 + tt, t = m % SEQ; const size_t cr = (size_t)m * NINP;
            { const int c0 = 4 * qa;
              const f32x4 hs = bf4(*(const GAS v2u*)(YAf + (size_t)m * 256 + c0)) + bf4(*(const GAS v2u*)(YAb + (size_t)m * 256 + c0));
              const float mean = row16_sum((hs.x + hs.y) + (hs.z + hs.w)) * (1.f / 64.f); const f32x4 d = hs - mean;
              const float var = row16_sum((d.x * d.x + d.y * d.y) + (d.z * d.z + d.w * d.w)) * (1.f / 64.f);
              const f32x4 o = bf4(*(const GAS v2u*)(cols + cr + A_O + c0));
              f32x4 y = d * (1.f / sqrtf(var + 1e-6f)) * mng4;
              y.x *= sigmoidf_(o.x); y.y *= sigmoidf_(o.y); y.z *= sigmoidf_(o.z); y.w *= sigmoidf_(o.w);
              *(GAS v2u*)(MIX + (size_t)m * DM + c0) = pk4(y); }
#pragma unroll
            for (int ps = 0; ps < 2; ++ps) { const int qd = ps ? qb : qa, c0 = 4 * qd; const bool act = ps == 0 || lane < 32;
              const f32x4 ys = bf4(*(const GAS v2u*)(YRf + (size_t)m * 384 + c0)) + bf4(*(const GAS v2u*)(YRb + (size_t)m * 384 + c0));
              const float mean = row16_sum((ys.x + ys.y) + (ys.z + ys.w)) * (1.f / 64.f); const f32x4 d = ys - mean;
              const float var = row16_sum((d.x * d.x + d.y * d.y) + (d.z * d.z + d.w * d.w)) * (1.f / 64.f);
              const f32x4 y = d * (1.f / sqrtf(var + 64e-5f)) * rng[ps] + rnb[ps];
              const f32x4 p1 = bf4(*(const GAS v2u*)(cols + cr + R_V + c0));
              f32x4 p0 = {0.f, 0.f, 0.f, 0.f}, p2 = {0.f, 0.f, 0.f, 0.f};
              if (t > 0) p0 = bf4(*(const GAS v2u*)(cols + cr - NINP + R_V + c0)); if (t < SEQ - 1) p2 = bf4(*(const GAS v2u*)(cols + cr + NINP + R_V + c0));
              const f32x4 vv = p1 + rmp[ps] * (p0 - p1) + rmn[ps] * (p2 - p1);
              const float ctv = CT[(size_t)m * 8 + (qd >> 4)];
              const f32x4 g4 = *(const LAS f32x4*)(gate + tt * 388 + c0);
              if (act) *(GAS v2u*)(MIX + (size_t)m * DM + 256 + c0) = pk4((y + vv * ctv) * g4); }
            f32x4 yv[2]; float ssq0 = 0.f, ssq1 = 0.f;
#pragma unroll
            for (int ps = 0; ps < 2; ++ps) { const int qd = ps ? qb : qa, c0 = 4 * qd; const bool act = ps == 0 || lane < 32;
              f32x4 s = scb[ps];
#pragma unroll
              for (int jj = 0; jj < 5; ++jj) { const int tq = t + jj - 2; if (tq >= 0 && tq < SEQ) s += *(const LAS f32x4*)(SCW + jj * 384 + c0) * bf4(*(const GAS v2u*)(cols + cr + (jj - 2) * NINP + S_X + c0)); }
              const f32x4 z = bf4(*(const GAS v2u*)(cols + cr + S_Z + c0));
              f32x4 y = bf4(*(const GAS v2u*)(YSf + (size_t)m * 384 + c0)) + bf4(*(const GAS v2u*)(YSb + (size_t)m * 384 + c0));
              const float dsk = sdk[qd >> 4];
              y.x = (y.x + dsk * siluf_(s.x)) * siluf_(z.x); y.y = (y.y + dsk * siluf_(s.y)) * siluf_(z.y); y.z = (y.z + dsk * siluf_(s.z)) * siluf_(z.z); y.w = (y.w + dsk * siluf_(s.w)) * siluf_(z.w);
              yv[ps] = y; const float sq = act ? (y.x * y.x + y.y * y.y) + (y.z * y.z + y.w * y.w) : 0.f;
              if (qd < 48) ssq0 += sq; else ssq1 += sq; }
            const float r0 = 1.f / sqrtf(wave_sum2(ssq0) * (1.f / 192.f) + 1e-6f), r1 = 1.f / sqrtf(wave_sum2(ssq1) * (1.f / 192.f) + 1e-6f);
#pragma unroll
            for (int ps = 0; ps < 2; ++ps) { const int qd = ps ? qb : qa, c0 = 4 * qd; const bool act = ps == 0 || lane < 32;
              if (act) *(GAS v2u*)(MIX + (size_t)m * DM + 640 + c0) = pk4(yv[ps] * (qd < 48 ? r0 : r1) * sng[ps]); }
        }
    }
    __syncthreads();
}
namespace cg = cooperative_groups;
constexpr int N_PHASES = 9 * DEPTH + 1;
__global__ void __launch_bounds__(NWAVES * 64, 2) mk_fwd(Args args) {
    extern __shared__ __attribute__((aligned(16))) unsigned char lds_raw[];
    Frame F;
    F.lds = (LAS unsigned char*)lds_raw;
    F.tid = threadIdx.x; F.lane = F.tid & 63; F.wave = __builtin_amdgcn_readfirstlane(F.tid >> 6);
    F.G = gridDim.x; { const int bx = blockIdx.x; F.vcu = (F.G % 8 == 0) ? (bx % 8) * (F.G / 8) + bx / 8 : bx; }
    volatile LAS unsigned* MISC = (volatile LAS unsigned*)(F.lds + MISC_OFF);
    if (F.tid < 64) MISC[F.tid] = 0u;
    if (F.tid < 34) *(LAS unsigned long long*)(F.lds + PTAB_OFF + 8 * F.tid) = ((const unsigned long long*)__builtin_amdgcn_kernarg_segment_ptr())[F.tid];
    __syncthreads();
    unsigned* ctl = (unsigned*)(WSP(F) + WS_CTL);
    XcdBarrier bar = xcd_barrier_post(ctl + CW_BAR, MISC + 8);
    const int lo = args.ph_lo, hi = args.ph_hi;
#define IN_(k) (lo <= (k) && (k) < hi)
#define SEAM(k) do { if (IN_(k) && IN_((k) + 1)) { if ((k) == 0) cg::this_grid().sync(); else xcd_barrier(bar); } } while (0)
#define LAYER(l, B) \
    if (IN_(B + 0)) { phase_convert(F, l); phase_norm(F, l == 0 ? INP(F, 0) : OUTP(F), INP(F, 1) + l * DM, (GAS bf16*)(WSP(F) + WS_XN)); } SEAM(B + 0); \
    if (IN_(B + 1)) { unsigned char* ws = (unsigned char*)WSP(F); pg8::Gemm g{(const bf16*)(ws + WS_XN), (const bf16*)(ws + WS_WIN), M, NINP, DM}; pg8::StaticOrder S; S.init(M, NINP, F.G, (int)blockIdx.x); \
            pg8::EpiBf16<0> E{(bf16*)(ws + WS_COLS), NINP, nullptr, 0, 0, 1.f}; \
            pg8::gemm_phase<pg8::EpiBf16<0>, pg8::StaticOrder, PG8_ALIGN, PG8_SP2>(F.lds, g, S, E); } SEAM(B + 1); \
    if (IN_(B + 2)) { phase_gates(F, l); phase_ssd_conv(F, l); } SEAM(B + 2); \
    if (IN_(B + 3)) { const int bx = blockIdx.x; \
            if (bx < 96) { const int c8 = bx & 7, k8 = bx >> 3; rwkv_scan(F, l, c8 + 8 * (k8 >> 2), k8 & 3, (unsigned)l * (SEQ / 32)); } else if (bx < 144) rwkv_produce(F, l, (bx - 96) % 24, (bx - 96) / 24, (unsigned)l * (SEQ / 32)); else if (bx < 216) { const int u = bx - 144, sg = 2 - (u / 24); ssd_seq(F, l, u % 24, sg == 0 ? 0 : (sg == 1 ? 43 : 86), sg == 0 ? 43 : (sg == 1 ? 86 : 128)); } else if (bx < 248) { const int u = bx - 216, sg = 1 - (u / 16); mlstm_seq(F, l, u % 16, 64 * sg, 64 * sg + 64); } } SEAM(B + 3); \
    if (IN_(B + 4)) phase_post(F, l); SEAM(B + 4); \
    if (IN_(B + 5)) { unsigned char* ws = (unsigned char*)WSP(F); pg8::Gemm g{(const bf16*)(ws + WS_XN), (const bf16*)(ws + WS_WOUT), M, DM, DM}; pg8::StaticOrder S; S.init(M, DM, F.G, (int)blockIdx.x); \
            pg8::EpiResidual E{l == 0 ? (const float*)INP(F, 0) : (const float*)OUTP(F), (float*)OUTP(F), DM}; \
            pg8::gemm_phase<pg8::EpiResidual, pg8::StaticOrder, PG8_ALIGN, PG8_SP2>(F.lds, g, S, E); } SEAM(B + 5); \
    if (IN_(B + 6)) phase_norm(F, OUTP(F), INP(F, 27) + l * DM, (GAS bf16*)(WSP(F) + WS_XN)); SEAM(B + 6); \
    if (IN_(B + 7)) { unsigned char* ws = (unsigned char*)WSP(F); pg8::Gemm g{(const bf16*)(ws + WS_XN), (const bf16*)(ws + WS_WGU), M, 2 * FFN, DM}; pg8::StaticOrder S; S.init(M, 2 * FFN, F.G, (int)blockIdx.x); \
            pg8::EpiSwiGLU E{(bf16*)(ws + WS_COLS), FFN}; \
            pg8::gemm_phase<pg8::EpiSwiGLU, pg8::StaticOrder, PG8_ALIGN, PG8_SP2>(F.lds, g, S, E); } SEAM(B + 7); \
    if (IN_(B + 8)) { unsigned char* ws = (unsigned char*)WSP(F); pg8::Gemm g{(const bf16*)(ws + WS_COLS), (const bf16*)(ws + WS_WDN), M, DM, FFN}; pg8::StaticOrder S; S.init(M, DM, F.G, (int)blockIdx.x); \
            pg8::EpiResidual E{(const float*)OUTP(F), (float*)OUTP(F), DM}; \
            pg8::gemm_phase<pg8::EpiResidual, pg8::StaticOrder, PG8_ALIGN, PG8_SP2>(F.lds, g, S, E); } SEAM(B + 8);
    LAYER(0, 0)
    LAYER(1, 9)
    if (IN_(18)) phase_final_norm(F, OUTP(F), INP(F, 31));
#undef IN_
#undef SEAM
#undef LAYER
}

#ifndef MK_PER_PHASE
#define MK_PER_PHASE 0
#endif
extern "C" void kernel_launch(void* const* d_in, const int* in_sizes, int n_in, void* d_out, int out_size, void* d_ws, size_t ws_size, hipStream_t stream) {
    static int grid = 0;
    if (grid == 0) {
        int dev = 0, cus = 0;
        if (n_in != 32 || out_size != M * DM || ws_size < WS_END) { fprintf(stderr, "kernel_launch: unexpected shapes (n_in %d out %d ws %zu)\n", n_in, out_size, ws_size); grid = -1; return; }
        if (hipGetDevice(&dev) != hipSuccess || hipDeviceGetAttribute(&cus, hipDeviceAttributeMultiprocessorCount, dev) != hipSuccess) { grid = -1; return; }
        if (hipFuncSetAttribute((const void*)mk_fwd, hipFuncAttributeMaxDynamicSharedMemorySize, LDS_BYTES) != hipSuccess) { fprintf(stderr, "kernel_launch: hipFuncSetAttribute failed\n"); grid = -1; return; }
        int per_cu = 0;
        if (hipOccupancyMaxActiveBlocksPerMultiprocessor(&per_cu, (const void*)mk_fwd, NWAVES * 64, LDS_BYTES) != hipSuccess || per_cu < 1) { fprintf(stderr, "kernel_launch: occupancy query says %d\n", per_cu); }
        (void)hipGetLastError();
        grid = cus;
    }
    if (grid < 0) return;
    (void)hipMemsetAsync((char*)d_ws + WS_CTL, 0, CTL_ZERO_BYTES, stream);
    Args a{};
    for (int i = 0; i < 32; ++i) a.in[i] = (const float*)d_in[i];
    a.out = (float*)d_out; a.ws = (unsigned char*)d_ws;
#if MK_PER_PHASE
    for (int p = 0; p < N_PHASES; ++p) { a.ph_lo = p; a.ph_hi = p + 1; hipLaunchKernelGGL(mk_fwd, dim3(grid), dim3(NWAVES * 64), LDS_BYTES, stream, a); }
#else
    a.ph_lo = 0; a.ph_hi = N_PHASES;
    void* kargs[] = {&a};
    hipError_t e = hipLaunchCooperativeKernel((const void*)mk_fwd, dim3(grid), dim3(NWAVES * 64), kargs, LDS_BYTES, stream);
    if (e != hipSuccess) fprintf(stderr, "cooperative launch failed: %s (grid %d)\n", hipGetErrorString(e), grid);
#endif
}
```

```cpp
#include <hip/hip_runtime.h>
#include <hip/hip_cooperative_groups.h>
#include <cstdio>
#include <cstdint>
namespace pg8 {
#define PG8_LAS __attribute__((address_space(3)))
typedef unsigned short bf16_t;
typedef short bf16x8 __attribute__((ext_vector_type(8)));
typedef float f32x4 __attribute__((ext_vector_type(4)));
typedef unsigned u32x4 __attribute__((ext_vector_type(4)));
constexpr int BM = 256, BK = 64, HALF = 128, HTB = HALF * BK * 2  , STAGE_BYTES = 8 * HTB, NXCD = 8, WGM = 8;

__host__ __device__ __forceinline__ int lds_byte(int r, int c) { const int st = (r >> 4) * 2 + (c >> 5), rr = r & 15, cc = c & 31, ob = rr * 64 + cc * 2; return st * 1024 + (ob ^ (((ob >> 9) & 1) << 5)); }
__host__ __device__ __forceinline__ void stage_rc(int b, int& R, int& C) { const int st = b / 1024, sb = b % 1024, swz = sb ^ (((sb >> 9) & 1) << 5); R = (st >> 1) * 16 + swz / 64; C = (st & 1) * 32 + (swz % 64) / 2; }
__host__ __device__ __forceinline__ int perm32(int rho) { const int n = rho >> 4, i = rho & 15; return 8 * (i >> 2) + 4 * n + (i & 3); }

struct Unit { int pm, pn; };
struct Gemm { const bf16_t* A; const bf16_t* Bt; int M, N, K; };

struct StaticOrder {
    int nM, nN, nwg, G, c;
    __host__ __device__ void init(int M, int N, int G_, int c_) { nM = M / BM; nN = N / BM; nwg = nM * nN; G = G_; c = c_; }
    __host__ __device__ bool next(int i, Unit& u) const {
        const long L = (long)i * G + c; if (L >= nwg) return false;
        int wgid = (int)L; { const int q = nwg / NXCD, r = nwg % NXCD, xcd = wgid % NXCD, off = wgid / NXCD; wgid = (xcd < r ? xcd * (q + 1) : r * (q + 1) + (xcd - r) * q) + off; }
        const int nig = WGM * nN, gid = wgid / nig, fm = gid * WGM, gsz = (nM - fm) < WGM ? (nM - fm) : WGM;
        u.pm = fm + ((wgid % nig) % gsz); u.pn = (wgid % nig) / gsz; return true;
    }
    __device__ __forceinline__ void a_ready(const Unit&) const {}
    __device__ __forceinline__ void done(const Unit&) const {}
};

__device__ __forceinline__ unsigned cvt_pk_bf16(float lo, float hi) { unsigned r; asm volatile("v_cvt_pk_bf16_f32 %0, %1, %2" : "=v"(r) : "v"(lo), "v"(hi)); return r; }
typedef float f32x2 __attribute__((ext_vector_type(2)));
__device__ __forceinline__ f32x2 gelu_pk(f32x2 v) {
    const f32x2 av = __builtin_elementwise_abs(v), d = av * 0.2316418882f + 1.0f;
    f32x2 t; t.x = __builtin_amdgcn_rcpf(d.x); t.y = __builtin_amdgcn_rcpf(d.y);
    f32x2 q = t * 0.5307027145f + (-0.7265760135f); q = q * t + 0.7107068705f; q = q * t + (-0.142248368f); q = q * t + 0.127414796f; q = q * t;
    const f32x2 s = (v * v) * (-0.72134752044f);
    f32x2 e; e.x = __builtin_amdgcn_exp2f(s.x); e.y = __builtin_amdgcn_exp2f(s.y);
    const f32x2 m = v * (q * e), r = v - m;
    f32x2 o; o.x = v.x < 0.f ? m.x : r.x; o.y = v.y < 0.f ? m.y : r.y; return o;
}

template <int ACT  > struct EpiBf16 {
    static constexpr bool PERM = true, AFTER_DRAIN = false; static_assert(ACT == 0 || ACT == 1, "EpiBf16: ACT is 0 (none) or 1 (gelu_pk)");
    bf16_t* O; int ldc; const float* bias; int split_cols; size_t split_stride; float scale0;
    __device__ __forceinline__ void operator()(const f32x4 (&acc)[2][2][4][2], const Unit& u, int wr, int wc, int fr, int fq) const {
        const int row0 = u.pm * BM + wr * 64 + fr; int colt = u.pn * BM; bf16_t* base = O;
        float sc = 1.f; if (split_cols) { const int t = colt / split_cols; base += (size_t)t * split_stride; colt -= t * split_cols; if (t == 0) sc = scale0; }
        const int col0 = colt + wc * 32 + 8 * fq, bcol0 = u.pn * BM + wc * 32 + 8 * fq;
        f32x4 bv[2][2];
#pragma unroll
        for (int bj = 0; bj < 2; ++bj)
#pragma unroll
            for (int n = 0; n < 2; ++n) bv[bj][n] = bias ? *(const f32x4*)(bias + bcol0 + bj * HALF + 4 * n) : (f32x4){0.f, 0.f, 0.f, 0.f};
#pragma unroll
        for (int ai = 0; ai < 2; ++ai)
#pragma unroll
            for (int m = 0; m < 4; ++m) { bf16_t* rowp = base + (size_t)(row0 + ai * HALF + m * 16) * ldc + col0;
#pragma unroll
                for (int bj = 0; bj < 2; ++bj) { f32x4 v0 = acc[ai][bj][m][0] + bv[bj][0], v1 = acc[ai][bj][m][1] + bv[bj][1];
                    if (ACT == 1) { f32x2 a = gelu_pk((f32x2){v0[0], v0[1]}), b = gelu_pk((f32x2){v0[2], v0[3]}), c = gelu_pk((f32x2){v1[0], v1[1]}), d = gelu_pk((f32x2){v1[2], v1[3]});
                        v0 = (f32x4){a.x, a.y, b.x, b.y}; v1 = (f32x4){c.x, c.y, d.x, d.y}; }
                    v0 = v0 * sc; v1 = v1 * sc; u32x4 w; w.x = cvt_pk_bf16(v0[0], v0[1]); w.y = cvt_pk_bf16(v0[2], v0[3]); w.z = cvt_pk_bf16(v1[0], v1[1]); w.w = cvt_pk_bf16(v1[2], v1[3]);
                    *(u32x4*)(rowp + bj * HALF) = w; } }
    }
};
struct EpiResidual {
    static constexpr bool PERM = false, AFTER_DRAIN = false;
    const float* base; float* out; int ldc;
    __device__ __forceinline__ void operator()(const f32x4 (&acc)[2][2][4][2], const Unit& u, int wr, int wc, int fr, int fq) const {
        const int col0 = u.pn * BM + wc * 32 + 4 * fq;
#pragma unroll
        for (int ai = 0; ai < 2; ++ai)
#pragma unroll
            for (int m = 0; m < 4; ++m) { const size_t off = (size_t)(u.pm * BM + ai * HALF + wr * 64 + m * 16 + fr) * ldc + col0;
#pragma unroll
                for (int bj = 0; bj < 2; ++bj)
#pragma unroll
                    for (int n = 0; n < 2; ++n) { const f32x4 bs = *(const f32x4*)(base + off + bj * HALF + n * 16); *(f32x4*)(out + off + bj * HALF + n * 16) = bs + acc[ai][bj][m][n]; }
                asm volatile("" ::: "memory"); }
    }
};
struct EpiSwiGLU {
    static constexpr bool PERM = true, AFTER_DRAIN = false;
    bf16_t* O; int ldc;
    __device__ __forceinline__ void operator()(const f32x4 (&acc)[2][2][4][2], const Unit& u, int wr, int wc, int fr, int fq) const {
        const int col0 = u.pn * HALF + wc * 32 + 8 * fq;
#pragma unroll
        for (int ai = 0; ai < 2; ++ai)
#pragma unroll
            for (int m = 0; m < 4; ++m) { bf16_t* rowp = O + (size_t)(u.pm * BM + ai * HALF + wr * 64 + m * 16 + fr) * ldc + col0;
                float r[8];
#pragma unroll
                for (int n = 0; n < 2; ++n)
#pragma unroll
                    for (int j = 0; j < 4; ++j) { const float g = acc[ai][0][m][n][j], up = acc[ai][1][m][n][j]; r[n * 4 + j] = g * __builtin_amdgcn_rcpf(1.f + __expf(-g)) * up; }
                u32x4 w; w.x = cvt_pk_bf16(r[0], r[1]); w.y = cvt_pk_bf16(r[2], r[3]); w.z = cvt_pk_bf16(r[4], r[5]); w.w = cvt_pk_bf16(r[6], r[7]);
                *(u32x4*)rowp = w; }
    }
};
template <class Epi, class Sched, bool ALIGN_EPI = false, bool SP2 = false>
__device__ __forceinline__ void gemm_phase(PG8_LAS unsigned char* lds, const Gemm g, const Sched& S, const Epi& E) {
    const int tid = threadIdx.x, wid = __builtin_amdgcn_readfirstlane(tid >> 6), lane = tid & 63, wr = wid >> 2, wc = wid & 3, fr = lane & 15, fq = lane >> 4;
    const int K = g.K, nt = K / BK;
    unsigned voffA[2], voffB[2];
#pragma unroll
    for (int i = 0; i < 2; ++i) { int R, C; stage_rc(tid * 16 + i * 8192, R, C); const int Rb = Epi::PERM ? ((R & ~31) + perm32(R & 31)) : R;
        voffA[i] = (unsigned)(R * K + C) * 2u; voffB[i] = (unsigned)(Rb * K + C) * 2u; }
    const size_t kstep = (size_t)(BK * 2);
    const size_t hstep = (size_t)HALF * K * 2;
    const size_t tstep = 2 * hstep;
    const unsigned ldsw = (unsigned)wid * 1024u;
    const int aoff = lds_byte(wr * 64 + fr, fq * 8), boff = lds_byte(wc * 32 + fr, fq * 8);
#define PG8_SA(b, h) (((b) * 2 + (h)) * HTB)
#define PG8_SB(b, h) ((4 + (b) * 2 + (h)) * HTB)
#define PG8_STAGE(bufoff, gbase, voff) do { _Pragma("unroll") for (int _i = 0; _i < 2; ++_i) \
        __builtin_amdgcn_global_load_lds((const unsigned*)((const char*)(gbase) + (voff)[_i]), (PG8_LAS unsigned*)(lds + (bufoff) + ldsw + _i * 8192), 16, 0, 0); } while (0)
#define PG8_LDA(dst, b, h) do { _Pragma("unroll") for (int m = 0; m < 4; ++m) _Pragma("unroll") for (int k = 0; k < 2; ++k) dst[m][k] = *(const PG8_LAS bf16x8*)(lds + PG8_SA(b, h) + aoff + m * 2048 + k * 1024); } while (0)
#define PG8_LDB(dst, b, h) do { _Pragma("unroll") for (int n = 0; n < 2; ++n) _Pragma("unroll") for (int k = 0; k < 2; ++k) dst[n][k] = *(const PG8_LAS bf16x8*)(lds + PG8_SB(b, h) + boff + n * 2048 + k * 1024); } while (0)
#define PG8_MMA(ai, bj, At, Bt) do { __builtin_amdgcn_s_setprio(1); _Pragma("unroll") for (int m = 0; m < 4; ++m) _Pragma("unroll") for (int n = 0; n < 2; ++n) _Pragma("unroll") for (int k = 0; k < 2; ++k) \
        acc[ai][bj][m][n] = __builtin_amdgcn_mfma_f32_16x16x32_bf16(Bt[n][k], At[m][k], acc[ai][bj][m][n], 0, 0, 0); __builtin_amdgcn_s_setprio(0); } while (0)
#define PG8_WAIT_V(n) asm volatile("s_waitcnt vmcnt(" #n ")" ::: "memory")
#define PG8_WAIT_L(n) asm volatile("s_waitcnt lgkmcnt(" #n ")" ::: "memory")
#define PG8_BAR __builtin_amdgcn_s_barrier()
#define PG8_SCHED __builtin_amdgcn_sched_barrier(0)
    Unit cur, nxt; int ui = 0;
    if (!S.next(0, cur)) return;
    f32x4 acc[2][2][4][2];
#pragma unroll
    for (int a = 0; a < 2; ++a)
#pragma unroll
        for (int b = 0; b < 2; ++b)
#pragma unroll
            for (int m = 0; m < 4; ++m)
#pragma unroll
                for (int n = 0; n < 2; ++n) acc[a][b][m][n] = (f32x4){0.f, 0.f, 0.f, 0.f};
    bf16x8 At[4][2], B0[2][2], B1[2][2];
    const char* cA = (const char*)g.A + (size_t)cur.pm * tstep; const char* cB = (const char*)g.Bt + (size_t)cur.pn * tstep;
    S.a_ready(cur);
    if constexpr (SP2) {
        PG8_STAGE(PG8_SB(0, 0), cB, voffB); PG8_STAGE(PG8_SB(0, 1), cB + hstep, voffB); PG8_STAGE(PG8_SA(0, 0), cA, voffA); PG8_STAGE(PG8_SA(0, 1), cA + hstep, voffA);
        if (wr == 1) PG8_BAR;
        PG8_WAIT_V(2); PG8_BAR;
        PG8_STAGE(PG8_SB(1, 0), cB + kstep, voffB); PG8_STAGE(PG8_SA(1, 0), cA + kstep, voffA); PG8_STAGE(PG8_SB(1, 1), cB + hstep + kstep, voffB);
        PG8_WAIT_V(6); PG8_BAR;
    } else {
        PG8_STAGE(PG8_SB(0, 0), cB, voffB); PG8_STAGE(PG8_SA(0, 0), cA, voffA); PG8_STAGE(PG8_SB(0, 1), cB + hstep, voffB); PG8_STAGE(PG8_SA(0, 1), cA + hstep, voffA);
        if (wr == 1) PG8_BAR;
        PG8_WAIT_V(4); PG8_BAR;
        PG8_STAGE(PG8_SB(1, 0), cB + kstep, voffB); PG8_STAGE(PG8_SA(1, 0), cA + kstep, voffA); PG8_STAGE(PG8_SB(1, 1), cB + hstep + kstep, voffB);
        PG8_WAIT_V(6); PG8_BAR;
    }
    for (;;) {
        const bool has_next = S.next(ui + 1, nxt);
        const char* nA = has_next ? (const char*)g.A + (size_t)nxt.pm * tstep : cA; const char* nB = has_next ? (const char*)g.Bt + (size_t)nxt.pn * tstep : cB;
        for (int t = 0; t < nt; t += 2) {
            const bool last = (t == nt - 2);
            const char* a1 = cA + (size_t)(t + 1) * kstep;
            const char* a2 = last ? nA : cA + (size_t)(t + 2) * kstep; const char* b2 = last ? nB : cB + (size_t)(t + 2) * kstep;
            const char* a3 = a2 + kstep; const char* b3 = b2 + kstep;
            if (last && has_next) S.a_ready(nxt);
            if constexpr (SP2) {
            PG8_LDB(B0, 0, 0); PG8_LDB(B1, 0, 1); PG8_SCHED; PG8_LDA(At, 0, 0); PG8_STAGE(PG8_SA(1, 1), a1 + hstep, voffA);
            PG8_WAIT_V(8); PG8_WAIT_L(0); PG8_BAR; PG8_MMA(0, 0, At, B0); PG8_MMA(0, 1, At, B1); PG8_BAR; PG8_SCHED;
            PG8_LDA(At, 0, 1); PG8_STAGE(PG8_SB(0, 0), b2, voffB); PG8_STAGE(PG8_SB(0, 1), b2 + hstep, voffB); PG8_STAGE(PG8_SA(0, 0), a2, voffA);
            PG8_WAIT_V(8); PG8_WAIT_L(0); PG8_BAR; PG8_MMA(1, 0, At, B0); PG8_MMA(1, 1, At, B1); PG8_BAR; PG8_SCHED;
            PG8_LDB(B0, 1, 0); PG8_LDB(B1, 1, 1); PG8_SCHED; PG8_LDA(At, 1, 0); PG8_STAGE(PG8_SA(0, 1), a2 + hstep, voffA);
            PG8_WAIT_V(8); PG8_WAIT_L(0); PG8_BAR; PG8_MMA(0, 0, At, B0); PG8_MMA(0, 1, At, B1); PG8_BAR; PG8_SCHED;
            PG8_LDA(At, 1, 1); PG8_STAGE(PG8_SB(1, 0), b3, voffB); PG8_STAGE(PG8_SB(1, 1), b3 + hstep, voffB); PG8_STAGE(PG8_SA(1, 0), a3, voffA);
            PG8_WAIT_V(8); PG8_WAIT_L(0); PG8_BAR; PG8_MMA(1, 0, At, B0); PG8_MMA(1, 1, At, B1); PG8_BAR; PG8_SCHED;
            } else {
            PG8_LDB(B0, 0, 0); PG8_SCHED; PG8_LDA(At, 0, 0); PG8_STAGE(PG8_SA(1, 1), a1 + hstep, voffA);
            PG8_WAIT_L(8); PG8_BAR; PG8_WAIT_L(0); PG8_MMA(0, 0, At, B0); PG8_BAR; PG8_SCHED;
            PG8_LDB(B1, 0, 1); PG8_STAGE(PG8_SB(0, 0), b2, voffB);
            PG8_BAR; PG8_WAIT_L(0); PG8_MMA(0, 1, At, B1); PG8_BAR;
            PG8_LDA(At, 0, 1); PG8_STAGE(PG8_SA(0, 0), a2, voffA);
            PG8_BAR; PG8_WAIT_L(0); PG8_MMA(1, 0, At, B0); PG8_BAR; PG8_SCHED;
            PG8_STAGE(PG8_SB(0, 1), b2 + hstep, voffB);
            PG8_WAIT_V(6); PG8_BAR; PG8_MMA(1, 1, At, B1); PG8_BAR;
            PG8_LDB(B0, 1, 0); PG8_SCHED; PG8_LDA(At, 1, 0); PG8_STAGE(PG8_SA(0, 1), a2 + hstep, voffA);
            PG8_WAIT_L(8); PG8_BAR; PG8_WAIT_L(0); PG8_MMA(0, 0, At, B0); PG8_BAR; PG8_SCHED;
            PG8_LDB(B1, 1, 1); PG8_STAGE(PG8_SB(1, 0), b3, voffB);
            PG8_BAR; PG8_WAIT_L(0); PG8_MMA(0, 1, At, B1); PG8_BAR;
            PG8_LDA(At, 1, 1); PG8_STAGE(PG8_SA(1, 0), a3, voffA);
            PG8_BAR; PG8_WAIT_L(0); PG8_MMA(1, 0, At, B0); PG8_BAR; PG8_SCHED;
            PG8_STAGE(PG8_SB(1, 1), b3 + hstep, voffB);
            PG8_WAIT_V(6); PG8_BAR; PG8_MMA(1, 1, At, B1); PG8_BAR;
            }
        }
        if constexpr (ALIGN_EPI) { if (wr == 0) PG8_BAR; }
        if constexpr (!Epi::AFTER_DRAIN) { E(acc, cur, wr, wc, fr, fq); S.done(cur); }
        if (!has_next) break;
#pragma unroll
        for (int a = 0; a < 2; ++a)
#pragma unroll
            for (int b = 0; b < 2; ++b)
#pragma unroll
                for (int m = 0; m < 4; ++m)
#pragma unroll
                    for (int n = 0; n < 2; ++n) acc[a][b][m][n] = (f32x4){0.f, 0.f, 0.f, 0.f};
        cur = nxt; cA = nA; cB = nB; ++ui;
        if constexpr (ALIGN_EPI) { if (wr == 1) PG8_BAR; }
    }
    PG8_WAIT_V(0);
    if constexpr (!ALIGN_EPI) { if (wr == 0) PG8_BAR; }
    PG8_BAR;
    if constexpr (Epi::AFTER_DRAIN) { E.fused(acc, cur, wr, wc, fr, fq, lds, wid, lane); S.done(cur); }
#undef PG8_SA
#undef PG8_SB
#undef PG8_STAGE
#undef PG8_LDA
#undef PG8_LDB
#undef PG8_MMA
#undef PG8_WAIT_V
#undef PG8_WAIT_L
#undef PG8_BAR
#undef PG8_SCHED
}
}

#ifndef PG8_SP2
#define PG8_SP2 true
#endif
#define PG8_ALIGN true
constexpr int NWAVES = 8;
constexpr int BATCH = 2, SEQ = 8192, DM = 1024, M = BATCH * SEQ, NIN = 3788, NINP = 3840, FFN = 2816, DEPTH = 2;
constexpr int A_Q = 0, A_K = 256, A_V = 512, A_O = 768;
constexpr int R_R = 1024, R_K = 1408, R_V = 1792, R_WDF = 2176, R_AD = 2304, R_GD = 2368;
constexpr int S_Z = 2496, S_X = 2880, S_B = 3264, S_C = 3520, S_DT = 3776;
constexpr size_t MiB = 1u << 20;
constexpr size_t WS_CTL = 0, CTL_ZERO_BYTES = 128 * 1024;
constexpr size_t WS_GATES = 1 * MiB, WS_CT = 2 * MiB, WS_DTV = 2 * MiB + 512 * 1024;
constexpr size_t WS_GUT = 31 * MiB;
constexpr size_t WS_WIN = 4 * MiB, WS_WOUT = 12 * MiB, WS_WGU = 14 * MiB, WS_WDN = 25 * MiB;
constexpr size_t WS_XN = 32 * MiB, WS_COLS = 64 * MiB, WS_Y = 184 * MiB, WS_END = 256 * MiB;
constexpr size_t Y_AF = WS_Y, Y_AB = WS_Y + 8 * MiB, Y_RF = WS_Y + 16 * MiB, Y_RB = WS_Y + 28 * MiB, Y_SF = WS_Y + 40 * MiB, Y_SB = WS_Y + 52 * MiB;
constexpr int CW_BAR = 1024;
constexpr int RING_BYTES = 131072;
constexpr int LDS_BYTES = 147456, MISC_OFF = LDS_BYTES - 256;

#define GAS __attribute__((address_space(1)))
#define LAS __attribute__((address_space(3)))
typedef unsigned short bf16;
typedef unsigned v4u __attribute__((ext_vector_type(4)));
typedef unsigned v2u __attribute__((ext_vector_type(2)));
typedef float f32x4 __attribute__((ext_vector_type(4)));
typedef short bf16x8 __attribute__((ext_vector_type(8)));
typedef GAS unsigned gu32;
#define RLX_AGENT __ATOMIC_RELAXED, __HIP_MEMORY_SCOPE_AGENT
#define LDS_WAIT() asm volatile("s_waitcnt lgkmcnt(0)" ::: "memory")
#define VM_WAIT() asm volatile("s_waitcnt vmcnt(0)" ::: "memory")
__device__ __forceinline__ unsigned f2bf(float f) { unsigned u = __builtin_bit_cast(unsigned, f); return (u + 0x7fffu + ((u >> 16) & 1u)) >> 16; }
__device__ __forceinline__ unsigned pk2(float lo, float hi) { return f2bf(lo) | (f2bf(hi) << 16); }
__device__ __forceinline__ float bf2f(unsigned u) { return __builtin_bit_cast(float, u << 16); }
__device__ __forceinline__ float sigmoidf_(float x) { return __builtin_amdgcn_rcpf(1.f + __expf(-x)); }
__device__ __forceinline__ float siluf_(float x) { return x * sigmoidf_(x); }
__device__ __forceinline__ float wave_sum(float v) {
#pragma unroll
    for (int o = 1; o < 64; o <<= 1) v += __shfl_xor(v, o);
    return v;
}
__device__ __forceinline__ float wave_max(float v) {
#pragma unroll
    for (int o = 1; o < 64; o <<= 1) v = fmaxf(v, __shfl_xor(v, o));
    return v;
}
template <int CTRL> __device__ __forceinline__ float dppf(float v) { return __builtin_bit_cast(float, __builtin_amdgcn_update_dpp(0, __builtin_bit_cast(int, v), CTRL, 0xf, 0xf, true)); }
__device__ __forceinline__ float row16_sum(float v) { v += dppf<0xB1>(v); v += dppf<0x4E>(v); v += dppf<0x141>(v); v += dppf<0x140>(v); return v; }
template <int K> __device__ __forceinline__ f32x4 mma16(const LAS bf16* A, int lda, const LAS bf16* Bt, int ldb, f32x4 acc, int lane) {
    const int r = lane & 15, q = lane >> 4;
    const LAS bf16* ap = A + r * lda + q * 8; const LAS bf16* bp = Bt + r * ldb + q * 8;
#pragma unroll
    for (int k0 = 0; k0 < K; k0 += 32) {
        const bf16x8 a = *(const LAS bf16x8*)(ap + k0); const bf16x8 b = *(const LAS bf16x8*)(bp + k0);
        acc = __builtin_amdgcn_mfma_f32_16x16x32_bf16(a, b, acc, 0, 0, 0);
    }
    return acc;
}

__device__ __forceinline__ int swz64(int row, int col) { return col ^ (((row >> 3) & 7) << 3); }
template <bool SWA, bool SWB> __device__ __forceinline__ f32x4 mma16s(const LAS bf16* A, int lda, int rowA0, const LAS bf16* Bt, int ldb, int rowB0, f32x4 acc, int lane) {
    const int r = lane & 15, q = lane >> 4; const int ra = rowA0 + r, rb = rowB0 + r;
#pragma unroll
    for (int k0 = 0; k0 < 64; k0 += 32) { const int ca = k0 + 8 * q, cb = k0 + 8 * q;
        const bf16x8 a = *(const LAS bf16x8*)(A + ra * lda + (SWA ? swz64(ra, ca) : ca)); const bf16x8 b = *(const LAS bf16x8*)(Bt + rb * ldb + (SWB ? swz64(rb, cb) : cb));
        acc = __builtin_amdgcn_mfma_f32_16x16x32_bf16(a, b, acc, 0, 0, 0); }
    return acc;
}

template <int CTRL, int RM, int BM> __device__ __forceinline__ float dppm(float oldv, float v) { return __builtin_bit_cast(float, __builtin_amdgcn_update_dpp(__builtin_bit_cast(int, oldv), __builtin_bit_cast(int, v), CTRL, RM, BM, false)); }
__device__ __forceinline__ float wave_scan_add(float x) {
    float y = x + dppm<0x111, 0xf, 0xf>(0.f, x); y += dppm<0x112, 0xf, 0xf>(0.f, x); y += dppm<0x113, 0xf, 0xf>(0.f, x);
    y += dppm<0x114, 0xf, 0xe>(0.f, y); y += dppm<0x118, 0xf, 0xc>(0.f, y);
    y += dppm<0x142, 0xa, 0xf>(0.f, y); y += dppm<0x143, 0xc, 0xf>(0.f, y);
    return y;
}
__device__ __forceinline__ float wave_scan_max(float x) {
    const float ninf = -INFINITY;
    float y = fmaxf(x, dppm<0x111, 0xf, 0xf>(ninf, x)); y = fmaxf(y, dppm<0x112, 0xf, 0xf>(ninf, x)); y = fmaxf(y, dppm<0x113, 0xf, 0xf>(ninf, x));
    y = fmaxf(y, dppm<0x114, 0xf, 0xe>(ninf, y)); y = fmaxf(y, dppm<0x118, 0xf, 0xc>(ninf, y));
    y = fmaxf(y, dppm<0x142, 0xa, 0xf>(ninf, y)); y = fmaxf(y, dppm<0x143, 0xc, 0xf>(ninf, y));
    return y;
}
#define XB_TMO      128
#define XB_XCNT(j)  (256  + 64 * (j))
#define XB_XSUB(j)  (1280 + 64 * (j))
#define XB_XGEN(j)  (2304 + 64 * (j))
#define XB_TOP      3328
#define XB_TOPGEN   3392
#define XCD_BAR_WORDS 3456
#define XB_SPIN_CAP (1u << 18)

__device__ __forceinline__ unsigned xb_ld(unsigned* p)              { return __hip_atomic_load(p, __ATOMIC_RELAXED, __HIP_MEMORY_SCOPE_AGENT); }
__device__ __forceinline__ unsigned xb_add(unsigned* p, unsigned v) { return __hip_atomic_fetch_add(p, v, __ATOMIC_RELAXED, __HIP_MEMORY_SCOPE_AGENT); }
__device__ __forceinline__ unsigned xb_xcc_id() { return (unsigned)__builtin_amdgcn_s_getreg((3 << 11) | 20) & 0xFu; }
#define XB_SPIN(cond, bar) do { unsigned _sp = 0; while (cond) { __builtin_amdgcn_s_sleep(1); \
    if ((++_sp & 255u) == 0u) { if (xb_ld(&(bar)[XB_TMO])) break; if (_sp > XB_SPIN_CAP) { atomicAdd(&(bar)[XB_TMO], 1u); break; } } } } while (0)

struct XcdBarrier {
    unsigned* bar; unsigned x;
    volatile LAS unsigned* st;
};

__device__ __forceinline__ XcdBarrier xcd_barrier_post(unsigned* bar, volatile LAS unsigned* st) {
    XcdBarrier b; b.bar = bar; b.x = xb_xcc_id(); b.st = st;
    if (threadIdx.x == 0) (void)xb_add(&bar[XB_XCNT(b.x)], 1u);
    return b;
}
__device__ __forceinline__ void xcd_barrier_complete(unsigned* bar, unsigned x, unsigned& nloc, unsigned& nx) {
    const unsigned G = gridDim.x * gridDim.y * gridDim.z;
    unsigned sum, cnt, mine, sp = 0u;
    for (;;) {
        sum = 0u; cnt = 0u; mine = 0u;
#pragma unroll
        for (unsigned j = 0; j < 16; ++j) { const unsigned c = xb_ld(&bar[XB_XCNT(j)]); sum += c; cnt += (c > 0u) ? 1u : 0u; mine = (j == x) ? c : mine; }
        if (sum == G) break;
        __builtin_amdgcn_s_sleep(1);
        if ((++sp & 255u) == 0u) { if (xb_ld(&bar[XB_TMO])) break; if (sp > XB_SPIN_CAP) { atomicAdd(&bar[XB_TMO], 1u); break; } }
    }
    nloc = mine > 0u ? mine : 1u; nx = cnt > 0u ? cnt : 1u;
}

__device__ __forceinline__ void xcd_barrier(const XcdBarrier& b) {
    asm volatile("s_waitcnt vmcnt(0)" ::: "memory");
    __syncthreads();
    if (threadIdx.x == 0) {
        unsigned* bar = b.bar;
        __builtin_amdgcn_s_waitcnt(0);
        unsigned nloc = b.st[0], nx = b.st[1];
        if (nloc == 0u) { xcd_barrier_complete(bar, b.x, nloc, nx); b.st[0] = nloc; b.st[1] = nx; }
        const unsigned old = xb_add(&bar[XB_XSUB(b.x)], 1u);
        const unsigned gen = old / nloc;
        if (old + 1u == (gen + 1u) * nloc) {
            __builtin_amdgcn_fence(__ATOMIC_RELEASE, "agent");
            asm volatile("s_waitcnt vmcnt(0)" ::: "memory");
            const unsigned og = xb_add(&bar[XB_TOP], 1u);
            const unsigned tg = og / nx;
            if (og + 1u == (tg + 1u) * nx) xb_add(&bar[XB_TOPGEN], 1u);
            else XB_SPIN(xb_ld(&bar[XB_TOPGEN]) == tg, bar);
            __builtin_amdgcn_fence(__ATOMIC_ACQUIRE, "agent");
            xb_add(&bar[XB_XGEN(b.x)], 1u);
            asm volatile("s_waitcnt vmcnt(0)" ::: "memory");
        } else {
            XB_SPIN(xb_ld(&bar[XB_XGEN(b.x)]) == gen, bar);
            __builtin_amdgcn_fence(__ATOMIC_ACQUIRE, "agent");
            asm volatile("s_waitcnt vmcnt(0)" ::: "memory");
        }
    }
    __syncthreads();
}
struct Frame {
    LAS unsigned char* lds;
    int tid, lane, wave, vcu, G;
};
struct Args { const float* in[32]; float* out; unsigned char* ws; int ph_lo, ph_hi; };
constexpr int PTAB_OFF = LDS_BYTES - 768;
__device__ __forceinline__ unsigned long long ptab_ld(const Frame& F, int i) {
    const unsigned long long v = *(volatile LAS unsigned long long*)(F.lds + PTAB_OFF + 8 * i);
    const unsigned lo = __builtin_amdgcn_readfirstlane((unsigned)v), hi = __builtin_amdgcn_readfirstlane((unsigned)(v >> 32));
    return ((unsigned long long)hi << 32) | lo;
}
__device__ __forceinline__ const GAS float* INP(const Frame& F, int i) { return (const GAS float*)ptab_ld(F, i); }
__device__ __forceinline__ GAS unsigned char* WSP(const Frame& F) { return (GAS unsigned char*)ptab_ld(F, 33); }
__device__ __forceinline__ GAS float* OUTP(const Frame& F) { return (GAS float*)ptab_ld(F, 32); }
__device__ __forceinline__ void transpose_item(const GAS float* W, int K, int N, int nblk, GAS bf16* WT, int mode, int row_off, LAS float* scr, int item, int lane) {
    const int kb = item / nblk, nb = item % nblk, k0 = 64 * kb, n0 = 32 * nb;
    const int ncol = n0 + (lane & 31); const bool ok = ncol < N;
#pragma unroll 8
    for (int i = 0; i < 32; ++i) { const int kk = 2 * i + (lane >> 5); scr[kk * 33 + (lane & 31)] = ok ? W[(size_t)(k0 + kk) * N + ncol] : 0.f; }
    LDS_WAIT(); asm volatile("" ::: "memory");
    const int c = lane & 7;
    const int drow0 = mode ? (256 * (n0 >> 7) + (n0 & 127) + row_off) : (row_off + n0);
#pragma unroll
    for (int j = 0; j < 4; ++j) { const int n = (lane >> 3) + 8 * j; const LAS float* s = scr + (8 * c) * 33 + n;
        v4u o; o.x = pk2(s[0 * 33], s[1 * 33]); o.y = pk2(s[2 * 33], s[3 * 33]); o.z = pk2(s[4 * 33], s[5 * 33]); o.w = pk2(s[6 * 33], s[7 * 33]);
        *(GAS v4u*)(WT + (size_t)(drow0 + n) * K + k0 + 8 * c) = o; }
    LDS_WAIT(); asm volatile("" ::: "memory");
}
__device__ __forceinline__ void phase_convert(const Frame& F, int l) {
    LAS float* scr = (LAS float*)(F.lds + F.wave * 16384);
    const int gw = F.vcu * NWAVES + F.wave, NGW = F.G * NWAVES;
    GAS bf16* Win = (GAS bf16*)(WSP(F) + WS_WIN); GAS bf16* Wout = (GAS bf16*)(WSP(F) + WS_WOUT); GAS bf16* Wgu = (GAS bf16*)(WSP(F) + WS_WGU); GAS bf16* Wdn = (GAS bf16*)(WSP(F) + WS_WDN);
    constexpr int I_IN = 16 * 120, I_OUT = 16 * 32, I_G = 16 * 88, I_D = 44 * 32, I_GU = 2 * 12;
    constexpr int NITEMS = I_IN + I_OUT + 2 * I_G + I_D + I_GU;
    for (int it = gw; it < NITEMS; it += NGW) {
        int r = it;
        if (r < I_IN) { transpose_item(INP(F, 2) + (size_t)l * DM * NIN, DM, NIN, 120, Win, 0, 0, scr, r, F.lane); continue; } r -= I_IN;
        if (r < I_OUT) { transpose_item(INP(F, 26) + (size_t)l * DM * DM, DM, DM, 32, Wout, 0, 0, scr, r, F.lane); continue; } r -= I_OUT;
        if (r < I_G) { transpose_item(INP(F, 28) + (size_t)l * DM * FFN, DM, FFN, 88, Wgu, 1, 0, scr, r, F.lane); continue; } r -= I_G;
        if (r < I_G) { transpose_item(INP(F, 29) + (size_t)l * DM * FFN, DM, FFN, 88, Wgu, 1, 128, scr, r, F.lane); continue; } r -= I_G;
        if (r < I_D) { transpose_item(INP(F, 30) + (size_t)l * FFN * DM, FFN, DM, 32, Wdn, 0, 0, scr, r, F.lane); continue; } r -= I_D;
        transpose_item(INP(F, 14) + (size_t)l * 128 * 384, 128, 384, 12, (GAS bf16*)(WSP(F) + WS_GUT), 0, 0, scr, r, F.lane);
    }
}
__device__ __forceinline__ void phase_norm(const Frame& F, const GAS float* hin, const GAS float* g, GAS bf16* XN) {
    const int gw = F.vcu * NWAVES + F.wave, NGW = F.G * NWAVES;
    f32x4 gv[4];
#pragma unroll
    for (int j = 0; j < 4; ++j) gv[j] = ((const GAS f32x4*)g)[64 * j + F.lane];
    for (int m = gw; m < M; m += NGW) {
        const GAS f32x4* xr = (const GAS f32x4*)(hin + (size_t)m * DM) + F.lane;
        f32x4 v[4]; float s = 0.f;
#pragma unroll
        for (int j = 0; j < 4; ++j) { v[j] = xr[64 * j]; s += (v[j].x * v[j].x + v[j].y * v[j].y) + (v[j].z * v[j].z + v[j].w * v[j].w); }
        const float r = __builtin_amdgcn_rsqf(wave_sum(s) * (1.f / DM) + 1e-6f);
        GAS v2u* o8 = (GAS v2u*)(XN + (size_t)m * DM) + F.lane;
#pragma unroll
        for (int j = 0; j < 4; ++j) { v2u w; w.x = pk2(v[j].x * r * gv[j].x, v[j].y * r * gv[j].y); w.y = pk2(v[j].z * r * gv[j].z, v[j].w * r * gv[j].w); o8[64 * j] = w; }
    }
}
__device__ __forceinline__ void phase_final_norm(const Frame& F, GAS float* h, const GAS float* g) {
    const int gw = F.vcu * NWAVES + F.wave, NGW = F.G * NWAVES;
    f32x4 gv[4];
#pragma unroll
    for (int j = 0; j < 4; ++j) gv[j] = ((const GAS f32x4*)g)[64 * j + F.lane];
    for (int m = gw; m < M; m += NGW) {
        GAS f32x4* xr = (GAS f32x4*)(h + (size_t)m * DM) + F.lane;
        f32x4 v[4]; float s = 0.f;
#pragma unroll
        for (int j = 0; j < 4; ++j) { v[j] = xr[64 * j]; s += (v[j].x * v[j].x + v[j].y * v[j].y) + (v[j].z * v[j].z + v[j].w * v[j].w); }
        const float r = __builtin_amdgcn_rsqf(wave_sum(s) * (1.f / DM) + 1e-6f);
#pragma unroll
        for (int j = 0; j < 4; ++j) xr[64 * j] = v[j] * r * gv[j];
    }
}
__device__ __forceinline__ void phase_gates(const Frame& F, int l) {
    const GAS bf16* cols = (const GAS bf16*)(WSP(F) + WS_COLS); GAS float* GT = (GAS float*)(WSP(F) + WS_GATES);
    LAS bf16* raw = (LAS bf16*)(F.lds);
    LAS bf16* featb = (LAS bf16*)(F.lds + 30720);
    LAS bf16* gwT = (LAS bf16*)(F.lds + 55552);
    LAS float* outp = (LAS float*)(F.lds + 80384);
    const GAS float* gwg = INP(F, 5) + (size_t)l * 768 * 16; const GAS float* gb = INP(F, 6) + l * 16;
    const int tid = F.tid, lane = F.lane, wave = F.wave;
    __syncthreads();
    for (int i = tid; i < 768 * 16; i += 512) gwT[(i & 15) * 776 + (i >> 4)] = (bf16)f2bf(gwg[i]);
    float cw[5]; { const GAS float* cwp = INP(F, 3) + (size_t)l * 5 * 512;
#pragma unroll
        for (int j = 0; j < 5; ++j) cw[j] = cwp[j * 512 + tid]; }
    const float cbv = INP(F, 4)[l * 512 + tid];
    const float gbv = gb[tid & 15];
    for (int tile = F.vcu; tile < M / 16; tile += F.G) {
        const int m0 = tile * 16, t0 = m0 % SEQ;
        __syncthreads();
        for (int ch = tid; ch < 20 * 96; ch += 512) { const int rr = ch / 96, cc = ch % 96; const int t = t0 - 2 + rr;
            v4u v = {0u, 0u, 0u, 0u}; if (t >= 0 && t < SEQ) v = *(const GAS v4u*)(cols + (size_t)(m0 - 2 + rr) * NINP + cc * 8);
            *(LAS v4u*)(raw + rr * 768 + cc * 8) = v; }
        if (tid < 256) outp[tid] = 0.f;
        __syncthreads();
        { float win[5];
#pragma unroll
          for (int j = 0; j < 4; ++j) win[j] = bf2f(raw[j * 768 + tid]);
#pragma unroll 4
          for (int t = 0; t < 16; ++t) { win[4] = bf2f(raw[(t + 4) * 768 + tid]); float s = cbv;
#pragma unroll
              for (int j = 0; j < 5; ++j) s += cw[j] * win[j];
#pragma unroll
              for (int j = 0; j < 4; ++j) win[j] = win[j + 1];
              featb[t * 776 + tid] = (bf16)f2bf(siluf_(s)); }
          const int t = tid >> 5, c8 = tid & 31; *(LAS v4u*)(featb + t * 776 + 512 + c8 * 8) = *(const LAS v4u*)(raw + (t + 2) * 768 + 512 + c8 * 8); }
        __syncthreads();
        { const f32x4 z = {0.f, 0.f, 0.f, 0.f}; const f32x4 acc = mma16<96>(featb + 96 * wave, 776, gwT + 96 * wave, 776, z, lane);
#pragma unroll
          for (int jj = 0; jj < 4; ++jj) __hip_atomic_fetch_add(outp + ((lane >> 4) * 4 + jj) * 16 + (lane & 15), acc[jj], __ATOMIC_RELAXED, __HIP_MEMORY_SCOPE_WORKGROUP); }
        __syncthreads();
        if (tid < 256) { float s = outp[tid] + gbv; if ((tid & 15) >= 8) s = fminf(s, 0.f) - log1pf(__expf(-fabsf(s))); GT[(size_t)(m0 + (tid >> 4)) * 16 + (tid & 15)] = s; }
    }
    __syncthreads();
}
__device__ __forceinline__ f32x4 mma16_a8(const LAS bf16* A8, const LAS bf16* Bt, f32x4 acc, int lane) {
    const int q = lane >> 4;
    const LAS bf16* ap = A8 + (lane & 7) * 72 + q * 8; const LAS bf16* bp = Bt + (lane & 15) * 72 + q * 8;
#pragma unroll
    for (int k0 = 0; k0 < 64; k0 += 32) { const bf16x8 a = *(const LAS bf16x8*)(ap + k0); const bf16x8 b = *(const LAS bf16x8*)(bp + k0); acc = __builtin_amdgcn_mfma_f32_16x16x32_bf16(a, b, acc, 0, 0, 0); }
    return acc;
}
typedef float f32x2 __attribute__((ext_vector_type(2)));
template <bool DIR> __device__ __forceinline__ void rwkv_steps(const LAS float* OPS, const LAS float* VV, LAS float* YB, f32x4& S, int j, int row) {
    float yk0 = 0.f, yk1 = 0.f;
    const LAS float* opb = OPS + 4 * j; const LAS float* vpb = VV + row;
#define RWLD(W_, KK_, KA_, KM_, R_, V_, tl_) do { const LAS float* op_ = opb + (tl_) * 320; W_ = *(const LAS f32x4*)(op_); KK_ = *(const LAS f32x4*)(op_ + 64); KA_ = *(const LAS f32x4*)(op_ + 128); KM_ = *(const LAS f32x4*)(op_ + 192); R_ = *(const LAS f32x4*)(op_ + 256); V_ = vpb[(tl_) * 16]; } while (0)
    f32x4 w4, kk4, ka4, km4, r4, w4b, kk4b, ka4b, km4b, r4b; float vv, vvb;
    RWLD(w4, kk4, ka4, km4, r4, vv, (DIR ? 31 : 0));
    RWLD(w4b, kk4b, ka4b, km4b, r4b, vvb, (DIR ? 30 : 1));
#pragma unroll
    for (int i = 0; i < 32; ++i) {
        f32x4 nw4, nkk4, nka4, nkm4, nr4; float nvv;
        if (i < 30) RWLD(nw4, nkk4, nka4, nkm4, nr4, nvv, (DIR ? 29 - i : i + 2));
        f32x2 t2 = S.xy * kk4.xy; t2 = S.zw * kk4.zw + t2;
        float sa = t2.x + t2.y;
        const f32x4 pre_s = S * w4 + km4 * vv;
        sa = row16_sum(sa);
        S = pre_s + ka4 * sa;
        f32x2 y2 = S.xy * r4.xy; y2 = S.zw * r4.zw + y2;
        float y = y2.x + y2.y;
        y = row16_sum(y);
        if ((i & 15) == j) { if (i < 16) yk0 = y; else yk1 = y; }
        w4 = w4b; kk4 = kk4b; ka4 = ka4b; km4 = km4b; r4 = r4b; vv = vvb;
        if (i < 30) { w4b = nw4; kk4b = nkk4; ka4b = nka4; km4b = nkm4; r4b = nr4; vvb = nvv; } }
#undef RWLD
    YB[(DIR ? 31 - j : j) * 16 + row] = yk0; YB[(DIR ? 15 - j : 16 + j) * 16 + row] = yk1;
}
struct RwCtx { LAS bf16* WA; LAS bf16* WW; LAS bf16* XA; LAS bf16* XW; LAS bf16* RAWB; LAS float* MU; GAS float* CT; const GAS bf16* colsb;
    f32x4 kk_c4, ka_c4, rk_c4; float ba[4], bw[4]; float mup_[5][2], mun_[5][2]; int h, dir, qtr, tb0; size_t mb; };
template <int NTOK> __device__ __forceinline__ void rw_addr_init(int (&poff)[5], int (&prr)[5], int lane, int tb0, int h, int dir) {
    constexpr int NCHK = (NTOK + 2) * 40;
#pragma unroll
    for (int i = 0; i < 5; ++i) { const int idx = lane + 64 * i; const int rr = idx / 40, q = idx % 40, wh = q >> 3, c8 = q & 7;
        const int gc = (wh == 0 ? R_R + h * 64 : wh == 1 ? R_K + h * 64 : wh == 2 ? R_V + h * 64 : wh == 3 ? R_WDF + dir * 64 : R_AD) + c8 * 8;
        prr[i] = idx < NCHK ? tb0 - 1 + rr : -100000; poff[i] = (tb0 - 1 + rr) * NINP + gc; }
}
template <int NTOK> __device__ __forceinline__ void rw_issue(v4u (&pre)[5], const int (&poff)[5], const int (&prr)[5], const GAS bf16* colsb, int T0) {
    constexpr int NCH = ((NTOK + 2) * 40 + 63) / 64;
#pragma unroll
    for (int i = 0; i < NCH; ++i) { const int t = T0 + prr[i]; const bool ok = t >= 0 && t < SEQ;
        const v4u vv = *(const GAS v4u*)(colsb + (size_t)T0 * NINP + (ok ? poff[i] : 0)); pre[i] = ok ? vv : (v4u){0u, 0u, 0u, 0u}; }
}
template <int NTOK, bool FULLV> __device__ __forceinline__ void rw_prep(const RwCtx& C, const v4u (&pre)[5], LAS float* OPS, LAS float* VV, int T0, int lane) {
    constexpr int NCHK = (NTOK + 2) * 40, NCH = (NCHK + 63) / 64;
    const int j = lane & 15, c2 = (lane & 31) * 2;
#pragma unroll
    for (int i = 0; i < NCH; ++i) { const int idx = lane + 64 * i; if (idx < NCHK) *(LAS v4u*)(C.RAWB + idx * 8) = pre[i]; }
    LDS_WAIT(); asm volatile("" ::: "memory");
#pragma unroll
    for (int which = 0; which < 5; ++which)
#pragma unroll
        for (int pr = 0; pr < NTOK / 2; ++pr) { const int tt = 2 * pr + (lane >> 5), cc = which * 64 + c2, t = C.tb0 + tt;
            const unsigned r0 = *(const LAS unsigned*)(C.RAWB + tt * 320 + cc), r1 = *(const LAS unsigned*)(C.RAWB + (tt + 1) * 320 + cc), r2 = *(const LAS unsigned*)(C.RAWB + (tt + 2) * 320 + cc);
            const float p1x = bf2f(r1 & 0xffffu), p1y = bf2f(r1 >> 16);
            const float vx = p1x + C.mup_[which][0] * (bf2f(r0 & 0xffffu) - p1x) + C.mun_[which][0] * (bf2f(r2 & 0xffffu) - p1x);
            const float vy = p1y + C.mup_[which][1] * (bf2f(r0 >> 16) - p1y) + C.mun_[which][1] * (bf2f(r2 >> 16) - p1y);
            if (which == 0) *(LAS f32x2*)(OPS + t * 320 + 256 + c2) = (f32x2){vx, vy};
            else if (which == 1) *(LAS f32x2*)(OPS + t * 320 + 192 + c2) = (f32x2){vx, vy};
            else if (which == 2) { if (FULLV) *(LAS f32x2*)(VV + t * 64 + c2) = (f32x2){vx, vy}; else if ((c2 >> 4) == C.qtr) *(LAS f32x2*)(VV + t * 16 + (c2 & 15)) = (f32x2){vx, vy}; }
            else if (which == 3) { const float ex = __expf(2.f * vx), ey = __expf(2.f * vy);
                *(LAS unsigned*)(C.XW + tt * 72 + c2) = pk2(1.f - 2.f * __builtin_amdgcn_rcpf(ex + 1.f), 1.f - 2.f * __builtin_amdgcn_rcpf(ey + 1.f)); }
            else *(LAS unsigned*)(C.XA + tt * 72 + c2) = pk2(vx, vy); }
    LDS_WAIT(); asm volatile("" ::: "memory");
    { const bool hi = lane >= 32; const int lr = ((lane >> 4) & 1) * 4 + (hi ? 2 : 0); const bool ok0 = lr < NTOK, ok1 = lr + 1 < NTOK; const int tb = C.tb0 + lr;
#pragma unroll
      for (int ct = 0; ct < 4; ++ct) { const f32x4 z = {0.f, 0.f, 0.f, 0.f};
        const f32x4 ca = mma16_a8(C.XA, C.WA + ct * 16 * 72, z, lane), cw = mma16_a8(C.XW, C.WW + ct * 16 * 72, z, lane);
        const int c = ct * 16 + j;
        const float a0v = hi ? ca[2] : ca[0], a1v = hi ? ca[3] : ca[1], w0v = hi ? cw[2] : cw[0], w1v = hi ? cw[3] : cw[1];
        if (ok0) { OPS[tb * 320 + 128 + c] = sigmoidf_(C.ba[ct] + a0v); OPS[tb * 320 + c] = __expf(-0.6065306597f * sigmoidf_(C.bw[ct] + w0v)); }
        if (ok1) { OPS[(tb + 1) * 320 + 128 + c] = sigmoidf_(C.ba[ct] + a1v); OPS[(tb + 1) * 320 + c] = __expf(-0.6065306597f * sigmoidf_(C.bw[ct] + w1v)); } } }
    LDS_WAIT(); asm volatile("" ::: "memory");
#pragma unroll
    for (int ps = 0; ps < (NTOK + 3) / 4; ++ps) { const int tl = 4 * ps + (lane >> 4); const bool ok = tl < NTOK; const int t = C.tb0 + (ok ? tl : 0); LAS float* op = OPS + t * 320 + 4 * j;
        const f32x4 av = *(const LAS f32x4*)(op + 128), kp = *(const LAS f32x4*)(op + 192), rp = *(const LAS f32x4*)(op + 256);
        const f32x4 kr = kp * C.kk_c4; const float ss = row16_sum((kr.x * kr.x + kr.y * kr.y) + (kr.z * kr.z + kr.w * kr.w));
        const f32x4 kkv = kr * __builtin_amdgcn_rcpf(fmaxf(__builtin_amdgcn_sqrtf(ss), 1e-12f));
        const f32x4 km = kp * ((av - 1.f) * C.ka_c4 + 1.f);
        const f32x4 q = rp * km * C.rk_c4; const float cs = row16_sum((q.x + q.y) + (q.z + q.w));
        if (ok) { *(LAS f32x4*)(op + 64) = kkv; *(LAS f32x4*)(op + 128) = kkv * (-av); *(LAS f32x4*)(op + 192) = km;
            if (C.dir == 0 && C.qtr == 0 && j == 0) C.CT[(C.mb + T0 + t) * 8 + C.h] = cs; } }
}

constexpr int RW_NSLOT = 6, RW_SLOT_WORDS = 32 * 320 + 32 * 64;
constexpr size_t WS_RING = 248 * MiB;
constexpr int CW_RW = 8192;
__device__ __forceinline__ unsigned rw_ld(GAS unsigned* p) { return __hip_atomic_load(p, __ATOMIC_RELAXED, __HIP_MEMORY_SCOPE_AGENT); }
__device__ __forceinline__ void rw_st(GAS unsigned* p, unsigned v) { __hip_atomic_store(p, v, __ATOMIC_RELAXED, __HIP_MEMORY_SCOPE_AGENT); }
__device__ __forceinline__ void rwkv_produce(const Frame& F, int l, int p, int pp, unsigned G0) {
    const int b = p / 12, rem = p % 12, h = rem >> 1, dir = rem & 1;
    const GAS bf16* cols = (const GAS bf16*)(WSP(F) + WS_COLS);
    const int tid = F.tid, lane = F.lane, wave = F.wave;
    LAS bf16* WA = (LAS bf16*)(F.lds); LAS bf16* WW = (LAS bf16*)(F.lds + 9216);
    LAS float* MU = (LAS float*)(F.lds + 67584);
    LAS float* OPS = (LAS float*)(F.lds + 70144);
    LAS float* VV = (LAS float*)(F.lds + 111104);
    LAS unsigned* flg = (LAS unsigned*)(F.lds + 119296);
    GAS unsigned* ctl = (GAS unsigned*)(WSP(F) + WS_CTL) + CW_RW + 384 * p;
    GAS unsigned long long* ring = (GAS unsigned long long*)(WSP(F) + WS_RING) + (size_t)p * RW_NSLOT * (RW_SLOT_WORDS / 2);
    constexpr int NB = SEQ / 32;
    __syncthreads();
    { const GAS float* aup = INP(F, 13) + (size_t)l * 64 * 384; const GAS float* wup = INP(F, 11) + (size_t)(l * 2 + dir) * 64 * 384;
      for (int idx = tid; idx < 4096; idx += 512) { const int i = idx >> 6, c = idx & 63;
          WA[c * 72 + i] = (bf16)f2bf(aup[i * 384 + h * 64 + c]); WW[c * 72 + i] = (bf16)f2bf(wup[i * 384 + h * 64 + c]); }
      if (tid < 320) { const int which = tid >> 6, c = tid & 63;
          const int rc = which == 0 ? h * 64 + c : which == 1 ? 384 + h * 64 + c : which == 2 ? 768 + h * 64 + c : which == 3 ? 1152 + dir * 64 + c : 1280 + c;
          MU[tid] = INP(F, 8)[l * 1472 + rc]; MU[320 + tid] = INP(F, 9)[l * 1472 + rc]; } }
    __syncthreads();
    const size_t mb = (size_t)b * SEQ;
    const int j = lane & 15;
    RwCtx C;
    C.WA = WA; C.WW = WW; C.XA = (LAS bf16*)(F.lds + 18432) + wave * 576; C.XW = (LAS bf16*)(F.lds + 27648) + wave * 576;
    C.RAWB = (LAS bf16*)(F.lds + 36864) + wave * 1920;
    C.MU = MU; C.CT = (GAS float*)(WSP(F) + WS_CT); C.colsb = cols + mb * NINP; C.h = h; C.dir = dir; C.qtr = 0; C.mb = mb; C.tb0 = 4 * wave;
    { const int hc4 = h * 64 + 4 * j;
      C.kk_c4 = *(const GAS f32x4*)(INP(F, 15) + l * 384 + hc4); C.ka_c4 = *(const GAS f32x4*)(INP(F, 16) + l * 384 + hc4); C.rk_c4 = *(const GAS f32x4*)(INP(F, 17) + l * 384 + hc4);
#pragma unroll
      for (int ct = 0; ct < 4; ++ct) { C.ba[ct] = INP(F, 12)[l * 384 + h * 64 + 16 * ct + j]; C.bw[ct] = INP(F, 10)[(l * 2 + dir) * 384 + h * 64 + 16 * ct + j]; }
      const int c2 = (lane & 31) * 2;
#pragma unroll
      for (int wq = 0; wq < 5; ++wq) { C.mup_[wq][0] = MU[wq * 64 + c2]; C.mup_[wq][1] = MU[wq * 64 + c2 + 1]; C.mun_[wq][0] = MU[320 + wq * 64 + c2]; C.mun_[wq][1] = MU[320 + wq * 64 + c2 + 1]; } }
    v4u pre[5]; int poff[5], prr[5];
    rw_addr_init<4>(poff, prr, lane, C.tb0, h, dir);
    rw_issue<4>(pre, poff, prr, C.colsb, dir ? SEQ - 32 * (pp + 1) : 32 * pp);
    bool dead = false; unsigned mseen = G0;
    GAS unsigned* myflag = ctl + 320 * pp; const unsigned PB = G0 / 2;
#pragma unroll 1
    for (int it = pp; it < NB; it += 2) {
        const int T0 = dir ? SEQ - 32 * (it + 1) : 32 * it;
        v4u cur[5];
#pragma unroll
        for (int i = 0; i < 5; ++i) cur[i] = pre[i];
        if (it + 2 < NB) rw_issue<4>(pre, poff, prr, C.colsb, dir ? SEQ - 32 * (it + 3) : 32 * (it + 2));
        rw_prep<4, true>(C, cur, OPS, VV, T0, lane);
        if (tid == 0) { const unsigned need = G0 + (unsigned)it + 1u; unsigned sp = 0u;
            if (need > (unsigned)RW_NSLOT && !dead) { const unsigned want = need - (unsigned)RW_NSLOT;
                while (mseen < want) { if (++sp > (1u << 17)) { dead = true; break; } __builtin_amdgcn_s_sleep(2);
                    const unsigned m01 = min(rw_ld(ctl + 64), rw_ld(ctl + 128)), m23 = min(rw_ld(ctl + 192), rw_ld(ctl + 256)); mseen = min(m01, m23); } }
            flg[0] = sp; }
        __syncthreads();
        { GAS unsigned long long* slot = ring + (size_t)((G0 + (unsigned)it) % RW_NSLOT) * (RW_SLOT_WORDS / 2);
          const LAS v4u* src = (const LAS v4u*)OPS;
#pragma unroll
          for (int i = 0; i < 6; ++i) { const int idx = tid + 512 * i; const v4u d = src[idx]; GAS v4u* dst = (GAS v4u*)slot + idx;
              asm volatile("global_store_dwordx4 %0, %1, off sc1\n\ts_nop 1" :: "v"(dst), "v"(d) : "memory"); } }
        asm volatile("s_waitcnt vmcnt(10)" ::: "memory");
        __syncthreads();
        if (tid == 0 && it >= 2) rw_st(myflag, PB + (unsigned)(it >> 1));
    }
    asm volatile("s_waitcnt vmcnt(0)" ::: "memory");
    __syncthreads();
    if (tid == 0) rw_st(myflag, PB + (unsigned)(NB / 2));
    __syncthreads();
}
__device__ __forceinline__ void rwkv_scan(const Frame& F, int l, int p, int qtr, unsigned G0) {
    const int b = p / 12, rem = p % 12, h = rem >> 1, dir = rem & 1;
    GAS bf16* Y = (GAS bf16*)(WSP(F) + (dir ? Y_RB : Y_RF));
    const int lane = F.lane, wave = F.wave;
    LAS float* OPSb = (LAS float*)(F.lds);
    LAS float* VVb = (LAS float*)(F.lds + 81920);
    LAS float* YBb = (LAS float*)(F.lds + 86016);
    GAS unsigned* ctl = (GAS unsigned*)(WSP(F) + WS_CTL) + CW_RW + 384 * p;
    const GAS unsigned long long* ring = (const GAS unsigned long long*)(WSP(F) + WS_RING) + (size_t)p * RW_NSLOT * (RW_SLOT_WORDS / 2);
    constexpr int NB = SEQ / 32;
    const size_t mb = (size_t)b * SEQ;
    const int j = lane & 15;
    __syncthreads();
    if (wave < 4) {
        const int lt = wave * 64 + lane;
        bool dead = false; unsigned pseen0 = G0 / 2, pseen1 = G0 / 2;
        unsigned long long va[21], vb[21];
#define RW_FETCH(v_, k_) do { const unsigned need_ = G0 / 2 + (unsigned)((k_) >> 1) + 1u; unsigned sp_ = 0u; GAS unsigned* fl_ = ctl + 320 * ((k_) & 1); \
            if (!dead) { unsigned ps_ = ((k_) & 1) ? pseen1 : pseen0; while (ps_ < need_) { ps_ = rw_ld(fl_); if (ps_ >= need_) break; if (++sp_ > (1u << 17)) { dead = true; break; } __builtin_amdgcn_s_sleep(2); } if ((k_) & 1) pseen1 = ps_; else pseen0 = ps_; } \
            const GAS unsigned long long* slot_ = ring + (size_t)((G0 + (unsigned)(k_)) % RW_NSLOT) * (RW_SLOT_WORDS / 2); \
            _Pragma("unroll") for (int i_ = 0; i_ < 20; ++i_) v_[i_] = __hip_atomic_load(slot_ + lt + 256 * i_, __ATOMIC_RELAXED, __HIP_MEMORY_SCOPE_AGENT); \
            v_[20] = __hip_atomic_load(slot_ + 5120 + (lt >> 3) * 32 + qtr * 8 + (lt & 7), __ATOMIC_RELAXED, __HIP_MEMORY_SCOPE_AGENT); } while (0)
#define RW_LITER(v_, k_) do { if ((k_) >= 1 && lt == 0) rw_st(ctl + 64 * (qtr + 1), G0 + (unsigned)(k_)); \
            if ((k_) < NB) { LAS unsigned long long* dO_ = (LAS unsigned long long*)(OPSb + ((k_) & 1) * 10240); LAS unsigned long long* dV_ = (LAS unsigned long long*)(VVb + ((k_) & 1) * 512); \
                _Pragma("unroll") for (int i_ = 0; i_ < 20; ++i_) dO_[lt + 256 * i_] = v_[i_]; dV_[lt] = v_[20]; \
                if ((k_) + 2 < NB) RW_FETCH(v_, (k_) + 2); } \
            if ((k_) >= 2) { const int bk_ = (k_) - 2; const int T0_ = dir ? SEQ - 32 * (bk_ + 1) : 32 * bk_; const LAS float* YB_ = YBb + (bk_ & 1) * 512; \
                const int idx_ = lt * 2, tl_ = idx_ >> 4, rw_ = idx_ & 15; \
                *(GAS unsigned*)(Y + (mb + T0_ + tl_) * 384 + h * 64 + 16 * qtr + rw_) = pk2(YB_[idx_], YB_[idx_ + 1]); } \
            __syncthreads(); } while (0)
        RW_FETCH(va, 0); RW_FETCH(vb, 1);
#pragma unroll 1
        for (int it = 0; it < NB; it += 2) { RW_LITER(va, it); RW_LITER(vb, it + 1); }
        RW_LITER(va, NB);
#undef RW_FETCH
#undef RW_LITER
        { const int bk = NB - 1; const int T0 = dir ? SEQ - 32 * (bk + 1) : 32 * bk; const LAS float* YB = YBb + (bk & 1) * 512;
          const int idx = lt * 2, tl = idx >> 4, rw = idx & 15;
          *(GAS unsigned*)(Y + (mb + T0 + tl) * 384 + h * 64 + 16 * qtr + rw) = pk2(YB[idx], YB[idx + 1]); }
    } else {
        const int row = (wave - 4) * 4 + (lane >> 4);
        f32x4 S = {0.f, 0.f, 0.f, 0.f};
#pragma unroll 1
        for (int it = 0; it <= NB; ++it) {
            if (it >= 1) { const int bk = it - 1;
                const LAS float* OPS = OPSb + (bk & 1) * 10240; const LAS float* VV = VVb + (bk & 1) * 512; LAS float* YB = YBb + (bk & 1) * 512;
                if (dir) rwkv_steps<true>(OPS, VV, YB, S, j, row); else rwkv_steps<false>(OPS, VV, YB, S, j, row);
            }
            __syncthreads();
        }
    }
    __syncthreads();
}
__device__ __forceinline__ float row8_sum(float v) { v += dppf<0xB1>(v); v += dppf<0x4E>(v); v += dppf<0x141>(v); return v; }
__device__ __forceinline__ void mlstm_seq(const Frame& F, int l, int task, int cfull0, int cend) {
    const int b = task >> 3, h = (task >> 1) & 3, dir = task & 1;
    const GAS bf16* cols = (const GAS bf16*)(WSP(F) + WS_COLS); const GAS float* GT = (const GAS float*)(WSP(F) + WS_GATES);
    GAS bf16* Y = (GAS bf16*)(WSP(F) + (dir ? Y_AB : Y_AF));
    LAS bf16* RAWQ = (LAS bf16*)(F.lds);
    LAS bf16* Qs = (LAS bf16*)(F.lds + 17408); LAS bf16* Ks = (LAS bf16*)(F.lds + 26624);
    LAS bf16* Vtb = (LAS bf16*)(F.lds + 35840);
    LAS bf16* KWt = (LAS bf16*)(F.lds + 54272); LAS bf16* Ps = (LAS bf16*)(F.lds + 63488);
    LAS bf16* Ctb = (LAS bf16*)(F.lds + 72704);
    LAS float* ub = (LAS float*)(F.lds + 91136);
    LAS float* blb = ub + 128; LAS float* rmb = ub + 256;
    LAS float* den = ub + 384; LAS float* qn = ub + 448; LAS float* nst = ub + 512; LAS float* scb = ub + 576;
    const int tid = F.tid, lane = F.lane, wave = F.wave;
    const size_t mb = (size_t)b * SEQ;
    constexpr int NC = SEQ / 64;
    __syncthreads();
    for (int i = tid; i < 2 * 64 * 72; i += 512) Ctb[i] = 0;
    if (tid < 64) nst[tid] = 0.f;
    const int cc = tid & 127, isK = cc >> 6, d0 = cc & 63, chn = isK * 256 + h * 64 + d0;
    float cw[5]; const GAS float* cwp = INP(F, 3) + (size_t)l * 5 * 512;
#pragma unroll
    for (int jj = 0; jj < 5; ++jj) cw[jj] = cwp[jj * 512 + chn];
    const float cbv = INP(F, 4)[l * 512 + chn];
    f32x4 st[2] = {{0.f, 0.f, 0.f, 0.f}, {0.f, 0.f, 0.f, 0.f}};
    float m_st = 0.f;
    v4u pre[3], prev; float gli = 0.f, glf = 0.f;
#define ML_ISSUE(c_) do { const int tlo_ = dir ? SEQ - 64 * ((c_) + 1) : 64 * (c_); _Pragma("unroll") for (int i_ = 0; i_ < 3; ++i_) { const int ch_ = tid + 512 * i_; pre[i_] = (v4u){0u, 0u, 0u, 0u}; \
        if (ch_ < 68 * 16) { const int rr_ = ch_ >> 4, q_ = ch_ & 15; const int t_ = tlo_ - 2 + rr_; if (t_ >= 0 && t_ < SEQ) pre[i_] = *(const GAS v4u*)(cols + (mb + t_) * NINP + (q_ >> 3) * 256 + h * 64 + (q_ & 7) * 8); } } \
        prev = *(const GAS v4u*)(cols + (mb + tlo_ + (tid >> 3)) * NINP + A_V + h * 64 + (tid & 7) * 8); \
        if (tid < 64) { const int t_ = dir ? tlo_ + 63 - tid : tlo_ + tid; gli = GT[(mb + t_) * 16 + dir * 4 + h]; glf = GT[(mb + t_) * 16 + 8 + dir * 4 + h]; } } while (0)
#define ML_FILL(c_) do { _Pragma("unroll") for (int i_ = 0; i_ < 3; ++i_) { const int ch_ = tid + 512 * i_; if (ch_ < 68 * 16) *(LAS v4u*)(RAWQ + (ch_ >> 4) * 128 + (ch_ & 15) * 8) = pre[i_]; } \
        { LAS bf16* Vt_ = Vtb + ((c_) & 1) * 4608; const int tl_ = tid >> 3, e8_ = tid & 7; const int lp_ = dir ? 63 - tl_ : tl_; const unsigned w_[4] = {prev.x, prev.y, prev.z, prev.w}; \
          _Pragma("unroll") for (int k_ = 0; k_ < 4; ++k_) { const int e_ = e8_ * 8 + 2 * k_; Vt_[e_ * 72 + swz64(e_, lp_)] = (bf16)(w_[k_] & 0xffffu); Vt_[(e_ + 1) * 72 + swz64(e_ + 1, lp_)] = (bf16)(w_[k_] >> 16); } } \
        if (tid < 64) { const float bl_ = wave_scan_add(glf); \
            const float u_ = gli - bl_; const float rm_ = wave_scan_max(u_); \
            ub[((c_) & 1) * 64 + tid] = u_; blb[((c_) & 1) * 64 + tid] = bl_; rmb[((c_) & 1) * 64 + tid] = rm_; if (tid == 63) { scb[((c_) & 1) * 2] = rm_; scb[((c_) & 1) * 2 + 1] = bl_; } } } while (0)
    ML_ISSUE(0); ML_FILL(0); ML_ISSUE(1);
    __syncthreads();
    if (cfull0 > 0) {
        const int dk = tid & 63; float cwk[5]; { const GAS float* cwq = INP(F, 3) + (size_t)l * 5 * 512;
#pragma unroll
            for (int jj = 0; jj < 5; ++jj) cwk[jj] = cwq[jj * 512 + 256 + h * 64 + dk]; }
        const float cbk = INP(F, 4)[l * 512 + 256 + h * 64 + dk];
#pragma unroll 1
        for (int c = 0; c < cfull0; ++c) {
            const LAS float* u = ub + (c & 1) * 64;
            const LAS bf16* Vt = Vtb + (c & 1) * 4608; LAS bf16* Ctn = Ctb + ((c + 1) & 1) * 4608;
            const float umax = scb[(c & 1) * 2], tot = scb[(c & 1) * 2 + 1];
#pragma unroll 2
            for (int i = 0; i < 8; ++i) { const int tl = (tid >> 6) + 8 * i; float s = cbk;
#pragma unroll
                for (int jj = 0; jj < 5; ++jj) s += cwk[jj] * bf2f(RAWQ[(tl + jj) * 128 + 64 + dk]);
                const int lp = dir ? 63 - tl : tl;
                KWt[dk * 72 + swz64(dk, lp)] = (bf16)f2bf(siluf_(s) * 0.125f * __expf(u[lp] - umax)); }
            __syncthreads();
            const float mmax = fmaxf(m_st, umax), s_old = __expf(m_st - mmax), s_new = __expf(umax - mmax);
#pragma unroll
            for (int k = 0; k < 2; ++k) { const int ti = 2 * wave + k, t0_ = ti >> 2, t1_ = ti & 3; const f32x4 z = {0.f, 0.f, 0.f, 0.f};
                const f32x4 lc = mma16s<true, true>(Vt, 72, t0_ * 16, KWt, 72, t1_ * 16, z, lane);
#pragma unroll
                for (int jj = 0; jj < 4; ++jj) { const int r_ = t0_ * 16 + (lane >> 4) * 4 + jj, c_ = t1_ * 16 + (lane & 15);
                    st[k][jj] = s_old * st[k][jj] + s_new * lc[jj]; Ctn[r_ * 72 + c_] = (bf16)f2bf(st[k][jj]); } }
            { const int dq = tid >> 3, part = tid & 7; float s = 0.f;
#pragma unroll
              for (int k = 0; k < 8; ++k) s += bf2f(KWt[dq * 72 + swz64(dq, part * 8) + k]);
              s = row8_sum(s); if (part == 0) nst[dq] = s_old * nst[dq] + s_new * s; }
            m_st = tot + mmax;
            ML_FILL(c + 1); if (c + 2 < cend) ML_ISSUE(c + 2);
            __syncthreads();
        }
    }
#pragma unroll 1
    for (int c = cfull0; c < cend; ++c) {
        const bool full = c >= cfull0;
        const int tlo = dir ? SEQ - 64 * (c + 1) : 64 * c;
        const LAS float* u = ub + (c & 1) * 64; const LAS float* bl = blb + (c & 1) * 64; const LAS float* rm = rmb + (c & 1) * 64;
        const LAS bf16* Vt = Vtb + (c & 1) * 4608; const LAS bf16* Ct = Ctb + (c & 1) * 4608; LAS bf16* Ctn = Ctb + ((c + 1) & 1) * 4608;
#pragma unroll 4
        for (int i = 0; i < 16; ++i) { const int tl = (tid >> 7) + 4 * i; float s = cbv;
#pragma unroll
            for (int jj = 0; jj < 5; ++jj) s += cw[jj] * bf2f(RAWQ[(tl + jj) * 128 + cc]);
            s = siluf_(s); const int lpos = dir ? 63 - tl : tl;
            if (isK) Ks[lpos * 72 + d0] = (bf16)f2bf(s * 0.125f); else Qs[lpos * 72 + d0] = (bf16)f2bf(s); }
        if (tid < 64) den[tid] = 0.f;
        __syncthreads();
        const float umax = scb[(c & 1) * 2], tot = scb[(c & 1) * 2 + 1];
        for (int idx = tid; idx < 4096; idx += 512) { const int lp = idx >> 6, d = idx & 63; KWt[d * 72 + swz64(d, lp)] = (bf16)f2bf(bf2f(Ks[lp * 72 + d]) * __expf(u[lp] - umax)); }
        if (full) {
#pragma unroll
        for (int k = 0; k < 2; ++k) { const int ti = 2 * wave + k, tl_ = ti >> 2, ts = ti & 3; f32x4 acc = {0.f, 0.f, 0.f, 0.f};
            if (ts <= tl_) acc = mma16<64>(Qs + tl_ * 16 * 72, 72, Ks + ts * 16 * 72, 72, acc, lane);
#pragma unroll
            for (int jj = 0; jj < 4; ++jj) { const int lr = tl_ * 16 + (lane >> 4) * 4 + jj, s = ts * 16 + (lane & 15);
                const float v = (s <= lr) ? acc[jj] * __expf(u[s] - fmaxf(m_st, rm[lr])) : 0.f; const unsigned vb = f2bf(v); Ps[lr * 72 + s] = (bf16)vb;
                if (ts <= tl_) { const float rs = row16_sum(bf2f(vb)); if ((lane & 15) == 0) __hip_atomic_fetch_add(den + lr, rs, __ATOMIC_RELAXED, __HIP_MEMORY_SCOPE_WORKGROUP); } } }
        { const int lq = tid >> 3, part = tid & 7; float s = 0.f;
#pragma unroll
          for (int k = 0; k < 8; ++k) s += bf2f(Qs[lq * 72 + part * 8 + k]) * nst[part * 8 + k];
          s = row8_sum(s); if (part == 0) qn[lq] = s; }
        }
        __syncthreads();
        const float mmax = fmaxf(m_st, umax), s_old = __expf(m_st - mmax), s_new = __expf(umax - mmax);
#pragma unroll
        for (int k = 0; k < 2; ++k) { const int ti = 2 * wave + k, t0_ = ti >> 2, t1_ = ti & 3; const f32x4 z = {0.f, 0.f, 0.f, 0.f};
            f32x4 a1 = z, a2 = z;
            if (full) { a1 = mma16s<false, true>(Ps, 72, t0_ * 16, Vt, 72, t1_ * 16, z, lane); a2 = mma16<64>(Qs + t0_ * 16 * 72, 72, Ct + t1_ * 16 * 72, 72, z, lane); }
            const f32x4 lc = mma16s<true, true>(Vt, 72, t0_ * 16, KWt, 72, t1_ * 16, z, lane);
#pragma unroll
            for (int jj = 0; jj < 4; ++jj) { const int r_ = t0_ * 16 + (lane >> 4) * 4 + jj, c_ = t1_ * 16 + (lane & 15);
                if (full) { const float mx = fmaxf(m_st, rm[r_]), iwv = __expf(m_st - mx);
                const float dn = den[r_] + iwv * qn[r_];
                const float val = (a1[jj] + iwv * a2[jj]) * __builtin_amdgcn_rcpf(fmaxf(fabsf(dn), __expf(-(bl[r_] + mx))));
                const int t = dir ? tlo + 63 - r_ : tlo + r_;
                Y[(mb + t) * 256 + h * 64 + c_] = (bf16)f2bf(val); }
                st[k][jj] = s_old * st[k][jj] + s_new * lc[jj];
                Ctn[r_ * 72 + c_] = (bf16)f2bf(st[k][jj]); } }
        { const int dq = tid >> 3, part = tid & 7; float s = 0.f;
#pragma unroll
          for (int k = 0; k < 8; ++k) s += bf2f(KWt[dq * 72 + swz64(dq, part * 8) + k]);
          s = row8_sum(s); if (part == 0) nst[dq] = s_old * nst[dq] + s_new * s; }
        m_st = tot + mmax;
        if (c + 1 < cend) { ML_FILL(c + 1); if (c + 2 < cend) ML_ISSUE(c + 2); }
        __syncthreads();
    }
#undef ML_ISSUE
#undef ML_FILL
}
__device__ __forceinline__ void phase_ssd_conv(const Frame& F, int l) {
    const GAS bf16* cols = (const GAS bf16*)(WSP(F) + WS_COLS); GAS bf16* XBC = (GAS bf16*)(WSP(F) + WS_XN);
    LAS bf16* raw = (LAS bf16*)(F.lds);
    const GAS float* cwp = INP(F, 20) + (size_t)l * 5 * 896; const GAS float* cbp = INP(F, 21) + l * 896;
    const int tid = F.tid;
    float cw0[5], cw1[5]; const int c1 = tid + 512 < 896 ? tid + 512 : tid;
#pragma unroll
    for (int jj = 0; jj < 5; ++jj) { cw0[jj] = cwp[jj * 896 + tid]; cw1[jj] = cwp[jj * 896 + c1]; }
    const float cb0 = cbp[tid], cb1 = cbp[c1];
    GAS float* DTV = (GAS float*)(WSP(F) + WS_DTV); const GAS float* dtbp = INP(F, 22) + l * 12;
    for (int tile = F.vcu; tile < M / 32; tile += F.G) {
        const int m0 = tile * 32, t0 = m0 % SEQ;
        __syncthreads();
        if (tid < 384) { const int tt = tid / 12, k = tid % 12; const float x = bf2f(cols[(size_t)(m0 + tt) * NINP + S_DT + k]) + dtbp[k]; DTV[(size_t)(m0 + tt) * 12 + k] = x > 20.f ? x : log1pf(__expf(x)); }
        for (int ch = tid; ch < 36 * 112; ch += 512) { const int rr = ch / 112, cc = ch % 112; const int t = t0 - 2 + rr;
            v4u v = {0u, 0u, 0u, 0u}; if (t >= 0 && t < SEQ) v = *(const GAS v4u*)(cols + (size_t)(m0 - 2 + rr) * NINP + S_X + cc * 8);
            *(LAS v4u*)(raw + rr * 896 + cc * 8) = v; }
        __syncthreads();
#pragma unroll
        for (int half = 0; half < 2; ++half) { const int c = half ? c1 : tid; if (half && tid + 512 >= 896) break;
            float win[5];
#pragma unroll
            for (int jj = 0; jj < 4; ++jj) win[jj] = bf2f(raw[jj * 896 + c]);
            for (int tl = 0; tl < 32; ++tl) { win[4] = bf2f(raw[(tl + 4) * 896 + c]);
                float s = half ? cb1 : cb0;
#pragma unroll
                for (int jj = 0; jj < 5; ++jj) s += (half ? cw1[jj] : cw0[jj]) * win[jj];
#pragma unroll
                for (int jj = 0; jj < 4; ++jj) win[jj] = win[jj + 1];
                XBC[(size_t)(m0 + tl) * 896 + c] = (bf16)f2bf(siluf_(s)); } }
    }
    __syncthreads();
}
__device__ __forceinline__ void ssd_seq(const Frame& F, int l, int task, int cfull0, int cend) {
    const int b = task / 12, rem = task % 12, head = rem >> 1, dir = rem & 1, g = head / 3;
    const GAS bf16* cols = (const GAS bf16*)(WSP(F) + WS_COLS); const GAS bf16* XBC = (const GAS bf16*)(WSP(F) + WS_XN);
    GAS bf16* Y = (GAS bf16*)(WSP(F) + (dir ? Y_SB : Y_SF));
    LAS bf16* Cm = (LAS bf16*)(F.lds); LAS bf16* Bm = (LAS bf16*)(F.lds + 17408);
    LAS bf16* Btw = (LAS bf16*)(F.lds + 34816); LAS bf16* Xt = (LAS bf16*)(F.lds + 53248);
    LAS bf16* Ps = (LAS bf16*)(F.lds + 62464); LAS bf16* Hs = (LAS bf16*)(F.lds + 71680);
    LAS float* dtvb = (LAS float*)(F.lds + 89088);
    LAS float* acsb = dtvb + 128;
    LAS float* totb = dtvb + 256;
    const int tid = F.tid, lane = F.lane, wave = F.wave;
    const size_t mb = (size_t)b * SEQ;
    constexpr int NC = SEQ / 64;
    __syncthreads();
    for (int i = tid; i < 64 * 136; i += 512) Hs[i] = 0;
    const GAS float* DTV = (const GAS float*)(WSP(F) + WS_DTV);
    const float aneg = -__expf(INP(F, 23)[(l * 2 + dir) * 6 + head]);
    f32x4 st[4];
#pragma unroll
    for (int k = 0; k < 4; ++k) st[k] = (f32x4){0.f, 0.f, 0.f, 0.f};
    v4u pre[5]; float dtraw = 0.f;
#define SSD_ISSUE(c_) do { const int tlo_ = dir ? SEQ - 64 * ((c_) + 1) : 64 * (c_); _Pragma("unroll") for (int i_ = 0; i_ < 5; ++i_) { const int idx_ = tid + 512 * i_; const int tl_ = idx_ / 40, q_ = idx_ % 40; \
        const int gc_ = q_ < 8 ? head * 64 + q_ * 8 : (q_ < 24 ? 384 + g * 128 + (q_ - 8) * 8 : 640 + g * 128 + (q_ - 24) * 8); \
        pre[i_] = *(const GAS v4u*)(XBC + (mb + tlo_ + tl_) * 896 + gc_); } } while (0)
#define SSD_DTLOAD(c_) do { if (tid < 64) { const int tlo_ = dir ? SEQ - 64 * ((c_) + 1) : 64 * (c_); const int t_ = dir ? tlo_ + 63 - tid : tlo_ + tid; dtraw = DTV[(mb + t_) * 12 + dir * 6 + head]; } } while (0)
#define SSD_DTCALC(c_) do { if (tid < 64) { const float dt_ = dtraw; float cs_ = dt_ * aneg; \
        cs_ = wave_scan_add(cs_); \
        const float tt_ = __builtin_bit_cast(float, __builtin_amdgcn_readlane(__builtin_bit_cast(int, cs_), 63)); dtvb[((c_) & 1) * 64 + tid] = dt_; acsb[((c_) & 1) * 64 + tid] = cs_; if (tid == 0) totb[(c_) & 1] = tt_; } } while (0)
    int lgo[3], llp[3], lq[3]; v4u prel[3];
#pragma unroll
    for (int i = 0; i < 3; ++i) { const int idx = tid + 512 * i; const int tl = idx / 24, q = idx % 24; lq[i] = q; llp[i] = dir ? 63 - tl : tl;
        lgo[i] = tl * 896 + (q < 8 ? head * 64 + q * 8 : 384 + g * 128 + (q - 8) * 8); }
#define SSD_ISSUE_L(dst_, c_) do { const int tlo_ = dir ? SEQ - 64 * ((c_) + 1) : 64 * (c_); const GAS bf16* b_ = XBC + (mb + tlo_) * 896; _Pragma("unroll") for (int i_ = 0; i_ < 3; ++i_) dst_[i_] = *(const GAS v4u*)(b_ + lgo[i_]); } while (0)
    v4u preN[3];
    if (cfull0 > 0) { SSD_ISSUE_L(prel, 0); if (cfull0 > 1) SSD_ISSUE_L(preN, 1); } else SSD_ISSUE(0);
    SSD_DTLOAD(0); SSD_DTCALC(0); SSD_DTLOAD(1);
    __syncthreads();
    if (cfull0 > 0) {
#pragma unroll 1
        for (int c = 0; c < cfull0; ++c) {
            LAS bf16* Xl = (c & 1) ? (LAS bf16*)(F.lds + 92160) : Xt; LAS bf16* Bl = (c & 1) ? (LAS bf16*)(F.lds + 101376) : Btw;
            const LAS float* dtv = dtvb + (c & 1) * 64; const LAS float* acs = acsb + (c & 1) * 64; const float tot = totb[c & 1];
#pragma unroll
            for (int i = 0; i < 3; ++i) { const int q = lq[i], lp = llp[i];
                const unsigned w[4] = {prel[i].x, prel[i].y, prel[i].z, prel[i].w};
                if (q < 8) {
#pragma unroll
                    for (int k = 0; k < 4; ++k) { const int p0 = q * 8 + 2 * k; Xl[p0 * 72 + swz64(p0, lp)] = (bf16)(w[k] & 0xffffu); Xl[(p0 + 1) * 72 + swz64(p0 + 1, lp)] = (bf16)(w[k] >> 16); } }
                else { const int n0 = (q - 8) * 8; const float sc = dtv[lp] * __expf(tot - acs[lp]);
#pragma unroll
                    for (int k = 0; k < 4; ++k) { const int nn = n0 + 2 * k; Bl[nn * 72 + swz64(nn, lp)] = (bf16)f2bf(bf2f(w[k] & 0xffffu) * sc); Bl[(nn + 1) * 72 + swz64(nn + 1, lp)] = (bf16)f2bf(bf2f(w[k] >> 16) * sc); } } }
            if (c + 1 < cfull0) {
#pragma unroll
                for (int i = 0; i < 3; ++i) prel[i] = preN[i];
                if (c + 2 < cfull0) SSD_ISSUE_L(preN, c + 2); }
            else SSD_ISSUE(c + 1);
            SSD_DTCALC(c + 1); if (c + 2 < cend) SSD_DTLOAD(c + 2);
            __syncthreads();
            const float cdec = __expf(tot);
#pragma unroll
            for (int k = 0; k < 4; ++k) { const int ti = 4 * wave + k, tp = ti >> 3, tn = ti & 7; const f32x4 z = {0.f, 0.f, 0.f, 0.f};
                const f32x4 lcv = mma16s<true, true>(Xl, 72, tp * 16, Bl, 72, tn * 16, z, lane);
                st[k] = st[k] * cdec + lcv; }
        }
#pragma unroll
        for (int k = 0; k < 4; ++k) { const int ti = 4 * wave + k, tp = ti >> 3, tn = ti & 7;
#pragma unroll
            for (int jj = 0; jj < 4; ++jj) { const int p = tp * 16 + (lane >> 4) * 4 + jj, n = tn * 16 + (lane & 15); Hs[p * 136 + n] = (bf16)f2bf(st[k][jj]); } }
        __syncthreads();
    }
#pragma unroll 1
    for (int c = cfull0; c < cend; ++c) {
        const bool full = c >= cfull0;
        const int tlo = dir ? SEQ - 64 * (c + 1) : 64 * c;
        const LAS float* dtv = dtvb + (c & 1) * 64; const LAS float* acs = acsb + (c & 1) * 64; const float tot = totb[c & 1];
#pragma unroll
        for (int i = 0; i < 5; ++i) { const int idx = tid + 512 * i; const int tl = idx / 40, q = idx % 40; const int lp = dir ? 63 - tl : tl;
            const unsigned w[4] = {pre[i].x, pre[i].y, pre[i].z, pre[i].w};
            if (q < 8) {
#pragma unroll
                for (int k = 0; k < 4; ++k) { const int p0 = q * 8 + 2 * k; Xt[p0 * 72 + swz64(p0, lp)] = (bf16)(w[k] & 0xffffu); Xt[(p0 + 1) * 72 + swz64(p0 + 1, lp)] = (bf16)(w[k] >> 16); } }
            else if (q < 24) { const int n0 = (q - 8) * 8; if (full) *(LAS v4u*)(Bm + lp * 136 + n0) = pre[i]; const float sc = dtv[lp] * __expf(tot - acs[lp]);
#pragma unroll
                for (int k = 0; k < 4; ++k) { const int nn = n0 + 2 * k; Btw[nn * 72 + swz64(nn, lp)] = (bf16)f2bf(bf2f(w[k] & 0xffffu) * sc); Btw[(nn + 1) * 72 + swz64(nn + 1, lp)] = (bf16)f2bf(bf2f(w[k] >> 16) * sc); } }
            else if (full) { const int n0 = (q - 24) * 8; *(LAS v4u*)(Cm + lp * 136 + n0) = pre[i]; } }
        if (c + 1 < cend) SSD_ISSUE(c + 1);
        __syncthreads();
        f32x4 yo[2] = {{0.f, 0.f, 0.f, 0.f}, {0.f, 0.f, 0.f, 0.f}}, lc[4];
        if (full) {
#pragma unroll
        for (int k = 0; k < 2; ++k) { const int ti = 2 * wave + k, tl_ = ti >> 2, ts = ti & 3; f32x4 acc = {0.f, 0.f, 0.f, 0.f};
            if (ts <= tl_) acc = mma16<128>(Cm + tl_ * 16 * 136, 136, Bm + ts * 16 * 136, 136, acc, lane);
#pragma unroll
            for (int jj = 0; jj < 4; ++jj) { const int lr = tl_ * 16 + (lane >> 4) * 4 + jj, s = ts * 16 + (lane & 15);
                const float v = (s <= lr) ? acc[jj] * __expf(acs[lr] - acs[s]) * dtv[s] : 0.f; Ps[lr * 72 + s] = (bf16)f2bf(v); }
            const f32x4 z = {0.f, 0.f, 0.f, 0.f};
            yo[k] = mma16<128>(Cm + tl_ * 16 * 136, 136, Hs + ts * 16 * 136, 136, z, lane); }
        }
#pragma unroll
        for (int k = 0; k < 4; ++k) { const int ti = 4 * wave + k, tp = ti >> 3, tn = ti & 7; const f32x4 z = {0.f, 0.f, 0.f, 0.f};
            lc[k] = mma16s<true, true>(Xt, 72, tp * 16, Btw, 72, tn * 16, z, lane); }
        __syncthreads();
        const float cdec = __expf(tot);
        if (full) {
#pragma unroll
        for (int k = 0; k < 2; ++k) { const int ti = 2 * wave + k, tl_ = ti >> 2, tp = ti & 3; const f32x4 z = {0.f, 0.f, 0.f, 0.f};
            const f32x4 yd = mma16s<false, true>(Ps, 72, tl_ * 16, Xt, 72, tp * 16, z, lane);
#pragma unroll
            for (int jj = 0; jj < 4; ++jj) { const int lr = tl_ * 16 + (lane >> 4) * 4 + jj, p = tp * 16 + (lane & 15);
                const float val = yd[jj] + yo[k][jj] * __expf(acs[lr]);
                const int t = dir ? tlo + 63 - lr : tlo + lr;
                Y[(mb + t) * 384 + head * 64 + p] = (bf16)f2bf(val); } }
        }
#pragma unroll
        for (int k = 0; k < 4; ++k) { const int ti = 4 * wave + k, tp = ti >> 3, tn = ti & 7;
#pragma unroll
            for (int jj = 0; jj < 4; ++jj) { const int p = tp * 16 + (lane >> 4) * 4 + jj, n = tn * 16 + (lane & 15);
                st[k][jj] = cdec * st[k][jj] + lc[k][jj]; Hs[p * 136 + n] = (bf16)f2bf(st[k][jj]); } }
        if (c + 1 < cend) { SSD_DTCALC(c + 1); if (c + 2 < cend) SSD_DTLOAD(c + 2); }
        __syncthreads();
    }
#undef SSD_ISSUE
#undef SSD_ISSUE_L
#undef SSD_DTLOAD
#undef SSD_DTCALC
}
__device__ __forceinline__ float wave_sum2(float v) { v = row16_sum(v); v += __shfl_xor(v, 16); v += __shfl_xor(v, 32); return v; }
__device__ __forceinline__ f32x4 bf4(v2u w) { return (f32x4){bf2f(w.x & 0xffffu), bf2f(w.x >> 16), bf2f(w.y & 0xffffu), bf2f(w.y >> 16)}; }
__device__ __forceinline__ v2u pk4(f32x4 v) { v2u w; w.x = pk2(v.x, v.y); w.y = pk2(v.z, v.w); return w; }
__device__ __forceinline__ void phase_post(const Frame& F, int l) {
    const GAS bf16* cols = (const GAS bf16*)(WSP(F) + WS_COLS); GAS bf16* MIX = (GAS bf16*)(WSP(F) + WS_XN);
    const GAS bf16* YAf = (const GAS bf16*)(WSP(F) + Y_AF); const GAS bf16* YAb = (const GAS bf16*)(WSP(F) + Y_AB);
    const GAS bf16* YRf = (const GAS bf16*)(WSP(F) + Y_RF); const GAS bf16* YRb = (const GAS bf16*)(WSP(F) + Y_RB);
    const GAS bf16* YSf = (const GAS bf16*)(WSP(F) + Y_SF); const GAS bf16* YSb = (const GAS bf16*)(WSP(F) + Y_SB);
    const GAS float* CT = (const GAS float*)(WSP(F) + WS_CT);
    LAS bf16* GU = (LAS bf16*)(F.lds);
    LAS bf16* SG = (LAS bf16*)(F.lds + 104448);
    LAS float* gate = (LAS float*)(F.lds + 108800);
    LAS float* SCW = (LAS float*)(F.lds + 133632);
    const int tid = F.tid, lane = F.lane, wave = F.wave;
    const GAS float* mup = INP(F, 8) + l * 1472; const GAS float* mun = INP(F, 9) + l * 1472;
    const GAS float* sdk = INP(F, 24) + l * 6;
    __syncthreads();
    { const GAS bf16* gut = (const GAS bf16*)(WSP(F) + WS_GUT); for (int ch = tid; ch < 384 * 16; ch += 512) { const int c = ch >> 4, q = ch & 15; *(LAS v4u*)(GU + c * 136 + q * 8) = *(const GAS v4u*)(gut + c * 128 + q * 8); } }
    { const GAS float* scw = INP(F, 20) + (size_t)l * 5 * 896; for (int idx = tid; idx < 5 * 384; idx += 512) SCW[idx] = scw[(idx / 384) * 896 + (idx % 384)]; }
    const int gch = tid & 15;
    float gmp[8], gmn[8];
#pragma unroll
    for (int k = 0; k < 8; ++k) { gmp[k] = mup[1344 + 8 * gch + k]; gmn[k] = mun[1344 + 8 * gch + k]; }
    const int qa = lane, qb = 64 + (lane & 31);
    const f32x4 mng4 = *(const GAS f32x4*)(INP(F, 7) + l * 256 + 4 * qa);
    f32x4 rmp[2], rmn[2], rng[2], rnb[2], scb[2], sng[2];
#pragma unroll
    for (int ps = 0; ps < 2; ++ps) { const int c0 = 4 * (ps ? qb : qa);
        rmp[ps] = *(const GAS f32x4*)(mup + 768 + c0); rmn[ps] = *(const GAS f32x4*)(mun + 768 + c0);
        rng[ps] = *(const GAS f32x4*)(INP(F, 18) + l * 384 + c0); rnb[ps] = *(const GAS f32x4*)(INP(F, 19) + l * 384 + c0);
        scb[ps] = *(const GAS f32x4*)(INP(F, 21) + l * 896 + c0); sng[ps] = *(const GAS f32x4*)(INP(F, 25) + l * 384 + c0); }
    for (int tile = F.vcu; tile < M / 16; tile += F.G) {
        const int m0 = tile * 16;
        __syncthreads();
        if (tid < 256) { const int tt = tid >> 4; const int m = m0 + tt, t = m % SEQ; const GAS bf16* cp = cols + (size_t)m * NINP + R_GD + 8 * gch;
            const v4u c1 = *(const GAS v4u*)cp; v4u c0 = {0u, 0u, 0u, 0u}, c2 = {0u, 0u, 0u, 0u};
            if (t > 0) c0 = *(const GAS v4u*)(cp - NINP); if (t < SEQ - 1) c2 = *(const GAS v4u*)(cp + NINP);
            const unsigned w0[4] = {c0.x, c0.y, c0.z, c0.w}, w1[4] = {c1.x, c1.y, c1.z, c1.w}, w2[4] = {c2.x, c2.y, c2.z, c2.w}; unsigned o[4];
#pragma unroll
            for (int k = 0; k < 4; ++k) { const float a1 = bf2f(w1[k] & 0xffffu), b1 = bf2f(w1[k] >> 16);
                const float va = a1 + gmp[2 * k] * (bf2f(w0[k] & 0xffffu) - a1) + gmn[2 * k] * (bf2f(w2[k] & 0xffffu) - a1);
                const float vb = b1 + gmp[2 * k + 1] * (bf2f(w0[k] >> 16) - b1) + gmn[2 * k + 1] * (bf2f(w2[k] >> 16) - b1);
                o[k] = pk2(sigmoidf_(va), sigmoidf_(vb)); }
            *(LAS v4u*)(SG + tt * 136 + 8 * gch) = (v4u){o[0], o[1], o[2], o[3]}; }
        __syncthreads();
#pragma unroll
        for (int k = 0; k < 3; ++k) { const int ct = wave + 8 * k; const f32x4 z = {0.f, 0.f, 0.f, 0.f};
            const f32x4 acc = mma16<128>(SG, 136, GU + ct * 16 * 136, 136, z, lane);
#pragma unroll
            for (int jj = 0; jj < 4; ++jj) gate[((lane >> 4) * 4 + jj) * 388 + ct * 16 + (lane & 15)] = acc[jj]; }
        __syncthreads();
#pragma unroll 1
        for (int k = 0; k < 2; ++k) { const int tt = wave * 2 + k; const int m = m0 + tt, t = m % SEQ; const size_t cr = (size_t)m * NINP;
            { const int c0 = 4 * qa;
              const f32x4 hs = bf4(*(const GAS v2u*)(YAf + (size_t)m * 256 + c0)) + bf4(*(const GAS v2u*)(YAb + (size_t)m * 256 + c0));
              const float mean = row16_sum((hs.x + hs.y) + (hs.z + hs.w)) * (1.f / 64.f); const f32x4 d = hs - mean;
              const float var = row16_sum((d.x * d.x + d.y * d.y) + (d.z * d.z + d.w * d.w)) * (1.f / 64.f);
              const f32x4 o = bf4(*(const GAS v2u*)(cols + cr + A_O + c0));
              f32x4 y = d * __builtin_amdgcn_rsqf(var + 1e-6f) * mng4;
              y.x *= sigmoidf_(o.x); y.y *= sigmoidf_(o.y); y.z *= sigmoidf_(o.z); y.w *= sigmoidf_(o.w);
              *(GAS v2u*)(MIX + (size_t)m * DM + c0) = pk4(y); }
#pragma unroll
            for (int ps = 0; ps < 2; ++ps) { const int qd = ps ? qb : qa, c0 = 4 * qd; const bool act = ps == 0 || lane < 32;
              const f32x4 ys = bf4(*(const GAS v2u*)(YRf + (size_t)m * 384 + c0)) + bf4(*(const GAS v2u*)(YRb + (size_t)m * 384 + c0));
              const float mean = row16_sum((ys.x + ys.y) + (ys.z + ys.w)) * (1.f / 64.f); const f32x4 d = ys - mean;
              const float var = row16_sum((d.x * d.x + d.y * d.y) + (d.z * d.z + d.w * d.w)) * (1.f / 64.f);
              const f32x4 y = d * __builtin_amdgcn_rsqf(var + 64e-5f) * rng[ps] + rnb[ps];
              const f32x4 p1 = bf4(*(const GAS v2u*)(cols + cr + R_V + c0));
              f32x4 p0 = {0.f, 0.f, 0.f, 0.f}, p2 = {0.f, 0.f, 0.f, 0.f};
              if (t > 0) p0 = bf4(*(const GAS v2u*)(cols + cr - NINP + R_V + c0)); if (t < SEQ - 1) p2 = bf4(*(const GAS v2u*)(cols + cr + NINP + R_V + c0));
              const f32x4 vv = p1 + rmp[ps] * (p0 - p1) + rmn[ps] * (p2 - p1);
              const float ctv = CT[(size_t)m * 8 + (qd >> 4)];
              const f32x4 g4 = *(const LAS f32x4*)(gate + tt * 388 + c0);
              if (act) *(GAS v2u*)(MIX + (size_t)m * DM + 256 + c0) = pk4((y + vv * ctv) * g4); }
            f32x4 yv[2]; float ssq0 = 0.f, ssq1 = 0.f;
#pragma unroll
            for (int ps = 0; ps < 2; ++ps) { const int qd = ps ? qb : qa, c0 = 4 * qd; const bool act = ps == 0 || lane < 32;
              f32x4 s = scb[ps];
#pragma unroll
              for (int jj = 0; jj < 5; ++jj) { const int tq = t + jj - 2; if (tq >= 0 && tq < SEQ) s += *(const LAS f32x4*)(SCW + jj * 384 + c0) * bf4(*(const GAS v2u*)(cols + cr + (jj - 2) * NINP + S_X + c0)); }
              const f32x4 z = bf4(*(const GAS v2u*)(cols + cr + S_Z + c0));
              f32x4 y = bf4(*(const GAS v2u*)(YSf + (size_t)m * 384 + c0)) + bf4(*(const GAS v2u*)(YSb + (size_t)m * 384 + c0));
              const float dsk = sdk[qd >> 4];
              y.x = (y.x + dsk * siluf_(s.x)) * siluf_(z.x); y.y = (y.y + dsk * siluf_(s.y)) * siluf_(z.y); y.z = (y.z + dsk * siluf_(s.z)) * siluf_(z.z); y.w = (y.w + dsk * siluf_(s.w)) * siluf_(z.w);
              yv[ps] = y; const float sq = act ? (y.x * y.x + y.y * y.y) + (y.z * y.z + y.w * y.w) : 0.f;
              if (qd < 48) ssq0 += sq; else ssq1 += sq; }
            const float r0 = __builtin_amdgcn_rsqf(wave_sum2(ssq0) * (1.f / 192.f) + 1e-6f), r1 = __builtin_amdgcn_rsqf(wave_sum2(ssq1) * (1.f / 192.f) + 1e-6f);
#pragma unroll
            for (int ps = 0; ps < 2; ++ps) { const int qd = ps ? qb : qa, c0 = 4 * qd; const bool act = ps == 0 || lane < 32;
              if (act) *(GAS v2u*)(MIX + (size_t)m * DM + 640 + c0) = pk4(yv[ps] * (qd < 48 ? r0 : r1) * sng[ps]); }
        }
    }
    __syncthreads();
}
namespace cg = cooperative_groups;
constexpr int N_PHASES = 9 * DEPTH + 1;
__global__ void __launch_bounds__(NWAVES * 64, 2) mk_fwd(Args args) {
    extern __shared__ __attribute__((aligned(16))) unsigned char lds_raw[];
    Frame F;
    F.lds = (LAS unsigned char*)lds_raw;
    F.tid = threadIdx.x; F.lane = F.tid & 63; F.wave = __builtin_amdgcn_readfirstlane(F.tid >> 6);
    F.G = gridDim.x; { const int bx = blockIdx.x; F.vcu = (F.G % 8 == 0) ? (bx % 8) * (F.G / 8) + bx / 8 : bx; }
    volatile LAS unsigned* MISC = (volatile LAS unsigned*)(F.lds + MISC_OFF);
    if (F.tid < 64) MISC[F.tid] = 0u;
    if (F.tid < 34) *(LAS unsigned long long*)(F.lds + PTAB_OFF + 8 * F.tid) = ((const unsigned long long*)__builtin_amdgcn_kernarg_segment_ptr())[F.tid];
    __syncthreads();
    unsigned* ctl = (unsigned*)(WSP(F) + WS_CTL);
    XcdBarrier bar = xcd_barrier_post(ctl + CW_BAR, MISC + 8);
    const int lo = args.ph_lo, hi = args.ph_hi;
#define IN_(k) (lo <= (k) && (k) < hi)
#define SEAM(k) do { if (IN_(k) && IN_((k) + 1)) { if ((k) == 0) cg::this_grid().sync(); else xcd_barrier(bar); } } while (0)
#define LAYER(l, B) \
    if (IN_(B + 0)) { phase_convert(F, l); phase_norm(F, l == 0 ? INP(F, 0) : OUTP(F), INP(F, 1) + l * DM, (GAS bf16*)(WSP(F) + WS_XN)); } SEAM(B + 0); \
    if (IN_(B + 1)) { unsigned char* ws = (unsigned char*)WSP(F); pg8::Gemm g{(const bf16*)(ws + WS_XN), (const bf16*)(ws + WS_WIN), M, NINP, DM}; pg8::StaticOrder S; S.init(M, NINP, F.G, (int)blockIdx.x); \
            pg8::EpiBf16<0> E{(bf16*)(ws + WS_COLS), NINP, nullptr, 0, 0, 1.f}; \
            pg8::gemm_phase<pg8::EpiBf16<0>, pg8::StaticOrder, PG8_ALIGN, PG8_SP2>(F.lds, g, S, E); } SEAM(B + 1); \
    if (IN_(B + 2)) { phase_gates(F, l); phase_ssd_conv(F, l); } SEAM(B + 2); \
    if (IN_(B + 3)) { const int bx = blockIdx.x; \
            if (bx < 96) { const int c8 = bx & 7, k8 = bx >> 3; rwkv_scan(F, l, c8 + 8 * (k8 >> 2), k8 & 3, (unsigned)l * (SEQ / 32)); } else if (bx < 144) rwkv_produce(F, l, (bx - 96) % 24, (bx - 96) / 24, (unsigned)l * (SEQ / 32)); else if (bx < 216) { const int u = bx - 144, sg = 2 - (u / 24); ssd_seq(F, l, u % 24, sg == 0 ? 0 : (sg == 1 ? 43 : 86), sg == 0 ? 43 : (sg == 1 ? 86 : 128)); } else if (bx < 248) { const int u = bx - 216, sg = 1 - (u / 16); mlstm_seq(F, l, u % 16, 64 * sg, 64 * sg + 64); } } SEAM(B + 3); \
    if (IN_(B + 4)) phase_post(F, l); SEAM(B + 4); \
    if (IN_(B + 5)) { unsigned char* ws = (unsigned char*)WSP(F); pg8::Gemm g{(const bf16*)(ws + WS_XN), (const bf16*)(ws + WS_WOUT), M, DM, DM}; pg8::StaticOrder S; S.init(M, DM, F.G, (int)blockIdx.x); \
            pg8::EpiResidual E{l == 0 ? (const float*)INP(F, 0) : (const float*)OUTP(F), (float*)OUTP(F), DM}; \
            pg8::gemm_phase<pg8::EpiResidual, pg8::StaticOrder, PG8_ALIGN, PG8_SP2>(F.lds, g, S, E); } SEAM(B + 5); \
    if (IN_(B + 6)) phase_norm(F, OUTP(F), INP(F, 27) + l * DM, (GAS bf16*)(WSP(F) + WS_XN)); SEAM(B + 6); \
    if (IN_(B + 7)) { unsigned char* ws = (unsigned char*)WSP(F); pg8::Gemm g{(const bf16*)(ws + WS_XN), (const bf16*)(ws + WS_WGU), M, 2 * FFN, DM}; pg8::StaticOrder S; S.init(M, 2 * FFN, F.G, (int)blockIdx.x); \
            pg8::EpiSwiGLU E{(bf16*)(ws + WS_COLS), FFN}; \
            pg8::gemm_phase<pg8::EpiSwiGLU, pg8::StaticOrder, PG8_ALIGN, PG8_SP2>(F.lds, g, S, E); } SEAM(B + 7); \
    if (IN_(B + 8)) { unsigned char* ws = (unsigned char*)WSP(F); pg8::Gemm g{(const bf16*)(ws + WS_COLS), (const bf16*)(ws + WS_WDN), M, DM, FFN}; pg8::StaticOrder S; S.init(M, DM, F.G, (int)blockIdx.x); \
            pg8::EpiResidual E{(const float*)OUTP(F), (float*)OUTP(F), DM}; \
            pg8::gemm_phase<pg8::EpiResidual, pg8::StaticOrder, PG8_ALIGN, PG8_SP2>(F.lds, g, S, E); } SEAM(B + 8);
    LAYER(0, 0)
    LAYER(1, 9)
    if (IN_(18)) phase_final_norm(F, OUTP(F), INP(F, 31));
#undef IN_
#undef SEAM
#undef LAYER
}

#ifndef MK_PER_PHASE
#define MK_PER_PHASE 0
#endif
extern "C" void kernel_launch(void* const* d_in, const int* in_sizes, int n_in, void* d_out, int out_size, void* d_ws, size_t ws_size, hipStream_t stream) {
    static int grid = 0;
    if (grid == 0) {
        int dev = 0, cus = 0;
        if (n_in != 32 || out_size != M * DM || ws_size < WS_END) { fprintf(stderr, "kernel_launch: unexpected shapes (n_in %d out %d ws %zu)\n", n_in, out_size, ws_size); grid = -1; return; }
        if (hipGetDevice(&dev) != hipSuccess || hipDeviceGetAttribute(&cus, hipDeviceAttributeMultiprocessorCount, dev) != hipSuccess) { grid = -1; return; }
        if (hipFuncSetAttribute((const void*)mk_fwd, hipFuncAttributeMaxDynamicSharedMemorySize, LDS_BYTES) != hipSuccess) { fprintf(stderr, "kernel_launch: hipFuncSetAttribute failed\n"); grid = -1; return; }
        int per_cu = 0;
        if (hipOccupancyMaxActiveBlocksPerMultiprocessor(&per_cu, (const void*)mk_fwd, NWAVES * 64, LDS_BYTES) != hipSuccess || per_cu < 1) { fprintf(stderr, "kernel_launch: occupancy query says %d\n", per_cu); }
        (void)hipGetLastError();
        grid = cus;
    }
    if (grid < 0) return;
    (void)hipMemsetAsync((char*)d_ws + WS_CTL, 0, CTL_ZERO_BYTES, stream);
    Args a{};
    for (int i = 0; i < 32; ++i) a.in[i] = (const float*)d_in[i];
    a.out = (float*)d_out; a.ws = (unsigned char*)d_ws;
#if MK_PER_PHASE
    for (int p = 0; p < N_PHASES; ++p) { a.ph_lo = p; a.ph_hi = p + 1; hipLaunchKernelGGL(mk_fwd, dim3(grid), dim3(NWAVES * 64), LDS_BYTES, stream, a); }
#else
    a.ph_lo = 0; a.ph_hi = N_PHASES;
    void* kargs[] = {&a};
    hipError_t e = hipLaunchCooperativeKernel((const void*)mk_fwd, dim3(grid), dim3(NWAVES * 64), kargs, LDS_BYTES, stream);
    if (e != hipSuccess) fprintf(stderr, "cooperative launch failed: %s (grid %d)\n", hipGetErrorString(e), grid);
#endif
}
```

```cpp
#include <hip/hip_runtime.h>
#include <hip/hip_cooperative_groups.h>
#include <cstdio>
#include <cstdint>
namespace pg8 {
#define PG8_LAS __attribute__((address_space(3)))
typedef unsigned short bf16_t;
typedef short bf16x8 __attribute__((ext_vector_type(8)));
typedef float f32x4 __attribute__((ext_vector_type(4)));
typedef unsigned u32x4 __attribute__((ext_vector_type(4)));
constexpr int BM = 256, BK = 64, HALF = 128, HTB = HALF * BK * 2  , STAGE_BYTES = 8 * HTB, NXCD = 8, WGM = 8;

__host__ __device__ __forceinline__ int lds_byte(int r, int c) { const int st = (r >> 4) * 2 + (c >> 5), rr = r & 15, cc = c & 31, ob = rr * 64 + cc * 2; return st * 1024 + (ob ^ (((ob >> 9) & 1) << 5)); }
__host__ __device__ __forceinline__ void stage_rc(int b, int& R, int& C) { const int st = b / 1024, sb = b % 1024, swz = sb ^ (((sb >> 9) & 1) << 5); R = (st >> 1) * 16 + swz / 64; C = (st & 1) * 32 + (swz % 64) / 2; }
__host__ __device__ __forceinline__ int perm32(int rho) { const int n = rho >> 4, i = rho & 15; return 8 * (i >> 2) + 4 * n + (i & 3); }

struct Unit { int pm, pn; };
struct Gemm { const bf16_t* A; const bf16_t* Bt; int M, N, K; };

struct StaticOrder {
    int nM, nN, nwg, G, c;
    __host__ __device__ void init(int M, int N, int G_, int c_) { nM = M / BM; nN = N / BM; nwg = nM * nN; G = G_; c = c_; }
    __host__ __device__ bool next(int i, Unit& u) const {
        const long L = (long)i * G + c; if (L >= nwg) return false;
        int wgid = (int)L; { const int q = nwg / NXCD, r = nwg % NXCD, xcd = wgid % NXCD, off = wgid / NXCD; wgid = (xcd < r ? xcd * (q + 1) : r * (q + 1) + (xcd - r) * q) + off; }
        const int nig = WGM * nN, gid = wgid / nig, fm = gid * WGM, gsz = (nM - fm) < WGM ? (nM - fm) : WGM;
        u.pm = fm + ((wgid % nig) % gsz); u.pn = (wgid % nig) / gsz; return true;
    }
    __device__ __forceinline__ void a_ready(const Unit&) const {}
    __device__ __forceinline__ void done(const Unit&) const {}
};

__device__ __forceinline__ unsigned cvt_pk_bf16(float lo, float hi) { unsigned r; asm volatile("v_cvt_pk_bf16_f32 %0, %1, %2" : "=v"(r) : "v"(lo), "v"(hi)); return r; }
typedef float f32x2 __attribute__((ext_vector_type(2)));
__device__ __forceinline__ f32x2 gelu_pk(f32x2 v) {
    const f32x2 av = __builtin_elementwise_abs(v), d = av * 0.2316418882f + 1.0f;
    f32x2 t; t.x = __builtin_amdgcn_rcpf(d.x); t.y = __builtin_amdgcn_rcpf(d.y);
    f32x2 q = t * 0.5307027145f + (-0.7265760135f); q = q * t + 0.7107068705f; q = q * t + (-0.142248368f); q = q * t + 0.127414796f; q = q * t;
    const f32x2 s = (v * v) * (-0.72134752044f);
    f32x2 e; e.x = __builtin_amdgcn_exp2f(s.x); e.y = __builtin_amdgcn_exp2f(s.y);
    const f32x2 m = v * (q * e), r = v - m;
    f32x2 o; o.x = v.x < 0.f ? m.x : r.x; o.y = v.y < 0.f ? m.y : r.y; return o;
}

template <int ACT  > struct EpiBf16 {
    static constexpr bool PERM = true, AFTER_DRAIN = false; static_assert(ACT == 0 || ACT == 1, "EpiBf16: ACT is 0 (none) or 1 (gelu_pk)");
    bf16_t* O; int ldc; const float* bias; int split_cols; size_t split_stride; float scale0;
    __device__ __forceinline__ void operator()(const f32x4 (&acc)[2][2][4][2], const Unit& u, int wr, int wc, int fr, int fq) const {
        const int row0 = u.pm * BM + wr * 64 + fr; int colt = u.pn * BM; bf16_t* base = O;
        float sc = 1.f; if (split_cols) { const int t = colt / split_cols; base += (size_t)t * split_stride; colt -= t * split_cols; if (t == 0) sc = scale0; }
        const int col0 = colt + wc * 32 + 8 * fq, bcol0 = u.pn * BM + wc * 32 + 8 * fq;
        f32x4 bv[2][2];
#pragma unroll
        for (int bj = 0; bj < 2; ++bj)
#pragma unroll
            for (int n = 0; n < 2; ++n) bv[bj][n] = bias ? *(const f32x4*)(bias + bcol0 + bj * HALF + 4 * n) : (f32x4){0.f, 0.f, 0.f, 0.f};
#pragma unroll
        for (int ai = 0; ai < 2; ++ai)
#pragma unroll
            for (int m = 0; m < 4; ++m) { bf16_t* rowp = base + (size_t)(row0 + ai * HALF + m * 16) * ldc + col0;
#pragma unroll
                for (int bj = 0; bj < 2; ++bj) { f32x4 v0 = acc[ai][bj][m][0] + bv[bj][0], v1 = acc[ai][bj][m][1] + bv[bj][1];
                    if (ACT == 1) { f32x2 a = gelu_pk((f32x2){v0[0], v0[1]}), b = gelu_pk((f32x2){v0[2], v0[3]}), c = gelu_pk((f32x2){v1[0], v1[1]}), d = gelu_pk((f32x2){v1[2], v1[3]});
                        v0 = (f32x4){a.x, a.y, b.x, b.y}; v1 = (f32x4){c.x, c.y, d.x, d.y}; }
                    v0 = v0 * sc; v1 = v1 * sc; u32x4 w; w.x = cvt_pk_bf16(v0[0], v0[1]); w.y = cvt_pk_bf16(v0[2], v0[3]); w.z = cvt_pk_bf16(v1[0], v1[1]); w.w = cvt_pk_bf16(v1[2], v1[3]);
                    *(u32x4*)(rowp + bj * HALF) = w; } }
    }
};
struct EpiResidual {
    static constexpr bool PERM = false, AFTER_DRAIN = false;
    const float* base; float* out; int ldc;
    __device__ __forceinline__ void operator()(const f32x4 (&acc)[2][2][4][2], const Unit& u, int wr, int wc, int fr, int fq) const {
        const int col0 = u.pn * BM + wc * 32 + 4 * fq;
#pragma unroll
        for (int ai = 0; ai < 2; ++ai)
#pragma unroll
            for (int m = 0; m < 4; ++m) { const size_t off = (size_t)(u.pm * BM + ai * HALF + wr * 64 + m * 16 + fr) * ldc + col0;
#pragma unroll
                for (int bj = 0; bj < 2; ++bj)
#pragma unroll
                    for (int n = 0; n < 2; ++n) { const f32x4 bs = *(const f32x4*)(base + off + bj * HALF + n * 16); *(f32x4*)(out + off + bj * HALF + n * 16) = bs + acc[ai][bj][m][n]; }
                if (m & 1) asm volatile("" ::: "memory"); }
    }
};
struct EpiSwiGLU {
    static constexpr bool PERM = true, AFTER_DRAIN = false;
    bf16_t* O; int ldc;
    __device__ __forceinline__ void operator()(const f32x4 (&acc)[2][2][4][2], const Unit& u, int wr, int wc, int fr, int fq) const {
        const int col0 = u.pn * HALF + wc * 32 + 8 * fq;
#pragma unroll
        for (int ai = 0; ai < 2; ++ai)
#pragma unroll
            for (int m = 0; m < 4; ++m) { bf16_t* rowp = O + (size_t)(u.pm * BM + ai * HALF + wr * 64 + m * 16 + fr) * ldc + col0;
                float r[8];
#pragma unroll
                for (int n = 0; n < 2; ++n)
#pragma unroll
                    for (int j = 0; j < 4; ++j) { const float g = acc[ai][0][m][n][j], up = acc[ai][1][m][n][j]; r[n * 4 + j] = g * __builtin_amdgcn_rcpf(1.f + __expf(-g)) * up; }
                u32x4 w; w.x = cvt_pk_bf16(r[0], r[1]); w.y = cvt_pk_bf16(r[2], r[3]); w.z = cvt_pk_bf16(r[4], r[5]); w.w = cvt_pk_bf16(r[6], r[7]);
                *(u32x4*)rowp = w; }
    }
};
template <class Epi, class Sched, bool ALIGN_EPI = false, bool SP2 = false>
__device__ __forceinline__ void gemm_phase(PG8_LAS unsigned char* lds, const Gemm g, const Sched& S, const Epi& E) {
    const int tid = threadIdx.x, wid = __builtin_amdgcn_readfirstlane(tid >> 6), lane = tid & 63, wr = wid >> 2, wc = wid & 3, fr = lane & 15, fq = lane >> 4;
    const int K = g.K, nt = K / BK;
    unsigned voffA[2], voffB[2];
#pragma unroll
    for (int i = 0; i < 2; ++i) { int R, C; stage_rc(tid * 16 + i * 8192, R, C); const int Rb = Epi::PERM ? ((R & ~31) + perm32(R & 31)) : R;
        voffA[i] = (unsigned)(R * K + C) * 2u; voffB[i] = (unsigned)(Rb * K + C) * 2u; }
    const size_t kstep = (size_t)(BK * 2);
    const size_t hstep = (size_t)HALF * K * 2;
    const size_t tstep = 2 * hstep;
    const unsigned ldsw = (unsigned)wid * 1024u;
    const int aoff = lds_byte(wr * 64 + fr, fq * 8), boff = lds_byte(wc * 32 + fr, fq * 8);
#define PG8_SA(b, h) (((b) * 2 + (h)) * HTB)
#define PG8_SB(b, h) ((4 + (b) * 2 + (h)) * HTB)
#define PG8_STAGE(bufoff, gbase, voff) do { _Pragma("unroll") for (int _i = 0; _i < 2; ++_i) \
        __builtin_amdgcn_global_load_lds((const unsigned*)((const char*)(gbase) + (voff)[_i]), (PG8_LAS unsigned*)(lds + (bufoff) + ldsw + _i * 8192), 16, 0, 0); } while (0)
#define PG8_LDA(dst, b, h) do { _Pragma("unroll") for (int m = 0; m < 4; ++m) _Pragma("unroll") for (int k = 0; k < 2; ++k) dst[m][k] = *(const PG8_LAS bf16x8*)(lds + PG8_SA(b, h) + aoff + m * 2048 + k * 1024); } while (0)
#define PG8_LDB(dst, b, h) do { _Pragma("unroll") for (int n = 0; n < 2; ++n) _Pragma("unroll") for (int k = 0; k < 2; ++k) dst[n][k] = *(const PG8_LAS bf16x8*)(lds + PG8_SB(b, h) + boff + n * 2048 + k * 1024); } while (0)
#define PG8_MMA(ai, bj, At, Bt) do { __builtin_amdgcn_s_setprio(1); _Pragma("unroll") for (int m = 0; m < 4; ++m) _Pragma("unroll") for (int n = 0; n < 2; ++n) _Pragma("unroll") for (int k = 0; k < 2; ++k) \
        acc[ai][bj][m][n] = __builtin_amdgcn_mfma_f32_16x16x32_bf16(Bt[n][k], At[m][k], acc[ai][bj][m][n], 0, 0, 0); __builtin_amdgcn_s_setprio(0); } while (0)
#define PG8_WAIT_V(n) asm volatile("s_waitcnt vmcnt(" #n ")" ::: "memory")
#define PG8_WAIT_L(n) asm volatile("s_waitcnt lgkmcnt(" #n ")" ::: "memory")
#define PG8_BAR __builtin_amdgcn_s_barrier()
#define PG8_SCHED __builtin_amdgcn_sched_barrier(0)
    Unit cur, nxt; int ui = 0;
    if (!S.next(0, cur)) return;
    f32x4 acc[2][2][4][2];
#pragma unroll
    for (int a = 0; a < 2; ++a)
#pragma unroll
        for (int b = 0; b < 2; ++b)
#pragma unroll
            for (int m = 0; m < 4; ++m)
#pragma unroll
                for (int n = 0; n < 2; ++n) acc[a][b][m][n] = (f32x4){0.f, 0.f, 0.f, 0.f};
    bf16x8 At[4][2], B0[2][2], B1[2][2];
    const char* cA = (const char*)g.A + (size_t)cur.pm * tstep; const char* cB = (const char*)g.Bt + (size_t)cur.pn * tstep;
    S.a_ready(cur);
    if constexpr (SP2) {
        PG8_STAGE(PG8_SB(0, 0), cB, voffB); PG8_STAGE(PG8_SB(0, 1), cB + hstep, voffB); PG8_STAGE(PG8_SA(0, 0), cA, voffA); PG8_STAGE(PG8_SA(0, 1), cA + hstep, voffA);
        if (wr == 1) PG8_BAR;
        PG8_WAIT_V(2); PG8_BAR;
        PG8_STAGE(PG8_SB(1, 0), cB + kstep, voffB); PG8_STAGE(PG8_SA(1, 0), cA + kstep, voffA); PG8_STAGE(PG8_SB(1, 1), cB + hstep + kstep, voffB);
        PG8_WAIT_V(6); PG8_BAR;
    } else {
        PG8_STAGE(PG8_SB(0, 0), cB, voffB); PG8_STAGE(PG8_SA(0, 0), cA, voffA); PG8_STAGE(PG8_SB(0, 1), cB + hstep, voffB); PG8_STAGE(PG8_SA(0, 1), cA + hstep, voffA);
        if (wr == 1) PG8_BAR;
        PG8_WAIT_V(4); PG8_BAR;
        PG8_STAGE(PG8_SB(1, 0), cB + kstep, voffB); PG8_STAGE(PG8_SA(1, 0), cA + kstep, voffA); PG8_STAGE(PG8_SB(1, 1), cB + hstep + kstep, voffB);
        PG8_WAIT_V(6); PG8_BAR;
    }
    for (;;) {
        const bool has_next = S.next(ui + 1, nxt);
        const char* nA = has_next ? (const char*)g.A + (size_t)nxt.pm * tstep : cA; const char* nB = has_next ? (const char*)g.Bt + (size_t)nxt.pn * tstep : cB;
        for (int t = 0; t < nt; t += 2) {
            const bool last = (t == nt - 2);
            const char* a1 = cA + (size_t)(t + 1) * kstep;
            const char* a2 = last ? nA : cA + (size_t)(t + 2) * kstep; const char* b2 = last ? nB : cB + (size_t)(t + 2) * kstep;
            const char* a3 = a2 + kstep; const char* b3 = b2 + kstep;
            if (last && has_next) S.a_ready(nxt);
            if constexpr (SP2) {
            PG8_LDB(B0, 0, 0); PG8_LDB(B1, 0, 1); PG8_SCHED; PG8_LDA(At, 0, 0); PG8_STAGE(PG8_SA(1, 1), a1 + hstep, voffA);
            PG8_WAIT_V(8); PG8_WAIT_L(0); PG8_BAR; PG8_MMA(0, 0, At, B0); PG8_MMA(0, 1, At, B1); PG8_BAR; PG8_SCHED;
            PG8_LDA(At, 0, 1); PG8_STAGE(PG8_SB(0, 0), b2, voffB); PG8_STAGE(PG8_SB(0, 1), b2 + hstep, voffB); PG8_STAGE(PG8_SA(0, 0), a2, voffA);
            PG8_WAIT_V(8); PG8_WAIT_L(0); PG8_BAR; PG8_MMA(1, 0, At, B0); PG8_MMA(1, 1, At, B1); PG8_BAR; PG8_SCHED;
            PG8_LDB(B0, 1, 0); PG8_LDB(B1, 1, 1); PG8_SCHED; PG8_LDA(At, 1, 0); PG8_STAGE(PG8_SA(0, 1), a2 + hstep, voffA);
            PG8_WAIT_V(8); PG8_WAIT_L(0); PG8_BAR; PG8_MMA(0, 0, At, B0); PG8_MMA(0, 1, At, B1); PG8_BAR; PG8_SCHED;
            PG8_LDA(At, 1, 1); PG8_STAGE(PG8_SB(1, 0), b3, voffB); PG8_STAGE(PG8_SB(1, 1), b3 + hstep, voffB); PG8_STAGE(PG8_SA(1, 0), a3, voffA);
            PG8_WAIT_V(8); PG8_WAIT_L(0); PG8_BAR; PG8_MMA(1, 0, At, B0); PG8_MMA(1, 1, At, B1); PG8_BAR; PG8_SCHED;
            } else {
            PG8_LDB(B0, 0, 0); PG8_SCHED; PG8_LDA(At, 0, 0); PG8_STAGE(PG8_SA(1, 1), a1 + hstep, voffA);
            PG8_WAIT_L(8); PG8_BAR; PG8_WAIT_L(0); PG8_MMA(0, 0, At, B0); PG8_BAR; PG8_SCHED;
            PG8_LDB(B1, 0, 1); PG8_STAGE(PG8_SB(0, 0), b2, voffB);
            PG8_BAR; PG8_WAIT_L(0); PG8_MMA(0, 1, At, B1); PG8_BAR;
            PG8_LDA(At, 0, 1); PG8_STAGE(PG8_SA(0, 0), a2, voffA);
            PG8_BAR; PG8_WAIT_L(0); PG8_MMA(1, 0, At, B0); PG8_BAR; PG8_SCHED;
            PG8_STAGE(PG8_SB(0, 1), b2 + hstep, voffB);
            PG8_WAIT_V(6); PG8_BAR; PG8_MMA(1, 1, At, B1); PG8_BAR;
            PG8_LDB(B0, 1, 0); PG8_SCHED; PG8_LDA(At, 1, 0); PG8_STAGE(PG8_SA(0, 1), a2 + hstep, voffA);
            PG8_WAIT_L(8); PG8_BAR; PG8_WAIT_L(0); PG8_MMA(0, 0, At, B0); PG8_BAR; PG8_SCHED;
            PG8_LDB(B1, 1, 1); PG8_STAGE(PG8_SB(1, 0), b3, voffB);
            PG8_BAR; PG8_WAIT_L(0); PG8_MMA(0, 1, At, B1); PG8_BAR;
            PG8_LDA(At, 1, 1); PG8_STAGE(PG8_SA(1, 0), a3, voffA);
            PG8_BAR; PG8_WAIT_L(0); PG8_MMA(1, 0, At, B0); PG8_BAR; PG8_SCHED;
            PG8_STAGE(PG8_SB(1, 1), b3 + hstep, voffB);
            PG8_WAIT_V(6); PG8_BAR; PG8_MMA(1, 1, At, B1); PG8_BAR;
            }
        }
        if constexpr (ALIGN_EPI) { if (wr == 0) PG8_BAR; }
        if constexpr (!Epi::AFTER_DRAIN) { E(acc, cur, wr, wc, fr, fq); S.done(cur); }
        if (!has_next) break;
#pragma unroll
        for (int a = 0; a < 2; ++a)
#pragma unroll
            for (int b = 0; b < 2; ++b)
#pragma unroll
                for (int m = 0; m < 4; ++m)
#pragma unroll
                    for (int n = 0; n < 2; ++n) acc[a][b][m][n] = (f32x4){0.f, 0.f, 0.f, 0.f};
        cur = nxt; cA = nA; cB = nB; ++ui;
        if constexpr (ALIGN_EPI) { if (wr == 1) PG8_BAR; }
    }
    PG8_WAIT_V(0);
    if constexpr (!ALIGN_EPI) { if (wr == 0) PG8_BAR; }
    PG8_BAR;
    if constexpr (Epi::AFTER_DRAIN) { E.fused(acc, cur, wr, wc, fr, fq, lds, wid, lane); S.done(cur); }
#undef PG8_SA
#undef PG8_SB
#undef PG8_STAGE
#undef PG8_LDA
#undef PG8_LDB
#undef PG8_MMA
#undef PG8_WAIT_V
#undef PG8_WAIT_L
#undef PG8_BAR
#undef PG8_SCHED
}
}

#ifndef PG8_SP2
#define PG8_SP2 true
#endif
#define PG8_ALIGN true
constexpr int NWAVES = 8;
constexpr int BATCH = 2, SEQ = 8192, DM = 1024, M = BATCH * SEQ, NIN = 3788, NINP = 3840, FFN = 2816, DEPTH = 2;
constexpr int A_Q = 0, A_K = 256, A_V = 512, A_O = 768;
constexpr int R_R = 1024, R_K = 1408, R_V = 1792, R_WDF = 2176, R_AD = 2304, R_GD = 2368;
constexpr int S_Z = 2496, S_X = 2880, S_B = 3264, S_C = 3520, S_DT = 3776;
constexpr size_t MiB = 1u << 20;
constexpr size_t WS_CTL = 0, CTL_ZERO_BYTES = 128 * 1024;
constexpr size_t WS_GATES = 1 * MiB, WS_CT = 2 * MiB, WS_DTV = 2 * MiB + 512 * 1024;
constexpr size_t WS_GUT = 31 * MiB;
constexpr size_t WS_WIN = 4 * MiB, WS_WOUT = 12 * MiB, WS_WGU = 14 * MiB, WS_WDN = 25 * MiB;
constexpr size_t WS_XN = 32 * MiB, WS_COLS = 64 * MiB, WS_Y = 184 * MiB, WS_END = 256 * MiB;
constexpr size_t Y_AF = WS_Y, Y_AB = WS_Y + 8 * MiB, Y_RF = WS_Y + 16 * MiB, Y_RB = WS_Y + 28 * MiB, Y_SF = WS_Y + 40 * MiB, Y_SB = WS_Y + 52 * MiB;
constexpr int CW_BAR = 1024;
constexpr int RING_BYTES = 131072;
constexpr int LDS_BYTES = 147456, MISC_OFF = LDS_BYTES - 256;

#define GAS __attribute__((address_space(1)))
#define LAS __attribute__((address_space(3)))
typedef unsigned short bf16;
typedef unsigned v4u __attribute__((ext_vector_type(4)));
typedef unsigned v2u __attribute__((ext_vector_type(2)));
typedef float f32x4 __attribute__((ext_vector_type(4)));
typedef short bf16x8 __attribute__((ext_vector_type(8)));
typedef GAS unsigned gu32;
#define RLX_AGENT __ATOMIC_RELAXED, __HIP_MEMORY_SCOPE_AGENT
#define LDS_WAIT() asm volatile("s_waitcnt lgkmcnt(0)" ::: "memory")
#define VM_WAIT() asm volatile("s_waitcnt vmcnt(0)" ::: "memory")
__device__ __forceinline__ unsigned f2bf(float f) { unsigned u = __builtin_bit_cast(unsigned, f); return (u + 0x7fffu + ((u >> 16) & 1u)) >> 16; }
__device__ __forceinline__ unsigned pk2(float lo, float hi) { return f2bf(lo) | (f2bf(hi) << 16); }
__device__ __forceinline__ float bf2f(unsigned u) { return __builtin_bit_cast(float, u << 16); }
__device__ __forceinline__ float sigmoidf_(float x) { return __builtin_amdgcn_rcpf(1.f + __expf(-x)); }
__device__ __forceinline__ float siluf_(float x) { return x * sigmoidf_(x); }
__device__ __forceinline__ float wave_sum(float v) {
#pragma unroll
    for (int o = 1; o < 64; o <<= 1) v += __shfl_xor(v, o);
    return v;
}
__device__ __forceinline__ float wave_max(float v) {
#pragma unroll
    for (int o = 1; o < 64; o <<= 1) v = fmaxf(v, __shfl_xor(v, o));
    return v;
}
template <int CTRL> __device__ __forceinline__ float dppf(float v) { return __builtin_bit_cast(float, __builtin_amdgcn_update_dpp(0, __builtin_bit_cast(int, v), CTRL, 0xf, 0xf, true)); }
__device__ __forceinline__ float row16_sum(float v) { v += dppf<0xB1>(v); v += dppf<0x4E>(v); v += dppf<0x141>(v); v += dppf<0x140>(v); return v; }
template <int K> __device__ __forceinline__ f32x4 mma16(const LAS bf16* A, int lda, const LAS bf16* Bt, int ldb, f32x4 acc, int lane) {
    const int r = lane & 15, q = lane >> 4;
    const LAS bf16* ap = A + r * lda + q * 8; const LAS bf16* bp = Bt + r * ldb + q * 8;
#pragma unroll
    for (int k0 = 0; k0 < K; k0 += 32) {
        const bf16x8 a = *(const LAS bf16x8*)(ap + k0); const bf16x8 b = *(const LAS bf16x8*)(bp + k0);
        acc = __builtin_amdgcn_mfma_f32_16x16x32_bf16(a, b, acc, 0, 0, 0);
    }
    return acc;
}

__device__ __forceinline__ int swz64(int row, int col) { return col ^ (((row >> 3) & 7) << 3); }
template <bool SWA, bool SWB> __device__ __forceinline__ f32x4 mma16s(const LAS bf16* A, int lda, int rowA0, const LAS bf16* Bt, int ldb, int rowB0, f32x4 acc, int lane) {
    const int r = lane & 15, q = lane >> 4; const int ra = rowA0 + r, rb = rowB0 + r;
#pragma unroll
    for (int k0 = 0; k0 < 64; k0 += 32) { const int ca = k0 + 8 * q, cb = k0 + 8 * q;
        const bf16x8 a = *(const LAS bf16x8*)(A + ra * lda + (SWA ? swz64(ra, ca) : ca)); const bf16x8 b = *(const LAS bf16x8*)(Bt + rb * ldb + (SWB ? swz64(rb, cb) : cb));
        acc = __builtin_amdgcn_mfma_f32_16x16x32_bf16(a, b, acc, 0, 0, 0); }
    return acc;
}

template <int CTRL, int RM, int BM> __device__ __forceinline__ float dppm(float oldv, float v) { return __builtin_bit_cast(float, __builtin_amdgcn_update_dpp(__builtin_bit_cast(int, oldv), __builtin_bit_cast(int, v), CTRL, RM, BM, false)); }
__device__ __forceinline__ float wave_scan_add(float x) {
    float y = x + dppm<0x111, 0xf, 0xf>(0.f, x); y += dppm<0x112, 0xf, 0xf>(0.f, x); y += dppm<0x113, 0xf, 0xf>(0.f, x);
    y += dppm<0x114, 0xf, 0xe>(0.f, y); y += dppm<0x118, 0xf, 0xc>(0.f, y);
    y += dppm<0x142, 0xa, 0xf>(0.f, y); y += dppm<0x143, 0xc, 0xf>(0.f, y);
    return y;
}
__device__ __forceinline__ float wave_scan_max(float x) {
    const float ninf = -INFINITY;
    float y = fmaxf(x, dppm<0x111, 0xf, 0xf>(ninf, x)); y = fmaxf(y, dppm<0x112, 0xf, 0xf>(ninf, x)); y = fmaxf(y, dppm<0x113, 0xf, 0xf>(ninf, x));
    y = fmaxf(y, dppm<0x114, 0xf, 0xe>(ninf, y)); y = fmaxf(y, dppm<0x118, 0xf, 0xc>(ninf, y));
    y = fmaxf(y, dppm<0x142, 0xa, 0xf>(ninf, y)); y = fmaxf(y, dppm<0x143, 0xc, 0xf>(ninf, y));
    return y;
}
#define XB_TMO      128
#define XB_XCNT(j)  (256  + 64 * (j))
#define XB_XSUB(j)  (1280 + 64 * (j))
#define XB_XGEN(j)  (2304 + 64 * (j))
#define XB_TOP      3328
#define XB_TOPGEN   3392
#define XCD_BAR_WORDS 3456
#define XB_SPIN_CAP (1u << 18)

__device__ __forceinline__ unsigned xb_ld(unsigned* p)              { return __hip_atomic_load(p, __ATOMIC_RELAXED, __HIP_MEMORY_SCOPE_AGENT); }
__device__ __forceinline__ unsigned xb_add(unsigned* p, unsigned v) { return __hip_atomic_fetch_add(p, v, __ATOMIC_RELAXED, __HIP_MEMORY_SCOPE_AGENT); }
__device__ __forceinline__ unsigned xb_xcc_id() { return (unsigned)__builtin_amdgcn_s_getreg((3 << 11) | 20) & 0xFu; }
#define XB_SPIN(cond, bar) do { unsigned _sp = 0; while (cond) { __builtin_amdgcn_s_sleep(1); \
    if ((++_sp & 255u) == 0u) { if (xb_ld(&(bar)[XB_TMO])) break; if (_sp > XB_SPIN_CAP) { atomicAdd(&(bar)[XB_TMO], 1u); break; } } } } while (0)

struct XcdBarrier {
    unsigned* bar; unsigned x;
    volatile LAS unsigned* st;
};

__device__ __forceinline__ XcdBarrier xcd_barrier_post(unsigned* bar, volatile LAS unsigned* st) {
    XcdBarrier b; b.bar = bar; b.x = xb_xcc_id(); b.st = st;
    if (threadIdx.x == 0) (void)xb_add(&bar[XB_XCNT(b.x)], 1u);
    return b;
}
__device__ __forceinline__ void xcd_barrier_complete(unsigned* bar, unsigned x, unsigned& nloc, unsigned& nx) {
    const unsigned G = gridDim.x * gridDim.y * gridDim.z;
    unsigned sum, cnt, mine, sp = 0u;
    for (;;) {
        sum = 0u; cnt = 0u; mine = 0u;
#pragma unroll
        for (unsigned j = 0; j < 16; ++j) { const unsigned c = xb_ld(&bar[XB_XCNT(j)]); sum += c; cnt += (c > 0u) ? 1u : 0u; mine = (j == x) ? c : mine; }
        if (sum == G) break;
        __builtin_amdgcn_s_sleep(1);
        if ((++sp & 255u) == 0u) { if (xb_ld(&bar[XB_TMO])) break; if (sp > XB_SPIN_CAP) { atomicAdd(&bar[XB_TMO], 1u); break; } }
    }
    nloc = mine > 0u ? mine : 1u; nx = cnt > 0u ? cnt : 1u;
}

__device__ __forceinline__ void xcd_barrier(const XcdBarrier& b) {
    asm volatile("s_waitcnt vmcnt(0)" ::: "memory");
    __syncthreads();
    if (threadIdx.x == 0) {
        unsigned* bar = b.bar;
        __builtin_amdgcn_s_waitcnt(0);
        unsigned nloc = b.st[0], nx = b.st[1];
        if (nloc == 0u) { xcd_barrier_complete(bar, b.x, nloc, nx); b.st[0] = nloc; b.st[1] = nx; }
        const unsigned old = xb_add(&bar[XB_XSUB(b.x)], 1u);
        const unsigned gen = old / nloc;
        if (old + 1u == (gen + 1u) * nloc) {
            __builtin_amdgcn_fence(__ATOMIC_RELEASE, "agent");
            asm volatile("s_waitcnt vmcnt(0)" ::: "memory");
            const unsigned og = xb_add(&bar[XB_TOP], 1u);
            const unsigned tg = og / nx;
            if (og + 1u == (tg + 1u) * nx) xb_add(&bar[XB_TOPGEN], 1u);
            else XB_SPIN(xb_ld(&bar[XB_TOPGEN]) == tg, bar);
            __builtin_amdgcn_fence(__ATOMIC_ACQUIRE, "agent");
            xb_add(&bar[XB_XGEN(b.x)], 1u);
            asm volatile("s_waitcnt vmcnt(0)" ::: "memory");
        } else {
            XB_SPIN(xb_ld(&bar[XB_XGEN(b.x)]) == gen, bar);
            __builtin_amdgcn_fence(__ATOMIC_ACQUIRE, "agent");
            asm volatile("s_waitcnt vmcnt(0)" ::: "memory");
        }
    }
    __syncthreads();
}
struct Frame {
    LAS unsigned char* lds;
    int tid, lane, wave, vcu, G;
};
struct Args { const float* in[32]; float* out; unsigned char* ws; int ph_lo, ph_hi; };
constexpr int PTAB_OFF = LDS_BYTES - 768;
__device__ __forceinline__ unsigned long long ptab_ld(const Frame& F, int i) {
    const unsigned long long v = *(volatile LAS unsigned long long*)(F.lds + PTAB_OFF + 8 * i);
    const unsigned lo = __builtin_amdgcn_readfirstlane((unsigned)v), hi = __builtin_amdgcn_readfirstlane((unsigned)(v >> 32));
    return ((unsigned long long)hi << 32) | lo;
}
__device__ __forceinline__ const GAS float* INP(const Frame& F, int i) { return (const GAS float*)ptab_ld(F, i); }
__device__ __forceinline__ GAS unsigned char* WSP(const Frame& F) { return (GAS unsigned char*)ptab_ld(F, 33); }
__device__ __forceinline__ GAS float* OUTP(const Frame& F) { return (GAS float*)ptab_ld(F, 32); }
__device__ __forceinline__ void transpose_item(const GAS float* W, int K, int N, int nblk, GAS bf16* WT, int mode, int row_off, LAS float* scr, int item, int lane) {
    const int kb = item / nblk, nb = item % nblk, k0 = 64 * kb, n0 = 32 * nb;
    const int ncol = n0 + (lane & 31); const bool ok = ncol < N;
#pragma unroll 8
    for (int i = 0; i < 32; ++i) { const int kk = 2 * i + (lane >> 5); scr[kk * 33 + (lane & 31)] = ok ? W[(size_t)(k0 + kk) * N + ncol] : 0.f; }
    LDS_WAIT(); asm volatile("" ::: "memory");
    const int c = lane & 7;
    const int drow0 = mode ? (256 * (n0 >> 7) + (n0 & 127) + row_off) : (row_off + n0);
#pragma unroll
    for (int j = 0; j < 4; ++j) { const int n = (lane >> 3) + 8 * j; const LAS float* s = scr + (8 * c) * 33 + n;
        v4u o; o.x = pk2(s[0 * 33], s[1 * 33]); o.y = pk2(s[2 * 33], s[3 * 33]); o.z = pk2(s[4 * 33], s[5 * 33]); o.w = pk2(s[6 * 33], s[7 * 33]);
        *(GAS v4u*)(WT + (size_t)(drow0 + n) * K + k0 + 8 * c) = o; }
    LDS_WAIT(); asm volatile("" ::: "memory");
}
__device__ __forceinline__ void phase_convert(const Frame& F, int l) {
    LAS float* scr = (LAS float*)(F.lds + F.wave * 16384);
    const int gw = F.vcu * NWAVES + F.wave, NGW = F.G * NWAVES;
    GAS bf16* Win = (GAS bf16*)(WSP(F) + WS_WIN); GAS bf16* Wout = (GAS bf16*)(WSP(F) + WS_WOUT); GAS bf16* Wgu = (GAS bf16*)(WSP(F) + WS_WGU); GAS bf16* Wdn = (GAS bf16*)(WSP(F) + WS_WDN);
    constexpr int I_IN = 16 * 120, I_OUT = 16 * 32, I_G = 16 * 88, I_D = 44 * 32, I_GU = 2 * 12;
    constexpr int NITEMS = I_IN + I_OUT + 2 * I_G + I_D + I_GU;
    for (int it = gw; it < NITEMS; it += NGW) {
        int r = it;
        if (r < I_IN) { transpose_item(INP(F, 2) + (size_t)l * DM * NIN, DM, NIN, 120, Win, 0, 0, scr, r, F.lane); continue; } r -= I_IN;
        if (r < I_OUT) { transpose_item(INP(F, 26) + (size_t)l * DM * DM, DM, DM, 32, Wout, 0, 0, scr, r, F.lane); continue; } r -= I_OUT;
        if (r < I_G) { transpose_item(INP(F, 28) + (size_t)l * DM * FFN, DM, FFN, 88, Wgu, 1, 0, scr, r, F.lane); continue; } r -= I_G;
        if (r < I_G) { transpose_item(INP(F, 29) + (size_t)l * DM * FFN, DM, FFN, 88, Wgu, 1, 128, scr, r, F.lane); continue; } r -= I_G;
        if (r < I_D) { transpose_item(INP(F, 30) + (size_t)l * FFN * DM, FFN, DM, 32, Wdn, 0, 0, scr, r, F.lane); continue; } r -= I_D;
        transpose_item(INP(F, 14) + (size_t)l * 128 * 384, 128, 384, 12, (GAS bf16*)(WSP(F) + WS_GUT), 0, 0, scr, r, F.lane);
    }
}
__device__ __forceinline__ void phase_norm(const Frame& F, const GAS float* hin, const GAS float* g, GAS bf16* XN) {
    const int gw = F.vcu * NWAVES + F.wave, NGW = F.G * NWAVES;
    f32x4 gv[4];
#pragma unroll
    for (int j = 0; j < 4; ++j) gv[j] = ((const GAS f32x4*)g)[64 * j + F.lane];
    for (int m = gw; m < M; m += NGW) {
        const GAS f32x4* xr = (const GAS f32x4*)(hin + (size_t)m * DM) + F.lane;
        f32x4 v[4]; float s = 0.f;
#pragma unroll
        for (int j = 0; j < 4; ++j) { v[j] = xr[64 * j]; s += (v[j].x * v[j].x + v[j].y * v[j].y) + (v[j].z * v[j].z + v[j].w * v[j].w); }
        const float r = __builtin_amdgcn_rsqf(wave_sum(s) * (1.f / DM) + 1e-6f);
        GAS v2u* o8 = (GAS v2u*)(XN + (size_t)m * DM) + F.lane;
#pragma unroll
        for (int j = 0; j < 4; ++j) { v2u w; w.x = pk2(v[j].x * r * gv[j].x, v[j].y * r * gv[j].y); w.y = pk2(v[j].z * r * gv[j].z, v[j].w * r * gv[j].w); o8[64 * j] = w; }
    }
}
__device__ __forceinline__ void phase_final_norm(const Frame& F, GAS float* h, const GAS float* g) {
    const int gw = F.vcu * NWAVES + F.wave, NGW = F.G * NWAVES;
    f32x4 gv[4];
#pragma unroll
    for (int j = 0; j < 4; ++j) gv[j] = ((const GAS f32x4*)g)[64 * j + F.lane];
    for (int m = gw; m < M; m += NGW) {
        GAS f32x4* xr = (GAS f32x4*)(h + (size_t)m * DM) + F.lane;
        f32x4 v[4]; float s = 0.f;
#pragma unroll
        for (int j = 0; j < 4; ++j) { v[j] = xr[64 * j]; s += (v[j].x * v[j].x + v[j].y * v[j].y) + (v[j].z * v[j].z + v[j].w * v[j].w); }
        const float r = __builtin_amdgcn_rsqf(wave_sum(s) * (1.f / DM) + 1e-6f);
#pragma unroll
        for (int j = 0; j < 4; ++j) xr[64 * j] = v[j] * r * gv[j];
    }
}
__device__ __forceinline__ void phase_gates(const Frame& F, int l) {
    const GAS bf16* cols = (const GAS bf16*)(WSP(F) + WS_COLS); GAS float* GT = (GAS float*)(WSP(F) + WS_GATES);
    LAS bf16* raw = (LAS bf16*)(F.lds);
    LAS bf16* featb = (LAS bf16*)(F.lds + 30720);
    LAS bf16* gwT = (LAS bf16*)(F.lds + 55552);
    LAS float* outp = (LAS float*)(F.lds + 80384);
    const GAS float* gwg = INP(F, 5) + (size_t)l * 768 * 16; const GAS float* gb = INP(F, 6) + l * 16;
    const int tid = F.tid, lane = F.lane, wave = F.wave;
    __syncthreads();
    for (int i = tid; i < 768 * 16; i += 512) gwT[(i & 15) * 776 + (i >> 4)] = (bf16)f2bf(gwg[i]);
    float cw[5]; { const GAS float* cwp = INP(F, 3) + (size_t)l * 5 * 512;
#pragma unroll
        for (int j = 0; j < 5; ++j) cw[j] = cwp[j * 512 + tid]; }
    const float cbv = INP(F, 4)[l * 512 + tid];
    const float gbv = gb[tid & 15];
    for (int tile = F.vcu; tile < M / 16; tile += F.G) {
        const int m0 = tile * 16, t0 = m0 % SEQ;
        __syncthreads();
        for (int ch = tid; ch < 20 * 96; ch += 512) { const int rr = ch / 96, cc = ch % 96; const int t = t0 - 2 + rr;
            v4u v = {0u, 0u, 0u, 0u}; if (t >= 0 && t < SEQ) v = *(const GAS v4u*)(cols + (size_t)(m0 - 2 + rr) * NINP + cc * 8);
            *(LAS v4u*)(raw + rr * 768 + cc * 8) = v; }
        if (tid < 256) outp[tid] = 0.f;
        __syncthreads();
        { float win[5];
#pragma unroll
          for (int j = 0; j < 4; ++j) win[j] = bf2f(raw[j * 768 + tid]);
#pragma unroll 4
          for (int t = 0; t < 16; ++t) { win[4] = bf2f(raw[(t + 4) * 768 + tid]); float s = cbv;
#pragma unroll
              for (int j = 0; j < 5; ++j) s += cw[j] * win[j];
#pragma unroll
              for (int j = 0; j < 4; ++j) win[j] = win[j + 1];
              featb[t * 776 + tid] = (bf16)f2bf(siluf_(s)); }
          const int t = tid >> 5, c8 = tid & 31; *(LAS v4u*)(featb + t * 776 + 512 + c8 * 8) = *(const LAS v4u*)(raw + (t + 2) * 768 + 512 + c8 * 8); }
        __syncthreads();
        { const f32x4 z = {0.f, 0.f, 0.f, 0.f}; const f32x4 acc = mma16<96>(featb + 96 * wave, 776, gwT + 96 * wave, 776, z, lane);
#pragma unroll
          for (int jj = 0; jj < 4; ++jj) __hip_atomic_fetch_add(outp + ((lane >> 4) * 4 + jj) * 16 + (lane & 15), acc[jj], __ATOMIC_RELAXED, __HIP_MEMORY_SCOPE_WORKGROUP); }
        __syncthreads();
        if (tid < 256) { float s = outp[tid] + gbv; if ((tid & 15) >= 8) s = fminf(s, 0.f) - log1pf(__expf(-fabsf(s))); GT[(size_t)(m0 + (tid >> 4)) * 16 + (tid & 15)] = s; }
    }
    __syncthreads();
}
__device__ __forceinline__ f32x4 mma16_a8(const LAS bf16* A8, const LAS bf16* Bt, f32x4 acc, int lane) {
    const int q = lane >> 4;
    const LAS bf16* ap = A8 + (lane & 7) * 72 + q * 8; const LAS bf16* bp = Bt + (lane & 15) * 72 + q * 8;
#pragma unroll
    for (int k0 = 0; k0 < 64; k0 += 32) { const bf16x8 a = *(const LAS bf16x8*)(ap + k0); const bf16x8 b = *(const LAS bf16x8*)(bp + k0); acc = __builtin_amdgcn_mfma_f32_16x16x32_bf16(a, b, acc, 0, 0, 0); }
    return acc;
}
typedef float f32x2 __attribute__((ext_vector_type(2)));
template <bool DIR> __device__ __forceinline__ void rwkv_steps(const LAS float* OPS, const LAS float* VV, LAS float* YB, f32x4& S, int j, int row) {
    float yk0 = 0.f, yk1 = 0.f;
    const LAS float* opb = OPS + 4 * j; const LAS float* vpb = VV + row;
#define RWLD(W_, KK_, KA_, KM_, R_, V_, tl_) do { const LAS float* op_ = opb + (tl_) * 320; W_ = *(const LAS f32x4*)(op_); KK_ = *(const LAS f32x4*)(op_ + 64); KA_ = *(const LAS f32x4*)(op_ + 128); KM_ = *(const LAS f32x4*)(op_ + 192); R_ = *(const LAS f32x4*)(op_ + 256); V_ = vpb[(tl_) * 16]; } while (0)
    f32x4 w4, kk4, ka4, km4, r4, w4b, kk4b, ka4b, km4b, r4b; float vv, vvb;
    RWLD(w4, kk4, ka4, km4, r4, vv, (DIR ? 31 : 0));
    RWLD(w4b, kk4b, ka4b, km4b, r4b, vvb, (DIR ? 30 : 1));
#pragma unroll
    for (int i = 0; i < 32; ++i) {
        f32x4 nw4, nkk4, nka4, nkm4, nr4; float nvv;
        if (i < 30) RWLD(nw4, nkk4, nka4, nkm4, nr4, nvv, (DIR ? 29 - i : i + 2));
        f32x2 t2 = S.xy * kk4.xy; t2 = S.zw * kk4.zw + t2;
        float sa = t2.x + t2.y;
        const f32x4 pre_s = S * w4 + km4 * vv;
        sa = row16_sum(sa);
        S = pre_s + ka4 * sa;
        f32x2 y2 = S.xy * r4.xy; y2 = S.zw * r4.zw + y2;
        float y = y2.x + y2.y;
        y = row16_sum(y);
        if ((i & 15) == j) { if (i < 16) yk0 = y; else yk1 = y; }
        w4 = w4b; kk4 = kk4b; ka4 = ka4b; km4 = km4b; r4 = r4b; vv = vvb;
        if (i < 30) { w4b = nw4; kk4b = nkk4; ka4b = nka4; km4b = nkm4; r4b = nr4; vvb = nvv; } }
#undef RWLD
    YB[(DIR ? 31 - j : j) * 16 + row] = yk0; YB[(DIR ? 15 - j : 16 + j) * 16 + row] = yk1;
}
struct RwCtx { LAS bf16* WA; LAS bf16* WW; LAS bf16* XA; LAS bf16* XW; LAS bf16* RAWB; LAS float* MU; GAS float* CT; const GAS bf16* colsb;
    f32x4 kk_c4, ka_c4, rk_c4; float ba[4], bw[4]; float mup_[5][2], mun_[5][2]; int h, dir, qtr, tb0; size_t mb; };
template <int NTOK> __device__ __forceinline__ void rw_addr_init(int (&poff)[5], int (&prr)[5], int lane, int tb0, int h, int dir) {
    constexpr int NCHK = (NTOK + 2) * 40;
#pragma unroll
    for (int i = 0; i < 5; ++i) { const int idx = lane + 64 * i; const int rr = idx / 40, q = idx % 40, wh = q >> 3, c8 = q & 7;
        const int gc = (wh == 0 ? R_R + h * 64 : wh == 1 ? R_K + h * 64 : wh == 2 ? R_V + h * 64 : wh == 3 ? R_WDF + dir * 64 : R_AD) + c8 * 8;
        prr[i] = idx < NCHK ? tb0 - 1 + rr : -100000; poff[i] = (tb0 - 1 + rr) * NINP + gc; }
}
template <int NTOK> __device__ __forceinline__ void rw_issue(v4u (&pre)[5], const int (&poff)[5], const int (&prr)[5], const GAS bf16* colsb, int T0) {
    constexpr int NCH = ((NTOK + 2) * 40 + 63) / 64;
#pragma unroll
    for (int i = 0; i < NCH; ++i) { const int t = T0 + prr[i]; const bool ok = t >= 0 && t < SEQ;
        const v4u vv = *(const GAS v4u*)(colsb + (size_t)T0 * NINP + (ok ? poff[i] : 0)); pre[i] = ok ? vv : (v4u){0u, 0u, 0u, 0u}; }
}
template <int NTOK, bool FULLV> __device__ __forceinline__ void rw_prep(const RwCtx& C, const v4u (&pre)[5], LAS float* OPS, LAS float* VV, int T0, int lane) {
    constexpr int NCHK = (NTOK + 2) * 40, NCH = (NCHK + 63) / 64;
    const int j = lane & 15, c2 = (lane & 31) * 2;
#pragma unroll
    for (int i = 0; i < NCH; ++i) { const int idx = lane + 64 * i; if (idx < NCHK) *(LAS v4u*)(C.RAWB + idx * 8) = pre[i]; }
    LDS_WAIT(); asm volatile("" ::: "memory");
#pragma unroll
    for (int which = 0; which < 5; ++which)
#pragma unroll
        for (int pr = 0; pr < NTOK / 2; ++pr) { const int tt = 2 * pr + (lane >> 5), cc = which * 64 + c2, t = C.tb0 + tt;
            const unsigned r0 = *(const LAS unsigned*)(C.RAWB + tt * 320 + cc), r1 = *(const LAS unsigned*)(C.RAWB + (tt + 1) * 320 + cc), r2 = *(const LAS unsigned*)(C.RAWB + (tt + 2) * 320 + cc);
            const float p1x = bf2f(r1 & 0xffffu), p1y = bf2f(r1 >> 16);
            const float vx = p1x + C.mup_[which][0] * (bf2f(r0 & 0xffffu) - p1x) + C.mun_[which][0] * (bf2f(r2 & 0xffffu) - p1x);
            const float vy = p1y + C.mup_[which][1] * (bf2f(r0 >> 16) - p1y) + C.mun_[which][1] * (bf2f(r2 >> 16) - p1y);
            if (which == 0) *(LAS f32x2*)(OPS + t * 320 + 256 + c2) = (f32x2){vx, vy};
            else if (which == 1) *(LAS f32x2*)(OPS + t * 320 + 192 + c2) = (f32x2){vx, vy};
            else if (which == 2) { if (FULLV) *(LAS f32x2*)(VV + t * 64 + c2) = (f32x2){vx, vy}; else if ((c2 >> 4) == C.qtr) *(LAS f32x2*)(VV + t * 16 + (c2 & 15)) = (f32x2){vx, vy}; }
            else if (which == 3) { const float ex = __expf(2.f * vx), ey = __expf(2.f * vy);
                *(LAS unsigned*)(C.XW + tt * 72 + c2) = pk2(1.f - 2.f * __builtin_amdgcn_rcpf(ex + 1.f), 1.f - 2.f * __builtin_amdgcn_rcpf(ey + 1.f)); }
            else *(LAS unsigned*)(C.XA + tt * 72 + c2) = pk2(vx, vy); }
    LDS_WAIT(); asm volatile("" ::: "memory");
    { const bool hi = lane >= 32; const int lr = ((lane >> 4) & 1) * 4 + (hi ? 2 : 0); const bool ok0 = lr < NTOK, ok1 = lr + 1 < NTOK; const int tb = C.tb0 + lr;
#pragma unroll
      for (int ct = 0; ct < 4; ++ct) { const f32x4 z = {0.f, 0.f, 0.f, 0.f};
        const f32x4 ca = mma16_a8(C.XA, C.WA + ct * 16 * 72, z, lane), cw = mma16_a8(C.XW, C.WW + ct * 16 * 72, z, lane);
        const int c = ct * 16 + j;
        const float a0v = hi ? ca[2] : ca[0], a1v = hi ? ca[3] : ca[1], w0v = hi ? cw[2] : cw[0], w1v = hi ? cw[3] : cw[1];
        if (ok0) { OPS[tb * 320 + 128 + c] = sigmoidf_(C.ba[ct] + a0v); OPS[tb * 320 + c] = __expf(-0.6065306597f * sigmoidf_(C.bw[ct] + w0v)); }
        if (ok1) { OPS[(tb + 1) * 320 + 128 + c] = sigmoidf_(C.ba[ct] + a1v); OPS[(tb + 1) * 320 + c] = __expf(-0.6065306597f * sigmoidf_(C.bw[ct] + w1v)); } } }
    LDS_WAIT(); asm volatile("" ::: "memory");
#pragma unroll
    for (int ps = 0; ps < (NTOK + 3) / 4; ++ps) { const int tl = 4 * ps + (lane >> 4); const bool ok = tl < NTOK; const int t = C.tb0 + (ok ? tl : 0); LAS float* op = OPS + t * 320 + 4 * j;
        const f32x4 av = *(const LAS f32x4*)(op + 128), kp = *(const LAS f32x4*)(op + 192), rp = *(const LAS f32x4*)(op + 256);
        const f32x4 kr = kp * C.kk_c4; const float ss = row16_sum((kr.x * kr.x + kr.y * kr.y) + (kr.z * kr.z + kr.w * kr.w));
        const f32x4 kkv = kr * __builtin_amdgcn_rcpf(fmaxf(__builtin_amdgcn_sqrtf(ss), 1e-12f));
        const f32x4 km = kp * ((av - 1.f) * C.ka_c4 + 1.f);
        const f32x4 q = rp * km * C.rk_c4; const float cs = row16_sum((q.x + q.y) + (q.z + q.w));
        if (ok) { *(LAS f32x4*)(op + 64) = kkv; *(LAS f32x4*)(op + 128) = kkv * (-av); *(LAS f32x4*)(op + 192) = km;
            if (C.dir == 0 && C.qtr == 0 && j == 0) C.CT[(C.mb + T0 + t) * 8 + C.h] = cs; } }
}

constexpr int RW_NSLOT = 6, RW_SLOT_WORDS = 32 * 320 + 32 * 64;
constexpr size_t WS_RING = 248 * MiB;
constexpr int CW_RW = 8192;
__device__ __forceinline__ unsigned rw_ld(GAS unsigned* p) { return __hip_atomic_load(p, __ATOMIC_RELAXED, __HIP_MEMORY_SCOPE_AGENT); }
__device__ __forceinline__ void rw_st(GAS unsigned* p, unsigned v) { __hip_atomic_store(p, v, __ATOMIC_RELAXED, __HIP_MEMORY_SCOPE_AGENT); }
__device__ __forceinline__ void rwkv_produce(const Frame& F, int l, int p, int pp, unsigned G0) {
    const int b = p / 12, rem = p % 12, h = rem >> 1, dir = rem & 1;
    const GAS bf16* cols = (const GAS bf16*)(WSP(F) + WS_COLS);
    const int tid = F.tid, lane = F.lane, wave = F.wave;
    LAS bf16* WA = (LAS bf16*)(F.lds); LAS bf16* WW = (LAS bf16*)(F.lds + 9216);
    LAS float* MU = (LAS float*)(F.lds + 67584);
    LAS float* OPS = (LAS float*)(F.lds + 70144);
    LAS float* VV = (LAS float*)(F.lds + 111104);
    LAS unsigned* flg = (LAS unsigned*)(F.lds + 119296);
    GAS unsigned* ctl = (GAS unsigned*)(WSP(F) + WS_CTL) + CW_RW + 384 * p;
    GAS unsigned long long* ring = (GAS unsigned long long*)(WSP(F) + WS_RING) + (size_t)p * RW_NSLOT * (RW_SLOT_WORDS / 2);
    constexpr int NB = SEQ / 32;
    __syncthreads();
    { const GAS float* aup = INP(F, 13) + (size_t)l * 64 * 384; const GAS float* wup = INP(F, 11) + (size_t)(l * 2 + dir) * 64 * 384;
      for (int idx = tid; idx < 4096; idx += 512) { const int i = idx >> 6, c = idx & 63;
          WA[c * 72 + i] = (bf16)f2bf(aup[i * 384 + h * 64 + c]); WW[c * 72 + i] = (bf16)f2bf(wup[i * 384 + h * 64 + c]); }
      if (tid < 320) { const int which = tid >> 6, c = tid & 63;
          const int rc = which == 0 ? h * 64 + c : which == 1 ? 384 + h * 64 + c : which == 2 ? 768 + h * 64 + c : which == 3 ? 1152 + dir * 64 + c : 1280 + c;
          MU[tid] = INP(F, 8)[l * 1472 + rc]; MU[320 + tid] = INP(F, 9)[l * 1472 + rc]; } }
    __syncthreads();
    const size_t mb = (size_t)b * SEQ;
    const int j = lane & 15;
    RwCtx C;
    C.WA = WA; C.WW = WW; C.XA = (LAS bf16*)(F.lds + 18432) + wave * 576; C.XW = (LAS bf16*)(F.lds + 27648) + wave * 576;
    C.RAWB = (LAS bf16*)(F.lds + 36864) + wave * 1920;
    C.MU = MU; C.CT = (GAS float*)(WSP(F) + WS_CT); C.colsb = cols + mb * NINP; C.h = h; C.dir = dir; C.qtr = 0; C.mb = mb; C.tb0 = 4 * wave;
    { const int hc4 = h * 64 + 4 * j;
      C.kk_c4 = *(const GAS f32x4*)(INP(F, 15) + l * 384 + hc4); C.ka_c4 = *(const GAS f32x4*)(INP(F, 16) + l * 384 + hc4); C.rk_c4 = *(const GAS f32x4*)(INP(F, 17) + l * 384 + hc4);
#pragma unroll
      for (int ct = 0; ct < 4; ++ct) { C.ba[ct] = INP(F, 12)[l * 384 + h * 64 + 16 * ct + j]; C.bw[ct] = INP(F, 10)[(l * 2 + dir) * 384 + h * 64 + 16 * ct + j]; }
      const int c2 = (lane & 31) * 2;
#pragma unroll
      for (int wq = 0; wq < 5; ++wq) { C.mup_[wq][0] = MU[wq * 64 + c2]; C.mup_[wq][1] = MU[wq * 64 + c2 + 1]; C.mun_[wq][0] = MU[320 + wq * 64 + c2]; C.mun_[wq][1] = MU[320 + wq * 64 + c2 + 1]; } }
    v4u pre[5]; int poff[5], prr[5];
    rw_addr_init<4>(poff, prr, lane, C.tb0, h, dir);
    rw_issue<4>(pre, poff, prr, C.colsb, dir ? SEQ - 32 * (pp + 1) : 32 * pp);
    bool dead = false; unsigned mseen = G0;
    GAS unsigned* myflag = ctl + 320 * pp; const unsigned PB = G0 / 2;
#pragma unroll 1
    for (int it = pp; it < NB; it += 2) {
        const int T0 = dir ? SEQ - 32 * (it + 1) : 32 * it;
        v4u cur[5];
#pragma unroll
        for (int i = 0; i < 5; ++i) cur[i] = pre[i];
        if (it + 2 < NB) rw_issue<4>(pre, poff, prr, C.colsb, dir ? SEQ - 32 * (it + 3) : 32 * (it + 2));
        rw_prep<4, true>(C, cur, OPS, VV, T0, lane);
        if (tid == 0) { const unsigned need = G0 + (unsigned)it + 1u; unsigned sp = 0u;
            if (need > (unsigned)RW_NSLOT && !dead) { const unsigned want = need - (unsigned)RW_NSLOT;
                while (mseen < want) { if (++sp > (1u << 17)) { dead = true; break; } __builtin_amdgcn_s_sleep(2);
                    const unsigned m01 = min(rw_ld(ctl + 64), rw_ld(ctl + 128)), m23 = min(rw_ld(ctl + 192), rw_ld(ctl + 256)); mseen = min(m01, m23); } }
            flg[0] = sp; }
        __syncthreads();
        { GAS unsigned long long* slot = ring + (size_t)((G0 + (unsigned)it) % RW_NSLOT) * (RW_SLOT_WORDS / 2);
          const LAS v4u* src = (const LAS v4u*)OPS;
#pragma unroll
          for (int i = 0; i < 6; ++i) { const int idx = tid + 512 * i; const v4u d = src[idx]; GAS v4u* dst = (GAS v4u*)slot + idx;
              asm volatile("global_store_dwordx4 %0, %1, off sc1\n\ts_nop 1" :: "v"(dst), "v"(d) : "memory"); } }
        asm volatile("s_waitcnt vmcnt(10)" ::: "memory");
        __syncthreads();
        if (tid == 0 && it >= 2) rw_st(myflag, PB + (unsigned)(it >> 1));
    }
    asm volatile("s_waitcnt vmcnt(0)" ::: "memory");
    __syncthreads();
    if (tid == 0) rw_st(myflag, PB + (unsigned)(NB / 2));
    __syncthreads();
}
__device__ __forceinline__ void rwkv_scan(const Frame& F, int l, int p, int qtr, unsigned G0) {
    const int b = p / 12, rem = p % 12, h = rem >> 1, dir = rem & 1;
    GAS bf16* Y = (GAS bf16*)(WSP(F) + (dir ? Y_RB : Y_RF));
    const int lane = F.lane, wave = F.wave;
    LAS float* OPSb = (LAS float*)(F.lds);
    LAS float* VVb = (LAS float*)(F.lds + 81920);
    LAS float* YBb = (LAS float*)(F.lds + 86016);
    GAS unsigned* ctl = (GAS unsigned*)(WSP(F) + WS_CTL) + CW_RW + 384 * p;
    const GAS unsigned long long* ring = (const GAS unsigned long long*)(WSP(F) + WS_RING) + (size_t)p * RW_NSLOT * (RW_SLOT_WORDS / 2);
    constexpr int NB = SEQ / 32;
    const size_t mb = (size_t)b * SEQ;
    const int j = lane & 15;
    __syncthreads();
    if (wave < 4) {
        const int lt = wave * 64 + lane;
        bool dead = false; unsigned pseen0 = G0 / 2, pseen1 = G0 / 2;
        unsigned long long va[21], vb[21];
#define RW_FETCH(v_, k_) do { const unsigned need_ = G0 / 2 + (unsigned)((k_) >> 1) + 1u; unsigned sp_ = 0u; GAS unsigned* fl_ = ctl + 320 * ((k_) & 1); \
            if (!dead) { unsigned ps_ = ((k_) & 1) ? pseen1 : pseen0; while (ps_ < need_) { ps_ = rw_ld(fl_); if (ps_ >= need_) break; if (++sp_ > (1u << 17)) { dead = true; break; } __builtin_amdgcn_s_sleep(2); } if ((k_) & 1) pseen1 = ps_; else pseen0 = ps_; } \
            const GAS unsigned long long* slot_ = ring + (size_t)((G0 + (unsigned)(k_)) % RW_NSLOT) * (RW_SLOT_WORDS / 2); \
            _Pragma("unroll") for (int i_ = 0; i_ < 20; ++i_) v_[i_] = __hip_atomic_load(slot_ + lt + 256 * i_, __ATOMIC_RELAXED, __HIP_MEMORY_SCOPE_AGENT); \
            v_[20] = __hip_atomic_load(slot_ + 5120 + (lt >> 3) * 32 + qtr * 8 + (lt & 7), __ATOMIC_RELAXED, __HIP_MEMORY_SCOPE_AGENT); } while (0)
#define RW_LITER(v_, k_) do { if ((k_) >= 1 && lt == 0) rw_st(ctl + 64 * (qtr + 1), G0 + (unsigned)(k_)); \
            if ((k_) < NB) { LAS unsigned long long* dO_ = (LAS unsigned long long*)(OPSb + ((k_) & 1) * 10240); LAS unsigned long long* dV_ = (LAS unsigned long long*)(VVb + ((k_) & 1) * 512); \
                _Pragma("unroll") for (int i_ = 0; i_ < 20; ++i_) dO_[lt + 256 * i_] = v_[i_]; dV_[lt] = v_[20]; \
                if ((k_) + 2 < NB) RW_FETCH(v_, (k_) + 2); } \
            if ((k_) >= 2) { const int bk_ = (k_) - 2; const int T0_ = dir ? SEQ - 32 * (bk_ + 1) : 32 * bk_; const LAS float* YB_ = YBb + (bk_ & 1) * 512; \
                const int idx_ = lt * 2, tl_ = idx_ >> 4, rw_ = idx_ & 15; \
                *(GAS unsigned*)(Y + (mb + T0_ + tl_) * 384 + h * 64 + 16 * qtr + rw_) = pk2(YB_[idx_], YB_[idx_ + 1]); } \
            __syncthreads(); } while (0)
        RW_FETCH(va, 0); RW_FETCH(vb, 1);
#pragma unroll 1
        for (int it = 0; it < NB; it += 2) { RW_LITER(va, it); RW_LITER(vb, it + 1); }
        RW_LITER(va, NB);
#undef RW_FETCH
#undef RW_LITER
        { const int bk = NB - 1; const int T0 = dir ? SEQ - 32 * (bk + 1) : 32 * bk; const LAS float* YB = YBb + (bk & 1) * 512;
          const int idx = lt * 2, tl = idx >> 4, rw = idx & 15;
          *(GAS unsigned*)(Y + (mb + T0 + tl) * 384 + h * 64 + 16 * qtr + rw) = pk2(YB[idx], YB[idx + 1]); }
    } else {
        const int row = (wave - 4) * 4 + (lane >> 4);
        f32x4 S = {0.f, 0.f, 0.f, 0.f};
#pragma unroll 1
        for (int it = 0; it <= NB; ++it) {
            if (it >= 1) { const int bk = it - 1;
                const LAS float* OPS = OPSb + (bk & 1) * 10240; const LAS float* VV = VVb + (bk & 1) * 512; LAS float* YB = YBb + (bk & 1) * 512;
                if (dir) rwkv_steps<true>(OPS, VV, YB, S, j, row); else rwkv_steps<false>(OPS, VV, YB, S, j, row);
            }
            __syncthreads();
        }
    }
    __syncthreads();
}
__device__ __forceinline__ float row8_sum(float v) { v += dppf<0xB1>(v); v += dppf<0x4E>(v); v += dppf<0x141>(v); return v; }
__device__ __forceinline__ void mlstm_seq(const Frame& F, int l, int task, int cfull0, int cend) {
    const int b = task >> 3, h = (task >> 1) & 3, dir = task & 1;
    const GAS bf16* cols = (const GAS bf16*)(WSP(F) + WS_COLS); const GAS float* GT = (const GAS float*)(WSP(F) + WS_GATES);
    GAS bf16* Y = (GAS bf16*)(WSP(F) + (dir ? Y_AB : Y_AF));
    LAS bf16* RAWQ = (LAS bf16*)(F.lds);
    LAS bf16* Qs = (LAS bf16*)(F.lds + 17408); LAS bf16* Ks = (LAS bf16*)(F.lds + 26624);
    LAS bf16* Vtb = (LAS bf16*)(F.lds + 35840);
    LAS bf16* KWt = (LAS bf16*)(F.lds + 54272); LAS bf16* Ps = (LAS bf16*)(F.lds + 63488);
    LAS bf16* Ctb = (LAS bf16*)(F.lds + 72704);
    LAS float* ub = (LAS float*)(F.lds + 91136);
    LAS float* blb = ub + 128; LAS float* rmb = ub + 256;
    LAS float* den = ub + 384; LAS float* qn = ub + 448; LAS float* nst = ub + 512; LAS float* scb = ub + 576;
    const int tid = F.tid, lane = F.lane, wave = F.wave;
    const size_t mb = (size_t)b * SEQ;
    constexpr int NC = SEQ / 64;
    __syncthreads();
    for (int i = tid; i < 2 * 64 * 72; i += 512) Ctb[i] = 0;
    if (tid < 64) nst[tid] = 0.f;
    const int cc = tid & 127, isK = cc >> 6, d0 = cc & 63, chn = isK * 256 + h * 64 + d0;
    float cw[5]; const GAS float* cwp = INP(F, 3) + (size_t)l * 5 * 512;
#pragma unroll
    for (int jj = 0; jj < 5; ++jj) cw[jj] = cwp[jj * 512 + chn];
    const float cbv = INP(F, 4)[l * 512 + chn];
    f32x4 st[2] = {{0.f, 0.f, 0.f, 0.f}, {0.f, 0.f, 0.f, 0.f}};
    float m_st = 0.f;
    v4u pre[3], prev; float gli = 0.f, glf = 0.f;
#define ML_ISSUE(c_) do { const int tlo_ = dir ? SEQ - 64 * ((c_) + 1) : 64 * (c_); _Pragma("unroll") for (int i_ = 0; i_ < 3; ++i_) { const int ch_ = tid + 512 * i_; pre[i_] = (v4u){0u, 0u, 0u, 0u}; \
        if (ch_ < 68 * 16) { const int rr_ = ch_ >> 4, q_ = ch_ & 15; const int t_ = tlo_ - 2 + rr_; if (t_ >= 0 && t_ < SEQ) pre[i_] = *(const GAS v4u*)(cols + (mb + t_) * NINP + (q_ >> 3) * 256 + h * 64 + (q_ & 7) * 8); } } \
        prev = *(const GAS v4u*)(cols + (mb + tlo_ + (tid >> 3)) * NINP + A_V + h * 64 + (tid & 7) * 8); \
        if (tid < 64) { const int t_ = dir ? tlo_ + 63 - tid : tlo_ + tid; gli = GT[(mb + t_) * 16 + dir * 4 + h]; glf = GT[(mb + t_) * 16 + 8 + dir * 4 + h]; } } while (0)
#define ML_FILL(c_) do { _Pragma("unroll") for (int i_ = 0; i_ < 3; ++i_) { const int ch_ = tid + 512 * i_; if (ch_ < 68 * 16) *(LAS v4u*)(RAWQ + (ch_ >> 4) * 128 + (ch_ & 15) * 8) = pre[i_]; } \
        { LAS bf16* Vt_ = Vtb + ((c_) & 1) * 4608; const int tl_ = tid >> 3, e8_ = tid & 7; const int lp_ = dir ? 63 - tl_ : tl_; const unsigned w_[4] = {prev.x, prev.y, prev.z, prev.w}; \
          _Pragma("unroll") for (int k_ = 0; k_ < 4; ++k_) { const int e_ = e8_ * 8 + 2 * k_; Vt_[e_ * 72 + swz64(e_, lp_)] = (bf16)(w_[k_] & 0xffffu); Vt_[(e_ + 1) * 72 + swz64(e_ + 1, lp_)] = (bf16)(w_[k_] >> 16); } } \
        if (tid < 64) { const float bl_ = wave_scan_add(glf); \
            const float u_ = gli - bl_; const float rm_ = wave_scan_max(u_); \
            ub[((c_) & 1) * 64 + tid] = u_; blb[((c_) & 1) * 64 + tid] = bl_; rmb[((c_) & 1) * 64 + tid] = rm_; if (tid == 63) { scb[((c_) & 1) * 2] = rm_; scb[((c_) & 1) * 2 + 1] = bl_; } } } while (0)
    ML_ISSUE(0); ML_FILL(0); ML_ISSUE(1);
    __syncthreads();
    if (cfull0 > 0) {
        const int dk = tid & 63; float cwk[5]; { const GAS float* cwq = INP(F, 3) + (size_t)l * 5 * 512;
#pragma unroll
            for (int jj = 0; jj < 5; ++jj) cwk[jj] = cwq[jj * 512 + 256 + h * 64 + dk]; }
        const float cbk = INP(F, 4)[l * 512 + 256 + h * 64 + dk];
#pragma unroll 1
        for (int c = 0; c < cfull0; ++c) {
            const LAS float* u = ub + (c & 1) * 64;
            const LAS bf16* Vt = Vtb + (c & 1) * 4608; LAS bf16* Ctn = Ctb + ((c + 1) & 1) * 4608;
            const float umax = scb[(c & 1) * 2], tot = scb[(c & 1) * 2 + 1];
#pragma unroll 2
            for (int i = 0; i < 8; ++i) { const int tl = (tid >> 6) + 8 * i; float s = cbk;
#pragma unroll
                for (int jj = 0; jj < 5; ++jj) s += cwk[jj] * bf2f(RAWQ[(tl + jj) * 128 + 64 + dk]);
                const int lp = dir ? 63 - tl : tl;
                KWt[dk * 72 + swz64(dk, lp)] = (bf16)f2bf(siluf_(s) * 0.125f * __expf(u[lp] - umax)); }
            __syncthreads();
            const float mmax = fmaxf(m_st, umax), s_old = __expf(m_st - mmax), s_new = __expf(umax - mmax);
#pragma unroll
            for (int k = 0; k < 2; ++k) { const int ti = 2 * wave + k, t0_ = ti >> 2, t1_ = ti & 3; const f32x4 z = {0.f, 0.f, 0.f, 0.f};
                const f32x4 lc = mma16s<true, true>(Vt, 72, t0_ * 16, KWt, 72, t1_ * 16, z, lane);
#pragma unroll
                for (int jj = 0; jj < 4; ++jj) { const int r_ = t0_ * 16 + (lane >> 4) * 4 + jj, c_ = t1_ * 16 + (lane & 15);
                    st[k][jj] = s_old * st[k][jj] + s_new * lc[jj]; Ctn[r_ * 72 + c_] = (bf16)f2bf(st[k][jj]); } }
            { const int dq = tid >> 3, part = tid & 7; float s = 0.f;
#pragma unroll
              for (int k = 0; k < 8; ++k) s += bf2f(KWt[dq * 72 + swz64(dq, part * 8) + k]);
              s = row8_sum(s); if (part == 0) nst[dq] = s_old * nst[dq] + s_new * s; }
            m_st = tot + mmax;
            ML_FILL(c + 1); if (c + 2 < cend) ML_ISSUE(c + 2);
            __syncthreads();
        }
    }
#pragma unroll 1
    for (int c = cfull0; c < cend; ++c) {
        const bool full = c >= cfull0;
        const int tlo = dir ? SEQ - 64 * (c + 1) : 64 * c;
        const LAS float* u = ub + (c & 1) * 64; const LAS float* bl = blb + (c & 1) * 64; const LAS float* rm = rmb + (c & 1) * 64;
        const LAS bf16* Vt = Vtb + (c & 1) * 4608; const LAS bf16* Ct = Ctb + (c & 1) * 4608; LAS bf16* Ctn = Ctb + ((c + 1) & 1) * 4608;
#pragma unroll 4
        for (int i = 0; i < 16; ++i) { const int tl = (tid >> 7) + 4 * i; float s = cbv;
#pragma unroll
            for (int jj = 0; jj < 5; ++jj) s += cw[jj] * bf2f(RAWQ[(tl + jj) * 128 + cc]);
            s = siluf_(s); const int lpos = dir ? 63 - tl : tl;
            if (isK) Ks[lpos * 72 + d0] = (bf16)f2bf(s * 0.125f); else Qs[lpos * 72 + d0] = (bf16)f2bf(s); }
        if (tid < 64) den[tid] = 0.f;
        __syncthreads();
        const float umax = scb[(c & 1) * 2], tot = scb[(c & 1) * 2 + 1];
        for (int idx = tid; idx < 4096; idx += 512) { const int lp = idx >> 6, d = idx & 63; KWt[d * 72 + swz64(d, lp)] = (bf16)f2bf(bf2f(Ks[lp * 72 + d]) * __expf(u[lp] - umax)); }
        if (full) {
#pragma unroll
        for (int k = 0; k < 2; ++k) { const int ti = 2 * wave + k, tl_ = ti >> 2, ts = ti & 3; f32x4 acc = {0.f, 0.f, 0.f, 0.f};
            if (ts <= tl_) acc = mma16<64>(Qs + tl_ * 16 * 72, 72, Ks + ts * 16 * 72, 72, acc, lane);
#pragma unroll
            for (int jj = 0; jj < 4; ++jj) { const int lr = tl_ * 16 + (lane >> 4) * 4 + jj, s = ts * 16 + (lane & 15);
                const float v = (s <= lr) ? acc[jj] * __expf(u[s] - fmaxf(m_st, rm[lr])) : 0.f; const unsigned vb = f2bf(v); Ps[lr * 72 + s] = (bf16)vb;
                if (ts <= tl_) { const float rs = row16_sum(bf2f(vb)); if ((lane & 15) == 0) __hip_atomic_fetch_add(den + lr, rs, __ATOMIC_RELAXED, __HIP_MEMORY_SCOPE_WORKGROUP); } } }
        { const int lq = tid >> 3, part = tid & 7; float s = 0.f;
#pragma unroll
          for (int k = 0; k < 8; ++k) s += bf2f(Qs[lq * 72 + part * 8 + k]) * nst[part * 8 + k];
          s = row8_sum(s); if (part == 0) qn[lq] = s; }
        }
        __syncthreads();
        const float mmax = fmaxf(m_st, umax), s_old = __expf(m_st - mmax), s_new = __expf(umax - mmax);
#pragma unroll
        for (int k = 0; k < 2; ++k) { const int ti = 2 * wave + k, t0_ = ti >> 2, t1_ = ti & 3; const f32x4 z = {0.f, 0.f, 0.f, 0.f};
            f32x4 a1 = z, a2 = z;
            if (full) { a1 = mma16s<false, true>(Ps, 72, t0_ * 16, Vt, 72, t1_ * 16, z, lane); a2 = mma16<64>(Qs + t0_ * 16 * 72, 72, Ct + t1_ * 16 * 72, 72, z, lane); }
            const f32x4 lc = mma16s<true, true>(Vt, 72, t0_ * 16, KWt, 72, t1_ * 16, z, lane);
#pragma unroll
            for (int jj = 0; jj < 4; ++jj) { const int r_ = t0_ * 16 + (lane >> 4) * 4 + jj, c_ = t1_ * 16 + (lane & 15);
                if (full) { const float mx = fmaxf(m_st, rm[r_]), iwv = __expf(m_st - mx);
                const float dn = den[r_] + iwv * qn[r_];
                const float val = (a1[jj] + iwv * a2[jj]) * __builtin_amdgcn_rcpf(fmaxf(fabsf(dn), __expf(-(bl[r_] + mx))));
                const int t = dir ? tlo + 63 - r_ : tlo + r_;
                Y[(mb + t) * 256 + h * 64 + c_] = (bf16)f2bf(val); }
                st[k][jj] = s_old * st[k][jj] + s_new * lc[jj];
                Ctn[r_ * 72 + c_] = (bf16)f2bf(st[k][jj]); } }
        { const int dq = tid >> 3, part = tid & 7; float s = 0.f;
#pragma unroll
          for (int k = 0; k < 8; ++k) s += bf2f(KWt[dq * 72 + swz64(dq, part * 8) + k]);
          s = row8_sum(s); if (part == 0) nst[dq] = s_old * nst[dq] + s_new * s; }
        m_st = tot + mmax;
        if (c + 1 < cend) { ML_FILL(c + 1); if (c + 2 < cend) ML_ISSUE(c + 2); }
        __syncthreads();
    }
#undef ML_ISSUE
#undef ML_FILL
}
__device__ __forceinline__ void phase_ssd_conv(const Frame& F, int l) {
    const GAS bf16* cols = (const GAS bf16*)(WSP(F) + WS_COLS); GAS bf16* XBC = (GAS bf16*)(WSP(F) + WS_XN);
    LAS bf16* raw = (LAS bf16*)(F.lds);
    const GAS float* cwp = INP(F, 20) + (size_t)l * 5 * 896; const GAS float* cbp = INP(F, 21) + l * 896;
    const int tid = F.tid;
    float cw0[5], cw1[5]; const int c1 = tid + 512 < 896 ? tid + 512 : tid;
#pragma unroll
    for (int jj = 0; jj < 5; ++jj) { cw0[jj] = cwp[jj * 896 + tid]; cw1[jj] = cwp[jj * 896 + c1]; }
    const float cb0 = cbp[tid], cb1 = cbp[c1];
    GAS float* DTV = (GAS float*)(WSP(F) + WS_DTV); const GAS float* dtbp = INP(F, 22) + l * 12;
    for (int tile = F.vcu; tile < M / 32; tile += F.G) {
        const int m0 = tile * 32, t0 = m0 % SEQ;
        __syncthreads();
        if (tid < 384) { const int tt = tid / 12, k = tid % 12; const float x = bf2f(cols[(size_t)(m0 + tt) * NINP + S_DT + k]) + dtbp[k]; DTV[(size_t)(m0 + tt) * 12 + k] = x > 20.f ? x : log1pf(__expf(x)); }
        for (int ch = tid; ch < 36 * 112; ch += 512) { const int rr = ch / 112, cc = ch % 112; const int t = t0 - 2 + rr;
            v4u v = {0u, 0u, 0u, 0u}; if (t >= 0 && t < SEQ) v = *(const GAS v4u*)(cols + (size_t)(m0 - 2 + rr) * NINP + S_X + cc * 8);
            *(LAS v4u*)(raw + rr * 896 + cc * 8) = v; }
        __syncthreads();
#pragma unroll
        for (int half = 0; half < 2; ++half) { const int c = half ? c1 : tid; if (half && tid + 512 >= 896) break;
            float win[5];
#pragma unroll
            for (int jj = 0; jj < 4; ++jj) win[jj] = bf2f(raw[jj * 896 + c]);
            for (int tl = 0; tl < 32; ++tl) { win[4] = bf2f(raw[(tl + 4) * 896 + c]);
                float s = half ? cb1 : cb0;
#pragma unroll
                for (int jj = 0; jj < 5; ++jj) s += (half ? cw1[jj] : cw0[jj]) * win[jj];
#pragma unroll
                for (int jj = 0; jj < 4; ++jj) win[jj] = win[jj + 1];
                XBC[(size_t)(m0 + tl) * 896 + c] = (bf16)f2bf(siluf_(s)); } }
    }
    __syncthreads();
}
__device__ __forceinline__ void ssd_seq(const Frame& F, int l, int task, int cfull0, int cend) {
    const int b = task / 12, rem = task % 12, head = rem >> 1, dir = rem & 1, g = head / 3;
    const GAS bf16* cols = (const GAS bf16*)(WSP(F) + WS_COLS); const GAS bf16* XBC = (const GAS bf16*)(WSP(F) + WS_XN);
    GAS bf16* Y = (GAS bf16*)(WSP(F) + (dir ? Y_SB : Y_SF));
    LAS bf16* Cm = (LAS bf16*)(F.lds); LAS bf16* Bm = (LAS bf16*)(F.lds + 17408);
    LAS bf16* Btw = (LAS bf16*)(F.lds + 34816); LAS bf16* Xt = (LAS bf16*)(F.lds + 53248);
    LAS bf16* Ps = (LAS bf16*)(F.lds + 62464); LAS bf16* Hs = (LAS bf16*)(F.lds + 71680);
    LAS float* dtvb = (LAS float*)(F.lds + 89088);
    LAS float* acsb = dtvb + 128;
    LAS float* totb = dtvb + 256;
    const int tid = F.tid, lane = F.lane, wave = F.wave;
    const size_t mb = (size_t)b * SEQ;
    constexpr int NC = SEQ / 64;
    __syncthreads();
    for (int i = tid; i < 64 * 136; i += 512) Hs[i] = 0;
    const GAS float* DTV = (const GAS float*)(WSP(F) + WS_DTV);
    const float aneg = -__expf(INP(F, 23)[(l * 2 + dir) * 6 + head]);
    f32x4 st[4];
#pragma unroll
    for (int k = 0; k < 4; ++k) st[k] = (f32x4){0.f, 0.f, 0.f, 0.f};
    v4u pre[5]; float dtraw = 0.f;
#define SSD_ISSUE(c_) do { const int tlo_ = dir ? SEQ - 64 * ((c_) + 1) : 64 * (c_); _Pragma("unroll") for (int i_ = 0; i_ < 5; ++i_) { const int idx_ = tid + 512 * i_; const int tl_ = idx_ / 40, q_ = idx_ % 40; \
        const int gc_ = q_ < 8 ? head * 64 + q_ * 8 : (q_ < 24 ? 384 + g * 128 + (q_ - 8) * 8 : 640 + g * 128 + (q_ - 24) * 8); \
        pre[i_] = *(const GAS v4u*)(XBC + (mb + tlo_ + tl_) * 896 + gc_); } } while (0)
#define SSD_DTLOAD(c_) do { if (tid < 64) { const int tlo_ = dir ? SEQ - 64 * ((c_) + 1) : 64 * (c_); const int t_ = dir ? tlo_ + 63 - tid : tlo_ + tid; dtraw = DTV[(mb + t_) * 12 + dir * 6 + head]; } } while (0)
#define SSD_DTCALC(c_) do { if (tid < 64) { const float dt_ = dtraw; float cs_ = dt_ * aneg; \
        cs_ = wave_scan_add(cs_); \
        const float tt_ = __builtin_bit_cast(float, __builtin_amdgcn_readlane(__builtin_bit_cast(int, cs_), 63)); dtvb[((c_) & 1) * 64 + tid] = dt_; acsb[((c_) & 1) * 64 + tid] = cs_; if (tid == 0) totb[(c_) & 1] = tt_; } } while (0)
    int lgo[3], llp[3], lq[3]; v4u prel[3];
#pragma unroll
    for (int i = 0; i < 3; ++i) { const int idx = tid + 512 * i; const int tl = idx / 24, q = idx % 24; lq[i] = q; llp[i] = dir ? 63 - tl : tl;
        lgo[i] = tl * 896 + (q < 8 ? head * 64 + q * 8 : 384 + g * 128 + (q - 8) * 8); }
#define SSD_ISSUE_L(dst_, c_) do { const int tlo_ = dir ? SEQ - 64 * ((c_) + 1) : 64 * (c_); const GAS bf16* b_ = XBC + (mb + tlo_) * 896; _Pragma("unroll") for (int i_ = 0; i_ < 3; ++i_) dst_[i_] = *(const GAS v4u*)(b_ + lgo[i_]); } while (0)
    v4u preN[3];
    if (cfull0 > 0) { SSD_ISSUE_L(prel, 0); if (cfull0 > 1) SSD_ISSUE_L(preN, 1); } else SSD_ISSUE(0);
    SSD_DTLOAD(0); SSD_DTCALC(0); SSD_DTLOAD(1);
    __syncthreads();
    if (cfull0 > 0) {
#pragma unroll 1
        for (int c = 0; c < cfull0; ++c) {
            LAS bf16* Xl = (c & 1) ? (LAS bf16*)(F.lds + 92160) : Xt; LAS bf16* Bl = (c & 1) ? (LAS bf16*)(F.lds + 101376) : Btw;
            const LAS float* dtv = dtvb + (c & 1) * 64; const LAS float* acs = acsb + (c & 1) * 64; const float tot = totb[c & 1];
#pragma unroll
            for (int i = 0; i < 3; ++i) { const int q = lq[i], lp = llp[i];
                const unsigned w[4] = {prel[i].x, prel[i].y, prel[i].z, prel[i].w};
                if (q < 8) {
#pragma unroll
                    for (int k = 0; k < 4; ++k) { const int p0 = q * 8 + 2 * k; Xl[p0 * 72 + swz64(p0, lp)] = (bf16)(w[k] & 0xffffu); Xl[(p0 + 1) * 72 + swz64(p0 + 1, lp)] = (bf16)(w[k] >> 16); } }
                else { const int n0 = (q - 8) * 8; const float sc = dtv[lp] * __expf(tot - acs[lp]);
#pragma unroll
                    for (int k = 0; k < 4; ++k) { const int nn = n0 + 2 * k; Bl[nn * 72 + swz64(nn, lp)] = (bf16)f2bf(bf2f(w[k] & 0xffffu) * sc); Bl[(nn + 1) * 72 + swz64(nn + 1, lp)] = (bf16)f2bf(bf2f(w[k] >> 16) * sc); } } }
            if (c + 1 < cfull0) {
#pragma unroll
                for (int i = 0; i < 3; ++i) prel[i] = preN[i];
                if (c + 2 < cfull0) SSD_ISSUE_L(preN, c + 2); }
            else SSD_ISSUE(c + 1);
            SSD_DTCALC(c + 1); if (c + 2 < cend) SSD_DTLOAD(c + 2);
            __syncthreads();
            const float cdec = __expf(tot);
#pragma unroll
            for (int k = 0; k < 4; ++k) { const int ti = 4 * wave + k, tp = ti >> 3, tn = ti & 7; const f32x4 z = {0.f, 0.f, 0.f, 0.f};
                const f32x4 lcv = mma16s<true, true>(Xl, 72, tp * 16, Bl, 72, tn * 16, z, lane);
                st[k] = st[k] * cdec + lcv; }
        }
#pragma unroll
        for (int k = 0; k < 4; ++k) { const int ti = 4 * wave + k, tp = ti >> 3, tn = ti & 7;
#pragma unroll
            for (int jj = 0; jj < 4; ++jj) { const int p = tp * 16 + (lane >> 4) * 4 + jj, n = tn * 16 + (lane & 15); Hs[p * 136 + n] = (bf16)f2bf(st[k][jj]); } }
        __syncthreads();
    }
#pragma unroll 1
    for (int c = cfull0; c < cend; ++c) {
        const bool full = c >= cfull0;
        const int tlo = dir ? SEQ - 64 * (c + 1) : 64 * c;
        const LAS float* dtv = dtvb + (c & 1) * 64; const LAS float* acs = acsb + (c & 1) * 64; const float tot = totb[c & 1];
#pragma unroll
        for (int i = 0; i < 5; ++i) { const int idx = tid + 512 * i; const int tl = idx / 40, q = idx % 40; const int lp = dir ? 63 - tl : tl;
            const unsigned w[4] = {pre[i].x, pre[i].y, pre[i].z, pre[i].w};
            if (q < 8) {
#pragma unroll
                for (int k = 0; k < 4; ++k) { const int p0 = q * 8 + 2 * k; Xt[p0 * 72 + swz64(p0, lp)] = (bf16)(w[k] & 0xffffu); Xt[(p0 + 1) * 72 + swz64(p0 + 1, lp)] = (bf16)(w[k] >> 16); } }
            else if (q < 24) { const int n0 = (q - 8) * 8; if (full) *(LAS v4u*)(Bm + lp * 136 + n0) = pre[i]; const float sc = dtv[lp] * __expf(tot - acs[lp]);
#pragma unroll
                for (int k = 0; k < 4; ++k) { const int nn = n0 + 2 * k; Btw[nn * 72 + swz64(nn, lp)] = (bf16)f2bf(bf2f(w[k] & 0xffffu) * sc); Btw[(nn + 1) * 72 + swz64(nn + 1, lp)] = (bf16)f2bf(bf2f(w[k] >> 16) * sc); } }
            else if (full) { const int n0 = (q - 24) * 8; *(LAS v4u*)(Cm + lp * 136 + n0) = pre[i]; } }
        if (c + 1 < cend) SSD_ISSUE(c + 1);
        __syncthreads();
        f32x4 yo[2] = {{0.f, 0.f, 0.f, 0.f}, {0.f, 0.f, 0.f, 0.f}}, lc[4];
        if (full) {
#pragma unroll
        for (int k = 0; k < 2; ++k) { const int ti = 2 * wave + k, tl_ = ti >> 2, ts = ti & 3; f32x4 acc = {0.f, 0.f, 0.f, 0.f};
            if (ts <= tl_) acc = mma16<128>(Cm + tl_ * 16 * 136, 136, Bm + ts * 16 * 136, 136, acc, lane);
#pragma unroll
            for (int jj = 0; jj < 4; ++jj) { const int lr = tl_ * 16 + (lane >> 4) * 4 + jj, s = ts * 16 + (lane & 15);
                const float v = (s <= lr) ? acc[jj] * __expf(acs[lr] - acs[s]) * dtv[s] : 0.f; Ps[lr * 72 + s] = (bf16)f2bf(v); }
            const f32x4 z = {0.f, 0.f, 0.f, 0.f};
            yo[k] = mma16<128>(Cm + tl_ * 16 * 136, 136, Hs + ts * 16 * 136, 136, z, lane); }
        }
#pragma unroll
        for (int k = 0; k < 4; ++k) { const int ti = 4 * wave + k, tp = ti >> 3, tn = ti & 7; const f32x4 z = {0.f, 0.f, 0.f, 0.f};
            lc[k] = mma16s<true, true>(Xt, 72, tp * 16, Btw, 72, tn * 16, z, lane); }
        __syncthreads();
        const float cdec = __expf(tot);
        if (full) {
#pragma unroll
        for (int k = 0; k < 2; ++k) { const int ti = 2 * wave + k, tl_ = ti >> 2, tp = ti & 3; const f32x4 z = {0.f, 0.f, 0.f, 0.f};
            const f32x4 yd = mma16s<false, true>(Ps, 72, tl_ * 16, Xt, 72, tp * 16, z, lane);
#pragma unroll
            for (int jj = 0; jj < 4; ++jj) { const int lr = tl_ * 16 + (lane >> 4) * 4 + jj, p = tp * 16 + (lane & 15);
                const float val = yd[jj] + yo[k][jj] * __expf(acs[lr]);
                const int t = dir ? tlo + 63 - lr : tlo + lr;
                Y[(mb + t) * 384 + head * 64 + p] = (bf16)f2bf(val); } }
        }
#pragma unroll
        for (int k = 0; k < 4; ++k) { const int ti = 4 * wave + k, tp = ti >> 3, tn = ti & 7;
#pragma unroll
            for (int jj = 0; jj < 4; ++jj) { const int p = tp * 16 + (lane >> 4) * 4 + jj, n = tn * 16 + (lane & 15);
                st[k][jj] = cdec * st[k][jj] + lc[k][jj]; Hs[p * 136 + n] = (bf16)f2bf(st[k][jj]); } }
        if (c + 1 < cend) { SSD_DTCALC(c + 1); if (c + 2 < cend) SSD_DTLOAD(c + 2); }
        __syncthreads();
    }
#undef SSD_ISSUE
#undef SSD_ISSUE_L
#undef SSD_DTLOAD
#undef SSD_DTCALC
}
__device__ __forceinline__ float wave_sum2(float v) { v = row16_sum(v); v += __shfl_xor(v, 16); v += __shfl_xor(v, 32); return v; }
__device__ __forceinline__ f32x4 bf4(v2u w) { return (f32x4){bf2f(w.x & 0xffffu), bf2f(w.x >> 16), bf2f(w.y & 0xffffu), bf2f(w.y >> 16)}; }
__device__ __forceinline__ v2u pk4(f32x4 v) { v2u w; w.x = pk2(v.x, v.y); w.y = pk2(v.z, v.w); return w; }
__device__ __forceinline__ void phase_post(const Frame& F, int l) {
    const GAS bf16* cols = (const GAS bf16*)(WSP(F) + WS_COLS); GAS bf16* MIX = (GAS bf16*)(WSP(F) + WS_XN);
    const GAS bf16* YAf = (const GAS bf16*)(WSP(F) + Y_AF); const GAS bf16* YAb = (const GAS bf16*)(WSP(F) + Y_AB);
    const GAS bf16* YRf = (const GAS bf16*)(WSP(F) + Y_RF); const GAS bf16* YRb = (const GAS bf16*)(WSP(F) + Y_RB);
    const GAS bf16* YSf = (const GAS bf16*)(WSP(F) + Y_SF); const GAS bf16* YSb = (const GAS bf16*)(WSP(F) + Y_SB);
    const GAS float* CT = (const GAS float*)(WSP(F) + WS_CT);
    LAS bf16* GU = (LAS bf16*)(F.lds);
    LAS bf16* SG = (LAS bf16*)(F.lds + 104448);
    LAS float* gate = (LAS float*)(F.lds + 108800);
    LAS float* SCW = (LAS float*)(F.lds + 133632);
    const int tid = F.tid, lane = F.lane, wave = F.wave;
    const GAS float* mup = INP(F, 8) + l * 1472; const GAS float* mun = INP(F, 9) + l * 1472;
    const GAS float* sdk = INP(F, 24) + l * 6;
    __syncthreads();
    { const GAS bf16* gut = (const GAS bf16*)(WSP(F) + WS_GUT); for (int ch = tid; ch < 384 * 16; ch += 512) { const int c = ch >> 4, q = ch & 15; *(LAS v4u*)(GU + c * 136 + q * 8) = *(const GAS v4u*)(gut + c * 128 + q * 8); } }
    { const GAS float* scw = INP(F, 20) + (size_t)l * 5 * 896; for (int idx = tid; idx < 5 * 384; idx += 512) SCW[idx] = scw[(idx / 384) * 896 + (idx % 384)]; }
    const int gch = tid & 15;
    float gmp[8], gmn[8];
#pragma unroll
    for (int k = 0; k < 8; ++k) { gmp[k] = mup[1344 + 8 * gch + k]; gmn[k] = mun[1344 + 8 * gch + k]; }
    const int qa = lane, qb = 64 + (lane & 31);
    const f32x4 mng4 = *(const GAS f32x4*)(INP(F, 7) + l * 256 + 4 * qa);
    f32x4 rmp[2], rmn[2], rng[2], rnb[2], scb[2], sng[2];
#pragma unroll
    for (int ps = 0; ps < 2; ++ps) { const int c0 = 4 * (ps ? qb : qa);
        rmp[ps] = *(const GAS f32x4*)(mup + 768 + c0); rmn[ps] = *(const GAS f32x4*)(mun + 768 + c0);
        rng[ps] = *(const GAS f32x4*)(INP(F, 18) + l * 384 + c0); rnb[ps] = *(const GAS f32x4*)(INP(F, 19) + l * 384 + c0);
        scb[ps] = *(const GAS f32x4*)(INP(F, 21) + l * 896 + c0); sng[ps] = *(const GAS f32x4*)(INP(F, 25) + l * 384 + c0); }
    for (int tile = F.vcu; tile < M / 16; tile += F.G) {
        const int m0 = tile * 16;
        __syncthreads();
        if (tid < 256) { const int tt = tid >> 4; const int m = m0 + tt, t = m % SEQ; const GAS bf16* cp = cols + (size_t)m * NINP + R_GD + 8 * gch;
            const v4u c1 = *(const GAS v4u*)cp; v4u c0 = {0u, 0u, 0u, 0u}, c2 = {0u, 0u, 0u, 0u};
            if (t > 0) c0 = *(const GAS v4u*)(cp - NINP); if (t < SEQ - 1) c2 = *(const GAS v4u*)(cp + NINP);
            const unsigned w0[4] = {c0.x, c0.y, c0.z, c0.w}, w1[4] = {c1.x, c1.y, c1.z, c1.w}, w2[4] = {c2.x, c2.y, c2.z, c2.w}; unsigned o[4];
#pragma unroll
            for (int k = 0; k < 4; ++k) { const float a1 = bf2f(w1[k] & 0xffffu), b1 = bf2f(w1[k] >> 16);
                const float va = a1 + gmp[2 * k] * (bf2f(w0[k] & 0xffffu) - a1) + gmn[2 * k] * (bf2f(w2[k] & 0xffffu) - a1);
                const float vb = b1 + gmp[2 * k + 1] * (bf2f(w0[k] >> 16) - b1) + gmn[2 * k + 1] * (bf2f(w2[k] >> 16) - b1);
                o[k] = pk2(sigmoidf_(va), sigmoidf_(vb)); }
            *(LAS v4u*)(SG + tt * 136 + 8 * gch) = (v4u){o[0], o[1], o[2], o[3]}; }
        __syncthreads();
#pragma unroll
        for (int k = 0; k < 3; ++k) { const int ct = wave + 8 * k; const f32x4 z = {0.f, 0.f, 0.f, 0.f};
            const f32x4 acc = mma16<128>(SG, 136, GU + ct * 16 * 136, 136, z, lane);
#pragma unroll
            for (int jj = 0; jj < 4; ++jj) gate[((lane >> 4) * 4 + jj) * 388 + ct * 16 + (lane & 15)] = acc[jj]; }
        __syncthreads();
#pragma unroll 1
        for (int k = 0; k < 2; ++k) { const int tt = wave * 2 + k; const int m = m0 + tt, t = m % SEQ; const size_t cr = (size_t)m * NINP;
            { const int c0 = 4 * qa;
              const f32x4 hs = bf4(*(const GAS v2u*)(YAf + (size_t)m * 256 + c0)) + bf4(*(const GAS v2u*)(YAb + (size_t)m * 256 + c0));
              const float mean = row16_sum((hs.x + hs.y) + (hs.z + hs.w)) * (1.f / 64.f); const f32x4 d = hs - mean;
              const float var = row16_sum((d.x * d.x + d.y * d.y) + (d.z * d.z + d.w * d.w)) * (1.f / 64.f);
              const f32x4 o = bf4(*(const GAS v2u*)(cols + cr + A_O + c0));
              f32x4 y = d * __builtin_amdgcn_rsqf(var + 1e-6f) * mng4;
              y.x *= sigmoidf_(o.x); y.y *= sigmoidf_(o.y); y.z *= sigmoidf_(o.z); y.w *= sigmoidf_(o.w);
              *(GAS v2u*)(MIX + (size_t)m * DM + c0) = pk4(y); }
#pragma unroll
            for (int ps = 0; ps < 2; ++ps) { const int qd = ps ? qb : qa, c0 = 4 * qd; const bool act = ps == 0 || lane < 32;
              const f32x4 ys = bf4(*(const GAS v2u*)(YRf + (size_t)m * 384 + c0)) + bf4(*(const GAS v2u*)(YRb + (size_t)m * 384 + c0));
              const float mean = row16_sum((ys.x + ys.y) + (ys.z + ys.w)) * (1.f / 64.f); const f32x4 d = ys - mean;
              const float var = row16_sum((d.x * d.x + d.y * d.y) + (d.z * d.z + d.w * d.w)) * (1.f / 64.f);
              const f32x4 y = d * __builtin_amdgcn_rsqf(var + 64e-5f) * rng[ps] + rnb[ps];
              const f32x4 p1 = bf4(*(const GAS v2u*)(cols + cr + R_V + c0));
              f32x4 p0 = {0.f, 0.f, 0.f, 0.f}, p2 = {0.f, 0.f, 0.f, 0.f};
              if (t > 0) p0 = bf4(*(const GAS v2u*)(cols + cr - NINP + R_V + c0)); if (t < SEQ - 1) p2 = bf4(*(const GAS v2u*)(cols + cr + NINP + R_V + c0));
              const f32x4 vv = p1 + rmp[ps] * (p0 - p1) + rmn[ps] * (p2 - p1);
              const float ctv = CT[(size_t)m * 8 + (qd >> 4)];
              const f32x4 g4 = *(const LAS f32x4*)(gate + tt * 388 + c0);
              if (act) *(GAS v2u*)(MIX + (size_t)m * DM + 256 + c0) = pk4((y + vv * ctv) * g4); }
            f32x4 yv[2]; float ssq0 = 0.f, ssq1 = 0.f;
#pragma unroll
            for (int ps = 0; ps < 2; ++ps) { const int qd = ps ? qb : qa, c0 = 4 * qd; const bool act = ps == 0 || lane < 32;
              f32x4 s = scb[ps];
#pragma unroll
              for (int jj = 0; jj < 5; ++jj) { const int tq = t + jj - 2; if (tq >= 0 && tq < SEQ) s += *(const LAS f32x4*)(SCW + jj * 384 + c0) * bf4(*(const GAS v2u*)(cols + cr + (jj - 2) * NINP + S_X + c0)); }
              const f32x4 z = bf4(*(const GAS v2u*)(cols + cr + S_Z + c0));
              f32x4 y = bf4(*(const GAS v2u*)(YSf + (size_t)m * 384 + c0)) + bf4(*(const GAS v2u*)(YSb + (size_t)m * 384 + c0));
              const float dsk = sdk[qd >> 4];
              y.x = (y.x + dsk * siluf_(s.x)) * siluf_(z.x); y.y = (y.y + dsk * siluf_(s.y)) * siluf_(z.y); y.z = (y.z + dsk * siluf_(s.z)) * siluf_(z.z); y.w = (y.w + dsk * siluf_(s.w)) * siluf_(z.w);
              yv[ps] = y; const float sq = act ? (y.x * y.x + y.y * y.y) + (y.z * y.z + y.w * y.w) : 0.f;
              if (qd < 48) ssq0 += sq; else ssq1 += sq; }
            const float r0 = __builtin_amdgcn_rsqf(wave_sum2(ssq0) * (1.f / 192.f) + 1e-6f), r1 = __builtin_amdgcn_rsqf(wave_sum2(ssq1) * (1.f / 192.f) + 1e-6f);
#pragma unroll
            for (int ps = 0; ps < 2; ++ps) { const int qd = ps ? qb : qa, c0 = 4 * qd; const bool act = ps == 0 || lane < 32;
              if (act) *(GAS v2u*)(MIX + (size_t)m * DM + 640 + c0) = pk4(yv[ps] * (qd < 48 ? r0 : r1) * sng[ps]); }
        }
    }
    __syncthreads();
}
namespace cg = cooperative_groups;
constexpr int N_PHASES = 9 * DEPTH + 1;
__global__ void __launch_bounds__(NWAVES * 64, 2) mk_fwd(Args args) {
    extern __shared__ __attribute__((aligned(16))) unsigned char lds_raw[];
    Frame F;
    F.lds = (LAS unsigned char*)lds_raw;
    F.tid = threadIdx.x; F.lane = F.tid & 63; F.wave = __builtin_amdgcn_readfirstlane(F.tid >> 6);
    F.G = gridDim.x; { const int bx = blockIdx.x; F.vcu = (F.G % 8 == 0) ? (bx % 8) * (F.G / 8) + bx / 8 : bx; }
    volatile LAS unsigned* MISC = (volatile LAS unsigned*)(F.lds + MISC_OFF);
    if (F.tid < 64) MISC[F.tid] = 0u;
    if (F.tid < 34) *(LAS unsigned long long*)(F.lds + PTAB_OFF + 8 * F.tid) = ((const unsigned long long*)__builtin_amdgcn_kernarg_segment_ptr())[F.tid];
    __syncthreads();
    unsigned* ctl = (unsigned*)(WSP(F) + WS_CTL);
    XcdBarrier bar = xcd_barrier_post(ctl + CW_BAR, MISC + 8);
    const int lo = args.ph_lo, hi = args.ph_hi;
#define IN_(k) (lo <= (k) && (k) < hi)
#define SEAM(k) do { if (IN_(k) && IN_((k) + 1)) { if ((k) == 0) cg::this_grid().sync(); else xcd_barrier(bar); } } while (0)
#define LAYER(l, B) \
    if (IN_(B + 0)) { phase_convert(F, l); phase_norm(F, l == 0 ? INP(F, 0) : OUTP(F), INP(F, 1) + l * DM, (GAS bf16*)(WSP(F) + WS_XN)); } SEAM(B + 0); \
    if (IN_(B + 1)) { unsigned char* ws = (unsigned char*)WSP(F); pg8::Gemm g{(const bf16*)(ws + WS_XN), (const bf16*)(ws + WS_WIN), M, NINP, DM}; pg8::StaticOrder S; S.init(M, NINP, F.G, (int)blockIdx.x); \
            pg8::EpiBf16<0> E{(bf16*)(ws + WS_COLS), NINP, nullptr, 0, 0, 1.f}; \
            pg8::gemm_phase<pg8::EpiBf16<0>, pg8::StaticOrder, PG8_ALIGN, PG8_SP2>(F.lds, g, S, E); } SEAM(B + 1); \
    if (IN_(B + 2)) { phase_gates(F, l); phase_ssd_conv(F, l); } SEAM(B + 2); \
    if (IN_(B + 3)) { const int bx = blockIdx.x; \
            if (bx < 96) { const int c8 = bx & 7, k8 = bx >> 3; rwkv_scan(F, l, c8 + 8 * (k8 >> 2), k8 & 3, (unsigned)l * (SEQ / 32)); } else if (bx < 144) rwkv_produce(F, l, (bx - 96) % 24, (bx - 96) / 24, (unsigned)l * (SEQ / 32)); else if (bx < 216) { const int u = bx - 144, sg = 2 - (u / 24); ssd_seq(F, l, u % 24, sg == 0 ? 0 : (sg == 1 ? 43 : 86), sg == 0 ? 43 : (sg == 1 ? 86 : 128)); } else if (bx < 248) { const int u = bx - 216, sg = 1 - (u / 16); mlstm_seq(F, l, u % 16, 64 * sg, 64 * sg + 64); } } SEAM(B + 3); \
    if (IN_(B + 4)) phase_post(F, l); SEAM(B + 4); \
    if (IN_(B + 5)) { unsigned char* ws = (unsigned char*)WSP(F); pg8::Gemm g{(const bf16*)(ws + WS_XN), (const bf16*)(ws + WS_WOUT), M, DM, DM}; pg8::StaticOrder S; S.init(M, DM, F.G, (int)blockIdx.x); \
            pg8::EpiResidual E{l == 0 ? (const float*)INP(F, 0) : (const float*)OUTP(F), (float*)OUTP(F), DM}; \
            pg8::gemm_phase<pg8::EpiResidual, pg8::StaticOrder, PG8_ALIGN, PG8_SP2>(F.lds, g, S, E); } SEAM(B + 5); \
    if (IN_(B + 6)) phase_norm(F, OUTP(F), INP(F, 27) + l * DM, (GAS bf16*)(WSP(F) + WS_XN)); SEAM(B + 6); \
    if (IN_(B + 7)) { unsigned char* ws = (unsigned char*)WSP(F); pg8::Gemm g{(const bf16*)(ws + WS_XN), (const bf16*)(ws + WS_WGU), M, 2 * FFN, DM}; pg8::StaticOrder S; S.init(M, 2 * FFN, F.G, (int)blockIdx.x); \
            pg8::EpiSwiGLU E{(bf16*)(ws + WS_COLS), FFN}; \
            pg8::gemm_phase<pg8::EpiSwiGLU, pg8::StaticOrder, PG8_ALIGN, PG8_SP2>(F.lds, g, S, E); } SEAM(B + 7); \
    if (IN_(B + 8)) { unsigned char* ws = (unsigned char*)WSP(F); pg8::Gemm g{(const bf16*)(ws + WS_COLS), (const bf16*)(ws + WS_WDN), M, DM, FFN}; pg8::StaticOrder S; S.init(M, DM, F.G, (int)blockIdx.x); \
            pg8::EpiResidual E{(const float*)OUTP(F), (float*)OUTP(F), DM}; \
            pg8::gemm_phase<pg8::EpiResidual, pg8::StaticOrder, PG8_ALIGN, PG8_SP2>(F.lds, g, S, E); } SEAM(B + 8);
    LAYER(0, 0)
    LAYER(1, 9)
    if (IN_(18)) phase_final_norm(F, OUTP(F), INP(F, 31));
#undef IN_
#undef SEAM
#undef LAYER
}

#ifndef MK_PER_PHASE
#define MK_PER_PHASE 0
#endif
extern "C" void kernel_launch(void* const* d_in, const int* in_sizes, int n_in, void* d_out, int out_size, void* d_ws, size_t ws_size, hipStream_t stream) {
    static int grid = 0;
    if (grid == 0) {
        int dev = 0, cus = 0;
        if (n_in != 32 || out_size != M * DM || ws_size < WS_END) { fprintf(stderr, "kernel_launch: unexpected shapes (n_in %d out %d ws %zu)\n", n_in, out_size, ws_size); grid = -1; return; }
        if (hipGetDevice(&dev) != hipSuccess || hipDeviceGetAttribute(&cus, hipDeviceAttributeMultiprocessorCount, dev) != hipSuccess) { grid = -1; return; }
        if (hipFuncSetAttribute((const void*)mk_fwd, hipFuncAttributeMaxDynamicSharedMemorySize, LDS_BYTES) != hipSuccess) { fprintf(stderr, "kernel_launch: hipFuncSetAttribute failed\n"); grid = -1; return; }
        int per_cu = 0;
        if (hipOccupancyMaxActiveBlocksPerMultiprocessor(&per_cu, (const void*)mk_fwd, NWAVES * 64, LDS_BYTES) != hipSuccess || per_cu < 1) { fprintf(stderr, "kernel_launch: occupancy query says %d\n", per_cu); }
        (void)hipGetLastError();
        grid = cus;
    }
    if (grid < 0) return;
    (void)hipMemsetAsync((char*)d_ws + WS_CTL, 0, CTL_ZERO_BYTES, stream);
    Args a{};
    for (int i = 0; i < 32; ++i) a.in[i] = (const float*)d_in[i];
    a.out = (float*)d_out; a.ws = (unsigned char*)d_ws;
#if MK_PER_PHASE
    for (int p = 0; p < N_PHASES; ++p) { a.ph_lo = p; a.ph_hi = p + 1; hipLaunchKernelGGL(mk_fwd, dim3(grid), dim3(NWAVES * 64), LDS_BYTES, stream, a); }
#else
    a.ph_lo = 0; a.ph_hi = N_PHASES;
    void* kargs[] = {&a};
    hipError_t e = hipLaunchCooperativeKernel((const void*)mk_fwd, dim3(grid), dim3(NWAVES * 64), kargs, LDS_BYTES, stream);
    if (e != hipSuccess) fprintf(stderr, "cooperative launch failed: %s (grid %d)\n", hipGetErrorString(e), grid);
#endif
}
```

```cpp
#include <hip/hip_runtime.h>
#include <hip/hip_cooperative_groups.h>
#include <cstdio>
#include <cstdint>
namespace pg8 {
#define PG8_LAS __attribute__((address_space(3)))
typedef unsigned short bf16_t;
typedef short bf16x8 __attribute__((ext_vector_type(8)));
typedef float f32x4 __attribute__((ext_vector_type(4)));
typedef unsigned u32x4 __attribute__((ext_vector_type(4)));
constexpr int BM = 256, BK = 64, HALF = 128, HTB = HALF * BK * 2  , STAGE_BYTES = 8 * HTB, NXCD = 8, WGM = 8;

__host__ __device__ __forceinline__ int lds_byte(int r, int c) { const int st = (r >> 4) * 2 + (c >> 5), rr = r & 15, cc = c & 31, ob = rr * 64 + cc * 2; return st * 1024 + (ob ^ (((ob >> 9) & 1) << 5)); }
__host__ __device__ __forceinline__ void stage_rc(int b, int& R, int& C) { const int st = b / 1024, sb = b % 1024, swz = sb ^ (((sb >> 9) & 1) << 5); R = (st >> 1) * 16 + swz / 64; C = (st & 1) * 32 + (swz % 64) / 2; }
__host__ __device__ __forceinline__ int perm32(int rho) { const int n = rho >> 4, i = rho & 15; return 8 * (i >> 2) + 4 * n + (i & 3); }

struct Unit { int pm, pn; };
struct Gemm { const bf16_t* A; const bf16_t* Bt; int M, N, K; };

struct StaticOrder {
    int nM, nN, nwg, G, c;
    __host__ __device__ void init(int M, int N, int G_, int c_) { nM = M / BM; nN = N / BM; nwg = nM * nN; G = G_; c = c_; }
    __host__ __device__ bool next(int i, Unit& u) const {
        const long L = (long)i * G + c; if (L >= nwg) return false;
        int wgid = (int)L; { const int q = nwg / NXCD, r = nwg % NXCD, xcd = wgid % NXCD, off = wgid / NXCD; wgid = (xcd < r ? xcd * (q + 1) : r * (q + 1) + (xcd - r) * q) + off; }
        const int nig = WGM * nN, gid = wgid / nig, fm = gid * WGM, gsz = (nM - fm) < WGM ? (nM - fm) : WGM;
        u.pm = fm + ((wgid % nig) % gsz); u.pn = (wgid % nig) / gsz; return true;
    }
    __device__ __forceinline__ void a_ready(const Unit&) const {}
    __device__ __forceinline__ void done(const Unit&) const {}
};

__device__ __forceinline__ unsigned cvt_pk_bf16(float lo, float hi) { unsigned r; asm volatile("v_cvt_pk_bf16_f32 %0, %1, %2" : "=v"(r) : "v"(lo), "v"(hi)); return r; }
typedef float f32x2 __attribute__((ext_vector_type(2)));
__device__ __forceinline__ f32x2 gelu_pk(f32x2 v) {
    const f32x2 av = __builtin_elementwise_abs(v), d = av * 0.2316418882f + 1.0f;
    f32x2 t; t.x = __builtin_amdgcn_rcpf(d.x); t.y = __builtin_amdgcn_rcpf(d.y);
    f32x2 q = t * 0.5307027145f + (-0.7265760135f); q = q * t + 0.7107068705f; q = q * t + (-0.142248368f); q = q * t + 0.127414796f; q = q * t;
    const f32x2 s = (v * v) * (-0.72134752044f);
    f32x2 e; e.x = __builtin_amdgcn_exp2f(s.x); e.y = __builtin_amdgcn_exp2f(s.y);
    const f32x2 m = v * (q * e), r = v - m;
    f32x2 o; o.x = v.x < 0.f ? m.x : r.x; o.y = v.y < 0.f ? m.y : r.y; return o;
}

template <int ACT  > struct EpiBf16 {
    static constexpr bool PERM = true, AFTER_DRAIN = false; static_assert(ACT == 0 || ACT == 1, "EpiBf16: ACT is 0 (none) or 1 (gelu_pk)");
    bf16_t* O; int ldc; const float* bias; int split_cols; size_t split_stride; float scale0;
    __device__ __forceinline__ void operator()(const f32x4 (&acc)[2][2][4][2], const Unit& u, int wr, int wc, int fr, int fq) const {
        const int row0 = u.pm * BM + wr * 64 + fr; int colt = u.pn * BM; bf16_t* base = O;
        float sc = 1.f; if (split_cols) { const int t = colt / split_cols; base += (size_t)t * split_stride; colt -= t * split_cols; if (t == 0) sc = scale0; }
        const int col0 = colt + wc * 32 + 8 * fq, bcol0 = u.pn * BM + wc * 32 + 8 * fq;
        f32x4 bv[2][2];
#pragma unroll
        for (int bj = 0; bj < 2; ++bj)
#pragma unroll
            for (int n = 0; n < 2; ++n) bv[bj][n] = bias ? *(const f32x4*)(bias + bcol0 + bj * HALF + 4 * n) : (f32x4){0.f, 0.f, 0.f, 0.f};
#pragma unroll
        for (int ai = 0; ai < 2; ++ai)
#pragma unroll
            for (int m = 0; m < 4; ++m) { bf16_t* rowp = base + (size_t)(row0 + ai * HALF + m * 16) * ldc + col0;
#pragma unroll
                for (int bj = 0; bj < 2; ++bj) { f32x4 v0 = acc[ai][bj][m][0] + bv[bj][0], v1 = acc[ai][bj][m][1] + bv[bj][1];
                    if (ACT == 1) { f32x2 a = gelu_pk((f32x2){v0[0], v0[1]}), b = gelu_pk((f32x2){v0[2], v0[3]}), c = gelu_pk((f32x2){v1[0], v1[1]}), d = gelu_pk((f32x2){v1[2], v1[3]});
                        v0 = (f32x4){a.x, a.y, b.x, b.y}; v1 = (f32x4){c.x, c.y, d.x, d.y}; }
                    v0 = v0 * sc; v1 = v1 * sc; u32x4 w; w.x = cvt_pk_bf16(v0[0], v0[1]); w.y = cvt_pk_bf16(v0[2], v0[3]); w.z = cvt_pk_bf16(v1[0], v1[1]); w.w = cvt_pk_bf16(v1[2], v1[3]);
                    *(u32x4*)(rowp + bj * HALF) = w; } }
    }
};
struct EpiResidual {
    static constexpr bool PERM = false, AFTER_DRAIN = false;
    const float* base; float* out; int ldc;
    __device__ __forceinline__ void operator()(const f32x4 (&acc)[2][2][4][2], const Unit& u, int wr, int wc, int fr, int fq) const {
        const int col0 = u.pn * BM + wc * 32 + 4 * fq;
#pragma unroll
        for (int ai = 0; ai < 2; ++ai)
#pragma unroll
            for (int m = 0; m < 4; ++m) { const size_t off = (size_t)(u.pm * BM + ai * HALF + wr * 64 + m * 16 + fr) * ldc + col0;
#pragma unroll
                for (int bj = 0; bj < 2; ++bj)
#pragma unroll
                    for (int n = 0; n < 2; ++n) { const f32x4 bs = *(const f32x4*)(base + off + bj * HALF + n * 16); *(f32x4*)(out + off + bj * HALF + n * 16) = bs + acc[ai][bj][m][n]; }
                if (m & 1) asm volatile("" ::: "memory"); }
    }
};
struct EpiSwiGLU {
    static constexpr bool PERM = true, AFTER_DRAIN = false;
    bf16_t* O; int ldc;
    __device__ __forceinline__ void operator()(const f32x4 (&acc)[2][2][4][2], const Unit& u, int wr, int wc, int fr, int fq) const {
        const int col0 = u.pn * HALF + wc * 32 + 8 * fq;
#pragma unroll
        for (int ai = 0; ai < 2; ++ai)
#pragma unroll
            for (int m = 0; m < 4; ++m) { bf16_t* rowp = O + (size_t)(u.pm * BM + ai * HALF + wr * 64 + m * 16 + fr) * ldc + col0;
                float r[8];
#pragma unroll
                for (int n = 0; n < 2; ++n)
#pragma unroll
                    for (int j = 0; j < 4; ++j) { const float g = acc[ai][0][m][n][j], up = acc[ai][1][m][n][j]; r[n * 4 + j] = g * __builtin_amdgcn_rcpf(1.f + __expf(-g)) * up; }
                u32x4 w; w.x = cvt_pk_bf16(r[0], r[1]); w.y = cvt_pk_bf16(r[2], r[3]); w.z = cvt_pk_bf16(r[4], r[5]); w.w = cvt_pk_bf16(r[6], r[7]);
                *(u32x4*)rowp = w; }
    }
};
template <class Epi, class Sched, bool ALIGN_EPI = false, bool SP2 = false>
__device__ __forceinline__ void gemm_phase(PG8_LAS unsigned char* lds, const Gemm g, const Sched& S, const Epi& E) {
    const int tid = threadIdx.x, wid = __builtin_amdgcn_readfirstlane(tid >> 6), lane = tid & 63, wr = wid >> 2, wc = wid & 3, fr = lane & 15, fq = lane >> 4;
    const int K = g.K, nt = K / BK;
    unsigned voffA[2], voffB[2];
#pragma unroll
    for (int i = 0; i < 2; ++i) { int R, C; stage_rc(tid * 16 + i * 8192, R, C); const int Rb = Epi::PERM ? ((R & ~31) + perm32(R & 31)) : R;
        voffA[i] = (unsigned)(R * K + C) * 2u; voffB[i] = (unsigned)(Rb * K + C) * 2u; }
    const size_t kstep = (size_t)(BK * 2);
    const size_t hstep = (size_t)HALF * K * 2;
    const size_t tstep = 2 * hstep;
    const unsigned ldsw = (unsigned)wid * 1024u;
    const int aoff = lds_byte(wr * 64 + fr, fq * 8), boff = lds_byte(wc * 32 + fr, fq * 8);
#define PG8_SA(b, h) (((b) * 2 + (h)) * HTB)
#define PG8_SB(b, h) ((4 + (b) * 2 + (h)) * HTB)
#define PG8_STAGE(bufoff, gbase, voff) do { _Pragma("unroll") for (int _i = 0; _i < 2; ++_i) \
        __builtin_amdgcn_global_load_lds((const unsigned*)((const char*)(gbase) + (voff)[_i]), (PG8_LAS unsigned*)(lds + (bufoff) + ldsw + _i * 8192), 16, 0, 0); } while (0)
#define PG8_LDA(dst, b, h) do { _Pragma("unroll") for (int m = 0; m < 4; ++m) _Pragma("unroll") for (int k = 0; k < 2; ++k) dst[m][k] = *(const PG8_LAS bf16x8*)(lds + PG8_SA(b, h) + aoff + m * 2048 + k * 1024); } while (0)
#define PG8_LDB(dst, b, h) do { _Pragma("unroll") for (int n = 0; n < 2; ++n) _Pragma("unroll") for (int k = 0; k < 2; ++k) dst[n][k] = *(const PG8_LAS bf16x8*)(lds + PG8_SB(b, h) + boff + n * 2048 + k * 1024); } while (0)
#define PG8_MMA(ai, bj, At, Bt) do { __builtin_amdgcn_s_setprio(1); _Pragma("unroll") for (int m = 0; m < 4; ++m) _Pragma("unroll") for (int n = 0; n < 2; ++n) _Pragma("unroll") for (int k = 0; k < 2; ++k) \
        acc[ai][bj][m][n] = __builtin_amdgcn_mfma_f32_16x16x32_bf16(Bt[n][k], At[m][k], acc[ai][bj][m][n], 0, 0, 0); __builtin_amdgcn_s_setprio(0); } while (0)
#define PG8_WAIT_V(n) asm volatile("s_waitcnt vmcnt(" #n ")" ::: "memory")
#define PG8_WAIT_L(n) asm volatile("s_waitcnt lgkmcnt(" #n ")" ::: "memory")
#define PG8_BAR __builtin_amdgcn_s_barrier()
#define PG8_SCHED __builtin_amdgcn_sched_barrier(0)
    Unit cur, nxt; int ui = 0;
    if (!S.next(0, cur)) return;
    f32x4 acc[2][2][4][2];
#pragma unroll
    for (int a = 0; a < 2; ++a)
#pragma unroll
        for (int b = 0; b < 2; ++b)
#pragma unroll
            for (int m = 0; m < 4; ++m)
#pragma unroll
                for (int n = 0; n < 2; ++n) acc[a][b][m][n] = (f32x4){0.f, 0.f, 0.f, 0.f};
    bf16x8 At[4][2], B0[2][2], B1[2][2];
    const char* cA = (const char*)g.A + (size_t)cur.pm * tstep; const char* cB = (const char*)g.Bt + (size_t)cur.pn * tstep;
    S.a_ready(cur);
    if constexpr (SP2) {
        PG8_STAGE(PG8_SB(0, 0), cB, voffB); PG8_STAGE(PG8_SB(0, 1), cB + hstep, voffB); PG8_STAGE(PG8_SA(0, 0), cA, voffA); PG8_STAGE(PG8_SA(0, 1), cA + hstep, voffA);
        if (wr == 1) PG8_BAR;
        PG8_WAIT_V(2); PG8_BAR;
        PG8_STAGE(PG8_SB(1, 0), cB + kstep, voffB); PG8_STAGE(PG8_SA(1, 0), cA + kstep, voffA); PG8_STAGE(PG8_SB(1, 1), cB + hstep + kstep, voffB);
        PG8_WAIT_V(6); PG8_BAR;
    } else {
        PG8_STAGE(PG8_SB(0, 0), cB, voffB); PG8_STAGE(PG8_SA(0, 0), cA, voffA); PG8_STAGE(PG8_SB(0, 1), cB + hstep, voffB); PG8_STAGE(PG8_SA(0, 1), cA + hstep, voffA);
        if (wr == 1) PG8_BAR;
        PG8_WAIT_V(4); PG8_BAR;
        PG8_STAGE(PG8_SB(1, 0), cB + kstep, voffB); PG8_STAGE(PG8_SA(1, 0), cA + kstep, voffA); PG8_STAGE(PG8_SB(1, 1), cB + hstep + kstep, voffB);
        PG8_WAIT_V(6); PG8_BAR;
    }
    for (;;) {
        const bool has_next = S.next(ui + 1, nxt);
        const char* nA = has_next ? (const char*)g.A + (size_t)nxt.pm * tstep : cA; const char* nB = has_next ? (const char*)g.Bt + (size_t)nxt.pn * tstep : cB;
        for (int t = 0; t < nt; t += 2) {
            const bool last = (t == nt - 2);
            const char* a1 = cA + (size_t)(t + 1) * kstep;
            const char* a2 = last ? nA : cA + (size_t)(t + 2) * kstep; const char* b2 = last ? nB : cB + (size_t)(t + 2) * kstep;
            const char* a3 = a2 + kstep; const char* b3 = b2 + kstep;
            if (last && has_next) S.a_ready(nxt);
            if constexpr (SP2) {
            PG8_LDB(B0, 0, 0); PG8_LDB(B1, 0, 1); PG8_SCHED; PG8_LDA(At, 0, 0); PG8_STAGE(PG8_SA(1, 1), a1 + hstep, voffA);
            PG8_WAIT_V(8); PG8_WAIT_L(0); PG8_BAR; PG8_MMA(0, 0, At, B0); PG8_MMA(0, 1, At, B1); PG8_BAR; PG8_SCHED;
            PG8_LDA(At, 0, 1); PG8_STAGE(PG8_SB(0, 0), b2, voffB); PG8_STAGE(PG8_SB(0, 1), b2 + hstep, voffB); PG8_STAGE(PG8_SA(0, 0), a2, voffA);
            PG8_WAIT_V(8); PG8_WAIT_L(0); PG8_BAR; PG8_MMA(1, 0, At, B0); PG8_MMA(1, 1, At, B1); PG8_BAR; PG8_SCHED;
            PG8_LDB(B0, 1, 0); PG8_LDB(B1, 1, 1); PG8_SCHED; PG8_LDA(At, 1, 0); PG8_STAGE(PG8_SA(0, 1), a2 + hstep, voffA);
            PG8_WAIT_V(8); PG8_WAIT_L(0); PG8_BAR; PG8_MMA(0, 0, At, B0); PG8_MMA(0, 1, At, B1); PG8_BAR; PG8_SCHED;
            PG8_LDA(At, 1, 1); PG8_STAGE(PG8_SB(1, 0), b3, voffB); PG8_STAGE(PG8_SB(1, 1), b3 + hstep, voffB); PG8_STAGE(PG8_SA(1, 0), a3, voffA);
            PG8_WAIT_V(8); PG8_WAIT_L(0); PG8_BAR; PG8_MMA(1, 0, At, B0); PG8_MMA(1, 1, At, B1); PG8_BAR; PG8_SCHED;
            } else {
            PG8_LDB(B0, 0, 0); PG8_SCHED; PG8_LDA(At, 0, 0); PG8_STAGE(PG8_SA(1, 1), a1 + hstep, voffA);
            PG8_WAIT_L(8); PG8_BAR; PG8_WAIT_L(0); PG8_MMA(0, 0, At, B0); PG8_BAR; PG8_SCHED;
            PG8_LDB(B1, 0, 1); PG8_STAGE(PG8_SB(0, 0), b2, voffB);
            PG8_BAR; PG8_WAIT_L(0); PG8_MMA(0, 1, At, B1); PG8_BAR;
            PG8_LDA(At, 0, 1); PG8_STAGE(PG8_SA(0, 0), a2, voffA);
            PG8_BAR; PG8_WAIT_L(0); PG8_MMA(1, 0, At, B0); PG8_BAR; PG8_SCHED;
            PG8_STAGE(PG8_SB(0, 1), b2 + hstep, voffB);
            PG8_WAIT_V(6); PG8_BAR; PG8_MMA(1, 1, At, B1); PG8_BAR;
            PG8_LDB(B0, 1, 0); PG8_SCHED; PG8_LDA(At, 1, 0); PG8_STAGE(PG8_SA(0, 1), a2 + hstep, voffA);
            PG8_WAIT_L(8); PG8_BAR; PG8_WAIT_L(0); PG8_MMA(0, 0, At, B0); PG8_BAR; PG8_SCHED;
            PG8_LDB(B1, 1, 1); PG8_STAGE(PG8_SB(1, 0), b3, voffB);
            PG8_BAR; PG8_WAIT_L(0); PG8_MMA(0, 1, At, B1); PG8_BAR;
            PG8_LDA(At, 1, 1); PG8_STAGE(PG8_SA(1, 0), a3, voffA);
            PG8_BAR; PG8_WAIT_L(0); PG8_MMA(1, 0, At, B0); PG8_BAR; PG8_SCHED;
            PG8_STAGE(PG8_SB(1, 1), b3 + hstep, voffB);
            PG8_WAIT_V(6); PG8_BAR; PG8_MMA(1, 1, At, B1); PG8_BAR;
            }
        }
        if constexpr (ALIGN_EPI) { if (wr == 0) PG8_BAR; }
        if constexpr (!Epi::AFTER_DRAIN) { E(acc, cur, wr, wc, fr, fq); S.done(cur); }
        if (!has_next) break;
#pragma unroll
        for (int a = 0; a < 2; ++a)
#pragma unroll
            for (int b = 0; b < 2; ++b)
#pragma unroll
                for (int m = 0; m < 4; ++m)
#pragma unroll
                    for (int n = 0; n < 2; ++n) acc[a][b][m][n] = (f32x4){0.f, 0.f, 0.f, 0.f};
        cur = nxt; cA = nA; cB = nB; ++ui;
        if constexpr (ALIGN_EPI) { if (wr == 1) PG8_BAR; }
    }
    PG8_WAIT_V(0);
    if constexpr (!ALIGN_EPI) { if (wr == 0) PG8_BAR; }
    PG8_BAR;
    if constexpr (Epi::AFTER_DRAIN) { E.fused(acc, cur, wr, wc, fr, fq, lds, wid, lane); S.done(cur); }
#undef PG8_SA
#undef PG8_SB
#undef PG8_STAGE
#undef PG8_LDA
#undef PG8_LDB
#undef PG8_MMA
#undef PG8_WAIT_V
#undef PG8_WAIT_L
#undef PG8_BAR
#undef PG8_SCHED
}
}

#ifndef PG8_SP2
#define PG8_SP2 true
#endif
#define PG8_ALIGN true
constexpr int NWAVES = 8;
constexpr int BATCH = 2, SEQ = 8192, DM = 1024, M = BATCH * SEQ, NIN = 3788, NINP = 3840, FFN = 2816, DEPTH = 2;
constexpr int A_Q = 0, A_K = 256, A_V = 512, A_O = 768;
constexpr int R_R = 1024, R_K = 1408, R_V = 1792, R_WDF = 2176, R_AD = 2304, R_GD = 2368;
constexpr int S_Z = 2496, S_X = 2880, S_B = 3264, S_C = 3520, S_DT = 3776;
constexpr size_t MiB = 1u << 20;
constexpr size_t WS_CTL = 0, CTL_ZERO_BYTES = 128 * 1024;
constexpr size_t WS_GATES = 1 * MiB, WS_CT = 2 * MiB, WS_DTV = 2 * MiB + 512 * 1024;
constexpr size_t WS_GUT = 31 * MiB;
constexpr size_t WS_WIN = 4 * MiB, WS_WOUT = 12 * MiB, WS_WGU = 14 * MiB, WS_WDN = 25 * MiB;
constexpr size_t WS_XN = 32 * MiB, WS_COLS = 64 * MiB, WS_Y = 184 * MiB, WS_END = 256 * MiB;
constexpr size_t Y_AF = WS_Y, Y_AB = WS_Y + 8 * MiB, Y_RF = WS_Y + 16 * MiB, Y_RB = WS_Y + 28 * MiB, Y_SF = WS_Y + 40 * MiB, Y_SB = WS_Y + 52 * MiB;
constexpr int CW_BAR = 1024;
constexpr int RING_BYTES = 131072;
constexpr int LDS_BYTES = 147456, MISC_OFF = LDS_BYTES - 256;

#define GAS __attribute__((address_space(1)))
#define LAS __attribute__((address_space(3)))
typedef unsigned short bf16;
typedef unsigned v4u __attribute__((ext_vector_type(4)));
typedef unsigned v2u __attribute__((ext_vector_type(2)));
typedef float f32x4 __attribute__((ext_vector_type(4)));
typedef short bf16x8 __attribute__((ext_vector_type(8)));
typedef GAS unsigned gu32;
#define RLX_AGENT __ATOMIC_RELAXED, __HIP_MEMORY_SCOPE_AGENT
#define LDS_WAIT() asm volatile("s_waitcnt lgkmcnt(0)" ::: "memory")
#define VM_WAIT() asm volatile("s_waitcnt vmcnt(0)" ::: "memory")
__device__ __forceinline__ unsigned f2bf(float f) { unsigned u = __builtin_bit_cast(unsigned, f); return (u + 0x7fffu + ((u >> 16) & 1u)) >> 16; }
__device__ __forceinline__ unsigned pk2(float lo, float hi) { return f2bf(lo) | (f2bf(hi) << 16); }
__device__ __forceinline__ float bf2f(unsigned u) { return __builtin_bit_cast(float, u << 16); }
__device__ __forceinline__ float sigmoidf_(float x) { return __builtin_amdgcn_rcpf(1.f + __expf(-x)); }
__device__ __forceinline__ float siluf_(float x) { return x * sigmoidf_(x); }
__device__ __forceinline__ float wave_sum(float v) {
#pragma unroll
    for (int o = 1; o < 64; o <<= 1) v += __shfl_xor(v, o);
    return v;
}
__device__ __forceinline__ float wave_max(float v) {
#pragma unroll
    for (int o = 1; o < 64; o <<= 1) v = fmaxf(v, __shfl_xor(v, o));
    return v;
}
template <int CTRL> __device__ __forceinline__ float dppf(float v) { return __builtin_bit_cast(float, __builtin_amdgcn_update_dpp(0, __builtin_bit_cast(int, v), CTRL, 0xf, 0xf, true)); }
__device__ __forceinline__ float row16_sum(float v) { v += dppf<0xB1>(v); v += dppf<0x4E>(v); v += dppf<0x141>(v); v += dppf<0x140>(v); return v; }
template <int K> __device__ __forceinline__ f32x4 mma16(const LAS bf16* A, int lda, const LAS bf16* Bt, int ldb, f32x4 acc, int lane) {
    const int r = lane & 15, q = lane >> 4;
    const LAS bf16* ap = A + r * lda + q * 8; const LAS bf16* bp = Bt + r * ldb + q * 8;
#pragma unroll
    for (int k0 = 0; k0 < K; k0 += 32) {
        const bf16x8 a = *(const LAS bf16x8*)(ap + k0); const bf16x8 b = *(const LAS bf16x8*)(bp + k0);
        acc = __builtin_amdgcn_mfma_f32_16x16x32_bf16(a, b, acc, 0, 0, 0);
    }
    return acc;
}

__device__ __forceinline__ int swz64(int row, int col) { return col ^ (((row >> 3) & 7) << 3); }
template <bool SWA, bool SWB> __device__ __forceinline__ f32x4 mma16s(const LAS bf16* A, int lda, int rowA0, const LAS bf16* Bt, int ldb, int rowB0, f32x4 acc, int lane) {
    const int r = lane & 15, q = lane >> 4; const int ra = rowA0 + r, rb = rowB0 + r;
#pragma unroll
    for (int k0 = 0; k0 < 64; k0 += 32) { const int ca = k0 + 8 * q, cb = k0 + 8 * q;
        const bf16x8 a = *(const LAS bf16x8*)(A + ra * lda + (SWA ? swz64(ra, ca) : ca)); const bf16x8 b = *(const LAS bf16x8*)(Bt + rb * ldb + (SWB ? swz64(rb, cb) : cb));
        acc = __builtin_amdgcn_mfma_f32_16x16x32_bf16(a, b, acc, 0, 0, 0); }
    return acc;
}

template <int CTRL, int RM, int BM> __device__ __forceinline__ float dppm(float oldv, float v) { return __builtin_bit_cast(float, __builtin_amdgcn_update_dpp(__builtin_bit_cast(int, oldv), __builtin_bit_cast(int, v), CTRL, RM, BM, false)); }
__device__ __forceinline__ float wave_scan_add(float x) {
    float y = x + dppm<0x111, 0xf, 0xf>(0.f, x); y += dppm<0x112, 0xf, 0xf>(0.f, x); y += dppm<0x113, 0xf, 0xf>(0.f, x);
    y += dppm<0x114, 0xf, 0xe>(0.f, y); y += dppm<0x118, 0xf, 0xc>(0.f, y);
    y += dppm<0x142, 0xa, 0xf>(0.f, y); y += dppm<0x143, 0xc, 0xf>(0.f, y);
    return y;
}
__device__ __forceinline__ float wave_scan_max(float x) {
    const float ninf = -INFINITY;
    float y = fmaxf(x, dppm<0x111, 0xf, 0xf>(ninf, x)); y = fmaxf(y, dppm<0x112, 0xf, 0xf>(ninf, x)); y = fmaxf(y, dppm<0x113, 0xf, 0xf>(ninf, x));
    y = fmaxf(y, dppm<0x114, 0xf, 0xe>(ninf, y)); y = fmaxf(y, dppm<0x118, 0xf, 0xc>(ninf, y));
    y = fmaxf(y, dppm<0x142, 0xa, 0xf>(ninf, y)); y = fmaxf(y, dppm<0x143, 0xc, 0xf>(ninf, y));
    return y;
}
__device__ __forceinline__ float row8_sum(float v) { v += dppf<0xB1>(v); v += dppf<0x4E>(v); v += dppf<0x141>(v); return v; }
#define XB_TMO      128
#define XB_XCNT(j)  (256  + 64 * (j))
#define XB_XSUB(j)  (1280 + 64 * (j))
#define XB_XGEN(j)  (2304 + 64 * (j))
#define XB_TOP      3328
#define XB_TOPGEN   3392
#define XCD_BAR_WORDS 3456
#define XB_SPIN_CAP (1u << 18)

__device__ __forceinline__ unsigned xb_ld(unsigned* p)              { return __hip_atomic_load(p, __ATOMIC_RELAXED, __HIP_MEMORY_SCOPE_AGENT); }
__device__ __forceinline__ unsigned xb_add(unsigned* p, unsigned v) { return __hip_atomic_fetch_add(p, v, __ATOMIC_RELAXED, __HIP_MEMORY_SCOPE_AGENT); }
__device__ __forceinline__ unsigned xb_xcc_id() { return (unsigned)__builtin_amdgcn_s_getreg((3 << 11) | 20) & 0xFu; }
#define XB_SPIN(cond, bar) do { unsigned _sp = 0; while (cond) { __builtin_amdgcn_s_sleep(1); \
    if ((++_sp & 255u) == 0u) { if (xb_ld(&(bar)[XB_TMO])) break; if (_sp > XB_SPIN_CAP) { atomicAdd(&(bar)[XB_TMO], 1u); break; } } } } while (0)

struct XcdBarrier {
    unsigned* bar; unsigned x;
    volatile LAS unsigned* st;
};

__device__ __forceinline__ XcdBarrier xcd_barrier_post(unsigned* bar, volatile LAS unsigned* st) {
    XcdBarrier b; b.bar = bar; b.x = xb_xcc_id(); b.st = st;
    if (threadIdx.x == 0) (void)xb_add(&bar[XB_XCNT(b.x)], 1u);
    return b;
}
__device__ __forceinline__ void xcd_barrier_complete(unsigned* bar, unsigned x, unsigned& nloc, unsigned& nx) {
    const unsigned G = gridDim.x * gridDim.y * gridDim.z;
    unsigned sum, cnt, mine, sp = 0u;
    for (;;) {
        sum = 0u; cnt = 0u; mine = 0u;
#pragma unroll
        for (unsigned j = 0; j < 16; ++j) { const unsigned c = xb_ld(&bar[XB_XCNT(j)]); sum += c; cnt += (c > 0u) ? 1u : 0u; mine = (j == x) ? c : mine; }
        if (sum == G) break;
        __builtin_amdgcn_s_sleep(1);
        if ((++sp & 255u) == 0u) { if (xb_ld(&bar[XB_TMO])) break; if (sp > XB_SPIN_CAP) { atomicAdd(&bar[XB_TMO], 1u); break; } }
    }
    nloc = mine > 0u ? mine : 1u; nx = cnt > 0u ? cnt : 1u;
}

__device__ __forceinline__ void xcd_barrier(const XcdBarrier& b) {
    asm volatile("s_waitcnt vmcnt(0)" ::: "memory");
    __syncthreads();
    if (threadIdx.x == 0) {
        unsigned* bar = b.bar;
        __builtin_amdgcn_s_waitcnt(0);
        unsigned nloc = b.st[0], nx = b.st[1];
        if (nloc == 0u) { xcd_barrier_complete(bar, b.x, nloc, nx); b.st[0] = nloc; b.st[1] = nx; }
        const unsigned old = xb_add(&bar[XB_XSUB(b.x)], 1u);
        const unsigned gen = old / nloc;
        if (old + 1u == (gen + 1u) * nloc) {
            __builtin_amdgcn_fence(__ATOMIC_RELEASE, "agent");
            asm volatile("s_waitcnt vmcnt(0)" ::: "memory");
            const unsigned og = xb_add(&bar[XB_TOP], 1u);
            const unsigned tg = og / nx;
            if (og + 1u == (tg + 1u) * nx) xb_add(&bar[XB_TOPGEN], 1u);
            else XB_SPIN(xb_ld(&bar[XB_TOPGEN]) == tg, bar);
            __builtin_amdgcn_fence(__ATOMIC_ACQUIRE, "agent");
            xb_add(&bar[XB_XGEN(b.x)], 1u);
            asm volatile("s_waitcnt vmcnt(0)" ::: "memory");
        } else {
            XB_SPIN(xb_ld(&bar[XB_XGEN(b.x)]) == gen, bar);
            __builtin_amdgcn_fence(__ATOMIC_ACQUIRE, "agent");
            asm volatile("s_waitcnt vmcnt(0)" ::: "memory");
        }
    }
    __syncthreads();
}
struct Frame {
    LAS unsigned char* lds;
    int tid, lane, wave, vcu, G;
};
struct Args { const float* in[32]; float* out; unsigned char* ws; int ph_lo, ph_hi; };
constexpr int PTAB_OFF = LDS_BYTES - 768;
__device__ __forceinline__ unsigned long long ptab_ld(const Frame& F, int i) {
    const unsigned long long v = *(volatile LAS unsigned long long*)(F.lds + PTAB_OFF + 8 * i);
    const unsigned lo = __builtin_amdgcn_readfirstlane((unsigned)v), hi = __builtin_amdgcn_readfirstlane((unsigned)(v >> 32));
    return ((unsigned long long)hi << 32) | lo;
}
__device__ __forceinline__ const GAS float* INP(const Frame& F, int i) { return (const GAS float*)ptab_ld(F, i); }
__device__ __forceinline__ GAS unsigned char* WSP(const Frame& F) { return (GAS unsigned char*)ptab_ld(F, 33); }
__device__ __forceinline__ GAS float* OUTP(const Frame& F) { return (GAS float*)ptab_ld(F, 32); }
__device__ __forceinline__ void transpose_item(const GAS float* W, int K, int N, int nblk, GAS bf16* WT, int mode, int row_off, LAS float* scr, int item, int lane) {
    const int kb = item / nblk, nb = item % nblk, k0 = 64 * kb, n0 = 32 * nb;
    const int ncol = n0 + (lane & 31); const bool ok = ncol < N;
#pragma unroll 8
    for (int i = 0; i < 32; ++i) { const int kk = 2 * i + (lane >> 5); scr[kk * 33 + (lane & 31)] = ok ? W[(size_t)(k0 + kk) * N + ncol] : 0.f; }
    LDS_WAIT(); asm volatile("" ::: "memory");
    const int c = lane & 7;
    const int drow0 = mode ? (256 * (n0 >> 7) + (n0 & 127) + row_off) : (row_off + n0);
#pragma unroll
    for (int j = 0; j < 4; ++j) { const int n = (lane >> 3) + 8 * j; const LAS float* s = scr + (8 * c) * 33 + n;
        v4u o; o.x = pk2(s[0 * 33], s[1 * 33]); o.y = pk2(s[2 * 33], s[3 * 33]); o.z = pk2(s[4 * 33], s[5 * 33]); o.w = pk2(s[6 * 33], s[7 * 33]);
        *(GAS v4u*)(WT + (size_t)(drow0 + n) * K + k0 + 8 * c) = o; }
    LDS_WAIT(); asm volatile("" ::: "memory");
}
__device__ __forceinline__ void phase_convert(const Frame& F, int l) {
    LAS float* scr = (LAS float*)(F.lds + F.wave * 16384);
    const int gw = F.vcu * NWAVES + F.wave, NGW = F.G * NWAVES;
    GAS bf16* Win = (GAS bf16*)(WSP(F) + WS_WIN); GAS bf16* Wout = (GAS bf16*)(WSP(F) + WS_WOUT); GAS bf16* Wgu = (GAS bf16*)(WSP(F) + WS_WGU); GAS bf16* Wdn = (GAS bf16*)(WSP(F) + WS_WDN);
    constexpr int I_IN = 16 * 120, I_OUT = 16 * 32, I_G = 16 * 88, I_D = 44 * 32, I_GU = 2 * 12;
    constexpr int NITEMS = I_IN + I_OUT + 2 * I_G + I_D + I_GU;
    for (int it = gw; it < NITEMS; it += NGW) {
        int r = it;
        if (r < I_IN) { transpose_item(INP(F, 2) + (size_t)l * DM * NIN, DM, NIN, 120, Win, 0, 0, scr, r, F.lane); continue; } r -= I_IN;
        if (r < I_OUT) { transpose_item(INP(F, 26) + (size_t)l * DM * DM, DM, DM, 32, Wout, 0, 0, scr, r, F.lane); continue; } r -= I_OUT;
        if (r < I_G) { transpose_item(INP(F, 28) + (size_t)l * DM * FFN, DM, FFN, 88, Wgu, 1, 0, scr, r, F.lane); continue; } r -= I_G;
        if (r < I_G) { transpose_item(INP(F, 29) + (size_t)l * DM * FFN, DM, FFN, 88, Wgu, 1, 128, scr, r, F.lane); continue; } r -= I_G;
        if (r < I_D) { transpose_item(INP(F, 30) + (size_t)l * FFN * DM, FFN, DM, 32, Wdn, 0, 0, scr, r, F.lane); continue; } r -= I_D;
        transpose_item(INP(F, 14) + (size_t)l * 128 * 384, 128, 384, 12, (GAS bf16*)(WSP(F) + WS_GUT), 0, 0, scr, r, F.lane);
    }
}
__device__ __forceinline__ void phase_norm(const Frame& F, const GAS float* hin, const GAS float* g, GAS bf16* XN) {
    const int gw = F.vcu * NWAVES + F.wave, NGW = F.G * NWAVES;
    f32x4 gv[4];
#pragma unroll
    for (int j = 0; j < 4; ++j) gv[j] = ((const GAS f32x4*)g)[64 * j + F.lane];
    for (int m = gw; m < M; m += NGW) {
        const GAS f32x4* xr = (const GAS f32x4*)(hin + (size_t)m * DM) + F.lane;
        f32x4 v[4]; float s = 0.f;
#pragma unroll
        for (int j = 0; j < 4; ++j) { v[j] = xr[64 * j]; s += (v[j].x * v[j].x + v[j].y * v[j].y) + (v[j].z * v[j].z + v[j].w * v[j].w); }
        const float r = __builtin_amdgcn_rsqf(wave_sum(s) * (1.f / DM) + 1e-6f);
        GAS v2u* o8 = (GAS v2u*)(XN + (size_t)m * DM) + F.lane;
#pragma unroll
        for (int j = 0; j < 4; ++j) { v2u w; w.x = pk2(v[j].x * r * gv[j].x, v[j].y * r * gv[j].y); w.y = pk2(v[j].z * r * gv[j].z, v[j].w * r * gv[j].w); o8[64 * j] = w; }
    }
}
__device__ __forceinline__ void phase_final_norm(const Frame& F, GAS float* h, const GAS float* g) {
    const int gw = F.vcu * NWAVES + F.wave, NGW = F.G * NWAVES;
    f32x4 gv[4];
#pragma unroll
    for (int j = 0; j < 4; ++j) gv[j] = ((const GAS f32x4*)g)[64 * j + F.lane];
    for (int m = gw; m < M; m += NGW) {
        GAS f32x4* xr = (GAS f32x4*)(h + (size_t)m * DM) + F.lane;
        f32x4 v[4]; float s = 0.f;
#pragma unroll
        for (int j = 0; j < 4; ++j) { v[j] = xr[64 * j]; s += (v[j].x * v[j].x + v[j].y * v[j].y) + (v[j].z * v[j].z + v[j].w * v[j].w); }
        const float r = __builtin_amdgcn_rsqf(wave_sum(s) * (1.f / DM) + 1e-6f);
#pragma unroll
        for (int j = 0; j < 4; ++j) xr[64 * j] = v[j] * r * gv[j];
    }
}
__device__ __forceinline__ void phase_gates(const Frame& F, int l) {
    const GAS bf16* cols = (const GAS bf16*)(WSP(F) + WS_COLS); GAS float* GT = (GAS float*)(WSP(F) + WS_GATES);
    LAS bf16* raw = (LAS bf16*)(F.lds);
    LAS bf16* featb = (LAS bf16*)(F.lds + 30720);
    LAS bf16* gwT = (LAS bf16*)(F.lds + 55552);
    LAS float* outp = (LAS float*)(F.lds + 80384);
    const GAS float* gwg = INP(F, 5) + (size_t)l * 768 * 16; const GAS float* gb = INP(F, 6) + l * 16;
    const int tid = F.tid, lane = F.lane, wave = F.wave;
    __syncthreads();
    for (int i = tid; i < 768 * 16; i += 512) gwT[(i & 15) * 776 + (i >> 4)] = (bf16)f2bf(gwg[i]);
    float cw[5]; { const GAS float* cwp = INP(F, 3) + (size_t)l * 5 * 512;
#pragma unroll
        for (int j = 0; j < 5; ++j) cw[j] = cwp[j * 512 + tid]; }
    const float cbv = INP(F, 4)[l * 512 + tid];
    const float gbv = gb[tid & 15];
    for (int tile = F.vcu; tile < M / 16; tile += F.G) {
        const int m0 = tile * 16, t0 = m0 % SEQ;
        __syncthreads();
        for (int ch = tid; ch < 20 * 96; ch += 512) { const int rr = ch / 96, cc = ch % 96; const int t = t0 - 2 + rr;
            v4u v = {0u, 0u, 0u, 0u}; if (t >= 0 && t < SEQ) v = *(const GAS v4u*)(cols + (size_t)(m0 - 2 + rr) * NINP + cc * 8);
            *(LAS v4u*)(raw + rr * 768 + cc * 8) = v; }
        if (tid < 256) outp[tid] = 0.f;
        __syncthreads();
        { float win[5];
#pragma unroll
          for (int j = 0; j < 4; ++j) win[j] = bf2f(raw[j * 768 + tid]);
#pragma unroll 4
          for (int t = 0; t < 16; ++t) { win[4] = bf2f(raw[(t + 4) * 768 + tid]); float s = cbv;
#pragma unroll
              for (int j = 0; j < 5; ++j) s += cw[j] * win[j];
#pragma unroll
              for (int j = 0; j < 4; ++j) win[j] = win[j + 1];
              featb[t * 776 + tid] = (bf16)f2bf(siluf_(s)); }
          const int t = tid >> 5, c8 = tid & 31; *(LAS v4u*)(featb + t * 776 + 512 + c8 * 8) = *(const LAS v4u*)(raw + (t + 2) * 768 + 512 + c8 * 8); }
        __syncthreads();
        { const f32x4 z = {0.f, 0.f, 0.f, 0.f}; const f32x4 acc = mma16<96>(featb + 96 * wave, 776, gwT + 96 * wave, 776, z, lane);
#pragma unroll
          for (int jj = 0; jj < 4; ++jj) __hip_atomic_fetch_add(outp + ((lane >> 4) * 4 + jj) * 16 + (lane & 15), acc[jj], __ATOMIC_RELAXED, __HIP_MEMORY_SCOPE_WORKGROUP); }
        __syncthreads();
        if (tid < 256) { float s = outp[tid] + gbv; if ((tid & 15) >= 8) s = fminf(s, 0.f) - log1pf(__expf(-fabsf(s))); GT[(size_t)(m0 + (tid >> 4)) * 16 + (tid & 15)] = s; }
    }
    __syncthreads();
}
__device__ __forceinline__ f32x4 mma16_a8(const LAS bf16* A8, const LAS bf16* Bt, f32x4 acc, int lane) {
    const int q = lane >> 4;
    const LAS bf16* ap = A8 + (lane & 7) * 72 + q * 8; const LAS bf16* bp = Bt + (lane & 15) * 72 + q * 8;
#pragma unroll
    for (int k0 = 0; k0 < 64; k0 += 32) { const bf16x8 a = *(const LAS bf16x8*)(ap + k0); const bf16x8 b = *(const LAS bf16x8*)(bp + k0); acc = __builtin_amdgcn_mfma_f32_16x16x32_bf16(a, b, acc, 0, 0, 0); }
    return acc;
}
typedef float f32x2 __attribute__((ext_vector_type(2)));
template <bool DIR> __device__ __forceinline__ void rwkv_steps(const LAS float* OPS, const LAS float* VV, LAS float* YB, f32x4& S, int j, int row) {
    float yk0 = 0.f, yk1 = 0.f;
    const LAS float* opb = OPS + 4 * j; const LAS float* vpb = VV + row;
#define RWLD(W_, KK_, KA_, KM_, R_, V_, tl_) do { const LAS float* op_ = opb + (tl_) * 320; W_ = *(const LAS f32x4*)(op_); KK_ = *(const LAS f32x4*)(op_ + 64); KA_ = *(const LAS f32x4*)(op_ + 128); KM_ = *(const LAS f32x4*)(op_ + 192); R_ = *(const LAS f32x4*)(op_ + 256); V_ = vpb[(tl_) * 16]; } while (0)
    f32x4 w4, kk4, ka4, km4, r4, w4b, kk4b, ka4b, km4b, r4b; float vv, vvb;
    RWLD(w4, kk4, ka4, km4, r4, vv, (DIR ? 31 : 0));
    RWLD(w4b, kk4b, ka4b, km4b, r4b, vvb, (DIR ? 30 : 1));
#pragma unroll
    for (int i = 0; i < 32; ++i) {
        f32x4 nw4, nkk4, nka4, nkm4, nr4; float nvv;
        if (i < 30) RWLD(nw4, nkk4, nka4, nkm4, nr4, nvv, (DIR ? 29 - i : i + 2));
        f32x2 t2 = S.xy * kk4.xy; t2 = S.zw * kk4.zw + t2;
        float sa = t2.x + t2.y;
        const f32x4 pre_s = S * w4 + km4 * vv;
        sa = row16_sum(sa);
        S = pre_s + ka4 * sa;
        f32x2 y2 = S.xy * r4.xy; y2 = S.zw * r4.zw + y2;
        float y = y2.x + y2.y;
        y = row16_sum(y);
        if ((i & 15) == j) { if (i < 16) yk0 = y; else yk1 = y; }
        w4 = w4b; kk4 = kk4b; ka4 = ka4b; km4 = km4b; r4 = r4b; vv = vvb;
        if (i < 30) { w4b = nw4; kk4b = nkk4; ka4b = nka4; km4b = nkm4; r4b = nr4; vvb = nvv; } }
#undef RWLD
    YB[(DIR ? 31 - j : j) * 16 + row] = yk0; YB[(DIR ? 15 - j : 16 + j) * 16 + row] = yk1;
}
struct RwCtx { LAS bf16* WA; LAS bf16* WW; LAS bf16* XA; LAS bf16* XW; LAS bf16* RAWB; LAS float* MU; GAS float* CT; const GAS bf16* colsb;
    f32x4 kk_c4, ka_c4, rk_c4; float ba[4], bw[4]; float mup_[5][2], mun_[5][2]; int h, dir, qtr, tb0; size_t mb; };
template <int NTOK> __device__ __forceinline__ void rw_addr_init(int (&poff)[5], int (&prr)[5], int lane, int tb0, int h, int dir) {
    constexpr int NCHK = (NTOK + 2) * 40;
#pragma unroll
    for (int i = 0; i < 5; ++i) { const int idx = lane + 64 * i; const int rr = idx / 40, q = idx % 40, wh = q >> 3, c8 = q & 7;
        const int gc = (wh == 0 ? R_R + h * 64 : wh == 1 ? R_K + h * 64 : wh == 2 ? R_V + h * 64 : wh == 3 ? R_WDF + dir * 64 : R_AD) + c8 * 8;
        prr[i] = idx < NCHK ? tb0 - 1 + rr : -100000; poff[i] = (tb0 - 1 + rr) * NINP + gc; }
}
template <int NTOK> __device__ __forceinline__ void rw_issue(v4u (&pre)[5], const int (&poff)[5], const int (&prr)[5], const GAS bf16* colsb, int T0) {
    constexpr int NCH = ((NTOK + 2) * 40 + 63) / 64;
#pragma unroll
    for (int i = 0; i < NCH; ++i) { const int t = T0 + prr[i]; const bool ok = t >= 0 && t < SEQ;
        const v4u vv = *(const GAS v4u*)(colsb + (size_t)T0 * NINP + (ok ? poff[i] : 0)); pre[i] = ok ? vv : (v4u){0u, 0u, 0u, 0u}; }
}
template <int NTOK, bool FULLV> __device__ __forceinline__ void rw_prep(const RwCtx& C, const v4u (&pre)[5], LAS float* OPS, LAS float* VV, int T0, int lane) {
    constexpr int NCHK = (NTOK + 2) * 40, NCH = (NCHK + 63) / 64;
    const int j = lane & 15, c2 = (lane & 31) * 2;
#pragma unroll
    for (int i = 0; i < NCH; ++i) { const int idx = lane + 64 * i; if (idx < NCHK) *(LAS v4u*)(C.RAWB + idx * 8) = pre[i]; }
    LDS_WAIT(); asm volatile("" ::: "memory");
#pragma unroll
    for (int which = 0; which < 5; ++which)
#pragma unroll
        for (int pr = 0; pr < NTOK / 2; ++pr) { const int tt = 2 * pr + (lane >> 5), cc = which * 64 + c2, t = C.tb0 + tt;
            const unsigned r0 = *(const LAS unsigned*)(C.RAWB + tt * 320 + cc), r1 = *(const LAS unsigned*)(C.RAWB + (tt + 1) * 320 + cc), r2 = *(const LAS unsigned*)(C.RAWB + (tt + 2) * 320 + cc);
            const float p1x = bf2f(r1 & 0xffffu), p1y = bf2f(r1 >> 16);
            const float vx = p1x + C.mup_[which][0] * (bf2f(r0 & 0xffffu) - p1x) + C.mun_[which][0] * (bf2f(r2 & 0xffffu) - p1x);
            const float vy = p1y + C.mup_[which][1] * (bf2f(r0 >> 16) - p1y) + C.mun_[which][1] * (bf2f(r2 >> 16) - p1y);
            if (which == 0) *(LAS f32x2*)(OPS + t * 320 + 256 + c2) = (f32x2){vx, vy};
            else if (which == 1) *(LAS f32x2*)(OPS + t * 320 + 192 + c2) = (f32x2){vx, vy};
            else if (which == 2) { if (FULLV) *(LAS f32x2*)(VV + t * 64 + c2) = (f32x2){vx, vy}; else if ((c2 >> 4) == C.qtr) *(LAS f32x2*)(VV + t * 16 + (c2 & 15)) = (f32x2){vx, vy}; }
            else if (which == 3) { const float ex = __expf(2.f * vx), ey = __expf(2.f * vy);
                *(LAS unsigned*)(C.XW + tt * 72 + c2) = pk2(1.f - 2.f * __builtin_amdgcn_rcpf(ex + 1.f), 1.f - 2.f * __builtin_amdgcn_rcpf(ey + 1.f)); }
            else *(LAS unsigned*)(C.XA + tt * 72 + c2) = pk2(vx, vy); }
    LDS_WAIT(); asm volatile("" ::: "memory");
    { const bool hi = lane >= 32; const int lr = ((lane >> 4) & 1) * 4 + (hi ? 2 : 0); const bool ok0 = lr < NTOK, ok1 = lr + 1 < NTOK; const int tb = C.tb0 + lr;
#pragma unroll
      for (int ct = 0; ct < 4; ++ct) { const f32x4 z = {0.f, 0.f, 0.f, 0.f};
        const f32x4 ca = mma16_a8(C.XA, C.WA + ct * 16 * 72, z, lane), cw = mma16_a8(C.XW, C.WW + ct * 16 * 72, z, lane);
        const int c = ct * 16 + j;
        const float a0v = hi ? ca[2] : ca[0], a1v = hi ? ca[3] : ca[1], w0v = hi ? cw[2] : cw[0], w1v = hi ? cw[3] : cw[1];
        if (ok0) { OPS[tb * 320 + 128 + c] = sigmoidf_(C.ba[ct] + a0v); OPS[tb * 320 + c] = __expf(-0.6065306597f * sigmoidf_(C.bw[ct] + w0v)); }
        if (ok1) { OPS[(tb + 1) * 320 + 128 + c] = sigmoidf_(C.ba[ct] + a1v); OPS[(tb + 1) * 320 + c] = __expf(-0.6065306597f * sigmoidf_(C.bw[ct] + w1v)); } } }
    LDS_WAIT(); asm volatile("" ::: "memory");
#pragma unroll
    for (int ps = 0; ps < (NTOK + 3) / 4; ++ps) { const int tl = 4 * ps + (lane >> 4); const bool ok = tl < NTOK; const int t = C.tb0 + (ok ? tl : 0); LAS float* op = OPS + t * 320 + 4 * j;
        const f32x4 av = *(const LAS f32x4*)(op + 128), kp = *(const LAS f32x4*)(op + 192), rp = *(const LAS f32x4*)(op + 256);
        const f32x4 kr = kp * C.kk_c4; const float ss = row16_sum((kr.x * kr.x + kr.y * kr.y) + (kr.z * kr.z + kr.w * kr.w));
        const f32x4 kkv = kr * __builtin_amdgcn_rcpf(fmaxf(__builtin_amdgcn_sqrtf(ss), 1e-12f));
        const f32x4 km = kp * ((av - 1.f) * C.ka_c4 + 1.f);
        const f32x4 q = rp * km * C.rk_c4; const float cs = row16_sum((q.x + q.y) + (q.z + q.w));
        if (ok) { *(LAS f32x4*)(op + 64) = kkv; *(LAS f32x4*)(op + 128) = kkv * (-av); *(LAS f32x4*)(op + 192) = km;
            if (C.dir == 0 && C.qtr == 0 && j == 0) C.CT[(C.mb + T0 + t) * 8 + C.h] = cs; } }
}

constexpr int RW_NSLOT = 6, RW_SLOT_WORDS = 32 * 320 + 32 * 64;
constexpr size_t WS_RING = 248 * MiB;
constexpr int CW_RW = 8192;
__device__ __forceinline__ unsigned rw_ld(GAS unsigned* p) { return __hip_atomic_load(p, __ATOMIC_RELAXED, __HIP_MEMORY_SCOPE_AGENT); }
__device__ __forceinline__ void rw_st(GAS unsigned* p, unsigned v) { __hip_atomic_store(p, v, __ATOMIC_RELAXED, __HIP_MEMORY_SCOPE_AGENT); }
__device__ __forceinline__ void rwkv_produce(const Frame& F, int l, int p, int pp, unsigned G0) {
    const int b = p / 12, rem = p % 12, h = rem >> 1, dir = rem & 1;
    const GAS bf16* cols = (const GAS bf16*)(WSP(F) + WS_COLS);
    const int tid = F.tid, lane = F.lane, wave = F.wave;
    LAS bf16* WA = (LAS bf16*)(F.lds); LAS bf16* WW = (LAS bf16*)(F.lds + 9216);
    LAS float* MU = (LAS float*)(F.lds + 67584);
    LAS float* OPS = (LAS float*)(F.lds + 70144);
    LAS float* VV = (LAS float*)(F.lds + 111104);
    LAS unsigned* flg = (LAS unsigned*)(F.lds + 119296);
    GAS unsigned* ctl = (GAS unsigned*)(WSP(F) + WS_CTL) + CW_RW + 384 * p;
    GAS unsigned long long* ring = (GAS unsigned long long*)(WSP(F) + WS_RING) + (size_t)p * RW_NSLOT * (RW_SLOT_WORDS / 2);
    constexpr int NB = SEQ / 32;
    __syncthreads();
    { const GAS float* aup = INP(F, 13) + (size_t)l * 64 * 384; const GAS float* wup = INP(F, 11) + (size_t)(l * 2 + dir) * 64 * 384;
      for (int idx = tid; idx < 4096; idx += 512) { const int i = idx >> 6, c = idx & 63;
          WA[c * 72 + i] = (bf16)f2bf(aup[i * 384 + h * 64 + c]); WW[c * 72 + i] = (bf16)f2bf(wup[i * 384 + h * 64 + c]); }
      if (tid < 320) { const int which = tid >> 6, c = tid & 63;
          const int rc = which == 0 ? h * 64 + c : which == 1 ? 384 + h * 64 + c : which == 2 ? 768 + h * 64 + c : which == 3 ? 1152 + dir * 64 + c : 1280 + c;
          MU[tid] = INP(F, 8)[l * 1472 + rc]; MU[320 + tid] = INP(F, 9)[l * 1472 + rc]; } }
    __syncthreads();
    const size_t mb = (size_t)b * SEQ;
    const int j = lane & 15;
    RwCtx C;
    C.WA = WA; C.WW = WW; C.XA = (LAS bf16*)(F.lds + 18432) + wave * 576; C.XW = (LAS bf16*)(F.lds + 27648) + wave * 576;
    C.RAWB = (LAS bf16*)(F.lds + 36864) + wave * 1920;
    C.MU = MU; C.CT = (GAS float*)(WSP(F) + WS_CT); C.colsb = cols + mb * NINP; C.h = h; C.dir = dir; C.qtr = 0; C.mb = mb; C.tb0 = 4 * wave;
    { const int hc4 = h * 64 + 4 * j;
      C.kk_c4 = *(const GAS f32x4*)(INP(F, 15) + l * 384 + hc4); C.ka_c4 = *(const GAS f32x4*)(INP(F, 16) + l * 384 + hc4); C.rk_c4 = *(const GAS f32x4*)(INP(F, 17) + l * 384 + hc4);
#pragma unroll
      for (int ct = 0; ct < 4; ++ct) { C.ba[ct] = INP(F, 12)[l * 384 + h * 64 + 16 * ct + j]; C.bw[ct] = INP(F, 10)[(l * 2 + dir) * 384 + h * 64 + 16 * ct + j]; }
      const int c2 = (lane & 31) * 2;
#pragma unroll
      for (int wq = 0; wq < 5; ++wq) { C.mup_[wq][0] = MU[wq * 64 + c2]; C.mup_[wq][1] = MU[wq * 64 + c2 + 1]; C.mun_[wq][0] = MU[320 + wq * 64 + c2]; C.mun_[wq][1] = MU[320 + wq * 64 + c2 + 1]; } }
    v4u pre[5]; int poff[5], prr[5];
    rw_addr_init<4>(poff, prr, lane, C.tb0, h, dir);
    rw_issue<4>(pre, poff, prr, C.colsb, dir ? SEQ - 32 * (pp + 1) : 32 * pp);
    bool dead = false; unsigned mseen = G0;
    GAS unsigned* myflag = ctl + 320 * pp; const unsigned PB = G0 / 2;
#pragma unroll 1
    for (int it = pp; it < NB; it += 2) {
        const int T0 = dir ? SEQ - 32 * (it + 1) : 32 * it;
        v4u cur[5];
#pragma unroll
        for (int i = 0; i < 5; ++i) cur[i] = pre[i];
        if (it + 2 < NB) rw_issue<4>(pre, poff, prr, C.colsb, dir ? SEQ - 32 * (it + 3) : 32 * (it + 2));
        rw_prep<4, true>(C, cur, OPS, VV, T0, lane);
        if (tid == 0) { const unsigned need = G0 + (unsigned)it + 1u; unsigned sp = 0u;
            if (need > (unsigned)RW_NSLOT && !dead) { const unsigned want = need - (unsigned)RW_NSLOT;
                while (mseen < want) { if (++sp > (1u << 17)) { dead = true; break; } __builtin_amdgcn_s_sleep(2);
                    const unsigned m01 = min(rw_ld(ctl + 64), rw_ld(ctl + 128)), m23 = min(rw_ld(ctl + 192), rw_ld(ctl + 256)); mseen = min(m01, m23); } }
            flg[0] = sp; }
        __syncthreads();
        { GAS unsigned long long* slot = ring + (size_t)((G0 + (unsigned)it) % RW_NSLOT) * (RW_SLOT_WORDS / 2);
          const LAS v4u* src = (const LAS v4u*)OPS;
#pragma unroll
          for (int i = 0; i < 6; ++i) { const int idx = tid + 512 * i; const v4u d = src[idx]; GAS v4u* dst = (GAS v4u*)slot + idx;
              asm volatile("global_store_dwordx4 %0, %1, off sc1\n\ts_nop 1" :: "v"(dst), "v"(d) : "memory"); } }
        asm volatile("s_waitcnt vmcnt(10)" ::: "memory");
        __syncthreads();
        if (tid == 0 && it >= 2) rw_st(myflag, PB + (unsigned)(it >> 1));
    }
    asm volatile("s_waitcnt vmcnt(0)" ::: "memory");
    __syncthreads();
    if (tid == 0) rw_st(myflag, PB + (unsigned)(NB / 2));
    __syncthreads();
}
__device__ __forceinline__ void rwkv_scan(const Frame& F, int l, int p, int qtr, unsigned G0) {
    const int b = p / 12, rem = p % 12, h = rem >> 1, dir = rem & 1;
    GAS bf16* Y = (GAS bf16*)(WSP(F) + (dir ? Y_RB : Y_RF));
    const int lane = F.lane, wave = F.wave;
    LAS float* OPSb = (LAS float*)(F.lds);
    LAS float* VVb = (LAS float*)(F.lds + 81920);
    LAS float* YBb = (LAS float*)(F.lds + 86016);
    GAS unsigned* ctl = (GAS unsigned*)(WSP(F) + WS_CTL) + CW_RW + 384 * p;
    const GAS unsigned long long* ring = (const GAS unsigned long long*)(WSP(F) + WS_RING) + (size_t)p * RW_NSLOT * (RW_SLOT_WORDS / 2);
    constexpr int NB = SEQ / 32;
    const size_t mb = (size_t)b * SEQ;
    const int j = lane & 15;
    __syncthreads();
    if (wave < 4) {
        const int lt = wave * 64 + lane;
        bool dead = false; unsigned pseen0 = G0 / 2, pseen1 = G0 / 2;
        unsigned long long va[21], vb[21];
#define RW_FETCH(v_, k_) do { const unsigned need_ = G0 / 2 + (unsigned)((k_) >> 1) + 1u; unsigned sp_ = 0u; GAS unsigned* fl_ = ctl + 320 * ((k_) & 1); \
            if (!dead) { unsigned ps_ = ((k_) & 1) ? pseen1 : pseen0; while (ps_ < need_) { ps_ = rw_ld(fl_); if (ps_ >= need_) break; if (++sp_ > (1u << 17)) { dead = true; break; } __builtin_amdgcn_s_sleep(2); } if ((k_) & 1) pseen1 = ps_; else pseen0 = ps_; } \
            const GAS unsigned long long* slot_ = ring + (size_t)((G0 + (unsigned)(k_)) % RW_NSLOT) * (RW_SLOT_WORDS / 2); \
            _Pragma("unroll") for (int i_ = 0; i_ < 20; ++i_) v_[i_] = __hip_atomic_load(slot_ + lt + 256 * i_, __ATOMIC_RELAXED, __HIP_MEMORY_SCOPE_AGENT); \
            v_[20] = __hip_atomic_load(slot_ + 5120 + (lt >> 3) * 32 + qtr * 8 + (lt & 7), __ATOMIC_RELAXED, __HIP_MEMORY_SCOPE_AGENT); } while (0)
#define RW_LITER(v_, k_) do { if ((k_) >= 1 && lt == 0) rw_st(ctl + 64 * (qtr + 1), G0 + (unsigned)(k_)); \
            if ((k_) < NB) { LAS unsigned long long* dO_ = (LAS unsigned long long*)(OPSb + ((k_) & 1) * 10240); LAS unsigned long long* dV_ = (LAS unsigned long long*)(VVb + ((k_) & 1) * 512); \
                _Pragma("unroll") for (int i_ = 0; i_ < 20; ++i_) dO_[lt + 256 * i_] = v_[i_]; dV_[lt] = v_[20]; \
                if ((k_) + 2 < NB) RW_FETCH(v_, (k_) + 2); } \
            if ((k_) >= 2) { const int bk_ = (k_) - 2; const int T0_ = dir ? SEQ - 32 * (bk_ + 1) : 32 * bk_; const LAS float* YB_ = YBb + (bk_ & 1) * 512; \
                const int idx_ = lt * 2, tl_ = idx_ >> 4, rw_ = idx_ & 15; \
                *(GAS unsigned*)(Y + (mb + T0_ + tl_) * 384 + h * 64 + 16 * qtr + rw_) = pk2(YB_[idx_], YB_[idx_ + 1]); } \
            __syncthreads(); } while (0)
        RW_FETCH(va, 0); RW_FETCH(vb, 1);
#pragma unroll 1
        for (int it = 0; it < NB; it += 2) { RW_LITER(va, it); RW_LITER(vb, it + 1); }
        RW_LITER(va, NB);
#undef RW_FETCH
#undef RW_LITER
        { const int bk = NB - 1; const int T0 = dir ? SEQ - 32 * (bk + 1) : 32 * bk; const LAS float* YB = YBb + (bk & 1) * 512;
          const int idx = lt * 2, tl = idx >> 4, rw = idx & 15;
          *(GAS unsigned*)(Y + (mb + T0 + tl) * 384 + h * 64 + 16 * qtr + rw) = pk2(YB[idx], YB[idx + 1]); }
    } else {
        const int row = (wave - 4) * 4 + (lane >> 4);
        f32x4 S = {0.f, 0.f, 0.f, 0.f};
        __builtin_amdgcn_s_setprio(3);
#pragma unroll 1
        for (int it = 0; it <= NB; ++it) {
            if (it >= 1) { const int bk = it - 1;
                const LAS float* OPS = OPSb + (bk & 1) * 10240; const LAS float* VV = VVb + (bk & 1) * 512; LAS float* YB = YBb + (bk & 1) * 512;
                if (dir) rwkv_steps<true>(OPS, VV, YB, S, j, row); else rwkv_steps<false>(OPS, VV, YB, S, j, row);
            }
            __syncthreads();
        }
        __builtin_amdgcn_s_setprio(0);
    }
    __syncthreads();
}
__device__ __forceinline__ void mlstm_seq(const Frame& F, int l, int task, int cfull0, int cend) {
    const int b = task >> 3, h = (task >> 1) & 3, dir = task & 1;
    const GAS bf16* cols = (const GAS bf16*)(WSP(F) + WS_COLS); const GAS float* GT = (const GAS float*)(WSP(F) + WS_GATES);
    GAS bf16* Y = (GAS bf16*)(WSP(F) + (dir ? Y_AB : Y_AF));
    LAS bf16* RAWQ = (LAS bf16*)(F.lds);
    LAS bf16* Qs = (LAS bf16*)(F.lds + 17408); LAS bf16* Ks = (LAS bf16*)(F.lds + 26624);
    LAS bf16* Vtb = (LAS bf16*)(F.lds + 35840);
    LAS bf16* KWt = (LAS bf16*)(F.lds + 54272); LAS bf16* Ps = (LAS bf16*)(F.lds + 63488);
    LAS bf16* Ctb = (LAS bf16*)(F.lds + 72704);
    LAS float* ub = (LAS float*)(F.lds + 91136);
    LAS float* blb = ub + 128; LAS float* rmb = ub + 256;
    LAS float* den = ub + 384; LAS float* qn = ub + 448; LAS float* nst = ub + 512; LAS float* scb = ub + 576;
    const int tid = F.tid, lane = F.lane, wave = F.wave;
    const size_t mb = (size_t)b * SEQ;
    constexpr int NC = SEQ / 64;
    __syncthreads();
    for (int i = tid; i < 2 * 64 * 72; i += 512) Ctb[i] = 0;
    if (tid < 64) nst[tid] = 0.f;
    const int cc = tid & 127, isK = cc >> 6, d0 = cc & 63, chn = isK * 256 + h * 64 + d0;
    float cw[5]; const GAS float* cwp = INP(F, 3) + (size_t)l * 5 * 512;
#pragma unroll
    for (int jj = 0; jj < 5; ++jj) cw[jj] = cwp[jj * 512 + chn];
    const float cbv = INP(F, 4)[l * 512 + chn];
    f32x4 st[2] = {{0.f, 0.f, 0.f, 0.f}, {0.f, 0.f, 0.f, 0.f}};
    float m_st = 0.f;
    v4u pre[3], prev; float gli = 0.f, glf = 0.f;
#define ML_ISSUE(c_) do { const int tlo_ = dir ? SEQ - 64 * ((c_) + 1) : 64 * (c_); _Pragma("unroll") for (int i_ = 0; i_ < 3; ++i_) { const int ch_ = tid + 512 * i_; pre[i_] = (v4u){0u, 0u, 0u, 0u}; \
        if (ch_ < 68 * 16) { const int rr_ = ch_ >> 4, q_ = ch_ & 15; const int t_ = tlo_ - 2 + rr_; if (t_ >= 0 && t_ < SEQ) pre[i_] = *(const GAS v4u*)(cols + (mb + t_) * NINP + (q_ >> 3) * 256 + h * 64 + (q_ & 7) * 8); } } \
        prev = *(const GAS v4u*)(cols + (mb + tlo_ + (tid >> 3)) * NINP + A_V + h * 64 + (tid & 7) * 8); \
        if (tid < 64) { const int t_ = dir ? tlo_ + 63 - tid : tlo_ + tid; gli = GT[(mb + t_) * 16 + dir * 4 + h]; glf = GT[(mb + t_) * 16 + 8 + dir * 4 + h]; } } while (0)
#define ML_FILL(c_) do { _Pragma("unroll") for (int i_ = 0; i_ < 3; ++i_) { const int ch_ = tid + 512 * i_; if (ch_ < 68 * 16) *(LAS v4u*)(RAWQ + (ch_ >> 4) * 128 + (ch_ & 15) * 8) = pre[i_]; } \
        { LAS bf16* Vt_ = Vtb + ((c_) & 1) * 4608; const int tl_ = tid >> 3, e8_ = tid & 7; const int lp_ = dir ? 63 - tl_ : tl_; const unsigned w_[4] = {prev.x, prev.y, prev.z, prev.w}; \
          _Pragma("unroll") for (int k_ = 0; k_ < 4; ++k_) { const int e_ = e8_ * 8 + 2 * k_; Vt_[e_ * 72 + swz64(e_, lp_)] = (bf16)(w_[k_] & 0xffffu); Vt_[(e_ + 1) * 72 + swz64(e_ + 1, lp_)] = (bf16)(w_[k_] >> 16); } } \
        if (tid < 64) { const float bl_ = wave_scan_add(glf); \
            const float u_ = gli - bl_; const float rm_ = wave_scan_max(u_); \
            ub[((c_) & 1) * 64 + tid] = u_; blb[((c_) & 1) * 64 + tid] = bl_; rmb[((c_) & 1) * 64 + tid] = rm_; if (tid == 63) { scb[((c_) & 1) * 2] = rm_; scb[((c_) & 1) * 2 + 1] = bl_; } } } while (0)
    ML_ISSUE(0); ML_FILL(0); ML_ISSUE(1);
    __syncthreads();
    if (cfull0 > 0) {
        const int dk = tid & 63; float cwk[5]; { const GAS float* cwq = INP(F, 3) + (size_t)l * 5 * 512;
#pragma unroll
            for (int jj = 0; jj < 5; ++jj) cwk[jj] = cwq[jj * 512 + 256 + h * 64 + dk]; }
        const float cbk = INP(F, 4)[l * 512 + 256 + h * 64 + dk];
#pragma unroll 1
        for (int c = 0; c < cfull0; ++c) {
            const LAS float* u = ub + (c & 1) * 64;
            const LAS bf16* Vt = Vtb + (c & 1) * 4608; LAS bf16* Ctn = Ctb + ((c + 1) & 1) * 4608;
            const float umax = scb[(c & 1) * 2], tot = scb[(c & 1) * 2 + 1];
#pragma unroll 2
            for (int i = 0; i < 8; ++i) { const int tl = (tid >> 6) + 8 * i; float s = cbk;
#pragma unroll
                for (int jj = 0; jj < 5; ++jj) s += cwk[jj] * bf2f(RAWQ[(tl + jj) * 128 + 64 + dk]);
                const int lp = dir ? 63 - tl : tl;
                KWt[dk * 72 + swz64(dk, lp)] = (bf16)f2bf(siluf_(s) * 0.125f * __expf(u[lp] - umax)); }
            __syncthreads();
            const float mmax = fmaxf(m_st, umax), s_old = __expf(m_st - mmax), s_new = __expf(umax - mmax);
#pragma unroll
            for (int k = 0; k < 2; ++k) { const int ti = 2 * wave + k, t0_ = ti >> 2, t1_ = ti & 3; const f32x4 z = {0.f, 0.f, 0.f, 0.f};
                const f32x4 lc = mma16s<true, true>(Vt, 72, t0_ * 16, KWt, 72, t1_ * 16, z, lane);
#pragma unroll
                for (int jj = 0; jj < 4; ++jj) { const int r_ = t0_ * 16 + (lane >> 4) * 4 + jj, c_ = t1_ * 16 + (lane & 15);
                    st[k][jj] = s_old * st[k][jj] + s_new * lc[jj]; Ctn[r_ * 72 + c_] = (bf16)f2bf(st[k][jj]); } }
            { const int dq = tid >> 3, part = tid & 7; float s = 0.f;
#pragma unroll
              for (int k = 0; k < 8; ++k) s += bf2f(KWt[dq * 72 + swz64(dq, part * 8) + k]);
              s = row8_sum(s); if (part == 0) nst[dq] = s_old * nst[dq] + s_new * s; }
            m_st = tot + mmax;
            ML_FILL(c + 1); if (c + 2 < cend) ML_ISSUE(c + 2);
            __syncthreads();
        }
    }
#pragma unroll 1
    for (int c = cfull0; c < cend; ++c) {
        const bool full = c >= cfull0;
        const int tlo = dir ? SEQ - 64 * (c + 1) : 64 * c;
        const LAS float* u = ub + (c & 1) * 64; const LAS float* bl = blb + (c & 1) * 64; const LAS float* rm = rmb + (c & 1) * 64;
        const LAS bf16* Vt = Vtb + (c & 1) * 4608; const LAS bf16* Ct = Ctb + (c & 1) * 4608; LAS bf16* Ctn = Ctb + ((c + 1) & 1) * 4608;
#pragma unroll 4
        for (int i = 0; i < 16; ++i) { const int tl = (tid >> 7) + 4 * i; float s = cbv;
#pragma unroll
            for (int jj = 0; jj < 5; ++jj) s += cw[jj] * bf2f(RAWQ[(tl + jj) * 128 + cc]);
            s = siluf_(s); const int lpos = dir ? 63 - tl : tl;
            if (isK) Ks[lpos * 72 + d0] = (bf16)f2bf(s * 0.125f); else Qs[lpos * 72 + d0] = (bf16)f2bf(s); }
        if (tid < 64) den[tid] = 0.f;
        __syncthreads();
        const float umax = scb[(c & 1) * 2], tot = scb[(c & 1) * 2 + 1];
        for (int idx = tid; idx < 4096; idx += 512) { const int lp = idx >> 6, d = idx & 63; KWt[d * 72 + swz64(d, lp)] = (bf16)f2bf(bf2f(Ks[lp * 72 + d]) * __expf(u[lp] - umax)); }
        if (full) {
#pragma unroll
        for (int k = 0; k < 2; ++k) { const int ti = 2 * wave + k, tl_ = ti >> 2, ts = ti & 3; f32x4 acc = {0.f, 0.f, 0.f, 0.f};
            if (ts <= tl_) acc = mma16<64>(Qs + tl_ * 16 * 72, 72, Ks + ts * 16 * 72, 72, acc, lane);
#pragma unroll
            for (int jj = 0; jj < 4; ++jj) { const int lr = tl_ * 16 + (lane >> 4) * 4 + jj, s = ts * 16 + (lane & 15);
                const float v = (s <= lr) ? acc[jj] * __expf(u[s] - fmaxf(m_st, rm[lr])) : 0.f; const unsigned vb = f2bf(v); Ps[lr * 72 + s] = (bf16)vb;
                if (ts <= tl_) { const float rs = row16_sum(bf2f(vb)); if ((lane & 15) == 0) __hip_atomic_fetch_add(den + lr, rs, __ATOMIC_RELAXED, __HIP_MEMORY_SCOPE_WORKGROUP); } } }
        { const int lq = tid >> 3, part = tid & 7; float s = 0.f;
#pragma unroll
          for (int k = 0; k < 8; ++k) s += bf2f(Qs[lq * 72 + part * 8 + k]) * nst[part * 8 + k];
          s = row8_sum(s); if (part == 0) qn[lq] = s; }
        }
        __syncthreads();
        const float mmax = fmaxf(m_st, umax), s_old = __expf(m_st - mmax), s_new = __expf(umax - mmax);
#pragma unroll
        for (int k = 0; k < 2; ++k) { const int ti = 2 * wave + k, t0_ = ti >> 2, t1_ = ti & 3; const f32x4 z = {0.f, 0.f, 0.f, 0.f};
            f32x4 a1 = z, a2 = z;
            if (full) { a1 = mma16s<false, true>(Ps, 72, t0_ * 16, Vt, 72, t1_ * 16, z, lane); a2 = mma16<64>(Qs + t0_ * 16 * 72, 72, Ct + t1_ * 16 * 72, 72, z, lane); }
            const f32x4 lc = mma16s<true, true>(Vt, 72, t0_ * 16, KWt, 72, t1_ * 16, z, lane);
#pragma unroll
            for (int jj = 0; jj < 4; ++jj) { const int r_ = t0_ * 16 + (lane >> 4) * 4 + jj, c_ = t1_ * 16 + (lane & 15);
                if (full) { const float mx = fmaxf(m_st, rm[r_]), iwv = __expf(m_st - mx);
                const float dn = den[r_] + iwv * qn[r_];
                const float val = (a1[jj] + iwv * a2[jj]) * __builtin_amdgcn_rcpf(fmaxf(fabsf(dn), __expf(-(bl[r_] + mx))));
                const int t = dir ? tlo + 63 - r_ : tlo + r_;
                Y[(mb + t) * 256 + h * 64 + c_] = (bf16)f2bf(val); }
                st[k][jj] = s_old * st[k][jj] + s_new * lc[jj];
                Ctn[r_ * 72 + c_] = (bf16)f2bf(st[k][jj]); } }
        { const int dq = tid >> 3, part = tid & 7; float s = 0.f;
#pragma unroll
          for (int k = 0; k < 8; ++k) s += bf2f(KWt[dq * 72 + swz64(dq, part * 8) + k]);
          s = row8_sum(s); if (part == 0) nst[dq] = s_old * nst[dq] + s_new * s; }
        m_st = tot + mmax;
        if (c + 1 < cend) { ML_FILL(c + 1); if (c + 2 < cend) ML_ISSUE(c + 2); }
        __syncthreads();
    }
#undef ML_ISSUE
#undef ML_FILL
}
__device__ __forceinline__ void phase_ssd_conv(const Frame& F, int l) {
    const GAS bf16* cols = (const GAS bf16*)(WSP(F) + WS_COLS); GAS bf16* XBC = (GAS bf16*)(WSP(F) + WS_XN);
    LAS bf16* raw = (LAS bf16*)(F.lds);
    const GAS float* cwp = INP(F, 20) + (size_t)l * 5 * 896; const GAS float* cbp = INP(F, 21) + l * 896;
    const int tid = F.tid;
    float cw0[5], cw1[5]; const int c1 = tid + 512 < 896 ? tid + 512 : tid;
#pragma unroll
    for (int jj = 0; jj < 5; ++jj) { cw0[jj] = cwp[jj * 896 + tid]; cw1[jj] = cwp[jj * 896 + c1]; }
    const float cb0 = cbp[tid], cb1 = cbp[c1];
    GAS float* DTV = (GAS float*)(WSP(F) + WS_DTV); const GAS float* dtbp = INP(F, 22) + l * 12;
    for (int tile = F.vcu; tile < M / 32; tile += F.G) {
        const int m0 = tile * 32, t0 = m0 % SEQ;
        __syncthreads();
        if (tid < 384) { const int tt = tid / 12, k = tid % 12; const float x = bf2f(cols[(size_t)(m0 + tt) * NINP + S_DT + k]) + dtbp[k]; DTV[(size_t)(m0 + tt) * 12 + k] = x > 20.f ? x : log1pf(__expf(x)); }
        for (int ch = tid; ch < 36 * 112; ch += 512) { const int rr = ch / 112, cc = ch % 112; const int t = t0 - 2 + rr;
            v4u v = {0u, 0u, 0u, 0u}; if (t >= 0 && t < SEQ) v = *(const GAS v4u*)(cols + (size_t)(m0 - 2 + rr) * NINP + S_X + cc * 8);
            *(LAS v4u*)(raw + rr * 896 + cc * 8) = v; }
        __syncthreads();
#pragma unroll
        for (int half = 0; half < 2; ++half) { const int c = half ? c1 : tid; if (half && tid + 512 >= 896) break;
            float win[5];
#pragma unroll
            for (int jj = 0; jj < 4; ++jj) win[jj] = bf2f(raw[jj * 896 + c]);
            for (int tl = 0; tl < 32; ++tl) { win[4] = bf2f(raw[(tl + 4) * 896 + c]);
                float s = half ? cb1 : cb0;
#pragma unroll
                for (int jj = 0; jj < 5; ++jj) s += (half ? cw1[jj] : cw0[jj]) * win[jj];
#pragma unroll
                for (int jj = 0; jj < 4; ++jj) win[jj] = win[jj + 1];
                XBC[(size_t)(m0 + tl) * 896 + c] = (bf16)f2bf(siluf_(s)); } }
    }
    __syncthreads();
}
__device__ __forceinline__ void ssd_seq(const Frame& F, int l, int task, int cfull0, int cend) {
    const int b = task / 12, rem = task % 12, head = rem >> 1, dir = rem & 1, g = head / 3;
    const GAS bf16* cols = (const GAS bf16*)(WSP(F) + WS_COLS); const GAS bf16* XBC = (const GAS bf16*)(WSP(F) + WS_XN);
    GAS bf16* Y = (GAS bf16*)(WSP(F) + (dir ? Y_SB : Y_SF));
    LAS bf16* Cm = (LAS bf16*)(F.lds); LAS bf16* Bm = (LAS bf16*)(F.lds + 17408);
    LAS bf16* Btw = (LAS bf16*)(F.lds + 34816); LAS bf16* Xt = (LAS bf16*)(F.lds + 53248);
    LAS bf16* Ps = (LAS bf16*)(F.lds + 62464); LAS bf16* Hs = (LAS bf16*)(F.lds + 71680);
    LAS float* dtvb = (LAS float*)(F.lds + 89088);
    LAS float* acsb = dtvb + 128;
    LAS float* totb = dtvb + 256;
    const int tid = F.tid, lane = F.lane, wave = F.wave;
    const size_t mb = (size_t)b * SEQ;
    constexpr int NC = SEQ / 64;
    __syncthreads();
    for (int i = tid; i < 64 * 136; i += 512) Hs[i] = 0;
    const GAS float* DTV = (const GAS float*)(WSP(F) + WS_DTV);
    const float aneg = -__expf(INP(F, 23)[(l * 2 + dir) * 6 + head]);
    f32x4 st[4];
#pragma unroll
    for (int k = 0; k < 4; ++k) st[k] = (f32x4){0.f, 0.f, 0.f, 0.f};
    v4u pre[5]; float dtraw = 0.f;
#define SSD_ISSUE(c_) do { const int tlo_ = dir ? SEQ - 64 * ((c_) + 1) : 64 * (c_); _Pragma("unroll") for (int i_ = 0; i_ < 5; ++i_) { const int idx_ = tid + 512 * i_; const int tl_ = idx_ / 40, q_ = idx_ % 40; \
        const int gc_ = q_ < 8 ? head * 64 + q_ * 8 : (q_ < 24 ? 384 + g * 128 + (q_ - 8) * 8 : 640 + g * 128 + (q_ - 24) * 8); \
        pre[i_] = *(const GAS v4u*)(XBC + (mb + tlo_ + tl_) * 896 + gc_); } } while (0)
#define SSD_DTLOAD(c_) do { if (tid < 64) { const int tlo_ = dir ? SEQ - 64 * ((c_) + 1) : 64 * (c_); const int t_ = dir ? tlo_ + 63 - tid : tlo_ + tid; dtraw = DTV[(mb + t_) * 12 + dir * 6 + head]; } } while (0)
#define SSD_DTCALC(c_) do { if (tid < 64) { const float dt_ = dtraw; float cs_ = dt_ * aneg; \
        cs_ = wave_scan_add(cs_); \
        const float tt_ = __builtin_bit_cast(float, __builtin_amdgcn_readlane(__builtin_bit_cast(int, cs_), 63)); dtvb[((c_) & 1) * 64 + tid] = dt_; acsb[((c_) & 1) * 64 + tid] = cs_; if (tid == 0) totb[(c_) & 1] = tt_; } } while (0)
    int lgo[3], llp[3], lq[3]; v4u prel[3];
#pragma unroll
    for (int i = 0; i < 3; ++i) { const int idx = tid + 512 * i; const int tl = idx / 24, q = idx % 24; lq[i] = q; llp[i] = dir ? 63 - tl : tl;
        lgo[i] = tl * 896 + (q < 8 ? head * 64 + q * 8 : 384 + g * 128 + (q - 8) * 8); }
#define SSD_ISSUE_L(dst_, c_) do { const int tlo_ = dir ? SEQ - 64 * ((c_) + 1) : 64 * (c_); const GAS bf16* b_ = XBC + (mb + tlo_) * 896; _Pragma("unroll") for (int i_ = 0; i_ < 3; ++i_) dst_[i_] = *(const GAS v4u*)(b_ + lgo[i_]); } while (0)
    v4u preN[3];
    if (cfull0 > 0) { SSD_ISSUE_L(prel, 0); if (cfull0 > 1) SSD_ISSUE_L(preN, 1); } else SSD_ISSUE(0);
    SSD_DTLOAD(0); SSD_DTCALC(0); SSD_DTLOAD(1);
    __syncthreads();
    if (cfull0 > 0) {
#pragma unroll 1
        for (int c = 0; c < cfull0; ++c) {
            LAS bf16* Xl = (c & 1) ? (LAS bf16*)(F.lds + 92160) : Xt; LAS bf16* Bl = (c & 1) ? (LAS bf16*)(F.lds + 101376) : Btw;
            const LAS float* dtv = dtvb + (c & 1) * 64; const LAS float* acs = acsb + (c & 1) * 64; const float tot = totb[c & 1];
#pragma unroll
            for (int i = 0; i < 3; ++i) { const int q = lq[i], lp = llp[i];
                const unsigned w[4] = {prel[i].x, prel[i].y, prel[i].z, prel[i].w};
                if (q < 8) {
#pragma unroll
                    for (int k = 0; k < 4; ++k) { const int p0 = q * 8 + 2 * k; Xl[p0 * 72 + swz64(p0, lp)] = (bf16)(w[k] & 0xffffu); Xl[(p0 + 1) * 72 + swz64(p0 + 1, lp)] = (bf16)(w[k] >> 16); } }
                else { const int n0 = (q - 8) * 8; const float sc = dtv[lp] * __expf(tot - acs[lp]);
#pragma unroll
                    for (int k = 0; k < 4; ++k) { const int nn = n0 + 2 * k; Bl[nn * 72 + swz64(nn, lp)] = (bf16)f2bf(bf2f(w[k] & 0xffffu) * sc); Bl[(nn + 1) * 72 + swz64(nn + 1, lp)] = (bf16)f2bf(bf2f(w[k] >> 16) * sc); } } }
            if (c + 1 < cfull0) {
#pragma unroll
                for (int i = 0; i < 3; ++i) prel[i] = preN[i];
                if (c + 2 < cfull0) SSD_ISSUE_L(preN, c + 2); }
            else SSD_ISSUE(c + 1);
            SSD_DTCALC(c + 1); if (c + 2 < cend) SSD_DTLOAD(c + 2);
            __syncthreads();
            const float cdec = __expf(tot);
#pragma unroll
            for (int k = 0; k < 4; ++k) { const int ti = 4 * wave + k, tp = ti >> 3, tn = ti & 7; const f32x4 z = {0.f, 0.f, 0.f, 0.f};
                const f32x4 lcv = mma16s<true, true>(Xl, 72, tp * 16, Bl, 72, tn * 16, z, lane);
                st[k] = st[k] * cdec + lcv; }
        }
#pragma unroll
        for (int k = 0; k < 4; ++k) { const int ti = 4 * wave + k, tp = ti >> 3, tn = ti & 7;
#pragma unroll
            for (int jj = 0; jj < 4; ++jj) { const int p = tp * 16 + (lane >> 4) * 4 + jj, n = tn * 16 + (lane & 15); Hs[p * 136 + n] = (bf16)f2bf(st[k][jj]); } }
        __syncthreads();
    }
#pragma unroll 1
    for (int c = cfull0; c < cend; ++c) {
        const bool full = c >= cfull0;
        const int tlo = dir ? SEQ - 64 * (c + 1) : 64 * c;
        const LAS float* dtv = dtvb + (c & 1) * 64; const LAS float* acs = acsb + (c & 1) * 64; const float tot = totb[c & 1];
#pragma unroll
        for (int i = 0; i < 5; ++i) { const int idx = tid + 512 * i; const int tl = idx / 40, q = idx % 40; const int lp = dir ? 63 - tl : tl;
            const unsigned w[4] = {pre[i].x, pre[i].y, pre[i].z, pre[i].w};
            if (q < 8) {
#pragma unroll
                for (int k = 0; k < 4; ++k) { const int p0 = q * 8 + 2 * k; Xt[p0 * 72 + swz64(p0, lp)] = (bf16)(w[k] & 0xffffu); Xt[(p0 + 1) * 72 + swz64(p0 + 1, lp)] = (bf16)(w[k] >> 16); } }
            else if (q < 24) { const int n0 = (q - 8) * 8; if (full) *(LAS v4u*)(Bm + lp * 136 + n0) = pre[i]; const float sc = dtv[lp] * __expf(tot - acs[lp]);
#pragma unroll
                for (int k = 0; k < 4; ++k) { const int nn = n0 + 2 * k; Btw[nn * 72 + swz64(nn, lp)] = (bf16)f2bf(bf2f(w[k] & 0xffffu) * sc); Btw[(nn + 1) * 72 + swz64(nn + 1, lp)] = (bf16)f2bf(bf2f(w[k] >> 16) * sc); } }
            else if (full) { const int n0 = (q - 24) * 8; *(LAS v4u*)(Cm + lp * 136 + n0) = pre[i]; } }
        if (c + 1 < cend) SSD_ISSUE(c + 1);
        __syncthreads();
        f32x4 yo[2] = {{0.f, 0.f, 0.f, 0.f}, {0.f, 0.f, 0.f, 0.f}}, lc[4];
        if (full) {
#pragma unroll
        for (int k = 0; k < 2; ++k) { const int ti = 2 * wave + k, tl_ = ti >> 2, ts = ti & 3; f32x4 acc = {0.f, 0.f, 0.f, 0.f};
            if (ts <= tl_) acc = mma16<128>(Cm + tl_ * 16 * 136, 136, Bm + ts * 16 * 136, 136, acc, lane);
#pragma unroll
            for (int jj = 0; jj < 4; ++jj) { const int lr = tl_ * 16 + (lane >> 4) * 4 + jj, s = ts * 16 + (lane & 15);
                const float v = (s <= lr) ? acc[jj] * __expf(acs[lr] - acs[s]) * dtv[s] : 0.f; Ps[lr * 72 + s] = (bf16)f2bf(v); }
            const f32x4 z = {0.f, 0.f, 0.f, 0.f};
            yo[k] = mma16<128>(Cm + tl_ * 16 * 136, 136, Hs + ts * 16 * 136, 136, z, lane); }
        }
#pragma unroll
        for (int k = 0; k < 4; ++k) { const int ti = 4 * wave + k, tp = ti >> 3, tn = ti & 7; const f32x4 z = {0.f, 0.f, 0.f, 0.f};
            lc[k] = mma16s<true, true>(Xt, 72, tp * 16, Btw, 72, tn * 16, z, lane); }
        __syncthreads();
        const float cdec = __expf(tot);
        if (full) {
#pragma unroll
        for (int k = 0; k < 2; ++k) { const int ti = 2 * wave + k, tl_ = ti >> 2, tp = ti & 3; const f32x4 z = {0.f, 0.f, 0.f, 0.f};
            const f32x4 yd = mma16s<false, true>(Ps, 72, tl_ * 16, Xt, 72, tp * 16, z, lane);
#pragma unroll
            for (int jj = 0; jj < 4; ++jj) { const int lr = tl_ * 16 + (lane >> 4) * 4 + jj, p = tp * 16 + (lane & 15);
                const float val = yd[jj] + yo[k][jj] * __expf(acs[lr]);
                const int t = dir ? tlo + 63 - lr : tlo + lr;
                Y[(mb + t) * 384 + head * 64 + p] = (bf16)f2bf(val); } }
        }
#pragma unroll
        for (int k = 0; k < 4; ++k) { const int ti = 4 * wave + k, tp = ti >> 3, tn = ti & 7;
#pragma unroll
            for (int jj = 0; jj < 4; ++jj) { const int p = tp * 16 + (lane >> 4) * 4 + jj, n = tn * 16 + (lane & 15);
                st[k][jj] = cdec * st[k][jj] + lc[k][jj]; Hs[p * 136 + n] = (bf16)f2bf(st[k][jj]); } }
        if (c + 1 < cend) { SSD_DTCALC(c + 1); if (c + 2 < cend) SSD_DTLOAD(c + 2); }
        __syncthreads();
    }
#undef SSD_ISSUE
#undef SSD_ISSUE_L
#undef SSD_DTLOAD
#undef SSD_DTCALC
}
__device__ __forceinline__ float wave_sum2(float v) { v = row16_sum(v); v += __shfl_xor(v, 16); v += __shfl_xor(v, 32); return v; }
__device__ __forceinline__ f32x4 bf4(v2u w) { return (f32x4){bf2f(w.x & 0xffffu), bf2f(w.x >> 16), bf2f(w.y & 0xffffu), bf2f(w.y >> 16)}; }
__device__ __forceinline__ v2u pk4(f32x4 v) { v2u w; w.x = pk2(v.x, v.y); w.y = pk2(v.z, v.w); return w; }
__device__ __forceinline__ void phase_post(const Frame& F, int l) {
    const GAS bf16* cols = (const GAS bf16*)(WSP(F) + WS_COLS); GAS bf16* MIX = (GAS bf16*)(WSP(F) + WS_XN);
    const GAS bf16* YAf = (const GAS bf16*)(WSP(F) + Y_AF); const GAS bf16* YAb = (const GAS bf16*)(WSP(F) + Y_AB);
    const GAS bf16* YRf = (const GAS bf16*)(WSP(F) + Y_RF); const GAS bf16* YRb = (const GAS bf16*)(WSP(F) + Y_RB);
    const GAS bf16* YSf = (const GAS bf16*)(WSP(F) + Y_SF); const GAS bf16* YSb = (const GAS bf16*)(WSP(F) + Y_SB);
    const GAS float* CT = (const GAS float*)(WSP(F) + WS_CT);
    LAS bf16* GU = (LAS bf16*)(F.lds);
    LAS bf16* SG = (LAS bf16*)(F.lds + 104448);
    LAS float* gate = (LAS float*)(F.lds + 108800);
    LAS float* SCW = (LAS float*)(F.lds + 133632);
    const int tid = F.tid, lane = F.lane, wave = F.wave;
    const GAS float* mup = INP(F, 8) + l * 1472; const GAS float* mun = INP(F, 9) + l * 1472;
    const GAS float* sdk = INP(F, 24) + l * 6;
    __syncthreads();
    { const GAS bf16* gut = (const GAS bf16*)(WSP(F) + WS_GUT); for (int ch = tid; ch < 384 * 16; ch += 512) { const int c = ch >> 4, q = ch & 15; *(LAS v4u*)(GU + c * 136 + q * 8) = *(const GAS v4u*)(gut + c * 128 + q * 8); } }
    { const GAS float* scw = INP(F, 20) + (size_t)l * 5 * 896; for (int idx = tid; idx < 5 * 384; idx += 512) SCW[idx] = scw[(idx / 384) * 896 + (idx % 384)]; }
    const int gch = tid & 15;
    float gmp[8], gmn[8];
#pragma unroll
    for (int k = 0; k < 8; ++k) { gmp[k] = mup[1344 + 8 * gch + k]; gmn[k] = mun[1344 + 8 * gch + k]; }
    const int qa = lane, qb = 64 + (lane & 31);
    const f32x4 mng4 = *(const GAS f32x4*)(INP(F, 7) + l * 256 + 4 * qa);
    f32x4 rmp[2], rmn[2], rng[2], rnb[2], scb[2], sng[2];
#pragma unroll
    for (int ps = 0; ps < 2; ++ps) { const int c0 = 4 * (ps ? qb : qa);
        rmp[ps] = *(const GAS f32x4*)(mup + 768 + c0); rmn[ps] = *(const GAS f32x4*)(mun + 768 + c0);
        rng[ps] = *(const GAS f32x4*)(INP(F, 18) + l * 384 + c0); rnb[ps] = *(const GAS f32x4*)(INP(F, 19) + l * 384 + c0);
        scb[ps] = *(const GAS f32x4*)(INP(F, 21) + l * 896 + c0); sng[ps] = *(const GAS f32x4*)(INP(F, 25) + l * 384 + c0); }
    for (int tile = F.vcu; tile < M / 16; tile += F.G) {
        const int m0 = tile * 16;
        __syncthreads();
        if (tid < 256) { const int tt = tid >> 4; const int m = m0 + tt, t = m % SEQ; const GAS bf16* cp = cols + (size_t)m * NINP + R_GD + 8 * gch;
            const v4u c1 = *(const GAS v4u*)cp; v4u c0 = {0u, 0u, 0u, 0u}, c2 = {0u, 0u, 0u, 0u};
            if (t > 0) c0 = *(const GAS v4u*)(cp - NINP); if (t < SEQ - 1) c2 = *(const GAS v4u*)(cp + NINP);
            const unsigned w0[4] = {c0.x, c0.y, c0.z, c0.w}, w1[4] = {c1.x, c1.y, c1.z, c1.w}, w2[4] = {c2.x, c2.y, c2.z, c2.w}; unsigned o[4];
#pragma unroll
            for (int k = 0; k < 4; ++k) { const float a1 = bf2f(w1[k] & 0xffffu), b1 = bf2f(w1[k] >> 16);
                const float va = a1 + gmp[2 * k] * (bf2f(w0[k] & 0xffffu) - a1) + gmn[2 * k] * (bf2f(w2[k] & 0xffffu) - a1);
                const float vb = b1 + gmp[2 * k + 1] * (bf2f(w0[k] >> 16) - b1) + gmn[2 * k + 1] * (bf2f(w2[k] >> 16) - b1);
                o[k] = pk2(sigmoidf_(va), sigmoidf_(vb)); }
            *(LAS v4u*)(SG + tt * 136 + 8 * gch) = (v4u){o[0], o[1], o[2], o[3]}; }
        __syncthreads();
#pragma unroll
        for (int k = 0; k < 3; ++k) { const int ct = wave + 8 * k; const f32x4 z = {0.f, 0.f, 0.f, 0.f};
            const f32x4 acc = mma16<128>(SG, 136, GU + ct * 16 * 136, 136, z, lane);
#pragma unroll
            for (int jj = 0; jj < 4; ++jj) gate[((lane >> 4) * 4 + jj) * 388 + ct * 16 + (lane & 15)] = acc[jj]; }
        __syncthreads();
#pragma unroll 1
        for (int k = 0; k < 2; ++k) { const int tt = wave * 2 + k; const int m = m0 + tt, t = m % SEQ; const size_t cr = (size_t)m * NINP;
            { const int c0 = 4 * qa;
              const f32x4 hs = bf4(*(const GAS v2u*)(YAf + (size_t)m * 256 + c0)) + bf4(*(const GAS v2u*)(YAb + (size_t)m * 256 + c0));
              const float mean = row16_sum((hs.x + hs.y) + (hs.z + hs.w)) * (1.f / 64.f); const f32x4 d = hs - mean;
              const float var = row16_sum((d.x * d.x + d.y * d.y) + (d.z * d.z + d.w * d.w)) * (1.f / 64.f);
              const f32x4 o = bf4(*(const GAS v2u*)(cols + cr + A_O + c0));
              f32x4 y = d * __builtin_amdgcn_rsqf(var + 1e-6f) * mng4;
              y.x *= sigmoidf_(o.x); y.y *= sigmoidf_(o.y); y.z *= sigmoidf_(o.z); y.w *= sigmoidf_(o.w);
              *(GAS v2u*)(MIX + (size_t)m * DM + c0) = pk4(y); }
#pragma unroll
            for (int ps = 0; ps < 2; ++ps) { const int qd = ps ? qb : qa, c0 = 4 * qd; const bool act = ps == 0 || lane < 32;
              const f32x4 ys = bf4(*(const GAS v2u*)(YRf + (size_t)m * 384 + c0)) + bf4(*(const GAS v2u*)(YRb + (size_t)m * 384 + c0));
              const float mean = row16_sum((ys.x + ys.y) + (ys.z + ys.w)) * (1.f / 64.f); const f32x4 d = ys - mean;
              const float var = row16_sum((d.x * d.x + d.y * d.y) + (d.z * d.z + d.w * d.w)) * (1.f / 64.f);
              const f32x4 y = d * __builtin_amdgcn_rsqf(var + 64e-5f) * rng[ps] + rnb[ps];
              const f32x4 p1 = bf4(*(const GAS v2u*)(cols + cr + R_V + c0));
              f32x4 p0 = {0.f, 0.f, 0.f, 0.f}, p2 = {0.f, 0.f, 0.f, 0.f};
              if (t > 0) p0 = bf4(*(const GAS v2u*)(cols + cr - NINP + R_V + c0)); if (t < SEQ - 1) p2 = bf4(*(const GAS v2u*)(cols + cr + NINP + R_V + c0));
              const f32x4 vv = p1 + rmp[ps] * (p0 - p1) + rmn[ps] * (p2 - p1);
              const float ctv = CT[(size_t)m * 8 + (qd >> 4)];
              const f32x4 g4 = *(const LAS f32x4*)(gate + tt * 388 + c0);
              if (act) *(GAS v2u*)(MIX + (size_t)m * DM + 256 + c0) = pk4((y + vv * ctv) * g4); }
            f32x4 yv[2]; float ssq0 = 0.f, ssq1 = 0.f;
#pragma unroll
            for (int ps = 0; ps < 2; ++ps) { const int qd = ps ? qb : qa, c0 = 4 * qd; const bool act = ps == 0 || lane < 32;
              f32x4 s = scb[ps];
#pragma unroll
              for (int jj = 0; jj < 5; ++jj) { const int tq = t + jj - 2; if (tq >= 0 && tq < SEQ) s += *(const LAS f32x4*)(SCW + jj * 384 + c0) * bf4(*(const GAS v2u*)(cols + cr + (jj - 2) * NINP + S_X + c0)); }
              const f32x4 z = bf4(*(const GAS v2u*)(cols + cr + S_Z + c0));
              f32x4 y = bf4(*(const GAS v2u*)(YSf + (size_t)m * 384 + c0)) + bf4(*(const GAS v2u*)(YSb + (size_t)m * 384 + c0));
              const float dsk = sdk[qd >> 4];
              y.x = (y.x + dsk * siluf_(s.x)) * siluf_(z.x); y.y = (y.y + dsk * siluf_(s.y)) * siluf_(z.y); y.z = (y.z + dsk * siluf_(s.z)) * siluf_(z.z); y.w = (y.w + dsk * siluf_(s.w)) * siluf_(z.w);
              yv[ps] = y; const float sq = act ? (y.x * y.x + y.y * y.y) + (y.z * y.z + y.w * y.w) : 0.f;
              if (qd < 48) ssq0 += sq; else ssq1 += sq; }
            const float r0 = __builtin_amdgcn_rsqf(wave_sum2(ssq0) * (1.f / 192.f) + 1e-6f), r1 = __builtin_amdgcn_rsqf(wave_sum2(ssq1) * (1.f / 192.f) + 1e-6f);
#pragma unroll
            for (int ps = 0; ps < 2; ++ps) { const int qd = ps ? qb : qa, c0 = 4 * qd; const bool act = ps == 0 || lane < 32;
              if (act) *(GAS v2u*)(MIX + (size_t)m * DM + 640 + c0) = pk4(yv[ps] * (qd < 48 ? r0 : r1) * sng[ps]); }
        }
    }
    __syncthreads();
}
namespace cg = cooperative_groups;
constexpr int N_PHASES = 9 * DEPTH + 1;
__global__ void __launch_bounds__(NWAVES * 64, 2) mk_fwd(Args args) {
    extern __shared__ __attribute__((aligned(16))) unsigned char lds_raw[];
    Frame F;
    F.lds = (LAS unsigned char*)lds_raw;
    F.tid = threadIdx.x; F.lane = F.tid & 63; F.wave = __builtin_amdgcn_readfirstlane(F.tid >> 6);
    F.G = gridDim.x; { const int bx = blockIdx.x; F.vcu = (F.G % 8 == 0) ? (bx % 8) * (F.G / 8) + bx / 8 : bx; }
    volatile LAS unsigned* MISC = (volatile LAS unsigned*)(F.lds + MISC_OFF);
    if (F.tid < 64) MISC[F.tid] = 0u;
    if (F.tid < 34) *(LAS unsigned long long*)(F.lds + PTAB_OFF + 8 * F.tid) = ((const unsigned long long*)__builtin_amdgcn_kernarg_segment_ptr())[F.tid];
    __syncthreads();
    unsigned* ctl = (unsigned*)(WSP(F) + WS_CTL);
    XcdBarrier bar = xcd_barrier_post(ctl + CW_BAR, MISC + 8);
    const int lo = args.ph_lo, hi = args.ph_hi;
#define IN_(k) (lo <= (k) && (k) < hi)
#define SEAM(k) do { if (IN_(k) && IN_((k) + 1)) { if ((k) == 0) cg::this_grid().sync(); else xcd_barrier(bar); } } while (0)
#define LAYER(l, B) \
    if (IN_(B + 0)) { phase_convert(F, l); phase_norm(F, l == 0 ? INP(F, 0) : OUTP(F), INP(F, 1) + l * DM, (GAS bf16*)(WSP(F) + WS_XN)); } SEAM(B + 0); \
    if (IN_(B + 1)) { unsigned char* ws = (unsigned char*)WSP(F); pg8::Gemm g{(const bf16*)(ws + WS_XN), (const bf16*)(ws + WS_WIN), M, NINP, DM}; pg8::StaticOrder S; S.init(M, NINP, F.G, (int)blockIdx.x); \
            pg8::EpiBf16<0> E{(bf16*)(ws + WS_COLS), NINP, nullptr, 0, 0, 1.f}; \
            pg8::gemm_phase<pg8::EpiBf16<0>, pg8::StaticOrder, PG8_ALIGN, PG8_SP2>(F.lds, g, S, E); } SEAM(B + 1); \
    if (IN_(B + 2)) { phase_gates(F, l); phase_ssd_conv(F, l); } SEAM(B + 2); \
    if (IN_(B + 3)) { const int bx = blockIdx.x; \
            if (bx < 96) { const int c8 = bx & 7, k8 = bx >> 3; rwkv_scan(F, l, c8 + 8 * (k8 >> 2), k8 & 3, (unsigned)l * (SEQ / 32)); } else if (bx < 144) rwkv_produce(F, l, (bx - 96) % 24, (bx - 96) / 24, (unsigned)l * (SEQ / 32)); else if (bx < 216) { const int u = bx - 144, sg = 2 - (u / 24); ssd_seq(F, l, u % 24, sg == 0 ? 0 : (sg == 1 ? 43 : 86), sg == 0 ? 43 : (sg == 1 ? 86 : 128)); } else if (bx < 248) { const int u = bx - 216, sg = 1 - (u / 16); mlstm_seq(F, l, u % 16, 64 * sg, 64 * sg + 64); } } SEAM(B + 3); \
    if (IN_(B + 4)) phase_post(F, l); SEAM(B + 4); \
    if (IN_(B + 5)) { unsigned char* ws = (unsigned char*)WSP(F); pg8::Gemm g{(const bf16*)(ws + WS_XN), (const bf16*)(ws + WS_WOUT), M, DM, DM}; pg8::StaticOrder S; S.init(M, DM, F.G, (int)blockIdx.x); \
            pg8::EpiResidual E{l == 0 ? (const float*)INP(F, 0) : (const float*)OUTP(F), (float*)OUTP(F), DM}; \
            pg8::gemm_phase<pg8::EpiResidual, pg8::StaticOrder, PG8_ALIGN, PG8_SP2>(F.lds, g, S, E); } SEAM(B + 5); \
    if (IN_(B + 6)) phase_norm(F, OUTP(F), INP(F, 27) + l * DM, (GAS bf16*)(WSP(F) + WS_XN)); SEAM(B + 6); \
    if (IN_(B + 7)) { unsigned char* ws = (unsigned char*)WSP(F); pg8::Gemm g{(const bf16*)(ws + WS_XN), (const bf16*)(ws + WS_WGU), M, 2 * FFN, DM}; pg8::StaticOrder S; S.init(M, 2 * FFN, F.G, (int)blockIdx.x); \
            pg8::EpiSwiGLU E{(bf16*)(ws + WS_COLS), FFN}; \
            pg8::gemm_phase<pg8::EpiSwiGLU, pg8::StaticOrder, PG8_ALIGN, PG8_SP2>(F.lds, g, S, E); } SEAM(B + 7); \
    if (IN_(B + 8)) { unsigned char* ws = (unsigned char*)WSP(F); pg8::Gemm g{(const bf16*)(ws + WS_COLS), (const bf16*)(ws + WS_WDN), M, DM, FFN}; pg8::StaticOrder S; S.init(M, DM, F.G, (int)blockIdx.x); \
            pg8::EpiResidual E{(const float*)OUTP(F), (float*)OUTP(F), DM}; \
            pg8::gemm_phase<pg8::EpiResidual, pg8::StaticOrder, PG8_ALIGN, PG8_SP2>(F.lds, g, S, E); } SEAM(B + 8);
    LAYER(0, 0)
    LAYER(1, 9)
    if (IN_(18)) phase_final_norm(F, OUTP(F), INP(F, 31));
#undef IN_
#undef SEAM
#undef LAYER
}

#ifndef MK_PER_PHASE
#define MK_PER_PHASE 0
#endif
extern "C" void kernel_launch(void* const* d_in, const int* in_sizes, int n_in, void* d_out, int out_size, void* d_ws, size_t ws_size, hipStream_t stream) {
    static int grid = 0;
    if (grid == 0) {
        int dev = 0, cus = 0;
        if (n_in != 32 || out_size != M * DM || ws_size < WS_END) { fprintf(stderr, "kernel_launch: unexpected shapes (n_in %d out %d ws %zu)\n", n_in, out_size, ws_size); grid = -1; return; }
        if (hipGetDevice(&dev) != hipSuccess || hipDeviceGetAttribute(&cus, hipDeviceAttributeMultiprocessorCount, dev) != hipSuccess) { grid = -1; return; }
        if (hipFuncSetAttribute((const void*)mk_fwd, hipFuncAttributeMaxDynamicSharedMemorySize, LDS_BYTES) != hipSuccess) { fprintf(stderr, "kernel_launch: hipFuncSetAttribute failed\n"); grid = -1; return; }
        int per_cu = 0;
        if (hipOccupancyMaxActiveBlocksPerMultiprocessor(&per_cu, (const void*)mk_fwd, NWAVES * 64, LDS_BYTES) != hipSuccess || per_cu < 1) { fprintf(stderr, "kernel_launch: occupancy query says %d\n", per_cu); }
        (void)hipGetLastError();
        grid = cus;
    }
    if (grid < 0) return;
    (void)hipMemsetAsync((char*)d_ws + WS_CTL, 0, CTL_ZERO_BYTES, stream);
    Args a{};
    for (int i = 0; i < 32; ++i) a.in[i] = (const float*)d_in[i];
    a.out = (float*)d_out; a.ws = (unsigned char*)d_ws;
#if MK_PER_PHASE
    for (int p = 0; p < N_PHASES; ++p) { a.ph_lo = p; a.ph_hi = p + 1; hipLaunchKernelGGL(mk_fwd, dim3(grid), dim3(NWAVES * 64), LDS_BYTES, stream, a); }
#else
    a.ph_lo = 0; a.ph_hi = N_PHASES;
    void* kargs[] = {&a};
    hipError_t e = hipLaunchCooperativeKernel((const void*)mk_fwd, dim3(grid), dim3(NWAVES * 64), kargs, LDS_BYTES, stream);
    if (e != hipSuccess) fprintf(stderr, "cooperative launch failed: %s (grid %d)\n", hipGetErrorString(e), grid);
#endif
}
```

```cpp
#include <hip/hip_runtime.h>
#include <hip/hip_cooperative_groups.h>
#include <cstdio>
#include <cstdint>
namespace pg8 {
#define PG8_LAS __attribute__((address_space(3)))
typedef unsigned short bf16_t;
typedef short bf16x8 __attribute__((ext_vector_type(8)));
typedef float f32x4 __attribute__((ext_vector_type(4)));
typedef unsigned u32x4 __attribute__((ext_vector_type(4)));
constexpr int BM = 256, BK = 64, HALF = 128, HTB = HALF * BK * 2  , STAGE_BYTES = 8 * HTB, NXCD = 8, WGM = 8;

__host__ __device__ __forceinline__ int lds_byte(int r, int c) { const int st = (r >> 4) * 2 + (c >> 5), rr = r & 15, cc = c & 31, ob = rr * 64 + cc * 2; return st * 1024 + (ob ^ (((ob >> 9) & 1) << 5)); }
__host__ __device__ __forceinline__ void stage_rc(int b, int& R, int& C) { const int st = b / 1024, sb = b % 1024, swz = sb ^ (((sb >> 9) & 1) << 5); R = (st >> 1) * 16 + swz / 64; C = (st & 1) * 32 + (swz % 64) / 2; }
__host__ __device__ __forceinline__ int perm32(int rho) { const int n = rho >> 4, i = rho & 15; return 8 * (i >> 2) + 4 * n + (i & 3); }

struct Unit { int pm, pn; };
struct Gemm { const bf16_t* A; const bf16_t* Bt; int M, N, K; };

struct StaticOrder {
    int nM, nN, nwg, G, c;
    __host__ __device__ void init(int M, int N, int G_, int c_) { nM = M / BM; nN = N / BM; nwg = nM * nN; G = G_; c = c_; }
    __host__ __device__ bool next(int i, Unit& u) const {
        const long L = (long)i * G + c; if (L >= nwg) return false;
        int wgid = (int)L; { const int q = nwg / NXCD, r = nwg % NXCD, xcd = wgid % NXCD, off = wgid / NXCD; wgid = (xcd < r ? xcd * (q + 1) : r * (q + 1) + (xcd - r) * q) + off; }
        const int nig = WGM * nN, gid = wgid / nig, fm = gid * WGM, gsz = (nM - fm) < WGM ? (nM - fm) : WGM;
        u.pm = fm + ((wgid % nig) % gsz); u.pn = (wgid % nig) / gsz; return true;
    }
    __device__ __forceinline__ void a_ready(const Unit&) const {}
    __device__ __forceinline__ void done(const Unit&) const {}
};

__device__ __forceinline__ unsigned cvt_pk_bf16(float lo, float hi) { unsigned r; asm volatile("v_cvt_pk_bf16_f32 %0, %1, %2" : "=v"(r) : "v"(lo), "v"(hi)); return r; }
typedef float f32x2 __attribute__((ext_vector_type(2)));
__device__ __forceinline__ f32x2 gelu_pk(f32x2 v) {
    const f32x2 av = __builtin_elementwise_abs(v), d = av * 0.2316418882f + 1.0f;
    f32x2 t; t.x = __builtin_amdgcn_rcpf(d.x); t.y = __builtin_amdgcn_rcpf(d.y);
    f32x2 q = t * 0.5307027145f + (-0.7265760135f); q = q * t + 0.7107068705f; q = q * t + (-0.142248368f); q = q * t + 0.127414796f; q = q * t;
    const f32x2 s = (v * v) * (-0.72134752044f);
    f32x2 e; e.x = __builtin_amdgcn_exp2f(s.x); e.y = __builtin_amdgcn_exp2f(s.y);
    const f32x2 m = v * (q * e), r = v - m;
    f32x2 o; o.x = v.x < 0.f ? m.x : r.x; o.y = v.y < 0.f ? m.y : r.y; return o;
}

template <int ACT  > struct EpiBf16 {
    static constexpr bool PERM = true, AFTER_DRAIN = false; static_assert(ACT == 0 || ACT == 1, "EpiBf16: ACT is 0 (none) or 1 (gelu_pk)");
    bf16_t* O; int ldc; const float* bias; int split_cols; size_t split_stride; float scale0;
    __device__ __forceinline__ void operator()(const f32x4 (&acc)[2][2][4][2], const Unit& u, int wr, int wc, int fr, int fq) const {
        const int row0 = u.pm * BM + wr * 64 + fr; int colt = u.pn * BM; bf16_t* base = O;
        float sc = 1.f; if (split_cols) { const int t = colt / split_cols; base += (size_t)t * split_stride; colt -= t * split_cols; if (t == 0) sc = scale0; }
        const int col0 = colt + wc * 32 + 8 * fq, bcol0 = u.pn * BM + wc * 32 + 8 * fq;
        f32x4 bv[2][2];
#pragma unroll
        for (int bj = 0; bj < 2; ++bj)
#pragma unroll
            for (int n = 0; n < 2; ++n) bv[bj][n] = bias ? *(const f32x4*)(bias + bcol0 + bj * HALF + 4 * n) : (f32x4){0.f, 0.f, 0.f, 0.f};
#pragma unroll
        for (int ai = 0; ai < 2; ++ai)
#pragma unroll
            for (int m = 0; m < 4; ++m) { bf16_t* rowp = base + (size_t)(row0 + ai * HALF + m * 16) * ldc + col0;
#pragma unroll
                for (int bj = 0; bj < 2; ++bj) { f32x4 v0 = acc[ai][bj][m][0] + bv[bj][0], v1 = acc[ai][bj][m][1] + bv[bj][1];
                    if (ACT == 1) { f32x2 a = gelu_pk((f32x2){v0[0], v0[1]}), b = gelu_pk((f32x2){v0[2], v0[3]}), c = gelu_pk((f32x2){v1[0], v1[1]}), d = gelu_pk((f32x2){v1[2], v1[3]});
                        v0 = (f32x4){a.x, a.y, b.x, b.y}; v1 = (f32x4){c.x, c.y, d.x, d.y}; }
                    v0 = v0 * sc; v1 = v1 * sc; u32x4 w; w.x = cvt_pk_bf16(v0[0], v0[1]); w.y = cvt_pk_bf16(v0[2], v0[3]); w.z = cvt_pk_bf16(v1[0], v1[1]); w.w = cvt_pk_bf16(v1[2], v1[3]);
                    *(u32x4*)(rowp + bj * HALF) = w; } }
    }
};
struct EpiResidual {
    static constexpr bool PERM = false, AFTER_DRAIN = false;
    const float* base; float* out; int ldc;
    __device__ __forceinline__ void operator()(const f32x4 (&acc)[2][2][4][2], const Unit& u, int wr, int wc, int fr, int fq) const {
        const int col0 = u.pn * BM + wc * 32 + 4 * fq;
#pragma unroll
        for (int ai = 0; ai < 2; ++ai)
#pragma unroll
            for (int m = 0; m < 4; ++m) { const size_t off = (size_t)(u.pm * BM + ai * HALF + wr * 64 + m * 16 + fr) * ldc + col0;
#pragma unroll
                for (int bj = 0; bj < 2; ++bj)
#pragma unroll
                    for (int n = 0; n < 2; ++n) { const f32x4 bs = *(const f32x4*)(base + off + bj * HALF + n * 16); *(f32x4*)(out + off + bj * HALF + n * 16) = bs + acc[ai][bj][m][n]; }
                if (m & 1) asm volatile("" ::: "memory"); }
    }
};
struct EpiSwiGLU {
    static constexpr bool PERM = true, AFTER_DRAIN = false;
    bf16_t* O; int ldc;
    __device__ __forceinline__ void operator()(const f32x4 (&acc)[2][2][4][2], const Unit& u, int wr, int wc, int fr, int fq) const {
        const int col0 = u.pn * HALF + wc * 32 + 8 * fq;
#pragma unroll
        for (int ai = 0; ai < 2; ++ai)
#pragma unroll
            for (int m = 0; m < 4; ++m) { bf16_t* rowp = O + (size_t)(u.pm * BM + ai * HALF + wr * 64 + m * 16 + fr) * ldc + col0;
                float r[8];
#pragma unroll
                for (int n = 0; n < 2; ++n)
#pragma unroll
                    for (int j = 0; j < 4; ++j) { const float g = acc[ai][0][m][n][j], up = acc[ai][1][m][n][j]; r[n * 4 + j] = g * __builtin_amdgcn_rcpf(1.f + __expf(-g)) * up; }
                u32x4 w; w.x = cvt_pk_bf16(r[0], r[1]); w.y = cvt_pk_bf16(r[2], r[3]); w.z = cvt_pk_bf16(r[4], r[5]); w.w = cvt_pk_bf16(r[6], r[7]);
                *(u32x4*)rowp = w; }
    }
};
template <class Epi, class Sched, bool ALIGN_EPI = false, bool SP2 = false>
__device__ __forceinline__ void gemm_phase(PG8_LAS unsigned char* lds, const Gemm g, const Sched& S, const Epi& E) {
    const int tid = threadIdx.x, wid = __builtin_amdgcn_readfirstlane(tid >> 6), lane = tid & 63, wr = wid >> 2, wc = wid & 3, fr = lane & 15, fq = lane >> 4;
    const int K = g.K, nt = K / BK;
    unsigned voffA[2], voffB[2];
#pragma unroll
    for (int i = 0; i < 2; ++i) { int R, C; stage_rc(tid * 16 + i * 8192, R, C); const int Rb = Epi::PERM ? ((R & ~31) + perm32(R & 31)) : R;
        voffA[i] = (unsigned)(R * K + C) * 2u; voffB[i] = (unsigned)(Rb * K + C) * 2u; }
    const size_t kstep = (size_t)(BK * 2);
    const size_t hstep = (size_t)HALF * K * 2;
    const size_t tstep = 2 * hstep;
    const unsigned ldsw = (unsigned)wid * 1024u;
    const int aoff = lds_byte(wr * 64 + fr, fq * 8), boff = lds_byte(wc * 32 + fr, fq * 8);
#define PG8_SA(b, h) (((b) * 2 + (h)) * HTB)
#define PG8_SB(b, h) ((4 + (b) * 2 + (h)) * HTB)
#define PG8_STAGE(bufoff, gbase, voff) do { _Pragma("unroll") for (int _i = 0; _i < 2; ++_i) \
        __builtin_amdgcn_global_load_lds((const unsigned*)((const char*)(gbase) + (voff)[_i]), (PG8_LAS unsigned*)(lds + (bufoff) + ldsw + _i * 8192), 16, 0, 0); } while (0)
#define PG8_LDA(dst, b, h) do { _Pragma("unroll") for (int m = 0; m < 4; ++m) _Pragma("unroll") for (int k = 0; k < 2; ++k) dst[m][k] = *(const PG8_LAS bf16x8*)(lds + PG8_SA(b, h) + aoff + m * 2048 + k * 1024); } while (0)
#define PG8_LDB(dst, b, h) do { _Pragma("unroll") for (int n = 0; n < 2; ++n) _Pragma("unroll") for (int k = 0; k < 2; ++k) dst[n][k] = *(const PG8_LAS bf16x8*)(lds + PG8_SB(b, h) + boff + n * 2048 + k * 1024); } while (0)
#define PG8_MMA(ai, bj, At, Bt) do { __builtin_amdgcn_s_setprio(1); _Pragma("unroll") for (int m = 0; m < 4; ++m) _Pragma("unroll") for (int n = 0; n < 2; ++n) _Pragma("unroll") for (int k = 0; k < 2; ++k) \
        acc[ai][bj][m][n] = __builtin_amdgcn_mfma_f32_16x16x32_bf16(Bt[n][k], At[m][k], acc[ai][bj][m][n], 0, 0, 0); __builtin_amdgcn_s_setprio(0); } while (0)
#define PG8_WAIT_V(n) asm volatile("s_waitcnt vmcnt(" #n ")" ::: "memory")
#define PG8_WAIT_L(n) asm volatile("s_waitcnt lgkmcnt(" #n ")" ::: "memory")
#define PG8_BAR __builtin_amdgcn_s_barrier()
#define PG8_SCHED __builtin_amdgcn_sched_barrier(0)
    Unit cur, nxt; int ui = 0;
    if (!S.next(0, cur)) return;
    f32x4 acc[2][2][4][2];
#pragma unroll
    for (int a = 0; a < 2; ++a)
#pragma unroll
        for (int b = 0; b < 2; ++b)
#pragma unroll
            for (int m = 0; m < 4; ++m)
#pragma unroll
                for (int n = 0; n < 2; ++n) acc[a][b][m][n] = (f32x4){0.f, 0.f, 0.f, 0.f};
    bf16x8 At[4][2], B0[2][2], B1[2][2];
    const char* cA = (const char*)g.A + (size_t)cur.pm * tstep; const char* cB = (const char*)g.Bt + (size_t)cur.pn * tstep;
    S.a_ready(cur);
    if constexpr (SP2) {
        PG8_STAGE(PG8_SB(0, 0), cB, voffB); PG8_STAGE(PG8_SB(0, 1), cB + hstep, voffB); PG8_STAGE(PG8_SA(0, 0), cA, voffA); PG8_STAGE(PG8_SA(0, 1), cA + hstep, voffA);
        if (wr == 1) PG8_BAR;
        PG8_WAIT_V(2); PG8_BAR;
        PG8_STAGE(PG8_SB(1, 0), cB + kstep, voffB); PG8_STAGE(PG8_SA(1, 0), cA + kstep, voffA); PG8_STAGE(PG8_SB(1, 1), cB + hstep + kstep, voffB);
        PG8_WAIT_V(6); PG8_BAR;
    } else {
        PG8_STAGE(PG8_SB(0, 0), cB, voffB); PG8_STAGE(PG8_SA(0, 0), cA, voffA); PG8_STAGE(PG8_SB(0, 1), cB + hstep, voffB); PG8_STAGE(PG8_SA(0, 1), cA + hstep, voffA);
        if (wr == 1) PG8_BAR;
        PG8_WAIT_V(4); PG8_BAR;
        PG8_STAGE(PG8_SB(1, 0), cB + kstep, voffB); PG8_STAGE(PG8_SA(1, 0), cA + kstep, voffA); PG8_STAGE(PG8_SB(1, 1), cB + hstep + kstep, voffB);
        PG8_WAIT_V(6); PG8_BAR;
    }
    for (;;) {
        const bool has_next = S.next(ui + 1, nxt);
        const char* nA = has_next ? (const char*)g.A + (size_t)nxt.pm * tstep : cA; const char* nB = has_next ? (const char*)g.Bt + (size_t)nxt.pn * tstep : cB;
        for (int t = 0; t < nt; t += 2) {
            const bool last = (t == nt - 2);
            const char* a1 = cA + (size_t)(t + 1) * kstep;
            const char* a2 = last ? nA : cA + (size_t)(t + 2) * kstep; const char* b2 = last ? nB : cB + (size_t)(t + 2) * kstep;
            const char* a3 = a2 + kstep; const char* b3 = b2 + kstep;
            if (last && has_next) S.a_ready(nxt);
            if constexpr (SP2) {
            PG8_LDB(B0, 0, 0); PG8_LDB(B1, 0, 1); PG8_SCHED; PG8_LDA(At, 0, 0); PG8_STAGE(PG8_SA(1, 1), a1 + hstep, voffA);
            PG8_WAIT_V(8); PG8_WAIT_L(0); PG8_BAR; PG8_MMA(0, 0, At, B0); PG8_MMA(0, 1, At, B1); PG8_BAR; PG8_SCHED;
            PG8_LDA(At, 0, 1); PG8_STAGE(PG8_SB(0, 0), b2, voffB); PG8_STAGE(PG8_SB(0, 1), b2 + hstep, voffB); PG8_STAGE(PG8_SA(0, 0), a2, voffA);
            PG8_WAIT_V(8); PG8_WAIT_L(0); PG8_BAR; PG8_MMA(1, 0, At, B0); PG8_MMA(1, 1, At, B1); PG8_BAR; PG8_SCHED;
            PG8_LDB(B0, 1, 0); PG8_LDB(B1, 1, 1); PG8_SCHED; PG8_LDA(At, 1, 0); PG8_STAGE(PG8_SA(0, 1), a2 + hstep, voffA);
            PG8_WAIT_V(8); PG8_WAIT_L(0); PG8_BAR; PG8_MMA(0, 0, At, B0); PG8_MMA(0, 1, At, B1); PG8_BAR; PG8_SCHED;
            PG8_LDA(At, 1, 1); PG8_STAGE(PG8_SB(1, 0), b3, voffB); PG8_STAGE(PG8_SB(1, 1), b3 + hstep, voffB); PG8_STAGE(PG8_SA(1, 0), a3, voffA);
            PG8_WAIT_V(8); PG8_WAIT_L(0); PG8_BAR; PG8_MMA(1, 0, At, B0); PG8_MMA(1, 1, At, B1); PG8_BAR; PG8_SCHED;
            } else {
            PG8_LDB(B0, 0, 0); PG8_SCHED; PG8_LDA(At, 0, 0); PG8_STAGE(PG8_SA(1, 1), a1 + hstep, voffA);
            PG8_WAIT_L(8); PG8_BAR; PG8_WAIT_L(0); PG8_MMA(0, 0, At, B0); PG8_BAR; PG8_SCHED;
            PG8_LDB(B1, 0, 1); PG8_STAGE(PG8_SB(0, 0), b2, voffB);
            PG8_BAR; PG8_WAIT_L(0); PG8_MMA(0, 1, At, B1); PG8_BAR;
            PG8_LDA(At, 0, 1); PG8_STAGE(PG8_SA(0, 0), a2, voffA);
            PG8_BAR; PG8_WAIT_L(0); PG8_MMA(1, 0, At, B0); PG8_BAR; PG8_SCHED;
            PG8_STAGE(PG8_SB(0, 1), b2 + hstep, voffB);
            PG8_WAIT_V(6); PG8_BAR; PG8_MMA(1, 1, At, B1); PG8_BAR;
            PG8_LDB(B0, 1, 0); PG8_SCHED; PG8_LDA(At, 1, 0); PG8_STAGE(PG8_SA(0, 1), a2 + hstep, voffA);
            PG8_WAIT_L(8); PG8_BAR; PG8_WAIT_L(0); PG8_MMA(0, 0, At, B0); PG8_BAR; PG8_SCHED;
            PG8_LDB(B1, 1, 1); PG8_STAGE(PG8_SB(1, 0), b3, voffB);
            PG8_BAR; PG8_WAIT_L(0); PG8_MMA(0, 1, At, B1); PG8_BAR;
            PG8_LDA(At, 1, 1); PG8_STAGE(PG8_SA(1, 0), a3, voffA);
            PG8_BAR; PG8_WAIT_L(0); PG8_MMA(1, 0, At, B0); PG8_BAR; PG8_SCHED;
            PG8_STAGE(PG8_SB(1, 1), b3 + hstep, voffB);
            PG8_WAIT_V(6); PG8_BAR; PG8_MMA(1, 1, At, B1); PG8_BAR;
            }
        }
        if constexpr (ALIGN_EPI) { if (wr == 0) PG8_BAR; }
        if constexpr (!Epi::AFTER_DRAIN) { E(acc, cur, wr, wc, fr, fq); S.done(cur); }
        if (!has_next) break;
#pragma unroll
        for (int a = 0; a < 2; ++a)
#pragma unroll
            for (int b = 0; b < 2; ++b)
#pragma unroll
                for (int m = 0; m < 4; ++m)
#pragma unroll
                    for (int n = 0; n < 2; ++n) acc[a][b][m][n] = (f32x4){0.f, 0.f, 0.f, 0.f};
        cur = nxt; cA = nA; cB = nB; ++ui;
        if constexpr (ALIGN_EPI) { if (wr == 1) PG8_BAR; }
    }
    PG8_WAIT_V(0);
    if constexpr (!ALIGN_EPI) { if (wr == 0) PG8_BAR; }
    PG8_BAR;
    if constexpr (Epi::AFTER_DRAIN) { E.fused(acc, cur, wr, wc, fr, fq, lds, wid, lane); S.done(cur); }
#undef PG8_SA
#undef PG8_SB
#undef PG8_STAGE
#undef PG8_LDA
#undef PG8_LDB
#undef PG8_MMA
#undef PG8_WAIT_V
#undef PG8_WAIT_L
#undef PG8_BAR
#undef PG8_SCHED
}
}

#ifndef PG8_SP2
#define PG8_SP2 true
#endif
#define PG8_ALIGN true
constexpr int NWAVES = 8;
constexpr int BATCH = 2, SEQ = 8192, DM = 1024, M = BATCH * SEQ, NIN = 3788, NINP = 3840, FFN = 2816, DEPTH = 2;
constexpr int A_Q = 0, A_K = 256, A_V = 512, A_O = 768;
constexpr int R_R = 1024, R_K = 1408, R_V = 1792, R_WDF = 2176, R_AD = 2304, R_GD = 2368;
constexpr int S_Z = 2496, S_X = 2880, S_B = 3264, S_C = 3520, S_DT = 3776;
constexpr size_t MiB = 1u << 20;
constexpr size_t WS_CTL = 0, CTL_ZERO_BYTES = 128 * 1024;
constexpr size_t WS_GATES = 1 * MiB, WS_CT = 2 * MiB, WS_DTV = 2 * MiB + 512 * 1024;
constexpr size_t WS_GUT = 31 * MiB;
constexpr size_t WS_WIN = 4 * MiB, WS_WOUT = 12 * MiB, WS_WGU = 14 * MiB, WS_WDN = 25 * MiB;
constexpr size_t WS_XN = 32 * MiB, WS_COLS = 64 * MiB, WS_Y = 184 * MiB, WS_END = 256 * MiB;
constexpr size_t Y_AF = WS_Y, Y_AB = WS_Y + 8 * MiB, Y_RF = WS_Y + 16 * MiB, Y_RB = WS_Y + 28 * MiB, Y_SF = WS_Y + 40 * MiB, Y_SB = WS_Y + 52 * MiB;
constexpr int CW_BAR = 1024;
constexpr int RING_BYTES = 131072;
constexpr int LDS_BYTES = 147456, MISC_OFF = LDS_BYTES - 256;

#define GAS __attribute__((address_space(1)))
#define LAS __attribute__((address_space(3)))
typedef unsigned short bf16;
typedef unsigned v4u __attribute__((ext_vector_type(4)));
typedef unsigned v2u __attribute__((ext_vector_type(2)));
typedef float f32x4 __attribute__((ext_vector_type(4)));
typedef short bf16x8 __attribute__((ext_vector_type(8)));
typedef GAS unsigned gu32;
#define RLX_AGENT __ATOMIC_RELAXED, __HIP_MEMORY_SCOPE_AGENT
#define LDS_WAIT() asm volatile("s_waitcnt lgkmcnt(0)" ::: "memory")
#define VM_WAIT() asm volatile("s_waitcnt vmcnt(0)" ::: "memory")
__device__ __forceinline__ unsigned f2bf(float f) { unsigned u = __builtin_bit_cast(unsigned, f); return (u + 0x7fffu + ((u >> 16) & 1u)) >> 16; }
__device__ __forceinline__ unsigned pk2(float lo, float hi) { return f2bf(lo) | (f2bf(hi) << 16); }
__device__ __forceinline__ float bf2f(unsigned u) { return __builtin_bit_cast(float, u << 16); }
__device__ __forceinline__ float sigmoidf_(float x) { return __builtin_amdgcn_rcpf(1.f + __expf(-x)); }
__device__ __forceinline__ float siluf_(float x) { return x * sigmoidf_(x); }
__device__ __forceinline__ float wave_sum(float v) {
#pragma unroll
    for (int o = 1; o < 64; o <<= 1) v += __shfl_xor(v, o);
    return v;
}
__device__ __forceinline__ float wave_max(float v) {
#pragma unroll
    for (int o = 1; o < 64; o <<= 1) v = fmaxf(v, __shfl_xor(v, o));
    return v;
}
template <int CTRL> __device__ __forceinline__ float dppf(float v) { return __builtin_bit_cast(float, __builtin_amdgcn_update_dpp(0, __builtin_bit_cast(int, v), CTRL, 0xf, 0xf, true)); }
__device__ __forceinline__ float row16_sum(float v) { v += dppf<0xB1>(v); v += dppf<0x4E>(v); v += dppf<0x141>(v); v += dppf<0x140>(v); return v; }
template <int K> __device__ __forceinline__ f32x4 mma16(const LAS bf16* A, int lda, const LAS bf16* Bt, int ldb, f32x4 acc, int lane) {
    const int r = lane & 15, q = lane >> 4;
    const LAS bf16* ap = A + r * lda + q * 8; const LAS bf16* bp = Bt + r * ldb + q * 8;
#pragma unroll
    for (int k0 = 0; k0 < K; k0 += 32) {
        const bf16x8 a = *(const LAS bf16x8*)(ap + k0); const bf16x8 b = *(const LAS bf16x8*)(bp + k0);
        acc = __builtin_amdgcn_mfma_f32_16x16x32_bf16(a, b, acc, 0, 0, 0);
    }
    return acc;
}

__device__ __forceinline__ int swz64(int row, int col) { return col ^ (((row >> 3) & 7) << 3); }
template <bool SWA, bool SWB> __device__ __forceinline__ f32x4 mma16s(const LAS bf16* A, int lda, int rowA0, const LAS bf16* Bt, int ldb, int rowB0, f32x4 acc, int lane) {
    const int r = lane & 15, q = lane >> 4; const int ra = rowA0 + r, rb = rowB0 + r;
#pragma unroll
    for (int k0 = 0; k0 < 64; k0 += 32) { const int ca = k0 + 8 * q, cb = k0 + 8 * q;
        const bf16x8 a = *(const LAS bf16x8*)(A + ra * lda + (SWA ? swz64(ra, ca) : ca)); const bf16x8 b = *(const LAS bf16x8*)(Bt + rb * ldb + (SWB ? swz64(rb, cb) : cb));
        acc = __builtin_amdgcn_mfma_f32_16x16x32_bf16(a, b, acc, 0, 0, 0); }
    return acc;
}

template <int CTRL, int RM, int BM> __device__ __forceinline__ float dppm(float oldv, float v) { return __builtin_bit_cast(float, __builtin_amdgcn_update_dpp(__builtin_bit_cast(int, oldv), __builtin_bit_cast(int, v), CTRL, RM, BM, false)); }
__device__ __forceinline__ float wave_scan_add(float x) {
    float y = x + dppm<0x111, 0xf, 0xf>(0.f, x); y += dppm<0x112, 0xf, 0xf>(0.f, x); y += dppm<0x113, 0xf, 0xf>(0.f, x);
    y += dppm<0x114, 0xf, 0xe>(0.f, y); y += dppm<0x118, 0xf, 0xc>(0.f, y);
    y += dppm<0x142, 0xa, 0xf>(0.f, y); y += dppm<0x143, 0xc, 0xf>(0.f, y);
    return y;
}
__device__ __forceinline__ float wave_scan_max(float x) {
    const float ninf = -INFINITY;
    float y = fmaxf(x, dppm<0x111, 0xf, 0xf>(ninf, x)); y = fmaxf(y, dppm<0x112, 0xf, 0xf>(ninf, x)); y = fmaxf(y, dppm<0x113, 0xf, 0xf>(ninf, x));
    y = fmaxf(y, dppm<0x114, 0xf, 0xe>(ninf, y)); y = fmaxf(y, dppm<0x118, 0xf, 0xc>(ninf, y));
    y = fmaxf(y, dppm<0x142, 0xa, 0xf>(ninf, y)); y = fmaxf(y, dppm<0x143, 0xc, 0xf>(ninf, y));
    return y;
}
__device__ __forceinline__ float row8_sum(float v) { v += dppf<0xB1>(v); v += dppf<0x4E>(v); v += dppf<0x141>(v); return v; }
#define XB_TMO      128
#define XB_XCNT(j)  (256  + 64 * (j))
#define XB_XSUB(j)  (1280 + 64 * (j))
#define XB_XGEN(j)  (2304 + 64 * (j))
#define XB_TOP      3328
#define XB_TOPGEN   3392
#define XCD_BAR_WORDS 3456
#define XB_SPIN_CAP (1u << 18)

__device__ __forceinline__ unsigned xb_ld(unsigned* p)              { return __hip_atomic_load(p, __ATOMIC_RELAXED, __HIP_MEMORY_SCOPE_AGENT); }
__device__ __forceinline__ unsigned xb_add(unsigned* p, unsigned v) { return __hip_atomic_fetch_add(p, v, __ATOMIC_RELAXED, __HIP_MEMORY_SCOPE_AGENT); }
__device__ __forceinline__ unsigned xb_xcc_id() { return (unsigned)__builtin_amdgcn_s_getreg((3 << 11) | 20) & 0xFu; }
#define XB_SPIN(cond, bar) do { unsigned _sp = 0; while (cond) { __builtin_amdgcn_s_sleep(1); \
    if ((++_sp & 255u) == 0u) { if (xb_ld(&(bar)[XB_TMO])) break; if (_sp > XB_SPIN_CAP) { atomicAdd(&(bar)[XB_TMO], 1u); break; } } } } while (0)

struct XcdBarrier {
    unsigned* bar; unsigned x;
    volatile LAS unsigned* st;
};

__device__ __forceinline__ XcdBarrier xcd_barrier_post(unsigned* bar, volatile LAS unsigned* st) {
    XcdBarrier b; b.bar = bar; b.x = xb_xcc_id(); b.st = st;
    if (threadIdx.x == 0) (void)xb_add(&bar[XB_XCNT(b.x)], 1u);
    return b;
}
__device__ __forceinline__ void xcd_barrier_complete(unsigned* bar, unsigned x, unsigned& nloc, unsigned& nx) {
    const unsigned G = gridDim.x * gridDim.y * gridDim.z;
    unsigned sum, cnt, mine, sp = 0u;
    for (;;) {
        sum = 0u; cnt = 0u; mine = 0u;
#pragma unroll
        for (unsigned j = 0; j < 16; ++j) { const unsigned c = xb_ld(&bar[XB_XCNT(j)]); sum += c; cnt += (c > 0u) ? 1u : 0u; mine = (j == x) ? c : mine; }
        if (sum == G) break;
        __builtin_amdgcn_s_sleep(1);
        if ((++sp & 255u) == 0u) { if (xb_ld(&bar[XB_TMO])) break; if (sp > XB_SPIN_CAP) { atomicAdd(&bar[XB_TMO], 1u); break; } }
    }
    nloc = mine > 0u ? mine : 1u; nx = cnt > 0u ? cnt : 1u;
}

__device__ __forceinline__ void xcd_barrier(const XcdBarrier& b) {
    asm volatile("s_waitcnt vmcnt(0)" ::: "memory");
    __syncthreads();
    if (threadIdx.x == 0) {
        unsigned* bar = b.bar;
        __builtin_amdgcn_s_waitcnt(0);
        unsigned nloc = b.st[0], nx = b.st[1];
        if (nloc == 0u) { xcd_barrier_complete(bar, b.x, nloc, nx); b.st[0] = nloc; b.st[1] = nx; }
        const unsigned old = xb_add(&bar[XB_XSUB(b.x)], 1u);
        const unsigned gen = old / nloc;
        if (old + 1u == (gen + 1u) * nloc) {
            __builtin_amdgcn_fence(__ATOMIC_RELEASE, "agent");
            asm volatile("s_waitcnt vmcnt(0)" ::: "memory");
            const unsigned og = xb_add(&bar[XB_TOP], 1u);
            const unsigned tg = og / nx;
            if (og + 1u == (tg + 1u) * nx) xb_add(&bar[XB_TOPGEN], 1u);
            else XB_SPIN(xb_ld(&bar[XB_TOPGEN]) == tg, bar);
            __builtin_amdgcn_fence(__ATOMIC_ACQUIRE, "agent");
            xb_add(&bar[XB_XGEN(b.x)], 1u);
            asm volatile("s_waitcnt vmcnt(0)" ::: "memory");
        } else {
            XB_SPIN(xb_ld(&bar[XB_XGEN(b.x)]) == gen, bar);
            __builtin_amdgcn_fence(__ATOMIC_ACQUIRE, "agent");
            asm volatile("s_waitcnt vmcnt(0)" ::: "memory");
        }
    }
    __syncthreads();
}
struct Frame {
    LAS unsigned char* lds;
    int tid, lane, wave, vcu, G;
};
struct Args { const float* in[32]; float* out; unsigned char* ws; int ph_lo, ph_hi; };
constexpr int PTAB_OFF = LDS_BYTES - 768;
__device__ __forceinline__ unsigned long long ptab_ld(const Frame& F, int i) {
    const unsigned long long v = *(volatile LAS unsigned long long*)(F.lds + PTAB_OFF + 8 * i);
    const unsigned lo = __builtin_amdgcn_readfirstlane((unsigned)v), hi = __builtin_amdgcn_readfirstlane((unsigned)(v >> 32));
    return ((unsigned long long)hi << 32) | lo;
}
__device__ __forceinline__ const GAS float* INP(const Frame& F, int i) { return (const GAS float*)ptab_ld(F, i); }
__device__ __forceinline__ GAS unsigned char* WSP(const Frame& F) { return (GAS unsigned char*)ptab_ld(F, 33); }
__device__ __forceinline__ GAS float* OUTP(const Frame& F) { return (GAS float*)ptab_ld(F, 32); }
__device__ __forceinline__ void transpose_item(const GAS float* W, int K, int N, int nblk, GAS bf16* WT, int mode, int row_off, LAS float* scr, int item, int lane) {
    const int kb = item / nblk, nb = item % nblk, k0 = 64 * kb, n0 = 32 * nb;
    const int ncol = n0 + (lane & 31); const bool ok = ncol < N;
#pragma unroll 8
    for (int i = 0; i < 32; ++i) { const int kk = 2 * i + (lane >> 5); scr[kk * 33 + (lane & 31)] = ok ? W[(size_t)(k0 + kk) * N + ncol] : 0.f; }
    LDS_WAIT(); asm volatile("" ::: "memory");
    const int c = lane & 7;
    const int drow0 = mode ? (256 * (n0 >> 7) + (n0 & 127) + row_off) : (row_off + n0);
#pragma unroll
    for (int j = 0; j < 4; ++j) { const int n = (lane >> 3) + 8 * j; const LAS float* s = scr + (8 * c) * 33 + n;
        v4u o; o.x = pk2(s[0 * 33], s[1 * 33]); o.y = pk2(s[2 * 33], s[3 * 33]); o.z = pk2(s[4 * 33], s[5 * 33]); o.w = pk2(s[6 * 33], s[7 * 33]);
        *(GAS v4u*)(WT + (size_t)(drow0 + n) * K + k0 + 8 * c) = o; }
    LDS_WAIT(); asm volatile("" ::: "memory");
}
__device__ __forceinline__ void phase_convert(const Frame& F, int l) {
    LAS float* scr = (LAS float*)(F.lds + F.wave * 16384);
    const int gw = F.vcu * NWAVES + F.wave, NGW = F.G * NWAVES;
    GAS bf16* Win = (GAS bf16*)(WSP(F) + WS_WIN); GAS bf16* Wout = (GAS bf16*)(WSP(F) + WS_WOUT); GAS bf16* Wgu = (GAS bf16*)(WSP(F) + WS_WGU); GAS bf16* Wdn = (GAS bf16*)(WSP(F) + WS_WDN);
    constexpr int I_IN = 16 * 120, I_OUT = 16 * 32, I_G = 16 * 88, I_D = 44 * 32, I_GU = 2 * 12;
    constexpr int NITEMS = I_IN + I_OUT + 2 * I_G + I_D + I_GU;
    for (int it = gw; it < NITEMS; it += NGW) {
        int r = it;
        if (r < I_IN) { transpose_item(INP(F, 2) + (size_t)l * DM * NIN, DM, NIN, 120, Win, 0, 0, scr, r, F.lane); continue; } r -= I_IN;
        if (r < I_OUT) { transpose_item(INP(F, 26) + (size_t)l * DM * DM, DM, DM, 32, Wout, 0, 0, scr, r, F.lane); continue; } r -= I_OUT;
        if (r < I_G) { transpose_item(INP(F, 28) + (size_t)l * DM * FFN, DM, FFN, 88, Wgu, 1, 0, scr, r, F.lane); continue; } r -= I_G;
        if (r < I_G) { transpose_item(INP(F, 29) + (size_t)l * DM * FFN, DM, FFN, 88, Wgu, 1, 128, scr, r, F.lane); continue; } r -= I_G;
        if (r < I_D) { transpose_item(INP(F, 30) + (size_t)l * FFN * DM, FFN, DM, 32, Wdn, 0, 0, scr, r, F.lane); continue; } r -= I_D;
        transpose_item(INP(F, 14) + (size_t)l * 128 * 384, 128, 384, 12, (GAS bf16*)(WSP(F) + WS_GUT), 0, 0, scr, r, F.lane);
    }
}
__device__ __forceinline__ void phase_norm(const Frame& F, const GAS float* hin, const GAS float* g, GAS bf16* XN) {
    const int gw = F.vcu * NWAVES + F.wave, NGW = F.G * NWAVES;
    f32x4 gv[4];
#pragma unroll
    for (int j = 0; j < 4; ++j) gv[j] = ((const GAS f32x4*)g)[64 * j + F.lane];
    for (int m = gw; m < M; m += NGW) {
        const GAS f32x4* xr = (const GAS f32x4*)(hin + (size_t)m * DM) + F.lane;
        f32x4 v[4]; float s = 0.f;
#pragma unroll
        for (int j = 0; j < 4; ++j) { v[j] = xr[64 * j]; s += (v[j].x * v[j].x + v[j].y * v[j].y) + (v[j].z * v[j].z + v[j].w * v[j].w); }
        const float r = __builtin_amdgcn_rsqf(wave_sum(s) * (1.f / DM) + 1e-6f);
        GAS v2u* o8 = (GAS v2u*)(XN + (size_t)m * DM) + F.lane;
#pragma unroll
        for (int j = 0; j < 4; ++j) { v2u w; w.x = pk2(v[j].x * r * gv[j].x, v[j].y * r * gv[j].y); w.y = pk2(v[j].z * r * gv[j].z, v[j].w * r * gv[j].w); o8[64 * j] = w; }
    }
}
__device__ __forceinline__ void phase_final_norm(const Frame& F, GAS float* h, const GAS float* g) {
    const int gw = F.vcu * NWAVES + F.wave, NGW = F.G * NWAVES;
    f32x4 gv[4];
#pragma unroll
    for (int j = 0; j < 4; ++j) gv[j] = ((const GAS f32x4*)g)[64 * j + F.lane];
    for (int m = gw; m < M; m += NGW) {
        GAS f32x4* xr = (GAS f32x4*)(h + (size_t)m * DM) + F.lane;
        f32x4 v[4]; float s = 0.f;
#pragma unroll
        for (int j = 0; j < 4; ++j) { v[j] = xr[64 * j]; s += (v[j].x * v[j].x + v[j].y * v[j].y) + (v[j].z * v[j].z + v[j].w * v[j].w); }
        const float r = __builtin_amdgcn_rsqf(wave_sum(s) * (1.f / DM) + 1e-6f);
#pragma unroll
        for (int j = 0; j < 4; ++j) xr[64 * j] = v[j] * r * gv[j];
    }
}
__device__ __forceinline__ void phase_gates(const Frame& F, int l) {
    const GAS bf16* cols = (const GAS bf16*)(WSP(F) + WS_COLS); GAS float* GT = (GAS float*)(WSP(F) + WS_GATES);
    LAS bf16* raw = (LAS bf16*)(F.lds);
    LAS bf16* featb = (LAS bf16*)(F.lds + 30720);
    LAS bf16* gwT = (LAS bf16*)(F.lds + 55552);
    LAS float* outp = (LAS float*)(F.lds + 80384);
    const GAS float* gwg = INP(F, 5) + (size_t)l * 768 * 16; const GAS float* gb = INP(F, 6) + l * 16;
    const int tid = F.tid, lane = F.lane, wave = F.wave;
    __syncthreads();
    for (int i = tid; i < 768 * 16; i += 512) gwT[(i & 15) * 776 + (i >> 4)] = (bf16)f2bf(gwg[i]);
    float cw[5]; { const GAS float* cwp = INP(F, 3) + (size_t)l * 5 * 512;
#pragma unroll
        for (int j = 0; j < 5; ++j) cw[j] = cwp[j * 512 + tid]; }
    const float cbv = INP(F, 4)[l * 512 + tid];
    const float gbv = gb[tid & 15];
    for (int tile = F.vcu; tile < M / 16; tile += F.G) {
        const int m0 = tile * 16, t0 = m0 % SEQ;
        __syncthreads();
        for (int ch = tid; ch < 20 * 96; ch += 512) { const int rr = ch / 96, cc = ch % 96; const int t = t0 - 2 + rr;
            v4u v = {0u, 0u, 0u, 0u}; if (t >= 0 && t < SEQ) v = *(const GAS v4u*)(cols + (size_t)(m0 - 2 + rr) * NINP + cc * 8);
            *(LAS v4u*)(raw + rr * 768 + cc * 8) = v; }
        if (tid < 256) outp[tid] = 0.f;
        __syncthreads();
        { float win[5];
#pragma unroll
          for (int j = 0; j < 4; ++j) win[j] = bf2f(raw[j * 768 + tid]);
#pragma unroll 4
          for (int t = 0; t < 16; ++t) { win[4] = bf2f(raw[(t + 4) * 768 + tid]); float s = cbv;
#pragma unroll
              for (int j = 0; j < 5; ++j) s += cw[j] * win[j];
#pragma unroll
              for (int j = 0; j < 4; ++j) win[j] = win[j + 1];
              featb[t * 776 + tid] = (bf16)f2bf(siluf_(s)); }
          const int t = tid >> 5, c8 = tid & 31; *(LAS v4u*)(featb + t * 776 + 512 + c8 * 8) = *(const LAS v4u*)(raw + (t + 2) * 768 + 512 + c8 * 8); }
        __syncthreads();
        { const f32x4 z = {0.f, 0.f, 0.f, 0.f}; const f32x4 acc = mma16<96>(featb + 96 * wave, 776, gwT + 96 * wave, 776, z, lane);
#pragma unroll
          for (int jj = 0; jj < 4; ++jj) __hip_atomic_fetch_add(outp + ((lane >> 4) * 4 + jj) * 16 + (lane & 15), acc[jj], __ATOMIC_RELAXED, __HIP_MEMORY_SCOPE_WORKGROUP); }
        __syncthreads();
        if (tid < 256) { float s = outp[tid] + gbv; if ((tid & 15) >= 8) s = fminf(s, 0.f) - log1pf(__expf(-fabsf(s))); GT[(size_t)(m0 + (tid >> 4)) * 16 + (tid & 15)] = s; }
    }
    __syncthreads();
}
__device__ __forceinline__ f32x4 mma16_a8(const LAS bf16* A8, const LAS bf16* Bt, f32x4 acc, int lane) {
    const int q = lane >> 4;
    const LAS bf16* ap = A8 + (lane & 7) * 72 + q * 8; const LAS bf16* bp = Bt + (lane & 15) * 72 + q * 8;
#pragma unroll
    for (int k0 = 0; k0 < 64; k0 += 32) { const bf16x8 a = *(const LAS bf16x8*)(ap + k0); const bf16x8 b = *(const LAS bf16x8*)(bp + k0); acc = __builtin_amdgcn_mfma_f32_16x16x32_bf16(a, b, acc, 0, 0, 0); }
    return acc;
}
typedef float f32x2 __attribute__((ext_vector_type(2)));
__device__ __forceinline__ float row16_transpose_sum(float (&p)[16], int j) {
    const bool b0 = j & 1, b1 = j & 2, b2 = j & 4, b3 = j & 8;
    float r[8], s4[4], t2[2];
#pragma unroll
    for (int m = 0; m < 8; ++m) { const float keep = b0 ? p[2 * m + 1] : p[2 * m], send = b0 ? p[2 * m] : p[2 * m + 1]; r[m] = keep + dppf<0xB1>(send); }
#pragma unroll
    for (int m = 0; m < 4; ++m) { const float keep = b1 ? r[2 * m + 1] : r[2 * m], send = b1 ? r[2 * m] : r[2 * m + 1]; s4[m] = keep + dppf<0x4E>(send); }
#pragma unroll
    for (int m = 0; m < 2; ++m) { const float keep = b2 ? s4[2 * m + 1] : s4[2 * m], send = b2 ? s4[2 * m] : s4[2 * m + 1]; t2[m] = keep + __shfl_xor(send, 4); }
    const float keep = b3 ? t2[1] : t2[0], send = b3 ? t2[0] : t2[1];
    return keep + __shfl_xor(send, 8);
}
template <bool DIR> __device__ __forceinline__ void rwkv_steps(const LAS float* OPS, const LAS float* VV, LAS float* YB, f32x4& S, int j, int row) {
    float yk0 = 0.f, yk1 = 0.f; float yp[16];
    const LAS float* opb = OPS + 4 * j; const LAS float* vpb = VV + row;
#define RWLD(W_, KK_, KA_, KM_, R_, V_, tl_) do { const LAS float* op_ = opb + (tl_) * 320; W_ = *(const LAS f32x4*)(op_); KK_ = *(const LAS f32x4*)(op_ + 64); KA_ = *(const LAS f32x4*)(op_ + 128); KM_ = *(const LAS f32x4*)(op_ + 192); R_ = *(const LAS f32x4*)(op_ + 256); V_ = vpb[(tl_) * 16]; } while (0)
    f32x4 w4, kk4, ka4, km4, r4, w4b, kk4b, ka4b, km4b, r4b; float vv, vvb;
    RWLD(w4, kk4, ka4, km4, r4, vv, (DIR ? 31 : 0));
    RWLD(w4b, kk4b, ka4b, km4b, r4b, vvb, (DIR ? 30 : 1));
#pragma unroll
    for (int i = 0; i < 32; ++i) {
        f32x4 nw4, nkk4, nka4, nkm4, nr4; float nvv;
        if (i < 30) RWLD(nw4, nkk4, nka4, nkm4, nr4, nvv, (DIR ? 29 - i : i + 2));
        f32x2 t2 = S.xy * kk4.xy; t2 = S.zw * kk4.zw + t2;
        float sa = t2.x + t2.y;
        const f32x4 pre_s = S * w4 + km4 * vv;
        sa = row16_sum(sa);
        S = pre_s + ka4 * sa;
        f32x2 y2 = S.xy * r4.xy; y2 = S.zw * r4.zw + y2;
        yp[i & 15] = y2.x + y2.y;
        if (i == 15) yk0 = row16_transpose_sum(yp, j);
        if (i == 31) yk1 = row16_transpose_sum(yp, j);
        w4 = w4b; kk4 = kk4b; ka4 = ka4b; km4 = km4b; r4 = r4b; vv = vvb;
        if (i < 30) { w4b = nw4; kk4b = nkk4; ka4b = nka4; km4b = nkm4; r4b = nr4; vvb = nvv; } }
#undef RWLD
    YB[(DIR ? 31 - j : j) * 16 + row] = yk0; YB[(DIR ? 15 - j : 16 + j) * 16 + row] = yk1;
}
struct RwCtx { LAS bf16* WA; LAS bf16* WW; LAS bf16* XA; LAS bf16* XW; LAS bf16* RAWB; LAS float* MU; GAS float* CT; const GAS bf16* colsb;
    f32x4 kk_c4, ka_c4, rk_c4; float ba[4], bw[4]; float mup_[5][2], mun_[5][2]; int h, dir, qtr, tb0; size_t mb; };
template <int NTOK> __device__ __forceinline__ void rw_addr_init(int (&poff)[5], int (&prr)[5], int lane, int tb0, int h, int dir) {
    constexpr int NCHK = (NTOK + 2) * 40;
#pragma unroll
    for (int i = 0; i < 5; ++i) { const int idx = lane + 64 * i; const int rr = idx / 40, q = idx % 40, wh = q >> 3, c8 = q & 7;
        const int gc = (wh == 0 ? R_R + h * 64 : wh == 1 ? R_K + h * 64 : wh == 2 ? R_V + h * 64 : wh == 3 ? R_WDF + dir * 64 : R_AD) + c8 * 8;
        prr[i] = idx < NCHK ? tb0 - 1 + rr : -100000; poff[i] = (tb0 - 1 + rr) * NINP + gc; }
}
template <int NTOK> __device__ __forceinline__ void rw_issue(v4u (&pre)[5], const int (&poff)[5], const int (&prr)[5], const GAS bf16* colsb, int T0) {
    constexpr int NCH = ((NTOK + 2) * 40 + 63) / 64;
#pragma unroll
    for (int i = 0; i < NCH; ++i) { const int t = T0 + prr[i]; const bool ok = t >= 0 && t < SEQ;
        const v4u vv = *(const GAS v4u*)(colsb + (size_t)T0 * NINP + (ok ? poff[i] : 0)); pre[i] = ok ? vv : (v4u){0u, 0u, 0u, 0u}; }
}
template <int NTOK, bool FULLV> __device__ __forceinline__ void rw_prep(const RwCtx& C, const v4u (&pre)[5], LAS float* OPS, LAS float* VV, int T0, int lane) {
    constexpr int NCHK = (NTOK + 2) * 40, NCH = (NCHK + 63) / 64;
    const int j = lane & 15, c2 = (lane & 31) * 2;
#pragma unroll
    for (int i = 0; i < NCH; ++i) { const int idx = lane + 64 * i; if (idx < NCHK) *(LAS v4u*)(C.RAWB + idx * 8) = pre[i]; }
    LDS_WAIT(); asm volatile("" ::: "memory");
#pragma unroll
    for (int which = 0; which < 5; ++which)
#pragma unroll
        for (int pr = 0; pr < NTOK / 2; ++pr) { const int tt = 2 * pr + (lane >> 5), cc = which * 64 + c2, t = C.tb0 + tt;
            const unsigned r0 = *(const LAS unsigned*)(C.RAWB + tt * 320 + cc), r1 = *(const LAS unsigned*)(C.RAWB + (tt + 1) * 320 + cc), r2 = *(const LAS unsigned*)(C.RAWB + (tt + 2) * 320 + cc);
            const float p1x = bf2f(r1 & 0xffffu), p1y = bf2f(r1 >> 16);
            const float vx = p1x + C.mup_[which][0] * (bf2f(r0 & 0xffffu) - p1x) + C.mun_[which][0] * (bf2f(r2 & 0xffffu) - p1x);
            const float vy = p1y + C.mup_[which][1] * (bf2f(r0 >> 16) - p1y) + C.mun_[which][1] * (bf2f(r2 >> 16) - p1y);
            if (which == 0) *(LAS f32x2*)(OPS + t * 320 + 256 + c2) = (f32x2){vx, vy};
            else if (which == 1) *(LAS f32x2*)(OPS + t * 320 + 192 + c2) = (f32x2){vx, vy};
            else if (which == 2) { if (FULLV) *(LAS f32x2*)(VV + t * 64 + c2) = (f32x2){vx, vy}; else if ((c2 >> 4) == C.qtr) *(LAS f32x2*)(VV + t * 16 + (c2 & 15)) = (f32x2){vx, vy}; }
            else if (which == 3) { const float ex = __expf(2.f * vx), ey = __expf(2.f * vy);
                *(LAS unsigned*)(C.XW + tt * 72 + c2) = pk2(1.f - 2.f * __builtin_amdgcn_rcpf(ex + 1.f), 1.f - 2.f * __builtin_amdgcn_rcpf(ey + 1.f)); }
            else *(LAS unsigned*)(C.XA + tt * 72 + c2) = pk2(vx, vy); }
    LDS_WAIT(); asm volatile("" ::: "memory");
    { const bool hi = lane >= 32; const int lr = ((lane >> 4) & 1) * 4 + (hi ? 2 : 0); const bool ok0 = lr < NTOK, ok1 = lr + 1 < NTOK; const int tb = C.tb0 + lr;
#pragma unroll
      for (int ct = 0; ct < 4; ++ct) { const f32x4 z = {0.f, 0.f, 0.f, 0.f};
        const f32x4 ca = mma16_a8(C.XA, C.WA + ct * 16 * 72, z, lane), cw = mma16_a8(C.XW, C.WW + ct * 16 * 72, z, lane);
        const int c = ct * 16 + j;
        const float a0v = hi ? ca[2] : ca[0], a1v = hi ? ca[3] : ca[1], w0v = hi ? cw[2] : cw[0], w1v = hi ? cw[3] : cw[1];
        if (ok0) { OPS[tb * 320 + 128 + c] = sigmoidf_(C.ba[ct] + a0v); OPS[tb * 320 + c] = __expf(-0.6065306597f * sigmoidf_(C.bw[ct] + w0v)); }
        if (ok1) { OPS[(tb + 1) * 320 + 128 + c] = sigmoidf_(C.ba[ct] + a1v); OPS[(tb + 1) * 320 + c] = __expf(-0.6065306597f * sigmoidf_(C.bw[ct] + w1v)); } } }
    LDS_WAIT(); asm volatile("" ::: "memory");
#pragma unroll
    for (int ps = 0; ps < (NTOK + 3) / 4; ++ps) { const int tl = 4 * ps + (lane >> 4); const bool ok = tl < NTOK; const int t = C.tb0 + (ok ? tl : 0); LAS float* op = OPS + t * 320 + 4 * j;
        const f32x4 av = *(const LAS f32x4*)(op + 128), kp = *(const LAS f32x4*)(op + 192), rp = *(const LAS f32x4*)(op + 256);
        const f32x4 kr = kp * C.kk_c4; const float ss = row16_sum((kr.x * kr.x + kr.y * kr.y) + (kr.z * kr.z + kr.w * kr.w));
        const f32x4 kkv = kr * __builtin_amdgcn_rcpf(fmaxf(__builtin_amdgcn_sqrtf(ss), 1e-12f));
        const f32x4 km = kp * ((av - 1.f) * C.ka_c4 + 1.f);
        const f32x4 q = rp * km * C.rk_c4; const float cs = row16_sum((q.x + q.y) + (q.z + q.w));
        if (ok) { *(LAS f32x4*)(op + 64) = kkv; *(LAS f32x4*)(op + 128) = kkv * (-av); *(LAS f32x4*)(op + 192) = km;
            if (C.dir == 0 && C.qtr == 0 && j == 0) C.CT[(C.mb + T0 + t) * 8 + C.h] = cs; } }
}

constexpr int RW_NSLOT = 6, RW_SLOT_WORDS = 32 * 320 + 32 * 64;
constexpr size_t WS_RING = 248 * MiB;
constexpr int CW_RW = 8192;
__device__ __forceinline__ unsigned rw_ld(GAS unsigned* p) { return __hip_atomic_load(p, __ATOMIC_RELAXED, __HIP_MEMORY_SCOPE_AGENT); }
__device__ __forceinline__ void rw_st(GAS unsigned* p, unsigned v) { __hip_atomic_store(p, v, __ATOMIC_RELAXED, __HIP_MEMORY_SCOPE_AGENT); }
__device__ __forceinline__ void rwkv_produce(const Frame& F, int l, int p, int pp, unsigned G0) {
    const int b = p / 12, rem = p % 12, h = rem >> 1, dir = rem & 1;
    const GAS bf16* cols = (const GAS bf16*)(WSP(F) + WS_COLS);
    const int tid = F.tid, lane = F.lane, wave = F.wave;
    LAS bf16* WA = (LAS bf16*)(F.lds); LAS bf16* WW = (LAS bf16*)(F.lds + 9216);
    LAS float* MU = (LAS float*)(F.lds + 67584);
    LAS float* OPS = (LAS float*)(F.lds + 70144);
    LAS float* VV = (LAS float*)(F.lds + 111104);
    LAS unsigned* flg = (LAS unsigned*)(F.lds + 119296);
    GAS unsigned* ctl = (GAS unsigned*)(WSP(F) + WS_CTL) + CW_RW + 384 * p;
    GAS unsigned long long* ring = (GAS unsigned long long*)(WSP(F) + WS_RING) + (size_t)p * RW_NSLOT * (RW_SLOT_WORDS / 2);
    constexpr int NB = SEQ / 32;
    __syncthreads();
    { const GAS float* aup = INP(F, 13) + (size_t)l * 64 * 384; const GAS float* wup = INP(F, 11) + (size_t)(l * 2 + dir) * 64 * 384;
      for (int idx = tid; idx < 4096; idx += 512) { const int i = idx >> 6, c = idx & 63;
          WA[c * 72 + i] = (bf16)f2bf(aup[i * 384 + h * 64 + c]); WW[c * 72 + i] = (bf16)f2bf(wup[i * 384 + h * 64 + c]); }
      if (tid < 320) { const int which = tid >> 6, c = tid & 63;
          const int rc = which == 0 ? h * 64 + c : which == 1 ? 384 + h * 64 + c : which == 2 ? 768 + h * 64 + c : which == 3 ? 1152 + dir * 64 + c : 1280 + c;
          MU[tid] = INP(F, 8)[l * 1472 + rc]; MU[320 + tid] = INP(F, 9)[l * 1472 + rc]; } }
    __syncthreads();
    const size_t mb = (size_t)b * SEQ;
    const int j = lane & 15;
    RwCtx C;
    C.WA = WA; C.WW = WW; C.XA = (LAS bf16*)(F.lds + 18432) + wave * 576; C.XW = (LAS bf16*)(F.lds + 27648) + wave * 576;
    C.RAWB = (LAS bf16*)(F.lds + 36864) + wave * 1920;
    C.MU = MU; C.CT = (GAS float*)(WSP(F) + WS_CT); C.colsb = cols + mb * NINP; C.h = h; C.dir = dir; C.qtr = 0; C.mb = mb; C.tb0 = 4 * wave;
    { const int hc4 = h * 64 + 4 * j;
      C.kk_c4 = *(const GAS f32x4*)(INP(F, 15) + l * 384 + hc4); C.ka_c4 = *(const GAS f32x4*)(INP(F, 16) + l * 384 + hc4); C.rk_c4 = *(const GAS f32x4*)(INP(F, 17) + l * 384 + hc4);
#pragma unroll
      for (int ct = 0; ct < 4; ++ct) { C.ba[ct] = INP(F, 12)[l * 384 + h * 64 + 16 * ct + j]; C.bw[ct] = INP(F, 10)[(l * 2 + dir) * 384 + h * 64 + 16 * ct + j]; }
      const int c2 = (lane & 31) * 2;
#pragma unroll
      for (int wq = 0; wq < 5; ++wq) { C.mup_[wq][0] = MU[wq * 64 + c2]; C.mup_[wq][1] = MU[wq * 64 + c2 + 1]; C.mun_[wq][0] = MU[320 + wq * 64 + c2]; C.mun_[wq][1] = MU[320 + wq * 64 + c2 + 1]; } }
    v4u pre[5]; int poff[5], prr[5];
    rw_addr_init<4>(poff, prr, lane, C.tb0, h, dir);
    rw_issue<4>(pre, poff, prr, C.colsb, dir ? SEQ - 32 * (pp + 1) : 32 * pp);
    bool dead = false; unsigned mseen = G0;
    GAS unsigned* myflag = ctl + 320 * pp; const unsigned PB = G0 / 2;
#pragma unroll 1
    for (int it = pp; it < NB; it += 2) {
        const int T0 = dir ? SEQ - 32 * (it + 1) : 32 * it;
        v4u cur[5];
#pragma unroll
        for (int i = 0; i < 5; ++i) cur[i] = pre[i];
        if (it + 2 < NB) rw_issue<4>(pre, poff, prr, C.colsb, dir ? SEQ - 32 * (it + 3) : 32 * (it + 2));
        rw_prep<4, true>(C, cur, OPS, VV, T0, lane);
        if (tid == 0) { const unsigned need = G0 + (unsigned)it + 1u; unsigned sp = 0u;
            if (need > (unsigned)RW_NSLOT && !dead) { const unsigned want = need - (unsigned)RW_NSLOT;
                while (mseen < want) { if (++sp > (1u << 17)) { dead = true; break; } __builtin_amdgcn_s_sleep(2);
                    const unsigned m01 = min(rw_ld(ctl + 64), rw_ld(ctl + 128)), m23 = min(rw_ld(ctl + 192), rw_ld(ctl + 256)); mseen = min(m01, m23); } }
            flg[0] = sp; }
        __syncthreads();
        { GAS unsigned long long* slot = ring + (size_t)((G0 + (unsigned)it) % RW_NSLOT) * (RW_SLOT_WORDS / 2);
          const LAS v4u* src = (const LAS v4u*)OPS;
#pragma unroll
          for (int i = 0; i < 6; ++i) { const int idx = tid + 512 * i; const v4u d = src[idx]; GAS v4u* dst = (GAS v4u*)slot + idx;
              asm volatile("global_store_dwordx4 %0, %1, off sc1\n\ts_nop 1" :: "v"(dst), "v"(d) : "memory"); } }
        asm volatile("s_waitcnt vmcnt(10)" ::: "memory");
        __syncthreads();
        if (tid == 0 && it >= 2) rw_st(myflag, PB + (unsigned)(it >> 1));
    }
    asm volatile("s_waitcnt vmcnt(0)" ::: "memory");
    __syncthreads();
    if (tid == 0) rw_st(myflag, PB + (unsigned)(NB / 2));
    __syncthreads();
}
__device__ __forceinline__ void rwkv_scan(const Frame& F, int l, int p, int qtr, unsigned G0) {
    const int b = p / 12, rem = p % 12, h = rem >> 1, dir = rem & 1;
    GAS bf16* Y = (GAS bf16*)(WSP(F) + (dir ? Y_RB : Y_RF));
    const int lane = F.lane, wave = F.wave;
    LAS float* OPSb = (LAS float*)(F.lds);
    LAS float* VVb = (LAS float*)(F.lds + 81920);
    LAS float* YBb = (LAS float*)(F.lds + 86016);
    GAS unsigned* ctl = (GAS unsigned*)(WSP(F) + WS_CTL) + CW_RW + 384 * p;
    const GAS unsigned long long* ring = (const GAS unsigned long long*)(WSP(F) + WS_RING) + (size_t)p * RW_NSLOT * (RW_SLOT_WORDS / 2);
    constexpr int NB = SEQ / 32;
    const size_t mb = (size_t)b * SEQ;
    const int j = lane & 15;
    __syncthreads();
    if (wave < 4) {
        const int lt = wave * 64 + lane;
        bool dead = false; unsigned pseen0 = G0 / 2, pseen1 = G0 / 2;
        unsigned long long va[21], vb[21];
#define RW_FETCH(v_, k_) do { const unsigned need_ = G0 / 2 + (unsigned)((k_) >> 1) + 1u; unsigned sp_ = 0u; GAS unsigned* fl_ = ctl + 320 * ((k_) & 1); \
            if (!dead) { unsigned ps_ = ((k_) & 1) ? pseen1 : pseen0; while (ps_ < need_) { ps_ = rw_ld(fl_); if (ps_ >= need_) break; if (++sp_ > (1u << 17)) { dead = true; break; } __builtin_amdgcn_s_sleep(2); } if ((k_) & 1) pseen1 = ps_; else pseen0 = ps_; } \
            const GAS unsigned long long* slot_ = ring + (size_t)((G0 + (unsigned)(k_)) % RW_NSLOT) * (RW_SLOT_WORDS / 2); \
            _Pragma("unroll") for (int i_ = 0; i_ < 20; ++i_) v_[i_] = __hip_atomic_load(slot_ + lt + 256 * i_, __ATOMIC_RELAXED, __HIP_MEMORY_SCOPE_AGENT); \
            v_[20] = __hip_atomic_load(slot_ + 5120 + (lt >> 3) * 32 + qtr * 8 + (lt & 7), __ATOMIC_RELAXED, __HIP_MEMORY_SCOPE_AGENT); } while (0)
#define RW_LITER(v_, k_) do { if ((k_) >= 1 && lt == 0) rw_st(ctl + 64 * (qtr + 1), G0 + (unsigned)(k_)); \
            if ((k_) < NB) { LAS unsigned long long* dO_ = (LAS unsigned long long*)(OPSb + ((k_) & 1) * 10240); LAS unsigned long long* dV_ = (LAS unsigned long long*)(VVb + ((k_) & 1) * 512); \
                _Pragma("unroll") for (int i_ = 0; i_ < 20; ++i_) dO_[lt + 256 * i_] = v_[i_]; dV_[lt] = v_[20]; \
                if ((k_) + 2 < NB) RW_FETCH(v_, (k_) + 2); } \
            if ((k_) >= 2) { const int bk_ = (k_) - 2; const int T0_ = dir ? SEQ - 32 * (bk_ + 1) : 32 * bk_; const LAS float* YB_ = YBb + (bk_ & 1) * 512; \
                const int idx_ = lt * 2, tl_ = idx_ >> 4, rw_ = idx_ & 15; \
                *(GAS unsigned*)(Y + (mb + T0_ + tl_) * 384 + h * 64 + 16 * qtr + rw_) = pk2(YB_[idx_], YB_[idx_ + 1]); } \
            __syncthreads(); } while (0)
        RW_FETCH(va, 0); RW_FETCH(vb, 1);
#pragma unroll 1
        for (int it = 0; it < NB; it += 2) { RW_LITER(va, it); RW_LITER(vb, it + 1); }
        RW_LITER(va, NB);
#undef RW_FETCH
#undef RW_LITER
        { const int bk = NB - 1; const int T0 = dir ? SEQ - 32 * (bk + 1) : 32 * bk; const LAS float* YB = YBb + (bk & 1) * 512;
          const int idx = lt * 2, tl = idx >> 4, rw = idx & 15;
          *(GAS unsigned*)(Y + (mb + T0 + tl) * 384 + h * 64 + 16 * qtr + rw) = pk2(YB[idx], YB[idx + 1]); }
    } else {
        const int row = (wave - 4) * 4 + (lane >> 4);
        f32x4 S = {0.f, 0.f, 0.f, 0.f};
        __builtin_amdgcn_s_setprio(3);
#pragma unroll 1
        for (int it = 0; it <= NB; ++it) {
            if (it >= 1) { const int bk = it - 1;
                const LAS float* OPS = OPSb + (bk & 1) * 10240; const LAS float* VV = VVb + (bk & 1) * 512; LAS float* YB = YBb + (bk & 1) * 512;
                if (dir) rwkv_steps<true>(OPS, VV, YB, S, j, row); else rwkv_steps<false>(OPS, VV, YB, S, j, row);
            }
            __syncthreads();
        }
        __builtin_amdgcn_s_setprio(0);
    }
    __syncthreads();
}
__device__ __forceinline__ void mlstm_seq(const Frame& F, int l, int task, int cfull0, int cend) {
    const int b = task >> 3, h = (task >> 1) & 3, dir = task & 1;
    const GAS bf16* cols = (const GAS bf16*)(WSP(F) + WS_COLS); const GAS float* GT = (const GAS float*)(WSP(F) + WS_GATES);
    GAS bf16* Y = (GAS bf16*)(WSP(F) + (dir ? Y_AB : Y_AF));
    LAS bf16* RAWQ = (LAS bf16*)(F.lds);
    LAS bf16* Qs = (LAS bf16*)(F.lds + 17408); LAS bf16* Ks = (LAS bf16*)(F.lds + 26624);
    LAS bf16* Vtb = (LAS bf16*)(F.lds + 35840);
    LAS bf16* KWt = (LAS bf16*)(F.lds + 54272); LAS bf16* Ps = (LAS bf16*)(F.lds + 63488);
    LAS bf16* Ctb = (LAS bf16*)(F.lds + 72704);
    LAS float* ub = (LAS float*)(F.lds + 91136);
    LAS float* blb = ub + 128; LAS float* rmb = ub + 256;
    LAS float* den = ub + 384; LAS float* qn = ub + 448; LAS float* nst = ub + 512; LAS float* scb = ub + 576;
    const int tid = F.tid, lane = F.lane, wave = F.wave;
    const size_t mb = (size_t)b * SEQ;
    constexpr int NC = SEQ / 64;
    __syncthreads();
    for (int i = tid; i < 2 * 64 * 72; i += 512) Ctb[i] = 0;
    if (tid < 64) nst[tid] = 0.f;
    const int cc = tid & 127, isK = cc >> 6, d0 = cc & 63, chn = isK * 256 + h * 64 + d0;
    float cw[5]; const GAS float* cwp = INP(F, 3) + (size_t)l * 5 * 512;
#pragma unroll
    for (int jj = 0; jj < 5; ++jj) cw[jj] = cwp[jj * 512 + chn];
    const float cbv = INP(F, 4)[l * 512 + chn];
    f32x4 st[2] = {{0.f, 0.f, 0.f, 0.f}, {0.f, 0.f, 0.f, 0.f}};
    float m_st = 0.f;
    v4u pre[3], prev; float gli = 0.f, glf = 0.f;
#define ML_ISSUE(c_) do { const int tlo_ = dir ? SEQ - 64 * ((c_) + 1) : 64 * (c_); _Pragma("unroll") for (int i_ = 0; i_ < 3; ++i_) { const int ch_ = tid + 512 * i_; pre[i_] = (v4u){0u, 0u, 0u, 0u}; \
        if (ch_ < 68 * 16) { const int rr_ = ch_ >> 4, q_ = ch_ & 15; const int t_ = tlo_ - 2 + rr_; if (t_ >= 0 && t_ < SEQ) pre[i_] = *(const GAS v4u*)(cols + (mb + t_) * NINP + (q_ >> 3) * 256 + h * 64 + (q_ & 7) * 8); } } \
        prev = *(const GAS v4u*)(cols + (mb + tlo_ + (tid >> 3)) * NINP + A_V + h * 64 + (tid & 7) * 8); \
        if (tid < 64) { const int t_ = dir ? tlo_ + 63 - tid : tlo_ + tid; gli = GT[(mb + t_) * 16 + dir * 4 + h]; glf = GT[(mb + t_) * 16 + 8 + dir * 4 + h]; } } while (0)
#define ML_FILL(c_) do { _Pragma("unroll") for (int i_ = 0; i_ < 3; ++i_) { const int ch_ = tid + 512 * i_; if (ch_ < 68 * 16) *(LAS v4u*)(RAWQ + (ch_ >> 4) * 128 + (ch_ & 15) * 8) = pre[i_]; } \
        { LAS bf16* Vt_ = Vtb + ((c_) & 1) * 4608; const int tl_ = tid >> 3, e8_ = tid & 7; const int lp_ = dir ? 63 - tl_ : tl_; const unsigned w_[4] = {prev.x, prev.y, prev.z, prev.w}; \
          _Pragma("unroll") for (int k_ = 0; k_ < 4; ++k_) { const int e_ = e8_ * 8 + 2 * k_; Vt_[e_ * 72 + swz64(e_, lp_)] = (bf16)(w_[k_] & 0xffffu); Vt_[(e_ + 1) * 72 + swz64(e_ + 1, lp_)] = (bf16)(w_[k_] >> 16); } } \
        if (tid < 64) { const float bl_ = wave_scan_add(glf); \
            const float u_ = gli - bl_; const float rm_ = wave_scan_max(u_); \
            ub[((c_) & 1) * 64 + tid] = u_; blb[((c_) & 1) * 64 + tid] = bl_; rmb[((c_) & 1) * 64 + tid] = rm_; if (tid == 63) { scb[((c_) & 1) * 2] = rm_; scb[((c_) & 1) * 2 + 1] = bl_; } } } while (0)
    ML_ISSUE(0); ML_FILL(0); ML_ISSUE(1);
    __syncthreads();
    if (cfull0 > 0) {
        const int dk = tid & 63; float cwk[5]; { const GAS float* cwq = INP(F, 3) + (size_t)l * 5 * 512;
#pragma unroll
            for (int jj = 0; jj < 5; ++jj) cwk[jj] = cwq[jj * 512 + 256 + h * 64 + dk]; }
        const float cbk = INP(F, 4)[l * 512 + 256 + h * 64 + dk];
#pragma unroll 1
        for (int c = 0; c < cfull0; ++c) {
            const LAS float* u = ub + (c & 1) * 64;
            const LAS bf16* Vt = Vtb + (c & 1) * 4608; LAS bf16* Ctn = Ctb + ((c + 1) & 1) * 4608;
            const float umax = scb[(c & 1) * 2], tot = scb[(c & 1) * 2 + 1];
#pragma unroll 2
            for (int i = 0; i < 8; ++i) { const int tl = (tid >> 6) + 8 * i; float s = cbk;
#pragma unroll
                for (int jj = 0; jj < 5; ++jj) s += cwk[jj] * bf2f(RAWQ[(tl + jj) * 128 + 64 + dk]);
                const int lp = dir ? 63 - tl : tl;
                KWt[dk * 72 + swz64(dk, lp)] = (bf16)f2bf(siluf_(s) * 0.125f * __expf(u[lp] - umax)); }
            __syncthreads();
            const float mmax = fmaxf(m_st, umax), s_old = __expf(m_st - mmax), s_new = __expf(umax - mmax);
#pragma unroll
            for (int k = 0; k < 2; ++k) { const int ti = 2 * wave + k, t0_ = ti >> 2, t1_ = ti & 3; const f32x4 z = {0.f, 0.f, 0.f, 0.f};
                const f32x4 lc = mma16s<true, true>(Vt, 72, t0_ * 16, KWt, 72, t1_ * 16, z, lane);
#pragma unroll
                for (int jj = 0; jj < 4; ++jj) { const int r_ = t0_ * 16 + (lane >> 4) * 4 + jj, c_ = t1_ * 16 + (lane & 15);
                    st[k][jj] = s_old * st[k][jj] + s_new * lc[jj]; Ctn[r_ * 72 + c_] = (bf16)f2bf(st[k][jj]); } }
            { const int dq = tid >> 3, part = tid & 7; float s = 0.f;
#pragma unroll
              for (int k = 0; k < 8; ++k) s += bf2f(KWt[dq * 72 + swz64(dq, part * 8) + k]);
              s = row8_sum(s); if (part == 0) nst[dq] = s_old * nst[dq] + s_new * s; }
            m_st = tot + mmax;
            ML_FILL(c + 1); if (c + 2 < cend) ML_ISSUE(c + 2);
            __syncthreads();
        }
    }
#pragma unroll 1
    for (int c = cfull0; c < cend; ++c) {
        const bool full = c >= cfull0;
        const int tlo = dir ? SEQ - 64 * (c + 1) : 64 * c;
        const LAS float* u = ub + (c & 1) * 64; const LAS float* bl = blb + (c & 1) * 64; const LAS float* rm = rmb + (c & 1) * 64;
        const LAS bf16* Vt = Vtb + (c & 1) * 4608; const LAS bf16* Ct = Ctb + (c & 1) * 4608; LAS bf16* Ctn = Ctb + ((c + 1) & 1) * 4608;
#pragma unroll 4
        for (int i = 0; i < 16; ++i) { const int tl = (tid >> 7) + 4 * i; float s = cbv;
#pragma unroll
            for (int jj = 0; jj < 5; ++jj) s += cw[jj] * bf2f(RAWQ[(tl + jj) * 128 + cc]);
            s = siluf_(s); const int lpos = dir ? 63 - tl : tl;
            if (isK) Ks[lpos * 72 + d0] = (bf16)f2bf(s * 0.125f); else Qs[lpos * 72 + d0] = (bf16)f2bf(s); }
        if (tid < 64) den[tid] = 0.f;
        __syncthreads();
        const float umax = scb[(c & 1) * 2], tot = scb[(c & 1) * 2 + 1];
        for (int idx = tid; idx < 4096; idx += 512) { const int lp = idx >> 6, d = idx & 63; KWt[d * 72 + swz64(d, lp)] = (bf16)f2bf(bf2f(Ks[lp * 72 + d]) * __expf(u[lp] - umax)); }
        if (full) {
#pragma unroll
        for (int k = 0; k < 2; ++k) { const int ti = 2 * wave + k, tl_ = ti >> 2, ts = ti & 3; f32x4 acc = {0.f, 0.f, 0.f, 0.f};
            if (ts <= tl_) acc = mma16<64>(Qs + tl_ * 16 * 72, 72, Ks + ts * 16 * 72, 72, acc, lane);
#pragma unroll
            for (int jj = 0; jj < 4; ++jj) { const int lr = tl_ * 16 + (lane >> 4) * 4 + jj, s = ts * 16 + (lane & 15);
                const float v = (s <= lr) ? acc[jj] * __expf(u[s] - fmaxf(m_st, rm[lr])) : 0.f; const unsigned vb = f2bf(v); Ps[lr * 72 + s] = (bf16)vb;
                if (ts <= tl_) { const float rs = row16_sum(bf2f(vb)); if ((lane & 15) == 0) __hip_atomic_fetch_add(den + lr, rs, __ATOMIC_RELAXED, __HIP_MEMORY_SCOPE_WORKGROUP); } } }
        { const int lq = tid >> 3, part = tid & 7; float s = 0.f;
#pragma unroll
          for (int k = 0; k < 8; ++k) s += bf2f(Qs[lq * 72 + part * 8 + k]) * nst[part * 8 + k];
          s = row8_sum(s); if (part == 0) qn[lq] = s; }
        }
        __syncthreads();
        const float mmax = fmaxf(m_st, umax), s_old = __expf(m_st - mmax), s_new = __expf(umax - mmax);
#pragma unroll
        for (int k = 0; k < 2; ++k) { const int ti = 2 * wave + k, t0_ = ti >> 2, t1_ = ti & 3; const f32x4 z = {0.f, 0.f, 0.f, 0.f};
            f32x4 a1 = z, a2 = z;
            if (full) { a1 = mma16s<false, true>(Ps, 72, t0_ * 16, Vt, 72, t1_ * 16, z, lane); a2 = mma16<64>(Qs + t0_ * 16 * 72, 72, Ct + t1_ * 16 * 72, 72, z, lane); }
            const f32x4 lc = mma16s<true, true>(Vt, 72, t0_ * 16, KWt, 72, t1_ * 16, z, lane);
#pragma unroll
            for (int jj = 0; jj < 4; ++jj) { const int r_ = t0_ * 16 + (lane >> 4) * 4 + jj, c_ = t1_ * 16 + (lane & 15);
                if (full) { const float mx = fmaxf(m_st, rm[r_]), iwv = __expf(m_st - mx);
                const float dn = den[r_] + iwv * qn[r_];
                const float val = (a1[jj] + iwv * a2[jj]) * __builtin_amdgcn_rcpf(fmaxf(fabsf(dn), __expf(-(bl[r_] + mx))));
                const int t = dir ? tlo + 63 - r_ : tlo + r_;
                Y[(mb + t) * 256 + h * 64 + c_] = (bf16)f2bf(val); }
                st[k][jj] = s_old * st[k][jj] + s_new * lc[jj];
                Ctn[r_ * 72 + c_] = (bf16)f2bf(st[k][jj]); } }
        { const int dq = tid >> 3, part = tid & 7; float s = 0.f;
#pragma unroll
          for (int k = 0; k < 8; ++k) s += bf2f(KWt[dq * 72 + swz64(dq, part * 8) + k]);
          s = row8_sum(s); if (part == 0) nst[dq] = s_old * nst[dq] + s_new * s; }
        m_st = tot + mmax;
        if (c + 1 < cend) { ML_FILL(c + 1); if (c + 2 < cend) ML_ISSUE(c + 2); }
        __syncthreads();
    }
#undef ML_ISSUE
#undef ML_FILL
}
__device__ __forceinline__ void phase_ssd_conv(const Frame& F, int l) {
    const GAS bf16* cols = (const GAS bf16*)(WSP(F) + WS_COLS); GAS bf16* XBC = (GAS bf16*)(WSP(F) + WS_XN);
    LAS bf16* raw = (LAS bf16*)(F.lds);
    const GAS float* cwp = INP(F, 20) + (size_t)l * 5 * 896; const GAS float* cbp = INP(F, 21) + l * 896;
    const int tid = F.tid;
    float cw0[5], cw1[5]; const int c1 = tid + 512 < 896 ? tid + 512 : tid;
#pragma unroll
    for (int jj = 0; jj < 5; ++jj) { cw0[jj] = cwp[jj * 896 + tid]; cw1[jj] = cwp[jj * 896 + c1]; }
    const float cb0 = cbp[tid], cb1 = cbp[c1];
    GAS float* DTV = (GAS float*)(WSP(F) + WS_DTV); const GAS float* dtbp = INP(F, 22) + l * 12;
    for (int tile = F.vcu; tile < M / 32; tile += F.G) {
        const int m0 = tile * 32, t0 = m0 % SEQ;
        __syncthreads();
        if (tid < 384) { const int tt = tid / 12, k = tid % 12; const float x = bf2f(cols[(size_t)(m0 + tt) * NINP + S_DT + k]) + dtbp[k]; DTV[(size_t)(m0 + tt) * 12 + k] = x > 20.f ? x : log1pf(__expf(x)); }
        for (int ch = tid; ch < 36 * 112; ch += 512) { const int rr = ch / 112, cc = ch % 112; const int t = t0 - 2 + rr;
            v4u v = {0u, 0u, 0u, 0u}; if (t >= 0 && t < SEQ) v = *(const GAS v4u*)(cols + (size_t)(m0 - 2 + rr) * NINP + S_X + cc * 8);
            *(LAS v4u*)(raw + rr * 896 + cc * 8) = v; }
        __syncthreads();
#pragma unroll
        for (int half = 0; half < 2; ++half) { const int c = half ? c1 : tid; if (half && tid + 512 >= 896) break;
            float win[5];
#pragma unroll
            for (int jj = 0; jj < 4; ++jj) win[jj] = bf2f(raw[jj * 896 + c]);
            for (int tl = 0; tl < 32; ++tl) { win[4] = bf2f(raw[(tl + 4) * 896 + c]);
                float s = half ? cb1 : cb0;
#pragma unroll
                for (int jj = 0; jj < 5; ++jj) s += (half ? cw1[jj] : cw0[jj]) * win[jj];
#pragma unroll
                for (int jj = 0; jj < 4; ++jj) win[jj] = win[jj + 1];
                XBC[(size_t)(m0 + tl) * 896 + c] = (bf16)f2bf(siluf_(s)); } }
    }
    __syncthreads();
}
__device__ __forceinline__ void ssd_seq(const Frame& F, int l, int task, int cfull0, int cend) {
    const int b = task / 12, rem = task % 12, head = rem >> 1, dir = rem & 1, g = head / 3;
    const GAS bf16* cols = (const GAS bf16*)(WSP(F) + WS_COLS); const GAS bf16* XBC = (const GAS bf16*)(WSP(F) + WS_XN);
    GAS bf16* Y = (GAS bf16*)(WSP(F) + (dir ? Y_SB : Y_SF));
    LAS bf16* Cm = (LAS bf16*)(F.lds); LAS bf16* Bm = (LAS bf16*)(F.lds + 17408);
    LAS bf16* Btw = (LAS bf16*)(F.lds + 34816); LAS bf16* Xt = (LAS bf16*)(F.lds + 53248);
    LAS bf16* Ps = (LAS bf16*)(F.lds + 62464); LAS bf16* Hs = (LAS bf16*)(F.lds + 71680);
    LAS float* dtvb = (LAS float*)(F.lds + 89088);
    LAS float* acsb = dtvb + 128;
    LAS float* totb = dtvb + 256;
    const int tid = F.tid, lane = F.lane, wave = F.wave;
    const size_t mb = (size_t)b * SEQ;
    constexpr int NC = SEQ / 64;
    __syncthreads();
    for (int i = tid; i < 64 * 136; i += 512) Hs[i] = 0;
    const GAS float* DTV = (const GAS float*)(WSP(F) + WS_DTV);
    const float aneg = -__expf(INP(F, 23)[(l * 2 + dir) * 6 + head]);
    f32x4 st[4];
#pragma unroll
    for (int k = 0; k < 4; ++k) st[k] = (f32x4){0.f, 0.f, 0.f, 0.f};
    v4u pre[5]; float dtraw = 0.f;
#define SSD_ISSUE(c_) do { const int tlo_ = dir ? SEQ - 64 * ((c_) + 1) : 64 * (c_); _Pragma("unroll") for (int i_ = 0; i_ < 5; ++i_) { const int idx_ = tid + 512 * i_; const int tl_ = idx_ / 40, q_ = idx_ % 40; \
        const int gc_ = q_ < 8 ? head * 64 + q_ * 8 : (q_ < 24 ? 384 + g * 128 + (q_ - 8) * 8 : 640 + g * 128 + (q_ - 24) * 8); \
        pre[i_] = *(const GAS v4u*)(XBC + (mb + tlo_ + tl_) * 896 + gc_); } } while (0)
#define SSD_DTLOAD(c_) do { if (tid < 64) { const int tlo_ = dir ? SEQ - 64 * ((c_) + 1) : 64 * (c_); const int t_ = dir ? tlo_ + 63 - tid : tlo_ + tid; dtraw = DTV[(mb + t_) * 12 + dir * 6 + head]; } } while (0)
#define SSD_DTCALC(c_) do { if (tid < 64) { const float dt_ = dtraw; float cs_ = dt_ * aneg; \
        cs_ = wave_scan_add(cs_); \
        const float tt_ = __builtin_bit_cast(float, __builtin_amdgcn_readlane(__builtin_bit_cast(int, cs_), 63)); dtvb[((c_) & 1) * 64 + tid] = dt_; acsb[((c_) & 1) * 64 + tid] = cs_; if (tid == 0) totb[(c_) & 1] = tt_; } } while (0)
    int lgo[3], llp[3], lq[3]; v4u prel[3];
#pragma unroll
    for (int i = 0; i < 3; ++i) { const int idx = tid + 512 * i; const int tl = idx / 24, q = idx % 24; lq[i] = q; llp[i] = dir ? 63 - tl : tl;
        lgo[i] = tl * 896 + (q < 8 ? head * 64 + q * 8 : 384 + g * 128 + (q - 8) * 8); }
#define SSD_ISSUE_L(dst_, c_) do { const int tlo_ = dir ? SEQ - 64 * ((c_) + 1) : 64 * (c_); const GAS bf16* b_ = XBC + (mb + tlo_) * 896; _Pragma("unroll") for (int i_ = 0; i_ < 3; ++i_) dst_[i_] = *(const GAS v4u*)(b_ + lgo[i_]); } while (0)
    v4u preN[3];
    if (cfull0 > 0) { SSD_ISSUE_L(prel, 0); if (cfull0 > 1) SSD_ISSUE_L(preN, 1); } else SSD_ISSUE(0);
    SSD_DTLOAD(0); SSD_DTCALC(0); SSD_DTLOAD(1);
    __syncthreads();
    if (cfull0 > 0) {
#pragma unroll 1
        for (int c = 0; c < cfull0; ++c) {
            LAS bf16* Xl = (c & 1) ? (LAS bf16*)(F.lds + 92160) : Xt; LAS bf16* Bl = (c & 1) ? (LAS bf16*)(F.lds + 101376) : Btw;
            const LAS float* dtv = dtvb + (c & 1) * 64; const LAS float* acs = acsb + (c & 1) * 64; const float tot = totb[c & 1];
#pragma unroll
            for (int i = 0; i < 3; ++i) { const int q = lq[i], lp = llp[i];
                const unsigned w[4] = {prel[i].x, prel[i].y, prel[i].z, prel[i].w};
                if (q < 8) {
#pragma unroll
                    for (int k = 0; k < 4; ++k) { const int p0 = q * 8 + 2 * k; Xl[p0 * 72 + swz64(p0, lp)] = (bf16)(w[k] & 0xffffu); Xl[(p0 + 1) * 72 + swz64(p0 + 1, lp)] = (bf16)(w[k] >> 16); } }
                else { const int n0 = (q - 8) * 8; const float sc = dtv[lp] * __expf(tot - acs[lp]);
#pragma unroll
                    for (int k = 0; k < 4; ++k) { const int nn = n0 + 2 * k; Bl[nn * 72 + swz64(nn, lp)] = (bf16)f2bf(bf2f(w[k] & 0xffffu) * sc); Bl[(nn + 1) * 72 + swz64(nn + 1, lp)] = (bf16)f2bf(bf2f(w[k] >> 16) * sc); } } }
            if (c + 1 < cfull0) {
#pragma unroll
                for (int i = 0; i < 3; ++i) prel[i] = preN[i];
                if (c + 2 < cfull0) SSD_ISSUE_L(preN, c + 2); }
            else SSD_ISSUE(c + 1);
            SSD_DTCALC(c + 1); if (c + 2 < cend) SSD_DTLOAD(c + 2);
            __syncthreads();
            const float cdec = __expf(tot);
#pragma unroll
            for (int k = 0; k < 4; ++k) { const int ti = 4 * wave + k, tp = ti >> 3, tn = ti & 7; const f32x4 z = {0.f, 0.f, 0.f, 0.f};
                const f32x4 lcv = mma16s<true, true>(Xl, 72, tp * 16, Bl, 72, tn * 16, z, lane);
                st[k] = st[k] * cdec + lcv; }
        }
#pragma unroll
        for (int k = 0; k < 4; ++k) { const int ti = 4 * wave + k, tp = ti >> 3, tn = ti & 7;
#pragma unroll
            for (int jj = 0; jj < 4; ++jj) { const int p = tp * 16 + (lane >> 4) * 4 + jj, n = tn * 16 + (lane & 15); Hs[p * 136 + n] = (bf16)f2bf(st[k][jj]); } }
        __syncthreads();
    }
#pragma unroll 1
    for (int c = cfull0; c < cend; ++c) {
        const bool full = c >= cfull0;
        const int tlo = dir ? SEQ - 64 * (c + 1) : 64 * c;
        const LAS float* dtv = dtvb + (c & 1) * 64; const LAS float* acs = acsb + (c & 1) * 64; const float tot = totb[c & 1];
#pragma unroll
        for (int i = 0; i < 5; ++i) { const int idx = tid + 512 * i; const int tl = idx / 40, q = idx % 40; const int lp = dir ? 63 - tl : tl;
            const unsigned w[4] = {pre[i].x, pre[i].y, pre[i].z, pre[i].w};
            if (q < 8) {
#pragma unroll
                for (int k = 0; k < 4; ++k) { const int p0 = q * 8 + 2 * k; Xt[p0 * 72 + swz64(p0, lp)] = (bf16)(w[k] & 0xffffu); Xt[(p0 + 1) * 72 + swz64(p0 + 1, lp)] = (bf16)(w[k] >> 16); } }
            else if (q < 24) { const int n0 = (q - 8) * 8; if (full) *(LAS v4u*)(Bm + lp * 136 + n0) = pre[i]; const float sc = dtv[lp] * __expf(tot - acs[lp]);
#pragma unroll
                for (int k = 0; k < 4; ++k) { const int nn = n0 + 2 * k; Btw[nn * 72 + swz64(nn, lp)] = (bf16)f2bf(bf2f(w[k] & 0xffffu) * sc); Btw[(nn + 1) * 72 + swz64(nn + 1, lp)] = (bf16)f2bf(bf2f(w[k] >> 16) * sc); } }
            else if (full) { const int n0 = (q - 24) * 8; *(LAS v4u*)(Cm + lp * 136 + n0) = pre[i]; } }
        if (c + 1 < cend) SSD_ISSUE(c + 1);
        __syncthreads();
        f32x4 yo[2] = {{0.f, 0.f, 0.f, 0.f}, {0.f, 0.f, 0.f, 0.f}}, lc[4];
        if (full) {
#pragma unroll
        for (int k = 0; k < 2; ++k) { const int ti = 2 * wave + k, tl_ = ti >> 2, ts = ti & 3; f32x4 acc = {0.f, 0.f, 0.f, 0.f};
            if (ts <= tl_) acc = mma16<128>(Cm + tl_ * 16 * 136, 136, Bm + ts * 16 * 136, 136, acc, lane);
#pragma unroll
            for (int jj = 0; jj < 4; ++jj) { const int lr = tl_ * 16 + (lane >> 4) * 4 + jj, s = ts * 16 + (lane & 15);
                const float v = (s <= lr) ? acc[jj] * __expf(acs[lr] - acs[s]) * dtv[s] : 0.f; Ps[lr * 72 + s] = (bf16)f2bf(v); }
            const f32x4 z = {0.f, 0.f, 0.f, 0.f};
            yo[k] = mma16<128>(Cm + tl_ * 16 * 136, 136, Hs + ts * 16 * 136, 136, z, lane); }
        }
#pragma unroll
        for (int k = 0; k < 4; ++k) { const int ti = 4 * wave + k, tp = ti >> 3, tn = ti & 7; const f32x4 z = {0.f, 0.f, 0.f, 0.f};
            lc[k] = mma16s<true, true>(Xt, 72, tp * 16, Btw, 72, tn * 16, z, lane); }
        __syncthreads();
        const float cdec = __expf(tot);
        if (full) {
#pragma unroll
        for (int k = 0; k < 2; ++k) { const int ti = 2 * wave + k, tl_ = ti >> 2, tp = ti & 3; const f32x4 z = {0.f, 0.f, 0.f, 0.f};
            const f32x4 yd = mma16s<false, true>(Ps, 72, tl_ * 16, Xt, 72, tp * 16, z, lane);
#pragma unroll
            for (int jj = 0; jj < 4; ++jj) { const int lr = tl_ * 16 + (lane >> 4) * 4 + jj, p = tp * 16 + (lane & 15);
                const float val = yd[jj] + yo[k][jj] * __expf(acs[lr]);
                const int t = dir ? tlo + 63 - lr : tlo + lr;
                Y[(mb + t) * 384 + head * 64 + p] = (bf16)f2bf(val); } }
        }
#pragma unroll
        for (int k = 0; k < 4; ++k) { const int ti = 4 * wave + k, tp = ti >> 3, tn = ti & 7;
#pragma unroll
            for (int jj = 0; jj < 4; ++jj) { const int p = tp * 16 + (lane >> 4) * 4 + jj, n = tn * 16 + (lane & 15);
                st[k][jj] = cdec * st[k][jj] + lc[k][jj]; Hs[p * 136 + n] = (bf16)f2bf(st[k][jj]); } }
        if (c + 1 < cend) { SSD_DTCALC(c + 1); if (c + 2 < cend) SSD_DTLOAD(c + 2); }
        __syncthreads();
    }
#undef SSD_ISSUE
#undef SSD_ISSUE_L
#undef SSD_DTLOAD
#undef SSD_DTCALC
}
__device__ __forceinline__ float wave_sum2(float v) { v = row16_sum(v); v += __shfl_xor(v, 16); v += __shfl_xor(v, 32); return v; }
__device__ __forceinline__ f32x4 bf4(v2u w) { return (f32x4){bf2f(w.x & 0xffffu), bf2f(w.x >> 16), bf2f(w.y & 0xffffu), bf2f(w.y >> 16)}; }
__device__ __forceinline__ v2u pk4(f32x4 v) { v2u w; w.x = pk2(v.x, v.y); w.y = pk2(v.z, v.w); return w; }
__device__ __forceinline__ void phase_post(const Frame& F, int l) {
    const GAS bf16* cols = (const GAS bf16*)(WSP(F) + WS_COLS); GAS bf16* MIX = (GAS bf16*)(WSP(F) + WS_XN);
    const GAS bf16* YAf = (const GAS bf16*)(WSP(F) + Y_AF); const GAS bf16* YAb = (const GAS bf16*)(WSP(F) + Y_AB);
    const GAS bf16* YRf = (const GAS bf16*)(WSP(F) + Y_RF); const GAS bf16* YRb = (const GAS bf16*)(WSP(F) + Y_RB);
    const GAS bf16* YSf = (const GAS bf16*)(WSP(F) + Y_SF); const GAS bf16* YSb = (const GAS bf16*)(WSP(F) + Y_SB);
    const GAS float* CT = (const GAS float*)(WSP(F) + WS_CT);
    LAS bf16* GU = (LAS bf16*)(F.lds);
    LAS bf16* SG = (LAS bf16*)(F.lds + 104448);
    LAS float* gate = (LAS float*)(F.lds + 108800);
    LAS float* SCW = (LAS float*)(F.lds + 133632);
    const int tid = F.tid, lane = F.lane, wave = F.wave;
    const GAS float* mup = INP(F, 8) + l * 1472; const GAS float* mun = INP(F, 9) + l * 1472;
    const GAS float* sdk = INP(F, 24) + l * 6;
    __syncthreads();
    { const GAS bf16* gut = (const GAS bf16*)(WSP(F) + WS_GUT); for (int ch = tid; ch < 384 * 16; ch += 512) { const int c = ch >> 4, q = ch & 15; *(LAS v4u*)(GU + c * 136 + q * 8) = *(const GAS v4u*)(gut + c * 128 + q * 8); } }
    { const GAS float* scw = INP(F, 20) + (size_t)l * 5 * 896; for (int idx = tid; idx < 5 * 384; idx += 512) SCW[idx] = scw[(idx / 384) * 896 + (idx % 384)]; }
    const int gch = tid & 15;
    float gmp[8], gmn[8];
#pragma unroll
    for (int k = 0; k < 8; ++k) { gmp[k] = mup[1344 + 8 * gch + k]; gmn[k] = mun[1344 + 8 * gch + k]; }
    const int qa = lane, qb = 64 + (lane & 31);
    const f32x4 mng4 = *(const GAS f32x4*)(INP(F, 7) + l * 256 + 4 * qa);
    f32x4 rmp[2], rmn[2], rng[2], rnb[2], scb[2], sng[2];
#pragma unroll
    for (int ps = 0; ps < 2; ++ps) { const int c0 = 4 * (ps ? qb : qa);
        rmp[ps] = *(const GAS f32x4*)(mup + 768 + c0); rmn[ps] = *(const GAS f32x4*)(mun + 768 + c0);
        rng[ps] = *(const GAS f32x4*)(INP(F, 18) + l * 384 + c0); rnb[ps] = *(const GAS f32x4*)(INP(F, 19) + l * 384 + c0);
        scb[ps] = *(const GAS f32x4*)(INP(F, 21) + l * 896 + c0); sng[ps] = *(const GAS f32x4*)(INP(F, 25) + l * 384 + c0); }
    for (int tile = F.vcu; tile < M / 16; tile += F.G) {
        const int m0 = tile * 16;
        __syncthreads();
        if (tid < 256) { const int tt = tid >> 4; const int m = m0 + tt, t = m % SEQ; const GAS bf16* cp = cols + (size_t)m * NINP + R_GD + 8 * gch;
            const v4u c1 = *(const GAS v4u*)cp; v4u c0 = {0u, 0u, 0u, 0u}, c2 = {0u, 0u, 0u, 0u};
            if (t > 0) c0 = *(const GAS v4u*)(cp - NINP); if (t < SEQ - 1) c2 = *(const GAS v4u*)(cp + NINP);
            const unsigned w0[4] = {c0.x, c0.y, c0.z, c0.w}, w1[4] = {c1.x, c1.y, c1.z, c1.w}, w2[4] = {c2.x, c2.y, c2.z, c2.w}; unsigned o[4];
#pragma unroll
            for (int k = 0; k < 4; ++k) { const float a1 = bf2f(w1[k] & 0xffffu), b1 = bf2f(w1[k] >> 16);
                const float va = a1 + gmp[2 * k] * (bf2f(w0[k] & 0xffffu) - a1) + gmn[2 * k] * (bf2f(w2[k] & 0xffffu) - a1);
                const float vb = b1 + gmp[2 * k + 1] * (bf2f(w0[k] >> 16) - b1) + gmn[2 * k + 1] * (bf2f(w2[k] >> 16) - b1);
                o[k] = pk2(sigmoidf_(va), sigmoidf_(vb)); }
            *(LAS v4u*)(SG + tt * 136 + 8 * gch) = (v4u){o[0], o[1], o[2], o[3]}; }
        __syncthreads();
#pragma unroll
        for (int k = 0; k < 3; ++k) { const int ct = wave + 8 * k; const f32x4 z = {0.f, 0.f, 0.f, 0.f};
            const f32x4 acc = mma16<128>(SG, 136, GU + ct * 16 * 136, 136, z, lane);
#pragma unroll
            for (int jj = 0; jj < 4; ++jj) gate[((lane >> 4) * 4 + jj) * 388 + ct * 16 + (lane & 15)] = acc[jj]; }
        __syncthreads();
#pragma unroll 1
        for (int k = 0; k < 2; ++k) { const int tt = wave * 2 + k; const int m = m0 + tt, t = m % SEQ; const size_t cr = (size_t)m * NINP;
            { const int c0 = 4 * qa;
              const f32x4 hs = bf4(*(const GAS v2u*)(YAf + (size_t)m * 256 + c0)) + bf4(*(const GAS v2u*)(YAb + (size_t)m * 256 + c0));
              const float mean = row16_sum((hs.x + hs.y) + (hs.z + hs.w)) * (1.f / 64.f); const f32x4 d = hs - mean;
              const float var = row16_sum((d.x * d.x + d.y * d.y) + (d.z * d.z + d.w * d.w)) * (1.f / 64.f);
              const f32x4 o = bf4(*(const GAS v2u*)(cols + cr + A_O + c0));
              f32x4 y = d * __builtin_amdgcn_rsqf(var + 1e-6f) * mng4;
              y.x *= sigmoidf_(o.x); y.y *= sigmoidf_(o.y); y.z *= sigmoidf_(o.z); y.w *= sigmoidf_(o.w);
              *(GAS v2u*)(MIX + (size_t)m * DM + c0) = pk4(y); }
#pragma unroll
            for (int ps = 0; ps < 2; ++ps) { const int qd = ps ? qb : qa, c0 = 4 * qd; const bool act = ps == 0 || lane < 32;
              const f32x4 ys = bf4(*(const GAS v2u*)(YRf + (size_t)m * 384 + c0)) + bf4(*(const GAS v2u*)(YRb + (size_t)m * 384 + c0));
              const float mean = row16_sum((ys.x + ys.y) + (ys.z + ys.w)) * (1.f / 64.f); const f32x4 d = ys - mean;
              const float var = row16_sum((d.x * d.x + d.y * d.y) + (d.z * d.z + d.w * d.w)) * (1.f / 64.f);
              const f32x4 y = d * __builtin_amdgcn_rsqf(var + 64e-5f) * rng[ps] + rnb[ps];
              const f32x4 p1 = bf4(*(const GAS v2u*)(cols + cr + R_V + c0));
              f32x4 p0 = {0.f, 0.f, 0.f, 0.f}, p2 = {0.f, 0.f, 0.f, 0.f};
              if (t > 0) p0 = bf4(*(const GAS v2u*)(cols + cr - NINP + R_V + c0)); if (t < SEQ - 1) p2 = bf4(*(const GAS v2u*)(cols + cr + NINP + R_V + c0));
              const f32x4 vv = p1 + rmp[ps] * (p0 - p1) + rmn[ps] * (p2 - p1);
              const float ctv = CT[(size_t)m * 8 + (qd >> 4)];
              const f32x4 g4 = *(const LAS f32x4*)(gate + tt * 388 + c0);
              if (act) *(GAS v2u*)(MIX + (size_t)m * DM + 256 + c0) = pk4((y + vv * ctv) * g4); }
            f32x4 yv[2]; float ssq0 = 0.f, ssq1 = 0.f;
#pragma unroll
            for (int ps = 0; ps < 2; ++ps) { const int qd = ps ? qb : qa, c0 = 4 * qd; const bool act = ps == 0 || lane < 32;
              f32x4 s = scb[ps];
#pragma unroll
              for (int jj = 0; jj < 5; ++jj) { const int tq = t + jj - 2; if (tq >= 0 && tq < SEQ) s += *(const LAS f32x4*)(SCW + jj * 384 + c0) * bf4(*(const GAS v2u*)(cols + cr + (jj - 2) * NINP + S_X + c0)); }
              const f32x4 z = bf4(*(const GAS v2u*)(cols + cr + S_Z + c0));
              f32x4 y = bf4(*(const GAS v2u*)(YSf + (size_t)m * 384 + c0)) + bf4(*(const GAS v2u*)(YSb + (size_t)m * 384 + c0));
              const float dsk = sdk[qd >> 4];
              y.x = (y.x + dsk * siluf_(s.x)) * siluf_(z.x); y.y = (y.y + dsk * siluf_(s.y)) * siluf_(z.y); y.z = (y.z + dsk * siluf_(s.z)) * siluf_(z.z); y.w = (y.w + dsk * siluf_(s.w)) * siluf_(z.w);
              yv[ps] = y; const float sq = act ? (y.x * y.x + y.y * y.y) + (y.z * y.z + y.w * y.w) : 0.f;
              if (qd < 48) ssq0 += sq; else ssq1 += sq; }
            const float r0 = __builtin_amdgcn_rsqf(wave_sum2(ssq0) * (1.f / 192.f) + 1e-6f), r1 = __builtin_amdgcn_rsqf(wave_sum2(ssq1) * (1.f / 192.f) + 1e-6f);
#pragma unroll
            for (int ps = 0; ps < 2; ++ps) { const int qd = ps ? qb : qa, c0 = 4 * qd; const bool act = ps == 0 || lane < 32;
              if (act) *(GAS v2u*)(MIX + (size_t)m * DM + 640 + c0) = pk4(yv[ps] * (qd < 48 ? r0 : r1) * sng[ps]); }
        }
    }
    __syncthreads();
}
namespace cg = cooperative_groups;
constexpr int N_PHASES = 9 * DEPTH + 1;
__global__ void __launch_bounds__(NWAVES * 64, 2) mk_fwd(Args args) {
    extern __shared__ __attribute__((aligned(16))) unsigned char lds_raw[];
    Frame F;
    F.lds = (LAS unsigned char*)lds_raw;
    F.tid = threadIdx.x; F.lane = F.tid & 63; F.wave = __builtin_amdgcn_readfirstlane(F.tid >> 6);
    F.G = gridDim.x; { const int bx = blockIdx.x; F.vcu = (F.G % 8 == 0) ? (bx % 8) * (F.G / 8) + bx / 8 : bx; }
    volatile LAS unsigned* MISC = (volatile LAS unsigned*)(F.lds + MISC_OFF);
    if (F.tid < 64) MISC[F.tid] = 0u;
    if (F.tid < 34) *(LAS unsigned long long*)(F.lds + PTAB_OFF + 8 * F.tid) = ((const unsigned long long*)__builtin_amdgcn_kernarg_segment_ptr())[F.tid];
    __syncthreads();
    unsigned* ctl = (unsigned*)(WSP(F) + WS_CTL);
    XcdBarrier bar = xcd_barrier_post(ctl + CW_BAR, MISC + 8);
    const int lo = args.ph_lo, hi = args.ph_hi;
#define IN_(k) (lo <= (k) && (k) < hi)
#define SEAM(k) do { if (IN_(k) && IN_((k) + 1)) { if ((k) == 0) cg::this_grid().sync(); else xcd_barrier(bar); } } while (0)
#define LAYER(l, B) \
    if (IN_(B + 0)) { phase_convert(F, l); phase_norm(F, l == 0 ? INP(F, 0) : OUTP(F), INP(F, 1) + l * DM, (GAS bf16*)(WSP(F) + WS_XN)); } SEAM(B + 0); \
    if (IN_(B + 1)) { unsigned char* ws = (unsigned char*)WSP(F); pg8::Gemm g{(const bf16*)(ws + WS_XN), (const bf16*)(ws + WS_WIN), M, NINP, DM}; pg8::StaticOrder S; S.init(M, NINP, F.G, (int)blockIdx.x); \
            pg8::EpiBf16<0> E{(bf16*)(ws + WS_COLS), NINP, nullptr, 0, 0, 1.f}; \
            pg8::gemm_phase<pg8::EpiBf16<0>, pg8::StaticOrder, PG8_ALIGN, PG8_SP2>(F.lds, g, S, E); } SEAM(B + 1); \
    if (IN_(B + 2)) { phase_gates(F, l); phase_ssd_conv(F, l); } SEAM(B + 2); \
    if (IN_(B + 3)) { const int bx = blockIdx.x; \
            if (bx < 96) { const int c8 = bx & 7, k8 = bx >> 3; rwkv_scan(F, l, c8 + 8 * (k8 >> 2), k8 & 3, (unsigned)l * (SEQ / 32)); } else if (bx < 144) rwkv_produce(F, l, (bx - 96) % 24, (bx - 96) / 24, (unsigned)l * (SEQ / 32)); else if (bx < 216) { const int u = bx - 144, sg = 2 - (u / 24); ssd_seq(F, l, u % 24, sg == 0 ? 0 : (sg == 1 ? 43 : 86), sg == 0 ? 43 : (sg == 1 ? 86 : 128)); } else if (bx < 248) { const int u = bx - 216, sg = 1 - (u / 16); mlstm_seq(F, l, u % 16, 64 * sg, 64 * sg + 64); } } SEAM(B + 3); \
    if (IN_(B + 4)) phase_post(F, l); SEAM(B + 4); \
    if (IN_(B + 5)) { unsigned char* ws = (unsigned char*)WSP(F); pg8::Gemm g{(const bf16*)(ws + WS_XN), (const bf16*)(ws + WS_WOUT), M, DM, DM}; pg8::StaticOrder S; S.init(M, DM, F.G, (int)blockIdx.x); \
            pg8::EpiResidual E{l == 0 ? (const float*)INP(F, 0) : (const float*)OUTP(F), (float*)OUTP(F), DM}; \
            pg8::gemm_phase<pg8::EpiResidual, pg8::StaticOrder, PG8_ALIGN, PG8_SP2>(F.lds, g, S, E); } SEAM(B + 5); \
    if (IN_(B + 6)) phase_norm(F, OUTP(F), INP(F, 27) + l * DM, (GAS bf16*)(WSP(F) + WS_XN)); SEAM(B + 6); \
    if (IN_(B + 7)) { unsigned char* ws = (unsigned char*)WSP(F); pg8::Gemm g{(const bf16*)(ws + WS_XN), (const bf16*)(ws + WS_WGU), M, 2 * FFN, DM}; pg8::StaticOrder S; S.init(M, 2 * FFN, F.G, (int)blockIdx.x); \
            pg8::EpiSwiGLU E{(bf16*)(ws + WS_COLS), FFN}; \
            pg8::gemm_phase<pg8::EpiSwiGLU, pg8::StaticOrder, PG8_ALIGN, PG8_SP2>(F.lds, g, S, E); } SEAM(B + 7); \
    if (IN_(B + 8)) { unsigned char* ws = (unsigned char*)WSP(F); pg8::Gemm g{(const bf16*)(ws + WS_COLS), (const bf16*)(ws + WS_WDN), M, DM, FFN}; pg8::StaticOrder S; S.init(M, DM, F.G, (int)blockIdx.x); \
            pg8::EpiResidual E{(const float*)OUTP(F), (float*)OUTP(F), DM}; \
            pg8::gemm_phase<pg8::EpiResidual, pg8::StaticOrder, PG8_ALIGN, PG8_SP2>(F.lds, g, S, E); } SEAM(B + 8);
    LAYER(0, 0)
    LAYER(1, 9)
    if (IN_(18)) phase_final_norm(F, OUTP(F), INP(F, 31));
#undef IN_
#undef SEAM
#undef LAYER
}

#ifndef MK_PER_PHASE
#define MK_PER_PHASE 0
#endif
extern "C" void kernel_launch(void* const* d_in, const int* in_sizes, int n_in, void* d_out, int out_size, void* d_ws, size_t ws_size, hipStream_t stream) {
    static int grid = 0;
    if (grid == 0) {
        int dev = 0, cus = 0;
        if (n_in != 32 || out_size != M * DM || ws_size < WS_END) { fprintf(stderr, "kernel_launch: unexpected shapes (n_in %d out %d ws %zu)\n", n_in, out_size, ws_size); grid = -1; return; }
        if (hipGetDevice(&dev) != hipSuccess || hipDeviceGetAttribute(&cus, hipDeviceAttributeMultiprocessorCount, dev) != hipSuccess) { grid = -1; return; }
        if (hipFuncSetAttribute((const void*)mk_fwd, hipFuncAttributeMaxDynamicSharedMemorySize, LDS_BYTES) != hipSuccess) { fprintf(stderr, "kernel_launch: hipFuncSetAttribute failed\n"); grid = -1; return; }
        int per_cu = 0;
        if (hipOccupancyMaxActiveBlocksPerMultiprocessor(&per_cu, (const void*)mk_fwd, NWAVES * 64, LDS_BYTES) != hipSuccess || per_cu < 1) { fprintf(stderr, "kernel_launch: occupancy query says %d\n", per_cu); }
        (void)hipGetLastError();
        grid = cus;
    }
    if (grid < 0) return;
    (void)hipMemsetAsync((char*)d_ws + WS_CTL, 0, CTL_ZERO_BYTES, stream);
    Args a{};
    for (int i = 0; i < 32; ++i) a.in[i] = (const float*)d_in[i];
    a.out = (float*)d_out; a.ws = (unsigned char*)d_ws;
#if MK_PER_PHASE
    for (int p = 0; p < N_PHASES; ++p) { a.ph_lo = p; a.ph_hi = p + 1; hipLaunchKernelGGL(mk_fwd, dim3(grid), dim3(NWAVES * 64), LDS_BYTES, stream, a); }
#else
    a.ph_lo = 0; a.ph_hi = N_PHASES;
    void* kargs[] = {&a};
    hipError_t e = hipLaunchCooperativeKernel((const void*)mk_fwd, dim3(grid), dim3(NWAVES * 64), kargs, LDS_BYTES, stream);
    if (e != hipSuccess) fprintf(stderr, "cooperative launch failed: %s (grid %d)\n", hipGetErrorString(e), grid);
#endif
}
```
